# Optimizing an MI355X kernel written in HIP

```python
import math
import jax, jax.numpy as jnp
from jax import lax
import numpy as np

D_MODEL = 1024
BATCH = 4
SEQ = 8192
DEPTH = 4

CHUNK = 64
N_MIXERS = 2
N_A_LAYERS = (DEPTH + 1) // 2
N_B_LAYERS = DEPTH // 2
HEAD_DIM = 64
N_HEADS = D_MODEL // HEAD_DIM
ATTN_DIM = N_HEADS * HEAD_DIM
KV_GROUPS = 4
Q_PER_KV = N_HEADS // KV_GROUPS
IDX_HEADS = 8
IDX_DIM = 64
TOPK_MAX = 256
QBLK = 128
T5_BUCKETS = 32
T5_MAX_DIST = 128
LEFT_CHUNKS = 8
BAND = (LEFT_CHUNKS + 1) * CHUNK
REL_CLIP = 256
D_FF = 2816
CONV_WIDTH = 3
EPS = 1e-6
A_SIZES = (ATTN_DIM, KV_GROUPS * HEAD_DIM, KV_GROUPS * HEAD_DIM,
           IDX_HEADS * IDX_DIM, IDX_DIM, IDX_HEADS)
A_IN = sum(A_SIZES)
A_SPLITS = tuple(int(v) for v in np.cumsum(A_SIZES)[:-1])
B_IN = 3 * ATTN_DIM

kernel_name = "hybrid_dsa_chunkband_convffn"


def rmsnorm(x, g):
    xf = x.astype(jnp.float32)
    y = xf * lax.rsqrt(jnp.mean(xf * xf, axis=-1, keepdims=True) + EPS)
    return (y * g.astype(jnp.float32)).astype(x.dtype)


def rms_unit(x):
    xf = x.astype(jnp.float32)
    return (xf * lax.rsqrt(jnp.mean(xf * xf, axis=-1, keepdims=True) + EPS)).astype(x.dtype)


def t5_bucket(rel):
    half = T5_BUCKETS // 2
    max_exact = half // 2
    n = jnp.abs(rel)
    nf = jnp.maximum(n, 1).astype(jnp.float32)
    large = max_exact + (jnp.log(nf / max_exact) / math.log(T5_MAX_DIST / max_exact)
                         * (half - max_exact)).astype(jnp.int32)
    large = jnp.minimum(large, half - 1)
    return jnp.where(rel > 0, half, 0) + jnp.where(n < max_exact, n, large)


def dsa_mixer(h, w_in, q_g, k_g, t5_table):
    B, S, _ = h.shape
    topk = min(TOPK_MAX, S // 4)
    proj = h @ w_in
    q, k, v, qi, ki, wi = jnp.split(proj, list(A_SPLITS), axis=-1)
    q = rmsnorm(q.reshape(B, S, KV_GROUPS, Q_PER_KV, HEAD_DIM), q_g)
    k = rmsnorm(k.reshape(B, S, KV_GROUPS, HEAD_DIM), k_g)
    v = v.reshape(B, S, KV_GROUPS, HEAD_DIM)
    qi = qi.reshape(B, S, IDX_HEADS, IDX_DIM)
    ki = rms_unit(ki)
    wi = wi * (IDX_HEADS ** -0.5 * IDX_DIM ** -0.5)
    key_chunk = jnp.arange(S) // CHUNK
    scale = HEAD_DIM ** -0.5

    def block(start):
        q_b = lax.dynamic_slice_in_dim(q, start, QBLK, axis=1)
        qi_b = lax.dynamic_slice_in_dim(qi, start, QBLK, axis=1)
        wi_b = lax.dynamic_slice_in_dim(wi, start, QBLK, axis=1)
        tpos = start + jnp.arange(QBLK)
        idx_logits = jnp.einsum('bqhd,bsd->bqhs', qi_b, ki)
        score = jnp.einsum('bqhs,bqh->bqs', jax.nn.relu(idx_logits), wi_b).astype(jnp.float32)
        admissible = key_chunk[None, :] <= (tpos // CHUNK)[:, None]
        score = jnp.where(admissible[None], score, -jnp.inf)
        sel_score, sel = lax.top_k(score, topk)
        valid = jnp.isfinite(sel_score)
        k_sel = jax.vmap(lambda kb, ib: kb[ib])(k, sel)
        v_sel = jax.vmap(lambda vb, ib: vb[ib])(v, sel)
        logits = jnp.einsum('bqgrd,bqkgd->bqgrk', q_b, k_sel).astype(jnp.float32) * scale
        bias = t5_table[t5_bucket(sel - tpos[None, :, None])]
        bias = bias.reshape(B, QBLK, topk, KV_GROUPS, Q_PER_KV).transpose(0, 1, 3, 4, 2)
        logits = logits + bias.astype(jnp.float32)
        logits = jnp.where(valid[:, :, None, None, :], logits, -jnp.inf)
        p = jax.nn.softmax(logits, axis=-1).astype(v.dtype)
        o = jnp.einsum('bqgrk,bqkgd->bqgrd', p, v_sel)
        return o.reshape(B, QBLK, ATTN_DIM)

    starts = jnp.arange(S // QBLK) * QBLK
    out = lax.map(block, starts)
    return out.transpose(1, 0, 2, 3).reshape(B, S, ATTN_DIM)


def chunk_band_mixer(h, w_in, q_g, k_g, rel_table):
    B, S, _ = h.shape
    proj = h @ w_in
    q, k, v = jnp.split(proj, 3, axis=-1)
    q = rmsnorm(q.reshape(B, S, N_HEADS, HEAD_DIM), q_g)
    k = rmsnorm(k.reshape(B, S, N_HEADS, HEAD_DIM), k_g)
    v = v.reshape(B, S, N_HEADS, HEAD_DIM)
    pad = LEFT_CHUNKS * CHUNK
    k_pad = jnp.pad(k, ((0, 0), (pad, 0), (0, 0), (0, 0)))
    v_pad = jnp.pad(v, ((0, 0), (pad, 0), (0, 0), (0, 0)))
    qi = jnp.arange(CHUNK)
    kj = jnp.arange(BAND)
    dist = qi[:, None] - kj[None, :] + pad
    bias = rel_table[jnp.clip(dist, -REL_CLIP, REL_CLIP) + REL_CLIP]
    bias = bias.transpose(2, 0, 1).astype(jnp.float32)
    scale = HEAD_DIM ** -0.5

    def chunk(c):
        start = c * CHUNK
        q_c = lax.dynamic_slice_in_dim(q, start, CHUNK, axis=1)
        k_c = lax.dynamic_slice_in_dim(k_pad, start, BAND, axis=1)
        v_c = lax.dynamic_slice_in_dim(v_pad, start, BAND, axis=1)
        logits = jnp.einsum('bqhd,bkhd->bhqk', q_c, k_c).astype(jnp.float32) * scale + bias
        valid = kj >= pad - start
        logits = jnp.where(valid, logits, -jnp.inf)
        p = jax.nn.softmax(logits, axis=-1).astype(v.dtype)
        o = jnp.einsum('bhqk,bkhd->bqhd', p, v_c)
        return o.reshape(B, CHUNK, ATTN_DIM)

    out = lax.map(chunk, jnp.arange(S // CHUNK))
    return out.transpose(1, 0, 2, 3).reshape(B, S, ATTN_DIM)


def _shift(u, n):
    return u if n == 0 else jnp.pad(u[:, :-n], ((0, 0), (n, 0), (0, 0)))


def conv_ffn(h, w_up, conv_w, conv_b, w_down):
    u = h @ w_up
    y = conv_b
    for j in range(CONV_WIDTH):
        y = y + conv_w[j] * _shift(u, CONV_WIDTH - 1 - j)
    a, g = jnp.split(y, 2, axis=-1)
    return (jax.nn.silu(g) * a) @ w_down


def setup_inputs(seed: int = 0) -> dict:
    key = jax.random.key(seed)
    ks = jax.random.split(key, 14)
    nrm = jax.random.normal
    f32 = jnp.float32
    x = nrm(ks[0], (BATCH, SEQ, D_MODEL), f32)
    attn_norm_g = 1.0 + 0.02 * nrm(ks[1], (DEPTH, D_MODEL), f32)
    w_in_a = nrm(ks[2], (N_A_LAYERS, D_MODEL, A_IN), f32) * D_MODEL ** -0.5
    w_in_b = nrm(ks[3], (N_B_LAYERS, D_MODEL, B_IN), f32) * D_MODEL ** -0.5
    q_norm_g = 1.0 + 0.02 * nrm(ks[4], (DEPTH, HEAD_DIM), f32)
    k_norm_g = 1.0 + 0.02 * nrm(ks[5], (DEPTH, HEAD_DIM), f32)
    t5_bias = 0.5 * nrm(ks[6], (T5_BUCKETS, N_HEADS), f32)
    rel_bias_b = 0.5 * nrm(ks[7], (N_B_LAYERS, 2 * REL_CLIP + 1, N_HEADS), f32)
    w_out = nrm(ks[8], (DEPTH, ATTN_DIM, D_MODEL), f32) * ATTN_DIM ** -0.5
    ffn_norm_g = 1.0 + 0.02 * nrm(ks[9], (DEPTH, D_MODEL), f32)
    w_up = nrm(ks[10], (DEPTH, D_MODEL, 2 * D_FF), f32) * D_MODEL ** -0.5
    conv_w = 0.3 * nrm(ks[11], (DEPTH, CONV_WIDTH, 2 * D_FF), f32) \
        + jnp.zeros((CONV_WIDTH,), f32).at[CONV_WIDTH - 1].set(1.0)[None, :, None]
    conv_b = 0.02 * nrm(ks[12], (DEPTH, 2 * D_FF), f32)
    w_down = nrm(ks[13], (DEPTH, D_FF, D_MODEL), f32) * D_FF ** -0.5
    return {"x": x, "attn_norm_g": attn_norm_g, "w_in_a": w_in_a, "w_in_b": w_in_b,
            "q_norm_g": q_norm_g, "k_norm_g": k_norm_g, "t5_bias": t5_bias,
            "rel_bias_b": rel_bias_b, "w_out": w_out, "ffn_norm_g": ffn_norm_g,
            "w_up": w_up, "conv_w": conv_w, "conv_b": conv_b, "w_down": w_down}


def reference(x, attn_norm_g, w_in_a, w_in_b, q_norm_g, k_norm_g, t5_bias,
              rel_bias_b, w_out, ffn_norm_g, w_up, conv_w, conv_b, w_down):
    h = x
    for i in range(DEPTH):
        n = rmsnorm(h, attn_norm_g[i])
        if i % N_MIXERS == 0:
            m = dsa_mixer(n, w_in_a[i // N_MIXERS], q_norm_g[i], k_norm_g[i], t5_bias)
        else:
            m = chunk_band_mixer(n, w_in_b[i // N_MIXERS], q_norm_g[i], k_norm_g[i],
                                 rel_bias_b[i // N_MIXERS])
        h = h + m @ w_out[i]
        h = h + conv_ffn(rmsnorm(h, ffn_norm_g[i]), w_up[i], conv_w[i], conv_b[i], w_down[i])
    return h
```

```cpp
#include <hip/hip_runtime.h>
#include <cstdio>
#include <cstdint>
namespace pg8 {
#define PG8_LAS __attribute__((address_space(3)))
typedef unsigned short bf16_t;
typedef short bf16x8 __attribute__((ext_vector_type(8)));
typedef float f32x4 __attribute__((ext_vector_type(4)));
typedef unsigned u32x4 __attribute__((ext_vector_type(4)));
constexpr int BM = 256, BK = 64, HALF = 128, HTB = HALF * BK * 2  , STAGE_BYTES = 8 * HTB, NXCD = 8, WGM = 8;

__host__ __device__ __forceinline__ int lds_byte(int r, int c) { const int st = (r >> 4) * 2 + (c >> 5), rr = r & 15, cc = c & 31, ob = rr * 64 + cc * 2; return st * 1024 + (ob ^ (((ob >> 9) & 1) << 5)); }
__host__ __device__ __forceinline__ void stage_rc(int b, int& R, int& C) { const int st = b / 1024, sb = b % 1024, swz = sb ^ (((sb >> 9) & 1) << 5); R = (st >> 1) * 16 + swz / 64; C = (st & 1) * 32 + (swz % 64) / 2; }
__host__ __device__ __forceinline__ int perm32(int rho) { const int n = rho >> 4, i = rho & 15; return 8 * (i >> 2) + 4 * n + (i & 3); }

struct Unit { int pm, pn; };
struct Gemm { const bf16_t* A; const bf16_t* Bt; int M, N, K; };

struct StaticOrder {
    int nM, nN, nwg, G, c;
    __host__ __device__ void init(int M, int N, int G_, int c_) { nM = M / BM; nN = N / BM; nwg = nM * nN; G = G_; c = c_; }
    __host__ __device__ bool next(int i, Unit& u) const {
        const long L = (long)i * G + c; if (L >= nwg) return false;
        int wgid = (int)L; { const int q = nwg / NXCD, r = nwg % NXCD, xcd = wgid % NXCD, off = wgid / NXCD; wgid = (xcd < r ? xcd * (q + 1) : r * (q + 1) + (xcd - r) * q) + off; }
        const int nig = WGM * nN, gid = wgid / nig, fm = gid * WGM, gsz = (nM - fm) < WGM ? (nM - fm) : WGM;
        u.pm = fm + ((wgid % nig) % gsz); u.pn = (wgid % nig) / gsz; return true;
    }
    __device__ __forceinline__ void a_ready(const Unit&) const {}
    __device__ __forceinline__ void done(const Unit&) const {}
};
__device__ __forceinline__ unsigned cvt_pk_bf16(float lo, float hi) { unsigned r; asm volatile("v_cvt_pk_bf16_f32 %0, %1, %2" : "=v"(r) : "v"(lo), "v"(hi)); return r; }
template <class Epi, class Sched, bool ALIGN_EPI = false, bool SP2 = false>
__device__ __forceinline__ void gemm_phase(PG8_LAS unsigned char* lds, const Gemm g, const Sched& S, const Epi& E) {
    int tid_ = threadIdx.x; asm volatile("" : "+v"(tid_));
    const int tid = tid_, wid = __builtin_amdgcn_readfirstlane(tid >> 6), lane = tid & 63, wr = wid >> 2, wc = wid & 3, fr = lane & 15, fq = lane >> 4;
    const int K = g.K, nt = K / BK;
    unsigned voffA[2], voffB[2];
#pragma unroll
    for (int i = 0; i < 2; ++i) { int R, C; stage_rc(tid * 16 + i * 8192, R, C); const int Rb = Epi::PERM ? ((R & ~31) + perm32(R & 31)) : R;
        voffA[i] = (unsigned)(R * K + C) * 2u; voffB[i] = (unsigned)(Rb * K + C) * 2u; }
    const size_t kstep = (size_t)(BK * 2);
    const size_t hstep = (size_t)HALF * K * 2;
    const size_t tstep = 2 * hstep;
    const unsigned ldsw = (unsigned)wid * 1024u;
    const int aoff = lds_byte(wr * 64 + fr, fq * 8), boff = lds_byte(wc * 32 + fr, fq * 8);
#define PG8_SA(b, h) (((b) * 2 + (h)) * HTB)
#define PG8_SB(b, h) ((4 + (b) * 2 + (h)) * HTB)
#define PG8_STAGE(bufoff, gbase, voff) do { _Pragma("unroll") for (int _i = 0; _i < 2; ++_i) \
        __builtin_amdgcn_global_load_lds((const unsigned*)((const char*)(gbase) + (voff)[_i]), (PG8_LAS unsigned*)(lds + (bufoff) + ldsw + _i * 8192), 16, 0, 0); } while (0)
#define PG8_LDA(dst, b, h) do { _Pragma("unroll") for (int m = 0; m < 4; ++m) _Pragma("unroll") for (int k = 0; k < 2; ++k) dst[m][k] = *(const PG8_LAS bf16x8*)(lds + PG8_SA(b, h) + aoff + m * 2048 + k * 1024); } while (0)
#define PG8_LDB(dst, b, h) do { _Pragma("unroll") for (int n = 0; n < 2; ++n) _Pragma("unroll") for (int k = 0; k < 2; ++k) dst[n][k] = *(const PG8_LAS bf16x8*)(lds + PG8_SB(b, h) + boff + n * 2048 + k * 1024); } while (0)
#define PG8_MMA(ai, bj, At, Bt) do { __builtin_amdgcn_s_setprio(1); _Pragma("unroll") for (int m = 0; m < 4; ++m) _Pragma("unroll") for (int n = 0; n < 2; ++n) _Pragma("unroll") for (int k = 0; k < 2; ++k) \
        acc[ai][bj][m][n] = __builtin_amdgcn_mfma_f32_16x16x32_bf16(Bt[n][k], At[m][k], acc[ai][bj][m][n], 0, 0, 0); __builtin_amdgcn_s_setprio(0); } while (0)
#define PG8_WAIT_V(n) asm volatile("s_waitcnt vmcnt(" #n ")" ::: "memory")
#define PG8_WAIT_L(n) asm volatile("s_waitcnt lgkmcnt(" #n ")" ::: "memory")
#define PG8_BAR __builtin_amdgcn_s_barrier()
#define PG8_SCHED __builtin_amdgcn_sched_barrier(0)
    Unit cur, nxt; int ui = 0;
    if (!S.next(0, cur)) return;
    f32x4 acc[2][2][4][2];
#pragma unroll
    for (int a = 0; a < 2; ++a)
#pragma unroll
        for (int b = 0; b < 2; ++b)
#pragma unroll
            for (int m = 0; m < 4; ++m)
#pragma unroll
                for (int n = 0; n < 2; ++n) acc[a][b][m][n] = (f32x4){0.f, 0.f, 0.f, 0.f};
    bf16x8 At[4][2], B0[2][2], B1[2][2];
    const char* cA = (const char*)g.A + (size_t)cur.pm * tstep; const char* cB = (const char*)g.Bt + (size_t)cur.pn * tstep;
    S.a_ready(cur);
    if constexpr (SP2) {
        PG8_STAGE(PG8_SB(0, 0), cB, voffB); PG8_STAGE(PG8_SB(0, 1), cB + hstep, voffB); PG8_STAGE(PG8_SA(0, 0), cA, voffA); PG8_STAGE(PG8_SA(0, 1), cA + hstep, voffA);
        if (wr == 1) PG8_BAR;
        PG8_WAIT_V(2); PG8_BAR;
        PG8_STAGE(PG8_SB(1, 0), cB + kstep, voffB); PG8_STAGE(PG8_SA(1, 0), cA + kstep, voffA); PG8_STAGE(PG8_SB(1, 1), cB + hstep + kstep, voffB);
        PG8_WAIT_V(6); PG8_BAR;
    } else {
        PG8_STAGE(PG8_SB(0, 0), cB, voffB); PG8_STAGE(PG8_SA(0, 0), cA, voffA); PG8_STAGE(PG8_SB(0, 1), cB + hstep, voffB); PG8_STAGE(PG8_SA(0, 1), cA + hstep, voffA);
        if (wr == 1) PG8_BAR;
        PG8_WAIT_V(4); PG8_BAR;
        PG8_STAGE(PG8_SB(1, 0), cB + kstep, voffB); PG8_STAGE(PG8_SA(1, 0), cA + kstep, voffA); PG8_STAGE(PG8_SB(1, 1), cB + hstep + kstep, voffB);
        PG8_WAIT_V(6); PG8_BAR;
    }
    for (;;) {
        const bool has_next = S.next(ui + 1, nxt);
        const char* nA = has_next ? (const char*)g.A + (size_t)nxt.pm * tstep : cA; const char* nB = has_next ? (const char*)g.Bt + (size_t)nxt.pn * tstep : cB;
        for (int t = 0; t < nt; t += 2) {
            const bool last = (t == nt - 2);
            const char* a1 = cA + (size_t)(t + 1) * kstep;
            const char* a2 = last ? nA : cA + (size_t)(t + 2) * kstep; const char* b2 = last ? nB : cB + (size_t)(t + 2) * kstep;
            const char* a3 = a2 + kstep; const char* b3 = b2 + kstep;
            if (last && has_next) S.a_ready(nxt);
            if constexpr (SP2) {
            PG8_LDB(B0, 0, 0); PG8_LDB(B1, 0, 1); PG8_SCHED; PG8_LDA(At, 0, 0); PG8_STAGE(PG8_SA(1, 1), a1 + hstep, voffA);
            PG8_WAIT_V(8); PG8_WAIT_L(0); PG8_BAR; PG8_MMA(0, 0, At, B0); PG8_MMA(0, 1, At, B1); PG8_BAR; PG8_SCHED;
            PG8_LDA(At, 0, 1); PG8_STAGE(PG8_SB(0, 0), b2, voffB); PG8_STAGE(PG8_SB(0, 1), b2 + hstep, voffB); PG8_STAGE(PG8_SA(0, 0), a2, voffA);
            PG8_WAIT_V(8); PG8_WAIT_L(0); PG8_BAR; PG8_MMA(1, 0, At, B0); PG8_MMA(1, 1, At, B1); PG8_BAR; PG8_SCHED;
            PG8_LDB(B0, 1, 0); PG8_LDB(B1, 1, 1); PG8_SCHED; PG8_LDA(At, 1, 0); PG8_STAGE(PG8_SA(0, 1), a2 + hstep, voffA);
            PG8_WAIT_V(8); PG8_WAIT_L(0); PG8_BAR; PG8_MMA(0, 0, At, B0); PG8_MMA(0, 1, At, B1); PG8_BAR; PG8_SCHED;
            PG8_LDA(At, 1, 1); PG8_STAGE(PG8_SB(1, 0), b3, voffB); PG8_STAGE(PG8_SB(1, 1), b3 + hstep, voffB); PG8_STAGE(PG8_SA(1, 0), a3, voffA);
            PG8_WAIT_V(8); PG8_WAIT_L(0); PG8_BAR; PG8_MMA(1, 0, At, B0); PG8_MMA(1, 1, At, B1); PG8_BAR; PG8_SCHED;
            } else {
            PG8_LDB(B0, 0, 0); PG8_SCHED; PG8_LDA(At, 0, 0); PG8_STAGE(PG8_SA(1, 1), a1 + hstep, voffA);
            PG8_WAIT_L(8); PG8_BAR; PG8_WAIT_L(0); PG8_MMA(0, 0, At, B0); PG8_BAR; PG8_SCHED;
            PG8_LDB(B1, 0, 1); PG8_STAGE(PG8_SB(0, 0), b2, voffB);
            PG8_BAR; PG8_WAIT_L(0); PG8_MMA(0, 1, At, B1); PG8_BAR;
            PG8_LDA(At, 0, 1); PG8_STAGE(PG8_SA(0, 0), a2, voffA);
            PG8_BAR; PG8_WAIT_L(0); PG8_MMA(1, 0, At, B0); PG8_BAR; PG8_SCHED;
            PG8_STAGE(PG8_SB(0, 1), b2 + hstep, voffB);
            PG8_WAIT_V(6); PG8_BAR; PG8_MMA(1, 1, At, B1); PG8_BAR;
            PG8_LDB(B0, 1, 0); PG8_SCHED; PG8_LDA(At, 1, 0); PG8_STAGE(PG8_SA(0, 1), a2 + hstep, voffA);
            PG8_WAIT_L(8); PG8_BAR; PG8_WAIT_L(0); PG8_MMA(0, 0, At, B0); PG8_BAR; PG8_SCHED;
            PG8_LDB(B1, 1, 1); PG8_STAGE(PG8_SB(1, 0), b3, voffB);
            PG8_BAR; PG8_WAIT_L(0); PG8_MMA(0, 1, At, B1); PG8_BAR;
            PG8_LDA(At, 1, 1); PG8_STAGE(PG8_SA(1, 0), a3, voffA);
            PG8_BAR; PG8_WAIT_L(0); PG8_MMA(1, 0, At, B0); PG8_BAR; PG8_SCHED;
            PG8_STAGE(PG8_SB(1, 1), b3 + hstep, voffB);
            PG8_WAIT_V(6); PG8_BAR; PG8_MMA(1, 1, At, B1); PG8_BAR;
            }
        }
        if constexpr (ALIGN_EPI) { if (wr == 0) PG8_BAR; }
        if constexpr (!Epi::AFTER_DRAIN) { E(acc, cur, wr, wc, fr, fq); S.done(cur); }
        if (!has_next) break;
#pragma unroll
        for (int a = 0; a < 2; ++a)
#pragma unroll
            for (int b = 0; b < 2; ++b)
#pragma unroll
                for (int m = 0; m < 4; ++m)
#pragma unroll
                    for (int n = 0; n < 2; ++n) acc[a][b][m][n] = (f32x4){0.f, 0.f, 0.f, 0.f};
        cur = nxt; cA = nA; cB = nB; ++ui;
        if constexpr (ALIGN_EPI) { if (wr == 1) PG8_BAR; }
    }
    PG8_WAIT_V(0);
    if constexpr (!ALIGN_EPI) { if (wr == 0) PG8_BAR; }
    PG8_BAR;
    if constexpr (Epi::AFTER_DRAIN) { E.fused(acc, cur, wr, wc, fr, fq, lds, wid, lane); S.done(cur); }
#undef PG8_SA
#undef PG8_SB
#undef PG8_STAGE
#undef PG8_LDA
#undef PG8_LDB
#undef PG8_MMA
#undef PG8_WAIT_V
#undef PG8_WAIT_L
#undef PG8_BAR
#undef PG8_SCHED
}
}

constexpr int NWAVES = 8;
constexpr int BATCH = 4, SEQ = 8192, DM = 1024, MTOK = BATCH * SEQ, DEPTH = 4;
constexpr int NA_SRC = 2120, NA_PAD = 2304, NB = 3072, FF = 2816, NUP = 2 * FF;
constexpr float EPS = 1e-6f;
constexpr float LOG2E = 1.4426950408889634f;
constexpr float C2 = 0.125f * LOG2E;
constexpr int NBLK64 = MTOK / 64;

constexpr size_t MiB = 1u << 20;
constexpr size_t WS_CTL = 0, CTL_ZERO_BYTES = 1 * MiB;
constexpr size_t WS_W_INA = 2 * MiB;
constexpr size_t WS_W_INB = 11 * MiB;
constexpr size_t WS_W_OUT = 23 * MiB;
constexpr size_t WS_W_UP = 31 * MiB;
constexpr size_t WS_W_DN = 75 * MiB;
constexpr size_t WS_HB = 98 * MiB;
constexpr size_t WS_M = 162 * MiB;
constexpr size_t WS_SS = 226 * MiB;
constexpr size_t WS_HALO = 228 * MiB;
constexpr size_t WS_PROJ = 272 * MiB;
constexpr size_t WS_END = 464 * MiB;
constexpr size_t PA_QA = 0, PA_KA = 64 * MiB, PA_VA = 80 * MiB, PA_QI = 96 * MiB, PA_KI = 128 * MiB, PA_WI = 132 * MiB;
constexpr size_t PB_STRIDE = 64 * MiB;
constexpr int CW_BAR = 4096;

constexpr int RING_OFF = 0, RING_BYTES = 131072;
constexpr int AUX_OFF = RING_BYTES;
constexpr int LDSCTL_OFF = RING_BYTES + 4096, MISC_OFF = LDSCTL_OFF + 320;
constexpr int LDS_BYTES = 147456;
static_assert(MISC_OFF + 128 <= LDS_BYTES, "LDS map");

#define GAS __attribute__((address_space(1)))
#define LAS __attribute__((address_space(3)))
typedef unsigned short bf16;
typedef unsigned v4u __attribute__((ext_vector_type(4)));
typedef unsigned v2u __attribute__((ext_vector_type(2)));
typedef float f32x4 __attribute__((ext_vector_type(4)));
typedef float f32x16 __attribute__((ext_vector_type(16)));
typedef short bf16x8 __attribute__((ext_vector_type(8)));
typedef short s16x4 __attribute__((ext_vector_type(4)));
typedef float f32x2_t __attribute__((ext_vector_type(2)));
typedef GAS unsigned gu32;
#define RLX_AGENT __ATOMIC_RELAXED, __HIP_MEMORY_SCOPE_AGENT
#define LDS_WAIT() asm volatile("s_waitcnt lgkmcnt(0)" ::: "memory")
#define VM_WAIT() asm volatile("s_waitcnt vmcnt(0)" ::: "memory")
__device__ __forceinline__ unsigned f2bf(float f) { unsigned u = __builtin_bit_cast(unsigned, f); return (u + 0x7fffu + ((u >> 16) & 1u)) >> 16; }
__device__ __forceinline__ unsigned pk2(float lo, float hi) { return f2bf(lo) | (f2bf(hi) << 16); }
__device__ __forceinline__ unsigned cvtpk(float lo, float hi) { return pg8::cvt_pk_bf16(lo, hi); }
__device__ __forceinline__ float bf_lo(unsigned u) { return __builtin_bit_cast(float, u << 16); }
__device__ __forceinline__ float bf_hi(unsigned u) { return __builtin_bit_cast(float, u & 0xffff0000u); }

#define XB_TMO      128
#define XB_XCNT(j)  (256  + 64 * (j))
#define XB_XSUB(j)  (1280 + 64 * (j))
#define XB_XGEN(j)  (2304 + 64 * (j))
#define XB_TOP      3328
#define XB_TOPGEN   3392
#define XCD_BAR_WORDS 3456
#define XB_SPIN_CAP (1u << 18)

__device__ __forceinline__ unsigned xb_ld(unsigned* p)              { return __hip_atomic_load(p, __ATOMIC_RELAXED, __HIP_MEMORY_SCOPE_AGENT); }
__device__ __forceinline__ unsigned xb_add(unsigned* p, unsigned v) { return __hip_atomic_fetch_add(p, v, __ATOMIC_RELAXED, __HIP_MEMORY_SCOPE_AGENT); }
__device__ __forceinline__ unsigned xb_xcc_id() { return (unsigned)__builtin_amdgcn_s_getreg((3 << 11) | 20) & 0xFu; }
#define XB_SPIN(cond, bar) do { unsigned _sp = 0; while (cond) { __builtin_amdgcn_s_sleep(1); \
    if ((++_sp & 255u) == 0u) { if (xb_ld(&(bar)[XB_TMO])) break; if (_sp > XB_SPIN_CAP) { atomicAdd(&(bar)[XB_TMO], 1u); break; } } } } while (0)

struct XcdBarrier {
    unsigned* bar; unsigned x;
    volatile LAS unsigned* st;
};

__device__ __forceinline__ XcdBarrier xcd_barrier_post(unsigned* bar, volatile LAS unsigned* st) {
    XcdBarrier b; b.bar = bar; b.x = xb_xcc_id(); b.st = st;
    if (threadIdx.x == 0) (void)xb_add(&bar[XB_XCNT(b.x)], 1u);
    return b;
}
__device__ __forceinline__ void xcd_barrier_complete(unsigned* bar, unsigned x, unsigned& nloc, unsigned& nx) {
    const unsigned G = gridDim.x * gridDim.y * gridDim.z;
    unsigned sum, cnt, mine, sp = 0u;
    for (;;) {
        sum = 0u; cnt = 0u; mine = 0u;
#pragma unroll
        for (unsigned j = 0; j < 16; ++j) { const unsigned c = xb_ld(&bar[XB_XCNT(j)]); sum += c; cnt += (c > 0u) ? 1u : 0u; mine = (j == x) ? c : mine; }
        if (sum == G) break;
        __builtin_amdgcn_s_sleep(1);
        if ((++sp & 255u) == 0u) { if (xb_ld(&bar[XB_TMO])) break; if (sp > XB_SPIN_CAP) { atomicAdd(&bar[XB_TMO], 1u); break; } }
    }
    nloc = mine > 0u ? mine : 1u; nx = cnt > 0u ? cnt : 1u;
}

__device__ __forceinline__ void xcd_barrier(const XcdBarrier& b) {
    asm volatile("s_waitcnt vmcnt(0)" ::: "memory");
    __syncthreads();
    if (threadIdx.x == 0) {
        unsigned* bar = b.bar;
        __builtin_amdgcn_s_waitcnt(0);
        unsigned nloc = b.st[0], nx = b.st[1];
        if (nloc == 0u) { xcd_barrier_complete(bar, b.x, nloc, nx); b.st[0] = nloc; b.st[1] = nx; }
        const unsigned old = xb_add(&bar[XB_XSUB(b.x)], 1u);
        const unsigned gen = old / nloc;
        if (old + 1u == (gen + 1u) * nloc) {
            __builtin_amdgcn_fence(__ATOMIC_RELEASE, "agent");
            asm volatile("s_waitcnt vmcnt(0)" ::: "memory");
            const unsigned og = xb_add(&bar[XB_TOP], 1u);
            const unsigned tg = og / nx;
            if (og + 1u == (tg + 1u) * nx) xb_add(&bar[XB_TOPGEN], 1u);
            else XB_SPIN(xb_ld(&bar[XB_TOPGEN]) == tg, bar);
            __builtin_amdgcn_fence(__ATOMIC_ACQUIRE, "agent");
            xb_add(&bar[XB_XGEN(b.x)], 1u);
            asm volatile("s_waitcnt vmcnt(0)" ::: "memory");
        } else {
            XB_SPIN(xb_ld(&bar[XB_XGEN(b.x)]) == gen, bar);
            __builtin_amdgcn_fence(__ATOMIC_ACQUIRE, "agent");
            asm volatile("s_waitcnt vmcnt(0)" ::: "memory");
        }
    }
    __syncthreads();
}


struct Args {
    const float* x; const float* attn_norm_g; const float* w_in_a; const float* w_in_b; const float* q_norm_g; const float* k_norm_g; const float* t5_bias;
    const float* rel_bias_b; const float* w_out; const float* ffn_norm_g; const float* w_up; const float* conv_w; const float* conv_b; const float* w_down;
    float* out; unsigned char* ws; int ph_lo, ph_hi, li, pad;
};

struct Frame {
    LAS unsigned char* lds;
    volatile LAS unsigned* MISC;
    gu32* ctl;
    int tid, lane, wave, vcu, G;
};

__host__ __device__ __forceinline__ int hmap(int p) { return 64 * ((p >> 5) & 3) + 16 * ((p >> 2) & 3) + 8 * (p >> 7) + 4 * ((p >> 4) & 1) + (p & 3); }
__host__ __device__ __forceinline__ int umap(int p) { return 32 * ((p >> 5) & 3) + 8 * ((p >> 2) & 3) + 4 * ((p >> 4) & 1) + (p & 3); }
__host__ __device__ __forceinline__ int src_col(int type, int n) {
    if (type == 0) return n;
    const int pn = n >> 8, p = n & 255;
    if (type == 2) return 256 * pn + hmap(p);
    if (type == 1) { const int c = hmap(p); return pn < 8 ? 256 * pn + c : (c < 72 ? 2048 + c : -1); }
    return (p >> 7) * FF + 128 * pn + umap(p);
}
__device__ __forceinline__ void convert_item(const float* W, int K, int Nsrc, int Ndst, int type, const float* gain, bf16* WT, LAS float* scr, int item, int lane) {
    const int nblk = Ndst / 32, kb = item / nblk, nb = item % nblk, k0 = 64 * kb, n0 = 32 * nb;
    const int sc = src_col(type, n0 + (lane & 31));
#pragma unroll 8
    for (int i = 0; i < 32; ++i) { const int kk = 2 * i + (lane >> 5); float v = 0.f; if (sc >= 0) v = W[(size_t)(k0 + kk) * Nsrc + sc]; if (gain) v *= gain[k0 + kk]; scr[kk * 33 + (lane & 31)] = v; }
    LDS_WAIT(); asm volatile("" ::: "memory");
    const int c = lane & 7;
#pragma unroll
    for (int j = 0; j < 4; ++j) { const int n = (lane >> 3) + 8 * j; const LAS float* s = scr + (8 * c) * 33 + n;
        v4u o; o.x = pk2(s[0 * 33], s[1 * 33]); o.y = pk2(s[2 * 33], s[3 * 33]); o.z = pk2(s[4 * 33], s[5 * 33]); o.w = pk2(s[6 * 33], s[7 * 33]);
        *(v4u*)(WT + (size_t)(n0 + n) * K + k0 + 8 * c) = o; }
    LDS_WAIT(); asm volatile("" ::: "memory");
}
__device__ __forceinline__ float wave_sum(float v) {
#pragma unroll
    for (int o = 1; o < 64; o <<= 1) v += __shfl_xor(v, o);
    return v;
}
__device__ __forceinline__ void p0_prologue(Frame& F, const Args& a) {
    LAS float* scr = (LAS float*)(F.lds + RING_OFF + F.wave * 16384);
    const int gw = F.vcu * NWAVES + F.wave, NGW = F.G * NWAVES;
    constexpr int I_INA = 16 * (NA_PAD / 32), I_INB = 16 * (NB / 32), I_OUT = 16 * 32, I_UP = 16 * (NUP / 32), I_DN = (FF / 64) * 32;
    constexpr int NITEMS = 2 * I_INA + 2 * I_INB + 4 * I_OUT + 4 * I_UP + 4 * I_DN;
    unsigned char* ws = a.ws;
    for (int it = gw; it < NITEMS; it += NGW) {
        int r = it;
        if (r < 2 * I_INA) { const int l = r / I_INA; convert_item(a.w_in_a + (size_t)l * DM * NA_SRC, DM, NA_SRC, NA_PAD, 1, a.attn_norm_g + (2 * l) * DM, (bf16*)(ws + WS_W_INA) + (size_t)l * NA_PAD * DM, scr, r % I_INA, F.lane); continue; } r -= 2 * I_INA;
        if (r < 2 * I_INB) { const int l = r / I_INB; convert_item(a.w_in_b + (size_t)l * DM * NB, DM, NB, NB, 2, a.attn_norm_g + (2 * l + 1) * DM, (bf16*)(ws + WS_W_INB) + (size_t)l * NB * DM, scr, r % I_INB, F.lane); continue; } r -= 2 * I_INB;
        if (r < 4 * I_OUT) { const int l = r / I_OUT; convert_item(a.w_out + (size_t)l * DM * DM, DM, DM, DM, 0, nullptr, (bf16*)(ws + WS_W_OUT) + (size_t)l * DM * DM, scr, r % I_OUT, F.lane); continue; } r -= 4 * I_OUT;
        if (r < 4 * I_UP) { const int l = r / I_UP; convert_item(a.w_up + (size_t)l * DM * NUP, DM, NUP, NUP, 3, a.ffn_norm_g + l * DM, (bf16*)(ws + WS_W_UP) + (size_t)l * NUP * DM, scr, r % I_UP, F.lane); continue; } r -= 4 * I_UP;
        { const int l = r / I_DN; convert_item(a.w_down + (size_t)l * FF * DM, FF, DM, DM, 0, nullptr, (bf16*)(ws + WS_W_DN) + (size_t)l * DM * FF, scr, r % I_DN, F.lane); }
    }
    bf16* hb = (bf16*)(ws + WS_HB); float* ss = (float*)(ws + WS_SS);
    for (int m = gw; m < MTOK; m += NGW) {
        const f32x4* xr = (const f32x4*)(a.x + (size_t)m * DM) + F.lane; f32x4 v[4]; float s = 0.f;
#pragma unroll
        for (int j = 0; j < 4; ++j) { v[j] = xr[64 * j]; s += (v[j].x * v[j].x + v[j].y * v[j].y) + (v[j].z * v[j].z + v[j].w * v[j].w); }
        s = wave_sum(s);
        v2u* o8 = (v2u*)(hb + (size_t)m * DM) + F.lane;
#pragma unroll
        for (int j = 0; j < 4; ++j) { v2u w; w.x = pk2(v[j].x, v[j].y); w.y = pk2(v[j].z, v[j].w); o8[64 * j] = w; }
        if (F.lane < 16) ss[(size_t)m * 16 + F.lane] = (F.lane == 0) ? s : 0.f;
    }
}

__device__ __forceinline__ float row_rstd(const float* ss, int row, int fq) {
    const f32x4 a = *(const f32x4*)(ss + (size_t)row * 16 + 4 * fq);
    float s = (a.x + a.y) + (a.z + a.w);
    s += __shfl_xor(s, 16); s += __shfl_xor(s, 32);
    return __builtin_amdgcn_rsqf(s * (1.0f / DM) + EPS);
}
struct EpiIn {
    static constexpr bool PERM = false, AFTER_DRAIN = false;
    const float* ss; unsigned char* proj; const float* qg; const float* kg; int isB;
    __device__ __forceinline__ void operator()(const pg8::f32x4 (&acc)[2][2][4][2], const pg8::Unit& u, int wr, int wc, int fr, int fq) const {
        asm volatile("" : "+v"(fr), "+v"(fq));
        const int pn = u.pn; int kind, pitch; bf16* dst;
        if (isB) { const int t = pn >> 2; kind = (t == 0) ? 1 : (t == 1 ? 2 : 0); dst = (bf16*)(proj + (size_t)t * PB_STRIDE) + 256 * (pn & 3); pitch = DM; }
        else if (pn < 4) { kind = 1; dst = (bf16*)(proj + PA_QA) + 256 * pn; pitch = DM; }
        else if (pn == 4) { kind = 2; dst = (bf16*)(proj + PA_KA); pitch = 256; }
        else if (pn == 5) { kind = 0; dst = (bf16*)(proj + PA_VA); pitch = 256; }
        else if (pn < 8) { kind = 0; dst = (bf16*)(proj + PA_QI) + 256 * (pn - 6); pitch = 512; }
        else { kind = 3; dst = (bf16*)(proj + PA_KI); pitch = 64; }
        if (kind == 3 && wc >= 2) return;
        const bool donorm = (kind == 1) || (kind == 2) || (kind == 3 && wc == 0);
        f32x4 g[2][2];
#pragma unroll
        for (int bj = 0; bj < 2; ++bj)
#pragma unroll
            for (int n = 0; n < 2; ++n) {
                if (kind == 1) g[bj][n] = *(const f32x4*)(qg + 16 * fq + 8 * bj + 4 * n) * C2;
                else if (kind == 2) g[bj][n] = *(const f32x4*)(kg + 16 * fq + 8 * bj + 4 * n);
                else g[bj][n] = (f32x4){1.f, 1.f, 1.f, 1.f};
            }
        float* wi = (float*)(proj + PA_WI);
#pragma unroll
        for (int ai = 0; ai < 2; ++ai)
#pragma unroll
            for (int m = 0; m < 4; ++m) {
                const int row = u.pm * 256 + ai * 128 + wr * 64 + m * 16 + fr;
                const float rs = row_rstd(ss, row, fq);
                f32x4 v[2][2]; float s = 0.f;
#pragma unroll
                for (int bj = 0; bj < 2; ++bj)
#pragma unroll
                    for (int n = 0; n < 2; ++n) { v[bj][n] = acc[ai][bj][m][n] * rs; const f32x4 q = v[bj][n] * v[bj][n]; s += (q.x + q.y) + (q.z + q.w); }
                if (donorm) {
                    s += __shfl_xor(s, 16); s += __shfl_xor(s, 32);
                    const float r = 1.0f / sqrtf(s * (1.0f / 64.0f) + EPS);
#pragma unroll
                    for (int bj = 0; bj < 2; ++bj)
#pragma unroll
                        for (int n = 0; n < 2; ++n) v[bj][n] = v[bj][n] * r * g[bj][n];
                }
                if (kind == 3 && wc == 1) {
                    if (fq == 0) { float* wp = wi + (size_t)row * 8; const float sc = 0.04419417382415922f;
                        *(f32x4*)(wp) = v[0][0] * sc; *(f32x4*)(wp + 4) = v[0][1] * sc; }
                } else {
                    bf16* rp = dst + (size_t)row * pitch + 64 * wc + 16 * fq;
#pragma unroll
                    for (int bj = 0; bj < 2; ++bj) { v4u w; w.x = cvtpk(v[bj][0].x, v[bj][0].y); w.y = cvtpk(v[bj][0].z, v[bj][0].w); w.z = cvtpk(v[bj][1].x, v[bj][1].y); w.w = cvtpk(v[bj][1].z, v[bj][1].w);
                        *(v4u*)(rp + 8 * bj) = w; }
                }
            }
    }
};
struct EpiRes {
    static constexpr bool PERM = false, AFTER_DRAIN = false;
    const float* hin; float* hout; bf16* hb; float* ss;
    __device__ __forceinline__ void operator()(const pg8::f32x4 (&acc)[2][2][4][2], const pg8::Unit& u, int wr, int wc, int fr, int fq) const {
        asm volatile("" : "+v"(fr), "+v"(fq));
        const int col0 = u.pn * 256 + wc * 32 + 4 * fq;
#pragma unroll
        for (int ai = 0; ai < 2; ++ai)
#pragma unroll
            for (int m = 0; m < 4; ++m) {
                const int row = u.pm * 256 + ai * 128 + wr * 64 + m * 16 + fr; const size_t off = (size_t)row * DM + col0; float s = 0.f;
#pragma unroll
                for (int bj = 0; bj < 2; ++bj)
#pragma unroll
                    for (int n = 0; n < 2; ++n) { const f32x4 o = *(const f32x4*)(hin + off + bj * 128 + n * 16) + acc[ai][bj][m][n];
                        *(f32x4*)(hout + off + bj * 128 + n * 16) = o; const f32x4 q = o * o; s += (q.x + q.y) + (q.z + q.w);
                        v2u w; w.x = cvtpk(o.x, o.y); w.y = cvtpk(o.z, o.w); *(v2u*)(hb + off + bj * 128 + n * 16) = w; }
                s += __shfl_xor(s, 16); s += __shfl_xor(s, 32);
                if (fq == 0) ss[(size_t)row * 16 + u.pn * 4 + wc] = s;
            }
    }
};
#ifdef X_NOBPERM
__device__ __forceinline__ float lane_from(int byteaddr, float v) { return v + (float)byteaddr; }
#else
__device__ __forceinline__ float lane_from(int byteaddr, float v) { return __builtin_bit_cast(float, __builtin_amdgcn_ds_bpermute(byteaddr, __builtin_bit_cast(int, v))); }
#endif
#ifdef X_NOSILU
__device__ __forceinline__ float silu_mul(float a, float g) { return a * g; }
#else
__device__ __forceinline__ float silu_mul(float a, float g) { return a * g * __builtin_amdgcn_rcpf(1.0f + __builtin_amdgcn_exp2f(-g * LOG2E)); }
#endif
struct EpiUp {
    static constexpr bool PERM = false, AFTER_DRAIN = false;
    const float* ss; const float* cw; const float* cb; bf16* act; float* halo;
    __device__ __forceinline__ void operator()(const pg8::f32x4 (&acc)[2][2][4][2], const pg8::Unit& u, int wr, int wc, int fr, int fq) const {
        asm volatile("" : "+v"(fr), "+v"(fq));
        unsigned pk[2][2][4][2][2];
#pragma unroll
        for (int ai = 0; ai < 2; ++ai)
#pragma unroll
            for (int m = 0; m < 4; ++m) {
                const float rs = row_rstd(ss, u.pm * 256 + ai * 128 + wr * 64 + m * 16 + fr, fq);
#pragma unroll
                for (int bj = 0; bj < 2; ++bj)
#pragma unroll
                    for (int n = 0; n < 2; ++n) { const f32x4 v = acc[ai][bj][m][n] * rs; pk[ai][bj][m][n][0] = cvtpk(v.x, v.y); pk[ai][bj][m][n][1] = cvtpk(v.z, v.w); }
            }
        __builtin_amdgcn_sched_barrier(0);
        const int lane_ = fq * 16 + fr, src1 = 4 * ((lane_ & 48) | ((fr + 15) & 15)), src2 = 4 * ((lane_ & 48) | ((fr + 14) & 15));
#pragma unroll
        for (int n = 0; n < 2; ++n) {
            const int ca0 = u.pn * 128 + wc * 32 + 8 * fq + 4 * n;
            f32x4 kk0[2], kk1[2], kk2[2], kkb[2];
#pragma unroll
            for (int bj = 0; bj < 2; ++bj) { const int c = bj * FF + ca0; kk0[bj] = *(const f32x4*)(cw + c); kk1[bj] = *(const f32x4*)(cw + NUP + c); kk2[bj] = *(const f32x4*)(cw + 2 * NUP + c); kkb[bj] = *(const f32x4*)(cb + c); }
#pragma unroll
            for (int ai = 0; ai < 2; ++ai) {
                const int blk = u.pm * 4 + ai * 2 + wr; const int row0 = blk * 64;
                unsigned outp[4][2];
#pragma unroll
                for (int pr = 0; pr < 2; ++pr) {
                    float y[2][4][2];
#pragma unroll
                    for (int bj = 0; bj < 2; ++bj) {
                        unsigned r1[4], r2[4];
#pragma unroll
                        for (int m = 0; m < 4; ++m) { const unsigned w = pk[ai][bj][m][n][pr]; r1[m] = (unsigned)__builtin_amdgcn_ds_bpermute(src1, (int)w); r2[m] = (unsigned)__builtin_amdgcn_ds_bpermute(src2, (int)w); }
                        const int c = bj * FF + ca0 + 2 * pr;
                        if (fr < 2) { const unsigned w = pk[ai][bj][0][n][pr]; *(f32x2_t*)(halo + ((size_t)blk * 4 + fr) * NUP + c) = (f32x2_t){bf_lo(w), bf_hi(w)}; }
                        if (fr >= 14) { const unsigned w = pk[ai][bj][3][n][pr]; *(f32x2_t*)(halo + ((size_t)blk * 4 + (fr - 12)) * NUP + c) = (f32x2_t){bf_lo(w), bf_hi(w)}; }
#pragma unroll
                        for (int m = 0; m < 4; ++m) {
                            const unsigned w = pk[ai][bj][m][n][pr];
                            const unsigned u1 = (fr >= 1) ? r1[m] : r1[m > 0 ? m - 1 : 0];
                            const unsigned u2 = (fr >= 2) ? r2[m] : r2[m > 0 ? m - 1 : 0];
                            y[bj][m][0] = kkb[bj][2 * pr] + kk0[bj][2 * pr] * bf_lo(u2) + kk1[bj][2 * pr] * bf_lo(u1) + kk2[bj][2 * pr] * bf_lo(w);
                            y[bj][m][1] = kkb[bj][2 * pr + 1] + kk0[bj][2 * pr + 1] * bf_hi(u2) + kk1[bj][2 * pr + 1] * bf_hi(u1) + kk2[bj][2 * pr + 1] * bf_hi(w);
                        }
                    }
#pragma unroll
                    for (int m = 0; m < 4; ++m) outp[m][pr] = cvtpk(silu_mul(y[0][m][0], y[1][m][0]), silu_mul(y[0][m][1], y[1][m][1]));
                }
#pragma unroll
                for (int m = 0; m < 4; ++m) {
                    if (m == 0 && fr < 2) continue;
                    v2u w; w.x = outp[m][0]; w.y = outp[m][1];
                    *(v2u*)(act + (size_t)(row0 + m * 16 + fr) * FF + ca0) = w;
                }
            }
        }
    }
};
__device__ __forceinline__ void fixup_phase(Frame& F, const float* cw, const float* cb, const float* halo, bf16* act) {
    const int gt = F.vcu * (NWAVES * 64) + F.tid, NT = F.G * NWAVES * 64;
    constexpr int C4 = FF / 4;
    for (int it = gt; it < NBLK64 * 2 * C4; it += NT) {
        const int c = (it % C4) * 4, rj = it / C4, j = rj & 1, blk = rj >> 1, t = blk * 64 + j, tb = t % SEQ;
        f32x4 y[2];
#pragma unroll
        for (int bj = 0; bj < 2; ++bj) {
            const int cc = bj * FF + c;
            const f32x4 z = (f32x4){0.f, 0.f, 0.f, 0.f};
            const f32x4 ut = *(const f32x4*)(halo + ((size_t)blk * 4 + j) * NUP + cc);
            f32x4 u1, u2;
            if (j == 1) { u1 = *(const f32x4*)(halo + ((size_t)blk * 4 + 0) * NUP + cc); u2 = (tb == 1) ? z : *(const f32x4*)(halo + ((size_t)(blk - 1) * 4 + 3) * NUP + cc); }
            else { u1 = (tb == 0) ? z : *(const f32x4*)(halo + ((size_t)(blk - 1) * 4 + 3) * NUP + cc); u2 = (tb == 0) ? z : *(const f32x4*)(halo + ((size_t)(blk - 1) * 4 + 2) * NUP + cc); }
            y[bj] = *(const f32x4*)(cb + cc) + *(const f32x4*)(cw + cc) * u2 + *(const f32x4*)(cw + NUP + cc) * u1 + *(const f32x4*)(cw + 2 * NUP + cc) * ut;
        }
        v2u w; w.x = cvtpk(silu_mul(y[0].x, y[1].x), silu_mul(y[0].y, y[1].y)); w.y = cvtpk(silu_mul(y[0].z, y[1].z), silu_mul(y[0].w, y[1].w));
        *(v2u*)(act + (size_t)t * FF + c) = w;
    }
}

__device__ __forceinline__ int crow(int r, int hi) { return (r & 3) + 8 * (r >> 2) + 4 * hi; }
__device__ __forceinline__ void glds16(const void* gsrc, unsigned lds_dst) { unsigned keep;
    asm volatile("s_mov_b32 %0, m0\n\ts_mov_b32 m0, %2\n\ts_nop 0\n\tglobal_load_lds_dwordx4 %1, off\n\ts_mov_b32 m0, %0" : "=&s"(keep) : "v"(gsrc), "s"(lds_dst) : "memory"); }
__device__ __forceinline__ float max3f(float a, float b, float c) { return fmaxf(fmaxf(a, b), c); }

namespace band {
constexpr int SLOTB = 8192;
constexpr int LDS_K = 0, LDS_V = 2 * SLOTB, LDS_WS = 4 * SLOTB, LDS_TB = LDS_WS + NWAVES * 64 * 4, LDS_OST = LDS_TB + 640 * 4 + 512, LDS_END = LDS_OST + NWAVES * 4096;
static_assert(LDS_END <= RING_BYTES, "band LDS");
__device__ __forceinline__ void unit(Frame& F, int b, int h, int U, const bf16* Q, const bf16* K, const bf16* V, bf16* O, const float* rel) {
    const int tid = F.tid, lane = F.lane, r32 = lane & 31, hi = lane >> 5, wid = F.wave;
    LAS unsigned char* shm = F.lds + RING_OFF;
    const unsigned lds0 = (unsigned)(uintptr_t)shm;
    const long rowbase = (long)b * SEQ; const int q0 = U * 256, c0 = 4 * U, cq = c0 + (wid >> 1);
    const bf16* Qw = Q + (rowbase + q0 + wid * 32) * DM + h * 64;
    const bf16* Kh = K + rowbase * DM + h * 64; const bf16* Vh = V + rowbase * DM + h * 64;
    LAS float* wsf = (LAS float*)(shm + LDS_WS) + wid * 64;
    LAS float* tb = (LAS float*)(shm + LDS_TB);
    const bf16* ksrc = Kh + (long)lane * DM + wid * 8;
    const bf16* vsrc = Vh + (long)(16 * (wid & 3) + (lane >> 2)) * DM + (wid >> 2) * 32 + (lane & 3) * 8;
    const unsigned kdst = lds0 + LDS_K + wid * 1024, vdst = lds0 + LDS_V + wid * 1024;
    const int lo = (c0 - 8 > 0) ? c0 - 8 : 0, hiT = c0 + 3, NT = hiT - lo + 1, t0 = (c0 - 5 > 0) ? c0 - 5 : 0;
#define BAND_KT(i) ((t0 + (i) <= hiT) ? t0 + (i) : lo + (t0 + (i) - hiT - 1))
    for (int i = tid; i < 640; i += NWAVES * 64) { int d = i - 64; d = d < -256 ? -256 : (d > 256 ? 256 : d); tb[i] = rel[(d + 256) * 16 + h] * LOG2E; }
    { const int kt = BAND_KT(0); glds16(ksrc + (long)kt * 64 * DM, (unsigned)__builtin_amdgcn_readfirstlane(kdst)); glds16(vsrc + (long)kt * 64 * DM, (unsigned)__builtin_amdgcn_readfirstlane(vdst)); }
    bf16x8 qr[4];
#pragma unroll
    for (int d0 = 0; d0 < 4; ++d0) qr[d0] = *(const bf16x8*)(Qw + (long)r32 * DM + d0 * 16 + hi * 8);
    float m_run = -INFINITY, l_run = 0.f; f32x16 o[2]; o[0] = f32x16{}; o[1] = f32x16{};
    const int qpos = q0 + wid * 32 + r32;
    const LAS unsigned char* vbase = shm + LDS_V + ((lane >> 4) & 1) * 32 + (lane & 3) * 8 + (4 * hi + ((lane & 15) >> 2)) * 64;
    for (int i = 0; i < NT; ++i) {
        asm volatile("s_waitcnt vmcnt(0) lgkmcnt(0)\n\ts_barrier" ::: "memory");
        if (i + 1 < NT) { const int kt = BAND_KT(i + 1); const unsigned so = ((i + 1) & 1) * SLOTB;
            glds16(ksrc + (long)kt * 64 * DM, (unsigned)__builtin_amdgcn_readfirstlane(kdst + so)); glds16(vsrc + (long)kt * 64 * DM, (unsigned)__builtin_amdgcn_readfirstlane(vdst + so)); }
        const int kt = BAND_KT(i);
        if (kt < cq - 8 || kt > cq) continue;
        const int so = (i & 1) * SLOTB;
        f32x16 p0 = f32x16{}, p1 = f32x16{};
        { const LAS unsigned char* kb = shm + LDS_K + so + hi * 1024 + r32 * 16;
#pragma unroll
          for (int d0 = 0; d0 < 4; ++d0) { const bf16x8 b0 = *(const LAS bf16x8*)(kb + d0 * 2048), b1 = *(const LAS bf16x8*)(kb + d0 * 2048 + 512);
              p0 = __builtin_amdgcn_mfma_f32_32x32x16_bf16(b0, qr[d0], p0, 0, 0, 0); p1 = __builtin_amdgcn_mfma_f32_32x32x16_bf16(b1, qr[d0], p1, 0, 0, 0); } }
        { const int ib = qpos - 64 * kt + 64 - 4 * hi;
#pragma unroll
          for (int r = 0; r < 16; ++r) { const int ix = ib - ((r & 3) + 8 * (r >> 2)); p0[r] += tb[ix]; p1[r] += tb[ix - 32]; } }
        float rm = p0[0];
#pragma unroll
        for (int r = 0; r < 16; ++r) rm = max3f(rm, p0[r], p1[r]);
        { auto rr = __builtin_amdgcn_permlane32_swap(__float_as_uint(rm), __float_as_uint(rm), false, false); rm = fmaxf(__uint_as_float(rr[0]), __uint_as_float(rr[1])); }
        const float mnew = fmaxf(m_run, rm), f = __builtin_amdgcn_exp2f(m_run - mnew); m_run = mnew;
        float sacc = 0.f;
#pragma unroll
        for (int r = 0; r < 16; ++r) { p0[r] = __builtin_amdgcn_exp2f(p0[r] - mnew); p1[r] = __builtin_amdgcn_exp2f(p1[r] - mnew); sacc += p0[r] + p1[r]; }
        l_run = l_run * f + sacc;
        if (hi == 0) wsf[r32] = f;
        LDS_WAIT();
#pragma unroll
        for (int r = 0; r < 16; ++r) { const float fr_ = wsf[crow(r, hi)]; o[0][r] *= fr_; o[1][r] *= fr_; }
        v4u pw[4];
        pw[0] = (v4u){cvtpk(p0[0], p0[1]), cvtpk(p0[2], p0[3]), cvtpk(p0[4], p0[5]), cvtpk(p0[6], p0[7])};
        pw[1] = (v4u){cvtpk(p0[8], p0[9]), cvtpk(p0[10], p0[11]), cvtpk(p0[12], p0[13]), cvtpk(p0[14], p0[15])};
        pw[2] = (v4u){cvtpk(p1[0], p1[1]), cvtpk(p1[2], p1[3]), cvtpk(p1[4], p1[5]), cvtpk(p1[6], p1[7])};
        pw[3] = (v4u){cvtpk(p1[8], p1[9]), cvtpk(p1[10], p1[11]), cvtpk(p1[12], p1[13]), cvtpk(p1[14], p1[15])};
        const LAS unsigned char* vb = vbase + so;
#pragma unroll
        for (int d0 = 0; d0 < 2; ++d0)
#pragma unroll
            for (int ks = 0; ks < 4; ++ks) {
                const s16x4 vlo = __builtin_bit_cast(s16x4, __builtin_amdgcn_ds_read_tr16_b64_v4i16((LAS s16x4*)(vb + d0 * 4096 + ks * 1024)));
                const s16x4 vhi = __builtin_bit_cast(s16x4, __builtin_amdgcn_ds_read_tr16_b64_v4i16((LAS s16x4*)(vb + d0 * 4096 + ks * 1024 + 512)));
                const bf16x8 vf = (bf16x8){vlo[0], vlo[1], vlo[2], vlo[3], vhi[0], vhi[1], vhi[2], vhi[3]};
                o[d0] = __builtin_amdgcn_mfma_f32_32x32x16_bf16(__builtin_bit_cast(bf16x8, pw[ks]), vf, o[d0], 0, 0, 0);
            }
    }
#undef BAND_KT
    { auto rr = __builtin_amdgcn_permlane32_swap(__float_as_uint(l_run), __float_as_uint(l_run), false, false); l_run = __uint_as_float(rr[0]) + __uint_as_float(rr[1]); }
    if (hi == 0) wsf[32 + r32] = l_run;
    LDS_WAIT();
    float rli[16];
#pragma unroll
    for (int r = 0; r < 16; ++r) rli[r] = __builtin_amdgcn_rcpf(wsf[32 + crow(r, hi)]);
    bf16* Ow = O + (rowbase + q0 + wid * 32) * DM + h * 64;
    { LAS bf16* stg = (LAS bf16*)(shm + LDS_OST) + wid * 2048;
#pragma unroll
      for (int r = 0; r < 16; ++r) { const int orow = crow(r, hi);
#pragma unroll
          for (int d0 = 0; d0 < 2; ++d0) stg[orow * 64 + d0 * 32 + r32] = (bf16)f2bf(o[d0][r] * rli[r]); }
      LDS_WAIT();
#pragma unroll
      for (int i = 0; i < 4; ++i) { const int row = i * 8 + (lane >> 3), ch = lane & 7; const v4u v = *(const LAS v4u*)(stg + row * 64 + ch * 8); *(v4u*)(Ow + (long)row * DM + ch * 8) = v; } }
    asm volatile("s_waitcnt lgkmcnt(0)\n\ts_barrier" ::: "memory");
}
__device__ __forceinline__ void phase(Frame& F, const bf16* Q, const bf16* K, const bf16* V, bf16* O, const float* rel) {
    const int NU = BATCH * 16 * 32, per = (NU + F.G - 1) / F.G;
    for (int i = 0; i < per; ++i) { const int uid = F.vcu * per + i; if (uid >= NU) break; unit(F, uid >> 9, (uid >> 5) & 15, uid & 31, Q, K, V, O, rel); }
}
}

namespace dsa {
__device__ __forceinline__ unsigned okey(float s) { const unsigned u = __float_as_uint(s + 0.0f); return (u & 0x80000000u) ? ~u : (u | 0x80000000u); }
struct Ctx { const bf16* QA; const bf16* KA; const bf16* VA; const bf16* QI; const bf16* KI; const float* WI; bf16* M; const LAS float* t5l; };

__device__ __forceinline__ void scan_hist(const LAS unsigned* hq, int lane, unsigned need, unsigned& bin, unsigned& above) {
    const LAS v4u* hp = (const LAS v4u*)hq + lane * 4;
    unsigned wds[16];
#pragma unroll
    for (int j = 0; j < 4; ++j) { const v4u t = hp[j]; wds[4 * j] = t.x; wds[4 * j + 1] = t.y; wds[4 * j + 2] = t.z; wds[4 * j + 3] = t.w; }
    unsigned tl = 0;
#pragma unroll
    for (int j = 0; j < 16; ++j) tl += (wds[j] & 0xffffu) + (wds[j] >> 16);
    unsigned suf = tl;
#pragma unroll
    for (int o = 1; o < 64; o <<= 1) { const unsigned v = __shfl_down(suf, o); if (lane + o < 64) suf += v; }
    const unsigned S = suf - tl;
    const bool cross = (S < need) && (need <= S + tl);
    unsigned c = S, bsel = 0, ab = 0; bool found = false;
#pragma unroll
    for (int k = 31; k >= 0; --k) { const unsigned cnt = (wds[k >> 1] >> (16 * (k & 1))) & 0xffffu; if (!found && c + cnt >= need) { bsel = 32 * lane + k; ab = c; found = true; } c += cnt; }
    const unsigned long long bal = __ballot(cross);
    const int src = bal ? __builtin_ctzll(bal) : 0;
    bin = __shfl(bsel, src); above = __shfl(ab, src);
}

__device__ __forceinline__ void quad(Frame& F, const Ctx& C, int b, int tq0) {
    const int lane = F.lane, r = lane & 31, hi = lane >> 5;
    LAS unsigned* hist = (LAS unsigned*)(F.lds + RING_OFF + F.wave * 16384);
    LAS unsigned short* sel = (LAS unsigned short*)hist;
    const long rowbase = (long)b * SEQ;
#ifdef DBG_PREZERO
    for (int j = lane; j < 4 * DM / 8; j += 64) ((v4u*)(C.M + (rowbase + tq0) * DM))[j] = (v4u){0u, 0u, 0u, 0u};
#endif
    const int c = tq0 >> 6, N = 64 * (c + 1), ntile = N / 32;
    int nvalid = 256;
#ifdef DBG_FIXSEL
    if (true) {
        nvalid = N < 256 ? N : 256;
#else
    if (N <= 256) {
        nvalid = N;
#endif
        for (int j = lane; j < 4 * 256; j += 64) sel[j] = (unsigned short)(j & 255);
    } else {
        const int aq = 2 * ((r >> 2) & 1) + (r >> 4), ah = 4 * ((r >> 3) & 1) + (r & 3);
        const bf16* qip = C.QI + (rowbase + tq0 + aq) * 512 + ah * 64 + 8 * hi;
        bf16x8 qa[4];
#pragma unroll
        for (int ks = 0; ks < 4; ++ks) qa[ks] = *(const bf16x8*)(qip + 16 * ks);
        float wv[2][8];
#pragma unroll
        for (int t = 0; t < 2; ++t) { const float* wp = C.WI + (rowbase + tq0 + 2 * hi + t) * 8; const f32x4 w0 = *(const f32x4*)wp, w1 = *(const f32x4*)(wp + 4);
            wv[t][0] = w0.x; wv[t][1] = w0.y; wv[t][2] = w0.z; wv[t][3] = w0.w; wv[t][4] = w1.x; wv[t][5] = w1.y; wv[t][6] = w1.z; wv[t][7] = w1.w; }
        const bf16* kip = C.KI + rowbase * 64 + (long)r * 64 + 8 * hi;
        unsigned pre[4] = {0u, 0u, 0u, 0u}, need[4] = {256u, 256u, 256u, 256u};
        unsigned cnt[4] = {0u, 0u, 0u, 0u}, tcnt[4] = {0u, 0u, 0u, 0u};
        for (int pass = 0; pass < 4; ++pass) {
            if (pass < 3) {
                LAS v4u* hz = (LAS v4u*)hist;
#pragma unroll
                for (int j = 0; j < 16; ++j) hz[j * 64 + lane] = (v4u){0u, 0u, 0u, 0u};
            }
            LDS_WAIT();
            const unsigned pre0 = hi ? pre[2] : pre[0], pre1 = hi ? pre[3] : pre[1];
            const unsigned need0 = hi ? need[2] : need[0], need1 = hi ? need[3] : need[1];
            bf16x8 kb[4];
#pragma unroll
            for (int ks = 0; ks < 4; ++ks) kb[ks] = *(const bf16x8*)(kip + 16 * ks);
            for (int ti = 0; ti < ntile; ++ti) {
                bf16x8 kn[4];
                const int tn = (ti + 1 < ntile) ? ti + 1 : ti;
#pragma unroll
                for (int ks = 0; ks < 4; ++ks) kn[ks] = *(const bf16x8*)(kip + (long)tn * 2048 + 16 * ks);
                f32x16 acc = f32x16{};
#pragma unroll
                for (int ks = 0; ks < 4; ++ks) acc = __builtin_amdgcn_mfma_f32_32x32x16_bf16(qa[ks], kb[ks], acc, 0, 0, 0);
                float s0 = 0.f, s1 = 0.f;
#pragma unroll
                for (int j = 0; j < 8; ++j) { s0 += wv[0][j] * fmaxf(acc[j], 0.f); s1 += wv[1][j] * fmaxf(acc[8 + j], 0.f); }
                const unsigned k0 = okey(s0), k1 = okey(s1);
                if (pass == 0) {
                    const unsigned b0 = k0 >> 21, b1 = k1 >> 21;
                    __hip_atomic_fetch_add(hist + (2 * hi) * 1024 + (b0 >> 1), 1u << (16 * (b0 & 1)), __ATOMIC_RELAXED, __HIP_MEMORY_SCOPE_WORKGROUP);
                    __hip_atomic_fetch_add(hist + (2 * hi + 1) * 1024 + (b1 >> 1), 1u << (16 * (b1 & 1)), __ATOMIC_RELAXED, __HIP_MEMORY_SCOPE_WORKGROUP);
                } else if (pass == 1) {
                    const unsigned b0 = (k0 >> 10) & 2047u, b1 = (k1 >> 10) & 2047u;
                    if ((k0 >> 21) == pre0) __hip_atomic_fetch_add(hist + (2 * hi) * 1024 + (b0 >> 1), 1u << (16 * (b0 & 1)), __ATOMIC_RELAXED, __HIP_MEMORY_SCOPE_WORKGROUP);
                    if ((k1 >> 21) == pre1) __hip_atomic_fetch_add(hist + (2 * hi + 1) * 1024 + (b1 >> 1), 1u << (16 * (b1 & 1)), __ATOMIC_RELAXED, __HIP_MEMORY_SCOPE_WORKGROUP);
                } else if (pass == 2) {
                    const unsigned b0 = k0 & 1023u, b1 = k1 & 1023u;
                    if ((k0 >> 10) == pre0) __hip_atomic_fetch_add(hist + (2 * hi) * 1024 + (b0 >> 1), 1u << (16 * (b0 & 1)), __ATOMIC_RELAXED, __HIP_MEMORY_SCOPE_WORKGROUP);
                    if ((k1 >> 10) == pre1) __hip_atomic_fetch_add(hist + (2 * hi + 1) * 1024 + (b1 >> 1), 1u << (16 * (b1 & 1)), __ATOMIC_RELAXED, __HIP_MEMORY_SCOPE_WORKGROUP);
                } else {
                    const unsigned below = (1u << r) - 1u;
#pragma unroll
                    for (int t = 0; t < 2; ++t) {
                        const unsigned kk = t ? k1 : k0, T = t ? pre1 : pre0, rq = t ? need1 : need0;
                        const bool gt = kk > T, eq = kk == T;
                        const unsigned long long me = __ballot(eq);
                        const unsigned meh = hi ? (unsigned)(me >> 32) : (unsigned)me;
                        const unsigned trank = (hi ? tcnt[2 + t] : tcnt[t]) + __builtin_popcount(meh & below);
                        const bool take = gt || (eq && trank < rq);
                        const unsigned long long mt = __ballot(take);
                        const unsigned mth = hi ? (unsigned)(mt >> 32) : (unsigned)mt;
                        const unsigned pos = (hi ? cnt[2 + t] : cnt[t]) + __builtin_popcount(mth & below);
                        if (take && pos < 256u) sel[(2 * hi + t) * 256 + pos] = (unsigned short)(ti * 32 + r);
                        cnt[t] += __builtin_popcount((unsigned)mt); cnt[2 + t] += __builtin_popcount((unsigned)(mt >> 32));
                        tcnt[t] += __builtin_popcount((unsigned)me); tcnt[2 + t] += __builtin_popcount((unsigned)(me >> 32));
                    }
                }
#pragma unroll
                for (int ks = 0; ks < 4; ++ks) kb[ks] = kn[ks];
            }
            LDS_WAIT();
            if (pass < 3) {
#pragma unroll
                for (int ql = 0; ql < 4; ++ql) { unsigned bin, above; scan_hist(hist + ql * 1024, lane, need[ql], bin, above);
                    bin = __builtin_amdgcn_readfirstlane(bin); above = __builtin_amdgcn_readfirstlane(above);
                    pre[ql] = (pass == 2) ? ((pre[ql] << 10) | bin) : ((pre[ql] << 11) | bin); need[ql] -= above; }
                LDS_WAIT();
            }
        }
    }
    LDS_WAIT();
    const int l15 = lane & 15, l4 = lane >> 4, nt16 = nvalid >> 4;
    for (int ql = 0; ql < 4; ++ql) {
        const long token = rowbase + tq0 + ql; const int tpos = tq0 + ql;
        const LAS unsigned short* sq = sel + ql * 256;
        for (int g = 0; g < 4; ++g) {
            const bf16* qp = C.QA + token * DM + (4 * g + (lane & 3)) * 64 + 8 * l4;
            const bf16x8 qf0 = *(const bf16x8*)qp, qf1 = *(const bf16x8*)(qp + 32);
            f32x4 S[16];
#pragma unroll
            for (int ti = 0; ti < 16; ++ti) {
                if (ti < nt16) {
                    const int s = sq[ti * 16 + l15];
                    const bf16* kp = C.KA + (rowbase + s) * 256 + g * 64 + 8 * l4;
                    const bf16x8 kf0 = *(const bf16x8*)kp, kf1 = *(const bf16x8*)(kp + 32);
                    const int rel = s - tpos, n = rel < 0 ? -rel : rel;
                    const int bk = (rel > 0 ? 16 : 0) + (n < 8 ? n : 8 + (n >= 12) + (n >= 16) + (n >= 23) + (n >= 32) + (n >= 46) + (n >= 64) + (n >= 91));
                    f32x4 a = *(const LAS f32x4*)(C.t5l + bk * 16 + 4 * g);
                    a = __builtin_amdgcn_mfma_f32_16x16x32_bf16(qf0, kf0, a, 0, 0, 0);
                    a = __builtin_amdgcn_mfma_f32_16x16x32_bf16(qf1, kf1, a, 0, 0, 0);
                    asm volatile("" :: "v"(kf0), "v"(kf1));
                    S[ti] = a;
                } else S[ti] = (f32x4){-INFINITY, -INFINITY, -INFINITY, -INFINITY};
            }
            f32x4 mx = S[0];
#pragma unroll
            for (int ti = 1; ti < 16; ++ti) { mx.x = fmaxf(mx.x, S[ti].x); mx.y = fmaxf(mx.y, S[ti].y); mx.z = fmaxf(mx.z, S[ti].z); mx.w = fmaxf(mx.w, S[ti].w); }
#pragma unroll
            for (int o = 1; o < 16; o <<= 1) { mx.x = fmaxf(mx.x, __shfl_xor(mx.x, o)); mx.y = fmaxf(mx.y, __shfl_xor(mx.y, o)); mx.z = fmaxf(mx.z, __shfl_xor(mx.z, o)); mx.w = fmaxf(mx.w, __shfl_xor(mx.w, o)); }
            f32x4 ls = (f32x4){0.f, 0.f, 0.f, 0.f};
            unsigned P01[16], P23[16];
#pragma unroll
            for (int ti = 0; ti < 16; ++ti) { const float e0 = __builtin_amdgcn_exp2f(S[ti].x - mx.x), e1 = __builtin_amdgcn_exp2f(S[ti].y - mx.y), e2 = __builtin_amdgcn_exp2f(S[ti].z - mx.z), e3 = __builtin_amdgcn_exp2f(S[ti].w - mx.w);
                ls += (f32x4){e0, e1, e2, e3}; P01[ti] = cvtpk(e0, e1); P23[ti] = cvtpk(e2, e3); }
#pragma unroll
            for (int o = 1; o < 16; o <<= 1) { ls.x += __shfl_xor(ls.x, o); ls.y += __shfl_xor(ls.y, o); ls.z += __shfl_xor(ls.z, o); ls.w += __shfl_xor(ls.w, o); }
            float o_[4][16];
#pragma unroll
            for (int h = 0; h < 4; ++h)
#pragma unroll
                for (int d = 0; d < 16; ++d) o_[h][d] = 0.f;
#pragma unroll
            for (int ti = 0; ti < 16; ++ti) {
                if (ti < nt16) {
                    const int s = sq[ti * 16 + l15];
                    const v4u* vp = (const v4u*)(C.VA + (rowbase + s) * 256 + g * 64 + 16 * l4);
                    const v4u v0 = vp[0], v1 = vp[1];
                    float vf[16];
                    vf[0] = bf_lo(v0.x); vf[1] = bf_hi(v0.x); vf[2] = bf_lo(v0.y); vf[3] = bf_hi(v0.y); vf[4] = bf_lo(v0.z); vf[5] = bf_hi(v0.z); vf[6] = bf_lo(v0.w); vf[7] = bf_hi(v0.w);
                    vf[8] = bf_lo(v1.x); vf[9] = bf_hi(v1.x); vf[10] = bf_lo(v1.y); vf[11] = bf_hi(v1.y); vf[12] = bf_lo(v1.z); vf[13] = bf_hi(v1.z); vf[14] = bf_lo(v1.w); vf[15] = bf_hi(v1.w);
                    const float p0 = bf_lo(P01[ti]), p1 = bf_hi(P01[ti]), p2 = bf_lo(P23[ti]), p3 = bf_hi(P23[ti]);
#pragma unroll
                    for (int d = 0; d < 16; ++d) { o_[0][d] += p0 * vf[d]; o_[1][d] += p1 * vf[d]; o_[2][d] += p2 * vf[d]; o_[3][d] += p3 * vf[d]; }
                }
                asm volatile("" ::: "memory");
            }
            float res[4];
#pragma unroll
            for (int h = 0; h < 4; ++h) {
                float a8[8], a4[4], a2[2];
                const bool b3 = (l15 & 8) != 0, b2 = (l15 & 4) != 0, b1 = (l15 & 2) != 0, b0 = (l15 & 1) != 0;
#pragma unroll
                for (int d = 0; d < 8; ++d) { const float keep = b3 ? o_[h][d + 8] : o_[h][d], send = b3 ? o_[h][d] : o_[h][d + 8]; a8[d] = keep + __shfl_xor(send, 8); }
#pragma unroll
                for (int d = 0; d < 4; ++d) { const float keep = b2 ? a8[d + 4] : a8[d], send = b2 ? a8[d] : a8[d + 4]; a4[d] = keep + __shfl_xor(send, 4); }
#pragma unroll
                for (int d = 0; d < 2; ++d) { const float keep = b1 ? a4[d + 2] : a4[d], send = b1 ? a4[d] : a4[d + 2]; a2[d] = keep + __shfl_xor(send, 2); }
                { const float keep = b0 ? a2[1] : a2[0], send = b0 ? a2[0] : a2[1]; res[h] = keep + __shfl_xor(send, 1); }
            }
            bf16* mp = C.M + token * DM + (4 * g) * 64 + lane;
            mp[0] = (bf16)f2bf(res[0] / ls.x); mp[64] = (bf16)f2bf(res[1] / ls.y); mp[128] = (bf16)f2bf(res[2] / ls.z); mp[192] = (bf16)f2bf(res[3] / ls.w);
        }
    }
    LDS_WAIT();
}
__device__ __forceinline__ void phase(Frame& F, const Ctx& C) {
    const int w = F.vcu * NWAVES + F.wave, NW = F.G * NWAVES;
    for (int q = w; q < 2048; q += NW) {
#pragma unroll 1
        for (int it = 0; it < 4; ++it) {
            const int qd = (it == 0) ? q : (it == 1) ? 4095 - q : (it == 2) ? 4096 + q : 8191 - q;
            quad(F, C, qd >> 11, (qd & 2047) * 4);
        }
    }
}
}

constexpr int N_PHASES = 1 + 6 * DEPTH;
#ifndef MK_N_LAUNCHES
#define MK_N_LAUNCHES 1
#endif
__global__ void __launch_bounds__(NWAVES * 64, 2) mega_fwd(Args args) {
    extern __shared__ __attribute__((aligned(16))) unsigned char lds[];
    Frame F;
    F.lds = (LAS unsigned char*)lds;
    F.MISC = (volatile LAS unsigned*)(F.lds + MISC_OFF);
    F.tid = threadIdx.x; F.lane = F.tid & 63; F.wave = __builtin_amdgcn_readfirstlane(F.tid >> 6);
    F.G = gridDim.x; { const int bx = blockIdx.x; F.vcu = (F.G % 8 == 0) ? (bx % 8) * (F.G / 8) + bx / 8 : bx; }
    unsigned char* ws = args.ws;
    F.ctl = (gu32*)(ws + WS_CTL);
    for (int u = F.tid; u < (LDS_BYTES - LDSCTL_OFF) / 4; u += NWAVES * 64) ((LAS unsigned*)(F.lds + LDSCTL_OFF))[u] = 0u;
    __syncthreads();
    XcdBarrier bar; bar.bar = (unsigned*)(F.ctl + CW_BAR); bar.x = 0; bar.st = nullptr;
    if (MK_N_LAUNCHES == 1) bar = xcd_barrier_post((unsigned*)(F.ctl + CW_BAR), F.MISC + 8);
    const int lo = args.ph_lo, hi = args.ph_hi;
#define IN(k) (lo <= (k) && (k) < hi)
#define OPQ_FRAME(Fl) Frame Fl = F; { int t_ = threadIdx.x; asm volatile("" : "+v"(t_)); Fl.tid = t_; Fl.lane = t_ & 63; }
#define SEAM(k) do { if (IN(k) && IN((k) + 1)) xcd_barrier(bar); } while (0)

    bf16* hb = (bf16*)(ws + WS_HB); bf16* mb = (bf16*)(ws + WS_M); float* ss = (float*)(ws + WS_SS); float* halo = (float*)(ws + WS_HALO);
    unsigned char* proj = ws + WS_PROJ; bf16* act = (bf16*)(ws + WS_PROJ);

#ifndef SKIP_P0
    if (IN(0)) { OPQ_FRAME(F0); p0_prologue(F0, args); }
#endif
    SEAM(0);

#pragma unroll 1
    for (int L = 0; L < DEPTH; ++L) {
        const int pb = 1 + 6 * L, li = L >> 1; const bool isB = (L & 1) != 0;
        if (IN(pb)) {
#ifndef SKIP_IN
            if (!isB) {
                pg8::Gemm g{hb, (const bf16*)(ws + WS_W_INA) + (size_t)li * NA_PAD * DM, MTOK, NA_PAD, DM}; pg8::StaticOrder S; S.init(MTOK, NA_PAD, F.G, (int)blockIdx.x);
                EpiIn E{ss, proj, args.q_norm_g + L * 64, args.k_norm_g + L * 64, 0};
                pg8::gemm_phase<EpiIn, pg8::StaticOrder, true, true>(F.lds + RING_OFF, g, S, E);
            } else {
                pg8::Gemm g{hb, (const bf16*)(ws + WS_W_INB) + (size_t)li * NB * DM, MTOK, NB, DM}; pg8::StaticOrder S; S.init(MTOK, NB, F.G, (int)blockIdx.x);
                EpiIn E{ss, proj, args.q_norm_g + L * 64, args.k_norm_g + L * 64, 1};
                pg8::gemm_phase<EpiIn, pg8::StaticOrder, true, true>(F.lds + RING_OFF, g, S, E);
            }
#endif
        }
        SEAM(pb);
#if defined(DBG_NODSA) || defined(DBG_NOBAND)
#ifdef DBG_NODSA
        const bool zero_m = !isB;
#else
        const bool zero_m = isB;
#endif
        if (IN(pb + 1) && zero_m) { for (size_t i = (size_t)blockIdx.x * 512 + threadIdx.x; i < (size_t)MTOK * DM / 8; i += (size_t)gridDim.x * 512) ((v4u*)mb)[i] = (v4u){0u, 0u, 0u, 0u}; }
        if (IN(pb + 1) && !zero_m) {
#else
        if (IN(pb + 1)) {
#endif
#ifndef SKIP_DSA
            if (!isB) {
                LAS float* t5l = (LAS float*)(F.lds + AUX_OFF);
                for (int i = threadIdx.x; i < 512; i += NWAVES * 64) t5l[i] = args.t5_bias[i] * LOG2E;
                __syncthreads();
                dsa::Ctx C{(const bf16*)(proj + PA_QA), (const bf16*)(proj + PA_KA), (const bf16*)(proj + PA_VA), (const bf16*)(proj + PA_QI), (const bf16*)(proj + PA_KI), (const float*)(proj + PA_WI), mb, t5l};
#ifdef DBG_DSACOPY
                { int t_ = threadIdx.x; asm volatile("" : "+v"(t_));
                for (unsigned i = blockIdx.x * 512u + (unsigned)t_; i < (unsigned)MTOK * DM; i += gridDim.x * 512u) { const unsigned t = i >> 10, c = i & 1023u;
                    float v = bf_lo(C.QA[i]); v += bf_lo(C.KA[t * 256 + (c & 255)]); v += bf_lo(C.VA[t * 256 + (c & 255)]); v += bf_lo(C.QI[t * 512 + (c & 511)]); v += bf_lo(C.KI[t * 64 + (c & 63)]); v += C.WI[t * 8 + (c & 7)];
                    mb[i] = (bf16)f2bf(v * 0.01f); asm volatile("" ::: "memory"); } }
#else
                OPQ_FRAME(F1); dsa::phase(F1, C);
#endif
            }
#endif
#ifndef SKIP_BAND
            if (isB) {
                OPQ_FRAME(F2); band::phase(F2, (const bf16*)proj, (const bf16*)(proj + PB_STRIDE), (const bf16*)(proj + 2 * PB_STRIDE), mb, args.rel_bias_b + (size_t)li * 513 * 16);
            }
#endif
        }
        SEAM(pb + 1);
        if (IN(pb + 2)) {
#ifndef SKIP_OUT
            pg8::Gemm g{mb, (const bf16*)(ws + WS_W_OUT) + (size_t)L * DM * DM, MTOK, DM, DM}; pg8::StaticOrder S; S.init(MTOK, DM, F.G, (int)blockIdx.x);
            EpiRes E{L == 0 ? args.x : (const float*)args.out, args.out, hb, ss};
            pg8::gemm_phase<EpiRes, pg8::StaticOrder, true, true>(F.lds + RING_OFF, g, S, E);
#endif
        }
        SEAM(pb + 2);
        if (IN(pb + 3)) {
#ifndef SKIP_UP
            pg8::Gemm g{hb, (const bf16*)(ws + WS_W_UP) + (size_t)L * NUP * DM, MTOK, NUP, DM}; pg8::StaticOrder S; S.init(MTOK, NUP, F.G, (int)blockIdx.x);
            EpiUp E{ss, args.conv_w + (size_t)L * 3 * NUP, args.conv_b + (size_t)L * NUP, act, halo};
            pg8::gemm_phase<EpiUp, pg8::StaticOrder, true, true>(F.lds + RING_OFF, g, S, E);
#endif
        }
        SEAM(pb + 3);
#ifndef SKIP_FIX
        if (IN(pb + 4)) { OPQ_FRAME(F3); fixup_phase(F3, args.conv_w + (size_t)L * 3 * NUP, args.conv_b + (size_t)L * NUP, halo, act); }
#endif
        SEAM(pb + 4);
        if (IN(pb + 5)) {
#ifndef SKIP_DN
            pg8::Gemm g{act, (const bf16*)(ws + WS_W_DN) + (size_t)L * DM * FF, MTOK, DM, FF}; pg8::StaticOrder S; S.init(MTOK, DM, F.G, (int)blockIdx.x);
            EpiRes E{args.out, args.out, hb, ss};
            pg8::gemm_phase<EpiRes, pg8::StaticOrder, true, true>(F.lds + RING_OFF, g, S, E);
#endif
        }
        SEAM(pb + 5);
    }
#undef IN
#undef SEAM
}

extern "C" void kernel_launch(void* const* d_in, const int* in_sizes, int n_in, void* d_out, int out_size, void* d_ws, size_t ws_size, hipStream_t stream) {
    static int grid = 0;
    if (grid == 0) {
        if (n_in != 14 || in_sizes[0] != MTOK * DM || out_size != MTOK * DM || ws_size < WS_END) { fprintf(stderr, "kernel_launch: unexpected shapes / workspace (n_in %d, ws %zu); nothing launched\n", n_in, ws_size); grid = -1; return; }
        int dev = 0, cus = 0, per_cu = 0;
        if (hipGetDevice(&dev) != hipSuccess || hipDeviceGetAttribute(&cus, hipDeviceAttributeMultiprocessorCount, dev) != hipSuccess) { grid = -1; return; }
        if (hipFuncSetAttribute((const void*)mega_fwd, hipFuncAttributeMaxDynamicSharedMemorySize, LDS_BYTES) != hipSuccess) { fprintf(stderr, "kernel_launch: hipFuncSetAttribute failed\n"); grid = -1; return; }
        if (hipOccupancyMaxActiveBlocksPerMultiprocessor(&per_cu, (const void*)mega_fwd, NWAVES * 64, LDS_BYTES) != hipSuccess || per_cu < 1) { fprintf(stderr, "kernel_launch: occupancy query reports %d blocks per CU\n", per_cu); }
        (void)hipGetLastError();
        grid = cus;
    }
    if (grid < 0) return;
    if (hipMemsetAsync((char*)d_ws + WS_CTL, 0, CTL_ZERO_BYTES, stream) != hipSuccess) return;
    Args a{};
    a.x = (const float*)d_in[0]; a.attn_norm_g = (const float*)d_in[1]; a.w_in_a = (const float*)d_in[2]; a.w_in_b = (const float*)d_in[3]; a.q_norm_g = (const float*)d_in[4];
    a.k_norm_g = (const float*)d_in[5]; a.t5_bias = (const float*)d_in[6]; a.rel_bias_b = (const float*)d_in[7]; a.w_out = (const float*)d_in[8]; a.ffn_norm_g = (const float*)d_in[9];
    a.w_up = (const float*)d_in[10]; a.conv_w = (const float*)d_in[11]; a.conv_b = (const float*)d_in[12]; a.w_down = (const float*)d_in[13];
    a.out = (float*)d_out; a.ws = (unsigned char*)d_ws; a.pad = 0;
#if MK_N_LAUNCHES == 1
    a.ph_lo = 0; a.ph_hi = N_PHASES; a.li = 0;
    hipLaunchKernelGGL(mega_fwd, dim3(grid), dim3(NWAVES * 64), LDS_BYTES, stream, a);
#else
    for (int p = 0; p < N_PHASES; ++p) { a.ph_lo = p; a.ph_hi = p + 1; a.li = p; hipLaunchKernelGGL(mega_fwd, dim3(grid), dim3(NWAVES * 64), LDS_BYTES, stream, a); }
#endif
}
```

```cpp
#include <hip/hip_runtime.h>
#include <cstdio>
#include <cstdint>
namespace pg8 {
#define PG8_LAS __attribute__((address_space(3)))
typedef unsigned short bf16_t;
typedef short bf16x8 __attribute__((ext_vector_type(8)));
typedef float f32x4 __attribute__((ext_vector_type(4)));
typedef unsigned u32x4 __attribute__((ext_vector_type(4)));
constexpr int BM = 256, BK = 64, HALF = 128, HTB = HALF * BK * 2  , STAGE_BYTES = 8 * HTB, NXCD = 8, WGM = 8;

__host__ __device__ __forceinline__ int lds_byte(int r, int c) { const int st = (r >> 4) * 2 + (c >> 5), rr = r & 15, cc = c & 31, ob = rr * 64 + cc * 2; return st * 1024 + (ob ^ (((ob >> 9) & 1) << 5)); }
__host__ __device__ __forceinline__ void stage_rc(int b, int& R, int& C) { const int st = b / 1024, sb = b % 1024, swz = sb ^ (((sb >> 9) & 1) << 5); R = (st >> 1) * 16 + swz / 64; C = (st & 1) * 32 + (swz % 64) / 2; }
__host__ __device__ __forceinline__ int perm32(int rho) { const int n = rho >> 4, i = rho & 15; return 8 * (i >> 2) + 4 * n + (i & 3); }

struct Unit { int pm, pn; };
struct Gemm { const bf16_t* A; const bf16_t* Bt; int M, N, K; };

struct StaticOrder {
    int nM, nN, nwg, G, c;
    __host__ __device__ void init(int M, int N, int G_, int c_) { nM = M / BM; nN = N / BM; nwg = nM * nN; G = G_; c = c_; }
    __host__ __device__ bool next(int i, Unit& u) const {
        const long L = (long)i * G + c; if (L >= nwg) return false;
        int wgid = (int)L; { const int q = nwg / NXCD, r = nwg % NXCD, xcd = wgid % NXCD, off = wgid / NXCD; wgid = (xcd < r ? xcd * (q + 1) : r * (q + 1) + (xcd - r) * q) + off; }
        const int nig = WGM * nN, gid = wgid / nig, fm = gid * WGM, gsz = (nM - fm) < WGM ? (nM - fm) : WGM;
        u.pm = fm + ((wgid % nig) % gsz); u.pn = (wgid % nig) / gsz; return true;
    }
    __device__ __forceinline__ void a_ready(const Unit&) const {}
    __device__ __forceinline__ void done(const Unit&) const {}
};
__device__ __forceinline__ unsigned cvt_pk_bf16(float lo, float hi) { unsigned r; asm volatile("v_cvt_pk_bf16_f32 %0, %1, %2" : "=v"(r) : "v"(lo), "v"(hi)); return r; }
template <class Epi, class Sched, bool ALIGN_EPI = false, bool SP2 = false>
__device__ __forceinline__ void gemm_phase(PG8_LAS unsigned char* lds, const Gemm g, const Sched& S, const Epi& E, const int wave_id) {
    int lane_; asm volatile("v_mbcnt_lo_u32_b32 %0, -1, 0\n\tv_mbcnt_hi_u32_b32 %0, -1, %0" : "=v"(lane_));
    int wid_ = wave_id; asm volatile("" : "+s"(wid_));
    const int wid = wid_, lane = lane_, tid = wid * 64 + lane, wr = wid >> 2, wc = wid & 3, fr = lane & 15, fq = lane >> 4;
    const int K = g.K, nt = K / BK;
    unsigned voffA[2], voffB[2];
#pragma unroll
    for (int i = 0; i < 2; ++i) { int R, C; stage_rc(tid * 16 + i * 8192, R, C); const int Rb = Epi::PERM ? ((R & ~31) + perm32(R & 31)) : R;
        voffA[i] = (unsigned)(R * K + C) * 2u; voffB[i] = (unsigned)(Rb * K + C) * 2u; }
    const size_t kstep = (size_t)(BK * 2);
    const size_t hstep = (size_t)HALF * K * 2;
    const size_t tstep = 2 * hstep;
    const unsigned ldsw = (unsigned)wid * 1024u;
    const int aoff = lds_byte(wr * 64 + fr, fq * 8), boff = lds_byte(wc * 32 + fr, fq * 8);
#define PG8_SA(b, h) (((b) * 2 + (h)) * HTB)
#define PG8_SB(b, h) ((4 + (b) * 2 + (h)) * HTB)
#define PG8_STAGE(bufoff, gbase, voff) do { _Pragma("unroll") for (int _i = 0; _i < 2; ++_i) \
        __builtin_amdgcn_global_load_lds((const unsigned*)((const char*)(gbase) + (voff)[_i]), (PG8_LAS unsigned*)(lds + (bufoff) + ldsw + _i * 8192), 16, 0, 0); } while (0)
#define PG8_LDA(dst, b, h) do { _Pragma("unroll") for (int m = 0; m < 4; ++m) _Pragma("unroll") for (int k = 0; k < 2; ++k) dst[m][k] = *(const PG8_LAS bf16x8*)(lds + PG8_SA(b, h) + aoff + m * 2048 + k * 1024); } while (0)
#define PG8_LDB(dst, b, h) do { _Pragma("unroll") for (int n = 0; n < 2; ++n) _Pragma("unroll") for (int k = 0; k < 2; ++k) dst[n][k] = *(const PG8_LAS bf16x8*)(lds + PG8_SB(b, h) + boff + n * 2048 + k * 1024); } while (0)
#define PG8_MMA(ai, bj, At, Bt) do { __builtin_amdgcn_s_setprio(1); _Pragma("unroll") for (int m = 0; m < 4; ++m) _Pragma("unroll") for (int n = 0; n < 2; ++n) _Pragma("unroll") for (int k = 0; k < 2; ++k) \
        acc[ai][bj][m][n] = __builtin_amdgcn_mfma_f32_16x16x32_bf16(Bt[n][k], At[m][k], acc[ai][bj][m][n], 0, 0, 0); __builtin_amdgcn_s_setprio(0); } while (0)
#define PG8_WAIT_V(n) asm volatile("s_waitcnt vmcnt(" #n ")" ::: "memory")
#define PG8_WAIT_L(n) asm volatile("s_waitcnt lgkmcnt(" #n ")" ::: "memory")
#define PG8_BAR __builtin_amdgcn_s_barrier()
#define PG8_SCHED __builtin_amdgcn_sched_barrier(0)
    Unit cur, nxt; int ui = 0;
    if (!S.next(0, cur)) return;
    f32x4 acc[2][2][4][2];
#pragma unroll
    for (int a = 0; a < 2; ++a)
#pragma unroll
        for (int b = 0; b < 2; ++b)
#pragma unroll
            for (int m = 0; m < 4; ++m)
#pragma unroll
                for (int n = 0; n < 2; ++n) acc[a][b][m][n] = (f32x4){0.f, 0.f, 0.f, 0.f};
    bf16x8 At[4][2], B0[2][2], B1[2][2];
    const char* cA = (const char*)g.A + (size_t)cur.pm * tstep; const char* cB = (const char*)g.Bt + (size_t)cur.pn * tstep;
    S.a_ready(cur);
    if constexpr (SP2) {
        PG8_STAGE(PG8_SB(0, 0), cB, voffB); PG8_STAGE(PG8_SB(0, 1), cB + hstep, voffB); PG8_STAGE(PG8_SA(0, 0), cA, voffA); PG8_STAGE(PG8_SA(0, 1), cA + hstep, voffA);
        if (wr == 1) PG8_BAR;
        PG8_WAIT_V(2); PG8_BAR;
        PG8_STAGE(PG8_SB(1, 0), cB + kstep, voffB); PG8_STAGE(PG8_SA(1, 0), cA + kstep, voffA); PG8_STAGE(PG8_SB(1, 1), cB + hstep + kstep, voffB);
        PG8_WAIT_V(6); PG8_BAR;
    } else {
        PG8_STAGE(PG8_SB(0, 0), cB, voffB); PG8_STAGE(PG8_SA(0, 0), cA, voffA); PG8_STAGE(PG8_SB(0, 1), cB + hstep, voffB); PG8_STAGE(PG8_SA(0, 1), cA + hstep, voffA);
        if (wr == 1) PG8_BAR;
        PG8_WAIT_V(4); PG8_BAR;
        PG8_STAGE(PG8_SB(1, 0), cB + kstep, voffB); PG8_STAGE(PG8_SA(1, 0), cA + kstep, voffA); PG8_STAGE(PG8_SB(1, 1), cB + hstep + kstep, voffB);
        PG8_WAIT_V(6); PG8_BAR;
    }
    for (;;) {
        const bool has_next = S.next(ui + 1, nxt);
        const char* nA = has_next ? (const char*)g.A + (size_t)nxt.pm * tstep : cA; const char* nB = has_next ? (const char*)g.Bt + (size_t)nxt.pn * tstep : cB;
        for (int t = 0; t < nt; t += 2) {
            const bool last = (t == nt - 2);
            const char* a1 = cA + (size_t)(t + 1) * kstep;
            const char* a2 = last ? nA : cA + (size_t)(t + 2) * kstep; const char* b2 = last ? nB : cB + (size_t)(t + 2) * kstep;
            const char* a3 = a2 + kstep; const char* b3 = b2 + kstep;
            if (last && has_next) S.a_ready(nxt);
            if constexpr (SP2) {
            PG8_LDB(B0, 0, 0); PG8_LDB(B1, 0, 1); PG8_SCHED; PG8_LDA(At, 0, 0); PG8_STAGE(PG8_SA(1, 1), a1 + hstep, voffA);
            PG8_WAIT_V(8); PG8_WAIT_L(0); PG8_BAR; PG8_MMA(0, 0, At, B0); PG8_MMA(0, 1, At, B1); PG8_BAR; PG8_SCHED;
            PG8_LDA(At, 0, 1); PG8_STAGE(PG8_SB(0, 0), b2, voffB); PG8_STAGE(PG8_SB(0, 1), b2 + hstep, voffB); PG8_STAGE(PG8_SA(0, 0), a2, voffA);
            PG8_WAIT_V(8); PG8_WAIT_L(0); PG8_BAR; PG8_MMA(1, 0, At, B0); PG8_MMA(1, 1, At, B1); PG8_BAR; PG8_SCHED;
            PG8_LDB(B0, 1, 0); PG8_LDB(B1, 1, 1); PG8_SCHED; PG8_LDA(At, 1, 0); PG8_STAGE(PG8_SA(0, 1), a2 + hstep, voffA);
            PG8_WAIT_V(8); PG8_WAIT_L(0); PG8_BAR; PG8_MMA(0, 0, At, B0); PG8_MMA(0, 1, At, B1); PG8_BAR; PG8_SCHED;
            PG8_LDA(At, 1, 1); PG8_STAGE(PG8_SB(1, 0), b3, voffB); PG8_STAGE(PG8_SB(1, 1), b3 + hstep, voffB); PG8_STAGE(PG8_SA(1, 0), a3, voffA);
            PG8_WAIT_V(8); PG8_WAIT_L(0); PG8_BAR; PG8_MMA(1, 0, At, B0); PG8_MMA(1, 1, At, B1); PG8_BAR; PG8_SCHED;
            } else {
            PG8_LDB(B0, 0, 0); PG8_SCHED; PG8_LDA(At, 0, 0); PG8_STAGE(PG8_SA(1, 1), a1 + hstep, voffA);
            PG8_WAIT_L(8); PG8_BAR; PG8_WAIT_L(0); PG8_MMA(0, 0, At, B0); PG8_BAR; PG8_SCHED;
            PG8_LDB(B1, 0, 1); PG8_STAGE(PG8_SB(0, 0), b2, voffB);
            PG8_BAR; PG8_WAIT_L(0); PG8_MMA(0, 1, At, B1); PG8_BAR;
            PG8_LDA(At, 0, 1); PG8_STAGE(PG8_SA(0, 0), a2, voffA);
            PG8_BAR; PG8_WAIT_L(0); PG8_MMA(1, 0, At, B0); PG8_BAR; PG8_SCHED;
            PG8_STAGE(PG8_SB(0, 1), b2 + hstep, voffB);
            PG8_WAIT_V(6); PG8_BAR; PG8_MMA(1, 1, At, B1); PG8_BAR;
            PG8_LDB(B0, 1, 0); PG8_SCHED; PG8_LDA(At, 1, 0); PG8_STAGE(PG8_SA(0, 1), a2 + hstep, voffA);
            PG8_WAIT_L(8); PG8_BAR; PG8_WAIT_L(0); PG8_MMA(0, 0, At, B0); PG8_BAR; PG8_SCHED;
            PG8_LDB(B1, 1, 1); PG8_STAGE(PG8_SB(1, 0), b3, voffB);
            PG8_BAR; PG8_WAIT_L(0); PG8_MMA(0, 1, At, B1); PG8_BAR;
            PG8_LDA(At, 1, 1); PG8_STAGE(PG8_SA(1, 0), a3, voffA);
            PG8_BAR; PG8_WAIT_L(0); PG8_MMA(1, 0, At, B0); PG8_BAR; PG8_SCHED;
            PG8_STAGE(PG8_SB(1, 1), b3 + hstep, voffB);
            PG8_WAIT_V(6); PG8_BAR; PG8_MMA(1, 1, At, B1); PG8_BAR;
            }
        }
        if constexpr (ALIGN_EPI) { if (wr == 0) PG8_BAR; }
        if constexpr (!Epi::AFTER_DRAIN) { E(acc, cur, wr, wc, fr, fq); S.done(cur); }
        if (!has_next) break;
#pragma unroll
        for (int a = 0; a < 2; ++a)
#pragma unroll
            for (int b = 0; b < 2; ++b)
#pragma unroll
                for (int m = 0; m < 4; ++m)
#pragma unroll
                    for (int n = 0; n < 2; ++n) acc[a][b][m][n] = (f32x4){0.f, 0.f, 0.f, 0.f};
        cur = nxt; cA = nA; cB = nB; ++ui;
        if constexpr (ALIGN_EPI) { if (wr == 1) PG8_BAR; }
    }
    PG8_WAIT_V(0);
    if constexpr (!ALIGN_EPI) { if (wr == 0) PG8_BAR; }
    PG8_BAR;
    if constexpr (Epi::AFTER_DRAIN) { E.fused(acc, cur, wr, wc, fr, fq, lds, wid, lane); S.done(cur); }
#undef PG8_SA
#undef PG8_SB
#undef PG8_STAGE
#undef PG8_LDA
#undef PG8_LDB
#undef PG8_MMA
#undef PG8_WAIT_V
#undef PG8_WAIT_L
#undef PG8_BAR
#undef PG8_SCHED
}
}

constexpr int NWAVES = 8, GRID = 256;
constexpr int BATCH = 4, SEQ = 8192, DM = 1024, MTOK = BATCH * SEQ, DEPTH = 4;
constexpr int NA_SRC = 2120, NA_PAD = 2304, NB = 3072, FF = 2816, NUP = 2 * FF;
constexpr float EPS = 1e-6f;
constexpr float LOG2E = 1.4426950408889634f;
constexpr float C2 = 0.125f * LOG2E;
constexpr int NBLK64 = MTOK / 64;

constexpr size_t MiB = 1u << 20;
constexpr size_t WS_CTL = 0, CTL_ZERO_BYTES = 1 * MiB;
constexpr size_t WS_W_INA = 2 * MiB;
constexpr size_t WS_W_INB = 11 * MiB;
constexpr size_t WS_W_OUT = 23 * MiB;
constexpr size_t WS_W_UP = 31 * MiB;
constexpr size_t WS_W_DN = 75 * MiB;
constexpr size_t WS_HB = 98 * MiB;
constexpr size_t WS_M = 162 * MiB;
constexpr size_t WS_SS = 226 * MiB;
constexpr size_t WS_HALO = 228 * MiB;
constexpr size_t WS_PROJ = 272 * MiB;
constexpr size_t WS_END = 464 * MiB;
constexpr size_t PA_QA = 0, PA_KA = 64 * MiB, PA_VA = 80 * MiB, PA_QI = 96 * MiB, PA_KI = 128 * MiB, PA_WI = 132 * MiB, PA_SEL = 136 * MiB;
constexpr size_t PB_STRIDE = 64 * MiB;
constexpr int CW_BAR = 4096;

constexpr int RING_OFF = 0, RING_BYTES = 131072;
constexpr int KS_OFF = RING_BYTES;
constexpr int AUX_OFF = RING_BYTES + 24576;
constexpr int LDSCTL_OFF = AUX_OFF + 4096, MISC_OFF = LDSCTL_OFF + 320;
constexpr int LDS_BYTES = 163840;
static_assert(MISC_OFF + 128 <= LDS_BYTES, "LDS map");

#define GAS __attribute__((address_space(1)))
#define LAS __attribute__((address_space(3)))
typedef unsigned short bf16;
typedef unsigned v4u __attribute__((ext_vector_type(4)));
typedef unsigned v2u __attribute__((ext_vector_type(2)));
typedef float f32x4 __attribute__((ext_vector_type(4)));
typedef float f32x16 __attribute__((ext_vector_type(16)));
typedef short bf16x8 __attribute__((ext_vector_type(8)));
typedef short s16x4 __attribute__((ext_vector_type(4)));
typedef float f32x2_t __attribute__((ext_vector_type(2)));
typedef GAS unsigned gu32;
#define RLX_AGENT __ATOMIC_RELAXED, __HIP_MEMORY_SCOPE_AGENT
#define LDS_WAIT() asm volatile("s_waitcnt lgkmcnt(0)" ::: "memory")
#define VM_WAIT() asm volatile("s_waitcnt vmcnt(0)" ::: "memory")
__device__ __forceinline__ unsigned f2bf(float f) { unsigned u = __builtin_bit_cast(unsigned, f); return (u + 0x7fffu + ((u >> 16) & 1u)) >> 16; }
__device__ __forceinline__ unsigned pk2(float lo, float hi) { return f2bf(lo) | (f2bf(hi) << 16); }
typedef float f32x2c_t __attribute__((ext_vector_type(2))); typedef __bf16 bf16x2c_t __attribute__((ext_vector_type(2)));
__device__ __forceinline__ unsigned cvtpk(float lo, float hi) { const f32x2c_t v = {lo, hi}; const bf16x2c_t b = __builtin_convertvector(v, bf16x2c_t); return __builtin_bit_cast(unsigned, b); }
__device__ __forceinline__ float bf_lo(unsigned u) { return __builtin_bit_cast(float, u << 16); }
__device__ __forceinline__ float bf_hi(unsigned u) { return __builtin_bit_cast(float, u & 0xffff0000u); }

#define XB_TMO      128
#define XB_XCNT(j)  (256  + 64 * (j))
#define XB_XSUB(j)  (1280 + 64 * (j))
#define XB_XGEN(j)  (2304 + 64 * (j))
#define XB_TOP      3328
#define XB_TOPGEN   3392
#define XCD_BAR_WORDS 3456
#define XB_SPIN_CAP (1u << 18)

__device__ __forceinline__ unsigned xb_ld(unsigned* p)              { return __hip_atomic_load(p, __ATOMIC_RELAXED, __HIP_MEMORY_SCOPE_AGENT); }
__device__ __forceinline__ unsigned xb_add(unsigned* p, unsigned v) { return __hip_atomic_fetch_add(p, v, __ATOMIC_RELAXED, __HIP_MEMORY_SCOPE_AGENT); }
__device__ __forceinline__ unsigned xb_xcc_id() { return (unsigned)__builtin_amdgcn_s_getreg((3 << 11) | 20) & 0xFu; }
#define XB_SPIN(cond, bar) do { unsigned _sp = 0; while (cond) { __builtin_amdgcn_s_sleep(1); \
    if ((++_sp & 255u) == 0u) { if (xb_ld(&(bar)[XB_TMO])) break; if (_sp > XB_SPIN_CAP) { atomicAdd(&(bar)[XB_TMO], 1u); break; } } } } while (0)

struct XcdBarrier {
    unsigned* bar; unsigned x;
    volatile LAS unsigned* st;
};

__device__ __forceinline__ XcdBarrier xcd_barrier_post(unsigned* bar, volatile LAS unsigned* st) {
    XcdBarrier b; b.bar = bar; b.x = xb_xcc_id(); b.st = st;
    if (threadIdx.x == 0) (void)xb_add(&bar[XB_XCNT(b.x)], 1u);
    return b;
}
__device__ __forceinline__ void xcd_barrier_complete(unsigned* bar, unsigned x, unsigned& nloc, unsigned& nx) {
    const unsigned G = gridDim.x * gridDim.y * gridDim.z;
    unsigned sum, cnt, mine, sp = 0u;
    for (;;) {
        sum = 0u; cnt = 0u; mine = 0u;
#pragma unroll
        for (unsigned j = 0; j < 16; ++j) { const unsigned c = xb_ld(&bar[XB_XCNT(j)]); sum += c; cnt += (c > 0u) ? 1u : 0u; mine = (j == x) ? c : mine; }
        if (sum == G) break;
        __builtin_amdgcn_s_sleep(1);
        if ((++sp & 255u) == 0u) { if (xb_ld(&bar[XB_TMO])) break; if (sp > XB_SPIN_CAP) { atomicAdd(&bar[XB_TMO], 1u); break; } }
    }
    nloc = mine > 0u ? mine : 1u; nx = cnt > 0u ? cnt : 1u;
}

__device__ __forceinline__ void xcd_barrier(const XcdBarrier& b) {
    asm volatile("s_waitcnt vmcnt(0)" ::: "memory");
    __syncthreads();
    if (threadIdx.x == 0) {
        unsigned* bar = b.bar;
        __builtin_amdgcn_s_waitcnt(0);
        unsigned nloc = b.st[0], nx = b.st[1];
        if (nloc == 0u) { xcd_barrier_complete(bar, b.x, nloc, nx); b.st[0] = nloc; b.st[1] = nx; }
        const unsigned old = xb_add(&bar[XB_XSUB(b.x)], 1u);
        const unsigned gen = old / nloc;
        if (old + 1u == (gen + 1u) * nloc) {
            __builtin_amdgcn_fence(__ATOMIC_RELEASE, "agent");
            asm volatile("s_waitcnt vmcnt(0)" ::: "memory");
            const unsigned og = xb_add(&bar[XB_TOP], 1u);
            const unsigned tg = og / nx;
            if (og + 1u == (tg + 1u) * nx) xb_add(&bar[XB_TOPGEN], 1u);
            else XB_SPIN(xb_ld(&bar[XB_TOPGEN]) == tg, bar);
            __builtin_amdgcn_fence(__ATOMIC_ACQUIRE, "agent");
            xb_add(&bar[XB_XGEN(b.x)], 1u);
            asm volatile("s_waitcnt vmcnt(0)" ::: "memory");
        } else {
            XB_SPIN(xb_ld(&bar[XB_XGEN(b.x)]) == gen, bar);
            __builtin_amdgcn_fence(__ATOMIC_ACQUIRE, "agent");
            asm volatile("s_waitcnt vmcnt(0)" ::: "memory");
        }
    }
    __syncthreads();
}


struct Args {
    const float* x; const float* attn_norm_g; const float* w_in_a; const float* w_in_b; const float* q_norm_g; const float* k_norm_g; const float* t5_bias;
    const float* rel_bias_b; const float* w_out; const float* ffn_norm_g; const float* w_up; const float* conv_w; const float* conv_b; const float* w_down;
    float* out; unsigned char* ws; int ph_lo, ph_hi, li, pad;
};

struct Frame {
    LAS unsigned char* lds;
    volatile LAS unsigned* MISC;
    gu32* ctl;
    int tid, lane, wave, vcu, G;
};

__host__ __device__ __forceinline__ int hmap(int p) { return 64 * ((p >> 5) & 3) + 16 * ((p >> 2) & 3) + 8 * (p >> 7) + 4 * ((p >> 4) & 1) + (p & 3); }
__host__ __device__ __forceinline__ int umap(int p) { return 32 * ((p >> 5) & 3) + 8 * ((p >> 2) & 3) + 4 * ((p >> 4) & 1) + (p & 3); }
__host__ __device__ __forceinline__ int src_col(int type, int n) {
    if (type == 0) return n;
    const int pn = n >> 8, p = n & 255;
    if (type == 2) return 256 * pn + hmap(p);
    if (type == 1) { const int c = hmap(p); return pn < 8 ? 256 * pn + c : (c < 72 ? 2048 + c : -1); }
    return (p >> 7) * FF + 128 * pn + umap(p);
}
__device__ __forceinline__ void convert_item(const float* W, int K, int Nsrc, int Ndst, int type, const float* gain, bf16* WT, LAS float* scr, int item, int lane) {
    const int nblk = Ndst / 32, kb = item / nblk, nb = item % nblk, k0 = 64 * kb, n0 = 32 * nb;
    const int sc = src_col(type, n0 + (lane & 31));
#pragma unroll 8
    for (int i = 0; i < 32; ++i) { const int kk = 2 * i + (lane >> 5); float v = 0.f; if (sc >= 0) v = W[(size_t)(k0 + kk) * Nsrc + sc]; if (gain) v *= gain[k0 + kk]; scr[kk * 33 + (lane & 31)] = v; }
    LDS_WAIT(); asm volatile("" ::: "memory");
    const int c = lane & 7;
#pragma unroll
    for (int j = 0; j < 4; ++j) { const int n = (lane >> 3) + 8 * j; const LAS float* s = scr + (8 * c) * 33 + n;
        v4u o; o.x = pk2(s[0 * 33], s[1 * 33]); o.y = pk2(s[2 * 33], s[3 * 33]); o.z = pk2(s[4 * 33], s[5 * 33]); o.w = pk2(s[6 * 33], s[7 * 33]);
        *(v4u*)(WT + (size_t)(n0 + n) * K + k0 + 8 * c) = o; }
    LDS_WAIT(); asm volatile("" ::: "memory");
}
__device__ __forceinline__ float wave_sum(float v) {
#pragma unroll
    for (int o = 1; o < 64; o <<= 1) v += __shfl_xor(v, o);
    return v;
}
__device__ __forceinline__ void p0_prologue(Frame& F, const Args& a) {
    LAS float* scr = (LAS float*)(F.lds + RING_OFF + F.wave * 16384);
    const int gw = F.vcu * NWAVES + F.wave, NGW = F.G * NWAVES;
    constexpr int I_INA = 16 * (NA_PAD / 32), I_INB = 16 * (NB / 32), I_OUT = 16 * 32, I_UP = 16 * (NUP / 32), I_DN = (FF / 64) * 32;
    constexpr int NITEMS = 2 * I_INA + 2 * I_INB + 4 * I_OUT + 4 * I_UP + 4 * I_DN;
    unsigned char* ws = a.ws;
    for (int it = gw; it < NITEMS; it += NGW) {
        int r = it;
        if (r < 2 * I_INA) { const int l = r / I_INA; convert_item(a.w_in_a + (size_t)l * DM * NA_SRC, DM, NA_SRC, NA_PAD, 1, a.attn_norm_g + (2 * l) * DM, (bf16*)(ws + WS_W_INA) + (size_t)l * NA_PAD * DM, scr, r % I_INA, F.lane); continue; } r -= 2 * I_INA;
        if (r < 2 * I_INB) { const int l = r / I_INB; convert_item(a.w_in_b + (size_t)l * DM * NB, DM, NB, NB, 2, a.attn_norm_g + (2 * l + 1) * DM, (bf16*)(ws + WS_W_INB) + (size_t)l * NB * DM, scr, r % I_INB, F.lane); continue; } r -= 2 * I_INB;
        if (r < 4 * I_OUT) { const int l = r / I_OUT; convert_item(a.w_out + (size_t)l * DM * DM, DM, DM, DM, 0, nullptr, (bf16*)(ws + WS_W_OUT) + (size_t)l * DM * DM, scr, r % I_OUT, F.lane); continue; } r -= 4 * I_OUT;
        if (r < 4 * I_UP) { const int l = r / I_UP; convert_item(a.w_up + (size_t)l * DM * NUP, DM, NUP, NUP, 3, a.ffn_norm_g + l * DM, (bf16*)(ws + WS_W_UP) + (size_t)l * NUP * DM, scr, r % I_UP, F.lane); continue; } r -= 4 * I_UP;
        { const int l = r / I_DN; convert_item(a.w_down + (size_t)l * FF * DM, FF, DM, DM, 0, nullptr, (bf16*)(ws + WS_W_DN) + (size_t)l * DM * FF, scr, r % I_DN, F.lane); }
    }
    bf16* hb = (bf16*)(ws + WS_HB); float* ss = (float*)(ws + WS_SS);
    for (int m = gw; m < MTOK; m += NGW) {
        const f32x4* xr = (const f32x4*)(a.x + (size_t)m * DM) + F.lane; f32x4 v[4]; float s = 0.f;
#pragma unroll
        for (int j = 0; j < 4; ++j) { v[j] = xr[64 * j]; s += (v[j].x * v[j].x + v[j].y * v[j].y) + (v[j].z * v[j].z + v[j].w * v[j].w); }
        s = wave_sum(s);
        v2u* o8 = (v2u*)(hb + (size_t)m * DM) + F.lane;
#pragma unroll
        for (int j = 0; j < 4; ++j) { v2u w; w.x = pk2(v[j].x, v[j].y); w.y = pk2(v[j].z, v[j].w); o8[64 * j] = w; }
        if (F.lane < 16) ss[(size_t)m * 16 + F.lane] = (F.lane == 0) ? s : 0.f;
    }
}

__device__ __forceinline__ float row_rstd(const float* ss, int row, int fq) {
    const f32x4 a = *(const f32x4*)(ss + (size_t)row * 16 + 4 * fq);
    float s = (a.x + a.y) + (a.z + a.w);
    s += __shfl_xor(s, 16); s += __shfl_xor(s, 32);
    return __builtin_amdgcn_rsqf(s * (1.0f / DM) + EPS);
}
__device__ __forceinline__ unsigned att_pk4(f32x4 v) { int r = __builtin_amdgcn_cvt_pk_fp8_f32(v.x, v.y, 0, false); r = __builtin_amdgcn_cvt_pk_fp8_f32(v.z, v.w, r, true); return (unsigned)r; }
struct EpiIn {
    static constexpr bool PERM = false, AFTER_DRAIN = false;
    const float* ss; unsigned char* proj; const float* qg; const float* kg; int isB;
    __device__ __forceinline__ void operator()(const pg8::f32x4 (&acc)[2][2][4][2], const pg8::Unit& u, int wr, int wc, int fr, int fq) const {
        asm volatile("" : "+v"(fr), "+v"(fq));
        const int pn = u.pn; int kind, pitch; bf16* dst;
        if (isB) { const int t = pn >> 2; kind = (t == 0) ? 1 : (t == 1 ? 2 : 0); dst = (bf16*)(proj + (size_t)t * PB_STRIDE) + 256 * (pn & 3); pitch = DM; }
        else if (pn < 4) { kind = 1; dst = (bf16*)(proj + PA_QA) + 256 * pn; pitch = DM; }
        else if (pn == 4) { kind = 2; dst = (bf16*)(proj + PA_KA); pitch = 256; }
        else if (pn == 5) { kind = 0; dst = (bf16*)(proj + PA_VA); pitch = 256; }
        else if (pn < 8) { kind = 0; dst = (bf16*)(proj + PA_QI) + 256 * (pn - 6); pitch = 512; }
        else { kind = 3; dst = (bf16*)(proj + PA_KI); pitch = 64; }
        if (kind == 3 && wc >= 2) return;
        const bool donorm = (kind == 1) || (kind == 2) || (kind == 3 && wc == 0);
        f32x4 g[2][2];
#pragma unroll
        for (int bj = 0; bj < 2; ++bj)
#pragma unroll
            for (int n = 0; n < 2; ++n) {
                if (kind == 1) g[bj][n] = *(const f32x4*)(qg + 16 * fq + 8 * bj + 4 * n) * (isB ? C2 : 1.0f);
                else if (kind == 2) g[bj][n] = *(const f32x4*)(kg + 16 * fq + 8 * bj + 4 * n);
                else g[bj][n] = (f32x4){1.f, 1.f, 1.f, 1.f};
            }
        float* wi = (float*)(proj + PA_WI);
#pragma unroll
        for (int ai = 0; ai < 2; ++ai)
#pragma unroll
            for (int m = 0; m < 4; ++m) {
                const int row = u.pm * 256 + ai * 128 + wr * 64 + m * 16 + fr;
                const float rs = row_rstd(ss, row, fq);
                f32x4 v[2][2]; float s = 0.f;
#pragma unroll
                for (int bj = 0; bj < 2; ++bj)
#pragma unroll
                    for (int n = 0; n < 2; ++n) { v[bj][n] = acc[ai][bj][m][n] * rs; const f32x4 q = v[bj][n] * v[bj][n]; s += (q.x + q.y) + (q.z + q.w); }
                if (donorm) {
                    s += __shfl_xor(s, 16); s += __shfl_xor(s, 32);
                    const float r = 1.0f / sqrtf(s * (1.0f / 64.0f) + EPS);
#pragma unroll
                    for (int bj = 0; bj < 2; ++bj)
#pragma unroll
                        for (int n = 0; n < 2; ++n) v[bj][n] = v[bj][n] * r * g[bj][n];
                }
                if (kind == 3 && wc == 1) {
                    if (fq == 0) { float* wp = wi + (size_t)row * 8; const float sc = 0.04419417382415922f;
                        *(f32x4*)(wp) = v[0][0] * sc; *(f32x4*)(wp + 4) = v[0][1] * sc; }
                } else if (!isB && pn < 6) {
                    unsigned char* p8 = (pn < 4) ? proj + PA_QA + (size_t)row * 1024 + 256 * pn + 64 * wc + 16 * fq : proj + PA_KA + (size_t)row * 512 + 128 * wc + 64 * (pn - 4) + 16 * fq;
                    v4u w; w.x = att_pk4(v[0][0]); w.y = att_pk4(v[0][1]); w.z = att_pk4(v[1][0]); w.w = att_pk4(v[1][1]);
                    *(v4u*)p8 = w;
                } else {
                    bf16* rp = dst + (size_t)row * pitch + 64 * wc + 16 * fq;
#pragma unroll
                    for (int bj = 0; bj < 2; ++bj) { v4u w; w.x = cvtpk(v[bj][0].x, v[bj][0].y); w.y = cvtpk(v[bj][0].z, v[bj][0].w); w.z = cvtpk(v[bj][1].x, v[bj][1].y); w.w = cvtpk(v[bj][1].z, v[bj][1].w);
                        *(v4u*)(rp + 8 * bj) = w; }
                }
            }
    }
};
struct EpiRes {
    static constexpr bool PERM = false, AFTER_DRAIN = false;
    const float* xin; float* fout; const bf16* hbi; bf16* hb; float* ss;
    __device__ __forceinline__ void operator()(const pg8::f32x4 (&acc)[2][2][4][2], const pg8::Unit& u, int wr, int wc, int fr, int fq) const {
        asm volatile("" : "+v"(fr), "+v"(fq));
        const int col0 = u.pn * 256 + wc * 32 + 4 * fq;
#pragma unroll
        for (int ai = 0; ai < 2; ++ai)
#pragma unroll
            for (int m = 0; m < 4; ++m) {
                const int row = u.pm * 256 + ai * 128 + wr * 64 + m * 16 + fr; const size_t off = (size_t)row * DM + col0; float s = 0.f;
#pragma unroll
                for (int bj = 0; bj < 2; ++bj)
#pragma unroll
                    for (int n = 0; n < 2; ++n) { const size_t o4 = off + bj * 128 + n * 16; f32x4 base;
                        if (xin) base = *(const f32x4*)(xin + o4); else { const v2u b = *(const v2u*)(hbi + o4); base = (f32x4){bf_lo(b.x), bf_hi(b.x), bf_lo(b.y), bf_hi(b.y)}; }
                        const f32x4 o = base + acc[ai][bj][m][n];
                        if (fout) *(f32x4*)(fout + o4) = o;
                        else { const f32x4 q = o * o; s += (q.x + q.y) + (q.z + q.w); v2u w; w.x = cvtpk(o.x, o.y); w.y = cvtpk(o.z, o.w); *(v2u*)(hb + o4) = w; } }
                if (!fout) { s += __shfl_xor(s, 16); s += __shfl_xor(s, 32); if (fq == 0) ss[(size_t)row * 16 + u.pn * 4 + wc] = s; }
            }
    }
};
#ifdef X_NOBPERM
__device__ __forceinline__ float lane_from(int byteaddr, float v) { return v + (float)byteaddr; }
#else
__device__ __forceinline__ float lane_from(int byteaddr, float v) { return __builtin_bit_cast(float, __builtin_amdgcn_ds_bpermute(byteaddr, __builtin_bit_cast(int, v))); }
#endif
#ifdef X_NOSILU
__device__ __forceinline__ float silu_mul(float a, float g) { return a * g; }
#else
__device__ __forceinline__ float silu_mul(float a, float g) { return a * g * __builtin_amdgcn_rcpf(1.0f + __builtin_amdgcn_exp2f(-g * LOG2E)); }
#endif
struct EpiUp {
    static constexpr bool PERM = false, AFTER_DRAIN = false;
    const float* ss; const float* cw; const float* cb; bf16* act; float* halo;
    __device__ __forceinline__ void operator()(const pg8::f32x4 (&acc)[2][2][4][2], const pg8::Unit& u, int wr, int wc, int fr, int fq) const {
        asm volatile("" : "+v"(fr), "+v"(fq));
        unsigned pk[2][2][4][2][2];
#pragma unroll
        for (int ai = 0; ai < 2; ++ai)
#pragma unroll
            for (int m = 0; m < 4; ++m) {
                const float rs = row_rstd(ss, u.pm * 256 + ai * 128 + wr * 64 + m * 16 + fr, fq);
#pragma unroll
                for (int bj = 0; bj < 2; ++bj)
#pragma unroll
                    for (int n = 0; n < 2; ++n) { const f32x4 v = acc[ai][bj][m][n] * rs; pk[ai][bj][m][n][0] = cvtpk(v.x, v.y); pk[ai][bj][m][n][1] = cvtpk(v.z, v.w); }
            }
        __builtin_amdgcn_sched_barrier(0);
        const int lane_ = fq * 16 + fr, src1 = 4 * ((lane_ & 48) | ((fr + 15) & 15)), src2 = 4 * ((lane_ & 48) | ((fr + 14) & 15));
        if (fr < 2 || fr >= 14) {
            const int mh = (fr < 2) ? 0 : 3, slot = (fr < 2) ? fr : fr - 12;
#pragma unroll
            for (int ai = 0; ai < 2; ++ai)
#pragma unroll
                for (int bj = 0; bj < 2; ++bj)
#pragma unroll
                    for (int n = 0; n < 2; ++n) { const unsigned w0 = (mh == 0) ? pk[ai][bj][0][n][0] : pk[ai][bj][3][n][0], w1 = (mh == 0) ? pk[ai][bj][0][n][1] : pk[ai][bj][3][n][1];
                        *(f32x4*)(halo + ((size_t)(u.pm * 4 + ai * 2 + wr) * 4 + slot) * NUP + bj * FF + u.pn * 128 + wc * 32 + 8 * fq + 4 * n) = (f32x4){bf_lo(w0), bf_hi(w0), bf_lo(w1), bf_hi(w1)}; }
        }
        __builtin_amdgcn_sched_barrier(0);
#pragma unroll
        for (int n = 0; n < 2; ++n)
#pragma unroll
            for (int pr = 0; pr < 2; ++pr) {
                const int ca0 = u.pn * 128 + wc * 32 + 8 * fq + 4 * n + 2 * pr;
                f32x2_t kk0[2], kk1[2], kk2[2], kkb[2];
#pragma unroll
                for (int bj = 0; bj < 2; ++bj) { const int c = bj * FF + ca0; kk0[bj] = *(const f32x2_t*)(cw + c); kk1[bj] = *(const f32x2_t*)(cw + NUP + c); kk2[bj] = *(const f32x2_t*)(cw + 2 * NUP + c); kkb[bj] = *(const f32x2_t*)(cb + c); }
#pragma unroll
                for (int ai = 0; ai < 2; ++ai) {
                    const int row0 = (u.pm * 4 + ai * 2 + wr) * 64;
                    float y[2][4][2];
#pragma unroll
                    for (int bj = 0; bj < 2; ++bj) {
                        unsigned r1[4], r2[4];
#pragma unroll
                        for (int m = 0; m < 4; ++m) { const unsigned w = pk[ai][bj][m][n][pr]; r1[m] = (unsigned)__builtin_amdgcn_ds_bpermute(src1, (int)w); r2[m] = (unsigned)__builtin_amdgcn_ds_bpermute(src2, (int)w); }
#pragma unroll
                        for (int m = 0; m < 4; ++m) {
                            const unsigned w = pk[ai][bj][m][n][pr];
                            const unsigned u1 = (fr >= 1) ? r1[m] : r1[m > 0 ? m - 1 : 0];
                            const unsigned u2 = (fr >= 2) ? r2[m] : r2[m > 0 ? m - 1 : 0];
                            y[bj][m][0] = kkb[bj].x + kk0[bj].x * bf_lo(u2) + kk1[bj].x * bf_lo(u1) + kk2[bj].x * bf_lo(w);
                            y[bj][m][1] = kkb[bj].y + kk0[bj].y * bf_hi(u2) + kk1[bj].y * bf_hi(u1) + kk2[bj].y * bf_hi(w);
                        }
                    }
#pragma unroll
                    for (int m = 0; m < 4; ++m) {
                        if (m == 0 && fr < 2) continue;
                        *(unsigned*)(act + (size_t)(row0 + m * 16 + fr) * FF + ca0) = cvtpk(silu_mul(y[0][m][0], y[1][m][0]), silu_mul(y[0][m][1], y[1][m][1]));
                    }
                }
                asm volatile("" ::: "memory");
            }
    }
};
__device__ __forceinline__ void fixup_phase(Frame& F, const float* cw, const float* cb, const float* halo, bf16* act) {
    const int gt = F.vcu * (NWAVES * 64) + F.tid, NT = F.G * NWAVES * 64;
    constexpr int C4 = FF / 4;
    for (int it = gt; it < NBLK64 * 2 * C4; it += NT) {
        const int c = (it % C4) * 4, rj = it / C4, j = rj & 1, blk = rj >> 1, t = blk * 64 + j, tb = t % SEQ;
        f32x4 y[2];
#pragma unroll
        for (int bj = 0; bj < 2; ++bj) {
            const int cc = bj * FF + c;
            const f32x4 z = (f32x4){0.f, 0.f, 0.f, 0.f};
            const f32x4 ut = *(const f32x4*)(halo + ((size_t)blk * 4 + j) * NUP + cc);
            f32x4 u1, u2;
            if (j == 1) { u1 = *(const f32x4*)(halo + ((size_t)blk * 4 + 0) * NUP + cc); u2 = (tb == 1) ? z : *(const f32x4*)(halo + ((size_t)(blk - 1) * 4 + 3) * NUP + cc); }
            else { u1 = (tb == 0) ? z : *(const f32x4*)(halo + ((size_t)(blk - 1) * 4 + 3) * NUP + cc); u2 = (tb == 0) ? z : *(const f32x4*)(halo + ((size_t)(blk - 1) * 4 + 2) * NUP + cc); }
            y[bj] = *(const f32x4*)(cb + cc) + *(const f32x4*)(cw + cc) * u2 + *(const f32x4*)(cw + NUP + cc) * u1 + *(const f32x4*)(cw + 2 * NUP + cc) * ut;
        }
        v2u w; w.x = cvtpk(silu_mul(y[0].x, y[1].x), silu_mul(y[0].y, y[1].y)); w.y = cvtpk(silu_mul(y[0].z, y[1].z), silu_mul(y[0].w, y[1].w));
        *(v2u*)(act + (size_t)t * FF + c) = w;
    }
}

__device__ __forceinline__ int crow(int r, int hi) { return (r & 3) + 8 * (r >> 2) + 4 * hi; }
__device__ __forceinline__ void glds16(const void* gsrc, unsigned lds_dst) { unsigned keep;
    asm volatile("s_mov_b32 %0, m0\n\ts_mov_b32 m0, %2\n\ts_nop 0\n\tglobal_load_lds_dwordx4 %1, off\n\ts_mov_b32 m0, %0" : "=&s"(keep) : "v"(gsrc), "s"(lds_dst) : "memory"); }
__device__ __forceinline__ float max3f(float a, float b, float c) { return fmaxf(fmaxf(a, b), c); }

namespace band {
constexpr int SLOTB = 8192;
constexpr int LDS_K = 0, LDS_V = 2 * SLOTB, LDS_WS = 4 * SLOTB, LDS_TB = LDS_WS + NWAVES * 64 * 4, LDS_OST = LDS_TB + 640 * 4 + 512, LDS_END = LDS_OST + NWAVES * 4096;
static_assert(LDS_END <= RING_BYTES, "band LDS");
__device__ __forceinline__ void unit(Frame& F, int b, int h, int U, const bf16* Q, const bf16* K, const bf16* V, bf16* O, const float* rel) {
    const int tid = F.tid, lane = F.lane, r32 = lane & 31, hi = lane >> 5, wid = F.wave;
    LAS unsigned char* shm = F.lds + RING_OFF;
    const unsigned lds0 = (unsigned)(uintptr_t)shm;
    const long rowbase = (long)b * SEQ; const int q0 = U * 256, c0 = 4 * U, cq = c0 + (wid >> 1);
    const bf16* Qw = Q + (rowbase + q0 + wid * 32) * DM + h * 64;
    const bf16* Kh = K + rowbase * DM + h * 64; const bf16* Vh = V + rowbase * DM + h * 64;
    LAS float* wsf = (LAS float*)(shm + LDS_WS) + wid * 64;
    LAS float* tb = (LAS float*)(shm + LDS_TB);
    const bf16* ksrc = Kh + (long)lane * DM + wid * 8;
    const bf16* vsrc = Vh + (long)(16 * (wid & 3) + (lane >> 2)) * DM + (wid >> 2) * 32 + (lane & 3) * 8;
    const unsigned kdst = lds0 + LDS_K + wid * 1024, vdst = lds0 + LDS_V + wid * 1024;
    const int lo = (c0 - 8 > 0) ? c0 - 8 : 0, hiT = c0 + 3, NT = hiT - lo + 1, t0 = (c0 - 5 > 0) ? c0 - 5 : 0;
#define BAND_KT(i) ((t0 + (i) <= hiT) ? t0 + (i) : lo + (t0 + (i) - hiT - 1))
    for (int i = tid; i < 640; i += NWAVES * 64) { int d = i - 64; d = d < -256 ? -256 : (d > 256 ? 256 : d); tb[i] = rel[(d + 256) * 16 + h] * LOG2E; }
    { const int kt = BAND_KT(0); glds16(ksrc + (long)kt * 64 * DM, (unsigned)__builtin_amdgcn_readfirstlane(kdst)); glds16(vsrc + (long)kt * 64 * DM, (unsigned)__builtin_amdgcn_readfirstlane(vdst)); }
    bf16x8 qr[4];
#pragma unroll
    for (int d0 = 0; d0 < 4; ++d0) qr[d0] = *(const bf16x8*)(Qw + (long)r32 * DM + d0 * 16 + hi * 8);
    float m_run = -INFINITY, l_run = 0.f; f32x16 o[2]; o[0] = f32x16{}; o[1] = f32x16{};
    const int qpos = q0 + wid * 32 + r32;
    const LAS unsigned char* vbase = shm + LDS_V + ((lane >> 4) & 1) * 32 + (lane & 3) * 8 + (4 * hi + ((lane & 15) >> 2)) * 64;
    for (int i = 0; i < NT; ++i) {
        asm volatile("s_waitcnt vmcnt(0) lgkmcnt(0)\n\ts_barrier" ::: "memory");
        if (i + 1 < NT) { const int kt = BAND_KT(i + 1); const unsigned so = ((i + 1) & 1) * SLOTB;
            glds16(ksrc + (long)kt * 64 * DM, (unsigned)__builtin_amdgcn_readfirstlane(kdst + so)); glds16(vsrc + (long)kt * 64 * DM, (unsigned)__builtin_amdgcn_readfirstlane(vdst + so)); }
        const int kt = BAND_KT(i);
        if (kt < cq - 8 || kt > cq) continue;
        const int so = (i & 1) * SLOTB;
        f32x16 p0 = f32x16{}, p1 = f32x16{};
        { const LAS unsigned char* kb = shm + LDS_K + so + hi * 1024 + r32 * 16;
#pragma unroll
          for (int d0 = 0; d0 < 4; ++d0) { const bf16x8 b0 = *(const LAS bf16x8*)(kb + d0 * 2048), b1 = *(const LAS bf16x8*)(kb + d0 * 2048 + 512);
              p0 = __builtin_amdgcn_mfma_f32_32x32x16_bf16(b0, qr[d0], p0, 0, 0, 0); p1 = __builtin_amdgcn_mfma_f32_32x32x16_bf16(b1, qr[d0], p1, 0, 0, 0); } }
        { const int ib = qpos - 64 * kt + 64 - 4 * hi;
#pragma unroll
          for (int r = 0; r < 16; ++r) { const int ix = ib - ((r & 3) + 8 * (r >> 2)); p0[r] += tb[ix]; p1[r] += tb[ix - 32]; } }
        float rm = p0[0];
#pragma unroll
        for (int r = 0; r < 16; ++r) rm = max3f(rm, p0[r], p1[r]);
        { auto rr = __builtin_amdgcn_permlane32_swap(__float_as_uint(rm), __float_as_uint(rm), false, false); rm = fmaxf(__uint_as_float(rr[0]), __uint_as_float(rr[1])); }
        const float mnew = fmaxf(m_run, rm), f = __builtin_amdgcn_exp2f(m_run - mnew); m_run = mnew;
        float sacc = 0.f;
#pragma unroll
        for (int r = 0; r < 16; ++r) { p0[r] = __builtin_amdgcn_exp2f(p0[r] - mnew); p1[r] = __builtin_amdgcn_exp2f(p1[r] - mnew); sacc += p0[r] + p1[r]; }
        l_run = l_run * f + sacc;
        if (hi == 0) wsf[r32] = f;
        LDS_WAIT();
#pragma unroll
        for (int r = 0; r < 16; ++r) { const float fr_ = wsf[crow(r, hi)]; o[0][r] *= fr_; o[1][r] *= fr_; }
        v4u pw[4];
        pw[0] = (v4u){cvtpk(p0[0], p0[1]), cvtpk(p0[2], p0[3]), cvtpk(p0[4], p0[5]), cvtpk(p0[6], p0[7])};
        pw[1] = (v4u){cvtpk(p0[8], p0[9]), cvtpk(p0[10], p0[11]), cvtpk(p0[12], p0[13]), cvtpk(p0[14], p0[15])};
        pw[2] = (v4u){cvtpk(p1[0], p1[1]), cvtpk(p1[2], p1[3]), cvtpk(p1[4], p1[5]), cvtpk(p1[6], p1[7])};
        pw[3] = (v4u){cvtpk(p1[8], p1[9]), cvtpk(p1[10], p1[11]), cvtpk(p1[12], p1[13]), cvtpk(p1[14], p1[15])};
        const LAS unsigned char* vb = vbase + so;
#pragma unroll
        for (int d0 = 0; d0 < 2; ++d0)
#pragma unroll
            for (int ks = 0; ks < 4; ++ks) {
                const s16x4 vlo = __builtin_bit_cast(s16x4, __builtin_amdgcn_ds_read_tr16_b64_v4i16((LAS s16x4*)(vb + d0 * 4096 + ks * 1024)));
                const s16x4 vhi = __builtin_bit_cast(s16x4, __builtin_amdgcn_ds_read_tr16_b64_v4i16((LAS s16x4*)(vb + d0 * 4096 + ks * 1024 + 512)));
                const bf16x8 vf = (bf16x8){vlo[0], vlo[1], vlo[2], vlo[3], vhi[0], vhi[1], vhi[2], vhi[3]};
                o[d0] = __builtin_amdgcn_mfma_f32_32x32x16_bf16(__builtin_bit_cast(bf16x8, pw[ks]), vf, o[d0], 0, 0, 0);
            }
    }
#undef BAND_KT
    { auto rr = __builtin_amdgcn_permlane32_swap(__float_as_uint(l_run), __float_as_uint(l_run), false, false); l_run = __uint_as_float(rr[0]) + __uint_as_float(rr[1]); }
    if (hi == 0) wsf[32 + r32] = l_run;
    LDS_WAIT();
    float rli[16];
#pragma unroll
    for (int r = 0; r < 16; ++r) rli[r] = __builtin_amdgcn_rcpf(wsf[32 + crow(r, hi)]);
    bf16* Ow = O + (rowbase + q0 + wid * 32) * DM + h * 64;
    { LAS bf16* stg = (LAS bf16*)(shm + LDS_OST) + wid * 2048;
#pragma unroll
      for (int r = 0; r < 16; ++r) { const int orow = crow(r, hi);
#pragma unroll
          for (int d0 = 0; d0 < 2; ++d0) stg[orow * 64 + d0 * 32 + r32] = (bf16)f2bf(o[d0][r] * rli[r]); }
      LDS_WAIT();
#pragma unroll
      for (int i = 0; i < 4; ++i) { const int row = i * 8 + (lane >> 3), ch = lane & 7; const v4u v = *(const LAS v4u*)(stg + row * 64 + ch * 8); *(v4u*)(Ow + (long)row * DM + ch * 8) = v; } }
    asm volatile("s_waitcnt lgkmcnt(0)\n\ts_barrier" ::: "memory");
}
__device__ __forceinline__ void phase(Frame& F, const bf16* Q, const bf16* K, const bf16* V, bf16* O, const float* rel) {
    const int NU = BATCH * 16 * 32, per = (NU + F.G - 1) / F.G;
    for (int i = 0; i < per; ++i) { const int uid = F.vcu * per + i; if (uid >= NU) break; unit(F, uid >> 9, (uid >> 5) & 15, uid & 31, Q, K, V, O, rel); }
}
}

namespace dsa {
__device__ __forceinline__ unsigned okey(float s) { const unsigned u = __float_as_uint(s + 0.0f); return (u & 0x80000000u) ? ~u : (u | 0x80000000u); }
struct Ctx { const bf16* QA; const bf16* KA; const bf16* VA; const bf16* QI; const bf16* KI; const float* WI; bf16* M; const LAS float* t5l; unsigned short* SEL; };

__device__ __forceinline__ void scan_hist(const LAS unsigned* hq, int lane, unsigned need, unsigned& bin, unsigned& above) {
    const LAS v4u* hp = (const LAS v4u*)hq + lane * 4;
    unsigned wds[16];
#pragma unroll
    for (int j = 0; j < 4; ++j) { const v4u t = hp[j]; wds[4 * j] = t.x; wds[4 * j + 1] = t.y; wds[4 * j + 2] = t.z; wds[4 * j + 3] = t.w; }
    unsigned tl = 0;
#pragma unroll
    for (int j = 0; j < 16; ++j) tl += (wds[j] & 0xffffu) + (wds[j] >> 16);
    unsigned suf = tl;
#pragma unroll
    for (int o = 1; o < 64; o <<= 1) { const unsigned v = __shfl_down(suf, o); if (lane + o < 64) suf += v; }
    const unsigned S = suf - tl;
    const bool cross = (S < need) && (need <= S + tl);
    unsigned c = S, bsel = 0, ab = 0; bool found = false;
#pragma unroll
    for (int k = 31; k >= 0; --k) { const unsigned cnt = (wds[k >> 1] >> (16 * (k & 1))) & 0xffffu; if (!found && c + cnt >= need) { bsel = 32 * lane + k; ab = c; found = true; } c += cnt; }
    const unsigned long long bal = __ballot(cross);
    const int src = bal ? __builtin_ctzll(bal) : 0;
    bin = __shfl(bsel, src); above = __shfl(ab, src);
}

__device__ __forceinline__ void attend(const Ctx& C, const LAS unsigned short* sq, int nvalid, long rowbase, long token, int tpos, int lane, int g0) {
    asm volatile("" : "+v"(lane));
    const int l15 = lane & 15, l4 = lane >> 4;
    int sidx[16];
#pragma unroll
    for (int ti = 0; ti < 16; ++ti) sidx[ti] = sq[ti * 16 + l15];
    unsigned bpk[4] = {0u, 0u, 0u, 0u};
#pragma unroll
    for (int ti = 0; ti < 16; ++ti) { const int rel = sidx[ti] - tpos, n = rel < 0 ? -rel : rel;
        const int bk = (rel > 0 ? 16 : 0) + (n < 8 ? n : 8 + (n >= 12) + (n >= 16) + (n >= 23) + (n >= 32) + (n >= 46) + (n >= 64) + (n >= 91));
        bpk[ti >> 2] |= (unsigned)bk << (8 * (ti & 3)); }
#pragma unroll 1
    for (int g = g0; g < g0 + 2; ++g) {
        const bf16* qp = C.QA + token * DM + (4 * g + (lane & 3)) * 64 + 8 * l4;
        const bf16x8 qf0 = *(const bf16x8*)qp, qf1 = *(const bf16x8*)(qp + 32);
        const bf16* kbase = C.KA + rowbase * 256 + g * 64 + 8 * l4;
        f32x4 S[16];
#pragma unroll
        for (int hh = 0; hh < 4; ++hh) {
            bf16x8 kf0[4], kf1[4];
#pragma unroll
            for (int j = 0; j < 4; ++j) { const bf16* kp = kbase + (long)sidx[hh * 4 + j] * 256; kf0[j] = *(const bf16x8*)kp; kf1[j] = *(const bf16x8*)(kp + 32); }
#pragma unroll
            for (int j = 0; j < 4; ++j) { const int ti = hh * 4 + j;
                f32x4 a = *(const LAS f32x4*)(C.t5l + ((bpk[hh] >> (8 * j)) & 255u) * 16 + 4 * g);
                asm volatile("v_mfma_f32_16x16x32_bf16 %0, %1, %2, %0" : "+v"(a) : "v"(qf0), "v"(kf0[j]));
                asm volatile("v_mfma_f32_16x16x32_bf16 %0, %1, %2, %0" : "+v"(a) : "v"(qf1), "v"(kf1[j]));
                S[ti] = a; }
            asm volatile("s_nop 15\n\ts_nop 7" : "+v"(S[hh * 4]), "+v"(S[hh * 4 + 1]), "+v"(S[hh * 4 + 2]), "+v"(S[hh * 4 + 3]));
        }
#pragma unroll
        for (int ti = 0; ti < 16; ++ti) if (ti * 16 >= nvalid) S[ti] = (f32x4){-INFINITY, -INFINITY, -INFINITY, -INFINITY};
        f32x4 mx = S[0];
#pragma unroll
        for (int ti = 1; ti < 16; ++ti) { mx.x = fmaxf(mx.x, S[ti].x); mx.y = fmaxf(mx.y, S[ti].y); mx.z = fmaxf(mx.z, S[ti].z); mx.w = fmaxf(mx.w, S[ti].w); }
#pragma unroll
        for (int o = 1; o < 16; o <<= 1) { mx.x = fmaxf(mx.x, __shfl_xor(mx.x, o)); mx.y = fmaxf(mx.y, __shfl_xor(mx.y, o)); mx.z = fmaxf(mx.z, __shfl_xor(mx.z, o)); mx.w = fmaxf(mx.w, __shfl_xor(mx.w, o)); }
        f32x4 ls = (f32x4){0.f, 0.f, 0.f, 0.f};
        unsigned P01[16], P23[16];
#pragma unroll
        for (int ti = 0; ti < 16; ++ti) { const float e0 = __builtin_amdgcn_exp2f(S[ti].x - mx.x), e1 = __builtin_amdgcn_exp2f(S[ti].y - mx.y), e2 = __builtin_amdgcn_exp2f(S[ti].z - mx.z), e3 = __builtin_amdgcn_exp2f(S[ti].w - mx.w);
            ls += (f32x4){e0, e1, e2, e3}; P01[ti] = cvtpk(e0, e1); P23[ti] = cvtpk(e2, e3); }
#pragma unroll
        for (int o = 1; o < 16; o <<= 1) { ls.x += __shfl_xor(ls.x, o); ls.y += __shfl_xor(ls.y, o); ls.z += __shfl_xor(ls.z, o); ls.w += __shfl_xor(ls.w, o); }
        float o_[4][16];
#pragma unroll
        for (int h = 0; h < 4; ++h)
#pragma unroll
            for (int d = 0; d < 16; ++d) o_[h][d] = 0.f;
        const bf16* vbase = C.VA + rowbase * 256 + g * 64 + 16 * l4;
#pragma unroll
        for (int hh = 0; hh < 4; ++hh) {
            v4u va[4], vb[4];
#pragma unroll
            for (int j = 0; j < 4; ++j) { const v4u* vp = (const v4u*)(vbase + (long)sidx[hh * 4 + j] * 256); va[j] = vp[0]; vb[j] = vp[1]; }
#pragma unroll
            for (int j = 0; j < 4; ++j) { const int ti = hh * 4 + j; const v4u v0 = va[j], v1 = vb[j];
                float vf[16];
                vf[0] = bf_lo(v0.x); vf[1] = bf_hi(v0.x); vf[2] = bf_lo(v0.y); vf[3] = bf_hi(v0.y); vf[4] = bf_lo(v0.z); vf[5] = bf_hi(v0.z); vf[6] = bf_lo(v0.w); vf[7] = bf_hi(v0.w);
                vf[8] = bf_lo(v1.x); vf[9] = bf_hi(v1.x); vf[10] = bf_lo(v1.y); vf[11] = bf_hi(v1.y); vf[12] = bf_lo(v1.z); vf[13] = bf_hi(v1.z); vf[14] = bf_lo(v1.w); vf[15] = bf_hi(v1.w);
                const float p0 = bf_lo(P01[ti]), p1 = bf_hi(P01[ti]), p2 = bf_lo(P23[ti]), p3 = bf_hi(P23[ti]);
#pragma unroll
                for (int d = 0; d < 16; ++d) { o_[0][d] += p0 * vf[d]; o_[1][d] += p1 * vf[d]; o_[2][d] += p2 * vf[d]; o_[3][d] += p3 * vf[d]; } }
        }
        float res[4];
#pragma unroll
        for (int h = 0; h < 4; ++h) {
            float a8[8], a4[4], a2[2];
            const bool b3 = (l15 & 8) != 0, b2 = (l15 & 4) != 0, b1 = (l15 & 2) != 0, b0 = (l15 & 1) != 0;
#pragma unroll
            for (int d = 0; d < 8; ++d) { const float keep = b3 ? o_[h][d + 8] : o_[h][d], send = b3 ? o_[h][d] : o_[h][d + 8]; a8[d] = keep + __shfl_xor(send, 8); }
#pragma unroll
            for (int d = 0; d < 4; ++d) { const float keep = b2 ? a8[d + 4] : a8[d], send = b2 ? a8[d] : a8[d + 4]; a4[d] = keep + __shfl_xor(send, 4); }
#pragma unroll
            for (int d = 0; d < 2; ++d) { const float keep = b1 ? a4[d + 2] : a4[d], send = b1 ? a4[d] : a4[d + 2]; a2[d] = keep + __shfl_xor(send, 2); }
            { const float keep = b0 ? a2[1] : a2[0], send = b0 ? a2[0] : a2[1]; res[h] = keep + __shfl_xor(send, 1); }
        }
        bf16* mp = C.M + token * DM + (4 * g) * 64 + lane;
        mp[0] = (bf16)f2bf(res[0] * __builtin_amdgcn_rcpf(ls.x)); mp[64] = (bf16)f2bf(res[1] * __builtin_amdgcn_rcpf(ls.y)); mp[128] = (bf16)f2bf(res[2] * __builtin_amdgcn_rcpf(ls.z)); mp[192] = (bf16)f2bf(res[3] * __builtin_amdgcn_rcpf(ls.w));
    }
}

constexpr int CAND_CAP = 64;
__device__ __forceinline__ float relu_i(float x) { const int i = __builtin_bit_cast(int, x); return __builtin_bit_cast(float, i > 0 ? i : 0); }
struct SelState { unsigned pre[4], need[4], cnt[4], tcnt[4]; };
__device__ __forceinline__ void tile_mfma(f32x16 (&acc)[2], const LAS unsigned char* kf, const int (&koff)[4], const bf16x8 (&qa)[4]) {
#pragma unroll
    for (int h2 = 0; h2 < 2; ++h2) { acc[h2] = f32x16{};
#pragma unroll
        for (int ks = 0; ks < 4; ++ks) { const bf16x8 kb = *(const LAS bf16x8*)(kf + koff[ks] + h2 * 4096); acc[h2] = __builtin_amdgcn_mfma_f32_32x32x16_bf16(qa[ks], kb, acc[h2], 0, 0, 0); } }
}
template <class ActionT>
__device__ __forceinline__ void tile_valu(const f32x16 (&acc)[2], const f32x2_t (&wp)[2][4], int kbase, ActionT&& act) {
#pragma unroll
    for (int h2 = 0; h2 < 2; ++h2) {
        f32x2_t sa = {0.f, 0.f}, sb = {0.f, 0.f};
#pragma unroll
        for (int jp = 0; jp < 4; ++jp) {
            const f32x2_t ra = {relu_i(acc[h2][2 * jp]), relu_i(acc[h2][2 * jp + 1])};
            const f32x2_t rb = {relu_i(acc[h2][8 + 2 * jp]), relu_i(acc[h2][8 + 2 * jp + 1])};
            sa = __builtin_elementwise_fma(ra, wp[0][jp], sa); sb = __builtin_elementwise_fma(rb, wp[1][jp], sb); }
        act(kbase + h2 * 32, (sa.x + sa.y) + 0.0f, (sb.x + sb.y) + 0.0f);
    }
}
template <class ActionT>
__device__ __forceinline__ void tile_pass(Frame& F, const bf16* ksrc, unsigned kdst, const LAS unsigned char* kfr, const int (&koff)[4], int NT, const bf16x8 (&qa)[4], const f32x2_t (&wp)[2][4], ActionT&& act) {
    asm volatile("s_waitcnt lgkmcnt(0)\n\ts_barrier" ::: "memory");
    glds16(ksrc, (unsigned)__builtin_amdgcn_readfirstlane(kdst));
    if (NT > 1) glds16(ksrc + 4096, (unsigned)__builtin_amdgcn_readfirstlane(kdst + 8192));
    if (NT > 2) glds16(ksrc + 8192, (unsigned)__builtin_amdgcn_readfirstlane(kdst + 16384));
    if (NT > 2) asm volatile("s_waitcnt vmcnt(2)\n\ts_barrier" ::: "memory");
    else if (NT > 1) asm volatile("s_waitcnt vmcnt(1)\n\ts_barrier" ::: "memory");
    else asm volatile("s_waitcnt vmcnt(0)\n\ts_barrier" ::: "memory");
    f32x16 accC[2];
    tile_mfma(accC, kfr, koff, qa);
    int sl = 0;
    for (int kt = 0; kt + 1 < NT; ++kt) {
        if (kt + 2 < NT) asm volatile("s_waitcnt vmcnt(1) lgkmcnt(0)\n\ts_barrier" ::: "memory");
        else asm volatile("s_waitcnt vmcnt(0) lgkmcnt(0)\n\ts_barrier" ::: "memory");
        if (kt + 3 < NT) glds16(ksrc + (long)(kt + 3) * 4096, (unsigned)__builtin_amdgcn_readfirstlane(kdst + sl * 8192));
        sl = (sl == 2) ? 0 : sl + 1;
        f32x16 accN[2];
        tile_mfma(accN, kfr + sl * 8192, koff, qa);
        tile_valu(accC, wp, kt * 64, act);
        accC[0] = accN[0]; accC[1] = accN[1];
    }
    tile_valu(accC, wp, (NT - 1) * 64, act);
    LDS_WAIT();
}
__device__ __forceinline__ void scan_hist_cnt(const LAS unsigned* hq, int lane, unsigned need, unsigned& bin, unsigned& above, unsigned& bcnt) {
    const LAS v4u* hp = (const LAS v4u*)hq + lane * 4;
    unsigned wds[16];
#pragma unroll
    for (int j = 0; j < 4; ++j) { const v4u t = hp[j]; wds[4 * j] = t.x; wds[4 * j + 1] = t.y; wds[4 * j + 2] = t.z; wds[4 * j + 3] = t.w; }
    unsigned tl = 0;
#pragma unroll
    for (int j = 0; j < 16; ++j) tl += wds[j];
    unsigned suf = tl;
#pragma unroll
    for (int o = 1; o < 64; o <<= 1) { const unsigned v = __shfl_down(suf, o); if (lane + o < 64) suf += v; }
    const unsigned S = suf - tl;
    const bool cross = (S < need) && (need <= S + tl);
    unsigned c = S, bsel = 0, ab = 0, bc = 0; bool found = false;
#pragma unroll
    for (int k = 15; k >= 0; --k) { const unsigned cnt = wds[k]; if (!found && c + cnt >= need) { bsel = 16 * lane + k; ab = c; bc = cnt; found = true; } c += cnt; }
    const unsigned long long bal = __ballot(cross);
    const int src = bal ? __builtin_ctzll(bal) : 0;
    bin = __builtin_amdgcn_readfirstlane(__shfl(bsel, src)); above = __builtin_amdgcn_readfirstlane(__shfl(ab, src)); bcnt = __builtin_amdgcn_readfirstlane(__shfl(bc, src));
}
__device__ __forceinline__ void step(Frame& F, const Ctx& C, int b, int c, int half) {
    int lane_ = F.lane; asm volatile("" : "+v"(lane_));
    const int lane = lane_, r = lane & 31, hi = lane >> 5, wave = F.wave;
    LAS unsigned* hist = (LAS unsigned*)(F.lds + RING_OFF + wave * 16384);
    LAS unsigned short* sel = (LAS unsigned short*)hist;
    LAS unsigned* cand = hist + 512;
    LAS unsigned* fbflag = (LAS unsigned*)(F.lds + AUX_OFF + 2048);
    const long rowbase = (long)b * SEQ;
    const int tq0 = 64 * c + 32 * half + 4 * wave;
    const int N = 64 * (c + 1), NT = c + 1;
    int nvalid = 256;
    if (N <= 256) {
        nvalid = N;
        for (int j = lane; j < 4 * 256; j += 64) sel[j] = (unsigned short)(((j & 255) < N) ? (j & 255) : 0);
    } else {
        const int aq = 2 * ((r >> 2) & 1) + (r >> 4), ah = 4 * ((r >> 3) & 1) + (r & 3);
        const bf16* qip = C.QI + (rowbase + tq0 + aq) * 512 + ah * 64 + 8 * hi;
        bf16x8 qa[4];
#pragma unroll
        for (int ks = 0; ks < 4; ++ks) qa[ks] = *(const bf16x8*)(qip + 16 * ks);
        f32x2_t wp[2][4];
#pragma unroll
        for (int t = 0; t < 2; ++t) { const float* wq = C.WI + (rowbase + tq0 + 2 * hi + t) * 8; const f32x4 w0 = *(const f32x4*)wq, w1 = *(const f32x4*)(wq + 4);
            wp[t][0] = (f32x2_t){w0.x, w0.y}; wp[t][1] = (f32x2_t){w0.z, w0.w}; wp[t][2] = (f32x2_t){w1.x, w1.y}; wp[t][3] = (f32x2_t){w1.z, w1.w}; }
        float Bq;
        { float ssq = 0.f;
#pragma unroll
          for (int ks = 0; ks < 4; ++ks)
#pragma unroll
              for (int e = 0; e < 8; ++e) { const float v = bf_lo((unsigned)(unsigned short)qa[ks][e]); ssq += v * v; }
          ssq += __shfl_xor(ssq, 32);
          float term = fabsf(C.WI[(rowbase + tq0 + aq) * 8 + ah]) * sqrtf(ssq);
          term += __shfl_xor(term, 1); term += __shfl_xor(term, 2); term += __shfl_xor(term, 8);
          Bq = term * 8.25f + 1e-20f; }
        const float B0 = __shfl(Bq, (hi << 2)), B1 = __shfl(Bq, (hi << 2) | 16);
        const float sc0 = 2048.0f / B0, sc1 = 2048.0f / B1;
        asm volatile("" :: "v"(qa[0]), "v"(qa[1]), "v"(qa[2]), "v"(qa[3]));
        asm volatile("" :: "v"(wp[0][0]), "v"(wp[0][1]), "v"(wp[0][2]), "v"(wp[0][3]), "v"(wp[1][0]), "v"(wp[1][1]), "v"(wp[1][2]), "v"(wp[1][3]), "v"(sc0), "v"(sc1));
        const bf16* ksrc = C.KI + rowbase * 64 + (long)(wave * 8 + (lane >> 3)) * 64 + ((lane & 7) ^ (lane >> 3)) * 8;
        const unsigned kdst = (unsigned)(uintptr_t)(F.lds + KS_OFF) + wave * 1024;
        const LAS unsigned char* kfr = F.lds + KS_OFF + r * 128;
        int koff[4];
#pragma unroll
        for (int ks = 0; ks < 4; ++ks) koff[ks] = ((2 * ks + hi) ^ (r & 7)) * 16;
        const unsigned below = (1u << r) - 1u;
        LAS v4u* hz = (LAS v4u*)hist;
        if (wave == 0 && lane == 0) *fbflag = 0u;
#pragma unroll
        for (int j = 0; j < 16; ++j) hz[j * 64 + lane] = (v4u){0u, 0u, 0u, 0u};
        tile_pass(F, ksrc, kdst, kfr, koff, NT, qa, wp, [&](int kbase, float s0, float s1) {
            const int b0 = (int)__builtin_amdgcn_fmed3f(__builtin_fmaf(s0, sc0, 512.0f), 0.0f, 1023.0f), b1 = (int)__builtin_amdgcn_fmed3f(__builtin_fmaf(s1, sc1, 512.0f), 0.0f, 1023.0f);
            __hip_atomic_fetch_add(hist + (2 * hi) * 1024 + b0, 1u, __ATOMIC_RELAXED, __HIP_MEMORY_SCOPE_WORKGROUP);
            __hip_atomic_fetch_add(hist + (2 * hi + 1) * 1024 + b1, 1u, __ATOMIC_RELAXED, __HIP_MEMORY_SCOPE_WORKGROUP);
        });
        SelState st;
        unsigned tbin[4], bcn[4]; bool ovf = false;
#pragma unroll
        for (int ql = 0; ql < 4; ++ql) { unsigned above; scan_hist_cnt(hist + ql * 1024, lane, 256u, tbin[ql], above, bcn[ql]); st.cnt[ql] = 0u; st.tcnt[ql] = 0u; st.need[ql] = 256u - above; st.pre[ql] = above; ovf |= bcn[ql] > (unsigned)CAND_CAP; }
        LDS_WAIT();
        if (ovf && lane == 0) *fbflag = 1u;
        asm volatile("s_waitcnt lgkmcnt(0)\n\ts_barrier" ::: "memory");
        const bool fb = __builtin_amdgcn_readfirstlane((int)*fbflag) != 0;
        if (!fb) {
            const int tb0 = (int)(hi ? tbin[2] : tbin[0]), tb1 = (int)(hi ? tbin[3] : tbin[1]);
            tile_pass(F, ksrc, kdst, kfr, koff, NT, qa, wp, [&](int kbase, float s0, float s1) {
#pragma unroll
                for (int t = 0; t < 2; ++t) {
                    const float s = t ? s1 : s0; const int bin = (int)__builtin_amdgcn_fmed3f(__builtin_fmaf(s, (t ? sc1 : sc0), 512.0f), 0.0f, 1023.0f), tb = t ? tb1 : tb0;
                    const bool gt = bin > tb, eq = bin == tb;
                    const unsigned long long mg = __ballot(gt), me = __ballot(eq);
                    const unsigned mgh = hi ? (unsigned)(mg >> 32) : (unsigned)mg, meh = hi ? (unsigned)(me >> 32) : (unsigned)me;
                    const unsigned pos = (hi ? st.cnt[2 + t] : st.cnt[t]) + __builtin_popcount(mgh & below);
                    sel[(gt && pos < 256u) ? (2 * hi + t) * 256 + pos : 2200 + lane] = (unsigned short)(kbase + r);
                    const unsigned cpos = (hi ? st.tcnt[2 + t] : st.tcnt[t]) + __builtin_popcount(meh & below);
                    { LAS unsigned* cp = hist + ((eq && cpos < (unsigned)CAND_CAP) ? 512 + ((2 * hi + t) * CAND_CAP + cpos) * 2 : 1200 + 2 * lane); cp[0] = okey(s); cp[1] = (unsigned)(kbase + r); }
                    st.cnt[t] += __builtin_popcount((unsigned)mg); st.cnt[2 + t] += __builtin_popcount((unsigned)(mg >> 32));
                    st.tcnt[t] += __builtin_popcount((unsigned)me); st.tcnt[2 + t] += __builtin_popcount((unsigned)(me >> 32));
                }
            });
#pragma unroll
            for (int ql = 0; ql < 4; ++ql) {
                const unsigned nc = bcn[ql], G = st.pre[ql], rq = st.need[ql];
                const LAS unsigned* cq = cand + ql * CAND_CAP * 2;
                const unsigned ki = ((unsigned)lane < nc) ? cq[2 * lane] : 0u, xi = ((unsigned)lane < nc) ? cq[2 * lane + 1] : 0u;
                unsigned rank = 0;
                for (unsigned j = 0; j < nc; ++j) { const unsigned kj = cq[2 * j]; rank += (kj > ki || (kj == ki && j < (unsigned)lane)) ? 1u : 0u; }
                const bool take = ((unsigned)lane < nc) && rank < rq;
                const unsigned long long mt = __ballot(take);
                const unsigned pos = G + __builtin_popcountll(mt & ((1ull << lane) - 1ull));
                if (take && pos < 256u) sel[ql * 256 + pos] = (unsigned short)xi;
            }
        } else {
#pragma unroll
            for (int ql = 0; ql < 4; ++ql) { st.pre[ql] = 0u; st.need[ql] = 256u; st.cnt[ql] = 0u; st.tcnt[ql] = 0u; }
#pragma unroll 1
            for (int lev = 0; lev < 4; ++lev) {
#pragma unroll
                for (int j = 0; j < 16; ++j) hz[j * 64 + lane] = (v4u){0u, 0u, 0u, 0u};
                const unsigned pre0 = hi ? st.pre[2] : st.pre[0], pre1 = hi ? st.pre[3] : st.pre[1];
                const int sh = (lev == 0) ? 22 : (lev == 1) ? 12 : (lev == 2) ? 2 : 0, wd = (lev == 3) ? 2 : 10;
                tile_pass(F, ksrc, kdst, kfr, koff, NT, qa, wp, [&](int kbase, float s0, float s1) {
                    const unsigned k0 = okey(s0), k1 = okey(s1);
                    const unsigned b0 = (k0 >> sh) & ((1u << wd) - 1u), b1 = (k1 >> sh) & ((1u << wd) - 1u);
                    const bool in0 = (lev == 0) || ((k0 >> (sh + wd)) == pre0), in1 = (lev == 0) || ((k1 >> (sh + wd)) == pre1);
                    if (in0) __hip_atomic_fetch_add(hist + (2 * hi) * 1024 + b0, 1u, __ATOMIC_RELAXED, __HIP_MEMORY_SCOPE_WORKGROUP);
                    if (in1) __hip_atomic_fetch_add(hist + (2 * hi + 1) * 1024 + b1, 1u, __ATOMIC_RELAXED, __HIP_MEMORY_SCOPE_WORKGROUP);
                });
#pragma unroll
                for (int ql = 0; ql < 4; ++ql) { unsigned bin, above, bc; scan_hist_cnt(hist + ql * 1024, lane, st.need[ql], bin, above, bc);
                    st.pre[ql] = (st.pre[ql] << wd) | bin; st.need[ql] -= above; }
                LDS_WAIT();
            }
            const unsigned T0 = hi ? st.pre[2] : st.pre[0], T1 = hi ? st.pre[3] : st.pre[1], rq0 = hi ? st.need[2] : st.need[0], rq1 = hi ? st.need[3] : st.need[1];
            tile_pass(F, ksrc, kdst, kfr, koff, NT, qa, wp, [&](int kbase, float s0, float s1) {
#pragma unroll
                for (int t = 0; t < 2; ++t) {
                    const unsigned kk = okey(t ? s1 : s0), T = t ? T1 : T0, rq = t ? rq1 : rq0;
                    const bool gt = kk > T, eq = kk == T;
                    const unsigned long long me = __ballot(eq);
                    const unsigned meh = hi ? (unsigned)(me >> 32) : (unsigned)me;
                    const unsigned trank = (hi ? st.tcnt[2 + t] : st.tcnt[t]) + __builtin_popcount(meh & below);
                    const bool take = gt || (eq && trank < rq);
                    const unsigned long long mt = __ballot(take);
                    const unsigned mth = hi ? (unsigned)(mt >> 32) : (unsigned)mt;
                    const unsigned pos = (hi ? st.cnt[2 + t] : st.cnt[t]) + __builtin_popcount(mth & below);
                    if (take && pos < 256u) sel[(2 * hi + t) * 256 + pos] = (unsigned short)(kbase + r);
                    st.cnt[t] += __builtin_popcount((unsigned)mt); st.cnt[2 + t] += __builtin_popcount((unsigned)(mt >> 32));
                    st.tcnt[t] += __builtin_popcount((unsigned)me); st.tcnt[2 + t] += __builtin_popcount((unsigned)(me >> 32));
                }
            });
        }
    }
    LDS_WAIT();
    { const LAS v4u* s4 = (const LAS v4u*)sel; v4u* g4 = (v4u*)(C.SEL + (rowbase + tq0) * 256);
#pragma unroll
      for (int j = 0; j < 2; ++j) g4[j * 64 + lane] = s4[j * 64 + lane]; }
    LDS_WAIT();
}
__device__ __forceinline__ void phase(Frame& F, const Ctx& C) {
    for (int v = F.vcu; v < 256; v += F.G) {
        const int b = v >> 6, c = v & 63;
#pragma unroll 1
        for (int it = 0; it < 4; ++it) step(F, C, b, (it < 2) ? c : 127 - c, it & 1);
    }
}
__device__ __forceinline__ void attn_phase(Frame& F, const Ctx& C) {
    int lane = F.lane; asm volatile("" : "+v"(lane));
    LAS unsigned short* sq = (LAS unsigned short*)(F.lds + RING_OFF + F.wave * 16384);
    const int nx = F.G / 32;
    for (int x = F.vcu / 32; x < 8; x += nx) {
        const int b = x >> 1, g0 = 2 * (x & 1); const long rowbase = (long)b * SEQ;
        const int w = (F.vcu & 31) * NWAVES + F.wave;
#pragma unroll 1
        for (int t = w; t < SEQ; t += 32 * NWAVES) {
            { const v4u* g4 = (const v4u*)(C.SEL + (rowbase + t) * 256); if (lane < 32) ((LAS v4u*)sq)[lane] = g4[lane]; }
            LDS_WAIT();
            const int N = 64 * ((t >> 6) + 1), nvalid = N < 256 ? N : 256;
            attend(C, sq, nvalid, rowbase, rowbase + t, t, lane, g0);
            LDS_WAIT();
        }
    }
}
}

namespace att8 {
typedef int v2i __attribute__((ext_vector_type(2)));
struct Ctx8 { const unsigned char* QA8; const unsigned char* KV8; const unsigned short* SEL; bf16* M; };
constexpr int T2_OFF = KS_OFF, T2_BYTES = 155 * 16 * 4, SELL_OFF = KS_OFF + 10240;
static_assert(T2_BYTES <= 10240 && SELL_OFF + NWAVES * 1024 <= AUX_OFF, "attention LDS map");
__device__ __forceinline__ void mfma8(f32x4& acc, long a, long b) { asm volatile("v_mfma_f32_16x16x32_fp8_fp8 %0, %1, %2, %0" : "+v"(acc) : "v"(a), "v"(b)); }
__device__ __forceinline__ unsigned pk4_fp8(float a, float b, float c, float d) { int r = __builtin_amdgcn_cvt_pk_fp8_f32(a, b, 0, false); r = __builtin_amdgcn_cvt_pk_fp8_f32(c, d, r, true); return (unsigned)r; }

__device__ __forceinline__ void attend8(const Ctx8& C, const LAS unsigned short* sq, LAS unsigned char* vreg, const LAS float* T2, int nvalid, long rowbase, long token, int tpos, int lane, int g0) {
    asm volatile("" : "+v"(lane));
    const int l15 = lane & 15, l4 = lane >> 4, h = l15 & 3;
    const unsigned vbase = (unsigned)(uintptr_t)vreg;
    unsigned cib[16];
#pragma unroll
    for (int ti = 0; ti < 16; ++ti) { const v2u i4 = *(const LAS v2u*)(sq + ti * 16 + 4 * l4);
        const int r0 = (int)(i4.x & 0xffffu) - tpos, r1 = (int)(i4.x >> 16) - tpos, r2 = (int)(i4.y & 0xffffu) - tpos, r3 = (int)(i4.y >> 16) - tpos;
        const int c0 = min(max(r0, -91), 63) + 91, c1 = min(max(r1, -91), 63) + 91, c2 = min(max(r2, -91), 63) + 91, c3 = min(max(r3, -91), 63) + 91;
        cib[ti] = (unsigned)c0 | ((unsigned)c1 << 8) | ((unsigned)c2 << 16) | ((unsigned)c3 << 24); }
    const int trk = 4 * l4 + ((l15 >> 1) & 3), trt = (l15 >> 3) & 1, xs = (l4 & 1) | (trt << 1);
    const int troff = trt * 1024 + trk * 64 + 8 * (l15 & 1);
#pragma unroll 1
    for (int g = g0; g < g0 + 2; ++g) {
        const unsigned char* kvb = C.KV8 + rowbase * 512 + g * 128;
        { const int kq = lane >> 2, p = lane & 3;
#pragma unroll
          for (int ti = 0; ti < 16; ++ti) { const int key = sq[ti * 16 + kq]; const int x = ((kq >> 2) & 1) | ((ti & 1) << 1);
              glds16(kvb + (long)key * 512 + 64 + 16 * (p ^ x), (unsigned)__builtin_amdgcn_readfirstlane(vbase + ti * 1024)); } }
        const v4u qv = *(const v4u*)(C.QA8 + token * 1024 + (4 * g + h) * 64 + 16 * l4);
        const long q0 = (long)(((unsigned long long)qv.y << 32) | qv.x), q1 = (long)(((unsigned long long)qv.w << 32) | qv.z);
        f32x4 S[16];
#pragma unroll
        for (int hh = 0; hh < 2; ++hh) {
            v4u kr[8];
#pragma unroll
            for (int j = 0; j < 8; ++j) kr[j] = *(const v4u*)(kvb + (long)sq[(hh * 8 + j) * 16 + l15] * 512 + 16 * l4);
#pragma unroll
            for (int j = 0; j < 8; ++j) { const int ti = hh * 8 + j; const unsigned cb = cib[ti];
                f32x4 a; a.x = T2[(cb & 255u) * 16 + 4 * g + h]; a.y = T2[((cb >> 8) & 255u) * 16 + 4 * g + h]; a.z = T2[((cb >> 16) & 255u) * 16 + 4 * g + h]; a.w = T2[(cb >> 24) * 16 + 4 * g + h];
                mfma8(a, (long)(((unsigned long long)kr[j].y << 32) | kr[j].x), q0);
                mfma8(a, (long)(((unsigned long long)kr[j].w << 32) | kr[j].z), q1);
                S[ti] = a; }
            asm volatile("s_nop 15\n\ts_nop 7" : "+v"(S[hh * 8]), "+v"(S[hh * 8 + 1]), "+v"(S[hh * 8 + 2]), "+v"(S[hh * 8 + 3]), "+v"(S[hh * 8 + 4]), "+v"(S[hh * 8 + 5]), "+v"(S[hh * 8 + 6]), "+v"(S[hh * 8 + 7]));
        }
#pragma unroll
        for (int ti = 0; ti < 16; ++ti) if (ti * 16 >= nvalid) S[ti] = (f32x4){-INFINITY, -INFINITY, -INFINITY, -INFINITY};
        float mx = S[0].x;
#pragma unroll
        for (int ti = 0; ti < 16; ++ti) mx = fmaxf(fmaxf(mx, fmaxf(S[ti].x, S[ti].y)), fmaxf(S[ti].z, S[ti].w));
        mx = fmaxf(mx, __shfl_xor(mx, 16)); mx = fmaxf(mx, __shfl_xor(mx, 32));
        const float mc = -mx * C2; float ls = 0.f;
        long P8[8];
#pragma unroll
        for (int j = 0; j < 8; ++j) { float e[8];
#pragma unroll
            for (int q = 0; q < 4; ++q) { e[q] = __builtin_amdgcn_exp2f(__builtin_fmaf(S[2 * j][q], C2, mc)); e[4 + q] = __builtin_amdgcn_exp2f(__builtin_fmaf(S[2 * j + 1][q], C2, mc)); }
            ls += ((e[0] + e[1]) + (e[2] + e[3])) + ((e[4] + e[5]) + (e[6] + e[7]));
            const unsigned lo = pk4_fp8(e[0] * 256.f, e[1] * 256.f, e[2] * 256.f, e[3] * 256.f), hi = pk4_fp8(e[4] * 256.f, e[5] * 256.f, e[6] * 256.f, e[7] * 256.f);
            P8[j] = (long)(((unsigned long long)hi << 32) | lo); }
        ls += __shfl_xor(ls, 16); ls += __shfl_xor(ls, 32);
        asm volatile("s_waitcnt vmcnt(0)" ::: "memory");
        f32x4 D[4];
#pragma unroll
        for (int db = 0; db < 4; ++db) D[db] = (f32x4){0.f, 0.f, 0.f, 0.f};
#pragma unroll
        for (int j = 0; j < 8; ++j)
#pragma unroll
            for (int db = 0; db < 4; ++db) {
                const v2i vv = __builtin_amdgcn_ds_read_tr8_b64_v2i32((LAS v2i*)(vreg + j * 2048 + troff + 16 * (db ^ xs)));
                mfma8(D[db], P8[j], __builtin_bit_cast(long, vv)); }
        asm volatile("s_nop 15\n\ts_nop 7" : "+v"(D[0]), "+v"(D[1]), "+v"(D[2]), "+v"(D[3]));
        const float lh = __shfl(ls, l4);
        const float inv = __builtin_amdgcn_rcpf(lh * 256.f);
        bf16* mp = C.M + token * DM + (4 * g + l4) * 64 + l15;
#pragma unroll
        for (int db = 0; db < 4; ++db) { const float v = (l4 == 0) ? D[db].x : (l4 == 1) ? D[db].y : (l4 == 2) ? D[db].z : D[db].w; mp[16 * db] = (bf16)f2bf(v * inv); }
        asm volatile("" ::: "memory");
    }
}
__device__ __forceinline__ void phase(Frame& F, const Ctx8& C, const float* t5) {
    int lane = F.lane; asm volatile("" : "+v"(lane));
    LAS float* T2 = (LAS float*)(F.lds + T2_OFF);
    for (int e = F.tid; e < 155 * 16; e += NWAVES * 64) { const int rel = (e >> 4) - 91, n = rel < 0 ? -rel : rel;
        const int bk = (rel > 0 ? 16 : 0) + (n < 8 ? n : 8 + (n >= 12) + (n >= 16) + (n >= 23) + (n >= 32) + (n >= 46) + (n >= 64) + (n >= 91));
        T2[e] = t5[bk * 16 + (e & 15)] * 8.0f; }
    __syncthreads();
    LAS unsigned short* sq = (LAS unsigned short*)(F.lds + SELL_OFF + F.wave * 1024);
    LAS unsigned char* vreg = F.lds + RING_OFF + F.wave * 16384;
    for (int x = F.vcu / 32; x < 8; x += GRID / 32) {
        const int b = x >> 1, g0 = 2 * (x & 1); const long rowbase = (long)b * SEQ;
        const int w = (F.vcu & 31) * NWAVES + F.wave;
        v4u nxt = (v4u){0u, 0u, 0u, 0u};
        if (lane < 32) nxt = ((const v4u*)(C.SEL + (rowbase + w) * 256))[lane];
        int buf = 0;
#pragma unroll 1
        for (int t = w; t < SEQ; t += 32 * NWAVES) {
            if (lane < 32) ((LAS v4u*)(sq + buf * 256))[lane] = nxt;
            if (t + 32 * NWAVES < SEQ && lane < 32) nxt = ((const v4u*)(C.SEL + (rowbase + t + 32 * NWAVES) * 256))[lane];
            LDS_WAIT();
            const int N = 64 * ((t >> 6) + 1), nvalid = N < 256 ? N : 256;
            attend8(C, sq + buf * 256, vreg, T2, nvalid, rowbase, rowbase + t, t, lane, g0);
            buf ^= 1;
        }
    }
}
}

#ifndef REP_P0
#define REP_P0 1
#endif
#ifndef REP_IN
#define REP_IN 1
#endif
#ifndef REP_DSA
#define REP_DSA 1
#endif
#ifndef REP_BAND
#define REP_BAND 1
#endif
#ifndef REP_UP
#define REP_UP 1
#endif
#ifndef REP_FIX
#define REP_FIX 1
#endif
constexpr int N_PHASES = 1 + 6 * DEPTH;
#ifndef MK_N_LAUNCHES
#define MK_N_LAUNCHES 1
#endif
__global__ void __launch_bounds__(NWAVES * 64, 2) mega_fwd(Args args) {
    extern __shared__ __attribute__((aligned(16))) unsigned char lds[];
    Frame F;
    F.lds = (LAS unsigned char*)lds;
    F.MISC = (volatile LAS unsigned*)(F.lds + MISC_OFF);
    F.tid = threadIdx.x; F.lane = F.tid & 63; F.wave = __builtin_amdgcn_readfirstlane(F.tid >> 6);
    F.G = GRID; { const int bx = blockIdx.x; F.vcu = (bx & 7) * (GRID / 8) + (bx >> 3); }
    unsigned char* ws = args.ws;
    F.ctl = (gu32*)(ws + WS_CTL);
    for (int u = F.tid; u < (LDS_BYTES - LDSCTL_OFF) / 4; u += NWAVES * 64) ((LAS unsigned*)(F.lds + LDSCTL_OFF))[u] = 0u;
    __syncthreads();
    XcdBarrier bar; bar.bar = (unsigned*)(F.ctl + CW_BAR); bar.x = 0; bar.st = nullptr;
    if (MK_N_LAUNCHES == 1) bar = xcd_barrier_post((unsigned*)(F.ctl + CW_BAR), F.MISC + 8);
    const int lo = args.ph_lo, hi = args.ph_hi;
#define IN(k) (lo <= (k) && (k) < hi)
#define OPQ_FRAME(Fl) Frame Fl = F; { int l_; asm volatile("v_mbcnt_lo_u32_b32 %0, -1, 0\n\tv_mbcnt_hi_u32_b32 %0, -1, %0" : "=v"(l_)); int w_ = F.wave; asm volatile("" : "+s"(w_)); Fl.wave = w_; Fl.lane = l_; Fl.tid = w_ * 64 + l_; }
#define SEAM(k) do { if (IN(k) && IN((k) + 1)) xcd_barrier(bar); } while (0)

    bf16* hb = (bf16*)(ws + WS_HB); bf16* mb = (bf16*)(ws + WS_M); float* ss = (float*)(ws + WS_SS); float* halo = (float*)(ws + WS_HALO);
    unsigned char* proj = ws + WS_PROJ; bf16* act = (bf16*)(ws + WS_PROJ);

#ifndef SKIP_P0
    if (IN(0)) { for (int rep = 0; rep < REP_P0; ++rep) { OPQ_FRAME(F0); p0_prologue(F0, args); } }
#endif
    SEAM(0);

#pragma unroll 1
    for (int L = 0; L < DEPTH; ++L) {
        const int pb = 1 + 6 * L, li = L >> 1; const bool isB = (L & 1) != 0;
        if (IN(pb)) {
#ifndef SKIP_IN
            for (int rep = 0; rep < REP_IN; ++rep)
            if (!isB) {
                pg8::Gemm g{hb, (const bf16*)(ws + WS_W_INA) + (size_t)li * NA_PAD * DM, MTOK, NA_PAD, DM}; pg8::StaticOrder S; S.init(MTOK, NA_PAD, F.G, (int)blockIdx.x);
                EpiIn E{ss, proj, args.q_norm_g + L * 64, args.k_norm_g + L * 64, 0};
                pg8::gemm_phase<EpiIn, pg8::StaticOrder, true, true>(F.lds + RING_OFF, g, S, E, F.wave);
            } else {
                pg8::Gemm g{hb, (const bf16*)(ws + WS_W_INB) + (size_t)li * NB * DM, MTOK, NB, DM}; pg8::StaticOrder S; S.init(MTOK, NB, F.G, (int)blockIdx.x);
                EpiIn E{ss, proj, args.q_norm_g + L * 64, args.k_norm_g + L * 64, 1};
                pg8::gemm_phase<EpiIn, pg8::StaticOrder, true, true>(F.lds + RING_OFF, g, S, E, F.wave);
            }
#endif
        }
        SEAM(pb);
#if defined(DBG_NODSA) || defined(DBG_NOBAND)
#ifdef DBG_NODSA
        const bool zero_m = !isB;
#else
        const bool zero_m = isB;
#endif
        if (IN(pb + 1) && zero_m) { for (size_t i = (size_t)blockIdx.x * 512 + threadIdx.x; i < (size_t)MTOK * DM / 8; i += (size_t)gridDim.x * 512) ((v4u*)mb)[i] = (v4u){0u, 0u, 0u, 0u}; }
        if (IN(pb + 1) && !zero_m) {
#else
        if (IN(pb + 1)) {
#endif
#ifndef SKIP_DSA
            if (!isB) {
                LAS float* t5l = (LAS float*)(F.lds + AUX_OFF);
                { OPQ_FRAME(Ft); for (int i = Ft.tid; i < 512; i += NWAVES * 64) t5l[i] = args.t5_bias[i] * LOG2E; }
                __syncthreads();
                dsa::Ctx C{(const bf16*)(proj + PA_QA), (const bf16*)(proj + PA_KA), (const bf16*)(proj + PA_VA), (const bf16*)(proj + PA_QI), (const bf16*)(proj + PA_KI), (const float*)(proj + PA_WI), mb, t5l, (unsigned short*)(proj + PA_SEL)};
#ifdef DBG_DSACOPY
                { int t_ = threadIdx.x; asm volatile("" : "+v"(t_));
                for (unsigned i = blockIdx.x * 512u + (unsigned)t_; i < (unsigned)MTOK * DM; i += gridDim.x * 512u) { const unsigned t = i >> 10, c = i & 1023u;
                    float v = bf_lo(C.QA[i]); v += bf_lo(C.KA[t * 256 + (c & 255)]); v += bf_lo(C.VA[t * 256 + (c & 255)]); v += bf_lo(C.QI[t * 512 + (c & 511)]); v += bf_lo(C.KI[t * 64 + (c & 63)]); v += C.WI[t * 8 + (c & 7)];
                    mb[i] = (bf16)f2bf(v * 0.01f); asm volatile("" ::: "memory"); } }
#else
                for (int rep = 0; rep < REP_DSA; ++rep) { OPQ_FRAME(F1); dsa::phase(F1, C); }
                xcd_barrier(bar);
                { OPQ_FRAME(F1b); att8::Ctx8 C8{(const unsigned char*)(proj + PA_QA), (const unsigned char*)(proj + PA_KA), (const unsigned short*)(proj + PA_SEL), mb};
#ifndef REP_ATT8
#define REP_ATT8 1
#endif
                  for (int rep = 0; rep < REP_ATT8; ++rep) { att8::phase(F1b, C8, args.t5_bias); __syncthreads(); } }
#endif
            }
#endif
#ifndef SKIP_BAND
            if (isB) {
                for (int rep = 0; rep < REP_BAND; ++rep) { OPQ_FRAME(F2); band::phase(F2, (const bf16*)proj, (const bf16*)(proj + PB_STRIDE), (const bf16*)(proj + 2 * PB_STRIDE), mb, args.rel_bias_b + (size_t)li * 513 * 16); }
            }
#endif
        }
        SEAM(pb + 1);
        if (IN(pb + 2)) {
#ifndef SKIP_OUT
            pg8::Gemm g{mb, (const bf16*)(ws + WS_W_OUT) + (size_t)L * DM * DM, MTOK, DM, DM}; pg8::StaticOrder S; S.init(MTOK, DM, F.G, (int)blockIdx.x);
#ifdef REP_OUT
            { EpiRes E0{L == 0 ? args.x : nullptr, nullptr, hb, (bf16*)proj, halo}; pg8::gemm_phase<EpiRes, pg8::StaticOrder, true, true>(F.lds + RING_OFF, g, S, E0, F.wave); }
#endif
            EpiRes E{L == 0 ? args.x : nullptr, nullptr, hb, hb, ss};
            pg8::gemm_phase<EpiRes, pg8::StaticOrder, true, true>(F.lds + RING_OFF, g, S, E, F.wave);
#endif
        }
        SEAM(pb + 2);
        if (IN(pb + 3)) {
#ifndef SKIP_UP
            for (int rep = 0; rep < REP_UP; ++rep) {
            pg8::Gemm g{hb, (const bf16*)(ws + WS_W_UP) + (size_t)L * NUP * DM, MTOK, NUP, DM}; pg8::StaticOrder S; S.init(MTOK, NUP, F.G, (int)blockIdx.x);
            EpiUp E{ss, args.conv_w + (size_t)L * 3 * NUP, args.conv_b + (size_t)L * NUP, act, halo};
            pg8::gemm_phase<EpiUp, pg8::StaticOrder, true, true>(F.lds + RING_OFF, g, S, E, F.wave); }
#endif
        }
        SEAM(pb + 3);
#ifndef SKIP_FIX
        if (IN(pb + 4)) for (int rep = 0; rep < REP_FIX; ++rep) { OPQ_FRAME(F3); fixup_phase(F3, args.conv_w + (size_t)L * 3 * NUP, args.conv_b + (size_t)L * NUP, halo, act); }
#endif
        SEAM(pb + 4);
        if (IN(pb + 5)) {
#ifndef SKIP_DN
            pg8::Gemm g{act, (const bf16*)(ws + WS_W_DN) + (size_t)L * DM * FF, MTOK, DM, FF}; pg8::StaticOrder S; S.init(MTOK, DM, F.G, (int)blockIdx.x);
#ifdef REP_DN
            { EpiRes E0{nullptr, nullptr, hb, mb, halo}; pg8::gemm_phase<EpiRes, pg8::StaticOrder, true, true>(F.lds + RING_OFF, g, S, E0, F.wave); }
#endif
            EpiRes E{nullptr, L == DEPTH - 1 ? args.out : nullptr, hb, hb, ss};
            pg8::gemm_phase<EpiRes, pg8::StaticOrder, true, true>(F.lds + RING_OFF, g, S, E, F.wave);
#endif
        }
        SEAM(pb + 5);
    }
#undef IN
#undef SEAM
}

extern "C" void kernel_launch(void* const* d_in, const int* in_sizes, int n_in, void* d_out, int out_size, void* d_ws, size_t ws_size, hipStream_t stream) {
    static int grid = 0;
    if (grid == 0) {
        if (n_in != 14 || in_sizes[0] != MTOK * DM || out_size != MTOK * DM || ws_size < WS_END) { fprintf(stderr, "kernel_launch: unexpected shapes / workspace (n_in %d, ws %zu); nothing launched\n", n_in, ws_size); grid = -1; return; }
        int dev = 0, cus = 0, per_cu = 0;
        if (hipGetDevice(&dev) != hipSuccess || hipDeviceGetAttribute(&cus, hipDeviceAttributeMultiprocessorCount, dev) != hipSuccess) { grid = -1; return; }
        if (hipFuncSetAttribute((const void*)mega_fwd, hipFuncAttributeMaxDynamicSharedMemorySize, LDS_BYTES) != hipSuccess) { fprintf(stderr, "kernel_launch: hipFuncSetAttribute failed\n"); grid = -1; return; }
        if (hipOccupancyMaxActiveBlocksPerMultiprocessor(&per_cu, (const void*)mega_fwd, NWAVES * 64, LDS_BYTES) != hipSuccess || per_cu < 1) { fprintf(stderr, "kernel_launch: occupancy query reports %d blocks per CU\n", per_cu); }
        (void)hipGetLastError();
        if (cus != GRID) { fprintf(stderr, "kernel_launch: built for a %d-CU device, found %d; nothing launched\n", GRID, cus); grid = -1; return; }
        grid = GRID;
    }
    if (grid < 0) return;
    if (hipMemsetAsync((char*)d_ws + WS_CTL, 0, CTL_ZERO_BYTES, stream) != hipSuccess) return;
    Args a{};
    a.x = (const float*)d_in[0]; a.attn_norm_g = (const float*)d_in[1]; a.w_in_a = (const float*)d_in[2]; a.w_in_b = (const float*)d_in[3]; a.q_norm_g = (const float*)d_in[4];
    a.k_norm_g = (const float*)d_in[5]; a.t5_bias = (const float*)d_in[6]; a.rel_bias_b = (const float*)d_in[7]; a.w_out = (const float*)d_in[8]; a.ffn_norm_g = (const float*)d_in[9];
    a.w_up = (const float*)d_in[10]; a.conv_w = (const float*)d_in[11]; a.conv_b = (const float*)d_in[12]; a.w_down = (const float*)d_in[13];
    a.out = (float*)d_out; a.ws = (unsigned char*)d_ws; a.pad = 0;
#if MK_N_LAUNCHES == 1
    a.ph_lo = 0; a.ph_hi = N_PHASES; a.li = 0;
    hipLaunchKernelGGL(mega_fwd, dim3(grid), dim3(NWAVES * 64), LDS_BYTES, stream, a);
#else
    for (int p = 0; p < N_PHASES; ++p) { a.ph_lo = p; a.ph_hi = p + 1; a.li = p; hipLaunchKernelGGL(mega_fwd, dim3(grid), dim3(NWAVES * 64), LDS_BYTES, stream, a); }
#endif
}
```

```cpp
#include <hip/hip_runtime.h>
#include <cstdio>
#include <cstdint>
namespace pg8 {
#define PG8_LAS __attribute__((address_space(3)))
typedef unsigned short bf16_t;
typedef short bf16x8 __attribute__((ext_vector_type(8)));
typedef float f32x4 __attribute__((ext_vector_type(4)));
typedef unsigned u32x4 __attribute__((ext_vector_type(4)));
constexpr int BM = 256, BK = 64, HALF = 128, HTB = HALF * BK * 2  , STAGE_BYTES = 8 * HTB, NXCD = 8, WGM = 8;

__host__ __device__ __forceinline__ int lds_byte(int r, int c) { const int st = (r >> 4) * 2 + (c >> 5), rr = r & 15, cc = c & 31, ob = rr * 64 + cc * 2; return st * 1024 + (ob ^ (((ob >> 9) & 1) << 5)); }
__host__ __device__ __forceinline__ void stage_rc(int b, int& R, int& C) { const int st = b / 1024, sb = b % 1024, swz = sb ^ (((sb >> 9) & 1) << 5); R = (st >> 1) * 16 + swz / 64; C = (st & 1) * 32 + (swz % 64) / 2; }
__host__ __device__ __forceinline__ int perm32(int rho) { const int n = rho >> 4, i = rho & 15; return 8 * (i >> 2) + 4 * n + (i & 3); }

struct Unit { int pm, pn; };
struct Gemm { const bf16_t* A; const bf16_t* Bt; int M, N, K; };

struct StaticOrder {
    int nM, nN, nwg, G, c;
    __host__ __device__ void init(int M, int N, int G_, int c_) { nM = M / BM; nN = N / BM; nwg = nM * nN; G = G_; c = c_; }
    __host__ __device__ bool next(int i, Unit& u) const {
        const long L = (long)i * G + c; if (L >= nwg) return false;
        int wgid = (int)L; { const int q = nwg / NXCD, r = nwg % NXCD, xcd = wgid % NXCD, off = wgid / NXCD; wgid = (xcd < r ? xcd * (q + 1) : r * (q + 1) + (xcd - r) * q) + off; }
        const int nig = WGM * nN, gid = wgid / nig, fm = gid * WGM, gsz = (nM - fm) < WGM ? (nM - fm) : WGM;
        u.pm = fm + ((wgid % nig) % gsz); u.pn = (wgid % nig) / gsz; return true;
    }
    __device__ __forceinline__ void a_ready(const Unit&) const {}
    __device__ __forceinline__ void done(const Unit&) const {}
};
__device__ __forceinline__ unsigned cvt_pk_bf16(float lo, float hi) { unsigned r; asm volatile("v_cvt_pk_bf16_f32 %0, %1, %2" : "=v"(r) : "v"(lo), "v"(hi)); return r; }
template <class Epi, class Sched, bool ALIGN_EPI = false, bool SP2 = false>
__device__ __forceinline__ void gemm_phase(PG8_LAS unsigned char* lds, const Gemm g, const Sched& S, const Epi& E, const int wave_id) {
    int lane_; asm volatile("v_mbcnt_lo_u32_b32 %0, -1, 0\n\tv_mbcnt_hi_u32_b32 %0, -1, %0" : "=v"(lane_));
    int wid_ = wave_id; asm volatile("" : "+s"(wid_));
    const int wid = wid_, lane = lane_, tid = wid * 64 + lane, wr = wid >> 2, wc = wid & 3, fr = lane & 15, fq = lane >> 4;
    const int K = g.K, nt = K / BK;
    unsigned voffA[2], voffB[2];
#pragma unroll
    for (int i = 0; i < 2; ++i) { int R, C; stage_rc(tid * 16 + i * 8192, R, C); const int Rb = Epi::PERM ? ((R & ~31) + perm32(R & 31)) : R;
        voffA[i] = (unsigned)(R * K + C) * 2u; voffB[i] = (unsigned)(Rb * K + C) * 2u; }
    const size_t kstep = (size_t)(BK * 2);
    const size_t hstep = (size_t)HALF * K * 2;
    const size_t tstep = 2 * hstep;
    const unsigned ldsw = (unsigned)wid * 1024u;
    const int aoff = lds_byte(wr * 64 + fr, fq * 8), boff = lds_byte(wc * 32 + fr, fq * 8);
#define PG8_SA(b, h) (((b) * 2 + (h)) * HTB)
#define PG8_SB(b, h) ((4 + (b) * 2 + (h)) * HTB)
#define PG8_STAGE(bufoff, gbase, voff) do { _Pragma("unroll") for (int _i = 0; _i < 2; ++_i) \
        __builtin_amdgcn_global_load_lds((const unsigned*)((const char*)(gbase) + (voff)[_i]), (PG8_LAS unsigned*)(lds + (bufoff) + ldsw + _i * 8192), 16, 0, 0); } while (0)
#define PG8_LDA(dst, b, h) do { _Pragma("unroll") for (int m = 0; m < 4; ++m) _Pragma("unroll") for (int k = 0; k < 2; ++k) dst[m][k] = *(const PG8_LAS bf16x8*)(lds + PG8_SA(b, h) + aoff + m * 2048 + k * 1024); } while (0)
#define PG8_LDB(dst, b, h) do { _Pragma("unroll") for (int n = 0; n < 2; ++n) _Pragma("unroll") for (int k = 0; k < 2; ++k) dst[n][k] = *(const PG8_LAS bf16x8*)(lds + PG8_SB(b, h) + boff + n * 2048 + k * 1024); } while (0)
#define PG8_MMA(ai, bj, At, Bt) do { __builtin_amdgcn_s_setprio(1); _Pragma("unroll") for (int m = 0; m < 4; ++m) _Pragma("unroll") for (int n = 0; n < 2; ++n) _Pragma("unroll") for (int k = 0; k < 2; ++k) \
        acc[ai][bj][m][n] = __builtin_amdgcn_mfma_f32_16x16x32_bf16(Bt[n][k], At[m][k], acc[ai][bj][m][n], 0, 0, 0); __builtin_amdgcn_s_setprio(0); } while (0)
#define PG8_WAIT_V(n) asm volatile("s_waitcnt vmcnt(" #n ")" ::: "memory")
#define PG8_WAIT_L(n) asm volatile("s_waitcnt lgkmcnt(" #n ")" ::: "memory")
#define PG8_BAR __builtin_amdgcn_s_barrier()
#define PG8_SCHED __builtin_amdgcn_sched_barrier(0)
    Unit cur, nxt; int ui = 0;
    if (!S.next(0, cur)) return;
    f32x4 acc[2][2][4][2];
#pragma unroll
    for (int a = 0; a < 2; ++a)
#pragma unroll
        for (int b = 0; b < 2; ++b)
#pragma unroll
            for (int m = 0; m < 4; ++m)
#pragma unroll
                for (int n = 0; n < 2; ++n) acc[a][b][m][n] = (f32x4){0.f, 0.f, 0.f, 0.f};
    bf16x8 At[4][2], B0[2][2], B1[2][2];
    const char* cA = (const char*)g.A + (size_t)cur.pm * tstep; const char* cB = (const char*)g.Bt + (size_t)cur.pn * tstep;
    S.a_ready(cur);
    if constexpr (SP2) {
        PG8_STAGE(PG8_SB(0, 0), cB, voffB); PG8_STAGE(PG8_SB(0, 1), cB + hstep, voffB); PG8_STAGE(PG8_SA(0, 0), cA, voffA); PG8_STAGE(PG8_SA(0, 1), cA + hstep, voffA);
        if (wr == 1) PG8_BAR;
        PG8_WAIT_V(2); PG8_BAR;
        PG8_STAGE(PG8_SB(1, 0), cB + kstep, voffB); PG8_STAGE(PG8_SA(1, 0), cA + kstep, voffA); PG8_STAGE(PG8_SB(1, 1), cB + hstep + kstep, voffB);
        PG8_WAIT_V(6); PG8_BAR;
    } else {
        PG8_STAGE(PG8_SB(0, 0), cB, voffB); PG8_STAGE(PG8_SA(0, 0), cA, voffA); PG8_STAGE(PG8_SB(0, 1), cB + hstep, voffB); PG8_STAGE(PG8_SA(0, 1), cA + hstep, voffA);
        if (wr == 1) PG8_BAR;
        PG8_WAIT_V(4); PG8_BAR;
        PG8_STAGE(PG8_SB(1, 0), cB + kstep, voffB); PG8_STAGE(PG8_SA(1, 0), cA + kstep, voffA); PG8_STAGE(PG8_SB(1, 1), cB + hstep + kstep, voffB);
        PG8_WAIT_V(6); PG8_BAR;
    }
    for (;;) {
        const bool has_next = S.next(ui + 1, nxt);
        const char* nA = has_next ? (const char*)g.A + (size_t)nxt.pm * tstep : cA; const char* nB = has_next ? (const char*)g.Bt + (size_t)nxt.pn * tstep : cB;
        for (int t = 0; t < nt; t += 2) {
            const bool last = (t == nt - 2);
            const char* a1 = cA + (size_t)(t + 1) * kstep;
            const char* a2 = last ? nA : cA + (size_t)(t + 2) * kstep; const char* b2 = last ? nB : cB + (size_t)(t + 2) * kstep;
            const char* a3 = a2 + kstep; const char* b3 = b2 + kstep;
            if (last && has_next) S.a_ready(nxt);
            if constexpr (SP2) {
            PG8_LDB(B0, 0, 0); PG8_LDB(B1, 0, 1); PG8_SCHED; PG8_LDA(At, 0, 0); PG8_STAGE(PG8_SA(1, 1), a1 + hstep, voffA);
            PG8_WAIT_V(8); PG8_WAIT_L(0); PG8_BAR; PG8_MMA(0, 0, At, B0); PG8_MMA(0, 1, At, B1); PG8_BAR; PG8_SCHED;
            PG8_LDA(At, 0, 1); PG8_STAGE(PG8_SB(0, 0), b2, voffB); PG8_STAGE(PG8_SB(0, 1), b2 + hstep, voffB); PG8_STAGE(PG8_SA(0, 0), a2, voffA);
            PG8_WAIT_V(8); PG8_WAIT_L(0); PG8_BAR; PG8_MMA(1, 0, At, B0); PG8_MMA(1, 1, At, B1); PG8_BAR; PG8_SCHED;
            PG8_LDB(B0, 1, 0); PG8_LDB(B1, 1, 1); PG8_SCHED; PG8_LDA(At, 1, 0); PG8_STAGE(PG8_SA(0, 1), a2 + hstep, voffA);
            PG8_WAIT_V(8); PG8_WAIT_L(0); PG8_BAR; PG8_MMA(0, 0, At, B0); PG8_MMA(0, 1, At, B1); PG8_BAR; PG8_SCHED;
            PG8_LDA(At, 1, 1); PG8_STAGE(PG8_SB(1, 0), b3, voffB); PG8_STAGE(PG8_SB(1, 1), b3 + hstep, voffB); PG8_STAGE(PG8_SA(1, 0), a3, voffA);
            PG8_WAIT_V(8); PG8_WAIT_L(0); PG8_BAR; PG8_MMA(1, 0, At, B0); PG8_MMA(1, 1, At, B1); PG8_BAR; PG8_SCHED;
            } else {
            PG8_LDB(B0, 0, 0); PG8_SCHED; PG8_LDA(At, 0, 0); PG8_STAGE(PG8_SA(1, 1), a1 + hstep, voffA);
            PG8_WAIT_L(8); PG8_BAR; PG8_WAIT_L(0); PG8_MMA(0, 0, At, B0); PG8_BAR; PG8_SCHED;
            PG8_LDB(B1, 0, 1); PG8_STAGE(PG8_SB(0, 0), b2, voffB);
            PG8_BAR; PG8_WAIT_L(0); PG8_MMA(0, 1, At, B1); PG8_BAR;
            PG8_LDA(At, 0, 1); PG8_STAGE(PG8_SA(0, 0), a2, voffA);
            PG8_BAR; PG8_WAIT_L(0); PG8_MMA(1, 0, At, B0); PG8_BAR; PG8_SCHED;
            PG8_STAGE(PG8_SB(0, 1), b2 + hstep, voffB);
            PG8_WAIT_V(6); PG8_BAR; PG8_MMA(1, 1, At, B1); PG8_BAR;
            PG8_LDB(B0, 1, 0); PG8_SCHED; PG8_LDA(At, 1, 0); PG8_STAGE(PG8_SA(0, 1), a2 + hstep, voffA);
            PG8_WAIT_L(8); PG8_BAR; PG8_WAIT_L(0); PG8_MMA(0, 0, At, B0); PG8_BAR; PG8_SCHED;
            PG8_LDB(B1, 1, 1); PG8_STAGE(PG8_SB(1, 0), b3, voffB);
            PG8_BAR; PG8_WAIT_L(0); PG8_MMA(0, 1, At, B1); PG8_BAR;
            PG8_LDA(At, 1, 1); PG8_STAGE(PG8_SA(1, 0), a3, voffA);
            PG8_BAR; PG8_WAIT_L(0); PG8_MMA(1, 0, At, B0); PG8_BAR; PG8_SCHED;
            PG8_STAGE(PG8_SB(1, 1), b3 + hstep, voffB);
            PG8_WAIT_V(6); PG8_BAR; PG8_MMA(1, 1, At, B1); PG8_BAR;
            }
        }
        if constexpr (ALIGN_EPI) { if (wr == 0) PG8_BAR; }
        if constexpr (!Epi::AFTER_DRAIN) { E(acc, cur, wr, wc, fr, fq); S.done(cur); }
        if (!has_next) break;
#pragma unroll
        for (int a = 0; a < 2; ++a)
#pragma unroll
            for (int b = 0; b < 2; ++b)
#pragma unroll
                for (int m = 0; m < 4; ++m)
#pragma unroll
                    for (int n = 0; n < 2; ++n) acc[a][b][m][n] = (f32x4){0.f, 0.f, 0.f, 0.f};
        cur = nxt; cA = nA; cB = nB; ++ui;
        if constexpr (ALIGN_EPI) { if (wr == 1) PG8_BAR; }
    }
    PG8_WAIT_V(0);
    if constexpr (!ALIGN_EPI) { if (wr == 0) PG8_BAR; }
    PG8_BAR;
    if constexpr (Epi::AFTER_DRAIN) { E.fused(acc, cur, wr, wc, fr, fq, lds, wid, lane); S.done(cur); }
#undef PG8_SA
#undef PG8_SB
#undef PG8_STAGE
#undef PG8_LDA
#undef PG8_LDB
#undef PG8_MMA
#undef PG8_WAIT_V
#undef PG8_WAIT_L
#undef PG8_BAR
#undef PG8_SCHED
}
}

constexpr int NWAVES = 8, GRID = 256;
constexpr int BATCH = 4, SEQ = 8192, DM = 1024, MTOK = BATCH * SEQ, DEPTH = 4;
constexpr int NA_SRC = 2120, NA_PAD = 2304, NB = 3072, FF = 2816, NUP = 2 * FF;
constexpr float EPS = 1e-6f;
constexpr float LOG2E = 1.4426950408889634f;
constexpr float C2 = 0.125f * LOG2E;
constexpr int NBLK64 = MTOK / 64;

constexpr size_t MiB = 1u << 20;
constexpr size_t WS_CTL = 0, CTL_ZERO_BYTES = 1 * MiB;
constexpr size_t WS_W_INA = 2 * MiB;
constexpr size_t WS_W_INB = 11 * MiB;
constexpr size_t WS_W_OUT = 23 * MiB;
constexpr size_t WS_W_UP = 31 * MiB;
constexpr size_t WS_W_DN = 75 * MiB;
constexpr size_t WS_HB = 98 * MiB;
constexpr size_t WS_M = 162 * MiB;
constexpr size_t WS_SS = 226 * MiB;
constexpr size_t WS_HALO = 228 * MiB;
constexpr size_t WS_PROJ = 272 * MiB;
constexpr size_t WS_END = 464 * MiB;
constexpr size_t PA_QA = 0, PA_KA = 64 * MiB, PA_VA = 80 * MiB, PA_QI = 96 * MiB, PA_KI = 128 * MiB, PA_WI = 132 * MiB, PA_SEL = 136 * MiB;
constexpr size_t PB_STRIDE = 64 * MiB;
constexpr int CW_BAR = 4096;

constexpr int RING_OFF = 0, RING_BYTES = 131072;
constexpr int KS_OFF = RING_BYTES;
constexpr int AUX_OFF = RING_BYTES + 24576;
constexpr int LDSCTL_OFF = AUX_OFF + 4096, MISC_OFF = LDSCTL_OFF + 320;
constexpr int LDS_BYTES = 163840;
static_assert(MISC_OFF + 128 <= LDS_BYTES, "LDS map");

#define GAS __attribute__((address_space(1)))
#define LAS __attribute__((address_space(3)))
typedef unsigned short bf16;
typedef unsigned v4u __attribute__((ext_vector_type(4)));
typedef unsigned v2u __attribute__((ext_vector_type(2)));
typedef float f32x4 __attribute__((ext_vector_type(4)));
typedef float f32x16 __attribute__((ext_vector_type(16)));
typedef short bf16x8 __attribute__((ext_vector_type(8)));
typedef short s16x4 __attribute__((ext_vector_type(4)));
typedef float f32x2_t __attribute__((ext_vector_type(2)));
typedef GAS unsigned gu32;
#define RLX_AGENT __ATOMIC_RELAXED, __HIP_MEMORY_SCOPE_AGENT
#define LDS_WAIT() asm volatile("s_waitcnt lgkmcnt(0)" ::: "memory")
#define VM_WAIT() asm volatile("s_waitcnt vmcnt(0)" ::: "memory")
__device__ __forceinline__ unsigned f2bf(float f) { unsigned u = __builtin_bit_cast(unsigned, f); return (u + 0x7fffu + ((u >> 16) & 1u)) >> 16; }
__device__ __forceinline__ unsigned pk2(float lo, float hi) { return f2bf(lo) | (f2bf(hi) << 16); }
typedef float f32x2c_t __attribute__((ext_vector_type(2))); typedef __bf16 bf16x2c_t __attribute__((ext_vector_type(2)));
__device__ __forceinline__ unsigned cvtpk(float lo, float hi) { const f32x2c_t v = {lo, hi}; const bf16x2c_t b = __builtin_convertvector(v, bf16x2c_t); return __builtin_bit_cast(unsigned, b); }
__device__ __forceinline__ float bf_lo(unsigned u) { return __builtin_bit_cast(float, u << 16); }
__device__ __forceinline__ float bf_hi(unsigned u) { return __builtin_bit_cast(float, u & 0xffff0000u); }

#define XB_TMO      128
#define XB_XCNT(j)  (256  + 64 * (j))
#define XB_XSUB(j)  (1280 + 64 * (j))
#define XB_XGEN(j)  (2304 + 64 * (j))
#define XB_TOP      3328
#define XB_TOPGEN   3392
#define XCD_BAR_WORDS 3456
#define XB_SPIN_CAP (1u << 18)

__device__ __forceinline__ unsigned xb_ld(unsigned* p)              { return __hip_atomic_load(p, __ATOMIC_RELAXED, __HIP_MEMORY_SCOPE_AGENT); }
__device__ __forceinline__ unsigned xb_add(unsigned* p, unsigned v) { return __hip_atomic_fetch_add(p, v, __ATOMIC_RELAXED, __HIP_MEMORY_SCOPE_AGENT); }
__device__ __forceinline__ unsigned xb_xcc_id() { return (unsigned)__builtin_amdgcn_s_getreg((3 << 11) | 20) & 0xFu; }
#define XB_SPIN(cond, bar) do { unsigned _sp = 0; while (cond) { __builtin_amdgcn_s_sleep(1); \
    if ((++_sp & 255u) == 0u) { if (xb_ld(&(bar)[XB_TMO])) break; if (_sp > XB_SPIN_CAP) { atomicAdd(&(bar)[XB_TMO], 1u); break; } } } } while (0)

struct XcdBarrier {
    unsigned* bar; unsigned x;
    volatile LAS unsigned* st;
};

__device__ __forceinline__ XcdBarrier xcd_barrier_post(unsigned* bar, volatile LAS unsigned* st) {
    XcdBarrier b; b.bar = bar; b.x = xb_xcc_id(); b.st = st;
    if (threadIdx.x == 0) (void)xb_add(&bar[XB_XCNT(b.x)], 1u);
    return b;
}
__device__ __forceinline__ void xcd_barrier_complete(unsigned* bar, unsigned x, unsigned& nloc, unsigned& nx) {
    const unsigned G = gridDim.x * gridDim.y * gridDim.z;
    unsigned sum, cnt, mine, sp = 0u;
    for (;;) {
        sum = 0u; cnt = 0u; mine = 0u;
#pragma unroll
        for (unsigned j = 0; j < 16; ++j) { const unsigned c = xb_ld(&bar[XB_XCNT(j)]); sum += c; cnt += (c > 0u) ? 1u : 0u; mine = (j == x) ? c : mine; }
        if (sum == G) break;
        __builtin_amdgcn_s_sleep(1);
        if ((++sp & 255u) == 0u) { if (xb_ld(&bar[XB_TMO])) break; if (sp > XB_SPIN_CAP) { atomicAdd(&bar[XB_TMO], 1u); break; } }
    }
    nloc = mine > 0u ? mine : 1u; nx = cnt > 0u ? cnt : 1u;
}

__device__ __forceinline__ void xcd_barrier(const XcdBarrier& b) {
    asm volatile("s_waitcnt vmcnt(0)" ::: "memory");
    __syncthreads();
    if (threadIdx.x == 0) {
        unsigned* bar = b.bar;
        __builtin_amdgcn_s_waitcnt(0);
        unsigned nloc = b.st[0], nx = b.st[1];
        if (nloc == 0u) { xcd_barrier_complete(bar, b.x, nloc, nx); b.st[0] = nloc; b.st[1] = nx; }
        const unsigned old = xb_add(&bar[XB_XSUB(b.x)], 1u);
        const unsigned gen = old / nloc;
        if (old + 1u == (gen + 1u) * nloc) {
            __builtin_amdgcn_fence(__ATOMIC_RELEASE, "agent");
            asm volatile("s_waitcnt vmcnt(0)" ::: "memory");
            const unsigned og = xb_add(&bar[XB_TOP], 1u);
            const unsigned tg = og / nx;
            if (og + 1u == (tg + 1u) * nx) xb_add(&bar[XB_TOPGEN], 1u);
            else XB_SPIN(xb_ld(&bar[XB_TOPGEN]) == tg, bar);
            __builtin_amdgcn_fence(__ATOMIC_ACQUIRE, "agent");
            xb_add(&bar[XB_XGEN(b.x)], 1u);
            asm volatile("s_waitcnt vmcnt(0)" ::: "memory");
        } else {
            XB_SPIN(xb_ld(&bar[XB_XGEN(b.x)]) == gen, bar);
            __builtin_amdgcn_fence(__ATOMIC_ACQUIRE, "agent");
            asm volatile("s_waitcnt vmcnt(0)" ::: "memory");
        }
    }
    __syncthreads();
}


struct Args {
    const float* x; const float* attn_norm_g; const float* w_in_a; const float* w_in_b; const float* q_norm_g; const float* k_norm_g; const float* t5_bias;
    const float* rel_bias_b; const float* w_out; const float* ffn_norm_g; const float* w_up; const float* conv_w; const float* conv_b; const float* w_down;
    float* out; unsigned char* ws; int ph_lo, ph_hi, li, pad;
};

struct Frame {
    LAS unsigned char* lds;
    volatile LAS unsigned* MISC;
    gu32* ctl;
    int tid, lane, wave, vcu, G;
};

__host__ __device__ __forceinline__ int hmap(int p) { return 64 * ((p >> 5) & 3) + 16 * ((p >> 2) & 3) + 8 * (p >> 7) + 4 * ((p >> 4) & 1) + (p & 3); }
__host__ __device__ __forceinline__ int umap(int p) { return 32 * ((p >> 5) & 3) + 8 * ((p >> 2) & 3) + 4 * ((p >> 4) & 1) + (p & 3); }
__host__ __device__ __forceinline__ int src_col(int type, int n) {
    if (type == 0) return n;
    const int pn = n >> 8, p = n & 255;
    if (type == 2) return 256 * pn + hmap(p);
    if (type == 1) { const int c = hmap(p); return pn < 8 ? 256 * pn + c : (c < 72 ? 2048 + c : -1); }
    return (p >> 7) * FF + 128 * pn + umap(p);
}
__device__ __forceinline__ void convert_item(const float* W, int K, int Nsrc, int Ndst, int type, const float* gain, bf16* WT, LAS float* scr, int item, int lane) {
    const int nblk = Ndst / 32, kb = item / nblk, nb = item % nblk, k0 = 64 * kb, n0 = 32 * nb;
    const int sc = src_col(type, n0 + (lane & 31));
#pragma unroll 8
    for (int i = 0; i < 32; ++i) { const int kk = 2 * i + (lane >> 5); float v = 0.f; if (sc >= 0) v = W[(size_t)(k0 + kk) * Nsrc + sc]; if (gain) v *= gain[k0 + kk]; scr[kk * 33 + (lane & 31)] = v; }
    LDS_WAIT(); asm volatile("" ::: "memory");
    const int c = lane & 7;
#pragma unroll
    for (int j = 0; j < 4; ++j) { const int n = (lane >> 3) + 8 * j; const LAS float* s = scr + (8 * c) * 33 + n;
        v4u o; o.x = pk2(s[0 * 33], s[1 * 33]); o.y = pk2(s[2 * 33], s[3 * 33]); o.z = pk2(s[4 * 33], s[5 * 33]); o.w = pk2(s[6 * 33], s[7 * 33]);
        *(v4u*)(WT + (size_t)(n0 + n) * K + k0 + 8 * c) = o; }
    LDS_WAIT(); asm volatile("" ::: "memory");
}
__device__ __forceinline__ float wave_sum(float v) {
#pragma unroll
    for (int o = 1; o < 64; o <<= 1) v += __shfl_xor(v, o);
    return v;
}
__device__ __forceinline__ void p0_prologue(Frame& F, const Args& a) {
    LAS float* scr = (LAS float*)(F.lds + RING_OFF + F.wave * 16384);
    const int gw = F.vcu * NWAVES + F.wave, NGW = F.G * NWAVES;
    constexpr int I_INA = 16 * (NA_PAD / 32), I_INB = 16 * (NB / 32), I_OUT = 16 * 32, I_UP = 16 * (NUP / 32), I_DN = (FF / 64) * 32;
    constexpr int NITEMS = 2 * I_INA + 2 * I_INB + 4 * I_OUT + 4 * I_UP + 4 * I_DN;
    unsigned char* ws = a.ws;
    for (int it = gw; it < NITEMS; it += NGW) {
        int r = it;
        if (r < 2 * I_INA) { const int l = r / I_INA; convert_item(a.w_in_a + (size_t)l * DM * NA_SRC, DM, NA_SRC, NA_PAD, 1, a.attn_norm_g + (2 * l) * DM, (bf16*)(ws + WS_W_INA) + (size_t)l * NA_PAD * DM, scr, r % I_INA, F.lane); continue; } r -= 2 * I_INA;
        if (r < 2 * I_INB) { const int l = r / I_INB; convert_item(a.w_in_b + (size_t)l * DM * NB, DM, NB, NB, 2, a.attn_norm_g + (2 * l + 1) * DM, (bf16*)(ws + WS_W_INB) + (size_t)l * NB * DM, scr, r % I_INB, F.lane); continue; } r -= 2 * I_INB;
        if (r < 4 * I_OUT) { const int l = r / I_OUT; convert_item(a.w_out + (size_t)l * DM * DM, DM, DM, DM, 0, nullptr, (bf16*)(ws + WS_W_OUT) + (size_t)l * DM * DM, scr, r % I_OUT, F.lane); continue; } r -= 4 * I_OUT;
        if (r < 4 * I_UP) { const int l = r / I_UP; convert_item(a.w_up + (size_t)l * DM * NUP, DM, NUP, NUP, 3, a.ffn_norm_g + l * DM, (bf16*)(ws + WS_W_UP) + (size_t)l * NUP * DM, scr, r % I_UP, F.lane); continue; } r -= 4 * I_UP;
        { const int l = r / I_DN; convert_item(a.w_down + (size_t)l * FF * DM, FF, DM, DM, 0, nullptr, (bf16*)(ws + WS_W_DN) + (size_t)l * DM * FF, scr, r % I_DN, F.lane); }
    }
    bf16* hb = (bf16*)(ws + WS_HB); float* ss = (float*)(ws + WS_SS);
    for (int m = gw; m < MTOK; m += NGW) {
        const f32x4* xr = (const f32x4*)(a.x + (size_t)m * DM) + F.lane; f32x4 v[4]; float s = 0.f;
#pragma unroll
        for (int j = 0; j < 4; ++j) { v[j] = xr[64 * j]; s += (v[j].x * v[j].x + v[j].y * v[j].y) + (v[j].z * v[j].z + v[j].w * v[j].w); }
        s = wave_sum(s);
        v2u* o8 = (v2u*)(hb + (size_t)m * DM) + F.lane;
#pragma unroll
        for (int j = 0; j < 4; ++j) { v2u w; w.x = pk2(v[j].x, v[j].y); w.y = pk2(v[j].z, v[j].w); o8[64 * j] = w; }
        if (F.lane < 16) ss[(size_t)m * 16 + F.lane] = (F.lane == 0) ? s : 0.f;
    }
}

__device__ __forceinline__ float row_rstd(const float* ss, int row, int fq) {
    const f32x4 a = *(const f32x4*)(ss + (size_t)row * 16 + 4 * fq);
    float s = (a.x + a.y) + (a.z + a.w);
    s += __shfl_xor(s, 16); s += __shfl_xor(s, 32);
    return __builtin_amdgcn_rsqf(s * (1.0f / DM) + EPS);
}
__device__ __forceinline__ unsigned att_pk4(f32x4 v) { int r = __builtin_amdgcn_cvt_pk_fp8_f32(v.x, v.y, 0, false); r = __builtin_amdgcn_cvt_pk_fp8_f32(v.z, v.w, r, true); return (unsigned)r; }
struct EpiIn {
    static constexpr bool PERM = false, AFTER_DRAIN = false;
    const float* ss; unsigned char* proj; const float* qg; const float* kg; int isB;
    __device__ __forceinline__ void operator()(const pg8::f32x4 (&acc)[2][2][4][2], const pg8::Unit& u, int wr, int wc, int fr, int fq) const {
        asm volatile("" : "+v"(fr), "+v"(fq));
        const int pn = u.pn; int kind, pitch; bf16* dst;
        if (isB) { const int t = pn >> 2; kind = (t == 0) ? 1 : (t == 1 ? 2 : 0); dst = (bf16*)(proj + (size_t)t * PB_STRIDE) + 256 * (pn & 3); pitch = DM; }
        else if (pn < 4) { kind = 1; dst = (bf16*)(proj + PA_QA) + 256 * pn; pitch = DM; }
        else if (pn == 4) { kind = 2; dst = (bf16*)(proj + PA_KA); pitch = 256; }
        else if (pn == 5) { kind = 0; dst = (bf16*)(proj + PA_VA); pitch = 256; }
        else if (pn < 8) { kind = 0; dst = (bf16*)(proj + PA_QI) + 256 * (pn - 6); pitch = 512; }
        else { kind = 3; dst = (bf16*)(proj + PA_KI); pitch = 64; }
        if (kind == 3 && wc >= 2) return;
        const bool donorm = (kind == 1) || (kind == 2) || (kind == 3 && wc == 0);
        f32x4 g[2][2];
#pragma unroll
        for (int bj = 0; bj < 2; ++bj)
#pragma unroll
            for (int n = 0; n < 2; ++n) {
                if (kind == 1) g[bj][n] = *(const f32x4*)(qg + 16 * fq + 8 * bj + 4 * n) * (isB ? C2 : 1.0f);
                else if (kind == 2) g[bj][n] = *(const f32x4*)(kg + 16 * fq + 8 * bj + 4 * n);
                else g[bj][n] = (f32x4){1.f, 1.f, 1.f, 1.f};
            }
        float* wi = (float*)(proj + PA_WI);
#pragma unroll
        for (int ai = 0; ai < 2; ++ai)
#pragma unroll
            for (int m = 0; m < 4; ++m) {
                const int row = u.pm * 256 + ai * 128 + wr * 64 + m * 16 + fr;
                const float rs = row_rstd(ss, row, fq);
                f32x4 v[2][2]; float s = 0.f;
#pragma unroll
                for (int bj = 0; bj < 2; ++bj)
#pragma unroll
                    for (int n = 0; n < 2; ++n) { v[bj][n] = acc[ai][bj][m][n] * rs; const f32x4 q = v[bj][n] * v[bj][n]; s += (q.x + q.y) + (q.z + q.w); }
                if (donorm) {
                    s += __shfl_xor(s, 16); s += __shfl_xor(s, 32);
                    const float r = 1.0f / sqrtf(s * (1.0f / 64.0f) + EPS);
#pragma unroll
                    for (int bj = 0; bj < 2; ++bj)
#pragma unroll
                        for (int n = 0; n < 2; ++n) v[bj][n] = v[bj][n] * r * g[bj][n];
                }
                if (kind == 3 && wc == 1) {
                    if (fq == 0) { float* wp = wi + (size_t)row * 8; const float sc = 0.04419417382415922f;
                        *(f32x4*)(wp) = v[0][0] * sc; *(f32x4*)(wp + 4) = v[0][1] * sc; }
                } else if (!isB && pn < 6) {
                    unsigned char* p8 = (pn < 4) ? proj + PA_QA + (size_t)row * 1024 + 256 * pn + 64 * wc + 16 * fq : proj + PA_KA + (size_t)row * 512 + 128 * wc + 64 * (pn - 4) + 16 * fq;
                    v4u w; w.x = att_pk4(v[0][0]); w.y = att_pk4(v[0][1]); w.z = att_pk4(v[1][0]); w.w = att_pk4(v[1][1]);
                    *(v4u*)p8 = w;
                } else {
                    bf16* rp = dst + (size_t)row * pitch + 64 * wc + 16 * fq;
#pragma unroll
                    for (int bj = 0; bj < 2; ++bj) { v4u w; w.x = cvtpk(v[bj][0].x, v[bj][0].y); w.y = cvtpk(v[bj][0].z, v[bj][0].w); w.z = cvtpk(v[bj][1].x, v[bj][1].y); w.w = cvtpk(v[bj][1].z, v[bj][1].w);
                        *(v4u*)(rp + 8 * bj) = w; }
                }
            }
    }
};
struct EpiRes {
    static constexpr bool PERM = false, AFTER_DRAIN = false;
    const float* xin; float* fout; const bf16* hbi; bf16* hb; float* ss;
    __device__ __forceinline__ void operator()(const pg8::f32x4 (&acc)[2][2][4][2], const pg8::Unit& u, int wr, int wc, int fr, int fq) const {
        asm volatile("" : "+v"(fr), "+v"(fq));
        const int col0 = u.pn * 256 + wc * 32 + 4 * fq;
#pragma unroll
        for (int ai = 0; ai < 2; ++ai)
#pragma unroll
            for (int m = 0; m < 4; ++m) {
                const int row = u.pm * 256 + ai * 128 + wr * 64 + m * 16 + fr; const size_t off = (size_t)row * DM + col0; float s = 0.f;
#pragma unroll
                for (int bj = 0; bj < 2; ++bj)
#pragma unroll
                    for (int n = 0; n < 2; ++n) { const size_t o4 = off + bj * 128 + n * 16; f32x4 base;
                        if (xin) base = *(const f32x4*)(xin + o4); else { const v2u b = *(const v2u*)(hbi + o4); base = (f32x4){bf_lo(b.x), bf_hi(b.x), bf_lo(b.y), bf_hi(b.y)}; }
                        const f32x4 o = base + acc[ai][bj][m][n];
                        if (fout) *(f32x4*)(fout + o4) = o;
                        else { const f32x4 q = o * o; s += (q.x + q.y) + (q.z + q.w); v2u w; w.x = cvtpk(o.x, o.y); w.y = cvtpk(o.z, o.w); *(v2u*)(hb + o4) = w; } }
                if (!fout) { s += __shfl_xor(s, 16); s += __shfl_xor(s, 32); if (fq == 0) ss[(size_t)row * 16 + u.pn * 4 + wc] = s; }
            }
    }
};
#ifdef X_NOBPERM
__device__ __forceinline__ float lane_from(int byteaddr, float v) { return v + (float)byteaddr; }
#else
__device__ __forceinline__ float lane_from(int byteaddr, float v) { return __builtin_bit_cast(float, __builtin_amdgcn_ds_bpermute(byteaddr, __builtin_bit_cast(int, v))); }
#endif
#ifdef X_NOSILU
__device__ __forceinline__ float silu_mul(float a, float g) { return a * g; }
#else
__device__ __forceinline__ float silu_mul(float a, float g) { return a * g * __builtin_amdgcn_rcpf(1.0f + __builtin_amdgcn_exp2f(-g * LOG2E)); }
#endif
struct EpiUp {
    static constexpr bool PERM = false, AFTER_DRAIN = false;
    const float* ss; const float* cw; const float* cb; bf16* act; float* halo;
    __device__ __forceinline__ void operator()(const pg8::f32x4 (&acc)[2][2][4][2], const pg8::Unit& u, int wr, int wc, int fr, int fq) const {
        asm volatile("" : "+v"(fr), "+v"(fq));
        unsigned pk[2][2][4][2][2];
#pragma unroll
        for (int ai = 0; ai < 2; ++ai)
#pragma unroll
            for (int m = 0; m < 4; ++m) {
                const float rs = row_rstd(ss, u.pm * 256 + ai * 128 + wr * 64 + m * 16 + fr, fq);
#pragma unroll
                for (int bj = 0; bj < 2; ++bj)
#pragma unroll
                    for (int n = 0; n < 2; ++n) { const f32x4 v = acc[ai][bj][m][n] * rs; pk[ai][bj][m][n][0] = cvtpk(v.x, v.y); pk[ai][bj][m][n][1] = cvtpk(v.z, v.w); }
            }
        __builtin_amdgcn_sched_barrier(0);
        const int lane_ = fq * 16 + fr, src1 = 4 * ((lane_ & 48) | ((fr + 15) & 15)), src2 = 4 * ((lane_ & 48) | ((fr + 14) & 15));
        if (fr < 2 || fr >= 14) {
            const int mh = (fr < 2) ? 0 : 3, slot = (fr < 2) ? fr : fr - 12;
#pragma unroll
            for (int ai = 0; ai < 2; ++ai)
#pragma unroll
                for (int bj = 0; bj < 2; ++bj)
#pragma unroll
                    for (int n = 0; n < 2; ++n) { const unsigned w0 = (mh == 0) ? pk[ai][bj][0][n][0] : pk[ai][bj][3][n][0], w1 = (mh == 0) ? pk[ai][bj][0][n][1] : pk[ai][bj][3][n][1];
                        *(f32x4*)(halo + ((size_t)(u.pm * 4 + ai * 2 + wr) * 4 + slot) * NUP + bj * FF + u.pn * 128 + wc * 32 + 8 * fq + 4 * n) = (f32x4){bf_lo(w0), bf_hi(w0), bf_lo(w1), bf_hi(w1)}; }
        }
        __builtin_amdgcn_sched_barrier(0);
#pragma unroll
        for (int n = 0; n < 2; ++n)
#pragma unroll
            for (int pr = 0; pr < 2; ++pr) {
                const int ca0 = u.pn * 128 + wc * 32 + 8 * fq + 4 * n + 2 * pr;
                f32x2_t kk0[2], kk1[2], kk2[2], kkb[2];
#pragma unroll
                for (int bj = 0; bj < 2; ++bj) { const int c = bj * FF + ca0; kk0[bj] = *(const f32x2_t*)(cw + c); kk1[bj] = *(const f32x2_t*)(cw + NUP + c); kk2[bj] = *(const f32x2_t*)(cw + 2 * NUP + c); kkb[bj] = *(const f32x2_t*)(cb + c); }
#pragma unroll
                for (int ai = 0; ai < 2; ++ai) {
                    const int row0 = (u.pm * 4 + ai * 2 + wr) * 64;
                    float y[2][4][2];
#pragma unroll
                    for (int bj = 0; bj < 2; ++bj) {
                        unsigned r1[4], r2[4];
#pragma unroll
                        for (int m = 0; m < 4; ++m) { const unsigned w = pk[ai][bj][m][n][pr]; r1[m] = (unsigned)__builtin_amdgcn_ds_bpermute(src1, (int)w); r2[m] = (unsigned)__builtin_amdgcn_ds_bpermute(src2, (int)w); }
#pragma unroll
                        for (int m = 0; m < 4; ++m) {
                            const unsigned w = pk[ai][bj][m][n][pr];
                            const unsigned u1 = (fr >= 1) ? r1[m] : r1[m > 0 ? m - 1 : 0];
                            const unsigned u2 = (fr >= 2) ? r2[m] : r2[m > 0 ? m - 1 : 0];
                            y[bj][m][0] = kkb[bj].x + kk0[bj].x * bf_lo(u2) + kk1[bj].x * bf_lo(u1) + kk2[bj].x * bf_lo(w);
                            y[bj][m][1] = kkb[bj].y + kk0[bj].y * bf_hi(u2) + kk1[bj].y * bf_hi(u1) + kk2[bj].y * bf_hi(w);
                        }
                    }
#pragma unroll
                    for (int m = 0; m < 4; ++m) {
                        if (m == 0 && fr < 2) continue;
                        *(unsigned*)(act + (size_t)(row0 + m * 16 + fr) * FF + ca0) = cvtpk(silu_mul(y[0][m][0], y[1][m][0]), silu_mul(y[0][m][1], y[1][m][1]));
                    }
                }
                asm volatile("" ::: "memory");
            }
    }
};
__device__ __forceinline__ void fixup_phase(Frame& F, const float* cw, const float* cb, const float* halo, bf16* act) {
    const int gt = F.vcu * (NWAVES * 64) + F.tid, NT = F.G * NWAVES * 64;
    constexpr int C4 = FF / 4;
    for (int it = gt; it < NBLK64 * 2 * C4; it += NT) {
        const int c = (it % C4) * 4, rj = it / C4, j = rj & 1, blk = rj >> 1, t = blk * 64 + j, tb = t % SEQ;
        f32x4 y[2];
#pragma unroll
        for (int bj = 0; bj < 2; ++bj) {
            const int cc = bj * FF + c;
            const f32x4 z = (f32x4){0.f, 0.f, 0.f, 0.f};
            const f32x4 ut = *(const f32x4*)(halo + ((size_t)blk * 4 + j) * NUP + cc);
            f32x4 u1, u2;
            if (j == 1) { u1 = *(const f32x4*)(halo + ((size_t)blk * 4 + 0) * NUP + cc); u2 = (tb == 1) ? z : *(const f32x4*)(halo + ((size_t)(blk - 1) * 4 + 3) * NUP + cc); }
            else { u1 = (tb == 0) ? z : *(const f32x4*)(halo + ((size_t)(blk - 1) * 4 + 3) * NUP + cc); u2 = (tb == 0) ? z : *(const f32x4*)(halo + ((size_t)(blk - 1) * 4 + 2) * NUP + cc); }
            y[bj] = *(const f32x4*)(cb + cc) + *(const f32x4*)(cw + cc) * u2 + *(const f32x4*)(cw + NUP + cc) * u1 + *(const f32x4*)(cw + 2 * NUP + cc) * ut;
        }
        v2u w; w.x = cvtpk(silu_mul(y[0].x, y[1].x), silu_mul(y[0].y, y[1].y)); w.y = cvtpk(silu_mul(y[0].z, y[1].z), silu_mul(y[0].w, y[1].w));
        *(v2u*)(act + (size_t)t * FF + c) = w;
    }
}

__device__ __forceinline__ int crow(int r, int hi) { return (r & 3) + 8 * (r >> 2) + 4 * hi; }
__device__ __forceinline__ void glds16(const void* gsrc, unsigned lds_dst) { unsigned keep;
    asm volatile("s_mov_b32 %0, m0\n\ts_mov_b32 m0, %2\n\ts_nop 0\n\tglobal_load_lds_dwordx4 %1, off\n\ts_mov_b32 m0, %0" : "=&s"(keep) : "v"(gsrc), "s"(lds_dst) : "memory"); }
__device__ __forceinline__ float max3f(float a, float b, float c) { return fmaxf(fmaxf(a, b), c); }

namespace band {
constexpr int SLOTB = 8192;
constexpr int LDS_K = 0, LDS_V = 2 * SLOTB, LDS_WS = 4 * SLOTB, LDS_TB = LDS_WS + NWAVES * 64 * 4, LDS_OST = LDS_TB + 640 * 4 + 512, LDS_END = LDS_OST + NWAVES * 4096;
static_assert(LDS_END <= RING_BYTES, "band LDS");
__device__ __forceinline__ void unit(Frame& F, int b, int h, int U, const bf16* Q, const bf16* K, const bf16* V, bf16* O, const float* rel) {
    const int tid = F.tid, lane = F.lane, r32 = lane & 31, hi = lane >> 5, wid = F.wave;
    LAS unsigned char* shm = F.lds + RING_OFF;
    const unsigned lds0 = (unsigned)(uintptr_t)shm;
    const long rowbase = (long)b * SEQ; const int q0 = U * 256, c0 = 4 * U, cq = c0 + (wid >> 1);
    const bf16* Qw = Q + (rowbase + q0 + wid * 32) * DM + h * 64;
    const bf16* Kh = K + rowbase * DM + h * 64; const bf16* Vh = V + rowbase * DM + h * 64;
    LAS float* wsf = (LAS float*)(shm + LDS_WS) + wid * 64;
    LAS float* tb = (LAS float*)(shm + LDS_TB);
    const bf16* ksrc = Kh + (long)lane * DM + wid * 8;
    const bf16* vsrc = Vh + (long)(16 * (wid & 3) + (lane >> 2)) * DM + (wid >> 2) * 32 + (lane & 3) * 8;
    const unsigned kdst = lds0 + LDS_K + wid * 1024, vdst = lds0 + LDS_V + wid * 1024;
    const int lo = (c0 - 8 > 0) ? c0 - 8 : 0, hiT = c0 + 3, NT = hiT - lo + 1, t0 = (c0 - 5 > 0) ? c0 - 5 : 0;
#define BAND_KT(i) ((t0 + (i) <= hiT) ? t0 + (i) : lo + (t0 + (i) - hiT - 1))
    for (int i = tid; i < 640; i += NWAVES * 64) { int d = i - 64; d = d < -256 ? -256 : (d > 256 ? 256 : d); tb[i] = rel[(d + 256) * 16 + h] * LOG2E; }
    { const int kt = BAND_KT(0); glds16(ksrc + (long)kt * 64 * DM, (unsigned)__builtin_amdgcn_readfirstlane(kdst)); glds16(vsrc + (long)kt * 64 * DM, (unsigned)__builtin_amdgcn_readfirstlane(vdst)); }
    bf16x8 qr[4];
#pragma unroll
    for (int d0 = 0; d0 < 4; ++d0) qr[d0] = *(const bf16x8*)(Qw + (long)r32 * DM + d0 * 16 + hi * 8);
    float m_run = -INFINITY, l_run = 0.f; f32x16 o[2]; o[0] = f32x16{}; o[1] = f32x16{};
    const int qpos = q0 + wid * 32 + r32;
    const LAS unsigned char* vbase = shm + LDS_V + ((lane >> 4) & 1) * 32 + (lane & 3) * 8 + (4 * hi + ((lane & 15) >> 2)) * 64;
    for (int i = 0; i < NT; ++i) {
        asm volatile("s_waitcnt vmcnt(0) lgkmcnt(0)\n\ts_barrier" ::: "memory");
        if (i + 1 < NT) { const int kt = BAND_KT(i + 1); const unsigned so = ((i + 1) & 1) * SLOTB;
            glds16(ksrc + (long)kt * 64 * DM, (unsigned)__builtin_amdgcn_readfirstlane(kdst + so)); glds16(vsrc + (long)kt * 64 * DM, (unsigned)__builtin_amdgcn_readfirstlane(vdst + so)); }
        const int kt = BAND_KT(i);
        if (kt < cq - 8 || kt > cq) continue;
        const int so = (i & 1) * SLOTB;
        f32x16 p0 = f32x16{}, p1 = f32x16{};
        { const LAS unsigned char* kb = shm + LDS_K + so + hi * 1024 + r32 * 16;
#pragma unroll
          for (int d0 = 0; d0 < 4; ++d0) { const bf16x8 b0 = *(const LAS bf16x8*)(kb + d0 * 2048), b1 = *(const LAS bf16x8*)(kb + d0 * 2048 + 512);
              p0 = __builtin_amdgcn_mfma_f32_32x32x16_bf16(b0, qr[d0], p0, 0, 0, 0); p1 = __builtin_amdgcn_mfma_f32_32x32x16_bf16(b1, qr[d0], p1, 0, 0, 0); } }
        { const int ib = qpos - 64 * kt + 64 - 4 * hi;
#pragma unroll
          for (int r = 0; r < 16; ++r) { const int ix = ib - ((r & 3) + 8 * (r >> 2)); p0[r] += tb[ix]; p1[r] += tb[ix - 32]; } }
        float rm = p0[0];
#pragma unroll
        for (int r = 0; r < 16; ++r) rm = max3f(rm, p0[r], p1[r]);
        { auto rr = __builtin_amdgcn_permlane32_swap(__float_as_uint(rm), __float_as_uint(rm), false, false); rm = fmaxf(__uint_as_float(rr[0]), __uint_as_float(rr[1])); }
        const float mnew = fmaxf(m_run, rm), f = __builtin_amdgcn_exp2f(m_run - mnew); m_run = mnew;
        float sacc = 0.f;
#pragma unroll
        for (int r = 0; r < 16; ++r) { p0[r] = __builtin_amdgcn_exp2f(p0[r] - mnew); p1[r] = __builtin_amdgcn_exp2f(p1[r] - mnew); sacc += p0[r] + p1[r]; }
        l_run = l_run * f + sacc;
        if (hi == 0) wsf[r32] = f;
        LDS_WAIT();
#pragma unroll
        for (int r = 0; r < 16; ++r) { const float fr_ = wsf[crow(r, hi)]; o[0][r] *= fr_; o[1][r] *= fr_; }
        v4u pw[4];
        pw[0] = (v4u){cvtpk(p0[0], p0[1]), cvtpk(p0[2], p0[3]), cvtpk(p0[4], p0[5]), cvtpk(p0[6], p0[7])};
        pw[1] = (v4u){cvtpk(p0[8], p0[9]), cvtpk(p0[10], p0[11]), cvtpk(p0[12], p0[13]), cvtpk(p0[14], p0[15])};
        pw[2] = (v4u){cvtpk(p1[0], p1[1]), cvtpk(p1[2], p1[3]), cvtpk(p1[4], p1[5]), cvtpk(p1[6], p1[7])};
        pw[3] = (v4u){cvtpk(p1[8], p1[9]), cvtpk(p1[10], p1[11]), cvtpk(p1[12], p1[13]), cvtpk(p1[14], p1[15])};
        const LAS unsigned char* vb = vbase + so;
#pragma unroll
        for (int d0 = 0; d0 < 2; ++d0)
#pragma unroll
            for (int ks = 0; ks < 4; ++ks) {
                const s16x4 vlo = __builtin_bit_cast(s16x4, __builtin_amdgcn_ds_read_tr16_b64_v4i16((LAS s16x4*)(vb + d0 * 4096 + ks * 1024)));
                const s16x4 vhi = __builtin_bit_cast(s16x4, __builtin_amdgcn_ds_read_tr16_b64_v4i16((LAS s16x4*)(vb + d0 * 4096 + ks * 1024 + 512)));
                const bf16x8 vf = (bf16x8){vlo[0], vlo[1], vlo[2], vlo[3], vhi[0], vhi[1], vhi[2], vhi[3]};
                o[d0] = __builtin_amdgcn_mfma_f32_32x32x16_bf16(__builtin_bit_cast(bf16x8, pw[ks]), vf, o[d0], 0, 0, 0);
            }
    }
#undef BAND_KT
    { auto rr = __builtin_amdgcn_permlane32_swap(__float_as_uint(l_run), __float_as_uint(l_run), false, false); l_run = __uint_as_float(rr[0]) + __uint_as_float(rr[1]); }
    if (hi == 0) wsf[32 + r32] = l_run;
    LDS_WAIT();
    float rli[16];
#pragma unroll
    for (int r = 0; r < 16; ++r) rli[r] = __builtin_amdgcn_rcpf(wsf[32 + crow(r, hi)]);
    bf16* Ow = O + (rowbase + q0 + wid * 32) * DM + h * 64;
    { LAS bf16* stg = (LAS bf16*)(shm + LDS_OST) + wid * 2048;
#pragma unroll
      for (int r = 0; r < 16; ++r) { const int orow = crow(r, hi);
#pragma unroll
          for (int d0 = 0; d0 < 2; ++d0) stg[orow * 64 + d0 * 32 + r32] = (bf16)f2bf(o[d0][r] * rli[r]); }
      LDS_WAIT();
#pragma unroll
      for (int i = 0; i < 4; ++i) { const int row = i * 8 + (lane >> 3), ch = lane & 7; const v4u v = *(const LAS v4u*)(stg + row * 64 + ch * 8); *(v4u*)(Ow + (long)row * DM + ch * 8) = v; } }
    asm volatile("s_waitcnt lgkmcnt(0)\n\ts_barrier" ::: "memory");
}
__device__ __forceinline__ void phase(Frame& F, const bf16* Q, const bf16* K, const bf16* V, bf16* O, const float* rel) {
    const int NU = BATCH * 16 * 32, per = (NU + F.G - 1) / F.G;
    for (int i = 0; i < per; ++i) { const int uid = F.vcu * per + i; if (uid >= NU) break; unit(F, uid >> 9, (uid >> 5) & 15, uid & 31, Q, K, V, O, rel); }
}
}

namespace dsa {
__device__ __forceinline__ unsigned okey(float s) { const unsigned u = __float_as_uint(s + 0.0f); return (u & 0x80000000u) ? ~u : (u | 0x80000000u); }
struct Ctx { const bf16* QA; const bf16* KA; const bf16* VA; const bf16* QI; const bf16* KI; const float* WI; bf16* M; const LAS float* t5l; unsigned short* SEL; };

__device__ __forceinline__ void scan_hist(const LAS unsigned* hq, int lane, unsigned need, unsigned& bin, unsigned& above) {
    const LAS v4u* hp = (const LAS v4u*)hq + lane * 4;
    unsigned wds[16];
#pragma unroll
    for (int j = 0; j < 4; ++j) { const v4u t = hp[j]; wds[4 * j] = t.x; wds[4 * j + 1] = t.y; wds[4 * j + 2] = t.z; wds[4 * j + 3] = t.w; }
    unsigned tl = 0;
#pragma unroll
    for (int j = 0; j < 16; ++j) tl += (wds[j] & 0xffffu) + (wds[j] >> 16);
    unsigned suf = tl;
#pragma unroll
    for (int o = 1; o < 64; o <<= 1) { const unsigned v = __shfl_down(suf, o); if (lane + o < 64) suf += v; }
    const unsigned S = suf - tl;
    const bool cross = (S < need) && (need <= S + tl);
    unsigned c = S, bsel = 0, ab = 0; bool found = false;
#pragma unroll
    for (int k = 31; k >= 0; --k) { const unsigned cnt = (wds[k >> 1] >> (16 * (k & 1))) & 0xffffu; if (!found && c + cnt >= need) { bsel = 32 * lane + k; ab = c; found = true; } c += cnt; }
    const unsigned long long bal = __ballot(cross);
    const int src = bal ? __builtin_ctzll(bal) : 0;
    bin = __shfl(bsel, src); above = __shfl(ab, src);
}

__device__ __forceinline__ void attend(const Ctx& C, const LAS unsigned short* sq, int nvalid, long rowbase, long token, int tpos, int lane, int g0) {
    asm volatile("" : "+v"(lane));
    const int l15 = lane & 15, l4 = lane >> 4;
    int sidx[16];
#pragma unroll
    for (int ti = 0; ti < 16; ++ti) sidx[ti] = sq[ti * 16 + l15];
    unsigned bpk[4] = {0u, 0u, 0u, 0u};
#pragma unroll
    for (int ti = 0; ti < 16; ++ti) { const int rel = sidx[ti] - tpos, n = rel < 0 ? -rel : rel;
        const int bk = (rel > 0 ? 16 : 0) + (n < 8 ? n : 8 + (n >= 12) + (n >= 16) + (n >= 23) + (n >= 32) + (n >= 46) + (n >= 64) + (n >= 91));
        bpk[ti >> 2] |= (unsigned)bk << (8 * (ti & 3)); }
#pragma unroll 1
    for (int g = g0; g < g0 + 2; ++g) {
        const bf16* qp = C.QA + token * DM + (4 * g + (lane & 3)) * 64 + 8 * l4;
        const bf16x8 qf0 = *(const bf16x8*)qp, qf1 = *(const bf16x8*)(qp + 32);
        const bf16* kbase = C.KA + rowbase * 256 + g * 64 + 8 * l4;
        f32x4 S[16];
#pragma unroll
        for (int hh = 0; hh < 4; ++hh) {
            bf16x8 kf0[4], kf1[4];
#pragma unroll
            for (int j = 0; j < 4; ++j) { const bf16* kp = kbase + (long)sidx[hh * 4 + j] * 256; kf0[j] = *(const bf16x8*)kp; kf1[j] = *(const bf16x8*)(kp + 32); }
#pragma unroll
            for (int j = 0; j < 4; ++j) { const int ti = hh * 4 + j;
                f32x4 a = *(const LAS f32x4*)(C.t5l + ((bpk[hh] >> (8 * j)) & 255u) * 16 + 4 * g);
                asm volatile("v_mfma_f32_16x16x32_bf16 %0, %1, %2, %0" : "+v"(a) : "v"(qf0), "v"(kf0[j]));
                asm volatile("v_mfma_f32_16x16x32_bf16 %0, %1, %2, %0" : "+v"(a) : "v"(qf1), "v"(kf1[j]));
                S[ti] = a; }
            asm volatile("s_nop 15\n\ts_nop 7" : "+v"(S[hh * 4]), "+v"(S[hh * 4 + 1]), "+v"(S[hh * 4 + 2]), "+v"(S[hh * 4 + 3]));
        }
#pragma unroll
        for (int ti = 0; ti < 16; ++ti) if (ti * 16 >= nvalid) S[ti] = (f32x4){-INFINITY, -INFINITY, -INFINITY, -INFINITY};
        f32x4 mx = S[0];
#pragma unroll
        for (int ti = 1; ti < 16; ++ti) { mx.x = fmaxf(mx.x, S[ti].x); mx.y = fmaxf(mx.y, S[ti].y); mx.z = fmaxf(mx.z, S[ti].z); mx.w = fmaxf(mx.w, S[ti].w); }
#pragma unroll
        for (int o = 1; o < 16; o <<= 1) { mx.x = fmaxf(mx.x, __shfl_xor(mx.x, o)); mx.y = fmaxf(mx.y, __shfl_xor(mx.y, o)); mx.z = fmaxf(mx.z, __shfl_xor(mx.z, o)); mx.w = fmaxf(mx.w, __shfl_xor(mx.w, o)); }
        f32x4 ls = (f32x4){0.f, 0.f, 0.f, 0.f};
        unsigned P01[16], P23[16];
#pragma unroll
        for (int ti = 0; ti < 16; ++ti) { const float e0 = __builtin_amdgcn_exp2f(S[ti].x - mx.x), e1 = __builtin_amdgcn_exp2f(S[ti].y - mx.y), e2 = __builtin_amdgcn_exp2f(S[ti].z - mx.z), e3 = __builtin_amdgcn_exp2f(S[ti].w - mx.w);
            ls += (f32x4){e0, e1, e2, e3}; P01[ti] = cvtpk(e0, e1); P23[ti] = cvtpk(e2, e3); }
#pragma unroll
        for (int o = 1; o < 16; o <<= 1) { ls.x += __shfl_xor(ls.x, o); ls.y += __shfl_xor(ls.y, o); ls.z += __shfl_xor(ls.z, o); ls.w += __shfl_xor(ls.w, o); }
        float o_[4][16];
#pragma unroll
        for (int h = 0; h < 4; ++h)
#pragma unroll
            for (int d = 0; d < 16; ++d) o_[h][d] = 0.f;
        const bf16* vbase = C.VA + rowbase * 256 + g * 64 + 16 * l4;
#pragma unroll
        for (int hh = 0; hh < 4; ++hh) {
            v4u va[4], vb[4];
#pragma unroll
            for (int j = 0; j < 4; ++j) { const v4u* vp = (const v4u*)(vbase + (long)sidx[hh * 4 + j] * 256); va[j] = vp[0]; vb[j] = vp[1]; }
#pragma unroll
            for (int j = 0; j < 4; ++j) { const int ti = hh * 4 + j; const v4u v0 = va[j], v1 = vb[j];
                float vf[16];
                vf[0] = bf_lo(v0.x); vf[1] = bf_hi(v0.x); vf[2] = bf_lo(v0.y); vf[3] = bf_hi(v0.y); vf[4] = bf_lo(v0.z); vf[5] = bf_hi(v0.z); vf[6] = bf_lo(v0.w); vf[7] = bf_hi(v0.w);
                vf[8] = bf_lo(v1.x); vf[9] = bf_hi(v1.x); vf[10] = bf_lo(v1.y); vf[11] = bf_hi(v1.y); vf[12] = bf_lo(v1.z); vf[13] = bf_hi(v1.z); vf[14] = bf_lo(v1.w); vf[15] = bf_hi(v1.w);
                const float p0 = bf_lo(P01[ti]), p1 = bf_hi(P01[ti]), p2 = bf_lo(P23[ti]), p3 = bf_hi(P23[ti]);
#pragma unroll
                for (int d = 0; d < 16; ++d) { o_[0][d] += p0 * vf[d]; o_[1][d] += p1 * vf[d]; o_[2][d] += p2 * vf[d]; o_[3][d] += p3 * vf[d]; } }
        }
        float res[4];
#pragma unroll
        for (int h = 0; h < 4; ++h) {
            float a8[8], a4[4], a2[2];
            const bool b3 = (l15 & 8) != 0, b2 = (l15 & 4) != 0, b1 = (l15 & 2) != 0, b0 = (l15 & 1) != 0;
#pragma unroll
            for (int d = 0; d < 8; ++d) { const float keep = b3 ? o_[h][d + 8] : o_[h][d], send = b3 ? o_[h][d] : o_[h][d + 8]; a8[d] = keep + __shfl_xor(send, 8); }
#pragma unroll
            for (int d = 0; d < 4; ++d) { const float keep = b2 ? a8[d + 4] : a8[d], send = b2 ? a8[d] : a8[d + 4]; a4[d] = keep + __shfl_xor(send, 4); }
#pragma unroll
            for (int d = 0; d < 2; ++d) { const float keep = b1 ? a4[d + 2] : a4[d], send = b1 ? a4[d] : a4[d + 2]; a2[d] = keep + __shfl_xor(send, 2); }
            { const float keep = b0 ? a2[1] : a2[0], send = b0 ? a2[0] : a2[1]; res[h] = keep + __shfl_xor(send, 1); }
        }
        bf16* mp = C.M + token * DM + (4 * g) * 64 + lane;
        mp[0] = (bf16)f2bf(res[0] * __builtin_amdgcn_rcpf(ls.x)); mp[64] = (bf16)f2bf(res[1] * __builtin_amdgcn_rcpf(ls.y)); mp[128] = (bf16)f2bf(res[2] * __builtin_amdgcn_rcpf(ls.z)); mp[192] = (bf16)f2bf(res[3] * __builtin_amdgcn_rcpf(ls.w));
    }
}

constexpr int CAND_CAP = 256;
constexpr int SELKS_OFF = KS_OFF;
__device__ __forceinline__ float relu_i(float x) { const int i = __builtin_bit_cast(int, x); return __builtin_bit_cast(float, i > 0 ? i : 0); }
struct SelState { unsigned pre[4], need[4], cnt[4], tcnt[4]; };
__device__ __forceinline__ void tile_mfma(f32x16 (&acc)[2], const LAS unsigned char* kf, const int (&koff)[4], const bf16x8 (&qa)[4]) {
#pragma unroll
    for (int h2 = 0; h2 < 2; ++h2) { acc[h2] = f32x16{};
#pragma unroll
        for (int ks = 0; ks < 4; ++ks) { const bf16x8 kb = *(const LAS bf16x8*)(kf + koff[ks] + h2 * 4096); acc[h2] = __builtin_amdgcn_mfma_f32_32x32x16_bf16(qa[ks], kb, acc[h2], 0, 0, 0); } }
}
template <class ActionT>
__device__ __forceinline__ void tile_valu(const f32x16 (&acc)[2], const f32x2_t (&wp)[2][4], int kbase, ActionT&& act) {
#pragma unroll
    for (int h2 = 0; h2 < 2; ++h2) {
        f32x2_t sa = {0.f, 0.f}, sb = {0.f, 0.f};
#pragma unroll
        for (int jp = 0; jp < 4; ++jp) {
            const f32x2_t ra = {relu_i(acc[h2][2 * jp]), relu_i(acc[h2][2 * jp + 1])};
            const f32x2_t rb = {relu_i(acc[h2][8 + 2 * jp]), relu_i(acc[h2][8 + 2 * jp + 1])};
            sa = __builtin_elementwise_fma(ra, wp[0][jp], sa); sb = __builtin_elementwise_fma(rb, wp[1][jp], sb); }
        act(kbase + h2 * 32, (sa.x + sa.y) + 0.0f, (sb.x + sb.y) + 0.0f);
    }
}
constexpr int KSLOTS = 3;
__device__ __forceinline__ void wait_tile(int newer) {
    if (newer >= 4) asm volatile("s_waitcnt vmcnt(4) lgkmcnt(0)\n\ts_barrier" ::: "memory");
    else if (newer == 3) asm volatile("s_waitcnt vmcnt(3) lgkmcnt(0)\n\ts_barrier" ::: "memory");
    else if (newer == 2) asm volatile("s_waitcnt vmcnt(2) lgkmcnt(0)\n\ts_barrier" ::: "memory");
    else if (newer == 1) asm volatile("s_waitcnt vmcnt(1) lgkmcnt(0)\n\ts_barrier" ::: "memory");
    else asm volatile("s_waitcnt vmcnt(0) lgkmcnt(0)\n\ts_barrier" ::: "memory");
}
template <class ActionT>
__device__ __forceinline__ void tile_pass(Frame& F, const bf16* ksrc, unsigned kdst, const LAS unsigned char* kfr, const int (&koff)[4], int NT, const bf16x8 (&qa)[4], const f32x2_t (&wp)[2][4], ActionT&& act) {
    asm volatile("s_waitcnt lgkmcnt(0)\n\ts_barrier" ::: "memory");
    const int npre = NT < KSLOTS ? NT : KSLOTS;
    for (int j = 0; j < npre; ++j) glds16(ksrc + (long)j * 4096, (unsigned)__builtin_amdgcn_readfirstlane(kdst + j * 8192));
    wait_tile(npre - 1);
    f32x16 accC[2];
    tile_mfma(accC, kfr, koff, qa);
    int sl = 0;
    for (int kt = 0; kt + 1 < NT; ++kt) {
        { const int inflight = (NT - kt - 2) < (KSLOTS - 2) ? (NT - kt - 2) : (KSLOTS - 2); wait_tile(inflight); }
        if (kt + KSLOTS < NT) glds16(ksrc + (long)(kt + KSLOTS) * 4096, (unsigned)__builtin_amdgcn_readfirstlane(kdst + sl * 8192));
        sl = (sl == KSLOTS - 1) ? 0 : sl + 1;
        f32x16 accN[2];
        tile_mfma(accN, kfr + sl * 8192, koff, qa);
        tile_valu(accC, wp, kt * 64, act);
        accC[0] = accN[0]; accC[1] = accN[1];
    }
    tile_valu(accC, wp, (NT - 1) * 64, act);
    LDS_WAIT();
}
__device__ __forceinline__ void scan_hist_cnt(const LAS unsigned* hq, int lane, unsigned need, unsigned& bin, unsigned& above, unsigned& bcnt) {
    const LAS v4u* hp = (const LAS v4u*)hq + lane * 2;
    unsigned wds[8];
#pragma unroll
    for (int j = 0; j < 2; ++j) { const v4u t = hp[j]; wds[4 * j] = t.x; wds[4 * j + 1] = t.y; wds[4 * j + 2] = t.z; wds[4 * j + 3] = t.w; }
    unsigned tl = 0;
#pragma unroll
    for (int j = 0; j < 8; ++j) tl += wds[j];
    unsigned suf = tl;
#pragma unroll
    for (int o = 1; o < 64; o <<= 1) { const unsigned v = __shfl_down(suf, o); if (lane + o < 64) suf += v; }
    const unsigned S = suf - tl;
    const bool cross = (S < need) && (need <= S + tl);
    unsigned c = S, bsel = 0, ab = 0, bc = 0; bool found = false;
#pragma unroll
    for (int k = 7; k >= 0; --k) { const unsigned cnt = wds[k]; if (!found && c + cnt >= need) { bsel = 8 * lane + k; ab = c; bc = cnt; found = true; } c += cnt; }
    const unsigned long long bal = __ballot(cross);
    const int src = bal ? __builtin_ctzll(bal) : 0;
    bin = __builtin_amdgcn_readfirstlane(__shfl(bsel, src)); above = __builtin_amdgcn_readfirstlane(__shfl(ab, src)); bcnt = __builtin_amdgcn_readfirstlane(__shfl(bc, src));
}
__device__ __forceinline__ void step(Frame& F, const Ctx& C, int b, int c, int half) {
    int lane_ = F.lane; asm volatile("" : "+v"(lane_));
    const int lane = lane_, r = lane & 31, hi = lane >> 5, wave = F.wave;
    LAS unsigned* hist = (LAS unsigned*)(F.lds + RING_OFF + wave * 16384);
    LAS unsigned short* sel = (LAS unsigned short*)hist;
    LAS unsigned* cand = hist + 2048;
    LAS unsigned* fbflag = (LAS unsigned*)(F.lds + AUX_OFF + 2048);
    const long rowbase = (long)b * SEQ;
    const int tq0 = 64 * c + 32 * half + 4 * wave;
    const int N = 64 * (c + 1), NT = c + 1;
    int nvalid = 256;
    if (N <= 256) {
        nvalid = N;
        for (int j = lane; j < 4 * 256; j += 64) sel[j] = (unsigned short)(((j & 255) < N) ? (j & 255) : 0);
    } else {
        const int aq = 2 * ((r >> 2) & 1) + (r >> 4), ah = 4 * ((r >> 3) & 1) + (r & 3);
        const bf16* qip = C.QI + (rowbase + tq0 + aq) * 512 + ah * 64 + 8 * hi;
        bf16x8 qa[4];
#pragma unroll
        for (int ks = 0; ks < 4; ++ks) qa[ks] = *(const bf16x8*)(qip + 16 * ks);
        f32x2_t wp[2][4];
#pragma unroll
        for (int t = 0; t < 2; ++t) { const float* wq = C.WI + (rowbase + tq0 + 2 * hi + t) * 8; const f32x4 w0 = *(const f32x4*)wq, w1 = *(const f32x4*)(wq + 4);
            wp[t][0] = (f32x2_t){w0.x, w0.y}; wp[t][1] = (f32x2_t){w0.z, w0.w}; wp[t][2] = (f32x2_t){w1.x, w1.y}; wp[t][3] = (f32x2_t){w1.z, w1.w}; }
        float Bq;
        { float ssq = 0.f;
#pragma unroll
          for (int ks = 0; ks < 4; ++ks)
#pragma unroll
              for (int e = 0; e < 8; ++e) { const float v = bf_lo((unsigned)(unsigned short)qa[ks][e]); ssq += v * v; }
          ssq += __shfl_xor(ssq, 32);
          float term = fabsf(C.WI[(rowbase + tq0 + aq) * 8 + ah]) * sqrtf(ssq);
          term += __shfl_xor(term, 1); term += __shfl_xor(term, 2); term += __shfl_xor(term, 8);
          Bq = term * 8.25f + 1e-20f; }
        const float B0 = __shfl(Bq, (hi << 2)), B1 = __shfl(Bq, (hi << 2) | 16);
        const float sc0 = 1024.0f / B0, sc1 = 1024.0f / B1;
        asm volatile("" :: "v"(qa[0]), "v"(qa[1]), "v"(qa[2]), "v"(qa[3]));
        asm volatile("" :: "v"(wp[0][0]), "v"(wp[0][1]), "v"(wp[0][2]), "v"(wp[0][3]), "v"(wp[1][0]), "v"(wp[1][1]), "v"(wp[1][2]), "v"(wp[1][3]), "v"(sc0), "v"(sc1));
        const bf16* ksrc = C.KI + rowbase * 64 + (long)(wave * 8 + (lane >> 3)) * 64 + ((lane & 7) ^ (lane >> 3)) * 8;
        const unsigned kdst = (unsigned)(uintptr_t)(F.lds + SELKS_OFF) + wave * 1024;
        const LAS unsigned char* kfr = F.lds + SELKS_OFF + r * 128;
        int koff[4];
#pragma unroll
        for (int ks = 0; ks < 4; ++ks) koff[ks] = ((2 * ks + hi) ^ (r & 7)) * 16;
        const unsigned below = (1u << r) - 1u;
        LAS v4u* hz = (LAS v4u*)hist;
        if (wave == 0 && lane == 0) *fbflag = 0u;
#pragma unroll
        for (int j = 0; j < 8; ++j) hz[j * 64 + lane] = (v4u){0u, 0u, 0u, 0u};
        tile_pass(F, ksrc, kdst, kfr, koff, NT, qa, wp, [&](int kbase, float s0, float s1) {
            const int b0 = (int)__builtin_amdgcn_fmed3f(__builtin_fmaf(s0, sc0, 256.0f), 0.0f, 511.0f), b1 = (int)__builtin_amdgcn_fmed3f(__builtin_fmaf(s1, sc1, 256.0f), 0.0f, 511.0f);
            __hip_atomic_fetch_add(hist + (2 * hi) * 512 + b0, 1u, __ATOMIC_RELAXED, __HIP_MEMORY_SCOPE_WORKGROUP);
            __hip_atomic_fetch_add(hist + (2 * hi + 1) * 512 + b1, 1u, __ATOMIC_RELAXED, __HIP_MEMORY_SCOPE_WORKGROUP);
        });
#ifdef PROBE_SKEL
        tile_pass(F, ksrc, kdst, kfr, koff, NT, qa, wp, [&](int kbase, float s0, float s1) { });
#endif
#ifdef PROBE_SCORE
        { float dsum = 0.f; tile_pass(F, ksrc, kdst, kfr, koff, NT, qa, wp, [&](int kbase, float s0, float s1) { dsum += s0 + s1; }); if (dsum == 12345.678f) hist[0] = 1u; }
#endif
        SelState st;
        unsigned tbin[4], bcn[4]; bool ovf = false;
#pragma unroll
        for (int ql = 0; ql < 4; ++ql) { unsigned above; scan_hist_cnt(hist + ql * 512, lane, 256u, tbin[ql], above, bcn[ql]); st.cnt[ql] = 0u; st.tcnt[ql] = 0u; st.need[ql] = 256u - above; st.pre[ql] = above;
#ifdef PROBE_OVF
            ovf |= bcn[ql] > (unsigned)PROBE_OVF; }
#else
            ovf |= bcn[ql] > (unsigned)CAND_CAP; }
#endif
        LDS_WAIT();
        if (ovf && lane == 0) *fbflag = 1u;
        asm volatile("s_waitcnt lgkmcnt(0)\n\ts_barrier" ::: "memory");
#ifdef PROBE_NOFB
        const bool fb = false;
#elif defined(PROBE_NOFB2)
        const bool fb = __builtin_amdgcn_readfirstlane((int)*fbflag) == 0x7fffffff;
#else
        const bool fb = __builtin_amdgcn_readfirstlane((int)*fbflag) != 0;
#endif
        if (!fb) {
            const int tb0 = (int)(hi ? tbin[2] : tbin[0]), tb1 = (int)(hi ? tbin[3] : tbin[1]);
            tile_pass(F, ksrc, kdst, kfr, koff, NT, qa, wp, [&](int kbase, float s0, float s1) {
#pragma unroll
                for (int t = 0; t < 2; ++t) {
                    const float s = t ? s1 : s0; const int bin = (int)__builtin_amdgcn_fmed3f(__builtin_fmaf(s, (t ? sc1 : sc0), 256.0f), 0.0f, 511.0f), tb = t ? tb1 : tb0;
                    const bool gt = bin > tb, eq = bin == tb;
                    const unsigned long long mg = __ballot(gt), me = __ballot(eq);
                    const unsigned mgh = hi ? (unsigned)(mg >> 32) : (unsigned)mg, meh = hi ? (unsigned)(me >> 32) : (unsigned)me;
                    const unsigned pos = (hi ? st.cnt[2 + t] : st.cnt[t]) + __builtin_popcount(mgh & below);
                    sel[(gt && pos < 256u) ? (2 * hi + t) * 256 + pos : 3200 + lane] = (unsigned short)(kbase + r);
                    const unsigned cpos = (hi ? st.tcnt[2 + t] : st.tcnt[t]) + __builtin_popcount(meh & below);
                    { LAS unsigned* cp = hist + ((eq && cpos < (unsigned)CAND_CAP) ? 2048 + ((2 * hi + t) * CAND_CAP + cpos) * 2 : 1700 + 2 * lane); cp[0] = okey(s); cp[1] = (unsigned)(kbase + r); }
                    st.cnt[t] += __builtin_popcount((unsigned)mg); st.cnt[2 + t] += __builtin_popcount((unsigned)(mg >> 32));
                    st.tcnt[t] += __builtin_popcount((unsigned)me); st.tcnt[2 + t] += __builtin_popcount((unsigned)(me >> 32));
                }
            });
#pragma unroll
            for (int ql = 0; ql < 4; ++ql) {
                const unsigned nc = bcn[ql], G = st.pre[ql], rq = st.need[ql];
                const LAS unsigned* cq = cand + ql * CAND_CAP * 2;
                unsigned ki4[4], xi4[4], rk4[4];
#pragma unroll
                for (int m = 0; m < 4; ++m) { const unsigned i = (unsigned)lane + 64u * m; ki4[m] = (i < nc) ? cq[2 * i] : 0u; xi4[m] = (i < nc) ? cq[2 * i + 1] : 0u; rk4[m] = 0u; }
                for (unsigned j = 0; j < nc; ++j) { const unsigned kj = cq[2 * j];
#pragma unroll
                    for (int m = 0; m < 4; ++m) rk4[m] += (kj > ki4[m] || (kj == ki4[m] && j < (unsigned)lane + 64u * m)) ? 1u : 0u; }
                unsigned base = G; const unsigned long long lt = (1ull << lane) - 1ull;
#pragma unroll
                for (int m = 0; m < 4; ++m) { const bool take = ((unsigned)lane + 64u * m < nc) && rk4[m] < rq; const unsigned long long mm = __ballot(take);
                    const unsigned pos = base + __builtin_popcountll(mm & lt); if (take && pos < 256u) sel[ql * 256 + pos] = (unsigned short)xi4[m]; base += __builtin_popcountll(mm); }
            }
        } else {
#pragma unroll
            for (int ql = 0; ql < 4; ++ql) { st.pre[ql] = 0u; st.need[ql] = 256u; st.cnt[ql] = 0u; st.tcnt[ql] = 0u; }
#pragma unroll 1
            for (int lev = 0; lev < 4; ++lev) {
#pragma unroll
                for (int j = 0; j < 8; ++j) hz[j * 64 + lane] = (v4u){0u, 0u, 0u, 0u};
                const unsigned pre0 = hi ? st.pre[2] : st.pre[0], pre1 = hi ? st.pre[3] : st.pre[1];
                const int sh = (lev == 0) ? 23 : (lev == 1) ? 14 : (lev == 2) ? 5 : 0, wd = (lev == 3) ? 5 : 9;
                tile_pass(F, ksrc, kdst, kfr, koff, NT, qa, wp, [&](int kbase, float s0, float s1) {
                    const unsigned k0 = okey(s0), k1 = okey(s1);
                    const unsigned b0 = (k0 >> sh) & ((1u << wd) - 1u), b1 = (k1 >> sh) & ((1u << wd) - 1u);
                    const bool in0 = (lev == 0) || ((k0 >> (sh + wd)) == pre0), in1 = (lev == 0) || ((k1 >> (sh + wd)) == pre1);
                    if (in0) __hip_atomic_fetch_add(hist + (2 * hi) * 512 + b0, 1u, __ATOMIC_RELAXED, __HIP_MEMORY_SCOPE_WORKGROUP);
                    if (in1) __hip_atomic_fetch_add(hist + (2 * hi + 1) * 512 + b1, 1u, __ATOMIC_RELAXED, __HIP_MEMORY_SCOPE_WORKGROUP);
                });
#pragma unroll
                for (int ql = 0; ql < 4; ++ql) { unsigned bin, above, bc; scan_hist_cnt(hist + ql * 512, lane, st.need[ql], bin, above, bc);
                    st.pre[ql] = (st.pre[ql] << wd) | bin; st.need[ql] -= above; }
                LDS_WAIT();
            }
            const unsigned T0 = hi ? st.pre[2] : st.pre[0], T1 = hi ? st.pre[3] : st.pre[1], rq0 = hi ? st.need[2] : st.need[0], rq1 = hi ? st.need[3] : st.need[1];
            tile_pass(F, ksrc, kdst, kfr, koff, NT, qa, wp, [&](int kbase, float s0, float s1) {
#pragma unroll
                for (int t = 0; t < 2; ++t) {
                    const unsigned kk = okey(t ? s1 : s0), T = t ? T1 : T0, rq = t ? rq1 : rq0;
                    const bool gt = kk > T, eq = kk == T;
                    const unsigned long long me = __ballot(eq);
                    const unsigned meh = hi ? (unsigned)(me >> 32) : (unsigned)me;
                    const unsigned trank = (hi ? st.tcnt[2 + t] : st.tcnt[t]) + __builtin_popcount(meh & below);
                    const bool take = gt || (eq && trank < rq);
                    const unsigned long long mt = __ballot(take);
                    const unsigned mth = hi ? (unsigned)(mt >> 32) : (unsigned)mt;
                    const unsigned pos = (hi ? st.cnt[2 + t] : st.cnt[t]) + __builtin_popcount(mth & below);
                    if (take && pos < 256u) sel[(2 * hi + t) * 256 + pos] = (unsigned short)(kbase + r);
                    st.cnt[t] += __builtin_popcount((unsigned)mt); st.cnt[2 + t] += __builtin_popcount((unsigned)(mt >> 32));
                    st.tcnt[t] += __builtin_popcount((unsigned)me); st.tcnt[2 + t] += __builtin_popcount((unsigned)(me >> 32));
                }
            });
        }
    }
    LDS_WAIT();
    { const LAS v4u* s4 = (const LAS v4u*)sel; v4u* g4 = (v4u*)(C.SEL + (rowbase + tq0) * 256);
#pragma unroll
      for (int j = 0; j < 2; ++j) g4[j * 64 + lane] = s4[j * 64 + lane]; }
    LDS_WAIT();
}
__device__ __forceinline__ void phase(Frame& F, const Ctx& C) {
    for (int v = F.vcu; v < 256; v += F.G) {
        const int b = v >> 6, c = v & 63;
#pragma unroll 1
        for (int it = 0; it < 4; ++it) step(F, C, b, (it < 2) ? c : 127 - c, it & 1);
    }
}
__device__ __forceinline__ void attn_phase(Frame& F, const Ctx& C) {
    int lane = F.lane; asm volatile("" : "+v"(lane));
    LAS unsigned short* sq = (LAS unsigned short*)(F.lds + RING_OFF + F.wave * 16384);
    const int nx = F.G / 32;
    for (int x = F.vcu / 32; x < 8; x += nx) {
        const int b = x >> 1, g0 = 2 * (x & 1); const long rowbase = (long)b * SEQ;
        const int w = (F.vcu & 31) * NWAVES + F.wave;
#pragma unroll 1
        for (int t = w; t < SEQ; t += 32 * NWAVES) {
            { const v4u* g4 = (const v4u*)(C.SEL + (rowbase + t) * 256); if (lane < 32) ((LAS v4u*)sq)[lane] = g4[lane]; }
            LDS_WAIT();
            const int N = 64 * ((t >> 6) + 1), nvalid = N < 256 ? N : 256;
            attend(C, sq, nvalid, rowbase, rowbase + t, t, lane, g0);
            LDS_WAIT();
        }
    }
}
}

namespace att8 {
typedef int v2i __attribute__((ext_vector_type(2)));
struct Ctx8 { const unsigned char* QA8; const unsigned char* KV8; const unsigned short* SEL; bf16* M; };
constexpr int T2_OFF = KS_OFF, T2_BYTES = 155 * 16 * 4, SELL_OFF = KS_OFF + 10240;
static_assert(T2_BYTES <= 10240 && SELL_OFF + NWAVES * 1024 <= AUX_OFF, "attention LDS map");
__device__ __forceinline__ void mfma8(f32x4& acc, long a, long b) { asm volatile("v_mfma_f32_16x16x32_fp8_fp8 %0, %1, %2, %0" : "+v"(acc) : "v"(a), "v"(b)); }
__device__ __forceinline__ unsigned pk4_fp8(float a, float b, float c, float d) { int r = __builtin_amdgcn_cvt_pk_fp8_f32(a, b, 0, false); r = __builtin_amdgcn_cvt_pk_fp8_f32(c, d, r, true); return (unsigned)r; }

__device__ __forceinline__ void attend8(const Ctx8& C, const LAS unsigned short* sq, LAS unsigned char* vreg, const LAS float* T2, int nvalid, long rowbase, long token, int tpos, int lane, int g0) {
    asm volatile("" : "+v"(lane));
    const int l15 = lane & 15, l4 = lane >> 4, h = l15 & 3;
    const unsigned vbase = (unsigned)(uintptr_t)vreg;
    unsigned cib[16];
#pragma unroll
    for (int ti = 0; ti < 16; ++ti) { const v2u i4 = *(const LAS v2u*)(sq + ti * 16 + 4 * l4);
        const int r0 = (int)(i4.x & 0xffffu) - tpos, r1 = (int)(i4.x >> 16) - tpos, r2 = (int)(i4.y & 0xffffu) - tpos, r3 = (int)(i4.y >> 16) - tpos;
        const int c0 = min(max(r0, -91), 63) + 91, c1 = min(max(r1, -91), 63) + 91, c2 = min(max(r2, -91), 63) + 91, c3 = min(max(r3, -91), 63) + 91;
        cib[ti] = (unsigned)c0 | ((unsigned)c1 << 8) | ((unsigned)c2 << 16) | ((unsigned)c3 << 24); }
    const int trk = 4 * l4 + ((l15 >> 1) & 3), trt = (l15 >> 3) & 1, xs = (l4 & 1) | (trt << 1);
    const int troff = trt * 1024 + trk * 64 + 8 * (l15 & 1);
#pragma unroll 1
    for (int g = g0; g < g0 + 2; ++g) {
        const unsigned char* kvb = C.KV8 + rowbase * 512 + g * 128;
        { const int kq = lane >> 2, p = lane & 3;
#pragma unroll
          for (int ti = 0; ti < 16; ++ti) { const int key = sq[ti * 16 + kq]; const int x = ((kq >> 2) & 1) | ((ti & 1) << 1);
              glds16(kvb + (long)key * 512 + 64 + 16 * (p ^ x), (unsigned)__builtin_amdgcn_readfirstlane(vbase + ti * 1024)); } }
        const v4u qv = *(const v4u*)(C.QA8 + token * 1024 + (4 * g + h) * 64 + 16 * l4);
        const long q0 = (long)(((unsigned long long)qv.y << 32) | qv.x), q1 = (long)(((unsigned long long)qv.w << 32) | qv.z);
        f32x4 S[16];
#pragma unroll
        for (int hh = 0; hh < 2; ++hh) {
            v4u kr[8];
#pragma unroll
            for (int j = 0; j < 8; ++j) kr[j] = *(const v4u*)(kvb + (long)sq[(hh * 8 + j) * 16 + l15] * 512 + 16 * l4);
#pragma unroll
            for (int j = 0; j < 8; ++j) { const int ti = hh * 8 + j; const unsigned cb = cib[ti];
                f32x4 a; a.x = T2[(cb & 255u) * 16 + 4 * g + h]; a.y = T2[((cb >> 8) & 255u) * 16 + 4 * g + h]; a.z = T2[((cb >> 16) & 255u) * 16 + 4 * g + h]; a.w = T2[(cb >> 24) * 16 + 4 * g + h];
                mfma8(a, (long)(((unsigned long long)kr[j].y << 32) | kr[j].x), q0);
                mfma8(a, (long)(((unsigned long long)kr[j].w << 32) | kr[j].z), q1);
                S[ti] = a; }
            asm volatile("s_nop 15\n\ts_nop 7" : "+v"(S[hh * 8]), "+v"(S[hh * 8 + 1]), "+v"(S[hh * 8 + 2]), "+v"(S[hh * 8 + 3]), "+v"(S[hh * 8 + 4]), "+v"(S[hh * 8 + 5]), "+v"(S[hh * 8 + 6]), "+v"(S[hh * 8 + 7]));
        }
#pragma unroll
        for (int ti = 0; ti < 16; ++ti) if (ti * 16 >= nvalid) S[ti] = (f32x4){-INFINITY, -INFINITY, -INFINITY, -INFINITY};
        float mx = S[0].x;
#pragma unroll
        for (int ti = 0; ti < 16; ++ti) mx = fmaxf(fmaxf(mx, fmaxf(S[ti].x, S[ti].y)), fmaxf(S[ti].z, S[ti].w));
        mx = fmaxf(mx, __shfl_xor(mx, 16)); mx = fmaxf(mx, __shfl_xor(mx, 32));
        const float mc = -mx * C2; float ls = 0.f;
        long P8[8];
#pragma unroll
        for (int j = 0; j < 8; ++j) { float e[8];
#pragma unroll
            for (int q = 0; q < 4; ++q) { e[q] = __builtin_amdgcn_exp2f(__builtin_fmaf(S[2 * j][q], C2, mc)); e[4 + q] = __builtin_amdgcn_exp2f(__builtin_fmaf(S[2 * j + 1][q], C2, mc)); }
            ls += ((e[0] + e[1]) + (e[2] + e[3])) + ((e[4] + e[5]) + (e[6] + e[7]));
            const unsigned lo = pk4_fp8(e[0] * 256.f, e[1] * 256.f, e[2] * 256.f, e[3] * 256.f), hi = pk4_fp8(e[4] * 256.f, e[5] * 256.f, e[6] * 256.f, e[7] * 256.f);
            P8[j] = (long)(((unsigned long long)hi << 32) | lo); }
        ls += __shfl_xor(ls, 16); ls += __shfl_xor(ls, 32);
        asm volatile("s_waitcnt vmcnt(0)" ::: "memory");
        f32x4 D[4];
#pragma unroll
        for (int db = 0; db < 4; ++db) D[db] = (f32x4){0.f, 0.f, 0.f, 0.f};
#pragma unroll
        for (int j = 0; j < 8; ++j)
#pragma unroll
            for (int db = 0; db < 4; ++db) {
                const v2i vv = __builtin_amdgcn_ds_read_tr8_b64_v2i32((LAS v2i*)(vreg + j * 2048 + troff + 16 * (db ^ xs)));
                mfma8(D[db], P8[j], __builtin_bit_cast(long, vv)); }
        asm volatile("s_nop 15\n\ts_nop 7" : "+v"(D[0]), "+v"(D[1]), "+v"(D[2]), "+v"(D[3]));
        const float lh = __shfl(ls, l4);
        const float inv = __builtin_amdgcn_rcpf(lh * 256.f);
        bf16* mp = C.M + token * DM + (4 * g + l4) * 64 + l15;
#pragma unroll
        for (int db = 0; db < 4; ++db) { const float v = (l4 == 0) ? D[db].x : (l4 == 1) ? D[db].y : (l4 == 2) ? D[db].z : D[db].w; mp[16 * db] = (bf16)f2bf(v * inv); }
        asm volatile("" ::: "memory");
    }
}
__device__ __forceinline__ void phase(Frame& F, const Ctx8& C, const float* t5) {
    int lane = F.lane; asm volatile("" : "+v"(lane));
    LAS float* T2 = (LAS float*)(F.lds + T2_OFF);
    for (int e = F.tid; e < 155 * 16; e += NWAVES * 64) { const int rel = (e >> 4) - 91, n = rel < 0 ? -rel : rel;
        const int bk = (rel > 0 ? 16 : 0) + (n < 8 ? n : 8 + (n >= 12) + (n >= 16) + (n >= 23) + (n >= 32) + (n >= 46) + (n >= 64) + (n >= 91));
        T2[e] = t5[bk * 16 + (e & 15)] * 8.0f; }
    __syncthreads();
    LAS unsigned short* sq = (LAS unsigned short*)(F.lds + SELL_OFF + F.wave * 1024);
    LAS unsigned char* vreg = F.lds + RING_OFF + F.wave * 16384;
    for (int x = F.vcu / 32; x < 8; x += GRID / 32) {
        const int b = x >> 1, g0 = 2 * (x & 1); const long rowbase = (long)b * SEQ;
        const int w = (F.vcu & 31) * NWAVES + F.wave;
        v4u nxt = (v4u){0u, 0u, 0u, 0u};
        if (lane < 32) nxt = ((const v4u*)(C.SEL + (rowbase + w) * 256))[lane];
        int buf = 0;
#pragma unroll 1
        for (int t = w; t < SEQ; t += 32 * NWAVES) {
            if (lane < 32) ((LAS v4u*)(sq + buf * 256))[lane] = nxt;
            if (t + 32 * NWAVES < SEQ && lane < 32) nxt = ((const v4u*)(C.SEL + (rowbase + t + 32 * NWAVES) * 256))[lane];
            LDS_WAIT();
            const int N = 64 * ((t >> 6) + 1), nvalid = N < 256 ? N : 256;
            attend8(C, sq + buf * 256, vreg, T2, nvalid, rowbase, rowbase + t, t, lane, g0);
            buf ^= 1;
        }
    }
}
}

#ifndef REP_P0
#define REP_P0 1
#endif
#ifndef REP_IN
#define REP_IN 1
#endif
#ifndef REP_DSA
#define REP_DSA 1
#endif
#ifndef REP_BAND
#define REP_BAND 1
#endif
#ifndef REP_UP
#define REP_UP 1
#endif
#ifndef REP_FIX
#define REP_FIX 1
#endif
constexpr int N_PHASES = 1 + 6 * DEPTH;
#ifndef MK_N_LAUNCHES
#define MK_N_LAUNCHES 1
#endif
__global__ void __launch_bounds__(NWAVES * 64, 2) mega_fwd(Args args) {
    extern __shared__ __attribute__((aligned(16))) unsigned char lds[];
    Frame F;
    F.lds = (LAS unsigned char*)lds;
    F.MISC = (volatile LAS unsigned*)(F.lds + MISC_OFF);
    F.tid = threadIdx.x; F.lane = F.tid & 63; F.wave = __builtin_amdgcn_readfirstlane(F.tid >> 6);
    F.G = GRID; { const int bx = blockIdx.x; F.vcu = (bx & 7) * (GRID / 8) + (bx >> 3); }
    unsigned char* ws = args.ws;
    F.ctl = (gu32*)(ws + WS_CTL);
    for (int u = F.tid; u < (LDS_BYTES - LDSCTL_OFF) / 4; u += NWAVES * 64) ((LAS unsigned*)(F.lds + LDSCTL_OFF))[u] = 0u;
    __syncthreads();
    XcdBarrier bar; bar.bar = (unsigned*)(F.ctl + CW_BAR); bar.x = 0; bar.st = nullptr;
    if (MK_N_LAUNCHES == 1) bar = xcd_barrier_post((unsigned*)(F.ctl + CW_BAR), F.MISC + 8);
    const int lo = args.ph_lo, hi = args.ph_hi;
#define IN(k) (lo <= (k) && (k) < hi)
#define OPQ_FRAME(Fl) Frame Fl = F; { int l_; asm volatile("v_mbcnt_lo_u32_b32 %0, -1, 0\n\tv_mbcnt_hi_u32_b32 %0, -1, %0" : "=v"(l_)); int w_ = F.wave; asm volatile("" : "+s"(w_)); Fl.wave = w_; Fl.lane = l_; Fl.tid = w_ * 64 + l_; }
#define SEAM(k) do { if (IN(k) && IN((k) + 1)) xcd_barrier(bar); } while (0)

    bf16* hb = (bf16*)(ws + WS_HB); bf16* mb = (bf16*)(ws + WS_M); float* ss = (float*)(ws + WS_SS); float* halo = (float*)(ws + WS_HALO);
    unsigned char* proj = ws + WS_PROJ; bf16* act = (bf16*)(ws + WS_PROJ);

#ifndef SKIP_P0
    if (IN(0)) { for (int rep = 0; rep < REP_P0; ++rep) { OPQ_FRAME(F0); p0_prologue(F0, args); } }
#endif
    SEAM(0);

#pragma unroll 1
    for (int L = 0; L < DEPTH; ++L) {
        const int pb = 1 + 6 * L, li = L >> 1; const bool isB = (L & 1) != 0;
        if (IN(pb)) {
#ifndef SKIP_IN
            for (int rep = 0; rep < REP_IN; ++rep)
            if (!isB) {
                pg8::Gemm g{hb, (const bf16*)(ws + WS_W_INA) + (size_t)li * NA_PAD * DM, MTOK, NA_PAD, DM}; pg8::StaticOrder S; S.init(MTOK, NA_PAD, F.G, (int)blockIdx.x);
                EpiIn E{ss, proj, args.q_norm_g + L * 64, args.k_norm_g + L * 64, 0};
                pg8::gemm_phase<EpiIn, pg8::StaticOrder, true, true>(F.lds + RING_OFF, g, S, E, F.wave);
            } else {
                pg8::Gemm g{hb, (const bf16*)(ws + WS_W_INB) + (size_t)li * NB * DM, MTOK, NB, DM}; pg8::StaticOrder S; S.init(MTOK, NB, F.G, (int)blockIdx.x);
                EpiIn E{ss, proj, args.q_norm_g + L * 64, args.k_norm_g + L * 64, 1};
                pg8::gemm_phase<EpiIn, pg8::StaticOrder, true, true>(F.lds + RING_OFF, g, S, E, F.wave);
            }
#endif
        }
        SEAM(pb);
#if defined(DBG_NODSA) || defined(DBG_NOBAND)
#ifdef DBG_NODSA
        const bool zero_m = !isB;
#else
        const bool zero_m = isB;
#endif
        if (IN(pb + 1) && zero_m) { for (size_t i = (size_t)blockIdx.x * 512 + threadIdx.x; i < (size_t)MTOK * DM / 8; i += (size_t)gridDim.x * 512) ((v4u*)mb)[i] = (v4u){0u, 0u, 0u, 0u}; }
        if (IN(pb + 1) && !zero_m) {
#else
        if (IN(pb + 1)) {
#endif
#ifndef SKIP_DSA
            if (!isB) {
                LAS float* t5l = (LAS float*)(F.lds + AUX_OFF);
                { OPQ_FRAME(Ft); for (int i = Ft.tid; i < 512; i += NWAVES * 64) t5l[i] = args.t5_bias[i] * LOG2E; }
                __syncthreads();
                dsa::Ctx C{(const bf16*)(proj + PA_QA), (const bf16*)(proj + PA_KA), (const bf16*)(proj + PA_VA), (const bf16*)(proj + PA_QI), (const bf16*)(proj + PA_KI), (const float*)(proj + PA_WI), mb, t5l, (unsigned short*)(proj + PA_SEL)};
#ifdef DBG_DSACOPY
                { int t_ = threadIdx.x; asm volatile("" : "+v"(t_));
                for (unsigned i = blockIdx.x * 512u + (unsigned)t_; i < (unsigned)MTOK * DM; i += gridDim.x * 512u) { const unsigned t = i >> 10, c = i & 1023u;
                    float v = bf_lo(C.QA[i]); v += bf_lo(C.KA[t * 256 + (c & 255)]); v += bf_lo(C.VA[t * 256 + (c & 255)]); v += bf_lo(C.QI[t * 512 + (c & 511)]); v += bf_lo(C.KI[t * 64 + (c & 63)]); v += C.WI[t * 8 + (c & 7)];
                    mb[i] = (bf16)f2bf(v * 0.01f); asm volatile("" ::: "memory"); } }
#else
                for (int rep = 0; rep < REP_DSA; ++rep) { OPQ_FRAME(F1); dsa::phase(F1, C); }
                xcd_barrier(bar);
                { OPQ_FRAME(F1b); att8::Ctx8 C8{(const unsigned char*)(proj + PA_QA), (const unsigned char*)(proj + PA_KA), (const unsigned short*)(proj + PA_SEL), mb};
#ifndef REP_ATT8
#define REP_ATT8 1
#endif
                  for (int rep = 0; rep < REP_ATT8; ++rep) { att8::phase(F1b, C8, args.t5_bias); __syncthreads(); } }
#endif
            }
#endif
#ifndef SKIP_BAND
            if (isB) {
                for (int rep = 0; rep < REP_BAND; ++rep) { OPQ_FRAME(F2); band::phase(F2, (const bf16*)proj, (const bf16*)(proj + PB_STRIDE), (const bf16*)(proj + 2 * PB_STRIDE), mb, args.rel_bias_b + (size_t)li * 513 * 16); }
            }
#endif
        }
        SEAM(pb + 1);
        if (IN(pb + 2)) {
#ifndef SKIP_OUT
            pg8::Gemm g{mb, (const bf16*)(ws + WS_W_OUT) + (size_t)L * DM * DM, MTOK, DM, DM}; pg8::StaticOrder S; S.init(MTOK, DM, F.G, (int)blockIdx.x);
#ifdef REP_OUT
            { EpiRes E0{L == 0 ? args.x : nullptr, nullptr, hb, (bf16*)proj, halo}; pg8::gemm_phase<EpiRes, pg8::StaticOrder, true, true>(F.lds + RING_OFF, g, S, E0, F.wave); }
#endif
            EpiRes E{L == 0 ? args.x : nullptr, nullptr, hb, hb, ss};
            pg8::gemm_phase<EpiRes, pg8::StaticOrder, true, true>(F.lds + RING_OFF, g, S, E, F.wave);
#endif
        }
        SEAM(pb + 2);
        if (IN(pb + 3)) {
#ifndef SKIP_UP
            for (int rep = 0; rep < REP_UP; ++rep) {
            pg8::Gemm g{hb, (const bf16*)(ws + WS_W_UP) + (size_t)L * NUP * DM, MTOK, NUP, DM}; pg8::StaticOrder S; S.init(MTOK, NUP, F.G, (int)blockIdx.x);
            EpiUp E{ss, args.conv_w + (size_t)L * 3 * NUP, args.conv_b + (size_t)L * NUP, act, halo};
            pg8::gemm_phase<EpiUp, pg8::StaticOrder, true, true>(F.lds + RING_OFF, g, S, E, F.wave); }
#endif
        }
        SEAM(pb + 3);
#ifndef SKIP_FIX
        if (IN(pb + 4)) for (int rep = 0; rep < REP_FIX; ++rep) { OPQ_FRAME(F3); fixup_phase(F3, args.conv_w + (size_t)L * 3 * NUP, args.conv_b + (size_t)L * NUP, halo, act); }
#endif
        SEAM(pb + 4);
        if (IN(pb + 5)) {
#ifndef SKIP_DN
            pg8::Gemm g{act, (const bf16*)(ws + WS_W_DN) + (size_t)L * DM * FF, MTOK, DM, FF}; pg8::StaticOrder S; S.init(MTOK, DM, F.G, (int)blockIdx.x);
#ifdef REP_DN
            { EpiRes E0{nullptr, nullptr, hb, mb, halo}; pg8::gemm_phase<EpiRes, pg8::StaticOrder, true, true>(F.lds + RING_OFF, g, S, E0, F.wave); }
#endif
            EpiRes E{nullptr, L == DEPTH - 1 ? args.out : nullptr, hb, hb, ss};
            pg8::gemm_phase<EpiRes, pg8::StaticOrder, true, true>(F.lds + RING_OFF, g, S, E, F.wave);
#endif
        }
        SEAM(pb + 5);
    }
#undef IN
#undef SEAM
}

extern "C" void kernel_launch(void* const* d_in, const int* in_sizes, int n_in, void* d_out, int out_size, void* d_ws, size_t ws_size, hipStream_t stream) {
    static int grid = 0;
    if (grid == 0) {
        if (n_in != 14 || in_sizes[0] != MTOK * DM || out_size != MTOK * DM || ws_size < WS_END) { fprintf(stderr, "kernel_launch: unexpected shapes / workspace (n_in %d, ws %zu); nothing launched\n", n_in, ws_size); grid = -1; return; }
        int dev = 0, cus = 0, per_cu = 0;
        if (hipGetDevice(&dev) != hipSuccess || hipDeviceGetAttribute(&cus, hipDeviceAttributeMultiprocessorCount, dev) != hipSuccess) { grid = -1; return; }
        if (hipFuncSetAttribute((const void*)mega_fwd, hipFuncAttributeMaxDynamicSharedMemorySize, LDS_BYTES) != hipSuccess) { fprintf(stderr, "kernel_launch: hipFuncSetAttribute failed\n"); grid = -1; return; }
        if (hipOccupancyMaxActiveBlocksPerMultiprocessor(&per_cu, (const void*)mega_fwd, NWAVES * 64, LDS_BYTES) != hipSuccess || per_cu < 1) { fprintf(stderr, "kernel_launch: occupancy query reports %d blocks per CU\n", per_cu); }
        (void)hipGetLastError();
        if (cus != GRID) { fprintf(stderr, "kernel_launch: built for a %d-CU device, found %d; nothing launched\n", GRID, cus); grid = -1; return; }
        grid = GRID;
    }
    if (grid < 0) return;
    if (hipMemsetAsync((char*)d_ws + WS_CTL, 0, CTL_ZERO_BYTES, stream) != hipSuccess) return;
    Args a{};
    a.x = (const float*)d_in[0]; a.attn_norm_g = (const float*)d_in[1]; a.w_in_a = (const float*)d_in[2]; a.w_in_b = (const float*)d_in[3]; a.q_norm_g = (const float*)d_in[4];
    a.k_norm_g = (const float*)d_in[5]; a.t5_bias = (const float*)d_in[6]; a.rel_bias_b = (const float*)d_in[7]; a.w_out = (const float*)d_in[8]; a.ffn_norm_g = (const float*)d_in[9];
    a.w_up = (const float*)d_in[10]; a.conv_w = (const float*)d_in[11]; a.conv_b = (const float*)d_in[12]; a.w_down = (const float*)d_in[13];
    a.out = (float*)d_out; a.ws = (unsigned char*)d_ws; a.pad = 0;
#if MK_N_LAUNCHES == 1
    a.ph_lo = 0; a.ph_hi = N_PHASES; a.li = 0;
    hipLaunchKernelGGL(mega_fwd, dim3(grid), dim3(NWAVES * 64), LDS_BYTES, stream, a);
#else
    for (int p = 0; p < N_PHASES; ++p) { a.ph_lo = p; a.ph_hi = p + 1; a.li = p; hipLaunchKernelGGL(mega_fwd, dim3(grid), dim3(NWAVES * 64), LDS_BYTES, stream, a); }
#endif
}
```

```cpp
#include <hip/hip_runtime.h>
#include <cstdio>
#include <cstdint>
namespace pg8 {
#define PG8_LAS __attribute__((address_space(3)))
typedef unsigned short bf16_t;
typedef short bf16x8 __attribute__((ext_vector_type(8)));
typedef float f32x4 __attribute__((ext_vector_type(4)));
typedef unsigned u32x4 __attribute__((ext_vector_type(4)));
constexpr int BM = 256, BK = 64, HALF = 128, HTB = HALF * BK * 2  , STAGE_BYTES = 8 * HTB, NXCD = 8, WGM = 8;

__host__ __device__ __forceinline__ int lds_byte(int r, int c) { const int st = (r >> 4) * 2 + (c >> 5), rr = r & 15, cc = c & 31, ob = rr * 64 + cc * 2; return st * 1024 + (ob ^ (((ob >> 9) & 1) << 5)); }
__host__ __device__ __forceinline__ void stage_rc(int b, int& R, int& C) { const int st = b / 1024, sb = b % 1024, swz = sb ^ (((sb >> 9) & 1) << 5); R = (st >> 1) * 16 + swz / 64; C = (st & 1) * 32 + (swz % 64) / 2; }
__host__ __device__ __forceinline__ int perm32(int rho) { const int n = rho >> 4, i = rho & 15; return 8 * (i >> 2) + 4 * n + (i & 3); }

struct Unit { int pm, pn; };
struct Gemm { const bf16_t* A; const bf16_t* Bt; int M, N, K; };

struct StaticOrder {
    int nM, nN, nwg, G, c;
    __host__ __device__ void init(int M, int N, int G_, int c_) { nM = M / BM; nN = N / BM; nwg = nM * nN; G = G_; c = c_; }
    __host__ __device__ bool next(int i, Unit& u) const {
        const long L = (long)i * G + c; if (L >= nwg) return false;
        int wgid = (int)L; { const int q = nwg / NXCD, r = nwg % NXCD, xcd = wgid % NXCD, off = wgid / NXCD; wgid = (xcd < r ? xcd * (q + 1) : r * (q + 1) + (xcd - r) * q) + off; }
        const int nig = WGM * nN, gid = wgid / nig, fm = gid * WGM, gsz = (nM - fm) < WGM ? (nM - fm) : WGM;
        u.pm = fm + ((wgid % nig) % gsz); u.pn = (wgid % nig) / gsz; return true;
    }
    __device__ __forceinline__ void a_ready(const Unit&) const {}
    __device__ __forceinline__ void done(const Unit&) const {}
};
__device__ __forceinline__ unsigned cvt_pk_bf16(float lo, float hi) { unsigned r; asm volatile("v_cvt_pk_bf16_f32 %0, %1, %2" : "=v"(r) : "v"(lo), "v"(hi)); return r; }
template <class Epi, class Sched, bool ALIGN_EPI = false, bool SP2 = false>
__device__ __forceinline__ void gemm_phase(PG8_LAS unsigned char* lds, const Gemm g, const Sched& S, const Epi& E, const int wave_id) {
    int lane_; asm volatile("v_mbcnt_lo_u32_b32 %0, -1, 0\n\tv_mbcnt_hi_u32_b32 %0, -1, %0" : "=v"(lane_));
    int wid_ = wave_id; asm volatile("" : "+s"(wid_));
    const int wid = wid_, lane = lane_, tid = wid * 64 + lane, wr = wid >> 2, wc = wid & 3, fr = lane & 15, fq = lane >> 4;
    const int K = g.K, nt = K / BK;
    unsigned voffA[2], voffB[2];
#pragma unroll
    for (int i = 0; i < 2; ++i) { int R, C; stage_rc(tid * 16 + i * 8192, R, C); const int Rb = Epi::PERM ? ((R & ~31) + perm32(R & 31)) : R;
        const int Ra = Epi::PERMA ? ((R & ~63) | (4 * (R & 15) + ((R >> 4) & 3))) : R;
        voffA[i] = (unsigned)(Ra * K + C) * 2u; voffB[i] = (unsigned)(Rb * K + C) * 2u; }
    const size_t kstep = (size_t)(BK * 2);
    const size_t hstep = (size_t)HALF * K * 2;
    const size_t tstep = 2 * hstep;
    const unsigned ldsw = (unsigned)wid * 1024u;
    const int aoff = lds_byte(wr * 64 + fr, fq * 8), boff = lds_byte(wc * 32 + fr, fq * 8);
#define PG8_SA(b, h) (((b) * 2 + (h)) * HTB)
#define PG8_SB(b, h) ((4 + (b) * 2 + (h)) * HTB)
#define PG8_STAGE(bufoff, gbase, voff) do { _Pragma("unroll") for (int _i = 0; _i < 2; ++_i) \
        __builtin_amdgcn_global_load_lds((const unsigned*)((const char*)(gbase) + (voff)[_i]), (PG8_LAS unsigned*)(lds + (bufoff) + ldsw + _i * 8192), 16, 0, 0); } while (0)
#define PG8_LDA(dst, b, h) do { _Pragma("unroll") for (int m = 0; m < 4; ++m) _Pragma("unroll") for (int k = 0; k < 2; ++k) dst[m][k] = *(const PG8_LAS bf16x8*)(lds + PG8_SA(b, h) + aoff + m * 2048 + k * 1024); } while (0)
#define PG8_LDB(dst, b, h) do { _Pragma("unroll") for (int n = 0; n < 2; ++n) _Pragma("unroll") for (int k = 0; k < 2; ++k) dst[n][k] = *(const PG8_LAS bf16x8*)(lds + PG8_SB(b, h) + boff + n * 2048 + k * 1024); } while (0)
#define PG8_MMA(ai, bj, At, Bt) do { __builtin_amdgcn_s_setprio(1); _Pragma("unroll") for (int m = 0; m < 4; ++m) _Pragma("unroll") for (int n = 0; n < 2; ++n) _Pragma("unroll") for (int k = 0; k < 2; ++k) \
        acc[ai][bj][m][n] = __builtin_amdgcn_mfma_f32_16x16x32_bf16(Bt[n][k], At[m][k], acc[ai][bj][m][n], 0, 0, 0); __builtin_amdgcn_s_setprio(0); } while (0)
#define PG8_WAIT_V(n) asm volatile("s_waitcnt vmcnt(" #n ")" ::: "memory")
#define PG8_WAIT_L(n) asm volatile("s_waitcnt lgkmcnt(" #n ")" ::: "memory")
#define PG8_BAR __builtin_amdgcn_s_barrier()
#define PG8_SCHED __builtin_amdgcn_sched_barrier(0)
    Unit cur, nxt; int ui = 0;
    if (!S.next(0, cur)) return;
    f32x4 acc[2][2][4][2];
#pragma unroll
    for (int a = 0; a < 2; ++a)
#pragma unroll
        for (int b = 0; b < 2; ++b)
#pragma unroll
            for (int m = 0; m < 4; ++m)
#pragma unroll
                for (int n = 0; n < 2; ++n) acc[a][b][m][n] = (f32x4){0.f, 0.f, 0.f, 0.f};
    bf16x8 At[4][2], B0[2][2], B1[2][2];
    const char* cA = (const char*)g.A + (size_t)cur.pm * tstep; const char* cB = (const char*)g.Bt + (size_t)cur.pn * tstep;
    S.a_ready(cur);
    if constexpr (SP2) {
        PG8_STAGE(PG8_SB(0, 0), cB, voffB); PG8_STAGE(PG8_SB(0, 1), cB + hstep, voffB); PG8_STAGE(PG8_SA(0, 0), cA, voffA); PG8_STAGE(PG8_SA(0, 1), cA + hstep, voffA);
        if (wr == 1) PG8_BAR;
        PG8_WAIT_V(2); PG8_BAR;
        PG8_STAGE(PG8_SB(1, 0), cB + kstep, voffB); PG8_STAGE(PG8_SA(1, 0), cA + kstep, voffA); PG8_STAGE(PG8_SB(1, 1), cB + hstep + kstep, voffB);
        PG8_WAIT_V(6); PG8_BAR;
    } else {
        PG8_STAGE(PG8_SB(0, 0), cB, voffB); PG8_STAGE(PG8_SA(0, 0), cA, voffA); PG8_STAGE(PG8_SB(0, 1), cB + hstep, voffB); PG8_STAGE(PG8_SA(0, 1), cA + hstep, voffA);
        if (wr == 1) PG8_BAR;
        PG8_WAIT_V(4); PG8_BAR;
        PG8_STAGE(PG8_SB(1, 0), cB + kstep, voffB); PG8_STAGE(PG8_SA(1, 0), cA + kstep, voffA); PG8_STAGE(PG8_SB(1, 1), cB + hstep + kstep, voffB);
        PG8_WAIT_V(6); PG8_BAR;
    }
    for (;;) {
        const bool has_next = S.next(ui + 1, nxt);
        const char* nA = has_next ? (const char*)g.A + (size_t)nxt.pm * tstep : cA; const char* nB = has_next ? (const char*)g.Bt + (size_t)nxt.pn * tstep : cB;
        for (int t = 0; t < nt; t += 2) {
            const bool last = (t == nt - 2);
            const char* a1 = cA + (size_t)(t + 1) * kstep;
            const char* a2 = last ? nA : cA + (size_t)(t + 2) * kstep; const char* b2 = last ? nB : cB + (size_t)(t + 2) * kstep;
            const char* a3 = a2 + kstep; const char* b3 = b2 + kstep;
            if (last && has_next) S.a_ready(nxt);
            if constexpr (SP2) {
            PG8_LDB(B0, 0, 0); PG8_LDB(B1, 0, 1); PG8_SCHED; PG8_LDA(At, 0, 0); PG8_STAGE(PG8_SA(1, 1), a1 + hstep, voffA);
            PG8_WAIT_V(8); PG8_WAIT_L(0); PG8_BAR; PG8_MMA(0, 0, At, B0); PG8_MMA(0, 1, At, B1); PG8_BAR; PG8_SCHED;
            PG8_LDA(At, 0, 1); PG8_STAGE(PG8_SB(0, 0), b2, voffB); PG8_STAGE(PG8_SB(0, 1), b2 + hstep, voffB); PG8_STAGE(PG8_SA(0, 0), a2, voffA);
            PG8_WAIT_V(8); PG8_WAIT_L(0); PG8_BAR; PG8_MMA(1, 0, At, B0); PG8_MMA(1, 1, At, B1); PG8_BAR; PG8_SCHED;
            PG8_LDB(B0, 1, 0); PG8_LDB(B1, 1, 1); PG8_SCHED; PG8_LDA(At, 1, 0); PG8_STAGE(PG8_SA(0, 1), a2 + hstep, voffA);
            PG8_WAIT_V(8); PG8_WAIT_L(0); PG8_BAR; PG8_MMA(0, 0, At, B0); PG8_MMA(0, 1, At, B1); PG8_BAR; PG8_SCHED;
            PG8_LDA(At, 1, 1); PG8_STAGE(PG8_SB(1, 0), b3, voffB); PG8_STAGE(PG8_SB(1, 1), b3 + hstep, voffB); PG8_STAGE(PG8_SA(1, 0), a3, voffA);
            PG8_WAIT_V(8); PG8_WAIT_L(0); PG8_BAR; PG8_MMA(1, 0, At, B0); PG8_MMA(1, 1, At, B1); PG8_BAR; PG8_SCHED;
            } else {
            PG8_LDB(B0, 0, 0); PG8_SCHED; PG8_LDA(At, 0, 0); PG8_STAGE(PG8_SA(1, 1), a1 + hstep, voffA);
            PG8_WAIT_L(8); PG8_BAR; PG8_WAIT_L(0); PG8_MMA(0, 0, At, B0); PG8_BAR; PG8_SCHED;
            PG8_LDB(B1, 0, 1); PG8_STAGE(PG8_SB(0, 0), b2, voffB);
            PG8_BAR; PG8_WAIT_L(0); PG8_MMA(0, 1, At, B1); PG8_BAR;
            PG8_LDA(At, 0, 1); PG8_STAGE(PG8_SA(0, 0), a2, voffA);
            PG8_BAR; PG8_WAIT_L(0); PG8_MMA(1, 0, At, B0); PG8_BAR; PG8_SCHED;
            PG8_STAGE(PG8_SB(0, 1), b2 + hstep, voffB);
            PG8_WAIT_V(6); PG8_BAR; PG8_MMA(1, 1, At, B1); PG8_BAR;
            PG8_LDB(B0, 1, 0); PG8_SCHED; PG8_LDA(At, 1, 0); PG8_STAGE(PG8_SA(0, 1), a2 + hstep, voffA);
            PG8_WAIT_L(8); PG8_BAR; PG8_WAIT_L(0); PG8_MMA(0, 0, At, B0); PG8_BAR; PG8_SCHED;
            PG8_LDB(B1, 1, 1); PG8_STAGE(PG8_SB(1, 0), b3, voffB);
            PG8_BAR; PG8_WAIT_L(0); PG8_MMA(0, 1, At, B1); PG8_BAR;
            PG8_LDA(At, 1, 1); PG8_STAGE(PG8_SA(1, 0), a3, voffA);
            PG8_BAR; PG8_WAIT_L(0); PG8_MMA(1, 0, At, B0); PG8_BAR; PG8_SCHED;
            PG8_STAGE(PG8_SB(1, 1), b3 + hstep, voffB);
            PG8_WAIT_V(6); PG8_BAR; PG8_MMA(1, 1, At, B1); PG8_BAR;
            }
        }
        if constexpr (ALIGN_EPI) { if (wr == 0) PG8_BAR; }
        if constexpr (!Epi::AFTER_DRAIN) { E(acc, cur, wr, wc, fr, fq); S.done(cur); }
        if (!has_next) break;
#pragma unroll
        for (int a = 0; a < 2; ++a)
#pragma unroll
            for (int b = 0; b < 2; ++b)
#pragma unroll
                for (int m = 0; m < 4; ++m)
#pragma unroll
                    for (int n = 0; n < 2; ++n) acc[a][b][m][n] = (f32x4){0.f, 0.f, 0.f, 0.f};
        cur = nxt; cA = nA; cB = nB; ++ui;
        if constexpr (ALIGN_EPI) { if (wr == 1) PG8_BAR; }
    }
    PG8_WAIT_V(0);
    if constexpr (!ALIGN_EPI) { if (wr == 0) PG8_BAR; }
    PG8_BAR;
    if constexpr (Epi::AFTER_DRAIN) { E.fused(acc, cur, wr, wc, fr, fq, lds, wid, lane); S.done(cur); }
#undef PG8_SA
#undef PG8_SB
#undef PG8_STAGE
#undef PG8_LDA
#undef PG8_LDB
#undef PG8_MMA
#undef PG8_WAIT_V
#undef PG8_WAIT_L
#undef PG8_BAR
#undef PG8_SCHED
}
}

constexpr int NWAVES = 8, GRID = 256;
constexpr int BATCH = 4, SEQ = 8192, DM = 1024, MTOK = BATCH * SEQ, DEPTH = 4;
constexpr int NA_SRC = 2120, NA_PAD = 2304, NB = 3072, FF = 2816, NUP = 2 * FF;
constexpr float EPS = 1e-6f;
constexpr float LOG2E = 1.4426950408889634f;
constexpr float C2 = 0.125f * LOG2E;
constexpr int NBLK64 = MTOK / 64;

constexpr size_t MiB = 1u << 20;
constexpr size_t WS_CTL = 0, CTL_ZERO_BYTES = 1 * MiB;
constexpr size_t WS_W_INA = 2 * MiB;
constexpr size_t WS_W_INB = 11 * MiB;
constexpr size_t WS_W_OUT = 23 * MiB;
constexpr size_t WS_W_UP = 31 * MiB;
constexpr size_t WS_W_DN = 75 * MiB;
constexpr size_t WS_HB = 98 * MiB;
constexpr size_t WS_M = 162 * MiB;
constexpr size_t WS_SS = 226 * MiB;
constexpr size_t WS_HALO = 228 * MiB;
constexpr size_t WS_PROJ = 272 * MiB;
constexpr size_t WS_END = 464 * MiB;
constexpr size_t PA_QA = 0, PA_KA = 64 * MiB, PA_VA = 80 * MiB, PA_QI = 96 * MiB, PA_KI = 128 * MiB, PA_WI = 132 * MiB, PA_SEL = 136 * MiB;
constexpr size_t PB_STRIDE = 64 * MiB;
constexpr int CW_BAR = 4096;

constexpr int RING_OFF = 0, RING_BYTES = 131072;
constexpr int KS_OFF = RING_BYTES;
constexpr int AUX_OFF = RING_BYTES + 24576;
constexpr int LDSCTL_OFF = AUX_OFF + 4096, MISC_OFF = LDSCTL_OFF + 320;
constexpr int LDS_BYTES = 163840;
static_assert(MISC_OFF + 128 <= LDS_BYTES, "LDS map");

#define GAS __attribute__((address_space(1)))
#define LAS __attribute__((address_space(3)))
typedef unsigned short bf16;
typedef unsigned v4u __attribute__((ext_vector_type(4)));
typedef unsigned v2u __attribute__((ext_vector_type(2)));
typedef float f32x4 __attribute__((ext_vector_type(4)));
typedef float f32x16 __attribute__((ext_vector_type(16)));
typedef short bf16x8 __attribute__((ext_vector_type(8)));
typedef short s16x4 __attribute__((ext_vector_type(4)));
typedef float f32x2_t __attribute__((ext_vector_type(2)));
typedef GAS unsigned gu32;
#define RLX_AGENT __ATOMIC_RELAXED, __HIP_MEMORY_SCOPE_AGENT
#define LDS_WAIT() asm volatile("s_waitcnt lgkmcnt(0)" ::: "memory")
#define VM_WAIT() asm volatile("s_waitcnt vmcnt(0)" ::: "memory")
__device__ __forceinline__ unsigned f2bf(float f) { unsigned u = __builtin_bit_cast(unsigned, f); return (u + 0x7fffu + ((u >> 16) & 1u)) >> 16; }
__device__ __forceinline__ unsigned pk2(float lo, float hi) { return f2bf(lo) | (f2bf(hi) << 16); }
typedef float f32x2c_t __attribute__((ext_vector_type(2))); typedef __bf16 bf16x2c_t __attribute__((ext_vector_type(2)));
__device__ __forceinline__ unsigned cvtpk(float lo, float hi) { const f32x2c_t v = {lo, hi}; const bf16x2c_t b = __builtin_convertvector(v, bf16x2c_t); return __builtin_bit_cast(unsigned, b); }
__device__ __forceinline__ float bf_lo(unsigned u) { return __builtin_bit_cast(float, u << 16); }
__device__ __forceinline__ float bf_hi(unsigned u) { return __builtin_bit_cast(float, u & 0xffff0000u); }

#define XB_TMO      128
#define XB_XCNT(j)  (256  + 64 * (j))
#define XB_XSUB(j)  (1280 + 64 * (j))
#define XB_XGEN(j)  (2304 + 64 * (j))
#define XB_TOP      3328
#define XB_TOPGEN   3392
#define XCD_BAR_WORDS 3456
#define XB_SPIN_CAP (1u << 18)

__device__ __forceinline__ unsigned xb_ld(unsigned* p)              { return __hip_atomic_load(p, __ATOMIC_RELAXED, __HIP_MEMORY_SCOPE_AGENT); }
__device__ __forceinline__ unsigned xb_add(unsigned* p, unsigned v) { return __hip_atomic_fetch_add(p, v, __ATOMIC_RELAXED, __HIP_MEMORY_SCOPE_AGENT); }
__device__ __forceinline__ unsigned xb_xcc_id() { return (unsigned)__builtin_amdgcn_s_getreg((3 << 11) | 20) & 0xFu; }
#define XB_SPIN(cond, bar) do { unsigned _sp = 0; while (cond) { __builtin_amdgcn_s_sleep(1); \
    if ((++_sp & 255u) == 0u) { if (xb_ld(&(bar)[XB_TMO])) break; if (_sp > XB_SPIN_CAP) { atomicAdd(&(bar)[XB_TMO], 1u); break; } } } } while (0)

struct XcdBarrier {
    unsigned* bar; unsigned x;
    volatile LAS unsigned* st;
};

__device__ __forceinline__ XcdBarrier xcd_barrier_post(unsigned* bar, volatile LAS unsigned* st) {
    XcdBarrier b; b.bar = bar; b.x = xb_xcc_id(); b.st = st;
    if (threadIdx.x == 0) (void)xb_add(&bar[XB_XCNT(b.x)], 1u);
    return b;
}
__device__ __forceinline__ void xcd_barrier_complete(unsigned* bar, unsigned x, unsigned& nloc, unsigned& nx) {
    const unsigned G = gridDim.x * gridDim.y * gridDim.z;
    unsigned sum, cnt, mine, sp = 0u;
    for (;;) {
        sum = 0u; cnt = 0u; mine = 0u;
#pragma unroll
        for (unsigned j = 0; j < 16; ++j) { const unsigned c = xb_ld(&bar[XB_XCNT(j)]); sum += c; cnt += (c > 0u) ? 1u : 0u; mine = (j == x) ? c : mine; }
        if (sum == G) break;
        __builtin_amdgcn_s_sleep(1);
        if ((++sp & 255u) == 0u) { if (xb_ld(&bar[XB_TMO])) break; if (sp > XB_SPIN_CAP) { atomicAdd(&bar[XB_TMO], 1u); break; } }
    }
    nloc = mine > 0u ? mine : 1u; nx = cnt > 0u ? cnt : 1u;
}

__device__ __forceinline__ void xcd_barrier(const XcdBarrier& b) {
    asm volatile("s_waitcnt vmcnt(0)" ::: "memory");
    __syncthreads();
    if (threadIdx.x == 0) {
        unsigned* bar = b.bar;
        __builtin_amdgcn_s_waitcnt(0);
        unsigned nloc = b.st[0], nx = b.st[1];
        if (nloc == 0u) { xcd_barrier_complete(bar, b.x, nloc, nx); b.st[0] = nloc; b.st[1] = nx; }
        const unsigned old = xb_add(&bar[XB_XSUB(b.x)], 1u);
        const unsigned gen = old / nloc;
        if (old + 1u == (gen + 1u) * nloc) {
            __builtin_amdgcn_fence(__ATOMIC_RELEASE, "agent");
            asm volatile("s_waitcnt vmcnt(0)" ::: "memory");
            const unsigned og = xb_add(&bar[XB_TOP], 1u);
            const unsigned tg = og / nx;
            if (og + 1u == (tg + 1u) * nx) xb_add(&bar[XB_TOPGEN], 1u);
            else XB_SPIN(xb_ld(&bar[XB_TOPGEN]) == tg, bar);
            __builtin_amdgcn_fence(__ATOMIC_ACQUIRE, "agent");
            xb_add(&bar[XB_XGEN(b.x)], 1u);
            asm volatile("s_waitcnt vmcnt(0)" ::: "memory");
        } else {
            XB_SPIN(xb_ld(&bar[XB_XGEN(b.x)]) == gen, bar);
            __builtin_amdgcn_fence(__ATOMIC_ACQUIRE, "agent");
            asm volatile("s_waitcnt vmcnt(0)" ::: "memory");
        }
    }
    __syncthreads();
}


struct Args {
    const float* x; const float* attn_norm_g; const float* w_in_a; const float* w_in_b; const float* q_norm_g; const float* k_norm_g; const float* t5_bias;
    const float* rel_bias_b; const float* w_out; const float* ffn_norm_g; const float* w_up; const float* conv_w; const float* conv_b; const float* w_down;
    float* out; unsigned char* ws; int ph_lo, ph_hi, li, pad;
};

struct Frame {
    LAS unsigned char* lds;
    volatile LAS unsigned* MISC;
    gu32* ctl;
    int tid, lane, wave, vcu, G;
};

__host__ __device__ __forceinline__ int hmap(int p) { return 64 * ((p >> 5) & 3) + 16 * ((p >> 2) & 3) + 8 * (p >> 7) + 4 * ((p >> 4) & 1) + (p & 3); }
__host__ __device__ __forceinline__ int umap(int p) { return 32 * ((p >> 5) & 3) + 8 * ((p >> 2) & 3) + 4 * ((p >> 4) & 1) + (p & 3); }
__host__ __device__ __forceinline__ int src_col(int type, int n) {
    if (type == 0) return n;
    const int pn = n >> 8, p = n & 255;
    if (type == 2) return 256 * pn + hmap(p);
    if (type == 1) { const int c = hmap(p); return pn < 8 ? 256 * pn + c : (c < 72 ? 2048 + c : -1); }
    return (p >> 7) * FF + 128 * pn + umap(p);
}
__device__ __forceinline__ void convert_item(const float* W, int K, int Nsrc, int Ndst, int type, const float* gain, bf16* WT, LAS float* scr, int item, int lane) {
    const int nblk = Ndst / 32, kb = item / nblk, nb = item % nblk, k0 = 64 * kb, n0 = 32 * nb;
    const int sc = src_col(type, n0 + (lane & 31));
#pragma unroll 8
    for (int i = 0; i < 32; ++i) { const int kk = 2 * i + (lane >> 5); float v = 0.f; if (sc >= 0) v = W[(size_t)(k0 + kk) * Nsrc + sc]; if (gain) v *= gain[k0 + kk]; scr[kk * 33 + (lane & 31)] = v; }
    LDS_WAIT(); asm volatile("" ::: "memory");
    const int c = lane & 7;
#pragma unroll
    for (int j = 0; j < 4; ++j) { const int n = (lane >> 3) + 8 * j; const LAS float* s = scr + (8 * c) * 33 + n;
        v4u o; o.x = pk2(s[0 * 33], s[1 * 33]); o.y = pk2(s[2 * 33], s[3 * 33]); o.z = pk2(s[4 * 33], s[5 * 33]); o.w = pk2(s[6 * 33], s[7 * 33]);
        *(v4u*)(WT + (size_t)(n0 + n) * K + k0 + 8 * c) = o; }
    LDS_WAIT(); asm volatile("" ::: "memory");
}
__device__ __forceinline__ float wave_sum(float v) {
#pragma unroll
    for (int o = 1; o < 64; o <<= 1) v += __shfl_xor(v, o);
    return v;
}
__device__ __forceinline__ void p0_prologue(Frame& F, const Args& a) {
    LAS float* scr = (LAS float*)(F.lds + RING_OFF + F.wave * 16384);
    const int gw = F.vcu * NWAVES + F.wave, NGW = F.G * NWAVES;
    constexpr int I_INA = 16 * (NA_PAD / 32), I_INB = 16 * (NB / 32), I_OUT = 16 * 32, I_UP = 16 * (NUP / 32), I_DN = (FF / 64) * 32;
    constexpr int NITEMS = 2 * I_INA + 2 * I_INB + 4 * I_OUT + 4 * I_UP + 4 * I_DN;
    unsigned char* ws = a.ws;
    for (int it = gw; it < NITEMS; it += NGW) {
        int r = it;
        if (r < 2 * I_INA) { const int l = r / I_INA; convert_item(a.w_in_a + (size_t)l * DM * NA_SRC, DM, NA_SRC, NA_PAD, 1, a.attn_norm_g + (2 * l) * DM, (bf16*)(ws + WS_W_INA) + (size_t)l * NA_PAD * DM, scr, r % I_INA, F.lane); continue; } r -= 2 * I_INA;
        if (r < 2 * I_INB) { const int l = r / I_INB; convert_item(a.w_in_b + (size_t)l * DM * NB, DM, NB, NB, 2, a.attn_norm_g + (2 * l + 1) * DM, (bf16*)(ws + WS_W_INB) + (size_t)l * NB * DM, scr, r % I_INB, F.lane); continue; } r -= 2 * I_INB;
        if (r < 4 * I_OUT) { const int l = r / I_OUT; convert_item(a.w_out + (size_t)l * DM * DM, DM, DM, DM, 0, nullptr, (bf16*)(ws + WS_W_OUT) + (size_t)l * DM * DM, scr, r % I_OUT, F.lane); continue; } r -= 4 * I_OUT;
        if (r < 4 * I_UP) { const int l = r / I_UP; convert_item(a.w_up + (size_t)l * DM * NUP, DM, NUP, NUP, 3, a.ffn_norm_g + l * DM, (bf16*)(ws + WS_W_UP) + (size_t)l * NUP * DM, scr, r % I_UP, F.lane); continue; } r -= 4 * I_UP;
        { const int l = r / I_DN; convert_item(a.w_down + (size_t)l * FF * DM, FF, DM, DM, 0, nullptr, (bf16*)(ws + WS_W_DN) + (size_t)l * DM * FF, scr, r % I_DN, F.lane); }
    }
    bf16* hb = (bf16*)(ws + WS_HB); float* ss = (float*)(ws + WS_SS);
    for (int m = gw; m < MTOK; m += NGW) {
        const f32x4* xr = (const f32x4*)(a.x + (size_t)m * DM) + F.lane; f32x4 v[4]; float s = 0.f;
#pragma unroll
        for (int j = 0; j < 4; ++j) { v[j] = xr[64 * j]; s += (v[j].x * v[j].x + v[j].y * v[j].y) + (v[j].z * v[j].z + v[j].w * v[j].w); }
        s = wave_sum(s);
        v2u* o8 = (v2u*)(hb + (size_t)m * DM) + F.lane;
#pragma unroll
        for (int j = 0; j < 4; ++j) { v2u w; w.x = pk2(v[j].x, v[j].y); w.y = pk2(v[j].z, v[j].w); o8[64 * j] = w; }
        if (F.lane < 16) ss[(size_t)m * 16 + F.lane] = (F.lane == 0) ? s : 0.f;
    }
}

__device__ __forceinline__ float row_rstd(const float* ss, int row, int fq) {
    const f32x4 a = *(const f32x4*)(ss + (size_t)row * 16 + 4 * fq);
    float s = (a.x + a.y) + (a.z + a.w);
    s += __shfl_xor(s, 16); s += __shfl_xor(s, 32);
    return __builtin_amdgcn_rsqf(s * (1.0f / DM) + EPS);
}
__device__ __forceinline__ unsigned att_pk4(f32x4 v) { int r = __builtin_amdgcn_cvt_pk_fp8_f32(v.x, v.y, 0, false); r = __builtin_amdgcn_cvt_pk_fp8_f32(v.z, v.w, r, true); return (unsigned)r; }
struct EpiIn {
    static constexpr bool PERM = false, PERMA = false, AFTER_DRAIN = false;
    const float* ss; unsigned char* proj; const float* qg; const float* kg; int isB;
    __device__ __forceinline__ void operator()(const pg8::f32x4 (&acc)[2][2][4][2], const pg8::Unit& u, int wr, int wc, int fr, int fq) const {
        asm volatile("" : "+v"(fr), "+v"(fq));
        const int pn = u.pn; int kind, pitch; bf16* dst;
        if (isB) { const int t = pn >> 2; kind = (t == 0) ? 1 : (t == 1 ? 2 : 0); dst = (bf16*)(proj + (size_t)t * PB_STRIDE) + 256 * (pn & 3); pitch = DM; }
        else if (pn < 4) { kind = 1; dst = (bf16*)(proj + PA_QA) + 256 * pn; pitch = DM; }
        else if (pn == 4) { kind = 2; dst = (bf16*)(proj + PA_KA); pitch = 256; }
        else if (pn == 5) { kind = 0; dst = (bf16*)(proj + PA_VA); pitch = 256; }
        else if (pn < 8) { kind = 0; dst = (bf16*)(proj + PA_QI) + 256 * (pn - 6); pitch = 512; }
        else { kind = 3; dst = (bf16*)(proj + PA_KI); pitch = 64; }
        if (kind == 3 && wc >= 2) return;
        const bool donorm = (kind == 1) || (kind == 2) || (kind == 3 && wc == 0);
        f32x4 g[2][2];
#pragma unroll
        for (int bj = 0; bj < 2; ++bj)
#pragma unroll
            for (int n = 0; n < 2; ++n) {
                if (kind == 1) g[bj][n] = *(const f32x4*)(qg + 16 * fq + 8 * bj + 4 * n) * (isB ? C2 : 1.0f);
                else if (kind == 2) g[bj][n] = *(const f32x4*)(kg + 16 * fq + 8 * bj + 4 * n);
                else g[bj][n] = (f32x4){1.f, 1.f, 1.f, 1.f};
            }
        float* wi = (float*)(proj + PA_WI);
#pragma unroll
        for (int ai = 0; ai < 2; ++ai)
#pragma unroll
            for (int m = 0; m < 4; ++m) {
                const int row = u.pm * 256 + ai * 128 + wr * 64 + m * 16 + fr;
                const float rs = row_rstd(ss, row, fq);
                f32x4 v[2][2]; float s = 0.f;
#pragma unroll
                for (int bj = 0; bj < 2; ++bj)
#pragma unroll
                    for (int n = 0; n < 2; ++n) { v[bj][n] = acc[ai][bj][m][n] * rs; const f32x4 q = v[bj][n] * v[bj][n]; s += (q.x + q.y) + (q.z + q.w); }
                if (donorm) {
                    s += __shfl_xor(s, 16); s += __shfl_xor(s, 32);
                    const float r = 1.0f / sqrtf(s * (1.0f / 64.0f) + EPS);
#pragma unroll
                    for (int bj = 0; bj < 2; ++bj)
#pragma unroll
                        for (int n = 0; n < 2; ++n) v[bj][n] = v[bj][n] * r * g[bj][n];
                }
                if (kind == 3 && wc == 1) {
                    if (fq == 0) { float* wp = wi + (size_t)row * 8; const float sc = 0.04419417382415922f;
                        *(f32x4*)(wp) = v[0][0] * sc; *(f32x4*)(wp + 4) = v[0][1] * sc; }
                } else if (!isB && pn < 6) {
                    unsigned char* p8 = (pn < 4) ? proj + PA_QA + (size_t)row * 1024 + 256 * pn + 64 * wc + 16 * fq : proj + PA_KA + (size_t)row * 512 + 128 * wc + 64 * (pn - 4) + 16 * fq;
                    v4u w; w.x = att_pk4(v[0][0]); w.y = att_pk4(v[0][1]); w.z = att_pk4(v[1][0]); w.w = att_pk4(v[1][1]);
                    *(v4u*)p8 = w;
                } else {
                    bf16* rp = dst + (size_t)row * pitch + 64 * wc + 16 * fq;
#pragma unroll
                    for (int bj = 0; bj < 2; ++bj) { v4u w; w.x = cvtpk(v[bj][0].x, v[bj][0].y); w.y = cvtpk(v[bj][0].z, v[bj][0].w); w.z = cvtpk(v[bj][1].x, v[bj][1].y); w.w = cvtpk(v[bj][1].z, v[bj][1].w);
                        *(v4u*)(rp + 8 * bj) = w; }
                }
            }
    }
};
struct EpiRes {
    static constexpr bool PERM = false, PERMA = false, AFTER_DRAIN = false;
    const float* xin; float* fout; const bf16* hbi; bf16* hb; float* ss;
    __device__ __forceinline__ void operator()(const pg8::f32x4 (&acc)[2][2][4][2], const pg8::Unit& u, int wr, int wc, int fr, int fq) const {
        asm volatile("" : "+v"(fr), "+v"(fq));
        const int col0 = u.pn * 256 + wc * 32 + 4 * fq;
#pragma unroll
        for (int ai = 0; ai < 2; ++ai)
#pragma unroll
            for (int m = 0; m < 4; ++m) {
                const int row = u.pm * 256 + ai * 128 + wr * 64 + m * 16 + fr; const size_t off = (size_t)row * DM + col0; float s = 0.f;
#pragma unroll
                for (int bj = 0; bj < 2; ++bj)
#pragma unroll
                    for (int n = 0; n < 2; ++n) { const size_t o4 = off + bj * 128 + n * 16; f32x4 base;
                        if (xin) base = *(const f32x4*)(xin + o4); else { const v2u b = *(const v2u*)(hbi + o4); base = (f32x4){bf_lo(b.x), bf_hi(b.x), bf_lo(b.y), bf_hi(b.y)}; }
                        const f32x4 o = base + acc[ai][bj][m][n];
                        if (fout) *(f32x4*)(fout + o4) = o;
                        else { const f32x4 q = o * o; s += (q.x + q.y) + (q.z + q.w); v2u w; w.x = cvtpk(o.x, o.y); w.y = cvtpk(o.z, o.w); *(v2u*)(hb + o4) = w; } }
                if (!fout) { s += __shfl_xor(s, 16); s += __shfl_xor(s, 32); if (fq == 0) ss[(size_t)row * 16 + u.pn * 4 + wc] = s; }
            }
    }
};
#ifdef X_NOBPERM
__device__ __forceinline__ float lane_from(int byteaddr, float v) { return v + (float)byteaddr; }
#else
__device__ __forceinline__ float lane_from(int byteaddr, float v) { return __builtin_bit_cast(float, __builtin_amdgcn_ds_bpermute(byteaddr, __builtin_bit_cast(int, v))); }
#endif
#ifdef X_NOSILU
__device__ __forceinline__ float silu_mul(float a, float g) { return a * g; }
#else
__device__ __forceinline__ float silu_mul(float a, float g) { return a * g * __builtin_amdgcn_rcpf(1.0f + __builtin_amdgcn_exp2f(-g * LOG2E)); }
#endif
__device__ __forceinline__ float dpp_prev_lane(float v) { return __builtin_bit_cast(float, __builtin_amdgcn_update_dpp(0, __builtin_bit_cast(int, v), 0x111  , 0xf, 0xf, true)); }
struct EpiUp {
    static constexpr bool PERM = false, PERMA = true, AFTER_DRAIN = false;
    const float* ss; const float* cw; const float* cb; bf16* act; float* halo;
    __device__ __forceinline__ void operator()(const pg8::f32x4 (&acc)[2][2][4][2], const pg8::Unit& u, int wr, int wc, int fr, int fq) const {
        asm volatile("" : "+v"(fr), "+v"(fq));
        const int colb = u.pn * 128 + wc * 32 + 8 * fq;
        unsigned pk[2][2][4][2][2];
#pragma unroll
        for (int ai = 0; ai < 2; ++ai) {
            const int blk = u.pm * 4 + ai * 2 + wr, row0 = blk * 64 + 4 * fr;
#pragma unroll
            for (int m = 0; m < 4; ++m) {
                const float rs = row_rstd(ss, row0 + m, fq);
#pragma unroll
                for (int bj = 0; bj < 2; ++bj)
#pragma unroll
                    for (int n = 0; n < 2; ++n) { const f32x4 v = acc[ai][bj][m][n] * rs; pk[ai][bj][m][n][0] = cvtpk(v.x, v.y); pk[ai][bj][m][n][1] = cvtpk(v.z, v.w); }
            }
        }
        __builtin_amdgcn_sched_barrier(0);
        if (fr == 0 || fr == 15) {
#pragma unroll
            for (int ai = 0; ai < 2; ++ai)
#pragma unroll
                for (int j = 0; j < 2; ++j)
#pragma unroll
                    for (int bj = 0; bj < 2; ++bj)
#pragma unroll
                        for (int n = 0; n < 2; ++n) { const unsigned w0 = (fr == 0) ? pk[ai][bj][j][n][0] : pk[ai][bj][2 + j][n][0], w1 = (fr == 0) ? pk[ai][bj][j][n][1] : pk[ai][bj][2 + j][n][1];
                            *(f32x4*)(halo + ((size_t)(u.pm * 4 + ai * 2 + wr) * 4 + (fr == 0 ? j : 2 + j)) * NUP + bj * FF + colb + 4 * n) = (f32x4){bf_lo(w0), bf_hi(w0), bf_lo(w1), bf_hi(w1)}; }
        }
        __builtin_amdgcn_sched_barrier(0);
#pragma unroll
        for (int ai = 0; ai < 2; ++ai) {
            const int row0 = (u.pm * 4 + ai * 2 + wr) * 64 + 4 * fr;
            unsigned outp[4][2][2];
#pragma unroll
            for (int n = 0; n < 2; ++n) {
#pragma unroll
                for (int ip = 0; ip < 2; ++ip) {
                    f32x2_t k0[2], k1[2], k2[2], kb[2];
#pragma unroll
                    for (int bj = 0; bj < 2; ++bj) { const int c = bj * FF + colb + 4 * n + 2 * ip; k0[bj] = *(const f32x2_t*)(cw + c); k1[bj] = *(const f32x2_t*)(cw + NUP + c); k2[bj] = *(const f32x2_t*)(cw + 2 * NUP + c); kb[bj] = *(const f32x2_t*)(cb + c); }
                    float y[2][4][2];
#pragma unroll
                    for (int bj = 0; bj < 2; ++bj) {
                        const unsigned w0 = pk[ai][bj][0][n][ip], w1 = pk[ai][bj][1][n][ip], w2 = pk[ai][bj][2][n][ip], w3 = pk[ai][bj][3][n][ip];
                        const unsigned q1 = (unsigned)__builtin_amdgcn_update_dpp(0, (int)w3, 0x111, 0xf, 0xf, true), q2 = (unsigned)__builtin_amdgcn_update_dpp(0, (int)w2, 0x111, 0xf, 0xf, true);
#pragma unroll
                        for (int e = 0; e < 2; ++e) { const int i = e;
                            const float u0 = e ? bf_hi(w0) : bf_lo(w0), u1 = e ? bf_hi(w1) : bf_lo(w1), u2 = e ? bf_hi(w2) : bf_lo(w2), u3 = e ? bf_hi(w3) : bf_lo(w3), p1 = e ? bf_hi(q1) : bf_lo(q1), p2 = e ? bf_hi(q2) : bf_lo(q2);
                            y[bj][0][e] = kb[bj][i] + k0[bj][i] * p2 + k1[bj][i] * p1 + k2[bj][i] * u0;
                            y[bj][1][e] = kb[bj][i] + k0[bj][i] * p1 + k1[bj][i] * u0 + k2[bj][i] * u1;
                            y[bj][2][e] = kb[bj][i] + k0[bj][i] * u0 + k1[bj][i] * u1 + k2[bj][i] * u2;
                            y[bj][3][e] = kb[bj][i] + k0[bj][i] * u1 + k1[bj][i] * u2 + k2[bj][i] * u3; }
                    }
#pragma unroll
                    for (int m = 0; m < 4; ++m) outp[m][n][ip] = cvtpk(silu_mul(y[0][m][0], y[1][m][0]), silu_mul(y[0][m][1], y[1][m][1]));
                }
            }
#pragma unroll
            for (int m = 0; m < 4; ++m) {
                if (m < 2 && fr == 0) continue;
                v4u w; w.x = outp[m][0][0]; w.y = outp[m][0][1]; w.z = outp[m][1][0]; w.w = outp[m][1][1];
                *(v4u*)(act + (size_t)(row0 + m) * FF + colb) = w;
            }
            asm volatile("" ::: "memory");
        }
    }
};
__device__ __forceinline__ void fixup_phase(Frame& F, const float* cw, const float* cb, const float* halo, bf16* act) {
    const int gt = F.vcu * (NWAVES * 64) + F.tid, NT = F.G * NWAVES * 64;
    constexpr int C4 = FF / 4;
    for (int it = gt; it < NBLK64 * 2 * C4; it += NT) {
        const int c = (it % C4) * 4, rj = it / C4, j = rj & 1, blk = rj >> 1, t = blk * 64 + j, tb = t % SEQ;
        f32x4 y[2];
#pragma unroll
        for (int bj = 0; bj < 2; ++bj) {
            const int cc = bj * FF + c;
            const f32x4 z = (f32x4){0.f, 0.f, 0.f, 0.f};
            const f32x4 ut = *(const f32x4*)(halo + ((size_t)blk * 4 + j) * NUP + cc);
            f32x4 u1, u2;
            if (j == 1) { u1 = *(const f32x4*)(halo + ((size_t)blk * 4 + 0) * NUP + cc); u2 = (tb == 1) ? z : *(const f32x4*)(halo + ((size_t)(blk - 1) * 4 + 3) * NUP + cc); }
            else { u1 = (tb == 0) ? z : *(const f32x4*)(halo + ((size_t)(blk - 1) * 4 + 3) * NUP + cc); u2 = (tb == 0) ? z : *(const f32x4*)(halo + ((size_t)(blk - 1) * 4 + 2) * NUP + cc); }
            y[bj] = *(const f32x4*)(cb + cc) + *(const f32x4*)(cw + cc) * u2 + *(const f32x4*)(cw + NUP + cc) * u1 + *(const f32x4*)(cw + 2 * NUP + cc) * ut;
        }
        v2u w; w.x = cvtpk(silu_mul(y[0].x, y[1].x), silu_mul(y[0].y, y[1].y)); w.y = cvtpk(silu_mul(y[0].z, y[1].z), silu_mul(y[0].w, y[1].w));
        *(v2u*)(act + (size_t)t * FF + c) = w;
    }
}

__device__ __forceinline__ int crow(int r, int hi) { return (r & 3) + 8 * (r >> 2) + 4 * hi; }
__device__ __forceinline__ void glds16(const void* gsrc, unsigned lds_dst) { unsigned keep;
    asm volatile("s_mov_b32 %0, m0\n\ts_mov_b32 m0, %2\n\ts_nop 0\n\tglobal_load_lds_dwordx4 %1, off\n\ts_mov_b32 m0, %0" : "=&s"(keep) : "v"(gsrc), "s"(lds_dst) : "memory"); }
__device__ __forceinline__ float max3f(float a, float b, float c) { return fmaxf(fmaxf(a, b), c); }

namespace band {
constexpr int SLOTB = 8192;
constexpr int LDS_K = 0, LDS_V = 2 * SLOTB, LDS_WS = 4 * SLOTB, LDS_TB = LDS_WS + NWAVES * 64 * 4, LDS_OST = LDS_TB + 640 * 4 + 512, LDS_END = LDS_OST + NWAVES * 4096;
static_assert(LDS_END <= RING_BYTES, "band LDS");
__device__ __forceinline__ void unit(Frame& F, int b, int h, int U, const bf16* Q, const bf16* K, const bf16* V, bf16* O, const float* rel) {
    const int tid = F.tid, lane = F.lane, r32 = lane & 31, hi = lane >> 5, wid = F.wave;
    LAS unsigned char* shm = F.lds + RING_OFF;
    const unsigned lds0 = (unsigned)(uintptr_t)shm;
    const long rowbase = (long)b * SEQ; const int q0 = U * 256, c0 = 4 * U, cq = c0 + (wid >> 1);
    const bf16* Qw = Q + (rowbase + q0 + wid * 32) * DM + h * 64;
    const bf16* Kh = K + rowbase * DM + h * 64; const bf16* Vh = V + rowbase * DM + h * 64;
    LAS float* wsf = (LAS float*)(shm + LDS_WS) + wid * 64;
    LAS float* tb = (LAS float*)(shm + LDS_TB);
    const bf16* ksrc = Kh + (long)lane * DM + wid * 8;
    const bf16* vsrc = Vh + (long)(16 * (wid & 3) + (lane >> 2)) * DM + (wid >> 2) * 32 + (lane & 3) * 8;
    const unsigned kdst = lds0 + LDS_K + wid * 1024, vdst = lds0 + LDS_V + wid * 1024;
    const int lo = (c0 - 8 > 0) ? c0 - 8 : 0, hiT = c0 + 3, NT = hiT - lo + 1, t0 = (c0 - 5 > 0) ? c0 - 5 : 0;
#define BAND_KT(i) ((t0 + (i) <= hiT) ? t0 + (i) : lo + (t0 + (i) - hiT - 1))
    for (int i = tid; i < 640; i += NWAVES * 64) { int d = i - 64; d = d < -256 ? -256 : (d > 256 ? 256 : d); tb[i] = rel[(d + 256) * 16 + h] * LOG2E; }
    { const int kt = BAND_KT(0); glds16(ksrc + (long)kt * 64 * DM, (unsigned)__builtin_amdgcn_readfirstlane(kdst)); glds16(vsrc + (long)kt * 64 * DM, (unsigned)__builtin_amdgcn_readfirstlane(vdst)); }
    bf16x8 qr[4];
#pragma unroll
    for (int d0 = 0; d0 < 4; ++d0) qr[d0] = *(const bf16x8*)(Qw + (long)r32 * DM + d0 * 16 + hi * 8);
    float m_run = -INFINITY, l_run = 0.f; f32x16 o[2]; o[0] = f32x16{}; o[1] = f32x16{};
    const int qpos = q0 + wid * 32 + r32;
    const LAS unsigned char* vbase = shm + LDS_V + ((lane >> 4) & 1) * 32 + (lane & 3) * 8 + (4 * hi + ((lane & 15) >> 2)) * 64;
    for (int i = 0; i < NT; ++i) {
        asm volatile("s_waitcnt vmcnt(0) lgkmcnt(0)\n\ts_barrier" ::: "memory");
        if (i + 1 < NT) { const int kt = BAND_KT(i + 1); const unsigned so = ((i + 1) & 1) * SLOTB;
            glds16(ksrc + (long)kt * 64 * DM, (unsigned)__builtin_amdgcn_readfirstlane(kdst + so)); glds16(vsrc + (long)kt * 64 * DM, (unsigned)__builtin_amdgcn_readfirstlane(vdst + so)); }
        const int kt = BAND_KT(i);
        if (kt < cq - 8 || kt > cq) continue;
        const int so = (i & 1) * SLOTB;
        f32x16 p0 = f32x16{}, p1 = f32x16{};
        { const LAS unsigned char* kb = shm + LDS_K + so + hi * 1024 + r32 * 16;
#pragma unroll
          for (int d0 = 0; d0 < 4; ++d0) { const bf16x8 b0 = *(const LAS bf16x8*)(kb + d0 * 2048), b1 = *(const LAS bf16x8*)(kb + d0 * 2048 + 512);
              p0 = __builtin_amdgcn_mfma_f32_32x32x16_bf16(b0, qr[d0], p0, 0, 0, 0); p1 = __builtin_amdgcn_mfma_f32_32x32x16_bf16(b1, qr[d0], p1, 0, 0, 0); } }
        { const int ib = qpos - 64 * kt + 64 - 4 * hi;
#pragma unroll
          for (int r = 0; r < 16; ++r) { const int ix = ib - ((r & 3) + 8 * (r >> 2)); p0[r] += tb[ix]; p1[r] += tb[ix - 32]; } }
        float rm = p0[0];
#pragma unroll
        for (int r = 0; r < 16; ++r) rm = max3f(rm, p0[r], p1[r]);
        { auto rr = __builtin_amdgcn_permlane32_swap(__float_as_uint(rm), __float_as_uint(rm), false, false); rm = fmaxf(__uint_as_float(rr[0]), __uint_as_float(rr[1])); }
        const float mnew = fmaxf(m_run, rm), f = __builtin_amdgcn_exp2f(m_run - mnew); m_run = mnew;
        float sacc = 0.f;
#pragma unroll
        for (int r = 0; r < 16; ++r) { p0[r] = __builtin_amdgcn_exp2f(p0[r] - mnew); p1[r] = __builtin_amdgcn_exp2f(p1[r] - mnew); sacc += p0[r] + p1[r]; }
        l_run = l_run * f + sacc;
        if (hi == 0) wsf[r32] = f;
        LDS_WAIT();
#pragma unroll
        for (int r = 0; r < 16; ++r) { const float fr_ = wsf[crow(r, hi)]; o[0][r] *= fr_; o[1][r] *= fr_; }
        v4u pw[4];
        pw[0] = (v4u){cvtpk(p0[0], p0[1]), cvtpk(p0[2], p0[3]), cvtpk(p0[4], p0[5]), cvtpk(p0[6], p0[7])};
        pw[1] = (v4u){cvtpk(p0[8], p0[9]), cvtpk(p0[10], p0[11]), cvtpk(p0[12], p0[13]), cvtpk(p0[14], p0[15])};
        pw[2] = (v4u){cvtpk(p1[0], p1[1]), cvtpk(p1[2], p1[3]), cvtpk(p1[4], p1[5]), cvtpk(p1[6], p1[7])};
        pw[3] = (v4u){cvtpk(p1[8], p1[9]), cvtpk(p1[10], p1[11]), cvtpk(p1[12], p1[13]), cvtpk(p1[14], p1[15])};
        const LAS unsigned char* vb = vbase + so;
#pragma unroll
        for (int d0 = 0; d0 < 2; ++d0)
#pragma unroll
            for (int ks = 0; ks < 4; ++ks) {
                const s16x4 vlo = __builtin_bit_cast(s16x4, __builtin_amdgcn_ds_read_tr16_b64_v4i16((LAS s16x4*)(vb + d0 * 4096 + ks * 1024)));
                const s16x4 vhi = __builtin_bit_cast(s16x4, __builtin_amdgcn_ds_read_tr16_b64_v4i16((LAS s16x4*)(vb + d0 * 4096 + ks * 1024 + 512)));
                const bf16x8 vf = (bf16x8){vlo[0], vlo[1], vlo[2], vlo[3], vhi[0], vhi[1], vhi[2], vhi[3]};
                o[d0] = __builtin_amdgcn_mfma_f32_32x32x16_bf16(__builtin_bit_cast(bf16x8, pw[ks]), vf, o[d0], 0, 0, 0);
            }
    }
#undef BAND_KT
    { auto rr = __builtin_amdgcn_permlane32_swap(__float_as_uint(l_run), __float_as_uint(l_run), false, false); l_run = __uint_as_float(rr[0]) + __uint_as_float(rr[1]); }
    if (hi == 0) wsf[32 + r32] = l_run;
    LDS_WAIT();
    float rli[16];
#pragma unroll
    for (int r = 0; r < 16; ++r) rli[r] = __builtin_amdgcn_rcpf(wsf[32 + crow(r, hi)]);
    bf16* Ow = O + (rowbase + q0 + wid * 32) * DM + h * 64;
    { LAS bf16* stg = (LAS bf16*)(shm + LDS_OST) + wid * 2048;
#pragma unroll
      for (int r = 0; r < 16; ++r) { const int orow = crow(r, hi);
#pragma unroll
          for (int d0 = 0; d0 < 2; ++d0) stg[orow * 64 + d0 * 32 + r32] = (bf16)f2bf(o[d0][r] * rli[r]); }
      LDS_WAIT();
#pragma unroll
      for (int i = 0; i < 4; ++i) { const int row = i * 8 + (lane >> 3), ch = lane & 7; const v4u v = *(const LAS v4u*)(stg + row * 64 + ch * 8); *(v4u*)(Ow + (long)row * DM + ch * 8) = v; } }
    asm volatile("s_waitcnt lgkmcnt(0)\n\ts_barrier" ::: "memory");
}
__device__ __forceinline__ void phase(Frame& F, const bf16* Q, const bf16* K, const bf16* V, bf16* O, const float* rel) {
    const int NU = BATCH * 16 * 32, per = (NU + F.G - 1) / F.G;
    for (int i = 0; i < per; ++i) { const int uid = F.vcu * per + i; if (uid >= NU) break; unit(F, uid >> 9, (uid >> 5) & 15, uid & 31, Q, K, V, O, rel); }
}
}

namespace dsa {
__device__ __forceinline__ unsigned okey(float s) { const unsigned u = __float_as_uint(s + 0.0f); return (u & 0x80000000u) ? ~u : (u | 0x80000000u); }
struct Ctx { const bf16* QA; const bf16* KA; const bf16* VA; const bf16* QI; const bf16* KI; const float* WI; bf16* M; const LAS float* t5l; unsigned short* SEL; };

__device__ __forceinline__ void scan_hist(const LAS unsigned* hq, int lane, unsigned need, unsigned& bin, unsigned& above) {
    const LAS v4u* hp = (const LAS v4u*)hq + lane * 4;
    unsigned wds[16];
#pragma unroll
    for (int j = 0; j < 4; ++j) { const v4u t = hp[j]; wds[4 * j] = t.x; wds[4 * j + 1] = t.y; wds[4 * j + 2] = t.z; wds[4 * j + 3] = t.w; }
    unsigned tl = 0;
#pragma unroll
    for (int j = 0; j < 16; ++j) tl += (wds[j] & 0xffffu) + (wds[j] >> 16);
    unsigned suf = tl;
#pragma unroll
    for (int o = 1; o < 64; o <<= 1) { const unsigned v = __shfl_down(suf, o); if (lane + o < 64) suf += v; }
    const unsigned S = suf - tl;
    const bool cross = (S < need) && (need <= S + tl);
    unsigned c = S, bsel = 0, ab = 0; bool found = false;
#pragma unroll
    for (int k = 31; k >= 0; --k) { const unsigned cnt = (wds[k >> 1] >> (16 * (k & 1))) & 0xffffu; if (!found && c + cnt >= need) { bsel = 32 * lane + k; ab = c; found = true; } c += cnt; }
    const unsigned long long bal = __ballot(cross);
    const int src = bal ? __builtin_ctzll(bal) : 0;
    bin = __shfl(bsel, src); above = __shfl(ab, src);
}

__device__ __forceinline__ void attend(const Ctx& C, const LAS unsigned short* sq, int nvalid, long rowbase, long token, int tpos, int lane, int g0) {
    asm volatile("" : "+v"(lane));
    const int l15 = lane & 15, l4 = lane >> 4;
    int sidx[16];
#pragma unroll
    for (int ti = 0; ti < 16; ++ti) sidx[ti] = sq[ti * 16 + l15];
    unsigned bpk[4] = {0u, 0u, 0u, 0u};
#pragma unroll
    for (int ti = 0; ti < 16; ++ti) { const int rel = sidx[ti] - tpos, n = rel < 0 ? -rel : rel;
        const int bk = (rel > 0 ? 16 : 0) + (n < 8 ? n : 8 + (n >= 12) + (n >= 16) + (n >= 23) + (n >= 32) + (n >= 46) + (n >= 64) + (n >= 91));
        bpk[ti >> 2] |= (unsigned)bk << (8 * (ti & 3)); }
#pragma unroll 1
    for (int g = g0; g < g0 + 2; ++g) {
        const bf16* qp = C.QA + token * DM + (4 * g + (lane & 3)) * 64 + 8 * l4;
        const bf16x8 qf0 = *(const bf16x8*)qp, qf1 = *(const bf16x8*)(qp + 32);
        const bf16* kbase = C.KA + rowbase * 256 + g * 64 + 8 * l4;
        f32x4 S[16];
#pragma unroll
        for (int hh = 0; hh < 4; ++hh) {
            bf16x8 kf0[4], kf1[4];
#pragma unroll
            for (int j = 0; j < 4; ++j) { const bf16* kp = kbase + (long)sidx[hh * 4 + j] * 256; kf0[j] = *(const bf16x8*)kp; kf1[j] = *(const bf16x8*)(kp + 32); }
#pragma unroll
            for (int j = 0; j < 4; ++j) { const int ti = hh * 4 + j;
                f32x4 a = *(const LAS f32x4*)(C.t5l + ((bpk[hh] >> (8 * j)) & 255u) * 16 + 4 * g);
                asm volatile("v_mfma_f32_16x16x32_bf16 %0, %1, %2, %0" : "+v"(a) : "v"(qf0), "v"(kf0[j]));
                asm volatile("v_mfma_f32_16x16x32_bf16 %0, %1, %2, %0" : "+v"(a) : "v"(qf1), "v"(kf1[j]));
                S[ti] = a; }
            asm volatile("s_nop 15\n\ts_nop 7" : "+v"(S[hh * 4]), "+v"(S[hh * 4 + 1]), "+v"(S[hh * 4 + 2]), "+v"(S[hh * 4 + 3]));
        }
#pragma unroll
        for (int ti = 0; ti < 16; ++ti) if (ti * 16 >= nvalid) S[ti] = (f32x4){-INFINITY, -INFINITY, -INFINITY, -INFINITY};
        f32x4 mx = S[0];
#pragma unroll
        for (int ti = 1; ti < 16; ++ti) { mx.x = fmaxf(mx.x, S[ti].x); mx.y = fmaxf(mx.y, S[ti].y); mx.z = fmaxf(mx.z, S[ti].z); mx.w = fmaxf(mx.w, S[ti].w); }
#pragma unroll
        for (int o = 1; o < 16; o <<= 1) { mx.x = fmaxf(mx.x, __shfl_xor(mx.x, o)); mx.y = fmaxf(mx.y, __shfl_xor(mx.y, o)); mx.z = fmaxf(mx.z, __shfl_xor(mx.z, o)); mx.w = fmaxf(mx.w, __shfl_xor(mx.w, o)); }
        f32x4 ls = (f32x4){0.f, 0.f, 0.f, 0.f};
        unsigned P01[16], P23[16];
#pragma unroll
        for (int ti = 0; ti < 16; ++ti) { const float e0 = __builtin_amdgcn_exp2f(S[ti].x - mx.x), e1 = __builtin_amdgcn_exp2f(S[ti].y - mx.y), e2 = __builtin_amdgcn_exp2f(S[ti].z - mx.z), e3 = __builtin_amdgcn_exp2f(S[ti].w - mx.w);
            ls += (f32x4){e0, e1, e2, e3}; P01[ti] = cvtpk(e0, e1); P23[ti] = cvtpk(e2, e3); }
#pragma unroll
        for (int o = 1; o < 16; o <<= 1) { ls.x += __shfl_xor(ls.x, o); ls.y += __shfl_xor(ls.y, o); ls.z += __shfl_xor(ls.z, o); ls.w += __shfl_xor(ls.w, o); }
        float o_[4][16];
#pragma unroll
        for (int h = 0; h < 4; ++h)
#pragma unroll
            for (int d = 0; d < 16; ++d) o_[h][d] = 0.f;
        const bf16* vbase = C.VA + rowbase * 256 + g * 64 + 16 * l4;
#pragma unroll
        for (int hh = 0; hh < 4; ++hh) {
            v4u va[4], vb[4];
#pragma unroll
            for (int j = 0; j < 4; ++j) { const v4u* vp = (const v4u*)(vbase + (long)sidx[hh * 4 + j] * 256); va[j] = vp[0]; vb[j] = vp[1]; }
#pragma unroll
            for (int j = 0; j < 4; ++j) { const int ti = hh * 4 + j; const v4u v0 = va[j], v1 = vb[j];
                float vf[16];
                vf[0] = bf_lo(v0.x); vf[1] = bf_hi(v0.x); vf[2] = bf_lo(v0.y); vf[3] = bf_hi(v0.y); vf[4] = bf_lo(v0.z); vf[5] = bf_hi(v0.z); vf[6] = bf_lo(v0.w); vf[7] = bf_hi(v0.w);
                vf[8] = bf_lo(v1.x); vf[9] = bf_hi(v1.x); vf[10] = bf_lo(v1.y); vf[11] = bf_hi(v1.y); vf[12] = bf_lo(v1.z); vf[13] = bf_hi(v1.z); vf[14] = bf_lo(v1.w); vf[15] = bf_hi(v1.w);
                const float p0 = bf_lo(P01[ti]), p1 = bf_hi(P01[ti]), p2 = bf_lo(P23[ti]), p3 = bf_hi(P23[ti]);
#pragma unroll
                for (int d = 0; d < 16; ++d) { o_[0][d] += p0 * vf[d]; o_[1][d] += p1 * vf[d]; o_[2][d] += p2 * vf[d]; o_[3][d] += p3 * vf[d]; } }
        }
        float res[4];
#pragma unroll
        for (int h = 0; h < 4; ++h) {
            float a8[8], a4[4], a2[2];
            const bool b3 = (l15 & 8) != 0, b2 = (l15 & 4) != 0, b1 = (l15 & 2) != 0, b0 = (l15 & 1) != 0;
#pragma unroll
            for (int d = 0; d < 8; ++d) { const float keep = b3 ? o_[h][d + 8] : o_[h][d], send = b3 ? o_[h][d] : o_[h][d + 8]; a8[d] = keep + __shfl_xor(send, 8); }
#pragma unroll
            for (int d = 0; d < 4; ++d) { const float keep = b2 ? a8[d + 4] : a8[d], send = b2 ? a8[d] : a8[d + 4]; a4[d] = keep + __shfl_xor(send, 4); }
#pragma unroll
            for (int d = 0; d < 2; ++d) { const float keep = b1 ? a4[d + 2] : a4[d], send = b1 ? a4[d] : a4[d + 2]; a2[d] = keep + __shfl_xor(send, 2); }
            { const float keep = b0 ? a2[1] : a2[0], send = b0 ? a2[0] : a2[1]; res[h] = keep + __shfl_xor(send, 1); }
        }
        bf16* mp = C.M + token * DM + (4 * g) * 64 + lane;
        mp[0] = (bf16)f2bf(res[0] * __builtin_amdgcn_rcpf(ls.x)); mp[64] = (bf16)f2bf(res[1] * __builtin_amdgcn_rcpf(ls.y)); mp[128] = (bf16)f2bf(res[2] * __builtin_amdgcn_rcpf(ls.z)); mp[192] = (bf16)f2bf(res[3] * __builtin_amdgcn_rcpf(ls.w));
    }
}

constexpr int CAND_CAP = 256;
constexpr int SELKS_OFF = KS_OFF;
__device__ __forceinline__ float relu_i(float x) { const int i = __builtin_bit_cast(int, x); return __builtin_bit_cast(float, i > 0 ? i : 0); }
struct SelState { unsigned pre[4], need[4], cnt[4], tcnt[4]; };
__device__ __forceinline__ void tile_mfma(f32x16 (&acc)[2], const LAS unsigned char* kf, const int (&koff)[4], const bf16x8 (&qa)[4]) {
#pragma unroll
    for (int h2 = 0; h2 < 2; ++h2) { acc[h2] = f32x16{};
#pragma unroll
        for (int ks = 0; ks < 4; ++ks) { const bf16x8 kb = *(const LAS bf16x8*)(kf + koff[ks] + h2 * 4096); acc[h2] = __builtin_amdgcn_mfma_f32_32x32x16_bf16(qa[ks], kb, acc[h2], 0, 0, 0); } }
}
template <class ActionT>
__device__ __forceinline__ void tile_valu(const f32x16 (&acc)[2], const f32x2_t (&wp)[2][4], int kbase, ActionT&& act) {
#pragma unroll
    for (int h2 = 0; h2 < 2; ++h2) {
        f32x2_t sa = {0.f, 0.f}, sb = {0.f, 0.f};
#pragma unroll
        for (int jp = 0; jp < 4; ++jp) {
            const f32x2_t ra = {relu_i(acc[h2][2 * jp]), relu_i(acc[h2][2 * jp + 1])};
            const f32x2_t rb = {relu_i(acc[h2][8 + 2 * jp]), relu_i(acc[h2][8 + 2 * jp + 1])};
            sa = __builtin_elementwise_fma(ra, wp[0][jp], sa); sb = __builtin_elementwise_fma(rb, wp[1][jp], sb); }
        act(kbase + h2 * 32, (sa.x + sa.y) + 0.0f, (sb.x + sb.y) + 0.0f);
    }
}
constexpr int KSLOTS = 3;
__device__ __forceinline__ void wait_tile(int newer) {
    if (newer >= 4) asm volatile("s_waitcnt vmcnt(4) lgkmcnt(0)\n\ts_barrier" ::: "memory");
    else if (newer == 3) asm volatile("s_waitcnt vmcnt(3) lgkmcnt(0)\n\ts_barrier" ::: "memory");
    else if (newer == 2) asm volatile("s_waitcnt vmcnt(2) lgkmcnt(0)\n\ts_barrier" ::: "memory");
    else if (newer == 1) asm volatile("s_waitcnt vmcnt(1) lgkmcnt(0)\n\ts_barrier" ::: "memory");
    else asm volatile("s_waitcnt vmcnt(0) lgkmcnt(0)\n\ts_barrier" ::: "memory");
}
template <class ActionT>
__device__ __forceinline__ void tile_pass(Frame& F, const bf16* ksrc, unsigned kdst, const LAS unsigned char* kfr, const int (&koff)[4], int NT, const bf16x8 (&qa)[4], const f32x2_t (&wp)[2][4], ActionT&& act) {
    asm volatile("s_waitcnt lgkmcnt(0)\n\ts_barrier" ::: "memory");
    const int npre = NT < KSLOTS ? NT : KSLOTS;
    for (int j = 0; j < npre; ++j) glds16(ksrc + (long)j * 4096, (unsigned)__builtin_amdgcn_readfirstlane(kdst + j * 8192));
    wait_tile(npre - 1);
    f32x16 accC[2];
    tile_mfma(accC, kfr, koff, qa);
    int sl = 0;
    for (int kt = 0; kt + 1 < NT; ++kt) {
        { const int inflight = (NT - kt - 2) < (KSLOTS - 2) ? (NT - kt - 2) : (KSLOTS - 2); wait_tile(inflight); }
        if (kt + KSLOTS < NT) glds16(ksrc + (long)(kt + KSLOTS) * 4096, (unsigned)__builtin_amdgcn_readfirstlane(kdst + sl * 8192));
        sl = (sl == KSLOTS - 1) ? 0 : sl + 1;
        f32x16 accN[2];
        tile_mfma(accN, kfr + sl * 8192, koff, qa);
        tile_valu(accC, wp, kt * 64, act);
        accC[0] = accN[0]; accC[1] = accN[1];
    }
    tile_valu(accC, wp, (NT - 1) * 64, act);
    LDS_WAIT();
}
__device__ __forceinline__ void scan_hist_cnt(const LAS unsigned* hq, int lane, unsigned need, unsigned& bin, unsigned& above, unsigned& bcnt) {
    const LAS v4u* hp = (const LAS v4u*)hq + lane * 2;
    unsigned wds[8];
#pragma unroll
    for (int j = 0; j < 2; ++j) { const v4u t = hp[j]; wds[4 * j] = t.x; wds[4 * j + 1] = t.y; wds[4 * j + 2] = t.z; wds[4 * j + 3] = t.w; }
    unsigned tl = 0;
#pragma unroll
    for (int j = 0; j < 8; ++j) tl += wds[j];
    unsigned suf = tl;
#pragma unroll
    for (int o = 1; o < 64; o <<= 1) { const unsigned v = __shfl_down(suf, o); if (lane + o < 64) suf += v; }
    const unsigned S = suf - tl;
    const bool cross = (S < need) && (need <= S + tl);
    unsigned c = S, bsel = 0, ab = 0, bc = 0; bool found = false;
#pragma unroll
    for (int k = 7; k >= 0; --k) { const unsigned cnt = wds[k]; if (!found && c + cnt >= need) { bsel = 8 * lane + k; ab = c; bc = cnt; found = true; } c += cnt; }
    const unsigned long long bal = __ballot(cross);
    const int src = bal ? __builtin_ctzll(bal) : 0;
    bin = __builtin_amdgcn_readfirstlane(__shfl(bsel, src)); above = __builtin_amdgcn_readfirstlane(__shfl(ab, src)); bcnt = __builtin_amdgcn_readfirstlane(__shfl(bc, src));
}
__device__ __forceinline__ void step(Frame& F, const Ctx& C, int b, int c, int half) {
    int lane_ = F.lane; asm volatile("" : "+v"(lane_));
    const int lane = lane_, r = lane & 31, hi = lane >> 5, wave = F.wave;
    LAS unsigned* hist = (LAS unsigned*)(F.lds + RING_OFF + wave * 16384);
    LAS unsigned short* sel = (LAS unsigned short*)hist;
    LAS unsigned* cand = hist + 2048;
    LAS unsigned* fbflag = (LAS unsigned*)(F.lds + AUX_OFF + 2048);
    const long rowbase = (long)b * SEQ;
    const int tq0 = 64 * c + 32 * half + 4 * wave;
    const int N = 64 * (c + 1), NT = c + 1;
    int nvalid = 256;
    if (N <= 256) {
        nvalid = N;
        for (int j = lane; j < 4 * 256; j += 64) sel[j] = (unsigned short)(((j & 255) < N) ? (j & 255) : 0);
    } else {
        const int aq = 2 * ((r >> 2) & 1) + (r >> 4), ah = 4 * ((r >> 3) & 1) + (r & 3);
        const bf16* qip = C.QI + (rowbase + tq0 + aq) * 512 + ah * 64 + 8 * hi;
        bf16x8 qa[4];
#pragma unroll
        for (int ks = 0; ks < 4; ++ks) qa[ks] = *(const bf16x8*)(qip + 16 * ks);
        f32x2_t wp[2][4];
#pragma unroll
        for (int t = 0; t < 2; ++t) { const float* wq = C.WI + (rowbase + tq0 + 2 * hi + t) * 8; const f32x4 w0 = *(const f32x4*)wq, w1 = *(const f32x4*)(wq + 4);
            wp[t][0] = (f32x2_t){w0.x, w0.y}; wp[t][1] = (f32x2_t){w0.z, w0.w}; wp[t][2] = (f32x2_t){w1.x, w1.y}; wp[t][3] = (f32x2_t){w1.z, w1.w}; }
        float Bq;
        { float ssq = 0.f;
#pragma unroll
          for (int ks = 0; ks < 4; ++ks)
#pragma unroll
              for (int e = 0; e < 8; ++e) { const float v = bf_lo((unsigned)(unsigned short)qa[ks][e]); ssq += v * v; }
          ssq += __shfl_xor(ssq, 32);
          float term = fabsf(C.WI[(rowbase + tq0 + aq) * 8 + ah]) * sqrtf(ssq);
          term += __shfl_xor(term, 1); term += __shfl_xor(term, 2); term += __shfl_xor(term, 8);
          Bq = term * 8.25f + 1e-20f; }
        const float B0 = __shfl(Bq, (hi << 2)), B1 = __shfl(Bq, (hi << 2) | 16);
        const float sc0 = 1024.0f / B0, sc1 = 1024.0f / B1;
        asm volatile("" :: "v"(qa[0]), "v"(qa[1]), "v"(qa[2]), "v"(qa[3]));
        asm volatile("" :: "v"(wp[0][0]), "v"(wp[0][1]), "v"(wp[0][2]), "v"(wp[0][3]), "v"(wp[1][0]), "v"(wp[1][1]), "v"(wp[1][2]), "v"(wp[1][3]), "v"(sc0), "v"(sc1));
        const bf16* ksrc = C.KI + rowbase * 64 + (long)(wave * 8 + (lane >> 3)) * 64 + ((lane & 7) ^ (lane >> 3)) * 8;
        const unsigned kdst = (unsigned)(uintptr_t)(F.lds + SELKS_OFF) + wave * 1024;
        const LAS unsigned char* kfr = F.lds + SELKS_OFF + r * 128;
        int koff[4];
#pragma unroll
        for (int ks = 0; ks < 4; ++ks) koff[ks] = ((2 * ks + hi) ^ (r & 7)) * 16;
        const unsigned below = (1u << r) - 1u;
        LAS v4u* hz = (LAS v4u*)hist;
        if (wave == 0 && lane == 0) *fbflag = 0u;
#pragma unroll
        for (int j = 0; j < 8; ++j) hz[j * 64 + lane] = (v4u){0u, 0u, 0u, 0u};
        tile_pass(F, ksrc, kdst, kfr, koff, NT, qa, wp, [&](int kbase, float s0, float s1) {
            const int b0 = (int)__builtin_amdgcn_fmed3f(__builtin_fmaf(s0, sc0, 256.0f), 0.0f, 511.0f), b1 = (int)__builtin_amdgcn_fmed3f(__builtin_fmaf(s1, sc1, 256.0f), 0.0f, 511.0f);
            __hip_atomic_fetch_add(hist + (2 * hi) * 512 + b0, 1u, __ATOMIC_RELAXED, __HIP_MEMORY_SCOPE_WORKGROUP);
            __hip_atomic_fetch_add(hist + (2 * hi + 1) * 512 + b1, 1u, __ATOMIC_RELAXED, __HIP_MEMORY_SCOPE_WORKGROUP);
        });
#ifdef PROBE_SKEL
        tile_pass(F, ksrc, kdst, kfr, koff, NT, qa, wp, [&](int kbase, float s0, float s1) { });
#endif
#ifdef PROBE_SCORE
        { float dsum = 0.f; tile_pass(F, ksrc, kdst, kfr, koff, NT, qa, wp, [&](int kbase, float s0, float s1) { dsum += s0 + s1; }); if (dsum == 12345.678f) hist[0] = 1u; }
#endif
        SelState st;
        unsigned tbin[4], bcn[4]; bool ovf = false;
#pragma unroll
        for (int ql = 0; ql < 4; ++ql) { unsigned above; scan_hist_cnt(hist + ql * 512, lane, 256u, tbin[ql], above, bcn[ql]); st.cnt[ql] = 0u; st.tcnt[ql] = 0u; st.need[ql] = 256u - above; st.pre[ql] = above;
#ifdef PROBE_OVF
            ovf |= bcn[ql] > (unsigned)PROBE_OVF; }
#else
            ovf |= bcn[ql] > (unsigned)CAND_CAP; }
#endif
        LDS_WAIT();
        if (ovf && lane == 0) *fbflag = 1u;
        asm volatile("s_waitcnt lgkmcnt(0)\n\ts_barrier" ::: "memory");
#ifdef PROBE_NOFB
        const bool fb = false;
#elif defined(PROBE_NOFB2)
        const bool fb = __builtin_amdgcn_readfirstlane((int)*fbflag) == 0x7fffffff;
#else
        const bool fb = __builtin_amdgcn_readfirstlane((int)*fbflag) != 0;
#endif
        if (!fb) {
            const int tb0 = (int)(hi ? tbin[2] : tbin[0]), tb1 = (int)(hi ? tbin[3] : tbin[1]);
            tile_pass(F, ksrc, kdst, kfr, koff, NT, qa, wp, [&](int kbase, float s0, float s1) {
#pragma unroll
                for (int t = 0; t < 2; ++t) {
                    const float s = t ? s1 : s0; const int bin = (int)__builtin_amdgcn_fmed3f(__builtin_fmaf(s, (t ? sc1 : sc0), 256.0f), 0.0f, 511.0f), tb = t ? tb1 : tb0;
                    const bool gt = bin > tb, eq = bin == tb;
                    const unsigned long long mg = __ballot(gt), me = __ballot(eq);
                    const unsigned mgh = hi ? (unsigned)(mg >> 32) : (unsigned)mg, meh = hi ? (unsigned)(me >> 32) : (unsigned)me;
                    const unsigned pos = (hi ? st.cnt[2 + t] : st.cnt[t]) + __builtin_popcount(mgh & below);
                    sel[(gt && pos < 256u) ? (2 * hi + t) * 256 + pos : 3200 + lane] = (unsigned short)(kbase + r);
                    const unsigned cpos = (hi ? st.tcnt[2 + t] : st.tcnt[t]) + __builtin_popcount(meh & below);
                    { LAS unsigned* cp = hist + ((eq && cpos < (unsigned)CAND_CAP) ? 2048 + ((2 * hi + t) * CAND_CAP + cpos) * 2 : 1700 + 2 * lane); cp[0] = okey(s); cp[1] = (unsigned)(kbase + r); }
                    st.cnt[t] += __builtin_popcount((unsigned)mg); st.cnt[2 + t] += __builtin_popcount((unsigned)(mg >> 32));
                    st.tcnt[t] += __builtin_popcount((unsigned)me); st.tcnt[2 + t] += __builtin_popcount((unsigned)(me >> 32));
                }
            });
#pragma unroll
            for (int ql = 0; ql < 4; ++ql) {
                const unsigned nc = bcn[ql], G = st.pre[ql], rq = st.need[ql];
                const LAS unsigned* cq = cand + ql * CAND_CAP * 2;
                unsigned ki4[4], xi4[4], rk4[4];
#pragma unroll
                for (int m = 0; m < 4; ++m) { const unsigned i = (unsigned)lane + 64u * m; ki4[m] = (i < nc) ? cq[2 * i] : 0u; xi4[m] = (i < nc) ? cq[2 * i + 1] : 0u; rk4[m] = 0u; }
                for (unsigned j = 0; j < nc; ++j) { const unsigned kj = cq[2 * j];
#pragma unroll
                    for (int m = 0; m < 4; ++m) rk4[m] += (kj > ki4[m] || (kj == ki4[m] && j < (unsigned)lane + 64u * m)) ? 1u : 0u; }
                unsigned base = G; const unsigned long long lt = (1ull << lane) - 1ull;
#pragma unroll
                for (int m = 0; m < 4; ++m) { const bool take = ((unsigned)lane + 64u * m < nc) && rk4[m] < rq; const unsigned long long mm = __ballot(take);
                    const unsigned pos = base + __builtin_popcountll(mm & lt); if (take && pos < 256u) sel[ql * 256 + pos] = (unsigned short)xi4[m]; base += __builtin_popcountll(mm); }
            }
        } else {
#pragma unroll
            for (int ql = 0; ql < 4; ++ql) { st.pre[ql] = 0u; st.need[ql] = 256u; st.cnt[ql] = 0u; st.tcnt[ql] = 0u; }
#pragma unroll 1
            for (int lev = 0; lev < 4; ++lev) {
#pragma unroll
                for (int j = 0; j < 8; ++j) hz[j * 64 + lane] = (v4u){0u, 0u, 0u, 0u};
                const unsigned pre0 = hi ? st.pre[2] : st.pre[0], pre1 = hi ? st.pre[3] : st.pre[1];
                const int sh = (lev == 0) ? 23 : (lev == 1) ? 14 : (lev == 2) ? 5 : 0, wd = (lev == 3) ? 5 : 9;
                tile_pass(F, ksrc, kdst, kfr, koff, NT, qa, wp, [&](int kbase, float s0, float s1) {
                    const unsigned k0 = okey(s0), k1 = okey(s1);
                    const unsigned b0 = (k0 >> sh) & ((1u << wd) - 1u), b1 = (k1 >> sh) & ((1u << wd) - 1u);
                    const bool in0 = (lev == 0) || ((k0 >> (sh + wd)) == pre0), in1 = (lev == 0) || ((k1 >> (sh + wd)) == pre1);
                    if (in0) __hip_atomic_fetch_add(hist + (2 * hi) * 512 + b0, 1u, __ATOMIC_RELAXED, __HIP_MEMORY_SCOPE_WORKGROUP);
                    if (in1) __hip_atomic_fetch_add(hist + (2 * hi + 1) * 512 + b1, 1u, __ATOMIC_RELAXED, __HIP_MEMORY_SCOPE_WORKGROUP);
                });
#pragma unroll
                for (int ql = 0; ql < 4; ++ql) { unsigned bin, above, bc; scan_hist_cnt(hist + ql * 512, lane, st.need[ql], bin, above, bc);
                    st.pre[ql] = (st.pre[ql] << wd) | bin; st.need[ql] -= above; }
                LDS_WAIT();
            }
            const unsigned T0 = hi ? st.pre[2] : st.pre[0], T1 = hi ? st.pre[3] : st.pre[1], rq0 = hi ? st.need[2] : st.need[0], rq1 = hi ? st.need[3] : st.need[1];
            tile_pass(F, ksrc, kdst, kfr, koff, NT, qa, wp, [&](int kbase, float s0, float s1) {
#pragma unroll
                for (int t = 0; t < 2; ++t) {
                    const unsigned kk = okey(t ? s1 : s0), T = t ? T1 : T0, rq = t ? rq1 : rq0;
                    const bool gt = kk > T, eq = kk == T;
                    const unsigned long long me = __ballot(eq);
                    const unsigned meh = hi ? (unsigned)(me >> 32) : (unsigned)me;
                    const unsigned trank = (hi ? st.tcnt[2 + t] : st.tcnt[t]) + __builtin_popcount(meh & below);
                    const bool take = gt || (eq && trank < rq);
                    const unsigned long long mt = __ballot(take);
                    const unsigned mth = hi ? (unsigned)(mt >> 32) : (unsigned)mt;
                    const unsigned pos = (hi ? st.cnt[2 + t] : st.cnt[t]) + __builtin_popcount(mth & below);
                    if (take && pos < 256u) sel[(2 * hi + t) * 256 + pos] = (unsigned short)(kbase + r);
                    st.cnt[t] += __builtin_popcount((unsigned)mt); st.cnt[2 + t] += __builtin_popcount((unsigned)(mt >> 32));
                    st.tcnt[t] += __builtin_popcount((unsigned)me); st.tcnt[2 + t] += __builtin_popcount((unsigned)(me >> 32));
                }
            });
        }
    }
    LDS_WAIT();
    { const LAS v4u* s4 = (const LAS v4u*)sel; v4u* g4 = (v4u*)(C.SEL + (rowbase + tq0) * 256);
#pragma unroll
      for (int j = 0; j < 2; ++j) g4[j * 64 + lane] = s4[j * 64 + lane]; }
    LDS_WAIT();
}
__device__ __forceinline__ void phase(Frame& F, const Ctx& C) {
    for (int v = F.vcu; v < 256; v += F.G) {
        const int b = v >> 6, c = v & 63;
#pragma unroll 1
        for (int it = 0; it < 4; ++it) step(F, C, b, (it < 2) ? c : 127 - c, it & 1);
    }
}
__device__ __forceinline__ void attn_phase(Frame& F, const Ctx& C) {
    int lane = F.lane; asm volatile("" : "+v"(lane));
    LAS unsigned short* sq = (LAS unsigned short*)(F.lds + RING_OFF + F.wave * 16384);
    const int nx = F.G / 32;
    for (int x = F.vcu / 32; x < 8; x += nx) {
        const int b = x >> 1, g0 = 2 * (x & 1); const long rowbase = (long)b * SEQ;
        const int w = (F.vcu & 31) * NWAVES + F.wave;
#pragma unroll 1
        for (int t = w; t < SEQ; t += 32 * NWAVES) {
            { const v4u* g4 = (const v4u*)(C.SEL + (rowbase + t) * 256); if (lane < 32) ((LAS v4u*)sq)[lane] = g4[lane]; }
            LDS_WAIT();
            const int N = 64 * ((t >> 6) + 1), nvalid = N < 256 ? N : 256;
            attend(C, sq, nvalid, rowbase, rowbase + t, t, lane, g0);
            LDS_WAIT();
        }
    }
}
}

namespace att8 {
typedef int v2i __attribute__((ext_vector_type(2)));
struct Ctx8 { const unsigned char* QA8; const unsigned char* KV8; const unsigned short* SEL; bf16* M; };
constexpr int T2_OFF = KS_OFF, T2_BYTES = 155 * 16 * 4, SELL_OFF = KS_OFF + 10240;
static_assert(T2_BYTES <= 10240 && SELL_OFF + NWAVES * 1024 <= AUX_OFF, "attention LDS map");
__device__ __forceinline__ void mfma8(f32x4& acc, long a, long b) { asm volatile("v_mfma_f32_16x16x32_fp8_fp8 %0, %1, %2, %0" : "+v"(acc) : "v"(a), "v"(b)); }
__device__ __forceinline__ unsigned pk4_fp8(float a, float b, float c, float d) { int r = __builtin_amdgcn_cvt_pk_fp8_f32(a, b, 0, false); r = __builtin_amdgcn_cvt_pk_fp8_f32(c, d, r, true); return (unsigned)r; }

__device__ __forceinline__ void attend8(const Ctx8& C, const LAS unsigned short* sq, LAS unsigned char* vreg, const LAS float* T2, int nvalid, long rowbase, long token, int tpos, int lane, int g0) {
    asm volatile("" : "+v"(lane));
    const int l15 = lane & 15, l4 = lane >> 4, h = l15 & 3;
    const unsigned vbase = (unsigned)(uintptr_t)vreg;
    unsigned cib[16];
#pragma unroll
    for (int ti = 0; ti < 16; ++ti) { const v2u i4 = *(const LAS v2u*)(sq + ti * 16 + 4 * l4);
        const int r0 = (int)(i4.x & 0xffffu) - tpos, r1 = (int)(i4.x >> 16) - tpos, r2 = (int)(i4.y & 0xffffu) - tpos, r3 = (int)(i4.y >> 16) - tpos;
        const int c0 = min(max(r0, -91), 63) + 91, c1 = min(max(r1, -91), 63) + 91, c2 = min(max(r2, -91), 63) + 91, c3 = min(max(r3, -91), 63) + 91;
        cib[ti] = (unsigned)c0 | ((unsigned)c1 << 8) | ((unsigned)c2 << 16) | ((unsigned)c3 << 24); }
    const int trk = 4 * l4 + ((l15 >> 1) & 3), trt = (l15 >> 3) & 1, xs = (l4 & 1) | (trt << 1);
    const int troff = trt * 1024 + trk * 64 + 8 * (l15 & 1);
#pragma unroll 1
    for (int g = g0; g < g0 + 2; ++g) {
        const unsigned char* kvb = C.KV8 + rowbase * 512 + g * 128;
        { const int kq = lane >> 2, p = lane & 3;
#pragma unroll
          for (int ti = 0; ti < 16; ++ti) { const int key = sq[ti * 16 + kq]; const int x = ((kq >> 2) & 1) | ((ti & 1) << 1);
              glds16(kvb + (long)key * 512 + 64 + 16 * (p ^ x), (unsigned)__builtin_amdgcn_readfirstlane(vbase + ti * 1024)); } }
        const v4u qv = *(const v4u*)(C.QA8 + token * 1024 + (4 * g + h) * 64 + 16 * l4);
        const long q0 = (long)(((unsigned long long)qv.y << 32) | qv.x), q1 = (long)(((unsigned long long)qv.w << 32) | qv.z);
        f32x4 S[16];
#pragma unroll
        for (int hh = 0; hh < 2; ++hh) {
            v4u kr[8];
#pragma unroll
            for (int j = 0; j < 8; ++j) kr[j] = *(const v4u*)(kvb + (long)sq[(hh * 8 + j) * 16 + l15] * 512 + 16 * l4);
#pragma unroll
            for (int j = 0; j < 8; ++j) { const int ti = hh * 8 + j; const unsigned cb = cib[ti];
                f32x4 a; a.x = T2[(cb & 255u) * 16 + 4 * g + h]; a.y = T2[((cb >> 8) & 255u) * 16 + 4 * g + h]; a.z = T2[((cb >> 16) & 255u) * 16 + 4 * g + h]; a.w = T2[(cb >> 24) * 16 + 4 * g + h];
                mfma8(a, (long)(((unsigned long long)kr[j].y << 32) | kr[j].x), q0);
                mfma8(a, (long)(((unsigned long long)kr[j].w << 32) | kr[j].z), q1);
                S[ti] = a; }
            asm volatile("s_nop 15\n\ts_nop 7" : "+v"(S[hh * 8]), "+v"(S[hh * 8 + 1]), "+v"(S[hh * 8 + 2]), "+v"(S[hh * 8 + 3]), "+v"(S[hh * 8 + 4]), "+v"(S[hh * 8 + 5]), "+v"(S[hh * 8 + 6]), "+v"(S[hh * 8 + 7]));
        }
#pragma unroll
        for (int ti = 0; ti < 16; ++ti) if (ti * 16 >= nvalid) S[ti] = (f32x4){-INFINITY, -INFINITY, -INFINITY, -INFINITY};
        float mx = S[0].x;
#pragma unroll
        for (int ti = 0; ti < 16; ++ti) mx = fmaxf(fmaxf(mx, fmaxf(S[ti].x, S[ti].y)), fmaxf(S[ti].z, S[ti].w));
        mx = fmaxf(mx, __shfl_xor(mx, 16)); mx = fmaxf(mx, __shfl_xor(mx, 32));
        const float mc = -mx * C2; float ls = 0.f;
        long P8[8];
#pragma unroll
        for (int j = 0; j < 8; ++j) { float e[8];
#pragma unroll
            for (int q = 0; q < 4; ++q) { e[q] = __builtin_amdgcn_exp2f(__builtin_fmaf(S[2 * j][q], C2, mc)); e[4 + q] = __builtin_amdgcn_exp2f(__builtin_fmaf(S[2 * j + 1][q], C2, mc)); }
            ls += ((e[0] + e[1]) + (e[2] + e[3])) + ((e[4] + e[5]) + (e[6] + e[7]));
            const unsigned lo = pk4_fp8(e[0] * 256.f, e[1] * 256.f, e[2] * 256.f, e[3] * 256.f), hi = pk4_fp8(e[4] * 256.f, e[5] * 256.f, e[6] * 256.f, e[7] * 256.f);
            P8[j] = (long)(((unsigned long long)hi << 32) | lo); }
        ls += __shfl_xor(ls, 16); ls += __shfl_xor(ls, 32);
        asm volatile("s_waitcnt vmcnt(0)" ::: "memory");
        f32x4 D[4];
#pragma unroll
        for (int db = 0; db < 4; ++db) D[db] = (f32x4){0.f, 0.f, 0.f, 0.f};
#pragma unroll
        for (int j = 0; j < 8; ++j)
#pragma unroll
            for (int db = 0; db < 4; ++db) {
                const v2i vv = __builtin_amdgcn_ds_read_tr8_b64_v2i32((LAS v2i*)(vreg + j * 2048 + troff + 16 * (db ^ xs)));
                mfma8(D[db], P8[j], __builtin_bit_cast(long, vv)); }
        asm volatile("s_nop 15\n\ts_nop 7" : "+v"(D[0]), "+v"(D[1]), "+v"(D[2]), "+v"(D[3]));
        const float lh = __shfl(ls, l4);
        const float inv = __builtin_amdgcn_rcpf(lh * 256.f);
        bf16* mp = C.M + token * DM + (4 * g + l4) * 64 + l15;
#pragma unroll
        for (int db = 0; db < 4; ++db) { const float v = (l4 == 0) ? D[db].x : (l4 == 1) ? D[db].y : (l4 == 2) ? D[db].z : D[db].w; mp[16 * db] = (bf16)f2bf(v * inv); }
        asm volatile("" ::: "memory");
    }
}
__device__ __forceinline__ void phase(Frame& F, const Ctx8& C, const float* t5) {
    int lane = F.lane; asm volatile("" : "+v"(lane));
    LAS float* T2 = (LAS float*)(F.lds + T2_OFF);
    for (int e = F.tid; e < 155 * 16; e += NWAVES * 64) { const int rel = (e >> 4) - 91, n = rel < 0 ? -rel : rel;
        const int bk = (rel > 0 ? 16 : 0) + (n < 8 ? n : 8 + (n >= 12) + (n >= 16) + (n >= 23) + (n >= 32) + (n >= 46) + (n >= 64) + (n >= 91));
        T2[e] = t5[bk * 16 + (e & 15)] * 8.0f; }
    __syncthreads();
    LAS unsigned short* sq = (LAS unsigned short*)(F.lds + SELL_OFF + F.wave * 1024);
    LAS unsigned char* vreg = F.lds + RING_OFF + F.wave * 16384;
    for (int x = F.vcu / 32; x < 8; x += GRID / 32) {
        const int b = x >> 1, g0 = 2 * (x & 1); const long rowbase = (long)b * SEQ;
        const int w = (F.vcu & 31) * NWAVES + F.wave;
        v4u nxt = (v4u){0u, 0u, 0u, 0u};
        if (lane < 32) nxt = ((const v4u*)(C.SEL + (rowbase + w) * 256))[lane];
        int buf = 0;
#pragma unroll 1
        for (int t = w; t < SEQ; t += 32 * NWAVES) {
            if (lane < 32) ((LAS v4u*)(sq + buf * 256))[lane] = nxt;
            if (t + 32 * NWAVES < SEQ && lane < 32) nxt = ((const v4u*)(C.SEL + (rowbase + t + 32 * NWAVES) * 256))[lane];
            LDS_WAIT();
            const int N = 64 * ((t >> 6) + 1), nvalid = N < 256 ? N : 256;
            attend8(C, sq + buf * 256, vreg, T2, nvalid, rowbase, rowbase + t, t, lane, g0);
            buf ^= 1;
        }
    }
}
}

#ifndef REP_P0
#define REP_P0 1
#endif
#ifndef REP_IN
#define REP_IN 1
#endif
#ifndef REP_DSA
#define REP_DSA 1
#endif
#ifndef REP_BAND
#define REP_BAND 1
#endif
#ifndef REP_UP
#define REP_UP 1
#endif
#ifndef REP_FIX
#define REP_FIX 1
#endif
constexpr int N_PHASES = 1 + 6 * DEPTH;
#ifndef MK_N_LAUNCHES
#define MK_N_LAUNCHES 1
#endif
__global__ void __launch_bounds__(NWAVES * 64, 2) mega_fwd(Args args) {
    extern __shared__ __attribute__((aligned(16))) unsigned char lds[];
    Frame F;
    F.lds = (LAS unsigned char*)lds;
    F.MISC = (volatile LAS unsigned*)(F.lds + MISC_OFF);
    F.tid = threadIdx.x; F.lane = F.tid & 63; F.wave = __builtin_amdgcn_readfirstlane(F.tid >> 6);
    F.G = GRID; { const int bx = blockIdx.x; F.vcu = (bx & 7) * (GRID / 8) + (bx >> 3); }
    unsigned char* ws = args.ws;
    F.ctl = (gu32*)(ws + WS_CTL);
    for (int u = F.tid; u < (LDS_BYTES - LDSCTL_OFF) / 4; u += NWAVES * 64) ((LAS unsigned*)(F.lds + LDSCTL_OFF))[u] = 0u;
    __syncthreads();
    XcdBarrier bar; bar.bar = (unsigned*)(F.ctl + CW_BAR); bar.x = 0; bar.st = nullptr;
    if (MK_N_LAUNCHES == 1) bar = xcd_barrier_post((unsigned*)(F.ctl + CW_BAR), F.MISC + 8);
    const int lo = args.ph_lo, hi = args.ph_hi;
#define IN(k) (lo <= (k) && (k) < hi)
#define OPQ_FRAME(Fl) Frame Fl = F; { int l_; asm volatile("v_mbcnt_lo_u32_b32 %0, -1, 0\n\tv_mbcnt_hi_u32_b32 %0, -1, %0" : "=v"(l_)); int w_ = F.wave; asm volatile("" : "+s"(w_)); Fl.wave = w_; Fl.lane = l_; Fl.tid = w_ * 64 + l_; }
#define SEAM(k) do { if (IN(k) && IN((k) + 1)) xcd_barrier(bar); } while (0)

    bf16* hb = (bf16*)(ws + WS_HB); bf16* mb = (bf16*)(ws + WS_M); float* ss = (float*)(ws + WS_SS); float* halo = (float*)(ws + WS_HALO);
    unsigned char* proj = ws + WS_PROJ; bf16* act = (bf16*)(ws + WS_PROJ);

#ifndef SKIP_P0
    if (IN(0)) { for (int rep = 0; rep < REP_P0; ++rep) { OPQ_FRAME(F0); p0_prologue(F0, args); } }
#endif
    SEAM(0);

#pragma unroll 1
    for (int L = 0; L < DEPTH; ++L) {
        const int pb = 1 + 6 * L, li = L >> 1; const bool isB = (L & 1) != 0;
        if (IN(pb)) {
#ifndef SKIP_IN
            for (int rep = 0; rep < REP_IN; ++rep)
            if (!isB) {
                pg8::Gemm g{hb, (const bf16*)(ws + WS_W_INA) + (size_t)li * NA_PAD * DM, MTOK, NA_PAD, DM}; pg8::StaticOrder S; S.init(MTOK, NA_PAD, F.G, (int)blockIdx.x);
                EpiIn E{ss, proj, args.q_norm_g + L * 64, args.k_norm_g + L * 64, 0};
                pg8::gemm_phase<EpiIn, pg8::StaticOrder, true, true>(F.lds + RING_OFF, g, S, E, F.wave);
            } else {
                pg8::Gemm g{hb, (const bf16*)(ws + WS_W_INB) + (size_t)li * NB * DM, MTOK, NB, DM}; pg8::StaticOrder S; S.init(MTOK, NB, F.G, (int)blockIdx.x);
                EpiIn E{ss, proj, args.q_norm_g + L * 64, args.k_norm_g + L * 64, 1};
                pg8::gemm_phase<EpiIn, pg8::StaticOrder, true, true>(F.lds + RING_OFF, g, S, E, F.wave);
            }
#endif
        }
        SEAM(pb);
#if defined(DBG_NODSA) || defined(DBG_NOBAND)
#ifdef DBG_NODSA
        const bool zero_m = !isB;
#else
        const bool zero_m = isB;
#endif
        if (IN(pb + 1) && zero_m) { for (size_t i = (size_t)blockIdx.x * 512 + threadIdx.x; i < (size_t)MTOK * DM / 8; i += (size_t)gridDim.x * 512) ((v4u*)mb)[i] = (v4u){0u, 0u, 0u, 0u}; }
        if (IN(pb + 1) && !zero_m) {
#else
        if (IN(pb + 1)) {
#endif
#ifndef SKIP_DSA
            if (!isB) {
                LAS float* t5l = (LAS float*)(F.lds + AUX_OFF);
                { OPQ_FRAME(Ft); for (int i = Ft.tid; i < 512; i += NWAVES * 64) t5l[i] = args.t5_bias[i] * LOG2E; }
                __syncthreads();
                dsa::Ctx C{(const bf16*)(proj + PA_QA), (const bf16*)(proj + PA_KA), (const bf16*)(proj + PA_VA), (const bf16*)(proj + PA_QI), (const bf16*)(proj + PA_KI), (const float*)(proj + PA_WI), mb, t5l, (unsigned short*)(proj + PA_SEL)};
#ifdef DBG_DSACOPY
                { int t_ = threadIdx.x; asm volatile("" : "+v"(t_));
                for (unsigned i = blockIdx.x * 512u + (unsigned)t_; i < (unsigned)MTOK * DM; i += gridDim.x * 512u) { const unsigned t = i >> 10, c = i & 1023u;
                    float v = bf_lo(C.QA[i]); v += bf_lo(C.KA[t * 256 + (c & 255)]); v += bf_lo(C.VA[t * 256 + (c & 255)]); v += bf_lo(C.QI[t * 512 + (c & 511)]); v += bf_lo(C.KI[t * 64 + (c & 63)]); v += C.WI[t * 8 + (c & 7)];
                    mb[i] = (bf16)f2bf(v * 0.01f); asm volatile("" ::: "memory"); } }
#else
                for (int rep = 0; rep < REP_DSA; ++rep) { OPQ_FRAME(F1); dsa::phase(F1, C); }
                xcd_barrier(bar);
                { OPQ_FRAME(F1b); att8::Ctx8 C8{(const unsigned char*)(proj + PA_QA), (const unsigned char*)(proj + PA_KA), (const unsigned short*)(proj + PA_SEL), mb};
#ifndef REP_ATT8
#define REP_ATT8 1
#endif
                  for (int rep = 0; rep < REP_ATT8; ++rep) { att8::phase(F1b, C8, args.t5_bias); __syncthreads(); } }
#endif
            }
#endif
#ifndef SKIP_BAND
            if (isB) {
                for (int rep = 0; rep < REP_BAND; ++rep) { OPQ_FRAME(F2); band::phase(F2, (const bf16*)proj, (const bf16*)(proj + PB_STRIDE), (const bf16*)(proj + 2 * PB_STRIDE), mb, args.rel_bias_b + (size_t)li * 513 * 16); }
            }
#endif
        }
        SEAM(pb + 1);
        if (IN(pb + 2)) {
#ifndef SKIP_OUT
            pg8::Gemm g{mb, (const bf16*)(ws + WS_W_OUT) + (size_t)L * DM * DM, MTOK, DM, DM}; pg8::StaticOrder S; S.init(MTOK, DM, F.G, (int)blockIdx.x);
#ifdef REP_OUT
            { EpiRes E0{L == 0 ? args.x : nullptr, nullptr, hb, (bf16*)proj, halo}; pg8::gemm_phase<EpiRes, pg8::StaticOrder, true, true>(F.lds + RING_OFF, g, S, E0, F.wave); }
#endif
            EpiRes E{L == 0 ? args.x : nullptr, nullptr, hb, hb, ss};
            pg8::gemm_phase<EpiRes, pg8::StaticOrder, true, true>(F.lds + RING_OFF, g, S, E, F.wave);
#endif
        }
        SEAM(pb + 2);
        if (IN(pb + 3)) {
#ifndef SKIP_UP
            for (int rep = 0; rep < REP_UP; ++rep) {
            pg8::Gemm g{hb, (const bf16*)(ws + WS_W_UP) + (size_t)L * NUP * DM, MTOK, NUP, DM}; pg8::StaticOrder S; S.init(MTOK, NUP, F.G, (int)blockIdx.x);
            EpiUp E{ss, args.conv_w + (size_t)L * 3 * NUP, args.conv_b + (size_t)L * NUP, act, halo};
            pg8::gemm_phase<EpiUp, pg8::StaticOrder, true, true>(F.lds + RING_OFF, g, S, E, F.wave); }
#endif
        }
        SEAM(pb + 3);
#ifndef SKIP_FIX
        if (IN(pb + 4)) for (int rep = 0; rep < REP_FIX; ++rep) { OPQ_FRAME(F3); fixup_phase(F3, args.conv_w + (size_t)L * 3 * NUP, args.conv_b + (size_t)L * NUP, halo, act); }
#endif
        SEAM(pb + 4);
        if (IN(pb + 5)) {
#ifndef SKIP_DN
            pg8::Gemm g{act, (const bf16*)(ws + WS_W_DN) + (size_t)L * DM * FF, MTOK, DM, FF}; pg8::StaticOrder S; S.init(MTOK, DM, F.G, (int)blockIdx.x);
#ifdef REP_DN
            { EpiRes E0{nullptr, nullptr, hb, mb, halo}; pg8::gemm_phase<EpiRes, pg8::StaticOrder, true, true>(F.lds + RING_OFF, g, S, E0, F.wave); }
#endif
            EpiRes E{nullptr, L == DEPTH - 1 ? args.out : nullptr, hb, hb, ss};
            pg8::gemm_phase<EpiRes, pg8::StaticOrder, true, true>(F.lds + RING_OFF, g, S, E, F.wave);
#endif
        }
        SEAM(pb + 5);
    }
#undef IN
#undef SEAM
}

extern "C" void kernel_launch(void* const* d_in, const int* in_sizes, int n_in, void* d_out, int out_size, void* d_ws, size_t ws_size, hipStream_t stream) {
    static int grid = 0;
    if (grid == 0) {
        if (n_in != 14 || in_sizes[0] != MTOK * DM || out_size != MTOK * DM || ws_size < WS_END) { fprintf(stderr, "kernel_launch: unexpected shapes / workspace (n_in %d, ws %zu); nothing launched\n", n_in, ws_size); grid = -1; return; }
        int dev = 0, cus = 0, per_cu = 0;
        if (hipGetDevice(&dev) != hipSuccess || hipDeviceGetAttribute(&cus, hipDeviceAttributeMultiprocessorCount, dev) != hipSuccess) { grid = -1; return; }
        if (hipFuncSetAttribute((const void*)mega_fwd, hipFuncAttributeMaxDynamicSharedMemorySize, LDS_BYTES) != hipSuccess) { fprintf(stderr, "kernel_launch: hipFuncSetAttribute failed\n"); grid = -1; return; }
        if (hipOccupancyMaxActiveBlocksPerMultiprocessor(&per_cu, (const void*)mega_fwd, NWAVES * 64, LDS_BYTES) != hipSuccess || per_cu < 1) { fprintf(stderr, "kernel_launch: occupancy query reports %d blocks per CU\n", per_cu); }
        (void)hipGetLastError();
        if (cus != GRID) { fprintf(stderr, "kernel_launch: built for a %d-CU device, found %d; nothing launched\n", GRID, cus); grid = -1; return; }
        grid = GRID;
    }
    if (grid < 0) return;
    if (hipMemsetAsync((char*)d_ws + WS_CTL, 0, CTL_ZERO_BYTES, stream) != hipSuccess) return;
    Args a{};
    a.x = (const float*)d_in[0]; a.attn_norm_g = (const float*)d_in[1]; a.w_in_a = (const float*)d_in[2]; a.w_in_b = (const float*)d_in[3]; a.q_norm_g = (const float*)d_in[4];
    a.k_norm_g = (const float*)d_in[5]; a.t5_bias = (const float*)d_in[6]; a.rel_bias_b = (const float*)d_in[7]; a.w_out = (const float*)d_in[8]; a.ffn_norm_g = (const float*)d_in[9];
    a.w_up = (const float*)d_in[10]; a.conv_w = (const float*)d_in[11]; a.conv_b = (const float*)d_in[12]; a.w_down = (const float*)d_in[13];
    a.out = (float*)d_out; a.ws = (unsigned char*)d_ws; a.pad = 0;
#if MK_N_LAUNCHES == 1
    a.ph_lo = 0; a.ph_hi = N_PHASES; a.li = 0;
    hipLaunchKernelGGL(mega_fwd, dim3(grid), dim3(NWAVES * 64), LDS_BYTES, stream, a);
#else
    for (int p = 0; p < N_PHASES; ++p) { a.ph_lo = p; a.ph_hi = p + 1; a.li = p; hipLaunchKernelGGL(mega_fwd, dim3(grid), dim3(NWAVES * 64), LDS_BYTES, stream, a); }
#endif
}
```

```cpp
#include <hip/hip_runtime.h>
#include <cstdio>
#include <cstdint>
namespace pg8 {
#define PG8_LAS __attribute__((address_space(3)))
typedef unsigned short bf16_t;
typedef short bf16x8 __attribute__((ext_vector_type(8)));
typedef float f32x4 __attribute__((ext_vector_type(4)));
typedef unsigned u32x4 __attribute__((ext_vector_type(4)));
constexpr int BM = 256, BK = 64, HALF = 128, HTB = HALF * BK * 2  , STAGE_BYTES = 8 * HTB, NXCD = 8, WGM = 8;

__host__ __device__ __forceinline__ int lds_byte(int r, int c) { const int st = (r >> 4) * 2 + (c >> 5), rr = r & 15, cc = c & 31, ob = rr * 64 + cc * 2; return st * 1024 + (ob ^ (((ob >> 9) & 1) << 5)); }
__host__ __device__ __forceinline__ void stage_rc(int b, int& R, int& C) { const int st = b / 1024, sb = b % 1024, swz = sb ^ (((sb >> 9) & 1) << 5); R = (st >> 1) * 16 + swz / 64; C = (st & 1) * 32 + (swz % 64) / 2; }
__host__ __device__ __forceinline__ int perm32(int rho) { const int n = rho >> 4, i = rho & 15; return 8 * (i >> 2) + 4 * n + (i & 3); }

struct Unit { int pm, pn; };
struct Gemm { const bf16_t* A; const bf16_t* Bt; int M, N, K; };

struct StaticOrder {
    int nM, nN, nwg, G, c;
    __host__ __device__ void init(int M, int N, int G_, int c_) { nM = M / BM; nN = N / BM; nwg = nM * nN; G = G_; c = c_; }
    __host__ __device__ bool next(int i, Unit& u) const {
        const long L = (long)i * G + c; if (L >= nwg) return false;
        int wgid = (int)L; { const int q = nwg / NXCD, r = nwg % NXCD, xcd = wgid % NXCD, off = wgid / NXCD; wgid = (xcd < r ? xcd * (q + 1) : r * (q + 1) + (xcd - r) * q) + off; }
        const int nig = WGM * nN, gid = wgid / nig, fm = gid * WGM, gsz = (nM - fm) < WGM ? (nM - fm) : WGM;
        u.pm = fm + ((wgid % nig) % gsz); u.pn = (wgid % nig) / gsz; return true;
    }
    __device__ __forceinline__ void a_ready(const Unit&) const {}
    __device__ __forceinline__ void done(const Unit&) const {}
};
__device__ __forceinline__ unsigned cvt_pk_bf16(float lo, float hi) { unsigned r; asm volatile("v_cvt_pk_bf16_f32 %0, %1, %2" : "=v"(r) : "v"(lo), "v"(hi)); return r; }
template <class Epi, class Sched, bool ALIGN_EPI = false, bool SP2 = false>
__device__ __forceinline__ void gemm_phase(PG8_LAS unsigned char* lds, const Gemm g, const Sched& S, const Epi& E, const int wave_id) {
    int lane_; asm volatile("v_mbcnt_lo_u32_b32 %0, -1, 0\n\tv_mbcnt_hi_u32_b32 %0, -1, %0" : "=v"(lane_));
    int wid_ = wave_id; asm volatile("" : "+s"(wid_));
    const int wid = wid_, lane = lane_, tid = wid * 64 + lane, wr = wid >> 2, wc = wid & 3, fr = lane & 15, fq = lane >> 4;
    const int K = g.K, nt = K / BK;
    unsigned voffA[2], voffB[2];
#pragma unroll
    for (int i = 0; i < 2; ++i) { int R, C; stage_rc(tid * 16 + i * 8192, R, C); const int Rb = Epi::PERM ? ((R & ~31) + perm32(R & 31)) : R;
        const int Ra = Epi::PERMA ? ((R & ~63) | (4 * (R & 15) + ((R >> 4) & 3))) : R;
        voffA[i] = (unsigned)(Ra * K + C) * 2u; voffB[i] = (unsigned)(Rb * K + C) * 2u; }
    const size_t kstep = (size_t)(BK * 2);
    const size_t hstep = (size_t)HALF * K * 2;
    const size_t tstep = 2 * hstep;
    const unsigned ldsw = (unsigned)wid * 1024u;
    const int aoff = lds_byte(wr * 64 + fr, fq * 8), boff = lds_byte(wc * 32 + fr, fq * 8);
#define PG8_SA(b, h) (((b) * 2 + (h)) * HTB)
#define PG8_SB(b, h) ((4 + (b) * 2 + (h)) * HTB)
#define PG8_STAGE(bufoff, gbase, voff) do { _Pragma("unroll") for (int _i = 0; _i < 2; ++_i) \
        __builtin_amdgcn_global_load_lds((const unsigned*)((const char*)(gbase) + (voff)[_i]), (PG8_LAS unsigned*)(lds + (bufoff) + ldsw + _i * 8192), 16, 0, 0); } while (0)
#define PG8_LDA(dst, b, h) do { _Pragma("unroll") for (int m = 0; m < 4; ++m) _Pragma("unroll") for (int k = 0; k < 2; ++k) dst[m][k] = *(const PG8_LAS bf16x8*)(lds + PG8_SA(b, h) + aoff + m * 2048 + k * 1024); } while (0)
#define PG8_LDB(dst, b, h) do { _Pragma("unroll") for (int n = 0; n < 2; ++n) _Pragma("unroll") for (int k = 0; k < 2; ++k) dst[n][k] = *(const PG8_LAS bf16x8*)(lds + PG8_SB(b, h) + boff + n * 2048 + k * 1024); } while (0)
#define PG8_MMA(ai, bj, At, Bt) do { __builtin_amdgcn_s_setprio(1); _Pragma("unroll") for (int m = 0; m < 4; ++m) _Pragma("unroll") for (int n = 0; n < 2; ++n) _Pragma("unroll") for (int k = 0; k < 2; ++k) \
        acc[ai][bj][m][n] = __builtin_amdgcn_mfma_f32_16x16x32_bf16(Bt[n][k], At[m][k], acc[ai][bj][m][n], 0, 0, 0); __builtin_amdgcn_s_setprio(0); } while (0)
#define PG8_WAIT_V(n) asm volatile("s_waitcnt vmcnt(" #n ")" ::: "memory")
#define PG8_WAIT_L(n) asm volatile("s_waitcnt lgkmcnt(" #n ")" ::: "memory")
#define PG8_BAR __builtin_amdgcn_s_barrier()
#define PG8_SCHED __builtin_amdgcn_sched_barrier(0)
    Unit cur, nxt; int ui = 0;
    if (!S.next(0, cur)) return;
    f32x4 acc[2][2][4][2];
#pragma unroll
    for (int a = 0; a < 2; ++a)
#pragma unroll
        for (int b = 0; b < 2; ++b)
#pragma unroll
            for (int m = 0; m < 4; ++m)
#pragma unroll
                for (int n = 0; n < 2; ++n) acc[a][b][m][n] = (f32x4){0.f, 0.f, 0.f, 0.f};
    bf16x8 At[4][2], B0[2][2], B1[2][2];
    const char* cA = (const char*)g.A + (size_t)cur.pm * tstep; const char* cB = (const char*)g.Bt + (size_t)cur.pn * tstep;
    S.a_ready(cur);
    if constexpr (SP2) {
        PG8_STAGE(PG8_SB(0, 0), cB, voffB); PG8_STAGE(PG8_SB(0, 1), cB + hstep, voffB); PG8_STAGE(PG8_SA(0, 0), cA, voffA); PG8_STAGE(PG8_SA(0, 1), cA + hstep, voffA);
        if (wr == 1) PG8_BAR;
        PG8_WAIT_V(2); PG8_BAR;
        PG8_STAGE(PG8_SB(1, 0), cB + kstep, voffB); PG8_STAGE(PG8_SA(1, 0), cA + kstep, voffA); PG8_STAGE(PG8_SB(1, 1), cB + hstep + kstep, voffB);
        PG8_WAIT_V(6); PG8_BAR;
    } else {
        PG8_STAGE(PG8_SB(0, 0), cB, voffB); PG8_STAGE(PG8_SA(0, 0), cA, voffA); PG8_STAGE(PG8_SB(0, 1), cB + hstep, voffB); PG8_STAGE(PG8_SA(0, 1), cA + hstep, voffA);
        if (wr == 1) PG8_BAR;
        PG8_WAIT_V(4); PG8_BAR;
        PG8_STAGE(PG8_SB(1, 0), cB + kstep, voffB); PG8_STAGE(PG8_SA(1, 0), cA + kstep, voffA); PG8_STAGE(PG8_SB(1, 1), cB + hstep + kstep, voffB);
        PG8_WAIT_V(6); PG8_BAR;
    }
    for (;;) {
        const bool has_next = S.next(ui + 1, nxt);
        const char* nA = has_next ? (const char*)g.A + (size_t)nxt.pm * tstep : cA; const char* nB = has_next ? (const char*)g.Bt + (size_t)nxt.pn * tstep : cB;
        for (int t = 0; t < nt; t += 2) {
            const bool last = (t == nt - 2);
            const char* a1 = cA + (size_t)(t + 1) * kstep;
            const char* a2 = last ? nA : cA + (size_t)(t + 2) * kstep; const char* b2 = last ? nB : cB + (size_t)(t + 2) * kstep;
            const char* a3 = a2 + kstep; const char* b3 = b2 + kstep;
            if (last && has_next) S.a_ready(nxt);
            if constexpr (SP2) {
            PG8_LDB(B0, 0, 0); PG8_LDB(B1, 0, 1); PG8_SCHED; PG8_LDA(At, 0, 0); PG8_STAGE(PG8_SA(1, 1), a1 + hstep, voffA);
            PG8_WAIT_V(8); PG8_WAIT_L(0); PG8_BAR; PG8_MMA(0, 0, At, B0); PG8_MMA(0, 1, At, B1); PG8_BAR; PG8_SCHED;
            PG8_LDA(At, 0, 1); PG8_STAGE(PG8_SB(0, 0), b2, voffB); PG8_STAGE(PG8_SB(0, 1), b2 + hstep, voffB); PG8_STAGE(PG8_SA(0, 0), a2, voffA);
            PG8_WAIT_V(8); PG8_WAIT_L(0); PG8_BAR; PG8_MMA(1, 0, At, B0); PG8_MMA(1, 1, At, B1); PG8_BAR; PG8_SCHED;
            PG8_LDB(B0, 1, 0); PG8_LDB(B1, 1, 1); PG8_SCHED; PG8_LDA(At, 1, 0); PG8_STAGE(PG8_SA(0, 1), a2 + hstep, voffA);
            PG8_WAIT_V(8); PG8_WAIT_L(0); PG8_BAR; PG8_MMA(0, 0, At, B0); PG8_MMA(0, 1, At, B1); PG8_BAR; PG8_SCHED;
            PG8_LDA(At, 1, 1); PG8_STAGE(PG8_SB(1, 0), b3, voffB); PG8_STAGE(PG8_SB(1, 1), b3 + hstep, voffB); PG8_STAGE(PG8_SA(1, 0), a3, voffA);
            PG8_WAIT_V(8); PG8_WAIT_L(0); PG8_BAR; PG8_MMA(1, 0, At, B0); PG8_MMA(1, 1, At, B1); PG8_BAR; PG8_SCHED;
            } else {
            PG8_LDB(B0, 0, 0); PG8_SCHED; PG8_LDA(At, 0, 0); PG8_STAGE(PG8_SA(1, 1), a1 + hstep, voffA);
            PG8_WAIT_L(8); PG8_BAR; PG8_WAIT_L(0); PG8_MMA(0, 0, At, B0); PG8_BAR; PG8_SCHED;
            PG8_LDB(B1, 0, 1); PG8_STAGE(PG8_SB(0, 0), b2, voffB);
            PG8_BAR; PG8_WAIT_L(0); PG8_MMA(0, 1, At, B1); PG8_BAR;
            PG8_LDA(At, 0, 1); PG8_STAGE(PG8_SA(0, 0), a2, voffA);
            PG8_BAR; PG8_WAIT_L(0); PG8_MMA(1, 0, At, B0); PG8_BAR; PG8_SCHED;
            PG8_STAGE(PG8_SB(0, 1), b2 + hstep, voffB);
            PG8_WAIT_V(6); PG8_BAR; PG8_MMA(1, 1, At, B1); PG8_BAR;
            PG8_LDB(B0, 1, 0); PG8_SCHED; PG8_LDA(At, 1, 0); PG8_STAGE(PG8_SA(0, 1), a2 + hstep, voffA);
            PG8_WAIT_L(8); PG8_BAR; PG8_WAIT_L(0); PG8_MMA(0, 0, At, B0); PG8_BAR; PG8_SCHED;
            PG8_LDB(B1, 1, 1); PG8_STAGE(PG8_SB(1, 0), b3, voffB);
            PG8_BAR; PG8_WAIT_L(0); PG8_MMA(0, 1, At, B1); PG8_BAR;
            PG8_LDA(At, 1, 1); PG8_STAGE(PG8_SA(1, 0), a3, voffA);
            PG8_BAR; PG8_WAIT_L(0); PG8_MMA(1, 0, At, B0); PG8_BAR; PG8_SCHED;
            PG8_STAGE(PG8_SB(1, 1), b3 + hstep, voffB);
            PG8_WAIT_V(6); PG8_BAR; PG8_MMA(1, 1, At, B1); PG8_BAR;
            }
        }
        if constexpr (ALIGN_EPI) { if (wr == 0) PG8_BAR; }
        if constexpr (!Epi::AFTER_DRAIN) { E(acc, cur, wr, wc, fr, fq); S.done(cur); }
        if (!has_next) break;
#pragma unroll
        for (int a = 0; a < 2; ++a)
#pragma unroll
            for (int b = 0; b < 2; ++b)
#pragma unroll
                for (int m = 0; m < 4; ++m)
#pragma unroll
                    for (int n = 0; n < 2; ++n) acc[a][b][m][n] = (f32x4){0.f, 0.f, 0.f, 0.f};
        cur = nxt; cA = nA; cB = nB; ++ui;
        if constexpr (ALIGN_EPI) { if (wr == 1) PG8_BAR; }
    }
    PG8_WAIT_V(0);
    if constexpr (!ALIGN_EPI) { if (wr == 0) PG8_BAR; }
    PG8_BAR;
    if constexpr (Epi::AFTER_DRAIN) { E.fused(acc, cur, wr, wc, fr, fq, lds, wid, lane); S.done(cur); }
#undef PG8_SA
#undef PG8_SB
#undef PG8_STAGE
#undef PG8_LDA
#undef PG8_LDB
#undef PG8_MMA
#undef PG8_WAIT_V
#undef PG8_WAIT_L
#undef PG8_BAR
#undef PG8_SCHED
}
}

constexpr int NWAVES = 8, GRID = 256;
constexpr int BATCH = 4, SEQ = 8192, DM = 1024, MTOK = BATCH * SEQ, DEPTH = 4;
constexpr int NA_SRC = 2120, NA_PAD = 2304, NB = 3072, FF = 2816, NUP = 2 * FF;
constexpr float EPS = 1e-6f;
constexpr float LOG2E = 1.4426950408889634f;
constexpr float C2 = 0.125f * LOG2E;
constexpr int NBLK64 = MTOK / 64;

constexpr size_t MiB = 1u << 20;
constexpr size_t WS_CTL = 0, CTL_ZERO_BYTES = 1 * MiB;
constexpr size_t WS_W_INA = 2 * MiB;
constexpr size_t WS_W_INB = 11 * MiB;
constexpr size_t WS_W_OUT = 23 * MiB;
constexpr size_t WS_W_UP = 31 * MiB;
constexpr size_t WS_W_DN = 75 * MiB;
constexpr size_t WS_HB = 98 * MiB;
constexpr size_t WS_M = 162 * MiB;
constexpr size_t WS_SS = 226 * MiB;
constexpr size_t WS_HALO = 228 * MiB;
constexpr size_t WS_PROJ = 272 * MiB;
constexpr size_t WS_END = 464 * MiB;
constexpr size_t PA_QA = 0, PA_KA = 64 * MiB, PA_VA = 80 * MiB, PA_QI = 96 * MiB, PA_KI = 128 * MiB, PA_WI = 132 * MiB, PA_SEL = 136 * MiB;
constexpr size_t PB_STRIDE = 64 * MiB;
constexpr int CW_BAR = 4096;

constexpr int RING_OFF = 0, RING_BYTES = 131072;
constexpr int KS_OFF = RING_BYTES;
constexpr int AUX_OFF = RING_BYTES + 24576;
constexpr int LDSCTL_OFF = AUX_OFF + 4096, MISC_OFF = LDSCTL_OFF + 320;
constexpr int LDS_BYTES = 163840;
static_assert(MISC_OFF + 128 <= LDS_BYTES, "LDS map");

#define GAS __attribute__((address_space(1)))
#define LAS __attribute__((address_space(3)))
typedef unsigned short bf16;
typedef unsigned v4u __attribute__((ext_vector_type(4)));
typedef unsigned v2u __attribute__((ext_vector_type(2)));
typedef float f32x4 __attribute__((ext_vector_type(4)));
typedef float f32x16 __attribute__((ext_vector_type(16)));
typedef short bf16x8 __attribute__((ext_vector_type(8)));
typedef short s16x4 __attribute__((ext_vector_type(4)));
typedef float f32x2_t __attribute__((ext_vector_type(2)));
typedef GAS unsigned gu32;
#define RLX_AGENT __ATOMIC_RELAXED, __HIP_MEMORY_SCOPE_AGENT
#define LDS_WAIT() asm volatile("s_waitcnt lgkmcnt(0)" ::: "memory")
#define VM_WAIT() asm volatile("s_waitcnt vmcnt(0)" ::: "memory")
__device__ __forceinline__ unsigned f2bf(float f) { unsigned u = __builtin_bit_cast(unsigned, f); return (u + 0x7fffu + ((u >> 16) & 1u)) >> 16; }
__device__ __forceinline__ unsigned pk2(float lo, float hi) { return f2bf(lo) | (f2bf(hi) << 16); }
typedef float f32x2c_t __attribute__((ext_vector_type(2))); typedef __bf16 bf16x2c_t __attribute__((ext_vector_type(2)));
__device__ __forceinline__ unsigned cvtpk(float lo, float hi) { const f32x2c_t v = {lo, hi}; const bf16x2c_t b = __builtin_convertvector(v, bf16x2c_t); return __builtin_bit_cast(unsigned, b); }
__device__ __forceinline__ float bf_lo(unsigned u) { return __builtin_bit_cast(float, u << 16); }
__device__ __forceinline__ float bf_hi(unsigned u) { return __builtin_bit_cast(float, u & 0xffff0000u); }

#define XB_TMO      128
#define XB_XCNT(j)  (256  + 64 * (j))
#define XB_XSUB(j)  (1280 + 64 * (j))
#define XB_XGEN(j)  (2304 + 64 * (j))
#define XB_TOP      3328
#define XB_TOPGEN   3392
#define XCD_BAR_WORDS 3456
#define XB_SPIN_CAP (1u << 18)

__device__ __forceinline__ unsigned xb_ld(unsigned* p)              { return __hip_atomic_load(p, __ATOMIC_RELAXED, __HIP_MEMORY_SCOPE_AGENT); }
__device__ __forceinline__ unsigned xb_add(unsigned* p, unsigned v) { return __hip_atomic_fetch_add(p, v, __ATOMIC_RELAXED, __HIP_MEMORY_SCOPE_AGENT); }
__device__ __forceinline__ unsigned xb_xcc_id() { return (unsigned)__builtin_amdgcn_s_getreg((3 << 11) | 20) & 0xFu; }
#define XB_SPIN(cond, bar) do { unsigned _sp = 0; while (cond) { __builtin_amdgcn_s_sleep(1); \
    if ((++_sp & 255u) == 0u) { if (xb_ld(&(bar)[XB_TMO])) break; if (_sp > XB_SPIN_CAP) { atomicAdd(&(bar)[XB_TMO], 1u); break; } } } } while (0)

struct XcdBarrier {
    unsigned* bar; unsigned x;
    volatile LAS unsigned* st;
};

__device__ __forceinline__ XcdBarrier xcd_barrier_post(unsigned* bar, volatile LAS unsigned* st) {
    XcdBarrier b; b.bar = bar; b.x = xb_xcc_id(); b.st = st;
    if (threadIdx.x == 0) (void)xb_add(&bar[XB_XCNT(b.x)], 1u);
    return b;
}
__device__ __forceinline__ void xcd_barrier_complete(unsigned* bar, unsigned x, unsigned& nloc, unsigned& nx) {
    const unsigned G = gridDim.x * gridDim.y * gridDim.z;
    unsigned sum, cnt, mine, sp = 0u;
    for (;;) {
        sum = 0u; cnt = 0u; mine = 0u;
#pragma unroll
        for (unsigned j = 0; j < 16; ++j) { const unsigned c = xb_ld(&bar[XB_XCNT(j)]); sum += c; cnt += (c > 0u) ? 1u : 0u; mine = (j == x) ? c : mine; }
        if (sum == G) break;
        __builtin_amdgcn_s_sleep(1);
        if ((++sp & 255u) == 0u) { if (xb_ld(&bar[XB_TMO])) break; if (sp > XB_SPIN_CAP) { atomicAdd(&bar[XB_TMO], 1u); break; } }
    }
    nloc = mine > 0u ? mine : 1u; nx = cnt > 0u ? cnt : 1u;
}

__device__ __forceinline__ void xcd_barrier(const XcdBarrier& b) {
    asm volatile("s_waitcnt vmcnt(0)" ::: "memory");
    __syncthreads();
    if (threadIdx.x == 0) {
        unsigned* bar = b.bar;
        __builtin_amdgcn_s_waitcnt(0);
        unsigned nloc = b.st[0], nx = b.st[1];
        if (nloc == 0u) { xcd_barrier_complete(bar, b.x, nloc, nx); b.st[0] = nloc; b.st[1] = nx; }
        const unsigned old = xb_add(&bar[XB_XSUB(b.x)], 1u);
        const unsigned gen = old / nloc;
        if (old + 1u == (gen + 1u) * nloc) {
            __builtin_amdgcn_fence(__ATOMIC_RELEASE, "agent");
            asm volatile("s_waitcnt vmcnt(0)" ::: "memory");
            const unsigned og = xb_add(&bar[XB_TOP], 1u);
            const unsigned tg = og / nx;
            if (og + 1u == (tg + 1u) * nx) xb_add(&bar[XB_TOPGEN], 1u);
            else XB_SPIN(xb_ld(&bar[XB_TOPGEN]) == tg, bar);
            __builtin_amdgcn_fence(__ATOMIC_ACQUIRE, "agent");
            xb_add(&bar[XB_XGEN(b.x)], 1u);
            asm volatile("s_waitcnt vmcnt(0)" ::: "memory");
        } else {
            XB_SPIN(xb_ld(&bar[XB_XGEN(b.x)]) == gen, bar);
            __builtin_amdgcn_fence(__ATOMIC_ACQUIRE, "agent");
            asm volatile("s_waitcnt vmcnt(0)" ::: "memory");
        }
    }
    __syncthreads();
}


struct Args {
    const float* x; const float* attn_norm_g; const float* w_in_a; const float* w_in_b; const float* q_norm_g; const float* k_norm_g; const float* t5_bias;
    const float* rel_bias_b; const float* w_out; const float* ffn_norm_g; const float* w_up; const float* conv_w; const float* conv_b; const float* w_down;
    float* out; unsigned char* ws; int ph_lo, ph_hi, li, pad;
};

struct Frame {
    LAS unsigned char* lds;
    volatile LAS unsigned* MISC;
    gu32* ctl;
    int tid, lane, wave, vcu, G;
};

__host__ __device__ __forceinline__ int hmap(int p) { return 64 * ((p >> 5) & 3) + 16 * ((p >> 2) & 3) + 8 * (p >> 7) + 4 * ((p >> 4) & 1) + (p & 3); }
__host__ __device__ __forceinline__ int umap(int p) { return 32 * ((p >> 5) & 3) + 8 * ((p >> 2) & 3) + 4 * ((p >> 4) & 1) + (p & 3); }
__host__ __device__ __forceinline__ int src_col(int type, int n) {
    if (type == 0) return n;
    const int pn = n >> 8, p = n & 255;
    if (type == 2) return 256 * pn + hmap(p);
    if (type == 1) { const int c = hmap(p); return pn < 8 ? 256 * pn + c : (c < 72 ? 2048 + c : -1); }
    return (p >> 7) * FF + 128 * pn + umap(p);
}
__device__ __forceinline__ void convert_item(const float* W, int K, int Nsrc, int Ndst, int type, const float* gain, bf16* WT, LAS float* scr, int item, int lane) {
    const int nblk = Ndst / 32, kb = item / nblk, nb = item % nblk, k0 = 64 * kb, n0 = 32 * nb;
    const int sc = src_col(type, n0 + (lane & 31));
#pragma unroll 8
    for (int i = 0; i < 32; ++i) { const int kk = 2 * i + (lane >> 5); float v = 0.f; if (sc >= 0) v = W[(size_t)(k0 + kk) * Nsrc + sc]; if (gain) v *= gain[k0 + kk]; scr[kk * 33 + (lane & 31)] = v; }
    LDS_WAIT(); asm volatile("" ::: "memory");
    const int c = lane & 7;
#pragma unroll
    for (int j = 0; j < 4; ++j) { const int n = (lane >> 3) + 8 * j; const LAS float* s = scr + (8 * c) * 33 + n;
        v4u o; o.x = pk2(s[0 * 33], s[1 * 33]); o.y = pk2(s[2 * 33], s[3 * 33]); o.z = pk2(s[4 * 33], s[5 * 33]); o.w = pk2(s[6 * 33], s[7 * 33]);
        *(v4u*)(WT + (size_t)(n0 + n) * K + k0 + 8 * c) = o; }
    LDS_WAIT(); asm volatile("" ::: "memory");
}
__device__ __forceinline__ float wave_sum(float v) {
#pragma unroll
    for (int o = 1; o < 64; o <<= 1) v += __shfl_xor(v, o);
    return v;
}
__device__ __forceinline__ void p0_prologue(Frame& F, const Args& a) {
    LAS float* scr = (LAS float*)(F.lds + RING_OFF + F.wave * 16384);
    const int gw = F.vcu * NWAVES + F.wave, NGW = F.G * NWAVES;
    constexpr int I_INA = 16 * (NA_PAD / 32), I_INB = 16 * (NB / 32), I_OUT = 16 * 32, I_UP = 16 * (NUP / 32), I_DN = (FF / 64) * 32;
    constexpr int NITEMS = 2 * I_INA + 2 * I_INB + 4 * I_OUT + 4 * I_UP + 4 * I_DN;
    unsigned char* ws = a.ws;
    for (int it = gw; it < NITEMS; it += NGW) {
        int r = it;
        if (r < 2 * I_INA) { const int l = r / I_INA; convert_item(a.w_in_a + (size_t)l * DM * NA_SRC, DM, NA_SRC, NA_PAD, 1, a.attn_norm_g + (2 * l) * DM, (bf16*)(ws + WS_W_INA) + (size_t)l * NA_PAD * DM, scr, r % I_INA, F.lane); continue; } r -= 2 * I_INA;
        if (r < 2 * I_INB) { const int l = r / I_INB; convert_item(a.w_in_b + (size_t)l * DM * NB, DM, NB, NB, 2, a.attn_norm_g + (2 * l + 1) * DM, (bf16*)(ws + WS_W_INB) + (size_t)l * NB * DM, scr, r % I_INB, F.lane); continue; } r -= 2 * I_INB;
        if (r < 4 * I_OUT) { const int l = r / I_OUT; convert_item(a.w_out + (size_t)l * DM * DM, DM, DM, DM, 0, nullptr, (bf16*)(ws + WS_W_OUT) + (size_t)l * DM * DM, scr, r % I_OUT, F.lane); continue; } r -= 4 * I_OUT;
        if (r < 4 * I_UP) { const int l = r / I_UP; convert_item(a.w_up + (size_t)l * DM * NUP, DM, NUP, NUP, 3, a.ffn_norm_g + l * DM, (bf16*)(ws + WS_W_UP) + (size_t)l * NUP * DM, scr, r % I_UP, F.lane); continue; } r -= 4 * I_UP;
        { const int l = r / I_DN; convert_item(a.w_down + (size_t)l * FF * DM, FF, DM, DM, 0, nullptr, (bf16*)(ws + WS_W_DN) + (size_t)l * DM * FF, scr, r % I_DN, F.lane); }
    }
    bf16* hb = (bf16*)(ws + WS_HB); float* ss = (float*)(ws + WS_SS);
    for (int m = gw; m < MTOK; m += NGW) {
        const f32x4* xr = (const f32x4*)(a.x + (size_t)m * DM) + F.lane; f32x4 v[4]; float s = 0.f;
#pragma unroll
        for (int j = 0; j < 4; ++j) { v[j] = xr[64 * j]; s += (v[j].x * v[j].x + v[j].y * v[j].y) + (v[j].z * v[j].z + v[j].w * v[j].w); }
        s = wave_sum(s);
        v2u* o8 = (v2u*)(hb + (size_t)m * DM) + F.lane;
#pragma unroll
        for (int j = 0; j < 4; ++j) { v2u w; w.x = pk2(v[j].x, v[j].y); w.y = pk2(v[j].z, v[j].w); o8[64 * j] = w; }
        if (F.lane < 16) ss[(size_t)m * 16 + F.lane] = (F.lane == 0) ? s : 0.f;
    }
}

__device__ __forceinline__ f32x4 rstd_load(const float* ss, int row, int fq) { return *(const f32x4*)(ss + (size_t)row * 16 + 4 * fq); }
__device__ __forceinline__ float rstd_finish(f32x4 a) {
    float s = (a.x + a.y) + (a.z + a.w);
    s += __shfl_xor(s, 16); s += __shfl_xor(s, 32);
    return __builtin_amdgcn_rsqf(s * (1.0f / DM) + EPS);
}
__device__ __forceinline__ float row_rstd(const float* ss, int row, int fq) { return rstd_finish(rstd_load(ss, row, fq)); }
__device__ __forceinline__ unsigned att_pk4(f32x4 v) { int r = __builtin_amdgcn_cvt_pk_fp8_f32(v.x, v.y, 0, false); r = __builtin_amdgcn_cvt_pk_fp8_f32(v.z, v.w, r, true); return (unsigned)r; }
struct EpiIn {
    static constexpr bool PERM = false, PERMA = false, AFTER_DRAIN = false;
    const float* ss; unsigned char* proj; const float* qg; const float* kg; int isB;
    __device__ __forceinline__ void operator()(const pg8::f32x4 (&acc)[2][2][4][2], const pg8::Unit& u, int wr, int wc, int fr, int fq) const {
        asm volatile("" : "+v"(fr), "+v"(fq));
        const int pn = u.pn; int kind, pitch; bf16* dst;
        if (isB) { const int t = pn >> 2; kind = (t == 0) ? 1 : (t == 1 ? 2 : 0); dst = (bf16*)(proj + (size_t)t * PB_STRIDE) + 256 * (pn & 3); pitch = DM; }
        else if (pn < 4) { kind = 1; dst = (bf16*)(proj + PA_QA) + 256 * pn; pitch = DM; }
        else if (pn == 4) { kind = 2; dst = (bf16*)(proj + PA_KA); pitch = 256; }
        else if (pn == 5) { kind = 0; dst = (bf16*)(proj + PA_VA); pitch = 256; }
        else if (pn < 8) { kind = 0; dst = (bf16*)(proj + PA_QI) + 256 * (pn - 6); pitch = 512; }
        else { kind = 3; dst = (bf16*)(proj + PA_KI); pitch = 64; }
        if (kind == 3 && wc >= 2) return;
        const bool donorm = (kind == 1) || (kind == 2) || (kind == 3 && wc == 0);
        f32x4 g[2][2];
#pragma unroll
        for (int bj = 0; bj < 2; ++bj)
#pragma unroll
            for (int n = 0; n < 2; ++n) {
                if (kind == 1) g[bj][n] = *(const f32x4*)(qg + 16 * fq + 8 * bj + 4 * n) * (isB ? C2 : 1.0f);
                else if (kind == 2) g[bj][n] = *(const f32x4*)(kg + 16 * fq + 8 * bj + 4 * n);
                else g[bj][n] = (f32x4){1.f, 1.f, 1.f, 1.f};
            }
        float* wi = (float*)(proj + PA_WI);
        f32x4 rsl[2][4];
#pragma unroll
        for (int ai = 0; ai < 2; ++ai)
#pragma unroll
            for (int m = 0; m < 4; ++m) rsl[ai][m] = rstd_load(ss, u.pm * 256 + ai * 128 + wr * 64 + m * 16 + fr, fq);
#pragma unroll
        for (int ai = 0; ai < 2; ++ai)
#pragma unroll
            for (int m = 0; m < 4; ++m) {
                const int row = u.pm * 256 + ai * 128 + wr * 64 + m * 16 + fr;
                const float rs = rstd_finish(rsl[ai][m]);
                f32x4 v[2][2]; float s = 0.f;
#pragma unroll
                for (int bj = 0; bj < 2; ++bj)
#pragma unroll
                    for (int n = 0; n < 2; ++n) { v[bj][n] = acc[ai][bj][m][n] * rs; const f32x4 q = v[bj][n] * v[bj][n]; s += (q.x + q.y) + (q.z + q.w); }
                if (donorm) {
                    s += __shfl_xor(s, 16); s += __shfl_xor(s, 32);
                    const float r = 1.0f / sqrtf(s * (1.0f / 64.0f) + EPS);
#pragma unroll
                    for (int bj = 0; bj < 2; ++bj)
#pragma unroll
                        for (int n = 0; n < 2; ++n) v[bj][n] = v[bj][n] * r * g[bj][n];
                }
                if (kind == 3 && wc == 1) {
                    if (fq == 0) { float* wp = wi + (size_t)row * 8; const float sc = 0.04419417382415922f;
                        *(f32x4*)(wp) = v[0][0] * sc; *(f32x4*)(wp + 4) = v[0][1] * sc; }
                } else if (!isB && pn < 6) {
                    unsigned char* p8 = (pn < 4) ? proj + PA_QA + (size_t)row * 1024 + 256 * pn + 64 * wc + 16 * fq : proj + PA_KA + (size_t)row * 512 + 128 * wc + 64 * (pn - 4) + 16 * fq;
                    v4u w; w.x = att_pk4(v[0][0]); w.y = att_pk4(v[0][1]); w.z = att_pk4(v[1][0]); w.w = att_pk4(v[1][1]);
                    *(v4u*)p8 = w;
                } else {
                    bf16* rp = dst + (size_t)row * pitch + 64 * wc + 16 * fq;
#pragma unroll
                    for (int bj = 0; bj < 2; ++bj) { v4u w; w.x = cvtpk(v[bj][0].x, v[bj][0].y); w.y = cvtpk(v[bj][0].z, v[bj][0].w); w.z = cvtpk(v[bj][1].x, v[bj][1].y); w.w = cvtpk(v[bj][1].z, v[bj][1].w);
                        *(v4u*)(rp + 8 * bj) = w; }
                }
            }
    }
};
struct EpiRes {
    static constexpr bool PERM = false, PERMA = false, AFTER_DRAIN = false;
    const float* xin; float* fout; const bf16* hbi; bf16* hb; float* ss;
    __device__ __forceinline__ void operator()(const pg8::f32x4 (&acc)[2][2][4][2], const pg8::Unit& u, int wr, int wc, int fr, int fq) const {
        asm volatile("" : "+v"(fr), "+v"(fq));
        const int col0 = u.pn * 256 + wc * 32 + 4 * fq;
#pragma unroll
        for (int ai = 0; ai < 2; ++ai)
#pragma unroll
            for (int m = 0; m < 4; ++m) {
                const int row = u.pm * 256 + ai * 128 + wr * 64 + m * 16 + fr; const size_t off = (size_t)row * DM + col0; float s = 0.f;
#pragma unroll
                for (int bj = 0; bj < 2; ++bj)
#pragma unroll
                    for (int n = 0; n < 2; ++n) { const size_t o4 = off + bj * 128 + n * 16; f32x4 base;
                        if (xin) base = *(const f32x4*)(xin + o4); else { const v2u b = *(const v2u*)(hbi + o4); base = (f32x4){bf_lo(b.x), bf_hi(b.x), bf_lo(b.y), bf_hi(b.y)}; }
                        const f32x4 o = base + acc[ai][bj][m][n];
                        if (fout) *(f32x4*)(fout + o4) = o;
                        else { const f32x4 q = o * o; s += (q.x + q.y) + (q.z + q.w); v2u w; w.x = cvtpk(o.x, o.y); w.y = cvtpk(o.z, o.w); *(v2u*)(hb + o4) = w; } }
                if (!fout) { s += __shfl_xor(s, 16); s += __shfl_xor(s, 32); if (fq == 0) ss[(size_t)row * 16 + u.pn * 4 + wc] = s; }
            }
    }
};
#ifdef X_NOBPERM
__device__ __forceinline__ float lane_from(int byteaddr, float v) { return v + (float)byteaddr; }
#else
__device__ __forceinline__ float lane_from(int byteaddr, float v) { return __builtin_bit_cast(float, __builtin_amdgcn_ds_bpermute(byteaddr, __builtin_bit_cast(int, v))); }
#endif
#ifdef X_NOSILU
__device__ __forceinline__ float silu_mul(float a, float g) { return a * g; }
#else
__device__ __forceinline__ float silu_mul(float a, float g) { return a * g * __builtin_amdgcn_rcpf(1.0f + __builtin_amdgcn_exp2f(-g * LOG2E)); }
#endif
__device__ __forceinline__ float dpp_prev_lane(float v) { return __builtin_bit_cast(float, __builtin_amdgcn_update_dpp(0, __builtin_bit_cast(int, v), 0x111  , 0xf, 0xf, true)); }
struct EpiUp {
    static constexpr bool PERM = false, PERMA = true, AFTER_DRAIN = false;
    const float* ss; const float* cw; const float* cb; bf16* act; float* halo; LAS float* cl;
    __device__ __forceinline__ void operator()(const pg8::f32x4 (&acc)[2][2][4][2], const pg8::Unit& u, int wr, int wc, int fr, int fq) const {
        asm volatile("" : "+v"(fr), "+v"(fq));
        const int colb = u.pn * 128 + wc * 32 + 8 * fq;
        const int tid_ = ((wr * 4 + wc) * 4 + fq) * 16 + fr, ce = 2 * tid_, cbj = ce >> 9, carr = (ce >> 7) & 3, cc = ce & 127;
        const f32x2_t cpre = *(const f32x2_t*)((carr < 3 ? cw + carr * NUP : cb) + cbj * FF + u.pn * 128 + cc);
        f32x4 rsl[2][4];
#pragma unroll
        for (int ai = 0; ai < 2; ++ai)
#pragma unroll
            for (int m = 0; m < 4; ++m) rsl[ai][m] = rstd_load(ss, (u.pm * 4 + ai * 2 + wr) * 64 + 4 * fr + m, fq);
        unsigned pk[2][2][4][2][2];
#pragma unroll
        for (int ai = 0; ai < 2; ++ai) {
#pragma unroll
            for (int m = 0; m < 4; ++m) {
                const float rs = rstd_finish(rsl[ai][m]);
#pragma unroll
                for (int bj = 0; bj < 2; ++bj)
#pragma unroll
                    for (int n = 0; n < 2; ++n) { const f32x4 v = acc[ai][bj][m][n] * rs; pk[ai][bj][m][n][0] = cvtpk(v.x, v.y); pk[ai][bj][m][n][1] = cvtpk(v.z, v.w); }
            }
        }
        *(LAS f32x2_t*)(cl + ce) = cpre;
        asm volatile("s_waitcnt lgkmcnt(0)" ::: "memory"); __builtin_amdgcn_s_barrier(); asm volatile("" ::: "memory");
        __builtin_amdgcn_sched_barrier(0);
        if (fr == 0 || fr == 15) {
#pragma unroll
            for (int ai = 0; ai < 2; ++ai)
#pragma unroll
                for (int j = 0; j < 2; ++j)
#pragma unroll
                    for (int bj = 0; bj < 2; ++bj)
#pragma unroll
                        for (int n = 0; n < 2; ++n) { const unsigned w0 = (fr == 0) ? pk[ai][bj][j][n][0] : pk[ai][bj][2 + j][n][0], w1 = (fr == 0) ? pk[ai][bj][j][n][1] : pk[ai][bj][2 + j][n][1];
                            *(f32x4*)(halo + ((size_t)(u.pm * 4 + ai * 2 + wr) * 4 + (fr == 0 ? j : 2 + j)) * NUP + bj * FF + colb + 4 * n) = (f32x4){bf_lo(w0), bf_hi(w0), bf_lo(w1), bf_hi(w1)}; }
        }
        __builtin_amdgcn_sched_barrier(0);
#pragma unroll
        for (int ai = 0; ai < 2; ++ai) {
            const int row0 = (u.pm * 4 + ai * 2 + wr) * 64 + 4 * fr;
            unsigned outp[4][2][2];
#pragma unroll
            for (int n = 0; n < 2; ++n) {
#pragma unroll
                for (int ip = 0; ip < 2; ++ip) {
                    f32x2_t k0[2], k1[2], k2[2], kb[2];
#pragma unroll
                    for (int bj = 0; bj < 2; ++bj) { const LAS float* c = cl + bj * 512 + wc * 32 + 8 * fq + 4 * n + 2 * ip; k0[bj] = *(const LAS f32x2_t*)(c); k1[bj] = *(const LAS f32x2_t*)(c + 128); k2[bj] = *(const LAS f32x2_t*)(c + 256); kb[bj] = *(const LAS f32x2_t*)(c + 384); }
                    float y[2][4][2];
#pragma unroll
                    for (int bj = 0; bj < 2; ++bj) {
                        const unsigned w0 = pk[ai][bj][0][n][ip], w1 = pk[ai][bj][1][n][ip], w2 = pk[ai][bj][2][n][ip], w3 = pk[ai][bj][3][n][ip];
                        const unsigned q1 = (unsigned)__builtin_amdgcn_update_dpp(0, (int)w3, 0x111, 0xf, 0xf, true), q2 = (unsigned)__builtin_amdgcn_update_dpp(0, (int)w2, 0x111, 0xf, 0xf, true);
#pragma unroll
                        for (int e = 0; e < 2; ++e) { const int i = e;
                            const float u0 = e ? bf_hi(w0) : bf_lo(w0), u1 = e ? bf_hi(w1) : bf_lo(w1), u2 = e ? bf_hi(w2) : bf_lo(w2), u3 = e ? bf_hi(w3) : bf_lo(w3), p1 = e ? bf_hi(q1) : bf_lo(q1), p2 = e ? bf_hi(q2) : bf_lo(q2);
                            y[bj][0][e] = kb[bj][i] + k0[bj][i] * p2 + k1[bj][i] * p1 + k2[bj][i] * u0;
                            y[bj][1][e] = kb[bj][i] + k0[bj][i] * p1 + k1[bj][i] * u0 + k2[bj][i] * u1;
                            y[bj][2][e] = kb[bj][i] + k0[bj][i] * u0 + k1[bj][i] * u1 + k2[bj][i] * u2;
                            y[bj][3][e] = kb[bj][i] + k0[bj][i] * u1 + k1[bj][i] * u2 + k2[bj][i] * u3; }
                    }
#pragma unroll
                    for (int m = 0; m < 4; ++m) outp[m][n][ip] = cvtpk(silu_mul(y[0][m][0], y[1][m][0]), silu_mul(y[0][m][1], y[1][m][1]));
                }
            }
#pragma unroll
            for (int m = 0; m < 4; ++m) {
                if (m < 2 && fr == 0) continue;
                v4u w; w.x = outp[m][0][0]; w.y = outp[m][0][1]; w.z = outp[m][1][0]; w.w = outp[m][1][1];
                *(v4u*)(act + (size_t)(row0 + m) * FF + colb) = w;
            }
            asm volatile("" ::: "memory");
        }
    }
};
struct EpiDummy {
    static constexpr bool PERM = false, PERMA = true, AFTER_DRAIN = false;
    float* scratch;
    __device__ __forceinline__ void operator()(const pg8::f32x4 (&acc)[2][2][4][2], const pg8::Unit& u, int wr, int wc, int fr, int fq) const {
        f32x4 s = (f32x4){0.f, 0.f, 0.f, 0.f};
#pragma unroll
        for (int ai = 0; ai < 2; ++ai)
#pragma unroll
            for (int bj = 0; bj < 2; ++bj)
#pragma unroll
                for (int m = 0; m < 4; ++m)
#pragma unroll
                    for (int n = 0; n < 2; ++n) s += acc[ai][bj][m][n];
        scratch[(size_t)(u.pm * 22 + u.pn) * 512 + ((wr * 4 + wc) * 4 + fq) * 16 + fr] = (s.x + s.y) + (s.z + s.w);
    }
};
__device__ __forceinline__ void fixup_phase(Frame& F, const float* cw, const float* cb, const float* halo, bf16* act) {
    const int gt = F.vcu * (NWAVES * 64) + F.tid, NT = F.G * NWAVES * 64;
    constexpr int C4 = FF / 4;
    for (int it = gt; it < NBLK64 * 2 * C4; it += NT) {
        const int c = (it % C4) * 4, rj = it / C4, j = rj & 1, blk = rj >> 1, t = blk * 64 + j, tb = t % SEQ;
        f32x4 y[2];
#pragma unroll
        for (int bj = 0; bj < 2; ++bj) {
            const int cc = bj * FF + c;
            const f32x4 z = (f32x4){0.f, 0.f, 0.f, 0.f};
            const f32x4 ut = *(const f32x4*)(halo + ((size_t)blk * 4 + j) * NUP + cc);
            f32x4 u1, u2;
            if (j == 1) { u1 = *(const f32x4*)(halo + ((size_t)blk * 4 + 0) * NUP + cc); u2 = (tb == 1) ? z : *(const f32x4*)(halo + ((size_t)(blk - 1) * 4 + 3) * NUP + cc); }
            else { u1 = (tb == 0) ? z : *(const f32x4*)(halo + ((size_t)(blk - 1) * 4 + 3) * NUP + cc); u2 = (tb == 0) ? z : *(const f32x4*)(halo + ((size_t)(blk - 1) * 4 + 2) * NUP + cc); }
            y[bj] = *(const f32x4*)(cb + cc) + *(const f32x4*)(cw + cc) * u2 + *(const f32x4*)(cw + NUP + cc) * u1 + *(const f32x4*)(cw + 2 * NUP + cc) * ut;
        }
        v2u w; w.x = cvtpk(silu_mul(y[0].x, y[1].x), silu_mul(y[0].y, y[1].y)); w.y = cvtpk(silu_mul(y[0].z, y[1].z), silu_mul(y[0].w, y[1].w));
        *(v2u*)(act + (size_t)t * FF + c) = w;
    }
}

__device__ __forceinline__ int crow(int r, int hi) { return (r & 3) + 8 * (r >> 2) + 4 * hi; }
__device__ __forceinline__ void glds16(const void* gsrc, unsigned lds_dst) { unsigned keep;
    asm volatile("s_mov_b32 %0, m0\n\ts_mov_b32 m0, %2\n\ts_nop 0\n\tglobal_load_lds_dwordx4 %1, off\n\ts_mov_b32 m0, %0" : "=&s"(keep) : "v"(gsrc), "s"(lds_dst) : "memory"); }
__device__ __forceinline__ float max3f(float a, float b, float c) { return fmaxf(fmaxf(a, b), c); }

namespace band {
constexpr int SLOTB = 8192;
constexpr int LDS_K = 0, LDS_V = 2 * SLOTB, LDS_WS = 4 * SLOTB, LDS_TB = LDS_WS + NWAVES * 64 * 4, LDS_OST = LDS_TB + 640 * 4 + 512, LDS_END = LDS_OST + NWAVES * 4096;
static_assert(LDS_END <= RING_BYTES, "band LDS");
__device__ __forceinline__ void unit(Frame& F, int b, int h, int U, const bf16* Q, const bf16* K, const bf16* V, bf16* O, const float* rel) {
    const int tid = F.tid, lane = F.lane, r32 = lane & 31, hi = lane >> 5, wid = F.wave;
    LAS unsigned char* shm = F.lds + RING_OFF;
    const unsigned lds0 = (unsigned)(uintptr_t)shm;
    const long rowbase = (long)b * SEQ; const int q0 = U * 256, c0 = 4 * U, cq = c0 + (wid >> 1);
    const bf16* Qw = Q + (rowbase + q0 + wid * 32) * DM + h * 64;
    const bf16* Kh = K + rowbase * DM + h * 64; const bf16* Vh = V + rowbase * DM + h * 64;
    LAS float* wsf = (LAS float*)(shm + LDS_WS) + wid * 64;
    LAS float* tb = (LAS float*)(shm + LDS_TB);
    const bf16* ksrc = Kh + (long)lane * DM + wid * 8;
    const bf16* vsrc = Vh + (long)(16 * (wid & 3) + (lane >> 2)) * DM + (wid >> 2) * 32 + (lane & 3) * 8;
    const unsigned kdst = lds0 + LDS_K + wid * 1024, vdst = lds0 + LDS_V + wid * 1024;
    const int lo = (c0 - 8 > 0) ? c0 - 8 : 0, hiT = c0 + 3, NT = hiT - lo + 1, t0 = (c0 - 5 > 0) ? c0 - 5 : 0;
#define BAND_KT(i) ((t0 + (i) <= hiT) ? t0 + (i) : lo + (t0 + (i) - hiT - 1))
    for (int i = tid; i < 640; i += NWAVES * 64) { int d = i - 64; d = d < -256 ? -256 : (d > 256 ? 256 : d); tb[i] = rel[(d + 256) * 16 + h] * LOG2E; }
    { const int kt = BAND_KT(0); glds16(ksrc + (long)kt * 64 * DM, (unsigned)__builtin_amdgcn_readfirstlane(kdst)); glds16(vsrc + (long)kt * 64 * DM, (unsigned)__builtin_amdgcn_readfirstlane(vdst)); }
    bf16x8 qr[4];
#pragma unroll
    for (int d0 = 0; d0 < 4; ++d0) qr[d0] = *(const bf16x8*)(Qw + (long)r32 * DM + d0 * 16 + hi * 8);
    float m_run = -INFINITY, l_run = 0.f; f32x16 o[2]; o[0] = f32x16{}; o[1] = f32x16{};
    const int qpos = q0 + wid * 32 + r32;
    const LAS unsigned char* vbase = shm + LDS_V + ((lane >> 4) & 1) * 32 + (lane & 3) * 8 + (4 * hi + ((lane & 15) >> 2)) * 64;
    for (int i = 0; i < NT; ++i) {
        asm volatile("s_waitcnt vmcnt(0) lgkmcnt(0)\n\ts_barrier" ::: "memory");
        if (i + 1 < NT) { const int kt = BAND_KT(i + 1); const unsigned so = ((i + 1) & 1) * SLOTB;
            glds16(ksrc + (long)kt * 64 * DM, (unsigned)__builtin_amdgcn_readfirstlane(kdst + so)); glds16(vsrc + (long)kt * 64 * DM, (unsigned)__builtin_amdgcn_readfirstlane(vdst + so)); }
        const int kt = BAND_KT(i);
        if (kt < cq - 8 || kt > cq) continue;
        const int so = (i & 1) * SLOTB;
        f32x16 p0 = f32x16{}, p1 = f32x16{};
        { const LAS unsigned char* kb = shm + LDS_K + so + hi * 1024 + r32 * 16;
#pragma unroll
          for (int d0 = 0; d0 < 4; ++d0) { const bf16x8 b0 = *(const LAS bf16x8*)(kb + d0 * 2048), b1 = *(const LAS bf16x8*)(kb + d0 * 2048 + 512);
              p0 = __builtin_amdgcn_mfma_f32_32x32x16_bf16(b0, qr[d0], p0, 0, 0, 0); p1 = __builtin_amdgcn_mfma_f32_32x32x16_bf16(b1, qr[d0], p1, 0, 0, 0); } }
        { const int ib = qpos - 64 * kt + 64 - 4 * hi;
#pragma unroll
          for (int r = 0; r < 16; ++r) { const int ix = ib - ((r & 3) + 8 * (r >> 2)); p0[r] += tb[ix]; p1[r] += tb[ix - 32]; } }
        float rm = p0[0];
#pragma unroll
        for (int r = 0; r < 16; ++r) rm = max3f(rm, p0[r], p1[r]);
        { auto rr = __builtin_amdgcn_permlane32_swap(__float_as_uint(rm), __float_as_uint(rm), false, false); rm = fmaxf(__uint_as_float(rr[0]), __uint_as_float(rr[1])); }
        const float mnew = fmaxf(m_run, rm), f = __builtin_amdgcn_exp2f(m_run - mnew); m_run = mnew;
        float sacc = 0.f;
#pragma unroll
        for (int r = 0; r < 16; ++r) { p0[r] = __builtin_amdgcn_exp2f(p0[r] - mnew); p1[r] = __builtin_amdgcn_exp2f(p1[r] - mnew); sacc += p0[r] + p1[r]; }
        l_run = l_run * f + sacc;
        if (hi == 0) wsf[r32] = f;
        LDS_WAIT();
#pragma unroll
        for (int r = 0; r < 16; ++r) { const float fr_ = wsf[crow(r, hi)]; o[0][r] *= fr_; o[1][r] *= fr_; }
        v4u pw[4];
        pw[0] = (v4u){cvtpk(p0[0], p0[1]), cvtpk(p0[2], p0[3]), cvtpk(p0[4], p0[5]), cvtpk(p0[6], p0[7])};
        pw[1] = (v4u){cvtpk(p0[8], p0[9]), cvtpk(p0[10], p0[11]), cvtpk(p0[12], p0[13]), cvtpk(p0[14], p0[15])};
        pw[2] = (v4u){cvtpk(p1[0], p1[1]), cvtpk(p1[2], p1[3]), cvtpk(p1[4], p1[5]), cvtpk(p1[6], p1[7])};
        pw[3] = (v4u){cvtpk(p1[8], p1[9]), cvtpk(p1[10], p1[11]), cvtpk(p1[12], p1[13]), cvtpk(p1[14], p1[15])};
        const LAS unsigned char* vb = vbase + so;
#pragma unroll
        for (int d0 = 0; d0 < 2; ++d0)
#pragma unroll
            for (int ks = 0; ks < 4; ++ks) {
                const s16x4 vlo = __builtin_bit_cast(s16x4, __builtin_amdgcn_ds_read_tr16_b64_v4i16((LAS s16x4*)(vb + d0 * 4096 + ks * 1024)));
                const s16x4 vhi = __builtin_bit_cast(s16x4, __builtin_amdgcn_ds_read_tr16_b64_v4i16((LAS s16x4*)(vb + d0 * 4096 + ks * 1024 + 512)));
                const bf16x8 vf = (bf16x8){vlo[0], vlo[1], vlo[2], vlo[3], vhi[0], vhi[1], vhi[2], vhi[3]};
                o[d0] = __builtin_amdgcn_mfma_f32_32x32x16_bf16(__builtin_bit_cast(bf16x8, pw[ks]), vf, o[d0], 0, 0, 0);
            }
    }
#undef BAND_KT
    { auto rr = __builtin_amdgcn_permlane32_swap(__float_as_uint(l_run), __float_as_uint(l_run), false, false); l_run = __uint_as_float(rr[0]) + __uint_as_float(rr[1]); }
    if (hi == 0) wsf[32 + r32] = l_run;
    LDS_WAIT();
    float rli[16];
#pragma unroll
    for (int r = 0; r < 16; ++r) rli[r] = __builtin_amdgcn_rcpf(wsf[32 + crow(r, hi)]);
    bf16* Ow = O + (rowbase + q0 + wid * 32) * DM + h * 64;
    { LAS bf16* stg = (LAS bf16*)(shm + LDS_OST) + wid * 2048;
#pragma unroll
      for (int r = 0; r < 16; ++r) { const int orow = crow(r, hi);
#pragma unroll
          for (int d0 = 0; d0 < 2; ++d0) stg[orow * 64 + d0 * 32 + r32] = (bf16)f2bf(o[d0][r] * rli[r]); }
      LDS_WAIT();
#pragma unroll
      for (int i = 0; i < 4; ++i) { const int row = i * 8 + (lane >> 3), ch = lane & 7; const v4u v = *(const LAS v4u*)(stg + row * 64 + ch * 8); *(v4u*)(Ow + (long)row * DM + ch * 8) = v; } }
    asm volatile("s_waitcnt lgkmcnt(0)\n\ts_barrier" ::: "memory");
}
__device__ __forceinline__ void phase(Frame& F, const bf16* Q, const bf16* K, const bf16* V, bf16* O, const float* rel) {
    const int NU = BATCH * 16 * 32, per = (NU + F.G - 1) / F.G;
    for (int i = 0; i < per; ++i) { const int uid = F.vcu * per + i; if (uid >= NU) break; unit(F, uid >> 9, (uid >> 5) & 15, uid & 31, Q, K, V, O, rel); }
}
}

namespace dsa {
__device__ __forceinline__ unsigned okey(float s) { const unsigned u = __float_as_uint(s + 0.0f); return (u & 0x80000000u) ? ~u : (u | 0x80000000u); }
struct Ctx { const bf16* QA; const bf16* KA; const bf16* VA; const bf16* QI; const bf16* KI; const float* WI; bf16* M; const LAS float* t5l; unsigned short* SEL; };

__device__ __forceinline__ void scan_hist(const LAS unsigned* hq, int lane, unsigned need, unsigned& bin, unsigned& above) {
    const LAS v4u* hp = (const LAS v4u*)hq + lane * 4;
    unsigned wds[16];
#pragma unroll
    for (int j = 0; j < 4; ++j) { const v4u t = hp[j]; wds[4 * j] = t.x; wds[4 * j + 1] = t.y; wds[4 * j + 2] = t.z; wds[4 * j + 3] = t.w; }
    unsigned tl = 0;
#pragma unroll
    for (int j = 0; j < 16; ++j) tl += (wds[j] & 0xffffu) + (wds[j] >> 16);
    unsigned suf = tl;
#pragma unroll
    for (int o = 1; o < 64; o <<= 1) { const unsigned v = __shfl_down(suf, o); if (lane + o < 64) suf += v; }
    const unsigned S = suf - tl;
    const bool cross = (S < need) && (need <= S + tl);
    unsigned c = S, bsel = 0, ab = 0; bool found = false;
#pragma unroll
    for (int k = 31; k >= 0; --k) { const unsigned cnt = (wds[k >> 1] >> (16 * (k & 1))) & 0xffffu; if (!found && c + cnt >= need) { bsel = 32 * lane + k; ab = c; found = true; } c += cnt; }
    const unsigned long long bal = __ballot(cross);
    const int src = bal ? __builtin_ctzll(bal) : 0;
    bin = __shfl(bsel, src); above = __shfl(ab, src);
}

__device__ __forceinline__ void attend(const Ctx& C, const LAS unsigned short* sq, int nvalid, long rowbase, long token, int tpos, int lane, int g0) {
    asm volatile("" : "+v"(lane));
    const int l15 = lane & 15, l4 = lane >> 4;
    int sidx[16];
#pragma unroll
    for (int ti = 0; ti < 16; ++ti) sidx[ti] = sq[ti * 16 + l15];
    unsigned bpk[4] = {0u, 0u, 0u, 0u};
#pragma unroll
    for (int ti = 0; ti < 16; ++ti) { const int rel = sidx[ti] - tpos, n = rel < 0 ? -rel : rel;
        const int bk = (rel > 0 ? 16 : 0) + (n < 8 ? n : 8 + (n >= 12) + (n >= 16) + (n >= 23) + (n >= 32) + (n >= 46) + (n >= 64) + (n >= 91));
        bpk[ti >> 2] |= (unsigned)bk << (8 * (ti & 3)); }
#pragma unroll 1
    for (int g = g0; g < g0 + 2; ++g) {
        const bf16* qp = C.QA + token * DM + (4 * g + (lane & 3)) * 64 + 8 * l4;
        const bf16x8 qf0 = *(const bf16x8*)qp, qf1 = *(const bf16x8*)(qp + 32);
        const bf16* kbase = C.KA + rowbase * 256 + g * 64 + 8 * l4;
        f32x4 S[16];
#pragma unroll
        for (int hh = 0; hh < 4; ++hh) {
            bf16x8 kf0[4], kf1[4];
#pragma unroll
            for (int j = 0; j < 4; ++j) { const bf16* kp = kbase + (long)sidx[hh * 4 + j] * 256; kf0[j] = *(const bf16x8*)kp; kf1[j] = *(const bf16x8*)(kp + 32); }
#pragma unroll
            for (int j = 0; j < 4; ++j) { const int ti = hh * 4 + j;
                f32x4 a = *(const LAS f32x4*)(C.t5l + ((bpk[hh] >> (8 * j)) & 255u) * 16 + 4 * g);
                asm volatile("v_mfma_f32_16x16x32_bf16 %0, %1, %2, %0" : "+v"(a) : "v"(qf0), "v"(kf0[j]));
                asm volatile("v_mfma_f32_16x16x32_bf16 %0, %1, %2, %0" : "+v"(a) : "v"(qf1), "v"(kf1[j]));
                S[ti] = a; }
            asm volatile("s_nop 15\n\ts_nop 7" : "+v"(S[hh * 4]), "+v"(S[hh * 4 + 1]), "+v"(S[hh * 4 + 2]), "+v"(S[hh * 4 + 3]));
        }
#pragma unroll
        for (int ti = 0; ti < 16; ++ti) if (ti * 16 >= nvalid) S[ti] = (f32x4){-INFINITY, -INFINITY, -INFINITY, -INFINITY};
        f32x4 mx = S[0];
#pragma unroll
        for (int ti = 1; ti < 16; ++ti) { mx.x = fmaxf(mx.x, S[ti].x); mx.y = fmaxf(mx.y, S[ti].y); mx.z = fmaxf(mx.z, S[ti].z); mx.w = fmaxf(mx.w, S[ti].w); }
#pragma unroll
        for (int o = 1; o < 16; o <<= 1) { mx.x = fmaxf(mx.x, __shfl_xor(mx.x, o)); mx.y = fmaxf(mx.y, __shfl_xor(mx.y, o)); mx.z = fmaxf(mx.z, __shfl_xor(mx.z, o)); mx.w = fmaxf(mx.w, __shfl_xor(mx.w, o)); }
        f32x4 ls = (f32x4){0.f, 0.f, 0.f, 0.f};
        unsigned P01[16], P23[16];
#pragma unroll
        for (int ti = 0; ti < 16; ++ti) { const float e0 = __builtin_amdgcn_exp2f(S[ti].x - mx.x), e1 = __builtin_amdgcn_exp2f(S[ti].y - mx.y), e2 = __builtin_amdgcn_exp2f(S[ti].z - mx.z), e3 = __builtin_amdgcn_exp2f(S[ti].w - mx.w);
            ls += (f32x4){e0, e1, e2, e3}; P01[ti] = cvtpk(e0, e1); P23[ti] = cvtpk(e2, e3); }
#pragma unroll
        for (int o = 1; o < 16; o <<= 1) { ls.x += __shfl_xor(ls.x, o); ls.y += __shfl_xor(ls.y, o); ls.z += __shfl_xor(ls.z, o); ls.w += __shfl_xor(ls.w, o); }
        float o_[4][16];
#pragma unroll
        for (int h = 0; h < 4; ++h)
#pragma unroll
            for (int d = 0; d < 16; ++d) o_[h][d] = 0.f;
        const bf16* vbase = C.VA + rowbase * 256 + g * 64 + 16 * l4;
#pragma unroll
        for (int hh = 0; hh < 4; ++hh) {
            v4u va[4], vb[4];
#pragma unroll
            for (int j = 0; j < 4; ++j) { const v4u* vp = (const v4u*)(vbase + (long)sidx[hh * 4 + j] * 256); va[j] = vp[0]; vb[j] = vp[1]; }
#pragma unroll
            for (int j = 0; j < 4; ++j) { const int ti = hh * 4 + j; const v4u v0 = va[j], v1 = vb[j];
                float vf[16];
                vf[0] = bf_lo(v0.x); vf[1] = bf_hi(v0.x); vf[2] = bf_lo(v0.y); vf[3] = bf_hi(v0.y); vf[4] = bf_lo(v0.z); vf[5] = bf_hi(v0.z); vf[6] = bf_lo(v0.w); vf[7] = bf_hi(v0.w);
                vf[8] = bf_lo(v1.x); vf[9] = bf_hi(v1.x); vf[10] = bf_lo(v1.y); vf[11] = bf_hi(v1.y); vf[12] = bf_lo(v1.z); vf[13] = bf_hi(v1.z); vf[14] = bf_lo(v1.w); vf[15] = bf_hi(v1.w);
                const float p0 = bf_lo(P01[ti]), p1 = bf_hi(P01[ti]), p2 = bf_lo(P23[ti]), p3 = bf_hi(P23[ti]);
#pragma unroll
                for (int d = 0; d < 16; ++d) { o_[0][d] += p0 * vf[d]; o_[1][d] += p1 * vf[d]; o_[2][d] += p2 * vf[d]; o_[3][d] += p3 * vf[d]; } }
        }
        float res[4];
#pragma unroll
        for (int h = 0; h < 4; ++h) {
            float a8[8], a4[4], a2[2];
            const bool b3 = (l15 & 8) != 0, b2 = (l15 & 4) != 0, b1 = (l15 & 2) != 0, b0 = (l15 & 1) != 0;
#pragma unroll
            for (int d = 0; d < 8; ++d) { const float keep = b3 ? o_[h][d + 8] : o_[h][d], send = b3 ? o_[h][d] : o_[h][d + 8]; a8[d] = keep + __shfl_xor(send, 8); }
#pragma unroll
            for (int d = 0; d < 4; ++d) { const float keep = b2 ? a8[d + 4] : a8[d], send = b2 ? a8[d] : a8[d + 4]; a4[d] = keep + __shfl_xor(send, 4); }
#pragma unroll
            for (int d = 0; d < 2; ++d) { const float keep = b1 ? a4[d + 2] : a4[d], send = b1 ? a4[d] : a4[d + 2]; a2[d] = keep + __shfl_xor(send, 2); }
            { const float keep = b0 ? a2[1] : a2[0], send = b0 ? a2[0] : a2[1]; res[h] = keep + __shfl_xor(send, 1); }
        }
        bf16* mp = C.M + token * DM + (4 * g) * 64 + lane;
        mp[0] = (bf16)f2bf(res[0] * __builtin_amdgcn_rcpf(ls.x)); mp[64] = (bf16)f2bf(res[1] * __builtin_amdgcn_rcpf(ls.y)); mp[128] = (bf16)f2bf(res[2] * __builtin_amdgcn_rcpf(ls.z)); mp[192] = (bf16)f2bf(res[3] * __builtin_amdgcn_rcpf(ls.w));
    }
}

constexpr int CAND_CAP = 256;
constexpr int SELKS_OFF = KS_OFF;
__device__ __forceinline__ float relu_i(float x) { const int i = __builtin_bit_cast(int, x); return __builtin_bit_cast(float, i > 0 ? i : 0); }
struct SelState { unsigned pre[4], need[4], cnt[4], tcnt[4]; };
__device__ __forceinline__ void tile_mfma(f32x16 (&acc)[2], const LAS unsigned char* kf, const int (&koff)[4], const bf16x8 (&qa)[4]) {
#pragma unroll
    for (int h2 = 0; h2 < 2; ++h2) { acc[h2] = f32x16{};
#pragma unroll
        for (int ks = 0; ks < 4; ++ks) { const bf16x8 kb = *(const LAS bf16x8*)(kf + koff[ks] + h2 * 4096); acc[h2] = __builtin_amdgcn_mfma_f32_32x32x16_bf16(qa[ks], kb, acc[h2], 0, 0, 0); } }
}
template <class ActionT>
__device__ __forceinline__ void tile_valu(const f32x16 (&acc)[2], const f32x2_t (&wp)[2][4], int kbase, ActionT&& act) {
#pragma unroll
    for (int h2 = 0; h2 < 2; ++h2) {
        f32x2_t sa = {0.f, 0.f}, sb = {0.f, 0.f};
#pragma unroll
        for (int jp = 0; jp < 4; ++jp) {
            const f32x2_t ra = {relu_i(acc[h2][2 * jp]), relu_i(acc[h2][2 * jp + 1])};
            const f32x2_t rb = {relu_i(acc[h2][8 + 2 * jp]), relu_i(acc[h2][8 + 2 * jp + 1])};
            sa = __builtin_elementwise_fma(ra, wp[0][jp], sa); sb = __builtin_elementwise_fma(rb, wp[1][jp], sb); }
        act(kbase + h2 * 32, (sa.x + sa.y) + 0.0f, (sb.x + sb.y) + 0.0f);
    }
}
constexpr int KSLOTS = 3;
__device__ __forceinline__ void wait_tile(int newer) {
    if (newer >= 4) asm volatile("s_waitcnt vmcnt(4) lgkmcnt(0)\n\ts_barrier" ::: "memory");
    else if (newer == 3) asm volatile("s_waitcnt vmcnt(3) lgkmcnt(0)\n\ts_barrier" ::: "memory");
    else if (newer == 2) asm volatile("s_waitcnt vmcnt(2) lgkmcnt(0)\n\ts_barrier" ::: "memory");
    else if (newer == 1) asm volatile("s_waitcnt vmcnt(1) lgkmcnt(0)\n\ts_barrier" ::: "memory");
    else asm volatile("s_waitcnt vmcnt(0) lgkmcnt(0)\n\ts_barrier" ::: "memory");
}
template <class ActionT>
__device__ __forceinline__ void tile_pass(Frame& F, const bf16* ksrc, unsigned kdst, const LAS unsigned char* kfr, const int (&koff)[4], int NT, const bf16x8 (&qa)[4], const f32x2_t (&wp)[2][4], ActionT&& act) {
    asm volatile("s_waitcnt lgkmcnt(0)\n\ts_barrier" ::: "memory");
    const int npre = NT < KSLOTS ? NT : KSLOTS;
    for (int j = 0; j < npre; ++j) glds16(ksrc + (long)j * 4096, (unsigned)__builtin_amdgcn_readfirstlane(kdst + j * 8192));
    wait_tile(npre - 1);
    f32x16 accC[2];
    tile_mfma(accC, kfr, koff, qa);
    int sl = 0;
    for (int kt = 0; kt + 1 < NT; ++kt) {
        { const int inflight = (NT - kt - 2) < (KSLOTS - 2) ? (NT - kt - 2) : (KSLOTS - 2); wait_tile(inflight); }
        if (kt + KSLOTS < NT) glds16(ksrc + (long)(kt + KSLOTS) * 4096, (unsigned)__builtin_amdgcn_readfirstlane(kdst + sl * 8192));
        sl = (sl == KSLOTS - 1) ? 0 : sl + 1;
        f32x16 accN[2];
        tile_mfma(accN, kfr + sl * 8192, koff, qa);
        tile_valu(accC, wp, kt * 64, act);
        accC[0] = accN[0]; accC[1] = accN[1];
    }
    tile_valu(accC, wp, (NT - 1) * 64, act);
    LDS_WAIT();
}
__device__ __forceinline__ void scan_hist_cnt(const LAS unsigned* hq, int lane, unsigned need, unsigned& bin, unsigned& above, unsigned& bcnt) {
    const LAS v4u* hp = (const LAS v4u*)hq + lane * 2;
    unsigned wds[8];
#pragma unroll
    for (int j = 0; j < 2; ++j) { const v4u t = hp[j]; wds[4 * j] = t.x; wds[4 * j + 1] = t.y; wds[4 * j + 2] = t.z; wds[4 * j + 3] = t.w; }
    unsigned tl = 0;
#pragma unroll
    for (int j = 0; j < 8; ++j) tl += wds[j];
    unsigned suf = tl;
#pragma unroll
    for (int o = 1; o < 64; o <<= 1) { const unsigned v = __shfl_down(suf, o); if (lane + o < 64) suf += v; }
    const unsigned S = suf - tl;
    const bool cross = (S < need) && (need <= S + tl);
    unsigned c = S, bsel = 0, ab = 0, bc = 0; bool found = false;
#pragma unroll
    for (int k = 7; k >= 0; --k) { const unsigned cnt = wds[k]; if (!found && c + cnt >= need) { bsel = 8 * lane + k; ab = c; bc = cnt; found = true; } c += cnt; }
    const unsigned long long bal = __ballot(cross);
    const int src = bal ? __builtin_ctzll(bal) : 0;
    bin = __builtin_amdgcn_readfirstlane(__shfl(bsel, src)); above = __builtin_amdgcn_readfirstlane(__shfl(ab, src)); bcnt = __builtin_amdgcn_readfirstlane(__shfl(bc, src));
}
__device__ __forceinline__ void step(Frame& F, const Ctx& C, int b, int c, int half) {
    int lane_ = F.lane; asm volatile("" : "+v"(lane_));
    const int lane = lane_, r = lane & 31, hi = lane >> 5, wave = F.wave;
    LAS unsigned* hist = (LAS unsigned*)(F.lds + RING_OFF + wave * 16384);
    LAS unsigned short* sel = (LAS unsigned short*)hist;
    LAS unsigned* cand = hist + 2048;
    LAS unsigned* fbflag = (LAS unsigned*)(F.lds + AUX_OFF + 2048);
    const long rowbase = (long)b * SEQ;
    const int tq0 = 64 * c + 32 * half + 4 * wave;
    const int N = 64 * (c + 1), NT = c + 1;
    int nvalid = 256;
    if (N <= 256) {
        nvalid = N;
        for (int j = lane; j < 4 * 256; j += 64) sel[j] = (unsigned short)(((j & 255) < N) ? (j & 255) : 0);
    } else {
        const int aq = 2 * ((r >> 2) & 1) + (r >> 4), ah = 4 * ((r >> 3) & 1) + (r & 3);
        const bf16* qip = C.QI + (rowbase + tq0 + aq) * 512 + ah * 64 + 8 * hi;
        bf16x8 qa[4];
#pragma unroll
        for (int ks = 0; ks < 4; ++ks) qa[ks] = *(const bf16x8*)(qip + 16 * ks);
        f32x2_t wp[2][4];
#pragma unroll
        for (int t = 0; t < 2; ++t) { const float* wq = C.WI + (rowbase + tq0 + 2 * hi + t) * 8; const f32x4 w0 = *(const f32x4*)wq, w1 = *(const f32x4*)(wq + 4);
            wp[t][0] = (f32x2_t){w0.x, w0.y}; wp[t][1] = (f32x2_t){w0.z, w0.w}; wp[t][2] = (f32x2_t){w1.x, w1.y}; wp[t][3] = (f32x2_t){w1.z, w1.w}; }
        float Bq;
        { float ssq = 0.f;
#pragma unroll
          for (int ks = 0; ks < 4; ++ks)
#pragma unroll
              for (int e = 0; e < 8; ++e) { const float v = bf_lo((unsigned)(unsigned short)qa[ks][e]); ssq += v * v; }
          ssq += __shfl_xor(ssq, 32);
          float term = fabsf(C.WI[(rowbase + tq0 + aq) * 8 + ah]) * sqrtf(ssq);
          term += __shfl_xor(term, 1); term += __shfl_xor(term, 2); term += __shfl_xor(term, 8);
          Bq = term * 8.25f + 1e-20f; }
        const float B0 = __shfl(Bq, (hi << 2)), B1 = __shfl(Bq, (hi << 2) | 16);
        const float sc0 = 1024.0f / B0, sc1 = 1024.0f / B1;
        asm volatile("" :: "v"(qa[0]), "v"(qa[1]), "v"(qa[2]), "v"(qa[3]));
        asm volatile("" :: "v"(wp[0][0]), "v"(wp[0][1]), "v"(wp[0][2]), "v"(wp[0][3]), "v"(wp[1][0]), "v"(wp[1][1]), "v"(wp[1][2]), "v"(wp[1][3]), "v"(sc0), "v"(sc1));
        const bf16* ksrc = C.KI + rowbase * 64 + (long)(wave * 8 + (lane >> 3)) * 64 + ((lane & 7) ^ (lane >> 3)) * 8;
        const unsigned kdst = (unsigned)(uintptr_t)(F.lds + SELKS_OFF) + wave * 1024;
        const LAS unsigned char* kfr = F.lds + SELKS_OFF + r * 128;
        int koff[4];
#pragma unroll
        for (int ks = 0; ks < 4; ++ks) koff[ks] = ((2 * ks + hi) ^ (r & 7)) * 16;
        const unsigned below = (1u << r) - 1u;
        LAS v4u* hz = (LAS v4u*)hist;
        if (wave == 0 && lane == 0) *fbflag = 0u;
#pragma unroll
        for (int j = 0; j < 8; ++j) hz[j * 64 + lane] = (v4u){0u, 0u, 0u, 0u};
        tile_pass(F, ksrc, kdst, kfr, koff, NT, qa, wp, [&](int kbase, float s0, float s1) {
            const int b0 = (int)__builtin_amdgcn_fmed3f(__builtin_fmaf(s0, sc0, 256.0f), 0.0f, 511.0f), b1 = (int)__builtin_amdgcn_fmed3f(__builtin_fmaf(s1, sc1, 256.0f), 0.0f, 511.0f);
            __hip_atomic_fetch_add(hist + (2 * hi) * 512 + b0, 1u, __ATOMIC_RELAXED, __HIP_MEMORY_SCOPE_WORKGROUP);
            __hip_atomic_fetch_add(hist + (2 * hi + 1) * 512 + b1, 1u, __ATOMIC_RELAXED, __HIP_MEMORY_SCOPE_WORKGROUP);
        });
#ifdef PROBE_SKEL
        tile_pass(F, ksrc, kdst, kfr, koff, NT, qa, wp, [&](int kbase, float s0, float s1) { });
#endif
#ifdef PROBE_SCORE
        { float dsum = 0.f; tile_pass(F, ksrc, kdst, kfr, koff, NT, qa, wp, [&](int kbase, float s0, float s1) { dsum += s0 + s1; }); if (dsum == 12345.678f) hist[0] = 1u; }
#endif
        SelState st;
        unsigned tbin[4], bcn[4]; bool ovf = false;
#pragma unroll
        for (int ql = 0; ql < 4; ++ql) { unsigned above; scan_hist_cnt(hist + ql * 512, lane, 256u, tbin[ql], above, bcn[ql]); st.cnt[ql] = 0u; st.tcnt[ql] = 0u; st.need[ql] = 256u - above; st.pre[ql] = above;
#ifdef PROBE_OVF
            ovf |= bcn[ql] > (unsigned)PROBE_OVF; }
#else
            ovf |= bcn[ql] > (unsigned)CAND_CAP; }
#endif
        LDS_WAIT();
        if (ovf && lane == 0) *fbflag = 1u;
        asm volatile("s_waitcnt lgkmcnt(0)\n\ts_barrier" ::: "memory");
#ifdef PROBE_NOFB
        const bool fb = false;
#elif defined(PROBE_NOFB2)
        const bool fb = __builtin_amdgcn_readfirstlane((int)*fbflag) == 0x7fffffff;
#else
        const bool fb = __builtin_amdgcn_readfirstlane((int)*fbflag) != 0;
#endif
        if (!fb) {
            const int tb0 = (int)(hi ? tbin[2] : tbin[0]), tb1 = (int)(hi ? tbin[3] : tbin[1]);
            tile_pass(F, ksrc, kdst, kfr, koff, NT, qa, wp, [&](int kbase, float s0, float s1) {
#pragma unroll
                for (int t = 0; t < 2; ++t) {
                    const float s = t ? s1 : s0; const int bin = (int)__builtin_amdgcn_fmed3f(__builtin_fmaf(s, (t ? sc1 : sc0), 256.0f), 0.0f, 511.0f), tb = t ? tb1 : tb0;
                    const bool gt = bin > tb, eq = bin == tb;
                    const unsigned long long mg = __ballot(gt), me = __ballot(eq);
                    const unsigned mgh = hi ? (unsigned)(mg >> 32) : (unsigned)mg, meh = hi ? (unsigned)(me >> 32) : (unsigned)me;
                    const unsigned pos = (hi ? st.cnt[2 + t] : st.cnt[t]) + __builtin_popcount(mgh & below);
                    sel[(gt && pos < 256u) ? (2 * hi + t) * 256 + pos : 3200 + lane] = (unsigned short)(kbase + r);
                    const unsigned cpos = (hi ? st.tcnt[2 + t] : st.tcnt[t]) + __builtin_popcount(meh & below);
                    { LAS unsigned* cp = hist + ((eq && cpos < (unsigned)CAND_CAP) ? 2048 + ((2 * hi + t) * CAND_CAP + cpos) * 2 : 1700 + 2 * lane); cp[0] = okey(s); cp[1] = (unsigned)(kbase + r); }
                    st.cnt[t] += __builtin_popcount((unsigned)mg); st.cnt[2 + t] += __builtin_popcount((unsigned)(mg >> 32));
                    st.tcnt[t] += __builtin_popcount((unsigned)me); st.tcnt[2 + t] += __builtin_popcount((unsigned)(me >> 32));
                }
            });
#pragma unroll
            for (int ql = 0; ql < 4; ++ql) {
                const unsigned nc = bcn[ql], G = st.pre[ql], rq = st.need[ql];
                const LAS unsigned* cq = cand + ql * CAND_CAP * 2;
                unsigned ki4[4], xi4[4], rk4[4];
#pragma unroll
                for (int m = 0; m < 4; ++m) { const unsigned i = (unsigned)lane + 64u * m; ki4[m] = (i < nc) ? cq[2 * i] : 0u; xi4[m] = (i < nc) ? cq[2 * i + 1] : 0u; rk4[m] = 0u; }
                for (unsigned j = 0; j < nc; ++j) { const unsigned kj = cq[2 * j];
#pragma unroll
                    for (int m = 0; m < 4; ++m) rk4[m] += (kj > ki4[m] || (kj == ki4[m] && j < (unsigned)lane + 64u * m)) ? 1u : 0u; }
                unsigned base = G; const unsigned long long lt = (1ull << lane) - 1ull;
#pragma unroll
                for (int m = 0; m < 4; ++m) { const bool take = ((unsigned)lane + 64u * m < nc) && rk4[m] < rq; const unsigned long long mm = __ballot(take);
                    const unsigned pos = base + __builtin_popcountll(mm & lt); if (take && pos < 256u) sel[ql * 256 + pos] = (unsigned short)xi4[m]; base += __builtin_popcountll(mm); }
            }
        } else {
#pragma unroll
            for (int ql = 0; ql < 4; ++ql) { st.pre[ql] = 0u; st.need[ql] = 256u; st.cnt[ql] = 0u; st.tcnt[ql] = 0u; }
#pragma unroll 1
            for (int lev = 0; lev < 4; ++lev) {
#pragma unroll
                for (int j = 0; j < 8; ++j) hz[j * 64 + lane] = (v4u){0u, 0u, 0u, 0u};
                const unsigned pre0 = hi ? st.pre[2] : st.pre[0], pre1 = hi ? st.pre[3] : st.pre[1];
                const int sh = (lev == 0) ? 23 : (lev == 1) ? 14 : (lev == 2) ? 5 : 0, wd = (lev == 3) ? 5 : 9;
                tile_pass(F, ksrc, kdst, kfr, koff, NT, qa, wp, [&](int kbase, float s0, float s1) {
                    const unsigned k0 = okey(s0), k1 = okey(s1);
                    const unsigned b0 = (k0 >> sh) & ((1u << wd) - 1u), b1 = (k1 >> sh) & ((1u << wd) - 1u);
                    const bool in0 = (lev == 0) || ((k0 >> (sh + wd)) == pre0), in1 = (lev == 0) || ((k1 >> (sh + wd)) == pre1);
                    if (in0) __hip_atomic_fetch_add(hist + (2 * hi) * 512 + b0, 1u, __ATOMIC_RELAXED, __HIP_MEMORY_SCOPE_WORKGROUP);
                    if (in1) __hip_atomic_fetch_add(hist + (2 * hi + 1) * 512 + b1, 1u, __ATOMIC_RELAXED, __HIP_MEMORY_SCOPE_WORKGROUP);
                });
#pragma unroll
                for (int ql = 0; ql < 4; ++ql) { unsigned bin, above, bc; scan_hist_cnt(hist + ql * 512, lane, st.need[ql], bin, above, bc);
                    st.pre[ql] = (st.pre[ql] << wd) | bin; st.need[ql] -= above; }
                LDS_WAIT();
            }
            const unsigned T0 = hi ? st.pre[2] : st.pre[0], T1 = hi ? st.pre[3] : st.pre[1], rq0 = hi ? st.need[2] : st.need[0], rq1 = hi ? st.need[3] : st.need[1];
            tile_pass(F, ksrc, kdst, kfr, koff, NT, qa, wp, [&](int kbase, float s0, float s1) {
#pragma unroll
                for (int t = 0; t < 2; ++t) {
                    const unsigned kk = okey(t ? s1 : s0), T = t ? T1 : T0, rq = t ? rq1 : rq0;
                    const bool gt = kk > T, eq = kk == T;
                    const unsigned long long me = __ballot(eq);
                    const unsigned meh = hi ? (unsigned)(me >> 32) : (unsigned)me;
                    const unsigned trank = (hi ? st.tcnt[2 + t] : st.tcnt[t]) + __builtin_popcount(meh & below);
                    const bool take = gt || (eq && trank < rq);
                    const unsigned long long mt = __ballot(take);
                    const unsigned mth = hi ? (unsigned)(mt >> 32) : (unsigned)mt;
                    const unsigned pos = (hi ? st.cnt[2 + t] : st.cnt[t]) + __builtin_popcount(mth & below);
                    if (take && pos < 256u) sel[(2 * hi + t) * 256 + pos] = (unsigned short)(kbase + r);
                    st.cnt[t] += __builtin_popcount((unsigned)mt); st.cnt[2 + t] += __builtin_popcount((unsigned)(mt >> 32));
                    st.tcnt[t] += __builtin_popcount((unsigned)me); st.tcnt[2 + t] += __builtin_popcount((unsigned)(me >> 32));
                }
            });
        }
    }
    LDS_WAIT();
    { const LAS v4u* s4 = (const LAS v4u*)sel; v4u* g4 = (v4u*)(C.SEL + (rowbase + tq0) * 256);
#pragma unroll
      for (int j = 0; j < 2; ++j) g4[j * 64 + lane] = s4[j * 64 + lane]; }
    LDS_WAIT();
}
__device__ __forceinline__ void phase(Frame& F, const Ctx& C) {
    for (int v = F.vcu; v < 256; v += F.G) {
        const int b = v >> 6, c = v & 63;
#pragma unroll 1
        for (int it = 0; it < 4; ++it) step(F, C, b, (it < 2) ? c : 127 - c, it & 1);
    }
}
__device__ __forceinline__ void attn_phase(Frame& F, const Ctx& C) {
    int lane = F.lane; asm volatile("" : "+v"(lane));
    LAS unsigned short* sq = (LAS unsigned short*)(F.lds + RING_OFF + F.wave * 16384);
    const int nx = F.G / 32;
    for (int x = F.vcu / 32; x < 8; x += nx) {
        const int b = x >> 1, g0 = 2 * (x & 1); const long rowbase = (long)b * SEQ;
        const int w = (F.vcu & 31) * NWAVES + F.wave;
#pragma unroll 1
        for (int t = w; t < SEQ; t += 32 * NWAVES) {
            { const v4u* g4 = (const v4u*)(C.SEL + (rowbase + t) * 256); if (lane < 32) ((LAS v4u*)sq)[lane] = g4[lane]; }
            LDS_WAIT();
            const int N = 64 * ((t >> 6) + 1), nvalid = N < 256 ? N : 256;
            attend(C, sq, nvalid, rowbase, rowbase + t, t, lane, g0);
            LDS_WAIT();
        }
    }
}
}

namespace att8 {
typedef int v2i __attribute__((ext_vector_type(2)));
struct Ctx8 { const unsigned char* QA8; const unsigned char* KV8; const unsigned short* SEL; bf16* M; };
constexpr int T2_OFF = KS_OFF, T2_BYTES = 155 * 16 * 4, SELL_OFF = KS_OFF + 10240;
static_assert(T2_BYTES <= 10240 && SELL_OFF + NWAVES * 1024 <= AUX_OFF, "attention LDS map");
__device__ __forceinline__ void mfma8(f32x4& acc, long a, long b) { asm volatile("v_mfma_f32_16x16x32_fp8_fp8 %0, %1, %2, %0" : "+v"(acc) : "v"(a), "v"(b)); }
__device__ __forceinline__ unsigned pk4_fp8(float a, float b, float c, float d) { int r = __builtin_amdgcn_cvt_pk_fp8_f32(a, b, 0, false); r = __builtin_amdgcn_cvt_pk_fp8_f32(c, d, r, true); return (unsigned)r; }

__device__ __forceinline__ void gld16(v4u& dst, const void* p) { asm volatile("global_load_dwordx4 %0, %1, off" : "=v"(dst) : "v"(p) : "memory"); }
__device__ __forceinline__ void issue_kq(const Ctx8& C, const LAS unsigned short* sq, long rowbase, long token, int g, int l15, int l4, int h, v4u (&kr)[16], v4u& qv) {
    const unsigned char* kvb = C.KV8 + rowbase * 512 + g * 128 + 16 * l4;
#pragma unroll
    for (int j = 0; j < 16; ++j) gld16(kr[j], kvb + (long)sq[j * 16 + l15] * 512);
    gld16(qv, C.QA8 + token * 1024 + (4 * g + h) * 64 + 16 * l4);
}
__device__ __forceinline__ void issue_v_half(const Ctx8& C, const LAS unsigned short* sq, long rowbase, int g, int lane, unsigned vbase, int half) {
    const unsigned char* kvb = C.KV8 + rowbase * 512 + g * 128 + 64; const int kq = lane >> 2, p = lane & 3;
#pragma unroll
    for (int j = 0; j < 8; ++j) { const int ti = half * 8 + j; const int key = sq[ti * 16 + kq]; const int x = ((kq >> 2) & 1) | ((ti & 1) << 1);
        glds16(kvb + (long)key * 512 + 16 * (p ^ x), (unsigned)__builtin_amdgcn_readfirstlane(vbase + ti * 1024)); }
}
__device__ __forceinline__ void phase(Frame& F, const Ctx8& C, const float* t5) {
    int lane = F.lane; asm volatile("" : "+v"(lane));
    LAS float* T2 = (LAS float*)(F.lds + T2_OFF);
    for (int e = F.tid; e < 155 * 16; e += NWAVES * 64) { const int rel = (e >> 4) - 91, n = rel < 0 ? -rel : rel;
        const int bk = (rel > 0 ? 16 : 0) + (n < 8 ? n : 8 + (n >= 12) + (n >= 16) + (n >= 23) + (n >= 32) + (n >= 46) + (n >= 64) + (n >= 91));
        T2[e] = t5[bk * 16 + (e & 15)] * 8.0f; }
    __syncthreads();
    LAS unsigned short* sqb = (LAS unsigned short*)(F.lds + SELL_OFF + F.wave * 1024);
    LAS unsigned char* vreg = F.lds + RING_OFF + F.wave * 16384;
    const unsigned vbase = (unsigned)(uintptr_t)vreg;
    const int l15 = lane & 15, l4 = lane >> 4, h = l15 & 3;
    const int trk = 4 * l4 + ((l15 >> 1) & 3), trt = (l15 >> 3) & 1, xs = (l4 & 1) | (trt << 1);
    const int troff = trt * 1024 + trk * 64 + 8 * (l15 & 1);
    const int x = F.vcu / 32, b = x >> 1, g0 = 2 * (x & 1); const long rowbase = (long)b * SEQ;
    const int w = (F.vcu & 31) * NWAVES + F.wave;
    constexpr int NQ = SEQ / (32 * NWAVES), NI = 2 * NQ;
    if (lane < 32) { ((LAS v4u*)sqb)[lane] = ((const v4u*)(C.SEL + (rowbase + w) * 256))[lane]; ((LAS v4u*)(sqb + 256))[lane] = ((const v4u*)(C.SEL + (rowbase + w + 32 * NWAVES) * 256))[lane]; }
    LDS_WAIT();
    v4u kr[16], qv, pf = (v4u){0u, 0u, 0u, 0u};
    issue_kq(C, sqb, rowbase, rowbase + w, g0, l15, l4, h, kr, qv);
    issue_v_half(C, sqb, rowbase, g0, lane, vbase, 0); issue_v_half(C, sqb, rowbase, g0, lane, vbase, 1);
    unsigned cib[16];
#pragma unroll 1
    for (int idx = 0; idx < NI; ++idx) {
        const int qn = idx >> 1, gi = idx & 1, g = g0 + gi, t = w + 32 * NWAVES * qn;
        const LAS unsigned short* sq = sqb + (qn & 1) * 256;
        const int nidx = (idx + 1 < NI) ? idx + 1 : idx, nq = nidx >> 1, ng = g0 + (nidx & 1), nt = w + 32 * NWAVES * nq;
        const LAS unsigned short* nsq = sqb + (nq & 1) * 256;
        if (gi == 1) { asm volatile("s_waitcnt vmcnt(34)" : "+v"(pf) :: "memory"); if (lane < 32) ((LAS v4u*)(sqb + (qn & 1) * 256))[lane] = pf; }
        { const int pq = (qn + 2 < NQ) ? qn + 2 : NQ - 1; gld16(pf, (const v4u*)(C.SEL + (rowbase + w + 32 * NWAVES * pq) * 256) + (lane & 31)); }
        if (idx == 0) asm volatile("s_waitcnt vmcnt(0)" : "+v"(qv), "+v"(kr[0]), "+v"(kr[1]), "+v"(kr[2]), "+v"(kr[3]), "+v"(kr[4]), "+v"(kr[5]), "+v"(kr[6]), "+v"(kr[7]), "+v"(kr[8]), "+v"(kr[9]), "+v"(kr[10]), "+v"(kr[11]), "+v"(kr[12]), "+v"(kr[13]), "+v"(kr[14]), "+v"(kr[15]) :: "memory");
        else asm volatile("s_waitcnt vmcnt(20)" : "+v"(qv), "+v"(kr[0]), "+v"(kr[1]), "+v"(kr[2]), "+v"(kr[3]), "+v"(kr[4]), "+v"(kr[5]), "+v"(kr[6]), "+v"(kr[7]), "+v"(kr[8]), "+v"(kr[9]), "+v"(kr[10]), "+v"(kr[11]), "+v"(kr[12]), "+v"(kr[13]), "+v"(kr[14]), "+v"(kr[15]) :: "memory");
        if (gi == 0) {
#pragma unroll
            for (int ti = 0; ti < 16; ++ti) { const v2u i4 = *(const LAS v2u*)(sq + ti * 16 + 4 * l4);
                const int r0 = (int)(i4.x & 0xffffu) - t, r1 = (int)(i4.x >> 16) - t, r2 = (int)(i4.y & 0xffffu) - t, r3 = (int)(i4.y >> 16) - t;
                const int c0 = min(max(r0, -91), 63) + 91, c1 = min(max(r1, -91), 63) + 91, c2 = min(max(r2, -91), 63) + 91, c3 = min(max(r3, -91), 63) + 91;
                cib[ti] = (unsigned)c0 | ((unsigned)c1 << 8) | ((unsigned)c2 << 16) | ((unsigned)c3 << 24); }
        }
        const int N = 64 * ((t >> 6) + 1), nvalid = N < 256 ? N : 256;
        const long q0 = (long)(((unsigned long long)qv.y << 32) | qv.x), q1 = (long)(((unsigned long long)qv.w << 32) | qv.z);
        f32x4 S[16];
#pragma unroll
        for (int ti = 0; ti < 16; ++ti) { const unsigned cb = cib[ti];
            f32x4 a; a.x = T2[(cb & 255u) * 16 + 4 * g + h]; a.y = T2[((cb >> 8) & 255u) * 16 + 4 * g + h]; a.z = T2[((cb >> 16) & 255u) * 16 + 4 * g + h]; a.w = T2[(cb >> 24) * 16 + 4 * g + h];
            mfma8(a, (long)(((unsigned long long)kr[ti].y << 32) | kr[ti].x), q0);
            mfma8(a, (long)(((unsigned long long)kr[ti].w << 32) | kr[ti].z), q1);
            S[ti] = a; }
        asm volatile("s_nop 15\n\ts_nop 7" : "+v"(S[0]), "+v"(S[1]), "+v"(S[2]), "+v"(S[3]), "+v"(S[4]), "+v"(S[5]), "+v"(S[6]), "+v"(S[7]), "+v"(S[8]), "+v"(S[9]), "+v"(S[10]), "+v"(S[11]), "+v"(S[12]), "+v"(S[13]), "+v"(S[14]), "+v"(S[15]));
        issue_kq(C, nsq, rowbase, rowbase + nt, ng, l15, l4, h, kr, qv);
#pragma unroll
        for (int ti = 0; ti < 16; ++ti) if (ti * 16 >= nvalid) S[ti] = (f32x4){-INFINITY, -INFINITY, -INFINITY, -INFINITY};
        float mx = S[0].x;
#pragma unroll
        for (int ti = 0; ti < 16; ++ti) mx = fmaxf(fmaxf(mx, fmaxf(S[ti].x, S[ti].y)), fmaxf(S[ti].z, S[ti].w));
        mx = fmaxf(mx, __shfl_xor(mx, 16)); mx = fmaxf(mx, __shfl_xor(mx, 32));
        const float mc = -mx * C2; float ls = 0.f;
        long P8[8];
#pragma unroll
        for (int j = 0; j < 8; ++j) { float e[8];
#pragma unroll
            for (int q = 0; q < 4; ++q) { e[q] = __builtin_amdgcn_exp2f(__builtin_fmaf(S[2 * j][q], C2, mc)); e[4 + q] = __builtin_amdgcn_exp2f(__builtin_fmaf(S[2 * j + 1][q], C2, mc)); }
            ls += ((e[0] + e[1]) + (e[2] + e[3])) + ((e[4] + e[5]) + (e[6] + e[7]));
            const unsigned lo = pk4_fp8(e[0] * 256.f, e[1] * 256.f, e[2] * 256.f, e[3] * 256.f), hi = pk4_fp8(e[4] * 256.f, e[5] * 256.f, e[6] * 256.f, e[7] * 256.f);
            P8[j] = (long)(((unsigned long long)hi << 32) | lo); }
        ls += __shfl_xor(ls, 16); ls += __shfl_xor(ls, 32);
        f32x4 D[4];
#pragma unroll
        for (int db = 0; db < 4; ++db) D[db] = (f32x4){0.f, 0.f, 0.f, 0.f};
#pragma unroll
        for (int hf = 0; hf < 2; ++hf) {
            asm volatile("s_waitcnt vmcnt(28)" ::: "memory");
#pragma unroll
            for (int j = 4 * hf; j < 4 * hf + 4; ++j)
#pragma unroll
                for (int db = 0; db < 4; ++db) {
                    const v2i vv = __builtin_amdgcn_ds_read_tr8_b64_v2i32((LAS v2i*)(vreg + j * 2048 + troff + 16 * (db ^ xs)));
                    mfma8(D[db], P8[j], __builtin_bit_cast(long, vv)); }
            asm volatile("s_waitcnt lgkmcnt(0)" ::: "memory");
            issue_v_half(C, nsq, rowbase, ng, lane, vbase, hf);
        }
        asm volatile("s_nop 15\n\ts_nop 7" : "+v"(D[0]), "+v"(D[1]), "+v"(D[2]), "+v"(D[3]));
        const float lh = __shfl(ls, l4);
        const float inv = __builtin_amdgcn_rcpf(lh * 256.f);
        bf16* mp = C.M + (rowbase + t) * DM + (4 * g + l4) * 64 + l15;
#pragma unroll
        for (int db = 0; db < 4; ++db) { const float v = (l4 == 0) ? D[db].x : (l4 == 1) ? D[db].y : (l4 == 2) ? D[db].z : D[db].w; const unsigned short ob = (unsigned short)f2bf(v * inv);
            asm volatile("global_store_short %0, %1, off" :: "v"(mp + 16 * db), "v"((unsigned)ob) : "memory"); }
    }
    asm volatile("s_waitcnt vmcnt(0)" ::: "memory");
}
}

#ifndef REP_P0
#define REP_P0 1
#endif
#ifndef REP_IN
#define REP_IN 1
#endif
#ifndef REP_DSA
#define REP_DSA 1
#endif
#ifndef REP_BAND
#define REP_BAND 1
#endif
#ifndef REP_UP
#define REP_UP 1
#endif
#ifndef REP_FIX
#define REP_FIX 1
#endif
constexpr int N_PHASES = 1 + 6 * DEPTH;
#ifndef MK_N_LAUNCHES
#define MK_N_LAUNCHES 1
#endif
__global__ void __launch_bounds__(NWAVES * 64, 2) mega_fwd(Args args) {
    extern __shared__ __attribute__((aligned(16))) unsigned char lds[];
    Frame F;
    F.lds = (LAS unsigned char*)lds;
    F.MISC = (volatile LAS unsigned*)(F.lds + MISC_OFF);
    F.tid = threadIdx.x; F.lane = F.tid & 63; F.wave = __builtin_amdgcn_readfirstlane(F.tid >> 6);
    F.G = GRID; { const int bx = blockIdx.x; F.vcu = (bx & 7) * (GRID / 8) + (bx >> 3); }
    unsigned char* ws = args.ws;
    F.ctl = (gu32*)(ws + WS_CTL);
    for (int u = F.tid; u < (LDS_BYTES - LDSCTL_OFF) / 4; u += NWAVES * 64) ((LAS unsigned*)(F.lds + LDSCTL_OFF))[u] = 0u;
    __syncthreads();
    XcdBarrier bar; bar.bar = (unsigned*)(F.ctl + CW_BAR); bar.x = 0; bar.st = nullptr;
    if (MK_N_LAUNCHES == 1) bar = xcd_barrier_post((unsigned*)(F.ctl + CW_BAR), F.MISC + 8);
    const int lo = args.ph_lo, hi = args.ph_hi;
#define IN(k) (lo <= (k) && (k) < hi)
#define OPQ_FRAME(Fl) Frame Fl = F; { int l_; asm volatile("v_mbcnt_lo_u32_b32 %0, -1, 0\n\tv_mbcnt_hi_u32_b32 %0, -1, %0" : "=v"(l_)); int w_ = F.wave; asm volatile("" : "+s"(w_)); Fl.wave = w_; Fl.lane = l_; Fl.tid = w_ * 64 + l_; }
#define SEAM(k) do { if (IN(k) && IN((k) + 1)) xcd_barrier(bar); } while (0)

    bf16* hb = (bf16*)(ws + WS_HB); bf16* mb = (bf16*)(ws + WS_M); float* ss = (float*)(ws + WS_SS); float* halo = (float*)(ws + WS_HALO);
    unsigned char* proj = ws + WS_PROJ; bf16* act = (bf16*)(ws + WS_PROJ);

#ifndef SKIP_P0
    if (IN(0)) { for (int rep = 0; rep < REP_P0; ++rep) { OPQ_FRAME(F0); p0_prologue(F0, args); } }
#endif
    SEAM(0);

#pragma unroll 1
    for (int L = 0; L < DEPTH; ++L) {
        const int pb = 1 + 6 * L, li = L >> 1; const bool isB = (L & 1) != 0;
        if (IN(pb)) {
#ifndef SKIP_IN
            for (int rep = 0; rep < REP_IN; ++rep)
            if (!isB) {
                pg8::Gemm g{hb, (const bf16*)(ws + WS_W_INA) + (size_t)li * NA_PAD * DM, MTOK, NA_PAD, DM}; pg8::StaticOrder S; S.init(MTOK, NA_PAD, F.G, (int)blockIdx.x);
                EpiIn E{ss, proj, args.q_norm_g + L * 64, args.k_norm_g + L * 64, 0};
                pg8::gemm_phase<EpiIn, pg8::StaticOrder, true, true>(F.lds + RING_OFF, g, S, E, F.wave);
            } else {
                pg8::Gemm g{hb, (const bf16*)(ws + WS_W_INB) + (size_t)li * NB * DM, MTOK, NB, DM}; pg8::StaticOrder S; S.init(MTOK, NB, F.G, (int)blockIdx.x);
                EpiIn E{ss, proj, args.q_norm_g + L * 64, args.k_norm_g + L * 64, 1};
                pg8::gemm_phase<EpiIn, pg8::StaticOrder, true, true>(F.lds + RING_OFF, g, S, E, F.wave);
            }
#endif
        }
        SEAM(pb);
#if defined(DBG_NODSA) || defined(DBG_NOBAND)
#ifdef DBG_NODSA
        const bool zero_m = !isB;
#else
        const bool zero_m = isB;
#endif
        if (IN(pb + 1) && zero_m) { for (size_t i = (size_t)blockIdx.x * 512 + threadIdx.x; i < (size_t)MTOK * DM / 8; i += (size_t)gridDim.x * 512) ((v4u*)mb)[i] = (v4u){0u, 0u, 0u, 0u}; }
        if (IN(pb + 1) && !zero_m) {
#else
        if (IN(pb + 1)) {
#endif
#ifndef SKIP_DSA
            if (!isB) {
                LAS float* t5l = (LAS float*)(F.lds + AUX_OFF);
                { OPQ_FRAME(Ft); for (int i = Ft.tid; i < 512; i += NWAVES * 64) t5l[i] = args.t5_bias[i] * LOG2E; }
                __syncthreads();
                dsa::Ctx C{(const bf16*)(proj + PA_QA), (const bf16*)(proj + PA_KA), (const bf16*)(proj + PA_VA), (const bf16*)(proj + PA_QI), (const bf16*)(proj + PA_KI), (const float*)(proj + PA_WI), mb, t5l, (unsigned short*)(proj + PA_SEL)};
#ifdef DBG_DSACOPY
                { int t_ = threadIdx.x; asm volatile("" : "+v"(t_));
                for (unsigned i = blockIdx.x * 512u + (unsigned)t_; i < (unsigned)MTOK * DM; i += gridDim.x * 512u) { const unsigned t = i >> 10, c = i & 1023u;
                    float v = bf_lo(C.QA[i]); v += bf_lo(C.KA[t * 256 + (c & 255)]); v += bf_lo(C.VA[t * 256 + (c & 255)]); v += bf_lo(C.QI[t * 512 + (c & 511)]); v += bf_lo(C.KI[t * 64 + (c & 63)]); v += C.WI[t * 8 + (c & 7)];
                    mb[i] = (bf16)f2bf(v * 0.01f); asm volatile("" ::: "memory"); } }
#else
                for (int rep = 0; rep < REP_DSA; ++rep) { OPQ_FRAME(F1); dsa::phase(F1, C); }
                xcd_barrier(bar);
                { OPQ_FRAME(F1b); att8::Ctx8 C8{(const unsigned char*)(proj + PA_QA), (const unsigned char*)(proj + PA_KA), (const unsigned short*)(proj + PA_SEL), mb};
#ifndef REP_ATT8
#define REP_ATT8 1
#endif
                  for (int rep = 0; rep < REP_ATT8; ++rep) { att8::phase(F1b, C8, args.t5_bias); __syncthreads(); } }
#endif
            }
#endif
#ifndef SKIP_BAND
            if (isB) {
                for (int rep = 0; rep < REP_BAND; ++rep) { OPQ_FRAME(F2); band::phase(F2, (const bf16*)proj, (const bf16*)(proj + PB_STRIDE), (const bf16*)(proj + 2 * PB_STRIDE), mb, args.rel_bias_b + (size_t)li * 513 * 16); }
            }
#endif
        }
        SEAM(pb + 1);
        if (IN(pb + 2)) {
#ifndef SKIP_OUT
            pg8::Gemm g{mb, (const bf16*)(ws + WS_W_OUT) + (size_t)L * DM * DM, MTOK, DM, DM}; pg8::StaticOrder S; S.init(MTOK, DM, F.G, (int)blockIdx.x);
#ifdef REP_OUT
            { EpiRes E0{L == 0 ? args.x : nullptr, nullptr, hb, (bf16*)proj, halo}; pg8::gemm_phase<EpiRes, pg8::StaticOrder, true, true>(F.lds + RING_OFF, g, S, E0, F.wave); }
#endif
            EpiRes E{L == 0 ? args.x : nullptr, nullptr, hb, hb, ss};
            pg8::gemm_phase<EpiRes, pg8::StaticOrder, true, true>(F.lds + RING_OFF, g, S, E, F.wave);
#endif
        }
        SEAM(pb + 2);
        if (IN(pb + 3)) {
#ifndef SKIP_UP
            for (int rep = 0; rep < REP_UP; ++rep) {
            pg8::Gemm g{hb, (const bf16*)(ws + WS_W_UP) + (size_t)L * NUP * DM, MTOK, NUP, DM}; pg8::StaticOrder S; S.init(MTOK, NUP, F.G, (int)blockIdx.x);
#ifdef PROBE_UPK
            { EpiDummy E0{halo}; pg8::gemm_phase<EpiDummy, pg8::StaticOrder, true, true>(F.lds + RING_OFF, g, S, E0, F.wave); }
#endif
            EpiUp E{ss, args.conv_w + (size_t)L * 3 * NUP, args.conv_b + (size_t)L * NUP, act, halo, (LAS float*)(F.lds + AUX_OFF)};
            pg8::gemm_phase<EpiUp, pg8::StaticOrder, true, true>(F.lds + RING_OFF, g, S, E, F.wave); }
#endif
        }
        SEAM(pb + 3);
#ifndef SKIP_FIX
        if (IN(pb + 4)) for (int rep = 0; rep < REP_FIX; ++rep) { OPQ_FRAME(F3); fixup_phase(F3, args.conv_w + (size_t)L * 3 * NUP, args.conv_b + (size_t)L * NUP, halo, act); }
#endif
        SEAM(pb + 4);
        if (IN(pb + 5)) {
#ifndef SKIP_DN
            pg8::Gemm g{act, (const bf16*)(ws + WS_W_DN) + (size_t)L * DM * FF, MTOK, DM, FF}; pg8::StaticOrder S; S.init(MTOK, DM, F.G, (int)blockIdx.x);
#ifdef REP_DN
            { EpiRes E0{nullptr, nullptr, hb, mb, halo}; pg8::gemm_phase<EpiRes, pg8::StaticOrder, true, true>(F.lds + RING_OFF, g, S, E0, F.wave); }
#endif
            EpiRes E{nullptr, L == DEPTH - 1 ? args.out : nullptr, hb, hb, ss};
            pg8::gemm_phase<EpiRes, pg8::StaticOrder, true, true>(F.lds + RING_OFF, g, S, E, F.wave);
#endif
        }
        SEAM(pb + 5);
    }
#undef IN
#undef SEAM
}

extern "C" void kernel_launch(void* const* d_in, const int* in_sizes, int n_in, void* d_out, int out_size, void* d_ws, size_t ws_size, hipStream_t stream) {
    static int grid = 0;
    if (grid == 0) {
        if (n_in != 14 || in_sizes[0] != MTOK * DM || out_size != MTOK * DM || ws_size < WS_END) { fprintf(stderr, "kernel_launch: unexpected shapes / workspace (n_in %d, ws %zu); nothing launched\n", n_in, ws_size); grid = -1; return; }
        int dev = 0, cus = 0, per_cu = 0;
        if (hipGetDevice(&dev) != hipSuccess || hipDeviceGetAttribute(&cus, hipDeviceAttributeMultiprocessorCount, dev) != hipSuccess) { grid = -1; return; }
        if (hipFuncSetAttribute((const void*)mega_fwd, hipFuncAttributeMaxDynamicSharedMemorySize, LDS_BYTES) != hipSuccess) { fprintf(stderr, "kernel_launch: hipFuncSetAttribute failed\n"); grid = -1; return; }
        if (hipOccupancyMaxActiveBlocksPerMultiprocessor(&per_cu, (const void*)mega_fwd, NWAVES * 64, LDS_BYTES) != hipSuccess || per_cu < 1) { fprintf(stderr, "kernel_launch: occupancy query reports %d blocks per CU\n", per_cu); }
        (void)hipGetLastError();
        if (cus != GRID) { fprintf(stderr, "kernel_launch: built for a %d-CU device, found %d; nothing launched\n", GRID, cus); grid = -1; return; }
        grid = GRID;
    }
    if (grid < 0) return;
    if (hipMemsetAsync((char*)d_ws + WS_CTL, 0, CTL_ZERO_BYTES, stream) != hipSuccess) return;
    Args a{};
    a.x = (const float*)d_in[0]; a.attn_norm_g = (const float*)d_in[1]; a.w_in_a = (const float*)d_in[2]; a.w_in_b = (const float*)d_in[3]; a.q_norm_g = (const float*)d_in[4];
    a.k_norm_g = (const float*)d_in[5]; a.t5_bias = (const float*)d_in[6]; a.rel_bias_b = (const float*)d_in[7]; a.w_out = (const float*)d_in[8]; a.ffn_norm_g = (const float*)d_in[9];
    a.w_up = (const float*)d_in[10]; a.conv_w = (const float*)d_in[11]; a.conv_b = (const float*)d_in[12]; a.w_down = (const float*)d_in[13];
    a.out = (float*)d_out; a.ws = (unsigned char*)d_ws; a.pad = 0;
#if MK_N_LAUNCHES == 1
    a.ph_lo = 0; a.ph_hi = N_PHASES; a.li = 0;
    hipLaunchKernelGGL(mega_fwd, dim3(grid), dim3(NWAVES * 64), LDS_BYTES, stream, a);
#else
    for (int p = 0; p < N_PHASES; ++p) { a.ph_lo = p; a.ph_hi = p + 1; a.li = p; hipLaunchKernelGGL(mega_fwd, dim3(grid), dim3(NWAVES * 64), LDS_BYTES, stream, a); }
#endif
}
```

```cpp
#include <hip/hip_runtime.h>
#include <cstdio>
#include <cstdint>
namespace pg8 {
#define PG8_LAS __attribute__((address_space(3)))
typedef unsigned short bf16_t;
typedef short bf16x8 __attribute__((ext_vector_type(8)));
typedef float f32x4 __attribute__((ext_vector_type(4)));
typedef unsigned u32x4 __attribute__((ext_vector_type(4)));
constexpr int BM = 256, BK = 64, HALF = 128, HTB = HALF * BK * 2  , STAGE_BYTES = 8 * HTB, NXCD = 8, WGM = 8;

__host__ __device__ __forceinline__ int lds_byte(int r, int c) { const int st = (r >> 4) * 2 + (c >> 5), rr = r & 15, cc = c & 31, ob = rr * 64 + cc * 2; return st * 1024 + (ob ^ (((ob >> 9) & 1) << 5)); }
__host__ __device__ __forceinline__ void stage_rc(int b, int& R, int& C) { const int st = b / 1024, sb = b % 1024, swz = sb ^ (((sb >> 9) & 1) << 5); R = (st >> 1) * 16 + swz / 64; C = (st & 1) * 32 + (swz % 64) / 2; }
__host__ __device__ __forceinline__ int perm32(int rho) { const int n = rho >> 4, i = rho & 15; return 8 * (i >> 2) + 4 * n + (i & 3); }

struct Unit { int pm, pn; };
struct Gemm { const bf16_t* A; const bf16_t* Bt; int M, N, K; };

struct StaticOrder {
    int nM, nN, nwg, G, c;
    __host__ __device__ void init(int M, int N, int G_, int c_) { nM = M / BM; nN = N / BM; nwg = nM * nN; G = G_; c = c_; }
    __host__ __device__ bool next(int i, Unit& u) const {
        const long L = (long)i * G + c; if (L >= nwg) return false;
        int wgid = (int)L; { const int q = nwg / NXCD, r = nwg % NXCD, xcd = wgid % NXCD, off = wgid / NXCD; wgid = (xcd < r ? xcd * (q + 1) : r * (q + 1) + (xcd - r) * q) + off; }
        const int nig = WGM * nN, gid = wgid / nig, fm = gid * WGM, gsz = (nM - fm) < WGM ? (nM - fm) : WGM;
        u.pm = fm + ((wgid % nig) % gsz); u.pn = (wgid % nig) / gsz; return true;
    }
    __device__ __forceinline__ void a_ready(const Unit&) const {}
    __device__ __forceinline__ void done(const Unit&) const {}
};
__device__ __forceinline__ unsigned cvt_pk_bf16(float lo, float hi) { unsigned r; asm volatile("v_cvt_pk_bf16_f32 %0, %1, %2" : "=v"(r) : "v"(lo), "v"(hi)); return r; }
template <class Epi, class Sched, bool ALIGN_EPI = false, bool SP2 = false>
__device__ __forceinline__ void gemm_phase(PG8_LAS unsigned char* lds, const Gemm g, const Sched& S, const Epi& E, const int wave_id) {
    int lane_; asm volatile("v_mbcnt_lo_u32_b32 %0, -1, 0\n\tv_mbcnt_hi_u32_b32 %0, -1, %0" : "=v"(lane_));
    int wid_ = wave_id; asm volatile("" : "+s"(wid_));
    const int wid = wid_, lane = lane_, tid = wid * 64 + lane, wr = wid >> 2, wc = wid & 3, fr = lane & 15, fq = lane >> 4;
    const int K = g.K, nt = K / BK;
    unsigned voffA[2], voffB[2];
#pragma unroll
    for (int i = 0; i < 2; ++i) { int R, C; stage_rc(tid * 16 + i * 8192, R, C); const int Rb = Epi::PERM ? ((R & ~31) + perm32(R & 31)) : R;
        const int Ra = Epi::PERMA ? ((R & ~63) | (4 * (R & 15) + ((R >> 4) & 3))) : R;
        voffA[i] = (unsigned)(Ra * K + C) * 2u; voffB[i] = (unsigned)(Rb * K + C) * 2u; }
    const size_t kstep = (size_t)(BK * 2);
    const size_t hstep = (size_t)HALF * K * 2;
    const size_t tstep = 2 * hstep;
    const unsigned ldsw = (unsigned)wid * 1024u;
    const int aoff = lds_byte(wr * 64 + fr, fq * 8), boff = lds_byte(wc * 32 + fr, fq * 8);
#define PG8_SA(b, h) (((b) * 2 + (h)) * HTB)
#define PG8_SB(b, h) ((4 + (b) * 2 + (h)) * HTB)
#define PG8_STAGE(bufoff, gbase, voff) do { _Pragma("unroll") for (int _i = 0; _i < 2; ++_i) \
        __builtin_amdgcn_global_load_lds((const unsigned*)((const char*)(gbase) + (voff)[_i]), (PG8_LAS unsigned*)(lds + (bufoff) + ldsw + _i * 8192), 16, 0, 0); } while (0)
#define PG8_LDA(dst, b, h) do { _Pragma("unroll") for (int m = 0; m < 4; ++m) _Pragma("unroll") for (int k = 0; k < 2; ++k) dst[m][k] = *(const PG8_LAS bf16x8*)(lds + PG8_SA(b, h) + aoff + m * 2048 + k * 1024); } while (0)
#define PG8_LDB(dst, b, h) do { _Pragma("unroll") for (int n = 0; n < 2; ++n) _Pragma("unroll") for (int k = 0; k < 2; ++k) dst[n][k] = *(const PG8_LAS bf16x8*)(lds + PG8_SB(b, h) + boff + n * 2048 + k * 1024); } while (0)
#define PG8_MMA(ai, bj, At, Bt) do { __builtin_amdgcn_s_setprio(1); _Pragma("unroll") for (int m = 0; m < 4; ++m) _Pragma("unroll") for (int n = 0; n < 2; ++n) _Pragma("unroll") for (int k = 0; k < 2; ++k) \
        acc[ai][bj][m][n] = __builtin_amdgcn_mfma_f32_16x16x32_bf16(Bt[n][k], At[m][k], acc[ai][bj][m][n], 0, 0, 0); __builtin_amdgcn_s_setprio(0); } while (0)
#define PG8_WAIT_V(n) asm volatile("s_waitcnt vmcnt(" #n ")" ::: "memory")
#define PG8_WAIT_L(n) asm volatile("s_waitcnt lgkmcnt(" #n ")" ::: "memory")
#define PG8_BAR __builtin_amdgcn_s_barrier()
#define PG8_SCHED __builtin_amdgcn_sched_barrier(0)
    Unit cur, nxt; int ui = 0;
    if (!S.next(0, cur)) return;
    f32x4 acc[2][2][4][2];
#pragma unroll
    for (int a = 0; a < 2; ++a)
#pragma unroll
        for (int b = 0; b < 2; ++b)
#pragma unroll
            for (int m = 0; m < 4; ++m)
#pragma unroll
                for (int n = 0; n < 2; ++n) acc[a][b][m][n] = (f32x4){0.f, 0.f, 0.f, 0.f};
    bf16x8 At[4][2], B0[2][2], B1[2][2];
    const char* cA = (const char*)g.A + (size_t)cur.pm * tstep; const char* cB = (const char*)g.Bt + (size_t)cur.pn * tstep;
    S.a_ready(cur);
    if constexpr (SP2) {
        PG8_STAGE(PG8_SB(0, 0), cB, voffB); PG8_STAGE(PG8_SB(0, 1), cB + hstep, voffB); PG8_STAGE(PG8_SA(0, 0), cA, voffA); PG8_STAGE(PG8_SA(0, 1), cA + hstep, voffA);
        if (wr == 1) PG8_BAR;
        PG8_WAIT_V(2); PG8_BAR;
        PG8_STAGE(PG8_SB(1, 0), cB + kstep, voffB); PG8_STAGE(PG8_SA(1, 0), cA + kstep, voffA); PG8_STAGE(PG8_SB(1, 1), cB + hstep + kstep, voffB);
        PG8_WAIT_V(6); PG8_BAR;
    } else {
        PG8_STAGE(PG8_SB(0, 0), cB, voffB); PG8_STAGE(PG8_SA(0, 0), cA, voffA); PG8_STAGE(PG8_SB(0, 1), cB + hstep, voffB); PG8_STAGE(PG8_SA(0, 1), cA + hstep, voffA);
        if (wr == 1) PG8_BAR;
        PG8_WAIT_V(4); PG8_BAR;
        PG8_STAGE(PG8_SB(1, 0), cB + kstep, voffB); PG8_STAGE(PG8_SA(1, 0), cA + kstep, voffA); PG8_STAGE(PG8_SB(1, 1), cB + hstep + kstep, voffB);
        PG8_WAIT_V(6); PG8_BAR;
    }
    for (;;) {
        const bool has_next = S.next(ui + 1, nxt);
        const char* nA = has_next ? (const char*)g.A + (size_t)nxt.pm * tstep : cA; const char* nB = has_next ? (const char*)g.Bt + (size_t)nxt.pn * tstep : cB;
        for (int t = 0; t < nt; t += 2) {
            const bool last = (t == nt - 2);
            const char* a1 = cA + (size_t)(t + 1) * kstep;
            const char* a2 = last ? nA : cA + (size_t)(t + 2) * kstep; const char* b2 = last ? nB : cB + (size_t)(t + 2) * kstep;
            const char* a3 = a2 + kstep; const char* b3 = b2 + kstep;
            if (last && has_next) S.a_ready(nxt);
            if constexpr (SP2) {
            PG8_LDB(B0, 0, 0); PG8_LDB(B1, 0, 1); PG8_SCHED; PG8_LDA(At, 0, 0); PG8_STAGE(PG8_SA(1, 1), a1 + hstep, voffA);
            PG8_WAIT_V(8); PG8_WAIT_L(0); PG8_BAR; PG8_MMA(0, 0, At, B0); PG8_MMA(0, 1, At, B1); PG8_BAR; PG8_SCHED;
            PG8_LDA(At, 0, 1); PG8_STAGE(PG8_SB(0, 0), b2, voffB); PG8_STAGE(PG8_SB(0, 1), b2 + hstep, voffB); PG8_STAGE(PG8_SA(0, 0), a2, voffA);
            PG8_WAIT_V(8); PG8_WAIT_L(0); PG8_BAR; PG8_MMA(1, 0, At, B0); PG8_MMA(1, 1, At, B1); PG8_BAR; PG8_SCHED;
            PG8_LDB(B0, 1, 0); PG8_LDB(B1, 1, 1); PG8_SCHED; PG8_LDA(At, 1, 0); PG8_STAGE(PG8_SA(0, 1), a2 + hstep, voffA);
            PG8_WAIT_V(8); PG8_WAIT_L(0); PG8_BAR; PG8_MMA(0, 0, At, B0); PG8_MMA(0, 1, At, B1); PG8_BAR; PG8_SCHED;
            PG8_LDA(At, 1, 1); PG8_STAGE(PG8_SB(1, 0), b3, voffB); PG8_STAGE(PG8_SB(1, 1), b3 + hstep, voffB); PG8_STAGE(PG8_SA(1, 0), a3, voffA);
            PG8_WAIT_V(8); PG8_WAIT_L(0); PG8_BAR; PG8_MMA(1, 0, At, B0); PG8_MMA(1, 1, At, B1); PG8_BAR; PG8_SCHED;
            } else {
            PG8_LDB(B0, 0, 0); PG8_SCHED; PG8_LDA(At, 0, 0); PG8_STAGE(PG8_SA(1, 1), a1 + hstep, voffA);
            PG8_WAIT_L(8); PG8_BAR; PG8_WAIT_L(0); PG8_MMA(0, 0, At, B0); PG8_BAR; PG8_SCHED;
            PG8_LDB(B1, 0, 1); PG8_STAGE(PG8_SB(0, 0), b2, voffB);
            PG8_BAR; PG8_WAIT_L(0); PG8_MMA(0, 1, At, B1); PG8_BAR;
            PG8_LDA(At, 0, 1); PG8_STAGE(PG8_SA(0, 0), a2, voffA);
            PG8_BAR; PG8_WAIT_L(0); PG8_MMA(1, 0, At, B0); PG8_BAR; PG8_SCHED;
            PG8_STAGE(PG8_SB(0, 1), b2 + hstep, voffB);
            PG8_WAIT_V(6); PG8_BAR; PG8_MMA(1, 1, At, B1); PG8_BAR;
            PG8_LDB(B0, 1, 0); PG8_SCHED; PG8_LDA(At, 1, 0); PG8_STAGE(PG8_SA(0, 1), a2 + hstep, voffA);
            PG8_WAIT_L(8); PG8_BAR; PG8_WAIT_L(0); PG8_MMA(0, 0, At, B0); PG8_BAR; PG8_SCHED;
            PG8_LDB(B1, 1, 1); PG8_STAGE(PG8_SB(1, 0), b3, voffB);
            PG8_BAR; PG8_WAIT_L(0); PG8_MMA(0, 1, At, B1); PG8_BAR;
            PG8_LDA(At, 1, 1); PG8_STAGE(PG8_SA(1, 0), a3, voffA);
            PG8_BAR; PG8_WAIT_L(0); PG8_MMA(1, 0, At, B0); PG8_BAR; PG8_SCHED;
            PG8_STAGE(PG8_SB(1, 1), b3 + hstep, voffB);
            PG8_WAIT_V(6); PG8_BAR; PG8_MMA(1, 1, At, B1); PG8_BAR;
            }
        }
        if constexpr (ALIGN_EPI) { if (wr == 0) PG8_BAR; }
        if constexpr (!Epi::AFTER_DRAIN) { E(acc, cur, wr, wc, fr, fq); S.done(cur); }
        if (!has_next) break;
#pragma unroll
        for (int a = 0; a < 2; ++a)
#pragma unroll
            for (int b = 0; b < 2; ++b)
#pragma unroll
                for (int m = 0; m < 4; ++m)
#pragma unroll
                    for (int n = 0; n < 2; ++n) acc[a][b][m][n] = (f32x4){0.f, 0.f, 0.f, 0.f};
        cur = nxt; cA = nA; cB = nB; ++ui;
        if constexpr (ALIGN_EPI) { if (wr == 1) PG8_BAR; }
    }
    PG8_WAIT_V(0);
    if constexpr (!ALIGN_EPI) { if (wr == 0) PG8_BAR; }
    PG8_BAR;
    if constexpr (Epi::AFTER_DRAIN) { E.fused(acc, cur, wr, wc, fr, fq, lds, wid, lane); S.done(cur); }
#undef PG8_SA
#undef PG8_SB
#undef PG8_STAGE
#undef PG8_LDA
#undef PG8_LDB
#undef PG8_MMA
#undef PG8_WAIT_V
#undef PG8_WAIT_L
#undef PG8_BAR
#undef PG8_SCHED
}
}

constexpr int NWAVES = 8, GRID = 256;
constexpr int BATCH = 4, SEQ = 8192, DM = 1024, MTOK = BATCH * SEQ, DEPTH = 4;
constexpr int NA_SRC = 2120, NA_PAD = 2304, NB = 3072, FF = 2816, NUP = 2 * FF;
constexpr float EPS = 1e-6f;
constexpr float LOG2E = 1.4426950408889634f;
constexpr float C2 = 0.125f * LOG2E;
constexpr int NBLK64 = MTOK / 64;

constexpr size_t MiB = 1u << 20;
constexpr size_t WS_CTL = 0, CTL_ZERO_BYTES = 1 * MiB;
constexpr size_t WS_W_INA = 2 * MiB;
constexpr size_t WS_W_INB = 11 * MiB;
constexpr size_t WS_W_OUT = 23 * MiB;
constexpr size_t WS_W_UP = 31 * MiB;
constexpr size_t WS_W_DN = 75 * MiB;
constexpr size_t WS_HB = 98 * MiB;
constexpr size_t WS_M = 162 * MiB;
constexpr size_t WS_SS = 226 * MiB;
constexpr size_t WS_HALO = 228 * MiB;
constexpr size_t WS_PROJ = 272 * MiB;
constexpr size_t WS_END = 464 * MiB;
constexpr size_t PA_QA = 0, PA_KA = 64 * MiB, PA_VA = 80 * MiB, PA_QI = 96 * MiB, PA_KI = 128 * MiB, PA_WI = 132 * MiB, PA_SEL = 136 * MiB;
constexpr size_t PB_STRIDE = 64 * MiB;
constexpr int CW_BAR = 4096;

constexpr int RING_OFF = 0, RING_BYTES = 131072;
constexpr int KS_OFF = RING_BYTES;
constexpr int AUX_OFF = RING_BYTES + 24576;
constexpr int LDSCTL_OFF = AUX_OFF + 4096, MISC_OFF = LDSCTL_OFF + 320;
constexpr int LDS_BYTES = 163840;
static_assert(MISC_OFF + 128 <= LDS_BYTES, "LDS map");

#define GAS __attribute__((address_space(1)))
#define LAS __attribute__((address_space(3)))
typedef unsigned short bf16;
typedef unsigned v4u __attribute__((ext_vector_type(4)));
typedef unsigned v2u __attribute__((ext_vector_type(2)));
typedef float f32x4 __attribute__((ext_vector_type(4)));
typedef float f32x16 __attribute__((ext_vector_type(16)));
typedef short bf16x8 __attribute__((ext_vector_type(8)));
typedef short s16x4 __attribute__((ext_vector_type(4)));
typedef float f32x2_t __attribute__((ext_vector_type(2)));
typedef GAS unsigned gu32;
#define RLX_AGENT __ATOMIC_RELAXED, __HIP_MEMORY_SCOPE_AGENT
#define LDS_WAIT() asm volatile("s_waitcnt lgkmcnt(0)" ::: "memory")
#define VM_WAIT() asm volatile("s_waitcnt vmcnt(0)" ::: "memory")
__device__ __forceinline__ unsigned f2bf(float f) { unsigned u = __builtin_bit_cast(unsigned, f); return (u + 0x7fffu + ((u >> 16) & 1u)) >> 16; }
__device__ __forceinline__ unsigned pk2(float lo, float hi) { return f2bf(lo) | (f2bf(hi) << 16); }
typedef float f32x2c_t __attribute__((ext_vector_type(2))); typedef __bf16 bf16x2c_t __attribute__((ext_vector_type(2)));
__device__ __forceinline__ unsigned cvtpk(float lo, float hi) { const f32x2c_t v = {lo, hi}; const bf16x2c_t b = __builtin_convertvector(v, bf16x2c_t); return __builtin_bit_cast(unsigned, b); }
__device__ __forceinline__ float bf_lo(unsigned u) { return __builtin_bit_cast(float, u << 16); }
__device__ __forceinline__ float bf_hi(unsigned u) { return __builtin_bit_cast(float, u & 0xffff0000u); }

#define XB_TMO      128
#define XB_XCNT(j)  (256  + 64 * (j))
#define XB_XSUB(j)  (1280 + 64 * (j))
#define XB_XGEN(j)  (2304 + 64 * (j))
#define XB_TOP      3328
#define XB_TOPGEN   3392
#define XCD_BAR_WORDS 3456
#define XB_SPIN_CAP (1u << 18)

__device__ __forceinline__ unsigned xb_ld(unsigned* p)              { return __hip_atomic_load(p, __ATOMIC_RELAXED, __HIP_MEMORY_SCOPE_AGENT); }
__device__ __forceinline__ unsigned xb_add(unsigned* p, unsigned v) { return __hip_atomic_fetch_add(p, v, __ATOMIC_RELAXED, __HIP_MEMORY_SCOPE_AGENT); }
__device__ __forceinline__ unsigned xb_xcc_id() { return (unsigned)__builtin_amdgcn_s_getreg((3 << 11) | 20) & 0xFu; }
#define XB_SPIN(cond, bar) do { unsigned _sp = 0; while (cond) { __builtin_amdgcn_s_sleep(1); \
    if ((++_sp & 255u) == 0u) { if (xb_ld(&(bar)[XB_TMO])) break; if (_sp > XB_SPIN_CAP) { atomicAdd(&(bar)[XB_TMO], 1u); break; } } } } while (0)

struct XcdBarrier {
    unsigned* bar; unsigned x;
    volatile LAS unsigned* st;
};

__device__ __forceinline__ XcdBarrier xcd_barrier_post(unsigned* bar, volatile LAS unsigned* st) {
    XcdBarrier b; b.bar = bar; b.x = xb_xcc_id(); b.st = st;
    if (threadIdx.x == 0) (void)xb_add(&bar[XB_XCNT(b.x)], 1u);
    return b;
}
__device__ __forceinline__ void xcd_barrier_complete(unsigned* bar, unsigned x, unsigned& nloc, unsigned& nx) {
    const unsigned G = gridDim.x * gridDim.y * gridDim.z;
    unsigned sum, cnt, mine, sp = 0u;
    for (;;) {
        sum = 0u; cnt = 0u; mine = 0u;
#pragma unroll
        for (unsigned j = 0; j < 16; ++j) { const unsigned c = xb_ld(&bar[XB_XCNT(j)]); sum += c; cnt += (c > 0u) ? 1u : 0u; mine = (j == x) ? c : mine; }
        if (sum == G) break;
        __builtin_amdgcn_s_sleep(1);
        if ((++sp & 255u) == 0u) { if (xb_ld(&bar[XB_TMO])) break; if (sp > XB_SPIN_CAP) { atomicAdd(&bar[XB_TMO], 1u); break; } }
    }
    nloc = mine > 0u ? mine : 1u; nx = cnt > 0u ? cnt : 1u;
}

__device__ __forceinline__ void xcd_barrier(const XcdBarrier& b) {
    asm volatile("s_waitcnt vmcnt(0)" ::: "memory");
    __syncthreads();
    if (threadIdx.x == 0) {
        unsigned* bar = b.bar;
        __builtin_amdgcn_s_waitcnt(0);
        unsigned nloc = b.st[0], nx = b.st[1];
        if (nloc == 0u) { xcd_barrier_complete(bar, b.x, nloc, nx); b.st[0] = nloc; b.st[1] = nx; }
        const unsigned old = xb_add(&bar[XB_XSUB(b.x)], 1u);
        const unsigned gen = old / nloc;
        if (old + 1u == (gen + 1u) * nloc) {
            __builtin_amdgcn_fence(__ATOMIC_RELEASE, "agent");
            asm volatile("s_waitcnt vmcnt(0)" ::: "memory");
            const unsigned og = xb_add(&bar[XB_TOP], 1u);
            const unsigned tg = og / nx;
            if (og + 1u == (tg + 1u) * nx) xb_add(&bar[XB_TOPGEN], 1u);
            else XB_SPIN(xb_ld(&bar[XB_TOPGEN]) == tg, bar);
            __builtin_amdgcn_fence(__ATOMIC_ACQUIRE, "agent");
            xb_add(&bar[XB_XGEN(b.x)], 1u);
            asm volatile("s_waitcnt vmcnt(0)" ::: "memory");
        } else {
            XB_SPIN(xb_ld(&bar[XB_XGEN(b.x)]) == gen, bar);
            __builtin_amdgcn_fence(__ATOMIC_ACQUIRE, "agent");
            asm volatile("s_waitcnt vmcnt(0)" ::: "memory");
        }
    }
    __syncthreads();
}


struct Args {
    const float* x; const float* attn_norm_g; const float* w_in_a; const float* w_in_b; const float* q_norm_g; const float* k_norm_g; const float* t5_bias;
    const float* rel_bias_b; const float* w_out; const float* ffn_norm_g; const float* w_up; const float* conv_w; const float* conv_b; const float* w_down;
    float* out; unsigned char* ws; int ph_lo, ph_hi, li, pad;
};

struct Frame {
    LAS unsigned char* lds;
    volatile LAS unsigned* MISC;
    gu32* ctl;
    int tid, lane, wave, vcu, G;
};

__host__ __device__ __forceinline__ int hmap(int p) { return 64 * ((p >> 5) & 3) + 16 * ((p >> 2) & 3) + 8 * (p >> 7) + 4 * ((p >> 4) & 1) + (p & 3); }
__host__ __device__ __forceinline__ int umap(int p) { return 32 * ((p >> 5) & 3) + 8 * ((p >> 2) & 3) + 4 * ((p >> 4) & 1) + (p & 3); }
__host__ __device__ __forceinline__ int src_col(int type, int n) {
    if (type == 0) return n;
    const int pn = n >> 8, p = n & 255;
    if (type == 2) return 256 * pn + hmap(p);
    if (type == 1) { const int c = hmap(p); return pn < 8 ? 256 * pn + c : (c < 72 ? 2048 + c : -1); }
    return (p >> 7) * FF + 128 * pn + umap(p);
}
__device__ __forceinline__ void convert_item(const float* W, int K, int Nsrc, int Ndst, int type, const float* gain, bf16* WT, LAS float* scr, int item, int lane) {
    const int nblk = Ndst / 32, kb = item / nblk, nb = item % nblk, k0 = 64 * kb, n0 = 32 * nb;
    const int sc = src_col(type, n0 + (lane & 31));
#pragma unroll 8
    for (int i = 0; i < 32; ++i) { const int kk = 2 * i + (lane >> 5); float v = 0.f; if (sc >= 0) v = W[(size_t)(k0 + kk) * Nsrc + sc]; if (gain) v *= gain[k0 + kk]; scr[kk * 33 + (lane & 31)] = v; }
    LDS_WAIT(); asm volatile("" ::: "memory");
    const int c = lane & 7;
#pragma unroll
    for (int j = 0; j < 4; ++j) { const int n = (lane >> 3) + 8 * j; const LAS float* s = scr + (8 * c) * 33 + n;
        v4u o; o.x = pk2(s[0 * 33], s[1 * 33]); o.y = pk2(s[2 * 33], s[3 * 33]); o.z = pk2(s[4 * 33], s[5 * 33]); o.w = pk2(s[6 * 33], s[7 * 33]);
        *(v4u*)(WT + (size_t)(n0 + n) * K + k0 + 8 * c) = o; }
    LDS_WAIT(); asm volatile("" ::: "memory");
}
__device__ __forceinline__ float wave_sum(float v) {
#pragma unroll
    for (int o = 1; o < 64; o <<= 1) v += __shfl_xor(v, o);
    return v;
}
__device__ __forceinline__ void p0_prologue(Frame& F, const Args& a) {
    LAS float* scr = (LAS float*)(F.lds + RING_OFF + F.wave * 16384);
    const int gw = F.vcu * NWAVES + F.wave, NGW = F.G * NWAVES;
    constexpr int I_INA = 16 * (NA_PAD / 32), I_INB = 16 * (NB / 32), I_OUT = 16 * 32, I_UP = 16 * (NUP / 32), I_DN = (FF / 64) * 32;
    constexpr int NITEMS = 2 * I_INA + 2 * I_INB + 4 * I_OUT + 4 * I_UP + 4 * I_DN;
    unsigned char* ws = a.ws;
    for (int it = gw; it < NITEMS; it += NGW) {
        int r = it;
        if (r < 2 * I_INA) { const int l = r / I_INA; convert_item(a.w_in_a + (size_t)l * DM * NA_SRC, DM, NA_SRC, NA_PAD, 1, a.attn_norm_g + (2 * l) * DM, (bf16*)(ws + WS_W_INA) + (size_t)l * NA_PAD * DM, scr, r % I_INA, F.lane); continue; } r -= 2 * I_INA;
        if (r < 2 * I_INB) { const int l = r / I_INB; convert_item(a.w_in_b + (size_t)l * DM * NB, DM, NB, NB, 2, a.attn_norm_g + (2 * l + 1) * DM, (bf16*)(ws + WS_W_INB) + (size_t)l * NB * DM, scr, r % I_INB, F.lane); continue; } r -= 2 * I_INB;
        if (r < 4 * I_OUT) { const int l = r / I_OUT; convert_item(a.w_out + (size_t)l * DM * DM, DM, DM, DM, 0, nullptr, (bf16*)(ws + WS_W_OUT) + (size_t)l * DM * DM, scr, r % I_OUT, F.lane); continue; } r -= 4 * I_OUT;
        if (r < 4 * I_UP) { const int l = r / I_UP; convert_item(a.w_up + (size_t)l * DM * NUP, DM, NUP, NUP, 3, a.ffn_norm_g + l * DM, (bf16*)(ws + WS_W_UP) + (size_t)l * NUP * DM, scr, r % I_UP, F.lane); continue; } r -= 4 * I_UP;
        { const int l = r / I_DN; convert_item(a.w_down + (size_t)l * FF * DM, FF, DM, DM, 0, nullptr, (bf16*)(ws + WS_W_DN) + (size_t)l * DM * FF, scr, r % I_DN, F.lane); }
    }
    bf16* hb = (bf16*)(ws + WS_HB); float* ss = (float*)(ws + WS_SS);
    for (int m = gw; m < MTOK; m += NGW) {
        const f32x4* xr = (const f32x4*)(a.x + (size_t)m * DM) + F.lane; f32x4 v[4]; float s = 0.f;
#pragma unroll
        for (int j = 0; j < 4; ++j) { v[j] = xr[64 * j]; s += (v[j].x * v[j].x + v[j].y * v[j].y) + (v[j].z * v[j].z + v[j].w * v[j].w); }
        s = wave_sum(s);
        v2u* o8 = (v2u*)(hb + (size_t)m * DM) + F.lane;
#pragma unroll
        for (int j = 0; j < 4; ++j) { v2u w; w.x = pk2(v[j].x, v[j].y); w.y = pk2(v[j].z, v[j].w); o8[64 * j] = w; }
        if (F.lane < 16) ss[(size_t)m * 16 + F.lane] = (F.lane == 0) ? s : 0.f;
    }
}

__device__ __forceinline__ f32x4 rstd_load(const float* ss, int row, int fq) { return *(const f32x4*)(ss + (size_t)row * 16 + 4 * fq); }
__device__ __forceinline__ float rstd_finish(f32x4 a) {
    float s = (a.x + a.y) + (a.z + a.w);
    s += __shfl_xor(s, 16); s += __shfl_xor(s, 32);
    return __builtin_amdgcn_rsqf(s * (1.0f / DM) + EPS);
}
__device__ __forceinline__ float row_rstd(const float* ss, int row, int fq) { return rstd_finish(rstd_load(ss, row, fq)); }
__device__ __forceinline__ unsigned att_pk4(f32x4 v) { int r = __builtin_amdgcn_cvt_pk_fp8_f32(v.x, v.y, 0, false); r = __builtin_amdgcn_cvt_pk_fp8_f32(v.z, v.w, r, true); return (unsigned)r; }
struct EpiIn {
    static constexpr bool PERM = false, PERMA = false, AFTER_DRAIN = false;
    const float* ss; unsigned char* proj; const float* qg; const float* kg; int isB;
    __device__ __forceinline__ void operator()(const pg8::f32x4 (&acc)[2][2][4][2], const pg8::Unit& u, int wr, int wc, int fr, int fq) const {
        asm volatile("" : "+v"(fr), "+v"(fq));
        const int pn = u.pn; int kind, pitch; bf16* dst;
        if (isB) { const int t = pn >> 2; kind = (t == 0) ? 1 : (t == 1 ? 2 : 0); dst = (bf16*)(proj + (size_t)t * PB_STRIDE) + 256 * (pn & 3); pitch = DM; }
        else if (pn < 4) { kind = 1; dst = (bf16*)(proj + PA_QA) + 256 * pn; pitch = DM; }
        else if (pn == 4) { kind = 2; dst = (bf16*)(proj + PA_KA); pitch = 256; }
        else if (pn == 5) { kind = 0; dst = (bf16*)(proj + PA_VA); pitch = 256; }
        else if (pn < 8) { kind = 0; dst = (bf16*)(proj + PA_QI) + 256 * (pn - 6); pitch = 512; }
        else { kind = 3; dst = (bf16*)(proj + PA_KI); pitch = 64; }
        if (kind == 3 && wc >= 2) return;
        const bool donorm = (kind == 1) || (kind == 2) || (kind == 3 && wc == 0);
        f32x4 g[2][2];
#pragma unroll
        for (int bj = 0; bj < 2; ++bj)
#pragma unroll
            for (int n = 0; n < 2; ++n) {
                if (kind == 1) g[bj][n] = *(const f32x4*)(qg + 16 * fq + 8 * bj + 4 * n) * (isB ? C2 : 1.0f);
                else if (kind == 2) g[bj][n] = *(const f32x4*)(kg + 16 * fq + 8 * bj + 4 * n);
                else g[bj][n] = (f32x4){1.f, 1.f, 1.f, 1.f};
            }
        float* wi = (float*)(proj + PA_WI);
        f32x4 rsl[2][4];
#pragma unroll
        for (int ai = 0; ai < 2; ++ai)
#pragma unroll
            for (int m = 0; m < 4; ++m) rsl[ai][m] = rstd_load(ss, u.pm * 256 + ai * 128 + wr * 64 + m * 16 + fr, fq);
#pragma unroll
        for (int ai = 0; ai < 2; ++ai)
#pragma unroll
            for (int m = 0; m < 4; ++m) {
                const int row = u.pm * 256 + ai * 128 + wr * 64 + m * 16 + fr;
                const float rs = rstd_finish(rsl[ai][m]);
                f32x4 v[2][2]; float s = 0.f;
#pragma unroll
                for (int bj = 0; bj < 2; ++bj)
#pragma unroll
                    for (int n = 0; n < 2; ++n) { v[bj][n] = acc[ai][bj][m][n] * rs; const f32x4 q = v[bj][n] * v[bj][n]; s += (q.x + q.y) + (q.z + q.w); }
                if (donorm) {
                    s += __shfl_xor(s, 16); s += __shfl_xor(s, 32);
                    const float r = 1.0f / sqrtf(s * (1.0f / 64.0f) + EPS);
#pragma unroll
                    for (int bj = 0; bj < 2; ++bj)
#pragma unroll
                        for (int n = 0; n < 2; ++n) v[bj][n] = v[bj][n] * r * g[bj][n];
                }
                if (kind == 3 && wc == 1) {
                    if (fq == 0) { float* wp = wi + (size_t)row * 8; const float sc = 0.04419417382415922f;
                        *(f32x4*)(wp) = v[0][0] * sc; *(f32x4*)(wp + 4) = v[0][1] * sc; }
                } else if (!isB && pn < 6) {
                    unsigned char* p8 = (pn < 4) ? proj + PA_QA + (size_t)row * 1024 + 256 * pn + 64 * wc + 16 * fq : proj + PA_KA + (size_t)row * 512 + 128 * wc + 64 * (pn - 4) + 16 * fq;
                    v4u w; w.x = att_pk4(v[0][0]); w.y = att_pk4(v[0][1]); w.z = att_pk4(v[1][0]); w.w = att_pk4(v[1][1]);
                    *(v4u*)p8 = w;
                } else {
                    bf16* rp = dst + (size_t)row * pitch + 64 * wc + 16 * fq;
#pragma unroll
                    for (int bj = 0; bj < 2; ++bj) { v4u w; w.x = cvtpk(v[bj][0].x, v[bj][0].y); w.y = cvtpk(v[bj][0].z, v[bj][0].w); w.z = cvtpk(v[bj][1].x, v[bj][1].y); w.w = cvtpk(v[bj][1].z, v[bj][1].w);
                        *(v4u*)(rp + 8 * bj) = w; }
                }
            }
    }
};
struct EpiRes {
    static constexpr bool PERM = false, PERMA = false, AFTER_DRAIN = false;
    const float* xin; float* fout; const bf16* hbi; bf16* hb; float* ss;
    __device__ __forceinline__ void operator()(const pg8::f32x4 (&acc)[2][2][4][2], const pg8::Unit& u, int wr, int wc, int fr, int fq) const {
        asm volatile("" : "+v"(fr), "+v"(fq));
        const int col0 = u.pn * 256 + wc * 32 + 4 * fq;
#pragma unroll
        for (int ai = 0; ai < 2; ++ai)
#pragma unroll
            for (int m = 0; m < 4; ++m) {
                const int row = u.pm * 256 + ai * 128 + wr * 64 + m * 16 + fr; const size_t off = (size_t)row * DM + col0; float s = 0.f;
#pragma unroll
                for (int bj = 0; bj < 2; ++bj)
#pragma unroll
                    for (int n = 0; n < 2; ++n) { const size_t o4 = off + bj * 128 + n * 16; f32x4 base;
                        if (xin) base = *(const f32x4*)(xin + o4); else { const v2u b = *(const v2u*)(hbi + o4); base = (f32x4){bf_lo(b.x), bf_hi(b.x), bf_lo(b.y), bf_hi(b.y)}; }
                        const f32x4 o = base + acc[ai][bj][m][n];
                        if (fout) *(f32x4*)(fout + o4) = o;
                        else { const f32x4 q = o * o; s += (q.x + q.y) + (q.z + q.w); v2u w; w.x = cvtpk(o.x, o.y); w.y = cvtpk(o.z, o.w); *(v2u*)(hb + o4) = w; } }
                if (!fout) { s += __shfl_xor(s, 16); s += __shfl_xor(s, 32); if (fq == 0) ss[(size_t)row * 16 + u.pn * 4 + wc] = s; }
            }
    }
};
#ifdef X_NOBPERM
__device__ __forceinline__ float lane_from(int byteaddr, float v) { return v + (float)byteaddr; }
#else
__device__ __forceinline__ float lane_from(int byteaddr, float v) { return __builtin_bit_cast(float, __builtin_amdgcn_ds_bpermute(byteaddr, __builtin_bit_cast(int, v))); }
#endif
#ifdef X_NOSILU
__device__ __forceinline__ float silu_mul(float a, float g) { return a * g; }
#else
__device__ __forceinline__ float silu_mul(float a, float g) { return a * g * __builtin_amdgcn_rcpf(1.0f + __builtin_amdgcn_exp2f(-g * LOG2E)); }
#endif
__device__ __forceinline__ float dpp_prev_lane(float v) { return __builtin_bit_cast(float, __builtin_amdgcn_update_dpp(0, __builtin_bit_cast(int, v), 0x111  , 0xf, 0xf, true)); }
struct EpiUp {
    static constexpr bool PERM = false, PERMA = true, AFTER_DRAIN = false;
    const float* ss; const float* cw; const float* cb; bf16* act; float* halo; LAS float* cl;
    __device__ __forceinline__ void operator()(const pg8::f32x4 (&acc)[2][2][4][2], const pg8::Unit& u, int wr, int wc, int fr, int fq) const {
        asm volatile("" : "+v"(fr), "+v"(fq));
        const int colb = u.pn * 128 + wc * 32 + 8 * fq;
        const int tid_ = ((wr * 4 + wc) * 4 + fq) * 16 + fr, ce = 2 * tid_, cbj = ce >> 9, carr = (ce >> 7) & 3, cc = ce & 127;
        const f32x2_t cpre = *(const f32x2_t*)((carr < 3 ? cw + carr * NUP : cb) + cbj * FF + u.pn * 128 + cc);
        f32x4 rsl[2][4];
#pragma unroll
        for (int ai = 0; ai < 2; ++ai)
#pragma unroll
            for (int m = 0; m < 4; ++m) rsl[ai][m] = rstd_load(ss, (u.pm * 4 + ai * 2 + wr) * 64 + 4 * fr + m, fq);
        unsigned pk[2][2][4][2][2];
#pragma unroll
        for (int ai = 0; ai < 2; ++ai) {
#pragma unroll
            for (int m = 0; m < 4; ++m) {
                const float rs = rstd_finish(rsl[ai][m]);
#pragma unroll
                for (int bj = 0; bj < 2; ++bj)
#pragma unroll
                    for (int n = 0; n < 2; ++n) { const f32x4 v = acc[ai][bj][m][n] * rs; pk[ai][bj][m][n][0] = cvtpk(v.x, v.y); pk[ai][bj][m][n][1] = cvtpk(v.z, v.w); }
            }
        }
        *(LAS f32x2_t*)(cl + ce) = cpre;
        asm volatile("s_waitcnt lgkmcnt(0)" ::: "memory"); __builtin_amdgcn_s_barrier(); asm volatile("" ::: "memory");
        __builtin_amdgcn_sched_barrier(0);
        if (fr == 0 || fr == 15) {
#pragma unroll
            for (int ai = 0; ai < 2; ++ai)
#pragma unroll
                for (int j = 0; j < 2; ++j)
#pragma unroll
                    for (int bj = 0; bj < 2; ++bj)
#pragma unroll
                        for (int n = 0; n < 2; ++n) { const unsigned w0 = (fr == 0) ? pk[ai][bj][j][n][0] : pk[ai][bj][2 + j][n][0], w1 = (fr == 0) ? pk[ai][bj][j][n][1] : pk[ai][bj][2 + j][n][1];
                            *(f32x4*)(halo + ((size_t)(u.pm * 4 + ai * 2 + wr) * 4 + (fr == 0 ? j : 2 + j)) * NUP + bj * FF + colb + 4 * n) = (f32x4){bf_lo(w0), bf_hi(w0), bf_lo(w1), bf_hi(w1)}; }
        }
        __builtin_amdgcn_sched_barrier(0);
#pragma unroll
        for (int ai = 0; ai < 2; ++ai) {
            const int row0 = (u.pm * 4 + ai * 2 + wr) * 64 + 4 * fr;
            unsigned outp[4][2][2];
#pragma unroll
            for (int n = 0; n < 2; ++n) {
#pragma unroll
                for (int ip = 0; ip < 2; ++ip) {
                    f32x2_t k0[2], k1[2], k2[2], kb[2];
#pragma unroll
                    for (int bj = 0; bj < 2; ++bj) { const LAS float* c = cl + bj * 512 + wc * 32 + 8 * fq + 4 * n + 2 * ip; k0[bj] = *(const LAS f32x2_t*)(c); k1[bj] = *(const LAS f32x2_t*)(c + 128); k2[bj] = *(const LAS f32x2_t*)(c + 256); kb[bj] = *(const LAS f32x2_t*)(c + 384); }
                    float y[2][4][2];
#pragma unroll
                    for (int bj = 0; bj < 2; ++bj) {
                        const unsigned w0 = pk[ai][bj][0][n][ip], w1 = pk[ai][bj][1][n][ip], w2 = pk[ai][bj][2][n][ip], w3 = pk[ai][bj][3][n][ip];
                        const unsigned q1 = (unsigned)__builtin_amdgcn_update_dpp(0, (int)w3, 0x111, 0xf, 0xf, true), q2 = (unsigned)__builtin_amdgcn_update_dpp(0, (int)w2, 0x111, 0xf, 0xf, true);
#pragma unroll
                        for (int e = 0; e < 2; ++e) { const int i = e;
                            const float u0 = e ? bf_hi(w0) : bf_lo(w0), u1 = e ? bf_hi(w1) : bf_lo(w1), u2 = e ? bf_hi(w2) : bf_lo(w2), u3 = e ? bf_hi(w3) : bf_lo(w3), p1 = e ? bf_hi(q1) : bf_lo(q1), p2 = e ? bf_hi(q2) : bf_lo(q2);
                            y[bj][0][e] = kb[bj][i] + k0[bj][i] * p2 + k1[bj][i] * p1 + k2[bj][i] * u0;
                            y[bj][1][e] = kb[bj][i] + k0[bj][i] * p1 + k1[bj][i] * u0 + k2[bj][i] * u1;
                            y[bj][2][e] = kb[bj][i] + k0[bj][i] * u0 + k1[bj][i] * u1 + k2[bj][i] * u2;
                            y[bj][3][e] = kb[bj][i] + k0[bj][i] * u1 + k1[bj][i] * u2 + k2[bj][i] * u3; }
                    }
#pragma unroll
                    for (int m = 0; m < 4; ++m) outp[m][n][ip] = cvtpk(silu_mul(y[0][m][0], y[1][m][0]), silu_mul(y[0][m][1], y[1][m][1]));
                }
            }
#pragma unroll
            for (int m = 0; m < 4; ++m) {
                if (m < 2 && fr == 0) continue;
                v4u w; w.x = outp[m][0][0]; w.y = outp[m][0][1]; w.z = outp[m][1][0]; w.w = outp[m][1][1];
                *(v4u*)(act + (size_t)(row0 + m) * FF + colb) = w;
            }
            asm volatile("" ::: "memory");
        }
    }
};
struct EpiDummy {
    static constexpr bool PERM = false, PERMA = true, AFTER_DRAIN = false;
    float* scratch;
    __device__ __forceinline__ void operator()(const pg8::f32x4 (&acc)[2][2][4][2], const pg8::Unit& u, int wr, int wc, int fr, int fq) const {
        f32x4 s = (f32x4){0.f, 0.f, 0.f, 0.f};
#pragma unroll
        for (int ai = 0; ai < 2; ++ai)
#pragma unroll
            for (int bj = 0; bj < 2; ++bj)
#pragma unroll
                for (int m = 0; m < 4; ++m)
#pragma unroll
                    for (int n = 0; n < 2; ++n) s += acc[ai][bj][m][n];
        scratch[(size_t)(u.pm * 22 + u.pn) * 512 + ((wr * 4 + wc) * 4 + fq) * 16 + fr] = (s.x + s.y) + (s.z + s.w);
    }
};
__device__ __forceinline__ void fixup_phase(Frame& F, const float* cw, const float* cb, const float* halo, bf16* act) {
    const int gt = F.vcu * (NWAVES * 64) + F.tid, NT = F.G * NWAVES * 64;
    constexpr int C4 = FF / 4;
    for (int it = gt; it < NBLK64 * 2 * C4; it += NT) {
        const int c = (it % C4) * 4, rj = it / C4, j = rj & 1, blk = rj >> 1, t = blk * 64 + j, tb = t % SEQ;
        f32x4 y[2];
#pragma unroll
        for (int bj = 0; bj < 2; ++bj) {
            const int cc = bj * FF + c;
            const f32x4 z = (f32x4){0.f, 0.f, 0.f, 0.f};
            const f32x4 ut = *(const f32x4*)(halo + ((size_t)blk * 4 + j) * NUP + cc);
            f32x4 u1, u2;
            if (j == 1) { u1 = *(const f32x4*)(halo + ((size_t)blk * 4 + 0) * NUP + cc); u2 = (tb == 1) ? z : *(const f32x4*)(halo + ((size_t)(blk - 1) * 4 + 3) * NUP + cc); }
            else { u1 = (tb == 0) ? z : *(const f32x4*)(halo + ((size_t)(blk - 1) * 4 + 3) * NUP + cc); u2 = (tb == 0) ? z : *(const f32x4*)(halo + ((size_t)(blk - 1) * 4 + 2) * NUP + cc); }
            y[bj] = *(const f32x4*)(cb + cc) + *(const f32x4*)(cw + cc) * u2 + *(const f32x4*)(cw + NUP + cc) * u1 + *(const f32x4*)(cw + 2 * NUP + cc) * ut;
        }
        v2u w; w.x = cvtpk(silu_mul(y[0].x, y[1].x), silu_mul(y[0].y, y[1].y)); w.y = cvtpk(silu_mul(y[0].z, y[1].z), silu_mul(y[0].w, y[1].w));
        *(v2u*)(act + (size_t)t * FF + c) = w;
    }
}

__device__ __forceinline__ int crow(int r, int hi) { return (r & 3) + 8 * (r >> 2) + 4 * hi; }
__device__ __forceinline__ void glds16(const void* gsrc, unsigned lds_dst) { unsigned keep;
    asm volatile("s_mov_b32 %0, m0\n\ts_mov_b32 m0, %2\n\ts_nop 0\n\tglobal_load_lds_dwordx4 %1, off\n\ts_mov_b32 m0, %0" : "=&s"(keep) : "v"(gsrc), "s"(lds_dst) : "memory"); }
__device__ __forceinline__ float max3f(float a, float b, float c) { return fmaxf(fmaxf(a, b), c); }

namespace band {
constexpr int SLOTB = 8192;
constexpr int LDS_K = 0, LDS_V = 2 * SLOTB, LDS_WS = 4 * SLOTB, LDS_TB = LDS_WS + NWAVES * 64 * 4, LDS_OST = LDS_TB + 640 * 4 + 512, LDS_END = LDS_OST + NWAVES * 4096;
static_assert(LDS_END <= RING_BYTES, "band LDS");
__device__ __forceinline__ void unit(Frame& F, int b, int h, int U, const bf16* Q, const bf16* K, const bf16* V, bf16* O, const float* rel) {
    const int tid = F.tid, lane = F.lane, r32 = lane & 31, hi = lane >> 5, wid = F.wave;
    LAS unsigned char* shm = F.lds + RING_OFF;
    const unsigned lds0 = (unsigned)(uintptr_t)shm;
    const long rowbase = (long)b * SEQ; const int q0 = U * 256, c0 = 4 * U, cq = c0 + (wid >> 1);
    const bf16* Qw = Q + (rowbase + q0 + wid * 32) * DM + h * 64;
    const bf16* Kh = K + rowbase * DM + h * 64; const bf16* Vh = V + rowbase * DM + h * 64;
    LAS float* wsf = (LAS float*)(shm + LDS_WS) + wid * 64;
    LAS float* tb = (LAS float*)(shm + LDS_TB);
    const bf16* ksrc = Kh + (long)lane * DM + wid * 8;
    const bf16* vsrc = Vh + (long)(16 * (wid & 3) + (lane >> 2)) * DM + (wid >> 2) * 32 + (lane & 3) * 8;
    const unsigned kdst = lds0 + LDS_K + wid * 1024, vdst = lds0 + LDS_V + wid * 1024;
    const int lo = (c0 - 8 > 0) ? c0 - 8 : 0, hiT = c0 + 3, NT = hiT - lo + 1, t0 = (c0 - 5 > 0) ? c0 - 5 : 0;
#define BAND_KT(i) ((t0 + (i) <= hiT) ? t0 + (i) : lo + (t0 + (i) - hiT - 1))
    for (int i = tid; i < 640; i += NWAVES * 64) { int d = i - 64; d = d < -256 ? -256 : (d > 256 ? 256 : d); tb[i] = rel[(d + 256) * 16 + h] * LOG2E; }
    { const int kt = BAND_KT(0); glds16(ksrc + (long)kt * 64 * DM, (unsigned)__builtin_amdgcn_readfirstlane(kdst)); glds16(vsrc + (long)kt * 64 * DM, (unsigned)__builtin_amdgcn_readfirstlane(vdst)); }
    bf16x8 qr[4];
#pragma unroll
    for (int d0 = 0; d0 < 4; ++d0) qr[d0] = *(const bf16x8*)(Qw + (long)r32 * DM + d0 * 16 + hi * 8);
    float m_run = -INFINITY, l_run = 0.f; f32x16 o[2]; o[0] = f32x16{}; o[1] = f32x16{};
    const int qpos = q0 + wid * 32 + r32;
    const LAS unsigned char* vbase = shm + LDS_V + ((lane >> 4) & 1) * 32 + (lane & 3) * 8 + (4 * hi + ((lane & 15) >> 2)) * 64;
    for (int i = 0; i < NT; ++i) {
        asm volatile("s_waitcnt vmcnt(0) lgkmcnt(0)\n\ts_barrier" ::: "memory");
        if (i + 1 < NT) { const int kt = BAND_KT(i + 1); const unsigned so = ((i + 1) & 1) * SLOTB;
            glds16(ksrc + (long)kt * 64 * DM, (unsigned)__builtin_amdgcn_readfirstlane(kdst + so)); glds16(vsrc + (long)kt * 64 * DM, (unsigned)__builtin_amdgcn_readfirstlane(vdst + so)); }
        const int kt = BAND_KT(i);
        if (kt < cq - 8 || kt > cq) continue;
        const int so = (i & 1) * SLOTB;
        f32x16 p0 = f32x16{}, p1 = f32x16{};
        { const LAS unsigned char* kb = shm + LDS_K + so + hi * 1024 + r32 * 16;
#pragma unroll
          for (int d0 = 0; d0 < 4; ++d0) { const bf16x8 b0 = *(const LAS bf16x8*)(kb + d0 * 2048), b1 = *(const LAS bf16x8*)(kb + d0 * 2048 + 512);
              p0 = __builtin_amdgcn_mfma_f32_32x32x16_bf16(b0, qr[d0], p0, 0, 0, 0); p1 = __builtin_amdgcn_mfma_f32_32x32x16_bf16(b1, qr[d0], p1, 0, 0, 0); } }
        if (kt + 5 <= cq) { const float cbias = tb[639];
#pragma unroll
          for (int r = 0; r < 16; ++r) { p0[r] += cbias; p1[r] += cbias; } }
        else { const int ib = qpos - 64 * kt + 64 - 4 * hi;
#pragma unroll
          for (int r = 0; r < 16; ++r) { const int ix = ib - ((r & 3) + 8 * (r >> 2)); p0[r] += tb[ix]; p1[r] += tb[ix - 32]; } }
        float rm = p0[0];
#pragma unroll
        for (int r = 0; r < 16; ++r) rm = max3f(rm, p0[r], p1[r]);
        { auto rr = __builtin_amdgcn_permlane32_swap(__float_as_uint(rm), __float_as_uint(rm), false, false); rm = fmaxf(__uint_as_float(rr[0]), __uint_as_float(rr[1])); }
        const float mnew = fmaxf(m_run, rm), f = __builtin_amdgcn_exp2f(m_run - mnew); m_run = mnew;
        float sacc = 0.f;
#pragma unroll
        for (int r = 0; r < 16; ++r) { p0[r] = __builtin_amdgcn_exp2f(p0[r] - mnew); p1[r] = __builtin_amdgcn_exp2f(p1[r] - mnew); sacc += p0[r] + p1[r]; }
        l_run = l_run * f + sacc;
        if (!__all(f == 1.0f)) {
            if (hi == 0) wsf[r32] = f;
            LDS_WAIT();
#pragma unroll
            for (int r = 0; r < 16; ++r) { const float fr_ = wsf[crow(r, hi)]; o[0][r] *= fr_; o[1][r] *= fr_; }
        }
        v4u pw[4];
        pw[0] = (v4u){cvtpk(p0[0], p0[1]), cvtpk(p0[2], p0[3]), cvtpk(p0[4], p0[5]), cvtpk(p0[6], p0[7])};
        pw[1] = (v4u){cvtpk(p0[8], p0[9]), cvtpk(p0[10], p0[11]), cvtpk(p0[12], p0[13]), cvtpk(p0[14], p0[15])};
        pw[2] = (v4u){cvtpk(p1[0], p1[1]), cvtpk(p1[2], p1[3]), cvtpk(p1[4], p1[5]), cvtpk(p1[6], p1[7])};
        pw[3] = (v4u){cvtpk(p1[8], p1[9]), cvtpk(p1[10], p1[11]), cvtpk(p1[12], p1[13]), cvtpk(p1[14], p1[15])};
        const LAS unsigned char* vb = vbase + so;
#pragma unroll
        for (int d0 = 0; d0 < 2; ++d0)
#pragma unroll
            for (int ks = 0; ks < 4; ++ks) {
                const s16x4 vlo = __builtin_bit_cast(s16x4, __builtin_amdgcn_ds_read_tr16_b64_v4i16((LAS s16x4*)(vb + d0 * 4096 + ks * 1024)));
                const s16x4 vhi = __builtin_bit_cast(s16x4, __builtin_amdgcn_ds_read_tr16_b64_v4i16((LAS s16x4*)(vb + d0 * 4096 + ks * 1024 + 512)));
                const bf16x8 vf = (bf16x8){vlo[0], vlo[1], vlo[2], vlo[3], vhi[0], vhi[1], vhi[2], vhi[3]};
                o[d0] = __builtin_amdgcn_mfma_f32_32x32x16_bf16(__builtin_bit_cast(bf16x8, pw[ks]), vf, o[d0], 0, 0, 0);
            }
    }
#undef BAND_KT
    { auto rr = __builtin_amdgcn_permlane32_swap(__float_as_uint(l_run), __float_as_uint(l_run), false, false); l_run = __uint_as_float(rr[0]) + __uint_as_float(rr[1]); }
    if (hi == 0) wsf[32 + r32] = l_run;
    LDS_WAIT();
    float rli[16];
#pragma unroll
    for (int r = 0; r < 16; ++r) rli[r] = __builtin_amdgcn_rcpf(wsf[32 + crow(r, hi)]);
    bf16* Ow = O + (rowbase + q0 + wid * 32) * DM + h * 64;
    { LAS bf16* stg = (LAS bf16*)(shm + LDS_OST) + wid * 2048;
#pragma unroll
      for (int r = 0; r < 16; ++r) { const int orow = crow(r, hi);
#pragma unroll
          for (int d0 = 0; d0 < 2; ++d0) stg[orow * 64 + d0 * 32 + r32] = (bf16)f2bf(o[d0][r] * rli[r]); }
      LDS_WAIT();
#pragma unroll
      for (int i = 0; i < 4; ++i) { const int row = i * 8 + (lane >> 3), ch = lane & 7; const v4u v = *(const LAS v4u*)(stg + row * 64 + ch * 8); *(v4u*)(Ow + (long)row * DM + ch * 8) = v; } }
    asm volatile("s_waitcnt lgkmcnt(0)\n\ts_barrier" ::: "memory");
}
__device__ __forceinline__ void phase(Frame& F, const bf16* Q, const bf16* K, const bf16* V, bf16* O, const float* rel) {
    const int NU = BATCH * 16 * 32, per = (NU + F.G - 1) / F.G;
    for (int i = 0; i < per; ++i) { const int uid = F.vcu * per + i; if (uid >= NU) break; unit(F, uid >> 9, (uid >> 5) & 15, uid & 31, Q, K, V, O, rel); }
}
}

namespace dsa {
__device__ __forceinline__ unsigned okey(float s) { const unsigned u = __float_as_uint(s + 0.0f); return (u & 0x80000000u) ? ~u : (u | 0x80000000u); }
struct Ctx { const bf16* QA; const bf16* KA; const bf16* VA; const bf16* QI; const bf16* KI; const float* WI; bf16* M; const LAS float* t5l; unsigned short* SEL; };

__device__ __forceinline__ void scan_hist(const LAS unsigned* hq, int lane, unsigned need, unsigned& bin, unsigned& above) {
    const LAS v4u* hp = (const LAS v4u*)hq + lane * 4;
    unsigned wds[16];
#pragma unroll
    for (int j = 0; j < 4; ++j) { const v4u t = hp[j]; wds[4 * j] = t.x; wds[4 * j + 1] = t.y; wds[4 * j + 2] = t.z; wds[4 * j + 3] = t.w; }
    unsigned tl = 0;
#pragma unroll
    for (int j = 0; j < 16; ++j) tl += (wds[j] & 0xffffu) + (wds[j] >> 16);
    unsigned suf = tl;
#pragma unroll
    for (int o = 1; o < 64; o <<= 1) { const unsigned v = __shfl_down(suf, o); if (lane + o < 64) suf += v; }
    const unsigned S = suf - tl;
    const bool cross = (S < need) && (need <= S + tl);
    unsigned c = S, bsel = 0, ab = 0; bool found = false;
#pragma unroll
    for (int k = 31; k >= 0; --k) { const unsigned cnt = (wds[k >> 1] >> (16 * (k & 1))) & 0xffffu; if (!found && c + cnt >= need) { bsel = 32 * lane + k; ab = c; found = true; } c += cnt; }
    const unsigned long long bal = __ballot(cross);
    const int src = bal ? __builtin_ctzll(bal) : 0;
    bin = __shfl(bsel, src); above = __shfl(ab, src);
}

__device__ __forceinline__ void attend(const Ctx& C, const LAS unsigned short* sq, int nvalid, long rowbase, long token, int tpos, int lane, int g0) {
    asm volatile("" : "+v"(lane));
    const int l15 = lane & 15, l4 = lane >> 4;
    int sidx[16];
#pragma unroll
    for (int ti = 0; ti < 16; ++ti) sidx[ti] = sq[ti * 16 + l15];
    unsigned bpk[4] = {0u, 0u, 0u, 0u};
#pragma unroll
    for (int ti = 0; ti < 16; ++ti) { const int rel = sidx[ti] - tpos, n = rel < 0 ? -rel : rel;
        const int bk = (rel > 0 ? 16 : 0) + (n < 8 ? n : 8 + (n >= 12) + (n >= 16) + (n >= 23) + (n >= 32) + (n >= 46) + (n >= 64) + (n >= 91));
        bpk[ti >> 2] |= (unsigned)bk << (8 * (ti & 3)); }
#pragma unroll 1
    for (int g = g0; g < g0 + 2; ++g) {
        const bf16* qp = C.QA + token * DM + (4 * g + (lane & 3)) * 64 + 8 * l4;
        const bf16x8 qf0 = *(const bf16x8*)qp, qf1 = *(const bf16x8*)(qp + 32);
        const bf16* kbase = C.KA + rowbase * 256 + g * 64 + 8 * l4;
        f32x4 S[16];
#pragma unroll
        for (int hh = 0; hh < 4; ++hh) {
            bf16x8 kf0[4], kf1[4];
#pragma unroll
            for (int j = 0; j < 4; ++j) { const bf16* kp = kbase + (long)sidx[hh * 4 + j] * 256; kf0[j] = *(const bf16x8*)kp; kf1[j] = *(const bf16x8*)(kp + 32); }
#pragma unroll
            for (int j = 0; j < 4; ++j) { const int ti = hh * 4 + j;
                f32x4 a = *(const LAS f32x4*)(C.t5l + ((bpk[hh] >> (8 * j)) & 255u) * 16 + 4 * g);
                asm volatile("v_mfma_f32_16x16x32_bf16 %0, %1, %2, %0" : "+v"(a) : "v"(qf0), "v"(kf0[j]));
                asm volatile("v_mfma_f32_16x16x32_bf16 %0, %1, %2, %0" : "+v"(a) : "v"(qf1), "v"(kf1[j]));
                S[ti] = a; }
            asm volatile("s_nop 15\n\ts_nop 7" : "+v"(S[hh * 4]), "+v"(S[hh * 4 + 1]), "+v"(S[hh * 4 + 2]), "+v"(S[hh * 4 + 3]));
        }
#pragma unroll
        for (int ti = 0; ti < 16; ++ti) if (ti * 16 >= nvalid) S[ti] = (f32x4){-INFINITY, -INFINITY, -INFINITY, -INFINITY};
        f32x4 mx = S[0];
#pragma unroll
        for (int ti = 1; ti < 16; ++ti) { mx.x = fmaxf(mx.x, S[ti].x); mx.y = fmaxf(mx.y, S[ti].y); mx.z = fmaxf(mx.z, S[ti].z); mx.w = fmaxf(mx.w, S[ti].w); }
#pragma unroll
        for (int o = 1; o < 16; o <<= 1) { mx.x = fmaxf(mx.x, __shfl_xor(mx.x, o)); mx.y = fmaxf(mx.y, __shfl_xor(mx.y, o)); mx.z = fmaxf(mx.z, __shfl_xor(mx.z, o)); mx.w = fmaxf(mx.w, __shfl_xor(mx.w, o)); }
        f32x4 ls = (f32x4){0.f, 0.f, 0.f, 0.f};
        unsigned P01[16], P23[16];
#pragma unroll
        for (int ti = 0; ti < 16; ++ti) { const float e0 = __builtin_amdgcn_exp2f(S[ti].x - mx.x), e1 = __builtin_amdgcn_exp2f(S[ti].y - mx.y), e2 = __builtin_amdgcn_exp2f(S[ti].z - mx.z), e3 = __builtin_amdgcn_exp2f(S[ti].w - mx.w);
            ls += (f32x4){e0, e1, e2, e3}; P01[ti] = cvtpk(e0, e1); P23[ti] = cvtpk(e2, e3); }
#pragma unroll
        for (int o = 1; o < 16; o <<= 1) { ls.x += __shfl_xor(ls.x, o); ls.y += __shfl_xor(ls.y, o); ls.z += __shfl_xor(ls.z, o); ls.w += __shfl_xor(ls.w, o); }
        float o_[4][16];
#pragma unroll
        for (int h = 0; h < 4; ++h)
#pragma unroll
            for (int d = 0; d < 16; ++d) o_[h][d] = 0.f;
        const bf16* vbase = C.VA + rowbase * 256 + g * 64 + 16 * l4;
#pragma unroll
        for (int hh = 0; hh < 4; ++hh) {
            v4u va[4], vb[4];
#pragma unroll
            for (int j = 0; j < 4; ++j) { const v4u* vp = (const v4u*)(vbase + (long)sidx[hh * 4 + j] * 256); va[j] = vp[0]; vb[j] = vp[1]; }
#pragma unroll
            for (int j = 0; j < 4; ++j) { const int ti = hh * 4 + j; const v4u v0 = va[j], v1 = vb[j];
                float vf[16];
                vf[0] = bf_lo(v0.x); vf[1] = bf_hi(v0.x); vf[2] = bf_lo(v0.y); vf[3] = bf_hi(v0.y); vf[4] = bf_lo(v0.z); vf[5] = bf_hi(v0.z); vf[6] = bf_lo(v0.w); vf[7] = bf_hi(v0.w);
                vf[8] = bf_lo(v1.x); vf[9] = bf_hi(v1.x); vf[10] = bf_lo(v1.y); vf[11] = bf_hi(v1.y); vf[12] = bf_lo(v1.z); vf[13] = bf_hi(v1.z); vf[14] = bf_lo(v1.w); vf[15] = bf_hi(v1.w);
                const float p0 = bf_lo(P01[ti]), p1 = bf_hi(P01[ti]), p2 = bf_lo(P23[ti]), p3 = bf_hi(P23[ti]);
#pragma unroll
                for (int d = 0; d < 16; ++d) { o_[0][d] += p0 * vf[d]; o_[1][d] += p1 * vf[d]; o_[2][d] += p2 * vf[d]; o_[3][d] += p3 * vf[d]; } }
        }
        float res[4];
#pragma unroll
        for (int h = 0; h < 4; ++h) {
            float a8[8], a4[4], a2[2];
            const bool b3 = (l15 & 8) != 0, b2 = (l15 & 4) != 0, b1 = (l15 & 2) != 0, b0 = (l15 & 1) != 0;
#pragma unroll
            for (int d = 0; d < 8; ++d) { const float keep = b3 ? o_[h][d + 8] : o_[h][d], send = b3 ? o_[h][d] : o_[h][d + 8]; a8[d] = keep + __shfl_xor(send, 8); }
#pragma unroll
            for (int d = 0; d < 4; ++d) { const float keep = b2 ? a8[d + 4] : a8[d], send = b2 ? a8[d] : a8[d + 4]; a4[d] = keep + __shfl_xor(send, 4); }
#pragma unroll
            for (int d = 0; d < 2; ++d) { const float keep = b1 ? a4[d + 2] : a4[d], send = b1 ? a4[d] : a4[d + 2]; a2[d] = keep + __shfl_xor(send, 2); }
            { const float keep = b0 ? a2[1] : a2[0], send = b0 ? a2[0] : a2[1]; res[h] = keep + __shfl_xor(send, 1); }
        }
        bf16* mp = C.M + token * DM + (4 * g) * 64 + lane;
        mp[0] = (bf16)f2bf(res[0] * __builtin_amdgcn_rcpf(ls.x)); mp[64] = (bf16)f2bf(res[1] * __builtin_amdgcn_rcpf(ls.y)); mp[128] = (bf16)f2bf(res[2] * __builtin_amdgcn_rcpf(ls.z)); mp[192] = (bf16)f2bf(res[3] * __builtin_amdgcn_rcpf(ls.w));
    }
}

constexpr int CAND_CAP = 256;
constexpr int SELKS_OFF = KS_OFF;
__device__ __forceinline__ float relu_i(float x) { const int i = __builtin_bit_cast(int, x); return __builtin_bit_cast(float, i > 0 ? i : 0); }
struct SelState { unsigned pre[4], need[4], cnt[4], tcnt[4]; };
__device__ __forceinline__ void tile_mfma(f32x16 (&acc)[2], const LAS unsigned char* kf, const int (&koff)[4], const bf16x8 (&qa)[4]) {
#pragma unroll
    for (int h2 = 0; h2 < 2; ++h2) { acc[h2] = f32x16{};
#pragma unroll
        for (int ks = 0; ks < 4; ++ks) { const bf16x8 kb = *(const LAS bf16x8*)(kf + koff[ks] + h2 * 4096); acc[h2] = __builtin_amdgcn_mfma_f32_32x32x16_bf16(qa[ks], kb, acc[h2], 0, 0, 0); } }
}
template <class ActionT>
__device__ __forceinline__ void tile_valu(const f32x16 (&acc)[2], const f32x2_t (&wp)[2][4], int kbase, ActionT&& act) {
#pragma unroll
    for (int h2 = 0; h2 < 2; ++h2) {
        f32x2_t sa = {0.f, 0.f}, sb = {0.f, 0.f};
#pragma unroll
        for (int jp = 0; jp < 4; ++jp) {
            const f32x2_t ra = {relu_i(acc[h2][2 * jp]), relu_i(acc[h2][2 * jp + 1])};
            const f32x2_t rb = {relu_i(acc[h2][8 + 2 * jp]), relu_i(acc[h2][8 + 2 * jp + 1])};
            sa = __builtin_elementwise_fma(ra, wp[0][jp], sa); sb = __builtin_elementwise_fma(rb, wp[1][jp], sb); }
        act(kbase + h2 * 32, (sa.x + sa.y) + 0.0f, (sb.x + sb.y) + 0.0f);
    }
}
constexpr int KSLOTS = 3;
__device__ __forceinline__ void wait_tile(int newer) {
    if (newer >= 4) asm volatile("s_waitcnt vmcnt(4) lgkmcnt(0)\n\ts_barrier" ::: "memory");
    else if (newer == 3) asm volatile("s_waitcnt vmcnt(3) lgkmcnt(0)\n\ts_barrier" ::: "memory");
    else if (newer == 2) asm volatile("s_waitcnt vmcnt(2) lgkmcnt(0)\n\ts_barrier" ::: "memory");
    else if (newer == 1) asm volatile("s_waitcnt vmcnt(1) lgkmcnt(0)\n\ts_barrier" ::: "memory");
    else asm volatile("s_waitcnt vmcnt(0) lgkmcnt(0)\n\ts_barrier" ::: "memory");
}
template <class ActionT>
__device__ __forceinline__ void tile_pass(Frame& F, const bf16* ksrc, unsigned kdst, const LAS unsigned char* kfr, const int (&koff)[4], int NT, const bf16x8 (&qa)[4], const f32x2_t (&wp)[2][4], ActionT&& act) {
    asm volatile("s_waitcnt lgkmcnt(0)\n\ts_barrier" ::: "memory");
    const int npre = NT < KSLOTS ? NT : KSLOTS;
    for (int j = 0; j < npre; ++j) glds16(ksrc + (long)j * 4096, (unsigned)__builtin_amdgcn_readfirstlane(kdst + j * 8192));
    wait_tile(npre - 1);
    f32x16 accC[2];
    tile_mfma(accC, kfr, koff, qa);
    int sl = 0;
    for (int kt = 0; kt + 1 < NT; ++kt) {
        { const int inflight = (NT - kt - 2) < (KSLOTS - 2) ? (NT - kt - 2) : (KSLOTS - 2); wait_tile(inflight); }
        if (kt + KSLOTS < NT) glds16(ksrc + (long)(kt + KSLOTS) * 4096, (unsigned)__builtin_amdgcn_readfirstlane(kdst + sl * 8192));
        sl = (sl == KSLOTS - 1) ? 0 : sl + 1;
        f32x16 accN[2];
        tile_mfma(accN, kfr + sl * 8192, koff, qa);
        tile_valu(accC, wp, kt * 64, act);
        accC[0] = accN[0]; accC[1] = accN[1];
    }
    tile_valu(accC, wp, (NT - 1) * 64, act);
    LDS_WAIT();
}
__device__ __forceinline__ void scan_hist_cnt(const LAS unsigned* hq, int lane, unsigned need, unsigned& bin, unsigned& above, unsigned& bcnt) {
    const LAS v4u* hp = (const LAS v4u*)hq + lane * 2;
    unsigned wds[8];
#pragma unroll
    for (int j = 0; j < 2; ++j) { const v4u t = hp[j]; wds[4 * j] = t.x; wds[4 * j + 1] = t.y; wds[4 * j + 2] = t.z; wds[4 * j + 3] = t.w; }
    unsigned tl = 0;
#pragma unroll
    for (int j = 0; j < 8; ++j) tl += wds[j];
    unsigned suf = tl;
#pragma unroll
    for (int o = 1; o < 64; o <<= 1) { const unsigned v = __shfl_down(suf, o); if (lane + o < 64) suf += v; }
    const unsigned S = suf - tl;
    const bool cross = (S < need) && (need <= S + tl);
    unsigned c = S, bsel = 0, ab = 0, bc = 0; bool found = false;
#pragma unroll
    for (int k = 7; k >= 0; --k) { const unsigned cnt = wds[k]; if (!found && c + cnt >= need) { bsel = 8 * lane + k; ab = c; bc = cnt; found = true; } c += cnt; }
    const unsigned long long bal = __ballot(cross);
    const int src = bal ? __builtin_ctzll(bal) : 0;
    bin = __builtin_amdgcn_readfirstlane(__shfl(bsel, src)); above = __builtin_amdgcn_readfirstlane(__shfl(ab, src)); bcnt = __builtin_amdgcn_readfirstlane(__shfl(bc, src));
}
__device__ __forceinline__ void step(Frame& F, const Ctx& C, int b, int c, int half) {
    int lane_ = F.lane; asm volatile("" : "+v"(lane_));
    const int lane = lane_, r = lane & 31, hi = lane >> 5, wave = F.wave;
    LAS unsigned* hist = (LAS unsigned*)(F.lds + RING_OFF + wave * 16384);
    LAS unsigned short* sel = (LAS unsigned short*)hist;
    LAS unsigned* cand = hist + 2048;
    LAS unsigned* fbflag = (LAS unsigned*)(F.lds + AUX_OFF + 2048);
    const long rowbase = (long)b * SEQ;
    const int tq0 = 64 * c + 32 * half + 4 * wave;
    const int N = 64 * (c + 1), NT = c + 1;
    int nvalid = 256;
    if (N <= 256) {
        nvalid = N;
        for (int j = lane; j < 4 * 256; j += 64) sel[j] = (unsigned short)(((j & 255) < N) ? (j & 255) : 0);
    } else {
        const int aq = 2 * ((r >> 2) & 1) + (r >> 4), ah = 4 * ((r >> 3) & 1) + (r & 3);
        const bf16* qip = C.QI + (rowbase + tq0 + aq) * 512 + ah * 64 + 8 * hi;
        bf16x8 qa[4];
#pragma unroll
        for (int ks = 0; ks < 4; ++ks) qa[ks] = *(const bf16x8*)(qip + 16 * ks);
        f32x2_t wp[2][4];
#pragma unroll
        for (int t = 0; t < 2; ++t) { const float* wq = C.WI + (rowbase + tq0 + 2 * hi + t) * 8; const f32x4 w0 = *(const f32x4*)wq, w1 = *(const f32x4*)(wq + 4);
            wp[t][0] = (f32x2_t){w0.x, w0.y}; wp[t][1] = (f32x2_t){w0.z, w0.w}; wp[t][2] = (f32x2_t){w1.x, w1.y}; wp[t][3] = (f32x2_t){w1.z, w1.w}; }
        float Bq;
        { float ssq = 0.f;
#pragma unroll
          for (int ks = 0; ks < 4; ++ks)
#pragma unroll
              for (int e = 0; e < 8; ++e) { const float v = bf_lo((unsigned)(unsigned short)qa[ks][e]); ssq += v * v; }
          ssq += __shfl_xor(ssq, 32);
          float term = fabsf(C.WI[(rowbase + tq0 + aq) * 8 + ah]) * sqrtf(ssq);
          term += __shfl_xor(term, 1); term += __shfl_xor(term, 2); term += __shfl_xor(term, 8);
          Bq = term * 8.25f + 1e-20f; }
        const float B0 = __shfl(Bq, (hi << 2)), B1 = __shfl(Bq, (hi << 2) | 16);
        const float sc0 = 1024.0f / B0, sc1 = 1024.0f / B1;
        asm volatile("" :: "v"(qa[0]), "v"(qa[1]), "v"(qa[2]), "v"(qa[3]));
        asm volatile("" :: "v"(wp[0][0]), "v"(wp[0][1]), "v"(wp[0][2]), "v"(wp[0][3]), "v"(wp[1][0]), "v"(wp[1][1]), "v"(wp[1][2]), "v"(wp[1][3]), "v"(sc0), "v"(sc1));
        const bf16* ksrc = C.KI + rowbase * 64 + (long)(wave * 8 + (lane >> 3)) * 64 + ((lane & 7) ^ (lane >> 3)) * 8;
        const unsigned kdst = (unsigned)(uintptr_t)(F.lds + SELKS_OFF) + wave * 1024;
        const LAS unsigned char* kfr = F.lds + SELKS_OFF + r * 128;
        int koff[4];
#pragma unroll
        for (int ks = 0; ks < 4; ++ks) koff[ks] = ((2 * ks + hi) ^ (r & 7)) * 16;
        const unsigned below = (1u << r) - 1u;
        LAS v4u* hz = (LAS v4u*)hist;
        if (wave == 0 && lane == 0) *fbflag = 0u;
#pragma unroll
        for (int j = 0; j < 8; ++j) hz[j * 64 + lane] = (v4u){0u, 0u, 0u, 0u};
        tile_pass(F, ksrc, kdst, kfr, koff, NT, qa, wp, [&](int kbase, float s0, float s1) {
            const int b0 = (int)__builtin_amdgcn_fmed3f(__builtin_fmaf(s0, sc0, 256.0f), 0.0f, 511.0f), b1 = (int)__builtin_amdgcn_fmed3f(__builtin_fmaf(s1, sc1, 256.0f), 0.0f, 511.0f);
            __hip_atomic_fetch_add(hist + (2 * hi) * 512 + b0, 1u, __ATOMIC_RELAXED, __HIP_MEMORY_SCOPE_WORKGROUP);
            __hip_atomic_fetch_add(hist + (2 * hi + 1) * 512 + b1, 1u, __ATOMIC_RELAXED, __HIP_MEMORY_SCOPE_WORKGROUP);
        });
#ifdef PROBE_SKEL
        tile_pass(F, ksrc, kdst, kfr, koff, NT, qa, wp, [&](int kbase, float s0, float s1) { });
#endif
#ifdef PROBE_SCORE
        { float dsum = 0.f; tile_pass(F, ksrc, kdst, kfr, koff, NT, qa, wp, [&](int kbase, float s0, float s1) { dsum += s0 + s1; }); if (dsum == 12345.678f) hist[0] = 1u; }
#endif
        SelState st;
        unsigned tbin[4], bcn[4]; bool ovf = false;
#pragma unroll
        for (int ql = 0; ql < 4; ++ql) { unsigned above; scan_hist_cnt(hist + ql * 512, lane, 256u, tbin[ql], above, bcn[ql]); st.cnt[ql] = 0u; st.tcnt[ql] = 0u; st.need[ql] = 256u - above; st.pre[ql] = above;
#ifdef PROBE_OVF
            ovf |= bcn[ql] > (unsigned)PROBE_OVF; }
#else
            ovf |= bcn[ql] > (unsigned)CAND_CAP; }
#endif
        LDS_WAIT();
        if (ovf && lane == 0) *fbflag = 1u;
        asm volatile("s_waitcnt lgkmcnt(0)\n\ts_barrier" ::: "memory");
#ifdef PROBE_NOFB
        const bool fb = false;
#elif defined(PROBE_NOFB2)
        const bool fb = __builtin_amdgcn_readfirstlane((int)*fbflag) == 0x7fffffff;
#else
        const bool fb = __builtin_amdgcn_readfirstlane((int)*fbflag) != 0;
#endif
        if (!fb) {
            const int tb0 = (int)(hi ? tbin[2] : tbin[0]), tb1 = (int)(hi ? tbin[3] : tbin[1]);
            tile_pass(F, ksrc, kdst, kfr, koff, NT, qa, wp, [&](int kbase, float s0, float s1) {
#pragma unroll
                for (int t = 0; t < 2; ++t) {
                    const float s = t ? s1 : s0; const int bin = (int)__builtin_amdgcn_fmed3f(__builtin_fmaf(s, (t ? sc1 : sc0), 256.0f), 0.0f, 511.0f), tb = t ? tb1 : tb0;
                    const bool gt = bin > tb, eq = bin == tb;
                    const unsigned long long mg = __ballot(gt), me = __ballot(eq);
                    const unsigned mgh = hi ? (unsigned)(mg >> 32) : (unsigned)mg, meh = hi ? (unsigned)(me >> 32) : (unsigned)me;
                    const unsigned pos = (hi ? st.cnt[2 + t] : st.cnt[t]) + __builtin_popcount(mgh & below);
                    sel[(gt && pos < 256u) ? (2 * hi + t) * 256 + pos : 3200 + lane] = (unsigned short)(kbase + r);
                    const unsigned cpos = (hi ? st.tcnt[2 + t] : st.tcnt[t]) + __builtin_popcount(meh & below);
                    { LAS unsigned* cp = hist + ((eq && cpos < (unsigned)CAND_CAP) ? 2048 + ((2 * hi + t) * CAND_CAP + cpos) * 2 : 1700 + 2 * lane); cp[0] = okey(s); cp[1] = (unsigned)(kbase + r); }
                    st.cnt[t] += __builtin_popcount((unsigned)mg); st.cnt[2 + t] += __builtin_popcount((unsigned)(mg >> 32));
                    st.tcnt[t] += __builtin_popcount((unsigned)me); st.tcnt[2 + t] += __builtin_popcount((unsigned)(me >> 32));
                }
            });
#pragma unroll
            for (int ql = 0; ql < 4; ++ql) {
                const unsigned nc = bcn[ql], G = st.pre[ql], rq = st.need[ql];
                const LAS unsigned* cq = cand + ql * CAND_CAP * 2;
                unsigned ki4[4], xi4[4], rk4[4];
#pragma unroll
                for (int m = 0; m < 4; ++m) { const unsigned i = (unsigned)lane + 64u * m; ki4[m] = (i < nc) ? cq[2 * i] : 0u; xi4[m] = (i < nc) ? cq[2 * i + 1] : 0u; rk4[m] = 0u; }
                for (unsigned j = 0; j < nc; ++j) { const unsigned kj = cq[2 * j];
#pragma unroll
                    for (int m = 0; m < 4; ++m) rk4[m] += (kj > ki4[m] || (kj == ki4[m] && j < (unsigned)lane + 64u * m)) ? 1u : 0u; }
                unsigned base = G; const unsigned long long lt = (1ull << lane) - 1ull;
#pragma unroll
                for (int m = 0; m < 4; ++m) { const bool take = ((unsigned)lane + 64u * m < nc) && rk4[m] < rq; const unsigned long long mm = __ballot(take);
                    const unsigned pos = base + __builtin_popcountll(mm & lt); if (take && pos < 256u) sel[ql * 256 + pos] = (unsigned short)xi4[m]; base += __builtin_popcountll(mm); }
            }
        } else {
#pragma unroll
            for (int ql = 0; ql < 4; ++ql) { st.pre[ql] = 0u; st.need[ql] = 256u; st.cnt[ql] = 0u; st.tcnt[ql] = 0u; }
#pragma unroll 1
            for (int lev = 0; lev < 4; ++lev) {
#pragma unroll
                for (int j = 0; j < 8; ++j) hz[j * 64 + lane] = (v4u){0u, 0u, 0u, 0u};
                const unsigned pre0 = hi ? st.pre[2] : st.pre[0], pre1 = hi ? st.pre[3] : st.pre[1];
                const int sh = (lev == 0) ? 23 : (lev == 1) ? 14 : (lev == 2) ? 5 : 0, wd = (lev == 3) ? 5 : 9;
                tile_pass(F, ksrc, kdst, kfr, koff, NT, qa, wp, [&](int kbase, float s0, float s1) {
                    const unsigned k0 = okey(s0), k1 = okey(s1);
                    const unsigned b0 = (k0 >> sh) & ((1u << wd) - 1u), b1 = (k1 >> sh) & ((1u << wd) - 1u);
                    const bool in0 = (lev == 0) || ((k0 >> (sh + wd)) == pre0), in1 = (lev == 0) || ((k1 >> (sh + wd)) == pre1);
                    if (in0) __hip_atomic_fetch_add(hist + (2 * hi) * 512 + b0, 1u, __ATOMIC_RELAXED, __HIP_MEMORY_SCOPE_WORKGROUP);
                    if (in1) __hip_atomic_fetch_add(hist + (2 * hi + 1) * 512 + b1, 1u, __ATOMIC_RELAXED, __HIP_MEMORY_SCOPE_WORKGROUP);
                });
#pragma unroll
                for (int ql = 0; ql < 4; ++ql) { unsigned bin, above, bc; scan_hist_cnt(hist + ql * 512, lane, st.need[ql], bin, above, bc);
                    st.pre[ql] = (st.pre[ql] << wd) | bin; st.need[ql] -= above; }
                LDS_WAIT();
            }
            const unsigned T0 = hi ? st.pre[2] : st.pre[0], T1 = hi ? st.pre[3] : st.pre[1], rq0 = hi ? st.need[2] : st.need[0], rq1 = hi ? st.need[3] : st.need[1];
            tile_pass(F, ksrc, kdst, kfr, koff, NT, qa, wp, [&](int kbase, float s0, float s1) {
#pragma unroll
                for (int t = 0; t < 2; ++t) {
                    const unsigned kk = okey(t ? s1 : s0), T = t ? T1 : T0, rq = t ? rq1 : rq0;
                    const bool gt = kk > T, eq = kk == T;
                    const unsigned long long me = __ballot(eq);
                    const unsigned meh = hi ? (unsigned)(me >> 32) : (unsigned)me;
                    const unsigned trank = (hi ? st.tcnt[2 + t] : st.tcnt[t]) + __builtin_popcount(meh & below);
                    const bool take = gt || (eq && trank < rq);
                    const unsigned long long mt = __ballot(take);
                    const unsigned mth = hi ? (unsigned)(mt >> 32) : (unsigned)mt;
                    const unsigned pos = (hi ? st.cnt[2 + t] : st.cnt[t]) + __builtin_popcount(mth & below);
                    if (take && pos < 256u) sel[(2 * hi + t) * 256 + pos] = (unsigned short)(kbase + r);
                    st.cnt[t] += __builtin_popcount((unsigned)mt); st.cnt[2 + t] += __builtin_popcount((unsigned)(mt >> 32));
                    st.tcnt[t] += __builtin_popcount((unsigned)me); st.tcnt[2 + t] += __builtin_popcount((unsigned)(me >> 32));
                }
            });
        }
    }
    LDS_WAIT();
    { const LAS v4u* s4 = (const LAS v4u*)sel; v4u* g4 = (v4u*)(C.SEL + (rowbase + tq0) * 256);
#pragma unroll
      for (int j = 0; j < 2; ++j) g4[j * 64 + lane] = s4[j * 64 + lane]; }
    LDS_WAIT();
}
__device__ __forceinline__ void phase(Frame& F, const Ctx& C) {
    for (int v = F.vcu; v < 256; v += F.G) {
        const int b = v >> 6, c = v & 63;
#pragma unroll 1
        for (int it = 0; it < 4; ++it) step(F, C, b, (it < 2) ? c : 127 - c, it & 1);
    }
}
__device__ __forceinline__ void attn_phase(Frame& F, const Ctx& C) {
    int lane = F.lane; asm volatile("" : "+v"(lane));
    LAS unsigned short* sq = (LAS unsigned short*)(F.lds + RING_OFF + F.wave * 16384);
    const int nx = F.G / 32;
    for (int x = F.vcu / 32; x < 8; x += nx) {
        const int b = x >> 1, g0 = 2 * (x & 1); const long rowbase = (long)b * SEQ;
        const int w = (F.vcu & 31) * NWAVES + F.wave;
#pragma unroll 1
        for (int t = w; t < SEQ; t += 32 * NWAVES) {
            { const v4u* g4 = (const v4u*)(C.SEL + (rowbase + t) * 256); if (lane < 32) ((LAS v4u*)sq)[lane] = g4[lane]; }
            LDS_WAIT();
            const int N = 64 * ((t >> 6) + 1), nvalid = N < 256 ? N : 256;
            attend(C, sq, nvalid, rowbase, rowbase + t, t, lane, g0);
            LDS_WAIT();
        }
    }
}
}

namespace att8 {
typedef int v2i __attribute__((ext_vector_type(2)));
struct Ctx8 { const unsigned char* QA8; const unsigned char* KV8; const unsigned short* SEL; bf16* M; };
constexpr int T2_OFF = KS_OFF, T2_BYTES = 155 * 16 * 4, SELL_OFF = KS_OFF + 10240;
static_assert(T2_BYTES <= 10240 && SELL_OFF + NWAVES * 1024 <= AUX_OFF, "attention LDS map");
__device__ __forceinline__ void mfma8(f32x4& acc, long a, long b) { asm volatile("v_mfma_f32_16x16x32_fp8_fp8 %0, %1, %2, %0" : "+v"(acc) : "v"(a), "v"(b)); }
__device__ __forceinline__ unsigned pk4_fp8(float a, float b, float c, float d) { int r = __builtin_amdgcn_cvt_pk_fp8_f32(a, b, 0, false); r = __builtin_amdgcn_cvt_pk_fp8_f32(c, d, r, true); return (unsigned)r; }

__device__ __forceinline__ void gld16(v4u& dst, const void* p) { asm volatile("global_load_dwordx4 %0, %1, off" : "=v"(dst) : "v"(p) : "memory"); }
__device__ __forceinline__ void issue_kq(const Ctx8& C, const LAS unsigned short* sq, long rowbase, long token, int g, int l15, int l4, int h, v4u (&kr)[16], v4u& qv) {
    const unsigned char* kvb = C.KV8 + rowbase * 512 + g * 128 + 16 * l4;
#pragma unroll
    for (int j = 0; j < 16; ++j) gld16(kr[j], kvb + (long)sq[j * 16 + l15] * 512);
    gld16(qv, C.QA8 + token * 1024 + (4 * g + h) * 64 + 16 * l4);
}
__device__ __forceinline__ void issue_v_half(const Ctx8& C, const LAS unsigned short* sq, long rowbase, int g, int lane, unsigned vbase, int half) {
    const unsigned char* kvb = C.KV8 + rowbase * 512 + g * 128 + 64; const int kq = lane >> 2, p = lane & 3;
#pragma unroll
    for (int j = 0; j < 8; ++j) { const int ti = half * 8 + j; const int key = sq[ti * 16 + kq]; const int x = ((kq >> 2) & 1) | ((ti & 1) << 1);
        glds16(kvb + (long)key * 512 + 16 * (p ^ x), (unsigned)__builtin_amdgcn_readfirstlane(vbase + ti * 1024)); }
}
__device__ __forceinline__ void phase(Frame& F, const Ctx8& C, const float* t5) {
    int lane = F.lane; asm volatile("" : "+v"(lane));
    LAS float* T2 = (LAS float*)(F.lds + T2_OFF);
    for (int e = F.tid; e < 155 * 16; e += NWAVES * 64) { const int rel = (e >> 4) - 91, n = rel < 0 ? -rel : rel;
        const int bk = (rel > 0 ? 16 : 0) + (n < 8 ? n : 8 + (n >= 12) + (n >= 16) + (n >= 23) + (n >= 32) + (n >= 46) + (n >= 64) + (n >= 91));
        T2[e] = t5[bk * 16 + (e & 15)] * 8.0f; }
    __syncthreads();
    LAS unsigned short* sqb = (LAS unsigned short*)(F.lds + SELL_OFF + F.wave * 1024);
    LAS unsigned char* vreg = F.lds + RING_OFF + F.wave * 16384;
    const unsigned vbase = (unsigned)(uintptr_t)vreg;
    const int l15 = lane & 15, l4 = lane >> 4, h = l15 & 3;
    const int trk = 4 * l4 + ((l15 >> 1) & 3), trt = (l15 >> 3) & 1, xs = (l4 & 1) | (trt << 1);
    const int troff = trt * 1024 + trk * 64 + 8 * (l15 & 1);
    const int x = F.vcu / 32, b = x >> 1, g0 = 2 * (x & 1); const long rowbase = (long)b * SEQ;
    const int w = (F.vcu & 31) * NWAVES + F.wave;
    constexpr int NQ = SEQ / (32 * NWAVES), NI = 2 * NQ;
    if (lane < 32) { ((LAS v4u*)sqb)[lane] = ((const v4u*)(C.SEL + (rowbase + w) * 256))[lane]; ((LAS v4u*)(sqb + 256))[lane] = ((const v4u*)(C.SEL + (rowbase + w + 32 * NWAVES) * 256))[lane]; }
    LDS_WAIT();
    v4u kr[16], qv, pf = (v4u){0u, 0u, 0u, 0u};
    issue_kq(C, sqb, rowbase, rowbase + w, g0, l15, l4, h, kr, qv);
    issue_v_half(C, sqb, rowbase, g0, lane, vbase, 0); issue_v_half(C, sqb, rowbase, g0, lane, vbase, 1);
    unsigned cib[16];
#pragma unroll 1
    for (int idx = 0; idx < NI; ++idx) {
        const int qn = idx >> 1, gi = idx & 1, g = g0 + gi, t = w + 32 * NWAVES * qn;
        const LAS unsigned short* sq = sqb + (qn & 1) * 256;
        const int nidx = (idx + 1 < NI) ? idx + 1 : idx, nq = nidx >> 1, ng = g0 + (nidx & 1), nt = w + 32 * NWAVES * nq;
        const LAS unsigned short* nsq = sqb + (nq & 1) * 256;
        if (gi == 1) { asm volatile("s_waitcnt vmcnt(34)" : "+v"(pf) :: "memory"); if (lane < 32) ((LAS v4u*)(sqb + (qn & 1) * 256))[lane] = pf; }
        { const int pq = (qn + 2 < NQ) ? qn + 2 : NQ - 1; gld16(pf, (const v4u*)(C.SEL + (rowbase + w + 32 * NWAVES * pq) * 256) + (lane & 31)); }
        if (idx == 0) asm volatile("s_waitcnt vmcnt(0)" : "+v"(qv), "+v"(kr[0]), "+v"(kr[1]), "+v"(kr[2]), "+v"(kr[3]), "+v"(kr[4]), "+v"(kr[5]), "+v"(kr[6]), "+v"(kr[7]), "+v"(kr[8]), "+v"(kr[9]), "+v"(kr[10]), "+v"(kr[11]), "+v"(kr[12]), "+v"(kr[13]), "+v"(kr[14]), "+v"(kr[15]) :: "memory");
        else asm volatile("s_waitcnt vmcnt(20)" : "+v"(qv), "+v"(kr[0]), "+v"(kr[1]), "+v"(kr[2]), "+v"(kr[3]), "+v"(kr[4]), "+v"(kr[5]), "+v"(kr[6]), "+v"(kr[7]), "+v"(kr[8]), "+v"(kr[9]), "+v"(kr[10]), "+v"(kr[11]), "+v"(kr[12]), "+v"(kr[13]), "+v"(kr[14]), "+v"(kr[15]) :: "memory");
        if (gi == 0) {
#pragma unroll
            for (int ti = 0; ti < 16; ++ti) { const v2u i4 = *(const LAS v2u*)(sq + ti * 16 + 4 * l4);
                const int r0 = (int)(i4.x & 0xffffu) - t, r1 = (int)(i4.x >> 16) - t, r2 = (int)(i4.y & 0xffffu) - t, r3 = (int)(i4.y >> 16) - t;
                const int c0 = min(max(r0, -91), 63) + 91, c1 = min(max(r1, -91), 63) + 91, c2 = min(max(r2, -91), 63) + 91, c3 = min(max(r3, -91), 63) + 91;
                cib[ti] = (unsigned)c0 | ((unsigned)c1 << 8) | ((unsigned)c2 << 16) | ((unsigned)c3 << 24); }
        }
        const int N = 64 * ((t >> 6) + 1), nvalid = N < 256 ? N : 256;
        const long q0 = (long)(((unsigned long long)qv.y << 32) | qv.x), q1 = (long)(((unsigned long long)qv.w << 32) | qv.z);
        f32x4 S[16];
#pragma unroll
        for (int ti = 0; ti < 16; ++ti) { const unsigned cb = cib[ti];
            f32x4 a; a.x = T2[(cb & 255u) * 16 + 4 * g + h]; a.y = T2[((cb >> 8) & 255u) * 16 + 4 * g + h]; a.z = T2[((cb >> 16) & 255u) * 16 + 4 * g + h]; a.w = T2[(cb >> 24) * 16 + 4 * g + h];
            mfma8(a, (long)(((unsigned long long)kr[ti].y << 32) | kr[ti].x), q0);
            mfma8(a, (long)(((unsigned long long)kr[ti].w << 32) | kr[ti].z), q1);
            S[ti] = a; }
        asm volatile("s_nop 15\n\ts_nop 7" : "+v"(S[0]), "+v"(S[1]), "+v"(S[2]), "+v"(S[3]), "+v"(S[4]), "+v"(S[5]), "+v"(S[6]), "+v"(S[7]), "+v"(S[8]), "+v"(S[9]), "+v"(S[10]), "+v"(S[11]), "+v"(S[12]), "+v"(S[13]), "+v"(S[14]), "+v"(S[15]));
        issue_kq(C, nsq, rowbase, rowbase + nt, ng, l15, l4, h, kr, qv);
#pragma unroll
        for (int ti = 0; ti < 16; ++ti) if (ti * 16 >= nvalid) S[ti] = (f32x4){-INFINITY, -INFINITY, -INFINITY, -INFINITY};
        float mx = S[0].x;
#pragma unroll
        for (int ti = 0; ti < 16; ++ti) mx = fmaxf(fmaxf(mx, fmaxf(S[ti].x, S[ti].y)), fmaxf(S[ti].z, S[ti].w));
        mx = fmaxf(mx, __shfl_xor(mx, 16)); mx = fmaxf(mx, __shfl_xor(mx, 32));
        const float mc = -mx * C2; float ls = 0.f;
        long P8[8];
#pragma unroll
        for (int j = 0; j < 8; ++j) { float e[8];
#pragma unroll
            for (int q = 0; q < 4; ++q) { e[q] = __builtin_amdgcn_exp2f(__builtin_fmaf(S[2 * j][q], C2, mc)); e[4 + q] = __builtin_amdgcn_exp2f(__builtin_fmaf(S[2 * j + 1][q], C2, mc)); }
            ls += ((e[0] + e[1]) + (e[2] + e[3])) + ((e[4] + e[5]) + (e[6] + e[7]));
            const unsigned lo = pk4_fp8(e[0] * 256.f, e[1] * 256.f, e[2] * 256.f, e[3] * 256.f), hi = pk4_fp8(e[4] * 256.f, e[5] * 256.f, e[6] * 256.f, e[7] * 256.f);
            P8[j] = (long)(((unsigned long long)hi << 32) | lo); }
        ls += __shfl_xor(ls, 16); ls += __shfl_xor(ls, 32);
        f32x4 D[4];
#pragma unroll
        for (int db = 0; db < 4; ++db) D[db] = (f32x4){0.f, 0.f, 0.f, 0.f};
#pragma unroll
        for (int hf = 0; hf < 2; ++hf) {
            asm volatile("s_waitcnt vmcnt(28)" ::: "memory");
#pragma unroll
            for (int j = 4 * hf; j < 4 * hf + 4; ++j)
#pragma unroll
                for (int db = 0; db < 4; ++db) {
                    const v2i vv = __builtin_amdgcn_ds_read_tr8_b64_v2i32((LAS v2i*)(vreg + j * 2048 + troff + 16 * (db ^ xs)));
                    mfma8(D[db], P8[j], __builtin_bit_cast(long, vv)); }
            asm volatile("s_waitcnt lgkmcnt(0)" ::: "memory");
            issue_v_half(C, nsq, rowbase, ng, lane, vbase, hf);
        }
        asm volatile("s_nop 15\n\ts_nop 7" : "+v"(D[0]), "+v"(D[1]), "+v"(D[2]), "+v"(D[3]));
        const float lh = __shfl(ls, l4);
        const float inv = __builtin_amdgcn_rcpf(lh * 256.f);
        bf16* mp = C.M + (rowbase + t) * DM + (4 * g + l4) * 64 + l15;
#pragma unroll
        for (int db = 0; db < 4; ++db) { const float v = (l4 == 0) ? D[db].x : (l4 == 1) ? D[db].y : (l4 == 2) ? D[db].z : D[db].w; const unsigned short ob = (unsigned short)f2bf(v * inv);
            asm volatile("global_store_short %0, %1, off" :: "v"(mp + 16 * db), "v"((unsigned)ob) : "memory"); }
    }
    asm volatile("s_waitcnt vmcnt(0)" ::: "memory");
}
}

#ifndef REP_P0
#define REP_P0 1
#endif
#ifndef REP_IN
#define REP_IN 1
#endif
#ifndef REP_DSA
#define REP_DSA 1
#endif
#ifndef REP_BAND
#define REP_BAND 1
#endif
#ifndef REP_UP
#define REP_UP 1
#endif
#ifndef REP_FIX
#define REP_FIX 1
#endif
constexpr int N_PHASES = 1 + 6 * DEPTH;
#ifndef MK_N_LAUNCHES
#define MK_N_LAUNCHES 1
#endif
__global__ void __launch_bounds__(NWAVES * 64, 2) mega_fwd(Args args) {
    extern __shared__ __attribute__((aligned(16))) unsigned char lds[];
    Frame F;
    F.lds = (LAS unsigned char*)lds;
    F.MISC = (volatile LAS unsigned*)(F.lds + MISC_OFF);
    F.tid = threadIdx.x; F.lane = F.tid & 63; F.wave = __builtin_amdgcn_readfirstlane(F.tid >> 6);
    F.G = GRID; { const int bx = blockIdx.x; F.vcu = (bx & 7) * (GRID / 8) + (bx >> 3); }
    unsigned char* ws = args.ws;
    F.ctl = (gu32*)(ws + WS_CTL);
    for (int u = F.tid; u < (LDS_BYTES - LDSCTL_OFF) / 4; u += NWAVES * 64) ((LAS unsigned*)(F.lds + LDSCTL_OFF))[u] = 0u;
    __syncthreads();
    XcdBarrier bar; bar.bar = (unsigned*)(F.ctl + CW_BAR); bar.x = 0; bar.st = nullptr;
    if (MK_N_LAUNCHES == 1) bar = xcd_barrier_post((unsigned*)(F.ctl + CW_BAR), F.MISC + 8);
    const int lo = args.ph_lo, hi = args.ph_hi;
#define IN(k) (lo <= (k) && (k) < hi)
#define OPQ_FRAME(Fl) Frame Fl = F; { int l_; asm volatile("v_mbcnt_lo_u32_b32 %0, -1, 0\n\tv_mbcnt_hi_u32_b32 %0, -1, %0" : "=v"(l_)); int w_ = F.wave; asm volatile("" : "+s"(w_)); Fl.wave = w_; Fl.lane = l_; Fl.tid = w_ * 64 + l_; }
#define SEAM(k) do { if (IN(k) && IN((k) + 1)) xcd_barrier(bar); } while (0)

    bf16* hb = (bf16*)(ws + WS_HB); bf16* mb = (bf16*)(ws + WS_M); float* ss = (float*)(ws + WS_SS); float* halo = (float*)(ws + WS_HALO);
    unsigned char* proj = ws + WS_PROJ; bf16* act = (bf16*)(ws + WS_PROJ);

#ifndef SKIP_P0
    if (IN(0)) { for (int rep = 0; rep < REP_P0; ++rep) { OPQ_FRAME(F0); p0_prologue(F0, args); } }
#endif
    SEAM(0);

#pragma unroll 1
    for (int L = 0; L < DEPTH; ++L) {
        const int pb = 1 + 6 * L, li = L >> 1; const bool isB = (L & 1) != 0;
        if (IN(pb)) {
#ifndef SKIP_IN
            for (int rep = 0; rep < REP_IN; ++rep)
            if (!isB) {
                pg8::Gemm g{hb, (const bf16*)(ws + WS_W_INA) + (size_t)li * NA_PAD * DM, MTOK, NA_PAD, DM}; pg8::StaticOrder S; S.init(MTOK, NA_PAD, F.G, (int)blockIdx.x);
                EpiIn E{ss, proj, args.q_norm_g + L * 64, args.k_norm_g + L * 64, 0};
                pg8::gemm_phase<EpiIn, pg8::StaticOrder, true, true>(F.lds + RING_OFF, g, S, E, F.wave);
            } else {
                pg8::Gemm g{hb, (const bf16*)(ws + WS_W_INB) + (size_t)li * NB * DM, MTOK, NB, DM}; pg8::StaticOrder S; S.init(MTOK, NB, F.G, (int)blockIdx.x);
                EpiIn E{ss, proj, args.q_norm_g + L * 64, args.k_norm_g + L * 64, 1};
                pg8::gemm_phase<EpiIn, pg8::StaticOrder, true, true>(F.lds + RING_OFF, g, S, E, F.wave);
            }
#endif
        }
        SEAM(pb);
#if defined(DBG_NODSA) || defined(DBG_NOBAND)
#ifdef DBG_NODSA
        const bool zero_m = !isB;
#else
        const bool zero_m = isB;
#endif
        if (IN(pb + 1) && zero_m) { for (size_t i = (size_t)blockIdx.x * 512 + threadIdx.x; i < (size_t)MTOK * DM / 8; i += (size_t)gridDim.x * 512) ((v4u*)mb)[i] = (v4u){0u, 0u, 0u, 0u}; }
        if (IN(pb + 1) && !zero_m) {
#else
        if (IN(pb + 1)) {
#endif
#ifndef SKIP_DSA
            if (!isB) {
                LAS float* t5l = (LAS float*)(F.lds + AUX_OFF);
                { OPQ_FRAME(Ft); for (int i = Ft.tid; i < 512; i += NWAVES * 64) t5l[i] = args.t5_bias[i] * LOG2E; }
                __syncthreads();
                dsa::Ctx C{(const bf16*)(proj + PA_QA), (const bf16*)(proj + PA_KA), (const bf16*)(proj + PA_VA), (const bf16*)(proj + PA_QI), (const bf16*)(proj + PA_KI), (const float*)(proj + PA_WI), mb, t5l, (unsigned short*)(proj + PA_SEL)};
#ifdef DBG_DSACOPY
                { int t_ = threadIdx.x; asm volatile("" : "+v"(t_));
                for (unsigned i = blockIdx.x * 512u + (unsigned)t_; i < (unsigned)MTOK * DM; i += gridDim.x * 512u) { const unsigned t = i >> 10, c = i & 1023u;
                    float v = bf_lo(C.QA[i]); v += bf_lo(C.KA[t * 256 + (c & 255)]); v += bf_lo(C.VA[t * 256 + (c & 255)]); v += bf_lo(C.QI[t * 512 + (c & 511)]); v += bf_lo(C.KI[t * 64 + (c & 63)]); v += C.WI[t * 8 + (c & 7)];
                    mb[i] = (bf16)f2bf(v * 0.01f); asm volatile("" ::: "memory"); } }
#else
                for (int rep = 0; rep < REP_DSA; ++rep) { OPQ_FRAME(F1); dsa::phase(F1, C); }
                xcd_barrier(bar);
                { OPQ_FRAME(F1b); att8::Ctx8 C8{(const unsigned char*)(proj + PA_QA), (const unsigned char*)(proj + PA_KA), (const unsigned short*)(proj + PA_SEL), mb};
#ifndef REP_ATT8
#define REP_ATT8 1
#endif
                  for (int rep = 0; rep < REP_ATT8; ++rep) { att8::phase(F1b, C8, args.t5_bias); __syncthreads(); } }
#endif
            }
#endif
#ifndef SKIP_BAND
            if (isB) {
                for (int rep = 0; rep < REP_BAND; ++rep) { OPQ_FRAME(F2); band::phase(F2, (const bf16*)proj, (const bf16*)(proj + PB_STRIDE), (const bf16*)(proj + 2 * PB_STRIDE), mb, args.rel_bias_b + (size_t)li * 513 * 16); }
            }
#endif
        }
        SEAM(pb + 1);
        if (IN(pb + 2)) {
#ifndef SKIP_OUT
            pg8::Gemm g{mb, (const bf16*)(ws + WS_W_OUT) + (size_t)L * DM * DM, MTOK, DM, DM}; pg8::StaticOrder S; S.init(MTOK, DM, F.G, (int)blockIdx.x);
#ifdef REP_OUT
            { EpiRes E0{L == 0 ? args.x : nullptr, nullptr, hb, (bf16*)proj, halo}; pg8::gemm_phase<EpiRes, pg8::StaticOrder, true, true>(F.lds + RING_OFF, g, S, E0, F.wave); }
#endif
            EpiRes E{L == 0 ? args.x : nullptr, nullptr, hb, hb, ss};
            pg8::gemm_phase<EpiRes, pg8::StaticOrder, true, true>(F.lds + RING_OFF, g, S, E, F.wave);
#endif
        }
        SEAM(pb + 2);
        if (IN(pb + 3)) {
#ifndef SKIP_UP
            for (int rep = 0; rep < REP_UP; ++rep) {
            pg8::Gemm g{hb, (const bf16*)(ws + WS_W_UP) + (size_t)L * NUP * DM, MTOK, NUP, DM}; pg8::StaticOrder S; S.init(MTOK, NUP, F.G, (int)blockIdx.x);
#ifdef PROBE_UPK
            { EpiDummy E0{halo}; pg8::gemm_phase<EpiDummy, pg8::StaticOrder, true, true>(F.lds + RING_OFF, g, S, E0, F.wave); }
#endif
            EpiUp E{ss, args.conv_w + (size_t)L * 3 * NUP, args.conv_b + (size_t)L * NUP, act, halo, (LAS float*)(F.lds + AUX_OFF)};
            pg8::gemm_phase<EpiUp, pg8::StaticOrder, true, true>(F.lds + RING_OFF, g, S, E, F.wave); }
#endif
        }
        SEAM(pb + 3);
#ifndef SKIP_FIX
        if (IN(pb + 4)) for (int rep = 0; rep < REP_FIX; ++rep) { OPQ_FRAME(F3); fixup_phase(F3, args.conv_w + (size_t)L * 3 * NUP, args.conv_b + (size_t)L * NUP, halo, act); }
#endif
        SEAM(pb + 4);
        if (IN(pb + 5)) {
#ifndef SKIP_DN
            pg8::Gemm g{act, (const bf16*)(ws + WS_W_DN) + (size_t)L * DM * FF, MTOK, DM, FF}; pg8::StaticOrder S; S.init(MTOK, DM, F.G, (int)blockIdx.x);
#ifdef REP_DN
            { EpiRes E0{nullptr, nullptr, hb, mb, halo}; pg8::gemm_phase<EpiRes, pg8::StaticOrder, true, true>(F.lds + RING_OFF, g, S, E0, F.wave); }
#endif
            EpiRes E{nullptr, L == DEPTH - 1 ? args.out : nullptr, hb, hb, ss};
            pg8::gemm_phase<EpiRes, pg8::StaticOrder, true, true>(F.lds + RING_OFF, g, S, E, F.wave);
#endif
        }
        SEAM(pb + 5);
    }
#undef IN
#undef SEAM
}

extern "C" void kernel_launch(void* const* d_in, const int* in_sizes, int n_in, void* d_out, int out_size, void* d_ws, size_t ws_size, hipStream_t stream) {
    static int grid = 0;
    if (grid == 0) {
        if (n_in != 14 || in_sizes[0] != MTOK * DM || out_size != MTOK * DM || ws_size < WS_END) { fprintf(stderr, "kernel_launch: unexpected shapes / workspace (n_in %d, ws %zu); nothing launched\n", n_in, ws_size); grid = -1; return; }
        int dev = 0, cus = 0, per_cu = 0;
        if (hipGetDevice(&dev) != hipSuccess || hipDeviceGetAttribute(&cus, hipDeviceAttributeMultiprocessorCount, dev) != hipSuccess) { grid = -1; return; }
        if (hipFuncSetAttribute((const void*)mega_fwd, hipFuncAttributeMaxDynamicSharedMemorySize, LDS_BYTES) != hipSuccess) { fprintf(stderr, "kernel_launch: hipFuncSetAttribute failed\n"); grid = -1; return; }
        if (hipOccupancyMaxActiveBlocksPerMultiprocessor(&per_cu, (const void*)mega_fwd, NWAVES * 64, LDS_BYTES) != hipSuccess || per_cu < 1) { fprintf(stderr, "kernel_launch: occupancy query reports %d blocks per CU\n", per_cu); }
        (void)hipGetLastError();
        if (cus != GRID) { fprintf(stderr, "kernel_launch: built for a %d-CU device, found %d; nothing launched\n", GRID, cus); grid = -1; return; }
        grid = GRID;
    }
    if (grid < 0) return;
    if (hipMemsetAsync((char*)d_ws + WS_CTL, 0, CTL_ZERO_BYTES, stream) != hipSuccess) return;
    Args a{};
    a.x = (const float*)d_in[0]; a.attn_norm_g = (const float*)d_in[1]; a.w_in_a = (const float*)d_in[2]; a.w_in_b = (const float*)d_in[3]; a.q_norm_g = (const float*)d_in[4];
    a.k_norm_g = (const float*)d_in[5]; a.t5_bias = (const float*)d_in[6]; a.rel_bias_b = (const float*)d_in[7]; a.w_out = (const float*)d_in[8]; a.ffn_norm_g = (const float*)d_in[9];
    a.w_up = (const float*)d_in[10]; a.conv_w = (const float*)d_in[11]; a.conv_b = (const float*)d_in[12]; a.w_down = (const float*)d_in[13];
    a.out = (float*)d_out; a.ws = (unsigned char*)d_ws; a.pad = 0;
#if MK_N_LAUNCHES == 1
    a.ph_lo = 0; a.ph_hi = N_PHASES; a.li = 0;
    hipLaunchKernelGGL(mega_fwd, dim3(grid), dim3(NWAVES * 64), LDS_BYTES, stream, a);
#else
    for (int p = 0; p < N_PHASES; ++p) { a.ph_lo = p; a.ph_hi = p + 1; a.li = p; hipLaunchKernelGGL(mega_fwd, dim3(grid), dim3(NWAVES * 64), LDS_BYTES, stream, a); }
#endif
}
```

```cpp
#include <hip/hip_runtime.h>
#include <cstdio>
#include <cstdint>
namespace pg8 {
#define PG8_LAS __attribute__((address_space(3)))
typedef unsigned short bf16_t;
typedef short bf16x8 __attribute__((ext_vector_type(8)));
typedef float f32x4 __attribute__((ext_vector_type(4)));
typedef unsigned u32x4 __attribute__((ext_vector_type(4)));
constexpr int BM = 256, BK = 64, HALF = 128, HTB = HALF * BK * 2  , STAGE_BYTES = 8 * HTB, NXCD = 8, WGM = 8;

__host__ __device__ __forceinline__ int lds_byte(int r, int c) { const int st = (r >> 4) * 2 + (c >> 5), rr = r & 15, cc = c & 31, ob = rr * 64 + cc * 2; return st * 1024 + (ob ^ (((ob >> 9) & 1) << 5)); }
__host__ __device__ __forceinline__ void stage_rc(int b, int& R, int& C) { const int st = b / 1024, sb = b % 1024, swz = sb ^ (((sb >> 9) & 1) << 5); R = (st >> 1) * 16 + swz / 64; C = (st & 1) * 32 + (swz % 64) / 2; }
__host__ __device__ __forceinline__ int perm32(int rho) { const int n = rho >> 4, i = rho & 15; return 8 * (i >> 2) + 4 * n + (i & 3); }

struct Unit { int pm, pn; };
struct Gemm { const bf16_t* A; const bf16_t* Bt; int M, N, K; };

struct StaticOrder {
    int nM, nN, nwg, G, c;
    __host__ __device__ void init(int M, int N, int G_, int c_) { nM = M / BM; nN = N / BM; nwg = nM * nN; G = G_; c = c_; }
    __host__ __device__ bool next(int i, Unit& u) const {
        const long L = (long)i * G + c; if (L >= nwg) return false;
        int wgid = (int)L; { const int q = nwg / NXCD, r = nwg % NXCD, xcd = wgid % NXCD, off = wgid / NXCD; wgid = (xcd < r ? xcd * (q + 1) : r * (q + 1) + (xcd - r) * q) + off; }
        const int nig = WGM * nN, gid = wgid / nig, fm = gid * WGM, gsz = (nM - fm) < WGM ? (nM - fm) : WGM;
        u.pm = fm + ((wgid % nig) % gsz); u.pn = (wgid % nig) / gsz; return true;
    }
    __device__ __forceinline__ void a_ready(const Unit&) const {}
    __device__ __forceinline__ void done(const Unit&) const {}
};
__device__ __forceinline__ unsigned cvt_pk_bf16(float lo, float hi) { unsigned r; asm volatile("v_cvt_pk_bf16_f32 %0, %1, %2" : "=v"(r) : "v"(lo), "v"(hi)); return r; }
template <class Epi, class Sched, bool ALIGN_EPI = false, bool SP2 = false>
__device__ __forceinline__ void gemm_phase(PG8_LAS unsigned char* lds, const Gemm g, const Sched& S, const Epi& E, const int wave_id) {
    int lane_; asm volatile("v_mbcnt_lo_u32_b32 %0, -1, 0\n\tv_mbcnt_hi_u32_b32 %0, -1, %0" : "=v"(lane_));
    int wid_ = wave_id; asm volatile("" : "+s"(wid_));
    const int wid = wid_, lane = lane_, tid = wid * 64 + lane, wr = wid >> 2, wc = wid & 3, fr = lane & 15, fq = lane >> 4;
    const int K = g.K, nt = K / BK;
    unsigned voffA[2], voffB[2];
#pragma unroll
    for (int i = 0; i < 2; ++i) { int R, C; stage_rc(tid * 16 + i * 8192, R, C); const int Rb = Epi::PERM ? ((R & ~31) + perm32(R & 31)) : R;
        const int Ra = Epi::PERMA ? ((R & ~63) | (4 * (R & 15) + ((R >> 4) & 3))) : R;
        voffA[i] = (unsigned)(Ra * K + C) * 2u; voffB[i] = (unsigned)(Rb * K + C) * 2u; }
    const size_t kstep = (size_t)(BK * 2);
    const size_t hstep = (size_t)HALF * K * 2;
    const size_t tstep = 2 * hstep;
    const unsigned ldsw = (unsigned)wid * 1024u;
    const int aoff = lds_byte(wr * 64 + fr, fq * 8), boff = lds_byte(wc * 32 + fr, fq * 8);
#define PG8_SA(b, h) (((b) * 2 + (h)) * HTB)
#define PG8_SB(b, h) ((4 + (b) * 2 + (h)) * HTB)
#define PG8_STAGE(bufoff, gbase, voff) do { _Pragma("unroll") for (int _i = 0; _i < 2; ++_i) \
        __builtin_amdgcn_global_load_lds((const unsigned*)((const char*)(gbase) + (voff)[_i]), (PG8_LAS unsigned*)(lds + (bufoff) + ldsw + _i * 8192), 16, 0, 0); } while (0)
#define PG8_LDA(dst, b, h) do { _Pragma("unroll") for (int m = 0; m < 4; ++m) _Pragma("unroll") for (int k = 0; k < 2; ++k) dst[m][k] = *(const PG8_LAS bf16x8*)(lds + PG8_SA(b, h) + aoff + m * 2048 + k * 1024); } while (0)
#define PG8_LDB(dst, b, h) do { _Pragma("unroll") for (int n = 0; n < 2; ++n) _Pragma("unroll") for (int k = 0; k < 2; ++k) dst[n][k] = *(const PG8_LAS bf16x8*)(lds + PG8_SB(b, h) + boff + n * 2048 + k * 1024); } while (0)
#define PG8_MMA(ai, bj, At, Bt) do { __builtin_amdgcn_s_setprio(1); _Pragma("unroll") for (int m = 0; m < 4; ++m) _Pragma("unroll") for (int n = 0; n < 2; ++n) _Pragma("unroll") for (int k = 0; k < 2; ++k) \
        acc[ai][bj][m][n] = __builtin_amdgcn_mfma_f32_16x16x32_bf16(Bt[n][k], At[m][k], acc[ai][bj][m][n], 0, 0, 0); __builtin_amdgcn_s_setprio(0); } while (0)
#define PG8_WAIT_V(n) asm volatile("s_waitcnt vmcnt(" #n ")" ::: "memory")
#define PG8_WAIT_L(n) asm volatile("s_waitcnt lgkmcnt(" #n ")" ::: "memory")
#define PG8_BAR __builtin_amdgcn_s_barrier()
#define PG8_SCHED __builtin_amdgcn_sched_barrier(0)
    Unit cur, nxt; int ui = 0;
    if (!S.next(0, cur)) return;
    f32x4 acc[2][2][4][2];
#pragma unroll
    for (int a = 0; a < 2; ++a)
#pragma unroll
        for (int b = 0; b < 2; ++b)
#pragma unroll
            for (int m = 0; m < 4; ++m)
#pragma unroll
                for (int n = 0; n < 2; ++n) acc[a][b][m][n] = (f32x4){0.f, 0.f, 0.f, 0.f};
    bf16x8 At[4][2], B0[2][2], B1[2][2];
    const char* cA = (const char*)g.A + (size_t)cur.pm * tstep; const char* cB = (const char*)g.Bt + (size_t)cur.pn * tstep;
    S.a_ready(cur);
    if constexpr (SP2) {
        PG8_STAGE(PG8_SB(0, 0), cB, voffB); PG8_STAGE(PG8_SB(0, 1), cB + hstep, voffB); PG8_STAGE(PG8_SA(0, 0), cA, voffA); PG8_STAGE(PG8_SA(0, 1), cA + hstep, voffA);
        if (wr == 1) PG8_BAR;
        PG8_WAIT_V(2); PG8_BAR;
        PG8_STAGE(PG8_SB(1, 0), cB + kstep, voffB); PG8_STAGE(PG8_SA(1, 0), cA + kstep, voffA); PG8_STAGE(PG8_SB(1, 1), cB + hstep + kstep, voffB);
        PG8_WAIT_V(6); PG8_BAR;
    } else {
        PG8_STAGE(PG8_SB(0, 0), cB, voffB); PG8_STAGE(PG8_SA(0, 0), cA, voffA); PG8_STAGE(PG8_SB(0, 1), cB + hstep, voffB); PG8_STAGE(PG8_SA(0, 1), cA + hstep, voffA);
        if (wr == 1) PG8_BAR;
        PG8_WAIT_V(4); PG8_BAR;
        PG8_STAGE(PG8_SB(1, 0), cB + kstep, voffB); PG8_STAGE(PG8_SA(1, 0), cA + kstep, voffA); PG8_STAGE(PG8_SB(1, 1), cB + hstep + kstep, voffB);
        PG8_WAIT_V(6); PG8_BAR;
    }
    for (;;) {
        const bool has_next = S.next(ui + 1, nxt);
        const char* nA = has_next ? (const char*)g.A + (size_t)nxt.pm * tstep : cA; const char* nB = has_next ? (const char*)g.Bt + (size_t)nxt.pn * tstep : cB;
        for (int t = 0; t < nt; t += 2) {
            const bool last = (t == nt - 2);
            const char* a1 = cA + (size_t)(t + 1) * kstep;
            const char* a2 = last ? nA : cA + (size_t)(t + 2) * kstep; const char* b2 = last ? nB : cB + (size_t)(t + 2) * kstep;
            const char* a3 = a2 + kstep; const char* b3 = b2 + kstep;
            if (last && has_next) S.a_ready(nxt);
            if constexpr (SP2) {
            PG8_LDB(B0, 0, 0); PG8_LDB(B1, 0, 1); PG8_SCHED; PG8_LDA(At, 0, 0); PG8_STAGE(PG8_SA(1, 1), a1 + hstep, voffA);
            PG8_WAIT_V(8); PG8_WAIT_L(0); PG8_BAR; PG8_MMA(0, 0, At, B0); PG8_MMA(0, 1, At, B1); PG8_BAR; PG8_SCHED;
            PG8_LDA(At, 0, 1); PG8_STAGE(PG8_SB(0, 0), b2, voffB); PG8_STAGE(PG8_SB(0, 1), b2 + hstep, voffB); PG8_STAGE(PG8_SA(0, 0), a2, voffA);
            PG8_WAIT_V(8); PG8_WAIT_L(0); PG8_BAR; PG8_MMA(1, 0, At, B0); PG8_MMA(1, 1, At, B1); PG8_BAR; PG8_SCHED;
            PG8_LDB(B0, 1, 0); PG8_LDB(B1, 1, 1); PG8_SCHED; PG8_LDA(At, 1, 0); PG8_STAGE(PG8_SA(0, 1), a2 + hstep, voffA);
            PG8_WAIT_V(8); PG8_WAIT_L(0); PG8_BAR; PG8_MMA(0, 0, At, B0); PG8_MMA(0, 1, At, B1); PG8_BAR; PG8_SCHED;
            PG8_LDA(At, 1, 1); PG8_STAGE(PG8_SB(1, 0), b3, voffB); PG8_STAGE(PG8_SB(1, 1), b3 + hstep, voffB); PG8_STAGE(PG8_SA(1, 0), a3, voffA);
            PG8_WAIT_V(8); PG8_WAIT_L(0); PG8_BAR; PG8_MMA(1, 0, At, B0); PG8_MMA(1, 1, At, B1); PG8_BAR; PG8_SCHED;
            } else {
            PG8_LDB(B0, 0, 0); PG8_SCHED; PG8_LDA(At, 0, 0); PG8_STAGE(PG8_SA(1, 1), a1 + hstep, voffA);
            PG8_WAIT_L(8); PG8_BAR; PG8_WAIT_L(0); PG8_MMA(0, 0, At, B0); PG8_BAR; PG8_SCHED;
            PG8_LDB(B1, 0, 1); PG8_STAGE(PG8_SB(0, 0), b2, voffB);
            PG8_BAR; PG8_WAIT_L(0); PG8_MMA(0, 1, At, B1); PG8_BAR;
            PG8_LDA(At, 0, 1); PG8_STAGE(PG8_SA(0, 0), a2, voffA);
            PG8_BAR; PG8_WAIT_L(0); PG8_MMA(1, 0, At, B0); PG8_BAR; PG8_SCHED;
            PG8_STAGE(PG8_SB(0, 1), b2 + hstep, voffB);
            PG8_WAIT_V(6); PG8_BAR; PG8_MMA(1, 1, At, B1); PG8_BAR;
            PG8_LDB(B0, 1, 0); PG8_SCHED; PG8_LDA(At, 1, 0); PG8_STAGE(PG8_SA(0, 1), a2 + hstep, voffA);
            PG8_WAIT_L(8); PG8_BAR; PG8_WAIT_L(0); PG8_MMA(0, 0, At, B0); PG8_BAR; PG8_SCHED;
            PG8_LDB(B1, 1, 1); PG8_STAGE(PG8_SB(1, 0), b3, voffB);
            PG8_BAR; PG8_WAIT_L(0); PG8_MMA(0, 1, At, B1); PG8_BAR;
            PG8_LDA(At, 1, 1); PG8_STAGE(PG8_SA(1, 0), a3, voffA);
            PG8_BAR; PG8_WAIT_L(0); PG8_MMA(1, 0, At, B0); PG8_BAR; PG8_SCHED;
            PG8_STAGE(PG8_SB(1, 1), b3 + hstep, voffB);
            PG8_WAIT_V(6); PG8_BAR; PG8_MMA(1, 1, At, B1); PG8_BAR;
            }
        }
        if constexpr (ALIGN_EPI) { if (wr == 0) PG8_BAR; }
        if constexpr (!Epi::AFTER_DRAIN) { E(acc, cur, wr, wc, fr, fq); S.done(cur); }
        if (!has_next) break;
#pragma unroll
        for (int a = 0; a < 2; ++a)
#pragma unroll
            for (int b = 0; b < 2; ++b)
#pragma unroll
                for (int m = 0; m < 4; ++m)
#pragma unroll
                    for (int n = 0; n < 2; ++n) acc[a][b][m][n] = (f32x4){0.f, 0.f, 0.f, 0.f};
        cur = nxt; cA = nA; cB = nB; ++ui;
        if constexpr (ALIGN_EPI) { if (wr == 1) PG8_BAR; }
    }
    PG8_WAIT_V(0);
    if constexpr (!ALIGN_EPI) { if (wr == 0) PG8_BAR; }
    PG8_BAR;
    if constexpr (Epi::AFTER_DRAIN) { E.fused(acc, cur, wr, wc, fr, fq, lds, wid, lane); S.done(cur); }
#undef PG8_SA
#undef PG8_SB
#undef PG8_STAGE
#undef PG8_LDA
#undef PG8_LDB
#undef PG8_MMA
#undef PG8_WAIT_V
#undef PG8_WAIT_L
#undef PG8_BAR
#undef PG8_SCHED
}
}

constexpr int NWAVES = 8, GRID = 256;
constexpr int BATCH = 4, SEQ = 8192, DM = 1024, MTOK = BATCH * SEQ, DEPTH = 4;
constexpr int NA_SRC = 2120, NA_PAD = 2304, NB = 3072, FF = 2816, NUP = 2 * FF;
constexpr float EPS = 1e-6f;
constexpr float LOG2E = 1.4426950408889634f;
constexpr float C2 = 0.125f * LOG2E;
constexpr int NBLK64 = MTOK / 64;

constexpr size_t MiB = 1u << 20;
constexpr size_t WS_CTL = 0, CTL_ZERO_BYTES = 1 * MiB;
constexpr size_t WS_W_INA = 2 * MiB;
constexpr size_t WS_W_INB = 11 * MiB;
constexpr size_t WS_W_OUT = 23 * MiB;
constexpr size_t WS_W_UP = 31 * MiB;
constexpr size_t WS_W_DN = 75 * MiB;
constexpr size_t WS_HB = 98 * MiB;
constexpr size_t WS_M = 162 * MiB;
constexpr size_t WS_SS = 226 * MiB;
constexpr size_t WS_HALO = 228 * MiB;
constexpr size_t WS_PROJ = 272 * MiB;
constexpr size_t WS_END = 464 * MiB;
constexpr size_t PA_QA = 0, PA_KA = 64 * MiB, PA_VA = 80 * MiB, PA_QI = 96 * MiB, PA_KI = 128 * MiB, PA_WI = 132 * MiB, PA_SEL = 136 * MiB;
constexpr size_t PB_STRIDE = 64 * MiB;
constexpr int CW_BAR = 4096;

constexpr int RING_OFF = 0, RING_BYTES = 131072;
constexpr int KS_OFF = RING_BYTES;
constexpr int AUX_OFF = RING_BYTES + 24576;
constexpr int LDSCTL_OFF = AUX_OFF + 4096, MISC_OFF = LDSCTL_OFF + 320;
constexpr int LDS_BYTES = 163840;
static_assert(MISC_OFF + 128 <= LDS_BYTES, "LDS map");

#define GAS __attribute__((address_space(1)))
#define LAS __attribute__((address_space(3)))
typedef unsigned short bf16;
typedef unsigned v4u __attribute__((ext_vector_type(4)));
typedef unsigned v2u __attribute__((ext_vector_type(2)));
typedef float f32x4 __attribute__((ext_vector_type(4)));
typedef float f32x16 __attribute__((ext_vector_type(16)));
typedef short bf16x8 __attribute__((ext_vector_type(8)));
typedef short s16x4 __attribute__((ext_vector_type(4)));
typedef float f32x2_t __attribute__((ext_vector_type(2)));
typedef GAS unsigned gu32;
#define RLX_AGENT __ATOMIC_RELAXED, __HIP_MEMORY_SCOPE_AGENT
#define LDS_WAIT() asm volatile("s_waitcnt lgkmcnt(0)" ::: "memory")
#define VM_WAIT() asm volatile("s_waitcnt vmcnt(0)" ::: "memory")
__device__ __forceinline__ unsigned f2bf(float f) { unsigned u = __builtin_bit_cast(unsigned, f); return (u + 0x7fffu + ((u >> 16) & 1u)) >> 16; }
__device__ __forceinline__ unsigned pk2(float lo, float hi) { return f2bf(lo) | (f2bf(hi) << 16); }
typedef float f32x2c_t __attribute__((ext_vector_type(2))); typedef __bf16 bf16x2c_t __attribute__((ext_vector_type(2)));
__device__ __forceinline__ unsigned cvtpk(float lo, float hi) { const f32x2c_t v = {lo, hi}; const bf16x2c_t b = __builtin_convertvector(v, bf16x2c_t); return __builtin_bit_cast(unsigned, b); }
__device__ __forceinline__ float bf_lo(unsigned u) { return __builtin_bit_cast(float, u << 16); }
__device__ __forceinline__ float bf_hi(unsigned u) { return __builtin_bit_cast(float, u & 0xffff0000u); }

#define XB_TMO      128
#define XB_XCNT(j)  (256  + 64 * (j))
#define XB_XSUB(j)  (1280 + 64 * (j))
#define XB_XGEN(j)  (2304 + 64 * (j))
#define XB_TOP      3328
#define XB_TOPGEN   3392
#define XCD_BAR_WORDS 3456
#define XB_SPIN_CAP (1u << 18)

__device__ __forceinline__ unsigned xb_ld(unsigned* p)              { return __hip_atomic_load(p, __ATOMIC_RELAXED, __HIP_MEMORY_SCOPE_AGENT); }
__device__ __forceinline__ unsigned xb_add(unsigned* p, unsigned v) { return __hip_atomic_fetch_add(p, v, __ATOMIC_RELAXED, __HIP_MEMORY_SCOPE_AGENT); }
__device__ __forceinline__ unsigned xb_xcc_id() { return (unsigned)__builtin_amdgcn_s_getreg((3 << 11) | 20) & 0xFu; }
#define XB_SPIN(cond, bar) do { unsigned _sp = 0; while (cond) { __builtin_amdgcn_s_sleep(1); \
    if ((++_sp & 255u) == 0u) { if (xb_ld(&(bar)[XB_TMO])) break; if (_sp > XB_SPIN_CAP) { atomicAdd(&(bar)[XB_TMO], 1u); break; } } } } while (0)

struct XcdBarrier {
    unsigned* bar; unsigned x;
    volatile LAS unsigned* st;
};

__device__ __forceinline__ XcdBarrier xcd_barrier_post(unsigned* bar, volatile LAS unsigned* st) {
    XcdBarrier b; b.bar = bar; b.x = xb_xcc_id(); b.st = st;
    if (threadIdx.x == 0) (void)xb_add(&bar[XB_XCNT(b.x)], 1u);
    return b;
}
__device__ __forceinline__ void xcd_barrier_complete(unsigned* bar, unsigned x, unsigned& nloc, unsigned& nx) {
    const unsigned G = gridDim.x * gridDim.y * gridDim.z;
    unsigned sum, cnt, mine, sp = 0u;
    for (;;) {
        sum = 0u; cnt = 0u; mine = 0u;
#pragma unroll
        for (unsigned j = 0; j < 16; ++j) { const unsigned c = xb_ld(&bar[XB_XCNT(j)]); sum += c; cnt += (c > 0u) ? 1u : 0u; mine = (j == x) ? c : mine; }
        if (sum == G) break;
        __builtin_amdgcn_s_sleep(1);
        if ((++sp & 255u) == 0u) { if (xb_ld(&bar[XB_TMO])) break; if (sp > XB_SPIN_CAP) { atomicAdd(&bar[XB_TMO], 1u); break; } }
    }
    nloc = mine > 0u ? mine : 1u; nx = cnt > 0u ? cnt : 1u;
}

__device__ __forceinline__ void xcd_barrier(const XcdBarrier& b) {
    asm volatile("s_waitcnt vmcnt(0)" ::: "memory");
    __syncthreads();
    if (threadIdx.x == 0) {
        unsigned* bar = b.bar;
        __builtin_amdgcn_s_waitcnt(0);
        unsigned nloc = b.st[0], nx = b.st[1];
        if (nloc == 0u) { xcd_barrier_complete(bar, b.x, nloc, nx); b.st[0] = nloc; b.st[1] = nx; }
        const unsigned old = xb_add(&bar[XB_XSUB(b.x)], 1u);
        const unsigned gen = old / nloc;
        if (old + 1u == (gen + 1u) * nloc) {
            __builtin_amdgcn_fence(__ATOMIC_RELEASE, "agent");
            asm volatile("s_waitcnt vmcnt(0)" ::: "memory");
            const unsigned og = xb_add(&bar[XB_TOP], 1u);
            const unsigned tg = og / nx;
            if (og + 1u == (tg + 1u) * nx) xb_add(&bar[XB_TOPGEN], 1u);
            else XB_SPIN(xb_ld(&bar[XB_TOPGEN]) == tg, bar);
            __builtin_amdgcn_fence(__ATOMIC_ACQUIRE, "agent");
            xb_add(&bar[XB_XGEN(b.x)], 1u);
            asm volatile("s_waitcnt vmcnt(0)" ::: "memory");
        } else {
            XB_SPIN(xb_ld(&bar[XB_XGEN(b.x)]) == gen, bar);
            __builtin_amdgcn_fence(__ATOMIC_ACQUIRE, "agent");
            asm volatile("s_waitcnt vmcnt(0)" ::: "memory");
        }
    }
    __syncthreads();
}


struct Args {
    const float* x; const float* attn_norm_g; const float* w_in_a; const float* w_in_b; const float* q_norm_g; const float* k_norm_g; const float* t5_bias;
    const float* rel_bias_b; const float* w_out; const float* ffn_norm_g; const float* w_up; const float* conv_w; const float* conv_b; const float* w_down;
    float* out; unsigned char* ws; int ph_lo, ph_hi, li, pad;
};

struct Frame {
    LAS unsigned char* lds;
    volatile LAS unsigned* MISC;
    gu32* ctl;
    int tid, lane, wave, vcu, G;
};

__host__ __device__ __forceinline__ int hmap(int p) { return 64 * ((p >> 5) & 3) + 16 * ((p >> 2) & 3) + 8 * (p >> 7) + 4 * ((p >> 4) & 1) + (p & 3); }
__host__ __device__ __forceinline__ int umap(int p) { return 32 * ((p >> 5) & 3) + 8 * ((p >> 2) & 3) + 4 * ((p >> 4) & 1) + (p & 3); }
__host__ __device__ __forceinline__ int src_col(int type, int n) {
    if (type == 0) return n;
    const int pn = n >> 8, p = n & 255;
    if (type == 2) return 256 * pn + hmap(p);
    if (type == 1) { const int c = hmap(p); return pn < 8 ? 256 * pn + c : (c < 72 ? 2048 + c : -1); }
    return (p >> 7) * FF + 128 * pn + umap(p);
}
__device__ __forceinline__ void convert_item(const float* W, int K, int Nsrc, int Ndst, int type, const float* gain, bf16* WT, LAS float* scr, int item, int lane) {
    const int nblk = Ndst / 32, kb = item / nblk, nb = item % nblk, k0 = 64 * kb, n0 = 32 * nb;
    const int sc = src_col(type, n0 + (lane & 31));
#pragma unroll 8
    for (int i = 0; i < 32; ++i) { const int kk = 2 * i + (lane >> 5); float v = 0.f; if (sc >= 0) v = W[(size_t)(k0 + kk) * Nsrc + sc]; if (gain) v *= gain[k0 + kk]; scr[kk * 33 + (lane & 31)] = v; }
    LDS_WAIT(); asm volatile("" ::: "memory");
    const int c = lane & 7;
#pragma unroll
    for (int j = 0; j < 4; ++j) { const int n = (lane >> 3) + 8 * j; const LAS float* s = scr + (8 * c) * 33 + n;
        v4u o; o.x = pk2(s[0 * 33], s[1 * 33]); o.y = pk2(s[2 * 33], s[3 * 33]); o.z = pk2(s[4 * 33], s[5 * 33]); o.w = pk2(s[6 * 33], s[7 * 33]);
        *(v4u*)(WT + (size_t)(n0 + n) * K + k0 + 8 * c) = o; }
    LDS_WAIT(); asm volatile("" ::: "memory");
}
__device__ __forceinline__ float wave_sum(float v) {
#pragma unroll
    for (int o = 1; o < 64; o <<= 1) v += __shfl_xor(v, o);
    return v;
}
__device__ __forceinline__ void p0_prologue(Frame& F, const Args& a) {
    LAS float* scr = (LAS float*)(F.lds + RING_OFF + F.wave * 16384);
    const int gw = F.vcu * NWAVES + F.wave, NGW = F.G * NWAVES;
    constexpr int I_INA = 16 * (NA_PAD / 32), I_INB = 16 * (NB / 32), I_OUT = 16 * 32, I_UP = 16 * (NUP / 32), I_DN = (FF / 64) * 32;
    constexpr int NITEMS = 2 * I_INA + 2 * I_INB + 4 * I_OUT + 4 * I_UP + 4 * I_DN;
    unsigned char* ws = a.ws;
    for (int it = gw; it < NITEMS; it += NGW) {
        int r = it;
        if (r < 2 * I_INA) { const int l = r / I_INA; convert_item(a.w_in_a + (size_t)l * DM * NA_SRC, DM, NA_SRC, NA_PAD, 1, a.attn_norm_g + (2 * l) * DM, (bf16*)(ws + WS_W_INA) + (size_t)l * NA_PAD * DM, scr, r % I_INA, F.lane); continue; } r -= 2 * I_INA;
        if (r < 2 * I_INB) { const int l = r / I_INB; convert_item(a.w_in_b + (size_t)l * DM * NB, DM, NB, NB, 2, a.attn_norm_g + (2 * l + 1) * DM, (bf16*)(ws + WS_W_INB) + (size_t)l * NB * DM, scr, r % I_INB, F.lane); continue; } r -= 2 * I_INB;
        if (r < 4 * I_OUT) { const int l = r / I_OUT; convert_item(a.w_out + (size_t)l * DM * DM, DM, DM, DM, 0, nullptr, (bf16*)(ws + WS_W_OUT) + (size_t)l * DM * DM, scr, r % I_OUT, F.lane); continue; } r -= 4 * I_OUT;
        if (r < 4 * I_UP) { const int l = r / I_UP; convert_item(a.w_up + (size_t)l * DM * NUP, DM, NUP, NUP, 3, a.ffn_norm_g + l * DM, (bf16*)(ws + WS_W_UP) + (size_t)l * NUP * DM, scr, r % I_UP, F.lane); continue; } r -= 4 * I_UP;
        { const int l = r / I_DN; convert_item(a.w_down + (size_t)l * FF * DM, FF, DM, DM, 0, nullptr, (bf16*)(ws + WS_W_DN) + (size_t)l * DM * FF, scr, r % I_DN, F.lane); }
    }
    bf16* hb = (bf16*)(ws + WS_HB); float* ss = (float*)(ws + WS_SS);
    for (int m = gw; m < MTOK; m += NGW) {
        const f32x4* xr = (const f32x4*)(a.x + (size_t)m * DM) + F.lane; f32x4 v[4]; float s = 0.f;
#pragma unroll
        for (int j = 0; j < 4; ++j) { v[j] = xr[64 * j]; s += (v[j].x * v[j].x + v[j].y * v[j].y) + (v[j].z * v[j].z + v[j].w * v[j].w); }
        s = wave_sum(s);
        v2u* o8 = (v2u*)(hb + (size_t)m * DM) + F.lane;
#pragma unroll
        for (int j = 0; j < 4; ++j) { v2u w; w.x = pk2(v[j].x, v[j].y); w.y = pk2(v[j].z, v[j].w); o8[64 * j] = w; }
        if (F.lane < 16) ss[(size_t)m * 16 + F.lane] = (F.lane == 0) ? s : 0.f;
    }
}

__device__ __forceinline__ f32x4 rstd_load(const float* ss, int row, int fq) { return *(const f32x4*)(ss + (size_t)row * 16 + 4 * fq); }
__device__ __forceinline__ float rstd_finish(f32x4 a) {
    float s = (a.x + a.y) + (a.z + a.w);
    s += __shfl_xor(s, 16); s += __shfl_xor(s, 32);
    return __builtin_amdgcn_rsqf(s * (1.0f / DM) + EPS);
}
__device__ __forceinline__ float row_rstd(const float* ss, int row, int fq) { return rstd_finish(rstd_load(ss, row, fq)); }
__device__ __forceinline__ unsigned att_pk4(f32x4 v) { int r = __builtin_amdgcn_cvt_pk_fp8_f32(v.x, v.y, 0, false); r = __builtin_amdgcn_cvt_pk_fp8_f32(v.z, v.w, r, true); return (unsigned)r; }
struct EpiIn {
    static constexpr bool PERM = false, PERMA = false, AFTER_DRAIN = false;
    const float* ss; unsigned char* proj; const float* qg; const float* kg; int isB;
    __device__ __forceinline__ void operator()(const pg8::f32x4 (&acc)[2][2][4][2], const pg8::Unit& u, int wr, int wc, int fr, int fq) const {
        asm volatile("" : "+v"(fr), "+v"(fq));
        const int pn = u.pn; int kind, pitch; bf16* dst;
        if (isB) { const int t = pn >> 2; kind = (t == 0) ? 1 : (t == 1 ? 2 : 0); dst = (bf16*)(proj + (size_t)t * PB_STRIDE) + 256 * (pn & 3); pitch = DM; }
        else if (pn < 4) { kind = 1; dst = (bf16*)(proj + PA_QA) + 256 * pn; pitch = DM; }
        else if (pn == 4) { kind = 2; dst = (bf16*)(proj + PA_KA); pitch = 256; }
        else if (pn == 5) { kind = 0; dst = (bf16*)(proj + PA_VA); pitch = 256; }
        else if (pn < 8) { kind = 0; dst = (bf16*)(proj + PA_QI) + 256 * (pn - 6); pitch = 512; }
        else { kind = 3; dst = (bf16*)(proj + PA_KI); pitch = 64; }
        if (kind == 3 && wc >= 2) return;
        const bool donorm = (kind == 1) || (kind == 2) || (kind == 3 && wc == 0);
        f32x4 g[2][2];
#pragma unroll
        for (int bj = 0; bj < 2; ++bj)
#pragma unroll
            for (int n = 0; n < 2; ++n) {
                if (kind == 1) g[bj][n] = *(const f32x4*)(qg + 16 * fq + 8 * bj + 4 * n) * (isB ? C2 : 1.0f);
                else if (kind == 2) g[bj][n] = *(const f32x4*)(kg + 16 * fq + 8 * bj + 4 * n);
                else g[bj][n] = (f32x4){1.f, 1.f, 1.f, 1.f};
            }
        float* wi = (float*)(proj + PA_WI);
        f32x4 rsl[2][4];
#pragma unroll
        for (int ai = 0; ai < 2; ++ai)
#pragma unroll
            for (int m = 0; m < 4; ++m) rsl[ai][m] = rstd_load(ss, u.pm * 256 + ai * 128 + wr * 64 + m * 16 + fr, fq);
#pragma unroll
        for (int ai = 0; ai < 2; ++ai)
#pragma unroll
            for (int m = 0; m < 4; ++m) {
                const int row = u.pm * 256 + ai * 128 + wr * 64 + m * 16 + fr;
                const float rs = rstd_finish(rsl[ai][m]);
                f32x4 v[2][2]; float s = 0.f;
#pragma unroll
                for (int bj = 0; bj < 2; ++bj)
#pragma unroll
                    for (int n = 0; n < 2; ++n) { v[bj][n] = acc[ai][bj][m][n] * rs; const f32x4 q = v[bj][n] * v[bj][n]; s += (q.x + q.y) + (q.z + q.w); }
                if (donorm) {
                    s += __shfl_xor(s, 16); s += __shfl_xor(s, 32);
                    const float r = 1.0f / sqrtf(s * (1.0f / 64.0f) + EPS);
#pragma unroll
                    for (int bj = 0; bj < 2; ++bj)
#pragma unroll
                        for (int n = 0; n < 2; ++n) v[bj][n] = v[bj][n] * r * g[bj][n];
                }
                if (kind == 3 && wc == 1) {
                    if (fq == 0) { float* wp = wi + (size_t)row * 8; const float sc = 0.04419417382415922f;
                        *(f32x4*)(wp) = v[0][0] * sc; *(f32x4*)(wp + 4) = v[0][1] * sc; }
                } else if (!isB && pn < 6) {
                    unsigned char* p8 = (pn < 4) ? proj + PA_QA + (size_t)row * 1024 + 256 * pn + 64 * wc + 16 * fq : proj + PA_KA + (size_t)row * 512 + 128 * wc + 64 * (pn - 4) + 16 * fq;
                    v4u w; w.x = att_pk4(v[0][0]); w.y = att_pk4(v[0][1]); w.z = att_pk4(v[1][0]); w.w = att_pk4(v[1][1]);
                    *(v4u*)p8 = w;
                } else {
                    bf16* rp = dst + (size_t)row * pitch + 64 * wc + 16 * fq;
#pragma unroll
                    for (int bj = 0; bj < 2; ++bj) { v4u w; w.x = cvtpk(v[bj][0].x, v[bj][0].y); w.y = cvtpk(v[bj][0].z, v[bj][0].w); w.z = cvtpk(v[bj][1].x, v[bj][1].y); w.w = cvtpk(v[bj][1].z, v[bj][1].w);
                        *(v4u*)(rp + 8 * bj) = w; }
                }
            }
    }
};
struct EpiRes {
    static constexpr bool PERM = false, PERMA = false, AFTER_DRAIN = false;
    const float* xin; float* fout; const bf16* hbi; bf16* hb; float* ss;
    __device__ __forceinline__ void operator()(const pg8::f32x4 (&acc)[2][2][4][2], const pg8::Unit& u, int wr, int wc, int fr, int fq) const {
        asm volatile("" : "+v"(fr), "+v"(fq));
        const int col0 = u.pn * 256 + wc * 32 + 4 * fq;
#pragma unroll
        for (int ai = 0; ai < 2; ++ai)
#pragma unroll
            for (int m = 0; m < 4; ++m) {
                const int row = u.pm * 256 + ai * 128 + wr * 64 + m * 16 + fr; const size_t off = (size_t)row * DM + col0; float s = 0.f;
#pragma unroll
                for (int bj = 0; bj < 2; ++bj)
#pragma unroll
                    for (int n = 0; n < 2; ++n) { const size_t o4 = off + bj * 128 + n * 16; f32x4 base;
                        if (xin) base = *(const f32x4*)(xin + o4); else { const v2u b = *(const v2u*)(hbi + o4); base = (f32x4){bf_lo(b.x), bf_hi(b.x), bf_lo(b.y), bf_hi(b.y)}; }
                        const f32x4 o = base + acc[ai][bj][m][n];
                        if (fout) *(f32x4*)(fout + o4) = o;
                        else { const f32x4 q = o * o; s += (q.x + q.y) + (q.z + q.w); v2u w; w.x = cvtpk(o.x, o.y); w.y = cvtpk(o.z, o.w); *(v2u*)(hb + o4) = w; } }
                if (!fout) { s += __shfl_xor(s, 16); s += __shfl_xor(s, 32); if (fq == 0) ss[(size_t)row * 16 + u.pn * 4 + wc] = s; }
            }
    }
};
#ifdef X_NOBPERM
__device__ __forceinline__ float lane_from(int byteaddr, float v) { return v + (float)byteaddr; }
#else
__device__ __forceinline__ float lane_from(int byteaddr, float v) { return __builtin_bit_cast(float, __builtin_amdgcn_ds_bpermute(byteaddr, __builtin_bit_cast(int, v))); }
#endif
#ifdef X_NOSILU
__device__ __forceinline__ float silu_mul(float a, float g) { return a * g; }
#else
__device__ __forceinline__ float silu_mul(float a, float g) { return a * g * __builtin_amdgcn_rcpf(1.0f + __builtin_amdgcn_exp2f(-g * LOG2E)); }
#endif
__device__ __forceinline__ float dpp_prev_lane(float v) { return __builtin_bit_cast(float, __builtin_amdgcn_update_dpp(0, __builtin_bit_cast(int, v), 0x111  , 0xf, 0xf, true)); }
struct EpiUp {
    static constexpr bool PERM = false, PERMA = true, AFTER_DRAIN = false;
    const float* ss; const float* cw; const float* cb; bf16* act; float* halo; LAS float* cl;
    __device__ __forceinline__ void operator()(const pg8::f32x4 (&acc)[2][2][4][2], const pg8::Unit& u, int wr, int wc, int fr, int fq) const {
        asm volatile("" : "+v"(fr), "+v"(fq));
        const int colb = u.pn * 128 + wc * 32 + 8 * fq;
        const int tid_ = ((wr * 4 + wc) * 4 + fq) * 16 + fr, ce = 2 * tid_, cbj = ce >> 9, carr = (ce >> 7) & 3, cc = ce & 127;
        const f32x2_t cpre = *(const f32x2_t*)((carr < 3 ? cw + carr * NUP : cb) + cbj * FF + u.pn * 128 + cc);
        f32x4 rsl[2][4];
#pragma unroll
        for (int ai = 0; ai < 2; ++ai)
#pragma unroll
            for (int m = 0; m < 4; ++m) rsl[ai][m] = rstd_load(ss, (u.pm * 4 + ai * 2 + wr) * 64 + 4 * fr + m, fq);
        unsigned pk[2][2][4][2][2];
#pragma unroll
        for (int ai = 0; ai < 2; ++ai) {
#pragma unroll
            for (int m = 0; m < 4; ++m) {
                const float rs = rstd_finish(rsl[ai][m]);
#pragma unroll
                for (int bj = 0; bj < 2; ++bj)
#pragma unroll
                    for (int n = 0; n < 2; ++n) { const f32x4 v = acc[ai][bj][m][n] * rs; pk[ai][bj][m][n][0] = cvtpk(v.x, v.y); pk[ai][bj][m][n][1] = cvtpk(v.z, v.w); }
            }
        }
        *(LAS f32x2_t*)(cl + ce) = cpre;
        asm volatile("s_waitcnt lgkmcnt(0)" ::: "memory"); __builtin_amdgcn_s_barrier(); asm volatile("" ::: "memory");
        __builtin_amdgcn_sched_barrier(0);
        if (fr == 0 || fr == 15) {
#pragma unroll
            for (int ai = 0; ai < 2; ++ai)
#pragma unroll
                for (int j = 0; j < 2; ++j)
#pragma unroll
                    for (int bj = 0; bj < 2; ++bj)
#pragma unroll
                        for (int n = 0; n < 2; ++n) { const unsigned w0 = (fr == 0) ? pk[ai][bj][j][n][0] : pk[ai][bj][2 + j][n][0], w1 = (fr == 0) ? pk[ai][bj][j][n][1] : pk[ai][bj][2 + j][n][1];
                            *(f32x4*)(halo + ((size_t)(u.pm * 4 + ai * 2 + wr) * 4 + (fr == 0 ? j : 2 + j)) * NUP + bj * FF + colb + 4 * n) = (f32x4){bf_lo(w0), bf_hi(w0), bf_lo(w1), bf_hi(w1)}; }
        }
        __builtin_amdgcn_sched_barrier(0);
#pragma unroll
        for (int ai = 0; ai < 2; ++ai) {
            const int row0 = (u.pm * 4 + ai * 2 + wr) * 64 + 4 * fr;
            unsigned outp[4][2][2];
#pragma unroll
            for (int n = 0; n < 2; ++n) {
#pragma unroll
                for (int ip = 0; ip < 2; ++ip) {
                    f32x2_t k0[2], k1[2], k2[2], kb[2];
#pragma unroll
                    for (int bj = 0; bj < 2; ++bj) { const LAS float* c = cl + bj * 512 + wc * 32 + 8 * fq + 4 * n + 2 * ip; k0[bj] = *(const LAS f32x2_t*)(c); k1[bj] = *(const LAS f32x2_t*)(c + 128); k2[bj] = *(const LAS f32x2_t*)(c + 256); kb[bj] = *(const LAS f32x2_t*)(c + 384); }
                    float y[2][4][2];
#pragma unroll
                    for (int bj = 0; bj < 2; ++bj) {
                        const unsigned w0 = pk[ai][bj][0][n][ip], w1 = pk[ai][bj][1][n][ip], w2 = pk[ai][bj][2][n][ip], w3 = pk[ai][bj][3][n][ip];
                        const unsigned q1 = (unsigned)__builtin_amdgcn_update_dpp(0, (int)w3, 0x111, 0xf, 0xf, true), q2 = (unsigned)__builtin_amdgcn_update_dpp(0, (int)w2, 0x111, 0xf, 0xf, true);
#pragma unroll
                        for (int e = 0; e < 2; ++e) { const int i = e;
                            const float u0 = e ? bf_hi(w0) : bf_lo(w0), u1 = e ? bf_hi(w1) : bf_lo(w1), u2 = e ? bf_hi(w2) : bf_lo(w2), u3 = e ? bf_hi(w3) : bf_lo(w3), p1 = e ? bf_hi(q1) : bf_lo(q1), p2 = e ? bf_hi(q2) : bf_lo(q2);
                            y[bj][0][e] = kb[bj][i] + k0[bj][i] * p2 + k1[bj][i] * p1 + k2[bj][i] * u0;
                            y[bj][1][e] = kb[bj][i] + k0[bj][i] * p1 + k1[bj][i] * u0 + k2[bj][i] * u1;
                            y[bj][2][e] = kb[bj][i] + k0[bj][i] * u0 + k1[bj][i] * u1 + k2[bj][i] * u2;
                            y[bj][3][e] = kb[bj][i] + k0[bj][i] * u1 + k1[bj][i] * u2 + k2[bj][i] * u3; }
                    }
#pragma unroll
                    for (int m = 0; m < 4; ++m) outp[m][n][ip] = cvtpk(silu_mul(y[0][m][0], y[1][m][0]), silu_mul(y[0][m][1], y[1][m][1]));
                }
            }
#pragma unroll
            for (int m = 0; m < 4; ++m) {
                if (m < 2 && fr == 0) continue;
                v4u w; w.x = outp[m][0][0]; w.y = outp[m][0][1]; w.z = outp[m][1][0]; w.w = outp[m][1][1];
                *(v4u*)(act + (size_t)(row0 + m) * FF + colb) = w;
            }
            asm volatile("" ::: "memory");
        }
    }
};
struct EpiDummy {
    static constexpr bool PERM = false, PERMA = true, AFTER_DRAIN = false;
    float* scratch;
    __device__ __forceinline__ void operator()(const pg8::f32x4 (&acc)[2][2][4][2], const pg8::Unit& u, int wr, int wc, int fr, int fq) const {
        f32x4 s = (f32x4){0.f, 0.f, 0.f, 0.f};
#pragma unroll
        for (int ai = 0; ai < 2; ++ai)
#pragma unroll
            for (int bj = 0; bj < 2; ++bj)
#pragma unroll
                for (int m = 0; m < 4; ++m)
#pragma unroll
                    for (int n = 0; n < 2; ++n) s += acc[ai][bj][m][n];
        scratch[(size_t)(u.pm * 22 + u.pn) * 512 + ((wr * 4 + wc) * 4 + fq) * 16 + fr] = (s.x + s.y) + (s.z + s.w);
    }
};
__device__ __forceinline__ void fixup_phase(Frame& F, const float* cw, const float* cb, const float* halo, bf16* act) {
    const int gt = F.vcu * (NWAVES * 64) + F.tid, NT = F.G * NWAVES * 64;
    constexpr int C4 = FF / 4;
    for (int it = gt; it < NBLK64 * 2 * C4; it += NT) {
        const int c = (it % C4) * 4, rj = it / C4, j = rj & 1, blk = rj >> 1, t = blk * 64 + j, tb = t % SEQ;
        f32x4 y[2];
#pragma unroll
        for (int bj = 0; bj < 2; ++bj) {
            const int cc = bj * FF + c;
            const f32x4 z = (f32x4){0.f, 0.f, 0.f, 0.f};
            const f32x4 ut = *(const f32x4*)(halo + ((size_t)blk * 4 + j) * NUP + cc);
            f32x4 u1, u2;
            if (j == 1) { u1 = *(const f32x4*)(halo + ((size_t)blk * 4 + 0) * NUP + cc); u2 = (tb == 1) ? z : *(const f32x4*)(halo + ((size_t)(blk - 1) * 4 + 3) * NUP + cc); }
            else { u1 = (tb == 0) ? z : *(const f32x4*)(halo + ((size_t)(blk - 1) * 4 + 3) * NUP + cc); u2 = (tb == 0) ? z : *(const f32x4*)(halo + ((size_t)(blk - 1) * 4 + 2) * NUP + cc); }
            y[bj] = *(const f32x4*)(cb + cc) + *(const f32x4*)(cw + cc) * u2 + *(const f32x4*)(cw + NUP + cc) * u1 + *(const f32x4*)(cw + 2 * NUP + cc) * ut;
        }
        v2u w; w.x = cvtpk(silu_mul(y[0].x, y[1].x), silu_mul(y[0].y, y[1].y)); w.y = cvtpk(silu_mul(y[0].z, y[1].z), silu_mul(y[0].w, y[1].w));
        *(v2u*)(act + (size_t)t * FF + c) = w;
    }
}

__device__ __forceinline__ int crow(int r, int hi) { return (r & 3) + 8 * (r >> 2) + 4 * hi; }
__device__ __forceinline__ void glds16(const void* gsrc, unsigned lds_dst) { unsigned keep;
    asm volatile("s_mov_b32 %0, m0\n\ts_mov_b32 m0, %2\n\ts_nop 0\n\tglobal_load_lds_dwordx4 %1, off\n\ts_mov_b32 m0, %0" : "=&s"(keep) : "v"(gsrc), "s"(lds_dst) : "memory"); }
__device__ __forceinline__ float max3f(float a, float b, float c) { return fmaxf(fmaxf(a, b), c); }

namespace band {
constexpr int SLOTB = 8192;
constexpr int LDS_K = 0, LDS_V = 2 * SLOTB, LDS_WS = 4 * SLOTB, LDS_TB = LDS_WS + NWAVES * 64 * 4, LDS_OST = LDS_TB + 640 * 4 + 512, LDS_END = LDS_OST + NWAVES * 4096;
static_assert(LDS_END <= RING_BYTES, "band LDS");
__device__ __forceinline__ void unit(Frame& F, int b, int h, int U, const bf16* Q, const bf16* K, const bf16* V, bf16* O, const float* rel) {
    const int tid = F.tid, lane = F.lane, r32 = lane & 31, hi = lane >> 5, wid = F.wave;
    LAS unsigned char* shm = F.lds + RING_OFF;
    const unsigned lds0 = (unsigned)(uintptr_t)shm;
    const long rowbase = (long)b * SEQ; const int q0 = U * 256, c0 = 4 * U, cq = c0 + (wid >> 1);
    const bf16* Qw = Q + (rowbase + q0 + wid * 32) * DM + h * 64;
    const bf16* Kh = K + rowbase * DM + h * 64; const bf16* Vh = V + rowbase * DM + h * 64;
    LAS float* wsf = (LAS float*)(shm + LDS_WS) + wid * 64;
    LAS float* tb = (LAS float*)(shm + LDS_TB);
    const bf16* ksrc = Kh + (long)lane * DM + wid * 8;
    const bf16* vsrc = Vh + (long)(16 * (wid & 3) + (lane >> 2)) * DM + (wid >> 2) * 32 + (lane & 3) * 8;
    const unsigned kdst = lds0 + LDS_K + wid * 1024, vdst = lds0 + LDS_V + wid * 1024;
    const int lo = (c0 - 8 > 0) ? c0 - 8 : 0, hiT = c0 + 3, NT = hiT - lo + 1, t0 = (c0 - 5 > 0) ? c0 - 5 : 0;
#define BAND_KT(i) ((t0 + (i) <= hiT) ? t0 + (i) : lo + (t0 + (i) - hiT - 1))
    for (int i = tid; i < 640; i += NWAVES * 64) { int d = i - 64; d = d < -256 ? -256 : (d > 256 ? 256 : d); tb[i] = rel[(d + 256) * 16 + h] * LOG2E; }
    { const int kt = BAND_KT(0); glds16(ksrc + (long)kt * 64 * DM, (unsigned)__builtin_amdgcn_readfirstlane(kdst)); glds16(vsrc + (long)kt * 64 * DM, (unsigned)__builtin_amdgcn_readfirstlane(vdst)); }
    bf16x8 qr[4];
#pragma unroll
    for (int d0 = 0; d0 < 4; ++d0) qr[d0] = *(const bf16x8*)(Qw + (long)r32 * DM + d0 * 16 + hi * 8);
    float m_run = -INFINITY, l_run = 0.f; f32x16 o[2]; o[0] = f32x16{}; o[1] = f32x16{};
    const int qpos = q0 + wid * 32 + r32;
    const LAS unsigned char* vbase = shm + LDS_V + ((lane >> 4) & 1) * 32 + (lane & 3) * 8 + (4 * hi + ((lane & 15) >> 2)) * 64;
    for (int i = 0; i < NT; ++i) {
        asm volatile("s_waitcnt vmcnt(0) lgkmcnt(0)\n\ts_barrier" ::: "memory");
        if (i + 1 < NT) { const int kt = BAND_KT(i + 1); const unsigned so = ((i + 1) & 1) * SLOTB;
            glds16(ksrc + (long)kt * 64 * DM, (unsigned)__builtin_amdgcn_readfirstlane(kdst + so)); glds16(vsrc + (long)kt * 64 * DM, (unsigned)__builtin_amdgcn_readfirstlane(vdst + so)); }
        const int kt = BAND_KT(i);
        if (kt < cq - 8 || kt > cq) continue;
        const int so = (i & 1) * SLOTB;
        f32x16 p0 = f32x16{}, p1 = f32x16{};
        { const LAS unsigned char* kb = shm + LDS_K + so + hi * 1024 + r32 * 16;
#pragma unroll
          for (int d0 = 0; d0 < 4; ++d0) { const bf16x8 b0 = *(const LAS bf16x8*)(kb + d0 * 2048), b1 = *(const LAS bf16x8*)(kb + d0 * 2048 + 512);
              p0 = __builtin_amdgcn_mfma_f32_32x32x16_bf16(b0, qr[d0], p0, 0, 0, 0); p1 = __builtin_amdgcn_mfma_f32_32x32x16_bf16(b1, qr[d0], p1, 0, 0, 0); } }
        if (kt + 5 <= cq) { const float cbias = tb[639];
#pragma unroll
          for (int r = 0; r < 16; ++r) { p0[r] += cbias; p1[r] += cbias; } }
        else { const int ib = qpos - 64 * kt + 64 - 4 * hi;
#pragma unroll
          for (int r = 0; r < 16; ++r) { const int ix = ib - ((r & 3) + 8 * (r >> 2)); p0[r] += tb[ix]; p1[r] += tb[ix - 32]; } }
        float rm = p0[0];
#pragma unroll
        for (int r = 0; r < 16; ++r) rm = max3f(rm, p0[r], p1[r]);
        { auto rr = __builtin_amdgcn_permlane32_swap(__float_as_uint(rm), __float_as_uint(rm), false, false); rm = fmaxf(__uint_as_float(rr[0]), __uint_as_float(rr[1])); }
        const float mnew = fmaxf(m_run, rm), f = __builtin_amdgcn_exp2f(m_run - mnew); m_run = mnew;
        float sacc = 0.f;
#pragma unroll
        for (int r = 0; r < 16; ++r) { p0[r] = __builtin_amdgcn_exp2f(p0[r] - mnew); p1[r] = __builtin_amdgcn_exp2f(p1[r] - mnew); sacc += p0[r] + p1[r]; }
        l_run = l_run * f + sacc;
        if (!__all(f == 1.0f)) {
            if (hi == 0) wsf[r32] = f;
            LDS_WAIT();
#pragma unroll
            for (int r = 0; r < 16; ++r) { const float fr_ = wsf[crow(r, hi)]; o[0][r] *= fr_; o[1][r] *= fr_; }
        }
        v4u pw[4];
        pw[0] = (v4u){cvtpk(p0[0], p0[1]), cvtpk(p0[2], p0[3]), cvtpk(p0[4], p0[5]), cvtpk(p0[6], p0[7])};
        pw[1] = (v4u){cvtpk(p0[8], p0[9]), cvtpk(p0[10], p0[11]), cvtpk(p0[12], p0[13]), cvtpk(p0[14], p0[15])};
        pw[2] = (v4u){cvtpk(p1[0], p1[1]), cvtpk(p1[2], p1[3]), cvtpk(p1[4], p1[5]), cvtpk(p1[6], p1[7])};
        pw[3] = (v4u){cvtpk(p1[8], p1[9]), cvtpk(p1[10], p1[11]), cvtpk(p1[12], p1[13]), cvtpk(p1[14], p1[15])};
        const LAS unsigned char* vb = vbase + so;
#pragma unroll
        for (int d0 = 0; d0 < 2; ++d0)
#pragma unroll
            for (int ks = 0; ks < 4; ++ks) {
                const s16x4 vlo = __builtin_bit_cast(s16x4, __builtin_amdgcn_ds_read_tr16_b64_v4i16((LAS s16x4*)(vb + d0 * 4096 + ks * 1024)));
                const s16x4 vhi = __builtin_bit_cast(s16x4, __builtin_amdgcn_ds_read_tr16_b64_v4i16((LAS s16x4*)(vb + d0 * 4096 + ks * 1024 + 512)));
                const bf16x8 vf = (bf16x8){vlo[0], vlo[1], vlo[2], vlo[3], vhi[0], vhi[1], vhi[2], vhi[3]};
                o[d0] = __builtin_amdgcn_mfma_f32_32x32x16_bf16(__builtin_bit_cast(bf16x8, pw[ks]), vf, o[d0], 0, 0, 0);
            }
    }
#undef BAND_KT
    { auto rr = __builtin_amdgcn_permlane32_swap(__float_as_uint(l_run), __float_as_uint(l_run), false, false); l_run = __uint_as_float(rr[0]) + __uint_as_float(rr[1]); }
    if (hi == 0) wsf[32 + r32] = l_run;
    LDS_WAIT();
    float rli[16];
#pragma unroll
    for (int r = 0; r < 16; ++r) rli[r] = __builtin_amdgcn_rcpf(wsf[32 + crow(r, hi)]);
    bf16* Ow = O + (rowbase + q0 + wid * 32) * DM + h * 64;
    { LAS bf16* stg = (LAS bf16*)(shm + LDS_OST) + wid * 2048;
#pragma unroll
      for (int r = 0; r < 16; ++r) { const int orow = crow(r, hi);
#pragma unroll
          for (int d0 = 0; d0 < 2; ++d0) stg[orow * 64 + d0 * 32 + r32] = (bf16)f2bf(o[d0][r] * rli[r]); }
      LDS_WAIT();
#pragma unroll
      for (int i = 0; i < 4; ++i) { const int row = i * 8 + (lane >> 3), ch = lane & 7; const v4u v = *(const LAS v4u*)(stg + row * 64 + ch * 8); *(v4u*)(Ow + (long)row * DM + ch * 8) = v; } }
    asm volatile("s_waitcnt lgkmcnt(0)\n\ts_barrier" ::: "memory");
}
__device__ __forceinline__ void phase(Frame& F, const bf16* Q, const bf16* K, const bf16* V, bf16* O, const float* rel) {
    const int NU = BATCH * 16 * 32, per = (NU + F.G - 1) / F.G;
    for (int i = 0; i < per; ++i) { const int uid = F.vcu * per + i; if (uid >= NU) break; unit(F, uid >> 9, (uid >> 5) & 15, uid & 31, Q, K, V, O, rel); }
}
}

namespace dsa {
__device__ __forceinline__ unsigned okey(float s) { const unsigned u = __float_as_uint(s + 0.0f); return (u & 0x80000000u) ? ~u : (u | 0x80000000u); }
struct Ctx { const bf16* QA; const bf16* KA; const bf16* VA; const bf16* QI; const bf16* KI; const float* WI; bf16* M; const LAS float* t5l; unsigned short* SEL; };

__device__ __forceinline__ void scan_hist(const LAS unsigned* hq, int lane, unsigned need, unsigned& bin, unsigned& above) {
    const LAS v4u* hp = (const LAS v4u*)hq + lane * 4;
    unsigned wds[16];
#pragma unroll
    for (int j = 0; j < 4; ++j) { const v4u t = hp[j]; wds[4 * j] = t.x; wds[4 * j + 1] = t.y; wds[4 * j + 2] = t.z; wds[4 * j + 3] = t.w; }
    unsigned tl = 0;
#pragma unroll
    for (int j = 0; j < 16; ++j) tl += (wds[j] & 0xffffu) + (wds[j] >> 16);
    unsigned suf = tl;
#pragma unroll
    for (int o = 1; o < 64; o <<= 1) { const unsigned v = __shfl_down(suf, o); if (lane + o < 64) suf += v; }
    const unsigned S = suf - tl;
    const bool cross = (S < need) && (need <= S + tl);
    unsigned c = S, bsel = 0, ab = 0; bool found = false;
#pragma unroll
    for (int k = 31; k >= 0; --k) { const unsigned cnt = (wds[k >> 1] >> (16 * (k & 1))) & 0xffffu; if (!found && c + cnt >= need) { bsel = 32 * lane + k; ab = c; found = true; } c += cnt; }
    const unsigned long long bal = __ballot(cross);
    const int src = bal ? __builtin_ctzll(bal) : 0;
    bin = __shfl(bsel, src); above = __shfl(ab, src);
}

__device__ __forceinline__ void attend(const Ctx& C, const LAS unsigned short* sq, int nvalid, long rowbase, long token, int tpos, int lane, int g0) {
    asm volatile("" : "+v"(lane));
    const int l15 = lane & 15, l4 = lane >> 4;
    int sidx[16];
#pragma unroll
    for (int ti = 0; ti < 16; ++ti) sidx[ti] = sq[ti * 16 + l15];
    unsigned bpk[4] = {0u, 0u, 0u, 0u};
#pragma unroll
    for (int ti = 0; ti < 16; ++ti) { const int rel = sidx[ti] - tpos, n = rel < 0 ? -rel : rel;
        const int bk = (rel > 0 ? 16 : 0) + (n < 8 ? n : 8 + (n >= 12) + (n >= 16) + (n >= 23) + (n >= 32) + (n >= 46) + (n >= 64) + (n >= 91));
        bpk[ti >> 2] |= (unsigned)bk << (8 * (ti & 3)); }
#pragma unroll 1
    for (int g = g0; g < g0 + 2; ++g) {
        const bf16* qp = C.QA + token * DM + (4 * g + (lane & 3)) * 64 + 8 * l4;
        const bf16x8 qf0 = *(const bf16x8*)qp, qf1 = *(const bf16x8*)(qp + 32);
        const bf16* kbase = C.KA + rowbase * 256 + g * 64 + 8 * l4;
        f32x4 S[16];
#pragma unroll
        for (int hh = 0; hh < 4; ++hh) {
            bf16x8 kf0[4], kf1[4];
#pragma unroll
            for (int j = 0; j < 4; ++j) { const bf16* kp = kbase + (long)sidx[hh * 4 + j] * 256; kf0[j] = *(const bf16x8*)kp; kf1[j] = *(const bf16x8*)(kp + 32); }
#pragma unroll
            for (int j = 0; j < 4; ++j) { const int ti = hh * 4 + j;
                f32x4 a = *(const LAS f32x4*)(C.t5l + ((bpk[hh] >> (8 * j)) & 255u) * 16 + 4 * g);
                asm volatile("v_mfma_f32_16x16x32_bf16 %0, %1, %2, %0" : "+v"(a) : "v"(qf0), "v"(kf0[j]));
                asm volatile("v_mfma_f32_16x16x32_bf16 %0, %1, %2, %0" : "+v"(a) : "v"(qf1), "v"(kf1[j]));
                S[ti] = a; }
            asm volatile("s_nop 15\n\ts_nop 7" : "+v"(S[hh * 4]), "+v"(S[hh * 4 + 1]), "+v"(S[hh * 4 + 2]), "+v"(S[hh * 4 + 3]));
        }
#pragma unroll
        for (int ti = 0; ti < 16; ++ti) if (ti * 16 >= nvalid) S[ti] = (f32x4){-INFINITY, -INFINITY, -INFINITY, -INFINITY};
        f32x4 mx = S[0];
#pragma unroll
        for (int ti = 1; ti < 16; ++ti) { mx.x = fmaxf(mx.x, S[ti].x); mx.y = fmaxf(mx.y, S[ti].y); mx.z = fmaxf(mx.z, S[ti].z); mx.w = fmaxf(mx.w, S[ti].w); }
#pragma unroll
        for (int o = 1; o < 16; o <<= 1) { mx.x = fmaxf(mx.x, __shfl_xor(mx.x, o)); mx.y = fmaxf(mx.y, __shfl_xor(mx.y, o)); mx.z = fmaxf(mx.z, __shfl_xor(mx.z, o)); mx.w = fmaxf(mx.w, __shfl_xor(mx.w, o)); }
        f32x4 ls = (f32x4){0.f, 0.f, 0.f, 0.f};
        unsigned P01[16], P23[16];
#pragma unroll
        for (int ti = 0; ti < 16; ++ti) { const float e0 = __builtin_amdgcn_exp2f(S[ti].x - mx.x), e1 = __builtin_amdgcn_exp2f(S[ti].y - mx.y), e2 = __builtin_amdgcn_exp2f(S[ti].z - mx.z), e3 = __builtin_amdgcn_exp2f(S[ti].w - mx.w);
            ls += (f32x4){e0, e1, e2, e3}; P01[ti] = cvtpk(e0, e1); P23[ti] = cvtpk(e2, e3); }
#pragma unroll
        for (int o = 1; o < 16; o <<= 1) { ls.x += __shfl_xor(ls.x, o); ls.y += __shfl_xor(ls.y, o); ls.z += __shfl_xor(ls.z, o); ls.w += __shfl_xor(ls.w, o); }
        float o_[4][16];
#pragma unroll
        for (int h = 0; h < 4; ++h)
#pragma unroll
            for (int d = 0; d < 16; ++d) o_[h][d] = 0.f;
        const bf16* vbase = C.VA + rowbase * 256 + g * 64 + 16 * l4;
#pragma unroll
        for (int hh = 0; hh < 4; ++hh) {
            v4u va[4], vb[4];
#pragma unroll
            for (int j = 0; j < 4; ++j) { const v4u* vp = (const v4u*)(vbase + (long)sidx[hh * 4 + j] * 256); va[j] = vp[0]; vb[j] = vp[1]; }
#pragma unroll
            for (int j = 0; j < 4; ++j) { const int ti = hh * 4 + j; const v4u v0 = va[j], v1 = vb[j];
                float vf[16];
                vf[0] = bf_lo(v0.x); vf[1] = bf_hi(v0.x); vf[2] = bf_lo(v0.y); vf[3] = bf_hi(v0.y); vf[4] = bf_lo(v0.z); vf[5] = bf_hi(v0.z); vf[6] = bf_lo(v0.w); vf[7] = bf_hi(v0.w);
                vf[8] = bf_lo(v1.x); vf[9] = bf_hi(v1.x); vf[10] = bf_lo(v1.y); vf[11] = bf_hi(v1.y); vf[12] = bf_lo(v1.z); vf[13] = bf_hi(v1.z); vf[14] = bf_lo(v1.w); vf[15] = bf_hi(v1.w);
                const float p0 = bf_lo(P01[ti]), p1 = bf_hi(P01[ti]), p2 = bf_lo(P23[ti]), p3 = bf_hi(P23[ti]);
#pragma unroll
                for (int d = 0; d < 16; ++d) { o_[0][d] += p0 * vf[d]; o_[1][d] += p1 * vf[d]; o_[2][d] += p2 * vf[d]; o_[3][d] += p3 * vf[d]; } }
        }
        float res[4];
#pragma unroll
        for (int h = 0; h < 4; ++h) {
            float a8[8], a4[4], a2[2];
            const bool b3 = (l15 & 8) != 0, b2 = (l15 & 4) != 0, b1 = (l15 & 2) != 0, b0 = (l15 & 1) != 0;
#pragma unroll
            for (int d = 0; d < 8; ++d) { const float keep = b3 ? o_[h][d + 8] : o_[h][d], send = b3 ? o_[h][d] : o_[h][d + 8]; a8[d] = keep + __shfl_xor(send, 8); }
#pragma unroll
            for (int d = 0; d < 4; ++d) { const float keep = b2 ? a8[d + 4] : a8[d], send = b2 ? a8[d] : a8[d + 4]; a4[d] = keep + __shfl_xor(send, 4); }
#pragma unroll
            for (int d = 0; d < 2; ++d) { const float keep = b1 ? a4[d + 2] : a4[d], send = b1 ? a4[d] : a4[d + 2]; a2[d] = keep + __shfl_xor(send, 2); }
            { const float keep = b0 ? a2[1] : a2[0], send = b0 ? a2[0] : a2[1]; res[h] = keep + __shfl_xor(send, 1); }
        }
        bf16* mp = C.M + token * DM + (4 * g) * 64 + lane;
        mp[0] = (bf16)f2bf(res[0] * __builtin_amdgcn_rcpf(ls.x)); mp[64] = (bf16)f2bf(res[1] * __builtin_amdgcn_rcpf(ls.y)); mp[128] = (bf16)f2bf(res[2] * __builtin_amdgcn_rcpf(ls.z)); mp[192] = (bf16)f2bf(res[3] * __builtin_amdgcn_rcpf(ls.w));
    }
}

constexpr int CAND_CAP = 256;
constexpr int SELKS_OFF = KS_OFF;
__device__ __forceinline__ float relu_i(float x) { const int i = __builtin_bit_cast(int, x); return __builtin_bit_cast(float, i > 0 ? i : 0); }
struct SelState { unsigned pre[4], need[4], cnt[4], tcnt[4]; };
__device__ __forceinline__ void tile_mfma(f32x16 (&acc)[2], const LAS unsigned char* kf, const int (&koff)[4], const bf16x8 (&qa)[4]) {
#pragma unroll
    for (int h2 = 0; h2 < 2; ++h2) { acc[h2] = f32x16{};
#pragma unroll
        for (int ks = 0; ks < 4; ++ks) { const bf16x8 kb = *(const LAS bf16x8*)(kf + koff[ks] + h2 * 4096); acc[h2] = __builtin_amdgcn_mfma_f32_32x32x16_bf16(qa[ks], kb, acc[h2], 0, 0, 0); } }
}
template <class ActionT>
__device__ __forceinline__ void tile_valu(const f32x16 (&acc)[2], const f32x2_t (&wp)[2][4], int kbase, ActionT&& act) {
#pragma unroll
    for (int h2 = 0; h2 < 2; ++h2) {
        f32x2_t sa = {0.f, 0.f}, sb = {0.f, 0.f};
#pragma unroll
        for (int jp = 0; jp < 4; ++jp) {
            const f32x2_t ra = {relu_i(acc[h2][2 * jp]), relu_i(acc[h2][2 * jp + 1])};
            const f32x2_t rb = {relu_i(acc[h2][8 + 2 * jp]), relu_i(acc[h2][8 + 2 * jp + 1])};
            sa = __builtin_elementwise_fma(ra, wp[0][jp], sa); sb = __builtin_elementwise_fma(rb, wp[1][jp], sb); }
        act(kbase + h2 * 32, (sa.x + sa.y) + 0.0f, (sb.x + sb.y) + 0.0f);
    }
}
constexpr int KSLOTS = 3;
__device__ __forceinline__ void wait_tile(int newer) {
    if (newer >= 4) asm volatile("s_waitcnt vmcnt(4) lgkmcnt(0)\n\ts_barrier" ::: "memory");
    else if (newer == 3) asm volatile("s_waitcnt vmcnt(3) lgkmcnt(0)\n\ts_barrier" ::: "memory");
    else if (newer == 2) asm volatile("s_waitcnt vmcnt(2) lgkmcnt(0)\n\ts_barrier" ::: "memory");
    else if (newer == 1) asm volatile("s_waitcnt vmcnt(1) lgkmcnt(0)\n\ts_barrier" ::: "memory");
    else asm volatile("s_waitcnt vmcnt(0) lgkmcnt(0)\n\ts_barrier" ::: "memory");
}
template <class ActionT>
__device__ __forceinline__ void tile_pass(Frame& F, const bf16* ksrc, unsigned kdst, const LAS unsigned char* kfr, const int (&koff)[4], int NT, const bf16x8 (&qa)[4], const f32x2_t (&wp)[2][4], ActionT&& act) {
    asm volatile("s_waitcnt lgkmcnt(0)\n\ts_barrier" ::: "memory");
    const int npre = NT < KSLOTS ? NT : KSLOTS;
    for (int j = 0; j < npre; ++j) glds16(ksrc + (long)j * 4096, (unsigned)__builtin_amdgcn_readfirstlane(kdst + j * 8192));
    wait_tile(npre - 1);
    f32x16 accA[2], accB[2];
    tile_mfma(accA, kfr, koff, qa);
    int sl = 0;
    int kt = 0;
    for (; kt + 2 < NT; kt += 2) {
        { const int inflight = (NT - kt - 2) < (KSLOTS - 2) ? (NT - kt - 2) : (KSLOTS - 2); wait_tile(inflight); }
        if (kt + KSLOTS < NT) glds16(ksrc + (long)(kt + KSLOTS) * 4096, (unsigned)__builtin_amdgcn_readfirstlane(kdst + sl * 8192));
        sl = (sl == KSLOTS - 1) ? 0 : sl + 1;
        tile_mfma(accB, kfr + sl * 8192, koff, qa);
        tile_valu(accA, wp, kt * 64, act);
        { const int inflight = (NT - kt - 3) < (KSLOTS - 2) ? (NT - kt - 3) : (KSLOTS - 2); wait_tile(inflight); }
        if (kt + 1 + KSLOTS < NT) glds16(ksrc + (long)(kt + 1 + KSLOTS) * 4096, (unsigned)__builtin_amdgcn_readfirstlane(kdst + sl * 8192));
        sl = (sl == KSLOTS - 1) ? 0 : sl + 1;
        tile_mfma(accA, kfr + sl * 8192, koff, qa);
        tile_valu(accB, wp, (kt + 1) * 64, act);
    }
    if (kt + 1 < NT) {
        wait_tile(0);
        sl = (sl == KSLOTS - 1) ? 0 : sl + 1;
        tile_mfma(accB, kfr + sl * 8192, koff, qa);
        tile_valu(accA, wp, kt * 64, act);
        tile_valu(accB, wp, (kt + 1) * 64, act);
    } else tile_valu(accA, wp, kt * 64, act);
    LDS_WAIT();
}
__device__ __forceinline__ void scan_hist_cnt(const LAS unsigned* hq, int lane, unsigned need, unsigned& bin, unsigned& above, unsigned& bcnt) {
    const LAS v4u* hp = (const LAS v4u*)hq + lane * 2;
    unsigned wds[8];
#pragma unroll
    for (int j = 0; j < 2; ++j) { const v4u t = hp[j]; wds[4 * j] = t.x; wds[4 * j + 1] = t.y; wds[4 * j + 2] = t.z; wds[4 * j + 3] = t.w; }
    unsigned tl = 0;
#pragma unroll
    for (int j = 0; j < 8; ++j) tl += wds[j];
    unsigned suf = tl;
#pragma unroll
    for (int o = 1; o < 64; o <<= 1) { const unsigned v = __shfl_down(suf, o); if (lane + o < 64) suf += v; }
    const unsigned S = suf - tl;
    const bool cross = (S < need) && (need <= S + tl);
    unsigned c = S, bsel = 0, ab = 0, bc = 0; bool found = false;
#pragma unroll
    for (int k = 7; k >= 0; --k) { const unsigned cnt = wds[k]; if (!found && c + cnt >= need) { bsel = 8 * lane + k; ab = c; bc = cnt; found = true; } c += cnt; }
    const unsigned long long bal = __ballot(cross);
    const int src = bal ? __builtin_ctzll(bal) : 0;
    bin = __builtin_amdgcn_readfirstlane(__shfl(bsel, src)); above = __builtin_amdgcn_readfirstlane(__shfl(ab, src)); bcnt = __builtin_amdgcn_readfirstlane(__shfl(bc, src));
}
__device__ __forceinline__ void step(Frame& F, const Ctx& C, int b, int c, int half) {
    int lane_ = F.lane; asm volatile("" : "+v"(lane_));
    const int lane = lane_, r = lane & 31, hi = lane >> 5, wave = F.wave;
    LAS unsigned* hist = (LAS unsigned*)(F.lds + RING_OFF + wave * 16384);
    LAS unsigned short* sel = (LAS unsigned short*)hist;
    LAS unsigned* cand = hist + 2048;
    LAS unsigned* fbflag = (LAS unsigned*)(F.lds + AUX_OFF + 2048);
    const long rowbase = (long)b * SEQ;
    const int tq0 = 64 * c + 32 * half + 4 * wave;
    const int N = 64 * (c + 1), NT = c + 1;
    int nvalid = 256;
    if (N <= 256) {
        nvalid = N;
        for (int j = lane; j < 4 * 256; j += 64) sel[j] = (unsigned short)(((j & 255) < N) ? (j & 255) : 0);
    } else {
        const int aq = 2 * ((r >> 2) & 1) + (r >> 4), ah = 4 * ((r >> 3) & 1) + (r & 3);
        const bf16* qip = C.QI + (rowbase + tq0 + aq) * 512 + ah * 64 + 8 * hi;
        bf16x8 qa[4];
#pragma unroll
        for (int ks = 0; ks < 4; ++ks) qa[ks] = *(const bf16x8*)(qip + 16 * ks);
        f32x2_t wp[2][4];
#pragma unroll
        for (int t = 0; t < 2; ++t) { const float* wq = C.WI + (rowbase + tq0 + 2 * hi + t) * 8; const f32x4 w0 = *(const f32x4*)wq, w1 = *(const f32x4*)(wq + 4);
            wp[t][0] = (f32x2_t){w0.x, w0.y}; wp[t][1] = (f32x2_t){w0.z, w0.w}; wp[t][2] = (f32x2_t){w1.x, w1.y}; wp[t][3] = (f32x2_t){w1.z, w1.w}; }
        float Bq;
        { float ssq = 0.f;
#pragma unroll
          for (int ks = 0; ks < 4; ++ks)
#pragma unroll
              for (int e = 0; e < 8; ++e) { const float v = bf_lo((unsigned)(unsigned short)qa[ks][e]); ssq += v * v; }
          ssq += __shfl_xor(ssq, 32);
          float term = fabsf(C.WI[(rowbase + tq0 + aq) * 8 + ah]) * sqrtf(ssq);
          term += __shfl_xor(term, 1); term += __shfl_xor(term, 2); term += __shfl_xor(term, 8);
          Bq = term * 8.25f + 1e-20f; }
        const float B0 = __shfl(Bq, (hi << 2)), B1 = __shfl(Bq, (hi << 2) | 16);
        const float sc0 = 1024.0f / B0, sc1 = 1024.0f / B1;
        asm volatile("" :: "v"(qa[0]), "v"(qa[1]), "v"(qa[2]), "v"(qa[3]));
        asm volatile("" :: "v"(wp[0][0]), "v"(wp[0][1]), "v"(wp[0][2]), "v"(wp[0][3]), "v"(wp[1][0]), "v"(wp[1][1]), "v"(wp[1][2]), "v"(wp[1][3]), "v"(sc0), "v"(sc1));
        const bf16* ksrc = C.KI + rowbase * 64 + (long)(wave * 8 + (lane >> 3)) * 64 + ((lane & 7) ^ (lane >> 3)) * 8;
        const unsigned kdst = (unsigned)(uintptr_t)(F.lds + SELKS_OFF) + wave * 1024;
        const LAS unsigned char* kfr = F.lds + SELKS_OFF + r * 128;
        int koff[4];
#pragma unroll
        for (int ks = 0; ks < 4; ++ks) koff[ks] = ((2 * ks + hi) ^ (r & 7)) * 16;
        const unsigned below = (1u << r) - 1u;
        LAS v4u* hz = (LAS v4u*)hist;
        if (wave == 0 && lane == 0) *fbflag = 0u;
#pragma unroll
        for (int j = 0; j < 8; ++j) hz[j * 64 + lane] = (v4u){0u, 0u, 0u, 0u};
        tile_pass(F, ksrc, kdst, kfr, koff, NT, qa, wp, [&](int kbase, float s0, float s1) {
            const int b0 = (int)__builtin_amdgcn_fmed3f(__builtin_fmaf(s0, sc0, 256.0f), 0.0f, 511.0f), b1 = (int)__builtin_amdgcn_fmed3f(__builtin_fmaf(s1, sc1, 256.0f), 0.0f, 511.0f);
            __hip_atomic_fetch_add(hist + (2 * hi) * 512 + b0, 1u, __ATOMIC_RELAXED, __HIP_MEMORY_SCOPE_WORKGROUP);
            __hip_atomic_fetch_add(hist + (2 * hi + 1) * 512 + b1, 1u, __ATOMIC_RELAXED, __HIP_MEMORY_SCOPE_WORKGROUP);
        });
#ifdef PROBE_SKEL
        tile_pass(F, ksrc, kdst, kfr, koff, NT, qa, wp, [&](int kbase, float s0, float s1) { });
#endif
#ifdef PROBE_SCORE
        { float dsum = 0.f; tile_pass(F, ksrc, kdst, kfr, koff, NT, qa, wp, [&](int kbase, float s0, float s1) { dsum += s0 + s1; }); if (dsum == 12345.678f) hist[0] = 1u; }
#endif
        SelState st;
        unsigned tbin[4], bcn[4]; bool ovf = false;
#pragma unroll
        for (int ql = 0; ql < 4; ++ql) { unsigned above; scan_hist_cnt(hist + ql * 512, lane, 256u, tbin[ql], above, bcn[ql]); st.cnt[ql] = 0u; st.tcnt[ql] = 0u; st.need[ql] = 256u - above; st.pre[ql] = above;
#ifdef PROBE_OVF
            ovf |= bcn[ql] > (unsigned)PROBE_OVF; }
#else
            ovf |= bcn[ql] > (unsigned)CAND_CAP; }
#endif
        LDS_WAIT();
        if (ovf && lane == 0) *fbflag = 1u;
        asm volatile("s_waitcnt lgkmcnt(0)\n\ts_barrier" ::: "memory");
#ifdef PROBE_NOFB
        const bool fb = false;
#elif defined(PROBE_NOFB2)
        const bool fb = __builtin_amdgcn_readfirstlane((int)*fbflag) == 0x7fffffff;
#else
        const bool fb = __builtin_amdgcn_readfirstlane((int)*fbflag) != 0;
#endif
        if (!fb) {
            const int tb0 = (int)(hi ? tbin[2] : tbin[0]), tb1 = (int)(hi ? tbin[3] : tbin[1]);
            tile_pass(F, ksrc, kdst, kfr, koff, NT, qa, wp, [&](int kbase, float s0, float s1) {
#pragma unroll
                for (int t = 0; t < 2; ++t) {
                    const float s = t ? s1 : s0; const int bin = (int)__builtin_amdgcn_fmed3f(__builtin_fmaf(s, (t ? sc1 : sc0), 256.0f), 0.0f, 511.0f), tb = t ? tb1 : tb0;
                    const bool gt = bin > tb, eq = bin == tb;
                    const unsigned long long mg = __ballot(gt), me = __ballot(eq);
                    const unsigned mgh = hi ? (unsigned)(mg >> 32) : (unsigned)mg, meh = hi ? (unsigned)(me >> 32) : (unsigned)me;
                    const unsigned pos = (hi ? st.cnt[2 + t] : st.cnt[t]) + __builtin_popcount(mgh & below);
                    sel[(gt && pos < 256u) ? (2 * hi + t) * 256 + pos : 3200 + lane] = (unsigned short)(kbase + r);
                    const unsigned cpos = (hi ? st.tcnt[2 + t] : st.tcnt[t]) + __builtin_popcount(meh & below);
                    { LAS unsigned* cp = hist + ((eq && cpos < (unsigned)CAND_CAP) ? 2048 + ((2 * hi + t) * CAND_CAP + cpos) * 2 : 1700 + 2 * lane); cp[0] = okey(s); cp[1] = (unsigned)(kbase + r); }
                    st.cnt[t] += __builtin_popcount((unsigned)mg); st.cnt[2 + t] += __builtin_popcount((unsigned)(mg >> 32));
                    st.tcnt[t] += __builtin_popcount((unsigned)me); st.tcnt[2 + t] += __builtin_popcount((unsigned)(me >> 32));
                }
            });
#pragma unroll
            for (int ql = 0; ql < 4; ++ql) {
                const unsigned nc = bcn[ql], G = st.pre[ql], rq = st.need[ql];
                const LAS unsigned* cq = cand + ql * CAND_CAP * 2;
                unsigned ki4[4], xi4[4], rk4[4];
#pragma unroll
                for (int m = 0; m < 4; ++m) { const unsigned i = (unsigned)lane + 64u * m; ki4[m] = (i < nc) ? cq[2 * i] : 0u; xi4[m] = (i < nc) ? cq[2 * i + 1] : 0u; rk4[m] = 0u; }
                for (unsigned j = 0; j < nc; ++j) { const unsigned kj = cq[2 * j];
#pragma unroll
                    for (int m = 0; m < 4; ++m) rk4[m] += (kj > ki4[m] || (kj == ki4[m] && j < (unsigned)lane + 64u * m)) ? 1u : 0u; }
                unsigned base = G; const unsigned long long lt = (1ull << lane) - 1ull;
#pragma unroll
                for (int m = 0; m < 4; ++m) { const bool take = ((unsigned)lane + 64u * m < nc) && rk4[m] < rq; const unsigned long long mm = __ballot(take);
                    const unsigned pos = base + __builtin_popcountll(mm & lt); if (take && pos < 256u) sel[ql * 256 + pos] = (unsigned short)xi4[m]; base += __builtin_popcountll(mm); }
            }
        } else {
#pragma unroll
            for (int ql = 0; ql < 4; ++ql) { st.pre[ql] = 0u; st.need[ql] = 256u; st.cnt[ql] = 0u; st.tcnt[ql] = 0u; }
#pragma unroll 1
            for (int lev = 0; lev < 4; ++lev) {
#pragma unroll
                for (int j = 0; j < 8; ++j) hz[j * 64 + lane] = (v4u){0u, 0u, 0u, 0u};
                const unsigned pre0 = hi ? st.pre[2] : st.pre[0], pre1 = hi ? st.pre[3] : st.pre[1];
                const int sh = (lev == 0) ? 23 : (lev == 1) ? 14 : (lev == 2) ? 5 : 0, wd = (lev == 3) ? 5 : 9;
                tile_pass(F, ksrc, kdst, kfr, koff, NT, qa, wp, [&](int kbase, float s0, float s1) {
                    const unsigned k0 = okey(s0), k1 = okey(s1);
                    const unsigned b0 = (k0 >> sh) & ((1u << wd) - 1u), b1 = (k1 >> sh) & ((1u << wd) - 1u);
                    const bool in0 = (lev == 0) || ((k0 >> (sh + wd)) == pre0), in1 = (lev == 0) || ((k1 >> (sh + wd)) == pre1);
                    if (in0) __hip_atomic_fetch_add(hist + (2 * hi) * 512 + b0, 1u, __ATOMIC_RELAXED, __HIP_MEMORY_SCOPE_WORKGROUP);
                    if (in1) __hip_atomic_fetch_add(hist + (2 * hi + 1) * 512 + b1, 1u, __ATOMIC_RELAXED, __HIP_MEMORY_SCOPE_WORKGROUP);
                });
#pragma unroll
                for (int ql = 0; ql < 4; ++ql) { unsigned bin, above, bc; scan_hist_cnt(hist + ql * 512, lane, st.need[ql], bin, above, bc);
                    st.pre[ql] = (st.pre[ql] << wd) | bin; st.need[ql] -= above; }
                LDS_WAIT();
            }
            const unsigned T0 = hi ? st.pre[2] : st.pre[0], T1 = hi ? st.pre[3] : st.pre[1], rq0 = hi ? st.need[2] : st.need[0], rq1 = hi ? st.need[3] : st.need[1];
            tile_pass(F, ksrc, kdst, kfr, koff, NT, qa, wp, [&](int kbase, float s0, float s1) {
#pragma unroll
                for (int t = 0; t < 2; ++t) {
                    const unsigned kk = okey(t ? s1 : s0), T = t ? T1 : T0, rq = t ? rq1 : rq0;
                    const bool gt = kk > T, eq = kk == T;
                    const unsigned long long me = __ballot(eq);
                    const unsigned meh = hi ? (unsigned)(me >> 32) : (unsigned)me;
                    const unsigned trank = (hi ? st.tcnt[2 + t] : st.tcnt[t]) + __builtin_popcount(meh & below);
                    const bool take = gt || (eq && trank < rq);
                    const unsigned long long mt = __ballot(take);
                    const unsigned mth = hi ? (unsigned)(mt >> 32) : (unsigned)mt;
                    const unsigned pos = (hi ? st.cnt[2 + t] : st.cnt[t]) + __builtin_popcount(mth & below);
                    if (take && pos < 256u) sel[(2 * hi + t) * 256 + pos] = (unsigned short)(kbase + r);
                    st.cnt[t] += __builtin_popcount((unsigned)mt); st.cnt[2 + t] += __builtin_popcount((unsigned)(mt >> 32));
                    st.tcnt[t] += __builtin_popcount((unsigned)me); st.tcnt[2 + t] += __builtin_popcount((unsigned)(me >> 32));
                }
            });
        }
    }
    LDS_WAIT();
    { const LAS v4u* s4 = (const LAS v4u*)sel; v4u* g4 = (v4u*)(C.SEL + (rowbase + tq0) * 256);
#pragma unroll
      for (int j = 0; j < 2; ++j) g4[j * 64 + lane] = s4[j * 64 + lane]; }
    LDS_WAIT();
}
__device__ __forceinline__ void phase(Frame& F, const Ctx& C) {
    for (int v = F.vcu; v < 256; v += F.G) {
        const int b = v >> 6, c = v & 63;
#pragma unroll 1
        for (int it = 0; it < 4; ++it) step(F, C, b, (it < 2) ? c : 127 - c, it & 1);
    }
}
__device__ __forceinline__ void attn_phase(Frame& F, const Ctx& C) {
    int lane = F.lane; asm volatile("" : "+v"(lane));
    LAS unsigned short* sq = (LAS unsigned short*)(F.lds + RING_OFF + F.wave * 16384);
    const int nx = F.G / 32;
    for (int x = F.vcu / 32; x < 8; x += nx) {
        const int b = x >> 1, g0 = 2 * (x & 1); const long rowbase = (long)b * SEQ;
        const int w = (F.vcu & 31) * NWAVES + F.wave;
#pragma unroll 1
        for (int t = w; t < SEQ; t += 32 * NWAVES) {
            { const v4u* g4 = (const v4u*)(C.SEL + (rowbase + t) * 256); if (lane < 32) ((LAS v4u*)sq)[lane] = g4[lane]; }
            LDS_WAIT();
            const int N = 64 * ((t >> 6) + 1), nvalid = N < 256 ? N : 256;
            attend(C, sq, nvalid, rowbase, rowbase + t, t, lane, g0);
            LDS_WAIT();
        }
    }
}
}

namespace att8 {
typedef int v2i __attribute__((ext_vector_type(2)));
struct Ctx8 { const unsigned char* QA8; const unsigned char* KV8; const unsigned short* SEL; bf16* M; };
constexpr int T2_OFF = KS_OFF, T2_BYTES = 155 * 16 * 4, SELL_OFF = KS_OFF + 10240;
static_assert(T2_BYTES <= 10240 && SELL_OFF + NWAVES * 1024 <= AUX_OFF, "attention LDS map");
__device__ __forceinline__ void mfma8(f32x4& acc, long a, long b) { asm volatile("v_mfma_f32_16x16x32_fp8_fp8 %0, %1, %2, %0" : "+v"(acc) : "v"(a), "v"(b)); }
__device__ __forceinline__ unsigned pk4_fp8(float a, float b, float c, float d) { int r = __builtin_amdgcn_cvt_pk_fp8_f32(a, b, 0, false); r = __builtin_amdgcn_cvt_pk_fp8_f32(c, d, r, true); return (unsigned)r; }

__device__ __forceinline__ void gld16(v4u& dst, const void* p) { asm volatile("global_load_dwordx4 %0, %1, off" : "=v"(dst) : "v"(p) : "memory"); }
__device__ __forceinline__ void issue_kq(const Ctx8& C, const LAS unsigned short* sq, long rowbase, long token, int g, int l15, int l4, int h, v4u (&kr)[16], v4u& qv) {
    const unsigned char* kvb = C.KV8 + rowbase * 512 + g * 128 + 16 * l4;
#pragma unroll
    for (int j = 0; j < 16; ++j) gld16(kr[j], kvb + (long)sq[j * 16 + l15] * 512);
    gld16(qv, C.QA8 + token * 1024 + (4 * g + h) * 64 + 16 * l4);
}
__device__ __forceinline__ void issue_v_half(const Ctx8& C, const LAS unsigned short* sq, long rowbase, int g, int lane, unsigned vbase, int half) {
    const unsigned char* kvb = C.KV8 + rowbase * 512 + g * 128 + 64; const int kq = lane >> 2, p = lane & 3;
#pragma unroll
    for (int j = 0; j < 8; ++j) { const int ti = half * 8 + j; const int key = sq[ti * 16 + kq]; const int x = ((kq >> 2) & 1) | ((ti & 1) << 1);
        glds16(kvb + (long)key * 512 + 16 * (p ^ x), (unsigned)__builtin_amdgcn_readfirstlane(vbase + ti * 1024)); }
}
__device__ __forceinline__ void phase(Frame& F, const Ctx8& C, const float* t5) {
    int lane = F.lane; asm volatile("" : "+v"(lane));
    LAS float* T2 = (LAS float*)(F.lds + T2_OFF);
    for (int e = F.tid; e < 155 * 16; e += NWAVES * 64) { const int rel = (e >> 4) - 91, n = rel < 0 ? -rel : rel;
        const int bk = (rel > 0 ? 16 : 0) + (n < 8 ? n : 8 + (n >= 12) + (n >= 16) + (n >= 23) + (n >= 32) + (n >= 46) + (n >= 64) + (n >= 91));
        T2[e] = t5[bk * 16 + (e & 15)] * 8.0f; }
    __syncthreads();
    LAS unsigned short* sqb = (LAS unsigned short*)(F.lds + SELL_OFF + F.wave * 1024);
    LAS unsigned char* vreg = F.lds + RING_OFF + F.wave * 16384;
    const unsigned vbase = (unsigned)(uintptr_t)vreg;
    const int l15 = lane & 15, l4 = lane >> 4, h = l15 & 3;
    const int trk = 4 * l4 + ((l15 >> 1) & 3), trt = (l15 >> 3) & 1, xs = (l4 & 1) | (trt << 1);
    const int troff = trt * 1024 + trk * 64 + 8 * (l15 & 1);
    const int x = F.vcu / 32, b = x >> 1, g0 = 2 * (x & 1); const long rowbase = (long)b * SEQ;
    const int w = (F.vcu & 31) * NWAVES + F.wave;
    constexpr int NQ = SEQ / (32 * NWAVES), NI = 2 * NQ;
    if (lane < 32) { ((LAS v4u*)sqb)[lane] = ((const v4u*)(C.SEL + (rowbase + w) * 256))[lane]; ((LAS v4u*)(sqb + 256))[lane] = ((const v4u*)(C.SEL + (rowbase + w + 32 * NWAVES) * 256))[lane]; }
    LDS_WAIT();
    v4u kr[16], qv, pf = (v4u){0u, 0u, 0u, 0u};
    issue_kq(C, sqb, rowbase, rowbase + w, g0, l15, l4, h, kr, qv);
    issue_v_half(C, sqb, rowbase, g0, lane, vbase, 0); issue_v_half(C, sqb, rowbase, g0, lane, vbase, 1);
    unsigned cib[16];
#pragma unroll 1
    for (int idx = 0; idx < NI; ++idx) {
        const int qn = idx >> 1, gi = idx & 1, g = g0 + gi, t = w + 32 * NWAVES * qn;
        const LAS unsigned short* sq = sqb + (qn & 1) * 256;
        const int nidx = (idx + 1 < NI) ? idx + 1 : idx, nq = nidx >> 1, ng = g0 + (nidx & 1), nt = w + 32 * NWAVES * nq;
        const LAS unsigned short* nsq = sqb + (nq & 1) * 256;
        if (gi == 1) { asm volatile("s_waitcnt vmcnt(34)" : "+v"(pf) :: "memory"); if (lane < 32) ((LAS v4u*)(sqb + (qn & 1) * 256))[lane] = pf; }
        { const int pq = (qn + 2 < NQ) ? qn + 2 : NQ - 1; gld16(pf, (const v4u*)(C.SEL + (rowbase + w + 32 * NWAVES * pq) * 256) + (lane & 31)); }
        if (idx == 0) asm volatile("s_waitcnt vmcnt(0)" : "+v"(qv), "+v"(kr[0]), "+v"(kr[1]), "+v"(kr[2]), "+v"(kr[3]), "+v"(kr[4]), "+v"(kr[5]), "+v"(kr[6]), "+v"(kr[7]), "+v"(kr[8]), "+v"(kr[9]), "+v"(kr[10]), "+v"(kr[11]), "+v"(kr[12]), "+v"(kr[13]), "+v"(kr[14]), "+v"(kr[15]) :: "memory");
        else asm volatile("s_waitcnt vmcnt(20)" : "+v"(qv), "+v"(kr[0]), "+v"(kr[1]), "+v"(kr[2]), "+v"(kr[3]), "+v"(kr[4]), "+v"(kr[5]), "+v"(kr[6]), "+v"(kr[7]), "+v"(kr[8]), "+v"(kr[9]), "+v"(kr[10]), "+v"(kr[11]), "+v"(kr[12]), "+v"(kr[13]), "+v"(kr[14]), "+v"(kr[15]) :: "memory");
        if (gi == 0) {
#pragma unroll
            for (int ti = 0; ti < 16; ++ti) { const v2u i4 = *(const LAS v2u*)(sq + ti * 16 + 4 * l4);
                const int r0 = (int)(i4.x & 0xffffu) - t, r1 = (int)(i4.x >> 16) - t, r2 = (int)(i4.y & 0xffffu) - t, r3 = (int)(i4.y >> 16) - t;
                const int c0 = min(max(r0, -91), 63) + 91, c1 = min(max(r1, -91), 63) + 91, c2 = min(max(r2, -91), 63) + 91, c3 = min(max(r3, -91), 63) + 91;
                cib[ti] = (unsigned)c0 | ((unsigned)c1 << 8) | ((unsigned)c2 << 16) | ((unsigned)c3 << 24); }
        }
        const int N = 64 * ((t >> 6) + 1), nvalid = N < 256 ? N : 256;
        const long q0 = (long)(((unsigned long long)qv.y << 32) | qv.x), q1 = (long)(((unsigned long long)qv.w << 32) | qv.z);
        f32x4 S[16];
#pragma unroll
        for (int ti = 0; ti < 16; ++ti) { const unsigned cb = cib[ti];
            f32x4 a; a.x = T2[(cb & 255u) * 16 + 4 * g + h]; a.y = T2[((cb >> 8) & 255u) * 16 + 4 * g + h]; a.z = T2[((cb >> 16) & 255u) * 16 + 4 * g + h]; a.w = T2[(cb >> 24) * 16 + 4 * g + h];
            mfma8(a, (long)(((unsigned long long)kr[ti].y << 32) | kr[ti].x), q0);
            mfma8(a, (long)(((unsigned long long)kr[ti].w << 32) | kr[ti].z), q1);
            S[ti] = a; }
        asm volatile("s_nop 15\n\ts_nop 7" : "+v"(S[0]), "+v"(S[1]), "+v"(S[2]), "+v"(S[3]), "+v"(S[4]), "+v"(S[5]), "+v"(S[6]), "+v"(S[7]), "+v"(S[8]), "+v"(S[9]), "+v"(S[10]), "+v"(S[11]), "+v"(S[12]), "+v"(S[13]), "+v"(S[14]), "+v"(S[15]));
        issue_kq(C, nsq, rowbase, rowbase + nt, ng, l15, l4, h, kr, qv);
#pragma unroll
        for (int ti = 0; ti < 16; ++ti) if (ti * 16 >= nvalid) S[ti] = (f32x4){-INFINITY, -INFINITY, -INFINITY, -INFINITY};
        float mx = S[0].x;
#pragma unroll
        for (int ti = 0; ti < 16; ++ti) mx = fmaxf(fmaxf(mx, fmaxf(S[ti].x, S[ti].y)), fmaxf(S[ti].z, S[ti].w));
        mx = fmaxf(mx, __shfl_xor(mx, 16)); mx = fmaxf(mx, __shfl_xor(mx, 32));
        const float mc = -mx * C2; float ls = 0.f;
        long P8[8];
#pragma unroll
        for (int j = 0; j < 8; ++j) { float e[8];
#pragma unroll
            for (int q = 0; q < 4; ++q) { e[q] = __builtin_amdgcn_exp2f(__builtin_fmaf(S[2 * j][q], C2, mc)); e[4 + q] = __builtin_amdgcn_exp2f(__builtin_fmaf(S[2 * j + 1][q], C2, mc)); }
            ls += ((e[0] + e[1]) + (e[2] + e[3])) + ((e[4] + e[5]) + (e[6] + e[7]));
            const unsigned lo = pk4_fp8(e[0] * 256.f, e[1] * 256.f, e[2] * 256.f, e[3] * 256.f), hi = pk4_fp8(e[4] * 256.f, e[5] * 256.f, e[6] * 256.f, e[7] * 256.f);
            P8[j] = (long)(((unsigned long long)hi << 32) | lo); }
        ls += __shfl_xor(ls, 16); ls += __shfl_xor(ls, 32);
        f32x4 D[4];
#pragma unroll
        for (int db = 0; db < 4; ++db) D[db] = (f32x4){0.f, 0.f, 0.f, 0.f};
#pragma unroll
        for (int hf = 0; hf < 2; ++hf) {
            asm volatile("s_waitcnt vmcnt(28)" ::: "memory");
#pragma unroll
            for (int j = 4 * hf; j < 4 * hf + 4; ++j)
#pragma unroll
                for (int db = 0; db < 4; ++db) {
                    const v2i vv = __builtin_amdgcn_ds_read_tr8_b64_v2i32((LAS v2i*)(vreg + j * 2048 + troff + 16 * (db ^ xs)));
                    mfma8(D[db], P8[j], __builtin_bit_cast(long, vv)); }
            asm volatile("s_waitcnt lgkmcnt(0)" ::: "memory");
            issue_v_half(C, nsq, rowbase, ng, lane, vbase, hf);
        }
        asm volatile("s_nop 15\n\ts_nop 7" : "+v"(D[0]), "+v"(D[1]), "+v"(D[2]), "+v"(D[3]));
        const float lh = __shfl(ls, l4);
        const float inv = __builtin_amdgcn_rcpf(lh * 256.f);
        bf16* mp = C.M + (rowbase + t) * DM + (4 * g + l4) * 64 + l15;
#pragma unroll
        for (int db = 0; db < 4; ++db) { const float v = (l4 == 0) ? D[db].x : (l4 == 1) ? D[db].y : (l4 == 2) ? D[db].z : D[db].w; const unsigned short ob = (unsigned short)f2bf(v * inv);
            asm volatile("global_store_short %0, %1, off" :: "v"(mp + 16 * db), "v"((unsigned)ob) : "memory"); }
    }
    asm volatile("s_waitcnt vmcnt(0)" ::: "memory");
}
}

#ifndef REP_P0
#define REP_P0 1
#endif
#ifndef REP_IN
#define REP_IN 1
#endif
#ifndef REP_DSA
#define REP_DSA 1
#endif
#ifndef REP_BAND
#define REP_BAND 1
#endif
#ifndef REP_UP
#define REP_UP 1
#endif
#ifndef REP_FIX
#define REP_FIX 1
#endif
constexpr int N_PHASES = 1 + 6 * DEPTH;
#ifndef MK_N_LAUNCHES
#define MK_N_LAUNCHES 1
#endif
__global__ void __launch_bounds__(NWAVES * 64, 2) mega_fwd(Args args) {
    extern __shared__ __attribute__((aligned(16))) unsigned char lds[];
    Frame F;
    F.lds = (LAS unsigned char*)lds;
    F.MISC = (volatile LAS unsigned*)(F.lds + MISC_OFF);
    F.tid = threadIdx.x; F.lane = F.tid & 63; F.wave = __builtin_amdgcn_readfirstlane(F.tid >> 6);
    F.G = GRID; { const int bx = blockIdx.x; F.vcu = (bx & 7) * (GRID / 8) + (bx >> 3); }
    unsigned char* ws = args.ws;
    F.ctl = (gu32*)(ws + WS_CTL);
    for (int u = F.tid; u < (LDS_BYTES - LDSCTL_OFF) / 4; u += NWAVES * 64) ((LAS unsigned*)(F.lds + LDSCTL_OFF))[u] = 0u;
    __syncthreads();
    XcdBarrier bar; bar.bar = (unsigned*)(F.ctl + CW_BAR); bar.x = 0; bar.st = nullptr;
    if (MK_N_LAUNCHES == 1) bar = xcd_barrier_post((unsigned*)(F.ctl + CW_BAR), F.MISC + 8);
    const int lo = args.ph_lo, hi = args.ph_hi;
#define IN(k) (lo <= (k) && (k) < hi)
#define OPQ_FRAME(Fl) Frame Fl = F; { int l_; asm volatile("v_mbcnt_lo_u32_b32 %0, -1, 0\n\tv_mbcnt_hi_u32_b32 %0, -1, %0" : "=v"(l_)); int w_ = F.wave; asm volatile("" : "+s"(w_)); Fl.wave = w_; Fl.lane = l_; Fl.tid = w_ * 64 + l_; }
#define SEAM(k) do { if (IN(k) && IN((k) + 1)) xcd_barrier(bar); } while (0)

    bf16* hb = (bf16*)(ws + WS_HB); bf16* mb = (bf16*)(ws + WS_M); float* ss = (float*)(ws + WS_SS); float* halo = (float*)(ws + WS_HALO);
    unsigned char* proj = ws + WS_PROJ; bf16* act = (bf16*)(ws + WS_PROJ);

#ifndef SKIP_P0
    if (IN(0)) { for (int rep = 0; rep < REP_P0; ++rep) { OPQ_FRAME(F0); p0_prologue(F0, args); } }
#endif
    SEAM(0);

#pragma unroll 1
    for (int L = 0; L < DEPTH; ++L) {
        const int pb = 1 + 6 * L, li = L >> 1; const bool isB = (L & 1) != 0;
        if (IN(pb)) {
#ifndef SKIP_IN
            for (int rep = 0; rep < REP_IN; ++rep)
            if (!isB) {
                pg8::Gemm g{hb, (const bf16*)(ws + WS_W_INA) + (size_t)li * NA_PAD * DM, MTOK, NA_PAD, DM}; pg8::StaticOrder S; S.init(MTOK, NA_PAD, F.G, (int)blockIdx.x);
                EpiIn E{ss, proj, args.q_norm_g + L * 64, args.k_norm_g + L * 64, 0};
                pg8::gemm_phase<EpiIn, pg8::StaticOrder, true, true>(F.lds + RING_OFF, g, S, E, F.wave);
            } else {
                pg8::Gemm g{hb, (const bf16*)(ws + WS_W_INB) + (size_t)li * NB * DM, MTOK, NB, DM}; pg8::StaticOrder S; S.init(MTOK, NB, F.G, (int)blockIdx.x);
                EpiIn E{ss, proj, args.q_norm_g + L * 64, args.k_norm_g + L * 64, 1};
                pg8::gemm_phase<EpiIn, pg8::StaticOrder, true, true>(F.lds + RING_OFF, g, S, E, F.wave);
            }
#endif
        }
        SEAM(pb);
#if defined(DBG_NODSA) || defined(DBG_NOBAND)
#ifdef DBG_NODSA
        const bool zero_m = !isB;
#else
        const bool zero_m = isB;
#endif
        if (IN(pb + 1) && zero_m) { for (size_t i = (size_t)blockIdx.x * 512 + threadIdx.x; i < (size_t)MTOK * DM / 8; i += (size_t)gridDim.x * 512) ((v4u*)mb)[i] = (v4u){0u, 0u, 0u, 0u}; }
        if (IN(pb + 1) && !zero_m) {
#else
        if (IN(pb + 1)) {
#endif
#ifndef SKIP_DSA
            if (!isB) {
                LAS float* t5l = (LAS float*)(F.lds + AUX_OFF);
                { OPQ_FRAME(Ft); for (int i = Ft.tid; i < 512; i += NWAVES * 64) t5l[i] = args.t5_bias[i] * LOG2E; }
                __syncthreads();
                dsa::Ctx C{(const bf16*)(proj + PA_QA), (const bf16*)(proj + PA_KA), (const bf16*)(proj + PA_VA), (const bf16*)(proj + PA_QI), (const bf16*)(proj + PA_KI), (const float*)(proj + PA_WI), mb, t5l, (unsigned short*)(proj + PA_SEL)};
#ifdef DBG_DSACOPY
                { int t_ = threadIdx.x; asm volatile("" : "+v"(t_));
                for (unsigned i = blockIdx.x * 512u + (unsigned)t_; i < (unsigned)MTOK * DM; i += gridDim.x * 512u) { const unsigned t = i >> 10, c = i & 1023u;
                    float v = bf_lo(C.QA[i]); v += bf_lo(C.KA[t * 256 + (c & 255)]); v += bf_lo(C.VA[t * 256 + (c & 255)]); v += bf_lo(C.QI[t * 512 + (c & 511)]); v += bf_lo(C.KI[t * 64 + (c & 63)]); v += C.WI[t * 8 + (c & 7)];
                    mb[i] = (bf16)f2bf(v * 0.01f); asm volatile("" ::: "memory"); } }
#else
                for (int rep = 0; rep < REP_DSA; ++rep) { OPQ_FRAME(F1); dsa::phase(F1, C); }
                xcd_barrier(bar);
                { OPQ_FRAME(F1b); att8::Ctx8 C8{(const unsigned char*)(proj + PA_QA), (const unsigned char*)(proj + PA_KA), (const unsigned short*)(proj + PA_SEL), mb};
#ifndef REP_ATT8
#define REP_ATT8 1
#endif
                  for (int rep = 0; rep < REP_ATT8; ++rep) { att8::phase(F1b, C8, args.t5_bias); __syncthreads(); } }
#endif
            }
#endif
#ifndef SKIP_BAND
            if (isB) {
                for (int rep = 0; rep < REP_BAND; ++rep) { OPQ_FRAME(F2); band::phase(F2, (const bf16*)proj, (const bf16*)(proj + PB_STRIDE), (const bf16*)(proj + 2 * PB_STRIDE), mb, args.rel_bias_b + (size_t)li * 513 * 16); }
            }
#endif
        }
        SEAM(pb + 1);
        if (IN(pb + 2)) {
#ifndef SKIP_OUT
            pg8::Gemm g{mb, (const bf16*)(ws + WS_W_OUT) + (size_t)L * DM * DM, MTOK, DM, DM}; pg8::StaticOrder S; S.init(MTOK, DM, F.G, (int)blockIdx.x);
#ifdef REP_OUT
            { EpiRes E0{L == 0 ? args.x : nullptr, nullptr, hb, (bf16*)proj, halo}; pg8::gemm_phase<EpiRes, pg8::StaticOrder, true, true>(F.lds + RING_OFF, g, S, E0, F.wave); }
#endif
            EpiRes E{L == 0 ? args.x : nullptr, nullptr, hb, hb, ss};
            pg8::gemm_phase<EpiRes, pg8::StaticOrder, true, true>(F.lds + RING_OFF, g, S, E, F.wave);
#endif
        }
        SEAM(pb + 2);
        if (IN(pb + 3)) {
#ifndef SKIP_UP
            for (int rep = 0; rep < REP_UP; ++rep) {
            pg8::Gemm g{hb, (const bf16*)(ws + WS_W_UP) + (size_t)L * NUP * DM, MTOK, NUP, DM}; pg8::StaticOrder S; S.init(MTOK, NUP, F.G, (int)blockIdx.x);
#ifdef PROBE_UPK
            { EpiDummy E0{halo}; pg8::gemm_phase<EpiDummy, pg8::StaticOrder, true, true>(F.lds + RING_OFF, g, S, E0, F.wave); }
#endif
            EpiUp E{ss, args.conv_w + (size_t)L * 3 * NUP, args.conv_b + (size_t)L * NUP, act, halo, (LAS float*)(F.lds + AUX_OFF)};
            pg8::gemm_phase<EpiUp, pg8::StaticOrder, true, true>(F.lds + RING_OFF, g, S, E, F.wave); }
#endif
        }
        SEAM(pb + 3);
#ifndef SKIP_FIX
        if (IN(pb + 4)) for (int rep = 0; rep < REP_FIX; ++rep) { OPQ_FRAME(F3); fixup_phase(F3, args.conv_w + (size_t)L * 3 * NUP, args.conv_b + (size_t)L * NUP, halo, act); }
#endif
        SEAM(pb + 4);
        if (IN(pb + 5)) {
#ifndef SKIP_DN
            pg8::Gemm g{act, (const bf16*)(ws + WS_W_DN) + (size_t)L * DM * FF, MTOK, DM, FF}; pg8::StaticOrder S; S.init(MTOK, DM, F.G, (int)blockIdx.x);
#ifdef REP_DN
            { EpiRes E0{nullptr, nullptr, hb, mb, halo}; pg8::gemm_phase<EpiRes, pg8::StaticOrder, true, true>(F.lds + RING_OFF, g, S, E0, F.wave); }
#endif
            EpiRes E{nullptr, L == DEPTH - 1 ? args.out : nullptr, hb, hb, ss};
            pg8::gemm_phase<EpiRes, pg8::StaticOrder, true, true>(F.lds + RING_OFF, g, S, E, F.wave);
#endif
        }
        SEAM(pb + 5);
    }
#undef IN
#undef SEAM
}

extern "C" void kernel_launch(void* const* d_in, const int* in_sizes, int n_in, void* d_out, int out_size, void* d_ws, size_t ws_size, hipStream_t stream) {
    static int grid = 0;
    if (grid == 0) {
        if (n_in != 14 || in_sizes[0] != MTOK * DM || out_size != MTOK * DM || ws_size < WS_END) { fprintf(stderr, "kernel_launch: unexpected shapes / workspace (n_in %d, ws %zu); nothing launched\n", n_in, ws_size); grid = -1; return; }
        int dev = 0, cus = 0, per_cu = 0;
        if (hipGetDevice(&dev) != hipSuccess || hipDeviceGetAttribute(&cus, hipDeviceAttributeMultiprocessorCount, dev) != hipSuccess) { grid = -1; return; }
        if (hipFuncSetAttribute((const void*)mega_fwd, hipFuncAttributeMaxDynamicSharedMemorySize, LDS_BYTES) != hipSuccess) { fprintf(stderr, "kernel_launch: hipFuncSetAttribute failed\n"); grid = -1; return; }
        if (hipOccupancyMaxActiveBlocksPerMultiprocessor(&per_cu, (const void*)mega_fwd, NWAVES * 64, LDS_BYTES) != hipSuccess || per_cu < 1) { fprintf(stderr, "kernel_launch: occupancy query reports %d blocks per CU\n", per_cu); }
        (void)hipGetLastError();
        if (cus != GRID) { fprintf(stderr, "kernel_launch: built for a %d-CU device, found %d; nothing launched\n", GRID, cus); grid = -1; return; }
        grid = GRID;
    }
    if (grid < 0) return;
    if (hipMemsetAsync((char*)d_ws + WS_CTL, 0, CTL_ZERO_BYTES, stream) != hipSuccess) return;
    Args a{};
    a.x = (const float*)d_in[0]; a.attn_norm_g = (const float*)d_in[1]; a.w_in_a = (const float*)d_in[2]; a.w_in_b = (const float*)d_in[3]; a.q_norm_g = (const float*)d_in[4];
    a.k_norm_g = (const float*)d_in[5]; a.t5_bias = (const float*)d_in[6]; a.rel_bias_b = (const float*)d_in[7]; a.w_out = (const float*)d_in[8]; a.ffn_norm_g = (const float*)d_in[9];
    a.w_up = (const float*)d_in[10]; a.conv_w = (const float*)d_in[11]; a.conv_b = (const float*)d_in[12]; a.w_down = (const float*)d_in[13];
    a.out = (float*)d_out; a.ws = (unsigned char*)d_ws; a.pad = 0;
#if MK_N_LAUNCHES == 1
    a.ph_lo = 0; a.ph_hi = N_PHASES; a.li = 0;
    hipLaunchKernelGGL(mega_fwd, dim3(grid), dim3(NWAVES * 64), LDS_BYTES, stream, a);
#else
    for (int p = 0; p < N_PHASES; ++p) { a.ph_lo = p; a.ph_hi = p + 1; a.li = p; hipLaunchKernelGGL(mega_fwd, dim3(grid), dim3(NWAVES * 64), LDS_BYTES, stream, a); }
#endif
}
```

```cpp
#include <hip/hip_runtime.h>
#include <cstdio>
#include <cstdint>
namespace pg8 {
#define PG8_LAS __attribute__((address_space(3)))
typedef unsigned short bf16_t;
typedef short bf16x8 __attribute__((ext_vector_type(8)));
typedef float f32x4 __attribute__((ext_vector_type(4)));
typedef unsigned u32x4 __attribute__((ext_vector_type(4)));
constexpr int BM = 256, BK = 64, HALF = 128, HTB = HALF * BK * 2  , STAGE_BYTES = 8 * HTB, NXCD = 8, WGM = 8;

__host__ __device__ __forceinline__ int lds_byte(int r, int c) { const int st = (r >> 4) * 2 + (c >> 5), rr = r & 15, cc = c & 31, ob = rr * 64 + cc * 2; return st * 1024 + (ob ^ (((ob >> 9) & 1) << 5)); }
__host__ __device__ __forceinline__ void stage_rc(int b, int& R, int& C) { const int st = b / 1024, sb = b % 1024, swz = sb ^ (((sb >> 9) & 1) << 5); R = (st >> 1) * 16 + swz / 64; C = (st & 1) * 32 + (swz % 64) / 2; }
__host__ __device__ __forceinline__ int perm32(int rho) { const int n = rho >> 4, i = rho & 15; return 8 * (i >> 2) + 4 * n + (i & 3); }

struct Unit { int pm, pn; };
struct Gemm { const bf16_t* A; const bf16_t* Bt; int M, N, K; };

struct StaticOrder {
    int nM, nN, nwg, G, c;
    __host__ __device__ void init(int M, int N, int G_, int c_) { nM = M / BM; nN = N / BM; nwg = nM * nN; G = G_; c = c_; }
    __host__ __device__ bool next(int i, Unit& u) const {
        const long L = (long)i * G + c; if (L >= nwg) return false;
        int wgid = (int)L; { const int q = nwg / NXCD, r = nwg % NXCD, xcd = wgid % NXCD, off = wgid / NXCD; wgid = (xcd < r ? xcd * (q + 1) : r * (q + 1) + (xcd - r) * q) + off; }
        const int nig = WGM * nN, gid = wgid / nig, fm = gid * WGM, gsz = (nM - fm) < WGM ? (nM - fm) : WGM;
        u.pm = fm + ((wgid % nig) % gsz); u.pn = (wgid % nig) / gsz; return true;
    }
    __device__ __forceinline__ void a_ready(const Unit&) const {}
    __device__ __forceinline__ void done(const Unit&) const {}
};
__device__ __forceinline__ unsigned cvt_pk_bf16(float lo, float hi) { unsigned r; asm volatile("v_cvt_pk_bf16_f32 %0, %1, %2" : "=v"(r) : "v"(lo), "v"(hi)); return r; }
template <class Epi, class Sched, bool ALIGN_EPI = false, bool SP2 = false>
__device__ __forceinline__ void gemm_phase(PG8_LAS unsigned char* lds, const Gemm g, const Sched& S, const Epi& E, const int wave_id) {
    int lane_; asm volatile("v_mbcnt_lo_u32_b32 %0, -1, 0\n\tv_mbcnt_hi_u32_b32 %0, -1, %0" : "=v"(lane_));
    int wid_ = wave_id; asm volatile("" : "+s"(wid_));
    const int wid = wid_, lane = lane_, tid = wid * 64 + lane, wr = wid >> 2, wc = wid & 3, fr = lane & 15, fq = lane >> 4;
    const int K = g.K, nt = K / BK;
    unsigned voffA[2], voffB[2];
#pragma unroll
    for (int i = 0; i < 2; ++i) { int R, C; stage_rc(tid * 16 + i * 8192, R, C); const int Rb = Epi::PERM ? ((R & ~31) + perm32(R & 31)) : R;
        const int Ra = Epi::PERMA ? ((R & ~63) | (4 * (R & 15) + ((R >> 4) & 3))) : R;
        voffA[i] = (unsigned)(Ra * K + C) * 2u; voffB[i] = (unsigned)(Rb * K + C) * 2u; }
    const size_t kstep = (size_t)(BK * 2);
    const size_t hstep = (size_t)HALF * K * 2;
    const size_t tstep = 2 * hstep;
    const unsigned ldsw = (unsigned)wid * 1024u;
    const int aoff = lds_byte(wr * 64 + fr, fq * 8), boff = lds_byte(wc * 32 + fr, fq * 8);
#define PG8_SA(b, h) (((b) * 2 + (h)) * HTB)
#define PG8_SB(b, h) ((4 + (b) * 2 + (h)) * HTB)
#define PG8_STAGE(bufoff, gbase, voff) do { _Pragma("unroll") for (int _i = 0; _i < 2; ++_i) \
        __builtin_amdgcn_global_load_lds((const unsigned*)((const char*)(gbase) + (voff)[_i]), (PG8_LAS unsigned*)(lds + (bufoff) + ldsw + _i * 8192), 16, 0, 0); } while (0)
#define PG8_LDA(dst, b, h) do { _Pragma("unroll") for (int m = 0; m < 4; ++m) _Pragma("unroll") for (int k = 0; k < 2; ++k) dst[m][k] = *(const PG8_LAS bf16x8*)(lds + PG8_SA(b, h) + aoff + m * 2048 + k * 1024); } while (0)
#define PG8_LDB(dst, b, h) do { _Pragma("unroll") for (int n = 0; n < 2; ++n) _Pragma("unroll") for (int k = 0; k < 2; ++k) dst[n][k] = *(const PG8_LAS bf16x8*)(lds + PG8_SB(b, h) + boff + n * 2048 + k * 1024); } while (0)
#define PG8_MMA(ai, bj, At, Bt) do { __builtin_amdgcn_s_setprio(1); _Pragma("unroll") for (int m = 0; m < 4; ++m) _Pragma("unroll") for (int n = 0; n < 2; ++n) _Pragma("unroll") for (int k = 0; k < 2; ++k) \
        acc[ai][bj][m][n] = __builtin_amdgcn_mfma_f32_16x16x32_bf16(Bt[n][k], At[m][k], acc[ai][bj][m][n], 0, 0, 0); __builtin_amdgcn_s_setprio(0); } while (0)
#define PG8_WAIT_V(n) asm volatile("s_waitcnt vmcnt(" #n ")" ::: "memory")
#define PG8_WAIT_L(n) asm volatile("s_waitcnt lgkmcnt(" #n ")" ::: "memory")
#define PG8_BAR __builtin_amdgcn_s_barrier()
#define PG8_SCHED __builtin_amdgcn_sched_barrier(0)
    Unit cur, nxt; int ui = 0;
    if (!S.next(0, cur)) return;
    f32x4 acc[2][2][4][2];
#pragma unroll
    for (int a = 0; a < 2; ++a)
#pragma unroll
        for (int b = 0; b < 2; ++b)
#pragma unroll
            for (int m = 0; m < 4; ++m)
#pragma unroll
                for (int n = 0; n < 2; ++n) acc[a][b][m][n] = (f32x4){0.f, 0.f, 0.f, 0.f};
    bf16x8 At[4][2], B0[2][2], B1[2][2];
    const char* cA = (const char*)g.A + (size_t)cur.pm * tstep; const char* cB = (const char*)g.Bt + (size_t)cur.pn * tstep;
    S.a_ready(cur);
    if constexpr (SP2) {
        PG8_STAGE(PG8_SB(0, 0), cB, voffB); PG8_STAGE(PG8_SB(0, 1), cB + hstep, voffB); PG8_STAGE(PG8_SA(0, 0), cA, voffA); PG8_STAGE(PG8_SA(0, 1), cA + hstep, voffA);
        if (wr == 1) PG8_BAR;
        PG8_WAIT_V(2); PG8_BAR;
        PG8_STAGE(PG8_SB(1, 0), cB + kstep, voffB); PG8_STAGE(PG8_SA(1, 0), cA + kstep, voffA); PG8_STAGE(PG8_SB(1, 1), cB + hstep + kstep, voffB);
        PG8_WAIT_V(6); PG8_BAR;
    } else {
        PG8_STAGE(PG8_SB(0, 0), cB, voffB); PG8_STAGE(PG8_SA(0, 0), cA, voffA); PG8_STAGE(PG8_SB(0, 1), cB + hstep, voffB); PG8_STAGE(PG8_SA(0, 1), cA + hstep, voffA);
        if (wr == 1) PG8_BAR;
        PG8_WAIT_V(4); PG8_BAR;
        PG8_STAGE(PG8_SB(1, 0), cB + kstep, voffB); PG8_STAGE(PG8_SA(1, 0), cA + kstep, voffA); PG8_STAGE(PG8_SB(1, 1), cB + hstep + kstep, voffB);
        PG8_WAIT_V(6); PG8_BAR;
    }
    for (;;) {
        const bool has_next = S.next(ui + 1, nxt);
        const char* nA = has_next ? (const char*)g.A + (size_t)nxt.pm * tstep : cA; const char* nB = has_next ? (const char*)g.Bt + (size_t)nxt.pn * tstep : cB;
        for (int t = 0; t < nt; t += 2) {
            const bool last = (t == nt - 2);
            const char* a1 = cA + (size_t)(t + 1) * kstep;
            const char* a2 = last ? nA : cA + (size_t)(t + 2) * kstep; const char* b2 = last ? nB : cB + (size_t)(t + 2) * kstep;
            const char* a3 = a2 + kstep; const char* b3 = b2 + kstep;
            if (last && has_next) S.a_ready(nxt);
            if constexpr (SP2) {
            PG8_LDB(B0, 0, 0); PG8_LDB(B1, 0, 1); PG8_SCHED; PG8_LDA(At, 0, 0); PG8_STAGE(PG8_SA(1, 1), a1 + hstep, voffA);
            PG8_WAIT_V(8); PG8_WAIT_L(0); PG8_BAR; PG8_MMA(0, 0, At, B0); PG8_MMA(0, 1, At, B1); PG8_BAR; PG8_SCHED;
            PG8_LDA(At, 0, 1); PG8_STAGE(PG8_SB(0, 0), b2, voffB); PG8_STAGE(PG8_SB(0, 1), b2 + hstep, voffB); PG8_STAGE(PG8_SA(0, 0), a2, voffA);
            PG8_WAIT_V(8); PG8_WAIT_L(0); PG8_BAR; PG8_MMA(1, 0, At, B0); PG8_MMA(1, 1, At, B1); PG8_BAR; PG8_SCHED;
            PG8_LDB(B0, 1, 0); PG8_LDB(B1, 1, 1); PG8_SCHED; PG8_LDA(At, 1, 0); PG8_STAGE(PG8_SA(0, 1), a2 + hstep, voffA);
            PG8_WAIT_V(8); PG8_WAIT_L(0); PG8_BAR; PG8_MMA(0, 0, At, B0); PG8_MMA(0, 1, At, B1); PG8_BAR; PG8_SCHED;
            PG8_LDA(At, 1, 1); PG8_STAGE(PG8_SB(1, 0), b3, voffB); PG8_STAGE(PG8_SB(1, 1), b3 + hstep, voffB); PG8_STAGE(PG8_SA(1, 0), a3, voffA);
            PG8_WAIT_V(8); PG8_WAIT_L(0); PG8_BAR; PG8_MMA(1, 0, At, B0); PG8_MMA(1, 1, At, B1); PG8_BAR; PG8_SCHED;
            } else {
            PG8_LDB(B0, 0, 0); PG8_SCHED; PG8_LDA(At, 0, 0); PG8_STAGE(PG8_SA(1, 1), a1 + hstep, voffA);
            PG8_WAIT_L(8); PG8_BAR; PG8_WAIT_L(0); PG8_MMA(0, 0, At, B0); PG8_BAR; PG8_SCHED;
            PG8_LDB(B1, 0, 1); PG8_STAGE(PG8_SB(0, 0), b2, voffB);
            PG8_BAR; PG8_WAIT_L(0); PG8_MMA(0, 1, At, B1); PG8_BAR;
            PG8_LDA(At, 0, 1); PG8_STAGE(PG8_SA(0, 0), a2, voffA);
            PG8_BAR; PG8_WAIT_L(0); PG8_MMA(1, 0, At, B0); PG8_BAR; PG8_SCHED;
            PG8_STAGE(PG8_SB(0, 1), b2 + hstep, voffB);
            PG8_WAIT_V(6); PG8_BAR; PG8_MMA(1, 1, At, B1); PG8_BAR;
            PG8_LDB(B0, 1, 0); PG8_SCHED; PG8_LDA(At, 1, 0); PG8_STAGE(PG8_SA(0, 1), a2 + hstep, voffA);
            PG8_WAIT_L(8); PG8_BAR; PG8_WAIT_L(0); PG8_MMA(0, 0, At, B0); PG8_BAR; PG8_SCHED;
            PG8_LDB(B1, 1, 1); PG8_STAGE(PG8_SB(1, 0), b3, voffB);
            PG8_BAR; PG8_WAIT_L(0); PG8_MMA(0, 1, At, B1); PG8_BAR;
            PG8_LDA(At, 1, 1); PG8_STAGE(PG8_SA(1, 0), a3, voffA);
            PG8_BAR; PG8_WAIT_L(0); PG8_MMA(1, 0, At, B0); PG8_BAR; PG8_SCHED;
            PG8_STAGE(PG8_SB(1, 1), b3 + hstep, voffB);
            PG8_WAIT_V(6); PG8_BAR; PG8_MMA(1, 1, At, B1); PG8_BAR;
            }
        }
        if constexpr (ALIGN_EPI) { if (wr == 0) PG8_BAR; }
        if constexpr (!Epi::AFTER_DRAIN) { E(acc, cur, wr, wc, fr, fq); S.done(cur); }
        if (!has_next) break;
#pragma unroll
        for (int a = 0; a < 2; ++a)
#pragma unroll
            for (int b = 0; b < 2; ++b)
#pragma unroll
                for (int m = 0; m < 4; ++m)
#pragma unroll
                    for (int n = 0; n < 2; ++n) acc[a][b][m][n] = (f32x4){0.f, 0.f, 0.f, 0.f};
        cur = nxt; cA = nA; cB = nB; ++ui;
        if constexpr (ALIGN_EPI) { if (wr == 1) PG8_BAR; }
    }
    PG8_WAIT_V(0);
    if constexpr (!ALIGN_EPI) { if (wr == 0) PG8_BAR; }
    PG8_BAR;
    if constexpr (Epi::AFTER_DRAIN) { E.fused(acc, cur, wr, wc, fr, fq, lds, wid, lane); S.done(cur); }
#undef PG8_SA
#undef PG8_SB
#undef PG8_STAGE
#undef PG8_LDA
#undef PG8_LDB
#undef PG8_MMA
#undef PG8_WAIT_V
#undef PG8_WAIT_L
#undef PG8_BAR
#undef PG8_SCHED
}
}

constexpr int NWAVES = 8, GRID = 256;
constexpr int BATCH = 4, SEQ = 8192, DM = 1024, MTOK = BATCH * SEQ, DEPTH = 4;
constexpr int NA_SRC = 2120, NA_PAD = 2304, NB = 3072, FF = 2816, NUP = 2 * FF;
constexpr float EPS = 1e-6f;
constexpr float LOG2E = 1.4426950408889634f;
constexpr float C2 = 0.125f * LOG2E;
constexpr int NBLK64 = MTOK / 64;

constexpr size_t MiB = 1u << 20;
constexpr size_t WS_CTL = 0, CTL_ZERO_BYTES = 1 * MiB;
constexpr size_t WS_W_INA = 2 * MiB;
constexpr size_t WS_W_INB = 11 * MiB;
constexpr size_t WS_W_OUT = 23 * MiB;
constexpr size_t WS_W_UP = 31 * MiB;
constexpr size_t WS_W_DN = 75 * MiB;
constexpr size_t WS_HB = 98 * MiB;
constexpr size_t WS_M = 162 * MiB;
constexpr size_t WS_SS = 226 * MiB;
constexpr size_t WS_HALO = 228 * MiB;
constexpr size_t WS_PROJ = 272 * MiB;
constexpr size_t WS_END = 464 * MiB;
constexpr size_t PA_QA = 0, PA_KA = 64 * MiB, PA_VA = 80 * MiB, PA_QI = 96 * MiB, PA_KI = 128 * MiB, PA_WI = 132 * MiB, PA_SEL = 136 * MiB;
constexpr size_t PB_STRIDE = 64 * MiB;
constexpr int CW_BAR = 4096;

constexpr int RING_OFF = 0, RING_BYTES = 131072;
constexpr int KS_OFF = RING_BYTES;
constexpr int AUX_OFF = RING_BYTES + 24576;
constexpr int LDSCTL_OFF = AUX_OFF + 4096, MISC_OFF = LDSCTL_OFF + 320;
constexpr int LDS_BYTES = 163840;
static_assert(MISC_OFF + 128 <= LDS_BYTES, "LDS map");

#define GAS __attribute__((address_space(1)))
#define LAS __attribute__((address_space(3)))
typedef unsigned short bf16;
typedef unsigned v4u __attribute__((ext_vector_type(4)));
typedef unsigned v2u __attribute__((ext_vector_type(2)));
typedef float f32x4 __attribute__((ext_vector_type(4)));
typedef float f32x16 __attribute__((ext_vector_type(16)));
typedef short bf16x8 __attribute__((ext_vector_type(8)));
typedef short s16x4 __attribute__((ext_vector_type(4)));
typedef float f32x2_t __attribute__((ext_vector_type(2)));
typedef GAS unsigned gu32;
#define RLX_AGENT __ATOMIC_RELAXED, __HIP_MEMORY_SCOPE_AGENT
#define LDS_WAIT() asm volatile("s_waitcnt lgkmcnt(0)" ::: "memory")
#define VM_WAIT() asm volatile("s_waitcnt vmcnt(0)" ::: "memory")
__device__ __forceinline__ unsigned f2bf(float f) { unsigned u = __builtin_bit_cast(unsigned, f); return (u + 0x7fffu + ((u >> 16) & 1u)) >> 16; }
__device__ __forceinline__ unsigned pk2(float lo, float hi) { return f2bf(lo) | (f2bf(hi) << 16); }
typedef float f32x2c_t __attribute__((ext_vector_type(2))); typedef __bf16 bf16x2c_t __attribute__((ext_vector_type(2)));
__device__ __forceinline__ unsigned cvtpk(float lo, float hi) { const f32x2c_t v = {lo, hi}; const bf16x2c_t b = __builtin_convertvector(v, bf16x2c_t); return __builtin_bit_cast(unsigned, b); }
__device__ __forceinline__ float bf_lo(unsigned u) { return __builtin_bit_cast(float, u << 16); }
__device__ __forceinline__ float bf_hi(unsigned u) { return __builtin_bit_cast(float, u & 0xffff0000u); }

#define XB_TMO      128
#define XB_XCNT(j)  (256  + 64 * (j))
#define XB_XSUB(j)  (1280 + 64 * (j))
#define XB_XGEN(j)  (2304 + 64 * (j))
#define XB_TOP      3328
#define XB_TOPGEN   3392
#define XCD_BAR_WORDS 3456
#define XB_SPIN_CAP (1u << 18)

__device__ __forceinline__ unsigned xb_ld(unsigned* p)              { return __hip_atomic_load(p, __ATOMIC_RELAXED, __HIP_MEMORY_SCOPE_AGENT); }
__device__ __forceinline__ unsigned xb_add(unsigned* p, unsigned v) { return __hip_atomic_fetch_add(p, v, __ATOMIC_RELAXED, __HIP_MEMORY_SCOPE_AGENT); }
__device__ __forceinline__ unsigned xb_xcc_id() { return (unsigned)__builtin_amdgcn_s_getreg((3 << 11) | 20) & 0xFu; }
#define XB_SPIN(cond, bar) do { unsigned _sp = 0; while (cond) { __builtin_amdgcn_s_sleep(1); \
    if ((++_sp & 255u) == 0u) { if (xb_ld(&(bar)[XB_TMO])) break; if (_sp > XB_SPIN_CAP) { atomicAdd(&(bar)[XB_TMO], 1u); break; } } } } while (0)

struct XcdBarrier {
    unsigned* bar; unsigned x;
    volatile LAS unsigned* st;
};

__device__ __forceinline__ XcdBarrier xcd_barrier_post(unsigned* bar, volatile LAS unsigned* st) {
    XcdBarrier b; b.bar = bar; b.x = xb_xcc_id(); b.st = st;
    if (threadIdx.x == 0) (void)xb_add(&bar[XB_XCNT(b.x)], 1u);
    return b;
}
__device__ __forceinline__ void xcd_barrier_complete(unsigned* bar, unsigned x, unsigned& nloc, unsigned& nx) {
    const unsigned G = gridDim.x * gridDim.y * gridDim.z;
    unsigned sum, cnt, mine, sp = 0u;
    for (;;) {
        sum = 0u; cnt = 0u; mine = 0u;
#pragma unroll
        for (unsigned j = 0; j < 16; ++j) { const unsigned c = xb_ld(&bar[XB_XCNT(j)]); sum += c; cnt += (c > 0u) ? 1u : 0u; mine = (j == x) ? c : mine; }
        if (sum == G) break;
        __builtin_amdgcn_s_sleep(1);
        if ((++sp & 255u) == 0u) { if (xb_ld(&bar[XB_TMO])) break; if (sp > XB_SPIN_CAP) { atomicAdd(&bar[XB_TMO], 1u); break; } }
    }
    nloc = mine > 0u ? mine : 1u; nx = cnt > 0u ? cnt : 1u;
}

__device__ __forceinline__ void xcd_barrier(const XcdBarrier& b) {
    asm volatile("s_waitcnt vmcnt(0)" ::: "memory");
    __syncthreads();
    if (threadIdx.x == 0) {
        unsigned* bar = b.bar;
        __builtin_amdgcn_s_waitcnt(0);
        unsigned nloc = b.st[0], nx = b.st[1];
        if (nloc == 0u) { xcd_barrier_complete(bar, b.x, nloc, nx); b.st[0] = nloc; b.st[1] = nx; }
        const unsigned old = xb_add(&bar[XB_XSUB(b.x)], 1u);
        const unsigned gen = old / nloc;
        if (old + 1u == (gen + 1u) * nloc) {
            __builtin_amdgcn_fence(__ATOMIC_RELEASE, "agent");
            asm volatile("s_waitcnt vmcnt(0)" ::: "memory");
            const unsigned og = xb_add(&bar[XB_TOP], 1u);
            const unsigned tg = og / nx;
            if (og + 1u == (tg + 1u) * nx) xb_add(&bar[XB_TOPGEN], 1u);
            else XB_SPIN(xb_ld(&bar[XB_TOPGEN]) == tg, bar);
            __builtin_amdgcn_fence(__ATOMIC_ACQUIRE, "agent");
            xb_add(&bar[XB_XGEN(b.x)], 1u);
            asm volatile("s_waitcnt vmcnt(0)" ::: "memory");
        } else {
            XB_SPIN(xb_ld(&bar[XB_XGEN(b.x)]) == gen, bar);
            __builtin_amdgcn_fence(__ATOMIC_ACQUIRE, "agent");
            asm volatile("s_waitcnt vmcnt(0)" ::: "memory");
        }
    }
    __syncthreads();
}


struct Args {
    const float* x; const float* attn_norm_g; const float* w_in_a; const float* w_in_b; const float* q_norm_g; const float* k_norm_g; const float* t5_bias;
    const float* rel_bias_b; const float* w_out; const float* ffn_norm_g; const float* w_up; const float* conv_w; const float* conv_b; const float* w_down;
    float* out; unsigned char* ws; int ph_lo, ph_hi, li, pad;
};

struct Frame {
    LAS unsigned char* lds;
    volatile LAS unsigned* MISC;
    gu32* ctl;
    int tid, lane, wave, vcu, G;
};

__host__ __device__ __forceinline__ int hmap(int p) { return 64 * ((p >> 5) & 3) + 16 * ((p >> 2) & 3) + 8 * (p >> 7) + 4 * ((p >> 4) & 1) + (p & 3); }
__host__ __device__ __forceinline__ int umap(int p) { return 32 * ((p >> 5) & 3) + 8 * ((p >> 2) & 3) + 4 * ((p >> 4) & 1) + (p & 3); }
__host__ __device__ __forceinline__ int src_col(int type, int n) {
    if (type == 0) return n;
    const int pn = n >> 8, p = n & 255;
    if (type == 2) return 256 * pn + hmap(p);
    if (type == 1) { const int c = hmap(p); return pn < 8 ? 256 * pn + c : (c < 72 ? 2048 + c : -1); }
    return (p >> 7) * FF + 128 * pn + umap(p);
}
__device__ __forceinline__ void convert_item(const float* W, int K, int Nsrc, int Ndst, int type, const float* gain, bf16* WT, LAS float* scr, int item, int lane) {
    const int nblk = Ndst / 32, kb = item / nblk, nb = item % nblk, k0 = 64 * kb, n0 = 32 * nb;
    const int sc = src_col(type, n0 + (lane & 31));
#pragma unroll 8
    for (int i = 0; i < 32; ++i) { const int kk = 2 * i + (lane >> 5); float v = 0.f; if (sc >= 0) v = W[(size_t)(k0 + kk) * Nsrc + sc]; if (gain) v *= gain[k0 + kk]; scr[kk * 33 + (lane & 31)] = v; }
    LDS_WAIT(); asm volatile("" ::: "memory");
    const int c = lane & 7;
#pragma unroll
    for (int j = 0; j < 4; ++j) { const int n = (lane >> 3) + 8 * j; const LAS float* s = scr + (8 * c) * 33 + n;
        v4u o; o.x = pk2(s[0 * 33], s[1 * 33]); o.y = pk2(s[2 * 33], s[3 * 33]); o.z = pk2(s[4 * 33], s[5 * 33]); o.w = pk2(s[6 * 33], s[7 * 33]);
        *(v4u*)(WT + (size_t)(n0 + n) * K + k0 + 8 * c) = o; }
    LDS_WAIT(); asm volatile("" ::: "memory");
}
__device__ __forceinline__ float wave_sum(float v) {
#pragma unroll
    for (int o = 1; o < 64; o <<= 1) v += __shfl_xor(v, o);
    return v;
}
__device__ __forceinline__ void p0_prologue(Frame& F, const Args& a) {
    LAS float* scr = (LAS float*)(F.lds + RING_OFF + F.wave * 16384);
    const int gw = F.vcu * NWAVES + F.wave, NGW = F.G * NWAVES;
    constexpr int I_INA = 16 * (NA_PAD / 32), I_INB = 16 * (NB / 32), I_OUT = 16 * 32, I_UP = 16 * (NUP / 32), I_DN = (FF / 64) * 32;
    constexpr int NITEMS = 2 * I_INA + 2 * I_INB + 4 * I_OUT + 4 * I_UP + 4 * I_DN;
    unsigned char* ws = a.ws;
    for (int it = gw; it < NITEMS; it += NGW) {
        int r = it;
        if (r < 2 * I_INA) { const int l = r / I_INA; convert_item(a.w_in_a + (size_t)l * DM * NA_SRC, DM, NA_SRC, NA_PAD, 1, a.attn_norm_g + (2 * l) * DM, (bf16*)(ws + WS_W_INA) + (size_t)l * NA_PAD * DM, scr, r % I_INA, F.lane); continue; } r -= 2 * I_INA;
        if (r < 2 * I_INB) { const int l = r / I_INB; convert_item(a.w_in_b + (size_t)l * DM * NB, DM, NB, NB, 2, a.attn_norm_g + (2 * l + 1) * DM, (bf16*)(ws + WS_W_INB) + (size_t)l * NB * DM, scr, r % I_INB, F.lane); continue; } r -= 2 * I_INB;
        if (r < 4 * I_OUT) { const int l = r / I_OUT; convert_item(a.w_out + (size_t)l * DM * DM, DM, DM, DM, 0, nullptr, (bf16*)(ws + WS_W_OUT) + (size_t)l * DM * DM, scr, r % I_OUT, F.lane); continue; } r -= 4 * I_OUT;
        if (r < 4 * I_UP) { const int l = r / I_UP; convert_item(a.w_up + (size_t)l * DM * NUP, DM, NUP, NUP, 3, a.ffn_norm_g + l * DM, (bf16*)(ws + WS_W_UP) + (size_t)l * NUP * DM, scr, r % I_UP, F.lane); continue; } r -= 4 * I_UP;
        { const int l = r / I_DN; convert_item(a.w_down + (size_t)l * FF * DM, FF, DM, DM, 0, nullptr, (bf16*)(ws + WS_W_DN) + (size_t)l * DM * FF, scr, r % I_DN, F.lane); }
    }
    bf16* hb = (bf16*)(ws + WS_HB); float* ss = (float*)(ws + WS_SS);
    for (int m = gw; m < MTOK; m += NGW) {
        const f32x4* xr = (const f32x4*)(a.x + (size_t)m * DM) + F.lane; f32x4 v[4]; float s = 0.f;
#pragma unroll
        for (int j = 0; j < 4; ++j) { v[j] = xr[64 * j]; s += (v[j].x * v[j].x + v[j].y * v[j].y) + (v[j].z * v[j].z + v[j].w * v[j].w); }
        s = wave_sum(s);
        v2u* o8 = (v2u*)(hb + (size_t)m * DM) + F.lane;
#pragma unroll
        for (int j = 0; j < 4; ++j) { v2u w; w.x = pk2(v[j].x, v[j].y); w.y = pk2(v[j].z, v[j].w); o8[64 * j] = w; }
        if (F.lane < 16) ss[(size_t)m * 16 + F.lane] = (F.lane == 0) ? s : 0.f;
    }
}

__device__ __forceinline__ f32x4 rstd_load(const float* ss, int row, int fq) { return *(const f32x4*)(ss + (size_t)row * 16 + 4 * fq); }
__device__ __forceinline__ float rstd_finish(f32x4 a) {
    float s = (a.x + a.y) + (a.z + a.w);
    s += __shfl_xor(s, 16); s += __shfl_xor(s, 32);
    return __builtin_amdgcn_rsqf(s * (1.0f / DM) + EPS);
}
__device__ __forceinline__ float row_rstd(const float* ss, int row, int fq) { return rstd_finish(rstd_load(ss, row, fq)); }
__device__ __forceinline__ unsigned att_pk4(f32x4 v) { int r = __builtin_amdgcn_cvt_pk_fp8_f32(v.x, v.y, 0, false); r = __builtin_amdgcn_cvt_pk_fp8_f32(v.z, v.w, r, true); return (unsigned)r; }
struct EpiIn {
    static constexpr bool PERM = false, PERMA = false, AFTER_DRAIN = false;
    const float* ss; unsigned char* proj; const float* qg; const float* kg; int isB;
    __device__ __forceinline__ void operator()(const pg8::f32x4 (&acc)[2][2][4][2], const pg8::Unit& u, int wr, int wc, int fr, int fq) const {
        asm volatile("" : "+v"(fr), "+v"(fq));
        const int pn = u.pn; int kind, pitch; bf16* dst;
        if (isB) { const int t = pn >> 2; kind = (t == 0) ? 1 : (t == 1 ? 2 : 0); dst = (bf16*)(proj + (size_t)t * PB_STRIDE) + 256 * (pn & 3); pitch = DM; }
        else if (pn < 4) { kind = 1; dst = (bf16*)(proj + PA_QA) + 256 * pn; pitch = DM; }
        else if (pn == 4) { kind = 2; dst = (bf16*)(proj + PA_KA); pitch = 256; }
        else if (pn == 5) { kind = 0; dst = (bf16*)(proj + PA_VA); pitch = 256; }
        else if (pn < 8) { kind = 0; dst = (bf16*)(proj + PA_QI) + 256 * (pn - 6); pitch = 512; }
        else { kind = 3; dst = (bf16*)(proj + PA_KI); pitch = 64; }
        if (kind == 3 && wc >= 2) return;
        const bool donorm = (kind == 1) || (kind == 2) || (kind == 3 && wc == 0);
        f32x4 g[2][2];
#pragma unroll
        for (int bj = 0; bj < 2; ++bj)
#pragma unroll
            for (int n = 0; n < 2; ++n) {
                if (kind == 1) g[bj][n] = *(const f32x4*)(qg + 16 * fq + 8 * bj + 4 * n) * (isB ? C2 : 1.0f);
                else if (kind == 2) g[bj][n] = *(const f32x4*)(kg + 16 * fq + 8 * bj + 4 * n);
                else g[bj][n] = (f32x4){1.f, 1.f, 1.f, 1.f};
            }
        float* wi = (float*)(proj + PA_WI);
        f32x4 rsl[2][4];
#pragma unroll
        for (int ai = 0; ai < 2; ++ai)
#pragma unroll
            for (int m = 0; m < 4; ++m) rsl[ai][m] = rstd_load(ss, u.pm * 256 + ai * 128 + wr * 64 + m * 16 + fr, fq);
#pragma unroll
        for (int ai = 0; ai < 2; ++ai)
#pragma unroll
            for (int m = 0; m < 4; ++m) {
                const int row = u.pm * 256 + ai * 128 + wr * 64 + m * 16 + fr;
                const float rs = rstd_finish(rsl[ai][m]);
                f32x4 v[2][2]; float s = 0.f;
#pragma unroll
                for (int bj = 0; bj < 2; ++bj)
#pragma unroll
                    for (int n = 0; n < 2; ++n) { v[bj][n] = acc[ai][bj][m][n] * rs; const f32x4 q = v[bj][n] * v[bj][n]; s += (q.x + q.y) + (q.z + q.w); }
                if (donorm) {
                    s += __shfl_xor(s, 16); s += __shfl_xor(s, 32);
                    const float r = 1.0f / sqrtf(s * (1.0f / 64.0f) + EPS);
#pragma unroll
                    for (int bj = 0; bj < 2; ++bj)
#pragma unroll
                        for (int n = 0; n < 2; ++n) v[bj][n] = v[bj][n] * r * g[bj][n];
                }
                if (kind == 3 && wc == 1) {
                    if (fq == 0) { float* wp = wi + (size_t)row * 8; const float sc = 0.04419417382415922f;
                        *(f32x4*)(wp) = v[0][0] * sc; *(f32x4*)(wp + 4) = v[0][1] * sc; }
                } else if (!isB && pn < 6) {
                    unsigned char* p8 = (pn < 4) ? proj + PA_QA + (size_t)row * 1024 + 256 * pn + 64 * wc + 16 * fq : proj + PA_KA + (size_t)row * 512 + 128 * wc + 64 * (pn - 4) + 16 * fq;
                    v4u w; w.x = att_pk4(v[0][0]); w.y = att_pk4(v[0][1]); w.z = att_pk4(v[1][0]); w.w = att_pk4(v[1][1]);
                    *(v4u*)p8 = w;
                } else {
                    bf16* rp = dst + (size_t)row * pitch + 64 * wc + 16 * fq;
#pragma unroll
                    for (int bj = 0; bj < 2; ++bj) { v4u w; w.x = cvtpk(v[bj][0].x, v[bj][0].y); w.y = cvtpk(v[bj][0].z, v[bj][0].w); w.z = cvtpk(v[bj][1].x, v[bj][1].y); w.w = cvtpk(v[bj][1].z, v[bj][1].w);
                        *(v4u*)(rp + 8 * bj) = w; }
                }
            }
    }
};
struct EpiRes {
    static constexpr bool PERM = false, PERMA = false, AFTER_DRAIN = false;
    const float* xin; float* fout; const bf16* hbi; bf16* hb; float* ss;
    __device__ __forceinline__ void operator()(const pg8::f32x4 (&acc)[2][2][4][2], const pg8::Unit& u, int wr, int wc, int fr, int fq) const {
        asm volatile("" : "+v"(fr), "+v"(fq));
        const int col0 = u.pn * 256 + wc * 32 + 4 * fq;
#pragma unroll
        for (int ai = 0; ai < 2; ++ai) {
            f32x4 base[4][2][2];
#pragma unroll
            for (int m = 0; m < 4; ++m)
#pragma unroll
                for (int bj = 0; bj < 2; ++bj)
#pragma unroll
                    for (int n = 0; n < 2; ++n) { const size_t o4 = (size_t)(u.pm * 256 + ai * 128 + wr * 64 + m * 16 + fr) * DM + col0 + bj * 128 + n * 16;
                        if (xin) base[m][bj][n] = *(const f32x4*)(xin + o4); else { const v2u b = *(const v2u*)(hbi + o4); base[m][bj][n] = (f32x4){bf_lo(b.x), bf_hi(b.x), bf_lo(b.y), bf_hi(b.y)}; } }
            asm volatile("" ::: "memory");
#pragma unroll
            for (int m = 0; m < 4; ++m) {
                const int row = u.pm * 256 + ai * 128 + wr * 64 + m * 16 + fr; const size_t off = (size_t)row * DM + col0; float s = 0.f;
#pragma unroll
                for (int bj = 0; bj < 2; ++bj)
#pragma unroll
                    for (int n = 0; n < 2; ++n) { const size_t o4 = off + bj * 128 + n * 16;
                        const f32x4 o = base[m][bj][n] + acc[ai][bj][m][n];
                        if (fout) *(f32x4*)(fout + o4) = o;
                        else { const f32x4 q = o * o; s += (q.x + q.y) + (q.z + q.w); v2u w; w.x = cvtpk(o.x, o.y); w.y = cvtpk(o.z, o.w); *(v2u*)(hb + o4) = w; } }
                if (!fout) { s += __shfl_xor(s, 16); s += __shfl_xor(s, 32); if (fq == 0) ss[(size_t)row * 16 + u.pn * 4 + wc] = s; }
            }
        }
    }
};
#ifdef X_NOBPERM
__device__ __forceinline__ float lane_from(int byteaddr, float v) { return v + (float)byteaddr; }
#else
__device__ __forceinline__ float lane_from(int byteaddr, float v) { return __builtin_bit_cast(float, __builtin_amdgcn_ds_bpermute(byteaddr, __builtin_bit_cast(int, v))); }
#endif
#ifdef X_NOSILU
__device__ __forceinline__ float silu_mul(float a, float g) { return a * g; }
#else
__device__ __forceinline__ float silu_mul(float a, float g) { return a * g * __builtin_amdgcn_rcpf(1.0f + __builtin_amdgcn_exp2f(-g * LOG2E)); }
#endif
__device__ __forceinline__ float dpp_prev_lane(float v) { return __builtin_bit_cast(float, __builtin_amdgcn_update_dpp(0, __builtin_bit_cast(int, v), 0x111  , 0xf, 0xf, true)); }
struct EpiUp {
    static constexpr bool PERM = false, PERMA = true, AFTER_DRAIN = false;
    const float* ss; const float* cw; const float* cb; bf16* act; float* halo; LAS float* cl;
    __device__ __forceinline__ void operator()(const pg8::f32x4 (&acc)[2][2][4][2], const pg8::Unit& u, int wr, int wc, int fr, int fq) const {
        asm volatile("" : "+v"(fr), "+v"(fq));
        const int colb = u.pn * 128 + wc * 32 + 8 * fq;
        const int tid_ = ((wr * 4 + wc) * 4 + fq) * 16 + fr, ce = 2 * tid_, cbj = ce >> 9, carr = (ce >> 7) & 3, cc = ce & 127;
        const f32x2_t cpre = *(const f32x2_t*)((carr < 3 ? cw + carr * NUP : cb) + cbj * FF + u.pn * 128 + cc);
        f32x4 rsl[2][4];
#pragma unroll
        for (int ai = 0; ai < 2; ++ai)
#pragma unroll
            for (int m = 0; m < 4; ++m) rsl[ai][m] = rstd_load(ss, (u.pm * 4 + ai * 2 + wr) * 64 + 4 * fr + m, fq);
        unsigned pk[2][2][4][2][2];
#pragma unroll
        for (int ai = 0; ai < 2; ++ai) {
#pragma unroll
            for (int m = 0; m < 4; ++m) {
                const float rs = rstd_finish(rsl[ai][m]);
#pragma unroll
                for (int bj = 0; bj < 2; ++bj)
#pragma unroll
                    for (int n = 0; n < 2; ++n) { const f32x4 v = acc[ai][bj][m][n] * rs; pk[ai][bj][m][n][0] = cvtpk(v.x, v.y); pk[ai][bj][m][n][1] = cvtpk(v.z, v.w); }
            }
        }
        *(LAS f32x2_t*)(cl + ce) = cpre;
        asm volatile("s_waitcnt lgkmcnt(0)" ::: "memory"); __builtin_amdgcn_s_barrier(); asm volatile("" ::: "memory");
        __builtin_amdgcn_sched_barrier(0);
        if (fr == 0 || fr == 15) {
#pragma unroll
            for (int ai = 0; ai < 2; ++ai)
#pragma unroll
                for (int j = 0; j < 2; ++j)
#pragma unroll
                    for (int bj = 0; bj < 2; ++bj)
#pragma unroll
                        for (int n = 0; n < 2; ++n) { const unsigned w0 = (fr == 0) ? pk[ai][bj][j][n][0] : pk[ai][bj][2 + j][n][0], w1 = (fr == 0) ? pk[ai][bj][j][n][1] : pk[ai][bj][2 + j][n][1];
                            *(f32x4*)(halo + ((size_t)(u.pm * 4 + ai * 2 + wr) * 4 + (fr == 0 ? j : 2 + j)) * NUP + bj * FF + colb + 4 * n) = (f32x4){bf_lo(w0), bf_hi(w0), bf_lo(w1), bf_hi(w1)}; }
        }
        __builtin_amdgcn_sched_barrier(0);
#pragma unroll
        for (int ai = 0; ai < 2; ++ai) {
            const int row0 = (u.pm * 4 + ai * 2 + wr) * 64 + 4 * fr;
            unsigned outp[4][2][2];
#pragma unroll
            for (int n = 0; n < 2; ++n) {
#pragma unroll
                for (int ip = 0; ip < 2; ++ip) {
                    f32x2_t k0[2], k1[2], k2[2], kb[2];
#pragma unroll
                    for (int bj = 0; bj < 2; ++bj) { const LAS float* c = cl + bj * 512 + wc * 32 + 8 * fq + 4 * n + 2 * ip; k0[bj] = *(const LAS f32x2_t*)(c); k1[bj] = *(const LAS f32x2_t*)(c + 128); k2[bj] = *(const LAS f32x2_t*)(c + 256); kb[bj] = *(const LAS f32x2_t*)(c + 384); }
                    float y[2][4][2];
#pragma unroll
                    for (int bj = 0; bj < 2; ++bj) {
                        const unsigned w0 = pk[ai][bj][0][n][ip], w1 = pk[ai][bj][1][n][ip], w2 = pk[ai][bj][2][n][ip], w3 = pk[ai][bj][3][n][ip];
                        const unsigned q1 = (unsigned)__builtin_amdgcn_update_dpp(0, (int)w3, 0x111, 0xf, 0xf, true), q2 = (unsigned)__builtin_amdgcn_update_dpp(0, (int)w2, 0x111, 0xf, 0xf, true);
#pragma unroll
                        for (int e = 0; e < 2; ++e) { const int i = e;
                            const float u0 = e ? bf_hi(w0) : bf_lo(w0), u1 = e ? bf_hi(w1) : bf_lo(w1), u2 = e ? bf_hi(w2) : bf_lo(w2), u3 = e ? bf_hi(w3) : bf_lo(w3), p1 = e ? bf_hi(q1) : bf_lo(q1), p2 = e ? bf_hi(q2) : bf_lo(q2);
                            y[bj][0][e] = kb[bj][i] + k0[bj][i] * p2 + k1[bj][i] * p1 + k2[bj][i] * u0;
                            y[bj][1][e] = kb[bj][i] + k0[bj][i] * p1 + k1[bj][i] * u0 + k2[bj][i] * u1;
                            y[bj][2][e] = kb[bj][i] + k0[bj][i] * u0 + k1[bj][i] * u1 + k2[bj][i] * u2;
                            y[bj][3][e] = kb[bj][i] + k0[bj][i] * u1 + k1[bj][i] * u2 + k2[bj][i] * u3; }
                    }
#pragma unroll
                    for (int m = 0; m < 4; ++m) outp[m][n][ip] = cvtpk(silu_mul(y[0][m][0], y[1][m][0]), silu_mul(y[0][m][1], y[1][m][1]));
                }
            }
#pragma unroll
            for (int m = 0; m < 4; ++m) {
                if (m < 2 && fr == 0) continue;
                v4u w; w.x = outp[m][0][0]; w.y = outp[m][0][1]; w.z = outp[m][1][0]; w.w = outp[m][1][1];
                *(v4u*)(act + (size_t)(row0 + m) * FF + colb) = w;
            }
            asm volatile("" ::: "memory");
        }
    }
};
struct EpiDummy {
    static constexpr bool PERM = false, PERMA = true, AFTER_DRAIN = false;
    float* scratch;
    __device__ __forceinline__ void operator()(const pg8::f32x4 (&acc)[2][2][4][2], const pg8::Unit& u, int wr, int wc, int fr, int fq) const {
        f32x4 s = (f32x4){0.f, 0.f, 0.f, 0.f};
#pragma unroll
        for (int ai = 0; ai < 2; ++ai)
#pragma unroll
            for (int bj = 0; bj < 2; ++bj)
#pragma unroll
                for (int m = 0; m < 4; ++m)
#pragma unroll
                    for (int n = 0; n < 2; ++n) s += acc[ai][bj][m][n];
        scratch[(size_t)(u.pm * 22 + u.pn) * 512 + ((wr * 4 + wc) * 4 + fq) * 16 + fr] = (s.x + s.y) + (s.z + s.w);
    }
};
__device__ __forceinline__ void fixup_phase(Frame& F, const float* cw, const float* cb, const float* halo, bf16* act) {
    const int gt = F.vcu * (NWAVES * 64) + F.tid, NT = F.G * NWAVES * 64;
    constexpr int C4 = FF / 4;
    for (int it = gt; it < NBLK64 * 2 * C4; it += NT) {
        const int c = (it % C4) * 4, rj = it / C4, j = rj & 1, blk = rj >> 1, t = blk * 64 + j, tb = t % SEQ;
        f32x4 y[2];
#pragma unroll
        for (int bj = 0; bj < 2; ++bj) {
            const int cc = bj * FF + c;
            const f32x4 z = (f32x4){0.f, 0.f, 0.f, 0.f};
            const f32x4 ut = *(const f32x4*)(halo + ((size_t)blk * 4 + j) * NUP + cc);
            f32x4 u1, u2;
            if (j == 1) { u1 = *(const f32x4*)(halo + ((size_t)blk * 4 + 0) * NUP + cc); u2 = (tb == 1) ? z : *(const f32x4*)(halo + ((size_t)(blk - 1) * 4 + 3) * NUP + cc); }
            else { u1 = (tb == 0) ? z : *(const f32x4*)(halo + ((size_t)(blk - 1) * 4 + 3) * NUP + cc); u2 = (tb == 0) ? z : *(const f32x4*)(halo + ((size_t)(blk - 1) * 4 + 2) * NUP + cc); }
            y[bj] = *(const f32x4*)(cb + cc) + *(const f32x4*)(cw + cc) * u2 + *(const f32x4*)(cw + NUP + cc) * u1 + *(const f32x4*)(cw + 2 * NUP + cc) * ut;
        }
        v2u w; w.x = cvtpk(silu_mul(y[0].x, y[1].x), silu_mul(y[0].y, y[1].y)); w.y = cvtpk(silu_mul(y[0].z, y[1].z), silu_mul(y[0].w, y[1].w));
        *(v2u*)(act + (size_t)t * FF + c) = w;
    }
}

__device__ __forceinline__ int crow(int r, int hi) { return (r & 3) + 8 * (r >> 2) + 4 * hi; }
__device__ __forceinline__ void glds16(const void* gsrc, unsigned lds_dst) { unsigned keep;
    asm volatile("s_mov_b32 %0, m0\n\ts_mov_b32 m0, %2\n\ts_nop 0\n\tglobal_load_lds_dwordx4 %1, off\n\ts_mov_b32 m0, %0" : "=&s"(keep) : "v"(gsrc), "s"(lds_dst) : "memory"); }
__device__ __forceinline__ float max3f(float a, float b, float c) { return fmaxf(fmaxf(a, b), c); }

namespace band {
constexpr int SLOTB = 8192;
constexpr int LDS_K = 0, LDS_V = 2 * SLOTB, LDS_WS = 4 * SLOTB, LDS_TB = LDS_WS + NWAVES * 64 * 4, LDS_OST = LDS_TB + 640 * 4 + 512, LDS_END = LDS_OST + NWAVES * 4096;
static_assert(LDS_END <= RING_BYTES, "band LDS");
__device__ __forceinline__ void unit(Frame& F, int b, int h, int U, const bf16* Q, const bf16* K, const bf16* V, bf16* O, const float* rel) {
    const int tid = F.tid, lane = F.lane, r32 = lane & 31, hi = lane >> 5, wid = F.wave;
    LAS unsigned char* shm = F.lds + RING_OFF;
    const unsigned lds0 = (unsigned)(uintptr_t)shm;
    const long rowbase = (long)b * SEQ; const int q0 = U * 256, c0 = 4 * U, cq = c0 + (wid >> 1);
    const bf16* Qw = Q + (rowbase + q0 + wid * 32) * DM + h * 64;
    const bf16* Kh = K + rowbase * DM + h * 64; const bf16* Vh = V + rowbase * DM + h * 64;
    LAS float* wsf = (LAS float*)(shm + LDS_WS) + wid * 64;
    LAS float* tb = (LAS float*)(shm + LDS_TB);
    const bf16* ksrc = Kh + (long)lane * DM + wid * 8;
    const bf16* vsrc = Vh + (long)(16 * (wid & 3) + (lane >> 2)) * DM + (wid >> 2) * 32 + (lane & 3) * 8;
    const unsigned kdst = lds0 + LDS_K + wid * 1024, vdst = lds0 + LDS_V + wid * 1024;
    const int lo = (c0 - 8 > 0) ? c0 - 8 : 0, hiT = c0 + 3, NT = hiT - lo + 1, t0 = (c0 - 5 > 0) ? c0 - 5 : 0;
#define BAND_KT(i) ((t0 + (i) <= hiT) ? t0 + (i) : lo + (t0 + (i) - hiT - 1))
    for (int i = tid; i < 640; i += NWAVES * 64) { int d = i - 64; d = d < -256 ? -256 : (d > 256 ? 256 : d); tb[i] = rel[(d + 256) * 16 + h] * LOG2E; }
    { const int kt = BAND_KT(0); glds16(ksrc + (long)kt * 64 * DM, (unsigned)__builtin_amdgcn_readfirstlane(kdst)); glds16(vsrc + (long)kt * 64 * DM, (unsigned)__builtin_amdgcn_readfirstlane(vdst)); }
    bf16x8 qr[4];
#pragma unroll
    for (int d0 = 0; d0 < 4; ++d0) qr[d0] = *(const bf16x8*)(Qw + (long)r32 * DM + d0 * 16 + hi * 8);
    float m_run = -INFINITY, l_run = 0.f; f32x16 o[2]; o[0] = f32x16{}; o[1] = f32x16{};
    const int qpos = q0 + wid * 32 + r32;
    const LAS unsigned char* vbase = shm + LDS_V + ((lane >> 4) & 1) * 32 + (lane & 3) * 8 + (4 * hi + ((lane & 15) >> 2)) * 64;
    for (int i = 0; i < NT; ++i) {
        asm volatile("s_waitcnt vmcnt(0) lgkmcnt(0)\n\ts_barrier" ::: "memory");
        if (i + 1 < NT) { const int kt = BAND_KT(i + 1); const unsigned so = ((i + 1) & 1) * SLOTB;
            glds16(ksrc + (long)kt * 64 * DM, (unsigned)__builtin_amdgcn_readfirstlane(kdst + so)); glds16(vsrc + (long)kt * 64 * DM, (unsigned)__builtin_amdgcn_readfirstlane(vdst + so)); }
        const int kt = BAND_KT(i);
        if (kt < cq - 8 || kt > cq) continue;
        const int so = (i & 1) * SLOTB;
        f32x16 p0 = f32x16{}, p1 = f32x16{};
        { const LAS unsigned char* kb = shm + LDS_K + so + hi * 1024 + r32 * 16;
#pragma unroll
          for (int d0 = 0; d0 < 4; ++d0) { const bf16x8 b0 = *(const LAS bf16x8*)(kb + d0 * 2048), b1 = *(const LAS bf16x8*)(kb + d0 * 2048 + 512);
              p0 = __builtin_amdgcn_mfma_f32_32x32x16_bf16(b0, qr[d0], p0, 0, 0, 0); p1 = __builtin_amdgcn_mfma_f32_32x32x16_bf16(b1, qr[d0], p1, 0, 0, 0); } }
        if (kt + 5 <= cq) { const float cbias = tb[639];
#pragma unroll
          for (int r = 0; r < 16; ++r) { p0[r] += cbias; p1[r] += cbias; } }
        else { const int ib = qpos - 64 * kt + 64 - 4 * hi;
#pragma unroll
          for (int r = 0; r < 16; ++r) { const int ix = ib - ((r & 3) + 8 * (r >> 2)); p0[r] += tb[ix]; p1[r] += tb[ix - 32]; } }
        float rm = p0[0];
#pragma unroll
        for (int r = 0; r < 16; ++r) rm = max3f(rm, p0[r], p1[r]);
        { auto rr = __builtin_amdgcn_permlane32_swap(__float_as_uint(rm), __float_as_uint(rm), false, false); rm = fmaxf(__uint_as_float(rr[0]), __uint_as_float(rr[1])); }
        const float mnew = fmaxf(m_run, rm), f = __builtin_amdgcn_exp2f(m_run - mnew); m_run = mnew;
        float sacc = 0.f;
#pragma unroll
        for (int r = 0; r < 16; ++r) { p0[r] = __builtin_amdgcn_exp2f(p0[r] - mnew); p1[r] = __builtin_amdgcn_exp2f(p1[r] - mnew); sacc += p0[r] + p1[r]; }
        l_run = l_run * f + sacc;
        if (!__all(f == 1.0f)) {
            if (hi == 0) wsf[r32] = f;
            LDS_WAIT();
#pragma unroll
            for (int r = 0; r < 16; ++r) { const float fr_ = wsf[crow(r, hi)]; o[0][r] *= fr_; o[1][r] *= fr_; }
        }
        v4u pw[4];
        pw[0] = (v4u){cvtpk(p0[0], p0[1]), cvtpk(p0[2], p0[3]), cvtpk(p0[4], p0[5]), cvtpk(p0[6], p0[7])};
        pw[1] = (v4u){cvtpk(p0[8], p0[9]), cvtpk(p0[10], p0[11]), cvtpk(p0[12], p0[13]), cvtpk(p0[14], p0[15])};
        pw[2] = (v4u){cvtpk(p1[0], p1[1]), cvtpk(p1[2], p1[3]), cvtpk(p1[4], p1[5]), cvtpk(p1[6], p1[7])};
        pw[3] = (v4u){cvtpk(p1[8], p1[9]), cvtpk(p1[10], p1[11]), cvtpk(p1[12], p1[13]), cvtpk(p1[14], p1[15])};
        const LAS unsigned char* vb = vbase + so;
#pragma unroll
        for (int d0 = 0; d0 < 2; ++d0)
#pragma unroll
            for (int ks = 0; ks < 4; ++ks) {
                const s16x4 vlo = __builtin_bit_cast(s16x4, __builtin_amdgcn_ds_read_tr16_b64_v4i16((LAS s16x4*)(vb + d0 * 4096 + ks * 1024)));
                const s16x4 vhi = __builtin_bit_cast(s16x4, __builtin_amdgcn_ds_read_tr16_b64_v4i16((LAS s16x4*)(vb + d0 * 4096 + ks * 1024 + 512)));
                const bf16x8 vf = (bf16x8){vlo[0], vlo[1], vlo[2], vlo[3], vhi[0], vhi[1], vhi[2], vhi[3]};
                o[d0] = __builtin_amdgcn_mfma_f32_32x32x16_bf16(__builtin_bit_cast(bf16x8, pw[ks]), vf, o[d0], 0, 0, 0);
            }
    }
#undef BAND_KT
    { auto rr = __builtin_amdgcn_permlane32_swap(__float_as_uint(l_run), __float_as_uint(l_run), false, false); l_run = __uint_as_float(rr[0]) + __uint_as_float(rr[1]); }
    if (hi == 0) wsf[32 + r32] = l_run;
    LDS_WAIT();
    float rli[16];
#pragma unroll
    for (int r = 0; r < 16; ++r) rli[r] = __builtin_amdgcn_rcpf(wsf[32 + crow(r, hi)]);
    bf16* Ow = O + (rowbase + q0 + wid * 32) * DM + h * 64;
    { LAS bf16* stg = (LAS bf16*)(shm + LDS_OST) + wid * 2048;
#pragma unroll
      for (int r = 0; r < 16; ++r) { const int orow = crow(r, hi);
#pragma unroll
          for (int d0 = 0; d0 < 2; ++d0) stg[orow * 64 + d0 * 32 + r32] = (bf16)f2bf(o[d0][r] * rli[r]); }
      LDS_WAIT();
#pragma unroll
      for (int i = 0; i < 4; ++i) { const int row = i * 8 + (lane >> 3), ch = lane & 7; const v4u v = *(const LAS v4u*)(stg + row * 64 + ch * 8); *(v4u*)(Ow + (long)row * DM + ch * 8) = v; } }
    asm volatile("s_waitcnt lgkmcnt(0)\n\ts_barrier" ::: "memory");
}
__device__ __forceinline__ void phase(Frame& F, const bf16* Q, const bf16* K, const bf16* V, bf16* O, const float* rel) {
    const int NU = BATCH * 16 * 32, per = (NU + F.G - 1) / F.G;
    for (int i = 0; i < per; ++i) { const int uid = F.vcu * per + i; if (uid >= NU) break; unit(F, uid >> 9, (uid >> 5) & 15, uid & 31, Q, K, V, O, rel); }
}
}

namespace dsa {
__device__ __forceinline__ unsigned okey(float s) { const unsigned u = __float_as_uint(s + 0.0f); return (u & 0x80000000u) ? ~u : (u | 0x80000000u); }
struct Ctx { const bf16* QA; const bf16* KA; const bf16* VA; const bf16* QI; const bf16* KI; const float* WI; bf16* M; const LAS float* t5l; unsigned short* SEL; };

__device__ __forceinline__ void scan_hist(const LAS unsigned* hq, int lane, unsigned need, unsigned& bin, unsigned& above) {
    const LAS v4u* hp = (const LAS v4u*)hq + lane * 4;
    unsigned wds[16];
#pragma unroll
    for (int j = 0; j < 4; ++j) { const v4u t = hp[j]; wds[4 * j] = t.x; wds[4 * j + 1] = t.y; wds[4 * j + 2] = t.z; wds[4 * j + 3] = t.w; }
    unsigned tl = 0;
#pragma unroll
    for (int j = 0; j < 16; ++j) tl += (wds[j] & 0xffffu) + (wds[j] >> 16);
    unsigned suf = tl;
#pragma unroll
    for (int o = 1; o < 64; o <<= 1) { const unsigned v = __shfl_down(suf, o); if (lane + o < 64) suf += v; }
    const unsigned S = suf - tl;
    const bool cross = (S < need) && (need <= S + tl);
    unsigned c = S, bsel = 0, ab = 0; bool found = false;
#pragma unroll
    for (int k = 31; k >= 0; --k) { const unsigned cnt = (wds[k >> 1] >> (16 * (k & 1))) & 0xffffu; if (!found && c + cnt >= need) { bsel = 32 * lane + k; ab = c; found = true; } c += cnt; }
    const unsigned long long bal = __ballot(cross);
    const int src = bal ? __builtin_ctzll(bal) : 0;
    bin = __shfl(bsel, src); above = __shfl(ab, src);
}

__device__ __forceinline__ void attend(const Ctx& C, const LAS unsigned short* sq, int nvalid, long rowbase, long token, int tpos, int lane, int g0) {
    asm volatile("" : "+v"(lane));
    const int l15 = lane & 15, l4 = lane >> 4;
    int sidx[16];
#pragma unroll
    for (int ti = 0; ti < 16; ++ti) sidx[ti] = sq[ti * 16 + l15];
    unsigned bpk[4] = {0u, 0u, 0u, 0u};
#pragma unroll
    for (int ti = 0; ti < 16; ++ti) { const int rel = sidx[ti] - tpos, n = rel < 0 ? -rel : rel;
        const int bk = (rel > 0 ? 16 : 0) + (n < 8 ? n : 8 + (n >= 12) + (n >= 16) + (n >= 23) + (n >= 32) + (n >= 46) + (n >= 64) + (n >= 91));
        bpk[ti >> 2] |= (unsigned)bk << (8 * (ti & 3)); }
#pragma unroll 1
    for (int g = g0; g < g0 + 2; ++g) {
        const bf16* qp = C.QA + token * DM + (4 * g + (lane & 3)) * 64 + 8 * l4;
        const bf16x8 qf0 = *(const bf16x8*)qp, qf1 = *(const bf16x8*)(qp + 32);
        const bf16* kbase = C.KA + rowbase * 256 + g * 64 + 8 * l4;
        f32x4 S[16];
#pragma unroll
        for (int hh = 0; hh < 4; ++hh) {
            bf16x8 kf0[4], kf1[4];
#pragma unroll
            for (int j = 0; j < 4; ++j) { const bf16* kp = kbase + (long)sidx[hh * 4 + j] * 256; kf0[j] = *(const bf16x8*)kp; kf1[j] = *(const bf16x8*)(kp + 32); }
#pragma unroll
            for (int j = 0; j < 4; ++j) { const int ti = hh * 4 + j;
                f32x4 a = *(const LAS f32x4*)(C.t5l + ((bpk[hh] >> (8 * j)) & 255u) * 16 + 4 * g);
                asm volatile("v_mfma_f32_16x16x32_bf16 %0, %1, %2, %0" : "+v"(a) : "v"(qf0), "v"(kf0[j]));
                asm volatile("v_mfma_f32_16x16x32_bf16 %0, %1, %2, %0" : "+v"(a) : "v"(qf1), "v"(kf1[j]));
                S[ti] = a; }
            asm volatile("s_nop 15\n\ts_nop 7" : "+v"(S[hh * 4]), "+v"(S[hh * 4 + 1]), "+v"(S[hh * 4 + 2]), "+v"(S[hh * 4 + 3]));
        }
#pragma unroll
        for (int ti = 0; ti < 16; ++ti) if (ti * 16 >= nvalid) S[ti] = (f32x4){-INFINITY, -INFINITY, -INFINITY, -INFINITY};
        f32x4 mx = S[0];
#pragma unroll
        for (int ti = 1; ti < 16; ++ti) { mx.x = fmaxf(mx.x, S[ti].x); mx.y = fmaxf(mx.y, S[ti].y); mx.z = fmaxf(mx.z, S[ti].z); mx.w = fmaxf(mx.w, S[ti].w); }
#pragma unroll
        for (int o = 1; o < 16; o <<= 1) { mx.x = fmaxf(mx.x, __shfl_xor(mx.x, o)); mx.y = fmaxf(mx.y, __shfl_xor(mx.y, o)); mx.z = fmaxf(mx.z, __shfl_xor(mx.z, o)); mx.w = fmaxf(mx.w, __shfl_xor(mx.w, o)); }
        f32x4 ls = (f32x4){0.f, 0.f, 0.f, 0.f};
        unsigned P01[16], P23[16];
#pragma unroll
        for (int ti = 0; ti < 16; ++ti) { const float e0 = __builtin_amdgcn_exp2f(S[ti].x - mx.x), e1 = __builtin_amdgcn_exp2f(S[ti].y - mx.y), e2 = __builtin_amdgcn_exp2f(S[ti].z - mx.z), e3 = __builtin_amdgcn_exp2f(S[ti].w - mx.w);
            ls += (f32x4){e0, e1, e2, e3}; P01[ti] = cvtpk(e0, e1); P23[ti] = cvtpk(e2, e3); }
#pragma unroll
        for (int o = 1; o < 16; o <<= 1) { ls.x += __shfl_xor(ls.x, o); ls.y += __shfl_xor(ls.y, o); ls.z += __shfl_xor(ls.z, o); ls.w += __shfl_xor(ls.w, o); }
        float o_[4][16];
#pragma unroll
        for (int h = 0; h < 4; ++h)
#pragma unroll
            for (int d = 0; d < 16; ++d) o_[h][d] = 0.f;
        const bf16* vbase = C.VA + rowbase * 256 + g * 64 + 16 * l4;
#pragma unroll
        for (int hh = 0; hh < 4; ++hh) {
            v4u va[4], vb[4];
#pragma unroll
            for (int j = 0; j < 4; ++j) { const v4u* vp = (const v4u*)(vbase + (long)sidx[hh * 4 + j] * 256); va[j] = vp[0]; vb[j] = vp[1]; }
#pragma unroll
            for (int j = 0; j < 4; ++j) { const int ti = hh * 4 + j; const v4u v0 = va[j], v1 = vb[j];
                float vf[16];
                vf[0] = bf_lo(v0.x); vf[1] = bf_hi(v0.x); vf[2] = bf_lo(v0.y); vf[3] = bf_hi(v0.y); vf[4] = bf_lo(v0.z); vf[5] = bf_hi(v0.z); vf[6] = bf_lo(v0.w); vf[7] = bf_hi(v0.w);
                vf[8] = bf_lo(v1.x); vf[9] = bf_hi(v1.x); vf[10] = bf_lo(v1.y); vf[11] = bf_hi(v1.y); vf[12] = bf_lo(v1.z); vf[13] = bf_hi(v1.z); vf[14] = bf_lo(v1.w); vf[15] = bf_hi(v1.w);
                const float p0 = bf_lo(P01[ti]), p1 = bf_hi(P01[ti]), p2 = bf_lo(P23[ti]), p3 = bf_hi(P23[ti]);
#pragma unroll
                for (int d = 0; d < 16; ++d) { o_[0][d] += p0 * vf[d]; o_[1][d] += p1 * vf[d]; o_[2][d] += p2 * vf[d]; o_[3][d] += p3 * vf[d]; } }
        }
        float res[4];
#pragma unroll
        for (int h = 0; h < 4; ++h) {
            float a8[8], a4[4], a2[2];
            const bool b3 = (l15 & 8) != 0, b2 = (l15 & 4) != 0, b1 = (l15 & 2) != 0, b0 = (l15 & 1) != 0;
#pragma unroll
            for (int d = 0; d < 8; ++d) { const float keep = b3 ? o_[h][d + 8] : o_[h][d], send = b3 ? o_[h][d] : o_[h][d + 8]; a8[d] = keep + __shfl_xor(send, 8); }
#pragma unroll
            for (int d = 0; d < 4; ++d) { const float keep = b2 ? a8[d + 4] : a8[d], send = b2 ? a8[d] : a8[d + 4]; a4[d] = keep + __shfl_xor(send, 4); }
#pragma unroll
            for (int d = 0; d < 2; ++d) { const float keep = b1 ? a4[d + 2] : a4[d], send = b1 ? a4[d] : a4[d + 2]; a2[d] = keep + __shfl_xor(send, 2); }
            { const float keep = b0 ? a2[1] : a2[0], send = b0 ? a2[0] : a2[1]; res[h] = keep + __shfl_xor(send, 1); }
        }
        bf16* mp = C.M + token * DM + (4 * g) * 64 + lane;
        mp[0] = (bf16)f2bf(res[0] * __builtin_amdgcn_rcpf(ls.x)); mp[64] = (bf16)f2bf(res[1] * __builtin_amdgcn_rcpf(ls.y)); mp[128] = (bf16)f2bf(res[2] * __builtin_amdgcn_rcpf(ls.z)); mp[192] = (bf16)f2bf(res[3] * __builtin_amdgcn_rcpf(ls.w));
    }
}

constexpr int CAND_CAP = 256;
constexpr int SELKS_OFF = KS_OFF;
__device__ __forceinline__ float relu_i(float x) { const int i = __builtin_bit_cast(int, x); return __builtin_bit_cast(float, i > 0 ? i : 0); }
struct SelState { unsigned pre[4], need[4], cnt[4], tcnt[4]; };
__device__ __forceinline__ void tile_mfma(f32x16 (&acc)[2], const LAS unsigned char* kf, const int (&koff)[4], const bf16x8 (&qa)[4]) {
#pragma unroll
    for (int h2 = 0; h2 < 2; ++h2) { acc[h2] = f32x16{};
#pragma unroll
        for (int ks = 0; ks < 4; ++ks) { const bf16x8 kb = *(const LAS bf16x8*)(kf + koff[ks] + h2 * 4096); acc[h2] = __builtin_amdgcn_mfma_f32_32x32x16_bf16(qa[ks], kb, acc[h2], 0, 0, 0); } }
}
template <class ActionT>
__device__ __forceinline__ void tile_valu(const f32x16 (&acc)[2], const f32x2_t (&wp)[2][4], int kbase, ActionT&& act) {
#pragma unroll
    for (int h2 = 0; h2 < 2; ++h2) {
        f32x2_t sa = {0.f, 0.f}, sb = {0.f, 0.f};
#pragma unroll
        for (int jp = 0; jp < 4; ++jp) {
            const f32x2_t ra = {relu_i(acc[h2][2 * jp]), relu_i(acc[h2][2 * jp + 1])};
            const f32x2_t rb = {relu_i(acc[h2][8 + 2 * jp]), relu_i(acc[h2][8 + 2 * jp + 1])};
            sa = __builtin_elementwise_fma(ra, wp[0][jp], sa); sb = __builtin_elementwise_fma(rb, wp[1][jp], sb); }
        act(kbase + h2 * 32, (sa.x + sa.y) + 0.0f, (sb.x + sb.y) + 0.0f);
    }
}
constexpr int KSLOTS = 3;
__device__ __forceinline__ void wait_tile(int newer) {
    if (newer >= 4) asm volatile("s_waitcnt vmcnt(4) lgkmcnt(0)\n\ts_barrier" ::: "memory");
    else if (newer == 3) asm volatile("s_waitcnt vmcnt(3) lgkmcnt(0)\n\ts_barrier" ::: "memory");
    else if (newer == 2) asm volatile("s_waitcnt vmcnt(2) lgkmcnt(0)\n\ts_barrier" ::: "memory");
    else if (newer == 1) asm volatile("s_waitcnt vmcnt(1) lgkmcnt(0)\n\ts_barrier" ::: "memory");
    else asm volatile("s_waitcnt vmcnt(0) lgkmcnt(0)\n\ts_barrier" ::: "memory");
}
template <class ActionT>
__device__ __forceinline__ void tile_pass(Frame& F, const bf16* ksrc, unsigned kdst, const LAS unsigned char* kfr, const int (&koff)[4], int NT, const bf16x8 (&qa)[4], const f32x2_t (&wp)[2][4], ActionT&& act) {
    asm volatile("s_waitcnt lgkmcnt(0)\n\ts_barrier" ::: "memory");
    const int npre = NT < KSLOTS ? NT : KSLOTS;
    for (int j = 0; j < npre; ++j) glds16(ksrc + (long)j * 4096, (unsigned)__builtin_amdgcn_readfirstlane(kdst + j * 8192));
    wait_tile(npre - 1);
    f32x16 accA[2], accB[2];
    tile_mfma(accA, kfr, koff, qa);
    int sl = 0;
    int kt = 0;
    for (; kt + 2 < NT; kt += 2) {
        { const int inflight = (NT - kt - 2) < (KSLOTS - 2) ? (NT - kt - 2) : (KSLOTS - 2); wait_tile(inflight); }
        if (kt + KSLOTS < NT) glds16(ksrc + (long)(kt + KSLOTS) * 4096, (unsigned)__builtin_amdgcn_readfirstlane(kdst + sl * 8192));
        sl = (sl == KSLOTS - 1) ? 0 : sl + 1;
        tile_mfma(accB, kfr + sl * 8192, koff, qa);
        tile_valu(accA, wp, kt * 64, act);
        { const int inflight = (NT - kt - 3) < (KSLOTS - 2) ? (NT - kt - 3) : (KSLOTS - 2); wait_tile(inflight); }
        if (kt + 1 + KSLOTS < NT) glds16(ksrc + (long)(kt + 1 + KSLOTS) * 4096, (unsigned)__builtin_amdgcn_readfirstlane(kdst + sl * 8192));
        sl = (sl == KSLOTS - 1) ? 0 : sl + 1;
        tile_mfma(accA, kfr + sl * 8192, koff, qa);
        tile_valu(accB, wp, (kt + 1) * 64, act);
    }
    if (kt + 1 < NT) {
        wait_tile(0);
        sl = (sl == KSLOTS - 1) ? 0 : sl + 1;
        tile_mfma(accB, kfr + sl * 8192, koff, qa);
        tile_valu(accA, wp, kt * 64, act);
        tile_valu(accB, wp, (kt + 1) * 64, act);
    } else tile_valu(accA, wp, kt * 64, act);
    LDS_WAIT();
}
__device__ __forceinline__ void scan_hist_cnt(const LAS unsigned* hq, int lane, unsigned need, unsigned& bin, unsigned& above, unsigned& bcnt) {
    const LAS v4u* hp = (const LAS v4u*)hq + lane * 2;
    unsigned wds[8];
#pragma unroll
    for (int j = 0; j < 2; ++j) { const v4u t = hp[j]; wds[4 * j] = t.x; wds[4 * j + 1] = t.y; wds[4 * j + 2] = t.z; wds[4 * j + 3] = t.w; }
    unsigned tl = 0;
#pragma unroll
    for (int j = 0; j < 8; ++j) tl += wds[j];
    unsigned suf = tl;
#pragma unroll
    for (int o = 1; o < 64; o <<= 1) { const unsigned v = __shfl_down(suf, o); if (lane + o < 64) suf += v; }
    const unsigned S = suf - tl;
    const bool cross = (S < need) && (need <= S + tl);
    unsigned c = S, bsel = 0, ab = 0, bc = 0; bool found = false;
#pragma unroll
    for (int k = 7; k >= 0; --k) { const unsigned cnt = wds[k]; if (!found && c + cnt >= need) { bsel = 8 * lane + k; ab = c; bc = cnt; found = true; } c += cnt; }
    const unsigned long long bal = __ballot(cross);
    const int src = bal ? __builtin_ctzll(bal) : 0;
    bin = __builtin_amdgcn_readfirstlane(__shfl(bsel, src)); above = __builtin_amdgcn_readfirstlane(__shfl(ab, src)); bcnt = __builtin_amdgcn_readfirstlane(__shfl(bc, src));
}
__device__ __forceinline__ void step(Frame& F, const Ctx& C, int b, int c, int half) {
    int lane_ = F.lane; asm volatile("" : "+v"(lane_));
    const int lane = lane_, r = lane & 31, hi = lane >> 5, wave = F.wave;
    LAS unsigned* hist = (LAS unsigned*)(F.lds + RING_OFF + wave * 16384);
    LAS unsigned short* sel = (LAS unsigned short*)hist;
    LAS unsigned* cand = hist + 2048;
    LAS unsigned* fbflag = (LAS unsigned*)(F.lds + AUX_OFF + 2048);
    const long rowbase = (long)b * SEQ;
    const int tq0 = 64 * c + 32 * half + 4 * wave;
    const int N = 64 * (c + 1), NT = c + 1;
    int nvalid = 256;
    if (N <= 256) {
        nvalid = N;
        for (int j = lane; j < 4 * 256; j += 64) sel[j] = (unsigned short)(((j & 255) < N) ? (j & 255) : 0);
    } else {
        const int aq = 2 * ((r >> 2) & 1) + (r >> 4), ah = 4 * ((r >> 3) & 1) + (r & 3);
        const bf16* qip = C.QI + (rowbase + tq0 + aq) * 512 + ah * 64 + 8 * hi;
        bf16x8 qa[4];
#pragma unroll
        for (int ks = 0; ks < 4; ++ks) qa[ks] = *(const bf16x8*)(qip + 16 * ks);
        f32x2_t wp[2][4];
#pragma unroll
        for (int t = 0; t < 2; ++t) { const float* wq = C.WI + (rowbase + tq0 + 2 * hi + t) * 8; const f32x4 w0 = *(const f32x4*)wq, w1 = *(const f32x4*)(wq + 4);
            wp[t][0] = (f32x2_t){w0.x, w0.y}; wp[t][1] = (f32x2_t){w0.z, w0.w}; wp[t][2] = (f32x2_t){w1.x, w1.y}; wp[t][3] = (f32x2_t){w1.z, w1.w}; }
        float Bq;
        { float ssq = 0.f;
#pragma unroll
          for (int ks = 0; ks < 4; ++ks)
#pragma unroll
              for (int e = 0; e < 8; ++e) { const float v = bf_lo((unsigned)(unsigned short)qa[ks][e]); ssq += v * v; }
          ssq += __shfl_xor(ssq, 32);
          float term = fabsf(C.WI[(rowbase + tq0 + aq) * 8 + ah]) * sqrtf(ssq);
          term += __shfl_xor(term, 1); term += __shfl_xor(term, 2); term += __shfl_xor(term, 8);
          Bq = term * 8.25f + 1e-20f; }
        const float B0 = __shfl(Bq, (hi << 2)), B1 = __shfl(Bq, (hi << 2) | 16);
        const float sc0 = 1024.0f / B0, sc1 = 1024.0f / B1;
        asm volatile("" :: "v"(qa[0]), "v"(qa[1]), "v"(qa[2]), "v"(qa[3]));
        asm volatile("" :: "v"(wp[0][0]), "v"(wp[0][1]), "v"(wp[0][2]), "v"(wp[0][3]), "v"(wp[1][0]), "v"(wp[1][1]), "v"(wp[1][2]), "v"(wp[1][3]), "v"(sc0), "v"(sc1));
        const bf16* ksrc = C.KI + rowbase * 64 + (long)(wave * 8 + (lane >> 3)) * 64 + ((lane & 7) ^ (lane >> 3)) * 8;
        const unsigned kdst = (unsigned)(uintptr_t)(F.lds + SELKS_OFF) + wave * 1024;
        const LAS unsigned char* kfr = F.lds + SELKS_OFF + r * 128;
        int koff[4];
#pragma unroll
        for (int ks = 0; ks < 4; ++ks) koff[ks] = ((2 * ks + hi) ^ (r & 7)) * 16;
        const unsigned below = (1u << r) - 1u;
        LAS v4u* hz = (LAS v4u*)hist;
        if (wave == 0 && lane == 0) *fbflag = 0u;
#pragma unroll
        for (int j = 0; j < 8; ++j) hz[j * 64 + lane] = (v4u){0u, 0u, 0u, 0u};
        tile_pass(F, ksrc, kdst, kfr, koff, NT, qa, wp, [&](int kbase, float s0, float s1) {
            const int b0 = (int)__builtin_amdgcn_fmed3f(__builtin_fmaf(s0, sc0, 256.0f), 0.0f, 511.0f), b1 = (int)__builtin_amdgcn_fmed3f(__builtin_fmaf(s1, sc1, 256.0f), 0.0f, 511.0f);
            __hip_atomic_fetch_add(hist + (2 * hi) * 512 + b0, 1u, __ATOMIC_RELAXED, __HIP_MEMORY_SCOPE_WORKGROUP);
            __hip_atomic_fetch_add(hist + (2 * hi + 1) * 512 + b1, 1u, __ATOMIC_RELAXED, __HIP_MEMORY_SCOPE_WORKGROUP);
        });
#ifdef PROBE_SKEL
        tile_pass(F, ksrc, kdst, kfr, koff, NT, qa, wp, [&](int kbase, float s0, float s1) { });
#endif
#ifdef PROBE_SCORE
        { float dsum = 0.f; tile_pass(F, ksrc, kdst, kfr, koff, NT, qa, wp, [&](int kbase, float s0, float s1) { dsum += s0 + s1; }); if (dsum == 12345.678f) hist[0] = 1u; }
#endif
        SelState st;
        unsigned tbin[4], bcn[4]; bool ovf = false;
#pragma unroll
        for (int ql = 0; ql < 4; ++ql) { unsigned above; scan_hist_cnt(hist + ql * 512, lane, 256u, tbin[ql], above, bcn[ql]); st.cnt[ql] = 0u; st.tcnt[ql] = 0u; st.need[ql] = 256u - above; st.pre[ql] = above;
#ifdef PROBE_OVF
            ovf |= bcn[ql] > (unsigned)PROBE_OVF; }
#else
            ovf |= bcn[ql] > (unsigned)CAND_CAP; }
#endif
        LDS_WAIT();
        if (ovf && lane == 0) *fbflag = 1u;
        asm volatile("s_waitcnt lgkmcnt(0)\n\ts_barrier" ::: "memory");
#ifdef PROBE_NOFB
        const bool fb = false;
#elif defined(PROBE_NOFB2)
        const bool fb = __builtin_amdgcn_readfirstlane((int)*fbflag) == 0x7fffffff;
#else
        const bool fb = __builtin_amdgcn_readfirstlane((int)*fbflag) != 0;
#endif
        if (!fb) {
            const int tb0 = (int)(hi ? tbin[2] : tbin[0]), tb1 = (int)(hi ? tbin[3] : tbin[1]);
            tile_pass(F, ksrc, kdst, kfr, koff, NT, qa, wp, [&](int kbase, float s0, float s1) {
#pragma unroll
                for (int t = 0; t < 2; ++t) {
                    const float s = t ? s1 : s0; const int bin = (int)__builtin_amdgcn_fmed3f(__builtin_fmaf(s, (t ? sc1 : sc0), 256.0f), 0.0f, 511.0f), tb = t ? tb1 : tb0;
                    const bool gt = bin > tb, eq = bin == tb;
                    const unsigned long long mg = __ballot(gt), me = __ballot(eq);
                    const unsigned mgh = hi ? (unsigned)(mg >> 32) : (unsigned)mg, meh = hi ? (unsigned)(me >> 32) : (unsigned)me;
                    const unsigned pos = (hi ? st.cnt[2 + t] : st.cnt[t]) + __builtin_popcount(mgh & below);
                    sel[(gt && pos < 256u) ? (2 * hi + t) * 256 + pos : 3200 + lane] = (unsigned short)(kbase + r);
                    const unsigned cpos = (hi ? st.tcnt[2 + t] : st.tcnt[t]) + __builtin_popcount(meh & below);
                    { LAS unsigned* cp = hist + ((eq && cpos < (unsigned)CAND_CAP) ? 2048 + ((2 * hi + t) * CAND_CAP + cpos) * 2 : 1700 + 2 * lane); cp[0] = okey(s); cp[1] = (unsigned)(kbase + r); }
                    st.cnt[t] += __builtin_popcount((unsigned)mg); st.cnt[2 + t] += __builtin_popcount((unsigned)(mg >> 32));
                    st.tcnt[t] += __builtin_popcount((unsigned)me); st.tcnt[2 + t] += __builtin_popcount((unsigned)(me >> 32));
                }
            });
#pragma unroll
            for (int ql = 0; ql < 4; ++ql) {
                const unsigned nc = bcn[ql], G = st.pre[ql], rq = st.need[ql];
                const LAS unsigned* cq = cand + ql * CAND_CAP * 2;
                unsigned ki4[4], xi4[4], rk4[4];
#pragma unroll
                for (int m = 0; m < 4; ++m) { const unsigned i = (unsigned)lane + 64u * m; ki4[m] = (i < nc) ? cq[2 * i] : 0u; xi4[m] = (i < nc) ? cq[2 * i + 1] : 0u; rk4[m] = 0u; }
                for (unsigned j = 0; j < nc; ++j) { const unsigned kj = cq[2 * j];
#pragma unroll
                    for (int m = 0; m < 4; ++m) rk4[m] += (kj > ki4[m] || (kj == ki4[m] && j < (unsigned)lane + 64u * m)) ? 1u : 0u; }
                unsigned base = G; const unsigned long long lt = (1ull << lane) - 1ull;
#pragma unroll
                for (int m = 0; m < 4; ++m) { const bool take = ((unsigned)lane + 64u * m < nc) && rk4[m] < rq; const unsigned long long mm = __ballot(take);
                    const unsigned pos = base + __builtin_popcountll(mm & lt); if (take && pos < 256u) sel[ql * 256 + pos] = (unsigned short)xi4[m]; base += __builtin_popcountll(mm); }
            }
        } else {
#pragma unroll
            for (int ql = 0; ql < 4; ++ql) { st.pre[ql] = 0u; st.need[ql] = 256u; st.cnt[ql] = 0u; st.tcnt[ql] = 0u; }
#pragma unroll 1
            for (int lev = 0; lev < 4; ++lev) {
#pragma unroll
                for (int j = 0; j < 8; ++j) hz[j * 64 + lane] = (v4u){0u, 0u, 0u, 0u};
                const unsigned pre0 = hi ? st.pre[2] : st.pre[0], pre1 = hi ? st.pre[3] : st.pre[1];
                const int sh = (lev == 0) ? 23 : (lev == 1) ? 14 : (lev == 2) ? 5 : 0, wd = (lev == 3) ? 5 : 9;
                tile_pass(F, ksrc, kdst, kfr, koff, NT, qa, wp, [&](int kbase, float s0, float s1) {
                    const unsigned k0 = okey(s0), k1 = okey(s1);
                    const unsigned b0 = (k0 >> sh) & ((1u << wd) - 1u), b1 = (k1 >> sh) & ((1u << wd) - 1u);
                    const bool in0 = (lev == 0) || ((k0 >> (sh + wd)) == pre0), in1 = (lev == 0) || ((k1 >> (sh + wd)) == pre1);
                    if (in0) __hip_atomic_fetch_add(hist + (2 * hi) * 512 + b0, 1u, __ATOMIC_RELAXED, __HIP_MEMORY_SCOPE_WORKGROUP);
                    if (in1) __hip_atomic_fetch_add(hist + (2 * hi + 1) * 512 + b1, 1u, __ATOMIC_RELAXED, __HIP_MEMORY_SCOPE_WORKGROUP);
                });
#pragma unroll
                for (int ql = 0; ql < 4; ++ql) { unsigned bin, above, bc; scan_hist_cnt(hist + ql * 512, lane, st.need[ql], bin, above, bc);
                    st.pre[ql] = (st.pre[ql] << wd) | bin; st.need[ql] -= above; }
                LDS_WAIT();
            }
            const unsigned T0 = hi ? st.pre[2] : st.pre[0], T1 = hi ? st.pre[3] : st.pre[1], rq0 = hi ? st.need[2] : st.need[0], rq1 = hi ? st.need[3] : st.need[1];
            tile_pass(F, ksrc, kdst, kfr, koff, NT, qa, wp, [&](int kbase, float s0, float s1) {
#pragma unroll
                for (int t = 0; t < 2; ++t) {
                    const unsigned kk = okey(t ? s1 : s0), T = t ? T1 : T0, rq = t ? rq1 : rq0;
                    const bool gt = kk > T, eq = kk == T;
                    const unsigned long long me = __ballot(eq);
                    const unsigned meh = hi ? (unsigned)(me >> 32) : (unsigned)me;
                    const unsigned trank = (hi ? st.tcnt[2 + t] : st.tcnt[t]) + __builtin_popcount(meh & below);
                    const bool take = gt || (eq && trank < rq);
                    const unsigned long long mt = __ballot(take);
                    const unsigned mth = hi ? (unsigned)(mt >> 32) : (unsigned)mt;
                    const unsigned pos = (hi ? st.cnt[2 + t] : st.cnt[t]) + __builtin_popcount(mth & below);
                    if (take && pos < 256u) sel[(2 * hi + t) * 256 + pos] = (unsigned short)(kbase + r);
                    st.cnt[t] += __builtin_popcount((unsigned)mt); st.cnt[2 + t] += __builtin_popcount((unsigned)(mt >> 32));
                    st.tcnt[t] += __builtin_popcount((unsigned)me); st.tcnt[2 + t] += __builtin_popcount((unsigned)(me >> 32));
                }
            });
        }
    }
    LDS_WAIT();
    { const LAS v4u* s4 = (const LAS v4u*)sel; v4u* g4 = (v4u*)(C.SEL + (rowbase + tq0) * 256);
#pragma unroll
      for (int j = 0; j < 2; ++j) g4[j * 64 + lane] = s4[j * 64 + lane]; }
    LDS_WAIT();
}
__device__ __forceinline__ void phase(Frame& F, const Ctx& C) {
    for (int v = F.vcu; v < 256; v += F.G) {
        const int b = v >> 6, c = v & 63;
#pragma unroll 1
        for (int it = 0; it < 4; ++it) step(F, C, b, (it < 2) ? c : 127 - c, it & 1);
    }
}
__device__ __forceinline__ void attn_phase(Frame& F, const Ctx& C) {
    int lane = F.lane; asm volatile("" : "+v"(lane));
    LAS unsigned short* sq = (LAS unsigned short*)(F.lds + RING_OFF + F.wave * 16384);
    const int nx = F.G / 32;
    for (int x = F.vcu / 32; x < 8; x += nx) {
        const int b = x >> 1, g0 = 2 * (x & 1); const long rowbase = (long)b * SEQ;
        const int w = (F.vcu & 31) * NWAVES + F.wave;
#pragma unroll 1
        for (int t = w; t < SEQ; t += 32 * NWAVES) {
            { const v4u* g4 = (const v4u*)(C.SEL + (rowbase + t) * 256); if (lane < 32) ((LAS v4u*)sq)[lane] = g4[lane]; }
            LDS_WAIT();
            const int N = 64 * ((t >> 6) + 1), nvalid = N < 256 ? N : 256;
            attend(C, sq, nvalid, rowbase, rowbase + t, t, lane, g0);
            LDS_WAIT();
        }
    }
}
}

namespace att8 {
typedef int v2i __attribute__((ext_vector_type(2)));
struct Ctx8 { const unsigned char* QA8; const unsigned char* KV8; const unsigned short* SEL; bf16* M; };
constexpr int T2_OFF = KS_OFF, T2_BYTES = 155 * 16 * 4, SELL_OFF = KS_OFF + 10240;
static_assert(T2_BYTES <= 10240 && SELL_OFF + NWAVES * 1024 <= AUX_OFF, "attention LDS map");
__device__ __forceinline__ void mfma8(f32x4& acc, long a, long b) { asm volatile("v_mfma_f32_16x16x32_fp8_fp8 %0, %1, %2, %0" : "+v"(acc) : "v"(a), "v"(b)); }
__device__ __forceinline__ unsigned pk4_fp8(float a, float b, float c, float d) { int r = __builtin_amdgcn_cvt_pk_fp8_f32(a, b, 0, false); r = __builtin_amdgcn_cvt_pk_fp8_f32(c, d, r, true); return (unsigned)r; }

__device__ __forceinline__ void gld16(v4u& dst, const void* p) { asm volatile("global_load_dwordx4 %0, %1, off" : "=v"(dst) : "v"(p) : "memory"); }
__device__ __forceinline__ void issue_kq(const Ctx8& C, const LAS unsigned short* sq, long rowbase, long token, int g, int l15, int l4, int h, v4u (&kr)[16], v4u& qv) {
    const unsigned char* kvb = C.KV8 + rowbase * 512 + g * 128 + 16 * l4;
#pragma unroll
    for (int j = 0; j < 16; ++j) gld16(kr[j], kvb + (long)sq[j * 16 + l15] * 512);
    gld16(qv, C.QA8 + token * 1024 + (4 * g + h) * 64 + 16 * l4);
}
__device__ __forceinline__ void issue_v_half(const Ctx8& C, const LAS unsigned short* sq, long rowbase, int g, int lane, unsigned vbase, int half) {
    const unsigned char* kvb = C.KV8 + rowbase * 512 + g * 128 + 64; const int kq = lane >> 2, p = lane & 3;
#pragma unroll
    for (int j = 0; j < 8; ++j) { const int ti = half * 8 + j; const int key = sq[ti * 16 + kq]; const int x = ((kq >> 2) & 1) | ((ti & 1) << 1);
        glds16(kvb + (long)key * 512 + 16 * (p ^ x), (unsigned)__builtin_amdgcn_readfirstlane(vbase + ti * 1024)); }
}
__device__ __forceinline__ void phase(Frame& F, const Ctx8& C, const float* t5) {
    int lane = F.lane; asm volatile("" : "+v"(lane));
    LAS float* T2 = (LAS float*)(F.lds + T2_OFF);
    for (int e = F.tid; e < 155 * 16; e += NWAVES * 64) { const int rel = (e >> 4) - 91, n = rel < 0 ? -rel : rel;
        const int bk = (rel > 0 ? 16 : 0) + (n < 8 ? n : 8 + (n >= 12) + (n >= 16) + (n >= 23) + (n >= 32) + (n >= 46) + (n >= 64) + (n >= 91));
        T2[e] = t5[bk * 16 + (e & 15)] * 8.0f; }
    __syncthreads();
    LAS unsigned short* sqb = (LAS unsigned short*)(F.lds + SELL_OFF + F.wave * 1024);
    LAS unsigned char* vreg = F.lds + RING_OFF + F.wave * 16384;
    const unsigned vbase = (unsigned)(uintptr_t)vreg;
    const int l15 = lane & 15, l4 = lane >> 4, h = l15 & 3;
    const int trk = 4 * l4 + ((l15 >> 1) & 3), trt = (l15 >> 3) & 1, xs = (l4 & 1) | (trt << 1);
    const int troff = trt * 1024 + trk * 64 + 8 * (l15 & 1);
    const int x = F.vcu / 32, b = x >> 1, g0 = 2 * (x & 1); const long rowbase = (long)b * SEQ;
    const int w = (F.vcu & 31) * NWAVES + F.wave;
    constexpr int NQ = SEQ / (32 * NWAVES), NI = 2 * NQ;
    if (lane < 32) { ((LAS v4u*)sqb)[lane] = ((const v4u*)(C.SEL + (rowbase + w) * 256))[lane]; ((LAS v4u*)(sqb + 256))[lane] = ((const v4u*)(C.SEL + (rowbase + w + 32 * NWAVES) * 256))[lane]; }
    LDS_WAIT();
    v4u kr[16], qv, pf = (v4u){0u, 0u, 0u, 0u};
    issue_kq(C, sqb, rowbase, rowbase + w, g0, l15, l4, h, kr, qv);
    issue_v_half(C, sqb, rowbase, g0, lane, vbase, 0); issue_v_half(C, sqb, rowbase, g0, lane, vbase, 1);
    unsigned cib[16];
#pragma unroll 1
    for (int idx = 0; idx < NI; ++idx) {
        const int qn = idx >> 1, gi = idx & 1, g = g0 + gi, t = w + 32 * NWAVES * qn;
        const LAS unsigned short* sq = sqb + (qn & 1) * 256;
        const int nidx = (idx + 1 < NI) ? idx + 1 : idx, nq = nidx >> 1, ng = g0 + (nidx & 1), nt = w + 32 * NWAVES * nq;
        const LAS unsigned short* nsq = sqb + (nq & 1) * 256;
        if (gi == 1) { asm volatile("s_waitcnt vmcnt(34)" : "+v"(pf) :: "memory"); if (lane < 32) ((LAS v4u*)(sqb + (qn & 1) * 256))[lane] = pf; }
        { const int pq = (qn + 2 < NQ) ? qn + 2 : NQ - 1; gld16(pf, (const v4u*)(C.SEL + (rowbase + w + 32 * NWAVES * pq) * 256) + (lane & 31)); }
        if (idx == 0) asm volatile("s_waitcnt vmcnt(0)" : "+v"(qv), "+v"(kr[0]), "+v"(kr[1]), "+v"(kr[2]), "+v"(kr[3]), "+v"(kr[4]), "+v"(kr[5]), "+v"(kr[6]), "+v"(kr[7]), "+v"(kr[8]), "+v"(kr[9]), "+v"(kr[10]), "+v"(kr[11]), "+v"(kr[12]), "+v"(kr[13]), "+v"(kr[14]), "+v"(kr[15]) :: "memory");
        else asm volatile("s_waitcnt vmcnt(20)" : "+v"(qv), "+v"(kr[0]), "+v"(kr[1]), "+v"(kr[2]), "+v"(kr[3]), "+v"(kr[4]), "+v"(kr[5]), "+v"(kr[6]), "+v"(kr[7]), "+v"(kr[8]), "+v"(kr[9]), "+v"(kr[10]), "+v"(kr[11]), "+v"(kr[12]), "+v"(kr[13]), "+v"(kr[14]), "+v"(kr[15]) :: "memory");
        if (gi == 0) {
#pragma unroll
            for (int ti = 0; ti < 16; ++ti) { const v2u i4 = *(const LAS v2u*)(sq + ti * 16 + 4 * l4);
                const int r0 = (int)(i4.x & 0xffffu) - t, r1 = (int)(i4.x >> 16) - t, r2 = (int)(i4.y & 0xffffu) - t, r3 = (int)(i4.y >> 16) - t;
                const int c0 = min(max(r0, -91), 63) + 91, c1 = min(max(r1, -91), 63) + 91, c2 = min(max(r2, -91), 63) + 91, c3 = min(max(r3, -91), 63) + 91;
                cib[ti] = (unsigned)c0 | ((unsigned)c1 << 8) | ((unsigned)c2 << 16) | ((unsigned)c3 << 24); }
        }
        const int N = 64 * ((t >> 6) + 1), nvalid = N < 256 ? N : 256;
        const long q0 = (long)(((unsigned long long)qv.y << 32) | qv.x), q1 = (long)(((unsigned long long)qv.w << 32) | qv.z);
        f32x4 S[16];
#pragma unroll
        for (int ti = 0; ti < 16; ++ti) { const unsigned cb = cib[ti];
            f32x4 a; a.x = T2[(cb & 255u) * 16 + 4 * g + h]; a.y = T2[((cb >> 8) & 255u) * 16 + 4 * g + h]; a.z = T2[((cb >> 16) & 255u) * 16 + 4 * g + h]; a.w = T2[(cb >> 24) * 16 + 4 * g + h];
            mfma8(a, (long)(((unsigned long long)kr[ti].y << 32) | kr[ti].x), q0);
            mfma8(a, (long)(((unsigned long long)kr[ti].w << 32) | kr[ti].z), q1);
            S[ti] = a; }
        asm volatile("s_nop 15\n\ts_nop 7" : "+v"(S[0]), "+v"(S[1]), "+v"(S[2]), "+v"(S[3]), "+v"(S[4]), "+v"(S[5]), "+v"(S[6]), "+v"(S[7]), "+v"(S[8]), "+v"(S[9]), "+v"(S[10]), "+v"(S[11]), "+v"(S[12]), "+v"(S[13]), "+v"(S[14]), "+v"(S[15]));
        issue_kq(C, nsq, rowbase, rowbase + nt, ng, l15, l4, h, kr, qv);
#pragma unroll
        for (int ti = 0; ti < 16; ++ti) if (ti * 16 >= nvalid) S[ti] = (f32x4){-INFINITY, -INFINITY, -INFINITY, -INFINITY};
        float mx = S[0].x;
#pragma unroll
        for (int ti = 0; ti < 16; ++ti) mx = fmaxf(fmaxf(mx, fmaxf(S[ti].x, S[ti].y)), fmaxf(S[ti].z, S[ti].w));
        mx = fmaxf(mx, __shfl_xor(mx, 16)); mx = fmaxf(mx, __shfl_xor(mx, 32));
        const float mc = -mx * C2; float ls = 0.f;
        long P8[8];
#pragma unroll
        for (int j = 0; j < 8; ++j) { float e[8];
#pragma unroll
            for (int q = 0; q < 4; ++q) { e[q] = __builtin_amdgcn_exp2f(__builtin_fmaf(S[2 * j][q], C2, mc)); e[4 + q] = __builtin_amdgcn_exp2f(__builtin_fmaf(S[2 * j + 1][q], C2, mc)); }
            ls += ((e[0] + e[1]) + (e[2] + e[3])) + ((e[4] + e[5]) + (e[6] + e[7]));
            const unsigned lo = pk4_fp8(e[0] * 256.f, e[1] * 256.f, e[2] * 256.f, e[3] * 256.f), hi = pk4_fp8(e[4] * 256.f, e[5] * 256.f, e[6] * 256.f, e[7] * 256.f);
            P8[j] = (long)(((unsigned long long)hi << 32) | lo); }
        ls += __shfl_xor(ls, 16); ls += __shfl_xor(ls, 32);
        f32x4 D[4];
#pragma unroll
        for (int db = 0; db < 4; ++db) D[db] = (f32x4){0.f, 0.f, 0.f, 0.f};
#pragma unroll
        for (int hf = 0; hf < 2; ++hf) {
            asm volatile("s_waitcnt vmcnt(28)" ::: "memory");
#pragma unroll
            for (int j = 4 * hf; j < 4 * hf + 4; ++j)
#pragma unroll
                for (int db = 0; db < 4; ++db) {
                    const v2i vv = __builtin_amdgcn_ds_read_tr8_b64_v2i32((LAS v2i*)(vreg + j * 2048 + troff + 16 * (db ^ xs)));
                    mfma8(D[db], P8[j], __builtin_bit_cast(long, vv)); }
            asm volatile("s_waitcnt lgkmcnt(0)" ::: "memory");
            issue_v_half(C, nsq, rowbase, ng, lane, vbase, hf);
        }
        asm volatile("s_nop 15\n\ts_nop 7" : "+v"(D[0]), "+v"(D[1]), "+v"(D[2]), "+v"(D[3]));
        const float lh = __shfl(ls, l4);
        const float inv = __builtin_amdgcn_rcpf(lh * 256.f);
        bf16* mp = C.M + (rowbase + t) * DM + (4 * g + l4) * 64 + l15;
#pragma unroll
        for (int db = 0; db < 4; ++db) { const float v = (l4 == 0) ? D[db].x : (l4 == 1) ? D[db].y : (l4 == 2) ? D[db].z : D[db].w; const unsigned short ob = (unsigned short)f2bf(v * inv);
            asm volatile("global_store_short %0, %1, off" :: "v"(mp + 16 * db), "v"((unsigned)ob) : "memory"); }
    }
    asm volatile("s_waitcnt vmcnt(0)" ::: "memory");
}
}

#ifndef REP_P0
#define REP_P0 1
#endif
#ifndef REP_IN
#define REP_IN 1
#endif
#ifndef REP_DSA
#define REP_DSA 1
#endif
#ifndef REP_BAND
#define REP_BAND 1
#endif
#ifndef REP_UP
#define REP_UP 1
#endif
#ifndef REP_FIX
#define REP_FIX 1
#endif
constexpr int N_PHASES = 1 + 6 * DEPTH;
#ifndef MK_N_LAUNCHES
#define MK_N_LAUNCHES 1
#endif
__global__ void __launch_bounds__(NWAVES * 64, 2) mega_fwd(Args args) {
    extern __shared__ __attribute__((aligned(16))) unsigned char lds[];
    Frame F;
    F.lds = (LAS unsigned char*)lds;
    F.MISC = (volatile LAS unsigned*)(F.lds + MISC_OFF);
    F.tid = threadIdx.x; F.lane = F.tid & 63; F.wave = __builtin_amdgcn_readfirstlane(F.tid >> 6);
    F.G = GRID; { const int bx = blockIdx.x; F.vcu = (bx & 7) * (GRID / 8) + (bx >> 3); }
    unsigned char* ws = args.ws;
    F.ctl = (gu32*)(ws + WS_CTL);
    for (int u = F.tid; u < (LDS_BYTES - LDSCTL_OFF) / 4; u += NWAVES * 64) ((LAS unsigned*)(F.lds + LDSCTL_OFF))[u] = 0u;
    __syncthreads();
    XcdBarrier bar; bar.bar = (unsigned*)(F.ctl + CW_BAR); bar.x = 0; bar.st = nullptr;
    if (MK_N_LAUNCHES == 1) bar = xcd_barrier_post((unsigned*)(F.ctl + CW_BAR), F.MISC + 8);
    const int lo = args.ph_lo, hi = args.ph_hi;
#define IN(k) (lo <= (k) && (k) < hi)
#define OPQ_FRAME(Fl) Frame Fl = F; { int l_; asm volatile("v_mbcnt_lo_u32_b32 %0, -1, 0\n\tv_mbcnt_hi_u32_b32 %0, -1, %0" : "=v"(l_)); int w_ = F.wave; asm volatile("" : "+s"(w_)); Fl.wave = w_; Fl.lane = l_; Fl.tid = w_ * 64 + l_; }
#define SEAM(k) do { if (IN(k) && IN((k) + 1)) xcd_barrier(bar); } while (0)

    bf16* hb = (bf16*)(ws + WS_HB); bf16* mb = (bf16*)(ws + WS_M); float* ss = (float*)(ws + WS_SS); float* halo = (float*)(ws + WS_HALO);
    unsigned char* proj = ws + WS_PROJ; bf16* act = (bf16*)(ws + WS_PROJ);

#ifndef SKIP_P0
    if (IN(0)) { for (int rep = 0; rep < REP_P0; ++rep) { OPQ_FRAME(F0); p0_prologue(F0, args); } }
#endif
    SEAM(0);

#pragma unroll 1
    for (int L = 0; L < DEPTH; ++L) {
        const int pb = 1 + 6 * L, li = L >> 1; const bool isB = (L & 1) != 0;
        if (IN(pb)) {
#ifndef SKIP_IN
            for (int rep = 0; rep < REP_IN; ++rep)
            if (!isB) {
                pg8::Gemm g{hb, (const bf16*)(ws + WS_W_INA) + (size_t)li * NA_PAD * DM, MTOK, NA_PAD, DM}; pg8::StaticOrder S; S.init(MTOK, NA_PAD, F.G, (int)blockIdx.x);
                EpiIn E{ss, proj, args.q_norm_g + L * 64, args.k_norm_g + L * 64, 0};
                pg8::gemm_phase<EpiIn, pg8::StaticOrder, true, true>(F.lds + RING_OFF, g, S, E, F.wave);
            } else {
                pg8::Gemm g{hb, (const bf16*)(ws + WS_W_INB) + (size_t)li * NB * DM, MTOK, NB, DM}; pg8::StaticOrder S; S.init(MTOK, NB, F.G, (int)blockIdx.x);
                EpiIn E{ss, proj, args.q_norm_g + L * 64, args.k_norm_g + L * 64, 1};
                pg8::gemm_phase<EpiIn, pg8::StaticOrder, true, true>(F.lds + RING_OFF, g, S, E, F.wave);
            }
#endif
        }
        SEAM(pb);
#if defined(DBG_NODSA) || defined(DBG_NOBAND)
#ifdef DBG_NODSA
        const bool zero_m = !isB;
#else
        const bool zero_m = isB;
#endif
        if (IN(pb + 1) && zero_m) { for (size_t i = (size_t)blockIdx.x * 512 + threadIdx.x; i < (size_t)MTOK * DM / 8; i += (size_t)gridDim.x * 512) ((v4u*)mb)[i] = (v4u){0u, 0u, 0u, 0u}; }
        if (IN(pb + 1) && !zero_m) {
#else
        if (IN(pb + 1)) {
#endif
#ifndef SKIP_DSA
            if (!isB) {
                LAS float* t5l = (LAS float*)(F.lds + AUX_OFF);
                { OPQ_FRAME(Ft); for (int i = Ft.tid; i < 512; i += NWAVES * 64) t5l[i] = args.t5_bias[i] * LOG2E; }
                __syncthreads();
                dsa::Ctx C{(const bf16*)(proj + PA_QA), (const bf16*)(proj + PA_KA), (const bf16*)(proj + PA_VA), (const bf16*)(proj + PA_QI), (const bf16*)(proj + PA_KI), (const float*)(proj + PA_WI), mb, t5l, (unsigned short*)(proj + PA_SEL)};
#ifdef DBG_DSACOPY
                { int t_ = threadIdx.x; asm volatile("" : "+v"(t_));
                for (unsigned i = blockIdx.x * 512u + (unsigned)t_; i < (unsigned)MTOK * DM; i += gridDim.x * 512u) { const unsigned t = i >> 10, c = i & 1023u;
                    float v = bf_lo(C.QA[i]); v += bf_lo(C.KA[t * 256 + (c & 255)]); v += bf_lo(C.VA[t * 256 + (c & 255)]); v += bf_lo(C.QI[t * 512 + (c & 511)]); v += bf_lo(C.KI[t * 64 + (c & 63)]); v += C.WI[t * 8 + (c & 7)];
                    mb[i] = (bf16)f2bf(v * 0.01f); asm volatile("" ::: "memory"); } }
#else
                for (int rep = 0; rep < REP_DSA; ++rep) { OPQ_FRAME(F1); dsa::phase(F1, C); }
                xcd_barrier(bar);
                { OPQ_FRAME(F1b); att8::Ctx8 C8{(const unsigned char*)(proj + PA_QA), (const unsigned char*)(proj + PA_KA), (const unsigned short*)(proj + PA_SEL), mb};
#ifndef REP_ATT8
#define REP_ATT8 1
#endif
                  for (int rep = 0; rep < REP_ATT8; ++rep) { att8::phase(F1b, C8, args.t5_bias); __syncthreads(); } }
#endif
            }
#endif
#ifndef SKIP_BAND
            if (isB) {
                for (int rep = 0; rep < REP_BAND; ++rep) { OPQ_FRAME(F2); band::phase(F2, (const bf16*)proj, (const bf16*)(proj + PB_STRIDE), (const bf16*)(proj + 2 * PB_STRIDE), mb, args.rel_bias_b + (size_t)li * 513 * 16); }
            }
#endif
        }
        SEAM(pb + 1);
        if (IN(pb + 2)) {
#ifndef SKIP_OUT
            pg8::Gemm g{mb, (const bf16*)(ws + WS_W_OUT) + (size_t)L * DM * DM, MTOK, DM, DM}; pg8::StaticOrder S; S.init(MTOK, DM, F.G, (int)blockIdx.x);
#ifdef REP_OUT
            { EpiRes E0{L == 0 ? args.x : nullptr, nullptr, hb, (bf16*)proj, halo}; pg8::gemm_phase<EpiRes, pg8::StaticOrder, true, true>(F.lds + RING_OFF, g, S, E0, F.wave); }
#endif
            EpiRes E{L == 0 ? args.x : nullptr, nullptr, hb, hb, ss};
            pg8::gemm_phase<EpiRes, pg8::StaticOrder, true, true>(F.lds + RING_OFF, g, S, E, F.wave);
#endif
        }
        SEAM(pb + 2);
        if (IN(pb + 3)) {
#ifndef SKIP_UP
            for (int rep = 0; rep < REP_UP; ++rep) {
            pg8::Gemm g{hb, (const bf16*)(ws + WS_W_UP) + (size_t)L * NUP * DM, MTOK, NUP, DM}; pg8::StaticOrder S; S.init(MTOK, NUP, F.G, (int)blockIdx.x);
#ifdef PROBE_UPK
            { EpiDummy E0{halo}; pg8::gemm_phase<EpiDummy, pg8::StaticOrder, true, true>(F.lds + RING_OFF, g, S, E0, F.wave); }
#endif
            EpiUp E{ss, args.conv_w + (size_t)L * 3 * NUP, args.conv_b + (size_t)L * NUP, act, halo, (LAS float*)(F.lds + AUX_OFF)};
            pg8::gemm_phase<EpiUp, pg8::StaticOrder, true, true>(F.lds + RING_OFF, g, S, E, F.wave); }
#endif
        }
        SEAM(pb + 3);
#ifndef SKIP_FIX
        if (IN(pb + 4)) for (int rep = 0; rep < REP_FIX; ++rep) { OPQ_FRAME(F3); fixup_phase(F3, args.conv_w + (size_t)L * 3 * NUP, args.conv_b + (size_t)L * NUP, halo, act); }
#endif
        SEAM(pb + 4);
        if (IN(pb + 5)) {
#ifndef SKIP_DN
            pg8::Gemm g{act, (const bf16*)(ws + WS_W_DN) + (size_t)L * DM * FF, MTOK, DM, FF}; pg8::StaticOrder S; S.init(MTOK, DM, F.G, (int)blockIdx.x);
#ifdef REP_DN
            { EpiRes E0{nullptr, nullptr, hb, mb, halo}; pg8::gemm_phase<EpiRes, pg8::StaticOrder, true, true>(F.lds + RING_OFF, g, S, E0, F.wave); }
#endif
            EpiRes E{nullptr, L == DEPTH - 1 ? args.out : nullptr, hb, hb, ss};
            pg8::gemm_phase<EpiRes, pg8::StaticOrder, true, true>(F.lds + RING_OFF, g, S, E, F.wave);
#endif
        }
        SEAM(pb + 5);
    }
#undef IN
#undef SEAM
}

extern "C" void kernel_launch(void* const* d_in, const int* in_sizes, int n_in, void* d_out, int out_size, void* d_ws, size_t ws_size, hipStream_t stream) {
    static int grid = 0;
    if (grid == 0) {
        if (n_in != 14 || in_sizes[0] != MTOK * DM || out_size != MTOK * DM || ws_size < WS_END) { fprintf(stderr, "kernel_launch: unexpected shapes / workspace (n_in %d, ws %zu); nothing launched\n", n_in, ws_size); grid = -1; return; }
        int dev = 0, cus = 0, per_cu = 0;
        if (hipGetDevice(&dev) != hipSuccess || hipDeviceGetAttribute(&cus, hipDeviceAttributeMultiprocessorCount, dev) != hipSuccess) { grid = -1; return; }
        if (hipFuncSetAttribute((const void*)mega_fwd, hipFuncAttributeMaxDynamicSharedMemorySize, LDS_BYTES) != hipSuccess) { fprintf(stderr, "kernel_launch: hipFuncSetAttribute failed\n"); grid = -1; return; }
        if (hipOccupancyMaxActiveBlocksPerMultiprocessor(&per_cu, (const void*)mega_fwd, NWAVES * 64, LDS_BYTES) != hipSuccess || per_cu < 1) { fprintf(stderr, "kernel_launch: occupancy query reports %d blocks per CU\n", per_cu); }
        (void)hipGetLastError();
        if (cus != GRID) { fprintf(stderr, "kernel_launch: built for a %d-CU device, found %d; nothing launched\n", GRID, cus); grid = -1; return; }
        grid = GRID;
    }
    if (grid < 0) return;
    if (hipMemsetAsync((char*)d_ws + WS_CTL, 0, CTL_ZERO_BYTES, stream) != hipSuccess) return;
    Args a{};
    a.x = (const float*)d_in[0]; a.attn_norm_g = (const float*)d_in[1]; a.w_in_a = (const float*)d_in[2]; a.w_in_b = (const float*)d_in[3]; a.q_norm_g = (const float*)d_in[4];
    a.k_norm_g = (const float*)d_in[5]; a.t5_bias = (const float*)d_in[6]; a.rel_bias_b = (const float*)d_in[7]; a.w_out = (const float*)d_in[8]; a.ffn_norm_g = (const float*)d_in[9];
    a.w_up = (const float*)d_in[10]; a.conv_w = (const float*)d_in[11]; a.conv_b = (const float*)d_in[12]; a.w_down = (const float*)d_in[13];
    a.out = (float*)d_out; a.ws = (unsigned char*)d_ws; a.pad = 0;
#if MK_N_LAUNCHES == 1
    a.ph_lo = 0; a.ph_hi = N_PHASES; a.li = 0;
    hipLaunchKernelGGL(mega_fwd, dim3(grid), dim3(NWAVES * 64), LDS_BYTES, stream, a);
#else
    for (int p = 0; p < N_PHASES; ++p) { a.ph_lo = p; a.ph_hi = p + 1; a.li = p; hipLaunchKernelGGL(mega_fwd, dim3(grid), dim3(NWAVES * 64), LDS_BYTES, stream, a); }
#endif
}
```

```cpp
#include <hip/hip_runtime.h>
#include <cstdio>
#include <cstdint>
namespace pg8 {
#define PG8_LAS __attribute__((address_space(3)))
typedef unsigned short bf16_t;
typedef short bf16x8 __attribute__((ext_vector_type(8)));
typedef float f32x4 __attribute__((ext_vector_type(4)));
typedef unsigned u32x4 __attribute__((ext_vector_type(4)));
typedef int i32x4 __attribute__((ext_vector_type(4)));
typedef int i32x8 __attribute__((ext_vector_type(8)));
constexpr int BM = 256, BK = 64, HALF = 128, HTB = HALF * BK * 2  , STAGE_BYTES = 8 * HTB, NXCD = 8, WGM = 8;

__host__ __device__ __forceinline__ int lds_byte(int r, int c) { const int st = (r >> 4) * 2 + (c >> 5), rr = r & 15, cc = c & 31, ob = rr * 64 + cc * 2; return st * 1024 + (ob ^ (((ob >> 9) & 1) << 5)); }
__host__ __device__ __forceinline__ void stage_rc(int b, int& R, int& C) { const int st = b / 1024, sb = b % 1024, swz = sb ^ (((sb >> 9) & 1) << 5); R = (st >> 1) * 16 + swz / 64; C = (st & 1) * 32 + (swz % 64) / 2; }
__host__ __device__ __forceinline__ int perm32(int rho) { const int n = rho >> 4, i = rho & 15; return 8 * (i >> 2) + 4 * n + (i & 3); }

struct Unit { int pm, pn; };
struct Gemm { const bf16_t* A; const bf16_t* Bt; int M, N, K; };

struct StaticOrder {
    int nM, nN, nwg, G, c;
    __host__ __device__ void init(int M, int N, int G_, int c_) { nM = M / BM; nN = N / BM; nwg = nM * nN; G = G_; c = c_; }
    __host__ __device__ bool next(int i, Unit& u) const {
        const long L = (long)i * G + c; if (L >= nwg) return false;
        int wgid = (int)L; { const int q = nwg / NXCD, r = nwg % NXCD, xcd = wgid % NXCD, off = wgid / NXCD; wgid = (xcd < r ? xcd * (q + 1) : r * (q + 1) + (xcd - r) * q) + off; }
        const int nig = WGM * nN, gid = wgid / nig, fm = gid * WGM, gsz = (nM - fm) < WGM ? (nM - fm) : WGM;
        u.pm = fm + ((wgid % nig) % gsz); u.pn = (wgid % nig) / gsz; return true;
    }
    __device__ __forceinline__ void a_ready(const Unit&) const {}
    __device__ __forceinline__ void done(const Unit&) const {}
};
__device__ __forceinline__ unsigned cvt_pk_bf16(float lo, float hi) { unsigned r; asm volatile("v_cvt_pk_bf16_f32 %0, %1, %2" : "=v"(r) : "v"(lo), "v"(hi)); return r; }
template <class Epi, class Sched, bool ALIGN_EPI = false, bool SP2 = false, bool F8 = false>
__device__ __forceinline__ void gemm_phase(PG8_LAS unsigned char* lds, const Gemm g, const Sched& S, const Epi& E, const int wave_id) {
    int lane_; asm volatile("v_mbcnt_lo_u32_b32 %0, -1, 0\n\tv_mbcnt_hi_u32_b32 %0, -1, %0" : "=v"(lane_));
    int wid_ = wave_id; asm volatile("" : "+s"(wid_));
    const int wid = wid_, lane = lane_, tid = wid * 64 + lane, wr = wid >> 2, wc = wid & 3, fr = lane & 15, fq = lane >> 4;
    const int K = g.K, nt = K / BK;
    unsigned voffA[2], voffB[2];
#pragma unroll
    for (int i = 0; i < 2; ++i) { int R, C; stage_rc(tid * 16 + i * 8192, R, C); const int Rb = Epi::PERM ? ((R & ~31) + perm32(R & 31)) : R;
        const int Ra = Epi::PERMA ? ((R & ~63) | (4 * (R & 15) + ((R >> 4) & 3))) : R;
        voffA[i] = (unsigned)(Ra * K + C) * 2u; voffB[i] = (unsigned)(Rb * K + C) * 2u; }
    const size_t kstep = (size_t)(BK * 2);
    const size_t hstep = (size_t)HALF * K * 2;
    const size_t tstep = 2 * hstep;
    const unsigned ldsw = (unsigned)wid * 1024u;
    const int aoff = lds_byte(wr * 64 + fr, fq * 8), boff = lds_byte(wc * 32 + fr, fq * 8);
#define PG8_SA(b, h) (((b) * 2 + (h)) * HTB)
#define PG8_SB(b, h) ((4 + (b) * 2 + (h)) * HTB)
#define PG8_STAGE(bufoff, gbase, voff) do { _Pragma("unroll") for (int _i = 0; _i < 2; ++_i) \
        __builtin_amdgcn_global_load_lds((const unsigned*)((const char*)(gbase) + (voff)[_i]), (PG8_LAS unsigned*)(lds + (bufoff) + ldsw + _i * 8192), 16, 0, 0); } while (0)
#define PG8_LDA(dst, b, h) do { _Pragma("unroll") for (int m = 0; m < 4; ++m) _Pragma("unroll") for (int k = 0; k < 2; ++k) dst[m][k] = *(const PG8_LAS bf16x8*)(lds + PG8_SA(b, h) + aoff + m * 2048 + k * 1024); } while (0)
#define PG8_LDB(dst, b, h) do { _Pragma("unroll") for (int n = 0; n < 2; ++n) _Pragma("unroll") for (int k = 0; k < 2; ++k) dst[n][k] = *(const PG8_LAS bf16x8*)(lds + PG8_SB(b, h) + boff + n * 2048 + k * 1024); } while (0)
#define PG8_CAT(lo, hi) __builtin_shufflevector(__builtin_bit_cast(i32x4, lo), __builtin_bit_cast(i32x4, hi), 0, 1, 2, 3, 4, 5, 6, 7)
#define PG8_MMA(ai, bj, At, Bt) do { __builtin_amdgcn_s_setprio(1); _Pragma("unroll") for (int m = 0; m < 4; ++m) _Pragma("unroll") for (int n = 0; n < 2; ++n) { \
        if constexpr (F8) { const i32x8 b8_ = PG8_CAT(Bt[n][0], Bt[n][1]), a8_ = PG8_CAT(At[m][0], At[m][1]); asm volatile("v_mfma_f32_16x16x128_f8f6f4 %0, %1, %2, %0" : "+v"(acc[ai][bj][m][n]) : "v"(b8_), "v"(a8_)); } \
        else { _Pragma("unroll") for (int k = 0; k < 2; ++k) acc[ai][bj][m][n] = __builtin_amdgcn_mfma_f32_16x16x32_bf16(Bt[n][k], At[m][k], acc[ai][bj][m][n], 0, 0, 0); } } __builtin_amdgcn_s_setprio(0); } while (0)
#define PG8_WAIT_V(n) asm volatile("s_waitcnt vmcnt(" #n ")" ::: "memory")
#define PG8_WAIT_L(n) asm volatile("s_waitcnt lgkmcnt(" #n ")" ::: "memory")
#define PG8_BAR __builtin_amdgcn_s_barrier()
#define PG8_SCHED __builtin_amdgcn_sched_barrier(0)
    Unit cur, nxt; int ui = 0;
    if (!S.next(0, cur)) return;
    f32x4 acc[2][2][4][2];
#pragma unroll
    for (int a = 0; a < 2; ++a)
#pragma unroll
        for (int b = 0; b < 2; ++b)
#pragma unroll
            for (int m = 0; m < 4; ++m)
#pragma unroll
                for (int n = 0; n < 2; ++n) acc[a][b][m][n] = (f32x4){0.f, 0.f, 0.f, 0.f};
    bf16x8 At[4][2], B0[2][2], B1[2][2];
    const char* cA = (const char*)g.A + (size_t)cur.pm * tstep; const char* cB = (const char*)g.Bt + (size_t)cur.pn * tstep;
    S.a_ready(cur);
    if constexpr (SP2) {
        PG8_STAGE(PG8_SB(0, 0), cB, voffB); PG8_STAGE(PG8_SB(0, 1), cB + hstep, voffB); PG8_STAGE(PG8_SA(0, 0), cA, voffA); PG8_STAGE(PG8_SA(0, 1), cA + hstep, voffA);
        if (wr == 1) PG8_BAR;
        PG8_WAIT_V(2); PG8_BAR;
        PG8_STAGE(PG8_SB(1, 0), cB + kstep, voffB); PG8_STAGE(PG8_SA(1, 0), cA + kstep, voffA); PG8_STAGE(PG8_SB(1, 1), cB + hstep + kstep, voffB);
        PG8_WAIT_V(6); PG8_BAR;
    } else {
        PG8_STAGE(PG8_SB(0, 0), cB, voffB); PG8_STAGE(PG8_SA(0, 0), cA, voffA); PG8_STAGE(PG8_SB(0, 1), cB + hstep, voffB); PG8_STAGE(PG8_SA(0, 1), cA + hstep, voffA);
        if (wr == 1) PG8_BAR;
        PG8_WAIT_V(4); PG8_BAR;
        PG8_STAGE(PG8_SB(1, 0), cB + kstep, voffB); PG8_STAGE(PG8_SA(1, 0), cA + kstep, voffA); PG8_STAGE(PG8_SB(1, 1), cB + hstep + kstep, voffB);
        PG8_WAIT_V(6); PG8_BAR;
    }
    for (;;) {
        const bool has_next = S.next(ui + 1, nxt);
        const char* nA = has_next ? (const char*)g.A + (size_t)nxt.pm * tstep : cA; const char* nB = has_next ? (const char*)g.Bt + (size_t)nxt.pn * tstep : cB;
        for (int t = 0; t < nt; t += 2) {
            const bool last = (t == nt - 2);
            const char* a1 = cA + (size_t)(t + 1) * kstep;
            const char* a2 = last ? nA : cA + (size_t)(t + 2) * kstep; const char* b2 = last ? nB : cB + (size_t)(t + 2) * kstep;
            const char* a3 = a2 + kstep; const char* b3 = b2 + kstep;
            if (last && has_next) S.a_ready(nxt);
            if constexpr (SP2) {
            PG8_LDB(B0, 0, 0); PG8_LDB(B1, 0, 1); PG8_SCHED; PG8_LDA(At, 0, 0); PG8_STAGE(PG8_SA(1, 1), a1 + hstep, voffA);
            PG8_WAIT_V(8); PG8_WAIT_L(0); PG8_BAR; PG8_MMA(0, 0, At, B0); PG8_MMA(0, 1, At, B1); PG8_BAR; PG8_SCHED;
            PG8_LDA(At, 0, 1); PG8_STAGE(PG8_SB(0, 0), b2, voffB); PG8_STAGE(PG8_SB(0, 1), b2 + hstep, voffB); PG8_STAGE(PG8_SA(0, 0), a2, voffA);
            PG8_WAIT_V(8); PG8_WAIT_L(0); PG8_BAR; PG8_MMA(1, 0, At, B0); PG8_MMA(1, 1, At, B1); PG8_BAR; PG8_SCHED;
            PG8_LDB(B0, 1, 0); PG8_LDB(B1, 1, 1); PG8_SCHED; PG8_LDA(At, 1, 0); PG8_STAGE(PG8_SA(0, 1), a2 + hstep, voffA);
            PG8_WAIT_V(8); PG8_WAIT_L(0); PG8_BAR; PG8_MMA(0, 0, At, B0); PG8_MMA(0, 1, At, B1); PG8_BAR; PG8_SCHED;
            PG8_LDA(At, 1, 1); PG8_STAGE(PG8_SB(1, 0), b3, voffB); PG8_STAGE(PG8_SB(1, 1), b3 + hstep, voffB); PG8_STAGE(PG8_SA(1, 0), a3, voffA);
            PG8_WAIT_V(8); PG8_WAIT_L(0); PG8_BAR; PG8_MMA(1, 0, At, B0); PG8_MMA(1, 1, At, B1); PG8_BAR; PG8_SCHED;
            } else {
            PG8_LDB(B0, 0, 0); PG8_SCHED; PG8_LDA(At, 0, 0); PG8_STAGE(PG8_SA(1, 1), a1 + hstep, voffA);
            PG8_WAIT_L(8); PG8_BAR; PG8_WAIT_L(0); PG8_MMA(0, 0, At, B0); PG8_BAR; PG8_SCHED;
            PG8_LDB(B1, 0, 1); PG8_STAGE(PG8_SB(0, 0), b2, voffB);
            PG8_BAR; PG8_WAIT_L(0); PG8_MMA(0, 1, At, B1); PG8_BAR;
            PG8_LDA(At, 0, 1); PG8_STAGE(PG8_SA(0, 0), a2, voffA);
            PG8_BAR; PG8_WAIT_L(0); PG8_MMA(1, 0, At, B0); PG8_BAR; PG8_SCHED;
            PG8_STAGE(PG8_SB(0, 1), b2 + hstep, voffB);
            PG8_WAIT_V(6); PG8_BAR; PG8_MMA(1, 1, At, B1); PG8_BAR;
            PG8_LDB(B0, 1, 0); PG8_SCHED; PG8_LDA(At, 1, 0); PG8_STAGE(PG8_SA(0, 1), a2 + hstep, voffA);
            PG8_WAIT_L(8); PG8_BAR; PG8_WAIT_L(0); PG8_MMA(0, 0, At, B0); PG8_BAR; PG8_SCHED;
            PG8_LDB(B1, 1, 1); PG8_STAGE(PG8_SB(1, 0), b3, voffB);
            PG8_BAR; PG8_WAIT_L(0); PG8_MMA(0, 1, At, B1); PG8_BAR;
            PG8_LDA(At, 1, 1); PG8_STAGE(PG8_SA(1, 0), a3, voffA);
            PG8_BAR; PG8_WAIT_L(0); PG8_MMA(1, 0, At, B0); PG8_BAR; PG8_SCHED;
            PG8_STAGE(PG8_SB(1, 1), b3 + hstep, voffB);
            PG8_WAIT_V(6); PG8_BAR; PG8_MMA(1, 1, At, B1); PG8_BAR;
            }
        }
        if constexpr (F8) asm volatile("s_nop 15\n\ts_nop 15" ::: "memory");
        if constexpr (ALIGN_EPI) { if (wr == 0) PG8_BAR; }
        if constexpr (!Epi::AFTER_DRAIN) { E(acc, cur, wr, wc, fr, fq); S.done(cur); }
        if (!has_next) break;
#pragma unroll
        for (int a = 0; a < 2; ++a)
#pragma unroll
            for (int b = 0; b < 2; ++b)
#pragma unroll
                for (int m = 0; m < 4; ++m)
#pragma unroll
                    for (int n = 0; n < 2; ++n) acc[a][b][m][n] = (f32x4){0.f, 0.f, 0.f, 0.f};
        cur = nxt; cA = nA; cB = nB; ++ui;
        if constexpr (ALIGN_EPI) { if (wr == 1) PG8_BAR; }
    }
    PG8_WAIT_V(0);
    if constexpr (!ALIGN_EPI) { if (wr == 0) PG8_BAR; }
    PG8_BAR;
    if constexpr (Epi::AFTER_DRAIN) { E.fused(acc, cur, wr, wc, fr, fq, lds, wid, lane); S.done(cur); }
#undef PG8_SA
#undef PG8_SB
#undef PG8_STAGE
#undef PG8_LDA
#undef PG8_LDB
#undef PG8_MMA
#undef PG8_CAT
#undef PG8_WAIT_V
#undef PG8_WAIT_L
#undef PG8_BAR
#undef PG8_SCHED
}
}

constexpr int NWAVES = 8, GRID = 256;
constexpr int BATCH = 4, SEQ = 8192, DM = 1024, MTOK = BATCH * SEQ, DEPTH = 4;
constexpr int NA_SRC = 2120, NA_PAD = 2304, NB = 3072, FF = 2816, NUP = 2 * FF;
constexpr float EPS = 1e-6f;
constexpr float LOG2E = 1.4426950408889634f;
constexpr float C2 = 0.125f * LOG2E;
constexpr int NBLK64 = MTOK / 64;

constexpr size_t MiB = 1u << 20;
constexpr size_t WS_CTL = 0, CTL_ZERO_BYTES = 1 * MiB;
constexpr size_t WS_W_INA = 2 * MiB;
constexpr size_t WS_W_INB = 11 * MiB;
constexpr size_t WS_W_OUT = 23 * MiB;
constexpr size_t WS_W_UP = 31 * MiB;
constexpr size_t WS_W_DN = 75 * MiB;
constexpr size_t WS_HB = 98 * MiB;
constexpr size_t WS_M = 162 * MiB;
constexpr size_t WS_SS = 226 * MiB;
constexpr size_t WS_HALO = 228 * MiB;
constexpr size_t WS_PROJ = 272 * MiB;
constexpr size_t WS_END = 464 * MiB;
constexpr size_t PA_QA = 0, PA_KA = 64 * MiB, PA_VA = 80 * MiB, PA_QI = 96 * MiB, PA_KI = 128 * MiB, PA_WI = 132 * MiB, PA_SEL = 136 * MiB;
constexpr size_t PB_STRIDE = 64 * MiB;
constexpr int CW_BAR = 4096;
constexpr int F8_L0 = 2;
constexpr size_t PX_HB8 = 96 * MiB;
constexpr float W8S = 128.f, W8I = 1.f / 128.f;

constexpr int RING_OFF = 0, RING_BYTES = 131072;
constexpr int KS_OFF = RING_BYTES;
constexpr int AUX_OFF = RING_BYTES + 24576;
constexpr int LDSCTL_OFF = AUX_OFF + 4096, MISC_OFF = LDSCTL_OFF + 320;
constexpr int LDS_BYTES = 163840;
static_assert(MISC_OFF + 128 <= LDS_BYTES, "LDS map");

#define GAS __attribute__((address_space(1)))
#define LAS __attribute__((address_space(3)))
typedef unsigned short bf16;
typedef unsigned v4u __attribute__((ext_vector_type(4)));
typedef unsigned v2u __attribute__((ext_vector_type(2)));
typedef float f32x4 __attribute__((ext_vector_type(4)));
typedef float f32x16 __attribute__((ext_vector_type(16)));
typedef short bf16x8 __attribute__((ext_vector_type(8)));
typedef short s16x4 __attribute__((ext_vector_type(4)));
typedef float f32x2_t __attribute__((ext_vector_type(2)));
typedef GAS unsigned gu32;
#define RLX_AGENT __ATOMIC_RELAXED, __HIP_MEMORY_SCOPE_AGENT
#define LDS_WAIT() asm volatile("s_waitcnt lgkmcnt(0)" ::: "memory")
#define VM_WAIT() asm volatile("s_waitcnt vmcnt(0)" ::: "memory")
__device__ __forceinline__ unsigned f2bf(float f) { unsigned u = __builtin_bit_cast(unsigned, f); return (u + 0x7fffu + ((u >> 16) & 1u)) >> 16; }
__device__ __forceinline__ unsigned pk2(float lo, float hi) { return f2bf(lo) | (f2bf(hi) << 16); }
typedef float f32x2c_t __attribute__((ext_vector_type(2))); typedef __bf16 bf16x2c_t __attribute__((ext_vector_type(2)));
__device__ __forceinline__ unsigned cvtpk(float lo, float hi) { const f32x2c_t v = {lo, hi}; const bf16x2c_t b = __builtin_convertvector(v, bf16x2c_t); return __builtin_bit_cast(unsigned, b); }
__device__ __forceinline__ float bf_lo(unsigned u) { return __builtin_bit_cast(float, u << 16); }
__device__ __forceinline__ float bf_hi(unsigned u) { return __builtin_bit_cast(float, u & 0xffff0000u); }

__device__ __forceinline__ unsigned pk4f8(float a, float b, float c, float d) { int r = __builtin_amdgcn_cvt_pk_fp8_f32(a, b, 0, false); r = __builtin_amdgcn_cvt_pk_fp8_f32(c, d, r, true); return (unsigned)r; }

#define XB_TMO      128
#define XB_XCNT(j)  (256  + 64 * (j))
#define XB_XSUB(j)  (1280 + 64 * (j))
#define XB_XGEN(j)  (2304 + 64 * (j))
#define XB_TOP      3328
#define XB_TOPGEN   3392
#define XCD_BAR_WORDS 3456
#define XB_SPIN_CAP (1u << 18)

__device__ __forceinline__ unsigned xb_ld(unsigned* p)              { return __hip_atomic_load(p, __ATOMIC_RELAXED, __HIP_MEMORY_SCOPE_AGENT); }
__device__ __forceinline__ unsigned xb_add(unsigned* p, unsigned v) { return __hip_atomic_fetch_add(p, v, __ATOMIC_RELAXED, __HIP_MEMORY_SCOPE_AGENT); }
__device__ __forceinline__ unsigned xb_xcc_id() { return (unsigned)__builtin_amdgcn_s_getreg((3 << 11) | 20) & 0xFu; }
#define XB_SPIN(cond, bar) do { unsigned _sp = 0; while (cond) { __builtin_amdgcn_s_sleep(1); \
    if ((++_sp & 255u) == 0u) { if (xb_ld(&(bar)[XB_TMO])) break; if (_sp > XB_SPIN_CAP) { atomicAdd(&(bar)[XB_TMO], 1u); break; } } } } while (0)

struct XcdBarrier {
    unsigned* bar; unsigned x;
    volatile LAS unsigned* st;
};

__device__ __forceinline__ XcdBarrier xcd_barrier_post(unsigned* bar, volatile LAS unsigned* st) {
    XcdBarrier b; b.bar = bar; b.x = xb_xcc_id(); b.st = st;
    if (threadIdx.x == 0) (void)xb_add(&bar[XB_XCNT(b.x)], 1u);
    return b;
}
__device__ __forceinline__ void xcd_barrier_complete(unsigned* bar, unsigned x, unsigned& nloc, unsigned& nx) {
    const unsigned G = gridDim.x * gridDim.y * gridDim.z;
    unsigned sum, cnt, mine, sp = 0u;
    for (;;) {
        sum = 0u; cnt = 0u; mine = 0u;
#pragma unroll
        for (unsigned j = 0; j < 16; ++j) { const unsigned c = xb_ld(&bar[XB_XCNT(j)]); sum += c; cnt += (c > 0u) ? 1u : 0u; mine = (j == x) ? c : mine; }
        if (sum == G) break;
        __builtin_amdgcn_s_sleep(1);
        if ((++sp & 255u) == 0u) { if (xb_ld(&bar[XB_TMO])) break; if (sp > XB_SPIN_CAP) { atomicAdd(&bar[XB_TMO], 1u); break; } }
    }
    nloc = mine > 0u ? mine : 1u; nx = cnt > 0u ? cnt : 1u;
}

__device__ __forceinline__ void xcd_barrier(const XcdBarrier& b) {
    asm volatile("s_waitcnt vmcnt(0)" ::: "memory");
    __syncthreads();
    if (threadIdx.x == 0) {
        unsigned* bar = b.bar;
        __builtin_amdgcn_s_waitcnt(0);
        unsigned nloc = b.st[0], nx = b.st[1];
        if (nloc == 0u) { xcd_barrier_complete(bar, b.x, nloc, nx); b.st[0] = nloc; b.st[1] = nx; }
        const unsigned old = xb_add(&bar[XB_XSUB(b.x)], 1u);
        const unsigned gen = old / nloc;
        if (old + 1u == (gen + 1u) * nloc) {
            __builtin_amdgcn_fence(__ATOMIC_RELEASE, "agent");
            asm volatile("s_waitcnt vmcnt(0)" ::: "memory");
            const unsigned og = xb_add(&bar[XB_TOP], 1u);
            const unsigned tg = og / nx;
            if (og + 1u == (tg + 1u) * nx) xb_add(&bar[XB_TOPGEN], 1u);
            else XB_SPIN(xb_ld(&bar[XB_TOPGEN]) == tg, bar);
            __builtin_amdgcn_fence(__ATOMIC_ACQUIRE, "agent");
            xb_add(&bar[XB_XGEN(b.x)], 1u);
            asm volatile("s_waitcnt vmcnt(0)" ::: "memory");
        } else {
            XB_SPIN(xb_ld(&bar[XB_XGEN(b.x)]) == gen, bar);
            __builtin_amdgcn_fence(__ATOMIC_ACQUIRE, "agent");
            asm volatile("s_waitcnt vmcnt(0)" ::: "memory");
        }
    }
    __syncthreads();
}


struct Args {
    const float* x; const float* attn_norm_g; const float* w_in_a; const float* w_in_b; const float* q_norm_g; const float* k_norm_g; const float* t5_bias;
    const float* rel_bias_b; const float* w_out; const float* ffn_norm_g; const float* w_up; const float* conv_w; const float* conv_b; const float* w_down;
    float* out; unsigned char* ws; int ph_lo, ph_hi, li, pad;
};

struct Frame {
    LAS unsigned char* lds;
    volatile LAS unsigned* MISC;
    gu32* ctl;
    int tid, lane, wave, vcu, G;
};

__host__ __device__ __forceinline__ int hmap(int p) { return 64 * ((p >> 5) & 3) + 16 * ((p >> 2) & 3) + 8 * (p >> 7) + 4 * ((p >> 4) & 1) + (p & 3); }
__host__ __device__ __forceinline__ int umap(int p) { return 32 * ((p >> 5) & 3) + 8 * ((p >> 2) & 3) + 4 * ((p >> 4) & 1) + (p & 3); }
__host__ __device__ __forceinline__ int src_col(int type, int n) {
    if (type == 0) return n;
    const int pn = n >> 8, p = n & 255;
    if (type == 2) return 256 * pn + hmap(p);
    if (type == 1) { const int c = hmap(p); return pn < 8 ? 256 * pn + c : (c < 72 ? 2048 + c : -1); }
    return (p >> 7) * FF + 128 * pn + umap(p);
}
__device__ __forceinline__ void convert_item(const float* W, int K, int Nsrc, int Ndst, int type, const float* gain, bf16* WT, LAS float* scr, int item, int lane, bool o8 = false) {
    const int nblk = Ndst / 32, kb = item / nblk, nb = item % nblk, k0 = 64 * kb, n0 = 32 * nb;
    const int sc = src_col(type, n0 + (lane & 31));
#pragma unroll 8
    for (int i = 0; i < 32; ++i) { const int kk = 2 * i + (lane >> 5); float v = 0.f; if (sc >= 0) v = W[(size_t)(k0 + kk) * Nsrc + sc]; if (gain) v *= gain[k0 + kk]; scr[kk * 33 + (lane & 31)] = v; }
    LDS_WAIT(); asm volatile("" ::: "memory");
    const int c = lane & 7;
#pragma unroll
    for (int j = 0; j < 4; ++j) { const int n = (lane >> 3) + 8 * j; const LAS float* s = scr + (8 * c) * 33 + n;
        if (o8) { v2u o; o.x = pk4f8(s[0 * 33] * W8S, s[1 * 33] * W8S, s[2 * 33] * W8S, s[3 * 33] * W8S); o.y = pk4f8(s[4 * 33] * W8S, s[5 * 33] * W8S, s[6 * 33] * W8S, s[7 * 33] * W8S);
            *(v2u*)((unsigned char*)WT + (size_t)(n0 + n) * K + k0 + 8 * c) = o; }
        else { v4u o; o.x = pk2(s[0 * 33], s[1 * 33]); o.y = pk2(s[2 * 33], s[3 * 33]); o.z = pk2(s[4 * 33], s[5 * 33]); o.w = pk2(s[6 * 33], s[7 * 33]);
            *(v4u*)(WT + (size_t)(n0 + n) * K + k0 + 8 * c) = o; } }
    LDS_WAIT(); asm volatile("" ::: "memory");
}
__device__ __forceinline__ float wave_sum(float v) {
#pragma unroll
    for (int o = 1; o < 64; o <<= 1) v += __shfl_xor(v, o);
    return v;
}
__device__ __forceinline__ void p0_prologue(Frame& F, const Args& a) {
    LAS float* scr = (LAS float*)(F.lds + RING_OFF + F.wave * 16384);
    const int gw = F.vcu * NWAVES + F.wave, NGW = F.G * NWAVES;
    constexpr int I_INA = 16 * (NA_PAD / 32), I_INB = 16 * (NB / 32), I_OUT = 16 * 32, I_UP = 16 * (NUP / 32), I_DN = (FF / 64) * 32;
    constexpr int NITEMS = 2 * I_INA + 2 * I_INB + 4 * I_OUT + 4 * I_UP + 4 * I_DN;
    unsigned char* ws = a.ws;
    for (int it = gw; it < NITEMS; it += NGW) {
        int r = it;
        if (r < 2 * I_INA) { const int l = r / I_INA; convert_item(a.w_in_a + (size_t)l * DM * NA_SRC, DM, NA_SRC, NA_PAD, 1, a.attn_norm_g + (2 * l) * DM, (bf16*)(ws + WS_W_INA) + (size_t)l * NA_PAD * DM, scr, r % I_INA, F.lane); continue; } r -= 2 * I_INA;
        if (r < 2 * I_INB) { const int l = r / I_INB; convert_item(a.w_in_b + (size_t)l * DM * NB, DM, NB, NB, 2, a.attn_norm_g + (2 * l + 1) * DM, (bf16*)(ws + WS_W_INB) + (size_t)l * NB * DM, scr, r % I_INB, F.lane); continue; } r -= 2 * I_INB;
        if (r < 4 * I_OUT) { const int l = r / I_OUT; convert_item(a.w_out + (size_t)l * DM * DM, DM, DM, DM, 0, nullptr, (bf16*)(ws + WS_W_OUT) + (size_t)l * DM * DM, scr, r % I_OUT, F.lane); continue; } r -= 4 * I_OUT;
        if (r < 4 * I_UP) { const int l = r / I_UP; convert_item(a.w_up + (size_t)l * DM * NUP, DM, NUP, NUP, 3, a.ffn_norm_g + l * DM, (bf16*)(ws + WS_W_UP) + (size_t)l * NUP * DM, scr, r % I_UP, F.lane, l >= F8_L0); continue; } r -= 4 * I_UP;
        { const int l = r / I_DN; convert_item(a.w_down + (size_t)l * FF * DM, FF, DM, DM, 0, nullptr, (bf16*)(ws + WS_W_DN) + (size_t)l * DM * FF, scr, r % I_DN, F.lane, l >= F8_L0); }
    }
    bf16* hb = (bf16*)(ws + WS_HB); float* ss = (float*)(ws + WS_SS);
    for (int m = gw; m < MTOK; m += NGW) {
        const f32x4* xr = (const f32x4*)(a.x + (size_t)m * DM) + F.lane; f32x4 v[4]; float s = 0.f;
#pragma unroll
        for (int j = 0; j < 4; ++j) { v[j] = xr[64 * j]; s += (v[j].x * v[j].x + v[j].y * v[j].y) + (v[j].z * v[j].z + v[j].w * v[j].w); }
        s = wave_sum(s);
        v2u* o8 = (v2u*)(hb + (size_t)m * DM) + F.lane;
#pragma unroll
        for (int j = 0; j < 4; ++j) { v2u w; w.x = pk2(v[j].x, v[j].y); w.y = pk2(v[j].z, v[j].w); o8[64 * j] = w; }
        if (F.lane < 16) ss[(size_t)m * 16 + F.lane] = (F.lane == 0) ? s : 0.f;
    }
}

__device__ __forceinline__ f32x4 rstd_load(const float* ss, int row, int fq) { return *(const f32x4*)(ss + (size_t)row * 16 + 4 * fq); }
__device__ __forceinline__ float rstd_finish(f32x4 a) {
    float s = (a.x + a.y) + (a.z + a.w);
    s += __shfl_xor(s, 16); s += __shfl_xor(s, 32);
    return __builtin_amdgcn_rsqf(s * (1.0f / DM) + EPS);
}
__device__ __forceinline__ float row_rstd(const float* ss, int row, int fq) { return rstd_finish(rstd_load(ss, row, fq)); }
__device__ __forceinline__ unsigned att_pk4(f32x4 v) { int r = __builtin_amdgcn_cvt_pk_fp8_f32(v.x, v.y, 0, false); r = __builtin_amdgcn_cvt_pk_fp8_f32(v.z, v.w, r, true); return (unsigned)r; }
struct EpiIn {
    static constexpr bool PERM = false, PERMA = false, AFTER_DRAIN = false;
    const float* ss; unsigned char* proj; const float* qg; const float* kg; int isB;
    __device__ __forceinline__ void operator()(const pg8::f32x4 (&acc)[2][2][4][2], const pg8::Unit& u, int wr, int wc, int fr, int fq) const {
        asm volatile("" : "+v"(fr), "+v"(fq));
        const int pn = u.pn; int kind, pitch; bf16* dst;
        if (isB) { const int t = pn >> 2; kind = (t == 0) ? 1 : (t == 1 ? 2 : 0); dst = (bf16*)(proj + (size_t)t * PB_STRIDE) + 256 * (pn & 3); pitch = DM; }
        else if (pn < 4) { kind = 1; dst = (bf16*)(proj + PA_QA) + 256 * pn; pitch = DM; }
        else if (pn == 4) { kind = 2; dst = (bf16*)(proj + PA_KA); pitch = 256; }
        else if (pn == 5) { kind = 0; dst = (bf16*)(proj + PA_VA); pitch = 256; }
        else if (pn < 8) { kind = 0; dst = (bf16*)(proj + PA_QI) + 256 * (pn - 6); pitch = 512; }
        else { kind = 3; dst = (bf16*)(proj + PA_KI); pitch = 64; }
        if (kind == 3 && wc >= 2) return;
        const bool donorm = (kind == 1) || (kind == 2) || (kind == 3 && wc == 0);
        f32x4 g[2][2];
#pragma unroll
        for (int bj = 0; bj < 2; ++bj)
#pragma unroll
            for (int n = 0; n < 2; ++n) {
                if (kind == 1) g[bj][n] = *(const f32x4*)(qg + 16 * fq + 8 * bj + 4 * n) * (isB ? C2 : 1.0f);
                else if (kind == 2) g[bj][n] = *(const f32x4*)(kg + 16 * fq + 8 * bj + 4 * n);
                else g[bj][n] = (f32x4){1.f, 1.f, 1.f, 1.f};
            }
        float* wi = (float*)(proj + PA_WI);
        f32x4 rsl[2][4];
#pragma unroll
        for (int ai = 0; ai < 2; ++ai)
#pragma unroll
            for (int m = 0; m < 4; ++m) rsl[ai][m] = rstd_load(ss, u.pm * 256 + ai * 128 + wr * 64 + m * 16 + fr, fq);
#pragma unroll
        for (int ai = 0; ai < 2; ++ai)
#pragma unroll
            for (int m = 0; m < 4; ++m) {
                const int row = u.pm * 256 + ai * 128 + wr * 64 + m * 16 + fr;
                const float rs = rstd_finish(rsl[ai][m]);
                f32x4 v[2][2]; float s = 0.f;
#pragma unroll
                for (int bj = 0; bj < 2; ++bj)
#pragma unroll
                    for (int n = 0; n < 2; ++n) { v[bj][n] = acc[ai][bj][m][n] * rs; const f32x4 q = v[bj][n] * v[bj][n]; s += (q.x + q.y) + (q.z + q.w); }
                if (donorm) {
                    s += __shfl_xor(s, 16); s += __shfl_xor(s, 32);
                    const float r = 1.0f / sqrtf(s * (1.0f / 64.0f) + EPS);
#pragma unroll
                    for (int bj = 0; bj < 2; ++bj)
#pragma unroll
                        for (int n = 0; n < 2; ++n) v[bj][n] = v[bj][n] * r * g[bj][n];
                }
                if (kind == 3 && wc == 1) {
                    if (fq == 0) { float* wp = wi + (size_t)row * 8; const float sc = 0.04419417382415922f;
                        *(f32x4*)(wp) = v[0][0] * sc; *(f32x4*)(wp + 4) = v[0][1] * sc; }
                } else if (!isB && pn < 6) {
                    unsigned char* p8 = (pn < 4) ? proj + PA_QA + (size_t)row * 1024 + 256 * pn + 64 * wc + 16 * fq : proj + PA_KA + (size_t)row * 512 + 128 * wc + 64 * (pn - 4) + 16 * fq;
                    v4u w; w.x = att_pk4(v[0][0]); w.y = att_pk4(v[0][1]); w.z = att_pk4(v[1][0]); w.w = att_pk4(v[1][1]);
                    *(v4u*)p8 = w;
                } else {
                    bf16* rp = dst + (size_t)row * pitch + 64 * wc + 16 * fq;
#pragma unroll
                    for (int bj = 0; bj < 2; ++bj) { v4u w; w.x = cvtpk(v[bj][0].x, v[bj][0].y); w.y = cvtpk(v[bj][0].z, v[bj][0].w); w.z = cvtpk(v[bj][1].x, v[bj][1].y); w.w = cvtpk(v[bj][1].z, v[bj][1].w);
                        *(v4u*)(rp + 8 * bj) = w; }
                }
            }
    }
};
template <int MODE>
struct EpiResT {
    static constexpr bool PERM = false, PERMA = false, AFTER_DRAIN = false;
    const float* xin; float* fout; const bf16* hbi; bf16* hb; float* ss; unsigned char* hb8;
    __device__ __forceinline__ void operator()(const pg8::f32x4 (&acc)[2][2][4][2], const pg8::Unit& u, int wr, int wc, int fr, int fq) const {
        asm volatile("" : "+v"(fr), "+v"(fq));
        const int col0 = u.pn * 256 + wc * 32 + 4 * fq;
#pragma unroll
        for (int ai = 0; ai < 2; ++ai) {
            f32x4 base[4][2][2];
#pragma unroll
            for (int m = 0; m < 4; ++m)
#pragma unroll
                for (int bj = 0; bj < 2; ++bj)
#pragma unroll
                    for (int n = 0; n < 2; ++n) { const size_t o4 = (size_t)(u.pm * 256 + ai * 128 + wr * 64 + m * 16 + fr) * DM + col0 + bj * 128 + n * 16;
                        if (xin) base[m][bj][n] = *(const f32x4*)(xin + o4); else { const v2u b = *(const v2u*)(hbi + o4); base[m][bj][n] = (f32x4){bf_lo(b.x), bf_hi(b.x), bf_lo(b.y), bf_hi(b.y)}; } }
            asm volatile("" ::: "memory");
#pragma unroll
            for (int m = 0; m < 4; ++m) {
                const int row = u.pm * 256 + ai * 128 + wr * 64 + m * 16 + fr; const size_t off = (size_t)row * DM + col0; float s = 0.f;
#pragma unroll
                for (int bj = 0; bj < 2; ++bj)
#pragma unroll
                    for (int n = 0; n < 2; ++n) { const size_t o4 = off + bj * 128 + n * 16;
                        const f32x4 o = (MODE & 1) ? base[m][bj][n] + acc[ai][bj][m][n] * W8I : base[m][bj][n] + acc[ai][bj][m][n];
                        if (fout) *(f32x4*)(fout + o4) = o;
                        else { const f32x4 q = o * o; s += (q.x + q.y) + (q.z + q.w); v2u w; w.x = cvtpk(o.x, o.y); w.y = cvtpk(o.z, o.w); *(v2u*)(hb + o4) = w;
                            if constexpr (MODE & 2) *(unsigned*)(hb8 + o4) = pk4f8(o.x, o.y, o.z, o.w); } }
                if (!fout) { s += __shfl_xor(s, 16); s += __shfl_xor(s, 32); if (fq == 0) ss[(size_t)row * 16 + u.pn * 4 + wc] = s; }
            }
        }
    }
};
typedef EpiResT<0> EpiRes;
#ifdef X_NOBPERM
__device__ __forceinline__ float lane_from(int byteaddr, float v) { return v + (float)byteaddr; }
#else
__device__ __forceinline__ float lane_from(int byteaddr, float v) { return __builtin_bit_cast(float, __builtin_amdgcn_ds_bpermute(byteaddr, __builtin_bit_cast(int, v))); }
#endif
#ifdef X_NOSILU
__device__ __forceinline__ float silu_mul(float a, float g) { return a * g; }
#else
__device__ __forceinline__ float silu_mul(float a, float g) { return a * g * __builtin_amdgcn_rcpf(1.0f + __builtin_amdgcn_exp2f(-g * LOG2E)); }
#endif
__device__ __forceinline__ float dpp_prev_lane(float v) { return __builtin_bit_cast(float, __builtin_amdgcn_update_dpp(0, __builtin_bit_cast(int, v), 0x111  , 0xf, 0xf, true)); }
template <bool F8>
struct EpiUpT {
    static constexpr bool PERM = false, PERMA = true, AFTER_DRAIN = false;
    const float* ss; const float* cw; const float* cb; bf16* act; float* halo; LAS float* cl;
    __device__ __forceinline__ void operator()(const pg8::f32x4 (&acc)[2][2][4][2], const pg8::Unit& u, int wr, int wc, int fr, int fq) const {
        asm volatile("" : "+v"(fr), "+v"(fq));
        const int colb = u.pn * 128 + wc * 32 + 8 * fq;
        const int tid_ = ((wr * 4 + wc) * 4 + fq) * 16 + fr, ce = 2 * tid_, cbj = ce >> 9, carr = (ce >> 7) & 3, cc = ce & 127;
        const f32x2_t cpre = *(const f32x2_t*)((carr < 3 ? cw + carr * NUP : cb) + cbj * FF + u.pn * 128 + cc);
        f32x4 rsl[2][4];
#pragma unroll
        for (int ai = 0; ai < 2; ++ai)
#pragma unroll
            for (int m = 0; m < 4; ++m) rsl[ai][m] = rstd_load(ss, (u.pm * 4 + ai * 2 + wr) * 64 + 4 * fr + m, fq);
        unsigned pk[2][2][4][2][2];
#pragma unroll
        for (int ai = 0; ai < 2; ++ai) {
#pragma unroll
            for (int m = 0; m < 4; ++m) {
                const float rs = F8 ? rstd_finish(rsl[ai][m]) * W8I : rstd_finish(rsl[ai][m]);
#pragma unroll
                for (int bj = 0; bj < 2; ++bj)
#pragma unroll
                    for (int n = 0; n < 2; ++n) { const f32x4 v = acc[ai][bj][m][n] * rs; pk[ai][bj][m][n][0] = cvtpk(v.x, v.y); pk[ai][bj][m][n][1] = cvtpk(v.z, v.w); }
            }
        }
        *(LAS f32x2_t*)(cl + ce) = cpre;
        asm volatile("s_waitcnt lgkmcnt(0)" ::: "memory"); __builtin_amdgcn_s_barrier(); asm volatile("" ::: "memory");
        __builtin_amdgcn_sched_barrier(0);
        if (fr == 0 || fr == 15) {
#pragma unroll
            for (int ai = 0; ai < 2; ++ai)
#pragma unroll
                for (int j = 0; j < 2; ++j)
#pragma unroll
                    for (int bj = 0; bj < 2; ++bj)
#pragma unroll
                        for (int n = 0; n < 2; ++n) { const unsigned w0 = (fr == 0) ? pk[ai][bj][j][n][0] : pk[ai][bj][2 + j][n][0], w1 = (fr == 0) ? pk[ai][bj][j][n][1] : pk[ai][bj][2 + j][n][1];
                            *(f32x4*)(halo + ((size_t)(u.pm * 4 + ai * 2 + wr) * 4 + (fr == 0 ? j : 2 + j)) * NUP + bj * FF + colb + 4 * n) = (f32x4){bf_lo(w0), bf_hi(w0), bf_lo(w1), bf_hi(w1)}; }
        }
        __builtin_amdgcn_sched_barrier(0);
#pragma unroll
        for (int ai = 0; ai < 2; ++ai) {
            const int row0 = (u.pm * 4 + ai * 2 + wr) * 64 + 4 * fr;
            unsigned outp[4][2][2];
#pragma unroll
            for (int n = 0; n < 2; ++n) {
#pragma unroll
                for (int ip = 0; ip < 2; ++ip) {
                    f32x2_t k0[2], k1[2], k2[2], kb[2];
#pragma unroll
                    for (int bj = 0; bj < 2; ++bj) { const LAS float* c = cl + bj * 512 + wc * 32 + 8 * fq + 4 * n + 2 * ip; k0[bj] = *(const LAS f32x2_t*)(c); k1[bj] = *(const LAS f32x2_t*)(c + 128); k2[bj] = *(const LAS f32x2_t*)(c + 256); kb[bj] = *(const LAS f32x2_t*)(c + 384); }
                    float y[2][4][2];
#pragma unroll
                    for (int bj = 0; bj < 2; ++bj) {
                        const unsigned w0 = pk[ai][bj][0][n][ip], w1 = pk[ai][bj][1][n][ip], w2 = pk[ai][bj][2][n][ip], w3 = pk[ai][bj][3][n][ip];
                        const unsigned q1 = (unsigned)__builtin_amdgcn_update_dpp(0, (int)w3, 0x111, 0xf, 0xf, true), q2 = (unsigned)__builtin_amdgcn_update_dpp(0, (int)w2, 0x111, 0xf, 0xf, true);
#pragma unroll
                        for (int e = 0; e < 2; ++e) { const int i = e;
                            const float u0 = e ? bf_hi(w0) : bf_lo(w0), u1 = e ? bf_hi(w1) : bf_lo(w1), u2 = e ? bf_hi(w2) : bf_lo(w2), u3 = e ? bf_hi(w3) : bf_lo(w3), p1 = e ? bf_hi(q1) : bf_lo(q1), p2 = e ? bf_hi(q2) : bf_lo(q2);
                            y[bj][0][e] = kb[bj][i] + k0[bj][i] * p2 + k1[bj][i] * p1 + k2[bj][i] * u0;
                            y[bj][1][e] = kb[bj][i] + k0[bj][i] * p1 + k1[bj][i] * u0 + k2[bj][i] * u1;
                            y[bj][2][e] = kb[bj][i] + k0[bj][i] * u0 + k1[bj][i] * u1 + k2[bj][i] * u2;
                            y[bj][3][e] = kb[bj][i] + k0[bj][i] * u1 + k1[bj][i] * u2 + k2[bj][i] * u3; }
                    }
#pragma unroll
                    for (int m = 0; m < 4; ++m) {
                        if constexpr (F8) { if (ip == 0) outp[m][n][0] = (unsigned)__builtin_amdgcn_cvt_pk_fp8_f32(silu_mul(y[0][m][0], y[1][m][0]), silu_mul(y[0][m][1], y[1][m][1]), 0, false);
                            else outp[m][n][0] = (unsigned)__builtin_amdgcn_cvt_pk_fp8_f32(silu_mul(y[0][m][0], y[1][m][0]), silu_mul(y[0][m][1], y[1][m][1]), (int)outp[m][n][0], true); }
                        else outp[m][n][ip] = cvtpk(silu_mul(y[0][m][0], y[1][m][0]), silu_mul(y[0][m][1], y[1][m][1])); }
                }
            }
#pragma unroll
            for (int m = 0; m < 4; ++m) {
                if (m < 2 && fr == 0) continue;
                if constexpr (F8) { v2u w; w.x = outp[m][0][0]; w.y = outp[m][1][0]; *(v2u*)((unsigned char*)act + (size_t)(row0 + m) * FF + colb) = w; }
                else { v4u w; w.x = outp[m][0][0]; w.y = outp[m][0][1]; w.z = outp[m][1][0]; w.w = outp[m][1][1];
                    *(v4u*)(act + (size_t)(row0 + m) * FF + colb) = w; }
            }
            asm volatile("" ::: "memory");
        }
    }
};
typedef EpiUpT<false> EpiUp;
struct EpiDummy {
    static constexpr bool PERM = false, PERMA = true, AFTER_DRAIN = false;
    float* scratch;
    __device__ __forceinline__ void operator()(const pg8::f32x4 (&acc)[2][2][4][2], const pg8::Unit& u, int wr, int wc, int fr, int fq) const {
        f32x4 s = (f32x4){0.f, 0.f, 0.f, 0.f};
#pragma unroll
        for (int ai = 0; ai < 2; ++ai)
#pragma unroll
            for (int bj = 0; bj < 2; ++bj)
#pragma unroll
                for (int m = 0; m < 4; ++m)
#pragma unroll
                    for (int n = 0; n < 2; ++n) s += acc[ai][bj][m][n];
        scratch[(size_t)(u.pm * 22 + u.pn) * 512 + ((wr * 4 + wc) * 4 + fq) * 16 + fr] = (s.x + s.y) + (s.z + s.w);
    }
};
template <bool F8>
__device__ __forceinline__ void fixup_phase(Frame& F, const float* cw, const float* cb, const float* halo, bf16* act) {
    const int gt = F.vcu * (NWAVES * 64) + F.tid, NT = F.G * NWAVES * 64;
    constexpr int C4 = FF / 4;
    for (int it = gt; it < NBLK64 * 2 * C4; it += NT) {
        const int c = (it % C4) * 4, rj = it / C4, j = rj & 1, blk = rj >> 1, t = blk * 64 + j, tb = t % SEQ;
        f32x4 y[2];
#pragma unroll
        for (int bj = 0; bj < 2; ++bj) {
            const int cc = bj * FF + c;
            const f32x4 z = (f32x4){0.f, 0.f, 0.f, 0.f};
            const f32x4 ut = *(const f32x4*)(halo + ((size_t)blk * 4 + j) * NUP + cc);
            f32x4 u1, u2;
            if (j == 1) { u1 = *(const f32x4*)(halo + ((size_t)blk * 4 + 0) * NUP + cc); u2 = (tb == 1) ? z : *(const f32x4*)(halo + ((size_t)(blk - 1) * 4 + 3) * NUP + cc); }
            else { u1 = (tb == 0) ? z : *(const f32x4*)(halo + ((size_t)(blk - 1) * 4 + 3) * NUP + cc); u2 = (tb == 0) ? z : *(const f32x4*)(halo + ((size_t)(blk - 1) * 4 + 2) * NUP + cc); }
            y[bj] = *(const f32x4*)(cb + cc) + *(const f32x4*)(cw + cc) * u2 + *(const f32x4*)(cw + NUP + cc) * u1 + *(const f32x4*)(cw + 2 * NUP + cc) * ut;
        }
        if constexpr (F8) *(unsigned*)((unsigned char*)act + (size_t)t * FF + c) = pk4f8(silu_mul(y[0].x, y[1].x), silu_mul(y[0].y, y[1].y), silu_mul(y[0].z, y[1].z), silu_mul(y[0].w, y[1].w));
        else { v2u w; w.x = cvtpk(silu_mul(y[0].x, y[1].x), silu_mul(y[0].y, y[1].y)); w.y = cvtpk(silu_mul(y[0].z, y[1].z), silu_mul(y[0].w, y[1].w));
            *(v2u*)(act + (size_t)t * FF + c) = w; }
    }
}

__device__ __forceinline__ int crow(int r, int hi) { return (r & 3) + 8 * (r >> 2) + 4 * hi; }
__device__ __forceinline__ void glds16(const void* gsrc, unsigned lds_dst) { unsigned keep;
    asm volatile("s_mov_b32 %0, m0\n\ts_mov_b32 m0, %2\n\ts_nop 0\n\tglobal_load_lds_dwordx4 %1, off\n\ts_mov_b32 m0, %0" : "=&s"(keep) : "v"(gsrc), "s"(lds_dst) : "memory"); }
__device__ __forceinline__ float max3f(float a, float b, float c) { return fmaxf(fmaxf(a, b), c); }

namespace band {
constexpr int SLOTB = 8192;
constexpr int LDS_K = 0, LDS_V = 2 * SLOTB, LDS_WS = 4 * SLOTB, LDS_TB = LDS_WS + NWAVES * 64 * 4, LDS_OST = LDS_TB + 640 * 4 + 512, LDS_END = LDS_OST + NWAVES * 4096;
static_assert(LDS_END <= RING_BYTES, "band LDS");
__device__ __forceinline__ void unit(Frame& F, int b, int h, int U, const bf16* Q, const bf16* K, const bf16* V, bf16* O, const float* rel) {
    const int tid = F.tid, lane = F.lane, r32 = lane & 31, hi = lane >> 5, wid = F.wave;
    LAS unsigned char* shm = F.lds + RING_OFF;
    const unsigned lds0 = (unsigned)(uintptr_t)shm;
    const long rowbase = (long)b * SEQ; const int q0 = U * 256, c0 = 4 * U, cq = c0 + (wid >> 1);
    const bf16* Qw = Q + (rowbase + q0 + wid * 32) * DM + h * 64;
    const bf16* Kh = K + rowbase * DM + h * 64; const bf16* Vh = V + rowbase * DM + h * 64;
    LAS float* wsf = (LAS float*)(shm + LDS_WS) + wid * 64;
    LAS float* tb = (LAS float*)(shm + LDS_TB);
    const bf16* ksrc = Kh + (long)lane * DM + wid * 8;
    const bf16* vsrc = Vh + (long)(16 * (wid & 3) + (lane >> 2)) * DM + (wid >> 2) * 32 + (lane & 3) * 8;
    const unsigned kdst = lds0 + LDS_K + wid * 1024, vdst = lds0 + LDS_V + wid * 1024;
    const int lo = (c0 - 8 > 0) ? c0 - 8 : 0, hiT = c0 + 3, NT = hiT - lo + 1, t0 = (c0 - 5 > 0) ? c0 - 5 : 0;
#define BAND_KT(i) ((t0 + (i) <= hiT) ? t0 + (i) : lo + (t0 + (i) - hiT - 1))
    for (int i = tid; i < 640; i += NWAVES * 64) { int d = i - 64; d = d < -256 ? -256 : (d > 256 ? 256 : d); tb[i] = rel[(d + 256) * 16 + h] * LOG2E; }
    { const int kt = BAND_KT(0); glds16(ksrc + (long)kt * 64 * DM, (unsigned)__builtin_amdgcn_readfirstlane(kdst)); glds16(vsrc + (long)kt * 64 * DM, (unsigned)__builtin_amdgcn_readfirstlane(vdst)); }
    bf16x8 qr[4];
#pragma unroll
    for (int d0 = 0; d0 < 4; ++d0) qr[d0] = *(const bf16x8*)(Qw + (long)r32 * DM + d0 * 16 + hi * 8);
    float m_run = -INFINITY, l_run = 0.f; f32x16 o[2]; o[0] = f32x16{}; o[1] = f32x16{};
    const int qpos = q0 + wid * 32 + r32;
    const LAS unsigned char* vbase = shm + LDS_V + ((lane >> 4) & 1) * 32 + (lane & 3) * 8 + (4 * hi + ((lane & 15) >> 2)) * 64;
    for (int i = 0; i < NT; ++i) {
        asm volatile("s_waitcnt vmcnt(0) lgkmcnt(0)\n\ts_barrier" ::: "memory");
        if (i + 1 < NT) { const int kt = BAND_KT(i + 1); const unsigned so = ((i + 1) & 1) * SLOTB;
            glds16(ksrc + (long)kt * 64 * DM, (unsigned)__builtin_amdgcn_readfirstlane(kdst + so)); glds16(vsrc + (long)kt * 64 * DM, (unsigned)__builtin_amdgcn_readfirstlane(vdst + so)); }
        const int kt = BAND_KT(i);
        if (kt < cq - 8 || kt > cq) continue;
        const int so = (i & 1) * SLOTB;
        f32x16 p0 = f32x16{}, p1 = f32x16{};
        { const LAS unsigned char* kb = shm + LDS_K + so + hi * 1024 + r32 * 16;
#pragma unroll
          for (int d0 = 0; d0 < 4; ++d0) { const bf16x8 b0 = *(const LAS bf16x8*)(kb + d0 * 2048), b1 = *(const LAS bf16x8*)(kb + d0 * 2048 + 512);
              p0 = __builtin_amdgcn_mfma_f32_32x32x16_bf16(b0, qr[d0], p0, 0, 0, 0); p1 = __builtin_amdgcn_mfma_f32_32x32x16_bf16(b1, qr[d0], p1, 0, 0, 0); } }
        if (kt + 5 <= cq) { const float cbias = tb[639];
#pragma unroll
          for (int r = 0; r < 16; ++r) { p0[r] += cbias; p1[r] += cbias; } }
        else { const int ib = qpos - 64 * kt + 64 - 4 * hi;
#pragma unroll
          for (int r = 0; r < 16; ++r) { const int ix = ib - ((r & 3) + 8 * (r >> 2)); p0[r] += tb[ix]; p1[r] += tb[ix - 32]; } }
        float rm = p0[0];
#pragma unroll
        for (int r = 0; r < 16; ++r) rm = max3f(rm, p0[r], p1[r]);
        { auto rr = __builtin_amdgcn_permlane32_swap(__float_as_uint(rm), __float_as_uint(rm), false, false); rm = fmaxf(__uint_as_float(rr[0]), __uint_as_float(rr[1])); }
        const float mnew = fmaxf(m_run, rm), f = __builtin_amdgcn_exp2f(m_run - mnew); m_run = mnew;
        float sacc = 0.f;
#pragma unroll
        for (int r = 0; r < 16; ++r) { p0[r] = __builtin_amdgcn_exp2f(p0[r] - mnew); p1[r] = __builtin_amdgcn_exp2f(p1[r] - mnew); sacc += p0[r] + p1[r]; }
        l_run = l_run * f + sacc;
        if (!__all(f == 1.0f)) {
            if (hi == 0) wsf[r32] = f;
            LDS_WAIT();
#pragma unroll
            for (int r = 0; r < 16; ++r) { const float fr_ = wsf[crow(r, hi)]; o[0][r] *= fr_; o[1][r] *= fr_; }
        }
        v4u pw[4];
        pw[0] = (v4u){cvtpk(p0[0], p0[1]), cvtpk(p0[2], p0[3]), cvtpk(p0[4], p0[5]), cvtpk(p0[6], p0[7])};
        pw[1] = (v4u){cvtpk(p0[8], p0[9]), cvtpk(p0[10], p0[11]), cvtpk(p0[12], p0[13]), cvtpk(p0[14], p0[15])};
        pw[2] = (v4u){cvtpk(p1[0], p1[1]), cvtpk(p1[2], p1[3]), cvtpk(p1[4], p1[5]), cvtpk(p1[6], p1[7])};
        pw[3] = (v4u){cvtpk(p1[8], p1[9]), cvtpk(p1[10], p1[11]), cvtpk(p1[12], p1[13]), cvtpk(p1[14], p1[15])};
        const LAS unsigned char* vb = vbase + so;
#pragma unroll
        for (int d0 = 0; d0 < 2; ++d0)
#pragma unroll
            for (int ks = 0; ks < 4; ++ks) {
                const s16x4 vlo = __builtin_bit_cast(s16x4, __builtin_amdgcn_ds_read_tr16_b64_v4i16((LAS s16x4*)(vb + d0 * 4096 + ks * 1024)));
                const s16x4 vhi = __builtin_bit_cast(s16x4, __builtin_amdgcn_ds_read_tr16_b64_v4i16((LAS s16x4*)(vb + d0 * 4096 + ks * 1024 + 512)));
                const bf16x8 vf = (bf16x8){vlo[0], vlo[1], vlo[2], vlo[3], vhi[0], vhi[1], vhi[2], vhi[3]};
                o[d0] = __builtin_amdgcn_mfma_f32_32x32x16_bf16(__builtin_bit_cast(bf16x8, pw[ks]), vf, o[d0], 0, 0, 0);
            }
    }
#undef BAND_KT
    { auto rr = __builtin_amdgcn_permlane32_swap(__float_as_uint(l_run), __float_as_uint(l_run), false, false); l_run = __uint_as_float(rr[0]) + __uint_as_float(rr[1]); }
    if (hi == 0) wsf[32 + r32] = l_run;
    LDS_WAIT();
    float rli[16];
#pragma unroll
    for (int r = 0; r < 16; ++r) rli[r] = __builtin_amdgcn_rcpf(wsf[32 + crow(r, hi)]);
    bf16* Ow = O + (rowbase + q0 + wid * 32) * DM + h * 64;
    { LAS bf16* stg = (LAS bf16*)(shm + LDS_OST) + wid * 2048;
#pragma unroll
      for (int r = 0; r < 16; ++r) { const int orow = crow(r, hi);
#pragma unroll
          for (int d0 = 0; d0 < 2; ++d0) stg[orow * 64 + d0 * 32 + r32] = (bf16)f2bf(o[d0][r] * rli[r]); }
      LDS_WAIT();
#pragma unroll
      for (int i = 0; i < 4; ++i) { const int row = i * 8 + (lane >> 3), ch = lane & 7; const v4u v = *(const LAS v4u*)(stg + row * 64 + ch * 8); *(v4u*)(Ow + (long)row * DM + ch * 8) = v; } }
    asm volatile("s_waitcnt lgkmcnt(0)\n\ts_barrier" ::: "memory");
}
__device__ __forceinline__ void phase(Frame& F, const bf16* Q, const bf16* K, const bf16* V, bf16* O, const float* rel) {
    const int NU = BATCH * 16 * 32, per = (NU + F.G - 1) / F.G;
    for (int i = 0; i < per; ++i) { const int uid = F.vcu * per + i; if (uid >= NU) break; unit(F, uid >> 9, (uid >> 5) & 15, uid & 31, Q, K, V, O, rel); }
}
}

namespace dsa {
__device__ __forceinline__ unsigned okey(float s) { const unsigned u = __float_as_uint(s + 0.0f); return (u & 0x80000000u) ? ~u : (u | 0x80000000u); }
struct Ctx { const bf16* QA; const bf16* KA; const bf16* VA; const bf16* QI; const bf16* KI; const float* WI; bf16* M; const LAS float* t5l; unsigned short* SEL; };

__device__ __forceinline__ void scan_hist(const LAS unsigned* hq, int lane, unsigned need, unsigned& bin, unsigned& above) {
    const LAS v4u* hp = (const LAS v4u*)hq + lane * 4;
    unsigned wds[16];
#pragma unroll
    for (int j = 0; j < 4; ++j) { const v4u t = hp[j]; wds[4 * j] = t.x; wds[4 * j + 1] = t.y; wds[4 * j + 2] = t.z; wds[4 * j + 3] = t.w; }
    unsigned tl = 0;
#pragma unroll
    for (int j = 0; j < 16; ++j) tl += (wds[j] & 0xffffu) + (wds[j] >> 16);
    unsigned suf = tl;
#pragma unroll
    for (int o = 1; o < 64; o <<= 1) { const unsigned v = __shfl_down(suf, o); if (lane + o < 64) suf += v; }
    const unsigned S = suf - tl;
    const bool cross = (S < need) && (need <= S + tl);
    unsigned c = S, bsel = 0, ab = 0; bool found = false;
#pragma unroll
    for (int k = 31; k >= 0; --k) { const unsigned cnt = (wds[k >> 1] >> (16 * (k & 1))) & 0xffffu; if (!found && c + cnt >= need) { bsel = 32 * lane + k; ab = c; found = true; } c += cnt; }
    const unsigned long long bal = __ballot(cross);
    const int src = bal ? __builtin_ctzll(bal) : 0;
    bin = __shfl(bsel, src); above = __shfl(ab, src);
}

__device__ __forceinline__ void attend(const Ctx& C, const LAS unsigned short* sq, int nvalid, long rowbase, long token, int tpos, int lane, int g0) {
    asm volatile("" : "+v"(lane));
    const int l15 = lane & 15, l4 = lane >> 4;
    int sidx[16];
#pragma unroll
    for (int ti = 0; ti < 16; ++ti) sidx[ti] = sq[ti * 16 + l15];
    unsigned bpk[4] = {0u, 0u, 0u, 0u};
#pragma unroll
    for (int ti = 0; ti < 16; ++ti) { const int rel = sidx[ti] - tpos, n = rel < 0 ? -rel : rel;
        const int bk = (rel > 0 ? 16 : 0) + (n < 8 ? n : 8 + (n >= 12) + (n >= 16) + (n >= 23) + (n >= 32) + (n >= 46) + (n >= 64) + (n >= 91));
        bpk[ti >> 2] |= (unsigned)bk << (8 * (ti & 3)); }
#pragma unroll 1
    for (int g = g0; g < g0 + 2; ++g) {
        const bf16* qp = C.QA + token * DM + (4 * g + (lane & 3)) * 64 + 8 * l4;
        const bf16x8 qf0 = *(const bf16x8*)qp, qf1 = *(const bf16x8*)(qp + 32);
        const bf16* kbase = C.KA + rowbase * 256 + g * 64 + 8 * l4;
        f32x4 S[16];
#pragma unroll
        for (int hh = 0; hh < 4; ++hh) {
            bf16x8 kf0[4], kf1[4];
#pragma unroll
            for (int j = 0; j < 4; ++j) { const bf16* kp = kbase + (long)sidx[hh * 4 + j] * 256; kf0[j] = *(const bf16x8*)kp; kf1[j] = *(const bf16x8*)(kp + 32); }
#pragma unroll
            for (int j = 0; j < 4; ++j) { const int ti = hh * 4 + j;
                f32x4 a = *(const LAS f32x4*)(C.t5l + ((bpk[hh] >> (8 * j)) & 255u) * 16 + 4 * g);
                asm volatile("v_mfma_f32_16x16x32_bf16 %0, %1, %2, %0" : "+v"(a) : "v"(qf0), "v"(kf0[j]));
                asm volatile("v_mfma_f32_16x16x32_bf16 %0, %1, %2, %0" : "+v"(a) : "v"(qf1), "v"(kf1[j]));
                S[ti] = a; }
            asm volatile("s_nop 15\n\ts_nop 7" : "+v"(S[hh * 4]), "+v"(S[hh * 4 + 1]), "+v"(S[hh * 4 + 2]), "+v"(S[hh * 4 + 3]));
        }
#pragma unroll
        for (int ti = 0; ti < 16; ++ti) if (ti * 16 >= nvalid) S[ti] = (f32x4){-INFINITY, -INFINITY, -INFINITY, -INFINITY};
        f32x4 mx = S[0];
#pragma unroll
        for (int ti = 1; ti < 16; ++ti) { mx.x = fmaxf(mx.x, S[ti].x); mx.y = fmaxf(mx.y, S[ti].y); mx.z = fmaxf(mx.z, S[ti].z); mx.w = fmaxf(mx.w, S[ti].w); }
#pragma unroll
        for (int o = 1; o < 16; o <<= 1) { mx.x = fmaxf(mx.x, __shfl_xor(mx.x, o)); mx.y = fmaxf(mx.y, __shfl_xor(mx.y, o)); mx.z = fmaxf(mx.z, __shfl_xor(mx.z, o)); mx.w = fmaxf(mx.w, __shfl_xor(mx.w, o)); }
        f32x4 ls = (f32x4){0.f, 0.f, 0.f, 0.f};
        unsigned P01[16], P23[16];
#pragma unroll
        for (int ti = 0; ti < 16; ++ti) { const float e0 = __builtin_amdgcn_exp2f(S[ti].x - mx.x), e1 = __builtin_amdgcn_exp2f(S[ti].y - mx.y), e2 = __builtin_amdgcn_exp2f(S[ti].z - mx.z), e3 = __builtin_amdgcn_exp2f(S[ti].w - mx.w);
            ls += (f32x4){e0, e1, e2, e3}; P01[ti] = cvtpk(e0, e1); P23[ti] = cvtpk(e2, e3); }
#pragma unroll
        for (int o = 1; o < 16; o <<= 1) { ls.x += __shfl_xor(ls.x, o); ls.y += __shfl_xor(ls.y, o); ls.z += __shfl_xor(ls.z, o); ls.w += __shfl_xor(ls.w, o); }
        float o_[4][16];
#pragma unroll
        for (int h = 0; h < 4; ++h)
#pragma unroll
            for (int d = 0; d < 16; ++d) o_[h][d] = 0.f;
        const bf16* vbase = C.VA + rowbase * 256 + g * 64 + 16 * l4;
#pragma unroll
        for (int hh = 0; hh < 4; ++hh) {
            v4u va[4], vb[4];
#pragma unroll
            for (int j = 0; j < 4; ++j) { const v4u* vp = (const v4u*)(vbase + (long)sidx[hh * 4 + j] * 256); va[j] = vp[0]; vb[j] = vp[1]; }
#pragma unroll
            for (int j = 0; j < 4; ++j) { const int ti = hh * 4 + j; const v4u v0 = va[j], v1 = vb[j];
                float vf[16];
                vf[0] = bf_lo(v0.x); vf[1] = bf_hi(v0.x); vf[2] = bf_lo(v0.y); vf[3] = bf_hi(v0.y); vf[4] = bf_lo(v0.z); vf[5] = bf_hi(v0.z); vf[6] = bf_lo(v0.w); vf[7] = bf_hi(v0.w);
                vf[8] = bf_lo(v1.x); vf[9] = bf_hi(v1.x); vf[10] = bf_lo(v1.y); vf[11] = bf_hi(v1.y); vf[12] = bf_lo(v1.z); vf[13] = bf_hi(v1.z); vf[14] = bf_lo(v1.w); vf[15] = bf_hi(v1.w);
                const float p0 = bf_lo(P01[ti]), p1 = bf_hi(P01[ti]), p2 = bf_lo(P23[ti]), p3 = bf_hi(P23[ti]);
#pragma unroll
                for (int d = 0; d < 16; ++d) { o_[0][d] += p0 * vf[d]; o_[1][d] += p1 * vf[d]; o_[2][d] += p2 * vf[d]; o_[3][d] += p3 * vf[d]; } }
        }
        float res[4];
#pragma unroll
        for (int h = 0; h < 4; ++h) {
            float a8[8], a4[4], a2[2];
            const bool b3 = (l15 & 8) != 0, b2 = (l15 & 4) != 0, b1 = (l15 & 2) != 0, b0 = (l15 & 1) != 0;
#pragma unroll
            for (int d = 0; d < 8; ++d) { const float keep = b3 ? o_[h][d + 8] : o_[h][d], send = b3 ? o_[h][d] : o_[h][d + 8]; a8[d] = keep + __shfl_xor(send, 8); }
#pragma unroll
            for (int d = 0; d < 4; ++d) { const float keep = b2 ? a8[d + 4] : a8[d], send = b2 ? a8[d] : a8[d + 4]; a4[d] = keep + __shfl_xor(send, 4); }
#pragma unroll
            for (int d = 0; d < 2; ++d) { const float keep = b1 ? a4[d + 2] : a4[d], send = b1 ? a4[d] : a4[d + 2]; a2[d] = keep + __shfl_xor(send, 2); }
            { const float keep = b0 ? a2[1] : a2[0], send = b0 ? a2[0] : a2[1]; res[h] = keep + __shfl_xor(send, 1); }
        }
        bf16* mp = C.M + token * DM + (4 * g) * 64 + lane;
        mp[0] = (bf16)f2bf(res[0] * __builtin_amdgcn_rcpf(ls.x)); mp[64] = (bf16)f2bf(res[1] * __builtin_amdgcn_rcpf(ls.y)); mp[128] = (bf16)f2bf(res[2] * __builtin_amdgcn_rcpf(ls.z)); mp[192] = (bf16)f2bf(res[3] * __builtin_amdgcn_rcpf(ls.w));
    }
}

constexpr int CAND_CAP = 256;
constexpr int SELKS_OFF = KS_OFF;
__device__ __forceinline__ float relu_i(float x) { const int i = __builtin_bit_cast(int, x); return __builtin_bit_cast(float, i > 0 ? i : 0); }
struct SelState { unsigned pre[4], need[4], cnt[4], tcnt[4]; };
__device__ __forceinline__ void tile_mfma(f32x16 (&acc)[2], const LAS unsigned char* kf, const int (&koff)[4], const bf16x8 (&qa)[4]) {
#pragma unroll
    for (int h2 = 0; h2 < 2; ++h2) { acc[h2] = f32x16{};
#pragma unroll
        for (int ks = 0; ks < 4; ++ks) { const bf16x8 kb = *(const LAS bf16x8*)(kf + koff[ks] + h2 * 4096); acc[h2] = __builtin_amdgcn_mfma_f32_32x32x16_bf16(qa[ks], kb, acc[h2], 0, 0, 0); } }
}
template <class ActionT>
__device__ __forceinline__ void tile_valu(const f32x16 (&acc)[2], const f32x2_t (&wp)[2][4], int kbase, ActionT&& act) {
#pragma unroll
    for (int h2 = 0; h2 < 2; ++h2) {
        f32x2_t sa = {0.f, 0.f}, sb = {0.f, 0.f};
#pragma unroll
        for (int jp = 0; jp < 4; ++jp) {
            const f32x2_t ra = {relu_i(acc[h2][2 * jp]), relu_i(acc[h2][2 * jp + 1])};
            const f32x2_t rb = {relu_i(acc[h2][8 + 2 * jp]), relu_i(acc[h2][8 + 2 * jp + 1])};
            sa = __builtin_elementwise_fma(ra, wp[0][jp], sa); sb = __builtin_elementwise_fma(rb, wp[1][jp], sb); }
        act(kbase + h2 * 32, (sa.x + sa.y) + 0.0f, (sb.x + sb.y) + 0.0f);
    }
}
constexpr int KSLOTS = 3;
__device__ __forceinline__ void wait_tile(int newer) {
    if (newer >= 4) asm volatile("s_waitcnt vmcnt(4) lgkmcnt(0)\n\ts_barrier" ::: "memory");
    else if (newer == 3) asm volatile("s_waitcnt vmcnt(3) lgkmcnt(0)\n\ts_barrier" ::: "memory");
    else if (newer == 2) asm volatile("s_waitcnt vmcnt(2) lgkmcnt(0)\n\ts_barrier" ::: "memory");
    else if (newer == 1) asm volatile("s_waitcnt vmcnt(1) lgkmcnt(0)\n\ts_barrier" ::: "memory");
    else asm volatile("s_waitcnt vmcnt(0) lgkmcnt(0)\n\ts_barrier" ::: "memory");
}
template <class ActionT>
__device__ __forceinline__ void tile_pass(Frame& F, const bf16* ksrc, unsigned kdst, const LAS unsigned char* kfr, const int (&koff)[4], int NT, const bf16x8 (&qa)[4], const f32x2_t (&wp)[2][4], ActionT&& act) {
    asm volatile("s_waitcnt lgkmcnt(0)\n\ts_barrier" ::: "memory");
    const int npre = NT < KSLOTS ? NT : KSLOTS;
    for (int j = 0; j < npre; ++j) glds16(ksrc + (long)j * 4096, (unsigned)__builtin_amdgcn_readfirstlane(kdst + j * 8192));
    wait_tile(npre - 1);
    f32x16 accA[2], accB[2];
    tile_mfma(accA, kfr, koff, qa);
    int sl = 0;
    int kt = 0;
    for (; kt + 2 < NT; kt += 2) {
        { const int inflight = (NT - kt - 2) < (KSLOTS - 2) ? (NT - kt - 2) : (KSLOTS - 2); wait_tile(inflight); }
        if (kt + KSLOTS < NT) glds16(ksrc + (long)(kt + KSLOTS) * 4096, (unsigned)__builtin_amdgcn_readfirstlane(kdst + sl * 8192));
        sl = (sl == KSLOTS - 1) ? 0 : sl + 1;
        tile_mfma(accB, kfr + sl * 8192, koff, qa);
        tile_valu(accA, wp, kt * 64, act);
        { const int inflight = (NT - kt - 3) < (KSLOTS - 2) ? (NT - kt - 3) : (KSLOTS - 2); wait_tile(inflight); }
        if (kt + 1 + KSLOTS < NT) glds16(ksrc + (long)(kt + 1 + KSLOTS) * 4096, (unsigned)__builtin_amdgcn_readfirstlane(kdst + sl * 8192));
        sl = (sl == KSLOTS - 1) ? 0 : sl + 1;
        tile_mfma(accA, kfr + sl * 8192, koff, qa);
        tile_valu(accB, wp, (kt + 1) * 64, act);
    }
    if (kt + 1 < NT) {
        wait_tile(0);
        sl = (sl == KSLOTS - 1) ? 0 : sl + 1;
        tile_mfma(accB, kfr + sl * 8192, koff, qa);
        tile_valu(accA, wp, kt * 64, act);
        tile_valu(accB, wp, (kt + 1) * 64, act);
    } else tile_valu(accA, wp, kt * 64, act);
    LDS_WAIT();
}
__device__ __forceinline__ void scan_hist_cnt(const LAS unsigned* hq, int lane, unsigned need, unsigned& bin, unsigned& above, unsigned& bcnt) {
    const LAS v4u* hp = (const LAS v4u*)hq + lane * 2;
    unsigned wds[8];
#pragma unroll
    for (int j = 0; j < 2; ++j) { const v4u t = hp[j]; wds[4 * j] = t.x; wds[4 * j + 1] = t.y; wds[4 * j + 2] = t.z; wds[4 * j + 3] = t.w; }
    unsigned tl = 0;
#pragma unroll
    for (int j = 0; j < 8; ++j) tl += wds[j];
    unsigned suf = tl;
#pragma unroll
    for (int o = 1; o < 64; o <<= 1) { const unsigned v = __shfl_down(suf, o); if (lane + o < 64) suf += v; }
    const unsigned S = suf - tl;
    const bool cross = (S < need) && (need <= S + tl);
    unsigned c = S, bsel = 0, ab = 0, bc = 0; bool found = false;
#pragma unroll
    for (int k = 7; k >= 0; --k) { const unsigned cnt = wds[k]; if (!found && c + cnt >= need) { bsel = 8 * lane + k; ab = c; bc = cnt; found = true; } c += cnt; }
    const unsigned long long bal = __ballot(cross);
    const int src = bal ? __builtin_ctzll(bal) : 0;
    bin = __builtin_amdgcn_readfirstlane(__shfl(bsel, src)); above = __builtin_amdgcn_readfirstlane(__shfl(ab, src)); bcnt = __builtin_amdgcn_readfirstlane(__shfl(bc, src));
}
__device__ __forceinline__ void step(Frame& F, const Ctx& C, int b, int c, int half) {
    int lane_ = F.lane; asm volatile("" : "+v"(lane_));
    const int lane = lane_, r = lane & 31, hi = lane >> 5, wave = F.wave;
    LAS unsigned* hist = (LAS unsigned*)(F.lds + RING_OFF + wave * 16384);
    LAS unsigned short* sel = (LAS unsigned short*)hist;
    LAS unsigned* cand = hist + 2048;
    LAS unsigned* fbflag = (LAS unsigned*)(F.lds + AUX_OFF + 2048);
    const long rowbase = (long)b * SEQ;
    const int tq0 = 64 * c + 32 * half + 4 * wave;
    const int N = 64 * (c + 1), NT = c + 1;
    int nvalid = 256;
    if (N <= 256) {
        nvalid = N;
        for (int j = lane; j < 4 * 256; j += 64) sel[j] = (unsigned short)(((j & 255) < N) ? (j & 255) : 0);
    } else {
        const int aq = 2 * ((r >> 2) & 1) + (r >> 4), ah = 4 * ((r >> 3) & 1) + (r & 3);
        const bf16* qip = C.QI + (rowbase + tq0 + aq) * 512 + ah * 64 + 8 * hi;
        bf16x8 qa[4];
#pragma unroll
        for (int ks = 0; ks < 4; ++ks) qa[ks] = *(const bf16x8*)(qip + 16 * ks);
        f32x2_t wp[2][4];
#pragma unroll
        for (int t = 0; t < 2; ++t) { const float* wq = C.WI + (rowbase + tq0 + 2 * hi + t) * 8; const f32x4 w0 = *(const f32x4*)wq, w1 = *(const f32x4*)(wq + 4);
            wp[t][0] = (f32x2_t){w0.x, w0.y}; wp[t][1] = (f32x2_t){w0.z, w0.w}; wp[t][2] = (f32x2_t){w1.x, w1.y}; wp[t][3] = (f32x2_t){w1.z, w1.w}; }
        float Bq;
        { float ssq = 0.f;
#pragma unroll
          for (int ks = 0; ks < 4; ++ks)
#pragma unroll
              for (int e = 0; e < 8; ++e) { const float v = bf_lo((unsigned)(unsigned short)qa[ks][e]); ssq += v * v; }
          ssq += __shfl_xor(ssq, 32);
          float term = fabsf(C.WI[(rowbase + tq0 + aq) * 8 + ah]) * sqrtf(ssq);
          term += __shfl_xor(term, 1); term += __shfl_xor(term, 2); term += __shfl_xor(term, 8);
          Bq = term * 8.25f + 1e-20f; }
        const float B0 = __shfl(Bq, (hi << 2)), B1 = __shfl(Bq, (hi << 2) | 16);
        const float sc0 = 1024.0f / B0, sc1 = 1024.0f / B1;
        asm volatile("" :: "v"(qa[0]), "v"(qa[1]), "v"(qa[2]), "v"(qa[3]));
        asm volatile("" :: "v"(wp[0][0]), "v"(wp[0][1]), "v"(wp[0][2]), "v"(wp[0][3]), "v"(wp[1][0]), "v"(wp[1][1]), "v"(wp[1][2]), "v"(wp[1][3]), "v"(sc0), "v"(sc1));
        const bf16* ksrc = C.KI + rowbase * 64 + (long)(wave * 8 + (lane >> 3)) * 64 + ((lane & 7) ^ (lane >> 3)) * 8;
        const unsigned kdst = (unsigned)(uintptr_t)(F.lds + SELKS_OFF) + wave * 1024;
        const LAS unsigned char* kfr = F.lds + SELKS_OFF + r * 128;
        int koff[4];
#pragma unroll
        for (int ks = 0; ks < 4; ++ks) koff[ks] = ((2 * ks + hi) ^ (r & 7)) * 16;
        const unsigned below = (1u << r) - 1u;
        LAS v4u* hz = (LAS v4u*)hist;
        if (wave == 0 && lane == 0) *fbflag = 0u;
#pragma unroll
        for (int j = 0; j < 8; ++j) hz[j * 64 + lane] = (v4u){0u, 0u, 0u, 0u};
        tile_pass(F, ksrc, kdst, kfr, koff, NT, qa, wp, [&](int kbase, float s0, float s1) {
            const int b0 = (int)__builtin_amdgcn_fmed3f(__builtin_fmaf(s0, sc0, 256.0f), 0.0f, 511.0f), b1 = (int)__builtin_amdgcn_fmed3f(__builtin_fmaf(s1, sc1, 256.0f), 0.0f, 511.0f);
            __hip_atomic_fetch_add(hist + (2 * hi) * 512 + b0, 1u, __ATOMIC_RELAXED, __HIP_MEMORY_SCOPE_WORKGROUP);
            __hip_atomic_fetch_add(hist + (2 * hi + 1) * 512 + b1, 1u, __ATOMIC_RELAXED, __HIP_MEMORY_SCOPE_WORKGROUP);
        });
#ifdef PROBE_SKEL
        tile_pass(F, ksrc, kdst, kfr, koff, NT, qa, wp, [&](int kbase, float s0, float s1) { });
#endif
#ifdef PROBE_SCORE
        { float dsum = 0.f; tile_pass(F, ksrc, kdst, kfr, koff, NT, qa, wp, [&](int kbase, float s0, float s1) { dsum += s0 + s1; }); if (dsum == 12345.678f) hist[0] = 1u; }
#endif
        SelState st;
        unsigned tbin[4], bcn[4]; bool ovf = false;
#pragma unroll
        for (int ql = 0; ql < 4; ++ql) { unsigned above; scan_hist_cnt(hist + ql * 512, lane, 256u, tbin[ql], above, bcn[ql]); st.cnt[ql] = 0u; st.tcnt[ql] = 0u; st.need[ql] = 256u - above; st.pre[ql] = above;
#ifdef PROBE_OVF
            ovf |= bcn[ql] > (unsigned)PROBE_OVF; }
#else
            ovf |= bcn[ql] > (unsigned)CAND_CAP; }
#endif
        LDS_WAIT();
        if (ovf && lane == 0) *fbflag = 1u;
        asm volatile("s_waitcnt lgkmcnt(0)\n\ts_barrier" ::: "memory");
#ifdef PROBE_NOFB
        const bool fb = false;
#elif defined(PROBE_NOFB2)
        const bool fb = __builtin_amdgcn_readfirstlane((int)*fbflag) == 0x7fffffff;
#else
        const bool fb = __builtin_amdgcn_readfirstlane((int)*fbflag) != 0;
#endif
        if (!fb) {
            const int tb0 = (int)(hi ? tbin[2] : tbin[0]), tb1 = (int)(hi ? tbin[3] : tbin[1]);
            tile_pass(F, ksrc, kdst, kfr, koff, NT, qa, wp, [&](int kbase, float s0, float s1) {
#pragma unroll
                for (int t = 0; t < 2; ++t) {
                    const float s = t ? s1 : s0; const int bin = (int)__builtin_amdgcn_fmed3f(__builtin_fmaf(s, (t ? sc1 : sc0), 256.0f), 0.0f, 511.0f), tb = t ? tb1 : tb0;
                    const bool gt = bin > tb, eq = bin == tb;
                    const unsigned long long mg = __ballot(gt), me = __ballot(eq);
                    const unsigned mgh = hi ? (unsigned)(mg >> 32) : (unsigned)mg, meh = hi ? (unsigned)(me >> 32) : (unsigned)me;
                    const unsigned pos = (hi ? st.cnt[2 + t] : st.cnt[t]) + __builtin_popcount(mgh & below);
                    sel[(gt && pos < 256u) ? (2 * hi + t) * 256 + pos : 3200 + lane] = (unsigned short)(kbase + r);
                    const unsigned cpos = (hi ? st.tcnt[2 + t] : st.tcnt[t]) + __builtin_popcount(meh & below);
                    { LAS unsigned* cp = hist + ((eq && cpos < (unsigned)CAND_CAP) ? 2048 + ((2 * hi + t) * CAND_CAP + cpos) * 2 : 1700 + 2 * lane); cp[0] = okey(s); cp[1] = (unsigned)(kbase + r); }
                    st.cnt[t] += __builtin_popcount((unsigned)mg); st.cnt[2 + t] += __builtin_popcount((unsigned)(mg >> 32));
                    st.tcnt[t] += __builtin_popcount((unsigned)me); st.tcnt[2 + t] += __builtin_popcount((unsigned)(me >> 32));
                }
            });
#pragma unroll
            for (int ql = 0; ql < 4; ++ql) {
                const unsigned nc = bcn[ql], G = st.pre[ql], rq = st.need[ql];
                const LAS unsigned* cq = cand + ql * CAND_CAP * 2;
                unsigned ki4[4], xi4[4], rk4[4];
#pragma unroll
                for (int m = 0; m < 4; ++m) { const unsigned i = (unsigned)lane + 64u * m; ki4[m] = (i < nc) ? cq[2 * i] : 0u; xi4[m] = (i < nc) ? cq[2 * i + 1] : 0u; rk4[m] = 0u; }
                for (unsigned j = 0; j < nc; ++j) { const unsigned kj = cq[2 * j];
#pragma unroll
                    for (int m = 0; m < 4; ++m) rk4[m] += (kj > ki4[m] || (kj == ki4[m] && j < (unsigned)lane + 64u * m)) ? 1u : 0u; }
                unsigned base = G; const unsigned long long lt = (1ull << lane) - 1ull;
#pragma unroll
                for (int m = 0; m < 4; ++m) { const bool take = ((unsigned)lane + 64u * m < nc) && rk4[m] < rq; const unsigned long long mm = __ballot(take);
                    const unsigned pos = base + __builtin_popcountll(mm & lt); if (take && pos < 256u) sel[ql * 256 + pos] = (unsigned short)xi4[m]; base += __builtin_popcountll(mm); }
            }
        } else {
#pragma unroll
            for (int ql = 0; ql < 4; ++ql) { st.pre[ql] = 0u; st.need[ql] = 256u; st.cnt[ql] = 0u; st.tcnt[ql] = 0u; }
#pragma unroll 1
            for (int lev = 0; lev < 4; ++lev) {
#pragma unroll
                for (int j = 0; j < 8; ++j) hz[j * 64 + lane] = (v4u){0u, 0u, 0u, 0u};
                const unsigned pre0 = hi ? st.pre[2] : st.pre[0], pre1 = hi ? st.pre[3] : st.pre[1];
                const int sh = (lev == 0) ? 23 : (lev == 1) ? 14 : (lev == 2) ? 5 : 0, wd = (lev == 3) ? 5 : 9;
                tile_pass(F, ksrc, kdst, kfr, koff, NT, qa, wp, [&](int kbase, float s0, float s1) {
                    const unsigned k0 = okey(s0), k1 = okey(s1);
                    const unsigned b0 = (k0 >> sh) & ((1u << wd) - 1u), b1 = (k1 >> sh) & ((1u << wd) - 1u);
                    const bool in0 = (lev == 0) || ((k0 >> (sh + wd)) == pre0), in1 = (lev == 0) || ((k1 >> (sh + wd)) == pre1);
                    if (in0) __hip_atomic_fetch_add(hist + (2 * hi) * 512 + b0, 1u, __ATOMIC_RELAXED, __HIP_MEMORY_SCOPE_WORKGROUP);
                    if (in1) __hip_atomic_fetch_add(hist + (2 * hi + 1) * 512 + b1, 1u, __ATOMIC_RELAXED, __HIP_MEMORY_SCOPE_WORKGROUP);
                });
#pragma unroll
                for (int ql = 0; ql < 4; ++ql) { unsigned bin, above, bc; scan_hist_cnt(hist + ql * 512, lane, st.need[ql], bin, above, bc);
                    st.pre[ql] = (st.pre[ql] << wd) | bin; st.need[ql] -= above; }
                LDS_WAIT();
            }
            const unsigned T0 = hi ? st.pre[2] : st.pre[0], T1 = hi ? st.pre[3] : st.pre[1], rq0 = hi ? st.need[2] : st.need[0], rq1 = hi ? st.need[3] : st.need[1];
            tile_pass(F, ksrc, kdst, kfr, koff, NT, qa, wp, [&](int kbase, float s0, float s1) {
#pragma unroll
                for (int t = 0; t < 2; ++t) {
                    const unsigned kk = okey(t ? s1 : s0), T = t ? T1 : T0, rq = t ? rq1 : rq0;
                    const bool gt = kk > T, eq = kk == T;
                    const unsigned long long me = __ballot(eq);
                    const unsigned meh = hi ? (unsigned)(me >> 32) : (unsigned)me;
                    const unsigned trank = (hi ? st.tcnt[2 + t] : st.tcnt[t]) + __builtin_popcount(meh & below);
                    const bool take = gt || (eq && trank < rq);
                    const unsigned long long mt = __ballot(take);
                    const unsigned mth = hi ? (unsigned)(mt >> 32) : (unsigned)mt;
                    const unsigned pos = (hi ? st.cnt[2 + t] : st.cnt[t]) + __builtin_popcount(mth & below);
                    if (take && pos < 256u) sel[(2 * hi + t) * 256 + pos] = (unsigned short)(kbase + r);
                    st.cnt[t] += __builtin_popcount((unsigned)mt); st.cnt[2 + t] += __builtin_popcount((unsigned)(mt >> 32));
                    st.tcnt[t] += __builtin_popcount((unsigned)me); st.tcnt[2 + t] += __builtin_popcount((unsigned)(me >> 32));
                }
            });
        }
    }
    LDS_WAIT();
    { const LAS v4u* s4 = (const LAS v4u*)sel; v4u* g4 = (v4u*)(C.SEL + (rowbase + tq0) * 256);
#pragma unroll
      for (int j = 0; j < 2; ++j) g4[j * 64 + lane] = s4[j * 64 + lane]; }
    LDS_WAIT();
}
__device__ __forceinline__ void phase(Frame& F, const Ctx& C) {
    for (int v = F.vcu; v < 256; v += F.G) {
        const int b = v >> 6, c = v & 63;
#pragma unroll 1
        for (int it = 0; it < 4; ++it) step(F, C, b, (it < 2) ? c : 127 - c, it & 1);
    }
}
__device__ __forceinline__ void attn_phase(Frame& F, const Ctx& C) {
    int lane = F.lane; asm volatile("" : "+v"(lane));
    LAS unsigned short* sq = (LAS unsigned short*)(F.lds + RING_OFF + F.wave * 16384);
    const int nx = F.G / 32;
    for (int x = F.vcu / 32; x < 8; x += nx) {
        const int b = x >> 1, g0 = 2 * (x & 1); const long rowbase = (long)b * SEQ;
        const int w = (F.vcu & 31) * NWAVES + F.wave;
#pragma unroll 1
        for (int t = w; t < SEQ; t += 32 * NWAVES) {
            { const v4u* g4 = (const v4u*)(C.SEL + (rowbase + t) * 256); if (lane < 32) ((LAS v4u*)sq)[lane] = g4[lane]; }
            LDS_WAIT();
            const int N = 64 * ((t >> 6) + 1), nvalid = N < 256 ? N : 256;
            attend(C, sq, nvalid, rowbase, rowbase + t, t, lane, g0);
            LDS_WAIT();
        }
    }
}
}

namespace att8 {
typedef int v2i __attribute__((ext_vector_type(2)));
struct Ctx8 { const unsigned char* QA8; const unsigned char* KV8; const unsigned short* SEL; bf16* M; };
constexpr int T2_OFF = KS_OFF, T2_BYTES = 155 * 16 * 4, SELL_OFF = KS_OFF + 10240;
static_assert(T2_BYTES <= 10240 && SELL_OFF + NWAVES * 1024 <= AUX_OFF, "attention LDS map");
__device__ __forceinline__ void mfma8(f32x4& acc, long a, long b) { asm volatile("v_mfma_f32_16x16x32_fp8_fp8 %0, %1, %2, %0" : "+v"(acc) : "v"(a), "v"(b)); }
__device__ __forceinline__ unsigned pk4_fp8(float a, float b, float c, float d) { int r = __builtin_amdgcn_cvt_pk_fp8_f32(a, b, 0, false); r = __builtin_amdgcn_cvt_pk_fp8_f32(c, d, r, true); return (unsigned)r; }

__device__ __forceinline__ void gld16(v4u& dst, const void* p) { asm volatile("global_load_dwordx4 %0, %1, off" : "=v"(dst) : "v"(p) : "memory"); }
__device__ __forceinline__ void issue_kq(const Ctx8& C, const LAS unsigned short* sq, long rowbase, long token, int g, int l15, int l4, int h, v4u (&kr)[16], v4u& qv) {
    const unsigned char* kvb = C.KV8 + rowbase * 512 + g * 128 + 16 * l4;
#pragma unroll
    for (int j = 0; j < 16; ++j) gld16(kr[j], kvb + (long)sq[j * 16 + l15] * 512);
    gld16(qv, C.QA8 + token * 1024 + (4 * g + h) * 64 + 16 * l4);
}
__device__ __forceinline__ void issue_v_half(const Ctx8& C, const LAS unsigned short* sq, long rowbase, int g, int lane, unsigned vbase, int half) {
    const unsigned char* kvb = C.KV8 + rowbase * 512 + g * 128 + 64; const int kq = lane >> 2, p = lane & 3;
#pragma unroll
    for (int j = 0; j < 8; ++j) { const int ti = half * 8 + j; const int key = sq[ti * 16 + kq]; const int x = ((kq >> 2) & 1) | ((ti & 1) << 1);
        glds16(kvb + (long)key * 512 + 16 * (p ^ x), (unsigned)__builtin_amdgcn_readfirstlane(vbase + ti * 1024)); }
}
__device__ __forceinline__ void phase(Frame& F, const Ctx8& C, const float* t5) {
    int lane = F.lane; asm volatile("" : "+v"(lane));
    LAS float* T2 = (LAS float*)(F.lds + T2_OFF);
    for (int e = F.tid; e < 155 * 16; e += NWAVES * 64) { const int rel = (e >> 4) - 91, n = rel < 0 ? -rel : rel;
        const int bk = (rel > 0 ? 16 : 0) + (n < 8 ? n : 8 + (n >= 12) + (n >= 16) + (n >= 23) + (n >= 32) + (n >= 46) + (n >= 64) + (n >= 91));
        T2[e] = t5[bk * 16 + (e & 15)] * 8.0f; }
    __syncthreads();
    LAS unsigned short* sqb = (LAS unsigned short*)(F.lds + SELL_OFF + F.wave * 1024);
    LAS unsigned char* vreg = F.lds + RING_OFF + F.wave * 16384;
    const unsigned vbase = (unsigned)(uintptr_t)vreg;
    const int l15 = lane & 15, l4 = lane >> 4, h = l15 & 3;
    const int trk = 4 * l4 + ((l15 >> 1) & 3), trt = (l15 >> 3) & 1, xs = (l4 & 1) | (trt << 1);
    const int troff = trt * 1024 + trk * 64 + 8 * (l15 & 1);
    const int x = F.vcu / 32, b = x >> 1, g0 = 2 * (x & 1); const long rowbase = (long)b * SEQ;
    const int w = (F.vcu & 31) * NWAVES + F.wave;
    constexpr int NQ = SEQ / (32 * NWAVES), NI = 2 * NQ;
    if (lane < 32) { ((LAS v4u*)sqb)[lane] = ((const v4u*)(C.SEL + (rowbase + w) * 256))[lane]; ((LAS v4u*)(sqb + 256))[lane] = ((const v4u*)(C.SEL + (rowbase + w + 32 * NWAVES) * 256))[lane]; }
    LDS_WAIT();
    v4u kr[16], qv, pf = (v4u){0u, 0u, 0u, 0u};
    issue_kq(C, sqb, rowbase, rowbase + w, g0, l15, l4, h, kr, qv);
    issue_v_half(C, sqb, rowbase, g0, lane, vbase, 0); issue_v_half(C, sqb, rowbase, g0, lane, vbase, 1);
    unsigned cib[16];
#pragma unroll 1
    for (int idx = 0; idx < NI; ++idx) {
        const int qn = idx >> 1, gi = idx & 1, g = g0 + gi, t = w + 32 * NWAVES * qn;
        const LAS unsigned short* sq = sqb + (qn & 1) * 256;
        const int nidx = (idx + 1 < NI) ? idx + 1 : idx, nq = nidx >> 1, ng = g0 + (nidx & 1), nt = w + 32 * NWAVES * nq;
        const LAS unsigned short* nsq = sqb + (nq & 1) * 256;
        if (gi == 1) { asm volatile("s_waitcnt vmcnt(34)" : "+v"(pf) :: "memory"); if (lane < 32) ((LAS v4u*)(sqb + (qn & 1) * 256))[lane] = pf; }
        { const int pq = (qn + 2 < NQ) ? qn + 2 : NQ - 1; gld16(pf, (const v4u*)(C.SEL + (rowbase + w + 32 * NWAVES * pq) * 256) + (lane & 31)); }
        if (idx == 0) asm volatile("s_waitcnt vmcnt(0)" : "+v"(qv), "+v"(kr[0]), "+v"(kr[1]), "+v"(kr[2]), "+v"(kr[3]), "+v"(kr[4]), "+v"(kr[5]), "+v"(kr[6]), "+v"(kr[7]), "+v"(kr[8]), "+v"(kr[9]), "+v"(kr[10]), "+v"(kr[11]), "+v"(kr[12]), "+v"(kr[13]), "+v"(kr[14]), "+v"(kr[15]) :: "memory");
        else asm volatile("s_waitcnt vmcnt(20)" : "+v"(qv), "+v"(kr[0]), "+v"(kr[1]), "+v"(kr[2]), "+v"(kr[3]), "+v"(kr[4]), "+v"(kr[5]), "+v"(kr[6]), "+v"(kr[7]), "+v"(kr[8]), "+v"(kr[9]), "+v"(kr[10]), "+v"(kr[11]), "+v"(kr[12]), "+v"(kr[13]), "+v"(kr[14]), "+v"(kr[15]) :: "memory");
        if (gi == 0) {
#pragma unroll
            for (int ti = 0; ti < 16; ++ti) { const v2u i4 = *(const LAS v2u*)(sq + ti * 16 + 4 * l4);
                const int r0 = (int)(i4.x & 0xffffu) - t, r1 = (int)(i4.x >> 16) - t, r2 = (int)(i4.y & 0xffffu) - t, r3 = (int)(i4.y >> 16) - t;
                const int c0 = min(max(r0, -91), 63) + 91, c1 = min(max(r1, -91), 63) + 91, c2 = min(max(r2, -91), 63) + 91, c3 = min(max(r3, -91), 63) + 91;
                cib[ti] = (unsigned)c0 | ((unsigned)c1 << 8) | ((unsigned)c2 << 16) | ((unsigned)c3 << 24); }
        }
        const int N = 64 * ((t >> 6) + 1), nvalid = N < 256 ? N : 256;
        const long q0 = (long)(((unsigned long long)qv.y << 32) | qv.x), q1 = (long)(((unsigned long long)qv.w << 32) | qv.z);
        f32x4 S[16];
#pragma unroll
        for (int ti = 0; ti < 16; ++ti) { const unsigned cb = cib[ti];
            f32x4 a; a.x = T2[(cb & 255u) * 16 + 4 * g + h]; a.y = T2[((cb >> 8) & 255u) * 16 + 4 * g + h]; a.z = T2[((cb >> 16) & 255u) * 16 + 4 * g + h]; a.w = T2[(cb >> 24) * 16 + 4 * g + h];
            mfma8(a, (long)(((unsigned long long)kr[ti].y << 32) | kr[ti].x), q0);
            mfma8(a, (long)(((unsigned long long)kr[ti].w << 32) | kr[ti].z), q1);
            S[ti] = a; }
        asm volatile("s_nop 15\n\ts_nop 7" : "+v"(S[0]), "+v"(S[1]), "+v"(S[2]), "+v"(S[3]), "+v"(S[4]), "+v"(S[5]), "+v"(S[6]), "+v"(S[7]), "+v"(S[8]), "+v"(S[9]), "+v"(S[10]), "+v"(S[11]), "+v"(S[12]), "+v"(S[13]), "+v"(S[14]), "+v"(S[15]));
        issue_kq(C, nsq, rowbase, rowbase + nt, ng, l15, l4, h, kr, qv);
#pragma unroll
        for (int ti = 0; ti < 16; ++ti) if (ti * 16 >= nvalid) S[ti] = (f32x4){-INFINITY, -INFINITY, -INFINITY, -INFINITY};
        float mx = S[0].x;
#pragma unroll
        for (int ti = 0; ti < 16; ++ti) mx = fmaxf(fmaxf(mx, fmaxf(S[ti].x, S[ti].y)), fmaxf(S[ti].z, S[ti].w));
        mx = fmaxf(mx, __shfl_xor(mx, 16)); mx = fmaxf(mx, __shfl_xor(mx, 32));
        const float mc = -mx * C2; float ls = 0.f;
        long P8[8];
#pragma unroll
        for (int j = 0; j < 8; ++j) { float e[8];
#pragma unroll
            for (int q = 0; q < 4; ++q) { e[q] = __builtin_amdgcn_exp2f(__builtin_fmaf(S[2 * j][q], C2, mc)); e[4 + q] = __builtin_amdgcn_exp2f(__builtin_fmaf(S[2 * j + 1][q], C2, mc)); }
            ls += ((e[0] + e[1]) + (e[2] + e[3])) + ((e[4] + e[5]) + (e[6] + e[7]));
            const unsigned lo = pk4_fp8(e[0] * 256.f, e[1] * 256.f, e[2] * 256.f, e[3] * 256.f), hi = pk4_fp8(e[4] * 256.f, e[5] * 256.f, e[6] * 256.f, e[7] * 256.f);
            P8[j] = (long)(((unsigned long long)hi << 32) | lo); }
        ls += __shfl_xor(ls, 16); ls += __shfl_xor(ls, 32);
        f32x4 D[4];
#pragma unroll
        for (int db = 0; db < 4; ++db) D[db] = (f32x4){0.f, 0.f, 0.f, 0.f};
#pragma unroll
        for (int hf = 0; hf < 2; ++hf) {
            asm volatile("s_waitcnt vmcnt(28)" ::: "memory");
#pragma unroll
            for (int j = 4 * hf; j < 4 * hf + 4; ++j)
#pragma unroll
                for (int db = 0; db < 4; ++db) {
                    const v2i vv = __builtin_amdgcn_ds_read_tr8_b64_v2i32((LAS v2i*)(vreg + j * 2048 + troff + 16 * (db ^ xs)));
                    mfma8(D[db], P8[j], __builtin_bit_cast(long, vv)); }
            asm volatile("s_waitcnt lgkmcnt(0)" ::: "memory");
            issue_v_half(C, nsq, rowbase, ng, lane, vbase, hf);
        }
        asm volatile("s_nop 15\n\ts_nop 7" : "+v"(D[0]), "+v"(D[1]), "+v"(D[2]), "+v"(D[3]));
        const float lh = __shfl(ls, l4);
        const float inv = __builtin_amdgcn_rcpf(lh * 256.f);
        bf16* mp = C.M + (rowbase + t) * DM + (4 * g + l4) * 64 + l15;
#pragma unroll
        for (int db = 0; db < 4; ++db) { const float v = (l4 == 0) ? D[db].x : (l4 == 1) ? D[db].y : (l4 == 2) ? D[db].z : D[db].w; const unsigned short ob = (unsigned short)f2bf(v * inv);
            asm volatile("global_store_short %0, %1, off" :: "v"(mp + 16 * db), "v"((unsigned)ob) : "memory"); }
    }
    asm volatile("s_waitcnt vmcnt(0)" ::: "memory");
}
}

#ifndef REP_P0
#define REP_P0 1
#endif
#ifndef REP_IN
#define REP_IN 1
#endif
#ifndef REP_DSA
#define REP_DSA 1
#endif
#ifndef REP_BAND
#define REP_BAND 1
#endif
#ifndef REP_UP
#define REP_UP 1
#endif
#ifndef REP_FIX
#define REP_FIX 1
#endif
constexpr int N_PHASES = 1 + 6 * DEPTH;
#ifndef MK_N_LAUNCHES
#define MK_N_LAUNCHES 1
#endif
__global__ void __launch_bounds__(NWAVES * 64, 2) mega_fwd(Args args) {
    extern __shared__ __attribute__((aligned(16))) unsigned char lds[];
    Frame F;
    F.lds = (LAS unsigned char*)lds;
    F.MISC = (volatile LAS unsigned*)(F.lds + MISC_OFF);
    F.tid = threadIdx.x; F.lane = F.tid & 63; F.wave = __builtin_amdgcn_readfirstlane(F.tid >> 6);
    F.G = GRID; { const int bx = blockIdx.x; F.vcu = (bx & 7) * (GRID / 8) + (bx >> 3); }
    unsigned char* ws = args.ws;
    F.ctl = (gu32*)(ws + WS_CTL);
    for (int u = F.tid; u < (LDS_BYTES - LDSCTL_OFF) / 4; u += NWAVES * 64) ((LAS unsigned*)(F.lds + LDSCTL_OFF))[u] = 0u;
    __syncthreads();
    XcdBarrier bar; bar.bar = (unsigned*)(F.ctl + CW_BAR); bar.x = 0; bar.st = nullptr;
    if (MK_N_LAUNCHES == 1) bar = xcd_barrier_post((unsigned*)(F.ctl + CW_BAR), F.MISC + 8);
    const int lo = args.ph_lo, hi = args.ph_hi;
#define IN(k) (lo <= (k) && (k) < hi)
#define OPQ_FRAME(Fl) Frame Fl = F; { int l_; asm volatile("v_mbcnt_lo_u32_b32 %0, -1, 0\n\tv_mbcnt_hi_u32_b32 %0, -1, %0" : "=v"(l_)); int w_ = F.wave; asm volatile("" : "+s"(w_)); Fl.wave = w_; Fl.lane = l_; Fl.tid = w_ * 64 + l_; }
#define SEAM(k) do { if (IN(k) && IN((k) + 1)) xcd_barrier(bar); } while (0)

    bf16* hb = (bf16*)(ws + WS_HB); bf16* mb = (bf16*)(ws + WS_M); float* ss = (float*)(ws + WS_SS); float* halo = (float*)(ws + WS_HALO);
    unsigned char* proj = ws + WS_PROJ; bf16* act = (bf16*)(ws + WS_PROJ);

#ifndef SKIP_P0
    if (IN(0)) { for (int rep = 0; rep < REP_P0; ++rep) { OPQ_FRAME(F0); p0_prologue(F0, args); } }
#endif
    SEAM(0);

#pragma unroll 1
    for (int L = 0; L < DEPTH; ++L) {
        const int pb = 1 + 6 * L, li = L >> 1; const bool isB = (L & 1) != 0;
        if (IN(pb)) {
#ifndef SKIP_IN
            for (int rep = 0; rep < REP_IN; ++rep)
            if (!isB) {
                pg8::Gemm g{hb, (const bf16*)(ws + WS_W_INA) + (size_t)li * NA_PAD * DM, MTOK, NA_PAD, DM}; pg8::StaticOrder S; S.init(MTOK, NA_PAD, F.G, (int)blockIdx.x);
                EpiIn E{ss, proj, args.q_norm_g + L * 64, args.k_norm_g + L * 64, 0};
                pg8::gemm_phase<EpiIn, pg8::StaticOrder, true, true>(F.lds + RING_OFF, g, S, E, F.wave);
            } else {
                pg8::Gemm g{hb, (const bf16*)(ws + WS_W_INB) + (size_t)li * NB * DM, MTOK, NB, DM}; pg8::StaticOrder S; S.init(MTOK, NB, F.G, (int)blockIdx.x);
                EpiIn E{ss, proj, args.q_norm_g + L * 64, args.k_norm_g + L * 64, 1};
                pg8::gemm_phase<EpiIn, pg8::StaticOrder, true, true>(F.lds + RING_OFF, g, S, E, F.wave);
            }
#endif
        }
        SEAM(pb);
#if defined(DBG_NODSA) || defined(DBG_NOBAND)
#ifdef DBG_NODSA
        const bool zero_m = !isB;
#else
        const bool zero_m = isB;
#endif
        if (IN(pb + 1) && zero_m) { for (size_t i = (size_t)blockIdx.x * 512 + threadIdx.x; i < (size_t)MTOK * DM / 8; i += (size_t)gridDim.x * 512) ((v4u*)mb)[i] = (v4u){0u, 0u, 0u, 0u}; }
        if (IN(pb + 1) && !zero_m) {
#else
        if (IN(pb + 1)) {
#endif
#ifndef SKIP_DSA
            if (!isB) {
                LAS float* t5l = (LAS float*)(F.lds + AUX_OFF);
                { OPQ_FRAME(Ft); for (int i = Ft.tid; i < 512; i += NWAVES * 64) t5l[i] = args.t5_bias[i] * LOG2E; }
                __syncthreads();
                dsa::Ctx C{(const bf16*)(proj + PA_QA), (const bf16*)(proj + PA_KA), (const bf16*)(proj + PA_VA), (const bf16*)(proj + PA_QI), (const bf16*)(proj + PA_KI), (const float*)(proj + PA_WI), mb, t5l, (unsigned short*)(proj + PA_SEL)};
#ifdef DBG_DSACOPY
                { int t_ = threadIdx.x; asm volatile("" : "+v"(t_));
                for (unsigned i = blockIdx.x * 512u + (unsigned)t_; i < (unsigned)MTOK * DM; i += gridDim.x * 512u) { const unsigned t = i >> 10, c = i & 1023u;
                    float v = bf_lo(C.QA[i]); v += bf_lo(C.KA[t * 256 + (c & 255)]); v += bf_lo(C.VA[t * 256 + (c & 255)]); v += bf_lo(C.QI[t * 512 + (c & 511)]); v += bf_lo(C.KI[t * 64 + (c & 63)]); v += C.WI[t * 8 + (c & 7)];
                    mb[i] = (bf16)f2bf(v * 0.01f); asm volatile("" ::: "memory"); } }
#else
                for (int rep = 0; rep < REP_DSA; ++rep) { OPQ_FRAME(F1); dsa::phase(F1, C); }
                xcd_barrier(bar);
                { OPQ_FRAME(F1b); att8::Ctx8 C8{(const unsigned char*)(proj + PA_QA), (const unsigned char*)(proj + PA_KA), (const unsigned short*)(proj + PA_SEL), mb};
#ifndef REP_ATT8
#define REP_ATT8 1
#endif
                  for (int rep = 0; rep < REP_ATT8; ++rep) { att8::phase(F1b, C8, args.t5_bias); __syncthreads(); } }
#endif
            }
#endif
#ifndef SKIP_BAND
            if (isB) {
                for (int rep = 0; rep < REP_BAND; ++rep) { OPQ_FRAME(F2); band::phase(F2, (const bf16*)proj, (const bf16*)(proj + PB_STRIDE), (const bf16*)(proj + 2 * PB_STRIDE), mb, args.rel_bias_b + (size_t)li * 513 * 16); }
            }
#endif
        }
        SEAM(pb + 1);
        if (IN(pb + 2)) {
#ifndef SKIP_OUT
            pg8::Gemm g{mb, (const bf16*)(ws + WS_W_OUT) + (size_t)L * DM * DM, MTOK, DM, DM}; pg8::StaticOrder S; S.init(MTOK, DM, F.G, (int)blockIdx.x);
#ifdef REP_OUT
            { EpiRes E0{L == 0 ? args.x : nullptr, nullptr, hb, (bf16*)proj, halo}; pg8::gemm_phase<EpiRes, pg8::StaticOrder, true, true>(F.lds + RING_OFF, g, S, E0, F.wave); }
#endif
            if (L >= F8_L0) { EpiResT<2> E{nullptr, nullptr, hb, hb, ss, proj + PX_HB8};
                pg8::gemm_phase<EpiResT<2>, pg8::StaticOrder, true, true>(F.lds + RING_OFF, g, S, E, F.wave); }
            else { EpiRes E{L == 0 ? args.x : nullptr, nullptr, hb, hb, ss};
                pg8::gemm_phase<EpiRes, pg8::StaticOrder, true, true>(F.lds + RING_OFF, g, S, E, F.wave); }
#endif
        }
        SEAM(pb + 2);
        if (IN(pb + 3)) {
#ifndef SKIP_UP
            for (int rep = 0; rep < REP_UP; ++rep) {
            pg8::Gemm g{hb, (const bf16*)(ws + WS_W_UP) + (size_t)L * NUP * DM, MTOK, NUP, DM}; pg8::StaticOrder S; S.init(MTOK, NUP, F.G, (int)blockIdx.x);
#ifdef PROBE_UPK
            { EpiDummy E0{halo}; pg8::gemm_phase<EpiDummy, pg8::StaticOrder, true, true>(F.lds + RING_OFF, g, S, E0, F.wave); }
#endif
            if (L >= F8_L0) { pg8::Gemm g8{(const bf16*)(proj + PX_HB8), (const bf16*)(ws + WS_W_UP) + (size_t)L * NUP * DM, MTOK, NUP, DM / 2};
                EpiUpT<true> E{ss, args.conv_w + (size_t)L * 3 * NUP, args.conv_b + (size_t)L * NUP, act, halo, (LAS float*)(F.lds + AUX_OFF)};
                pg8::gemm_phase<EpiUpT<true>, pg8::StaticOrder, true, true, true>(F.lds + RING_OFF, g8, S, E, F.wave); }
            else { EpiUp E{ss, args.conv_w + (size_t)L * 3 * NUP, args.conv_b + (size_t)L * NUP, act, halo, (LAS float*)(F.lds + AUX_OFF)};
                pg8::gemm_phase<EpiUp, pg8::StaticOrder, true, true>(F.lds + RING_OFF, g, S, E, F.wave); } }
#endif
        }
        SEAM(pb + 3);
#ifndef SKIP_FIX
        if (IN(pb + 4)) for (int rep = 0; rep < REP_FIX; ++rep) { OPQ_FRAME(F3); if (L >= F8_L0) fixup_phase<true>(F3, args.conv_w + (size_t)L * 3 * NUP, args.conv_b + (size_t)L * NUP, halo, act); else fixup_phase<false>(F3, args.conv_w + (size_t)L * 3 * NUP, args.conv_b + (size_t)L * NUP, halo, act); }
#endif
        SEAM(pb + 4);
        if (IN(pb + 5)) {
#ifndef SKIP_DN
            pg8::Gemm g{act, (const bf16*)(ws + WS_W_DN) + (size_t)L * DM * FF, MTOK, DM, FF}; pg8::StaticOrder S; S.init(MTOK, DM, F.G, (int)blockIdx.x);
#ifdef REP_DN
            { EpiRes E0{nullptr, nullptr, hb, mb, halo}; pg8::gemm_phase<EpiRes, pg8::StaticOrder, true, true>(F.lds + RING_OFF, g, S, E0, F.wave); }
#endif
            if (L >= F8_L0) { pg8::Gemm g8{act, (const bf16*)(ws + WS_W_DN) + (size_t)L * DM * FF, MTOK, DM, FF / 2};
                EpiResT<1> E{nullptr, L == DEPTH - 1 ? args.out : nullptr, hb, hb, ss, nullptr};
                pg8::gemm_phase<EpiResT<1>, pg8::StaticOrder, true, true, true>(F.lds + RING_OFF, g8, S, E, F.wave); }
            else { EpiRes E{nullptr, L == DEPTH - 1 ? args.out : nullptr, hb, hb, ss};
                pg8::gemm_phase<EpiRes, pg8::StaticOrder, true, true>(F.lds + RING_OFF, g, S, E, F.wave); }
#endif
        }
        SEAM(pb + 5);
    }
#undef IN
#undef SEAM
}

extern "C" void kernel_launch(void* const* d_in, const int* in_sizes, int n_in, void* d_out, int out_size, void* d_ws, size_t ws_size, hipStream_t stream) {
    static int grid = 0;
    if (grid == 0) {
        if (n_in != 14 || in_sizes[0] != MTOK * DM || out_size != MTOK * DM || ws_size < WS_END) { fprintf(stderr, "kernel_launch: unexpected shapes / workspace (n_in %d, ws %zu); nothing launched\n", n_in, ws_size); grid = -1; return; }
        int dev = 0, cus = 0, per_cu = 0;
        if (hipGetDevice(&dev) != hipSuccess || hipDeviceGetAttribute(&cus, hipDeviceAttributeMultiprocessorCount, dev) != hipSuccess) { grid = -1; return; }
        if (hipFuncSetAttribute((const void*)mega_fwd, hipFuncAttributeMaxDynamicSharedMemorySize, LDS_BYTES) != hipSuccess) { fprintf(stderr, "kernel_launch: hipFuncSetAttribute failed\n"); grid = -1; return; }
        if (hipOccupancyMaxActiveBlocksPerMultiprocessor(&per_cu, (const void*)mega_fwd, NWAVES * 64, LDS_BYTES) != hipSuccess || per_cu < 1) { fprintf(stderr, "kernel_launch: occupancy query reports %d blocks per CU\n", per_cu); }
        (void)hipGetLastError();
        if (cus != GRID) { fprintf(stderr, "kernel_launch: built for a %d-CU device, found %d; nothing launched\n", GRID, cus); grid = -1; return; }
        grid = GRID;
    }
    if (grid < 0) return;
    if (hipMemsetAsync((char*)d_ws + WS_CTL, 0, CTL_ZERO_BYTES, stream) != hipSuccess) return;
    Args a{};
    a.x = (const float*)d_in[0]; a.attn_norm_g = (const float*)d_in[1]; a.w_in_a = (const float*)d_in[2]; a.w_in_b = (const float*)d_in[3]; a.q_norm_g = (const float*)d_in[4];
    a.k_norm_g = (const float*)d_in[5]; a.t5_bias = (const float*)d_in[6]; a.rel_bias_b = (const float*)d_in[7]; a.w_out = (const float*)d_in[8]; a.ffn_norm_g = (const float*)d_in[9];
    a.w_up = (const float*)d_in[10]; a.conv_w = (const float*)d_in[11]; a.conv_b = (const float*)d_in[12]; a.w_down = (const float*)d_in[13];
    a.out = (float*)d_out; a.ws = (unsigned char*)d_ws; a.pad = 0;
#if MK_N_LAUNCHES == 1
    a.ph_lo = 0; a.ph_hi = N_PHASES; a.li = 0;
    hipLaunchKernelGGL(mega_fwd, dim3(grid), dim3(NWAVES * 64), LDS_BYTES, stream, a);
#else
    for (int p = 0; p < N_PHASES; ++p) { a.ph_lo = p; a.ph_hi = p + 1; a.li = p; hipLaunchKernelGGL(mega_fwd, dim3(grid), dim3(NWAVES * 64), LDS_BYTES, stream, a); }
#endif
}
```

```cpp
#include <hip/hip_runtime.h>
#include <cstdio>
#include <cstdint>
namespace pg8 {
#define PG8_LAS __attribute__((address_space(3)))
typedef unsigned short bf16_t;
typedef short bf16x8 __attribute__((ext_vector_type(8)));
typedef float f32x4 __attribute__((ext_vector_type(4)));
typedef unsigned u32x4 __attribute__((ext_vector_type(4)));
typedef int i32x4 __attribute__((ext_vector_type(4)));
typedef int i32x8 __attribute__((ext_vector_type(8)));
constexpr int BM = 256, BK = 64, HALF = 128, HTB = HALF * BK * 2  , STAGE_BYTES = 8 * HTB, NXCD = 8, WGM = 8;

__host__ __device__ __forceinline__ int lds_byte(int r, int c) { const int st = (r >> 4) * 2 + (c >> 5), rr = r & 15, cc = c & 31, ob = rr * 64 + cc * 2; return st * 1024 + (ob ^ (((ob >> 9) & 1) << 5)); }
__host__ __device__ __forceinline__ void stage_rc(int b, int& R, int& C) { const int st = b / 1024, sb = b % 1024, swz = sb ^ (((sb >> 9) & 1) << 5); R = (st >> 1) * 16 + swz / 64; C = (st & 1) * 32 + (swz % 64) / 2; }
__host__ __device__ __forceinline__ int perm32(int rho) { const int n = rho >> 4, i = rho & 15; return 8 * (i >> 2) + 4 * n + (i & 3); }

struct Unit { int pm, pn; };
struct Gemm { const bf16_t* A; const bf16_t* Bt; int M, N, K; };

struct StaticOrder {
    int nM, nN, nwg, G, c;
    __host__ __device__ void init(int M, int N, int G_, int c_) { nM = M / BM; nN = N / BM; nwg = nM * nN; G = G_; c = c_; }
    __host__ __device__ bool next(int i, Unit& u) const {
        const long L = (long)i * G + c; if (L >= nwg) return false;
        int wgid = (int)L; { const int q = nwg / NXCD, r = nwg % NXCD, xcd = wgid % NXCD, off = wgid / NXCD; wgid = (xcd < r ? xcd * (q + 1) : r * (q + 1) + (xcd - r) * q) + off; }
        const int nig = WGM * nN, gid = wgid / nig, fm = gid * WGM, gsz = (nM - fm) < WGM ? (nM - fm) : WGM;
        u.pm = fm + ((wgid % nig) % gsz); u.pn = (wgid % nig) / gsz; return true;
    }
    __device__ __forceinline__ void a_ready(const Unit&) const {}
    __device__ __forceinline__ void done(const Unit&) const {}
};
__device__ __forceinline__ unsigned cvt_pk_bf16(float lo, float hi) { unsigned r; asm volatile("v_cvt_pk_bf16_f32 %0, %1, %2" : "=v"(r) : "v"(lo), "v"(hi)); return r; }
template <class Epi, class Sched, bool ALIGN_EPI = false, bool SP2 = false, bool F8 = false>
__device__ __forceinline__ void gemm_phase(PG8_LAS unsigned char* lds, const Gemm g, const Sched& S, const Epi& E, const int wave_id) {
    int lane_; asm volatile("v_mbcnt_lo_u32_b32 %0, -1, 0\n\tv_mbcnt_hi_u32_b32 %0, -1, %0" : "=v"(lane_));
    int wid_ = wave_id; asm volatile("" : "+s"(wid_));
    const int wid = wid_, lane = lane_, tid = wid * 64 + lane, wr = wid >> 2, wc = wid & 3, fr = lane & 15, fq = lane >> 4;
    const int K = g.K, nt = K / BK;
    unsigned voffA[2], voffB[2];
#pragma unroll
    for (int i = 0; i < 2; ++i) { int R, C; stage_rc(tid * 16 + i * 8192, R, C); const int Rb = Epi::PERM ? ((R & ~31) + perm32(R & 31)) : R;
        const int Ra = Epi::PERMA ? ((R & ~63) | (4 * (R & 15) + ((R >> 4) & 3))) : R;
        voffA[i] = (unsigned)(Ra * K + C) * 2u; voffB[i] = (unsigned)(Rb * K + C) * 2u; }
    const size_t kstep = (size_t)(BK * 2);
    const size_t hstep = (size_t)HALF * K * 2;
    const size_t tstep = 2 * hstep;
    const unsigned ldsw = (unsigned)wid * 1024u;
    const int aoff = lds_byte(wr * 64 + fr, fq * 8), boff = lds_byte(wc * 32 + fr, fq * 8);
#define PG8_SA(b, h) (((b) * 2 + (h)) * HTB)
#define PG8_SB(b, h) ((4 + (b) * 2 + (h)) * HTB)
#define PG8_STAGE(bufoff, gbase, voff) do { _Pragma("unroll") for (int _i = 0; _i < 2; ++_i) \
        __builtin_amdgcn_global_load_lds((const unsigned*)((const char*)(gbase) + (voff)[_i]), (PG8_LAS unsigned*)(lds + (bufoff) + ldsw + _i * 8192), 16, 0, 0); } while (0)
#define PG8_LDA(dst, b, h) do { _Pragma("unroll") for (int m = 0; m < 4; ++m) _Pragma("unroll") for (int k = 0; k < 2; ++k) dst[m][k] = *(const PG8_LAS bf16x8*)(lds + PG8_SA(b, h) + aoff + m * 2048 + k * 1024); } while (0)
#define PG8_LDB(dst, b, h) do { _Pragma("unroll") for (int n = 0; n < 2; ++n) _Pragma("unroll") for (int k = 0; k < 2; ++k) dst[n][k] = *(const PG8_LAS bf16x8*)(lds + PG8_SB(b, h) + boff + n * 2048 + k * 1024); } while (0)
#define PG8_CAT(lo, hi) __builtin_shufflevector(__builtin_bit_cast(i32x4, lo), __builtin_bit_cast(i32x4, hi), 0, 1, 2, 3, 4, 5, 6, 7)
#define PG8_MMA(ai, bj, At, Bt) do { __builtin_amdgcn_s_setprio(1); _Pragma("unroll") for (int m = 0; m < 4; ++m) _Pragma("unroll") for (int n = 0; n < 2; ++n) { \
        if constexpr (F8) { const i32x8 b8_ = PG8_CAT(Bt[n][0], Bt[n][1]), a8_ = PG8_CAT(At[m][0], At[m][1]); asm volatile("v_mfma_f32_16x16x128_f8f6f4 %0, %1, %2, %0" : "+v"(acc[ai][bj][m][n]) : "v"(b8_), "v"(a8_)); } \
        else { _Pragma("unroll") for (int k = 0; k < 2; ++k) acc[ai][bj][m][n] = __builtin_amdgcn_mfma_f32_16x16x32_bf16(Bt[n][k], At[m][k], acc[ai][bj][m][n], 0, 0, 0); } } __builtin_amdgcn_s_setprio(0); } while (0)
#define PG8_WAIT_V(n) asm volatile("s_waitcnt vmcnt(" #n ")" ::: "memory")
#define PG8_WAIT_L(n) asm volatile("s_waitcnt lgkmcnt(" #n ")" ::: "memory")
#define PG8_BAR __builtin_amdgcn_s_barrier()
#define PG8_SCHED __builtin_amdgcn_sched_barrier(0)
    Unit cur, nxt; int ui = 0;
    if (!S.next(0, cur)) return;
    f32x4 acc[2][2][4][2];
#pragma unroll
    for (int a = 0; a < 2; ++a)
#pragma unroll
        for (int b = 0; b < 2; ++b)
#pragma unroll
            for (int m = 0; m < 4; ++m)
#pragma unroll
                for (int n = 0; n < 2; ++n) acc[a][b][m][n] = (f32x4){0.f, 0.f, 0.f, 0.f};
    bf16x8 At[4][2], B0[2][2], B1[2][2];
    const char* cA = (const char*)g.A + (size_t)cur.pm * tstep; const char* cB = (const char*)g.Bt + (size_t)cur.pn * tstep;
    S.a_ready(cur);
    if constexpr (SP2) {
        PG8_STAGE(PG8_SB(0, 0), cB, voffB); PG8_STAGE(PG8_SB(0, 1), cB + hstep, voffB); PG8_STAGE(PG8_SA(0, 0), cA, voffA); PG8_STAGE(PG8_SA(0, 1), cA + hstep, voffA);
        if (wr == 1) PG8_BAR;
        PG8_WAIT_V(2); PG8_BAR;
        PG8_STAGE(PG8_SB(1, 0), cB + kstep, voffB); PG8_STAGE(PG8_SA(1, 0), cA + kstep, voffA); PG8_STAGE(PG8_SB(1, 1), cB + hstep + kstep, voffB);
        PG8_WAIT_V(6); PG8_BAR;
    } else {
        PG8_STAGE(PG8_SB(0, 0), cB, voffB); PG8_STAGE(PG8_SA(0, 0), cA, voffA); PG8_STAGE(PG8_SB(0, 1), cB + hstep, voffB); PG8_STAGE(PG8_SA(0, 1), cA + hstep, voffA);
        if (wr == 1) PG8_BAR;
        PG8_WAIT_V(4); PG8_BAR;
        PG8_STAGE(PG8_SB(1, 0), cB + kstep, voffB); PG8_STAGE(PG8_SA(1, 0), cA + kstep, voffA); PG8_STAGE(PG8_SB(1, 1), cB + hstep + kstep, voffB);
        PG8_WAIT_V(6); PG8_BAR;
    }
    for (;;) {
        const bool has_next = S.next(ui + 1, nxt);
        const char* nA = has_next ? (const char*)g.A + (size_t)nxt.pm * tstep : cA; const char* nB = has_next ? (const char*)g.Bt + (size_t)nxt.pn * tstep : cB;
        for (int t = 0; t < nt; t += 2) {
            const bool last = (t == nt - 2);
            const char* a1 = cA + (size_t)(t + 1) * kstep;
            const char* a2 = last ? nA : cA + (size_t)(t + 2) * kstep; const char* b2 = last ? nB : cB + (size_t)(t + 2) * kstep;
            const char* a3 = a2 + kstep; const char* b3 = b2 + kstep;
            if (last && has_next) S.a_ready(nxt);
            if constexpr (SP2) {
            PG8_LDB(B0, 0, 0); PG8_LDB(B1, 0, 1); PG8_SCHED; PG8_LDA(At, 0, 0); PG8_STAGE(PG8_SA(1, 1), a1 + hstep, voffA);
            PG8_WAIT_V(8); PG8_WAIT_L(0); PG8_BAR; PG8_MMA(0, 0, At, B0); PG8_MMA(0, 1, At, B1); PG8_BAR; PG8_SCHED;
            PG8_LDA(At, 0, 1); PG8_STAGE(PG8_SB(0, 0), b2, voffB); PG8_STAGE(PG8_SB(0, 1), b2 + hstep, voffB); PG8_STAGE(PG8_SA(0, 0), a2, voffA);
            PG8_WAIT_V(8); PG8_WAIT_L(0); PG8_BAR; PG8_MMA(1, 0, At, B0); PG8_MMA(1, 1, At, B1); PG8_BAR; PG8_SCHED;
            PG8_LDB(B0, 1, 0); PG8_LDB(B1, 1, 1); PG8_SCHED; PG8_LDA(At, 1, 0); PG8_STAGE(PG8_SA(0, 1), a2 + hstep, voffA);
            PG8_WAIT_V(8); PG8_WAIT_L(0); PG8_BAR; PG8_MMA(0, 0, At, B0); PG8_MMA(0, 1, At, B1); PG8_BAR; PG8_SCHED;
            PG8_LDA(At, 1, 1); PG8_STAGE(PG8_SB(1, 0), b3, voffB); PG8_STAGE(PG8_SB(1, 1), b3 + hstep, voffB); PG8_STAGE(PG8_SA(1, 0), a3, voffA);
            PG8_WAIT_V(8); PG8_WAIT_L(0); PG8_BAR; PG8_MMA(1, 0, At, B0); PG8_MMA(1, 1, At, B1); PG8_BAR; PG8_SCHED;
            } else {
            PG8_LDB(B0, 0, 0); PG8_SCHED; PG8_LDA(At, 0, 0); PG8_STAGE(PG8_SA(1, 1), a1 + hstep, voffA);
            PG8_WAIT_L(8); PG8_BAR; PG8_WAIT_L(0); PG8_MMA(0, 0, At, B0); PG8_BAR; PG8_SCHED;
            PG8_LDB(B1, 0, 1); PG8_STAGE(PG8_SB(0, 0), b2, voffB);
            PG8_BAR; PG8_WAIT_L(0); PG8_MMA(0, 1, At, B1); PG8_BAR;
            PG8_LDA(At, 0, 1); PG8_STAGE(PG8_SA(0, 0), a2, voffA);
            PG8_BAR; PG8_WAIT_L(0); PG8_MMA(1, 0, At, B0); PG8_BAR; PG8_SCHED;
            PG8_STAGE(PG8_SB(0, 1), b2 + hstep, voffB);
            PG8_WAIT_V(6); PG8_BAR; PG8_MMA(1, 1, At, B1); PG8_BAR;
            PG8_LDB(B0, 1, 0); PG8_SCHED; PG8_LDA(At, 1, 0); PG8_STAGE(PG8_SA(0, 1), a2 + hstep, voffA);
            PG8_WAIT_L(8); PG8_BAR; PG8_WAIT_L(0); PG8_MMA(0, 0, At, B0); PG8_BAR; PG8_SCHED;
            PG8_LDB(B1, 1, 1); PG8_STAGE(PG8_SB(1, 0), b3, voffB);
            PG8_BAR; PG8_WAIT_L(0); PG8_MMA(0, 1, At, B1); PG8_BAR;
            PG8_LDA(At, 1, 1); PG8_STAGE(PG8_SA(1, 0), a3, voffA);
            PG8_BAR; PG8_WAIT_L(0); PG8_MMA(1, 0, At, B0); PG8_BAR; PG8_SCHED;
            PG8_STAGE(PG8_SB(1, 1), b3 + hstep, voffB);
            PG8_WAIT_V(6); PG8_BAR; PG8_MMA(1, 1, At, B1); PG8_BAR;
            }
        }
        if constexpr (F8) asm volatile("s_nop 15\n\ts_nop 15" ::: "memory");
        if constexpr (ALIGN_EPI) { if (wr == 0) PG8_BAR; }
        if constexpr (!Epi::AFTER_DRAIN) { E(acc, cur, wr, wc, fr, fq); S.done(cur); }
        if (!has_next) break;
#pragma unroll
        for (int a = 0; a < 2; ++a)
#pragma unroll
            for (int b = 0; b < 2; ++b)
#pragma unroll
                for (int m = 0; m < 4; ++m)
#pragma unroll
                    for (int n = 0; n < 2; ++n) acc[a][b][m][n] = (f32x4){0.f, 0.f, 0.f, 0.f};
        cur = nxt; cA = nA; cB = nB; ++ui;
        if constexpr (ALIGN_EPI) { if (wr == 1) PG8_BAR; }
    }
    PG8_WAIT_V(0);
    if constexpr (!ALIGN_EPI) { if (wr == 0) PG8_BAR; }
    PG8_BAR;
    if constexpr (Epi::AFTER_DRAIN) { E.fused(acc, cur, wr, wc, fr, fq, lds, wid, lane); S.done(cur); }
#undef PG8_SA
#undef PG8_SB
#undef PG8_STAGE
#undef PG8_LDA
#undef PG8_LDB
#undef PG8_MMA
#undef PG8_CAT
#undef PG8_WAIT_V
#undef PG8_WAIT_L
#undef PG8_BAR
#undef PG8_SCHED
}
}

constexpr int NWAVES = 8, GRID = 256;
constexpr int BATCH = 4, SEQ = 8192, DM = 1024, MTOK = BATCH * SEQ, DEPTH = 4;
constexpr int NA_SRC = 2120, NA_PAD = 2304, NB = 3072, FF = 2816, NUP = 2 * FF;
constexpr float EPS = 1e-6f;
constexpr float LOG2E = 1.4426950408889634f;
constexpr float C2 = 0.125f * LOG2E;
constexpr int NBLK64 = MTOK / 64;

constexpr size_t MiB = 1u << 20;
constexpr size_t WS_CTL = 0, CTL_ZERO_BYTES = 1 * MiB;
constexpr size_t WS_W_INA = 2 * MiB;
constexpr size_t WS_W_INB = 11 * MiB;
constexpr size_t WS_W_OUT = 23 * MiB;
constexpr size_t WS_W_UP = 31 * MiB;
constexpr size_t WS_W_DN = 75 * MiB;
constexpr size_t WS_HB = 98 * MiB;
constexpr size_t WS_M = 162 * MiB;
constexpr size_t WS_SS = 226 * MiB;
constexpr size_t WS_HALO = 228 * MiB;
constexpr size_t WS_PROJ = 272 * MiB;
constexpr size_t WS_END = 464 * MiB;
constexpr size_t PA_QA = 0, PA_KA = 64 * MiB, PA_VA = 80 * MiB, PA_QI = 96 * MiB, PA_KI = 128 * MiB, PA_WI = 132 * MiB, PA_SEL = 136 * MiB;
constexpr size_t PB_STRIDE = 64 * MiB;
constexpr int CW_BAR = 4096;
constexpr int F8_L0 = 2;
constexpr size_t PX_HB8 = 96 * MiB;
constexpr float W8S = 128.f, W8I = 1.f / 128.f;

constexpr int RING_OFF = 0, RING_BYTES = 131072;
constexpr int KS_OFF = RING_BYTES;
constexpr int AUX_OFF = RING_BYTES + 24576;
constexpr int LDSCTL_OFF = AUX_OFF + 4096, MISC_OFF = LDSCTL_OFF + 320;
constexpr int LDS_BYTES = 163840;
static_assert(MISC_OFF + 128 <= LDS_BYTES, "LDS map");

#define GAS __attribute__((address_space(1)))
#define LAS __attribute__((address_space(3)))
typedef unsigned short bf16;
typedef unsigned v4u __attribute__((ext_vector_type(4)));
typedef unsigned v2u __attribute__((ext_vector_type(2)));
typedef float f32x4 __attribute__((ext_vector_type(4)));
typedef float f32x16 __attribute__((ext_vector_type(16)));
typedef short bf16x8 __attribute__((ext_vector_type(8)));
typedef short s16x4 __attribute__((ext_vector_type(4)));
typedef float f32x2_t __attribute__((ext_vector_type(2)));
typedef GAS unsigned gu32;
#define RLX_AGENT __ATOMIC_RELAXED, __HIP_MEMORY_SCOPE_AGENT
#define LDS_WAIT() asm volatile("s_waitcnt lgkmcnt(0)" ::: "memory")
#define VM_WAIT() asm volatile("s_waitcnt vmcnt(0)" ::: "memory")
__device__ __forceinline__ unsigned f2bf(float f) { unsigned u = __builtin_bit_cast(unsigned, f); return (u + 0x7fffu + ((u >> 16) & 1u)) >> 16; }
__device__ __forceinline__ unsigned pk2(float lo, float hi) { return f2bf(lo) | (f2bf(hi) << 16); }
typedef float f32x2c_t __attribute__((ext_vector_type(2))); typedef __bf16 bf16x2c_t __attribute__((ext_vector_type(2)));
__device__ __forceinline__ unsigned cvtpk(float lo, float hi) { const f32x2c_t v = {lo, hi}; const bf16x2c_t b = __builtin_convertvector(v, bf16x2c_t); return __builtin_bit_cast(unsigned, b); }
__device__ __forceinline__ float bf_lo(unsigned u) { return __builtin_bit_cast(float, u << 16); }
__device__ __forceinline__ float bf_hi(unsigned u) { return __builtin_bit_cast(float, u & 0xffff0000u); }

__device__ __forceinline__ unsigned pk4f8(float a, float b, float c, float d) { int r = __builtin_amdgcn_cvt_pk_fp8_f32(a, b, 0, false); r = __builtin_amdgcn_cvt_pk_fp8_f32(c, d, r, true); return (unsigned)r; }

#define XB_TMO      128
#define XB_XCNT(j)  (256  + 64 * (j))
#define XB_XSUB(j)  (1280 + 64 * (j))
#define XB_XGEN(j)  (2304 + 64 * (j))
#define XB_TOP      3328
#define XB_TOPGEN   3392
#define XCD_BAR_WORDS 3456
#define XB_SPIN_CAP (1u << 18)

__device__ __forceinline__ unsigned xb_ld(unsigned* p)              { return __hip_atomic_load(p, __ATOMIC_RELAXED, __HIP_MEMORY_SCOPE_AGENT); }
__device__ __forceinline__ unsigned xb_add(unsigned* p, unsigned v) { return __hip_atomic_fetch_add(p, v, __ATOMIC_RELAXED, __HIP_MEMORY_SCOPE_AGENT); }
__device__ __forceinline__ unsigned xb_xcc_id() { return (unsigned)__builtin_amdgcn_s_getreg((3 << 11) | 20) & 0xFu; }
#define XB_SPIN(cond, bar) do { unsigned _sp = 0; while (cond) { __builtin_amdgcn_s_sleep(1); \
    if ((++_sp & 255u) == 0u) { if (xb_ld(&(bar)[XB_TMO])) break; if (_sp > XB_SPIN_CAP) { atomicAdd(&(bar)[XB_TMO], 1u); break; } } } } while (0)

struct XcdBarrier {
    unsigned* bar; unsigned x;
    volatile LAS unsigned* st;
};

__device__ __forceinline__ XcdBarrier xcd_barrier_post(unsigned* bar, volatile LAS unsigned* st) {
    XcdBarrier b; b.bar = bar; b.x = xb_xcc_id(); b.st = st;
    if (threadIdx.x == 0) (void)xb_add(&bar[XB_XCNT(b.x)], 1u);
    return b;
}
__device__ __forceinline__ void xcd_barrier_complete(unsigned* bar, unsigned x, unsigned& nloc, unsigned& nx) {
    const unsigned G = gridDim.x * gridDim.y * gridDim.z;
    unsigned sum, cnt, mine, sp = 0u;
    for (;;) {
        sum = 0u; cnt = 0u; mine = 0u;
#pragma unroll
        for (unsigned j = 0; j < 16; ++j) { const unsigned c = xb_ld(&bar[XB_XCNT(j)]); sum += c; cnt += (c > 0u) ? 1u : 0u; mine = (j == x) ? c : mine; }
        if (sum == G) break;
        __builtin_amdgcn_s_sleep(1);
        if ((++sp & 255u) == 0u) { if (xb_ld(&bar[XB_TMO])) break; if (sp > XB_SPIN_CAP) { atomicAdd(&bar[XB_TMO], 1u); break; } }
    }
    nloc = mine > 0u ? mine : 1u; nx = cnt > 0u ? cnt : 1u;
}

__device__ __forceinline__ void xcd_barrier(const XcdBarrier& b) {
    asm volatile("s_waitcnt vmcnt(0)" ::: "memory");
    __syncthreads();
    if (threadIdx.x == 0) {
        unsigned* bar = b.bar;
        __builtin_amdgcn_s_waitcnt(0);
        unsigned nloc = b.st[0], nx = b.st[1];
        if (nloc == 0u) { xcd_barrier_complete(bar, b.x, nloc, nx); b.st[0] = nloc; b.st[1] = nx; }
        const unsigned old = xb_add(&bar[XB_XSUB(b.x)], 1u);
        const unsigned gen = old / nloc;
        if (old + 1u == (gen + 1u) * nloc) {
            __builtin_amdgcn_fence(__ATOMIC_RELEASE, "agent");
            asm volatile("s_waitcnt vmcnt(0)" ::: "memory");
            const unsigned og = xb_add(&bar[XB_TOP], 1u);
            const unsigned tg = og / nx;
            if (og + 1u == (tg + 1u) * nx) xb_add(&bar[XB_TOPGEN], 1u);
            else XB_SPIN(xb_ld(&bar[XB_TOPGEN]) == tg, bar);
            __builtin_amdgcn_fence(__ATOMIC_ACQUIRE, "agent");
            xb_add(&bar[XB_XGEN(b.x)], 1u);
            asm volatile("s_waitcnt vmcnt(0)" ::: "memory");
        } else {
            XB_SPIN(xb_ld(&bar[XB_XGEN(b.x)]) == gen, bar);
            __builtin_amdgcn_fence(__ATOMIC_ACQUIRE, "agent");
            asm volatile("s_waitcnt vmcnt(0)" ::: "memory");
        }
    }
    __syncthreads();
}


struct Args {
    const float* x; const float* attn_norm_g; const float* w_in_a; const float* w_in_b; const float* q_norm_g; const float* k_norm_g; const float* t5_bias;
    const float* rel_bias_b; const float* w_out; const float* ffn_norm_g; const float* w_up; const float* conv_w; const float* conv_b; const float* w_down;
    float* out; unsigned char* ws; int ph_lo, ph_hi, li, pad;
};

struct Frame {
    LAS unsigned char* lds;
    volatile LAS unsigned* MISC;
    gu32* ctl;
    int tid, lane, wave, vcu, G;
};

__host__ __device__ __forceinline__ int hmap(int p) { return 64 * ((p >> 5) & 3) + 16 * ((p >> 2) & 3) + 8 * (p >> 7) + 4 * ((p >> 4) & 1) + (p & 3); }
__host__ __device__ __forceinline__ int umap(int p) { return 32 * ((p >> 5) & 3) + 8 * ((p >> 2) & 3) + 4 * ((p >> 4) & 1) + (p & 3); }
__host__ __device__ __forceinline__ int src_col(int type, int n) {
    if (type == 0) return n;
    const int pn = n >> 8, p = n & 255;
    if (type == 2) return 256 * pn + hmap(p);
    if (type == 1) { const int c = hmap(p); return pn < 8 ? 256 * pn + c : (c < 72 ? 2048 + c : -1); }
    return (p >> 7) * FF + 128 * pn + umap(p);
}
__device__ __forceinline__ void convert_item(const float* W, int K, int Nsrc, int Ndst, int type, const float* gain, bf16* WT, LAS float* scr, int item, int lane, bool o8 = false) {
    const int nblk = Ndst / 32, kb = item / nblk, nb = item % nblk, k0 = 64 * kb, n0 = 32 * nb;
    const int sc = src_col(type, n0 + (lane & 31));
#pragma unroll 8
    for (int i = 0; i < 32; ++i) { const int kk = 2 * i + (lane >> 5); float v = 0.f; if (sc >= 0) v = W[(size_t)(k0 + kk) * Nsrc + sc]; if (gain) v *= gain[k0 + kk]; scr[kk * 33 + (lane & 31)] = v; }
    LDS_WAIT(); asm volatile("" ::: "memory");
    const int c = lane & 7;
#pragma unroll
    for (int j = 0; j < 4; ++j) { const int n = (lane >> 3) + 8 * j; const LAS float* s = scr + (8 * c) * 33 + n;
        if (o8) { v2u o; o.x = pk4f8(s[0 * 33] * W8S, s[1 * 33] * W8S, s[2 * 33] * W8S, s[3 * 33] * W8S); o.y = pk4f8(s[4 * 33] * W8S, s[5 * 33] * W8S, s[6 * 33] * W8S, s[7 * 33] * W8S);
            *(v2u*)((unsigned char*)WT + (size_t)(n0 + n) * K + k0 + 8 * c) = o; }
        else { v4u o; o.x = pk2(s[0 * 33], s[1 * 33]); o.y = pk2(s[2 * 33], s[3 * 33]); o.z = pk2(s[4 * 33], s[5 * 33]); o.w = pk2(s[6 * 33], s[7 * 33]);
            *(v4u*)(WT + (size_t)(n0 + n) * K + k0 + 8 * c) = o; } }
    LDS_WAIT(); asm volatile("" ::: "memory");
}
__device__ __forceinline__ float wave_sum(float v) {
#pragma unroll
    for (int o = 1; o < 64; o <<= 1) v += __shfl_xor(v, o);
    return v;
}
__device__ __forceinline__ void p0_prologue(Frame& F, const Args& a) {
    LAS float* scr = (LAS float*)(F.lds + RING_OFF + F.wave * 16384);
    const int gw = F.vcu * NWAVES + F.wave, NGW = F.G * NWAVES;
    constexpr int I_INA = 16 * (NA_PAD / 32), I_INB = 16 * (NB / 32), I_OUT = 16 * 32, I_UP = 16 * (NUP / 32), I_DN = (FF / 64) * 32;
    constexpr int NITEMS = 2 * I_INA + 2 * I_INB + 4 * I_OUT + 4 * I_UP + 4 * I_DN;
    unsigned char* ws = a.ws;
    for (int it = gw; it < NITEMS; it += NGW) {
        int r = it;
        if (r < 2 * I_INA) { const int l = r / I_INA; convert_item(a.w_in_a + (size_t)l * DM * NA_SRC, DM, NA_SRC, NA_PAD, 1, a.attn_norm_g + (2 * l) * DM, (bf16*)(ws + WS_W_INA) + (size_t)l * NA_PAD * DM, scr, r % I_INA, F.lane); continue; } r -= 2 * I_INA;
        if (r < 2 * I_INB) { const int l = r / I_INB; convert_item(a.w_in_b + (size_t)l * DM * NB, DM, NB, NB, 2, a.attn_norm_g + (2 * l + 1) * DM, (bf16*)(ws + WS_W_INB) + (size_t)l * NB * DM, scr, r % I_INB, F.lane, 2 * l + 1 > F8_L0); continue; } r -= 2 * I_INB;
        if (r < 4 * I_OUT) { const int l = r / I_OUT; convert_item(a.w_out + (size_t)l * DM * DM, DM, DM, DM, 0, nullptr, (bf16*)(ws + WS_W_OUT) + (size_t)l * DM * DM, scr, r % I_OUT, F.lane); continue; } r -= 4 * I_OUT;
        if (r < 4 * I_UP) { const int l = r / I_UP; convert_item(a.w_up + (size_t)l * DM * NUP, DM, NUP, NUP, 3, a.ffn_norm_g + l * DM, (bf16*)(ws + WS_W_UP) + (size_t)l * NUP * DM, scr, r % I_UP, F.lane, l >= F8_L0); continue; } r -= 4 * I_UP;
        { const int l = r / I_DN; convert_item(a.w_down + (size_t)l * FF * DM, FF, DM, DM, 0, nullptr, (bf16*)(ws + WS_W_DN) + (size_t)l * DM * FF, scr, r % I_DN, F.lane, l >= F8_L0); }
    }
    bf16* hb = (bf16*)(ws + WS_HB); float* ss = (float*)(ws + WS_SS);
    for (int m = gw; m < MTOK; m += NGW) {
        const f32x4* xr = (const f32x4*)(a.x + (size_t)m * DM) + F.lane; f32x4 v[4]; float s = 0.f;
#pragma unroll
        for (int j = 0; j < 4; ++j) { v[j] = xr[64 * j]; s += (v[j].x * v[j].x + v[j].y * v[j].y) + (v[j].z * v[j].z + v[j].w * v[j].w); }
        s = wave_sum(s);
        v2u* o8 = (v2u*)(hb + (size_t)m * DM) + F.lane;
#pragma unroll
        for (int j = 0; j < 4; ++j) { v2u w; w.x = pk2(v[j].x, v[j].y); w.y = pk2(v[j].z, v[j].w); o8[64 * j] = w; }
        if (F.lane < 16) ss[(size_t)m * 16 + F.lane] = (F.lane == 0) ? s : 0.f;
    }
}

__device__ __forceinline__ f32x4 rstd_load(const float* ss, int row, int fq) { return *(const f32x4*)(ss + (size_t)row * 16 + 4 * fq); }
__device__ __forceinline__ float rstd_finish(f32x4 a) {
    float s = (a.x + a.y) + (a.z + a.w);
    s += __shfl_xor(s, 16); s += __shfl_xor(s, 32);
    return __builtin_amdgcn_rsqf(s * (1.0f / DM) + EPS);
}
__device__ __forceinline__ float row_rstd(const float* ss, int row, int fq) { return rstd_finish(rstd_load(ss, row, fq)); }
__device__ __forceinline__ unsigned att_pk4(f32x4 v) { int r = __builtin_amdgcn_cvt_pk_fp8_f32(v.x, v.y, 0, false); r = __builtin_amdgcn_cvt_pk_fp8_f32(v.z, v.w, r, true); return (unsigned)r; }
struct EpiIn {
    static constexpr bool PERM = false, PERMA = false, AFTER_DRAIN = false;
    const float* ss; unsigned char* proj; const float* qg; const float* kg; int isB; float as;
    __device__ __forceinline__ void operator()(const pg8::f32x4 (&acc)[2][2][4][2], const pg8::Unit& u, int wr, int wc, int fr, int fq) const {
        asm volatile("" : "+v"(fr), "+v"(fq));
        const int pn = u.pn; int kind, pitch; bf16* dst;
        if (isB) { const int t = pn >> 2; kind = (t == 0) ? 1 : (t == 1 ? 2 : 0); dst = (bf16*)(proj + (size_t)t * PB_STRIDE) + 256 * (pn & 3); pitch = DM; }
        else if (pn < 4) { kind = 1; dst = (bf16*)(proj + PA_QA) + 256 * pn; pitch = DM; }
        else if (pn == 4) { kind = 2; dst = (bf16*)(proj + PA_KA); pitch = 256; }
        else if (pn == 5) { kind = 0; dst = (bf16*)(proj + PA_VA); pitch = 256; }
        else if (pn < 8) { kind = 0; dst = (bf16*)(proj + PA_QI) + 256 * (pn - 6); pitch = 512; }
        else { kind = 3; dst = (bf16*)(proj + PA_KI); pitch = 64; }
        if (kind == 3 && wc >= 2) return;
        const bool donorm = (kind == 1) || (kind == 2) || (kind == 3 && wc == 0);
        f32x4 g[2][2];
#pragma unroll
        for (int bj = 0; bj < 2; ++bj)
#pragma unroll
            for (int n = 0; n < 2; ++n) {
                if (kind == 1) g[bj][n] = *(const f32x4*)(qg + 16 * fq + 8 * bj + 4 * n) * (isB ? C2 : 1.0f);
                else if (kind == 2) g[bj][n] = *(const f32x4*)(kg + 16 * fq + 8 * bj + 4 * n);
                else g[bj][n] = (f32x4){1.f, 1.f, 1.f, 1.f};
            }
        float* wi = (float*)(proj + PA_WI);
        f32x4 rsl[2][4];
#pragma unroll
        for (int ai = 0; ai < 2; ++ai)
#pragma unroll
            for (int m = 0; m < 4; ++m) rsl[ai][m] = rstd_load(ss, u.pm * 256 + ai * 128 + wr * 64 + m * 16 + fr, fq);
#pragma unroll
        for (int ai = 0; ai < 2; ++ai)
#pragma unroll
            for (int m = 0; m < 4; ++m) {
                const int row = u.pm * 256 + ai * 128 + wr * 64 + m * 16 + fr;
                const float rs = rstd_finish(rsl[ai][m]) * as;
                f32x4 v[2][2]; float s = 0.f;
#pragma unroll
                for (int bj = 0; bj < 2; ++bj)
#pragma unroll
                    for (int n = 0; n < 2; ++n) { v[bj][n] = acc[ai][bj][m][n] * rs; const f32x4 q = v[bj][n] * v[bj][n]; s += (q.x + q.y) + (q.z + q.w); }
                if (donorm) {
                    s += __shfl_xor(s, 16); s += __shfl_xor(s, 32);
                    const float r = 1.0f / sqrtf(s * (1.0f / 64.0f) + EPS);
#pragma unroll
                    for (int bj = 0; bj < 2; ++bj)
#pragma unroll
                        for (int n = 0; n < 2; ++n) v[bj][n] = v[bj][n] * r * g[bj][n];
                }
                if (kind == 3 && wc == 1) {
                    if (fq == 0) { float* wp = wi + (size_t)row * 8; const float sc = 0.04419417382415922f;
                        *(f32x4*)(wp) = v[0][0] * sc; *(f32x4*)(wp + 4) = v[0][1] * sc; }
                } else if (!isB && pn < 6) {
                    unsigned char* p8 = (pn < 4) ? proj + PA_QA + (size_t)row * 1024 + 256 * pn + 64 * wc + 16 * fq : proj + PA_KA + (size_t)row * 512 + 128 * wc + 64 * (pn - 4) + 16 * fq;
                    v4u w; w.x = att_pk4(v[0][0]); w.y = att_pk4(v[0][1]); w.z = att_pk4(v[1][0]); w.w = att_pk4(v[1][1]);
                    *(v4u*)p8 = w;
                } else {
                    bf16* rp = dst + (size_t)row * pitch + 64 * wc + 16 * fq;
#pragma unroll
                    for (int bj = 0; bj < 2; ++bj) { v4u w; w.x = cvtpk(v[bj][0].x, v[bj][0].y); w.y = cvtpk(v[bj][0].z, v[bj][0].w); w.z = cvtpk(v[bj][1].x, v[bj][1].y); w.w = cvtpk(v[bj][1].z, v[bj][1].w);
                        *(v4u*)(rp + 8 * bj) = w; }
                }
            }
    }
};
template <int MODE>
struct EpiResT {
    static constexpr bool PERM = false, PERMA = false, AFTER_DRAIN = false;
    const float* xin; float* fout; const bf16* hbi; bf16* hb; float* ss; unsigned char* hb8;
    __device__ __forceinline__ void operator()(const pg8::f32x4 (&acc)[2][2][4][2], const pg8::Unit& u, int wr, int wc, int fr, int fq) const {
        asm volatile("" : "+v"(fr), "+v"(fq));
        const int col0 = u.pn * 256 + wc * 32 + 4 * fq;
#pragma unroll
        for (int ai = 0; ai < 2; ++ai) {
            f32x4 base[4][2][2];
#pragma unroll
            for (int m = 0; m < 4; ++m)
#pragma unroll
                for (int bj = 0; bj < 2; ++bj)
#pragma unroll
                    for (int n = 0; n < 2; ++n) { const size_t o4 = (size_t)(u.pm * 256 + ai * 128 + wr * 64 + m * 16 + fr) * DM + col0 + bj * 128 + n * 16;
                        if (xin) base[m][bj][n] = *(const f32x4*)(xin + o4); else { const v2u b = *(const v2u*)(hbi + o4); base[m][bj][n] = (f32x4){bf_lo(b.x), bf_hi(b.x), bf_lo(b.y), bf_hi(b.y)}; } }
            asm volatile("" ::: "memory");
#pragma unroll
            for (int m = 0; m < 4; ++m) {
                const int row = u.pm * 256 + ai * 128 + wr * 64 + m * 16 + fr; const size_t off = (size_t)row * DM + col0; float s = 0.f;
#pragma unroll
                for (int bj = 0; bj < 2; ++bj)
#pragma unroll
                    for (int n = 0; n < 2; ++n) { const size_t o4 = off + bj * 128 + n * 16;
                        const f32x4 o = (MODE & 1) ? base[m][bj][n] + acc[ai][bj][m][n] * W8I : base[m][bj][n] + acc[ai][bj][m][n];
                        if (fout) *(f32x4*)(fout + o4) = o;
                        else { const f32x4 q = o * o; s += (q.x + q.y) + (q.z + q.w); v2u w; w.x = cvtpk(o.x, o.y); w.y = cvtpk(o.z, o.w); *(v2u*)(hb + o4) = w;
                            if constexpr (MODE & 2) *(unsigned*)(hb8 + o4) = pk4f8(o.x, o.y, o.z, o.w); } }
                if (!fout) { s += __shfl_xor(s, 16); s += __shfl_xor(s, 32); if (fq == 0) ss[(size_t)row * 16 + u.pn * 4 + wc] = s; }
            }
        }
    }
};
typedef EpiResT<0> EpiRes;
#ifdef X_NOBPERM
__device__ __forceinline__ float lane_from(int byteaddr, float v) { return v + (float)byteaddr; }
#else
__device__ __forceinline__ float lane_from(int byteaddr, float v) { return __builtin_bit_cast(float, __builtin_amdgcn_ds_bpermute(byteaddr, __builtin_bit_cast(int, v))); }
#endif
#ifdef X_NOSILU
__device__ __forceinline__ float silu_mul(float a, float g) { return a * g; }
#else
__device__ __forceinline__ float silu_mul(float a, float g) { return a * g * __builtin_amdgcn_rcpf(1.0f + __builtin_amdgcn_exp2f(-g * LOG2E)); }
#endif
__device__ __forceinline__ float dpp_prev_lane(float v) { return __builtin_bit_cast(float, __builtin_amdgcn_update_dpp(0, __builtin_bit_cast(int, v), 0x111  , 0xf, 0xf, true)); }
template <bool F8>
struct EpiUpT {
    static constexpr bool PERM = false, PERMA = true, AFTER_DRAIN = false;
    const float* ss; const float* cw; const float* cb; bf16* act; float* halo; LAS float* cl;
    __device__ __forceinline__ void operator()(const pg8::f32x4 (&acc)[2][2][4][2], const pg8::Unit& u, int wr, int wc, int fr, int fq) const {
        asm volatile("" : "+v"(fr), "+v"(fq));
        const int colb = u.pn * 128 + wc * 32 + 8 * fq;
        const int tid_ = ((wr * 4 + wc) * 4 + fq) * 16 + fr, ce = 2 * tid_, cbj = ce >> 9, carr = (ce >> 7) & 3, cc = ce & 127;
        const f32x2_t cpre = *(const f32x2_t*)((carr < 3 ? cw + carr * NUP : cb) + cbj * FF + u.pn * 128 + cc);
        f32x4 rsl[2][4];
#pragma unroll
        for (int ai = 0; ai < 2; ++ai)
#pragma unroll
            for (int m = 0; m < 4; ++m) rsl[ai][m] = rstd_load(ss, (u.pm * 4 + ai * 2 + wr) * 64 + 4 * fr + m, fq);
        unsigned pk[2][2][4][2][2];
#pragma unroll
        for (int ai = 0; ai < 2; ++ai) {
#pragma unroll
            for (int m = 0; m < 4; ++m) {
                const float rs = F8 ? rstd_finish(rsl[ai][m]) * W8I : rstd_finish(rsl[ai][m]);
#pragma unroll
                for (int bj = 0; bj < 2; ++bj)
#pragma unroll
                    for (int n = 0; n < 2; ++n) { const f32x4 v = acc[ai][bj][m][n] * rs; pk[ai][bj][m][n][0] = cvtpk(v.x, v.y); pk[ai][bj][m][n][1] = cvtpk(v.z, v.w); }
            }
        }
        *(LAS f32x2_t*)(cl + ce) = cpre;
        asm volatile("s_waitcnt lgkmcnt(0)" ::: "memory"); __builtin_amdgcn_s_barrier(); asm volatile("" ::: "memory");
        __builtin_amdgcn_sched_barrier(0);
        if (fr == 0 || fr == 15) {
#pragma unroll
            for (int ai = 0; ai < 2; ++ai)
#pragma unroll
                for (int j = 0; j < 2; ++j)
#pragma unroll
                    for (int bj = 0; bj < 2; ++bj)
#pragma unroll
                        for (int n = 0; n < 2; ++n) { const unsigned w0 = (fr == 0) ? pk[ai][bj][j][n][0] : pk[ai][bj][2 + j][n][0], w1 = (fr == 0) ? pk[ai][bj][j][n][1] : pk[ai][bj][2 + j][n][1];
                            *(f32x4*)(halo + ((size_t)(u.pm * 4 + ai * 2 + wr) * 4 + (fr == 0 ? j : 2 + j)) * NUP + bj * FF + colb + 4 * n) = (f32x4){bf_lo(w0), bf_hi(w0), bf_lo(w1), bf_hi(w1)}; }
        }
        __builtin_amdgcn_sched_barrier(0);
#pragma unroll
        for (int ai = 0; ai < 2; ++ai) {
            const int row0 = (u.pm * 4 + ai * 2 + wr) * 64 + 4 * fr;
            unsigned outp[4][2][2];
#pragma unroll
            for (int n = 0; n < 2; ++n) {
#pragma unroll
                for (int ip = 0; ip < 2; ++ip) {
                    f32x2_t k0[2], k1[2], k2[2], kb[2];
#pragma unroll
                    for (int bj = 0; bj < 2; ++bj) { const LAS float* c = cl + bj * 512 + wc * 32 + 8 * fq + 4 * n + 2 * ip; k0[bj] = *(const LAS f32x2_t*)(c); k1[bj] = *(const LAS f32x2_t*)(c + 128); k2[bj] = *(const LAS f32x2_t*)(c + 256); kb[bj] = *(const LAS f32x2_t*)(c + 384); }
                    float y[2][4][2];
#pragma unroll
                    for (int bj = 0; bj < 2; ++bj) {
                        const unsigned w0 = pk[ai][bj][0][n][ip], w1 = pk[ai][bj][1][n][ip], w2 = pk[ai][bj][2][n][ip], w3 = pk[ai][bj][3][n][ip];
                        const unsigned q1 = (unsigned)__builtin_amdgcn_update_dpp(0, (int)w3, 0x111, 0xf, 0xf, true), q2 = (unsigned)__builtin_amdgcn_update_dpp(0, (int)w2, 0x111, 0xf, 0xf, true);
#pragma unroll
                        for (int e = 0; e < 2; ++e) { const int i = e;
                            const float u0 = e ? bf_hi(w0) : bf_lo(w0), u1 = e ? bf_hi(w1) : bf_lo(w1), u2 = e ? bf_hi(w2) : bf_lo(w2), u3 = e ? bf_hi(w3) : bf_lo(w3), p1 = e ? bf_hi(q1) : bf_lo(q1), p2 = e ? bf_hi(q2) : bf_lo(q2);
                            y[bj][0][e] = kb[bj][i] + k0[bj][i] * p2 + k1[bj][i] * p1 + k2[bj][i] * u0;
                            y[bj][1][e] = kb[bj][i] + k0[bj][i] * p1 + k1[bj][i] * u0 + k2[bj][i] * u1;
                            y[bj][2][e] = kb[bj][i] + k0[bj][i] * u0 + k1[bj][i] * u1 + k2[bj][i] * u2;
                            y[bj][3][e] = kb[bj][i] + k0[bj][i] * u1 + k1[bj][i] * u2 + k2[bj][i] * u3; }
                    }
#pragma unroll
                    for (int m = 0; m < 4; ++m) {
                        if constexpr (F8) { if (ip == 0) outp[m][n][0] = (unsigned)__builtin_amdgcn_cvt_pk_fp8_f32(silu_mul(y[0][m][0], y[1][m][0]), silu_mul(y[0][m][1], y[1][m][1]), 0, false);
                            else outp[m][n][0] = (unsigned)__builtin_amdgcn_cvt_pk_fp8_f32(silu_mul(y[0][m][0], y[1][m][0]), silu_mul(y[0][m][1], y[1][m][1]), (int)outp[m][n][0], true); }
                        else outp[m][n][ip] = cvtpk(silu_mul(y[0][m][0], y[1][m][0]), silu_mul(y[0][m][1], y[1][m][1])); }
                }
            }
#pragma unroll
            for (int m = 0; m < 4; ++m) {
                if (m < 2 && fr == 0) continue;
                if constexpr (F8) { v2u w; w.x = outp[m][0][0]; w.y = outp[m][1][0]; *(v2u*)((unsigned char*)act + (size_t)(row0 + m) * FF + colb) = w; }
                else { v4u w; w.x = outp[m][0][0]; w.y = outp[m][0][1]; w.z = outp[m][1][0]; w.w = outp[m][1][1];
                    *(v4u*)(act + (size_t)(row0 + m) * FF + colb) = w; }
            }
            asm volatile("" ::: "memory");
        }
    }
};
typedef EpiUpT<false> EpiUp;
struct EpiDummy {
    static constexpr bool PERM = false, PERMA = true, AFTER_DRAIN = false;
    float* scratch;
    __device__ __forceinline__ void operator()(const pg8::f32x4 (&acc)[2][2][4][2], const pg8::Unit& u, int wr, int wc, int fr, int fq) const {
        f32x4 s = (f32x4){0.f, 0.f, 0.f, 0.f};
#pragma unroll
        for (int ai = 0; ai < 2; ++ai)
#pragma unroll
            for (int bj = 0; bj < 2; ++bj)
#pragma unroll
                for (int m = 0; m < 4; ++m)
#pragma unroll
                    for (int n = 0; n < 2; ++n) s += acc[ai][bj][m][n];
        scratch[(size_t)(u.pm * 22 + u.pn) * 512 + ((wr * 4 + wc) * 4 + fq) * 16 + fr] = (s.x + s.y) + (s.z + s.w);
    }
};
template <bool F8>
__device__ __forceinline__ void fixup_phase(Frame& F, const float* cw, const float* cb, const float* halo, bf16* act) {
    const int gt = F.vcu * (NWAVES * 64) + F.tid, NT = F.G * NWAVES * 64;
    constexpr int C4 = FF / 4;
    for (int it = gt; it < NBLK64 * 2 * C4; it += NT) {
        const int c = (it % C4) * 4, rj = it / C4, j = rj & 1, blk = rj >> 1, t = blk * 64 + j, tb = t % SEQ;
        f32x4 y[2];
#pragma unroll
        for (int bj = 0; bj < 2; ++bj) {
            const int cc = bj * FF + c;
            const f32x4 z = (f32x4){0.f, 0.f, 0.f, 0.f};
            const f32x4 ut = *(const f32x4*)(halo + ((size_t)blk * 4 + j) * NUP + cc);
            f32x4 u1, u2;
            if (j == 1) { u1 = *(const f32x4*)(halo + ((size_t)blk * 4 + 0) * NUP + cc); u2 = (tb == 1) ? z : *(const f32x4*)(halo + ((size_t)(blk - 1) * 4 + 3) * NUP + cc); }
            else { u1 = (tb == 0) ? z : *(const f32x4*)(halo + ((size_t)(blk - 1) * 4 + 3) * NUP + cc); u2 = (tb == 0) ? z : *(const f32x4*)(halo + ((size_t)(blk - 1) * 4 + 2) * NUP + cc); }
            y[bj] = *(const f32x4*)(cb + cc) + *(const f32x4*)(cw + cc) * u2 + *(const f32x4*)(cw + NUP + cc) * u1 + *(const f32x4*)(cw + 2 * NUP + cc) * ut;
        }
        if constexpr (F8) *(unsigned*)((unsigned char*)act + (size_t)t * FF + c) = pk4f8(silu_mul(y[0].x, y[1].x), silu_mul(y[0].y, y[1].y), silu_mul(y[0].z, y[1].z), silu_mul(y[0].w, y[1].w));
        else { v2u w; w.x = cvtpk(silu_mul(y[0].x, y[1].x), silu_mul(y[0].y, y[1].y)); w.y = cvtpk(silu_mul(y[0].z, y[1].z), silu_mul(y[0].w, y[1].w));
            *(v2u*)(act + (size_t)t * FF + c) = w; }
    }
}

__device__ __forceinline__ int crow(int r, int hi) { return (r & 3) + 8 * (r >> 2) + 4 * hi; }
__device__ __forceinline__ void glds16(const void* gsrc, unsigned lds_dst) { unsigned keep;
    asm volatile("s_mov_b32 %0, m0\n\ts_mov_b32 m0, %2\n\ts_nop 0\n\tglobal_load_lds_dwordx4 %1, off\n\ts_mov_b32 m0, %0" : "=&s"(keep) : "v"(gsrc), "s"(lds_dst) : "memory"); }
__device__ __forceinline__ float max3f(float a, float b, float c) { return fmaxf(fmaxf(a, b), c); }

namespace band {
constexpr int SLOTB = 8192;
constexpr int LDS_K = 0, LDS_V = 2 * SLOTB, LDS_WS = 4 * SLOTB, LDS_TB = LDS_WS + NWAVES * 64 * 4, LDS_OST = LDS_TB + 640 * 4 + 512, LDS_END = LDS_OST + NWAVES * 4096;
static_assert(LDS_END <= RING_BYTES, "band LDS");
__device__ __forceinline__ void unit(Frame& F, int b, int h, int U, const bf16* Q, const bf16* K, const bf16* V, bf16* O, const float* rel) {
    const int tid = F.tid, lane = F.lane, r32 = lane & 31, hi = lane >> 5, wid = F.wave;
    LAS unsigned char* shm = F.lds + RING_OFF;
    const unsigned lds0 = (unsigned)(uintptr_t)shm;
    const long rowbase = (long)b * SEQ; const int q0 = U * 256, c0 = 4 * U, cq = c0 + (wid >> 1);
    const bf16* Qw = Q + (rowbase + q0 + wid * 32) * DM + h * 64;
    const bf16* Kh = K + rowbase * DM + h * 64; const bf16* Vh = V + rowbase * DM + h * 64;
    LAS float* wsf = (LAS float*)(shm + LDS_WS) + wid * 64;
    LAS float* tb = (LAS float*)(shm + LDS_TB);
    const bf16* ksrc = Kh + (long)lane * DM + wid * 8;
    const bf16* vsrc = Vh + (long)(16 * (wid & 3) + (lane >> 2)) * DM + (wid >> 2) * 32 + (lane & 3) * 8;
    const unsigned kdst = lds0 + LDS_K + wid * 1024, vdst = lds0 + LDS_V + wid * 1024;
    const int lo = (c0 - 8 > 0) ? c0 - 8 : 0, hiT = c0 + 3, NT = hiT - lo + 1, t0 = (c0 - 5 > 0) ? c0 - 5 : 0;
#define BAND_KT(i) ((t0 + (i) <= hiT) ? t0 + (i) : lo + (t0 + (i) - hiT - 1))
    for (int i = tid; i < 640; i += NWAVES * 64) { int d = i - 64; d = d < -256 ? -256 : (d > 256 ? 256 : d); tb[i] = rel[(d + 256) * 16 + h] * LOG2E; }
    { const int kt = BAND_KT(0); glds16(ksrc + (long)kt * 64 * DM, (unsigned)__builtin_amdgcn_readfirstlane(kdst)); glds16(vsrc + (long)kt * 64 * DM, (unsigned)__builtin_amdgcn_readfirstlane(vdst)); }
    bf16x8 qr[4];
#pragma unroll
    for (int d0 = 0; d0 < 4; ++d0) qr[d0] = *(const bf16x8*)(Qw + (long)r32 * DM + d0 * 16 + hi * 8);
    float m_run = -INFINITY, l_run = 0.f; f32x16 o[2]; o[0] = f32x16{}; o[1] = f32x16{};
    const int qpos = q0 + wid * 32 + r32;
    const LAS unsigned char* vbase = shm + LDS_V + ((lane >> 4) & 1) * 32 + (lane & 3) * 8 + (4 * hi + ((lane & 15) >> 2)) * 64;
    for (int i = 0; i < NT; ++i) {
        asm volatile("s_waitcnt vmcnt(0) lgkmcnt(0)\n\ts_barrier" ::: "memory");
        if (i + 1 < NT) { const int kt = BAND_KT(i + 1); const unsigned so = ((i + 1) & 1) * SLOTB;
            glds16(ksrc + (long)kt * 64 * DM, (unsigned)__builtin_amdgcn_readfirstlane(kdst + so)); glds16(vsrc + (long)kt * 64 * DM, (unsigned)__builtin_amdgcn_readfirstlane(vdst + so)); }
        const int kt = BAND_KT(i);
        if (kt < cq - 8 || kt > cq) continue;
        const int so = (i & 1) * SLOTB;
        f32x16 p0 = f32x16{}, p1 = f32x16{};
        { const LAS unsigned char* kb = shm + LDS_K + so + hi * 1024 + r32 * 16;
#pragma unroll
          for (int d0 = 0; d0 < 4; ++d0) { const bf16x8 b0 = *(const LAS bf16x8*)(kb + d0 * 2048), b1 = *(const LAS bf16x8*)(kb + d0 * 2048 + 512);
              p0 = __builtin_amdgcn_mfma_f32_32x32x16_bf16(b0, qr[d0], p0, 0, 0, 0); p1 = __builtin_amdgcn_mfma_f32_32x32x16_bf16(b1, qr[d0], p1, 0, 0, 0); } }
        if (kt + 5 <= cq) { const float cbias = tb[639];
#pragma unroll
          for (int r = 0; r < 16; ++r) { p0[r] += cbias; p1[r] += cbias; } }
        else { const int ib = qpos - 64 * kt + 64 - 4 * hi;
#pragma unroll
          for (int r = 0; r < 16; ++r) { const int ix = ib - ((r & 3) + 8 * (r >> 2)); p0[r] += tb[ix]; p1[r] += tb[ix - 32]; } }
        float rm = p0[0];
#pragma unroll
        for (int r = 0; r < 16; ++r) rm = max3f(rm, p0[r], p1[r]);
        { auto rr = __builtin_amdgcn_permlane32_swap(__float_as_uint(rm), __float_as_uint(rm), false, false); rm = fmaxf(__uint_as_float(rr[0]), __uint_as_float(rr[1])); }
        const float mnew = fmaxf(m_run, rm), f = __builtin_amdgcn_exp2f(m_run - mnew); m_run = mnew;
        float sacc = 0.f;
#pragma unroll
        for (int r = 0; r < 16; ++r) { p0[r] = __builtin_amdgcn_exp2f(p0[r] - mnew); p1[r] = __builtin_amdgcn_exp2f(p1[r] - mnew); sacc += p0[r] + p1[r]; }
        l_run = l_run * f + sacc;
        if (!__all(f == 1.0f)) {
            if (hi == 0) wsf[r32] = f;
            LDS_WAIT();
#pragma unroll
            for (int r = 0; r < 16; ++r) { const float fr_ = wsf[crow(r, hi)]; o[0][r] *= fr_; o[1][r] *= fr_; }
        }
        v4u pw[4];
        pw[0] = (v4u){cvtpk(p0[0], p0[1]), cvtpk(p0[2], p0[3]), cvtpk(p0[4], p0[5]), cvtpk(p0[6], p0[7])};
        pw[1] = (v4u){cvtpk(p0[8], p0[9]), cvtpk(p0[10], p0[11]), cvtpk(p0[12], p0[13]), cvtpk(p0[14], p0[15])};
        pw[2] = (v4u){cvtpk(p1[0], p1[1]), cvtpk(p1[2], p1[3]), cvtpk(p1[4], p1[5]), cvtpk(p1[6], p1[7])};
        pw[3] = (v4u){cvtpk(p1[8], p1[9]), cvtpk(p1[10], p1[11]), cvtpk(p1[12], p1[13]), cvtpk(p1[14], p1[15])};
        const LAS unsigned char* vb = vbase + so;
#pragma unroll
        for (int d0 = 0; d0 < 2; ++d0)
#pragma unroll
            for (int ks = 0; ks < 4; ++ks) {
                const s16x4 vlo = __builtin_bit_cast(s16x4, __builtin_amdgcn_ds_read_tr16_b64_v4i16((LAS s16x4*)(vb + d0 * 4096 + ks * 1024)));
                const s16x4 vhi = __builtin_bit_cast(s16x4, __builtin_amdgcn_ds_read_tr16_b64_v4i16((LAS s16x4*)(vb + d0 * 4096 + ks * 1024 + 512)));
                const bf16x8 vf = (bf16x8){vlo[0], vlo[1], vlo[2], vlo[3], vhi[0], vhi[1], vhi[2], vhi[3]};
                o[d0] = __builtin_amdgcn_mfma_f32_32x32x16_bf16(__builtin_bit_cast(bf16x8, pw[ks]), vf, o[d0], 0, 0, 0);
            }
    }
#undef BAND_KT
    { auto rr = __builtin_amdgcn_permlane32_swap(__float_as_uint(l_run), __float_as_uint(l_run), false, false); l_run = __uint_as_float(rr[0]) + __uint_as_float(rr[1]); }
    if (hi == 0) wsf[32 + r32] = l_run;
    LDS_WAIT();
    float rli[16];
#pragma unroll
    for (int r = 0; r < 16; ++r) rli[r] = __builtin_amdgcn_rcpf(wsf[32 + crow(r, hi)]);
    bf16* Ow = O + (rowbase + q0 + wid * 32) * DM + h * 64;
    { LAS bf16* stg = (LAS bf16*)(shm + LDS_OST) + wid * 2048;
#pragma unroll
      for (int r = 0; r < 16; ++r) { const int orow = crow(r, hi);
#pragma unroll
          for (int d0 = 0; d0 < 2; ++d0) stg[orow * 64 + d0 * 32 + r32] = (bf16)f2bf(o[d0][r] * rli[r]); }
      LDS_WAIT();
#pragma unroll
      for (int i = 0; i < 4; ++i) { const int row = i * 8 + (lane >> 3), ch = lane & 7; const v4u v = *(const LAS v4u*)(stg + row * 64 + ch * 8); *(v4u*)(Ow + (long)row * DM + ch * 8) = v; } }
    asm volatile("s_waitcnt lgkmcnt(0)\n\ts_barrier" ::: "memory");
}
__device__ __forceinline__ void phase(Frame& F, const bf16* Q, const bf16* K, const bf16* V, bf16* O, const float* rel) {
    const int NU = BATCH * 16 * 32, per = (NU + F.G - 1) / F.G;
    for (int i = 0; i < per; ++i) { const int uid = F.vcu * per + i; if (uid >= NU) break; unit(F, uid >> 9, (uid >> 5) & 15, uid & 31, Q, K, V, O, rel); }
}
}

namespace dsa {
__device__ __forceinline__ unsigned okey(float s) { const unsigned u = __float_as_uint(s + 0.0f); return (u & 0x80000000u) ? ~u : (u | 0x80000000u); }
struct Ctx { const bf16* QA; const bf16* KA; const bf16* VA; const bf16* QI; const bf16* KI; const float* WI; bf16* M; const LAS float* t5l; unsigned short* SEL; };

__device__ __forceinline__ void scan_hist(const LAS unsigned* hq, int lane, unsigned need, unsigned& bin, unsigned& above) {
    const LAS v4u* hp = (const LAS v4u*)hq + lane * 4;
    unsigned wds[16];
#pragma unroll
    for (int j = 0; j < 4; ++j) { const v4u t = hp[j]; wds[4 * j] = t.x; wds[4 * j + 1] = t.y; wds[4 * j + 2] = t.z; wds[4 * j + 3] = t.w; }
    unsigned tl = 0;
#pragma unroll
    for (int j = 0; j < 16; ++j) tl += (wds[j] & 0xffffu) + (wds[j] >> 16);
    unsigned suf = tl;
#pragma unroll
    for (int o = 1; o < 64; o <<= 1) { const unsigned v = __shfl_down(suf, o); if (lane + o < 64) suf += v; }
    const unsigned S = suf - tl;
    const bool cross = (S < need) && (need <= S + tl);
    unsigned c = S, bsel = 0, ab = 0; bool found = false;
#pragma unroll
    for (int k = 31; k >= 0; --k) { const unsigned cnt = (wds[k >> 1] >> (16 * (k & 1))) & 0xffffu; if (!found && c + cnt >= need) { bsel = 32 * lane + k; ab = c; found = true; } c += cnt; }
    const unsigned long long bal = __ballot(cross);
    const int src = bal ? __builtin_ctzll(bal) : 0;
    bin = __shfl(bsel, src); above = __shfl(ab, src);
}

__device__ __forceinline__ void attend(const Ctx& C, const LAS unsigned short* sq, int nvalid, long rowbase, long token, int tpos, int lane, int g0) {
    asm volatile("" : "+v"(lane));
    const int l15 = lane & 15, l4 = lane >> 4;
    int sidx[16];
#pragma unroll
    for (int ti = 0; ti < 16; ++ti) sidx[ti] = sq[ti * 16 + l15];
    unsigned bpk[4] = {0u, 0u, 0u, 0u};
#pragma unroll
    for (int ti = 0; ti < 16; ++ti) { const int rel = sidx[ti] - tpos, n = rel < 0 ? -rel : rel;
        const int bk = (rel > 0 ? 16 : 0) + (n < 8 ? n : 8 + (n >= 12) + (n >= 16) + (n >= 23) + (n >= 32) + (n >= 46) + (n >= 64) + (n >= 91));
        bpk[ti >> 2] |= (unsigned)bk << (8 * (ti & 3)); }
#pragma unroll 1
    for (int g = g0; g < g0 + 2; ++g) {
        const bf16* qp = C.QA + token * DM + (4 * g + (lane & 3)) * 64 + 8 * l4;
        const bf16x8 qf0 = *(const bf16x8*)qp, qf1 = *(const bf16x8*)(qp + 32);
        const bf16* kbase = C.KA + rowbase * 256 + g * 64 + 8 * l4;
        f32x4 S[16];
#pragma unroll
        for (int hh = 0; hh < 4; ++hh) {
            bf16x8 kf0[4], kf1[4];
#pragma unroll
            for (int j = 0; j < 4; ++j) { const bf16* kp = kbase + (long)sidx[hh * 4 + j] * 256; kf0[j] = *(const bf16x8*)kp; kf1[j] = *(const bf16x8*)(kp + 32); }
#pragma unroll
            for (int j = 0; j < 4; ++j) { const int ti = hh * 4 + j;
                f32x4 a = *(const LAS f32x4*)(C.t5l + ((bpk[hh] >> (8 * j)) & 255u) * 16 + 4 * g);
                asm volatile("v_mfma_f32_16x16x32_bf16 %0, %1, %2, %0" : "+v"(a) : "v"(qf0), "v"(kf0[j]));
                asm volatile("v_mfma_f32_16x16x32_bf16 %0, %1, %2, %0" : "+v"(a) : "v"(qf1), "v"(kf1[j]));
                S[ti] = a; }
            asm volatile("s_nop 15\n\ts_nop 7" : "+v"(S[hh * 4]), "+v"(S[hh * 4 + 1]), "+v"(S[hh * 4 + 2]), "+v"(S[hh * 4 + 3]));
        }
#pragma unroll
        for (int ti = 0; ti < 16; ++ti) if (ti * 16 >= nvalid) S[ti] = (f32x4){-INFINITY, -INFINITY, -INFINITY, -INFINITY};
        f32x4 mx = S[0];
#pragma unroll
        for (int ti = 1; ti < 16; ++ti) { mx.x = fmaxf(mx.x, S[ti].x); mx.y = fmaxf(mx.y, S[ti].y); mx.z = fmaxf(mx.z, S[ti].z); mx.w = fmaxf(mx.w, S[ti].w); }
#pragma unroll
        for (int o = 1; o < 16; o <<= 1) { mx.x = fmaxf(mx.x, __shfl_xor(mx.x, o)); mx.y = fmaxf(mx.y, __shfl_xor(mx.y, o)); mx.z = fmaxf(mx.z, __shfl_xor(mx.z, o)); mx.w = fmaxf(mx.w, __shfl_xor(mx.w, o)); }
        f32x4 ls = (f32x4){0.f, 0.f, 0.f, 0.f};
        unsigned P01[16], P23[16];
#pragma unroll
        for (int ti = 0; ti < 16; ++ti) { const float e0 = __builtin_amdgcn_exp2f(S[ti].x - mx.x), e1 = __builtin_amdgcn_exp2f(S[ti].y - mx.y), e2 = __builtin_amdgcn_exp2f(S[ti].z - mx.z), e3 = __builtin_amdgcn_exp2f(S[ti].w - mx.w);
            ls += (f32x4){e0, e1, e2, e3}; P01[ti] = cvtpk(e0, e1); P23[ti] = cvtpk(e2, e3); }
#pragma unroll
        for (int o = 1; o < 16; o <<= 1) { ls.x += __shfl_xor(ls.x, o); ls.y += __shfl_xor(ls.y, o); ls.z += __shfl_xor(ls.z, o); ls.w += __shfl_xor(ls.w, o); }
        float o_[4][16];
#pragma unroll
        for (int h = 0; h < 4; ++h)
#pragma unroll
            for (int d = 0; d < 16; ++d) o_[h][d] = 0.f;
        const bf16* vbase = C.VA + rowbase * 256 + g * 64 + 16 * l4;
#pragma unroll
        for (int hh = 0; hh < 4; ++hh) {
            v4u va[4], vb[4];
#pragma unroll
            for (int j = 0; j < 4; ++j) { const v4u* vp = (const v4u*)(vbase + (long)sidx[hh * 4 + j] * 256); va[j] = vp[0]; vb[j] = vp[1]; }
#pragma unroll
            for (int j = 0; j < 4; ++j) { const int ti = hh * 4 + j; const v4u v0 = va[j], v1 = vb[j];
                float vf[16];
                vf[0] = bf_lo(v0.x); vf[1] = bf_hi(v0.x); vf[2] = bf_lo(v0.y); vf[3] = bf_hi(v0.y); vf[4] = bf_lo(v0.z); vf[5] = bf_hi(v0.z); vf[6] = bf_lo(v0.w); vf[7] = bf_hi(v0.w);
                vf[8] = bf_lo(v1.x); vf[9] = bf_hi(v1.x); vf[10] = bf_lo(v1.y); vf[11] = bf_hi(v1.y); vf[12] = bf_lo(v1.z); vf[13] = bf_hi(v1.z); vf[14] = bf_lo(v1.w); vf[15] = bf_hi(v1.w);
                const float p0 = bf_lo(P01[ti]), p1 = bf_hi(P01[ti]), p2 = bf_lo(P23[ti]), p3 = bf_hi(P23[ti]);
#pragma unroll
                for (int d = 0; d < 16; ++d) { o_[0][d] += p0 * vf[d]; o_[1][d] += p1 * vf[d]; o_[2][d] += p2 * vf[d]; o_[3][d] += p3 * vf[d]; } }
        }
        float res[4];
#pragma unroll
        for (int h = 0; h < 4; ++h) {
            float a8[8], a4[4], a2[2];
            const bool b3 = (l15 & 8) != 0, b2 = (l15 & 4) != 0, b1 = (l15 & 2) != 0, b0 = (l15 & 1) != 0;
#pragma unroll
            for (int d = 0; d < 8; ++d) { const float keep = b3 ? o_[h][d + 8] : o_[h][d], send = b3 ? o_[h][d] : o_[h][d + 8]; a8[d] = keep + __shfl_xor(send, 8); }
#pragma unroll
            for (int d = 0; d < 4; ++d) { const float keep = b2 ? a8[d + 4] : a8[d], send = b2 ? a8[d] : a8[d + 4]; a4[d] = keep + __shfl_xor(send, 4); }
#pragma unroll
            for (int d = 0; d < 2; ++d) { const float keep = b1 ? a4[d + 2] : a4[d], send = b1 ? a4[d] : a4[d + 2]; a2[d] = keep + __shfl_xor(send, 2); }
            { const float keep = b0 ? a2[1] : a2[0], send = b0 ? a2[0] : a2[1]; res[h] = keep + __shfl_xor(send, 1); }
        }
        bf16* mp = C.M + token * DM + (4 * g) * 64 + lane;
        mp[0] = (bf16)f2bf(res[0] * __builtin_amdgcn_rcpf(ls.x)); mp[64] = (bf16)f2bf(res[1] * __builtin_amdgcn_rcpf(ls.y)); mp[128] = (bf16)f2bf(res[2] * __builtin_amdgcn_rcpf(ls.z)); mp[192] = (bf16)f2bf(res[3] * __builtin_amdgcn_rcpf(ls.w));
    }
}

constexpr int CAND_CAP = 256;
constexpr int SELKS_OFF = KS_OFF;
__device__ __forceinline__ float relu_i(float x) { const int i = __builtin_bit_cast(int, x); return __builtin_bit_cast(float, i > 0 ? i : 0); }
struct SelState { unsigned pre[4], need[4], cnt[4], tcnt[4]; };
__device__ __forceinline__ void tile_mfma(f32x16 (&acc)[2], const LAS unsigned char* kf, const int (&koff)[4], const bf16x8 (&qa)[4]) {
#pragma unroll
    for (int h2 = 0; h2 < 2; ++h2) { acc[h2] = f32x16{};
#pragma unroll
        for (int ks = 0; ks < 4; ++ks) { const bf16x8 kb = *(const LAS bf16x8*)(kf + koff[ks] + h2 * 4096); acc[h2] = __builtin_amdgcn_mfma_f32_32x32x16_bf16(qa[ks], kb, acc[h2], 0, 0, 0); } }
}
template <class ActionT>
__device__ __forceinline__ void tile_valu(const f32x16 (&acc)[2], const f32x2_t (&wp)[2][4], int kbase, ActionT&& act) {
#pragma unroll
    for (int h2 = 0; h2 < 2; ++h2) {
        f32x2_t sa = {0.f, 0.f}, sb = {0.f, 0.f};
#pragma unroll
        for (int jp = 0; jp < 4; ++jp) {
            const f32x2_t ra = {relu_i(acc[h2][2 * jp]), relu_i(acc[h2][2 * jp + 1])};
            const f32x2_t rb = {relu_i(acc[h2][8 + 2 * jp]), relu_i(acc[h2][8 + 2 * jp + 1])};
            sa = __builtin_elementwise_fma(ra, wp[0][jp], sa); sb = __builtin_elementwise_fma(rb, wp[1][jp], sb); }
        act(kbase + h2 * 32, (sa.x + sa.y) + 0.0f, (sb.x + sb.y) + 0.0f);
    }
}
constexpr int KSLOTS = 3;
__device__ __forceinline__ void wait_tile(int newer) {
    if (newer >= 4) asm volatile("s_waitcnt vmcnt(4) lgkmcnt(0)\n\ts_barrier" ::: "memory");
    else if (newer == 3) asm volatile("s_waitcnt vmcnt(3) lgkmcnt(0)\n\ts_barrier" ::: "memory");
    else if (newer == 2) asm volatile("s_waitcnt vmcnt(2) lgkmcnt(0)\n\ts_barrier" ::: "memory");
    else if (newer == 1) asm volatile("s_waitcnt vmcnt(1) lgkmcnt(0)\n\ts_barrier" ::: "memory");
    else asm volatile("s_waitcnt vmcnt(0) lgkmcnt(0)\n\ts_barrier" ::: "memory");
}
template <class ActionT>
__device__ __forceinline__ void tile_pass(Frame& F, const bf16* ksrc, unsigned kdst, const LAS unsigned char* kfr, const int (&koff)[4], int NT, const bf16x8 (&qa)[4], const f32x2_t (&wp)[2][4], ActionT&& act) {
    asm volatile("s_waitcnt lgkmcnt(0)\n\ts_barrier" ::: "memory");
    const int npre = NT < KSLOTS ? NT : KSLOTS;
    for (int j = 0; j < npre; ++j) glds16(ksrc + (long)j * 4096, (unsigned)__builtin_amdgcn_readfirstlane(kdst + j * 8192));
    wait_tile(npre - 1);
    f32x16 accA[2], accB[2];
    tile_mfma(accA, kfr, koff, qa);
    int sl = 0;
    int kt = 0;
    for (; kt + 2 < NT; kt += 2) {
        { const int inflight = (NT - kt - 2) < (KSLOTS - 2) ? (NT - kt - 2) : (KSLOTS - 2); wait_tile(inflight); }
        if (kt + KSLOTS < NT) glds16(ksrc + (long)(kt + KSLOTS) * 4096, (unsigned)__builtin_amdgcn_readfirstlane(kdst + sl * 8192));
        sl = (sl == KSLOTS - 1) ? 0 : sl + 1;
        tile_mfma(accB, kfr + sl * 8192, koff, qa);
        tile_valu(accA, wp, kt * 64, act);
        { const int inflight = (NT - kt - 3) < (KSLOTS - 2) ? (NT - kt - 3) : (KSLOTS - 2); wait_tile(inflight); }
        if (kt + 1 + KSLOTS < NT) glds16(ksrc + (long)(kt + 1 + KSLOTS) * 4096, (unsigned)__builtin_amdgcn_readfirstlane(kdst + sl * 8192));
        sl = (sl == KSLOTS - 1) ? 0 : sl + 1;
        tile_mfma(accA, kfr + sl * 8192, koff, qa);
        tile_valu(accB, wp, (kt + 1) * 64, act);
    }
    if (kt + 1 < NT) {
        wait_tile(0);
        sl = (sl == KSLOTS - 1) ? 0 : sl + 1;
        tile_mfma(accB, kfr + sl * 8192, koff, qa);
        tile_valu(accA, wp, kt * 64, act);
        tile_valu(accB, wp, (kt + 1) * 64, act);
    } else tile_valu(accA, wp, kt * 64, act);
    LDS_WAIT();
}
__device__ __forceinline__ void scan_hist_cnt(const LAS unsigned* hq, int lane, unsigned need, unsigned& bin, unsigned& above, unsigned& bcnt) {
    const LAS v4u* hp = (const LAS v4u*)hq + lane * 2;
    unsigned wds[8];
#pragma unroll
    for (int j = 0; j < 2; ++j) { const v4u t = hp[j]; wds[4 * j] = t.x; wds[4 * j + 1] = t.y; wds[4 * j + 2] = t.z; wds[4 * j + 3] = t.w; }
    unsigned tl = 0;
#pragma unroll
    for (int j = 0; j < 8; ++j) tl += wds[j];
    unsigned suf = tl;
#pragma unroll
    for (int o = 1; o < 64; o <<= 1) { const unsigned v = __shfl_down(suf, o); if (lane + o < 64) suf += v; }
    const unsigned S = suf - tl;
    const bool cross = (S < need) && (need <= S + tl);
    unsigned c = S, bsel = 0, ab = 0, bc = 0; bool found = false;
#pragma unroll
    for (int k = 7; k >= 0; --k) { const unsigned cnt = wds[k]; if (!found && c + cnt >= need) { bsel = 8 * lane + k; ab = c; bc = cnt; found = true; } c += cnt; }
    const unsigned long long bal = __ballot(cross);
    const int src = bal ? __builtin_ctzll(bal) : 0;
    bin = __builtin_amdgcn_readfirstlane(__shfl(bsel, src)); above = __builtin_amdgcn_readfirstlane(__shfl(ab, src)); bcnt = __builtin_amdgcn_readfirstlane(__shfl(bc, src));
}
__device__ __forceinline__ void step(Frame& F, const Ctx& C, int b, int c, int half) {
    int lane_ = F.lane; asm volatile("" : "+v"(lane_));
    const int lane = lane_, r = lane & 31, hi = lane >> 5, wave = F.wave;
    LAS unsigned* hist = (LAS unsigned*)(F.lds + RING_OFF + wave * 16384);
    LAS unsigned short* sel = (LAS unsigned short*)hist;
    LAS unsigned* cand = hist + 2048;
    LAS unsigned* fbflag = (LAS unsigned*)(F.lds + AUX_OFF + 2048);
    const long rowbase = (long)b * SEQ;
    const int tq0 = 64 * c + 32 * half + 4 * wave;
    const int N = 64 * (c + 1), NT = c + 1;
    int nvalid = 256;
    if (N <= 256) {
        nvalid = N;
        for (int j = lane; j < 4 * 256; j += 64) sel[j] = (unsigned short)(((j & 255) < N) ? (j & 255) : 0);
    } else {
        const int aq = 2 * ((r >> 2) & 1) + (r >> 4), ah = 4 * ((r >> 3) & 1) + (r & 3);
        const bf16* qip = C.QI + (rowbase + tq0 + aq) * 512 + ah * 64 + 8 * hi;
        bf16x8 qa[4];
#pragma unroll
        for (int ks = 0; ks < 4; ++ks) qa[ks] = *(const bf16x8*)(qip + 16 * ks);
        f32x2_t wp[2][4];
#pragma unroll
        for (int t = 0; t < 2; ++t) { const float* wq = C.WI + (rowbase + tq0 + 2 * hi + t) * 8; const f32x4 w0 = *(const f32x4*)wq, w1 = *(const f32x4*)(wq + 4);
            wp[t][0] = (f32x2_t){w0.x, w0.y}; wp[t][1] = (f32x2_t){w0.z, w0.w}; wp[t][2] = (f32x2_t){w1.x, w1.y}; wp[t][3] = (f32x2_t){w1.z, w1.w}; }
        float Bq;
        { float ssq = 0.f;
#pragma unroll
          for (int ks = 0; ks < 4; ++ks)
#pragma unroll
              for (int e = 0; e < 8; ++e) { const float v = bf_lo((unsigned)(unsigned short)qa[ks][e]); ssq += v * v; }
          ssq += __shfl_xor(ssq, 32);
          float term = fabsf(C.WI[(rowbase + tq0 + aq) * 8 + ah]) * sqrtf(ssq);
          term += __shfl_xor(term, 1); term += __shfl_xor(term, 2); term += __shfl_xor(term, 8);
          Bq = term * 8.25f + 1e-20f; }
        const float B0 = __shfl(Bq, (hi << 2)), B1 = __shfl(Bq, (hi << 2) | 16);
        const float sc0 = 1024.0f / B0, sc1 = 1024.0f / B1;
        asm volatile("" :: "v"(qa[0]), "v"(qa[1]), "v"(qa[2]), "v"(qa[3]));
        asm volatile("" :: "v"(wp[0][0]), "v"(wp[0][1]), "v"(wp[0][2]), "v"(wp[0][3]), "v"(wp[1][0]), "v"(wp[1][1]), "v"(wp[1][2]), "v"(wp[1][3]), "v"(sc0), "v"(sc1));
        const bf16* ksrc = C.KI + rowbase * 64 + (long)(wave * 8 + (lane >> 3)) * 64 + ((lane & 7) ^ (lane >> 3)) * 8;
        const unsigned kdst = (unsigned)(uintptr_t)(F.lds + SELKS_OFF) + wave * 1024;
        const LAS unsigned char* kfr = F.lds + SELKS_OFF + r * 128;
        int koff[4];
#pragma unroll
        for (int ks = 0; ks < 4; ++ks) koff[ks] = ((2 * ks + hi) ^ (r & 7)) * 16;
        const unsigned below = (1u << r) - 1u;
        LAS v4u* hz = (LAS v4u*)hist;
        if (wave == 0 && lane == 0) *fbflag = 0u;
#pragma unroll
        for (int j = 0; j < 8; ++j) hz[j * 64 + lane] = (v4u){0u, 0u, 0u, 0u};
        tile_pass(F, ksrc, kdst, kfr, koff, NT, qa, wp, [&](int kbase, float s0, float s1) {
            const int b0 = (int)__builtin_amdgcn_fmed3f(__builtin_fmaf(s0, sc0, 256.0f), 0.0f, 511.0f), b1 = (int)__builtin_amdgcn_fmed3f(__builtin_fmaf(s1, sc1, 256.0f), 0.0f, 511.0f);
            __hip_atomic_fetch_add(hist + (2 * hi) * 512 + b0, 1u, __ATOMIC_RELAXED, __HIP_MEMORY_SCOPE_WORKGROUP);
            __hip_atomic_fetch_add(hist + (2 * hi + 1) * 512 + b1, 1u, __ATOMIC_RELAXED, __HIP_MEMORY_SCOPE_WORKGROUP);
        });
#ifdef PROBE_SKEL
        tile_pass(F, ksrc, kdst, kfr, koff, NT, qa, wp, [&](int kbase, float s0, float s1) { });
#endif
#ifdef PROBE_SCORE
        { float dsum = 0.f; tile_pass(F, ksrc, kdst, kfr, koff, NT, qa, wp, [&](int kbase, float s0, float s1) { dsum += s0 + s1; }); if (dsum == 12345.678f) hist[0] = 1u; }
#endif
        SelState st;
        unsigned tbin[4], bcn[4]; bool ovf = false;
#pragma unroll
        for (int ql = 0; ql < 4; ++ql) { unsigned above; scan_hist_cnt(hist + ql * 512, lane, 256u, tbin[ql], above, bcn[ql]); st.cnt[ql] = 0u; st.tcnt[ql] = 0u; st.need[ql] = 256u - above; st.pre[ql] = above;
#ifdef PROBE_OVF
            ovf |= bcn[ql] > (unsigned)PROBE_OVF; }
#else
            ovf |= bcn[ql] > (unsigned)CAND_CAP; }
#endif
        LDS_WAIT();
        if (ovf && lane == 0) *fbflag = 1u;
        asm volatile("s_waitcnt lgkmcnt(0)\n\ts_barrier" ::: "memory");
#ifdef PROBE_NOFB
        const bool fb = false;
#elif defined(PROBE_NOFB2)
        const bool fb = __builtin_amdgcn_readfirstlane((int)*fbflag) == 0x7fffffff;
#else
        const bool fb = __builtin_amdgcn_readfirstlane((int)*fbflag) != 0;
#endif
        if (!fb) {
            const int tb0 = (int)(hi ? tbin[2] : tbin[0]), tb1 = (int)(hi ? tbin[3] : tbin[1]);
            tile_pass(F, ksrc, kdst, kfr, koff, NT, qa, wp, [&](int kbase, float s0, float s1) {
#pragma unroll
                for (int t = 0; t < 2; ++t) {
                    const float s = t ? s1 : s0; const int bin = (int)__builtin_amdgcn_fmed3f(__builtin_fmaf(s, (t ? sc1 : sc0), 256.0f), 0.0f, 511.0f), tb = t ? tb1 : tb0;
                    const bool gt = bin > tb, eq = bin == tb;
                    const unsigned long long mg = __ballot(gt), me = __ballot(eq);
                    const unsigned mgh = hi ? (unsigned)(mg >> 32) : (unsigned)mg, meh = hi ? (unsigned)(me >> 32) : (unsigned)me;
                    const unsigned pos = (hi ? st.cnt[2 + t] : st.cnt[t]) + __builtin_popcount(mgh & below);
                    sel[(gt && pos < 256u) ? (2 * hi + t) * 256 + pos : 3200 + lane] = (unsigned short)(kbase + r);
                    const unsigned cpos = (hi ? st.tcnt[2 + t] : st.tcnt[t]) + __builtin_popcount(meh & below);
                    { LAS unsigned* cp = hist + ((eq && cpos < (unsigned)CAND_CAP) ? 2048 + ((2 * hi + t) * CAND_CAP + cpos) * 2 : 1700 + 2 * lane); cp[0] = okey(s); cp[1] = (unsigned)(kbase + r); }
                    st.cnt[t] += __builtin_popcount((unsigned)mg); st.cnt[2 + t] += __builtin_popcount((unsigned)(mg >> 32));
                    st.tcnt[t] += __builtin_popcount((unsigned)me); st.tcnt[2 + t] += __builtin_popcount((unsigned)(me >> 32));
                }
            });
#pragma unroll
            for (int ql = 0; ql < 4; ++ql) {
                const unsigned nc = bcn[ql], G = st.pre[ql], rq = st.need[ql];
                const LAS unsigned* cq = cand + ql * CAND_CAP * 2;
                unsigned ki4[4], xi4[4], rk4[4];
#pragma unroll
                for (int m = 0; m < 4; ++m) { const unsigned i = (unsigned)lane + 64u * m; ki4[m] = (i < nc) ? cq[2 * i] : 0u; xi4[m] = (i < nc) ? cq[2 * i + 1] : 0u; rk4[m] = 0u; }
                for (unsigned j = 0; j < nc; ++j) { const unsigned kj = cq[2 * j];
#pragma unroll
                    for (int m = 0; m < 4; ++m) rk4[m] += (kj > ki4[m] || (kj == ki4[m] && j < (unsigned)lane + 64u * m)) ? 1u : 0u; }
                unsigned base = G; const unsigned long long lt = (1ull << lane) - 1ull;
#pragma unroll
                for (int m = 0; m < 4; ++m) { const bool take = ((unsigned)lane + 64u * m < nc) && rk4[m] < rq; const unsigned long long mm = __ballot(take);
                    const unsigned pos = base + __builtin_popcountll(mm & lt); if (take && pos < 256u) sel[ql * 256 + pos] = (unsigned short)xi4[m]; base += __builtin_popcountll(mm); }
            }
        } else {
#pragma unroll
            for (int ql = 0; ql < 4; ++ql) { st.pre[ql] = 0u; st.need[ql] = 256u; st.cnt[ql] = 0u; st.tcnt[ql] = 0u; }
#pragma unroll 1
            for (int lev = 0; lev < 4; ++lev) {
#pragma unroll
                for (int j = 0; j < 8; ++j) hz[j * 64 + lane] = (v4u){0u, 0u, 0u, 0u};
                const unsigned pre0 = hi ? st.pre[2] : st.pre[0], pre1 = hi ? st.pre[3] : st.pre[1];
                const int sh = (lev == 0) ? 23 : (lev == 1) ? 14 : (lev == 2) ? 5 : 0, wd = (lev == 3) ? 5 : 9;
                tile_pass(F, ksrc, kdst, kfr, koff, NT, qa, wp, [&](int kbase, float s0, float s1) {
                    const unsigned k0 = okey(s0), k1 = okey(s1);
                    const unsigned b0 = (k0 >> sh) & ((1u << wd) - 1u), b1 = (k1 >> sh) & ((1u << wd) - 1u);
                    const bool in0 = (lev == 0) || ((k0 >> (sh + wd)) == pre0), in1 = (lev == 0) || ((k1 >> (sh + wd)) == pre1);
                    if (in0) __hip_atomic_fetch_add(hist + (2 * hi) * 512 + b0, 1u, __ATOMIC_RELAXED, __HIP_MEMORY_SCOPE_WORKGROUP);
                    if (in1) __hip_atomic_fetch_add(hist + (2 * hi + 1) * 512 + b1, 1u, __ATOMIC_RELAXED, __HIP_MEMORY_SCOPE_WORKGROUP);
                });
#pragma unroll
                for (int ql = 0; ql < 4; ++ql) { unsigned bin, above, bc; scan_hist_cnt(hist + ql * 512, lane, st.need[ql], bin, above, bc);
                    st.pre[ql] = (st.pre[ql] << wd) | bin; st.need[ql] -= above; }
                LDS_WAIT();
            }
            const unsigned T0 = hi ? st.pre[2] : st.pre[0], T1 = hi ? st.pre[3] : st.pre[1], rq0 = hi ? st.need[2] : st.need[0], rq1 = hi ? st.need[3] : st.need[1];
            tile_pass(F, ksrc, kdst, kfr, koff, NT, qa, wp, [&](int kbase, float s0, float s1) {
#pragma unroll
                for (int t = 0; t < 2; ++t) {
                    const unsigned kk = okey(t ? s1 : s0), T = t ? T1 : T0, rq = t ? rq1 : rq0;
                    const bool gt = kk > T, eq = kk == T;
                    const unsigned long long me = __ballot(eq);
                    const unsigned meh = hi ? (unsigned)(me >> 32) : (unsigned)me;
                    const unsigned trank = (hi ? st.tcnt[2 + t] : st.tcnt[t]) + __builtin_popcount(meh & below);
                    const bool take = gt || (eq && trank < rq);
                    const unsigned long long mt = __ballot(take);
                    const unsigned mth = hi ? (unsigned)(mt >> 32) : (unsigned)mt;
                    const unsigned pos = (hi ? st.cnt[2 + t] : st.cnt[t]) + __builtin_popcount(mth & below);
                    if (take && pos < 256u) sel[(2 * hi + t) * 256 + pos] = (unsigned short)(kbase + r);
                    st.cnt[t] += __builtin_popcount((unsigned)mt); st.cnt[2 + t] += __builtin_popcount((unsigned)(mt >> 32));
                    st.tcnt[t] += __builtin_popcount((unsigned)me); st.tcnt[2 + t] += __builtin_popcount((unsigned)(me >> 32));
                }
            });
        }
    }
    LDS_WAIT();
    { const LAS v4u* s4 = (const LAS v4u*)sel; v4u* g4 = (v4u*)(C.SEL + (rowbase + tq0) * 256);
#pragma unroll
      for (int j = 0; j < 2; ++j) g4[j * 64 + lane] = s4[j * 64 + lane]; }
    LDS_WAIT();
}
__device__ __forceinline__ void phase(Frame& F, const Ctx& C) {
    for (int v = F.vcu; v < 256; v += F.G) {
        const int b = v >> 6, c = v & 63;
#pragma unroll 1
        for (int it = 0; it < 4; ++it) step(F, C, b, (it < 2) ? c : 127 - c, it & 1);
    }
}
__device__ __forceinline__ void attn_phase(Frame& F, const Ctx& C) {
    int lane = F.lane; asm volatile("" : "+v"(lane));
    LAS unsigned short* sq = (LAS unsigned short*)(F.lds + RING_OFF + F.wave * 16384);
    const int nx = F.G / 32;
    for (int x = F.vcu / 32; x < 8; x += nx) {
        const int b = x >> 1, g0 = 2 * (x & 1); const long rowbase = (long)b * SEQ;
        const int w = (F.vcu & 31) * NWAVES + F.wave;
#pragma unroll 1
        for (int t = w; t < SEQ; t += 32 * NWAVES) {
            { const v4u* g4 = (const v4u*)(C.SEL + (rowbase + t) * 256); if (lane < 32) ((LAS v4u*)sq)[lane] = g4[lane]; }
            LDS_WAIT();
            const int N = 64 * ((t >> 6) + 1), nvalid = N < 256 ? N : 256;
            attend(C, sq, nvalid, rowbase, rowbase + t, t, lane, g0);
            LDS_WAIT();
        }
    }
}
}

namespace att8 {
typedef int v2i __attribute__((ext_vector_type(2)));
struct Ctx8 { const unsigned char* QA8; const unsigned char* KV8; const unsigned short* SEL; bf16* M; };
constexpr int T2_OFF = KS_OFF, T2_BYTES = 155 * 16 * 4, SELL_OFF = KS_OFF + 10240;
static_assert(T2_BYTES <= 10240 && SELL_OFF + NWAVES * 1024 <= AUX_OFF, "attention LDS map");
__device__ __forceinline__ void mfma8(f32x4& acc, long a, long b) { asm volatile("v_mfma_f32_16x16x32_fp8_fp8 %0, %1, %2, %0" : "+v"(acc) : "v"(a), "v"(b)); }
__device__ __forceinline__ unsigned pk4_fp8(float a, float b, float c, float d) { int r = __builtin_amdgcn_cvt_pk_fp8_f32(a, b, 0, false); r = __builtin_amdgcn_cvt_pk_fp8_f32(c, d, r, true); return (unsigned)r; }

__device__ __forceinline__ void gld16(v4u& dst, const void* p) { asm volatile("global_load_dwordx4 %0, %1, off" : "=v"(dst) : "v"(p) : "memory"); }
__device__ __forceinline__ void issue_kq(const Ctx8& C, const LAS unsigned short* sq, long rowbase, long token, int g, int l15, int l4, int h, v4u (&kr)[16], v4u& qv) {
    const unsigned char* kvb = C.KV8 + rowbase * 512 + g * 128 + 16 * l4;
#pragma unroll
    for (int j = 0; j < 16; ++j) gld16(kr[j], kvb + (long)sq[j * 16 + l15] * 512);
    gld16(qv, C.QA8 + token * 1024 + (4 * g + h) * 64 + 16 * l4);
}
__device__ __forceinline__ void issue_v_half(const Ctx8& C, const LAS unsigned short* sq, long rowbase, int g, int lane, unsigned vbase, int half) {
    const unsigned char* kvb = C.KV8 + rowbase * 512 + g * 128 + 64; const int kq = lane >> 2, p = lane & 3;
#pragma unroll
    for (int j = 0; j < 8; ++j) { const int ti = half * 8 + j; const int key = sq[ti * 16 + kq]; const int x = ((kq >> 2) & 1) | ((ti & 1) << 1);
        glds16(kvb + (long)key * 512 + 16 * (p ^ x), (unsigned)__builtin_amdgcn_readfirstlane(vbase + ti * 1024)); }
}
__device__ __forceinline__ void phase(Frame& F, const Ctx8& C, const float* t5) {
    int lane = F.lane; asm volatile("" : "+v"(lane));
    LAS float* T2 = (LAS float*)(F.lds + T2_OFF);
    for (int e = F.tid; e < 155 * 16; e += NWAVES * 64) { const int rel = (e >> 4) - 91, n = rel < 0 ? -rel : rel;
        const int bk = (rel > 0 ? 16 : 0) + (n < 8 ? n : 8 + (n >= 12) + (n >= 16) + (n >= 23) + (n >= 32) + (n >= 46) + (n >= 64) + (n >= 91));
        T2[e] = t5[bk * 16 + (e & 15)] * 8.0f; }
    __syncthreads();
    LAS unsigned short* sqb = (LAS unsigned short*)(F.lds + SELL_OFF + F.wave * 1024);
    LAS unsigned char* vreg = F.lds + RING_OFF + F.wave * 16384;
    const unsigned vbase = (unsigned)(uintptr_t)vreg;
    const int l15 = lane & 15, l4 = lane >> 4, h = l15 & 3;
    const int trk = 4 * l4 + ((l15 >> 1) & 3), trt = (l15 >> 3) & 1, xs = (l4 & 1) | (trt << 1);
    const int troff = trt * 1024 + trk * 64 + 8 * (l15 & 1);
    const int x = F.vcu / 32, b = x >> 1, g0 = 2 * (x & 1); const long rowbase = (long)b * SEQ;
    const int w = (F.vcu & 31) * NWAVES + F.wave;
    constexpr int NQ = SEQ / (32 * NWAVES), NI = 2 * NQ;
    if (lane < 32) { ((LAS v4u*)sqb)[lane] = ((const v4u*)(C.SEL + (rowbase + w) * 256))[lane]; ((LAS v4u*)(sqb + 256))[lane] = ((const v4u*)(C.SEL + (rowbase + w + 32 * NWAVES) * 256))[lane]; }
    LDS_WAIT();
    v4u kr[16], qv, pf = (v4u){0u, 0u, 0u, 0u};
    issue_kq(C, sqb, rowbase, rowbase + w, g0, l15, l4, h, kr, qv);
    issue_v_half(C, sqb, rowbase, g0, lane, vbase, 0); issue_v_half(C, sqb, rowbase, g0, lane, vbase, 1);
    unsigned cib[16];
#pragma unroll 1
    for (int idx = 0; idx < NI; ++idx) {
        const int qn = idx >> 1, gi = idx & 1, g = g0 + gi, t = w + 32 * NWAVES * qn;
        const LAS unsigned short* sq = sqb + (qn & 1) * 256;
        const int nidx = (idx + 1 < NI) ? idx + 1 : idx, nq = nidx >> 1, ng = g0 + (nidx & 1), nt = w + 32 * NWAVES * nq;
        const LAS unsigned short* nsq = sqb + (nq & 1) * 256;
        if (gi == 1) { asm volatile("s_waitcnt vmcnt(34)" : "+v"(pf) :: "memory"); if (lane < 32) ((LAS v4u*)(sqb + (qn & 1) * 256))[lane] = pf; }
        { const int pq = (qn + 2 < NQ) ? qn + 2 : NQ - 1; gld16(pf, (const v4u*)(C.SEL + (rowbase + w + 32 * NWAVES * pq) * 256) + (lane & 31)); }
        if (idx == 0) asm volatile("s_waitcnt vmcnt(0)" : "+v"(qv), "+v"(kr[0]), "+v"(kr[1]), "+v"(kr[2]), "+v"(kr[3]), "+v"(kr[4]), "+v"(kr[5]), "+v"(kr[6]), "+v"(kr[7]), "+v"(kr[8]), "+v"(kr[9]), "+v"(kr[10]), "+v"(kr[11]), "+v"(kr[12]), "+v"(kr[13]), "+v"(kr[14]), "+v"(kr[15]) :: "memory");
        else asm volatile("s_waitcnt vmcnt(20)" : "+v"(qv), "+v"(kr[0]), "+v"(kr[1]), "+v"(kr[2]), "+v"(kr[3]), "+v"(kr[4]), "+v"(kr[5]), "+v"(kr[6]), "+v"(kr[7]), "+v"(kr[8]), "+v"(kr[9]), "+v"(kr[10]), "+v"(kr[11]), "+v"(kr[12]), "+v"(kr[13]), "+v"(kr[14]), "+v"(kr[15]) :: "memory");
        if (gi == 0) {
#pragma unroll
            for (int ti = 0; ti < 16; ++ti) { const v2u i4 = *(const LAS v2u*)(sq + ti * 16 + 4 * l4);
                const int r0 = (int)(i4.x & 0xffffu) - t, r1 = (int)(i4.x >> 16) - t, r2 = (int)(i4.y & 0xffffu) - t, r3 = (int)(i4.y >> 16) - t;
                const int c0 = min(max(r0, -91), 63) + 91, c1 = min(max(r1, -91), 63) + 91, c2 = min(max(r2, -91), 63) + 91, c3 = min(max(r3, -91), 63) + 91;
                cib[ti] = (unsigned)c0 | ((unsigned)c1 << 8) | ((unsigned)c2 << 16) | ((unsigned)c3 << 24); }
        }
        const int N = 64 * ((t >> 6) + 1), nvalid = N < 256 ? N : 256;
        const long q0 = (long)(((unsigned long long)qv.y << 32) | qv.x), q1 = (long)(((unsigned long long)qv.w << 32) | qv.z);
        f32x4 S[16];
#pragma unroll
        for (int ti = 0; ti < 16; ++ti) { const unsigned cb = cib[ti];
            f32x4 a; a.x = T2[(cb & 255u) * 16 + 4 * g + h]; a.y = T2[((cb >> 8) & 255u) * 16 + 4 * g + h]; a.z = T2[((cb >> 16) & 255u) * 16 + 4 * g + h]; a.w = T2[(cb >> 24) * 16 + 4 * g + h];
            mfma8(a, (long)(((unsigned long long)kr[ti].y << 32) | kr[ti].x), q0);
            mfma8(a, (long)(((unsigned long long)kr[ti].w << 32) | kr[ti].z), q1);
            S[ti] = a; }
        asm volatile("s_nop 15\n\ts_nop 7" : "+v"(S[0]), "+v"(S[1]), "+v"(S[2]), "+v"(S[3]), "+v"(S[4]), "+v"(S[5]), "+v"(S[6]), "+v"(S[7]), "+v"(S[8]), "+v"(S[9]), "+v"(S[10]), "+v"(S[11]), "+v"(S[12]), "+v"(S[13]), "+v"(S[14]), "+v"(S[15]));
        issue_kq(C, nsq, rowbase, rowbase + nt, ng, l15, l4, h, kr, qv);
#pragma unroll
        for (int ti = 0; ti < 16; ++ti) if (ti * 16 >= nvalid) S[ti] = (f32x4){-INFINITY, -INFINITY, -INFINITY, -INFINITY};
        float mx = S[0].x;
#pragma unroll
        for (int ti = 0; ti < 16; ++ti) mx = fmaxf(fmaxf(mx, fmaxf(S[ti].x, S[ti].y)), fmaxf(S[ti].z, S[ti].w));
        mx = fmaxf(mx, __shfl_xor(mx, 16)); mx = fmaxf(mx, __shfl_xor(mx, 32));
        const float mc = -mx * C2; float ls = 0.f;
        long P8[8];
#pragma unroll
        for (int j = 0; j < 8; ++j) { float e[8];
#pragma unroll
            for (int q = 0; q < 4; ++q) { e[q] = __builtin_amdgcn_exp2f(__builtin_fmaf(S[2 * j][q], C2, mc)); e[4 + q] = __builtin_amdgcn_exp2f(__builtin_fmaf(S[2 * j + 1][q], C2, mc)); }
            ls += ((e[0] + e[1]) + (e[2] + e[3])) + ((e[4] + e[5]) + (e[6] + e[7]));
            const unsigned lo = pk4_fp8(e[0] * 256.f, e[1] * 256.f, e[2] * 256.f, e[3] * 256.f), hi = pk4_fp8(e[4] * 256.f, e[5] * 256.f, e[6] * 256.f, e[7] * 256.f);
            P8[j] = (long)(((unsigned long long)hi << 32) | lo); }
        ls += __shfl_xor(ls, 16); ls += __shfl_xor(ls, 32);
        f32x4 D[4];
#pragma unroll
        for (int db = 0; db < 4; ++db) D[db] = (f32x4){0.f, 0.f, 0.f, 0.f};
#pragma unroll
        for (int hf = 0; hf < 2; ++hf) {
            asm volatile("s_waitcnt vmcnt(28)" ::: "memory");
#pragma unroll
            for (int j = 4 * hf; j < 4 * hf + 4; ++j)
#pragma unroll
                for (int db = 0; db < 4; ++db) {
                    const v2i vv = __builtin_amdgcn_ds_read_tr8_b64_v2i32((LAS v2i*)(vreg + j * 2048 + troff + 16 * (db ^ xs)));
                    mfma8(D[db], P8[j], __builtin_bit_cast(long, vv)); }
            asm volatile("s_waitcnt lgkmcnt(0)" ::: "memory");
            issue_v_half(C, nsq, rowbase, ng, lane, vbase, hf);
        }
        asm volatile("s_nop 15\n\ts_nop 7" : "+v"(D[0]), "+v"(D[1]), "+v"(D[2]), "+v"(D[3]));
        const float lh = __shfl(ls, l4);
        const float inv = __builtin_amdgcn_rcpf(lh * 256.f);
        bf16* mp = C.M + (rowbase + t) * DM + (4 * g + l4) * 64 + l15;
#pragma unroll
        for (int db = 0; db < 4; ++db) { const float v = (l4 == 0) ? D[db].x : (l4 == 1) ? D[db].y : (l4 == 2) ? D[db].z : D[db].w; const unsigned short ob = (unsigned short)f2bf(v * inv);
            asm volatile("global_store_short %0, %1, off" :: "v"(mp + 16 * db), "v"((unsigned)ob) : "memory"); }
    }
    asm volatile("s_waitcnt vmcnt(0)" ::: "memory");
}
}

#ifndef REP_P0
#define REP_P0 1
#endif
#ifndef REP_IN
#define REP_IN 1
#endif
#ifndef REP_DSA
#define REP_DSA 1
#endif
#ifndef REP_BAND
#define REP_BAND 1
#endif
#ifndef REP_UP
#define REP_UP 1
#endif
#ifndef REP_FIX
#define REP_FIX 1
#endif
constexpr int N_PHASES = 1 + 6 * DEPTH;
#ifndef MK_N_LAUNCHES
#define MK_N_LAUNCHES 1
#endif
__global__ void __launch_bounds__(NWAVES * 64, 2) mega_fwd(Args args) {
    extern __shared__ __attribute__((aligned(16))) unsigned char lds[];
    Frame F;
    F.lds = (LAS unsigned char*)lds;
    F.MISC = (volatile LAS unsigned*)(F.lds + MISC_OFF);
    F.tid = threadIdx.x; F.lane = F.tid & 63; F.wave = __builtin_amdgcn_readfirstlane(F.tid >> 6);
    F.G = GRID; { const int bx = blockIdx.x; F.vcu = (bx & 7) * (GRID / 8) + (bx >> 3); }
    unsigned char* ws = args.ws;
    F.ctl = (gu32*)(ws + WS_CTL);
    for (int u = F.tid; u < (LDS_BYTES - LDSCTL_OFF) / 4; u += NWAVES * 64) ((LAS unsigned*)(F.lds + LDSCTL_OFF))[u] = 0u;
    __syncthreads();
    XcdBarrier bar; bar.bar = (unsigned*)(F.ctl + CW_BAR); bar.x = 0; bar.st = nullptr;
    if (MK_N_LAUNCHES == 1) bar = xcd_barrier_post((unsigned*)(F.ctl + CW_BAR), F.MISC + 8);
    const int lo = args.ph_lo, hi = args.ph_hi;
#define IN(k) (lo <= (k) && (k) < hi)
#define OPQ_FRAME(Fl) Frame Fl = F; { int l_; asm volatile("v_mbcnt_lo_u32_b32 %0, -1, 0\n\tv_mbcnt_hi_u32_b32 %0, -1, %0" : "=v"(l_)); int w_ = F.wave; asm volatile("" : "+s"(w_)); Fl.wave = w_; Fl.lane = l_; Fl.tid = w_ * 64 + l_; }
#define SEAM(k) do { if (IN(k) && IN((k) + 1)) xcd_barrier(bar); } while (0)

    bf16* hb = (bf16*)(ws + WS_HB); bf16* mb = (bf16*)(ws + WS_M); float* ss = (float*)(ws + WS_SS); float* halo = (float*)(ws + WS_HALO);
    unsigned char* proj = ws + WS_PROJ; bf16* act = (bf16*)(ws + WS_PROJ);

#ifndef SKIP_P0
    if (IN(0)) { for (int rep = 0; rep < REP_P0; ++rep) { OPQ_FRAME(F0); p0_prologue(F0, args); } }
#endif
    SEAM(0);

#pragma unroll 1
    for (int L = 0; L < DEPTH; ++L) {
        const int pb = 1 + 6 * L, li = L >> 1; const bool isB = (L & 1) != 0;
        if (IN(pb)) {
#ifndef SKIP_IN
            for (int rep = 0; rep < REP_IN; ++rep)
            if (!isB) {
                pg8::Gemm g{hb, (const bf16*)(ws + WS_W_INA) + (size_t)li * NA_PAD * DM, MTOK, NA_PAD, DM}; pg8::StaticOrder S; S.init(MTOK, NA_PAD, F.G, (int)blockIdx.x);
                EpiIn E{ss, proj, args.q_norm_g + L * 64, args.k_norm_g + L * 64, 0, 1.0f};
                pg8::gemm_phase<EpiIn, pg8::StaticOrder, true, true>(F.lds + RING_OFF, g, S, E, F.wave);
            } else {
                pg8::Gemm g{hb, (const bf16*)(ws + WS_W_INB) + (size_t)li * NB * DM, MTOK, NB, DM}; pg8::StaticOrder S; S.init(MTOK, NB, F.G, (int)blockIdx.x);
                if (L > F8_L0) { pg8::Gemm g8{(const bf16*)(ws + WS_M), (const bf16*)(ws + WS_W_INB) + (size_t)li * NB * DM, MTOK, NB, DM / 2};
                    EpiIn E{ss, proj, args.q_norm_g + L * 64, args.k_norm_g + L * 64, 1, W8I};
                    pg8::gemm_phase<EpiIn, pg8::StaticOrder, true, true, true>(F.lds + RING_OFF, g8, S, E, F.wave); }
                else { EpiIn E{ss, proj, args.q_norm_g + L * 64, args.k_norm_g + L * 64, 1, 1.0f};
                    pg8::gemm_phase<EpiIn, pg8::StaticOrder, true, true>(F.lds + RING_OFF, g, S, E, F.wave); }
            }
#endif
        }
        SEAM(pb);
#if defined(DBG_NODSA) || defined(DBG_NOBAND)
#ifdef DBG_NODSA
        const bool zero_m = !isB;
#else
        const bool zero_m = isB;
#endif
        if (IN(pb + 1) && zero_m) { for (size_t i = (size_t)blockIdx.x * 512 + threadIdx.x; i < (size_t)MTOK * DM / 8; i += (size_t)gridDim.x * 512) ((v4u*)mb)[i] = (v4u){0u, 0u, 0u, 0u}; }
        if (IN(pb + 1) && !zero_m) {
#else
        if (IN(pb + 1)) {
#endif
#ifndef SKIP_DSA
            if (!isB) {
                LAS float* t5l = (LAS float*)(F.lds + AUX_OFF);
                { OPQ_FRAME(Ft); for (int i = Ft.tid; i < 512; i += NWAVES * 64) t5l[i] = args.t5_bias[i] * LOG2E; }
                __syncthreads();
                dsa::Ctx C{(const bf16*)(proj + PA_QA), (const bf16*)(proj + PA_KA), (const bf16*)(proj + PA_VA), (const bf16*)(proj + PA_QI), (const bf16*)(proj + PA_KI), (const float*)(proj + PA_WI), mb, t5l, (unsigned short*)(proj + PA_SEL)};
#ifdef DBG_DSACOPY
                { int t_ = threadIdx.x; asm volatile("" : "+v"(t_));
                for (unsigned i = blockIdx.x * 512u + (unsigned)t_; i < (unsigned)MTOK * DM; i += gridDim.x * 512u) { const unsigned t = i >> 10, c = i & 1023u;
                    float v = bf_lo(C.QA[i]); v += bf_lo(C.KA[t * 256 + (c & 255)]); v += bf_lo(C.VA[t * 256 + (c & 255)]); v += bf_lo(C.QI[t * 512 + (c & 511)]); v += bf_lo(C.KI[t * 64 + (c & 63)]); v += C.WI[t * 8 + (c & 7)];
                    mb[i] = (bf16)f2bf(v * 0.01f); asm volatile("" ::: "memory"); } }
#else
                for (int rep = 0; rep < REP_DSA; ++rep) { OPQ_FRAME(F1); dsa::phase(F1, C); }
                xcd_barrier(bar);
                { OPQ_FRAME(F1b); att8::Ctx8 C8{(const unsigned char*)(proj + PA_QA), (const unsigned char*)(proj + PA_KA), (const unsigned short*)(proj + PA_SEL), mb};
#ifndef REP_ATT8
#define REP_ATT8 1
#endif
                  for (int rep = 0; rep < REP_ATT8; ++rep) { att8::phase(F1b, C8, args.t5_bias); __syncthreads(); } }
#endif
            }
#endif
#ifndef SKIP_BAND
            if (isB) {
                for (int rep = 0; rep < REP_BAND; ++rep) { OPQ_FRAME(F2); band::phase(F2, (const bf16*)proj, (const bf16*)(proj + PB_STRIDE), (const bf16*)(proj + 2 * PB_STRIDE), mb, args.rel_bias_b + (size_t)li * 513 * 16); }
            }
#endif
        }
        SEAM(pb + 1);
        if (IN(pb + 2)) {
#ifndef SKIP_OUT
            pg8::Gemm g{mb, (const bf16*)(ws + WS_W_OUT) + (size_t)L * DM * DM, MTOK, DM, DM}; pg8::StaticOrder S; S.init(MTOK, DM, F.G, (int)blockIdx.x);
#ifdef REP_OUT
            { EpiRes E0{L == 0 ? args.x : nullptr, nullptr, hb, (bf16*)proj, halo}; pg8::gemm_phase<EpiRes, pg8::StaticOrder, true, true>(F.lds + RING_OFF, g, S, E0, F.wave); }
#endif
            if (L >= F8_L0) { EpiResT<2> E{nullptr, nullptr, hb, hb, ss, proj + PX_HB8};
                pg8::gemm_phase<EpiResT<2>, pg8::StaticOrder, true, true>(F.lds + RING_OFF, g, S, E, F.wave); }
            else { EpiRes E{L == 0 ? args.x : nullptr, nullptr, hb, hb, ss};
                pg8::gemm_phase<EpiRes, pg8::StaticOrder, true, true>(F.lds + RING_OFF, g, S, E, F.wave); }
#endif
        }
        SEAM(pb + 2);
        if (IN(pb + 3)) {
#ifndef SKIP_UP
            for (int rep = 0; rep < REP_UP; ++rep) {
            pg8::Gemm g{hb, (const bf16*)(ws + WS_W_UP) + (size_t)L * NUP * DM, MTOK, NUP, DM}; pg8::StaticOrder S; S.init(MTOK, NUP, F.G, (int)blockIdx.x);
#ifdef PROBE_UPK
            { EpiDummy E0{halo}; pg8::gemm_phase<EpiDummy, pg8::StaticOrder, true, true>(F.lds + RING_OFF, g, S, E0, F.wave); }
#endif
            if (L >= F8_L0) { pg8::Gemm g8{(const bf16*)(proj + PX_HB8), (const bf16*)(ws + WS_W_UP) + (size_t)L * NUP * DM, MTOK, NUP, DM / 2};
                EpiUpT<true> E{ss, args.conv_w + (size_t)L * 3 * NUP, args.conv_b + (size_t)L * NUP, act, halo, (LAS float*)(F.lds + AUX_OFF)};
                pg8::gemm_phase<EpiUpT<true>, pg8::StaticOrder, true, true, true>(F.lds + RING_OFF, g8, S, E, F.wave); }
            else { EpiUp E{ss, args.conv_w + (size_t)L * 3 * NUP, args.conv_b + (size_t)L * NUP, act, halo, (LAS float*)(F.lds + AUX_OFF)};
                pg8::gemm_phase<EpiUp, pg8::StaticOrder, true, true>(F.lds + RING_OFF, g, S, E, F.wave); } }
#endif
        }
        SEAM(pb + 3);
#ifndef SKIP_FIX
        if (IN(pb + 4)) for (int rep = 0; rep < REP_FIX; ++rep) { OPQ_FRAME(F3); if (L >= F8_L0) fixup_phase<true>(F3, args.conv_w + (size_t)L * 3 * NUP, args.conv_b + (size_t)L * NUP, halo, act); else fixup_phase<false>(F3, args.conv_w + (size_t)L * 3 * NUP, args.conv_b + (size_t)L * NUP, halo, act); }
#endif
        SEAM(pb + 4);
        if (IN(pb + 5)) {
#ifndef SKIP_DN
            pg8::Gemm g{act, (const bf16*)(ws + WS_W_DN) + (size_t)L * DM * FF, MTOK, DM, FF}; pg8::StaticOrder S; S.init(MTOK, DM, F.G, (int)blockIdx.x);
#ifdef REP_DN
            { EpiRes E0{nullptr, nullptr, hb, mb, halo}; pg8::gemm_phase<EpiRes, pg8::StaticOrder, true, true>(F.lds + RING_OFF, g, S, E0, F.wave); }
#endif
            if (L >= F8_L0) { pg8::Gemm g8{act, (const bf16*)(ws + WS_W_DN) + (size_t)L * DM * FF, MTOK, DM, FF / 2};
                EpiResT<3> E{nullptr, L == DEPTH - 1 ? args.out : nullptr, hb, hb, ss, ws + WS_M};
                pg8::gemm_phase<EpiResT<3>, pg8::StaticOrder, true, true, true>(F.lds + RING_OFF, g8, S, E, F.wave); }
            else { EpiRes E{nullptr, L == DEPTH - 1 ? args.out : nullptr, hb, hb, ss};
                pg8::gemm_phase<EpiRes, pg8::StaticOrder, true, true>(F.lds + RING_OFF, g, S, E, F.wave); }
#endif
        }
        SEAM(pb + 5);
    }
#undef IN
#undef SEAM
}

extern "C" void kernel_launch(void* const* d_in, const int* in_sizes, int n_in, void* d_out, int out_size, void* d_ws, size_t ws_size, hipStream_t stream) {
    static int grid = 0;
    if (grid == 0) {
        if (n_in != 14 || in_sizes[0] != MTOK * DM || out_size != MTOK * DM || ws_size < WS_END) { fprintf(stderr, "kernel_launch: unexpected shapes / workspace (n_in %d, ws %zu); nothing launched\n", n_in, ws_size); grid = -1; return; }
        int dev = 0, cus = 0, per_cu = 0;
        if (hipGetDevice(&dev) != hipSuccess || hipDeviceGetAttribute(&cus, hipDeviceAttributeMultiprocessorCount, dev) != hipSuccess) { grid = -1; return; }
        if (hipFuncSetAttribute((const void*)mega_fwd, hipFuncAttributeMaxDynamicSharedMemorySize, LDS_BYTES) != hipSuccess) { fprintf(stderr, "kernel_launch: hipFuncSetAttribute failed\n"); grid = -1; return; }
        if (hipOccupancyMaxActiveBlocksPerMultiprocessor(&per_cu, (const void*)mega_fwd, NWAVES * 64, LDS_BYTES) != hipSuccess || per_cu < 1) { fprintf(stderr, "kernel_launch: occupancy query reports %d blocks per CU\n", per_cu); }
        (void)hipGetLastError();
        if (cus != GRID) { fprintf(stderr, "kernel_launch: built for a %d-CU device, found %d; nothing launched\n", GRID, cus); grid = -1; return; }
        grid = GRID;
    }
    if (grid < 0) return;
    if (hipMemsetAsync((char*)d_ws + WS_CTL, 0, CTL_ZERO_BYTES, stream) != hipSuccess) return;
    Args a{};
    a.x = (const float*)d_in[0]; a.attn_norm_g = (const float*)d_in[1]; a.w_in_a = (const float*)d_in[2]; a.w_in_b = (const float*)d_in[3]; a.q_norm_g = (const float*)d_in[4];
    a.k_norm_g = (const float*)d_in[5]; a.t5_bias = (const float*)d_in[6]; a.rel_bias_b = (const float*)d_in[7]; a.w_out = (const float*)d_in[8]; a.ffn_norm_g = (const float*)d_in[9];
    a.w_up = (const float*)d_in[10]; a.conv_w = (const float*)d_in[11]; a.conv_b = (const float*)d_in[12]; a.w_down = (const float*)d_in[13];
    a.out = (float*)d_out; a.ws = (unsigned char*)d_ws; a.pad = 0;
#if MK_N_LAUNCHES == 1
    a.ph_lo = 0; a.ph_hi = N_PHASES; a.li = 0;
    hipLaunchKernelGGL(mega_fwd, dim3(grid), dim3(NWAVES * 64), LDS_BYTES, stream, a);
#else
    for (int p = 0; p < N_PHASES; ++p) { a.ph_lo = p; a.ph_hi = p + 1; a.li = p; hipLaunchKernelGGL(mega_fwd, dim3(grid), dim3(NWAVES * 64), LDS_BYTES, stream, a); }
#endif
}
```

```cpp
#include <hip/hip_runtime.h>
#include <cstdio>
#include <cstdint>
namespace pg8 {
#define PG8_LAS __attribute__((address_space(3)))
typedef unsigned short bf16_t;
typedef short bf16x8 __attribute__((ext_vector_type(8)));
typedef float f32x4 __attribute__((ext_vector_type(4)));
typedef unsigned u32x4 __attribute__((ext_vector_type(4)));
typedef int i32x4 __attribute__((ext_vector_type(4)));
typedef int i32x8 __attribute__((ext_vector_type(8)));
constexpr int BM = 256, BK = 64, HALF = 128, HTB = HALF * BK * 2  , STAGE_BYTES = 8 * HTB, NXCD = 8, WGM = 8;

__host__ __device__ __forceinline__ int lds_byte(int r, int c) { const int st = (r >> 4) * 2 + (c >> 5), rr = r & 15, cc = c & 31, ob = rr * 64 + cc * 2; return st * 1024 + (ob ^ (((ob >> 9) & 1) << 5)); }
__host__ __device__ __forceinline__ void stage_rc(int b, int& R, int& C) { const int st = b / 1024, sb = b % 1024, swz = sb ^ (((sb >> 9) & 1) << 5); R = (st >> 1) * 16 + swz / 64; C = (st & 1) * 32 + (swz % 64) / 2; }
__host__ __device__ __forceinline__ int perm32(int rho) { const int n = rho >> 4, i = rho & 15; return 8 * (i >> 2) + 4 * n + (i & 3); }

struct Unit { int pm, pn; };
struct Gemm { const bf16_t* A; const bf16_t* Bt; int M, N, K; };

struct StaticOrder {
    int nM, nN, nwg, G, c;
    __host__ __device__ void init(int M, int N, int G_, int c_) { nM = M / BM; nN = N / BM; nwg = nM * nN; G = G_; c = c_; }
    __host__ __device__ bool next(int i, Unit& u) const {
        const long L = (long)i * G + c; if (L >= nwg) return false;
        int wgid = (int)L; { const int q = nwg / NXCD, r = nwg % NXCD, xcd = wgid % NXCD, off = wgid / NXCD; wgid = (xcd < r ? xcd * (q + 1) : r * (q + 1) + (xcd - r) * q) + off; }
        const int nig = WGM * nN, gid = wgid / nig, fm = gid * WGM, gsz = (nM - fm) < WGM ? (nM - fm) : WGM;
        u.pm = fm + ((wgid % nig) % gsz); u.pn = (wgid % nig) / gsz; return true;
    }
    __device__ __forceinline__ void a_ready(const Unit&) const {}
    __device__ __forceinline__ void done(const Unit&) const {}
};
__device__ __forceinline__ unsigned cvt_pk_bf16(float lo, float hi) { unsigned r; asm volatile("v_cvt_pk_bf16_f32 %0, %1, %2" : "=v"(r) : "v"(lo), "v"(hi)); return r; }
template <class Epi, class Sched, bool ALIGN_EPI = false, bool SP2 = false, bool F8 = false>
__device__ __forceinline__ void gemm_phase(PG8_LAS unsigned char* lds, const Gemm g, const Sched& S, const Epi& E, const int wave_id) {
    int lane_; asm volatile("v_mbcnt_lo_u32_b32 %0, -1, 0\n\tv_mbcnt_hi_u32_b32 %0, -1, %0" : "=v"(lane_));
    int wid_ = wave_id; asm volatile("" : "+s"(wid_));
    const int wid = wid_, lane = lane_, tid = wid * 64 + lane, wr = wid >> 2, wc = wid & 3, fr = lane & 15, fq = lane >> 4;
    const int K = g.K, nt = K / BK;
    unsigned voffA[2], voffB[2];
#pragma unroll
    for (int i = 0; i < 2; ++i) { int R, C; stage_rc(tid * 16 + i * 8192, R, C); const int Rb = Epi::PERM ? ((R & ~31) + perm32(R & 31)) : R;
        const int Ra = Epi::PERMA ? ((R & ~63) | (4 * (R & 15) + ((R >> 4) & 3))) : R;
        voffA[i] = (unsigned)(Ra * K + C) * 2u; voffB[i] = (unsigned)(Rb * K + C) * 2u; }
    const size_t kstep = (size_t)(BK * 2);
    const size_t hstep = (size_t)HALF * K * 2;
    const size_t tstep = 2 * hstep;
    const unsigned ldsw = (unsigned)wid * 1024u;
    const int aoff = lds_byte(wr * 64 + fr, fq * 8), boff = lds_byte(wc * 32 + fr, fq * 8);
#define PG8_SA(b, h) (((b) * 2 + (h)) * HTB)
#define PG8_SB(b, h) ((4 + (b) * 2 + (h)) * HTB)
#define PG8_STAGE(bufoff, gbase, voff) do { _Pragma("unroll") for (int _i = 0; _i < 2; ++_i) \
        __builtin_amdgcn_global_load_lds((const unsigned*)((const char*)(gbase) + (voff)[_i]), (PG8_LAS unsigned*)(lds + (bufoff) + ldsw + _i * 8192), 16, 0, 0); } while (0)
#define PG8_LDA(dst, b, h) do { _Pragma("unroll") for (int m = 0; m < 4; ++m) _Pragma("unroll") for (int k = 0; k < 2; ++k) dst[m][k] = *(const PG8_LAS bf16x8*)(lds + PG8_SA(b, h) + aoff + m * 2048 + k * 1024); } while (0)
#define PG8_LDB(dst, b, h) do { _Pragma("unroll") for (int n = 0; n < 2; ++n) _Pragma("unroll") for (int k = 0; k < 2; ++k) dst[n][k] = *(const PG8_LAS bf16x8*)(lds + PG8_SB(b, h) + boff + n * 2048 + k * 1024); } while (0)
#define PG8_CAT(lo, hi) __builtin_shufflevector(__builtin_bit_cast(i32x4, lo), __builtin_bit_cast(i32x4, hi), 0, 1, 2, 3, 4, 5, 6, 7)
#define PG8_MMA(ai, bj, At, Bt) do { __builtin_amdgcn_s_setprio(1); _Pragma("unroll") for (int m = 0; m < 4; ++m) _Pragma("unroll") for (int n = 0; n < 2; ++n) { \
        if constexpr (F8) { const i32x8 b8_ = PG8_CAT(Bt[n][0], Bt[n][1]), a8_ = PG8_CAT(At[m][0], At[m][1]); asm volatile("v_mfma_f32_16x16x128_f8f6f4 %0, %1, %2, %0" : "+v"(acc[ai][bj][m][n]) : "v"(b8_), "v"(a8_)); } \
        else { _Pragma("unroll") for (int k = 0; k < 2; ++k) acc[ai][bj][m][n] = __builtin_amdgcn_mfma_f32_16x16x32_bf16(Bt[n][k], At[m][k], acc[ai][bj][m][n], 0, 0, 0); } } __builtin_amdgcn_s_setprio(0); } while (0)
#define PG8_WAIT_V(n) asm volatile("s_waitcnt vmcnt(" #n ")" ::: "memory")
#define PG8_WAIT_L(n) asm volatile("s_waitcnt lgkmcnt(" #n ")" ::: "memory")
#define PG8_BAR __builtin_amdgcn_s_barrier()
#define PG8_SCHED __builtin_amdgcn_sched_barrier(0)
    Unit cur, nxt; int ui = 0;
    if (!S.next(0, cur)) return;
    f32x4 acc[2][2][4][2];
#pragma unroll
    for (int a = 0; a < 2; ++a)
#pragma unroll
        for (int b = 0; b < 2; ++b)
#pragma unroll
            for (int m = 0; m < 4; ++m)
#pragma unroll
                for (int n = 0; n < 2; ++n) acc[a][b][m][n] = (f32x4){0.f, 0.f, 0.f, 0.f};
    bf16x8 At[4][2], B0[2][2], B1[2][2];
    const char* cA = (const char*)g.A + (size_t)cur.pm * tstep; const char* cB = (const char*)g.Bt + (size_t)cur.pn * tstep;
    S.a_ready(cur);
    if constexpr (SP2) {
        PG8_STAGE(PG8_SB(0, 0), cB, voffB); PG8_STAGE(PG8_SB(0, 1), cB + hstep, voffB); PG8_STAGE(PG8_SA(0, 0), cA, voffA); PG8_STAGE(PG8_SA(0, 1), cA + hstep, voffA);
        if (wr == 1) PG8_BAR;
        PG8_WAIT_V(2); PG8_BAR;
        PG8_STAGE(PG8_SB(1, 0), cB + kstep, voffB); PG8_STAGE(PG8_SA(1, 0), cA + kstep, voffA); PG8_STAGE(PG8_SB(1, 1), cB + hstep + kstep, voffB);
        PG8_WAIT_V(6); PG8_BAR;
    } else {
        PG8_STAGE(PG8_SB(0, 0), cB, voffB); PG8_STAGE(PG8_SA(0, 0), cA, voffA); PG8_STAGE(PG8_SB(0, 1), cB + hstep, voffB); PG8_STAGE(PG8_SA(0, 1), cA + hstep, voffA);
        if (wr == 1) PG8_BAR;
        PG8_WAIT_V(4); PG8_BAR;
        PG8_STAGE(PG8_SB(1, 0), cB + kstep, voffB); PG8_STAGE(PG8_SA(1, 0), cA + kstep, voffA); PG8_STAGE(PG8_SB(1, 1), cB + hstep + kstep, voffB);
        PG8_WAIT_V(6); PG8_BAR;
    }
    for (;;) {
        const bool has_next = S.next(ui + 1, nxt);
        const char* nA = has_next ? (const char*)g.A + (size_t)nxt.pm * tstep : cA; const char* nB = has_next ? (const char*)g.Bt + (size_t)nxt.pn * tstep : cB;
        for (int t = 0; t < nt; t += 2) {
            const bool last = (t == nt - 2);
            const char* a1 = cA + (size_t)(t + 1) * kstep;
            const char* a2 = last ? nA : cA + (size_t)(t + 2) * kstep; const char* b2 = last ? nB : cB + (size_t)(t + 2) * kstep;
            const char* a3 = a2 + kstep; const char* b3 = b2 + kstep;
            if (last && has_next) S.a_ready(nxt);
            if constexpr (SP2) {
            PG8_LDB(B0, 0, 0); PG8_LDB(B1, 0, 1); PG8_SCHED; PG8_LDA(At, 0, 0); PG8_STAGE(PG8_SA(1, 1), a1 + hstep, voffA);
            PG8_WAIT_V(8); PG8_WAIT_L(0); PG8_BAR; PG8_MMA(0, 0, At, B0); PG8_MMA(0, 1, At, B1); PG8_BAR; PG8_SCHED;
            PG8_LDA(At, 0, 1); PG8_STAGE(PG8_SB(0, 0), b2, voffB); PG8_STAGE(PG8_SB(0, 1), b2 + hstep, voffB); PG8_STAGE(PG8_SA(0, 0), a2, voffA);
            PG8_WAIT_V(8); PG8_WAIT_L(0); PG8_BAR; PG8_MMA(1, 0, At, B0); PG8_MMA(1, 1, At, B1); PG8_BAR; PG8_SCHED;
            PG8_LDB(B0, 1, 0); PG8_LDB(B1, 1, 1); PG8_SCHED; PG8_LDA(At, 1, 0); PG8_STAGE(PG8_SA(0, 1), a2 + hstep, voffA);
            PG8_WAIT_V(8); PG8_WAIT_L(0); PG8_BAR; PG8_MMA(0, 0, At, B0); PG8_MMA(0, 1, At, B1); PG8_BAR; PG8_SCHED;
            PG8_LDA(At, 1, 1); PG8_STAGE(PG8_SB(1, 0), b3, voffB); PG8_STAGE(PG8_SB(1, 1), b3 + hstep, voffB); PG8_STAGE(PG8_SA(1, 0), a3, voffA);
            PG8_WAIT_V(8); PG8_WAIT_L(0); PG8_BAR; PG8_MMA(1, 0, At, B0); PG8_MMA(1, 1, At, B1); PG8_BAR; PG8_SCHED;
            } else {
            PG8_LDB(B0, 0, 0); PG8_SCHED; PG8_LDA(At, 0, 0); PG8_STAGE(PG8_SA(1, 1), a1 + hstep, voffA);
            PG8_WAIT_L(8); PG8_BAR; PG8_WAIT_L(0); PG8_MMA(0, 0, At, B0); PG8_BAR; PG8_SCHED;
            PG8_LDB(B1, 0, 1); PG8_STAGE(PG8_SB(0, 0), b2, voffB);
            PG8_BAR; PG8_WAIT_L(0); PG8_MMA(0, 1, At, B1); PG8_BAR;
            PG8_LDA(At, 0, 1); PG8_STAGE(PG8_SA(0, 0), a2, voffA);
            PG8_BAR; PG8_WAIT_L(0); PG8_MMA(1, 0, At, B0); PG8_BAR; PG8_SCHED;
            PG8_STAGE(PG8_SB(0, 1), b2 + hstep, voffB);
            PG8_WAIT_V(6); PG8_BAR; PG8_MMA(1, 1, At, B1); PG8_BAR;
            PG8_LDB(B0, 1, 0); PG8_SCHED; PG8_LDA(At, 1, 0); PG8_STAGE(PG8_SA(0, 1), a2 + hstep, voffA);
            PG8_WAIT_L(8); PG8_BAR; PG8_WAIT_L(0); PG8_MMA(0, 0, At, B0); PG8_BAR; PG8_SCHED;
            PG8_LDB(B1, 1, 1); PG8_STAGE(PG8_SB(1, 0), b3, voffB);
            PG8_BAR; PG8_WAIT_L(0); PG8_MMA(0, 1, At, B1); PG8_BAR;
            PG8_LDA(At, 1, 1); PG8_STAGE(PG8_SA(1, 0), a3, voffA);
            PG8_BAR; PG8_WAIT_L(0); PG8_MMA(1, 0, At, B0); PG8_BAR; PG8_SCHED;
            PG8_STAGE(PG8_SB(1, 1), b3 + hstep, voffB);
            PG8_WAIT_V(6); PG8_BAR; PG8_MMA(1, 1, At, B1); PG8_BAR;
            }
        }
        if constexpr (F8) asm volatile("s_nop 15\n\ts_nop 15" ::: "memory");
        if constexpr (ALIGN_EPI) { if (wr == 0) PG8_BAR; }
        if constexpr (!Epi::AFTER_DRAIN) { E(acc, cur, wr, wc, fr, fq); S.done(cur); }
        if (!has_next) break;
#pragma unroll
        for (int a = 0; a < 2; ++a)
#pragma unroll
            for (int b = 0; b < 2; ++b)
#pragma unroll
                for (int m = 0; m < 4; ++m)
#pragma unroll
                    for (int n = 0; n < 2; ++n) acc[a][b][m][n] = (f32x4){0.f, 0.f, 0.f, 0.f};
        cur = nxt; cA = nA; cB = nB; ++ui;
        if constexpr (ALIGN_EPI) { if (wr == 1) PG8_BAR; }
    }
    PG8_WAIT_V(0);
    if constexpr (!ALIGN_EPI) { if (wr == 0) PG8_BAR; }
    PG8_BAR;
    if constexpr (Epi::AFTER_DRAIN) { E.fused(acc, cur, wr, wc, fr, fq, lds, wid, lane); S.done(cur); }
#undef PG8_SA
#undef PG8_SB
#undef PG8_STAGE
#undef PG8_LDA
#undef PG8_LDB
#undef PG8_MMA
#undef PG8_CAT
#undef PG8_WAIT_V
#undef PG8_WAIT_L
#undef PG8_BAR
#undef PG8_SCHED
}
}

constexpr int NWAVES = 8, GRID = 256;
constexpr int BATCH = 4, SEQ = 8192, DM = 1024, MTOK = BATCH * SEQ, DEPTH = 4;
constexpr int NA_SRC = 2120, NA_PAD = 2304, NB = 3072, FF = 2816, NUP = 2 * FF;
constexpr float EPS = 1e-6f;
constexpr float LOG2E = 1.4426950408889634f;
constexpr float C2 = 0.125f * LOG2E;
constexpr int NBLK64 = MTOK / 64;

constexpr size_t MiB = 1u << 20;
constexpr size_t WS_CTL = 0, CTL_ZERO_BYTES = 1 * MiB;
constexpr size_t WS_W_INA = 2 * MiB;
constexpr size_t WS_W_INB = 11 * MiB;
constexpr size_t WS_W_OUT = 23 * MiB;
constexpr size_t WS_W_UP = 31 * MiB;
constexpr size_t WS_W_DN = 75 * MiB;
constexpr size_t WS_HB = 98 * MiB;
constexpr size_t WS_M = 162 * MiB;
constexpr size_t WS_SS = 226 * MiB;
constexpr size_t WS_HALO = 228 * MiB;
constexpr size_t WS_PROJ = 272 * MiB;
constexpr size_t WS_END = 464 * MiB;
constexpr size_t PA_QA = 0, PA_KA = 64 * MiB, PA_VA = 80 * MiB, PA_QI = 96 * MiB, PA_KI = 128 * MiB, PA_WI = 132 * MiB, PA_SEL = 136 * MiB;
constexpr size_t PB_STRIDE = 64 * MiB;
constexpr int CW_BAR = 4096;
constexpr int F8_L0 = 2;
constexpr size_t PX_HB8 = 96 * MiB;
constexpr float W8S = 128.f, W8I = 1.f / 128.f;

constexpr int RING_OFF = 0, RING_BYTES = 131072;
constexpr int KS_OFF = RING_BYTES;
constexpr int AUX_OFF = RING_BYTES + 24576;
constexpr int LDSCTL_OFF = AUX_OFF + 4096, MISC_OFF = LDSCTL_OFF + 320;
constexpr int LDS_BYTES = 163840;
static_assert(MISC_OFF + 128 <= LDS_BYTES, "LDS map");

#define GAS __attribute__((address_space(1)))
#define LAS __attribute__((address_space(3)))
typedef unsigned short bf16;
typedef unsigned v4u __attribute__((ext_vector_type(4)));
typedef unsigned v2u __attribute__((ext_vector_type(2)));
typedef float f32x4 __attribute__((ext_vector_type(4)));
typedef float f32x16 __attribute__((ext_vector_type(16)));
typedef short bf16x8 __attribute__((ext_vector_type(8)));
typedef short s16x4 __attribute__((ext_vector_type(4)));
typedef float f32x2_t __attribute__((ext_vector_type(2)));
typedef GAS unsigned gu32;
#define RLX_AGENT __ATOMIC_RELAXED, __HIP_MEMORY_SCOPE_AGENT
#define LDS_WAIT() asm volatile("s_waitcnt lgkmcnt(0)" ::: "memory")
#define VM_WAIT() asm volatile("s_waitcnt vmcnt(0)" ::: "memory")
__device__ __forceinline__ unsigned f2bf(float f) { unsigned u = __builtin_bit_cast(unsigned, f); return (u + 0x7fffu + ((u >> 16) & 1u)) >> 16; }
__device__ __forceinline__ unsigned pk2(float lo, float hi) { return f2bf(lo) | (f2bf(hi) << 16); }
typedef float f32x2c_t __attribute__((ext_vector_type(2))); typedef __bf16 bf16x2c_t __attribute__((ext_vector_type(2)));
__device__ __forceinline__ unsigned cvtpk(float lo, float hi) { const f32x2c_t v = {lo, hi}; const bf16x2c_t b = __builtin_convertvector(v, bf16x2c_t); return __builtin_bit_cast(unsigned, b); }
__device__ __forceinline__ float bf_lo(unsigned u) { return __builtin_bit_cast(float, u << 16); }
__device__ __forceinline__ float bf_hi(unsigned u) { return __builtin_bit_cast(float, u & 0xffff0000u); }

__device__ __forceinline__ unsigned pk4f8(float a, float b, float c, float d) { int r = __builtin_amdgcn_cvt_pk_fp8_f32(a, b, 0, false); r = __builtin_amdgcn_cvt_pk_fp8_f32(c, d, r, true); return (unsigned)r; }

#define XB_TMO      128
#define XB_XCNT(j)  (256  + 64 * (j))
#define XB_XSUB(j)  (1280 + 64 * (j))
#define XB_XGEN(j)  (2304 + 64 * (j))
#define XB_TOP      3328
#define XB_TOPGEN   3392
#define XCD_BAR_WORDS 3456
#define XB_SPIN_CAP (1u << 18)

__device__ __forceinline__ unsigned xb_ld(unsigned* p)              { return __hip_atomic_load(p, __ATOMIC_RELAXED, __HIP_MEMORY_SCOPE_AGENT); }
__device__ __forceinline__ unsigned xb_add(unsigned* p, unsigned v) { return __hip_atomic_fetch_add(p, v, __ATOMIC_RELAXED, __HIP_MEMORY_SCOPE_AGENT); }
__device__ __forceinline__ unsigned xb_xcc_id() { return (unsigned)__builtin_amdgcn_s_getreg((3 << 11) | 20) & 0xFu; }
#define XB_SPIN(cond, bar) do { unsigned _sp = 0; while (cond) { __builtin_amdgcn_s_sleep(1); \
    if ((++_sp & 255u) == 0u) { if (xb_ld(&(bar)[XB_TMO])) break; if (_sp > XB_SPIN_CAP) { atomicAdd(&(bar)[XB_TMO], 1u); break; } } } } while (0)

struct XcdBarrier {
    unsigned* bar; unsigned x;
    volatile LAS unsigned* st;
};

__device__ __forceinline__ XcdBarrier xcd_barrier_post(unsigned* bar, volatile LAS unsigned* st) {
    XcdBarrier b; b.bar = bar; b.x = xb_xcc_id(); b.st = st;
    if (threadIdx.x == 0) (void)xb_add(&bar[XB_XCNT(b.x)], 1u);
    return b;
}
__device__ __forceinline__ void xcd_barrier_complete(unsigned* bar, unsigned x, unsigned& nloc, unsigned& nx) {
    const unsigned G = gridDim.x * gridDim.y * gridDim.z;
    unsigned sum, cnt, mine, sp = 0u;
    for (;;) {
        sum = 0u; cnt = 0u; mine = 0u;
#pragma unroll
        for (unsigned j = 0; j < 16; ++j) { const unsigned c = xb_ld(&bar[XB_XCNT(j)]); sum += c; cnt += (c > 0u) ? 1u : 0u; mine = (j == x) ? c : mine; }
        if (sum == G) break;
        __builtin_amdgcn_s_sleep(1);
        if ((++sp & 255u) == 0u) { if (xb_ld(&bar[XB_TMO])) break; if (sp > XB_SPIN_CAP) { atomicAdd(&bar[XB_TMO], 1u); break; } }
    }
    nloc = mine > 0u ? mine : 1u; nx = cnt > 0u ? cnt : 1u;
}

__device__ __forceinline__ void xcd_barrier(const XcdBarrier& b) {
    asm volatile("s_waitcnt vmcnt(0)" ::: "memory");
    __syncthreads();
    if (threadIdx.x == 0) {
        unsigned* bar = b.bar;
        __builtin_amdgcn_s_waitcnt(0);
        unsigned nloc = b.st[0], nx = b.st[1];
        if (nloc == 0u) { xcd_barrier_complete(bar, b.x, nloc, nx); b.st[0] = nloc; b.st[1] = nx; }
        const unsigned old = xb_add(&bar[XB_XSUB(b.x)], 1u);
        const unsigned gen = old / nloc;
        if (old + 1u == (gen + 1u) * nloc) {
            __builtin_amdgcn_fence(__ATOMIC_RELEASE, "agent");
            asm volatile("s_waitcnt vmcnt(0)" ::: "memory");
            const unsigned og = xb_add(&bar[XB_TOP], 1u);
            const unsigned tg = og / nx;
            if (og + 1u == (tg + 1u) * nx) xb_add(&bar[XB_TOPGEN], 1u);
            else XB_SPIN(xb_ld(&bar[XB_TOPGEN]) == tg, bar);
            __builtin_amdgcn_fence(__ATOMIC_ACQUIRE, "agent");
            xb_add(&bar[XB_XGEN(b.x)], 1u);
            asm volatile("s_waitcnt vmcnt(0)" ::: "memory");
        } else {
            XB_SPIN(xb_ld(&bar[XB_XGEN(b.x)]) == gen, bar);
            __builtin_amdgcn_fence(__ATOMIC_ACQUIRE, "agent");
            asm volatile("s_waitcnt vmcnt(0)" ::: "memory");
        }
    }
    __syncthreads();
}


struct Args {
    const float* x; const float* attn_norm_g; const float* w_in_a; const float* w_in_b; const float* q_norm_g; const float* k_norm_g; const float* t5_bias;
    const float* rel_bias_b; const float* w_out; const float* ffn_norm_g; const float* w_up; const float* conv_w; const float* conv_b; const float* w_down;
    float* out; unsigned char* ws; int ph_lo, ph_hi, li, pad;
};

struct Frame {
    LAS unsigned char* lds;
    volatile LAS unsigned* MISC;
    gu32* ctl;
    int tid, lane, wave, vcu, G;
};

__host__ __device__ __forceinline__ int hmap(int p) { return 64 * ((p >> 5) & 3) + 16 * ((p >> 2) & 3) + 8 * (p >> 7) + 4 * ((p >> 4) & 1) + (p & 3); }
__host__ __device__ __forceinline__ int umap(int p) { return 32 * ((p >> 5) & 3) + 8 * ((p >> 2) & 3) + 4 * ((p >> 4) & 1) + (p & 3); }
__host__ __device__ __forceinline__ int src_col(int type, int n) {
    if (type == 0) return n;
    const int pn = n >> 8, p = n & 255;
    if (type == 2) return 256 * pn + hmap(p);
    if (type == 1) { const int c = hmap(p); return pn < 8 ? 256 * pn + c : (c < 72 ? 2048 + c : -1); }
    return (p >> 7) * FF + 128 * pn + umap(p);
}
__device__ __forceinline__ void convert_item(const float* W, int K, int Nsrc, int Ndst, int type, const float* gain, bf16* WT, LAS float* scr, int item, int lane, bool o8 = false) {
    const int nblk = Ndst / 32, kb = item / nblk, nb = item % nblk, k0 = 64 * kb, n0 = 32 * nb;
    const int sc = src_col(type, n0 + (lane & 31));
#pragma unroll 8
    for (int i = 0; i < 32; ++i) { const int kk = 2 * i + (lane >> 5); float v = 0.f; if (sc >= 0) v = W[(size_t)(k0 + kk) * Nsrc + sc]; if (gain) v *= gain[k0 + kk]; scr[kk * 33 + (lane & 31)] = v; }
    LDS_WAIT(); asm volatile("" ::: "memory");
    const int c = lane & 7;
#pragma unroll
    for (int j = 0; j < 4; ++j) { const int n = (lane >> 3) + 8 * j; const LAS float* s = scr + (8 * c) * 33 + n;
        if (o8) { v2u o; o.x = pk4f8(s[0 * 33] * W8S, s[1 * 33] * W8S, s[2 * 33] * W8S, s[3 * 33] * W8S); o.y = pk4f8(s[4 * 33] * W8S, s[5 * 33] * W8S, s[6 * 33] * W8S, s[7 * 33] * W8S);
            *(v2u*)((unsigned char*)WT + (size_t)(n0 + n) * K + k0 + 8 * c) = o; }
        else { v4u o; o.x = pk2(s[0 * 33], s[1 * 33]); o.y = pk2(s[2 * 33], s[3 * 33]); o.z = pk2(s[4 * 33], s[5 * 33]); o.w = pk2(s[6 * 33], s[7 * 33]);
            *(v4u*)(WT + (size_t)(n0 + n) * K + k0 + 8 * c) = o; } }
    LDS_WAIT(); asm volatile("" ::: "memory");
}
__device__ __forceinline__ float wave_sum(float v) {
#pragma unroll
    for (int o = 1; o < 64; o <<= 1) v += __shfl_xor(v, o);
    return v;
}
__device__ __forceinline__ void p0_prologue(Frame& F, const Args& a) {
    LAS float* scr = (LAS float*)(F.lds + RING_OFF + F.wave * 16384);
    const int gw = F.vcu * NWAVES + F.wave, NGW = F.G * NWAVES;
    constexpr int I_INA = 16 * (NA_PAD / 32), I_INB = 16 * (NB / 32), I_OUT = 16 * 32, I_UP = 16 * (NUP / 32), I_DN = (FF / 64) * 32;
    constexpr int NITEMS = 2 * I_INA + 2 * I_INB + 4 * I_OUT + 4 * I_UP + 4 * I_DN;
    unsigned char* ws = a.ws;
    for (int it = gw; it < NITEMS; it += NGW) {
        int r = it;
        if (r < 2 * I_INA) { const int l = r / I_INA; convert_item(a.w_in_a + (size_t)l * DM * NA_SRC, DM, NA_SRC, NA_PAD, 1, a.attn_norm_g + (2 * l) * DM, (bf16*)(ws + WS_W_INA) + (size_t)l * NA_PAD * DM, scr, r % I_INA, F.lane); continue; } r -= 2 * I_INA;
        if (r < 2 * I_INB) { const int l = r / I_INB; convert_item(a.w_in_b + (size_t)l * DM * NB, DM, NB, NB, 2, a.attn_norm_g + (2 * l + 1) * DM, (bf16*)(ws + WS_W_INB) + (size_t)l * NB * DM, scr, r % I_INB, F.lane, 2 * l + 1 > F8_L0); continue; } r -= 2 * I_INB;
        if (r < 4 * I_OUT) { const int l = r / I_OUT; convert_item(a.w_out + (size_t)l * DM * DM, DM, DM, DM, 0, nullptr, (bf16*)(ws + WS_W_OUT) + (size_t)l * DM * DM, scr, r % I_OUT, F.lane, l >= F8_L0); continue; } r -= 4 * I_OUT;
        if (r < 4 * I_UP) { const int l = r / I_UP; convert_item(a.w_up + (size_t)l * DM * NUP, DM, NUP, NUP, 3, a.ffn_norm_g + l * DM, (bf16*)(ws + WS_W_UP) + (size_t)l * NUP * DM, scr, r % I_UP, F.lane, l >= F8_L0); continue; } r -= 4 * I_UP;
        { const int l = r / I_DN; convert_item(a.w_down + (size_t)l * FF * DM, FF, DM, DM, 0, nullptr, (bf16*)(ws + WS_W_DN) + (size_t)l * DM * FF, scr, r % I_DN, F.lane, l >= F8_L0); }
    }
    bf16* hb = (bf16*)(ws + WS_HB); float* ss = (float*)(ws + WS_SS);
    for (int m = gw; m < MTOK; m += NGW) {
        const f32x4* xr = (const f32x4*)(a.x + (size_t)m * DM) + F.lane; f32x4 v[4]; float s = 0.f;
#pragma unroll
        for (int j = 0; j < 4; ++j) { v[j] = xr[64 * j]; s += (v[j].x * v[j].x + v[j].y * v[j].y) + (v[j].z * v[j].z + v[j].w * v[j].w); }
        s = wave_sum(s);
        v2u* o8 = (v2u*)(hb + (size_t)m * DM) + F.lane;
#pragma unroll
        for (int j = 0; j < 4; ++j) { v2u w; w.x = pk2(v[j].x, v[j].y); w.y = pk2(v[j].z, v[j].w); o8[64 * j] = w; }
        if (F.lane < 16) ss[(size_t)m * 16 + F.lane] = (F.lane == 0) ? s : 0.f;
    }
}

__device__ __forceinline__ f32x4 rstd_load(const float* ss, int row, int fq) { return *(const f32x4*)(ss + (size_t)row * 16 + 4 * fq); }
__device__ __forceinline__ float rstd_finish(f32x4 a) {
    float s = (a.x + a.y) + (a.z + a.w);
    s += __shfl_xor(s, 16); s += __shfl_xor(s, 32);
    return __builtin_amdgcn_rsqf(s * (1.0f / DM) + EPS);
}
__device__ __forceinline__ float row_rstd(const float* ss, int row, int fq) { return rstd_finish(rstd_load(ss, row, fq)); }
__device__ __forceinline__ unsigned att_pk4(f32x4 v) { int r = __builtin_amdgcn_cvt_pk_fp8_f32(v.x, v.y, 0, false); r = __builtin_amdgcn_cvt_pk_fp8_f32(v.z, v.w, r, true); return (unsigned)r; }
struct EpiIn {
    static constexpr bool PERM = false, PERMA = false, AFTER_DRAIN = false;
    const float* ss; unsigned char* proj; const float* qg; const float* kg; int isB; float as;
    __device__ __forceinline__ void operator()(const pg8::f32x4 (&acc)[2][2][4][2], const pg8::Unit& u, int wr, int wc, int fr, int fq) const {
        asm volatile("" : "+v"(fr), "+v"(fq));
        const int pn = u.pn; int kind, pitch; bf16* dst;
        if (isB) { const int t = pn >> 2; kind = (t == 0) ? 1 : (t == 1 ? 2 : 0); dst = (bf16*)(proj + (size_t)t * PB_STRIDE) + 256 * (pn & 3); pitch = DM; }
        else if (pn < 4) { kind = 1; dst = (bf16*)(proj + PA_QA) + 256 * pn; pitch = DM; }
        else if (pn == 4) { kind = 2; dst = (bf16*)(proj + PA_KA); pitch = 256; }
        else if (pn == 5) { kind = 0; dst = (bf16*)(proj + PA_VA); pitch = 256; }
        else if (pn < 8) { kind = 0; dst = (bf16*)(proj + PA_QI) + 256 * (pn - 6); pitch = 512; }
        else { kind = 3; dst = (bf16*)(proj + PA_KI); pitch = 64; }
        if (kind == 3 && wc >= 2) return;
        const bool donorm = (kind == 1) || (kind == 2) || (kind == 3 && wc == 0);
        f32x4 g[2][2];
#pragma unroll
        for (int bj = 0; bj < 2; ++bj)
#pragma unroll
            for (int n = 0; n < 2; ++n) {
                if (kind == 1) g[bj][n] = *(const f32x4*)(qg + 16 * fq + 8 * bj + 4 * n) * (isB ? C2 : 1.0f);
                else if (kind == 2) g[bj][n] = *(const f32x4*)(kg + 16 * fq + 8 * bj + 4 * n);
                else g[bj][n] = (f32x4){1.f, 1.f, 1.f, 1.f};
            }
        float* wi = (float*)(proj + PA_WI);
        f32x4 rsl[2][4];
#pragma unroll
        for (int ai = 0; ai < 2; ++ai)
#pragma unroll
            for (int m = 0; m < 4; ++m) rsl[ai][m] = rstd_load(ss, u.pm * 256 + ai * 128 + wr * 64 + m * 16 + fr, fq);
#pragma unroll
        for (int ai = 0; ai < 2; ++ai)
#pragma unroll
            for (int m = 0; m < 4; ++m) {
                const int row = u.pm * 256 + ai * 128 + wr * 64 + m * 16 + fr;
                const float rs = rstd_finish(rsl[ai][m]) * as;
                f32x4 v[2][2]; float s = 0.f;
#pragma unroll
                for (int bj = 0; bj < 2; ++bj)
#pragma unroll
                    for (int n = 0; n < 2; ++n) { v[bj][n] = acc[ai][bj][m][n] * rs; const f32x4 q = v[bj][n] * v[bj][n]; s += (q.x + q.y) + (q.z + q.w); }
                if (donorm) {
                    s += __shfl_xor(s, 16); s += __shfl_xor(s, 32);
                    const float r = 1.0f / sqrtf(s * (1.0f / 64.0f) + EPS);
#pragma unroll
                    for (int bj = 0; bj < 2; ++bj)
#pragma unroll
                        for (int n = 0; n < 2; ++n) v[bj][n] = v[bj][n] * r * g[bj][n];
                }
                if (kind == 3 && wc == 1) {
                    if (fq == 0) { float* wp = wi + (size_t)row * 8; const float sc = 0.04419417382415922f;
                        *(f32x4*)(wp) = v[0][0] * sc; *(f32x4*)(wp + 4) = v[0][1] * sc; }
                } else if (!isB && pn < 6) {
                    unsigned char* p8 = (pn < 4) ? proj + PA_QA + (size_t)row * 1024 + 256 * pn + 64 * wc + 16 * fq : proj + PA_KA + (size_t)row * 512 + 128 * wc + 64 * (pn - 4) + 16 * fq;
                    v4u w; w.x = att_pk4(v[0][0]); w.y = att_pk4(v[0][1]); w.z = att_pk4(v[1][0]); w.w = att_pk4(v[1][1]);
                    *(v4u*)p8 = w;
                } else {
                    bf16* rp = dst + (size_t)row * pitch + 64 * wc + 16 * fq;
#pragma unroll
                    for (int bj = 0; bj < 2; ++bj) { v4u w; w.x = cvtpk(v[bj][0].x, v[bj][0].y); w.y = cvtpk(v[bj][0].z, v[bj][0].w); w.z = cvtpk(v[bj][1].x, v[bj][1].y); w.w = cvtpk(v[bj][1].z, v[bj][1].w);
                        *(v4u*)(rp + 8 * bj) = w; }
                }
            }
    }
};
template <int MODE>
struct EpiResT {
    static constexpr bool PERM = false, PERMA = false, AFTER_DRAIN = false;
    const float* xin; float* fout; const bf16* hbi; bf16* hb; float* ss; unsigned char* hb8;
    __device__ __forceinline__ void operator()(const pg8::f32x4 (&acc)[2][2][4][2], const pg8::Unit& u, int wr, int wc, int fr, int fq) const {
        asm volatile("" : "+v"(fr), "+v"(fq));
        const int col0 = u.pn * 256 + wc * 32 + 4 * fq;
#pragma unroll
        for (int ai = 0; ai < 2; ++ai) {
            f32x4 base[4][2][2];
#pragma unroll
            for (int m = 0; m < 4; ++m)
#pragma unroll
                for (int bj = 0; bj < 2; ++bj)
#pragma unroll
                    for (int n = 0; n < 2; ++n) { const size_t o4 = (size_t)(u.pm * 256 + ai * 128 + wr * 64 + m * 16 + fr) * DM + col0 + bj * 128 + n * 16;
                        if (xin) base[m][bj][n] = *(const f32x4*)(xin + o4); else { const v2u b = *(const v2u*)(hbi + o4); base[m][bj][n] = (f32x4){bf_lo(b.x), bf_hi(b.x), bf_lo(b.y), bf_hi(b.y)}; } }
            asm volatile("" ::: "memory");
#pragma unroll
            for (int m = 0; m < 4; ++m) {
                const int row = u.pm * 256 + ai * 128 + wr * 64 + m * 16 + fr; const size_t off = (size_t)row * DM + col0; float s = 0.f;
#pragma unroll
                for (int bj = 0; bj < 2; ++bj)
#pragma unroll
                    for (int n = 0; n < 2; ++n) { const size_t o4 = off + bj * 128 + n * 16;
                        const f32x4 o = (MODE & 1) ? base[m][bj][n] + acc[ai][bj][m][n] * W8I : base[m][bj][n] + acc[ai][bj][m][n];
                        if (fout) *(f32x4*)(fout + o4) = o;
                        else { const f32x4 q = o * o; s += (q.x + q.y) + (q.z + q.w); v2u w; w.x = cvtpk(o.x, o.y); w.y = cvtpk(o.z, o.w); *(v2u*)(hb + o4) = w;
                            if constexpr (MODE & 2) *(unsigned*)(hb8 + o4) = pk4f8(o.x, o.y, o.z, o.w); } }
                if (!fout) { s += __shfl_xor(s, 16); s += __shfl_xor(s, 32); if (fq == 0) ss[(size_t)row * 16 + u.pn * 4 + wc] = s; }
            }
        }
    }
};
typedef EpiResT<0> EpiRes;
#ifdef X_NOBPERM
__device__ __forceinline__ float lane_from(int byteaddr, float v) { return v + (float)byteaddr; }
#else
__device__ __forceinline__ float lane_from(int byteaddr, float v) { return __builtin_bit_cast(float, __builtin_amdgcn_ds_bpermute(byteaddr, __builtin_bit_cast(int, v))); }
#endif
#ifdef X_NOSILU
__device__ __forceinline__ float silu_mul(float a, float g) { return a * g; }
#else
__device__ __forceinline__ float silu_mul(float a, float g) { return a * g * __builtin_amdgcn_rcpf(1.0f + __builtin_amdgcn_exp2f(-g * LOG2E)); }
#endif
__device__ __forceinline__ float dpp_prev_lane(float v) { return __builtin_bit_cast(float, __builtin_amdgcn_update_dpp(0, __builtin_bit_cast(int, v), 0x111  , 0xf, 0xf, true)); }
template <bool F8>
struct EpiUpT {
    static constexpr bool PERM = false, PERMA = true, AFTER_DRAIN = false;
    const float* ss; const float* cw; const float* cb; bf16* act; float* halo; LAS float* cl;
    __device__ __forceinline__ void operator()(const pg8::f32x4 (&acc)[2][2][4][2], const pg8::Unit& u, int wr, int wc, int fr, int fq) const {
        asm volatile("" : "+v"(fr), "+v"(fq));
        const int colb = u.pn * 128 + wc * 32 + 8 * fq;
        const int tid_ = ((wr * 4 + wc) * 4 + fq) * 16 + fr, ce = 2 * tid_, cbj = ce >> 9, carr = (ce >> 7) & 3, cc = ce & 127;
        const f32x2_t cpre = *(const f32x2_t*)((carr < 3 ? cw + carr * NUP : cb) + cbj * FF + u.pn * 128 + cc);
        f32x4 rsl[2][4];
#pragma unroll
        for (int ai = 0; ai < 2; ++ai)
#pragma unroll
            for (int m = 0; m < 4; ++m) rsl[ai][m] = rstd_load(ss, (u.pm * 4 + ai * 2 + wr) * 64 + 4 * fr + m, fq);
        unsigned pk[2][2][4][2][2];
#pragma unroll
        for (int ai = 0; ai < 2; ++ai) {
#pragma unroll
            for (int m = 0; m < 4; ++m) {
                const float rs = F8 ? rstd_finish(rsl[ai][m]) * W8I : rstd_finish(rsl[ai][m]);
#pragma unroll
                for (int bj = 0; bj < 2; ++bj)
#pragma unroll
                    for (int n = 0; n < 2; ++n) { const f32x4 v = acc[ai][bj][m][n] * rs; pk[ai][bj][m][n][0] = cvtpk(v.x, v.y); pk[ai][bj][m][n][1] = cvtpk(v.z, v.w); }
            }
        }
        *(LAS f32x2_t*)(cl + ce) = cpre;
        asm volatile("s_waitcnt lgkmcnt(0)" ::: "memory"); __builtin_amdgcn_s_barrier(); asm volatile("" ::: "memory");
        __builtin_amdgcn_sched_barrier(0);
        if (fr == 0 || fr == 15) {
#pragma unroll
            for (int ai = 0; ai < 2; ++ai)
#pragma unroll
                for (int j = 0; j < 2; ++j)
#pragma unroll
                    for (int bj = 0; bj < 2; ++bj)
#pragma unroll
                        for (int n = 0; n < 2; ++n) { const unsigned w0 = (fr == 0) ? pk[ai][bj][j][n][0] : pk[ai][bj][2 + j][n][0], w1 = (fr == 0) ? pk[ai][bj][j][n][1] : pk[ai][bj][2 + j][n][1];
                            *(f32x4*)(halo + ((size_t)(u.pm * 4 + ai * 2 + wr) * 4 + (fr == 0 ? j : 2 + j)) * NUP + bj * FF + colb + 4 * n) = (f32x4){bf_lo(w0), bf_hi(w0), bf_lo(w1), bf_hi(w1)}; }
        }
        __builtin_amdgcn_sched_barrier(0);
#pragma unroll
        for (int ai = 0; ai < 2; ++ai) {
            const int row0 = (u.pm * 4 + ai * 2 + wr) * 64 + 4 * fr;
            unsigned outp[4][2][2];
#pragma unroll
            for (int n = 0; n < 2; ++n) {
#pragma unroll
                for (int ip = 0; ip < 2; ++ip) {
                    f32x2_t k0[2], k1[2], k2[2], kb[2];
#pragma unroll
                    for (int bj = 0; bj < 2; ++bj) { const LAS float* c = cl + bj * 512 + wc * 32 + 8 * fq + 4 * n + 2 * ip; k0[bj] = *(const LAS f32x2_t*)(c); k1[bj] = *(const LAS f32x2_t*)(c + 128); k2[bj] = *(const LAS f32x2_t*)(c + 256); kb[bj] = *(const LAS f32x2_t*)(c + 384); }
                    float y[2][4][2];
#pragma unroll
                    for (int bj = 0; bj < 2; ++bj) {
                        const unsigned w0 = pk[ai][bj][0][n][ip], w1 = pk[ai][bj][1][n][ip], w2 = pk[ai][bj][2][n][ip], w3 = pk[ai][bj][3][n][ip];
                        const unsigned q1 = (unsigned)__builtin_amdgcn_update_dpp(0, (int)w3, 0x111, 0xf, 0xf, true), q2 = (unsigned)__builtin_amdgcn_update_dpp(0, (int)w2, 0x111, 0xf, 0xf, true);
#pragma unroll
                        for (int e = 0; e < 2; ++e) { const int i = e;
                            const float u0 = e ? bf_hi(w0) : bf_lo(w0), u1 = e ? bf_hi(w1) : bf_lo(w1), u2 = e ? bf_hi(w2) : bf_lo(w2), u3 = e ? bf_hi(w3) : bf_lo(w3), p1 = e ? bf_hi(q1) : bf_lo(q1), p2 = e ? bf_hi(q2) : bf_lo(q2);
                            y[bj][0][e] = kb[bj][i] + k0[bj][i] * p2 + k1[bj][i] * p1 + k2[bj][i] * u0;
                            y[bj][1][e] = kb[bj][i] + k0[bj][i] * p1 + k1[bj][i] * u0 + k2[bj][i] * u1;
                            y[bj][2][e] = kb[bj][i] + k0[bj][i] * u0 + k1[bj][i] * u1 + k2[bj][i] * u2;
                            y[bj][3][e] = kb[bj][i] + k0[bj][i] * u1 + k1[bj][i] * u2 + k2[bj][i] * u3; }
                    }
#pragma unroll
                    for (int m = 0; m < 4; ++m) {
                        if constexpr (F8) { if (ip == 0) outp[m][n][0] = (unsigned)__builtin_amdgcn_cvt_pk_fp8_f32(silu_mul(y[0][m][0], y[1][m][0]), silu_mul(y[0][m][1], y[1][m][1]), 0, false);
                            else outp[m][n][0] = (unsigned)__builtin_amdgcn_cvt_pk_fp8_f32(silu_mul(y[0][m][0], y[1][m][0]), silu_mul(y[0][m][1], y[1][m][1]), (int)outp[m][n][0], true); }
                        else outp[m][n][ip] = cvtpk(silu_mul(y[0][m][0], y[1][m][0]), silu_mul(y[0][m][1], y[1][m][1])); }
                }
            }
#pragma unroll
            for (int m = 0; m < 4; ++m) {
                if (m < 2 && fr == 0) continue;
                if constexpr (F8) { v2u w; w.x = outp[m][0][0]; w.y = outp[m][1][0]; *(v2u*)((unsigned char*)act + (size_t)(row0 + m) * FF + colb) = w; }
                else { v4u w; w.x = outp[m][0][0]; w.y = outp[m][0][1]; w.z = outp[m][1][0]; w.w = outp[m][1][1];
                    *(v4u*)(act + (size_t)(row0 + m) * FF + colb) = w; }
            }
            asm volatile("" ::: "memory");
        }
    }
};
typedef EpiUpT<false> EpiUp;
struct EpiDummy {
    static constexpr bool PERM = false, PERMA = true, AFTER_DRAIN = false;
    float* scratch;
    __device__ __forceinline__ void operator()(const pg8::f32x4 (&acc)[2][2][4][2], const pg8::Unit& u, int wr, int wc, int fr, int fq) const {
        f32x4 s = (f32x4){0.f, 0.f, 0.f, 0.f};
#pragma unroll
        for (int ai = 0; ai < 2; ++ai)
#pragma unroll
            for (int bj = 0; bj < 2; ++bj)
#pragma unroll
                for (int m = 0; m < 4; ++m)
#pragma unroll
                    for (int n = 0; n < 2; ++n) s += acc[ai][bj][m][n];
        scratch[(size_t)(u.pm * 22 + u.pn) * 512 + ((wr * 4 + wc) * 4 + fq) * 16 + fr] = (s.x + s.y) + (s.z + s.w);
    }
};
template <bool F8>
__device__ __forceinline__ void fixup_phase(Frame& F, const float* cw, const float* cb, const float* halo, bf16* act) {
    const int gt = F.vcu * (NWAVES * 64) + F.tid, NT = F.G * NWAVES * 64;
    constexpr int C4 = FF / 4;
    for (int it = gt; it < NBLK64 * 2 * C4; it += NT) {
        const int c = (it % C4) * 4, rj = it / C4, j = rj & 1, blk = rj >> 1, t = blk * 64 + j, tb = t % SEQ;
        f32x4 y[2];
#pragma unroll
        for (int bj = 0; bj < 2; ++bj) {
            const int cc = bj * FF + c;
            const f32x4 z = (f32x4){0.f, 0.f, 0.f, 0.f};
            const f32x4 ut = *(const f32x4*)(halo + ((size_t)blk * 4 + j) * NUP + cc);
            f32x4 u1, u2;
            if (j == 1) { u1 = *(const f32x4*)(halo + ((size_t)blk * 4 + 0) * NUP + cc); u2 = (tb == 1) ? z : *(const f32x4*)(halo + ((size_t)(blk - 1) * 4 + 3) * NUP + cc); }
            else { u1 = (tb == 0) ? z : *(const f32x4*)(halo + ((size_t)(blk - 1) * 4 + 3) * NUP + cc); u2 = (tb == 0) ? z : *(const f32x4*)(halo + ((size_t)(blk - 1) * 4 + 2) * NUP + cc); }
            y[bj] = *(const f32x4*)(cb + cc) + *(const f32x4*)(cw + cc) * u2 + *(const f32x4*)(cw + NUP + cc) * u1 + *(const f32x4*)(cw + 2 * NUP + cc) * ut;
        }
        if constexpr (F8) *(unsigned*)((unsigned char*)act + (size_t)t * FF + c) = pk4f8(silu_mul(y[0].x, y[1].x), silu_mul(y[0].y, y[1].y), silu_mul(y[0].z, y[1].z), silu_mul(y[0].w, y[1].w));
        else { v2u w; w.x = cvtpk(silu_mul(y[0].x, y[1].x), silu_mul(y[0].y, y[1].y)); w.y = cvtpk(silu_mul(y[0].z, y[1].z), silu_mul(y[0].w, y[1].w));
            *(v2u*)(act + (size_t)t * FF + c) = w; }
    }
}

__device__ __forceinline__ int crow(int r, int hi) { return (r & 3) + 8 * (r >> 2) + 4 * hi; }
__device__ __forceinline__ void glds16(const void* gsrc, unsigned lds_dst) { unsigned keep;
    asm volatile("s_mov_b32 %0, m0\n\ts_mov_b32 m0, %2\n\ts_nop 0\n\tglobal_load_lds_dwordx4 %1, off\n\ts_mov_b32 m0, %0" : "=&s"(keep) : "v"(gsrc), "s"(lds_dst) : "memory"); }
__device__ __forceinline__ float max3f(float a, float b, float c) { return fmaxf(fmaxf(a, b), c); }

namespace band {
constexpr int SLOTB = 8192;
constexpr int LDS_K = 0, LDS_V = 2 * SLOTB, LDS_WS = 4 * SLOTB, LDS_TB = LDS_WS + NWAVES * 64 * 4, LDS_OST = LDS_TB + 640 * 4 + 512, LDS_END = LDS_OST + NWAVES * 4096;
static_assert(LDS_END <= RING_BYTES, "band LDS");
__device__ __forceinline__ void unit(Frame& F, int b, int h, int U, const bf16* Q, const bf16* K, const bf16* V, bf16* O, const float* rel, const bool o8) {
    const int tid = F.tid, lane = F.lane, r32 = lane & 31, hi = lane >> 5, wid = F.wave;
    LAS unsigned char* shm = F.lds + RING_OFF;
    const unsigned lds0 = (unsigned)(uintptr_t)shm;
    const long rowbase = (long)b * SEQ; const int q0 = U * 256, c0 = 4 * U, cq = c0 + (wid >> 1);
    const bf16* Qw = Q + (rowbase + q0 + wid * 32) * DM + h * 64;
    const bf16* Kh = K + rowbase * DM + h * 64; const bf16* Vh = V + rowbase * DM + h * 64;
    LAS float* wsf = (LAS float*)(shm + LDS_WS) + wid * 64;
    LAS float* tb = (LAS float*)(shm + LDS_TB);
    const bf16* ksrc = Kh + (long)lane * DM + wid * 8;
    const bf16* vsrc = Vh + (long)(16 * (wid & 3) + (lane >> 2)) * DM + (wid >> 2) * 32 + (lane & 3) * 8;
    const unsigned kdst = lds0 + LDS_K + wid * 1024, vdst = lds0 + LDS_V + wid * 1024;
    const int lo = (c0 - 8 > 0) ? c0 - 8 : 0, hiT = c0 + 3, NT = hiT - lo + 1, t0 = (c0 - 5 > 0) ? c0 - 5 : 0;
#define BAND_KT(i) ((t0 + (i) <= hiT) ? t0 + (i) : lo + (t0 + (i) - hiT - 1))
    for (int i = tid; i < 640; i += NWAVES * 64) { int d = i - 64; d = d < -256 ? -256 : (d > 256 ? 256 : d); tb[i] = rel[(d + 256) * 16 + h] * LOG2E; }
    { const int kt = BAND_KT(0); glds16(ksrc + (long)kt * 64 * DM, (unsigned)__builtin_amdgcn_readfirstlane(kdst)); glds16(vsrc + (long)kt * 64 * DM, (unsigned)__builtin_amdgcn_readfirstlane(vdst)); }
    bf16x8 qr[4];
#pragma unroll
    for (int d0 = 0; d0 < 4; ++d0) qr[d0] = *(const bf16x8*)(Qw + (long)r32 * DM + d0 * 16 + hi * 8);
    float m_run = -INFINITY, l_run = 0.f; f32x16 o[2]; o[0] = f32x16{}; o[1] = f32x16{};
    const int qpos = q0 + wid * 32 + r32;
    const LAS unsigned char* vbase = shm + LDS_V + ((lane >> 4) & 1) * 32 + (lane & 3) * 8 + (4 * hi + ((lane & 15) >> 2)) * 64;
    for (int i = 0; i < NT; ++i) {
        asm volatile("s_waitcnt vmcnt(0) lgkmcnt(0)\n\ts_barrier" ::: "memory");
        if (i + 1 < NT) { const int kt = BAND_KT(i + 1); const unsigned so = ((i + 1) & 1) * SLOTB;
            glds16(ksrc + (long)kt * 64 * DM, (unsigned)__builtin_amdgcn_readfirstlane(kdst + so)); glds16(vsrc + (long)kt * 64 * DM, (unsigned)__builtin_amdgcn_readfirstlane(vdst + so)); }
        const int kt = BAND_KT(i);
        if (kt < cq - 8 || kt > cq) continue;
        const int so = (i & 1) * SLOTB;
        f32x16 p0 = f32x16{}, p1 = f32x16{};
        { const LAS unsigned char* kb = shm + LDS_K + so + hi * 1024 + r32 * 16;
#pragma unroll
          for (int d0 = 0; d0 < 4; ++d0) { const bf16x8 b0 = *(const LAS bf16x8*)(kb + d0 * 2048), b1 = *(const LAS bf16x8*)(kb + d0 * 2048 + 512);
              p0 = __builtin_amdgcn_mfma_f32_32x32x16_bf16(b0, qr[d0], p0, 0, 0, 0); p1 = __builtin_amdgcn_mfma_f32_32x32x16_bf16(b1, qr[d0], p1, 0, 0, 0); } }
        if (kt + 5 <= cq) { const float cbias = tb[639];
#pragma unroll
          for (int r = 0; r < 16; ++r) { p0[r] += cbias; p1[r] += cbias; } }
        else { const int ib = qpos - 64 * kt + 64 - 4 * hi;
#pragma unroll
          for (int r = 0; r < 16; ++r) { const int ix = ib - ((r & 3) + 8 * (r >> 2)); p0[r] += tb[ix]; p1[r] += tb[ix - 32]; } }
        float rm = p0[0];
#pragma unroll
        for (int r = 0; r < 16; ++r) rm = max3f(rm, p0[r], p1[r]);
        { auto rr = __builtin_amdgcn_permlane32_swap(__float_as_uint(rm), __float_as_uint(rm), false, false); rm = fmaxf(__uint_as_float(rr[0]), __uint_as_float(rr[1])); }
        const float mnew = fmaxf(m_run, rm), f = __builtin_amdgcn_exp2f(m_run - mnew); m_run = mnew;
        float sacc = 0.f;
#pragma unroll
        for (int r = 0; r < 16; ++r) { p0[r] = __builtin_amdgcn_exp2f(p0[r] - mnew); p1[r] = __builtin_amdgcn_exp2f(p1[r] - mnew); sacc += p0[r] + p1[r]; }
        l_run = l_run * f + sacc;
        if (!__all(f == 1.0f)) {
            if (hi == 0) wsf[r32] = f;
            LDS_WAIT();
#pragma unroll
            for (int r = 0; r < 16; ++r) { const float fr_ = wsf[crow(r, hi)]; o[0][r] *= fr_; o[1][r] *= fr_; }
        }
        v4u pw[4];
        pw[0] = (v4u){cvtpk(p0[0], p0[1]), cvtpk(p0[2], p0[3]), cvtpk(p0[4], p0[5]), cvtpk(p0[6], p0[7])};
        pw[1] = (v4u){cvtpk(p0[8], p0[9]), cvtpk(p0[10], p0[11]), cvtpk(p0[12], p0[13]), cvtpk(p0[14], p0[15])};
        pw[2] = (v4u){cvtpk(p1[0], p1[1]), cvtpk(p1[2], p1[3]), cvtpk(p1[4], p1[5]), cvtpk(p1[6], p1[7])};
        pw[3] = (v4u){cvtpk(p1[8], p1[9]), cvtpk(p1[10], p1[11]), cvtpk(p1[12], p1[13]), cvtpk(p1[14], p1[15])};
        const LAS unsigned char* vb = vbase + so;
#pragma unroll
        for (int d0 = 0; d0 < 2; ++d0)
#pragma unroll
            for (int ks = 0; ks < 4; ++ks) {
                const s16x4 vlo = __builtin_bit_cast(s16x4, __builtin_amdgcn_ds_read_tr16_b64_v4i16((LAS s16x4*)(vb + d0 * 4096 + ks * 1024)));
                const s16x4 vhi = __builtin_bit_cast(s16x4, __builtin_amdgcn_ds_read_tr16_b64_v4i16((LAS s16x4*)(vb + d0 * 4096 + ks * 1024 + 512)));
                const bf16x8 vf = (bf16x8){vlo[0], vlo[1], vlo[2], vlo[3], vhi[0], vhi[1], vhi[2], vhi[3]};
                o[d0] = __builtin_amdgcn_mfma_f32_32x32x16_bf16(__builtin_bit_cast(bf16x8, pw[ks]), vf, o[d0], 0, 0, 0);
            }
    }
#undef BAND_KT
    { auto rr = __builtin_amdgcn_permlane32_swap(__float_as_uint(l_run), __float_as_uint(l_run), false, false); l_run = __uint_as_float(rr[0]) + __uint_as_float(rr[1]); }
    if (hi == 0) wsf[32 + r32] = l_run;
    LDS_WAIT();
    float rli[16];
#pragma unroll
    for (int r = 0; r < 16; ++r) rli[r] = __builtin_amdgcn_rcpf(wsf[32 + crow(r, hi)]);
    bf16* Ow = O + (rowbase + q0 + wid * 32) * DM + h * 64;
    { LAS bf16* stg = (LAS bf16*)(shm + LDS_OST) + wid * 2048;
#pragma unroll
      for (int r = 0; r < 16; ++r) { const int orow = crow(r, hi);
#pragma unroll
          for (int d0 = 0; d0 < 2; ++d0) stg[orow * 64 + d0 * 32 + r32] = (bf16)f2bf(o[d0][r] * rli[r]); }
      LDS_WAIT();
#pragma unroll
      for (int i = 0; i < 4; ++i) { const int row = i * 8 + (lane >> 3), ch = lane & 7; const v4u v = *(const LAS v4u*)(stg + row * 64 + ch * 8);
          if (o8) { v2u w; w.x = pk4f8(bf_lo(v.x), bf_hi(v.x), bf_lo(v.y), bf_hi(v.y)); w.y = pk4f8(bf_lo(v.z), bf_hi(v.z), bf_lo(v.w), bf_hi(v.w));
              *(v2u*)((unsigned char*)O + (rowbase + q0 + wid * 32 + row) * DM + h * 64 + ch * 8) = w; }
          else *(v4u*)(Ow + (long)row * DM + ch * 8) = v; } }
    asm volatile("s_waitcnt lgkmcnt(0)\n\ts_barrier" ::: "memory");
}
__device__ __forceinline__ void phase(Frame& F, const bf16* Q, const bf16* K, const bf16* V, bf16* O, const float* rel, const bool o8) {
    const int NU = BATCH * 16 * 32, per = (NU + F.G - 1) / F.G;
    for (int i = 0; i < per; ++i) { const int uid = F.vcu * per + i; if (uid >= NU) break; unit(F, uid >> 9, (uid >> 5) & 15, uid & 31, Q, K, V, O, rel, o8); }
}
}

namespace dsa {
__device__ __forceinline__ unsigned okey(float s) { const unsigned u = __float_as_uint(s + 0.0f); return (u & 0x80000000u) ? ~u : (u | 0x80000000u); }
struct Ctx { const bf16* QA; const bf16* KA; const bf16* VA; const bf16* QI; const bf16* KI; const float* WI; bf16* M; const LAS float* t5l; unsigned short* SEL; };

__device__ __forceinline__ void scan_hist(const LAS unsigned* hq, int lane, unsigned need, unsigned& bin, unsigned& above) {
    const LAS v4u* hp = (const LAS v4u*)hq + lane * 4;
    unsigned wds[16];
#pragma unroll
    for (int j = 0; j < 4; ++j) { const v4u t = hp[j]; wds[4 * j] = t.x; wds[4 * j + 1] = t.y; wds[4 * j + 2] = t.z; wds[4 * j + 3] = t.w; }
    unsigned tl = 0;
#pragma unroll
    for (int j = 0; j < 16; ++j) tl += (wds[j] & 0xffffu) + (wds[j] >> 16);
    unsigned suf = tl;
#pragma unroll
    for (int o = 1; o < 64; o <<= 1) { const unsigned v = __shfl_down(suf, o); if (lane + o < 64) suf += v; }
    const unsigned S = suf - tl;
    const bool cross = (S < need) && (need <= S + tl);
    unsigned c = S, bsel = 0, ab = 0; bool found = false;
#pragma unroll
    for (int k = 31; k >= 0; --k) { const unsigned cnt = (wds[k >> 1] >> (16 * (k & 1))) & 0xffffu; if (!found && c + cnt >= need) { bsel = 32 * lane + k; ab = c; found = true; } c += cnt; }
    const unsigned long long bal = __ballot(cross);
    const int src = bal ? __builtin_ctzll(bal) : 0;
    bin = __shfl(bsel, src); above = __shfl(ab, src);
}

__device__ __forceinline__ void attend(const Ctx& C, const LAS unsigned short* sq, int nvalid, long rowbase, long token, int tpos, int lane, int g0) {
    asm volatile("" : "+v"(lane));
    const int l15 = lane & 15, l4 = lane >> 4;
    int sidx[16];
#pragma unroll
    for (int ti = 0; ti < 16; ++ti) sidx[ti] = sq[ti * 16 + l15];
    unsigned bpk[4] = {0u, 0u, 0u, 0u};
#pragma unroll
    for (int ti = 0; ti < 16; ++ti) { const int rel = sidx[ti] - tpos, n = rel < 0 ? -rel : rel;
        const int bk = (rel > 0 ? 16 : 0) + (n < 8 ? n : 8 + (n >= 12) + (n >= 16) + (n >= 23) + (n >= 32) + (n >= 46) + (n >= 64) + (n >= 91));
        bpk[ti >> 2] |= (unsigned)bk << (8 * (ti & 3)); }
#pragma unroll 1
    for (int g = g0; g < g0 + 2; ++g) {
        const bf16* qp = C.QA + token * DM + (4 * g + (lane & 3)) * 64 + 8 * l4;
        const bf16x8 qf0 = *(const bf16x8*)qp, qf1 = *(const bf16x8*)(qp + 32);
        const bf16* kbase = C.KA + rowbase * 256 + g * 64 + 8 * l4;
        f32x4 S[16];
#pragma unroll
        for (int hh = 0; hh < 4; ++hh) {
            bf16x8 kf0[4], kf1[4];
#pragma unroll
            for (int j = 0; j < 4; ++j) { const bf16* kp = kbase + (long)sidx[hh * 4 + j] * 256; kf0[j] = *(const bf16x8*)kp; kf1[j] = *(const bf16x8*)(kp + 32); }
#pragma unroll
            for (int j = 0; j < 4; ++j) { const int ti = hh * 4 + j;
                f32x4 a = *(const LAS f32x4*)(C.t5l + ((bpk[hh] >> (8 * j)) & 255u) * 16 + 4 * g);
                asm volatile("v_mfma_f32_16x16x32_bf16 %0, %1, %2, %0" : "+v"(a) : "v"(qf0), "v"(kf0[j]));
                asm volatile("v_mfma_f32_16x16x32_bf16 %0, %1, %2, %0" : "+v"(a) : "v"(qf1), "v"(kf1[j]));
                S[ti] = a; }
            asm volatile("s_nop 15\n\ts_nop 7" : "+v"(S[hh * 4]), "+v"(S[hh * 4 + 1]), "+v"(S[hh * 4 + 2]), "+v"(S[hh * 4 + 3]));
        }
#pragma unroll
        for (int ti = 0; ti < 16; ++ti) if (ti * 16 >= nvalid) S[ti] = (f32x4){-INFINITY, -INFINITY, -INFINITY, -INFINITY};
        f32x4 mx = S[0];
#pragma unroll
        for (int ti = 1; ti < 16; ++ti) { mx.x = fmaxf(mx.x, S[ti].x); mx.y = fmaxf(mx.y, S[ti].y); mx.z = fmaxf(mx.z, S[ti].z); mx.w = fmaxf(mx.w, S[ti].w); }
#pragma unroll
        for (int o = 1; o < 16; o <<= 1) { mx.x = fmaxf(mx.x, __shfl_xor(mx.x, o)); mx.y = fmaxf(mx.y, __shfl_xor(mx.y, o)); mx.z = fmaxf(mx.z, __shfl_xor(mx.z, o)); mx.w = fmaxf(mx.w, __shfl_xor(mx.w, o)); }
        f32x4 ls = (f32x4){0.f, 0.f, 0.f, 0.f};
        unsigned P01[16], P23[16];
#pragma unroll
        for (int ti = 0; ti < 16; ++ti) { const float e0 = __builtin_amdgcn_exp2f(S[ti].x - mx.x), e1 = __builtin_amdgcn_exp2f(S[ti].y - mx.y), e2 = __builtin_amdgcn_exp2f(S[ti].z - mx.z), e3 = __builtin_amdgcn_exp2f(S[ti].w - mx.w);
            ls += (f32x4){e0, e1, e2, e3}; P01[ti] = cvtpk(e0, e1); P23[ti] = cvtpk(e2, e3); }
#pragma unroll
        for (int o = 1; o < 16; o <<= 1) { ls.x += __shfl_xor(ls.x, o); ls.y += __shfl_xor(ls.y, o); ls.z += __shfl_xor(ls.z, o); ls.w += __shfl_xor(ls.w, o); }
        float o_[4][16];
#pragma unroll
        for (int h = 0; h < 4; ++h)
#pragma unroll
            for (int d = 0; d < 16; ++d) o_[h][d] = 0.f;
        const bf16* vbase = C.VA + rowbase * 256 + g * 64 + 16 * l4;
#pragma unroll
        for (int hh = 0; hh < 4; ++hh) {
            v4u va[4], vb[4];
#pragma unroll
            for (int j = 0; j < 4; ++j) { const v4u* vp = (const v4u*)(vbase + (long)sidx[hh * 4 + j] * 256); va[j] = vp[0]; vb[j] = vp[1]; }
#pragma unroll
            for (int j = 0; j < 4; ++j) { const int ti = hh * 4 + j; const v4u v0 = va[j], v1 = vb[j];
                float vf[16];
                vf[0] = bf_lo(v0.x); vf[1] = bf_hi(v0.x); vf[2] = bf_lo(v0.y); vf[3] = bf_hi(v0.y); vf[4] = bf_lo(v0.z); vf[5] = bf_hi(v0.z); vf[6] = bf_lo(v0.w); vf[7] = bf_hi(v0.w);
                vf[8] = bf_lo(v1.x); vf[9] = bf_hi(v1.x); vf[10] = bf_lo(v1.y); vf[11] = bf_hi(v1.y); vf[12] = bf_lo(v1.z); vf[13] = bf_hi(v1.z); vf[14] = bf_lo(v1.w); vf[15] = bf_hi(v1.w);
                const float p0 = bf_lo(P01[ti]), p1 = bf_hi(P01[ti]), p2 = bf_lo(P23[ti]), p3 = bf_hi(P23[ti]);
#pragma unroll
                for (int d = 0; d < 16; ++d) { o_[0][d] += p0 * vf[d]; o_[1][d] += p1 * vf[d]; o_[2][d] += p2 * vf[d]; o_[3][d] += p3 * vf[d]; } }
        }
        float res[4];
#pragma unroll
        for (int h = 0; h < 4; ++h) {
            float a8[8], a4[4], a2[2];
            const bool b3 = (l15 & 8) != 0, b2 = (l15 & 4) != 0, b1 = (l15 & 2) != 0, b0 = (l15 & 1) != 0;
#pragma unroll
            for (int d = 0; d < 8; ++d) { const float keep = b3 ? o_[h][d + 8] : o_[h][d], send = b3 ? o_[h][d] : o_[h][d + 8]; a8[d] = keep + __shfl_xor(send, 8); }
#pragma unroll
            for (int d = 0; d < 4; ++d) { const float keep = b2 ? a8[d + 4] : a8[d], send = b2 ? a8[d] : a8[d + 4]; a4[d] = keep + __shfl_xor(send, 4); }
#pragma unroll
            for (int d = 0; d < 2; ++d) { const float keep = b1 ? a4[d + 2] : a4[d], send = b1 ? a4[d] : a4[d + 2]; a2[d] = keep + __shfl_xor(send, 2); }
            { const float keep = b0 ? a2[1] : a2[0], send = b0 ? a2[0] : a2[1]; res[h] = keep + __shfl_xor(send, 1); }
        }
        bf16* mp = C.M + token * DM + (4 * g) * 64 + lane;
        mp[0] = (bf16)f2bf(res[0] * __builtin_amdgcn_rcpf(ls.x)); mp[64] = (bf16)f2bf(res[1] * __builtin_amdgcn_rcpf(ls.y)); mp[128] = (bf16)f2bf(res[2] * __builtin_amdgcn_rcpf(ls.z)); mp[192] = (bf16)f2bf(res[3] * __builtin_amdgcn_rcpf(ls.w));
    }
}

constexpr int CAND_CAP = 256;
constexpr int SELKS_OFF = KS_OFF;
__device__ __forceinline__ float relu_i(float x) { const int i = __builtin_bit_cast(int, x); return __builtin_bit_cast(float, i > 0 ? i : 0); }
struct SelState { unsigned pre[4], need[4], cnt[4], tcnt[4]; };
__device__ __forceinline__ void tile_mfma(f32x16 (&acc)[2], const LAS unsigned char* kf, const int (&koff)[4], const bf16x8 (&qa)[4]) {
#pragma unroll
    for (int h2 = 0; h2 < 2; ++h2) { acc[h2] = f32x16{};
#pragma unroll
        for (int ks = 0; ks < 4; ++ks) { const bf16x8 kb = *(const LAS bf16x8*)(kf + koff[ks] + h2 * 4096); acc[h2] = __builtin_amdgcn_mfma_f32_32x32x16_bf16(qa[ks], kb, acc[h2], 0, 0, 0); } }
}
template <class ActionT>
__device__ __forceinline__ void tile_valu(const f32x16 (&acc)[2], const f32x2_t (&wp)[2][4], int kbase, ActionT&& act) {
#pragma unroll
    for (int h2 = 0; h2 < 2; ++h2) {
        f32x2_t sa = {0.f, 0.f}, sb = {0.f, 0.f};
#pragma unroll
        for (int jp = 0; jp < 4; ++jp) {
            const f32x2_t ra = {relu_i(acc[h2][2 * jp]), relu_i(acc[h2][2 * jp + 1])};
            const f32x2_t rb = {relu_i(acc[h2][8 + 2 * jp]), relu_i(acc[h2][8 + 2 * jp + 1])};
            sa = __builtin_elementwise_fma(ra, wp[0][jp], sa); sb = __builtin_elementwise_fma(rb, wp[1][jp], sb); }
        act(kbase + h2 * 32, (sa.x + sa.y) + 0.0f, (sb.x + sb.y) + 0.0f);
    }
}
constexpr int KSLOTS = 3;
__device__ __forceinline__ void wait_tile(int newer) {
    if (newer >= 4) asm volatile("s_waitcnt vmcnt(4) lgkmcnt(0)\n\ts_barrier" ::: "memory");
    else if (newer == 3) asm volatile("s_waitcnt vmcnt(3) lgkmcnt(0)\n\ts_barrier" ::: "memory");
    else if (newer == 2) asm volatile("s_waitcnt vmcnt(2) lgkmcnt(0)\n\ts_barrier" ::: "memory");
    else if (newer == 1) asm volatile("s_waitcnt vmcnt(1) lgkmcnt(0)\n\ts_barrier" ::: "memory");
    else asm volatile("s_waitcnt vmcnt(0) lgkmcnt(0)\n\ts_barrier" ::: "memory");
}
template <class ActionT>
__device__ __forceinline__ void tile_pass(Frame& F, const bf16* ksrc, unsigned kdst, const LAS unsigned char* kfr, const int (&koff)[4], int NT, const bf16x8 (&qa)[4], const f32x2_t (&wp)[2][4], ActionT&& act) {
    asm volatile("s_waitcnt lgkmcnt(0)\n\ts_barrier" ::: "memory");
    const int npre = NT < KSLOTS ? NT : KSLOTS;
    for (int j = 0; j < npre; ++j) glds16(ksrc + (long)j * 4096, (unsigned)__builtin_amdgcn_readfirstlane(kdst + j * 8192));
    wait_tile(npre - 1);
    f32x16 accA[2], accB[2];
    tile_mfma(accA, kfr, koff, qa);
    int sl = 0;
    int kt = 0;
    for (; kt + 2 < NT; kt += 2) {
        { const int inflight = (NT - kt - 2) < (KSLOTS - 2) ? (NT - kt - 2) : (KSLOTS - 2); wait_tile(inflight); }
        if (kt + KSLOTS < NT) glds16(ksrc + (long)(kt + KSLOTS) * 4096, (unsigned)__builtin_amdgcn_readfirstlane(kdst + sl * 8192));
        sl = (sl == KSLOTS - 1) ? 0 : sl + 1;
        tile_mfma(accB, kfr + sl * 8192, koff, qa);
        tile_valu(accA, wp, kt * 64, act);
        { const int inflight = (NT - kt - 3) < (KSLOTS - 2) ? (NT - kt - 3) : (KSLOTS - 2); wait_tile(inflight); }
        if (kt + 1 + KSLOTS < NT) glds16(ksrc + (long)(kt + 1 + KSLOTS) * 4096, (unsigned)__builtin_amdgcn_readfirstlane(kdst + sl * 8192));
        sl = (sl == KSLOTS - 1) ? 0 : sl + 1;
        tile_mfma(accA, kfr + sl * 8192, koff, qa);
        tile_valu(accB, wp, (kt + 1) * 64, act);
    }
    if (kt + 1 < NT) {
        wait_tile(0);
        sl = (sl == KSLOTS - 1) ? 0 : sl + 1;
        tile_mfma(accB, kfr + sl * 8192, koff, qa);
        tile_valu(accA, wp, kt * 64, act);
        tile_valu(accB, wp, (kt + 1) * 64, act);
    } else tile_valu(accA, wp, kt * 64, act);
    LDS_WAIT();
}
__device__ __forceinline__ void scan_hist_cnt(const LAS unsigned* hq, int lane, unsigned need, unsigned& bin, unsigned& above, unsigned& bcnt) {
    const LAS v4u* hp = (const LAS v4u*)hq + lane * 2;
    unsigned wds[8];
#pragma unroll
    for (int j = 0; j < 2; ++j) { const v4u t = hp[j]; wds[4 * j] = t.x; wds[4 * j + 1] = t.y; wds[4 * j + 2] = t.z; wds[4 * j + 3] = t.w; }
    unsigned tl = 0;
#pragma unroll
    for (int j = 0; j < 8; ++j) tl += wds[j];
    unsigned suf = tl;
#pragma unroll
    for (int o = 1; o < 64; o <<= 1) { const unsigned v = __shfl_down(suf, o); if (lane + o < 64) suf += v; }
    const unsigned S = suf - tl;
    const bool cross = (S < need) && (need <= S + tl);
    unsigned c = S, bsel = 0, ab = 0, bc = 0; bool found = false;
#pragma unroll
    for (int k = 7; k >= 0; --k) { const unsigned cnt = wds[k]; if (!found && c + cnt >= need) { bsel = 8 * lane + k; ab = c; bc = cnt; found = true; } c += cnt; }
    const unsigned long long bal = __ballot(cross);
    const int src = bal ? __builtin_ctzll(bal) : 0;
    bin = __builtin_amdgcn_readfirstlane(__shfl(bsel, src)); above = __builtin_amdgcn_readfirstlane(__shfl(ab, src)); bcnt = __builtin_amdgcn_readfirstlane(__shfl(bc, src));
}
__device__ __forceinline__ void step(Frame& F, const Ctx& C, int b, int c, int half) {
    int lane_ = F.lane; asm volatile("" : "+v"(lane_));
    const int lane = lane_, r = lane & 31, hi = lane >> 5, wave = F.wave;
    LAS unsigned* hist = (LAS unsigned*)(F.lds + RING_OFF + wave * 16384);
    LAS unsigned short* sel = (LAS unsigned short*)hist;
    LAS unsigned* cand = hist + 2048;
    LAS unsigned* fbflag = (LAS unsigned*)(F.lds + AUX_OFF + 2048);
    const long rowbase = (long)b * SEQ;
    const int tq0 = 64 * c + 32 * half + 4 * wave;
    const int N = 64 * (c + 1), NT = c + 1;
    int nvalid = 256;
    if (N <= 256) {
        nvalid = N;
        for (int j = lane; j < 4 * 256; j += 64) sel[j] = (unsigned short)(((j & 255) < N) ? (j & 255) : 0);
    } else {
        const int aq = 2 * ((r >> 2) & 1) + (r >> 4), ah = 4 * ((r >> 3) & 1) + (r & 3);
        const bf16* qip = C.QI + (rowbase + tq0 + aq) * 512 + ah * 64 + 8 * hi;
        bf16x8 qa[4];
#pragma unroll
        for (int ks = 0; ks < 4; ++ks) qa[ks] = *(const bf16x8*)(qip + 16 * ks);
        f32x2_t wp[2][4];
#pragma unroll
        for (int t = 0; t < 2; ++t) { const float* wq = C.WI + (rowbase + tq0 + 2 * hi + t) * 8; const f32x4 w0 = *(const f32x4*)wq, w1 = *(const f32x4*)(wq + 4);
            wp[t][0] = (f32x2_t){w0.x, w0.y}; wp[t][1] = (f32x2_t){w0.z, w0.w}; wp[t][2] = (f32x2_t){w1.x, w1.y}; wp[t][3] = (f32x2_t){w1.z, w1.w}; }
        float Bq;
        { float ssq = 0.f;
#pragma unroll
          for (int ks = 0; ks < 4; ++ks)
#pragma unroll
              for (int e = 0; e < 8; ++e) { const float v = bf_lo((unsigned)(unsigned short)qa[ks][e]); ssq += v * v; }
          ssq += __shfl_xor(ssq, 32);
          float term = fabsf(C.WI[(rowbase + tq0 + aq) * 8 + ah]) * sqrtf(ssq);
          term += __shfl_xor(term, 1); term += __shfl_xor(term, 2); term += __shfl_xor(term, 8);
          Bq = term * 8.25f + 1e-20f; }
        const float B0 = __shfl(Bq, (hi << 2)), B1 = __shfl(Bq, (hi << 2) | 16);
        const float sc0 = 1024.0f / B0, sc1 = 1024.0f / B1;
        asm volatile("" :: "v"(qa[0]), "v"(qa[1]), "v"(qa[2]), "v"(qa[3]));
        asm volatile("" :: "v"(wp[0][0]), "v"(wp[0][1]), "v"(wp[0][2]), "v"(wp[0][3]), "v"(wp[1][0]), "v"(wp[1][1]), "v"(wp[1][2]), "v"(wp[1][3]), "v"(sc0), "v"(sc1));
        const bf16* ksrc = C.KI + rowbase * 64 + (long)(wave * 8 + (lane >> 3)) * 64 + ((lane & 7) ^ (lane >> 3)) * 8;
        const unsigned kdst = (unsigned)(uintptr_t)(F.lds + SELKS_OFF) + wave * 1024;
        const LAS unsigned char* kfr = F.lds + SELKS_OFF + r * 128;
        int koff[4];
#pragma unroll
        for (int ks = 0; ks < 4; ++ks) koff[ks] = ((2 * ks + hi) ^ (r & 7)) * 16;
        const unsigned below = (1u << r) - 1u;
        LAS v4u* hz = (LAS v4u*)hist;
        if (wave == 0 && lane == 0) *fbflag = 0u;
#pragma unroll
        for (int j = 0; j < 8; ++j) hz[j * 64 + lane] = (v4u){0u, 0u, 0u, 0u};
        tile_pass(F, ksrc, kdst, kfr, koff, NT, qa, wp, [&](int kbase, float s0, float s1) {
            const int b0 = (int)__builtin_amdgcn_fmed3f(__builtin_fmaf(s0, sc0, 256.0f), 0.0f, 511.0f), b1 = (int)__builtin_amdgcn_fmed3f(__builtin_fmaf(s1, sc1, 256.0f), 0.0f, 511.0f);
            __hip_atomic_fetch_add(hist + (2 * hi) * 512 + b0, 1u, __ATOMIC_RELAXED, __HIP_MEMORY_SCOPE_WORKGROUP);
            __hip_atomic_fetch_add(hist + (2 * hi + 1) * 512 + b1, 1u, __ATOMIC_RELAXED, __HIP_MEMORY_SCOPE_WORKGROUP);
        });
#ifdef PROBE_SKEL
        tile_pass(F, ksrc, kdst, kfr, koff, NT, qa, wp, [&](int kbase, float s0, float s1) { });
#endif
#ifdef PROBE_SCORE
        { float dsum = 0.f; tile_pass(F, ksrc, kdst, kfr, koff, NT, qa, wp, [&](int kbase, float s0, float s1) { dsum += s0 + s1; }); if (dsum == 12345.678f) hist[0] = 1u; }
#endif
        SelState st;
        unsigned tbin[4], bcn[4]; bool ovf = false;
#pragma unroll
        for (int ql = 0; ql < 4; ++ql) { unsigned above; scan_hist_cnt(hist + ql * 512, lane, 256u, tbin[ql], above, bcn[ql]); st.cnt[ql] = 0u; st.tcnt[ql] = 0u; st.need[ql] = 256u - above; st.pre[ql] = above;
#ifdef PROBE_OVF
            ovf |= bcn[ql] > (unsigned)PROBE_OVF; }
#else
            ovf |= bcn[ql] > (unsigned)CAND_CAP; }
#endif
        LDS_WAIT();
        if (ovf && lane == 0) *fbflag = 1u;
        asm volatile("s_waitcnt lgkmcnt(0)\n\ts_barrier" ::: "memory");
#ifdef PROBE_NOFB
        const bool fb = false;
#elif defined(PROBE_NOFB2)
        const bool fb = __builtin_amdgcn_readfirstlane((int)*fbflag) == 0x7fffffff;
#else
        const bool fb = __builtin_amdgcn_readfirstlane((int)*fbflag) != 0;
#endif
        if (!fb) {
            const int tb0 = (int)(hi ? tbin[2] : tbin[0]), tb1 = (int)(hi ? tbin[3] : tbin[1]);
            tile_pass(F, ksrc, kdst, kfr, koff, NT, qa, wp, [&](int kbase, float s0, float s1) {
#pragma unroll
                for (int t = 0; t < 2; ++t) {
                    const float s = t ? s1 : s0; const int bin = (int)__builtin_amdgcn_fmed3f(__builtin_fmaf(s, (t ? sc1 : sc0), 256.0f), 0.0f, 511.0f), tb = t ? tb1 : tb0;
                    const bool gt = bin > tb, eq = bin == tb;
                    const unsigned long long mg = __ballot(gt), me = __ballot(eq);
                    const unsigned mgh = hi ? (unsigned)(mg >> 32) : (unsigned)mg, meh = hi ? (unsigned)(me >> 32) : (unsigned)me;
                    const unsigned pos = (hi ? st.cnt[2 + t] : st.cnt[t]) + __builtin_popcount(mgh & below);
                    sel[(gt && pos < 256u) ? (2 * hi + t) * 256 + pos : 3200 + lane] = (unsigned short)(kbase + r);
                    const unsigned cpos = (hi ? st.tcnt[2 + t] : st.tcnt[t]) + __builtin_popcount(meh & below);
                    { LAS unsigned* cp = hist + ((eq && cpos < (unsigned)CAND_CAP) ? 2048 + ((2 * hi + t) * CAND_CAP + cpos) * 2 : 1700 + 2 * lane); cp[0] = okey(s); cp[1] = (unsigned)(kbase + r); }
                    st.cnt[t] += __builtin_popcount((unsigned)mg); st.cnt[2 + t] += __builtin_popcount((unsigned)(mg >> 32));
                    st.tcnt[t] += __builtin_popcount((unsigned)me); st.tcnt[2 + t] += __builtin_popcount((unsigned)(me >> 32));
                }
            });
#pragma unroll
            for (int ql = 0; ql < 4; ++ql) {
                const unsigned nc = bcn[ql], G = st.pre[ql], rq = st.need[ql];
                const LAS unsigned* cq = cand + ql * CAND_CAP * 2;
                unsigned ki4[4], xi4[4], rk4[4];
#pragma unroll
                for (int m = 0; m < 4; ++m) { const unsigned i = (unsigned)lane + 64u * m; ki4[m] = (i < nc) ? cq[2 * i] : 0u; xi4[m] = (i < nc) ? cq[2 * i + 1] : 0u; rk4[m] = 0u; }
                for (unsigned j = 0; j < nc; ++j) { const unsigned kj = cq[2 * j];
#pragma unroll
                    for (int m = 0; m < 4; ++m) rk4[m] += (kj > ki4[m] || (kj == ki4[m] && j < (unsigned)lane + 64u * m)) ? 1u : 0u; }
                unsigned base = G; const unsigned long long lt = (1ull << lane) - 1ull;
#pragma unroll
                for (int m = 0; m < 4; ++m) { const bool take = ((unsigned)lane + 64u * m < nc) && rk4[m] < rq; const unsigned long long mm = __ballot(take);
                    const unsigned pos = base + __builtin_popcountll(mm & lt); if (take && pos < 256u) sel[ql * 256 + pos] = (unsigned short)xi4[m]; base += __builtin_popcountll(mm); }
            }
        } else {
#pragma unroll
            for (int ql = 0; ql < 4; ++ql) { st.pre[ql] = 0u; st.need[ql] = 256u; st.cnt[ql] = 0u; st.tcnt[ql] = 0u; }
#pragma unroll 1
            for (int lev = 0; lev < 4; ++lev) {
#pragma unroll
                for (int j = 0; j < 8; ++j) hz[j * 64 + lane] = (v4u){0u, 0u, 0u, 0u};
                const unsigned pre0 = hi ? st.pre[2] : st.pre[0], pre1 = hi ? st.pre[3] : st.pre[1];
                const int sh = (lev == 0) ? 23 : (lev == 1) ? 14 : (lev == 2) ? 5 : 0, wd = (lev == 3) ? 5 : 9;
                tile_pass(F, ksrc, kdst, kfr, koff, NT, qa, wp, [&](int kbase, float s0, float s1) {
                    const unsigned k0 = okey(s0), k1 = okey(s1);
                    const unsigned b0 = (k0 >> sh) & ((1u << wd) - 1u), b1 = (k1 >> sh) & ((1u << wd) - 1u);
                    const bool in0 = (lev == 0) || ((k0 >> (sh + wd)) == pre0), in1 = (lev == 0) || ((k1 >> (sh + wd)) == pre1);
                    if (in0) __hip_atomic_fetch_add(hist + (2 * hi) * 512 + b0, 1u, __ATOMIC_RELAXED, __HIP_MEMORY_SCOPE_WORKGROUP);
                    if (in1) __hip_atomic_fetch_add(hist + (2 * hi + 1) * 512 + b1, 1u, __ATOMIC_RELAXED, __HIP_MEMORY_SCOPE_WORKGROUP);
                });
#pragma unroll
                for (int ql = 0; ql < 4; ++ql) { unsigned bin, above, bc; scan_hist_cnt(hist + ql * 512, lane, st.need[ql], bin, above, bc);
                    st.pre[ql] = (st.pre[ql] << wd) | bin; st.need[ql] -= above; }
                LDS_WAIT();
            }
            const unsigned T0 = hi ? st.pre[2] : st.pre[0], T1 = hi ? st.pre[3] : st.pre[1], rq0 = hi ? st.need[2] : st.need[0], rq1 = hi ? st.need[3] : st.need[1];
            tile_pass(F, ksrc, kdst, kfr, koff, NT, qa, wp, [&](int kbase, float s0, float s1) {
#pragma unroll
                for (int t = 0; t < 2; ++t) {
                    const unsigned kk = okey(t ? s1 : s0), T = t ? T1 : T0, rq = t ? rq1 : rq0;
                    const bool gt = kk > T, eq = kk == T;
                    const unsigned long long me = __ballot(eq);
                    const unsigned meh = hi ? (unsigned)(me >> 32) : (unsigned)me;
                    const unsigned trank = (hi ? st.tcnt[2 + t] : st.tcnt[t]) + __builtin_popcount(meh & below);
                    const bool take = gt || (eq && trank < rq);
                    const unsigned long long mt = __ballot(take);
                    const unsigned mth = hi ? (unsigned)(mt >> 32) : (unsigned)mt;
                    const unsigned pos = (hi ? st.cnt[2 + t] : st.cnt[t]) + __builtin_popcount(mth & below);
                    if (take && pos < 256u) sel[(2 * hi + t) * 256 + pos] = (unsigned short)(kbase + r);
                    st.cnt[t] += __builtin_popcount((unsigned)mt); st.cnt[2 + t] += __builtin_popcount((unsigned)(mt >> 32));
                    st.tcnt[t] += __builtin_popcount((unsigned)me); st.tcnt[2 + t] += __builtin_popcount((unsigned)(me >> 32));
                }
            });
        }
    }
    LDS_WAIT();
    { const LAS v4u* s4 = (const LAS v4u*)sel; v4u* g4 = (v4u*)(C.SEL + (rowbase + tq0) * 256);
#pragma unroll
      for (int j = 0; j < 2; ++j) g4[j * 64 + lane] = s4[j * 64 + lane]; }
    LDS_WAIT();
}
__device__ __forceinline__ void phase(Frame& F, const Ctx& C) {
    for (int v = F.vcu; v < 256; v += F.G) {
        const int b = v >> 6, c = v & 63;
#pragma unroll 1
        for (int it = 0; it < 4; ++it) step(F, C, b, (it < 2) ? c : 127 - c, it & 1);
    }
}
__device__ __forceinline__ void attn_phase(Frame& F, const Ctx& C) {
    int lane = F.lane; asm volatile("" : "+v"(lane));
    LAS unsigned short* sq = (LAS unsigned short*)(F.lds + RING_OFF + F.wave * 16384);
    const int nx = F.G / 32;
    for (int x = F.vcu / 32; x < 8; x += nx) {
        const int b = x >> 1, g0 = 2 * (x & 1); const long rowbase = (long)b * SEQ;
        const int w = (F.vcu & 31) * NWAVES + F.wave;
#pragma unroll 1
        for (int t = w; t < SEQ; t += 32 * NWAVES) {
            { const v4u* g4 = (const v4u*)(C.SEL + (rowbase + t) * 256); if (lane < 32) ((LAS v4u*)sq)[lane] = g4[lane]; }
            LDS_WAIT();
            const int N = 64 * ((t >> 6) + 1), nvalid = N < 256 ? N : 256;
            attend(C, sq, nvalid, rowbase, rowbase + t, t, lane, g0);
            LDS_WAIT();
        }
    }
}
}

namespace att8 {
typedef int v2i __attribute__((ext_vector_type(2)));
struct Ctx8 { const unsigned char* QA8; const unsigned char* KV8; const unsigned short* SEL; bf16* M; bool o8; };
constexpr int T2_OFF = KS_OFF, T2_BYTES = 155 * 16 * 4, SELL_OFF = KS_OFF + 10240;
static_assert(T2_BYTES <= 10240 && SELL_OFF + NWAVES * 1024 <= AUX_OFF, "attention LDS map");
__device__ __forceinline__ void mfma8(f32x4& acc, long a, long b) { asm volatile("v_mfma_f32_16x16x32_fp8_fp8 %0, %1, %2, %0" : "+v"(acc) : "v"(a), "v"(b)); }
__device__ __forceinline__ unsigned pk4_fp8(float a, float b, float c, float d) { int r = __builtin_amdgcn_cvt_pk_fp8_f32(a, b, 0, false); r = __builtin_amdgcn_cvt_pk_fp8_f32(c, d, r, true); return (unsigned)r; }

__device__ __forceinline__ void gld16(v4u& dst, const void* p) { asm volatile("global_load_dwordx4 %0, %1, off" : "=v"(dst) : "v"(p) : "memory"); }
__device__ __forceinline__ void issue_kq(const Ctx8& C, const LAS unsigned short* sq, long rowbase, long token, int g, int l15, int l4, int h, v4u (&kr)[16], v4u& qv) {
    const unsigned char* kvb = C.KV8 + rowbase * 512 + g * 128 + 16 * l4;
#pragma unroll
    for (int j = 0; j < 16; ++j) gld16(kr[j], kvb + (long)sq[j * 16 + l15] * 512);
    gld16(qv, C.QA8 + token * 1024 + (4 * g + h) * 64 + 16 * l4);
}
__device__ __forceinline__ void issue_v_half(const Ctx8& C, const LAS unsigned short* sq, long rowbase, int g, int lane, unsigned vbase, int half) {
    const unsigned char* kvb = C.KV8 + rowbase * 512 + g * 128 + 64; const int kq = lane >> 2, p = lane & 3;
#pragma unroll
    for (int j = 0; j < 8; ++j) { const int ti = half * 8 + j; const int key = sq[ti * 16 + kq]; const int x = ((kq >> 2) & 1) | ((ti & 1) << 1);
        glds16(kvb + (long)key * 512 + 16 * (p ^ x), (unsigned)__builtin_amdgcn_readfirstlane(vbase + ti * 1024)); }
}
__device__ __forceinline__ void phase(Frame& F, const Ctx8& C, const float* t5) {
    int lane = F.lane; asm volatile("" : "+v"(lane));
    LAS float* T2 = (LAS float*)(F.lds + T2_OFF);
    for (int e = F.tid; e < 155 * 16; e += NWAVES * 64) { const int rel = (e >> 4) - 91, n = rel < 0 ? -rel : rel;
        const int bk = (rel > 0 ? 16 : 0) + (n < 8 ? n : 8 + (n >= 12) + (n >= 16) + (n >= 23) + (n >= 32) + (n >= 46) + (n >= 64) + (n >= 91));
        T2[e] = t5[bk * 16 + (e & 15)] * 8.0f; }
    __syncthreads();
    LAS unsigned short* sqb = (LAS unsigned short*)(F.lds + SELL_OFF + F.wave * 1024);
    LAS unsigned char* vreg = F.lds + RING_OFF + F.wave * 16384;
    const unsigned vbase = (unsigned)(uintptr_t)vreg;
    const int l15 = lane & 15, l4 = lane >> 4, h = l15 & 3;
    const int trk = 4 * l4 + ((l15 >> 1) & 3), trt = (l15 >> 3) & 1, xs = (l4 & 1) | (trt << 1);
    const int troff = trt * 1024 + trk * 64 + 8 * (l15 & 1);
    const int x = F.vcu / 32, b = x >> 1, g0 = 2 * (x & 1); const long rowbase = (long)b * SEQ;
    const int w = (F.vcu & 31) * NWAVES + F.wave;
    constexpr int NQ = SEQ / (32 * NWAVES), NI = 2 * NQ;
    if (lane < 32) { ((LAS v4u*)sqb)[lane] = ((const v4u*)(C.SEL + (rowbase + w) * 256))[lane]; ((LAS v4u*)(sqb + 256))[lane] = ((const v4u*)(C.SEL + (rowbase + w + 32 * NWAVES) * 256))[lane]; }
    LDS_WAIT();
    v4u kr[16], qv, pf = (v4u){0u, 0u, 0u, 0u};
    issue_kq(C, sqb, rowbase, rowbase + w, g0, l15, l4, h, kr, qv);
    issue_v_half(C, sqb, rowbase, g0, lane, vbase, 0); issue_v_half(C, sqb, rowbase, g0, lane, vbase, 1);
    unsigned cib[16];
#pragma unroll 1
    for (int idx = 0; idx < NI; ++idx) {
        const int qn = idx >> 1, gi = idx & 1, g = g0 + gi, t = w + 32 * NWAVES * qn;
        const LAS unsigned short* sq = sqb + (qn & 1) * 256;
        const int nidx = (idx + 1 < NI) ? idx + 1 : idx, nq = nidx >> 1, ng = g0 + (nidx & 1), nt = w + 32 * NWAVES * nq;
        const LAS unsigned short* nsq = sqb + (nq & 1) * 256;
        if (gi == 1) { asm volatile("s_waitcnt vmcnt(34)" : "+v"(pf) :: "memory"); if (lane < 32) ((LAS v4u*)(sqb + (qn & 1) * 256))[lane] = pf; }
        { const int pq = (qn + 2 < NQ) ? qn + 2 : NQ - 1; gld16(pf, (const v4u*)(C.SEL + (rowbase + w + 32 * NWAVES * pq) * 256) + (lane & 31)); }
        if (idx == 0) asm volatile("s_waitcnt vmcnt(0)" : "+v"(qv), "+v"(kr[0]), "+v"(kr[1]), "+v"(kr[2]), "+v"(kr[3]), "+v"(kr[4]), "+v"(kr[5]), "+v"(kr[6]), "+v"(kr[7]), "+v"(kr[8]), "+v"(kr[9]), "+v"(kr[10]), "+v"(kr[11]), "+v"(kr[12]), "+v"(kr[13]), "+v"(kr[14]), "+v"(kr[15]) :: "memory");
        else asm volatile("s_waitcnt vmcnt(20)" : "+v"(qv), "+v"(kr[0]), "+v"(kr[1]), "+v"(kr[2]), "+v"(kr[3]), "+v"(kr[4]), "+v"(kr[5]), "+v"(kr[6]), "+v"(kr[7]), "+v"(kr[8]), "+v"(kr[9]), "+v"(kr[10]), "+v"(kr[11]), "+v"(kr[12]), "+v"(kr[13]), "+v"(kr[14]), "+v"(kr[15]) :: "memory");
        if (gi == 0) {
#pragma unroll
            for (int ti = 0; ti < 16; ++ti) { const v2u i4 = *(const LAS v2u*)(sq + ti * 16 + 4 * l4);
                const int r0 = (int)(i4.x & 0xffffu) - t, r1 = (int)(i4.x >> 16) - t, r2 = (int)(i4.y & 0xffffu) - t, r3 = (int)(i4.y >> 16) - t;
                const int c0 = min(max(r0, -91), 63) + 91, c1 = min(max(r1, -91), 63) + 91, c2 = min(max(r2, -91), 63) + 91, c3 = min(max(r3, -91), 63) + 91;
                cib[ti] = (unsigned)c0 | ((unsigned)c1 << 8) | ((unsigned)c2 << 16) | ((unsigned)c3 << 24); }
        }
        const int N = 64 * ((t >> 6) + 1), nvalid = N < 256 ? N : 256;
        const long q0 = (long)(((unsigned long long)qv.y << 32) | qv.x), q1 = (long)(((unsigned long long)qv.w << 32) | qv.z);
        f32x4 S[16];
#pragma unroll
        for (int ti = 0; ti < 16; ++ti) { const unsigned cb = cib[ti];
            f32x4 a; a.x = T2[(cb & 255u) * 16 + 4 * g + h]; a.y = T2[((cb >> 8) & 255u) * 16 + 4 * g + h]; a.z = T2[((cb >> 16) & 255u) * 16 + 4 * g + h]; a.w = T2[(cb >> 24) * 16 + 4 * g + h];
            mfma8(a, (long)(((unsigned long long)kr[ti].y << 32) | kr[ti].x), q0);
            mfma8(a, (long)(((unsigned long long)kr[ti].w << 32) | kr[ti].z), q1);
            S[ti] = a; }
        asm volatile("s_nop 15\n\ts_nop 7" : "+v"(S[0]), "+v"(S[1]), "+v"(S[2]), "+v"(S[3]), "+v"(S[4]), "+v"(S[5]), "+v"(S[6]), "+v"(S[7]), "+v"(S[8]), "+v"(S[9]), "+v"(S[10]), "+v"(S[11]), "+v"(S[12]), "+v"(S[13]), "+v"(S[14]), "+v"(S[15]));
        issue_kq(C, nsq, rowbase, rowbase + nt, ng, l15, l4, h, kr, qv);
#pragma unroll
        for (int ti = 0; ti < 16; ++ti) if (ti * 16 >= nvalid) S[ti] = (f32x4){-INFINITY, -INFINITY, -INFINITY, -INFINITY};
        float mx = S[0].x;
#pragma unroll
        for (int ti = 0; ti < 16; ++ti) mx = fmaxf(fmaxf(mx, fmaxf(S[ti].x, S[ti].y)), fmaxf(S[ti].z, S[ti].w));
        mx = fmaxf(mx, __shfl_xor(mx, 16)); mx = fmaxf(mx, __shfl_xor(mx, 32));
        const float mc = -mx * C2; float ls = 0.f;
        long P8[8];
#pragma unroll
        for (int j = 0; j < 8; ++j) { float e[8];
#pragma unroll
            for (int q = 0; q < 4; ++q) { e[q] = __builtin_amdgcn_exp2f(__builtin_fmaf(S[2 * j][q], C2, mc)); e[4 + q] = __builtin_amdgcn_exp2f(__builtin_fmaf(S[2 * j + 1][q], C2, mc)); }
            ls += ((e[0] + e[1]) + (e[2] + e[3])) + ((e[4] + e[5]) + (e[6] + e[7]));
            const unsigned lo = pk4_fp8(e[0] * 256.f, e[1] * 256.f, e[2] * 256.f, e[3] * 256.f), hi = pk4_fp8(e[4] * 256.f, e[5] * 256.f, e[6] * 256.f, e[7] * 256.f);
            P8[j] = (long)(((unsigned long long)hi << 32) | lo); }
        ls += __shfl_xor(ls, 16); ls += __shfl_xor(ls, 32);
        f32x4 D[4];
#pragma unroll
        for (int db = 0; db < 4; ++db) D[db] = (f32x4){0.f, 0.f, 0.f, 0.f};
#pragma unroll
        for (int hf = 0; hf < 2; ++hf) {
            asm volatile("s_waitcnt vmcnt(28)" ::: "memory");
#pragma unroll
            for (int j = 4 * hf; j < 4 * hf + 4; ++j)
#pragma unroll
                for (int db = 0; db < 4; ++db) {
                    const v2i vv = __builtin_amdgcn_ds_read_tr8_b64_v2i32((LAS v2i*)(vreg + j * 2048 + troff + 16 * (db ^ xs)));
                    mfma8(D[db], P8[j], __builtin_bit_cast(long, vv)); }
            asm volatile("s_waitcnt lgkmcnt(0)" ::: "memory");
            issue_v_half(C, nsq, rowbase, ng, lane, vbase, hf);
        }
        asm volatile("s_nop 15\n\ts_nop 7" : "+v"(D[0]), "+v"(D[1]), "+v"(D[2]), "+v"(D[3]));
        const float lh = __shfl(ls, l4);
        const float inv = __builtin_amdgcn_rcpf(lh * 256.f);
        bf16* mp = C.M + (rowbase + t) * DM + (4 * g + l4) * 64 + l15;
#pragma unroll
        for (int db = 0; db < 4; ++db) { const float v = (l4 == 0) ? D[db].x : (l4 == 1) ? D[db].y : (l4 == 2) ? D[db].z : D[db].w;
            if (C.o8) { const unsigned o1 = (unsigned)__builtin_amdgcn_cvt_pk_fp8_f32(v * inv, 0.f, 0, false);
                asm volatile("global_store_byte %0, %1, off" :: "v"((unsigned char*)C.M + (rowbase + t) * DM + (4 * g + l4) * 64 + l15 + 16 * db), "v"(o1) : "memory"); }
            else { const unsigned short ob = (unsigned short)f2bf(v * inv);
                asm volatile("global_store_short %0, %1, off" :: "v"(mp + 16 * db), "v"((unsigned)ob) : "memory"); } }
    }
    asm volatile("s_waitcnt vmcnt(0)" ::: "memory");
}
}

#ifndef REP_P0
#define REP_P0 1
#endif
#ifndef REP_IN
#define REP_IN 1
#endif
#ifndef REP_DSA
#define REP_DSA 1
#endif
#ifndef REP_BAND
#define REP_BAND 1
#endif
#ifndef REP_UP
#define REP_UP 1
#endif
#ifndef REP_FIX
#define REP_FIX 1
#endif
constexpr int N_PHASES = 1 + 6 * DEPTH;
#ifndef MK_N_LAUNCHES
#define MK_N_LAUNCHES 1
#endif
__global__ void __launch_bounds__(NWAVES * 64, 2) mega_fwd(Args args) {
    extern __shared__ __attribute__((aligned(16))) unsigned char lds[];
    Frame F;
    F.lds = (LAS unsigned char*)lds;
    F.MISC = (volatile LAS unsigned*)(F.lds + MISC_OFF);
    F.tid = threadIdx.x; F.lane = F.tid & 63; F.wave = __builtin_amdgcn_readfirstlane(F.tid >> 6);
    F.G = GRID; { const int bx = blockIdx.x; F.vcu = (bx & 7) * (GRID / 8) + (bx >> 3); }
    unsigned char* ws = args.ws;
    F.ctl = (gu32*)(ws + WS_CTL);
    for (int u = F.tid; u < (LDS_BYTES - LDSCTL_OFF) / 4; u += NWAVES * 64) ((LAS unsigned*)(F.lds + LDSCTL_OFF))[u] = 0u;
    __syncthreads();
    XcdBarrier bar; bar.bar = (unsigned*)(F.ctl + CW_BAR); bar.x = 0; bar.st = nullptr;
    if (MK_N_LAUNCHES == 1) bar = xcd_barrier_post((unsigned*)(F.ctl + CW_BAR), F.MISC + 8);
    const int lo = args.ph_lo, hi = args.ph_hi;
#define IN(k) (lo <= (k) && (k) < hi)
#define OPQ_FRAME(Fl) Frame Fl = F; { int l_; asm volatile("v_mbcnt_lo_u32_b32 %0, -1, 0\n\tv_mbcnt_hi_u32_b32 %0, -1, %0" : "=v"(l_)); int w_ = F.wave; asm volatile("" : "+s"(w_)); Fl.wave = w_; Fl.lane = l_; Fl.tid = w_ * 64 + l_; }
#define SEAM(k) do { if (IN(k) && IN((k) + 1)) xcd_barrier(bar); } while (0)

    bf16* hb = (bf16*)(ws + WS_HB); bf16* mb = (bf16*)(ws + WS_M); float* ss = (float*)(ws + WS_SS); float* halo = (float*)(ws + WS_HALO);
    unsigned char* proj = ws + WS_PROJ; bf16* act = (bf16*)(ws + WS_PROJ);

#ifndef SKIP_P0
    if (IN(0)) { for (int rep = 0; rep < REP_P0; ++rep) { OPQ_FRAME(F0); p0_prologue(F0, args); } }
#endif
    SEAM(0);

#pragma unroll 1
    for (int L = 0; L < DEPTH; ++L) {
        const int pb = 1 + 6 * L, li = L >> 1; const bool isB = (L & 1) != 0;
        if (IN(pb)) {
#ifndef SKIP_IN
            for (int rep = 0; rep < REP_IN; ++rep)
            if (!isB) {
                pg8::Gemm g{hb, (const bf16*)(ws + WS_W_INA) + (size_t)li * NA_PAD * DM, MTOK, NA_PAD, DM}; pg8::StaticOrder S; S.init(MTOK, NA_PAD, F.G, (int)blockIdx.x);
                EpiIn E{ss, proj, args.q_norm_g + L * 64, args.k_norm_g + L * 64, 0, 1.0f};
                pg8::gemm_phase<EpiIn, pg8::StaticOrder, true, true>(F.lds + RING_OFF, g, S, E, F.wave);
            } else {
                pg8::Gemm g{hb, (const bf16*)(ws + WS_W_INB) + (size_t)li * NB * DM, MTOK, NB, DM}; pg8::StaticOrder S; S.init(MTOK, NB, F.G, (int)blockIdx.x);
                if (L > F8_L0) { pg8::Gemm g8{(const bf16*)(ws + WS_M), (const bf16*)(ws + WS_W_INB) + (size_t)li * NB * DM, MTOK, NB, DM / 2};
                    EpiIn E{ss, proj, args.q_norm_g + L * 64, args.k_norm_g + L * 64, 1, W8I};
                    pg8::gemm_phase<EpiIn, pg8::StaticOrder, true, true, true>(F.lds + RING_OFF, g8, S, E, F.wave); }
                else { EpiIn E{ss, proj, args.q_norm_g + L * 64, args.k_norm_g + L * 64, 1, 1.0f};
                    pg8::gemm_phase<EpiIn, pg8::StaticOrder, true, true>(F.lds + RING_OFF, g, S, E, F.wave); }
            }
#endif
        }
        SEAM(pb);
#if defined(DBG_NODSA) || defined(DBG_NOBAND)
#ifdef DBG_NODSA
        const bool zero_m = !isB;
#else
        const bool zero_m = isB;
#endif
        if (IN(pb + 1) && zero_m) { for (size_t i = (size_t)blockIdx.x * 512 + threadIdx.x; i < (size_t)MTOK * DM / 8; i += (size_t)gridDim.x * 512) ((v4u*)mb)[i] = (v4u){0u, 0u, 0u, 0u}; }
        if (IN(pb + 1) && !zero_m) {
#else
        if (IN(pb + 1)) {
#endif
#ifndef SKIP_DSA
            if (!isB) {
                LAS float* t5l = (LAS float*)(F.lds + AUX_OFF);
                { OPQ_FRAME(Ft); for (int i = Ft.tid; i < 512; i += NWAVES * 64) t5l[i] = args.t5_bias[i] * LOG2E; }
                __syncthreads();
                dsa::Ctx C{(const bf16*)(proj + PA_QA), (const bf16*)(proj + PA_KA), (const bf16*)(proj + PA_VA), (const bf16*)(proj + PA_QI), (const bf16*)(proj + PA_KI), (const float*)(proj + PA_WI), mb, t5l, (unsigned short*)(proj + PA_SEL)};
#ifdef DBG_DSACOPY
                { int t_ = threadIdx.x; asm volatile("" : "+v"(t_));
                for (unsigned i = blockIdx.x * 512u + (unsigned)t_; i < (unsigned)MTOK * DM; i += gridDim.x * 512u) { const unsigned t = i >> 10, c = i & 1023u;
                    float v = bf_lo(C.QA[i]); v += bf_lo(C.KA[t * 256 + (c & 255)]); v += bf_lo(C.VA[t * 256 + (c & 255)]); v += bf_lo(C.QI[t * 512 + (c & 511)]); v += bf_lo(C.KI[t * 64 + (c & 63)]); v += C.WI[t * 8 + (c & 7)];
                    mb[i] = (bf16)f2bf(v * 0.01f); asm volatile("" ::: "memory"); } }
#else
                for (int rep = 0; rep < REP_DSA; ++rep) { OPQ_FRAME(F1); dsa::phase(F1, C); }
                xcd_barrier(bar);
                { OPQ_FRAME(F1b); att8::Ctx8 C8{(const unsigned char*)(proj + PA_QA), (const unsigned char*)(proj + PA_KA), (const unsigned short*)(proj + PA_SEL), mb, L >= F8_L0};
#ifndef REP_ATT8
#define REP_ATT8 1
#endif
                  for (int rep = 0; rep < REP_ATT8; ++rep) { att8::phase(F1b, C8, args.t5_bias); __syncthreads(); } }
#endif
            }
#endif
#ifndef SKIP_BAND
            if (isB) {
                for (int rep = 0; rep < REP_BAND; ++rep) { OPQ_FRAME(F2); band::phase(F2, (const bf16*)proj, (const bf16*)(proj + PB_STRIDE), (const bf16*)(proj + 2 * PB_STRIDE), mb, args.rel_bias_b + (size_t)li * 513 * 16, L >= F8_L0); }
            }
#endif
        }
        SEAM(pb + 1);
        if (IN(pb + 2)) {
#ifndef SKIP_OUT
            pg8::Gemm g{mb, (const bf16*)(ws + WS_W_OUT) + (size_t)L * DM * DM, MTOK, DM, DM}; pg8::StaticOrder S; S.init(MTOK, DM, F.G, (int)blockIdx.x);
#ifdef REP_OUT
            { EpiRes E0{L == 0 ? args.x : nullptr, nullptr, hb, (bf16*)proj, halo}; pg8::gemm_phase<EpiRes, pg8::StaticOrder, true, true>(F.lds + RING_OFF, g, S, E0, F.wave); }
#endif
            if (L >= F8_L0) { pg8::Gemm g8{mb, (const bf16*)(ws + WS_W_OUT) + (size_t)L * DM * DM, MTOK, DM, DM / 2};
                EpiResT<3> E{nullptr, nullptr, hb, hb, ss, proj + PX_HB8};
                pg8::gemm_phase<EpiResT<3>, pg8::StaticOrder, true, true, true>(F.lds + RING_OFF, g8, S, E, F.wave); }
            else { EpiRes E{L == 0 ? args.x : nullptr, nullptr, hb, hb, ss};
                pg8::gemm_phase<EpiRes, pg8::StaticOrder, true, true>(F.lds + RING_OFF, g, S, E, F.wave); }
#endif
        }
        SEAM(pb + 2);
        if (IN(pb + 3)) {
#ifndef SKIP_UP
            for (int rep = 0; rep < REP_UP; ++rep) {
            pg8::Gemm g{hb, (const bf16*)(ws + WS_W_UP) + (size_t)L * NUP * DM, MTOK, NUP, DM}; pg8::StaticOrder S; S.init(MTOK, NUP, F.G, (int)blockIdx.x);
#ifdef PROBE_UPK
            { EpiDummy E0{halo}; pg8::gemm_phase<EpiDummy, pg8::StaticOrder, true, true>(F.lds + RING_OFF, g, S, E0, F.wave); }
#endif
            if (L >= F8_L0) { pg8::Gemm g8{(const bf16*)(proj + PX_HB8), (const bf16*)(ws + WS_W_UP) + (size_t)L * NUP * DM, MTOK, NUP, DM / 2};
                EpiUpT<true> E{ss, args.conv_w + (size_t)L * 3 * NUP, args.conv_b + (size_t)L * NUP, act, halo, (LAS float*)(F.lds + AUX_OFF)};
                pg8::gemm_phase<EpiUpT<true>, pg8::StaticOrder, true, true, true>(F.lds + RING_OFF, g8, S, E, F.wave); }
            else { EpiUp E{ss, args.conv_w + (size_t)L * 3 * NUP, args.conv_b + (size_t)L * NUP, act, halo, (LAS float*)(F.lds + AUX_OFF)};
                pg8::gemm_phase<EpiUp, pg8::StaticOrder, true, true>(F.lds + RING_OFF, g, S, E, F.wave); } }
#endif
        }
        SEAM(pb + 3);
#ifndef SKIP_FIX
        if (IN(pb + 4)) for (int rep = 0; rep < REP_FIX; ++rep) { OPQ_FRAME(F3); if (L >= F8_L0) fixup_phase<true>(F3, args.conv_w + (size_t)L * 3 * NUP, args.conv_b + (size_t)L * NUP, halo, act); else fixup_phase<false>(F3, args.conv_w + (size_t)L * 3 * NUP, args.conv_b + (size_t)L * NUP, halo, act); }
#endif
        SEAM(pb + 4);
        if (IN(pb + 5)) {
#ifndef SKIP_DN
            pg8::Gemm g{act, (const bf16*)(ws + WS_W_DN) + (size_t)L * DM * FF, MTOK, DM, FF}; pg8::StaticOrder S; S.init(MTOK, DM, F.G, (int)blockIdx.x);
#ifdef REP_DN
            { EpiRes E0{nullptr, nullptr, hb, mb, halo}; pg8::gemm_phase<EpiRes, pg8::StaticOrder, true, true>(F.lds + RING_OFF, g, S, E0, F.wave); }
#endif
            if (L >= F8_L0) { pg8::Gemm g8{act, (const bf16*)(ws + WS_W_DN) + (size_t)L * DM * FF, MTOK, DM, FF / 2};
                EpiResT<3> E{nullptr, L == DEPTH - 1 ? args.out : nullptr, hb, hb, ss, ws + WS_M};
                pg8::gemm_phase<EpiResT<3>, pg8::StaticOrder, true, true, true>(F.lds + RING_OFF, g8, S, E, F.wave); }
            else { EpiRes E{nullptr, L == DEPTH - 1 ? args.out : nullptr, hb, hb, ss};
                pg8::gemm_phase<EpiRes, pg8::StaticOrder, true, true>(F.lds + RING_OFF, g, S, E, F.wave); }
#endif
        }
        SEAM(pb + 5);
    }
#undef IN
#undef SEAM
}

extern "C" void kernel_launch(void* const* d_in, const int* in_sizes, int n_in, void* d_out, int out_size, void* d_ws, size_t ws_size, hipStream_t stream) {
    static int grid = 0;
    if (grid == 0) {
        if (n_in != 14 || in_sizes[0] != MTOK * DM || out_size != MTOK * DM || ws_size < WS_END) { fprintf(stderr, "kernel_launch: unexpected shapes / workspace (n_in %d, ws %zu); nothing launched\n", n_in, ws_size); grid = -1; return; }
        int dev = 0, cus = 0, per_cu = 0;
        if (hipGetDevice(&dev) != hipSuccess || hipDeviceGetAttribute(&cus, hipDeviceAttributeMultiprocessorCount, dev) != hipSuccess) { grid = -1; return; }
        if (hipFuncSetAttribute((const void*)mega_fwd, hipFuncAttributeMaxDynamicSharedMemorySize, LDS_BYTES) != hipSuccess) { fprintf(stderr, "kernel_launch: hipFuncSetAttribute failed\n"); grid = -1; return; }
        if (hipOccupancyMaxActiveBlocksPerMultiprocessor(&per_cu, (const void*)mega_fwd, NWAVES * 64, LDS_BYTES) != hipSuccess || per_cu < 1) { fprintf(stderr, "kernel_launch: occupancy query reports %d blocks per CU\n", per_cu); }
        (void)hipGetLastError();
        if (cus != GRID) { fprintf(stderr, "kernel_launch: built for a %d-CU device, found %d; nothing launched\n", GRID, cus); grid = -1; return; }
        grid = GRID;
    }
    if (grid < 0) return;
    if (hipMemsetAsync((char*)d_ws + WS_CTL, 0, CTL_ZERO_BYTES, stream) != hipSuccess) return;
    Args a{};
    a.x = (const float*)d_in[0]; a.attn_norm_g = (const float*)d_in[1]; a.w_in_a = (const float*)d_in[2]; a.w_in_b = (const float*)d_in[3]; a.q_norm_g = (const float*)d_in[4];
    a.k_norm_g = (const float*)d_in[5]; a.t5_bias = (const float*)d_in[6]; a.rel_bias_b = (const float*)d_in[7]; a.w_out = (const float*)d_in[8]; a.ffn_norm_g = (const float*)d_in[9];
    a.w_up = (const float*)d_in[10]; a.conv_w = (const float*)d_in[11]; a.conv_b = (const float*)d_in[12]; a.w_down = (const float*)d_in[13];
    a.out = (float*)d_out; a.ws = (unsigned char*)d_ws; a.pad = 0;
#if MK_N_LAUNCHES == 1
    a.ph_lo = 0; a.ph_hi = N_PHASES; a.li = 0;
    hipLaunchKernelGGL(mega_fwd, dim3(grid), dim3(NWAVES * 64), LDS_BYTES, stream, a);
#else
    for (int p = 0; p < N_PHASES; ++p) { a.ph_lo = p; a.ph_hi = p + 1; a.li = p; hipLaunchKernelGGL(mega_fwd, dim3(grid), dim3(NWAVES * 64), LDS_BYTES, stream, a); }
#endif
}
```

```cpp
#define OFF_G -1
#define OFF_S -1
#define OFF_A -1
#define OFF_B -1
#include <hip/hip_runtime.h>
#include <cstdio>
#include <cstdint>
#ifndef OFF_G
#define OFF_G 0
#endif
#ifndef OFF_S
#define OFF_S 0
#endif
#ifndef OFF_A
#define OFF_A 0
#endif
#ifndef OFF_B
#define OFF_B 0
#endif
#define LOOP_ALIGN_N(n) asm volatile(".p2align 6\n\t.rept %0\n\ts_nop 0\n\t.endr" :: "n"(n))
#if OFF_G < 0
#define LA_G
#else
#define LA_G LOOP_ALIGN_N(OFF_G)
#endif
#if OFF_S < 0
#define LA_S
#else
#define LA_S LOOP_ALIGN_N(OFF_S)
#endif
#if OFF_A < 0
#define LA_A
#else
#define LA_A LOOP_ALIGN_N(OFF_A)
#endif
#if OFF_B < 0
#define LA_B
#else
#define LA_B LOOP_ALIGN_N(OFF_B)
#endif
namespace pg8 {
#define PG8_LAS __attribute__((address_space(3)))
typedef unsigned short bf16_t;
typedef short bf16x8 __attribute__((ext_vector_type(8)));
typedef float f32x4 __attribute__((ext_vector_type(4)));
typedef unsigned u32x4 __attribute__((ext_vector_type(4)));
typedef int i32x4 __attribute__((ext_vector_type(4)));
typedef int i32x8 __attribute__((ext_vector_type(8)));
constexpr int BM = 256, BK = 64, HALF = 128, HTB = HALF * BK * 2  , STAGE_BYTES = 8 * HTB, NXCD = 8, WGM = 8;

__host__ __device__ __forceinline__ int lds_byte(int r, int c) { const int st = (r >> 4) * 2 + (c >> 5), rr = r & 15, cc = c & 31, ob = rr * 64 + cc * 2; return st * 1024 + (ob ^ (((ob >> 9) & 1) << 5)); }
__host__ __device__ __forceinline__ void stage_rc(int b, int& R, int& C) { const int st = b / 1024, sb = b % 1024, swz = sb ^ (((sb >> 9) & 1) << 5); R = (st >> 1) * 16 + swz / 64; C = (st & 1) * 32 + (swz % 64) / 2; }
__host__ __device__ __forceinline__ int perm32(int rho) { const int n = rho >> 4, i = rho & 15; return 8 * (i >> 2) + 4 * n + (i & 3); }

struct Unit { int pm, pn; };
struct Gemm { const bf16_t* A; const bf16_t* Bt; int M, N, K; };

struct StaticOrder {
    int nM, nN, nwg, G, c;
    __host__ __device__ void init(int M, int N, int G_, int c_) { nM = M / BM; nN = N / BM; nwg = nM * nN; G = G_; c = c_; }
    __host__ __device__ bool next(int i, Unit& u) const {
        const long L = (long)i * G + c; if (L >= nwg) return false;
        int wgid = (int)L; { const int q = nwg / NXCD, r = nwg % NXCD, xcd = wgid % NXCD, off = wgid / NXCD; wgid = (xcd < r ? xcd * (q + 1) : r * (q + 1) + (xcd - r) * q) + off; }
        const int nig = WGM * nN, gid = wgid / nig, fm = gid * WGM, gsz = (nM - fm) < WGM ? (nM - fm) : WGM;
        u.pm = fm + ((wgid % nig) % gsz); u.pn = (wgid % nig) / gsz; return true;
    }
    __device__ __forceinline__ void a_ready(const Unit&) const {}
    __device__ __forceinline__ void done(const Unit&) const {}
};
__device__ __forceinline__ unsigned cvt_pk_bf16(float lo, float hi) { unsigned r; asm volatile("v_cvt_pk_bf16_f32 %0, %1, %2" : "=v"(r) : "v"(lo), "v"(hi)); return r; }
template <class Epi, class Sched, bool ALIGN_EPI = false, bool SP2 = false, bool F8 = false>
__device__ __forceinline__ void gemm_phase(PG8_LAS unsigned char* lds, const Gemm g, const Sched& S, const Epi& E, const int wave_id) {
    int lane_; asm volatile("v_mbcnt_lo_u32_b32 %0, -1, 0\n\tv_mbcnt_hi_u32_b32 %0, -1, %0" : "=v"(lane_));
    int wid_ = wave_id; asm volatile("" : "+s"(wid_));
    const int wid = wid_, lane = lane_, tid = wid * 64 + lane, wr = wid >> 2, wc = wid & 3, fr = lane & 15, fq = lane >> 4;
    const int K = g.K, nt = K / BK;
    unsigned voffA[2], voffB[2];
#pragma unroll
    for (int i = 0; i < 2; ++i) { int R, C; stage_rc(tid * 16 + i * 8192, R, C); const int Rb = Epi::PERM ? ((R & ~31) + perm32(R & 31)) : R;
        const int Ra = Epi::PERMA ? ((R & ~63) | (4 * (R & 15) + ((R >> 4) & 3))) : R;
        voffA[i] = (unsigned)(Ra * K + C) * 2u; voffB[i] = (unsigned)(Rb * K + C) * 2u; }
    const size_t kstep = (size_t)(BK * 2);
    const size_t hstep = (size_t)HALF * K * 2;
    const size_t tstep = 2 * hstep;
    const unsigned ldsw = (unsigned)wid * 1024u;
    const int aoff = lds_byte(wr * 64 + fr, fq * 8), boff = lds_byte(wc * 32 + fr, fq * 8);
#define PG8_SA(b, h) (((b) * 2 + (h)) * HTB)
#define PG8_SB(b, h) ((4 + (b) * 2 + (h)) * HTB)
#define PG8_STAGE(bufoff, gbase, voff) do { _Pragma("unroll") for (int _i = 0; _i < 2; ++_i) \
        __builtin_amdgcn_global_load_lds((const unsigned*)((const char*)(gbase) + (voff)[_i]), (PG8_LAS unsigned*)(lds + (bufoff) + ldsw + _i * 8192), 16, 0, 0); } while (0)
#define PG8_LDA(dst, b, h) do { _Pragma("unroll") for (int m = 0; m < 4; ++m) _Pragma("unroll") for (int k = 0; k < 2; ++k) dst[m][k] = *(const PG8_LAS bf16x8*)(lds + PG8_SA(b, h) + aoff + m * 2048 + k * 1024); } while (0)
#define PG8_LDB(dst, b, h) do { _Pragma("unroll") for (int n = 0; n < 2; ++n) _Pragma("unroll") for (int k = 0; k < 2; ++k) dst[n][k] = *(const PG8_LAS bf16x8*)(lds + PG8_SB(b, h) + boff + n * 2048 + k * 1024); } while (0)
#define PG8_CAT(lo, hi) __builtin_shufflevector(__builtin_bit_cast(i32x4, lo), __builtin_bit_cast(i32x4, hi), 0, 1, 2, 3, 4, 5, 6, 7)
#define PG8_MMA(ai, bj, At, Bt) do { __builtin_amdgcn_s_setprio(1); _Pragma("unroll") for (int m = 0; m < 4; ++m) _Pragma("unroll") for (int n = 0; n < 2; ++n) { \
        if constexpr (F8) { const i32x8 b8_ = PG8_CAT(Bt[n][0], Bt[n][1]), a8_ = PG8_CAT(At[m][0], At[m][1]); asm volatile("v_mfma_f32_16x16x128_f8f6f4 %0, %1, %2, %0" : "+v"(acc[ai][bj][m][n]) : "v"(b8_), "v"(a8_)); } \
        else { _Pragma("unroll") for (int k = 0; k < 2; ++k) acc[ai][bj][m][n] = __builtin_amdgcn_mfma_f32_16x16x32_bf16(Bt[n][k], At[m][k], acc[ai][bj][m][n], 0, 0, 0); } } __builtin_amdgcn_s_setprio(0); } while (0)
#define PG8_WAIT_V(n) asm volatile("s_waitcnt vmcnt(" #n ")" ::: "memory")
#define PG8_WAIT_L(n) asm volatile("s_waitcnt lgkmcnt(" #n ")" ::: "memory")
#define PG8_BAR __builtin_amdgcn_s_barrier()
#define PG8_SCHED __builtin_amdgcn_sched_barrier(0)
    Unit cur, nxt; int ui = 0;
    if (!S.next(0, cur)) return;
    f32x4 acc[2][2][4][2];
#pragma unroll
    for (int a = 0; a < 2; ++a)
#pragma unroll
        for (int b = 0; b < 2; ++b)
#pragma unroll
            for (int m = 0; m < 4; ++m)
#pragma unroll
                for (int n = 0; n < 2; ++n) acc[a][b][m][n] = (f32x4){0.f, 0.f, 0.f, 0.f};
    bf16x8 At[4][2], B0[2][2], B1[2][2];
    const char* cA = (const char*)g.A + (size_t)cur.pm * tstep; const char* cB = (const char*)g.Bt + (size_t)cur.pn * tstep;
    S.a_ready(cur);
    if constexpr (SP2) {
        PG8_STAGE(PG8_SB(0, 0), cB, voffB); PG8_STAGE(PG8_SB(0, 1), cB + hstep, voffB); PG8_STAGE(PG8_SA(0, 0), cA, voffA); PG8_STAGE(PG8_SA(0, 1), cA + hstep, voffA);
        if (wr == 1) PG8_BAR;
        PG8_WAIT_V(2); PG8_BAR;
        PG8_STAGE(PG8_SB(1, 0), cB + kstep, voffB); PG8_STAGE(PG8_SA(1, 0), cA + kstep, voffA); PG8_STAGE(PG8_SB(1, 1), cB + hstep + kstep, voffB);
        PG8_WAIT_V(6); PG8_BAR;
    } else {
        PG8_STAGE(PG8_SB(0, 0), cB, voffB); PG8_STAGE(PG8_SA(0, 0), cA, voffA); PG8_STAGE(PG8_SB(0, 1), cB + hstep, voffB); PG8_STAGE(PG8_SA(0, 1), cA + hstep, voffA);
        if (wr == 1) PG8_BAR;
        PG8_WAIT_V(4); PG8_BAR;
        PG8_STAGE(PG8_SB(1, 0), cB + kstep, voffB); PG8_STAGE(PG8_SA(1, 0), cA + kstep, voffA); PG8_STAGE(PG8_SB(1, 1), cB + hstep + kstep, voffB);
        PG8_WAIT_V(6); PG8_BAR;
    }
    for (;;) {
        const bool has_next = S.next(ui + 1, nxt);
        const char* nA = has_next ? (const char*)g.A + (size_t)nxt.pm * tstep : cA; const char* nB = has_next ? (const char*)g.Bt + (size_t)nxt.pn * tstep : cB;
        for (int t = 0; t < nt; t += 2) { LA_G;
            const bool last = (t == nt - 2);
            const char* a1 = cA + (size_t)(t + 1) * kstep;
            const char* a2 = last ? nA : cA + (size_t)(t + 2) * kstep; const char* b2 = last ? nB : cB + (size_t)(t + 2) * kstep;
            const char* a3 = a2 + kstep; const char* b3 = b2 + kstep;
            if (last && has_next) S.a_ready(nxt);
            if constexpr (SP2) {
            PG8_LDB(B0, 0, 0); PG8_LDB(B1, 0, 1); PG8_SCHED; PG8_LDA(At, 0, 0); PG8_STAGE(PG8_SA(1, 1), a1 + hstep, voffA);
            PG8_WAIT_V(8); PG8_WAIT_L(0); PG8_BAR; PG8_MMA(0, 0, At, B0); PG8_MMA(0, 1, At, B1); PG8_BAR; PG8_SCHED;
            PG8_LDA(At, 0, 1); PG8_STAGE(PG8_SB(0, 0), b2, voffB); PG8_STAGE(PG8_SB(0, 1), b2 + hstep, voffB); PG8_STAGE(PG8_SA(0, 0), a2, voffA);
            PG8_WAIT_V(8); PG8_WAIT_L(0); PG8_BAR; PG8_MMA(1, 0, At, B0); PG8_MMA(1, 1, At, B1); PG8_BAR; PG8_SCHED;
            PG8_LDB(B0, 1, 0); PG8_LDB(B1, 1, 1); PG8_SCHED; PG8_LDA(At, 1, 0); PG8_STAGE(PG8_SA(0, 1), a2 + hstep, voffA);
            PG8_WAIT_V(8); PG8_WAIT_L(0); PG8_BAR; PG8_MMA(0, 0, At, B0); PG8_MMA(0, 1, At, B1); PG8_BAR; PG8_SCHED;
            PG8_LDA(At, 1, 1); PG8_STAGE(PG8_SB(1, 0), b3, voffB); PG8_STAGE(PG8_SB(1, 1), b3 + hstep, voffB); PG8_STAGE(PG8_SA(1, 0), a3, voffA);
            PG8_WAIT_V(8); PG8_WAIT_L(0); PG8_BAR; PG8_MMA(1, 0, At, B0); PG8_MMA(1, 1, At, B1); PG8_BAR; PG8_SCHED;
            } else {
            PG8_LDB(B0, 0, 0); PG8_SCHED; PG8_LDA(At, 0, 0); PG8_STAGE(PG8_SA(1, 1), a1 + hstep, voffA);
            PG8_WAIT_L(8); PG8_BAR; PG8_WAIT_L(0); PG8_MMA(0, 0, At, B0); PG8_BAR; PG8_SCHED;
            PG8_LDB(B1, 0, 1); PG8_STAGE(PG8_SB(0, 0), b2, voffB);
            PG8_BAR; PG8_WAIT_L(0); PG8_MMA(0, 1, At, B1); PG8_BAR;
            PG8_LDA(At, 0, 1); PG8_STAGE(PG8_SA(0, 0), a2, voffA);
            PG8_BAR; PG8_WAIT_L(0); PG8_MMA(1, 0, At, B0); PG8_BAR; PG8_SCHED;
            PG8_STAGE(PG8_SB(0, 1), b2 + hstep, voffB);
            PG8_WAIT_V(6); PG8_BAR; PG8_MMA(1, 1, At, B1); PG8_BAR;
            PG8_LDB(B0, 1, 0); PG8_SCHED; PG8_LDA(At, 1, 0); PG8_STAGE(PG8_SA(0, 1), a2 + hstep, voffA);
            PG8_WAIT_L(8); PG8_BAR; PG8_WAIT_L(0); PG8_MMA(0, 0, At, B0); PG8_BAR; PG8_SCHED;
            PG8_LDB(B1, 1, 1); PG8_STAGE(PG8_SB(1, 0), b3, voffB);
            PG8_BAR; PG8_WAIT_L(0); PG8_MMA(0, 1, At, B1); PG8_BAR;
            PG8_LDA(At, 1, 1); PG8_STAGE(PG8_SA(1, 0), a3, voffA);
            PG8_BAR; PG8_WAIT_L(0); PG8_MMA(1, 0, At, B0); PG8_BAR; PG8_SCHED;
            PG8_STAGE(PG8_SB(1, 1), b3 + hstep, voffB);
            PG8_WAIT_V(6); PG8_BAR; PG8_MMA(1, 1, At, B1); PG8_BAR;
            }
        }
        if constexpr (F8) asm volatile("s_nop 15\n\ts_nop 15" ::: "memory");
        if constexpr (ALIGN_EPI) { if (wr == 0) PG8_BAR; }
        if constexpr (!Epi::AFTER_DRAIN) { E(acc, cur, wr, wc, fr, fq); S.done(cur); }
        if (!has_next) break;
#pragma unroll
        for (int a = 0; a < 2; ++a)
#pragma unroll
            for (int b = 0; b < 2; ++b)
#pragma unroll
                for (int m = 0; m < 4; ++m)
#pragma unroll
                    for (int n = 0; n < 2; ++n) acc[a][b][m][n] = (f32x4){0.f, 0.f, 0.f, 0.f};
        cur = nxt; cA = nA; cB = nB; ++ui;
        if constexpr (ALIGN_EPI) { if (wr == 1) PG8_BAR; }
    }
    PG8_WAIT_V(0);
    if constexpr (!ALIGN_EPI) { if (wr == 0) PG8_BAR; }
    PG8_BAR;
    if constexpr (Epi::AFTER_DRAIN) { E.fused(acc, cur, wr, wc, fr, fq, lds, wid, lane); S.done(cur); }
#undef PG8_SA
#undef PG8_SB
#undef PG8_STAGE
#undef PG8_LDA
#undef PG8_LDB
#undef PG8_MMA
#undef PG8_CAT
#undef PG8_WAIT_V
#undef PG8_WAIT_L
#undef PG8_BAR
#undef PG8_SCHED
}
}

constexpr int NWAVES = 8, GRID = 256;
constexpr int BATCH = 4, SEQ = 8192, DM = 1024, MTOK = BATCH * SEQ, DEPTH = 4;
constexpr int NA_SRC = 2120, NA_PAD = 2304, NB = 3072, FF = 2816, NUP = 2 * FF;
constexpr float EPS = 1e-6f;
constexpr float LOG2E = 1.4426950408889634f;
constexpr float C2 = 0.125f * LOG2E;
constexpr int NBLK64 = MTOK / 64;

constexpr size_t MiB = 1u << 20;
constexpr size_t WS_CTL = 0, CTL_ZERO_BYTES = 1 * MiB;
constexpr size_t WS_W_INA = 2 * MiB;
constexpr size_t WS_W_INB = 11 * MiB;
constexpr size_t WS_W_OUT = 23 * MiB;
constexpr size_t WS_W_UP = 31 * MiB;
constexpr size_t WS_W_DN = 75 * MiB;
constexpr size_t WS_HB = 98 * MiB;
constexpr size_t WS_M = 162 * MiB;
constexpr size_t WS_SS = 226 * MiB;
constexpr size_t WS_HALO = 228 * MiB;
constexpr size_t WS_PROJ = 272 * MiB;
constexpr size_t WS_END = 464 * MiB;
constexpr size_t PA_QA = 0, PA_KA = 64 * MiB, PA_VA = 80 * MiB, PA_QI = 96 * MiB, PA_KI = 128 * MiB, PA_WI = 132 * MiB, PA_SEL = 136 * MiB;
constexpr size_t PB_STRIDE = 64 * MiB;
constexpr int CW_BAR = 4096;
constexpr int F8_L0 = 2;
#ifndef F8M_IN
#define F8M_IN 0x8
#endif
#ifndef F8M_OUT
#define F8M_OUT 0xC
#endif
#ifndef F8M_FFN
#define F8M_FFN 0xC
#endif
#define F8M_ALL ((F8M_IN & 0xA) | ((F8M_OUT & 0xF) << 4) | ((F8M_FFN & 0xF) << 8))
__host__ __device__ constexpr bool f8_in(int m, int L) { return L < DEPTH && ((m >> L) & 1) != 0; }
__host__ __device__ constexpr bool f8_out(int m, int L) { return ((m >> (4 + L)) & 1) != 0; }
__host__ __device__ constexpr bool f8_ffn(int m, int L) { return ((m >> (8 + L)) & 1) != 0; }
constexpr size_t PX_HB8 = 96 * MiB;
constexpr float W8S = 128.f, W8I = 1.f / 128.f;

constexpr int RING_OFF = 0, RING_BYTES = 131072;
constexpr int KS_OFF = RING_BYTES;
constexpr int AUX_OFF = RING_BYTES + 24576;
constexpr int LDSCTL_OFF = AUX_OFF + 4096, MISC_OFF = LDSCTL_OFF + 320;
constexpr int LDS_BYTES = 163840;
static_assert(MISC_OFF + 128 <= LDS_BYTES, "LDS map");

#define GAS __attribute__((address_space(1)))
#define LAS __attribute__((address_space(3)))
typedef unsigned short bf16;
typedef unsigned v4u __attribute__((ext_vector_type(4)));
typedef unsigned v2u __attribute__((ext_vector_type(2)));
typedef float f32x4 __attribute__((ext_vector_type(4)));
typedef float f32x16 __attribute__((ext_vector_type(16)));
typedef short bf16x8 __attribute__((ext_vector_type(8)));
typedef short s16x4 __attribute__((ext_vector_type(4)));
typedef float f32x2_t __attribute__((ext_vector_type(2)));
typedef GAS unsigned gu32;
#define RLX_AGENT __ATOMIC_RELAXED, __HIP_MEMORY_SCOPE_AGENT
#define LDS_WAIT() asm volatile("s_waitcnt lgkmcnt(0)" ::: "memory")
#define VM_WAIT() asm volatile("s_waitcnt vmcnt(0)" ::: "memory")
__device__ __forceinline__ unsigned f2bf(float f) { unsigned u = __builtin_bit_cast(unsigned, f); return (u + 0x7fffu + ((u >> 16) & 1u)) >> 16; }
__device__ __forceinline__ unsigned pk2(float lo, float hi) { return f2bf(lo) | (f2bf(hi) << 16); }
typedef float f32x2c_t __attribute__((ext_vector_type(2))); typedef __bf16 bf16x2c_t __attribute__((ext_vector_type(2)));
__device__ __forceinline__ unsigned cvtpk(float lo, float hi) { const f32x2c_t v = {lo, hi}; const bf16x2c_t b = __builtin_convertvector(v, bf16x2c_t); return __builtin_bit_cast(unsigned, b); }
__device__ __forceinline__ float bf_lo(unsigned u) { return __builtin_bit_cast(float, u << 16); }
__device__ __forceinline__ float bf_hi(unsigned u) { return __builtin_bit_cast(float, u & 0xffff0000u); }

__device__ __forceinline__ unsigned pk4f8(float a, float b, float c, float d) { int r = __builtin_amdgcn_cvt_pk_fp8_f32(a, b, 0, false); r = __builtin_amdgcn_cvt_pk_fp8_f32(c, d, r, true); return (unsigned)r; }

#define XB_TMO      128
#define XB_XCNT(j)  (256  + 64 * (j))
#define XB_XSUB(j)  (1280 + 64 * (j))
#define XB_XGEN(j)  (2304 + 64 * (j))
#define XB_TOP      3328
#define XB_TOPGEN   3392
#define XCD_BAR_WORDS 3456
#define XB_SPIN_CAP (1u << 18)

__device__ __forceinline__ unsigned xb_ld(unsigned* p)              { return __hip_atomic_load(p, __ATOMIC_RELAXED, __HIP_MEMORY_SCOPE_AGENT); }
__device__ __forceinline__ unsigned xb_add(unsigned* p, unsigned v) { return __hip_atomic_fetch_add(p, v, __ATOMIC_RELAXED, __HIP_MEMORY_SCOPE_AGENT); }
__device__ __forceinline__ unsigned xb_xcc_id() { return (unsigned)__builtin_amdgcn_s_getreg((3 << 11) | 20) & 0xFu; }
#define XB_SPIN(cond, bar) do { unsigned _sp = 0; while (cond) { __builtin_amdgcn_s_sleep(1); \
    if ((++_sp & 255u) == 0u) { if (xb_ld(&(bar)[XB_TMO])) break; if (_sp > XB_SPIN_CAP) { atomicAdd(&(bar)[XB_TMO], 1u); break; } } } } while (0)

struct XcdBarrier {
    unsigned* bar; unsigned x;
    volatile LAS unsigned* st;
};

__device__ __forceinline__ XcdBarrier xcd_barrier_post(unsigned* bar, volatile LAS unsigned* st) {
    XcdBarrier b; b.bar = bar; b.x = xb_xcc_id(); b.st = st;
    if (threadIdx.x == 0) (void)xb_add(&bar[XB_XCNT(b.x)], 1u);
    return b;
}
__device__ __forceinline__ void xcd_barrier_complete(unsigned* bar, unsigned x, unsigned& nloc, unsigned& nx) {
    const unsigned G = gridDim.x * gridDim.y * gridDim.z;
    unsigned sum, cnt, mine, sp = 0u;
    for (;;) {
        sum = 0u; cnt = 0u; mine = 0u;
#pragma unroll
        for (unsigned j = 0; j < 16; ++j) { const unsigned c = xb_ld(&bar[XB_XCNT(j)]); sum += c; cnt += (c > 0u) ? 1u : 0u; mine = (j == x) ? c : mine; }
        if (sum == G) break;
        __builtin_amdgcn_s_sleep(1);
        if ((++sp & 255u) == 0u) { if (xb_ld(&bar[XB_TMO])) break; if (sp > XB_SPIN_CAP) { atomicAdd(&bar[XB_TMO], 1u); break; } }
    }
    nloc = mine > 0u ? mine : 1u; nx = cnt > 0u ? cnt : 1u;
}

__device__ __forceinline__ void xcd_barrier(const XcdBarrier& b) {
    asm volatile("s_waitcnt vmcnt(0)" ::: "memory");
    __syncthreads();
    if (threadIdx.x == 0) {
        unsigned* bar = b.bar;
        __builtin_amdgcn_s_waitcnt(0);
        unsigned nloc = b.st[0], nx = b.st[1];
        if (nloc == 0u) { xcd_barrier_complete(bar, b.x, nloc, nx); b.st[0] = nloc; b.st[1] = nx; }
        const unsigned old = xb_add(&bar[XB_XSUB(b.x)], 1u);
        const unsigned gen = old / nloc;
        if (old + 1u == (gen + 1u) * nloc) {
            __builtin_amdgcn_fence(__ATOMIC_RELEASE, "agent");
            asm volatile("s_waitcnt vmcnt(0)" ::: "memory");
            const unsigned og = xb_add(&bar[XB_TOP], 1u);
            const unsigned tg = og / nx;
            if (og + 1u == (tg + 1u) * nx) xb_add(&bar[XB_TOPGEN], 1u);
            else XB_SPIN(xb_ld(&bar[XB_TOPGEN]) == tg, bar);
            __builtin_amdgcn_fence(__ATOMIC_ACQUIRE, "agent");
            xb_add(&bar[XB_XGEN(b.x)], 1u);
            asm volatile("s_waitcnt vmcnt(0)" ::: "memory");
        } else {
            XB_SPIN(xb_ld(&bar[XB_XGEN(b.x)]) == gen, bar);
            __builtin_amdgcn_fence(__ATOMIC_ACQUIRE, "agent");
            asm volatile("s_waitcnt vmcnt(0)" ::: "memory");
        }
    }
    __syncthreads();
}


struct Args {
    const float* x; const float* attn_norm_g; const float* w_in_a; const float* w_in_b; const float* q_norm_g; const float* k_norm_g; const float* t5_bias;
    const float* rel_bias_b; const float* w_out; const float* ffn_norm_g; const float* w_up; const float* conv_w; const float* conv_b; const float* w_down;
    float* out; unsigned char* ws; int ph_lo, ph_hi, li, f8m;
};

struct Frame {
    LAS unsigned char* lds;
    volatile LAS unsigned* MISC;
    gu32* ctl;
    int tid, lane, wave, vcu, G;
};

__host__ __device__ __forceinline__ int hmap(int p) { return 64 * ((p >> 5) & 3) + 16 * ((p >> 2) & 3) + 8 * (p >> 7) + 4 * ((p >> 4) & 1) + (p & 3); }
__host__ __device__ __forceinline__ int umap(int p) { return 32 * ((p >> 5) & 3) + 8 * ((p >> 2) & 3) + 4 * ((p >> 4) & 1) + (p & 3); }
__host__ __device__ __forceinline__ int src_col(int type, int n) {
    if (type == 0) return n;
    const int pn = n >> 8, p = n & 255;
    if (type == 2) return 256 * pn + hmap(p);
    if (type == 1) { const int c = hmap(p); return pn < 8 ? 256 * pn + c : (c < 72 ? 2048 + c : -1); }
    return (p >> 7) * FF + 128 * pn + umap(p);
}
__device__ __forceinline__ void convert_item(const float* W, int K, int Nsrc, int Ndst, int type, const float* gain, bf16* WT, LAS float* scr, int item, int lane, bool o8 = false) {
    const int nblk = Ndst / 32, kb = item / nblk, nb = item % nblk, k0 = 64 * kb, n0 = 32 * nb;
    const int sc = src_col(type, n0 + (lane & 31));
#pragma unroll 8
    for (int i = 0; i < 32; ++i) { const int kk = 2 * i + (lane >> 5); float v = 0.f; if (sc >= 0) v = W[(size_t)(k0 + kk) * Nsrc + sc]; if (gain) v *= gain[k0 + kk]; scr[kk * 33 + (lane & 31)] = v; }
    LDS_WAIT(); asm volatile("" ::: "memory");
    const int c = lane & 7;
#pragma unroll
    for (int j = 0; j < 4; ++j) { const int n = (lane >> 3) + 8 * j; const LAS float* s = scr + (8 * c) * 33 + n;
        if (o8) { v2u o; o.x = pk4f8(s[0 * 33] * W8S, s[1 * 33] * W8S, s[2 * 33] * W8S, s[3 * 33] * W8S); o.y = pk4f8(s[4 * 33] * W8S, s[5 * 33] * W8S, s[6 * 33] * W8S, s[7 * 33] * W8S);
            *(v2u*)((unsigned char*)WT + (size_t)(n0 + n) * K + k0 + 8 * c) = o; }
        else { v4u o; o.x = pk2(s[0 * 33], s[1 * 33]); o.y = pk2(s[2 * 33], s[3 * 33]); o.z = pk2(s[4 * 33], s[5 * 33]); o.w = pk2(s[6 * 33], s[7 * 33]);
            *(v4u*)(WT + (size_t)(n0 + n) * K + k0 + 8 * c) = o; } }
    LDS_WAIT(); asm volatile("" ::: "memory");
}
__device__ __forceinline__ float wave_sum(float v) {
#pragma unroll
    for (int o = 1; o < 64; o <<= 1) v += __shfl_xor(v, o);
    return v;
}
#ifdef F8M_RUNTIME
#define F8MV a.f8m
#else
#define F8MV F8M_ALL
#endif
__device__ __forceinline__ void p0_prologue(Frame& F, const Args& a) {
    LAS float* scr = (LAS float*)(F.lds + RING_OFF + F.wave * 16384);
    const int gw = F.vcu * NWAVES + F.wave, NGW = F.G * NWAVES;
    constexpr int I_INA = 16 * (NA_PAD / 32), I_INB = 16 * (NB / 32), I_OUT = 16 * 32, I_UP = 16 * (NUP / 32), I_DN = (FF / 64) * 32;
    constexpr int NITEMS = 2 * I_INA + 2 * I_INB + 4 * I_OUT + 4 * I_UP + 4 * I_DN;
    unsigned char* ws = a.ws;
    for (int it = gw; it < NITEMS; it += NGW) {
        int r = it;
        if (r < 2 * I_INA) { const int l = r / I_INA; convert_item(a.w_in_a + (size_t)l * DM * NA_SRC, DM, NA_SRC, NA_PAD, 1, a.attn_norm_g + (2 * l) * DM, (bf16*)(ws + WS_W_INA) + (size_t)l * NA_PAD * DM, scr, r % I_INA, F.lane); continue; } r -= 2 * I_INA;
        if (r < 2 * I_INB) { const int l = r / I_INB; convert_item(a.w_in_b + (size_t)l * DM * NB, DM, NB, NB, 2, a.attn_norm_g + (2 * l + 1) * DM, (bf16*)(ws + WS_W_INB) + (size_t)l * NB * DM, scr, r % I_INB, F.lane, f8_in(F8MV, 2 * l + 1)); continue; } r -= 2 * I_INB;
        if (r < 4 * I_OUT) { const int l = r / I_OUT; convert_item(a.w_out + (size_t)l * DM * DM, DM, DM, DM, 0, nullptr, (bf16*)(ws + WS_W_OUT) + (size_t)l * DM * DM, scr, r % I_OUT, F.lane, f8_out(F8MV, l)); continue; } r -= 4 * I_OUT;
        if (r < 4 * I_UP) { const int l = r / I_UP; convert_item(a.w_up + (size_t)l * DM * NUP, DM, NUP, NUP, 3, a.ffn_norm_g + l * DM, (bf16*)(ws + WS_W_UP) + (size_t)l * NUP * DM, scr, r % I_UP, F.lane, f8_ffn(F8MV, l)); continue; } r -= 4 * I_UP;
        { const int l = r / I_DN; convert_item(a.w_down + (size_t)l * FF * DM, FF, DM, DM, 0, nullptr, (bf16*)(ws + WS_W_DN) + (size_t)l * DM * FF, scr, r % I_DN, F.lane, f8_ffn(F8MV, l)); }
    }
    bf16* hb = (bf16*)(ws + WS_HB); float* ss = (float*)(ws + WS_SS);
    for (int m = gw; m < MTOK; m += NGW) {
        const f32x4* xr = (const f32x4*)(a.x + (size_t)m * DM) + F.lane; f32x4 v[4]; float s = 0.f;
#pragma unroll
        for (int j = 0; j < 4; ++j) { v[j] = xr[64 * j]; s += (v[j].x * v[j].x + v[j].y * v[j].y) + (v[j].z * v[j].z + v[j].w * v[j].w); }
        s = wave_sum(s);
        v2u* o8 = (v2u*)(hb + (size_t)m * DM) + F.lane;
#pragma unroll
        for (int j = 0; j < 4; ++j) { v2u w; w.x = pk2(v[j].x, v[j].y); w.y = pk2(v[j].z, v[j].w); o8[64 * j] = w; }
        if (F.lane < 16) ss[(size_t)m * 16 + F.lane] = (F.lane == 0) ? s : 0.f;
    }
}

__device__ __forceinline__ f32x4 rstd_load(const float* ss, int row, int fq) { return *(const f32x4*)(ss + (size_t)row * 16 + 4 * fq); }
__device__ __forceinline__ float rstd_finish(f32x4 a) {
    float s = (a.x + a.y) + (a.z + a.w);
    s += __shfl_xor(s, 16); s += __shfl_xor(s, 32);
    return __builtin_amdgcn_rsqf(s * (1.0f / DM) + EPS);
}
__device__ __forceinline__ float row_rstd(const float* ss, int row, int fq) { return rstd_finish(rstd_load(ss, row, fq)); }
__device__ __forceinline__ unsigned att_pk4(f32x4 v) { int r = __builtin_amdgcn_cvt_pk_fp8_f32(v.x, v.y, 0, false); r = __builtin_amdgcn_cvt_pk_fp8_f32(v.z, v.w, r, true); return (unsigned)r; }
struct EpiIn {
    static constexpr bool PERM = false, PERMA = false, AFTER_DRAIN = false;
    const float* ss; unsigned char* proj; const float* qg; const float* kg; int isB; float as;
    __device__ __forceinline__ void operator()(const pg8::f32x4 (&acc)[2][2][4][2], const pg8::Unit& u, int wr, int wc, int fr, int fq) const {
        asm volatile("" : "+v"(fr), "+v"(fq));
        const int pn = u.pn; int kind, pitch; bf16* dst;
        if (isB) { const int t = pn >> 2; kind = (t == 0) ? 1 : (t == 1 ? 2 : 0); dst = (bf16*)(proj + (size_t)t * PB_STRIDE) + 256 * (pn & 3); pitch = DM; }
        else if (pn < 4) { kind = 1; dst = (bf16*)(proj + PA_QA) + 256 * pn; pitch = DM; }
        else if (pn == 4) { kind = 2; dst = (bf16*)(proj + PA_KA); pitch = 256; }
        else if (pn == 5) { kind = 0; dst = (bf16*)(proj + PA_VA); pitch = 256; }
        else if (pn < 8) { kind = 0; dst = (bf16*)(proj + PA_QI) + 256 * (pn - 6); pitch = 512; }
        else { kind = 3; dst = (bf16*)(proj + PA_KI); pitch = 64; }
        if (kind == 3 && wc >= 2) return;
        const bool donorm = (kind == 1) || (kind == 2) || (kind == 3 && wc == 0);
        f32x4 g[2][2];
#pragma unroll
        for (int bj = 0; bj < 2; ++bj)
#pragma unroll
            for (int n = 0; n < 2; ++n) {
                if (kind == 1) g[bj][n] = *(const f32x4*)(qg + 16 * fq + 8 * bj + 4 * n) * (isB ? C2 : 1.0f);
                else if (kind == 2) g[bj][n] = *(const f32x4*)(kg + 16 * fq + 8 * bj + 4 * n);
                else g[bj][n] = (f32x4){1.f, 1.f, 1.f, 1.f};
            }
        float* wi = (float*)(proj + PA_WI);
        f32x4 rsl[2][4];
#pragma unroll
        for (int ai = 0; ai < 2; ++ai)
#pragma unroll
            for (int m = 0; m < 4; ++m) rsl[ai][m] = rstd_load(ss, u.pm * 256 + ai * 128 + wr * 64 + m * 16 + fr, fq);
#pragma unroll
        for (int ai = 0; ai < 2; ++ai)
#pragma unroll
            for (int m = 0; m < 4; ++m) {
                const int row = u.pm * 256 + ai * 128 + wr * 64 + m * 16 + fr;
                const float rs = rstd_finish(rsl[ai][m]) * as;
                f32x4 v[2][2]; float s = 0.f;
#pragma unroll
                for (int bj = 0; bj < 2; ++bj)
#pragma unroll
                    for (int n = 0; n < 2; ++n) { v[bj][n] = acc[ai][bj][m][n] * rs; const f32x4 q = v[bj][n] * v[bj][n]; s += (q.x + q.y) + (q.z + q.w); }
                if (donorm) {
                    s += __shfl_xor(s, 16); s += __shfl_xor(s, 32);
                    const float r = 1.0f / sqrtf(s * (1.0f / 64.0f) + EPS);
#pragma unroll
                    for (int bj = 0; bj < 2; ++bj)
#pragma unroll
                        for (int n = 0; n < 2; ++n) v[bj][n] = v[bj][n] * r * g[bj][n];
                }
                if (kind == 3 && wc == 1) {
                    if (fq == 0) { float* wp = wi + (size_t)row * 8; const float sc = 0.04419417382415922f;
                        *(f32x4*)(wp) = v[0][0] * sc; *(f32x4*)(wp + 4) = v[0][1] * sc; }
                } else if (!isB && pn < 6) {
                    unsigned char* p8 = (pn < 4) ? proj + PA_QA + (size_t)row * 1024 + 256 * pn + 64 * wc + 16 * fq : proj + PA_KA + (size_t)row * 512 + 128 * wc + 64 * (pn - 4) + 16 * fq;
                    v4u w; w.x = att_pk4(v[0][0]); w.y = att_pk4(v[0][1]); w.z = att_pk4(v[1][0]); w.w = att_pk4(v[1][1]);
                    *(v4u*)p8 = w;
                } else {
                    bf16* rp = dst + (size_t)row * pitch + 64 * wc + 16 * fq;
#pragma unroll
                    for (int bj = 0; bj < 2; ++bj) { v4u w; w.x = cvtpk(v[bj][0].x, v[bj][0].y); w.y = cvtpk(v[bj][0].z, v[bj][0].w); w.z = cvtpk(v[bj][1].x, v[bj][1].y); w.w = cvtpk(v[bj][1].z, v[bj][1].w);
                        *(v4u*)(rp + 8 * bj) = w; }
                }
            }
    }
};
template <int MODE>
struct EpiResT {
    static constexpr bool PERM = false, PERMA = false, AFTER_DRAIN = false;
    float* fout; const bf16* hbi; bf16* hb; float* ss; unsigned char* hb8; const float* xin;
    __device__ __forceinline__ void operator()(const pg8::f32x4 (&acc)[2][2][4][2], const pg8::Unit& u, int wr, int wc, int fr, int fq) const {
        if (fout) body<true, false, false>(acc, u, wr, wc, fr, fq); else if (hb8) body<false, true, false>(acc, u, wr, wc, fr, fq); else if (xin) body<false, false, true>(acc, u, wr, wc, fr, fq); else body<false, false, false>(acc, u, wr, wc, fr, fq);
    }
    template <bool FOUT, bool HB8, bool XIN>
    __device__ __forceinline__ void body(const pg8::f32x4 (&acc)[2][2][4][2], const pg8::Unit& u, int wr, int wc, int fr, int fq) const {
        asm volatile("" : "+v"(fr), "+v"(fq));
        const int col0 = u.pn * 256 + wc * 32 + 4 * fq;
#pragma unroll
        for (int ai = 0; ai < 2; ++ai) {
            v2u base[4][2][2]; f32x4 basex[XIN ? 4 : 1][2][2];
#pragma unroll
            for (int m = 0; m < 4; ++m)
#pragma unroll
                for (int bj = 0; bj < 2; ++bj)
#pragma unroll
                    for (int n = 0; n < 2; ++n) { const size_t o4 = (size_t)(u.pm * 256 + ai * 128 + wr * 64 + m * 16 + fr) * DM + col0 + bj * 128 + n * 16; if constexpr (XIN) basex[m][bj][n] = *(const f32x4*)(xin + o4); else base[m][bj][n] = *(const v2u*)(hbi + o4);
                        if ((MODE & 4) && n == 1) asm volatile("s_waitcnt vmcnt(0)" ::: "memory"); }
            asm volatile("" ::: "memory");
#pragma unroll
            for (int m = 0; m < 4; ++m) {
                const int row = u.pm * 256 + ai * 128 + wr * 64 + m * 16 + fr; const size_t off = (size_t)row * DM + col0; float s = 0.f;
#pragma unroll
                for (int bj = 0; bj < 2; ++bj)
#pragma unroll
                    for (int n = 0; n < 2; ++n) { const size_t o4 = off + bj * 128 + n * 16;
                        f32x4 bs; if constexpr (XIN) bs = basex[m][bj][n]; else { const v2u b = base[m][bj][n]; bs = (f32x4){bf_lo(b.x), bf_hi(b.x), bf_lo(b.y), bf_hi(b.y)}; }
                        const f32x4 o = (MODE & 1) ? bs + acc[ai][bj][m][n] * W8I : bs + acc[ai][bj][m][n];
                        if constexpr (FOUT) *(f32x4*)(fout + o4) = o;
                        else { const f32x4 q = o * o; s += (q.x + q.y) + (q.z + q.w); v2u w; w.x = cvtpk(o.x, o.y); w.y = cvtpk(o.z, o.w); *(v2u*)(hb + o4) = w;
                            if constexpr (HB8) *(unsigned*)(hb8 + o4) = pk4f8(o.x, o.y, o.z, o.w); } }
                if constexpr (!FOUT) { s += __shfl_xor(s, 16); s += __shfl_xor(s, 32); if (fq == 0) ss[(size_t)row * 16 + u.pn * 4 + wc] = s; }
            }
        }
    }
};
typedef EpiResT<0> EpiRes;
#ifndef SER_OUT
#define SER_OUT 0
#endif
#ifdef X_NOBPERM
__device__ __forceinline__ float lane_from(int byteaddr, float v) { return v + (float)byteaddr; }
#else
__device__ __forceinline__ float lane_from(int byteaddr, float v) { return __builtin_bit_cast(float, __builtin_amdgcn_ds_bpermute(byteaddr, __builtin_bit_cast(int, v))); }
#endif
#ifdef X_NOSILU
__device__ __forceinline__ float silu_mul(float a, float g) { return a * g; }
#else
__device__ __forceinline__ float silu_mul(float a, float g) { return a * g * __builtin_amdgcn_rcpf(1.0f + __builtin_amdgcn_exp2f(-g * LOG2E)); }
#endif
__device__ __forceinline__ float dpp_prev_lane(float v) { return __builtin_bit_cast(float, __builtin_amdgcn_update_dpp(0, __builtin_bit_cast(int, v), 0x111  , 0xf, 0xf, true)); }
template <bool F8>
struct EpiUpT {
    static constexpr bool PERM = false, PERMA = true, AFTER_DRAIN = false;
    const float* ss; const float* cw; const float* cb; bf16* act; float* halo; LAS float* cl;
    __device__ __forceinline__ void operator()(const pg8::f32x4 (&acc)[2][2][4][2], const pg8::Unit& u, int wr, int wc, int fr, int fq) const {
        asm volatile("" : "+v"(fr), "+v"(fq));
        const int colb = u.pn * 128 + wc * 32 + 8 * fq;
        const int tid_ = ((wr * 4 + wc) * 4 + fq) * 16 + fr, ce = 2 * tid_, cbj = ce >> 9, carr = (ce >> 7) & 3, cc = ce & 127;
        const f32x2_t cpre = *(const f32x2_t*)((carr < 3 ? cw + carr * NUP : cb) + cbj * FF + u.pn * 128 + cc);
        f32x4 rsl[2][4];
#pragma unroll
        for (int ai = 0; ai < 2; ++ai)
#pragma unroll
            for (int m = 0; m < 4; ++m) rsl[ai][m] = rstd_load(ss, (u.pm * 4 + ai * 2 + wr) * 64 + 4 * fr + m, fq);
        unsigned pk[2][2][4][2][2];
#pragma unroll
        for (int ai = 0; ai < 2; ++ai) {
#pragma unroll
            for (int m = 0; m < 4; ++m) {
                const float rs = F8 ? rstd_finish(rsl[ai][m]) * W8I : rstd_finish(rsl[ai][m]);
#pragma unroll
                for (int bj = 0; bj < 2; ++bj)
#pragma unroll
                    for (int n = 0; n < 2; ++n) { const f32x4 v = acc[ai][bj][m][n] * rs; pk[ai][bj][m][n][0] = cvtpk(v.x, v.y); pk[ai][bj][m][n][1] = cvtpk(v.z, v.w); }
            }
        }
        *(LAS f32x2_t*)(cl + ce) = cpre;
        asm volatile("s_waitcnt lgkmcnt(0)" ::: "memory"); __builtin_amdgcn_s_barrier(); asm volatile("" ::: "memory");
        __builtin_amdgcn_sched_barrier(0);
        if (fr == 0 || fr == 15) {
#pragma unroll
            for (int ai = 0; ai < 2; ++ai)
#pragma unroll
                for (int j = 0; j < 2; ++j)
#pragma unroll
                    for (int bj = 0; bj < 2; ++bj)
#pragma unroll
                        for (int n = 0; n < 2; ++n) { const unsigned w0 = (fr == 0) ? pk[ai][bj][j][n][0] : pk[ai][bj][2 + j][n][0], w1 = (fr == 0) ? pk[ai][bj][j][n][1] : pk[ai][bj][2 + j][n][1];
                            *(f32x4*)(halo + ((size_t)(u.pm * 4 + ai * 2 + wr) * 4 + (fr == 0 ? j : 2 + j)) * NUP + bj * FF + colb + 4 * n) = (f32x4){bf_lo(w0), bf_hi(w0), bf_lo(w1), bf_hi(w1)}; }
        }
        __builtin_amdgcn_sched_barrier(0);
#pragma unroll
        for (int ai = 0; ai < 2; ++ai) {
            const int row0 = (u.pm * 4 + ai * 2 + wr) * 64 + 4 * fr;
            unsigned outp[4][2][2];
#pragma unroll
            for (int n = 0; n < 2; ++n) {
#pragma unroll
                for (int ip = 0; ip < 2; ++ip) {
                    f32x2_t k0[2], k1[2], k2[2], kb[2];
#pragma unroll
                    for (int bj = 0; bj < 2; ++bj) { const LAS float* c = cl + bj * 512 + wc * 32 + 8 * fq + 4 * n + 2 * ip; k0[bj] = *(const LAS f32x2_t*)(c); k1[bj] = *(const LAS f32x2_t*)(c + 128); k2[bj] = *(const LAS f32x2_t*)(c + 256); kb[bj] = *(const LAS f32x2_t*)(c + 384); }
                    float y[2][4][2];
#pragma unroll
                    for (int bj = 0; bj < 2; ++bj) {
                        const unsigned w0 = pk[ai][bj][0][n][ip], w1 = pk[ai][bj][1][n][ip], w2 = pk[ai][bj][2][n][ip], w3 = pk[ai][bj][3][n][ip];
                        const unsigned q1 = (unsigned)__builtin_amdgcn_update_dpp(0, (int)w3, 0x111, 0xf, 0xf, true), q2 = (unsigned)__builtin_amdgcn_update_dpp(0, (int)w2, 0x111, 0xf, 0xf, true);
#pragma unroll
                        for (int e = 0; e < 2; ++e) { const int i = e;
                            const float u0 = e ? bf_hi(w0) : bf_lo(w0), u1 = e ? bf_hi(w1) : bf_lo(w1), u2 = e ? bf_hi(w2) : bf_lo(w2), u3 = e ? bf_hi(w3) : bf_lo(w3), p1 = e ? bf_hi(q1) : bf_lo(q1), p2 = e ? bf_hi(q2) : bf_lo(q2);
                            y[bj][0][e] = kb[bj][i] + k0[bj][i] * p2 + k1[bj][i] * p1 + k2[bj][i] * u0;
                            y[bj][1][e] = kb[bj][i] + k0[bj][i] * p1 + k1[bj][i] * u0 + k2[bj][i] * u1;
                            y[bj][2][e] = kb[bj][i] + k0[bj][i] * u0 + k1[bj][i] * u1 + k2[bj][i] * u2;
                            y[bj][3][e] = kb[bj][i] + k0[bj][i] * u1 + k1[bj][i] * u2 + k2[bj][i] * u3; }
                    }
#pragma unroll
                    for (int m = 0; m < 4; ++m) {
                        if constexpr (F8) { if (ip == 0) outp[m][n][0] = (unsigned)__builtin_amdgcn_cvt_pk_fp8_f32(silu_mul(y[0][m][0], y[1][m][0]), silu_mul(y[0][m][1], y[1][m][1]), 0, false);
                            else outp[m][n][0] = (unsigned)__builtin_amdgcn_cvt_pk_fp8_f32(silu_mul(y[0][m][0], y[1][m][0]), silu_mul(y[0][m][1], y[1][m][1]), (int)outp[m][n][0], true); }
                        else outp[m][n][ip] = cvtpk(silu_mul(y[0][m][0], y[1][m][0]), silu_mul(y[0][m][1], y[1][m][1])); }
                }
            }
#pragma unroll
            for (int m = 0; m < 4; ++m) {
                if (m < 2 && fr == 0) continue;
                if constexpr (F8) { v2u w; w.x = outp[m][0][0]; w.y = outp[m][1][0]; *(v2u*)((unsigned char*)act + (size_t)(row0 + m) * FF + colb) = w; }
                else { v4u w; w.x = outp[m][0][0]; w.y = outp[m][0][1]; w.z = outp[m][1][0]; w.w = outp[m][1][1];
                    *(v4u*)(act + (size_t)(row0 + m) * FF + colb) = w; }
            }
            asm volatile("" ::: "memory");
        }
    }
};
typedef EpiUpT<false> EpiUp;
struct EpiDummy {
    static constexpr bool PERM = false, PERMA = true, AFTER_DRAIN = false;
    float* scratch;
    __device__ __forceinline__ void operator()(const pg8::f32x4 (&acc)[2][2][4][2], const pg8::Unit& u, int wr, int wc, int fr, int fq) const {
        f32x4 s = (f32x4){0.f, 0.f, 0.f, 0.f};
#pragma unroll
        for (int ai = 0; ai < 2; ++ai)
#pragma unroll
            for (int bj = 0; bj < 2; ++bj)
#pragma unroll
                for (int m = 0; m < 4; ++m)
#pragma unroll
                    for (int n = 0; n < 2; ++n) s += acc[ai][bj][m][n];
        scratch[(size_t)(u.pm * 22 + u.pn) * 512 + ((wr * 4 + wc) * 4 + fq) * 16 + fr] = (s.x + s.y) + (s.z + s.w);
    }
};
template <bool F8>
__device__ __forceinline__ void fixup_phase(Frame& F, const float* cw, const float* cb, const float* halo, bf16* act) {
    const int gt = F.vcu * (NWAVES * 64) + F.tid, NT = F.G * NWAVES * 64;
    constexpr int C4 = FF / 4;
    for (int it = gt; it < NBLK64 * 2 * C4; it += NT) {
        const int c = (it % C4) * 4, rj = it / C4, j = rj & 1, blk = rj >> 1, t = blk * 64 + j, tb = t % SEQ;
        f32x4 y[2];
#pragma unroll
        for (int bj = 0; bj < 2; ++bj) {
            const int cc = bj * FF + c;
            const f32x4 z = (f32x4){0.f, 0.f, 0.f, 0.f};
            const f32x4 ut = *(const f32x4*)(halo + ((size_t)blk * 4 + j) * NUP + cc);
            f32x4 u1, u2;
            if (j == 1) { u1 = *(const f32x4*)(halo + ((size_t)blk * 4 + 0) * NUP + cc); u2 = (tb == 1) ? z : *(const f32x4*)(halo + ((size_t)(blk - 1) * 4 + 3) * NUP + cc); }
            else { u1 = (tb == 0) ? z : *(const f32x4*)(halo + ((size_t)(blk - 1) * 4 + 3) * NUP + cc); u2 = (tb == 0) ? z : *(const f32x4*)(halo + ((size_t)(blk - 1) * 4 + 2) * NUP + cc); }
            y[bj] = *(const f32x4*)(cb + cc) + *(const f32x4*)(cw + cc) * u2 + *(const f32x4*)(cw + NUP + cc) * u1 + *(const f32x4*)(cw + 2 * NUP + cc) * ut;
        }
        if constexpr (F8) *(unsigned*)((unsigned char*)act + (size_t)t * FF + c) = pk4f8(silu_mul(y[0].x, y[1].x), silu_mul(y[0].y, y[1].y), silu_mul(y[0].z, y[1].z), silu_mul(y[0].w, y[1].w));
        else { v2u w; w.x = cvtpk(silu_mul(y[0].x, y[1].x), silu_mul(y[0].y, y[1].y)); w.y = cvtpk(silu_mul(y[0].z, y[1].z), silu_mul(y[0].w, y[1].w));
            *(v2u*)(act + (size_t)t * FF + c) = w; }
    }
}

__device__ __forceinline__ int crow(int r, int hi) { return (r & 3) + 8 * (r >> 2) + 4 * hi; }
__device__ __forceinline__ void glds16(const void* gsrc, unsigned lds_dst) { unsigned keep;
    asm volatile("s_mov_b32 %0, m0\n\ts_mov_b32 m0, %2\n\ts_nop 0\n\tglobal_load_lds_dwordx4 %1, off\n\ts_mov_b32 m0, %0" : "=&s"(keep) : "v"(gsrc), "s"(lds_dst) : "memory"); }
__device__ __forceinline__ float max3f(float a, float b, float c) { return fmaxf(fmaxf(a, b), c); }

namespace band {
constexpr int SLOTB = 8192;
constexpr int LDS_K = 0, LDS_V = 2 * SLOTB, LDS_WS = 4 * SLOTB, LDS_TB = LDS_WS + NWAVES * 64 * 4, LDS_OST = LDS_TB + 640 * 4 + 512, LDS_END = LDS_OST + NWAVES * 4096;
static_assert(LDS_END <= RING_BYTES, "band LDS");
__device__ __forceinline__ void unit(Frame& F, int b, int h, int U, const bf16* Q, const bf16* K, const bf16* V, bf16* O, const float* rel, const bool o8) {
    const int tid = F.tid, lane = F.lane, r32 = lane & 31, hi = lane >> 5, wid = F.wave;
    LAS unsigned char* shm = F.lds + RING_OFF;
    const unsigned lds0 = (unsigned)(uintptr_t)shm;
    const long rowbase = (long)b * SEQ; const int q0 = U * 256, c0 = 4 * U, cq = c0 + (wid >> 1);
    const bf16* Qw = Q + (rowbase + q0 + wid * 32) * DM + h * 64;
    const bf16* Kh = K + rowbase * DM + h * 64; const bf16* Vh = V + rowbase * DM + h * 64;
    LAS float* wsf = (LAS float*)(shm + LDS_WS) + wid * 64;
    LAS float* tb = (LAS float*)(shm + LDS_TB);
    const bf16* ksrc = Kh + (long)lane * DM + wid * 8;
    const bf16* vsrc = Vh + (long)(16 * (wid & 3) + (lane >> 2)) * DM + (wid >> 2) * 32 + (lane & 3) * 8;
    const unsigned kdst = lds0 + LDS_K + wid * 1024, vdst = lds0 + LDS_V + wid * 1024;
    const int lo = (c0 - 8 > 0) ? c0 - 8 : 0, hiT = c0 + 3, NT = hiT - lo + 1, t0 = (c0 - 5 > 0) ? c0 - 5 : 0;
#define BAND_KT(i) ((t0 + (i) <= hiT) ? t0 + (i) : lo + (t0 + (i) - hiT - 1))
    for (int i = tid; i < 640; i += NWAVES * 64) { int d = i - 64; d = d < -256 ? -256 : (d > 256 ? 256 : d); tb[i] = rel[(d + 256) * 16 + h] * LOG2E; }
    { const int kt = BAND_KT(0); glds16(ksrc + (long)kt * 64 * DM, (unsigned)__builtin_amdgcn_readfirstlane(kdst)); glds16(vsrc + (long)kt * 64 * DM, (unsigned)__builtin_amdgcn_readfirstlane(vdst)); }
    bf16x8 qr[4];
#pragma unroll
    for (int d0 = 0; d0 < 4; ++d0) qr[d0] = *(const bf16x8*)(Qw + (long)r32 * DM + d0 * 16 + hi * 8);
    float m_run = -INFINITY, l_run = 0.f; f32x16 o[2]; o[0] = f32x16{}; o[1] = f32x16{};
    const int qpos = q0 + wid * 32 + r32;
    const LAS unsigned char* vbase = shm + LDS_V + ((lane >> 4) & 1) * 32 + (lane & 3) * 8 + (4 * hi + ((lane & 15) >> 2)) * 64;
    for (int i = 0; i < NT; ++i) { LA_B;
        asm volatile("s_waitcnt vmcnt(0) lgkmcnt(0)\n\ts_barrier" ::: "memory");
        if (i + 1 < NT) { const int kt = BAND_KT(i + 1); const unsigned so = ((i + 1) & 1) * SLOTB;
            glds16(ksrc + (long)kt * 64 * DM, (unsigned)__builtin_amdgcn_readfirstlane(kdst + so)); glds16(vsrc + (long)kt * 64 * DM, (unsigned)__builtin_amdgcn_readfirstlane(vdst + so)); }
        const int kt = BAND_KT(i);
        if (kt < cq - 8 || kt > cq) continue;
        const int so = (i & 1) * SLOTB;
        f32x16 p0 = f32x16{}, p1 = f32x16{};
        { const LAS unsigned char* kb = shm + LDS_K + so + hi * 1024 + r32 * 16;
#pragma unroll
          for (int d0 = 0; d0 < 4; ++d0) { const bf16x8 b0 = *(const LAS bf16x8*)(kb + d0 * 2048), b1 = *(const LAS bf16x8*)(kb + d0 * 2048 + 512);
              p0 = __builtin_amdgcn_mfma_f32_32x32x16_bf16(b0, qr[d0], p0, 0, 0, 0); p1 = __builtin_amdgcn_mfma_f32_32x32x16_bf16(b1, qr[d0], p1, 0, 0, 0); } }
        if (kt + 5 <= cq) { const float cbias = tb[639];
#pragma unroll
          for (int r = 0; r < 16; ++r) { p0[r] += cbias; p1[r] += cbias; } }
        else { const int ib = qpos - 64 * kt + 64 - 4 * hi;
#pragma unroll
          for (int r = 0; r < 16; ++r) { const int ix = ib - ((r & 3) + 8 * (r >> 2)); p0[r] += tb[ix]; p1[r] += tb[ix - 32]; } }
        float rm = p0[0];
#pragma unroll
        for (int r = 0; r < 16; ++r) rm = max3f(rm, p0[r], p1[r]);
        { auto rr = __builtin_amdgcn_permlane32_swap(__float_as_uint(rm), __float_as_uint(rm), false, false); rm = fmaxf(__uint_as_float(rr[0]), __uint_as_float(rr[1])); }
        const float mnew = fmaxf(m_run, rm), f = __builtin_amdgcn_exp2f(m_run - mnew); m_run = mnew;
        float sacc = 0.f;
#pragma unroll
        for (int r = 0; r < 16; ++r) { p0[r] = __builtin_amdgcn_exp2f(p0[r] - mnew); p1[r] = __builtin_amdgcn_exp2f(p1[r] - mnew); sacc += p0[r] + p1[r]; }
        l_run = l_run * f + sacc;
        if (!__all(f == 1.0f)) {
            if (hi == 0) wsf[r32] = f;
            LDS_WAIT();
#pragma unroll
            for (int r = 0; r < 16; ++r) { const float fr_ = wsf[crow(r, hi)]; o[0][r] *= fr_; o[1][r] *= fr_; }
        }
        v4u pw[4];
        pw[0] = (v4u){cvtpk(p0[0], p0[1]), cvtpk(p0[2], p0[3]), cvtpk(p0[4], p0[5]), cvtpk(p0[6], p0[7])};
        pw[1] = (v4u){cvtpk(p0[8], p0[9]), cvtpk(p0[10], p0[11]), cvtpk(p0[12], p0[13]), cvtpk(p0[14], p0[15])};
        pw[2] = (v4u){cvtpk(p1[0], p1[1]), cvtpk(p1[2], p1[3]), cvtpk(p1[4], p1[5]), cvtpk(p1[6], p1[7])};
        pw[3] = (v4u){cvtpk(p1[8], p1[9]), cvtpk(p1[10], p1[11]), cvtpk(p1[12], p1[13]), cvtpk(p1[14], p1[15])};
        const LAS unsigned char* vb = vbase + so;
#pragma unroll
        for (int d0 = 0; d0 < 2; ++d0)
#pragma unroll
            for (int ks = 0; ks < 4; ++ks) {
                const s16x4 vlo = __builtin_bit_cast(s16x4, __builtin_amdgcn_ds_read_tr16_b64_v4i16((LAS s16x4*)(vb + d0 * 4096 + ks * 1024)));
                const s16x4 vhi = __builtin_bit_cast(s16x4, __builtin_amdgcn_ds_read_tr16_b64_v4i16((LAS s16x4*)(vb + d0 * 4096 + ks * 1024 + 512)));
                const bf16x8 vf = (bf16x8){vlo[0], vlo[1], vlo[2], vlo[3], vhi[0], vhi[1], vhi[2], vhi[3]};
                o[d0] = __builtin_amdgcn_mfma_f32_32x32x16_bf16(__builtin_bit_cast(bf16x8, pw[ks]), vf, o[d0], 0, 0, 0);
            }
    }
#undef BAND_KT
    { auto rr = __builtin_amdgcn_permlane32_swap(__float_as_uint(l_run), __float_as_uint(l_run), false, false); l_run = __uint_as_float(rr[0]) + __uint_as_float(rr[1]); }
    if (hi == 0) wsf[32 + r32] = l_run;
    LDS_WAIT();
    float rli[16];
#pragma unroll
    for (int r = 0; r < 16; ++r) rli[r] = __builtin_amdgcn_rcpf(wsf[32 + crow(r, hi)]);
    bf16* Ow = O + (rowbase + q0 + wid * 32) * DM + h * 64;
    { LAS bf16* stg = (LAS bf16*)(shm + LDS_OST) + wid * 2048;
#pragma unroll
      for (int r = 0; r < 16; ++r) { const int orow = crow(r, hi);
#pragma unroll
          for (int d0 = 0; d0 < 2; ++d0) stg[orow * 64 + d0 * 32 + r32] = (bf16)f2bf(o[d0][r] * rli[r]); }
      LDS_WAIT();
#pragma unroll
      for (int i = 0; i < 4; ++i) { const int row = i * 8 + (lane >> 3), ch = lane & 7; const v4u v = *(const LAS v4u*)(stg + row * 64 + ch * 8);
          if (o8) { v2u w; w.x = pk4f8(bf_lo(v.x), bf_hi(v.x), bf_lo(v.y), bf_hi(v.y)); w.y = pk4f8(bf_lo(v.z), bf_hi(v.z), bf_lo(v.w), bf_hi(v.w));
              *(v2u*)((unsigned char*)O + (rowbase + q0 + wid * 32 + row) * DM + h * 64 + ch * 8) = w; }
          else *(v4u*)(Ow + (long)row * DM + ch * 8) = v; } }
    asm volatile("s_waitcnt lgkmcnt(0)\n\ts_barrier" ::: "memory");
}
__device__ __forceinline__ void phase(Frame& F, const bf16* Q, const bf16* K, const bf16* V, bf16* O, const float* rel, const bool o8) {
    const int NU = BATCH * 16 * 32, per = (NU + F.G - 1) / F.G;
    for (int i = 0; i < per; ++i) { const int uid = F.vcu * per + i; if (uid >= NU) break; unit(F, uid >> 9, (uid >> 5) & 15, uid & 31, Q, K, V, O, rel, o8); }
}
}

namespace dsa {
__device__ __forceinline__ unsigned okey(float s) { const unsigned u = __float_as_uint(s + 0.0f); return (u & 0x80000000u) ? ~u : (u | 0x80000000u); }
struct Ctx { const bf16* QA; const bf16* KA; const bf16* VA; const bf16* QI; const bf16* KI; const float* WI; bf16* M; const LAS float* t5l; unsigned short* SEL; };

__device__ __forceinline__ void scan_hist(const LAS unsigned* hq, int lane, unsigned need, unsigned& bin, unsigned& above) {
    const LAS v4u* hp = (const LAS v4u*)hq + lane * 4;
    unsigned wds[16];
#pragma unroll
    for (int j = 0; j < 4; ++j) { const v4u t = hp[j]; wds[4 * j] = t.x; wds[4 * j + 1] = t.y; wds[4 * j + 2] = t.z; wds[4 * j + 3] = t.w; }
    unsigned tl = 0;
#pragma unroll
    for (int j = 0; j < 16; ++j) tl += (wds[j] & 0xffffu) + (wds[j] >> 16);
    unsigned suf = tl;
#pragma unroll
    for (int o = 1; o < 64; o <<= 1) { const unsigned v = __shfl_down(suf, o); if (lane + o < 64) suf += v; }
    const unsigned S = suf - tl;
    const bool cross = (S < need) && (need <= S + tl);
    unsigned c = S, bsel = 0, ab = 0; bool found = false;
#pragma unroll
    for (int k = 31; k >= 0; --k) { const unsigned cnt = (wds[k >> 1] >> (16 * (k & 1))) & 0xffffu; if (!found && c + cnt >= need) { bsel = 32 * lane + k; ab = c; found = true; } c += cnt; }
    const unsigned long long bal = __ballot(cross);
    const int src = bal ? __builtin_ctzll(bal) : 0;
    bin = __shfl(bsel, src); above = __shfl(ab, src);
}

__device__ __forceinline__ void attend(const Ctx& C, const LAS unsigned short* sq, int nvalid, long rowbase, long token, int tpos, int lane, int g0) {
    asm volatile("" : "+v"(lane));
    const int l15 = lane & 15, l4 = lane >> 4;
    int sidx[16];
#pragma unroll
    for (int ti = 0; ti < 16; ++ti) sidx[ti] = sq[ti * 16 + l15];
    unsigned bpk[4] = {0u, 0u, 0u, 0u};
#pragma unroll
    for (int ti = 0; ti < 16; ++ti) { const int rel = sidx[ti] - tpos, n = rel < 0 ? -rel : rel;
        const int bk = (rel > 0 ? 16 : 0) + (n < 8 ? n : 8 + (n >= 12) + (n >= 16) + (n >= 23) + (n >= 32) + (n >= 46) + (n >= 64) + (n >= 91));
        bpk[ti >> 2] |= (unsigned)bk << (8 * (ti & 3)); }
#pragma unroll 1
    for (int g = g0; g < g0 + 2; ++g) {
        const bf16* qp = C.QA + token * DM + (4 * g + (lane & 3)) * 64 + 8 * l4;
        const bf16x8 qf0 = *(const bf16x8*)qp, qf1 = *(const bf16x8*)(qp + 32);
        const bf16* kbase = C.KA + rowbase * 256 + g * 64 + 8 * l4;
        f32x4 S[16];
#pragma unroll
        for (int hh = 0; hh < 4; ++hh) {
            bf16x8 kf0[4], kf1[4];
#pragma unroll
            for (int j = 0; j < 4; ++j) { const bf16* kp = kbase + (long)sidx[hh * 4 + j] * 256; kf0[j] = *(const bf16x8*)kp; kf1[j] = *(const bf16x8*)(kp + 32); }
#pragma unroll
            for (int j = 0; j < 4; ++j) { const int ti = hh * 4 + j;
                f32x4 a = *(const LAS f32x4*)(C.t5l + ((bpk[hh] >> (8 * j)) & 255u) * 16 + 4 * g);
                asm volatile("v_mfma_f32_16x16x32_bf16 %0, %1, %2, %0" : "+v"(a) : "v"(qf0), "v"(kf0[j]));
                asm volatile("v_mfma_f32_16x16x32_bf16 %0, %1, %2, %0" : "+v"(a) : "v"(qf1), "v"(kf1[j]));
                S[ti] = a; }
            asm volatile("s_nop 15\n\ts_nop 7" : "+v"(S[hh * 4]), "+v"(S[hh * 4 + 1]), "+v"(S[hh * 4 + 2]), "+v"(S[hh * 4 + 3]));
        }
#pragma unroll
        for (int ti = 0; ti < 16; ++ti) if (ti * 16 >= nvalid) S[ti] = (f32x4){-INFINITY, -INFINITY, -INFINITY, -INFINITY};
        f32x4 mx = S[0];
#pragma unroll
        for (int ti = 1; ti < 16; ++ti) { mx.x = fmaxf(mx.x, S[ti].x); mx.y = fmaxf(mx.y, S[ti].y); mx.z = fmaxf(mx.z, S[ti].z); mx.w = fmaxf(mx.w, S[ti].w); }
#pragma unroll
        for (int o = 1; o < 16; o <<= 1) { mx.x = fmaxf(mx.x, __shfl_xor(mx.x, o)); mx.y = fmaxf(mx.y, __shfl_xor(mx.y, o)); mx.z = fmaxf(mx.z, __shfl_xor(mx.z, o)); mx.w = fmaxf(mx.w, __shfl_xor(mx.w, o)); }
        f32x4 ls = (f32x4){0.f, 0.f, 0.f, 0.f};
        unsigned P01[16], P23[16];
#pragma unroll
        for (int ti = 0; ti < 16; ++ti) { const float e0 = __builtin_amdgcn_exp2f(S[ti].x - mx.x), e1 = __builtin_amdgcn_exp2f(S[ti].y - mx.y), e2 = __builtin_amdgcn_exp2f(S[ti].z - mx.z), e3 = __builtin_amdgcn_exp2f(S[ti].w - mx.w);
            ls += (f32x4){e0, e1, e2, e3}; P01[ti] = cvtpk(e0, e1); P23[ti] = cvtpk(e2, e3); }
#pragma unroll
        for (int o = 1; o < 16; o <<= 1) { ls.x += __shfl_xor(ls.x, o); ls.y += __shfl_xor(ls.y, o); ls.z += __shfl_xor(ls.z, o); ls.w += __shfl_xor(ls.w, o); }
        float o_[4][16];
#pragma unroll
        for (int h = 0; h < 4; ++h)
#pragma unroll
            for (int d = 0; d < 16; ++d) o_[h][d] = 0.f;
        const bf16* vbase = C.VA + rowbase * 256 + g * 64 + 16 * l4;
#pragma unroll
        for (int hh = 0; hh < 4; ++hh) {
            v4u va[4], vb[4];
#pragma unroll
            for (int j = 0; j < 4; ++j) { const v4u* vp = (const v4u*)(vbase + (long)sidx[hh * 4 + j] * 256); va[j] = vp[0]; vb[j] = vp[1]; }
#pragma unroll
            for (int j = 0; j < 4; ++j) { const int ti = hh * 4 + j; const v4u v0 = va[j], v1 = vb[j];
                float vf[16];
                vf[0] = bf_lo(v0.x); vf[1] = bf_hi(v0.x); vf[2] = bf_lo(v0.y); vf[3] = bf_hi(v0.y); vf[4] = bf_lo(v0.z); vf[5] = bf_hi(v0.z); vf[6] = bf_lo(v0.w); vf[7] = bf_hi(v0.w);
                vf[8] = bf_lo(v1.x); vf[9] = bf_hi(v1.x); vf[10] = bf_lo(v1.y); vf[11] = bf_hi(v1.y); vf[12] = bf_lo(v1.z); vf[13] = bf_hi(v1.z); vf[14] = bf_lo(v1.w); vf[15] = bf_hi(v1.w);
                const float p0 = bf_lo(P01[ti]), p1 = bf_hi(P01[ti]), p2 = bf_lo(P23[ti]), p3 = bf_hi(P23[ti]);
#pragma unroll
                for (int d = 0; d < 16; ++d) { o_[0][d] += p0 * vf[d]; o_[1][d] += p1 * vf[d]; o_[2][d] += p2 * vf[d]; o_[3][d] += p3 * vf[d]; } }
        }
        float res[4];
#pragma unroll
        for (int h = 0; h < 4; ++h) {
            float a8[8], a4[4], a2[2];
            const bool b3 = (l15 & 8) != 0, b2 = (l15 & 4) != 0, b1 = (l15 & 2) != 0, b0 = (l15 & 1) != 0;
#pragma unroll
            for (int d = 0; d < 8; ++d) { const float keep = b3 ? o_[h][d + 8] : o_[h][d], send = b3 ? o_[h][d] : o_[h][d + 8]; a8[d] = keep + __shfl_xor(send, 8); }
#pragma unroll
            for (int d = 0; d < 4; ++d) { const float keep = b2 ? a8[d + 4] : a8[d], send = b2 ? a8[d] : a8[d + 4]; a4[d] = keep + __shfl_xor(send, 4); }
#pragma unroll
            for (int d = 0; d < 2; ++d) { const float keep = b1 ? a4[d + 2] : a4[d], send = b1 ? a4[d] : a4[d + 2]; a2[d] = keep + __shfl_xor(send, 2); }
            { const float keep = b0 ? a2[1] : a2[0], send = b0 ? a2[0] : a2[1]; res[h] = keep + __shfl_xor(send, 1); }
        }
        bf16* mp = C.M + token * DM + (4 * g) * 64 + lane;
        mp[0] = (bf16)f2bf(res[0] * __builtin_amdgcn_rcpf(ls.x)); mp[64] = (bf16)f2bf(res[1] * __builtin_amdgcn_rcpf(ls.y)); mp[128] = (bf16)f2bf(res[2] * __builtin_amdgcn_rcpf(ls.z)); mp[192] = (bf16)f2bf(res[3] * __builtin_amdgcn_rcpf(ls.w));
    }
}

constexpr int CAND_CAP = 256;
constexpr int SELKS_OFF = KS_OFF;
__device__ __forceinline__ float relu_i(float x) { const int i = __builtin_bit_cast(int, x); return __builtin_bit_cast(float, i > 0 ? i : 0); }
struct SelState { unsigned pre[4], need[4], cnt[4], tcnt[4]; };
__device__ __forceinline__ void tile_mfma(f32x16 (&acc)[2], const LAS unsigned char* kf, const int (&koff)[4], const bf16x8 (&qa)[4]) {
#pragma unroll
    for (int h2 = 0; h2 < 2; ++h2) { acc[h2] = f32x16{};
#pragma unroll
        for (int ks = 0; ks < 4; ++ks) { const bf16x8 kb = *(const LAS bf16x8*)(kf + koff[ks] + h2 * 4096); acc[h2] = __builtin_amdgcn_mfma_f32_32x32x16_bf16(qa[ks], kb, acc[h2], 0, 0, 0); } }
}
template <class ActionT>
__device__ __forceinline__ void tile_valu(const f32x16 (&acc)[2], const f32x2_t (&wp)[2][4], int kbase, ActionT&& act) {
#pragma unroll
    for (int h2 = 0; h2 < 2; ++h2) {
        f32x2_t sa = {0.f, 0.f}, sb = {0.f, 0.f};
#pragma unroll
        for (int jp = 0; jp < 4; ++jp) {
            const f32x2_t ra = {relu_i(acc[h2][2 * jp]), relu_i(acc[h2][2 * jp + 1])};
            const f32x2_t rb = {relu_i(acc[h2][8 + 2 * jp]), relu_i(acc[h2][8 + 2 * jp + 1])};
            sa = __builtin_elementwise_fma(ra, wp[0][jp], sa); sb = __builtin_elementwise_fma(rb, wp[1][jp], sb); }
        act(kbase + h2 * 32, (sa.x + sa.y) + 0.0f, (sb.x + sb.y) + 0.0f);
    }
}
constexpr int KSLOTS = 3;
__device__ __forceinline__ void wait_tile(int newer) {
    if (newer >= 4) asm volatile("s_waitcnt vmcnt(4) lgkmcnt(0)\n\ts_barrier" ::: "memory");
    else if (newer == 3) asm volatile("s_waitcnt vmcnt(3) lgkmcnt(0)\n\ts_barrier" ::: "memory");
    else if (newer == 2) asm volatile("s_waitcnt vmcnt(2) lgkmcnt(0)\n\ts_barrier" ::: "memory");
    else if (newer == 1) asm volatile("s_waitcnt vmcnt(1) lgkmcnt(0)\n\ts_barrier" ::: "memory");
    else asm volatile("s_waitcnt vmcnt(0) lgkmcnt(0)\n\ts_barrier" ::: "memory");
}
template <class ActionT>
__device__ __forceinline__ void tile_pass(Frame& F, const bf16* ksrc, unsigned kdst, const LAS unsigned char* kfr, const int (&koff)[4], int NT, const bf16x8 (&qa)[4], const f32x2_t (&wp)[2][4], ActionT&& act) {
    asm volatile("s_waitcnt lgkmcnt(0)\n\ts_barrier" ::: "memory");
    const int npre = NT < KSLOTS ? NT : KSLOTS;
    for (int j = 0; j < npre; ++j) glds16(ksrc + (long)j * 4096, (unsigned)__builtin_amdgcn_readfirstlane(kdst + j * 8192));
    wait_tile(npre - 1);
    f32x16 accA[2], accB[2];
    tile_mfma(accA, kfr, koff, qa);
    int sl = 0;
    int kt = 0;
    for (; kt + 2 < NT; kt += 2) { LA_S;
        { const int inflight = (NT - kt - 2) < (KSLOTS - 2) ? (NT - kt - 2) : (KSLOTS - 2); wait_tile(inflight); }
        if (kt + KSLOTS < NT) glds16(ksrc + (long)(kt + KSLOTS) * 4096, (unsigned)__builtin_amdgcn_readfirstlane(kdst + sl * 8192));
        sl = (sl == KSLOTS - 1) ? 0 : sl + 1;
        tile_mfma(accB, kfr + sl * 8192, koff, qa);
        tile_valu(accA, wp, kt * 64, act);
        { const int inflight = (NT - kt - 3) < (KSLOTS - 2) ? (NT - kt - 3) : (KSLOTS - 2); wait_tile(inflight); }
        if (kt + 1 + KSLOTS < NT) glds16(ksrc + (long)(kt + 1 + KSLOTS) * 4096, (unsigned)__builtin_amdgcn_readfirstlane(kdst + sl * 8192));
        sl = (sl == KSLOTS - 1) ? 0 : sl + 1;
        tile_mfma(accA, kfr + sl * 8192, koff, qa);
        tile_valu(accB, wp, (kt + 1) * 64, act);
    }
    if (kt + 1 < NT) {
        wait_tile(0);
        sl = (sl == KSLOTS - 1) ? 0 : sl + 1;
        tile_mfma(accB, kfr + sl * 8192, koff, qa);
        tile_valu(accA, wp, kt * 64, act);
        tile_valu(accB, wp, (kt + 1) * 64, act);
    } else tile_valu(accA, wp, kt * 64, act);
    LDS_WAIT();
}
__device__ __forceinline__ void scan_hist_cnt(const LAS unsigned* hq, int lane, unsigned need, unsigned& bin, unsigned& above, unsigned& bcnt) {
    const LAS v4u* hp = (const LAS v4u*)hq + lane * 2;
    unsigned wds[8];
#pragma unroll
    for (int j = 0; j < 2; ++j) { const v4u t = hp[j]; wds[4 * j] = t.x; wds[4 * j + 1] = t.y; wds[4 * j + 2] = t.z; wds[4 * j + 3] = t.w; }
    unsigned tl = 0;
#pragma unroll
    for (int j = 0; j < 8; ++j) tl += wds[j];
    unsigned suf = tl;
#pragma unroll
    for (int o = 1; o < 64; o <<= 1) { const unsigned v = __shfl_down(suf, o); if (lane + o < 64) suf += v; }
    const unsigned S = suf - tl;
    const bool cross = (S < need) && (need <= S + tl);
    unsigned c = S, bsel = 0, ab = 0, bc = 0; bool found = false;
#pragma unroll
    for (int k = 7; k >= 0; --k) { const unsigned cnt = wds[k]; if (!found && c + cnt >= need) { bsel = 8 * lane + k; ab = c; bc = cnt; found = true; } c += cnt; }
    const unsigned long long bal = __ballot(cross);
    const int src = bal ? __builtin_ctzll(bal) : 0;
    bin = __builtin_amdgcn_readfirstlane(__shfl(bsel, src)); above = __builtin_amdgcn_readfirstlane(__shfl(ab, src)); bcnt = __builtin_amdgcn_readfirstlane(__shfl(bc, src));
}
__device__ __forceinline__ void step(Frame& F, const Ctx& C, int b, int c, int half) {
    int lane_ = F.lane; asm volatile("" : "+v"(lane_));
    const int lane = lane_, r = lane & 31, hi = lane >> 5, wave = F.wave;
    LAS unsigned* hist = (LAS unsigned*)(F.lds + RING_OFF + wave * 16384);
    LAS unsigned short* sel = (LAS unsigned short*)hist;
    LAS unsigned* cand = hist + 2048;
    LAS unsigned* fbflag = (LAS unsigned*)(F.lds + AUX_OFF + 2048);
    const long rowbase = (long)b * SEQ;
    const int tq0 = 64 * c + 32 * half + 4 * wave;
    const int N = 64 * (c + 1), NT = c + 1;
    int nvalid = 256;
    if (N <= 256) {
        nvalid = N;
        for (int j = lane; j < 4 * 256; j += 64) sel[j] = (unsigned short)(((j & 255) < N) ? (j & 255) : 0);
    } else {
        const int aq = 2 * ((r >> 2) & 1) + (r >> 4), ah = 4 * ((r >> 3) & 1) + (r & 3);
        const bf16* qip = C.QI + (rowbase + tq0 + aq) * 512 + ah * 64 + 8 * hi;
        bf16x8 qa[4];
#pragma unroll
        for (int ks = 0; ks < 4; ++ks) qa[ks] = *(const bf16x8*)(qip + 16 * ks);
        f32x2_t wp[2][4];
#pragma unroll
        for (int t = 0; t < 2; ++t) { const float* wq = C.WI + (rowbase + tq0 + 2 * hi + t) * 8; const f32x4 w0 = *(const f32x4*)wq, w1 = *(const f32x4*)(wq + 4);
            wp[t][0] = (f32x2_t){w0.x, w0.y}; wp[t][1] = (f32x2_t){w0.z, w0.w}; wp[t][2] = (f32x2_t){w1.x, w1.y}; wp[t][3] = (f32x2_t){w1.z, w1.w}; }
        float Bq;
        { float ssq = 0.f;
#pragma unroll
          for (int ks = 0; ks < 4; ++ks)
#pragma unroll
              for (int e = 0; e < 8; ++e) { const float v = bf_lo((unsigned)(unsigned short)qa[ks][e]); ssq += v * v; }
          ssq += __shfl_xor(ssq, 32);
          float term = fabsf(C.WI[(rowbase + tq0 + aq) * 8 + ah]) * sqrtf(ssq);
          term += __shfl_xor(term, 1); term += __shfl_xor(term, 2); term += __shfl_xor(term, 8);
          Bq = term * 8.25f + 1e-20f; }
        const float B0 = __shfl(Bq, (hi << 2)), B1 = __shfl(Bq, (hi << 2) | 16);
        const float sc0 = 1024.0f / B0, sc1 = 1024.0f / B1;
        asm volatile("" :: "v"(qa[0]), "v"(qa[1]), "v"(qa[2]), "v"(qa[3]));
        asm volatile("" :: "v"(wp[0][0]), "v"(wp[0][1]), "v"(wp[0][2]), "v"(wp[0][3]), "v"(wp[1][0]), "v"(wp[1][1]), "v"(wp[1][2]), "v"(wp[1][3]), "v"(sc0), "v"(sc1));
        const bf16* ksrc = C.KI + rowbase * 64 + (long)(wave * 8 + (lane >> 3)) * 64 + ((lane & 7) ^ (lane >> 3)) * 8;
        const unsigned kdst = (unsigned)(uintptr_t)(F.lds + SELKS_OFF) + wave * 1024;
        const LAS unsigned char* kfr = F.lds + SELKS_OFF + r * 128;
        int koff[4];
#pragma unroll
        for (int ks = 0; ks < 4; ++ks) koff[ks] = ((2 * ks + hi) ^ (r & 7)) * 16;
        const unsigned below = (1u << r) - 1u;
        LAS v4u* hz = (LAS v4u*)hist;
        if (wave == 0 && lane == 0) *fbflag = 0u;
#pragma unroll
        for (int j = 0; j < 8; ++j) hz[j * 64 + lane] = (v4u){0u, 0u, 0u, 0u};
        tile_pass(F, ksrc, kdst, kfr, koff, NT, qa, wp, [&](int kbase, float s0, float s1) {
            const int b0 = (int)__builtin_amdgcn_fmed3f(__builtin_fmaf(s0, sc0, 256.0f), 0.0f, 511.0f), b1 = (int)__builtin_amdgcn_fmed3f(__builtin_fmaf(s1, sc1, 256.0f), 0.0f, 511.0f);
            __hip_atomic_fetch_add(hist + (2 * hi) * 512 + b0, 1u, __ATOMIC_RELAXED, __HIP_MEMORY_SCOPE_WORKGROUP);
            __hip_atomic_fetch_add(hist + (2 * hi + 1) * 512 + b1, 1u, __ATOMIC_RELAXED, __HIP_MEMORY_SCOPE_WORKGROUP);
        });
#ifdef PROBE_SKEL
        tile_pass(F, ksrc, kdst, kfr, koff, NT, qa, wp, [&](int kbase, float s0, float s1) { });
#endif
#ifdef PROBE_SCORE
        { float dsum = 0.f; tile_pass(F, ksrc, kdst, kfr, koff, NT, qa, wp, [&](int kbase, float s0, float s1) { dsum += s0 + s1; }); if (dsum == 12345.678f) hist[0] = 1u; }
#endif
        SelState st;
        unsigned tbin[4], bcn[4]; bool ovf = false;
#pragma unroll
        for (int ql = 0; ql < 4; ++ql) { unsigned above; scan_hist_cnt(hist + ql * 512, lane, 256u, tbin[ql], above, bcn[ql]); st.cnt[ql] = 0u; st.tcnt[ql] = 0u; st.need[ql] = 256u - above; st.pre[ql] = above;
#ifdef PROBE_OVF
            ovf |= bcn[ql] > (unsigned)PROBE_OVF; }
#else
            ovf |= bcn[ql] > (unsigned)CAND_CAP; }
#endif
        LDS_WAIT();
        if (ovf && lane == 0) *fbflag = 1u;
        asm volatile("s_waitcnt lgkmcnt(0)\n\ts_barrier" ::: "memory");
#ifdef PROBE_NOFB
        const bool fb = false;
#elif defined(PROBE_NOFB2)
        const bool fb = __builtin_amdgcn_readfirstlane((int)*fbflag) == 0x7fffffff;
#else
        const bool fb = __builtin_amdgcn_readfirstlane((int)*fbflag) != 0;
#endif
        if (!fb) {
            const int tb0 = (int)(hi ? tbin[2] : tbin[0]), tb1 = (int)(hi ? tbin[3] : tbin[1]);
            tile_pass(F, ksrc, kdst, kfr, koff, NT, qa, wp, [&](int kbase, float s0, float s1) {
#pragma unroll
                for (int t = 0; t < 2; ++t) {
                    const float s = t ? s1 : s0; const int bin = (int)__builtin_amdgcn_fmed3f(__builtin_fmaf(s, (t ? sc1 : sc0), 256.0f), 0.0f, 511.0f), tb = t ? tb1 : tb0;
                    const bool gt = bin > tb, eq = bin == tb;
                    const unsigned long long mg = __ballot(gt), me = __ballot(eq);
                    const unsigned mgh = hi ? (unsigned)(mg >> 32) : (unsigned)mg, meh = hi ? (unsigned)(me >> 32) : (unsigned)me;
                    const unsigned pos = (hi ? st.cnt[2 + t] : st.cnt[t]) + __builtin_popcount(mgh & below);
                    sel[(gt && pos < 256u) ? (2 * hi + t) * 256 + pos : 3200 + lane] = (unsigned short)(kbase + r);
                    const unsigned cpos = (hi ? st.tcnt[2 + t] : st.tcnt[t]) + __builtin_popcount(meh & below);
                    { LAS unsigned* cp = hist + ((eq && cpos < (unsigned)CAND_CAP) ? 2048 + ((2 * hi + t) * CAND_CAP + cpos) * 2 : 1700 + 2 * lane); cp[0] = okey(s); cp[1] = (unsigned)(kbase + r); }
                    st.cnt[t] += __builtin_popcount((unsigned)mg); st.cnt[2 + t] += __builtin_popcount((unsigned)(mg >> 32));
                    st.tcnt[t] += __builtin_popcount((unsigned)me); st.tcnt[2 + t] += __builtin_popcount((unsigned)(me >> 32));
                }
            });
#pragma unroll
            for (int ql = 0; ql < 4; ++ql) {
                const unsigned nc = bcn[ql], G = st.pre[ql], rq = st.need[ql];
                const LAS unsigned* cq = cand + ql * CAND_CAP * 2;
                unsigned ki4[4], xi4[4], rk4[4];
#pragma unroll
                for (int m = 0; m < 4; ++m) { const unsigned i = (unsigned)lane + 64u * m; ki4[m] = (i < nc) ? cq[2 * i] : 0u; xi4[m] = (i < nc) ? cq[2 * i + 1] : 0u; rk4[m] = 0u; }
                for (unsigned j = 0; j < nc; ++j) { const unsigned kj = cq[2 * j];
#pragma unroll
                    for (int m = 0; m < 4; ++m) rk4[m] += (kj > ki4[m] || (kj == ki4[m] && j < (unsigned)lane + 64u * m)) ? 1u : 0u; }
                unsigned base = G; const unsigned long long lt = (1ull << lane) - 1ull;
#pragma unroll
                for (int m = 0; m < 4; ++m) { const bool take = ((unsigned)lane + 64u * m < nc) && rk4[m] < rq; const unsigned long long mm = __ballot(take);
                    const unsigned pos = base + __builtin_popcountll(mm & lt); if (take && pos < 256u) sel[ql * 256 + pos] = (unsigned short)xi4[m]; base += __builtin_popcountll(mm); }
            }
        } else {
#pragma unroll
            for (int ql = 0; ql < 4; ++ql) { st.pre[ql] = 0u; st.need[ql] = 256u; st.cnt[ql] = 0u; st.tcnt[ql] = 0u; }
#pragma unroll 1
            for (int lev = 0; lev < 4; ++lev) {
#pragma unroll
                for (int j = 0; j < 8; ++j) hz[j * 64 + lane] = (v4u){0u, 0u, 0u, 0u};
                const unsigned pre0 = hi ? st.pre[2] : st.pre[0], pre1 = hi ? st.pre[3] : st.pre[1];
                const int sh = (lev == 0) ? 23 : (lev == 1) ? 14 : (lev == 2) ? 5 : 0, wd = (lev == 3) ? 5 : 9;
                tile_pass(F, ksrc, kdst, kfr, koff, NT, qa, wp, [&](int kbase, float s0, float s1) {
                    const unsigned k0 = okey(s0), k1 = okey(s1);
                    const unsigned b0 = (k0 >> sh) & ((1u << wd) - 1u), b1 = (k1 >> sh) & ((1u << wd) - 1u);
                    const bool in0 = (lev == 0) || ((k0 >> (sh + wd)) == pre0), in1 = (lev == 0) || ((k1 >> (sh + wd)) == pre1);
                    if (in0) __hip_atomic_fetch_add(hist + (2 * hi) * 512 + b0, 1u, __ATOMIC_RELAXED, __HIP_MEMORY_SCOPE_WORKGROUP);
                    if (in1) __hip_atomic_fetch_add(hist + (2 * hi + 1) * 512 + b1, 1u, __ATOMIC_RELAXED, __HIP_MEMORY_SCOPE_WORKGROUP);
                });
#pragma unroll
                for (int ql = 0; ql < 4; ++ql) { unsigned bin, above, bc; scan_hist_cnt(hist + ql * 512, lane, st.need[ql], bin, above, bc);
                    st.pre[ql] = (st.pre[ql] << wd) | bin; st.need[ql] -= above; }
                LDS_WAIT();
            }
            const unsigned T0 = hi ? st.pre[2] : st.pre[0], T1 = hi ? st.pre[3] : st.pre[1], rq0 = hi ? st.need[2] : st.need[0], rq1 = hi ? st.need[3] : st.need[1];
            tile_pass(F, ksrc, kdst, kfr, koff, NT, qa, wp, [&](int kbase, float s0, float s1) {
#pragma unroll
                for (int t = 0; t < 2; ++t) {
                    const unsigned kk = okey(t ? s1 : s0), T = t ? T1 : T0, rq = t ? rq1 : rq0;
                    const bool gt = kk > T, eq = kk == T;
                    const unsigned long long me = __ballot(eq);
                    const unsigned meh = hi ? (unsigned)(me >> 32) : (unsigned)me;
                    const unsigned trank = (hi ? st.tcnt[2 + t] : st.tcnt[t]) + __builtin_popcount(meh & below);
                    const bool take = gt || (eq && trank < rq);
                    const unsigned long long mt = __ballot(take);
                    const unsigned mth = hi ? (unsigned)(mt >> 32) : (unsigned)mt;
                    const unsigned pos = (hi ? st.cnt[2 + t] : st.cnt[t]) + __builtin_popcount(mth & below);
                    if (take && pos < 256u) sel[(2 * hi + t) * 256 + pos] = (unsigned short)(kbase + r);
                    st.cnt[t] += __builtin_popcount((unsigned)mt); st.cnt[2 + t] += __builtin_popcount((unsigned)(mt >> 32));
                    st.tcnt[t] += __builtin_popcount((unsigned)me); st.tcnt[2 + t] += __builtin_popcount((unsigned)(me >> 32));
                }
            });
        }
    }
    LDS_WAIT();
    { const LAS v4u* s4 = (const LAS v4u*)sel; v4u* g4 = (v4u*)(C.SEL + (rowbase + tq0) * 256);
#pragma unroll
      for (int j = 0; j < 2; ++j) g4[j * 64 + lane] = s4[j * 64 + lane]; }
    LDS_WAIT();
}
__device__ __forceinline__ void phase(Frame& F, const Ctx& C) {
    for (int v = F.vcu; v < 256; v += F.G) {
        const int b = v >> 6, c = v & 63;
#pragma unroll 1
        for (int it = 0; it < 4; ++it) step(F, C, b, (it < 2) ? c : 127 - c, it & 1);
    }
}
__device__ __forceinline__ void attn_phase(Frame& F, const Ctx& C) {
    int lane = F.lane; asm volatile("" : "+v"(lane));
    LAS unsigned short* sq = (LAS unsigned short*)(F.lds + RING_OFF + F.wave * 16384);
    const int nx = F.G / 32;
    for (int x = F.vcu / 32; x < 8; x += nx) {
        const int b = x >> 1, g0 = 2 * (x & 1); const long rowbase = (long)b * SEQ;
        const int w = (F.vcu & 31) * NWAVES + F.wave;
#pragma unroll 1
        for (int t = w; t < SEQ; t += 32 * NWAVES) {
            { const v4u* g4 = (const v4u*)(C.SEL + (rowbase + t) * 256); if (lane < 32) ((LAS v4u*)sq)[lane] = g4[lane]; }
            LDS_WAIT();
            const int N = 64 * ((t >> 6) + 1), nvalid = N < 256 ? N : 256;
            attend(C, sq, nvalid, rowbase, rowbase + t, t, lane, g0);
            LDS_WAIT();
        }
    }
}
}

namespace att8 {
typedef int v2i __attribute__((ext_vector_type(2)));
struct Ctx8 { const unsigned char* QA8; const unsigned char* KV8; const unsigned short* SEL; bf16* M; bool o8; };
constexpr int T2_OFF = KS_OFF, T2_BYTES = 155 * 16 * 4, SELL_OFF = KS_OFF + 10240;
static_assert(T2_BYTES <= 10240 && SELL_OFF + NWAVES * 1024 <= AUX_OFF, "attention LDS map");
__device__ __forceinline__ void mfma8(f32x4& acc, long a, long b) { asm volatile("v_mfma_f32_16x16x32_fp8_fp8 %0, %1, %2, %0" : "+v"(acc) : "v"(a), "v"(b)); }
__device__ __forceinline__ unsigned pk4_fp8(float a, float b, float c, float d) { int r = __builtin_amdgcn_cvt_pk_fp8_f32(a, b, 0, false); r = __builtin_amdgcn_cvt_pk_fp8_f32(c, d, r, true); return (unsigned)r; }

__device__ __forceinline__ void gld16(v4u& dst, const void* p) { asm volatile("global_load_dwordx4 %0, %1, off" : "=v"(dst) : "v"(p) : "memory"); }
__device__ __forceinline__ void issue_kq(const Ctx8& C, const LAS unsigned short* sq, long rowbase, long token, int g, int l15, int l4, int h, v4u (&kr)[16], v4u& qv) {
    const unsigned char* kvb = C.KV8 + rowbase * 512 + g * 128 + 16 * l4;
#pragma unroll
    for (int j = 0; j < 16; ++j) gld16(kr[j], kvb + (long)sq[j * 16 + l15] * 512);
    gld16(qv, C.QA8 + token * 1024 + (4 * g + h) * 64 + 16 * l4);
}
__device__ __forceinline__ void issue_v_half(const Ctx8& C, const LAS unsigned short* sq, long rowbase, int g, int lane, unsigned vbase, int half) {
    const unsigned char* kvb = C.KV8 + rowbase * 512 + g * 128 + 64; const int kq = lane >> 2, p = lane & 3;
#pragma unroll
    for (int j = 0; j < 8; ++j) { const int ti = half * 8 + j; const int key = sq[ti * 16 + kq]; const int x = ((kq >> 2) & 1) | ((ti & 1) << 1);
        glds16(kvb + (long)key * 512 + 16 * (p ^ x), (unsigned)__builtin_amdgcn_readfirstlane(vbase + ti * 1024)); }
}
__device__ __forceinline__ void phase(Frame& F, const Ctx8& C, const float* t5) {
    int lane = F.lane; asm volatile("" : "+v"(lane));
    LAS float* T2 = (LAS float*)(F.lds + T2_OFF);
    for (int e = F.tid; e < 155 * 16; e += NWAVES * 64) { const int rel = (e >> 4) - 91, n = rel < 0 ? -rel : rel;
        const int bk = (rel > 0 ? 16 : 0) + (n < 8 ? n : 8 + (n >= 12) + (n >= 16) + (n >= 23) + (n >= 32) + (n >= 46) + (n >= 64) + (n >= 91));
        T2[e] = t5[bk * 16 + (e & 15)] * 8.0f; }
    __syncthreads();
    LAS unsigned short* sqb = (LAS unsigned short*)(F.lds + SELL_OFF + F.wave * 1024);
    LAS unsigned char* vreg = F.lds + RING_OFF + F.wave * 16384;
    const unsigned vbase = (unsigned)(uintptr_t)vreg;
    const int l15 = lane & 15, l4 = lane >> 4, h = l15 & 3;
    const int trk = 4 * l4 + ((l15 >> 1) & 3), trt = (l15 >> 3) & 1, xs = (l4 & 1) | (trt << 1);
    const int troff = trt * 1024 + trk * 64 + 8 * (l15 & 1);
    const int x = F.vcu / 32, b = x >> 1, g0 = 2 * (x & 1); const long rowbase = (long)b * SEQ;
    const int w = (F.vcu & 31) * NWAVES + F.wave;
    constexpr int NQ = SEQ / (32 * NWAVES), NI = 2 * NQ;
    if (lane < 32) { ((LAS v4u*)sqb)[lane] = ((const v4u*)(C.SEL + (rowbase + w) * 256))[lane]; ((LAS v4u*)(sqb + 256))[lane] = ((const v4u*)(C.SEL + (rowbase + w + 32 * NWAVES) * 256))[lane]; }
    LDS_WAIT();
    v4u kr[16], qv, pf = (v4u){0u, 0u, 0u, 0u};
    issue_kq(C, sqb, rowbase, rowbase + w, g0, l15, l4, h, kr, qv);
    issue_v_half(C, sqb, rowbase, g0, lane, vbase, 0); issue_v_half(C, sqb, rowbase, g0, lane, vbase, 1);
    unsigned cib[16];
#pragma unroll 1
    for (int idx = 0; idx < NI; ++idx) { LA_A;
        const int qn = idx >> 1, gi = idx & 1, g = g0 + gi, t = w + 32 * NWAVES * qn;
        const LAS unsigned short* sq = sqb + (qn & 1) * 256;
        const int nidx = (idx + 1 < NI) ? idx + 1 : idx, nq = nidx >> 1, ng = g0 + (nidx & 1), nt = w + 32 * NWAVES * nq;
        const LAS unsigned short* nsq = sqb + (nq & 1) * 256;
        if (gi == 1) { asm volatile("s_waitcnt vmcnt(34)" : "+v"(pf) :: "memory"); if (lane < 32) ((LAS v4u*)(sqb + (qn & 1) * 256))[lane] = pf; }
        { const int pq = (qn + 2 < NQ) ? qn + 2 : NQ - 1; gld16(pf, (const v4u*)(C.SEL + (rowbase + w + 32 * NWAVES * pq) * 256) + (lane & 31)); }
        if (idx == 0) asm volatile("s_waitcnt vmcnt(0)" : "+v"(qv), "+v"(kr[0]), "+v"(kr[1]), "+v"(kr[2]), "+v"(kr[3]), "+v"(kr[4]), "+v"(kr[5]), "+v"(kr[6]), "+v"(kr[7]), "+v"(kr[8]), "+v"(kr[9]), "+v"(kr[10]), "+v"(kr[11]), "+v"(kr[12]), "+v"(kr[13]), "+v"(kr[14]), "+v"(kr[15]) :: "memory");
        else asm volatile("s_waitcnt vmcnt(20)" : "+v"(qv), "+v"(kr[0]), "+v"(kr[1]), "+v"(kr[2]), "+v"(kr[3]), "+v"(kr[4]), "+v"(kr[5]), "+v"(kr[6]), "+v"(kr[7]), "+v"(kr[8]), "+v"(kr[9]), "+v"(kr[10]), "+v"(kr[11]), "+v"(kr[12]), "+v"(kr[13]), "+v"(kr[14]), "+v"(kr[15]) :: "memory");
        if (gi == 0) {
#pragma unroll
            for (int ti = 0; ti < 16; ++ti) { const v2u i4 = *(const LAS v2u*)(sq + ti * 16 + 4 * l4);
                const int r0 = (int)(i4.x & 0xffffu) - t, r1 = (int)(i4.x >> 16) - t, r2 = (int)(i4.y & 0xffffu) - t, r3 = (int)(i4.y >> 16) - t;
                const int c0 = min(max(r0, -91), 63) + 91, c1 = min(max(r1, -91), 63) + 91, c2 = min(max(r2, -91), 63) + 91, c3 = min(max(r3, -91), 63) + 91;
                cib[ti] = (unsigned)c0 | ((unsigned)c1 << 8) | ((unsigned)c2 << 16) | ((unsigned)c3 << 24); }
        }
        const int N = 64 * ((t >> 6) + 1), nvalid = N < 256 ? N : 256;
        const long q0 = (long)(((unsigned long long)qv.y << 32) | qv.x), q1 = (long)(((unsigned long long)qv.w << 32) | qv.z);
        f32x4 S[16];
#pragma unroll
        for (int ti = 0; ti < 16; ++ti) { const unsigned cb = cib[ti];
            f32x4 a; a.x = T2[(cb & 255u) * 16 + 4 * g + h]; a.y = T2[((cb >> 8) & 255u) * 16 + 4 * g + h]; a.z = T2[((cb >> 16) & 255u) * 16 + 4 * g + h]; a.w = T2[(cb >> 24) * 16 + 4 * g + h];
            mfma8(a, (long)(((unsigned long long)kr[ti].y << 32) | kr[ti].x), q0);
            mfma8(a, (long)(((unsigned long long)kr[ti].w << 32) | kr[ti].z), q1);
            S[ti] = a; }
        asm volatile("s_nop 15\n\ts_nop 7" : "+v"(S[0]), "+v"(S[1]), "+v"(S[2]), "+v"(S[3]), "+v"(S[4]), "+v"(S[5]), "+v"(S[6]), "+v"(S[7]), "+v"(S[8]), "+v"(S[9]), "+v"(S[10]), "+v"(S[11]), "+v"(S[12]), "+v"(S[13]), "+v"(S[14]), "+v"(S[15]));
        issue_kq(C, nsq, rowbase, rowbase + nt, ng, l15, l4, h, kr, qv);
#pragma unroll
        for (int ti = 0; ti < 16; ++ti) if (ti * 16 >= nvalid) S[ti] = (f32x4){-INFINITY, -INFINITY, -INFINITY, -INFINITY};
        float mx = S[0].x;
#pragma unroll
        for (int ti = 0; ti < 16; ++ti) mx = fmaxf(fmaxf(mx, fmaxf(S[ti].x, S[ti].y)), fmaxf(S[ti].z, S[ti].w));
        mx = fmaxf(mx, __shfl_xor(mx, 16)); mx = fmaxf(mx, __shfl_xor(mx, 32));
        const float mc = -mx * C2; float ls = 0.f;
        long P8[8];
#pragma unroll
        for (int j = 0; j < 8; ++j) { float e[8];
#pragma unroll
            for (int q = 0; q < 4; ++q) { e[q] = __builtin_amdgcn_exp2f(__builtin_fmaf(S[2 * j][q], C2, mc)); e[4 + q] = __builtin_amdgcn_exp2f(__builtin_fmaf(S[2 * j + 1][q], C2, mc)); }
            ls += ((e[0] + e[1]) + (e[2] + e[3])) + ((e[4] + e[5]) + (e[6] + e[7]));
            const unsigned lo = pk4_fp8(e[0] * 256.f, e[1] * 256.f, e[2] * 256.f, e[3] * 256.f), hi = pk4_fp8(e[4] * 256.f, e[5] * 256.f, e[6] * 256.f, e[7] * 256.f);
            P8[j] = (long)(((unsigned long long)hi << 32) | lo); }
        ls += __shfl_xor(ls, 16); ls += __shfl_xor(ls, 32);
        f32x4 D[4];
#pragma unroll
        for (int db = 0; db < 4; ++db) D[db] = (f32x4){0.f, 0.f, 0.f, 0.f};
#pragma unroll
        for (int hf = 0; hf < 2; ++hf) {
            asm volatile("s_waitcnt vmcnt(28)" ::: "memory");
#pragma unroll
            for (int j = 4 * hf; j < 4 * hf + 4; ++j)
#pragma unroll
                for (int db = 0; db < 4; ++db) {
                    const v2i vv = __builtin_amdgcn_ds_read_tr8_b64_v2i32((LAS v2i*)(vreg + j * 2048 + troff + 16 * (db ^ xs)));
                    mfma8(D[db], P8[j], __builtin_bit_cast(long, vv)); }
            asm volatile("s_waitcnt lgkmcnt(0)" ::: "memory");
            issue_v_half(C, nsq, rowbase, ng, lane, vbase, hf);
        }
        asm volatile("s_nop 15\n\ts_nop 7" : "+v"(D[0]), "+v"(D[1]), "+v"(D[2]), "+v"(D[3]));
        const float lh = __shfl(ls, l4);
        const float inv = __builtin_amdgcn_rcpf(lh * 256.f);
        bf16* mp = C.M + (rowbase + t) * DM + (4 * g + l4) * 64 + l15;
#pragma unroll
        for (int db = 0; db < 4; ++db) { const float v = (l4 == 0) ? D[db].x : (l4 == 1) ? D[db].y : (l4 == 2) ? D[db].z : D[db].w;
            if (C.o8) { const unsigned o1 = (unsigned)__builtin_amdgcn_cvt_pk_fp8_f32(v * inv, 0.f, 0, false);
                asm volatile("global_store_byte %0, %1, off" :: "v"((unsigned char*)C.M + (rowbase + t) * DM + (4 * g + l4) * 64 + l15 + 16 * db), "v"(o1) : "memory"); }
            else { const unsigned short ob = (unsigned short)f2bf(v * inv);
                asm volatile("global_store_short %0, %1, off" :: "v"(mp + 16 * db), "v"((unsigned)ob) : "memory"); } }
    }
    asm volatile("s_waitcnt vmcnt(0)" ::: "memory");
}
}

#ifndef REP_P0
#define REP_P0 1
#endif
#ifndef REP_IN
#define REP_IN 1
#endif
#ifndef REP_DSA
#define REP_DSA 1
#endif
#ifndef REP_BAND
#define REP_BAND 1
#endif
#ifndef REP_UP
#define REP_UP 1
#endif
#ifndef REP_FIX
#define REP_FIX 1
#endif
constexpr int N_PHASES = 1 + 6 * DEPTH;
#ifndef MK_N_LAUNCHES
#define MK_N_LAUNCHES 1
#endif
__global__ void __launch_bounds__(NWAVES * 64, 2) mega_fwd(Args args) {
    extern __shared__ __attribute__((aligned(16))) unsigned char lds[];
    Frame F;
    F.lds = (LAS unsigned char*)lds;
    F.MISC = (volatile LAS unsigned*)(F.lds + MISC_OFF);
    F.tid = threadIdx.x; F.lane = F.tid & 63; F.wave = __builtin_amdgcn_readfirstlane(F.tid >> 6);
    F.G = GRID; { const int bx = blockIdx.x; F.vcu = (bx & 7) * (GRID / 8) + (bx >> 3); }
    unsigned char* ws = args.ws;
    F.ctl = (gu32*)(ws + WS_CTL);
    for (int u = F.tid; u < (LDS_BYTES - LDSCTL_OFF) / 4; u += NWAVES * 64) ((LAS unsigned*)(F.lds + LDSCTL_OFF))[u] = 0u;
    __syncthreads();
    XcdBarrier bar; bar.bar = (unsigned*)(F.ctl + CW_BAR); bar.x = 0; bar.st = nullptr;
    if (MK_N_LAUNCHES == 1) bar = xcd_barrier_post((unsigned*)(F.ctl + CW_BAR), F.MISC + 8);
#ifdef F8M_RUNTIME
    const int lo = args.ph_lo, hi = args.ph_hi, f8m = args.f8m;
#else
    const int lo = args.ph_lo, hi = args.ph_hi; constexpr int f8m = F8M_ALL;
#ifdef PAD_NOPS
    asm volatile(".rept %0\n\ts_nop 0\n\t.endr" :: "n"(PAD_NOPS));
#endif
#endif
#define IN(k) (lo <= (k) && (k) < hi)
#define OPQ_FRAME(Fl) Frame Fl = F; { int l_; asm volatile("v_mbcnt_lo_u32_b32 %0, -1, 0\n\tv_mbcnt_hi_u32_b32 %0, -1, %0" : "=v"(l_)); int w_ = F.wave; asm volatile("" : "+s"(w_)); Fl.wave = w_; Fl.lane = l_; Fl.tid = w_ * 64 + l_; }
#define SEAM(k) do { if (IN(k) && IN((k) + 1)) xcd_barrier(bar); } while (0)

    bf16* hb = (bf16*)(ws + WS_HB); bf16* mb = (bf16*)(ws + WS_M); float* ss = (float*)(ws + WS_SS); float* halo = (float*)(ws + WS_HALO);
    unsigned char* proj = ws + WS_PROJ; bf16* act = (bf16*)(ws + WS_PROJ);

#ifndef SKIP_P0
    if (IN(0)) { for (int rep = 0; rep < REP_P0; ++rep) { OPQ_FRAME(F0); p0_prologue(F0, args); } }
#endif
    SEAM(0);

#pragma unroll 1
    for (int L = 0; L < DEPTH; ++L) {
        const int pb = 1 + 6 * L, li = L >> 1; const bool isB = (L & 1) != 0;
        if (IN(pb)) {
#ifndef SKIP_IN
            for (int rep = 0; rep < REP_IN; ++rep)
            if (!isB) {
                pg8::Gemm g{hb, (const bf16*)(ws + WS_W_INA) + (size_t)li * NA_PAD * DM, MTOK, NA_PAD, DM}; pg8::StaticOrder S; S.init(MTOK, NA_PAD, F.G, (int)blockIdx.x);
                EpiIn E{ss, proj, args.q_norm_g + L * 64, args.k_norm_g + L * 64, 0, 1.0f};
                pg8::gemm_phase<EpiIn, pg8::StaticOrder, true, true>(F.lds + RING_OFF, g, S, E, F.wave);
            } else {
                pg8::Gemm g{hb, (const bf16*)(ws + WS_W_INB) + (size_t)li * NB * DM, MTOK, NB, DM}; pg8::StaticOrder S; S.init(MTOK, NB, F.G, (int)blockIdx.x);
                if (f8_in(f8m, L)) { pg8::Gemm g8{(const bf16*)(ws + WS_M), (const bf16*)(ws + WS_W_INB) + (size_t)li * NB * DM, MTOK, NB, DM / 2};
                    EpiIn E{ss, proj, args.q_norm_g + L * 64, args.k_norm_g + L * 64, 1, W8I};
                    pg8::gemm_phase<EpiIn, pg8::StaticOrder, true, true, true>(F.lds + RING_OFF, g8, S, E, F.wave); }
                else { EpiIn E{ss, proj, args.q_norm_g + L * 64, args.k_norm_g + L * 64, 1, 1.0f};
                    pg8::gemm_phase<EpiIn, pg8::StaticOrder, true, true>(F.lds + RING_OFF, g, S, E, F.wave); }
            }
#endif
        }
        SEAM(pb);
#if defined(DBG_NODSA) || defined(DBG_NOBAND)
#ifdef DBG_NODSA
        const bool zero_m = !isB;
#else
        const bool zero_m = isB;
#endif
        if (IN(pb + 1) && zero_m) { for (size_t i = (size_t)blockIdx.x * 512 + threadIdx.x; i < (size_t)MTOK * DM / 8; i += (size_t)gridDim.x * 512) ((v4u*)mb)[i] = (v4u){0u, 0u, 0u, 0u}; }
        if (IN(pb + 1) && !zero_m) {
#else
        if (IN(pb + 1)) {
#endif
#ifndef SKIP_DSA
            if (!isB) {
                LAS float* t5l = (LAS float*)(F.lds + AUX_OFF);
                { OPQ_FRAME(Ft); for (int i = Ft.tid; i < 512; i += NWAVES * 64) t5l[i] = args.t5_bias[i] * LOG2E; }
                __syncthreads();
                dsa::Ctx C{(const bf16*)(proj + PA_QA), (const bf16*)(proj + PA_KA), (const bf16*)(proj + PA_VA), (const bf16*)(proj + PA_QI), (const bf16*)(proj + PA_KI), (const float*)(proj + PA_WI), mb, t5l, (unsigned short*)(proj + PA_SEL)};
#ifdef DBG_DSACOPY
                { int t_ = threadIdx.x; asm volatile("" : "+v"(t_));
                for (unsigned i = blockIdx.x * 512u + (unsigned)t_; i < (unsigned)MTOK * DM; i += gridDim.x * 512u) { const unsigned t = i >> 10, c = i & 1023u;
                    float v = bf_lo(C.QA[i]); v += bf_lo(C.KA[t * 256 + (c & 255)]); v += bf_lo(C.VA[t * 256 + (c & 255)]); v += bf_lo(C.QI[t * 512 + (c & 511)]); v += bf_lo(C.KI[t * 64 + (c & 63)]); v += C.WI[t * 8 + (c & 7)];
                    mb[i] = (bf16)f2bf(v * 0.01f); asm volatile("" ::: "memory"); } }
#else
                for (int rep = 0; rep < REP_DSA; ++rep) { OPQ_FRAME(F1); dsa::phase(F1, C); }
                xcd_barrier(bar);
                { OPQ_FRAME(F1b); att8::Ctx8 C8{(const unsigned char*)(proj + PA_QA), (const unsigned char*)(proj + PA_KA), (const unsigned short*)(proj + PA_SEL), mb, f8_out(f8m, L)};
#ifndef REP_ATT8
#define REP_ATT8 1
#endif
                  for (int rep = 0; rep < REP_ATT8; ++rep) { att8::phase(F1b, C8, args.t5_bias); __syncthreads(); } }
#endif
            }
#endif
#ifndef SKIP_BAND
            if (isB) {
                for (int rep = 0; rep < REP_BAND; ++rep) { OPQ_FRAME(F2); band::phase(F2, (const bf16*)proj, (const bf16*)(proj + PB_STRIDE), (const bf16*)(proj + 2 * PB_STRIDE), mb, args.rel_bias_b + (size_t)li * 513 * 16, f8_out(f8m, L)); }
            }
#endif
        }
        SEAM(pb + 1);
        if (IN(pb + 2)) {
#ifndef SKIP_OUT
            pg8::Gemm g{mb, (const bf16*)(ws + WS_W_OUT) + (size_t)L * DM * DM, MTOK, DM, DM}; pg8::StaticOrder S; S.init(MTOK, DM, F.G, (int)blockIdx.x);
#ifdef REP_OUT
            { EpiRes E0{nullptr, hb, (bf16*)proj, halo}; pg8::gemm_phase<EpiRes, pg8::StaticOrder, true, true>(F.lds + RING_OFF, g, S, E0, F.wave); }
#endif
            unsigned char* h8o = f8_ffn(f8m, L) ? proj + PX_HB8 : nullptr;
            if (f8_out(f8m, L)) { pg8::Gemm g8{mb, (const bf16*)(ws + WS_W_OUT) + (size_t)L * DM * DM, MTOK, DM, DM / 2};
                EpiResT<1 | SER_OUT> E{nullptr, hb, hb, ss, h8o};
                pg8::gemm_phase<EpiResT<1 | SER_OUT>, pg8::StaticOrder, true, true, true>(F.lds + RING_OFF, g8, S, E, F.wave); }
            else { EpiResT<SER_OUT> E{nullptr, hb, hb, ss, h8o, L == 0 ? args.x : nullptr};
                pg8::gemm_phase<EpiResT<SER_OUT>, pg8::StaticOrder, true, true>(F.lds + RING_OFF, g, S, E, F.wave); }
#endif
        }
        SEAM(pb + 2);
        if (IN(pb + 3)) {
#ifndef SKIP_UP
            for (int rep = 0; rep < REP_UP; ++rep) {
            pg8::Gemm g{hb, (const bf16*)(ws + WS_W_UP) + (size_t)L * NUP * DM, MTOK, NUP, DM}; pg8::StaticOrder S; S.init(MTOK, NUP, F.G, (int)blockIdx.x);
#ifdef PROBE_UPK
            { EpiDummy E0{halo}; pg8::gemm_phase<EpiDummy, pg8::StaticOrder, true, true>(F.lds + RING_OFF, g, S, E0, F.wave); }
#endif
            if (f8_ffn(f8m, L)) { pg8::Gemm g8{(const bf16*)(proj + PX_HB8), (const bf16*)(ws + WS_W_UP) + (size_t)L * NUP * DM, MTOK, NUP, DM / 2};
                EpiUpT<true> E{ss, args.conv_w + (size_t)L * 3 * NUP, args.conv_b + (size_t)L * NUP, act, halo, (LAS float*)(F.lds + AUX_OFF)};
                pg8::gemm_phase<EpiUpT<true>, pg8::StaticOrder, true, true, true>(F.lds + RING_OFF, g8, S, E, F.wave); }
            else { EpiUp E{ss, args.conv_w + (size_t)L * 3 * NUP, args.conv_b + (size_t)L * NUP, act, halo, (LAS float*)(F.lds + AUX_OFF)};
                pg8::gemm_phase<EpiUp, pg8::StaticOrder, true, true>(F.lds + RING_OFF, g, S, E, F.wave); } }
#endif
        }
        SEAM(pb + 3);
#ifndef SKIP_FIX
        if (IN(pb + 4)) for (int rep = 0; rep < REP_FIX; ++rep) { OPQ_FRAME(F3); if (f8_ffn(f8m, L)) fixup_phase<true>(F3, args.conv_w + (size_t)L * 3 * NUP, args.conv_b + (size_t)L * NUP, halo, act); else fixup_phase<false>(F3, args.conv_w + (size_t)L * 3 * NUP, args.conv_b + (size_t)L * NUP, halo, act); }
#endif
        SEAM(pb + 4);
        if (IN(pb + 5)) {
#ifndef SKIP_DN
            pg8::Gemm g{act, (const bf16*)(ws + WS_W_DN) + (size_t)L * DM * FF, MTOK, DM, FF}; pg8::StaticOrder S; S.init(MTOK, DM, F.G, (int)blockIdx.x);
#ifdef REP_DN
            { EpiRes E0{nullptr, hb, mb, halo}; pg8::gemm_phase<EpiRes, pg8::StaticOrder, true, true>(F.lds + RING_OFF, g, S, E0, F.wave); }
#endif
            unsigned char* h8d = f8_in(f8m, L + 1) ? ws + WS_M : nullptr;
            if (f8_ffn(f8m, L)) { pg8::Gemm g8{act, (const bf16*)(ws + WS_W_DN) + (size_t)L * DM * FF, MTOK, DM, FF / 2};
                EpiResT<1> E{L == DEPTH - 1 ? args.out : nullptr, hb, hb, ss, h8d};
                pg8::gemm_phase<EpiResT<1>, pg8::StaticOrder, true, true, true>(F.lds + RING_OFF, g8, S, E, F.wave); }
            else { EpiRes E{L == DEPTH - 1 ? args.out : nullptr, hb, hb, ss, h8d};
                pg8::gemm_phase<EpiRes, pg8::StaticOrder, true, true>(F.lds + RING_OFF, g, S, E, F.wave); }
#endif
        }
        SEAM(pb + 5);
    }
#undef IN
#undef SEAM
}

extern "C" void kernel_launch(void* const* d_in, const int* in_sizes, int n_in, void* d_out, int out_size, void* d_ws, size_t ws_size, hipStream_t stream) {
    static int grid = 0;
    if (grid == 0) {
        if (n_in != 14 || in_sizes[0] != MTOK * DM || out_size != MTOK * DM || ws_size < WS_END) { fprintf(stderr, "kernel_launch: unexpected shapes / workspace (n_in %d, ws %zu); nothing launched\n", n_in, ws_size); grid = -1; return; }
        int dev = 0, cus = 0, per_cu = 0;
        if (hipGetDevice(&dev) != hipSuccess || hipDeviceGetAttribute(&cus, hipDeviceAttributeMultiprocessorCount, dev) != hipSuccess) { grid = -1; return; }
        if (hipFuncSetAttribute((const void*)mega_fwd, hipFuncAttributeMaxDynamicSharedMemorySize, LDS_BYTES) != hipSuccess) { fprintf(stderr, "kernel_launch: hipFuncSetAttribute failed\n"); grid = -1; return; }
        if (hipOccupancyMaxActiveBlocksPerMultiprocessor(&per_cu, (const void*)mega_fwd, NWAVES * 64, LDS_BYTES) != hipSuccess || per_cu < 1) { fprintf(stderr, "kernel_launch: occupancy query reports %d blocks per CU\n", per_cu); }
        (void)hipGetLastError();
        if (cus != GRID) { fprintf(stderr, "kernel_launch: built for a %d-CU device, found %d; nothing launched\n", GRID, cus); grid = -1; return; }
        grid = GRID;
    }
    if (grid < 0) return;
    if (hipMemsetAsync((char*)d_ws + WS_CTL, 0, CTL_ZERO_BYTES, stream) != hipSuccess) return;
    Args a{};
    a.x = (const float*)d_in[0]; a.attn_norm_g = (const float*)d_in[1]; a.w_in_a = (const float*)d_in[2]; a.w_in_b = (const float*)d_in[3]; a.q_norm_g = (const float*)d_in[4];
    a.k_norm_g = (const float*)d_in[5]; a.t5_bias = (const float*)d_in[6]; a.rel_bias_b = (const float*)d_in[7]; a.w_out = (const float*)d_in[8]; a.ffn_norm_g = (const float*)d_in[9];
    a.w_up = (const float*)d_in[10]; a.conv_w = (const float*)d_in[11]; a.conv_b = (const float*)d_in[12]; a.w_down = (const float*)d_in[13];
    a.out = (float*)d_out; a.ws = (unsigned char*)d_ws; a.f8m = F8M_ALL;
#if MK_N_LAUNCHES == 1
    a.ph_lo = 0; a.ph_hi = N_PHASES; a.li = 0;
    hipLaunchKernelGGL(mega_fwd, dim3(grid), dim3(NWAVES * 64), LDS_BYTES, stream, a);
#else
    for (int p = 0; p < N_PHASES; ++p) { a.ph_lo = p; a.ph_hi = p + 1; a.li = p; hipLaunchKernelGGL(mega_fwd, dim3(grid), dim3(NWAVES * 64), LDS_BYTES, stream, a); }
#endif
}
```

```cpp
#define OFF_G -1
#define OFF_S -1
#define OFF_A -1
#define OFF_B -1
#define F8M_IN 0xA
#define F8M_OUT 0xE
#include <hip/hip_runtime.h>
#include <cstdio>
#include <cstdint>
#ifndef OFF_G
#define OFF_G 0
#endif
#ifndef OFF_S
#define OFF_S 0
#endif
#ifndef OFF_A
#define OFF_A 0
#endif
#ifndef OFF_B
#define OFF_B 0
#endif
#define LOOP_ALIGN_N(n) asm volatile(".p2align 6\n\t.rept %0\n\ts_nop 0\n\t.endr" :: "n"(n))
#if OFF_G < 0
#define LA_G
#else
#define LA_G LOOP_ALIGN_N(OFF_G)
#endif
#if OFF_S < 0
#define LA_S
#else
#define LA_S LOOP_ALIGN_N(OFF_S)
#endif
#if OFF_A < 0
#define LA_A
#else
#define LA_A LOOP_ALIGN_N(OFF_A)
#endif
#if OFF_B < 0
#define LA_B
#else
#define LA_B LOOP_ALIGN_N(OFF_B)
#endif
namespace pg8 {
#define PG8_LAS __attribute__((address_space(3)))
typedef unsigned short bf16_t;
typedef short bf16x8 __attribute__((ext_vector_type(8)));
typedef float f32x4 __attribute__((ext_vector_type(4)));
typedef unsigned u32x4 __attribute__((ext_vector_type(4)));
typedef int i32x4 __attribute__((ext_vector_type(4)));
typedef int i32x8 __attribute__((ext_vector_type(8)));
constexpr int BM = 256, BK = 64, HALF = 128, HTB = HALF * BK * 2  , STAGE_BYTES = 8 * HTB, NXCD = 8, WGM = 8;

__host__ __device__ __forceinline__ int lds_byte(int r, int c) { const int st = (r >> 4) * 2 + (c >> 5), rr = r & 15, cc = c & 31, ob = rr * 64 + cc * 2; return st * 1024 + (ob ^ (((ob >> 9) & 1) << 5)); }
__host__ __device__ __forceinline__ void stage_rc(int b, int& R, int& C) { const int st = b / 1024, sb = b % 1024, swz = sb ^ (((sb >> 9) & 1) << 5); R = (st >> 1) * 16 + swz / 64; C = (st & 1) * 32 + (swz % 64) / 2; }
__host__ __device__ __forceinline__ int perm32(int rho) { const int n = rho >> 4, i = rho & 15; return 8 * (i >> 2) + 4 * n + (i & 3); }

struct Unit { int pm, pn; };
struct Gemm { const bf16_t* A; const bf16_t* Bt; int M, N, K; };

struct StaticOrder {
    int nM, nN, nwg, G, c;
    __host__ __device__ void init(int M, int N, int G_, int c_) { nM = M / BM; nN = N / BM; nwg = nM * nN; G = G_; c = c_; }
    __host__ __device__ bool next(int i, Unit& u) const {
        const long L = (long)i * G + c; if (L >= nwg) return false;
        int wgid = (int)L; { const int q = nwg / NXCD, r = nwg % NXCD, xcd = wgid % NXCD, off = wgid / NXCD; wgid = (xcd < r ? xcd * (q + 1) : r * (q + 1) + (xcd - r) * q) + off; }
        const int nig = WGM * nN, gid = wgid / nig, fm = gid * WGM, gsz = (nM - fm) < WGM ? (nM - fm) : WGM;
        u.pm = fm + ((wgid % nig) % gsz); u.pn = (wgid % nig) / gsz; return true;
    }
    __device__ __forceinline__ void a_ready(const Unit&) const {}
    __device__ __forceinline__ void done(const Unit&) const {}
};
__device__ __forceinline__ unsigned cvt_pk_bf16(float lo, float hi) { unsigned r; asm volatile("v_cvt_pk_bf16_f32 %0, %1, %2" : "=v"(r) : "v"(lo), "v"(hi)); return r; }
template <class Epi, class Sched, bool ALIGN_EPI = false, bool SP2 = false, bool F8 = false>
__device__ __forceinline__ void gemm_phase(PG8_LAS unsigned char* lds, const Gemm g, const Sched& S, const Epi& E, const int wave_id) {
    int lane_; asm volatile("v_mbcnt_lo_u32_b32 %0, -1, 0\n\tv_mbcnt_hi_u32_b32 %0, -1, %0" : "=v"(lane_));
    int wid_ = wave_id; asm volatile("" : "+s"(wid_));
    const int wid = wid_, lane = lane_, tid = wid * 64 + lane, wr = wid >> 2, wc = wid & 3, fr = lane & 15, fq = lane >> 4;
    const int K = g.K, nt = K / BK;
    unsigned voffA[2], voffB[2];
#pragma unroll
    for (int i = 0; i < 2; ++i) { int R, C; stage_rc(tid * 16 + i * 8192, R, C); const int Rb = Epi::PERM ? ((R & ~31) + perm32(R & 31)) : R;
        const int Ra = Epi::PERMA ? ((R & ~63) | (4 * (R & 15) + ((R >> 4) & 3))) : R;
        voffA[i] = (unsigned)(Ra * K + C) * 2u; voffB[i] = (unsigned)(Rb * K + C) * 2u; }
    const size_t kstep = (size_t)(BK * 2);
    const size_t hstep = (size_t)HALF * K * 2;
    const size_t tstep = 2 * hstep;
    const unsigned ldsw = (unsigned)wid * 1024u;
    const int aoff = lds_byte(wr * 64 + fr, fq * 8), boff = lds_byte(wc * 32 + fr, fq * 8);
#define PG8_SA(b, h) (((b) * 2 + (h)) * HTB)
#define PG8_SB(b, h) ((4 + (b) * 2 + (h)) * HTB)
#define PG8_STAGE(bufoff, gbase, voff) do { _Pragma("unroll") for (int _i = 0; _i < 2; ++_i) \
        __builtin_amdgcn_global_load_lds((const unsigned*)((const char*)(gbase) + (voff)[_i]), (PG8_LAS unsigned*)(lds + (bufoff) + ldsw + _i * 8192), 16, 0, 0); } while (0)
#define PG8_LDA(dst, b, h) do { _Pragma("unroll") for (int m = 0; m < 4; ++m) _Pragma("unroll") for (int k = 0; k < 2; ++k) dst[m][k] = *(const PG8_LAS bf16x8*)(lds + PG8_SA(b, h) + aoff + m * 2048 + k * 1024); } while (0)
#define PG8_LDB(dst, b, h) do { _Pragma("unroll") for (int n = 0; n < 2; ++n) _Pragma("unroll") for (int k = 0; k < 2; ++k) dst[n][k] = *(const PG8_LAS bf16x8*)(lds + PG8_SB(b, h) + boff + n * 2048 + k * 1024); } while (0)
#define PG8_CAT(lo, hi) __builtin_shufflevector(__builtin_bit_cast(i32x4, lo), __builtin_bit_cast(i32x4, hi), 0, 1, 2, 3, 4, 5, 6, 7)
#define PG8_MMA(ai, bj, At, Bt) do { __builtin_amdgcn_s_setprio(1); _Pragma("unroll") for (int m = 0; m < 4; ++m) _Pragma("unroll") for (int n = 0; n < 2; ++n) { \
        if constexpr (F8) { const i32x8 b8_ = PG8_CAT(Bt[n][0], Bt[n][1]), a8_ = PG8_CAT(At[m][0], At[m][1]); asm volatile("v_mfma_f32_16x16x128_f8f6f4 %0, %1, %2, %0" : "+v"(acc[ai][bj][m][n]) : "v"(b8_), "v"(a8_)); } \
        else { _Pragma("unroll") for (int k = 0; k < 2; ++k) acc[ai][bj][m][n] = __builtin_amdgcn_mfma_f32_16x16x32_bf16(Bt[n][k], At[m][k], acc[ai][bj][m][n], 0, 0, 0); } } __builtin_amdgcn_s_setprio(0); } while (0)
#define PG8_WAIT_V(n) asm volatile("s_waitcnt vmcnt(" #n ")" ::: "memory")
#define PG8_WAIT_L(n) asm volatile("s_waitcnt lgkmcnt(" #n ")" ::: "memory")
#define PG8_BAR __builtin_amdgcn_s_barrier()
#define PG8_SCHED __builtin_amdgcn_sched_barrier(0)
    Unit cur, nxt; int ui = 0;
    if (!S.next(0, cur)) return;
    f32x4 acc[2][2][4][2];
#pragma unroll
    for (int a = 0; a < 2; ++a)
#pragma unroll
        for (int b = 0; b < 2; ++b)
#pragma unroll
            for (int m = 0; m < 4; ++m)
#pragma unroll
                for (int n = 0; n < 2; ++n) acc[a][b][m][n] = (f32x4){0.f, 0.f, 0.f, 0.f};
    bf16x8 At[4][2], B0[2][2], B1[2][2];
    const char* cA = (const char*)g.A + (size_t)cur.pm * tstep; const char* cB = (const char*)g.Bt + (size_t)cur.pn * tstep;
    S.a_ready(cur);
    if constexpr (SP2) {
        PG8_STAGE(PG8_SB(0, 0), cB, voffB); PG8_STAGE(PG8_SB(0, 1), cB + hstep, voffB); PG8_STAGE(PG8_SA(0, 0), cA, voffA); PG8_STAGE(PG8_SA(0, 1), cA + hstep, voffA);
        if (wr == 1) PG8_BAR;
        PG8_WAIT_V(2); PG8_BAR;
        PG8_STAGE(PG8_SB(1, 0), cB + kstep, voffB); PG8_STAGE(PG8_SA(1, 0), cA + kstep, voffA); PG8_STAGE(PG8_SB(1, 1), cB + hstep + kstep, voffB);
        PG8_WAIT_V(6); PG8_BAR;
    } else {
        PG8_STAGE(PG8_SB(0, 0), cB, voffB); PG8_STAGE(PG8_SA(0, 0), cA, voffA); PG8_STAGE(PG8_SB(0, 1), cB + hstep, voffB); PG8_STAGE(PG8_SA(0, 1), cA + hstep, voffA);
        if (wr == 1) PG8_BAR;
        PG8_WAIT_V(4); PG8_BAR;
        PG8_STAGE(PG8_SB(1, 0), cB + kstep, voffB); PG8_STAGE(PG8_SA(1, 0), cA + kstep, voffA); PG8_STAGE(PG8_SB(1, 1), cB + hstep + kstep, voffB);
        PG8_WAIT_V(6); PG8_BAR;
    }
    for (;;) {
        const bool has_next = S.next(ui + 1, nxt);
        const char* nA = has_next ? (const char*)g.A + (size_t)nxt.pm * tstep : cA; const char* nB = has_next ? (const char*)g.Bt + (size_t)nxt.pn * tstep : cB;
        for (int t = 0; t < nt; t += 2) { LA_G;
            const bool last = (t == nt - 2);
            const char* a1 = cA + (size_t)(t + 1) * kstep;
            const char* a2 = last ? nA : cA + (size_t)(t + 2) * kstep; const char* b2 = last ? nB : cB + (size_t)(t + 2) * kstep;
            const char* a3 = a2 + kstep; const char* b3 = b2 + kstep;
            if (last && has_next) S.a_ready(nxt);
            if constexpr (SP2) {
            PG8_LDB(B0, 0, 0); PG8_LDB(B1, 0, 1); PG8_SCHED; PG8_LDA(At, 0, 0); PG8_STAGE(PG8_SA(1, 1), a1 + hstep, voffA);
            PG8_WAIT_V(8); PG8_WAIT_L(0); PG8_BAR; PG8_MMA(0, 0, At, B0); PG8_MMA(0, 1, At, B1); PG8_BAR; PG8_SCHED;
            PG8_LDA(At, 0, 1); PG8_STAGE(PG8_SB(0, 0), b2, voffB); PG8_STAGE(PG8_SB(0, 1), b2 + hstep, voffB); PG8_STAGE(PG8_SA(0, 0), a2, voffA);
            PG8_WAIT_V(8); PG8_WAIT_L(0); PG8_BAR; PG8_MMA(1, 0, At, B0); PG8_MMA(1, 1, At, B1); PG8_BAR; PG8_SCHED;
            PG8_LDB(B0, 1, 0); PG8_LDB(B1, 1, 1); PG8_SCHED; PG8_LDA(At, 1, 0); PG8_STAGE(PG8_SA(0, 1), a2 + hstep, voffA);
            PG8_WAIT_V(8); PG8_WAIT_L(0); PG8_BAR; PG8_MMA(0, 0, At, B0); PG8_MMA(0, 1, At, B1); PG8_BAR; PG8_SCHED;
            PG8_LDA(At, 1, 1); PG8_STAGE(PG8_SB(1, 0), b3, voffB); PG8_STAGE(PG8_SB(1, 1), b3 + hstep, voffB); PG8_STAGE(PG8_SA(1, 0), a3, voffA);
            PG8_WAIT_V(8); PG8_WAIT_L(0); PG8_BAR; PG8_MMA(1, 0, At, B0); PG8_MMA(1, 1, At, B1); PG8_BAR; PG8_SCHED;
            } else {
            PG8_LDB(B0, 0, 0); PG8_SCHED; PG8_LDA(At, 0, 0); PG8_STAGE(PG8_SA(1, 1), a1 + hstep, voffA);
            PG8_WAIT_L(8); PG8_BAR; PG8_WAIT_L(0); PG8_MMA(0, 0, At, B0); PG8_BAR; PG8_SCHED;
            PG8_LDB(B1, 0, 1); PG8_STAGE(PG8_SB(0, 0), b2, voffB);
            PG8_BAR; PG8_WAIT_L(0); PG8_MMA(0, 1, At, B1); PG8_BAR;
            PG8_LDA(At, 0, 1); PG8_STAGE(PG8_SA(0, 0), a2, voffA);
            PG8_BAR; PG8_WAIT_L(0); PG8_MMA(1, 0, At, B0); PG8_BAR; PG8_SCHED;
            PG8_STAGE(PG8_SB(0, 1), b2 + hstep, voffB);
            PG8_WAIT_V(6); PG8_BAR; PG8_MMA(1, 1, At, B1); PG8_BAR;
            PG8_LDB(B0, 1, 0); PG8_SCHED; PG8_LDA(At, 1, 0); PG8_STAGE(PG8_SA(0, 1), a2 + hstep, voffA);
            PG8_WAIT_L(8); PG8_BAR; PG8_WAIT_L(0); PG8_MMA(0, 0, At, B0); PG8_BAR; PG8_SCHED;
            PG8_LDB(B1, 1, 1); PG8_STAGE(PG8_SB(1, 0), b3, voffB);
            PG8_BAR; PG8_WAIT_L(0); PG8_MMA(0, 1, At, B1); PG8_BAR;
            PG8_LDA(At, 1, 1); PG8_STAGE(PG8_SA(1, 0), a3, voffA);
            PG8_BAR; PG8_WAIT_L(0); PG8_MMA(1, 0, At, B0); PG8_BAR; PG8_SCHED;
            PG8_STAGE(PG8_SB(1, 1), b3 + hstep, voffB);
            PG8_WAIT_V(6); PG8_BAR; PG8_MMA(1, 1, At, B1); PG8_BAR;
            }
        }
        if constexpr (F8) asm volatile("s_nop 15\n\ts_nop 15" ::: "memory");
        if constexpr (ALIGN_EPI) { if (wr == 0) PG8_BAR; }
        if constexpr (!Epi::AFTER_DRAIN) { E(acc, cur, wr, wc, fr, fq); S.done(cur); }
        if (!has_next) break;
#pragma unroll
        for (int a = 0; a < 2; ++a)
#pragma unroll
            for (int b = 0; b < 2; ++b)
#pragma unroll
                for (int m = 0; m < 4; ++m)
#pragma unroll
                    for (int n = 0; n < 2; ++n) acc[a][b][m][n] = (f32x4){0.f, 0.f, 0.f, 0.f};
        cur = nxt; cA = nA; cB = nB; ++ui;
        if constexpr (ALIGN_EPI) { if (wr == 1) PG8_BAR; }
    }
    PG8_WAIT_V(0);
    if constexpr (!ALIGN_EPI) { if (wr == 0) PG8_BAR; }
    PG8_BAR;
    if constexpr (Epi::AFTER_DRAIN) { E.fused(acc, cur, wr, wc, fr, fq, lds, wid, lane); S.done(cur); }
#undef PG8_SA
#undef PG8_SB
#undef PG8_STAGE
#undef PG8_LDA
#undef PG8_LDB
#undef PG8_MMA
#undef PG8_CAT
#undef PG8_WAIT_V
#undef PG8_WAIT_L
#undef PG8_BAR
#undef PG8_SCHED
}
}

constexpr int NWAVES = 8, GRID = 256;
constexpr int BATCH = 4, SEQ = 8192, DM = 1024, MTOK = BATCH * SEQ, DEPTH = 4;
constexpr int NA_SRC = 2120, NA_PAD = 2304, NB = 3072, FF = 2816, NUP = 2 * FF;
constexpr float EPS = 1e-6f;
constexpr float LOG2E = 1.4426950408889634f;
constexpr float C2 = 0.125f * LOG2E;
constexpr int NBLK64 = MTOK / 64;

constexpr size_t MiB = 1u << 20;
constexpr size_t WS_CTL = 0, CTL_ZERO_BYTES = 1 * MiB;
constexpr size_t WS_W_INA = 2 * MiB;
constexpr size_t WS_W_INB = 11 * MiB;
constexpr size_t WS_W_OUT = 23 * MiB;
constexpr size_t WS_W_UP = 31 * MiB;
constexpr size_t WS_W_DN = 75 * MiB;
constexpr size_t WS_HB = 98 * MiB;
constexpr size_t WS_M = 162 * MiB;
constexpr size_t WS_SS = 226 * MiB;
constexpr size_t WS_HALO = 228 * MiB;
constexpr size_t WS_PROJ = 272 * MiB;
constexpr size_t WS_END = 464 * MiB;
constexpr size_t PA_QA = 0, PA_KA = 64 * MiB, PA_VA = 80 * MiB, PA_QI = 96 * MiB, PA_KI = 128 * MiB, PA_WI = 132 * MiB, PA_SEL = 136 * MiB;
constexpr size_t PB_STRIDE = 64 * MiB;
constexpr int CW_BAR = 4096;
constexpr int F8_L0 = 2;
#ifndef F8M_IN
#define F8M_IN 0x8
#endif
#ifndef F8M_OUT
#define F8M_OUT 0xC
#endif
#ifndef F8M_FFN
#define F8M_FFN 0xC
#endif
#define F8M_ALL ((F8M_IN & 0xA) | ((F8M_OUT & 0xF) << 4) | ((F8M_FFN & 0xF) << 8))
__host__ __device__ constexpr bool f8_in(int m, int L) { return L < DEPTH && ((m >> L) & 1) != 0; }
__host__ __device__ constexpr bool f8_out(int m, int L) { return ((m >> (4 + L)) & 1) != 0; }
__host__ __device__ constexpr bool f8_ffn(int m, int L) { return ((m >> (8 + L)) & 1) != 0; }
constexpr size_t PX_HB8 = 96 * MiB;
constexpr float W8S = 128.f, W8I = 1.f / 128.f;

constexpr int RING_OFF = 0, RING_BYTES = 131072;
constexpr int KS_OFF = RING_BYTES;
constexpr int AUX_OFF = RING_BYTES + 24576;
constexpr int LDSCTL_OFF = AUX_OFF + 4096, MISC_OFF = LDSCTL_OFF + 320;
constexpr int LDS_BYTES = 163840;
static_assert(MISC_OFF + 128 <= LDS_BYTES, "LDS map");

#define GAS __attribute__((address_space(1)))
#define LAS __attribute__((address_space(3)))
typedef unsigned short bf16;
typedef unsigned v4u __attribute__((ext_vector_type(4)));
typedef unsigned v2u __attribute__((ext_vector_type(2)));
typedef float f32x4 __attribute__((ext_vector_type(4)));
typedef float f32x16 __attribute__((ext_vector_type(16)));
typedef short bf16x8 __attribute__((ext_vector_type(8)));
typedef short s16x4 __attribute__((ext_vector_type(4)));
typedef float f32x2_t __attribute__((ext_vector_type(2)));
typedef GAS unsigned gu32;
#define RLX_AGENT __ATOMIC_RELAXED, __HIP_MEMORY_SCOPE_AGENT
#define LDS_WAIT() asm volatile("s_waitcnt lgkmcnt(0)" ::: "memory")
#define VM_WAIT() asm volatile("s_waitcnt vmcnt(0)" ::: "memory")
__device__ __forceinline__ unsigned f2bf(float f) { unsigned u = __builtin_bit_cast(unsigned, f); return (u + 0x7fffu + ((u >> 16) & 1u)) >> 16; }
__device__ __forceinline__ unsigned pk2(float lo, float hi) { return f2bf(lo) | (f2bf(hi) << 16); }
typedef float f32x2c_t __attribute__((ext_vector_type(2))); typedef __bf16 bf16x2c_t __attribute__((ext_vector_type(2)));
__device__ __forceinline__ unsigned cvtpk(float lo, float hi) { const f32x2c_t v = {lo, hi}; const bf16x2c_t b = __builtin_convertvector(v, bf16x2c_t); return __builtin_bit_cast(unsigned, b); }
__device__ __forceinline__ float bf_lo(unsigned u) { return __builtin_bit_cast(float, u << 16); }
__device__ __forceinline__ float bf_hi(unsigned u) { return __builtin_bit_cast(float, u & 0xffff0000u); }

__device__ __forceinline__ unsigned pk4f8(float a, float b, float c, float d) { int r = __builtin_amdgcn_cvt_pk_fp8_f32(a, b, 0, false); r = __builtin_amdgcn_cvt_pk_fp8_f32(c, d, r, true); return (unsigned)r; }

#define XB_TMO      128
#define XB_XCNT(j)  (256  + 64 * (j))
#define XB_XSUB(j)  (1280 + 64 * (j))
#define XB_XGEN(j)  (2304 + 64 * (j))
#define XB_TOP      3328
#define XB_TOPGEN   3392
#define XCD_BAR_WORDS 3456
#define XB_SPIN_CAP (1u << 18)

__device__ __forceinline__ unsigned xb_ld(unsigned* p)              { return __hip_atomic_load(p, __ATOMIC_RELAXED, __HIP_MEMORY_SCOPE_AGENT); }
__device__ __forceinline__ unsigned xb_add(unsigned* p, unsigned v) { return __hip_atomic_fetch_add(p, v, __ATOMIC_RELAXED, __HIP_MEMORY_SCOPE_AGENT); }
__device__ __forceinline__ unsigned xb_xcc_id() { return (unsigned)__builtin_amdgcn_s_getreg((3 << 11) | 20) & 0xFu; }
#define XB_SPIN(cond, bar) do { unsigned _sp = 0; while (cond) { __builtin_amdgcn_s_sleep(1); \
    if ((++_sp & 255u) == 0u) { if (xb_ld(&(bar)[XB_TMO])) break; if (_sp > XB_SPIN_CAP) { atomicAdd(&(bar)[XB_TMO], 1u); break; } } } } while (0)

struct XcdBarrier {
    unsigned* bar; unsigned x;
    volatile LAS unsigned* st;
};

__device__ __forceinline__ XcdBarrier xcd_barrier_post(unsigned* bar, volatile LAS unsigned* st) {
    XcdBarrier b; b.bar = bar; b.x = xb_xcc_id(); b.st = st;
    if (threadIdx.x == 0) (void)xb_add(&bar[XB_XCNT(b.x)], 1u);
    return b;
}
__device__ __forceinline__ void xcd_barrier_complete(unsigned* bar, unsigned x, unsigned& nloc, unsigned& nx) {
    const unsigned G = gridDim.x * gridDim.y * gridDim.z;
    unsigned sum, cnt, mine, sp = 0u;
    for (;;) {
        sum = 0u; cnt = 0u; mine = 0u;
#pragma unroll
        for (unsigned j = 0; j < 16; ++j) { const unsigned c = xb_ld(&bar[XB_XCNT(j)]); sum += c; cnt += (c > 0u) ? 1u : 0u; mine = (j == x) ? c : mine; }
        if (sum == G) break;
        __builtin_amdgcn_s_sleep(1);
        if ((++sp & 255u) == 0u) { if (xb_ld(&bar[XB_TMO])) break; if (sp > XB_SPIN_CAP) { atomicAdd(&bar[XB_TMO], 1u); break; } }
    }
    nloc = mine > 0u ? mine : 1u; nx = cnt > 0u ? cnt : 1u;
}

__device__ __forceinline__ void xcd_barrier(const XcdBarrier& b) {
    asm volatile("s_waitcnt vmcnt(0)" ::: "memory");
    __syncthreads();
    if (threadIdx.x == 0) {
        unsigned* bar = b.bar;
        __builtin_amdgcn_s_waitcnt(0);
        unsigned nloc = b.st[0], nx = b.st[1];
        if (nloc == 0u) { xcd_barrier_complete(bar, b.x, nloc, nx); b.st[0] = nloc; b.st[1] = nx; }
        const unsigned old = xb_add(&bar[XB_XSUB(b.x)], 1u);
        const unsigned gen = old / nloc;
        if (old + 1u == (gen + 1u) * nloc) {
            __builtin_amdgcn_fence(__ATOMIC_RELEASE, "agent");
            asm volatile("s_waitcnt vmcnt(0)" ::: "memory");
            const unsigned og = xb_add(&bar[XB_TOP], 1u);
            const unsigned tg = og / nx;
            if (og + 1u == (tg + 1u) * nx) xb_add(&bar[XB_TOPGEN], 1u);
            else XB_SPIN(xb_ld(&bar[XB_TOPGEN]) == tg, bar);
            __builtin_amdgcn_fence(__ATOMIC_ACQUIRE, "agent");
            xb_add(&bar[XB_XGEN(b.x)], 1u);
            asm volatile("s_waitcnt vmcnt(0)" ::: "memory");
        } else {
            XB_SPIN(xb_ld(&bar[XB_XGEN(b.x)]) == gen, bar);
            __builtin_amdgcn_fence(__ATOMIC_ACQUIRE, "agent");
            asm volatile("s_waitcnt vmcnt(0)" ::: "memory");
        }
    }
    __syncthreads();
}


struct Args {
    const float* x; const float* attn_norm_g; const float* w_in_a; const float* w_in_b; const float* q_norm_g; const float* k_norm_g; const float* t5_bias;
    const float* rel_bias_b; const float* w_out; const float* ffn_norm_g; const float* w_up; const float* conv_w; const float* conv_b; const float* w_down;
    float* out; unsigned char* ws; int ph_lo, ph_hi, li, f8m;
};

struct Frame {
    LAS unsigned char* lds;
    volatile LAS unsigned* MISC;
    gu32* ctl;
    int tid, lane, wave, vcu, G;
};

__host__ __device__ __forceinline__ int hmap(int p) { return 64 * ((p >> 5) & 3) + 16 * ((p >> 2) & 3) + 8 * (p >> 7) + 4 * ((p >> 4) & 1) + (p & 3); }
__host__ __device__ __forceinline__ int umap(int p) { return 32 * ((p >> 5) & 3) + 8 * ((p >> 2) & 3) + 4 * ((p >> 4) & 1) + (p & 3); }
__host__ __device__ __forceinline__ int src_col(int type, int n) {
    if (type == 0) return n;
    const int pn = n >> 8, p = n & 255;
    if (type == 2) return 256 * pn + hmap(p);
    if (type == 1) { const int c = hmap(p); return pn < 8 ? 256 * pn + c : (c < 72 ? 2048 + c : -1); }
    return (p >> 7) * FF + 128 * pn + umap(p);
}
__device__ __forceinline__ void convert_item(const float* W, int K, int Nsrc, int Ndst, int type, const float* gain, bf16* WT, LAS float* scr, int item, int lane, bool o8 = false) {
    const int nblk = Ndst / 32, kb = item / nblk, nb = item % nblk, k0 = 64 * kb, n0 = 32 * nb;
    const int sc = src_col(type, n0 + (lane & 31));
#pragma unroll 8
    for (int i = 0; i < 32; ++i) { const int kk = 2 * i + (lane >> 5); float v = 0.f; if (sc >= 0) v = W[(size_t)(k0 + kk) * Nsrc + sc]; if (gain) v *= gain[k0 + kk]; scr[kk * 33 + (lane & 31)] = v; }
    LDS_WAIT(); asm volatile("" ::: "memory");
    const int c = lane & 7;
#pragma unroll
    for (int j = 0; j < 4; ++j) { const int n = (lane >> 3) + 8 * j; const LAS float* s = scr + (8 * c) * 33 + n;
        if (o8) { v2u o; o.x = pk4f8(s[0 * 33] * W8S, s[1 * 33] * W8S, s[2 * 33] * W8S, s[3 * 33] * W8S); o.y = pk4f8(s[4 * 33] * W8S, s[5 * 33] * W8S, s[6 * 33] * W8S, s[7 * 33] * W8S);
            *(v2u*)((unsigned char*)WT + (size_t)(n0 + n) * K + k0 + 8 * c) = o; }
        else { v4u o; o.x = pk2(s[0 * 33], s[1 * 33]); o.y = pk2(s[2 * 33], s[3 * 33]); o.z = pk2(s[4 * 33], s[5 * 33]); o.w = pk2(s[6 * 33], s[7 * 33]);
            *(v4u*)(WT + (size_t)(n0 + n) * K + k0 + 8 * c) = o; } }
    LDS_WAIT(); asm volatile("" ::: "memory");
}
__device__ __forceinline__ float wave_sum(float v) {
#pragma unroll
    for (int o = 1; o < 64; o <<= 1) v += __shfl_xor(v, o);
    return v;
}
#ifdef F8M_RUNTIME
#define F8MV a.f8m
#else
#define F8MV F8M_ALL
#endif
__device__ __forceinline__ void p0_prologue(Frame& F, const Args& a) {
    LAS float* scr = (LAS float*)(F.lds + RING_OFF + F.wave * 16384);
    const int gw = F.vcu * NWAVES + F.wave, NGW = F.G * NWAVES;
    constexpr int I_INA = 16 * (NA_PAD / 32), I_INB = 16 * (NB / 32), I_OUT = 16 * 32, I_UP = 16 * (NUP / 32), I_DN = (FF / 64) * 32;
    constexpr int NITEMS = 2 * I_INA + 2 * I_INB + 4 * I_OUT + 4 * I_UP + 4 * I_DN;
    unsigned char* ws = a.ws;
    for (int it = gw; it < NITEMS; it += NGW) {
        int r = it;
        if (r < 2 * I_INA) { const int l = r / I_INA; convert_item(a.w_in_a + (size_t)l * DM * NA_SRC, DM, NA_SRC, NA_PAD, 1, a.attn_norm_g + (2 * l) * DM, (bf16*)(ws + WS_W_INA) + (size_t)l * NA_PAD * DM, scr, r % I_INA, F.lane); continue; } r -= 2 * I_INA;
        if (r < 2 * I_INB) { const int l = r / I_INB; convert_item(a.w_in_b + (size_t)l * DM * NB, DM, NB, NB, 2, a.attn_norm_g + (2 * l + 1) * DM, (bf16*)(ws + WS_W_INB) + (size_t)l * NB * DM, scr, r % I_INB, F.lane, f8_in(F8MV, 2 * l + 1)); continue; } r -= 2 * I_INB;
        if (r < 4 * I_OUT) { const int l = r / I_OUT; convert_item(a.w_out + (size_t)l * DM * DM, DM, DM, DM, 0, nullptr, (bf16*)(ws + WS_W_OUT) + (size_t)l * DM * DM, scr, r % I_OUT, F.lane, f8_out(F8MV, l)); continue; } r -= 4 * I_OUT;
        if (r < 4 * I_UP) { const int l = r / I_UP; convert_item(a.w_up + (size_t)l * DM * NUP, DM, NUP, NUP, 3, a.ffn_norm_g + l * DM, (bf16*)(ws + WS_W_UP) + (size_t)l * NUP * DM, scr, r % I_UP, F.lane, f8_ffn(F8MV, l)); continue; } r -= 4 * I_UP;
        { const int l = r / I_DN; convert_item(a.w_down + (size_t)l * FF * DM, FF, DM, DM, 0, nullptr, (bf16*)(ws + WS_W_DN) + (size_t)l * DM * FF, scr, r % I_DN, F.lane, f8_ffn(F8MV, l)); }
    }
    bf16* hb = (bf16*)(ws + WS_HB); float* ss = (float*)(ws + WS_SS);
    for (int m = gw; m < MTOK; m += NGW) {
        const f32x4* xr = (const f32x4*)(a.x + (size_t)m * DM) + F.lane; f32x4 v[4]; float s = 0.f;
#pragma unroll
        for (int j = 0; j < 4; ++j) { v[j] = xr[64 * j]; s += (v[j].x * v[j].x + v[j].y * v[j].y) + (v[j].z * v[j].z + v[j].w * v[j].w); }
        s = wave_sum(s);
        v2u* o8 = (v2u*)(hb + (size_t)m * DM) + F.lane;
#pragma unroll
        for (int j = 0; j < 4; ++j) { v2u w; w.x = pk2(v[j].x, v[j].y); w.y = pk2(v[j].z, v[j].w); o8[64 * j] = w; }
        if (F.lane < 16) ss[(size_t)m * 16 + F.lane] = (F.lane == 0) ? s : 0.f;
    }
}

__device__ __forceinline__ f32x4 rstd_load(const float* ss, int row, int fq) { return *(const f32x4*)(ss + (size_t)row * 16 + 4 * fq); }
__device__ __forceinline__ float rstd_finish(f32x4 a) {
    float s = (a.x + a.y) + (a.z + a.w);
    s += __shfl_xor(s, 16); s += __shfl_xor(s, 32);
    return __builtin_amdgcn_rsqf(s * (1.0f / DM) + EPS);
}
__device__ __forceinline__ float row_rstd(const float* ss, int row, int fq) { return rstd_finish(rstd_load(ss, row, fq)); }
__device__ __forceinline__ unsigned att_pk4(f32x4 v) { int r = __builtin_amdgcn_cvt_pk_fp8_f32(v.x, v.y, 0, false); r = __builtin_amdgcn_cvt_pk_fp8_f32(v.z, v.w, r, true); return (unsigned)r; }
struct EpiIn {
    static constexpr bool PERM = false, PERMA = false, AFTER_DRAIN = false;
    const float* ss; unsigned char* proj; const float* qg; const float* kg; int isB; float as;
    __device__ __forceinline__ void operator()(const pg8::f32x4 (&acc)[2][2][4][2], const pg8::Unit& u, int wr, int wc, int fr, int fq) const {
        asm volatile("" : "+v"(fr), "+v"(fq));
        const int pn = u.pn; int kind, pitch; bf16* dst;
        if (isB) { const int t = pn >> 2; kind = (t == 0) ? 1 : (t == 1 ? 2 : 0); dst = (bf16*)(proj + (size_t)t * PB_STRIDE) + 256 * (pn & 3); pitch = DM; }
        else if (pn < 4) { kind = 1; dst = (bf16*)(proj + PA_QA) + 256 * pn; pitch = DM; }
        else if (pn == 4) { kind = 2; dst = (bf16*)(proj + PA_KA); pitch = 256; }
        else if (pn == 5) { kind = 0; dst = (bf16*)(proj + PA_VA); pitch = 256; }
        else if (pn < 8) { kind = 0; dst = (bf16*)(proj + PA_QI) + 256 * (pn - 6); pitch = 512; }
        else { kind = 3; dst = (bf16*)(proj + PA_KI); pitch = 64; }
        if (kind == 3 && wc >= 2) return;
        const bool donorm = (kind == 1) || (kind == 2) || (kind == 3 && wc == 0);
        f32x4 g[2][2];
#pragma unroll
        for (int bj = 0; bj < 2; ++bj)
#pragma unroll
            for (int n = 0; n < 2; ++n) {
                if (kind == 1) g[bj][n] = *(const f32x4*)(qg + 16 * fq + 8 * bj + 4 * n) * (isB ? C2 : 1.0f);
                else if (kind == 2) g[bj][n] = *(const f32x4*)(kg + 16 * fq + 8 * bj + 4 * n);
                else g[bj][n] = (f32x4){1.f, 1.f, 1.f, 1.f};
            }
        float* wi = (float*)(proj + PA_WI);
        f32x4 rsl[2][4];
#pragma unroll
        for (int ai = 0; ai < 2; ++ai)
#pragma unroll
            for (int m = 0; m < 4; ++m) rsl[ai][m] = rstd_load(ss, u.pm * 256 + ai * 128 + wr * 64 + m * 16 + fr, fq);
#pragma unroll
        for (int ai = 0; ai < 2; ++ai)
#pragma unroll
            for (int m = 0; m < 4; ++m) {
                const int row = u.pm * 256 + ai * 128 + wr * 64 + m * 16 + fr;
                const float rs = rstd_finish(rsl[ai][m]) * as;
                f32x4 v[2][2]; float s = 0.f;
#pragma unroll
                for (int bj = 0; bj < 2; ++bj)
#pragma unroll
                    for (int n = 0; n < 2; ++n) { v[bj][n] = acc[ai][bj][m][n] * rs; const f32x4 q = v[bj][n] * v[bj][n]; s += (q.x + q.y) + (q.z + q.w); }
                if (donorm) {
                    s += __shfl_xor(s, 16); s += __shfl_xor(s, 32);
                    const float r = 1.0f / sqrtf(s * (1.0f / 64.0f) + EPS);
#pragma unroll
                    for (int bj = 0; bj < 2; ++bj)
#pragma unroll
                        for (int n = 0; n < 2; ++n) v[bj][n] = v[bj][n] * r * g[bj][n];
                }
                if (kind == 3 && wc == 1) {
                    if (fq == 0) { float* wp = wi + (size_t)row * 8; const float sc = 0.04419417382415922f;
                        *(f32x4*)(wp) = v[0][0] * sc; *(f32x4*)(wp + 4) = v[0][1] * sc; }
                } else if (!isB && pn < 6) {
                    unsigned char* p8 = (pn < 4) ? proj + PA_QA + (size_t)row * 1024 + 256 * pn + 64 * wc + 16 * fq : proj + PA_KA + (size_t)row * 512 + 128 * wc + 64 * (pn - 4) + 16 * fq;
                    v4u w; w.x = att_pk4(v[0][0]); w.y = att_pk4(v[0][1]); w.z = att_pk4(v[1][0]); w.w = att_pk4(v[1][1]);
                    *(v4u*)p8 = w;
                } else {
                    bf16* rp = dst + (size_t)row * pitch + 64 * wc + 16 * fq;
#pragma unroll
                    for (int bj = 0; bj < 2; ++bj) { v4u w; w.x = cvtpk(v[bj][0].x, v[bj][0].y); w.y = cvtpk(v[bj][0].z, v[bj][0].w); w.z = cvtpk(v[bj][1].x, v[bj][1].y); w.w = cvtpk(v[bj][1].z, v[bj][1].w);
                        *(v4u*)(rp + 8 * bj) = w; }
                }
            }
    }
};
template <int MODE>
struct EpiResT {
    static constexpr bool PERM = false, PERMA = false, AFTER_DRAIN = false;
    float* fout; const bf16* hbi; bf16* hb; float* ss; unsigned char* hb8; const float* xin;
    __device__ __forceinline__ void operator()(const pg8::f32x4 (&acc)[2][2][4][2], const pg8::Unit& u, int wr, int wc, int fr, int fq) const {
        if (fout) body<true, false, false>(acc, u, wr, wc, fr, fq); else if (hb8) body<false, true, false>(acc, u, wr, wc, fr, fq); else if (xin) body<false, false, true>(acc, u, wr, wc, fr, fq); else body<false, false, false>(acc, u, wr, wc, fr, fq);
    }
    template <bool FOUT, bool HB8, bool XIN>
    __device__ __forceinline__ void body(const pg8::f32x4 (&acc)[2][2][4][2], const pg8::Unit& u, int wr, int wc, int fr, int fq) const {
        asm volatile("" : "+v"(fr), "+v"(fq));
        const int col0 = u.pn * 256 + wc * 32 + 4 * fq;
#pragma unroll
        for (int ai = 0; ai < 2; ++ai) {
            v2u base[4][2][2]; f32x4 basex[XIN ? 4 : 1][2][2];
#pragma unroll
            for (int m = 0; m < 4; ++m)
#pragma unroll
                for (int bj = 0; bj < 2; ++bj)
#pragma unroll
                    for (int n = 0; n < 2; ++n) { const size_t o4 = (size_t)(u.pm * 256 + ai * 128 + wr * 64 + m * 16 + fr) * DM + col0 + bj * 128 + n * 16; if constexpr (XIN) basex[m][bj][n] = *(const f32x4*)(xin + o4); else base[m][bj][n] = *(const v2u*)(hbi + o4);
                        if ((MODE & 4) && n == 1) asm volatile("s_waitcnt vmcnt(0)" ::: "memory"); }
            asm volatile("" ::: "memory");
#pragma unroll
            for (int m = 0; m < 4; ++m) {
                const int row = u.pm * 256 + ai * 128 + wr * 64 + m * 16 + fr; const size_t off = (size_t)row * DM + col0; float s = 0.f;
#pragma unroll
                for (int bj = 0; bj < 2; ++bj)
#pragma unroll
                    for (int n = 0; n < 2; ++n) { const size_t o4 = off + bj * 128 + n * 16;
                        f32x4 bs; if constexpr (XIN) bs = basex[m][bj][n]; else { const v2u b = base[m][bj][n]; bs = (f32x4){bf_lo(b.x), bf_hi(b.x), bf_lo(b.y), bf_hi(b.y)}; }
                        const f32x4 o = (MODE & 1) ? bs + acc[ai][bj][m][n] * W8I : bs + acc[ai][bj][m][n];
                        if constexpr (FOUT) *(f32x4*)(fout + o4) = o;
                        else { const f32x4 q = o * o; s += (q.x + q.y) + (q.z + q.w); v2u w; w.x = cvtpk(o.x, o.y); w.y = cvtpk(o.z, o.w); *(v2u*)(hb + o4) = w;
                            if constexpr (HB8) *(unsigned*)(hb8 + o4) = pk4f8(o.x, o.y, o.z, o.w); } }
                if constexpr (!FOUT) { s += __shfl_xor(s, 16); s += __shfl_xor(s, 32); if (fq == 0) ss[(size_t)row * 16 + u.pn * 4 + wc] = s; }
            }
        }
    }
};
typedef EpiResT<0> EpiRes;
#ifndef SER_OUT
#define SER_OUT 0
#endif
#ifdef X_NOBPERM
__device__ __forceinline__ float lane_from(int byteaddr, float v) { return v + (float)byteaddr; }
#else
__device__ __forceinline__ float lane_from(int byteaddr, float v) { return __builtin_bit_cast(float, __builtin_amdgcn_ds_bpermute(byteaddr, __builtin_bit_cast(int, v))); }
#endif
#ifdef X_NOSILU
__device__ __forceinline__ float silu_mul(float a, float g) { return a * g; }
#else
__device__ __forceinline__ float silu_mul(float a, float g) { return a * g * __builtin_amdgcn_rcpf(1.0f + __builtin_amdgcn_exp2f(-g * LOG2E)); }
#endif
__device__ __forceinline__ float dpp_prev_lane(float v) { return __builtin_bit_cast(float, __builtin_amdgcn_update_dpp(0, __builtin_bit_cast(int, v), 0x111  , 0xf, 0xf, true)); }
template <bool F8>
struct EpiUpT {
    static constexpr bool PERM = false, PERMA = true, AFTER_DRAIN = false;
    const float* ss; const float* cw; const float* cb; bf16* act; float* halo; LAS float* cl;
    __device__ __forceinline__ void operator()(const pg8::f32x4 (&acc)[2][2][4][2], const pg8::Unit& u, int wr, int wc, int fr, int fq) const {
        asm volatile("" : "+v"(fr), "+v"(fq));
        const int colb = u.pn * 128 + wc * 32 + 8 * fq;
        const int tid_ = ((wr * 4 + wc) * 4 + fq) * 16 + fr, ce = 2 * tid_, cbj = ce >> 9, carr = (ce >> 7) & 3, cc = ce & 127;
        const f32x2_t cpre = *(const f32x2_t*)((carr < 3 ? cw + carr * NUP : cb) + cbj * FF + u.pn * 128 + cc);
        f32x4 rsl[2][4];
#pragma unroll
        for (int ai = 0; ai < 2; ++ai)
#pragma unroll
            for (int m = 0; m < 4; ++m) rsl[ai][m] = rstd_load(ss, (u.pm * 4 + ai * 2 + wr) * 64 + 4 * fr + m, fq);
        unsigned pk[2][2][4][2][2];
#pragma unroll
        for (int ai = 0; ai < 2; ++ai) {
#pragma unroll
            for (int m = 0; m < 4; ++m) {
                const float rs = F8 ? rstd_finish(rsl[ai][m]) * W8I : rstd_finish(rsl[ai][m]);
#pragma unroll
                for (int bj = 0; bj < 2; ++bj)
#pragma unroll
                    for (int n = 0; n < 2; ++n) { const f32x4 v = acc[ai][bj][m][n] * rs; pk[ai][bj][m][n][0] = cvtpk(v.x, v.y); pk[ai][bj][m][n][1] = cvtpk(v.z, v.w); }
            }
        }
        *(LAS f32x2_t*)(cl + ce) = cpre;
        asm volatile("s_waitcnt lgkmcnt(0)" ::: "memory"); __builtin_amdgcn_s_barrier(); asm volatile("" ::: "memory");
        __builtin_amdgcn_sched_barrier(0);
        if (fr == 0 || fr == 15) {
#pragma unroll
            for (int ai = 0; ai < 2; ++ai)
#pragma unroll
                for (int j = 0; j < 2; ++j)
#pragma unroll
                    for (int bj = 0; bj < 2; ++bj)
#pragma unroll
                        for (int n = 0; n < 2; ++n) { const unsigned w0 = (fr == 0) ? pk[ai][bj][j][n][0] : pk[ai][bj][2 + j][n][0], w1 = (fr == 0) ? pk[ai][bj][j][n][1] : pk[ai][bj][2 + j][n][1];
                            *(f32x4*)(halo + ((size_t)(u.pm * 4 + ai * 2 + wr) * 4 + (fr == 0 ? j : 2 + j)) * NUP + bj * FF + colb + 4 * n) = (f32x4){bf_lo(w0), bf_hi(w0), bf_lo(w1), bf_hi(w1)}; }
        }
        __builtin_amdgcn_sched_barrier(0);
#pragma unroll
        for (int ai = 0; ai < 2; ++ai) {
            const int row0 = (u.pm * 4 + ai * 2 + wr) * 64 + 4 * fr;
            unsigned outp[4][2][2];
#pragma unroll
            for (int n = 0; n < 2; ++n) {
#pragma unroll
                for (int ip = 0; ip < 2; ++ip) {
                    f32x2_t k0[2], k1[2], k2[2], kb[2];
#pragma unroll
                    for (int bj = 0; bj < 2; ++bj) { const LAS float* c = cl + bj * 512 + wc * 32 + 8 * fq + 4 * n + 2 * ip; k0[bj] = *(const LAS f32x2_t*)(c); k1[bj] = *(const LAS f32x2_t*)(c + 128); k2[bj] = *(const LAS f32x2_t*)(c + 256); kb[bj] = *(const LAS f32x2_t*)(c + 384); }
                    float y[2][4][2];
#pragma unroll
                    for (int bj = 0; bj < 2; ++bj) {
                        const unsigned w0 = pk[ai][bj][0][n][ip], w1 = pk[ai][bj][1][n][ip], w2 = pk[ai][bj][2][n][ip], w3 = pk[ai][bj][3][n][ip];
                        const unsigned q1 = (unsigned)__builtin_amdgcn_update_dpp(0, (int)w3, 0x111, 0xf, 0xf, true), q2 = (unsigned)__builtin_amdgcn_update_dpp(0, (int)w2, 0x111, 0xf, 0xf, true);
#pragma unroll
                        for (int e = 0; e < 2; ++e) { const int i = e;
                            const float u0 = e ? bf_hi(w0) : bf_lo(w0), u1 = e ? bf_hi(w1) : bf_lo(w1), u2 = e ? bf_hi(w2) : bf_lo(w2), u3 = e ? bf_hi(w3) : bf_lo(w3), p1 = e ? bf_hi(q1) : bf_lo(q1), p2 = e ? bf_hi(q2) : bf_lo(q2);
                            y[bj][0][e] = kb[bj][i] + k0[bj][i] * p2 + k1[bj][i] * p1 + k2[bj][i] * u0;
                            y[bj][1][e] = kb[bj][i] + k0[bj][i] * p1 + k1[bj][i] * u0 + k2[bj][i] * u1;
                            y[bj][2][e] = kb[bj][i] + k0[bj][i] * u0 + k1[bj][i] * u1 + k2[bj][i] * u2;
                            y[bj][3][e] = kb[bj][i] + k0[bj][i] * u1 + k1[bj][i] * u2 + k2[bj][i] * u3; }
                    }
#pragma unroll
                    for (int m = 0; m < 4; ++m) {
                        if constexpr (F8) { if (ip == 0) outp[m][n][0] = (unsigned)__builtin_amdgcn_cvt_pk_fp8_f32(silu_mul(y[0][m][0], y[1][m][0]), silu_mul(y[0][m][1], y[1][m][1]), 0, false);
                            else outp[m][n][0] = (unsigned)__builtin_amdgcn_cvt_pk_fp8_f32(silu_mul(y[0][m][0], y[1][m][0]), silu_mul(y[0][m][1], y[1][m][1]), (int)outp[m][n][0], true); }
                        else outp[m][n][ip] = cvtpk(silu_mul(y[0][m][0], y[1][m][0]), silu_mul(y[0][m][1], y[1][m][1])); }
                }
            }
#pragma unroll
            for (int m = 0; m < 4; ++m) {
                if (m < 2 && fr == 0) continue;
                if constexpr (F8) { v2u w; w.x = outp[m][0][0]; w.y = outp[m][1][0]; *(v2u*)((unsigned char*)act + (size_t)(row0 + m) * FF + colb) = w; }
                else { v4u w; w.x = outp[m][0][0]; w.y = outp[m][0][1]; w.z = outp[m][1][0]; w.w = outp[m][1][1];
                    *(v4u*)(act + (size_t)(row0 + m) * FF + colb) = w; }
            }
            asm volatile("" ::: "memory");
        }
    }
};
typedef EpiUpT<false> EpiUp;
struct EpiDummy {
    static constexpr bool PERM = false, PERMA = true, AFTER_DRAIN = false;
    float* scratch;
    __device__ __forceinline__ void operator()(const pg8::f32x4 (&acc)[2][2][4][2], const pg8::Unit& u, int wr, int wc, int fr, int fq) const {
        f32x4 s = (f32x4){0.f, 0.f, 0.f, 0.f};
#pragma unroll
        for (int ai = 0; ai < 2; ++ai)
#pragma unroll
            for (int bj = 0; bj < 2; ++bj)
#pragma unroll
                for (int m = 0; m < 4; ++m)
#pragma unroll
                    for (int n = 0; n < 2; ++n) s += acc[ai][bj][m][n];
        scratch[(size_t)(u.pm * 22 + u.pn) * 512 + ((wr * 4 + wc) * 4 + fq) * 16 + fr] = (s.x + s.y) + (s.z + s.w);
    }
};
template <bool F8>
__device__ __forceinline__ void fixup_phase(Frame& F, const float* cw, const float* cb, const float* halo, bf16* act) {
    const int gt = F.vcu * (NWAVES * 64) + F.tid, NT = F.G * NWAVES * 64;
    constexpr int C4 = FF / 4;
    for (int it = gt; it < NBLK64 * 2 * C4; it += NT) {
        const int c = (it % C4) * 4, rj = it / C4, j = rj & 1, blk = rj >> 1, t = blk * 64 + j, tb = t % SEQ;
        f32x4 y[2];
#pragma unroll
        for (int bj = 0; bj < 2; ++bj) {
            const int cc = bj * FF + c;
            const f32x4 z = (f32x4){0.f, 0.f, 0.f, 0.f};
            const f32x4 ut = *(const f32x4*)(halo + ((size_t)blk * 4 + j) * NUP + cc);
            f32x4 u1, u2;
            if (j == 1) { u1 = *(const f32x4*)(halo + ((size_t)blk * 4 + 0) * NUP + cc); u2 = (tb == 1) ? z : *(const f32x4*)(halo + ((size_t)(blk - 1) * 4 + 3) * NUP + cc); }
            else { u1 = (tb == 0) ? z : *(const f32x4*)(halo + ((size_t)(blk - 1) * 4 + 3) * NUP + cc); u2 = (tb == 0) ? z : *(const f32x4*)(halo + ((size_t)(blk - 1) * 4 + 2) * NUP + cc); }
            y[bj] = *(const f32x4*)(cb + cc) + *(const f32x4*)(cw + cc) * u2 + *(const f32x4*)(cw + NUP + cc) * u1 + *(const f32x4*)(cw + 2 * NUP + cc) * ut;
        }
        if constexpr (F8) *(unsigned*)((unsigned char*)act + (size_t)t * FF + c) = pk4f8(silu_mul(y[0].x, y[1].x), silu_mul(y[0].y, y[1].y), silu_mul(y[0].z, y[1].z), silu_mul(y[0].w, y[1].w));
        else { v2u w; w.x = cvtpk(silu_mul(y[0].x, y[1].x), silu_mul(y[0].y, y[1].y)); w.y = cvtpk(silu_mul(y[0].z, y[1].z), silu_mul(y[0].w, y[1].w));
            *(v2u*)(act + (size_t)t * FF + c) = w; }
    }
}

__device__ __forceinline__ int crow(int r, int hi) { return (r & 3) + 8 * (r >> 2) + 4 * hi; }
__device__ __forceinline__ void glds16(const void* gsrc, unsigned lds_dst) { unsigned keep;
    asm volatile("s_mov_b32 %0, m0\n\ts_mov_b32 m0, %2\n\ts_nop 0\n\tglobal_load_lds_dwordx4 %1, off\n\ts_mov_b32 m0, %0" : "=&s"(keep) : "v"(gsrc), "s"(lds_dst) : "memory"); }
__device__ __forceinline__ float max3f(float a, float b, float c) { return fmaxf(fmaxf(a, b), c); }

namespace band {
constexpr int SLOTB = 8192;
constexpr int LDS_K = 0, LDS_V = 2 * SLOTB, LDS_WS = 4 * SLOTB, LDS_TB = LDS_WS + NWAVES * 64 * 4, LDS_OST = LDS_TB + 640 * 4 + 512, LDS_END = LDS_OST + NWAVES * 4096;
static_assert(LDS_END <= RING_BYTES, "band LDS");
__device__ __forceinline__ void unit(Frame& F, int b, int h, int U, const bf16* Q, const bf16* K, const bf16* V, bf16* O, const float* rel, const bool o8) {
    const int tid = F.tid, lane = F.lane, r32 = lane & 31, hi = lane >> 5, wid = F.wave;
    LAS unsigned char* shm = F.lds + RING_OFF;
    const unsigned lds0 = (unsigned)(uintptr_t)shm;
    const long rowbase = (long)b * SEQ; const int q0 = U * 256, c0 = 4 * U, cq = c0 + (wid >> 1);
    const bf16* Qw = Q + (rowbase + q0 + wid * 32) * DM + h * 64;
    const bf16* Kh = K + rowbase * DM + h * 64; const bf16* Vh = V + rowbase * DM + h * 64;
    LAS float* wsf = (LAS float*)(shm + LDS_WS) + wid * 64;
    LAS float* tb = (LAS float*)(shm + LDS_TB);
    const bf16* ksrc = Kh + (long)lane * DM + wid * 8;
    const bf16* vsrc = Vh + (long)(16 * (wid & 3) + (lane >> 2)) * DM + (wid >> 2) * 32 + (lane & 3) * 8;
    const unsigned kdst = lds0 + LDS_K + wid * 1024, vdst = lds0 + LDS_V + wid * 1024;
    const int lo = (c0 - 8 > 0) ? c0 - 8 : 0, hiT = c0 + 3, NT = hiT - lo + 1, t0 = (c0 - 5 > 0) ? c0 - 5 : 0;
#define BAND_KT(i) ((t0 + (i) <= hiT) ? t0 + (i) : lo + (t0 + (i) - hiT - 1))
    for (int i = tid; i < 640; i += NWAVES * 64) { int d = i - 64; d = d < -256 ? -256 : (d > 256 ? 256 : d); tb[i] = rel[(d + 256) * 16 + h] * LOG2E; }
    { const int kt = BAND_KT(0); glds16(ksrc + (long)kt * 64 * DM, (unsigned)__builtin_amdgcn_readfirstlane(kdst)); glds16(vsrc + (long)kt * 64 * DM, (unsigned)__builtin_amdgcn_readfirstlane(vdst)); }
    bf16x8 qr[4];
#pragma unroll
    for (int d0 = 0; d0 < 4; ++d0) qr[d0] = *(const bf16x8*)(Qw + (long)r32 * DM + d0 * 16 + hi * 8);
    float m_run = -INFINITY, l_run = 0.f; f32x16 o[2]; o[0] = f32x16{}; o[1] = f32x16{};
    const int qpos = q0 + wid * 32 + r32;
    const LAS unsigned char* vbase = shm + LDS_V + ((lane >> 4) & 1) * 32 + (lane & 3) * 8 + (4 * hi + ((lane & 15) >> 2)) * 64;
    for (int i = 0; i < NT; ++i) { LA_B;
        asm volatile("s_waitcnt vmcnt(0) lgkmcnt(0)\n\ts_barrier" ::: "memory");
        if (i + 1 < NT) { const int kt = BAND_KT(i + 1); const unsigned so = ((i + 1) & 1) * SLOTB;
            glds16(ksrc + (long)kt * 64 * DM, (unsigned)__builtin_amdgcn_readfirstlane(kdst + so)); glds16(vsrc + (long)kt * 64 * DM, (unsigned)__builtin_amdgcn_readfirstlane(vdst + so)); }
        const int kt = BAND_KT(i);
        if (kt < cq - 8 || kt > cq) continue;
        const int so = (i & 1) * SLOTB;
        f32x16 p0 = f32x16{}, p1 = f32x16{};
        { const LAS unsigned char* kb = shm + LDS_K + so + hi * 1024 + r32 * 16;
#pragma unroll
          for (int d0 = 0; d0 < 4; ++d0) { const bf16x8 b0 = *(const LAS bf16x8*)(kb + d0 * 2048), b1 = *(const LAS bf16x8*)(kb + d0 * 2048 + 512);
              p0 = __builtin_amdgcn_mfma_f32_32x32x16_bf16(b0, qr[d0], p0, 0, 0, 0); p1 = __builtin_amdgcn_mfma_f32_32x32x16_bf16(b1, qr[d0], p1, 0, 0, 0); } }
        if (kt + 5 <= cq) { const float cbias = tb[639];
#pragma unroll
          for (int r = 0; r < 16; ++r) { p0[r] += cbias; p1[r] += cbias; } }
        else { const int ib = qpos - 64 * kt + 64 - 4 * hi;
#pragma unroll
          for (int r = 0; r < 16; ++r) { const int ix = ib - ((r & 3) + 8 * (r >> 2)); p0[r] += tb[ix]; p1[r] += tb[ix - 32]; } }
        float rm = p0[0];
#pragma unroll
        for (int r = 0; r < 16; ++r) rm = max3f(rm, p0[r], p1[r]);
        { auto rr = __builtin_amdgcn_permlane32_swap(__float_as_uint(rm), __float_as_uint(rm), false, false); rm = fmaxf(__uint_as_float(rr[0]), __uint_as_float(rr[1])); }
        const float mnew = fmaxf(m_run, rm), f = __builtin_amdgcn_exp2f(m_run - mnew); m_run = mnew;
        float sacc = 0.f;
#pragma unroll
        for (int r = 0; r < 16; ++r) { p0[r] = __builtin_amdgcn_exp2f(p0[r] - mnew); p1[r] = __builtin_amdgcn_exp2f(p1[r] - mnew); sacc += p0[r] + p1[r]; }
        l_run = l_run * f + sacc;
        if (!__all(f == 1.0f)) {
            if (hi == 0) wsf[r32] = f;
            LDS_WAIT();
#pragma unroll
            for (int r = 0; r < 16; ++r) { const float fr_ = wsf[crow(r, hi)]; o[0][r] *= fr_; o[1][r] *= fr_; }
        }
        v4u pw[4];
        pw[0] = (v4u){cvtpk(p0[0], p0[1]), cvtpk(p0[2], p0[3]), cvtpk(p0[4], p0[5]), cvtpk(p0[6], p0[7])};
        pw[1] = (v4u){cvtpk(p0[8], p0[9]), cvtpk(p0[10], p0[11]), cvtpk(p0[12], p0[13]), cvtpk(p0[14], p0[15])};
        pw[2] = (v4u){cvtpk(p1[0], p1[1]), cvtpk(p1[2], p1[3]), cvtpk(p1[4], p1[5]), cvtpk(p1[6], p1[7])};
        pw[3] = (v4u){cvtpk(p1[8], p1[9]), cvtpk(p1[10], p1[11]), cvtpk(p1[12], p1[13]), cvtpk(p1[14], p1[15])};
        const LAS unsigned char* vb = vbase + so;
#pragma unroll
        for (int d0 = 0; d0 < 2; ++d0)
#pragma unroll
            for (int ks = 0; ks < 4; ++ks) {
                const s16x4 vlo = __builtin_bit_cast(s16x4, __builtin_amdgcn_ds_read_tr16_b64_v4i16((LAS s16x4*)(vb + d0 * 4096 + ks * 1024)));
                const s16x4 vhi = __builtin_bit_cast(s16x4, __builtin_amdgcn_ds_read_tr16_b64_v4i16((LAS s16x4*)(vb + d0 * 4096 + ks * 1024 + 512)));
                const bf16x8 vf = (bf16x8){vlo[0], vlo[1], vlo[2], vlo[3], vhi[0], vhi[1], vhi[2], vhi[3]};
                o[d0] = __builtin_amdgcn_mfma_f32_32x32x16_bf16(__builtin_bit_cast(bf16x8, pw[ks]), vf, o[d0], 0, 0, 0);
            }
    }
#undef BAND_KT
    { auto rr = __builtin_amdgcn_permlane32_swap(__float_as_uint(l_run), __float_as_uint(l_run), false, false); l_run = __uint_as_float(rr[0]) + __uint_as_float(rr[1]); }
    if (hi == 0) wsf[32 + r32] = l_run;
    LDS_WAIT();
    float rli[16];
#pragma unroll
    for (int r = 0; r < 16; ++r) rli[r] = __builtin_amdgcn_rcpf(wsf[32 + crow(r, hi)]);
    bf16* Ow = O + (rowbase + q0 + wid * 32) * DM + h * 64;
    { LAS bf16* stg = (LAS bf16*)(shm + LDS_OST) + wid * 2048;
#pragma unroll
      for (int r = 0; r < 16; ++r) { const int orow = crow(r, hi);
#pragma unroll
          for (int d0 = 0; d0 < 2; ++d0) stg[orow * 64 + d0 * 32 + r32] = (bf16)f2bf(o[d0][r] * rli[r]); }
      LDS_WAIT();
#pragma unroll
      for (int i = 0; i < 4; ++i) { const int row = i * 8 + (lane >> 3), ch = lane & 7; const v4u v = *(const LAS v4u*)(stg + row * 64 + ch * 8);
          if (o8) { v2u w; w.x = pk4f8(bf_lo(v.x), bf_hi(v.x), bf_lo(v.y), bf_hi(v.y)); w.y = pk4f8(bf_lo(v.z), bf_hi(v.z), bf_lo(v.w), bf_hi(v.w));
              *(v2u*)((unsigned char*)O + (rowbase + q0 + wid * 32 + row) * DM + h * 64 + ch * 8) = w; }
          else *(v4u*)(Ow + (long)row * DM + ch * 8) = v; } }
    asm volatile("s_waitcnt lgkmcnt(0)\n\ts_barrier" ::: "memory");
}
__device__ __forceinline__ void phase(Frame& F, const bf16* Q, const bf16* K, const bf16* V, bf16* O, const float* rel, const bool o8) {
    const int NU = BATCH * 16 * 32, per = (NU + F.G - 1) / F.G;
    for (int i = 0; i < per; ++i) { const int uid = F.vcu * per + i; if (uid >= NU) break; unit(F, uid >> 9, (uid >> 5) & 15, uid & 31, Q, K, V, O, rel, o8); }
}
}

namespace dsa {
__device__ __forceinline__ unsigned okey(float s) { const unsigned u = __float_as_uint(s + 0.0f); return (u & 0x80000000u) ? ~u : (u | 0x80000000u); }
struct Ctx { const bf16* QA; const bf16* KA; const bf16* VA; const bf16* QI; const bf16* KI; const float* WI; bf16* M; const LAS float* t5l; unsigned short* SEL; };

__device__ __forceinline__ void scan_hist(const LAS unsigned* hq, int lane, unsigned need, unsigned& bin, unsigned& above) {
    const LAS v4u* hp = (const LAS v4u*)hq + lane * 4;
    unsigned wds[16];
#pragma unroll
    for (int j = 0; j < 4; ++j) { const v4u t = hp[j]; wds[4 * j] = t.x; wds[4 * j + 1] = t.y; wds[4 * j + 2] = t.z; wds[4 * j + 3] = t.w; }
    unsigned tl = 0;
#pragma unroll
    for (int j = 0; j < 16; ++j) tl += (wds[j] & 0xffffu) + (wds[j] >> 16);
    unsigned suf = tl;
#pragma unroll
    for (int o = 1; o < 64; o <<= 1) { const unsigned v = __shfl_down(suf, o); if (lane + o < 64) suf += v; }
    const unsigned S = suf - tl;
    const bool cross = (S < need) && (need <= S + tl);
    unsigned c = S, bsel = 0, ab = 0; bool found = false;
#pragma unroll
    for (int k = 31; k >= 0; --k) { const unsigned cnt = (wds[k >> 1] >> (16 * (k & 1))) & 0xffffu; if (!found && c + cnt >= need) { bsel = 32 * lane + k; ab = c; found = true; } c += cnt; }
    const unsigned long long bal = __ballot(cross);
    const int src = bal ? __builtin_ctzll(bal) : 0;
    bin = __shfl(bsel, src); above = __shfl(ab, src);
}

__device__ __forceinline__ void attend(const Ctx& C, const LAS unsigned short* sq, int nvalid, long rowbase, long token, int tpos, int lane, int g0) {
    asm volatile("" : "+v"(lane));
    const int l15 = lane & 15, l4 = lane >> 4;
    int sidx[16];
#pragma unroll
    for (int ti = 0; ti < 16; ++ti) sidx[ti] = sq[ti * 16 + l15];
    unsigned bpk[4] = {0u, 0u, 0u, 0u};
#pragma unroll
    for (int ti = 0; ti < 16; ++ti) { const int rel = sidx[ti] - tpos, n = rel < 0 ? -rel : rel;
        const int bk = (rel > 0 ? 16 : 0) + (n < 8 ? n : 8 + (n >= 12) + (n >= 16) + (n >= 23) + (n >= 32) + (n >= 46) + (n >= 64) + (n >= 91));
        bpk[ti >> 2] |= (unsigned)bk << (8 * (ti & 3)); }
#pragma unroll 1
    for (int g = g0; g < g0 + 2; ++g) {
        const bf16* qp = C.QA + token * DM + (4 * g + (lane & 3)) * 64 + 8 * l4;
        const bf16x8 qf0 = *(const bf16x8*)qp, qf1 = *(const bf16x8*)(qp + 32);
        const bf16* kbase = C.KA + rowbase * 256 + g * 64 + 8 * l4;
        f32x4 S[16];
#pragma unroll
        for (int hh = 0; hh < 4; ++hh) {
            bf16x8 kf0[4], kf1[4];
#pragma unroll
            for (int j = 0; j < 4; ++j) { const bf16* kp = kbase + (long)sidx[hh * 4 + j] * 256; kf0[j] = *(const bf16x8*)kp; kf1[j] = *(const bf16x8*)(kp + 32); }
#pragma unroll
            for (int j = 0; j < 4; ++j) { const int ti = hh * 4 + j;
                f32x4 a = *(const LAS f32x4*)(C.t5l + ((bpk[hh] >> (8 * j)) & 255u) * 16 + 4 * g);
                asm volatile("v_mfma_f32_16x16x32_bf16 %0, %1, %2, %0" : "+v"(a) : "v"(qf0), "v"(kf0[j]));
                asm volatile("v_mfma_f32_16x16x32_bf16 %0, %1, %2, %0" : "+v"(a) : "v"(qf1), "v"(kf1[j]));
                S[ti] = a; }
            asm volatile("s_nop 15\n\ts_nop 7" : "+v"(S[hh * 4]), "+v"(S[hh * 4 + 1]), "+v"(S[hh * 4 + 2]), "+v"(S[hh * 4 + 3]));
        }
#pragma unroll
        for (int ti = 0; ti < 16; ++ti) if (ti * 16 >= nvalid) S[ti] = (f32x4){-INFINITY, -INFINITY, -INFINITY, -INFINITY};
        f32x4 mx = S[0];
#pragma unroll
        for (int ti = 1; ti < 16; ++ti) { mx.x = fmaxf(mx.x, S[ti].x); mx.y = fmaxf(mx.y, S[ti].y); mx.z = fmaxf(mx.z, S[ti].z); mx.w = fmaxf(mx.w, S[ti].w); }
#pragma unroll
        for (int o = 1; o < 16; o <<= 1) { mx.x = fmaxf(mx.x, __shfl_xor(mx.x, o)); mx.y = fmaxf(mx.y, __shfl_xor(mx.y, o)); mx.z = fmaxf(mx.z, __shfl_xor(mx.z, o)); mx.w = fmaxf(mx.w, __shfl_xor(mx.w, o)); }
        f32x4 ls = (f32x4){0.f, 0.f, 0.f, 0.f};
        unsigned P01[16], P23[16];
#pragma unroll
        for (int ti = 0; ti < 16; ++ti) { const float e0 = __builtin_amdgcn_exp2f(S[ti].x - mx.x), e1 = __builtin_amdgcn_exp2f(S[ti].y - mx.y), e2 = __builtin_amdgcn_exp2f(S[ti].z - mx.z), e3 = __builtin_amdgcn_exp2f(S[ti].w - mx.w);
            ls += (f32x4){e0, e1, e2, e3}; P01[ti] = cvtpk(e0, e1); P23[ti] = cvtpk(e2, e3); }
#pragma unroll
        for (int o = 1; o < 16; o <<= 1) { ls.x += __shfl_xor(ls.x, o); ls.y += __shfl_xor(ls.y, o); ls.z += __shfl_xor(ls.z, o); ls.w += __shfl_xor(ls.w, o); }
        float o_[4][16];
#pragma unroll
        for (int h = 0; h < 4; ++h)
#pragma unroll
            for (int d = 0; d < 16; ++d) o_[h][d] = 0.f;
        const bf16* vbase = C.VA + rowbase * 256 + g * 64 + 16 * l4;
#pragma unroll
        for (int hh = 0; hh < 4; ++hh) {
            v4u va[4], vb[4];
#pragma unroll
            for (int j = 0; j < 4; ++j) { const v4u* vp = (const v4u*)(vbase + (long)sidx[hh * 4 + j] * 256); va[j] = vp[0]; vb[j] = vp[1]; }
#pragma unroll
            for (int j = 0; j < 4; ++j) { const int ti = hh * 4 + j; const v4u v0 = va[j], v1 = vb[j];
                float vf[16];
                vf[0] = bf_lo(v0.x); vf[1] = bf_hi(v0.x); vf[2] = bf_lo(v0.y); vf[3] = bf_hi(v0.y); vf[4] = bf_lo(v0.z); vf[5] = bf_hi(v0.z); vf[6] = bf_lo(v0.w); vf[7] = bf_hi(v0.w);
                vf[8] = bf_lo(v1.x); vf[9] = bf_hi(v1.x); vf[10] = bf_lo(v1.y); vf[11] = bf_hi(v1.y); vf[12] = bf_lo(v1.z); vf[13] = bf_hi(v1.z); vf[14] = bf_lo(v1.w); vf[15] = bf_hi(v1.w);
                const float p0 = bf_lo(P01[ti]), p1 = bf_hi(P01[ti]), p2 = bf_lo(P23[ti]), p3 = bf_hi(P23[ti]);
#pragma unroll
                for (int d = 0; d < 16; ++d) { o_[0][d] += p0 * vf[d]; o_[1][d] += p1 * vf[d]; o_[2][d] += p2 * vf[d]; o_[3][d] += p3 * vf[d]; } }
        }
        float res[4];
#pragma unroll
        for (int h = 0; h < 4; ++h) {
            float a8[8], a4[4], a2[2];
            const bool b3 = (l15 & 8) != 0, b2 = (l15 & 4) != 0, b1 = (l15 & 2) != 0, b0 = (l15 & 1) != 0;
#pragma unroll
            for (int d = 0; d < 8; ++d) { const float keep = b3 ? o_[h][d + 8] : o_[h][d], send = b3 ? o_[h][d] : o_[h][d + 8]; a8[d] = keep + __shfl_xor(send, 8); }
#pragma unroll
            for (int d = 0; d < 4; ++d) { const float keep = b2 ? a8[d + 4] : a8[d], send = b2 ? a8[d] : a8[d + 4]; a4[d] = keep + __shfl_xor(send, 4); }
#pragma unroll
            for (int d = 0; d < 2; ++d) { const float keep = b1 ? a4[d + 2] : a4[d], send = b1 ? a4[d] : a4[d + 2]; a2[d] = keep + __shfl_xor(send, 2); }
            { const float keep = b0 ? a2[1] : a2[0], send = b0 ? a2[0] : a2[1]; res[h] = keep + __shfl_xor(send, 1); }
        }
        bf16* mp = C.M + token * DM + (4 * g) * 64 + lane;
        mp[0] = (bf16)f2bf(res[0] * __builtin_amdgcn_rcpf(ls.x)); mp[64] = (bf16)f2bf(res[1] * __builtin_amdgcn_rcpf(ls.y)); mp[128] = (bf16)f2bf(res[2] * __builtin_amdgcn_rcpf(ls.z)); mp[192] = (bf16)f2bf(res[3] * __builtin_amdgcn_rcpf(ls.w));
    }
}

constexpr int CAND_CAP = 256;
constexpr int SELKS_OFF = KS_OFF;
__device__ __forceinline__ float relu_i(float x) { const int i = __builtin_bit_cast(int, x); return __builtin_bit_cast(float, i > 0 ? i : 0); }
struct SelState { unsigned pre[4], need[4], cnt[4], tcnt[4]; };
__device__ __forceinline__ void tile_mfma(f32x16 (&acc)[2], const LAS unsigned char* kf, const int (&koff)[4], const bf16x8 (&qa)[4]) {
#pragma unroll
    for (int h2 = 0; h2 < 2; ++h2) { acc[h2] = f32x16{};
#pragma unroll
        for (int ks = 0; ks < 4; ++ks) { const bf16x8 kb = *(const LAS bf16x8*)(kf + koff[ks] + h2 * 4096); acc[h2] = __builtin_amdgcn_mfma_f32_32x32x16_bf16(qa[ks], kb, acc[h2], 0, 0, 0); } }
}
template <class ActionT>
__device__ __forceinline__ void tile_valu(const f32x16 (&acc)[2], const f32x2_t (&wp)[2][4], int kbase, ActionT&& act) {
#pragma unroll
    for (int h2 = 0; h2 < 2; ++h2) {
        f32x2_t sa = {0.f, 0.f}, sb = {0.f, 0.f};
#pragma unroll
        for (int jp = 0; jp < 4; ++jp) {
            const f32x2_t ra = {relu_i(acc[h2][2 * jp]), relu_i(acc[h2][2 * jp + 1])};
            const f32x2_t rb = {relu_i(acc[h2][8 + 2 * jp]), relu_i(acc[h2][8 + 2 * jp + 1])};
            sa = __builtin_elementwise_fma(ra, wp[0][jp], sa); sb = __builtin_elementwise_fma(rb, wp[1][jp], sb); }
        act(kbase + h2 * 32, (sa.x + sa.y) + 0.0f, (sb.x + sb.y) + 0.0f);
    }
}
constexpr int KSLOTS = 3;
__device__ __forceinline__ void wait_tile(int newer) {
    if (newer >= 4) asm volatile("s_waitcnt vmcnt(4) lgkmcnt(0)\n\ts_barrier" ::: "memory");
    else if (newer == 3) asm volatile("s_waitcnt vmcnt(3) lgkmcnt(0)\n\ts_barrier" ::: "memory");
    else if (newer == 2) asm volatile("s_waitcnt vmcnt(2) lgkmcnt(0)\n\ts_barrier" ::: "memory");
    else if (newer == 1) asm volatile("s_waitcnt vmcnt(1) lgkmcnt(0)\n\ts_barrier" ::: "memory");
    else asm volatile("s_waitcnt vmcnt(0) lgkmcnt(0)\n\ts_barrier" ::: "memory");
}
template <class ActionT>
__device__ __forceinline__ void tile_pass(Frame& F, const bf16* ksrc, unsigned kdst, const LAS unsigned char* kfr, const int (&koff)[4], int NT, const bf16x8 (&qa)[4], const f32x2_t (&wp)[2][4], ActionT&& act) {
    asm volatile("s_waitcnt lgkmcnt(0)\n\ts_barrier" ::: "memory");
    const int npre = NT < KSLOTS ? NT : KSLOTS;
    for (int j = 0; j < npre; ++j) glds16(ksrc + (long)j * 4096, (unsigned)__builtin_amdgcn_readfirstlane(kdst + j * 8192));
    wait_tile(npre - 1);
    f32x16 accA[2], accB[2];
    tile_mfma(accA, kfr, koff, qa);
    int sl = 0;
    int kt = 0;
    for (; kt + 2 < NT; kt += 2) { LA_S;
        { const int inflight = (NT - kt - 2) < (KSLOTS - 2) ? (NT - kt - 2) : (KSLOTS - 2); wait_tile(inflight); }
        if (kt + KSLOTS < NT) glds16(ksrc + (long)(kt + KSLOTS) * 4096, (unsigned)__builtin_amdgcn_readfirstlane(kdst + sl * 8192));
        sl = (sl == KSLOTS - 1) ? 0 : sl + 1;
        tile_mfma(accB, kfr + sl * 8192, koff, qa);
        tile_valu(accA, wp, kt * 64, act);
        { const int inflight = (NT - kt - 3) < (KSLOTS - 2) ? (NT - kt - 3) : (KSLOTS - 2); wait_tile(inflight); }
        if (kt + 1 + KSLOTS < NT) glds16(ksrc + (long)(kt + 1 + KSLOTS) * 4096, (unsigned)__builtin_amdgcn_readfirstlane(kdst + sl * 8192));
        sl = (sl == KSLOTS - 1) ? 0 : sl + 1;
        tile_mfma(accA, kfr + sl * 8192, koff, qa);
        tile_valu(accB, wp, (kt + 1) * 64, act);
    }
    if (kt + 1 < NT) {
        wait_tile(0);
        sl = (sl == KSLOTS - 1) ? 0 : sl + 1;
        tile_mfma(accB, kfr + sl * 8192, koff, qa);
        tile_valu(accA, wp, kt * 64, act);
        tile_valu(accB, wp, (kt + 1) * 64, act);
    } else tile_valu(accA, wp, kt * 64, act);
    LDS_WAIT();
}
__device__ __forceinline__ void scan_hist_cnt(const LAS unsigned* hq, int lane, unsigned need, unsigned& bin, unsigned& above, unsigned& bcnt) {
    const LAS v4u* hp = (const LAS v4u*)hq + lane * 2;
    unsigned wds[8];
#pragma unroll
    for (int j = 0; j < 2; ++j) { const v4u t = hp[j]; wds[4 * j] = t.x; wds[4 * j + 1] = t.y; wds[4 * j + 2] = t.z; wds[4 * j + 3] = t.w; }
    unsigned tl = 0;
#pragma unroll
    for (int j = 0; j < 8; ++j) tl += wds[j];
    unsigned suf = tl;
#pragma unroll
    for (int o = 1; o < 64; o <<= 1) { const unsigned v = __shfl_down(suf, o); if (lane + o < 64) suf += v; }
    const unsigned S = suf - tl;
    const bool cross = (S < need) && (need <= S + tl);
    unsigned c = S, bsel = 0, ab = 0, bc = 0; bool found = false;
#pragma unroll
    for (int k = 7; k >= 0; --k) { const unsigned cnt = wds[k]; if (!found && c + cnt >= need) { bsel = 8 * lane + k; ab = c; bc = cnt; found = true; } c += cnt; }
    const unsigned long long bal = __ballot(cross);
    const int src = bal ? __builtin_ctzll(bal) : 0;
    bin = __builtin_amdgcn_readfirstlane(__shfl(bsel, src)); above = __builtin_amdgcn_readfirstlane(__shfl(ab, src)); bcnt = __builtin_amdgcn_readfirstlane(__shfl(bc, src));
}
__device__ __forceinline__ void step(Frame& F, const Ctx& C, int b, int c, int half) {
    int lane_ = F.lane; asm volatile("" : "+v"(lane_));
    const int lane = lane_, r = lane & 31, hi = lane >> 5, wave = F.wave;
    LAS unsigned* hist = (LAS unsigned*)(F.lds + RING_OFF + wave * 16384);
    LAS unsigned short* sel = (LAS unsigned short*)hist;
    LAS unsigned* cand = hist + 2048;
    LAS unsigned* fbflag = (LAS unsigned*)(F.lds + AUX_OFF + 2048);
    const long rowbase = (long)b * SEQ;
    const int tq0 = 64 * c + 32 * half + 4 * wave;
    const int N = 64 * (c + 1), NT = c + 1;
    int nvalid = 256;
    if (N <= 256) {
        nvalid = N;
        for (int j = lane; j < 4 * 256; j += 64) sel[j] = (unsigned short)(((j & 255) < N) ? (j & 255) : 0);
    } else {
        const int aq = 2 * ((r >> 2) & 1) + (r >> 4), ah = 4 * ((r >> 3) & 1) + (r & 3);
        const bf16* qip = C.QI + (rowbase + tq0 + aq) * 512 + ah * 64 + 8 * hi;
        bf16x8 qa[4];
#pragma unroll
        for (int ks = 0; ks < 4; ++ks) qa[ks] = *(const bf16x8*)(qip + 16 * ks);
        f32x2_t wp[2][4];
#pragma unroll
        for (int t = 0; t < 2; ++t) { const float* wq = C.WI + (rowbase + tq0 + 2 * hi + t) * 8; const f32x4 w0 = *(const f32x4*)wq, w1 = *(const f32x4*)(wq + 4);
            wp[t][0] = (f32x2_t){w0.x, w0.y}; wp[t][1] = (f32x2_t){w0.z, w0.w}; wp[t][2] = (f32x2_t){w1.x, w1.y}; wp[t][3] = (f32x2_t){w1.z, w1.w}; }
        float Bq;
        { float ssq = 0.f;
#pragma unroll
          for (int ks = 0; ks < 4; ++ks)
#pragma unroll
              for (int e = 0; e < 8; ++e) { const float v = bf_lo((unsigned)(unsigned short)qa[ks][e]); ssq += v * v; }
          ssq += __shfl_xor(ssq, 32);
          float term = fabsf(C.WI[(rowbase + tq0 + aq) * 8 + ah]) * sqrtf(ssq);
          term += __shfl_xor(term, 1); term += __shfl_xor(term, 2); term += __shfl_xor(term, 8);
          Bq = term * 8.25f + 1e-20f; }
        const float B0 = __shfl(Bq, (hi << 2)), B1 = __shfl(Bq, (hi << 2) | 16);
        const float sc0 = 1024.0f / B0, sc1 = 1024.0f / B1;
        asm volatile("" :: "v"(qa[0]), "v"(qa[1]), "v"(qa[2]), "v"(qa[3]));
        asm volatile("" :: "v"(wp[0][0]), "v"(wp[0][1]), "v"(wp[0][2]), "v"(wp[0][3]), "v"(wp[1][0]), "v"(wp[1][1]), "v"(wp[1][2]), "v"(wp[1][3]), "v"(sc0), "v"(sc1));
        const bf16* ksrc = C.KI + rowbase * 64 + (long)(wave * 8 + (lane >> 3)) * 64 + ((lane & 7) ^ (lane >> 3)) * 8;
        const unsigned kdst = (unsigned)(uintptr_t)(F.lds + SELKS_OFF) + wave * 1024;
        const LAS unsigned char* kfr = F.lds + SELKS_OFF + r * 128;
        int koff[4];
#pragma unroll
        for (int ks = 0; ks < 4; ++ks) koff[ks] = ((2 * ks + hi) ^ (r & 7)) * 16;
        const unsigned below = (1u << r) - 1u;
        LAS v4u* hz = (LAS v4u*)hist;
        if (wave == 0 && lane == 0) *fbflag = 0u;
#pragma unroll
        for (int j = 0; j < 8; ++j) hz[j * 64 + lane] = (v4u){0u, 0u, 0u, 0u};
        tile_pass(F, ksrc, kdst, kfr, koff, NT, qa, wp, [&](int kbase, float s0, float s1) {
            const int b0 = (int)__builtin_amdgcn_fmed3f(__builtin_fmaf(s0, sc0, 256.0f), 0.0f, 511.0f), b1 = (int)__builtin_amdgcn_fmed3f(__builtin_fmaf(s1, sc1, 256.0f), 0.0f, 511.0f);
            __hip_atomic_fetch_add(hist + (2 * hi) * 512 + b0, 1u, __ATOMIC_RELAXED, __HIP_MEMORY_SCOPE_WORKGROUP);
            __hip_atomic_fetch_add(hist + (2 * hi + 1) * 512 + b1, 1u, __ATOMIC_RELAXED, __HIP_MEMORY_SCOPE_WORKGROUP);
        });
#ifdef PROBE_SKEL
        tile_pass(F, ksrc, kdst, kfr, koff, NT, qa, wp, [&](int kbase, float s0, float s1) { });
#endif
#ifdef PROBE_SCORE
        { float dsum = 0.f; tile_pass(F, ksrc, kdst, kfr, koff, NT, qa, wp, [&](int kbase, float s0, float s1) { dsum += s0 + s1; }); if (dsum == 12345.678f) hist[0] = 1u; }
#endif
        SelState st;
        unsigned tbin[4], bcn[4]; bool ovf = false;
#pragma unroll
        for (int ql = 0; ql < 4; ++ql) { unsigned above; scan_hist_cnt(hist + ql * 512, lane, 256u, tbin[ql], above, bcn[ql]); st.cnt[ql] = 0u; st.tcnt[ql] = 0u; st.need[ql] = 256u - above; st.pre[ql] = above;
            }
        unsigned cbase[4]; { unsigned a = 0u;
#pragma unroll
            for (int ql = 0; ql < 4; ++ql) { cbase[ql] = a; a += bcn[ql]; }
            ovf = a > (unsigned)(4 * CAND_CAP); }
        LDS_WAIT();
        if (ovf && lane == 0) *fbflag = 1u;
        asm volatile("s_waitcnt lgkmcnt(0)\n\ts_barrier" ::: "memory");
#ifdef PROBE_NOFB
        const bool fb = false;
#elif defined(PROBE_NOFB2)
        const bool fb = __builtin_amdgcn_readfirstlane((int)*fbflag) == 0x7fffffff;
#else
        const bool fb = __builtin_amdgcn_readfirstlane((int)*fbflag) != 0;
#endif
        if (!fb) {
            const int tb0 = (int)(hi ? tbin[2] : tbin[0]), tb1 = (int)(hi ? tbin[3] : tbin[1]); const unsigned cb0 = hi ? cbase[2] : cbase[0], cb1 = hi ? cbase[3] : cbase[1];
            tile_pass(F, ksrc, kdst, kfr, koff, NT, qa, wp, [&](int kbase, float s0, float s1) {
#pragma unroll
                for (int t = 0; t < 2; ++t) {
                    const float s = t ? s1 : s0; const int bin = (int)__builtin_amdgcn_fmed3f(__builtin_fmaf(s, (t ? sc1 : sc0), 256.0f), 0.0f, 511.0f), tb = t ? tb1 : tb0;
                    const bool gt = bin > tb, eq = bin == tb;
                    const unsigned long long mg = __ballot(gt), me = __ballot(eq);
                    const unsigned mgh = hi ? (unsigned)(mg >> 32) : (unsigned)mg, meh = hi ? (unsigned)(me >> 32) : (unsigned)me;
                    const unsigned pos = (hi ? st.cnt[2 + t] : st.cnt[t]) + __builtin_popcount(mgh & below);
                    sel[(gt && pos < 256u) ? (2 * hi + t) * 256 + pos : 3200 + lane] = (unsigned short)(kbase + r);
                    const unsigned cpos = (hi ? st.tcnt[2 + t] : st.tcnt[t]) + __builtin_popcount(meh & below);
                    { const unsigned slot = (t ? cb1 : cb0) + cpos; LAS unsigned* cp = hist + ((eq && slot < (unsigned)(4 * CAND_CAP)) ? 2048 + slot * 2 : 1700 + 2 * lane); cp[0] = okey(s); cp[1] = (unsigned)(kbase + r); }
                    st.cnt[t] += __builtin_popcount((unsigned)mg); st.cnt[2 + t] += __builtin_popcount((unsigned)(mg >> 32));
                    st.tcnt[t] += __builtin_popcount((unsigned)me); st.tcnt[2 + t] += __builtin_popcount((unsigned)(me >> 32));
                }
            });
#pragma unroll
            for (int ql = 0; ql < 4; ++ql) {
                const unsigned nc = bcn[ql], G = st.pre[ql], rq = st.need[ql];
                const LAS unsigned* cq = cand + cbase[ql] * 2;
                unsigned base = G; const unsigned long long lt = (1ull << lane) - 1ull;
                for (unsigned c0 = 0; c0 < nc; c0 += 256u) {
                    unsigned ki4[4], xi4[4], rk4[4];
#pragma unroll
                    for (int m = 0; m < 4; ++m) { const unsigned i = c0 + (unsigned)lane + 64u * m; ki4[m] = (i < nc) ? cq[2 * i] : 0u; xi4[m] = (i < nc) ? cq[2 * i + 1] : 0u; rk4[m] = 0u; }
                    for (unsigned j = 0; j < nc; ++j) { const unsigned kj = cq[2 * j];
#pragma unroll
                        for (int m = 0; m < 4; ++m) rk4[m] += (kj > ki4[m] || (kj == ki4[m] && j < c0 + (unsigned)lane + 64u * m)) ? 1u : 0u; }
#pragma unroll
                    for (int m = 0; m < 4; ++m) { const bool take = (c0 + (unsigned)lane + 64u * m < nc) && rk4[m] < rq; const unsigned long long mm = __ballot(take);
                        const unsigned pos = base + __builtin_popcountll(mm & lt); if (take && pos < 256u) sel[ql * 256 + pos] = (unsigned short)xi4[m]; base += __builtin_popcountll(mm); }
                }
            }
        } else {
#pragma unroll
            for (int ql = 0; ql < 4; ++ql) { st.pre[ql] = 0u; st.need[ql] = 256u; st.cnt[ql] = 0u; st.tcnt[ql] = 0u; }
#pragma unroll 1
            for (int lev = 0; lev < 4; ++lev) {
#pragma unroll
                for (int j = 0; j < 8; ++j) hz[j * 64 + lane] = (v4u){0u, 0u, 0u, 0u};
                const unsigned pre0 = hi ? st.pre[2] : st.pre[0], pre1 = hi ? st.pre[3] : st.pre[1];
                const int sh = (lev == 0) ? 23 : (lev == 1) ? 14 : (lev == 2) ? 5 : 0, wd = (lev == 3) ? 5 : 9;
                tile_pass(F, ksrc, kdst, kfr, koff, NT, qa, wp, [&](int kbase, float s0, float s1) {
                    const unsigned k0 = okey(s0), k1 = okey(s1);
                    const unsigned b0 = (k0 >> sh) & ((1u << wd) - 1u), b1 = (k1 >> sh) & ((1u << wd) - 1u);
                    const bool in0 = (lev == 0) || ((k0 >> (sh + wd)) == pre0), in1 = (lev == 0) || ((k1 >> (sh + wd)) == pre1);
                    if (in0) __hip_atomic_fetch_add(hist + (2 * hi) * 512 + b0, 1u, __ATOMIC_RELAXED, __HIP_MEMORY_SCOPE_WORKGROUP);
                    if (in1) __hip_atomic_fetch_add(hist + (2 * hi + 1) * 512 + b1, 1u, __ATOMIC_RELAXED, __HIP_MEMORY_SCOPE_WORKGROUP);
                });
#pragma unroll
                for (int ql = 0; ql < 4; ++ql) { unsigned bin, above, bc; scan_hist_cnt(hist + ql * 512, lane, st.need[ql], bin, above, bc);
                    st.pre[ql] = (st.pre[ql] << wd) | bin; st.need[ql] -= above; }
                LDS_WAIT();
            }
            const unsigned T0 = hi ? st.pre[2] : st.pre[0], T1 = hi ? st.pre[3] : st.pre[1], rq0 = hi ? st.need[2] : st.need[0], rq1 = hi ? st.need[3] : st.need[1];
            tile_pass(F, ksrc, kdst, kfr, koff, NT, qa, wp, [&](int kbase, float s0, float s1) {
#pragma unroll
                for (int t = 0; t < 2; ++t) {
                    const unsigned kk = okey(t ? s1 : s0), T = t ? T1 : T0, rq = t ? rq1 : rq0;
                    const bool gt = kk > T, eq = kk == T;
                    const unsigned long long me = __ballot(eq);
                    const unsigned meh = hi ? (unsigned)(me >> 32) : (unsigned)me;
                    const unsigned trank = (hi ? st.tcnt[2 + t] : st.tcnt[t]) + __builtin_popcount(meh & below);
                    const bool take = gt || (eq && trank < rq);
                    const unsigned long long mt = __ballot(take);
                    const unsigned mth = hi ? (unsigned)(mt >> 32) : (unsigned)mt;
                    const unsigned pos = (hi ? st.cnt[2 + t] : st.cnt[t]) + __builtin_popcount(mth & below);
                    if (take && pos < 256u) sel[(2 * hi + t) * 256 + pos] = (unsigned short)(kbase + r);
                    st.cnt[t] += __builtin_popcount((unsigned)mt); st.cnt[2 + t] += __builtin_popcount((unsigned)(mt >> 32));
                    st.tcnt[t] += __builtin_popcount((unsigned)me); st.tcnt[2 + t] += __builtin_popcount((unsigned)(me >> 32));
                }
            });
        }
    }
    LDS_WAIT();
    { const LAS v4u* s4 = (const LAS v4u*)sel; v4u* g4 = (v4u*)(C.SEL + (rowbase + tq0) * 256);
#pragma unroll
      for (int j = 0; j < 2; ++j) g4[j * 64 + lane] = s4[j * 64 + lane]; }
    LDS_WAIT();
}
__device__ __forceinline__ void phase(Frame& F, const Ctx& C) {
    for (int v = F.vcu; v < 256; v += F.G) {
        const int b = v >> 6, c = v & 63;
#pragma unroll 1
        for (int it = 0; it < 4; ++it) step(F, C, b, (it < 2) ? c : 127 - c, it & 1);
    }
}
__device__ __forceinline__ void attn_phase(Frame& F, const Ctx& C) {
    int lane = F.lane; asm volatile("" : "+v"(lane));
    LAS unsigned short* sq = (LAS unsigned short*)(F.lds + RING_OFF + F.wave * 16384);
    const int nx = F.G / 32;
    for (int x = F.vcu / 32; x < 8; x += nx) {
        const int b = x >> 1, g0 = 2 * (x & 1); const long rowbase = (long)b * SEQ;
        const int w = (F.vcu & 31) * NWAVES + F.wave;
#pragma unroll 1
        for (int t = w; t < SEQ; t += 32 * NWAVES) {
            { const v4u* g4 = (const v4u*)(C.SEL + (rowbase + t) * 256); if (lane < 32) ((LAS v4u*)sq)[lane] = g4[lane]; }
            LDS_WAIT();
            const int N = 64 * ((t >> 6) + 1), nvalid = N < 256 ? N : 256;
            attend(C, sq, nvalid, rowbase, rowbase + t, t, lane, g0);
            LDS_WAIT();
        }
    }
}
}

namespace att8 {
typedef int v2i __attribute__((ext_vector_type(2)));
struct Ctx8 { const unsigned char* QA8; const unsigned char* KV8; const unsigned short* SEL; bf16* M; bool o8; };
constexpr int T2_OFF = KS_OFF, T2_BYTES = 155 * 16 * 4, SELL_OFF = KS_OFF + 10240;
static_assert(T2_BYTES <= 10240 && SELL_OFF + NWAVES * 1024 <= AUX_OFF, "attention LDS map");
__device__ __forceinline__ void mfma8(f32x4& acc, long a, long b) { asm volatile("v_mfma_f32_16x16x32_fp8_fp8 %0, %1, %2, %0" : "+v"(acc) : "v"(a), "v"(b)); }
__device__ __forceinline__ unsigned pk4_fp8(float a, float b, float c, float d) { int r = __builtin_amdgcn_cvt_pk_fp8_f32(a, b, 0, false); r = __builtin_amdgcn_cvt_pk_fp8_f32(c, d, r, true); return (unsigned)r; }

__device__ __forceinline__ void gld16(v4u& dst, const void* p) { asm volatile("global_load_dwordx4 %0, %1, off" : "=v"(dst) : "v"(p) : "memory"); }
__device__ __forceinline__ void issue_kq(const Ctx8& C, const LAS unsigned short* sq, long rowbase, long token, int g, int l15, int l4, int h, v4u (&kr)[16], v4u& qv) {
    const unsigned char* kvb = C.KV8 + rowbase * 512 + g * 128 + 16 * l4;
#pragma unroll
    for (int j = 0; j < 16; ++j) gld16(kr[j], kvb + (long)sq[j * 16 + l15] * 512);
    gld16(qv, C.QA8 + token * 1024 + (4 * g + h) * 64 + 16 * l4);
}
__device__ __forceinline__ void issue_v_half(const Ctx8& C, const LAS unsigned short* sq, long rowbase, int g, int lane, unsigned vbase, int half) {
    const unsigned char* kvb = C.KV8 + rowbase * 512 + g * 128 + 64; const int kq = lane >> 2, p = lane & 3;
#pragma unroll
    for (int j = 0; j < 8; ++j) { const int ti = half * 8 + j; const int key = sq[ti * 16 + kq]; const int x = ((kq >> 2) & 1) | ((ti & 1) << 1);
        glds16(kvb + (long)key * 512 + 16 * (p ^ x), (unsigned)__builtin_amdgcn_readfirstlane(vbase + ti * 1024)); }
}
__device__ __forceinline__ void phase(Frame& F, const Ctx8& C, const float* t5) {
    int lane = F.lane; asm volatile("" : "+v"(lane));
    LAS float* T2 = (LAS float*)(F.lds + T2_OFF);
    for (int e = F.tid; e < 155 * 16; e += NWAVES * 64) { const int rel = (e >> 4) - 91, n = rel < 0 ? -rel : rel;
        const int bk = (rel > 0 ? 16 : 0) + (n < 8 ? n : 8 + (n >= 12) + (n >= 16) + (n >= 23) + (n >= 32) + (n >= 46) + (n >= 64) + (n >= 91));
        T2[e] = t5[bk * 16 + (e & 15)] * 8.0f; }
    __syncthreads();
    LAS unsigned short* sqb = (LAS unsigned short*)(F.lds + SELL_OFF + F.wave * 1024);
    LAS unsigned char* vreg = F.lds + RING_OFF + F.wave * 16384;
    const unsigned vbase = (unsigned)(uintptr_t)vreg;
    const int l15 = lane & 15, l4 = lane >> 4, h = l15 & 3;
    const int trk = 4 * l4 + ((l15 >> 1) & 3), trt = (l15 >> 3) & 1, xs = (l4 & 1) | (trt << 1);
    const int troff = trt * 1024 + trk * 64 + 8 * (l15 & 1);
    const int x = F.vcu / 32, b = x >> 1, g0 = 2 * (x & 1); const long rowbase = (long)b * SEQ;
    const int w = (F.vcu & 31) * NWAVES + F.wave;
    constexpr int NQ = SEQ / (32 * NWAVES), NI = 2 * NQ;
    if (lane < 32) { ((LAS v4u*)sqb)[lane] = ((const v4u*)(C.SEL + (rowbase + w) * 256))[lane]; ((LAS v4u*)(sqb + 256))[lane] = ((const v4u*)(C.SEL + (rowbase + w + 32 * NWAVES) * 256))[lane]; }
    LDS_WAIT();
    v4u kr[16], qv, pf = (v4u){0u, 0u, 0u, 0u};
    issue_kq(C, sqb, rowbase, rowbase + w, g0, l15, l4, h, kr, qv);
    issue_v_half(C, sqb, rowbase, g0, lane, vbase, 0); issue_v_half(C, sqb, rowbase, g0, lane, vbase, 1);
    unsigned cib[16];
#pragma unroll 1
    for (int idx = 0; idx < NI; ++idx) { LA_A;
        const int qn = idx >> 1, gi = idx & 1, g = g0 + gi, t = w + 32 * NWAVES * qn;
        const LAS unsigned short* sq = sqb + (qn & 1) * 256;
        const int nidx = (idx + 1 < NI) ? idx + 1 : idx, nq = nidx >> 1, ng = g0 + (nidx & 1), nt = w + 32 * NWAVES * nq;
        const LAS unsigned short* nsq = sqb + (nq & 1) * 256;
        if (gi == 1) { asm volatile("s_waitcnt vmcnt(34)" : "+v"(pf) :: "memory"); if (lane < 32) ((LAS v4u*)(sqb + (qn & 1) * 256))[lane] = pf; }
        { const int pq = (qn + 2 < NQ) ? qn + 2 : NQ - 1; gld16(pf, (const v4u*)(C.SEL + (rowbase + w + 32 * NWAVES * pq) * 256) + (lane & 31)); }
        if (idx == 0) asm volatile("s_waitcnt vmcnt(0)" : "+v"(qv), "+v"(kr[0]), "+v"(kr[1]), "+v"(kr[2]), "+v"(kr[3]), "+v"(kr[4]), "+v"(kr[5]), "+v"(kr[6]), "+v"(kr[7]), "+v"(kr[8]), "+v"(kr[9]), "+v"(kr[10]), "+v"(kr[11]), "+v"(kr[12]), "+v"(kr[13]), "+v"(kr[14]), "+v"(kr[15]) :: "memory");
        else asm volatile("s_waitcnt vmcnt(20)" : "+v"(qv), "+v"(kr[0]), "+v"(kr[1]), "+v"(kr[2]), "+v"(kr[3]), "+v"(kr[4]), "+v"(kr[5]), "+v"(kr[6]), "+v"(kr[7]), "+v"(kr[8]), "+v"(kr[9]), "+v"(kr[10]), "+v"(kr[11]), "+v"(kr[12]), "+v"(kr[13]), "+v"(kr[14]), "+v"(kr[15]) :: "memory");
        if (gi == 0) {
#pragma unroll
            for (int ti = 0; ti < 16; ++ti) { const v2u i4 = *(const LAS v2u*)(sq + ti * 16 + 4 * l4);
                const int r0 = (int)(i4.x & 0xffffu) - t, r1 = (int)(i4.x >> 16) - t, r2 = (int)(i4.y & 0xffffu) - t, r3 = (int)(i4.y >> 16) - t;
                const int c0 = min(max(r0, -91), 63) + 91, c1 = min(max(r1, -91), 63) + 91, c2 = min(max(r2, -91), 63) + 91, c3 = min(max(r3, -91), 63) + 91;
                cib[ti] = (unsigned)c0 | ((unsigned)c1 << 8) | ((unsigned)c2 << 16) | ((unsigned)c3 << 24); }
        }
        const int N = 64 * ((t >> 6) + 1), nvalid = N < 256 ? N : 256;
        const long q0 = (long)(((unsigned long long)qv.y << 32) | qv.x), q1 = (long)(((unsigned long long)qv.w << 32) | qv.z);
        f32x4 S[16];
#pragma unroll
        for (int ti = 0; ti < 16; ++ti) { const unsigned cb = cib[ti];
            f32x4 a; a.x = T2[(cb & 255u) * 16 + 4 * g + h]; a.y = T2[((cb >> 8) & 255u) * 16 + 4 * g + h]; a.z = T2[((cb >> 16) & 255u) * 16 + 4 * g + h]; a.w = T2[(cb >> 24) * 16 + 4 * g + h];
            mfma8(a, (long)(((unsigned long long)kr[ti].y << 32) | kr[ti].x), q0);
            mfma8(a, (long)(((unsigned long long)kr[ti].w << 32) | kr[ti].z), q1);
            S[ti] = a; }
        asm volatile("s_nop 15\n\ts_nop 7" : "+v"(S[0]), "+v"(S[1]), "+v"(S[2]), "+v"(S[3]), "+v"(S[4]), "+v"(S[5]), "+v"(S[6]), "+v"(S[7]), "+v"(S[8]), "+v"(S[9]), "+v"(S[10]), "+v"(S[11]), "+v"(S[12]), "+v"(S[13]), "+v"(S[14]), "+v"(S[15]));
        issue_kq(C, nsq, rowbase, rowbase + nt, ng, l15, l4, h, kr, qv);
#pragma unroll
        for (int ti = 0; ti < 16; ++ti) if (ti * 16 >= nvalid) S[ti] = (f32x4){-INFINITY, -INFINITY, -INFINITY, -INFINITY};
        float mx = S[0].x;
#pragma unroll
        for (int ti = 0; ti < 16; ++ti) mx = fmaxf(fmaxf(mx, fmaxf(S[ti].x, S[ti].y)), fmaxf(S[ti].z, S[ti].w));
        mx = fmaxf(mx, __shfl_xor(mx, 16)); mx = fmaxf(mx, __shfl_xor(mx, 32));
        const float mc = -mx * C2; float ls = 0.f;
        long P8[8];
#pragma unroll
        for (int j = 0; j < 8; ++j) { float e[8];
#pragma unroll
            for (int q = 0; q < 4; ++q) { e[q] = __builtin_amdgcn_exp2f(__builtin_fmaf(S[2 * j][q], C2, mc)); e[4 + q] = __builtin_amdgcn_exp2f(__builtin_fmaf(S[2 * j + 1][q], C2, mc)); }
            ls += ((e[0] + e[1]) + (e[2] + e[3])) + ((e[4] + e[5]) + (e[6] + e[7]));
            const unsigned lo = pk4_fp8(e[0] * 256.f, e[1] * 256.f, e[2] * 256.f, e[3] * 256.f), hi = pk4_fp8(e[4] * 256.f, e[5] * 256.f, e[6] * 256.f, e[7] * 256.f);
            P8[j] = (long)(((unsigned long long)hi << 32) | lo); }
        ls += __shfl_xor(ls, 16); ls += __shfl_xor(ls, 32);
        f32x4 D[4];
#pragma unroll
        for (int db = 0; db < 4; ++db) D[db] = (f32x4){0.f, 0.f, 0.f, 0.f};
#pragma unroll
        for (int hf = 0; hf < 2; ++hf) {
            asm volatile("s_waitcnt vmcnt(28)" ::: "memory");
#pragma unroll
            for (int j = 4 * hf; j < 4 * hf + 4; ++j)
#pragma unroll
                for (int db = 0; db < 4; ++db) {
                    const v2i vv = __builtin_amdgcn_ds_read_tr8_b64_v2i32((LAS v2i*)(vreg + j * 2048 + troff + 16 * (db ^ xs)));
                    mfma8(D[db], P8[j], __builtin_bit_cast(long, vv)); }
            asm volatile("s_waitcnt lgkmcnt(0)" ::: "memory");
            issue_v_half(C, nsq, rowbase, ng, lane, vbase, hf);
        }
        asm volatile("s_nop 15\n\ts_nop 7" : "+v"(D[0]), "+v"(D[1]), "+v"(D[2]), "+v"(D[3]));
        const float lh = __shfl(ls, l4);
        const float inv = __builtin_amdgcn_rcpf(lh * 256.f);
        bf16* mp = C.M + (rowbase + t) * DM + (4 * g + l4) * 64 + l15;
#pragma unroll
        for (int db = 0; db < 4; ++db) { const float v = (l4 == 0) ? D[db].x : (l4 == 1) ? D[db].y : (l4 == 2) ? D[db].z : D[db].w;
            if (C.o8) { const unsigned o1 = (unsigned)__builtin_amdgcn_cvt_pk_fp8_f32(v * inv, 0.f, 0, false);
                asm volatile("global_store_byte %0, %1, off" :: "v"((unsigned char*)C.M + (rowbase + t) * DM + (4 * g + l4) * 64 + l15 + 16 * db), "v"(o1) : "memory"); }
            else { const unsigned short ob = (unsigned short)f2bf(v * inv);
                asm volatile("global_store_short %0, %1, off" :: "v"(mp + 16 * db), "v"((unsigned)ob) : "memory"); } }
    }
    asm volatile("s_waitcnt vmcnt(0)" ::: "memory");
}
}

#ifndef REP_P0
#define REP_P0 1
#endif
#ifndef REP_IN
#define REP_IN 1
#endif
#ifndef REP_DSA
#define REP_DSA 1
#endif
#ifndef REP_BAND
#define REP_BAND 1
#endif
#ifndef REP_UP
#define REP_UP 1
#endif
#ifndef REP_FIX
#define REP_FIX 1
#endif
constexpr int N_PHASES = 1 + 6 * DEPTH;
#ifndef MK_N_LAUNCHES
#define MK_N_LAUNCHES 1
#endif
__global__ void __launch_bounds__(NWAVES * 64, 2) mega_fwd(Args args) {
    extern __shared__ __attribute__((aligned(16))) unsigned char lds[];
    Frame F;
    F.lds = (LAS unsigned char*)lds;
    F.MISC = (volatile LAS unsigned*)(F.lds + MISC_OFF);
    F.tid = threadIdx.x; F.lane = F.tid & 63; F.wave = __builtin_amdgcn_readfirstlane(F.tid >> 6);
    F.G = GRID; { const int bx = blockIdx.x; F.vcu = (bx & 7) * (GRID / 8) + (bx >> 3); }
    unsigned char* ws = args.ws;
    F.ctl = (gu32*)(ws + WS_CTL);
    for (int u = F.tid; u < (LDS_BYTES - LDSCTL_OFF) / 4; u += NWAVES * 64) ((LAS unsigned*)(F.lds + LDSCTL_OFF))[u] = 0u;
    __syncthreads();
    XcdBarrier bar; bar.bar = (unsigned*)(F.ctl + CW_BAR); bar.x = 0; bar.st = nullptr;
    if (MK_N_LAUNCHES == 1) bar = xcd_barrier_post((unsigned*)(F.ctl + CW_BAR), F.MISC + 8);
#ifdef F8M_RUNTIME
    const int lo = args.ph_lo, hi = args.ph_hi, f8m = args.f8m;
#else
    const int lo = args.ph_lo, hi = args.ph_hi; constexpr int f8m = F8M_ALL;
#ifdef PAD_NOPS
    asm volatile(".rept %0\n\ts_nop 0\n\t.endr" :: "n"(PAD_NOPS));
#endif
#endif
#define IN(k) (lo <= (k) && (k) < hi)
#define OPQ_FRAME(Fl) Frame Fl = F; { int l_; asm volatile("v_mbcnt_lo_u32_b32 %0, -1, 0\n\tv_mbcnt_hi_u32_b32 %0, -1, %0" : "=v"(l_)); int w_ = F.wave; asm volatile("" : "+s"(w_)); Fl.wave = w_; Fl.lane = l_; Fl.tid = w_ * 64 + l_; }
#define SEAM(k) do { if (IN(k) && IN((k) + 1)) xcd_barrier(bar); } while (0)

    bf16* hb = (bf16*)(ws + WS_HB); bf16* mb = (bf16*)(ws + WS_M); float* ss = (float*)(ws + WS_SS); float* halo = (float*)(ws + WS_HALO);
    unsigned char* proj = ws + WS_PROJ; bf16* act = (bf16*)(ws + WS_PROJ);

#ifndef SKIP_P0
    if (IN(0)) { for (int rep = 0; rep < REP_P0; ++rep) { OPQ_FRAME(F0); p0_prologue(F0, args); } }
#endif
    SEAM(0);

#pragma unroll 1
    for (int L = 0; L < DEPTH; ++L) {
        const int pb = 1 + 6 * L, li = L >> 1; const bool isB = (L & 1) != 0;
        if (IN(pb)) {
#ifndef SKIP_IN
            for (int rep = 0; rep < REP_IN; ++rep)
            if (!isB) {
                pg8::Gemm g{hb, (const bf16*)(ws + WS_W_INA) + (size_t)li * NA_PAD * DM, MTOK, NA_PAD, DM}; pg8::StaticOrder S; S.init(MTOK, NA_PAD, F.G, (int)blockIdx.x);
                EpiIn E{ss, proj, args.q_norm_g + L * 64, args.k_norm_g + L * 64, 0, 1.0f};
                pg8::gemm_phase<EpiIn, pg8::StaticOrder, true, true>(F.lds + RING_OFF, g, S, E, F.wave);
            } else {
                pg8::Gemm g{hb, (const bf16*)(ws + WS_W_INB) + (size_t)li * NB * DM, MTOK, NB, DM}; pg8::StaticOrder S; S.init(MTOK, NB, F.G, (int)blockIdx.x);
                if (f8_in(f8m, L)) { pg8::Gemm g8{(const bf16*)(ws + WS_M), (const bf16*)(ws + WS_W_INB) + (size_t)li * NB * DM, MTOK, NB, DM / 2};
                    EpiIn E{ss, proj, args.q_norm_g + L * 64, args.k_norm_g + L * 64, 1, W8I};
                    pg8::gemm_phase<EpiIn, pg8::StaticOrder, true, true, true>(F.lds + RING_OFF, g8, S, E, F.wave); }
                else { EpiIn E{ss, proj, args.q_norm_g + L * 64, args.k_norm_g + L * 64, 1, 1.0f};
                    pg8::gemm_phase<EpiIn, pg8::StaticOrder, true, true>(F.lds + RING_OFF, g, S, E, F.wave); }
            }
#endif
        }
        SEAM(pb);
#if defined(DBG_NODSA) || defined(DBG_NOBAND)
#ifdef DBG_NODSA
        const bool zero_m = !isB;
#else
        const bool zero_m = isB;
#endif
        if (IN(pb + 1) && zero_m) { for (size_t i = (size_t)blockIdx.x * 512 + threadIdx.x; i < (size_t)MTOK * DM / 8; i += (size_t)gridDim.x * 512) ((v4u*)mb)[i] = (v4u){0u, 0u, 0u, 0u}; }
        if (IN(pb + 1) && !zero_m) {
#else
        if (IN(pb + 1)) {
#endif
#ifndef SKIP_DSA
            if (!isB) {
                LAS float* t5l = (LAS float*)(F.lds + AUX_OFF);
                { OPQ_FRAME(Ft); for (int i = Ft.tid; i < 512; i += NWAVES * 64) t5l[i] = args.t5_bias[i] * LOG2E; }
                __syncthreads();
                dsa::Ctx C{(const bf16*)(proj + PA_QA), (const bf16*)(proj + PA_KA), (const bf16*)(proj + PA_VA), (const bf16*)(proj + PA_QI), (const bf16*)(proj + PA_KI), (const float*)(proj + PA_WI), mb, t5l, (unsigned short*)(proj + PA_SEL)};
#ifdef DBG_DSACOPY
                { int t_ = threadIdx.x; asm volatile("" : "+v"(t_));
                for (unsigned i = blockIdx.x * 512u + (unsigned)t_; i < (unsigned)MTOK * DM; i += gridDim.x * 512u) { const unsigned t = i >> 10, c = i & 1023u;
                    float v = bf_lo(C.QA[i]); v += bf_lo(C.KA[t * 256 + (c & 255)]); v += bf_lo(C.VA[t * 256 + (c & 255)]); v += bf_lo(C.QI[t * 512 + (c & 511)]); v += bf_lo(C.KI[t * 64 + (c & 63)]); v += C.WI[t * 8 + (c & 7)];
                    mb[i] = (bf16)f2bf(v * 0.01f); asm volatile("" ::: "memory"); } }
#else
                for (int rep = 0; rep < REP_DSA; ++rep) { OPQ_FRAME(F1); dsa::phase(F1, C); }
                xcd_barrier(bar);
                { OPQ_FRAME(F1b); att8::Ctx8 C8{(const unsigned char*)(proj + PA_QA), (const unsigned char*)(proj + PA_KA), (const unsigned short*)(proj + PA_SEL), mb, f8_out(f8m, L)};
#ifndef REP_ATT8
#define REP_ATT8 1
#endif
                  for (int rep = 0; rep < REP_ATT8; ++rep) { att8::phase(F1b, C8, args.t5_bias); __syncthreads(); } }
#endif
            }
#endif
#ifndef SKIP_BAND
            if (isB) {
                for (int rep = 0; rep < REP_BAND; ++rep) { OPQ_FRAME(F2); band::phase(F2, (const bf16*)proj, (const bf16*)(proj + PB_STRIDE), (const bf16*)(proj + 2 * PB_STRIDE), mb, args.rel_bias_b + (size_t)li * 513 * 16, f8_out(f8m, L)); }
            }
#endif
        }
        SEAM(pb + 1);
        if (IN(pb + 2)) {
#ifndef SKIP_OUT
            pg8::Gemm g{mb, (const bf16*)(ws + WS_W_OUT) + (size_t)L * DM * DM, MTOK, DM, DM}; pg8::StaticOrder S; S.init(MTOK, DM, F.G, (int)blockIdx.x);
#ifdef REP_OUT
            { EpiRes E0{nullptr, hb, (bf16*)proj, halo}; pg8::gemm_phase<EpiRes, pg8::StaticOrder, true, true>(F.lds + RING_OFF, g, S, E0, F.wave); }
#endif
            unsigned char* h8o = f8_ffn(f8m, L) ? proj + PX_HB8 : nullptr;
            if (f8_out(f8m, L)) { pg8::Gemm g8{mb, (const bf16*)(ws + WS_W_OUT) + (size_t)L * DM * DM, MTOK, DM, DM / 2};
                EpiResT<1 | SER_OUT> E{nullptr, hb, hb, ss, h8o};
                pg8::gemm_phase<EpiResT<1 | SER_OUT>, pg8::StaticOrder, true, true, true>(F.lds + RING_OFF, g8, S, E, F.wave); }
            else { EpiResT<SER_OUT> E{nullptr, hb, hb, ss, h8o, L == 0 ? args.x : nullptr};
                pg8::gemm_phase<EpiResT<SER_OUT>, pg8::StaticOrder, true, true>(F.lds + RING_OFF, g, S, E, F.wave); }
#endif
        }
        SEAM(pb + 2);
        if (IN(pb + 3)) {
#ifndef SKIP_UP
            for (int rep = 0; rep < REP_UP; ++rep) {
            pg8::Gemm g{hb, (const bf16*)(ws + WS_W_UP) + (size_t)L * NUP * DM, MTOK, NUP, DM}; pg8::StaticOrder S; S.init(MTOK, NUP, F.G, (int)blockIdx.x);
#ifdef PROBE_UPK
            { EpiDummy E0{halo}; pg8::gemm_phase<EpiDummy, pg8::StaticOrder, true, true>(F.lds + RING_OFF, g, S, E0, F.wave); }
#endif
            if (f8_ffn(f8m, L)) { pg8::Gemm g8{(const bf16*)(proj + PX_HB8), (const bf16*)(ws + WS_W_UP) + (size_t)L * NUP * DM, MTOK, NUP, DM / 2};
                EpiUpT<true> E{ss, args.conv_w + (size_t)L * 3 * NUP, args.conv_b + (size_t)L * NUP, act, halo, (LAS float*)(F.lds + AUX_OFF)};
                pg8::gemm_phase<EpiUpT<true>, pg8::StaticOrder, true, true, true>(F.lds + RING_OFF, g8, S, E, F.wave); }
            else { EpiUp E{ss, args.conv_w + (size_t)L * 3 * NUP, args.conv_b + (size_t)L * NUP, act, halo, (LAS float*)(F.lds + AUX_OFF)};
                pg8::gemm_phase<EpiUp, pg8::StaticOrder, true, true>(F.lds + RING_OFF, g, S, E, F.wave); } }
#endif
        }
        SEAM(pb + 3);
#ifndef SKIP_FIX
        if (IN(pb + 4)) for (int rep = 0; rep < REP_FIX; ++rep) { OPQ_FRAME(F3); if (f8_ffn(f8m, L)) fixup_phase<true>(F3, args.conv_w + (size_t)L * 3 * NUP, args.conv_b + (size_t)L * NUP, halo, act); else fixup_phase<false>(F3, args.conv_w + (size_t)L * 3 * NUP, args.conv_b + (size_t)L * NUP, halo, act); }
#endif
        SEAM(pb + 4);
        if (IN(pb + 5)) {
#ifndef SKIP_DN
            pg8::Gemm g{act, (const bf16*)(ws + WS_W_DN) + (size_t)L * DM * FF, MTOK, DM, FF}; pg8::StaticOrder S; S.init(MTOK, DM, F.G, (int)blockIdx.x);
#ifdef REP_DN
            { EpiRes E0{nullptr, hb, mb, halo}; pg8::gemm_phase<EpiRes, pg8::StaticOrder, true, true>(F.lds + RING_OFF, g, S, E0, F.wave); }
#endif
            unsigned char* h8d = f8_in(f8m, L + 1) ? ws + WS_M : nullptr;
            if (f8_ffn(f8m, L)) { pg8::Gemm g8{act, (const bf16*)(ws + WS_W_DN) + (size_t)L * DM * FF, MTOK, DM, FF / 2};
                EpiResT<1> E{L == DEPTH - 1 ? args.out : nullptr, hb, hb, ss, h8d};
                pg8::gemm_phase<EpiResT<1>, pg8::StaticOrder, true, true, true>(F.lds + RING_OFF, g8, S, E, F.wave); }
            else { EpiRes E{L == DEPTH - 1 ? args.out : nullptr, hb, hb, ss, h8d};
                pg8::gemm_phase<EpiRes, pg8::StaticOrder, true, true>(F.lds + RING_OFF, g, S, E, F.wave); }
#endif
        }
        SEAM(pb + 5);
    }
#undef IN
#undef SEAM
}

extern "C" void kernel_launch(void* const* d_in, const int* in_sizes, int n_in, void* d_out, int out_size, void* d_ws, size_t ws_size, hipStream_t stream) {
    static int grid = 0;
    if (grid == 0) {
        if (n_in != 14 || in_sizes[0] != MTOK * DM || out_size != MTOK * DM || ws_size < WS_END) { fprintf(stderr, "kernel_launch: unexpected shapes / workspace (n_in %d, ws %zu); nothing launched\n", n_in, ws_size); grid = -1; return; }
        int dev = 0, cus = 0, per_cu = 0;
        if (hipGetDevice(&dev) != hipSuccess || hipDeviceGetAttribute(&cus, hipDeviceAttributeMultiprocessorCount, dev) != hipSuccess) { grid = -1; return; }
        if (hipFuncSetAttribute((const void*)mega_fwd, hipFuncAttributeMaxDynamicSharedMemorySize, LDS_BYTES) != hipSuccess) { fprintf(stderr, "kernel_launch: hipFuncSetAttribute failed\n"); grid = -1; return; }
        if (hipOccupancyMaxActiveBlocksPerMultiprocessor(&per_cu, (const void*)mega_fwd, NWAVES * 64, LDS_BYTES) != hipSuccess || per_cu < 1) { fprintf(stderr, "kernel_launch: occupancy query reports %d blocks per CU\n", per_cu); }
        (void)hipGetLastError();
        if (cus != GRID) { fprintf(stderr, "kernel_launch: built for a %d-CU device, found %d; nothing launched\n", GRID, cus); grid = -1; return; }
        grid = GRID;
    }
    if (grid < 0) return;
    if (hipMemsetAsync((char*)d_ws + WS_CTL, 0, CTL_ZERO_BYTES, stream) != hipSuccess) return;
    Args a{};
    a.x = (const float*)d_in[0]; a.attn_norm_g = (const float*)d_in[1]; a.w_in_a = (const float*)d_in[2]; a.w_in_b = (const float*)d_in[3]; a.q_norm_g = (const float*)d_in[4];
    a.k_norm_g = (const float*)d_in[5]; a.t5_bias = (const float*)d_in[6]; a.rel_bias_b = (const float*)d_in[7]; a.w_out = (const float*)d_in[8]; a.ffn_norm_g = (const float*)d_in[9];
    a.w_up = (const float*)d_in[10]; a.conv_w = (const float*)d_in[11]; a.conv_b = (const float*)d_in[12]; a.w_down = (const float*)d_in[13];
    a.out = (float*)d_out; a.ws = (unsigned char*)d_ws; a.f8m = F8M_ALL;
#if MK_N_LAUNCHES == 1
    a.ph_lo = 0; a.ph_hi = N_PHASES; a.li = 0;
    hipLaunchKernelGGL(mega_fwd, dim3(grid), dim3(NWAVES * 64), LDS_BYTES, stream, a);
#else
    for (int p = 0; p < N_PHASES; ++p) { a.ph_lo = p; a.ph_hi = p + 1; a.li = p; hipLaunchKernelGGL(mega_fwd, dim3(grid), dim3(NWAVES * 64), LDS_BYTES, stream, a); }
#endif
}
```

```cpp
#define OFF_G -1
#define OFF_S -1
#define OFF_A -1
#define OFF_B -1
#define F8M_IN 0xA
#define F8M_OUT 0xF
#include <hip/hip_runtime.h>
#include <cstdio>
#include <cstdint>
#ifndef OFF_G
#define OFF_G 0
#endif
#ifndef OFF_S
#define OFF_S 0
#endif
#ifndef OFF_A
#define OFF_A 0
#endif
#ifndef OFF_B
#define OFF_B 0
#endif
#define LOOP_ALIGN_N(n) asm volatile(".p2align 6\n\t.rept %0\n\ts_nop 0\n\t.endr" :: "n"(n))
#if OFF_G < 0
#define LA_G
#else
#define LA_G LOOP_ALIGN_N(OFF_G)
#endif
#if OFF_S < 0
#define LA_S
#else
#define LA_S LOOP_ALIGN_N(OFF_S)
#endif
#if OFF_A < 0
#define LA_A
#else
#define LA_A LOOP_ALIGN_N(OFF_A)
#endif
#if OFF_B < 0
#define LA_B
#else
#define LA_B LOOP_ALIGN_N(OFF_B)
#endif
namespace pg8 {
#define PG8_LAS __attribute__((address_space(3)))
typedef unsigned short bf16_t;
typedef short bf16x8 __attribute__((ext_vector_type(8)));
typedef float f32x4 __attribute__((ext_vector_type(4)));
typedef unsigned u32x4 __attribute__((ext_vector_type(4)));
typedef int i32x4 __attribute__((ext_vector_type(4)));
typedef int i32x8 __attribute__((ext_vector_type(8)));
constexpr int BM = 256, BK = 64, HALF = 128, HTB = HALF * BK * 2  , STAGE_BYTES = 8 * HTB, NXCD = 8, WGM = 8;

__host__ __device__ __forceinline__ int lds_byte(int r, int c) { const int st = (r >> 4) * 2 + (c >> 5), rr = r & 15, cc = c & 31, ob = rr * 64 + cc * 2; return st * 1024 + (ob ^ (((ob >> 9) & 1) << 5)); }
__host__ __device__ __forceinline__ void stage_rc(int b, int& R, int& C) { const int st = b / 1024, sb = b % 1024, swz = sb ^ (((sb >> 9) & 1) << 5); R = (st >> 1) * 16 + swz / 64; C = (st & 1) * 32 + (swz % 64) / 2; }
__host__ __device__ __forceinline__ int perm32(int rho) { const int n = rho >> 4, i = rho & 15; return 8 * (i >> 2) + 4 * n + (i & 3); }

struct Unit { int pm, pn; };
struct Gemm { const bf16_t* A; const bf16_t* Bt; int M, N, K; };

struct StaticOrder {
    int nM, nN, nwg, G, c;
    __host__ __device__ void init(int M, int N, int G_, int c_) { nM = M / BM; nN = N / BM; nwg = nM * nN; G = G_; c = c_; }
    __host__ __device__ bool next(int i, Unit& u) const {
        const long L = (long)i * G + c; if (L >= nwg) return false;
        int wgid = (int)L; { const int q = nwg / NXCD, r = nwg % NXCD, xcd = wgid % NXCD, off = wgid / NXCD; wgid = (xcd < r ? xcd * (q + 1) : r * (q + 1) + (xcd - r) * q) + off; }
        const int nig = WGM * nN, gid = wgid / nig, fm = gid * WGM, gsz = (nM - fm) < WGM ? (nM - fm) : WGM;
        u.pm = fm + ((wgid % nig) % gsz); u.pn = (wgid % nig) / gsz; return true;
    }
    __device__ __forceinline__ void a_ready(const Unit&) const {}
    __device__ __forceinline__ void done(const Unit&) const {}
};
__device__ __forceinline__ unsigned cvt_pk_bf16(float lo, float hi) { unsigned r; asm volatile("v_cvt_pk_bf16_f32 %0, %1, %2" : "=v"(r) : "v"(lo), "v"(hi)); return r; }
template <class Epi, class Sched, bool ALIGN_EPI = false, bool SP2 = false, bool F8 = false>
__device__ __forceinline__ void gemm_phase(PG8_LAS unsigned char* lds, const Gemm g, const Sched& S, const Epi& E, const int wave_id) {
    int lane_; asm volatile("v_mbcnt_lo_u32_b32 %0, -1, 0\n\tv_mbcnt_hi_u32_b32 %0, -1, %0" : "=v"(lane_));
    int wid_ = wave_id; asm volatile("" : "+s"(wid_));
    const int wid = wid_, lane = lane_, tid = wid * 64 + lane, wr = wid >> 2, wc = wid & 3, fr = lane & 15, fq = lane >> 4;
    const int K = g.K, nt = K / BK;
    unsigned voffA[2], voffB[2];
#pragma unroll
    for (int i = 0; i < 2; ++i) { int R, C; stage_rc(tid * 16 + i * 8192, R, C); const int Rb = Epi::PERM ? ((R & ~31) + perm32(R & 31)) : R;
        const int Ra = Epi::PERMA ? ((R & ~63) | (4 * (R & 15) + ((R >> 4) & 3))) : R;
        voffA[i] = (unsigned)(Ra * K + C) * 2u; voffB[i] = (unsigned)(Rb * K + C) * 2u; }
    const size_t kstep = (size_t)(BK * 2);
    const size_t hstep = (size_t)HALF * K * 2;
    const size_t tstep = 2 * hstep;
    const unsigned ldsw = (unsigned)wid * 1024u;
    const int aoff = lds_byte(wr * 64 + fr, fq * 8), boff = lds_byte(wc * 32 + fr, fq * 8);
#define PG8_SA(b, h) (((b) * 2 + (h)) * HTB)
#define PG8_SB(b, h) ((4 + (b) * 2 + (h)) * HTB)
#define PG8_STAGE(bufoff, gbase, voff) do { _Pragma("unroll") for (int _i = 0; _i < 2; ++_i) \
        __builtin_amdgcn_global_load_lds((const unsigned*)((const char*)(gbase) + (voff)[_i]), (PG8_LAS unsigned*)(lds + (bufoff) + ldsw + _i * 8192), 16, 0, 0); } while (0)
#define PG8_LDA(dst, b, h) do { _Pragma("unroll") for (int m = 0; m < 4; ++m) _Pragma("unroll") for (int k = 0; k < 2; ++k) dst[m][k] = *(const PG8_LAS bf16x8*)(lds + PG8_SA(b, h) + aoff + m * 2048 + k * 1024); } while (0)
#define PG8_LDB(dst, b, h) do { _Pragma("unroll") for (int n = 0; n < 2; ++n) _Pragma("unroll") for (int k = 0; k < 2; ++k) dst[n][k] = *(const PG8_LAS bf16x8*)(lds + PG8_SB(b, h) + boff + n * 2048 + k * 1024); } while (0)
#define PG8_CAT(lo, hi) __builtin_shufflevector(__builtin_bit_cast(i32x4, lo), __builtin_bit_cast(i32x4, hi), 0, 1, 2, 3, 4, 5, 6, 7)
#define PG8_MMA(ai, bj, At, Bt) do { __builtin_amdgcn_s_setprio(1); _Pragma("unroll") for (int m = 0; m < 4; ++m) _Pragma("unroll") for (int n = 0; n < 2; ++n) { \
        if constexpr (F8) { const i32x8 b8_ = PG8_CAT(Bt[n][0], Bt[n][1]), a8_ = PG8_CAT(At[m][0], At[m][1]); asm volatile("v_mfma_f32_16x16x128_f8f6f4 %0, %1, %2, %0" : "+v"(acc[ai][bj][m][n]) : "v"(b8_), "v"(a8_)); } \
        else { _Pragma("unroll") for (int k = 0; k < 2; ++k) acc[ai][bj][m][n] = __builtin_amdgcn_mfma_f32_16x16x32_bf16(Bt[n][k], At[m][k], acc[ai][bj][m][n], 0, 0, 0); } } __builtin_amdgcn_s_setprio(0); } while (0)
#define PG8_WAIT_V(n) asm volatile("s_waitcnt vmcnt(" #n ")" ::: "memory")
#define PG8_WAIT_L(n) asm volatile("s_waitcnt lgkmcnt(" #n ")" ::: "memory")
#define PG8_BAR __builtin_amdgcn_s_barrier()
#define PG8_SCHED __builtin_amdgcn_sched_barrier(0)
    Unit cur, nxt; int ui = 0;
    if (!S.next(0, cur)) return;
    f32x4 acc[2][2][4][2];
#pragma unroll
    for (int a = 0; a < 2; ++a)
#pragma unroll
        for (int b = 0; b < 2; ++b)
#pragma unroll
            for (int m = 0; m < 4; ++m)
#pragma unroll
                for (int n = 0; n < 2; ++n) acc[a][b][m][n] = (f32x4){0.f, 0.f, 0.f, 0.f};
    bf16x8 At[4][2], B0[2][2], B1[2][2];
    const char* cA = (const char*)g.A + (size_t)cur.pm * tstep; const char* cB = (const char*)g.Bt + (size_t)cur.pn * tstep;
    S.a_ready(cur);
    if constexpr (SP2) {
        PG8_STAGE(PG8_SB(0, 0), cB, voffB); PG8_STAGE(PG8_SB(0, 1), cB + hstep, voffB); PG8_STAGE(PG8_SA(0, 0), cA, voffA); PG8_STAGE(PG8_SA(0, 1), cA + hstep, voffA);
        if (wr == 1) PG8_BAR;
        PG8_WAIT_V(2); PG8_BAR;
        PG8_STAGE(PG8_SB(1, 0), cB + kstep, voffB); PG8_STAGE(PG8_SA(1, 0), cA + kstep, voffA); PG8_STAGE(PG8_SB(1, 1), cB + hstep + kstep, voffB);
        PG8_WAIT_V(6); PG8_BAR;
    } else {
        PG8_STAGE(PG8_SB(0, 0), cB, voffB); PG8_STAGE(PG8_SA(0, 0), cA, voffA); PG8_STAGE(PG8_SB(0, 1), cB + hstep, voffB); PG8_STAGE(PG8_SA(0, 1), cA + hstep, voffA);
        if (wr == 1) PG8_BAR;
        PG8_WAIT_V(4); PG8_BAR;
        PG8_STAGE(PG8_SB(1, 0), cB + kstep, voffB); PG8_STAGE(PG8_SA(1, 0), cA + kstep, voffA); PG8_STAGE(PG8_SB(1, 1), cB + hstep + kstep, voffB);
        PG8_WAIT_V(6); PG8_BAR;
    }
    for (;;) {
        const bool has_next = S.next(ui + 1, nxt);
        const char* nA = has_next ? (const char*)g.A + (size_t)nxt.pm * tstep : cA; const char* nB = has_next ? (const char*)g.Bt + (size_t)nxt.pn * tstep : cB;
        for (int t = 0; t < nt; t += 2) { LA_G;
            const bool last = (t == nt - 2);
            const char* a1 = cA + (size_t)(t + 1) * kstep;
            const char* a2 = last ? nA : cA + (size_t)(t + 2) * kstep; const char* b2 = last ? nB : cB + (size_t)(t + 2) * kstep;
            const char* a3 = a2 + kstep; const char* b3 = b2 + kstep;
            if (last && has_next) S.a_ready(nxt);
            if constexpr (SP2) {
            PG8_LDB(B0, 0, 0); PG8_LDB(B1, 0, 1); PG8_SCHED; PG8_LDA(At, 0, 0); PG8_STAGE(PG8_SA(1, 1), a1 + hstep, voffA);
            PG8_WAIT_V(8); PG8_WAIT_L(0); PG8_BAR; PG8_MMA(0, 0, At, B0); PG8_MMA(0, 1, At, B1); PG8_BAR; PG8_SCHED;
            PG8_LDA(At, 0, 1); PG8_STAGE(PG8_SB(0, 0), b2, voffB); PG8_STAGE(PG8_SB(0, 1), b2 + hstep, voffB); PG8_STAGE(PG8_SA(0, 0), a2, voffA);
            PG8_WAIT_V(8); PG8_WAIT_L(0); PG8_BAR; PG8_MMA(1, 0, At, B0); PG8_MMA(1, 1, At, B1); PG8_BAR; PG8_SCHED;
            PG8_LDB(B0, 1, 0); PG8_LDB(B1, 1, 1); PG8_SCHED; PG8_LDA(At, 1, 0); PG8_STAGE(PG8_SA(0, 1), a2 + hstep, voffA);
            PG8_WAIT_V(8); PG8_WAIT_L(0); PG8_BAR; PG8_MMA(0, 0, At, B0); PG8_MMA(0, 1, At, B1); PG8_BAR; PG8_SCHED;
            PG8_LDA(At, 1, 1); PG8_STAGE(PG8_SB(1, 0), b3, voffB); PG8_STAGE(PG8_SB(1, 1), b3 + hstep, voffB); PG8_STAGE(PG8_SA(1, 0), a3, voffA);
            PG8_WAIT_V(8); PG8_WAIT_L(0); PG8_BAR; PG8_MMA(1, 0, At, B0); PG8_MMA(1, 1, At, B1); PG8_BAR; PG8_SCHED;
            } else {
            PG8_LDB(B0, 0, 0); PG8_SCHED; PG8_LDA(At, 0, 0); PG8_STAGE(PG8_SA(1, 1), a1 + hstep, voffA);
            PG8_WAIT_L(8); PG8_BAR; PG8_WAIT_L(0); PG8_MMA(0, 0, At, B0); PG8_BAR; PG8_SCHED;
            PG8_LDB(B1, 0, 1); PG8_STAGE(PG8_SB(0, 0), b2, voffB);
            PG8_BAR; PG8_WAIT_L(0); PG8_MMA(0, 1, At, B1); PG8_BAR;
            PG8_LDA(At, 0, 1); PG8_STAGE(PG8_SA(0, 0), a2, voffA);
            PG8_BAR; PG8_WAIT_L(0); PG8_MMA(1, 0, At, B0); PG8_BAR; PG8_SCHED;
            PG8_STAGE(PG8_SB(0, 1), b2 + hstep, voffB);
            PG8_WAIT_V(6); PG8_BAR; PG8_MMA(1, 1, At, B1); PG8_BAR;
            PG8_LDB(B0, 1, 0); PG8_SCHED; PG8_LDA(At, 1, 0); PG8_STAGE(PG8_SA(0, 1), a2 + hstep, voffA);
            PG8_WAIT_L(8); PG8_BAR; PG8_WAIT_L(0); PG8_MMA(0, 0, At, B0); PG8_BAR; PG8_SCHED;
            PG8_LDB(B1, 1, 1); PG8_STAGE(PG8_SB(1, 0), b3, voffB);
            PG8_BAR; PG8_WAIT_L(0); PG8_MMA(0, 1, At, B1); PG8_BAR;
            PG8_LDA(At, 1, 1); PG8_STAGE(PG8_SA(1, 0), a3, voffA);
            PG8_BAR; PG8_WAIT_L(0); PG8_MMA(1, 0, At, B0); PG8_BAR; PG8_SCHED;
            PG8_STAGE(PG8_SB(1, 1), b3 + hstep, voffB);
            PG8_WAIT_V(6); PG8_BAR; PG8_MMA(1, 1, At, B1); PG8_BAR;
            }
        }
        if constexpr (F8) asm volatile("s_nop 15\n\ts_nop 15" ::: "memory");
        if constexpr (ALIGN_EPI) { if (wr == 0) PG8_BAR; }
        if constexpr (!Epi::AFTER_DRAIN) { E(acc, cur, wr, wc, fr, fq); S.done(cur); }
        if (!has_next) break;
#pragma unroll
        for (int a = 0; a < 2; ++a)
#pragma unroll
            for (int b = 0; b < 2; ++b)
#pragma unroll
                for (int m = 0; m < 4; ++m)
#pragma unroll
                    for (int n = 0; n < 2; ++n) acc[a][b][m][n] = (f32x4){0.f, 0.f, 0.f, 0.f};
        cur = nxt; cA = nA; cB = nB; ++ui;
        if constexpr (ALIGN_EPI) { if (wr == 1) PG8_BAR; }
    }
    PG8_WAIT_V(0);
    if constexpr (!ALIGN_EPI) { if (wr == 0) PG8_BAR; }
    PG8_BAR;
    if constexpr (Epi::AFTER_DRAIN) { E.fused(acc, cur, wr, wc, fr, fq, lds, wid, lane); S.done(cur); }
#undef PG8_SA
#undef PG8_SB
#undef PG8_STAGE
#undef PG8_LDA
#undef PG8_LDB
#undef PG8_MMA
#undef PG8_CAT
#undef PG8_WAIT_V
#undef PG8_WAIT_L
#undef PG8_BAR
#undef PG8_SCHED
}
}

constexpr int NWAVES = 8, GRID = 256;
constexpr int BATCH = 4, SEQ = 8192, DM = 1024, MTOK = BATCH * SEQ, DEPTH = 4;
constexpr int NA_SRC = 2120, NA_PAD = 2304, NB = 3072, FF = 2816, NUP = 2 * FF;
constexpr float EPS = 1e-6f;
constexpr float LOG2E = 1.4426950408889634f;
constexpr float C2 = 0.125f * LOG2E;
constexpr int NBLK64 = MTOK / 64;

constexpr size_t MiB = 1u << 20;
constexpr size_t WS_CTL = 0, CTL_ZERO_BYTES = 1 * MiB;
constexpr size_t WS_W_INA = 2 * MiB;
constexpr size_t WS_W_INB = 11 * MiB;
constexpr size_t WS_W_OUT = 23 * MiB;
constexpr size_t WS_W_UP = 31 * MiB;
constexpr size_t WS_W_DN = 75 * MiB;
constexpr size_t WS_HB = 98 * MiB;
constexpr size_t WS_M = 162 * MiB;
constexpr size_t WS_SS = 226 * MiB;
constexpr size_t WS_HALO = 228 * MiB;
constexpr size_t WS_PROJ = 272 * MiB;
constexpr size_t WS_END = 464 * MiB;
constexpr size_t PA_QA = 0, PA_KA = 64 * MiB, PA_VA = 80 * MiB, PA_QI = 96 * MiB, PA_KI = 128 * MiB, PA_WI = 132 * MiB, PA_SEL = 136 * MiB;
constexpr size_t PB_STRIDE = 64 * MiB;
constexpr int CW_BAR = 4096;
constexpr int F8_L0 = 2;
#ifndef F8M_IN
#define F8M_IN 0x8
#endif
#ifndef F8M_OUT
#define F8M_OUT 0xC
#endif
#ifndef F8M_FFN
#define F8M_FFN 0xC
#endif
#define F8M_ALL ((F8M_IN & 0xA) | ((F8M_OUT & 0xF) << 4) | ((F8M_FFN & 0xF) << 8))
__host__ __device__ constexpr bool f8_in(int m, int L) { return L < DEPTH && ((m >> L) & 1) != 0; }
__host__ __device__ constexpr bool f8_out(int m, int L) { return ((m >> (4 + L)) & 1) != 0; }
__host__ __device__ constexpr bool f8_ffn(int m, int L) { return ((m >> (8 + L)) & 1) != 0; }
constexpr size_t PX_HB8 = 96 * MiB;
constexpr float W8S = 128.f, W8I = 1.f / 128.f;

constexpr int RING_OFF = 0, RING_BYTES = 131072;
constexpr int KS_OFF = RING_BYTES;
constexpr int AUX_OFF = RING_BYTES + 24576;
constexpr int LDSCTL_OFF = AUX_OFF + 4096, MISC_OFF = LDSCTL_OFF + 320;
constexpr int LDS_BYTES = 163840;
static_assert(MISC_OFF + 128 <= LDS_BYTES, "LDS map");

#define GAS __attribute__((address_space(1)))
#define LAS __attribute__((address_space(3)))
typedef unsigned short bf16;
typedef unsigned v4u __attribute__((ext_vector_type(4)));
typedef unsigned v2u __attribute__((ext_vector_type(2)));
typedef float f32x4 __attribute__((ext_vector_type(4)));
typedef float f32x16 __attribute__((ext_vector_type(16)));
typedef short bf16x8 __attribute__((ext_vector_type(8)));
typedef short s16x4 __attribute__((ext_vector_type(4)));
typedef float f32x2_t __attribute__((ext_vector_type(2)));
typedef GAS unsigned gu32;
#define RLX_AGENT __ATOMIC_RELAXED, __HIP_MEMORY_SCOPE_AGENT
#define LDS_WAIT() asm volatile("s_waitcnt lgkmcnt(0)" ::: "memory")
#define VM_WAIT() asm volatile("s_waitcnt vmcnt(0)" ::: "memory")
__device__ __forceinline__ unsigned f2bf(float f) { unsigned u = __builtin_bit_cast(unsigned, f); return (u + 0x7fffu + ((u >> 16) & 1u)) >> 16; }
__device__ __forceinline__ unsigned pk2(float lo, float hi) { return f2bf(lo) | (f2bf(hi) << 16); }
typedef float f32x2c_t __attribute__((ext_vector_type(2))); typedef __bf16 bf16x2c_t __attribute__((ext_vector_type(2)));
__device__ __forceinline__ unsigned cvtpk(float lo, float hi) { const f32x2c_t v = {lo, hi}; const bf16x2c_t b = __builtin_convertvector(v, bf16x2c_t); return __builtin_bit_cast(unsigned, b); }
__device__ __forceinline__ float bf_lo(unsigned u) { return __builtin_bit_cast(float, u << 16); }
__device__ __forceinline__ float bf_hi(unsigned u) { return __builtin_bit_cast(float, u & 0xffff0000u); }

__device__ __forceinline__ unsigned pk4f8(float a, float b, float c, float d) { int r = __builtin_amdgcn_cvt_pk_fp8_f32(a, b, 0, false); r = __builtin_amdgcn_cvt_pk_fp8_f32(c, d, r, true); return (unsigned)r; }

#define XB_TMO      128
#define XB_XCNT(j)  (256  + 64 * (j))
#define XB_XSUB(j)  (1280 + 64 * (j))
#define XB_XGEN(j)  (2304 + 64 * (j))
#define XB_TOP      3328
#define XB_TOPGEN   3392
#define XCD_BAR_WORDS 3456
#define XB_SPIN_CAP (1u << 18)

__device__ __forceinline__ unsigned xb_ld(unsigned* p)              { return __hip_atomic_load(p, __ATOMIC_RELAXED, __HIP_MEMORY_SCOPE_AGENT); }
__device__ __forceinline__ unsigned xb_add(unsigned* p, unsigned v) { return __hip_atomic_fetch_add(p, v, __ATOMIC_RELAXED, __HIP_MEMORY_SCOPE_AGENT); }
__device__ __forceinline__ unsigned xb_xcc_id() { return (unsigned)__builtin_amdgcn_s_getreg((3 << 11) | 20) & 0xFu; }
#define XB_SPIN(cond, bar) do { unsigned _sp = 0; while (cond) { __builtin_amdgcn_s_sleep(1); \
    if ((++_sp & 255u) == 0u) { if (xb_ld(&(bar)[XB_TMO])) break; if (_sp > XB_SPIN_CAP) { atomicAdd(&(bar)[XB_TMO], 1u); break; } } } } while (0)

struct XcdBarrier {
    unsigned* bar; unsigned x;
    volatile LAS unsigned* st;
};

__device__ __forceinline__ XcdBarrier xcd_barrier_post(unsigned* bar, volatile LAS unsigned* st) {
    XcdBarrier b; b.bar = bar; b.x = xb_xcc_id(); b.st = st;
    if (threadIdx.x == 0) (void)xb_add(&bar[XB_XCNT(b.x)], 1u);
    return b;
}
__device__ __forceinline__ void xcd_barrier_complete(unsigned* bar, unsigned x, unsigned& nloc, unsigned& nx) {
    const unsigned G = gridDim.x * gridDim.y * gridDim.z;
    unsigned sum, cnt, mine, sp = 0u;
    for (;;) {
        sum = 0u; cnt = 0u; mine = 0u;
#pragma unroll
        for (unsigned j = 0; j < 16; ++j) { const unsigned c = xb_ld(&bar[XB_XCNT(j)]); sum += c; cnt += (c > 0u) ? 1u : 0u; mine = (j == x) ? c : mine; }
        if (sum == G) break;
        __builtin_amdgcn_s_sleep(1);
        if ((++sp & 255u) == 0u) { if (xb_ld(&bar[XB_TMO])) break; if (sp > XB_SPIN_CAP) { atomicAdd(&bar[XB_TMO], 1u); break; } }
    }
    nloc = mine > 0u ? mine : 1u; nx = cnt > 0u ? cnt : 1u;
}

__device__ __forceinline__ void xcd_barrier(const XcdBarrier& b) {
    asm volatile("s_waitcnt vmcnt(0)" ::: "memory");
    __syncthreads();
    if (threadIdx.x == 0) {
        unsigned* bar = b.bar;
        __builtin_amdgcn_s_waitcnt(0);
        unsigned nloc = b.st[0], nx = b.st[1];
        if (nloc == 0u) { xcd_barrier_complete(bar, b.x, nloc, nx); b.st[0] = nloc; b.st[1] = nx; }
        const unsigned old = xb_add(&bar[XB_XSUB(b.x)], 1u);
        const unsigned gen = old / nloc;
        if (old + 1u == (gen + 1u) * nloc) {
            __builtin_amdgcn_fence(__ATOMIC_RELEASE, "agent");
            asm volatile("s_waitcnt vmcnt(0)" ::: "memory");
            const unsigned og = xb_add(&bar[XB_TOP], 1u);
            const unsigned tg = og / nx;
            if (og + 1u == (tg + 1u) * nx) xb_add(&bar[XB_TOPGEN], 1u);
            else XB_SPIN(xb_ld(&bar[XB_TOPGEN]) == tg, bar);
            __builtin_amdgcn_fence(__ATOMIC_ACQUIRE, "agent");
            xb_add(&bar[XB_XGEN(b.x)], 1u);
            asm volatile("s_waitcnt vmcnt(0)" ::: "memory");
        } else {
            XB_SPIN(xb_ld(&bar[XB_XGEN(b.x)]) == gen, bar);
            __builtin_amdgcn_fence(__ATOMIC_ACQUIRE, "agent");
            asm volatile("s_waitcnt vmcnt(0)" ::: "memory");
        }
    }
    __syncthreads();
}


struct Args {
    const float* x; const float* attn_norm_g; const float* w_in_a; const float* w_in_b; const float* q_norm_g; const float* k_norm_g; const float* t5_bias;
    const float* rel_bias_b; const float* w_out; const float* ffn_norm_g; const float* w_up; const float* conv_w; const float* conv_b; const float* w_down;
    float* out; unsigned char* ws; int ph_lo, ph_hi, li, f8m;
};

struct Frame {
    LAS unsigned char* lds;
    volatile LAS unsigned* MISC;
    gu32* ctl;
    int tid, lane, wave, vcu, G;
};

__host__ __device__ __forceinline__ int hmap(int p) { return 64 * ((p >> 5) & 3) + 16 * ((p >> 2) & 3) + 8 * (p >> 7) + 4 * ((p >> 4) & 1) + (p & 3); }
__host__ __device__ __forceinline__ int umap(int p) { return 32 * ((p >> 5) & 3) + 8 * ((p >> 2) & 3) + 4 * ((p >> 4) & 1) + (p & 3); }
__host__ __device__ __forceinline__ int src_col(int type, int n) {
    if (type == 0) return n;
    const int pn = n >> 8, p = n & 255;
    if (type == 2) return 256 * pn + hmap(p);
    if (type == 1) { const int c = hmap(p); return pn < 8 ? 256 * pn + c : (c < 72 ? 2048 + c : -1); }
    return (p >> 7) * FF + 128 * pn + umap(p);
}
__device__ __forceinline__ void convert_item(const float* W, int K, int Nsrc, int Ndst, int type, const float* gain, bf16* WT, LAS float* scr, int item, int lane, bool o8 = false) {
    const int nblk = Ndst / 32, kb = item / nblk, nb = item % nblk, k0 = 64 * kb, n0 = 32 * nb;
    const int sc = src_col(type, n0 + (lane & 31));
#pragma unroll 8
    for (int i = 0; i < 32; ++i) { const int kk = 2 * i + (lane >> 5); float v = 0.f; if (sc >= 0) v = W[(size_t)(k0 + kk) * Nsrc + sc]; if (gain) v *= gain[k0 + kk]; scr[kk * 33 + (lane & 31)] = v; }
    LDS_WAIT(); asm volatile("" ::: "memory");
    const int c = lane & 7;
#pragma unroll
    for (int j = 0; j < 4; ++j) { const int n = (lane >> 3) + 8 * j; const LAS float* s = scr + (8 * c) * 33 + n;
        if (o8) { v2u o; o.x = pk4f8(s[0 * 33] * W8S, s[1 * 33] * W8S, s[2 * 33] * W8S, s[3 * 33] * W8S); o.y = pk4f8(s[4 * 33] * W8S, s[5 * 33] * W8S, s[6 * 33] * W8S, s[7 * 33] * W8S);
            *(v2u*)((unsigned char*)WT + (size_t)(n0 + n) * K + k0 + 8 * c) = o; }
        else { v4u o; o.x = pk2(s[0 * 33], s[1 * 33]); o.y = pk2(s[2 * 33], s[3 * 33]); o.z = pk2(s[4 * 33], s[5 * 33]); o.w = pk2(s[6 * 33], s[7 * 33]);
            *(v4u*)(WT + (size_t)(n0 + n) * K + k0 + 8 * c) = o; } }
    LDS_WAIT(); asm volatile("" ::: "memory");
}
__device__ __forceinline__ float wave_sum(float v) {
#pragma unroll
    for (int o = 1; o < 64; o <<= 1) v += __shfl_xor(v, o);
    return v;
}
#ifdef F8M_RUNTIME
#define F8MV a.f8m
#else
#define F8MV F8M_ALL
#endif
__device__ __forceinline__ void p0_prologue(Frame& F, const Args& a) {
    LAS float* scr = (LAS float*)(F.lds + RING_OFF + F.wave * 16384);
    const int gw = F.vcu * NWAVES + F.wave, NGW = F.G * NWAVES;
    constexpr int I_INA = 16 * (NA_PAD / 32), I_INB = 16 * (NB / 32), I_OUT = 16 * 32, I_UP = 16 * (NUP / 32), I_DN = (FF / 64) * 32;
    constexpr int NITEMS = 2 * I_INA + 2 * I_INB + 4 * I_OUT + 4 * I_UP + 4 * I_DN;
    unsigned char* ws = a.ws;
    for (int it = gw; it < NITEMS; it += NGW) {
        int r = it;
        if (r < 2 * I_INA) { const int l = r / I_INA; convert_item(a.w_in_a + (size_t)l * DM * NA_SRC, DM, NA_SRC, NA_PAD, 1, a.attn_norm_g + (2 * l) * DM, (bf16*)(ws + WS_W_INA) + (size_t)l * NA_PAD * DM, scr, r % I_INA, F.lane); continue; } r -= 2 * I_INA;
        if (r < 2 * I_INB) { const int l = r / I_INB; convert_item(a.w_in_b + (size_t)l * DM * NB, DM, NB, NB, 2, a.attn_norm_g + (2 * l + 1) * DM, (bf16*)(ws + WS_W_INB) + (size_t)l * NB * DM, scr, r % I_INB, F.lane, f8_in(F8MV, 2 * l + 1)); continue; } r -= 2 * I_INB;
        if (r < 4 * I_OUT) { const int l = r / I_OUT; convert_item(a.w_out + (size_t)l * DM * DM, DM, DM, DM, 0, nullptr, (bf16*)(ws + WS_W_OUT) + (size_t)l * DM * DM, scr, r % I_OUT, F.lane, f8_out(F8MV, l)); continue; } r -= 4 * I_OUT;
        if (r < 4 * I_UP) { const int l = r / I_UP; convert_item(a.w_up + (size_t)l * DM * NUP, DM, NUP, NUP, 3, a.ffn_norm_g + l * DM, (bf16*)(ws + WS_W_UP) + (size_t)l * NUP * DM, scr, r % I_UP, F.lane, f8_ffn(F8MV, l)); continue; } r -= 4 * I_UP;
        { const int l = r / I_DN; convert_item(a.w_down + (size_t)l * FF * DM, FF, DM, DM, 0, nullptr, (bf16*)(ws + WS_W_DN) + (size_t)l * DM * FF, scr, r % I_DN, F.lane, f8_ffn(F8MV, l)); }
    }
    bf16* hb = (bf16*)(ws + WS_HB); float* ss = (float*)(ws + WS_SS);
    for (int m = gw; m < MTOK; m += NGW) {
        const f32x4* xr = (const f32x4*)(a.x + (size_t)m * DM) + F.lane; f32x4 v[4]; float s = 0.f;
#pragma unroll
        for (int j = 0; j < 4; ++j) { v[j] = xr[64 * j]; s += (v[j].x * v[j].x + v[j].y * v[j].y) + (v[j].z * v[j].z + v[j].w * v[j].w); }
        s = wave_sum(s);
        v2u* o8 = (v2u*)(hb + (size_t)m * DM) + F.lane;
#pragma unroll
        for (int j = 0; j < 4; ++j) { v2u w; w.x = pk2(v[j].x, v[j].y); w.y = pk2(v[j].z, v[j].w); o8[64 * j] = w; }
        if (F.lane < 16) ss[(size_t)m * 16 + F.lane] = (F.lane == 0) ? s : 0.f;
    }
}

__device__ __forceinline__ f32x4 rstd_load(const float* ss, int row, int fq) { return *(const f32x4*)(ss + (size_t)row * 16 + 4 * fq); }
__device__ __forceinline__ float rstd_finish(f32x4 a) {
    float s = (a.x + a.y) + (a.z + a.w);
    s += __shfl_xor(s, 16); s += __shfl_xor(s, 32);
    return __builtin_amdgcn_rsqf(s * (1.0f / DM) + EPS);
}
__device__ __forceinline__ float row_rstd(const float* ss, int row, int fq) { return rstd_finish(rstd_load(ss, row, fq)); }
__device__ __forceinline__ unsigned att_pk4(f32x4 v) { int r = __builtin_amdgcn_cvt_pk_fp8_f32(v.x, v.y, 0, false); r = __builtin_amdgcn_cvt_pk_fp8_f32(v.z, v.w, r, true); return (unsigned)r; }
struct EpiIn {
    static constexpr bool PERM = false, PERMA = false, AFTER_DRAIN = false;
    const float* ss; unsigned char* proj; const float* qg; const float* kg; int isB; float as;
    __device__ __forceinline__ void operator()(const pg8::f32x4 (&acc)[2][2][4][2], const pg8::Unit& u, int wr, int wc, int fr, int fq) const {
        asm volatile("" : "+v"(fr), "+v"(fq));
        const int pn = u.pn; int kind, pitch; bf16* dst;
        if (isB) { const int t = pn >> 2; kind = (t == 0) ? 1 : (t == 1 ? 2 : 0); dst = (bf16*)(proj + (size_t)t * PB_STRIDE) + 256 * (pn & 3); pitch = DM; }
        else if (pn < 4) { kind = 1; dst = (bf16*)(proj + PA_QA) + 256 * pn; pitch = DM; }
        else if (pn == 4) { kind = 2; dst = (bf16*)(proj + PA_KA); pitch = 256; }
        else if (pn == 5) { kind = 0; dst = (bf16*)(proj + PA_VA); pitch = 256; }
        else if (pn < 8) { kind = 0; dst = (bf16*)(proj + PA_QI) + 256 * (pn - 6); pitch = 512; }
        else { kind = 3; dst = (bf16*)(proj + PA_KI); pitch = 64; }
        if (kind == 3 && wc >= 2) return;
        const bool donorm = (kind == 1) || (kind == 2) || (kind == 3 && wc == 0);
        f32x4 g[2][2];
#pragma unroll
        for (int bj = 0; bj < 2; ++bj)
#pragma unroll
            for (int n = 0; n < 2; ++n) {
                if (kind == 1) g[bj][n] = *(const f32x4*)(qg + 16 * fq + 8 * bj + 4 * n) * (isB ? C2 : 1.0f);
                else if (kind == 2) g[bj][n] = *(const f32x4*)(kg + 16 * fq + 8 * bj + 4 * n);
                else g[bj][n] = (f32x4){1.f, 1.f, 1.f, 1.f};
            }
        float* wi = (float*)(proj + PA_WI);
        f32x4 rsl[2][4];
#pragma unroll
        for (int ai = 0; ai < 2; ++ai)
#pragma unroll
            for (int m = 0; m < 4; ++m) rsl[ai][m] = rstd_load(ss, u.pm * 256 + ai * 128 + wr * 64 + m * 16 + fr, fq);
#pragma unroll
        for (int ai = 0; ai < 2; ++ai)
#pragma unroll
            for (int m = 0; m < 4; ++m) {
                const int row = u.pm * 256 + ai * 128 + wr * 64 + m * 16 + fr;
                const float rs = rstd_finish(rsl[ai][m]) * as;
                f32x4 v[2][2]; float s = 0.f;
#pragma unroll
                for (int bj = 0; bj < 2; ++bj)
#pragma unroll
                    for (int n = 0; n < 2; ++n) { v[bj][n] = acc[ai][bj][m][n] * rs; const f32x4 q = v[bj][n] * v[bj][n]; s += (q.x + q.y) + (q.z + q.w); }
                if (donorm) {
                    s += __shfl_xor(s, 16); s += __shfl_xor(s, 32);
                    const float r = 1.0f / sqrtf(s * (1.0f / 64.0f) + EPS);
#pragma unroll
                    for (int bj = 0; bj < 2; ++bj)
#pragma unroll
                        for (int n = 0; n < 2; ++n) v[bj][n] = v[bj][n] * r * g[bj][n];
                }
                if (kind == 3 && wc == 1) {
                    if (fq == 0) { float* wp = wi + (size_t)row * 8; const float sc = 0.04419417382415922f;
                        *(f32x4*)(wp) = v[0][0] * sc; *(f32x4*)(wp + 4) = v[0][1] * sc; }
                } else if (!isB && pn < 6) {
                    unsigned char* p8 = (pn < 4) ? proj + PA_QA + (size_t)row * 1024 + 256 * pn + 64 * wc + 16 * fq : proj + PA_KA + (size_t)row * 512 + 128 * wc + 64 * (pn - 4) + 16 * fq;
                    v4u w; w.x = att_pk4(v[0][0]); w.y = att_pk4(v[0][1]); w.z = att_pk4(v[1][0]); w.w = att_pk4(v[1][1]);
                    *(v4u*)p8 = w;
                } else {
                    bf16* rp = dst + (size_t)row * pitch + 64 * wc + 16 * fq;
#pragma unroll
                    for (int bj = 0; bj < 2; ++bj) { v4u w; w.x = cvtpk(v[bj][0].x, v[bj][0].y); w.y = cvtpk(v[bj][0].z, v[bj][0].w); w.z = cvtpk(v[bj][1].x, v[bj][1].y); w.w = cvtpk(v[bj][1].z, v[bj][1].w);
                        *(v4u*)(rp + 8 * bj) = w; }
                }
            }
    }
};
template <int MODE>
struct EpiResT {
    static constexpr bool PERM = false, PERMA = false, AFTER_DRAIN = false;
    float* fout; const bf16* hbi; bf16* hb; float* ss; unsigned char* hb8; const float* xin;
    __device__ __forceinline__ void operator()(const pg8::f32x4 (&acc)[2][2][4][2], const pg8::Unit& u, int wr, int wc, int fr, int fq) const {
        if (fout) body<true, false, false>(acc, u, wr, wc, fr, fq); else if (hb8) body<false, true, false>(acc, u, wr, wc, fr, fq); else if (xin) body<false, false, true>(acc, u, wr, wc, fr, fq); else body<false, false, false>(acc, u, wr, wc, fr, fq);
    }
    template <bool FOUT, bool HB8, bool XIN>
    __device__ __forceinline__ void body(const pg8::f32x4 (&acc)[2][2][4][2], const pg8::Unit& u, int wr, int wc, int fr, int fq) const {
        asm volatile("" : "+v"(fr), "+v"(fq));
        const int col0 = u.pn * 256 + wc * 32 + 4 * fq;
#pragma unroll
        for (int ai = 0; ai < 2; ++ai) {
            v2u base[4][2][2]; f32x4 basex[XIN ? 4 : 1][2][2];
#pragma unroll
            for (int m = 0; m < 4; ++m)
#pragma unroll
                for (int bj = 0; bj < 2; ++bj)
#pragma unroll
                    for (int n = 0; n < 2; ++n) { const size_t o4 = (size_t)(u.pm * 256 + ai * 128 + wr * 64 + m * 16 + fr) * DM + col0 + bj * 128 + n * 16; if constexpr (XIN) basex[m][bj][n] = *(const f32x4*)(xin + o4); else base[m][bj][n] = *(const v2u*)(hbi + o4);
                        if ((MODE & 4) && n == 1) asm volatile("s_waitcnt vmcnt(0)" ::: "memory"); }
            asm volatile("" ::: "memory");
#pragma unroll
            for (int m = 0; m < 4; ++m) {
                const int row = u.pm * 256 + ai * 128 + wr * 64 + m * 16 + fr; const size_t off = (size_t)row * DM + col0; float s = 0.f;
#pragma unroll
                for (int bj = 0; bj < 2; ++bj)
#pragma unroll
                    for (int n = 0; n < 2; ++n) { const size_t o4 = off + bj * 128 + n * 16;
                        f32x4 bs; if constexpr (XIN) bs = basex[m][bj][n]; else { const v2u b = base[m][bj][n]; bs = (f32x4){bf_lo(b.x), bf_hi(b.x), bf_lo(b.y), bf_hi(b.y)}; }
                        const f32x4 o = (MODE & 1) ? bs + acc[ai][bj][m][n] * W8I : bs + acc[ai][bj][m][n];
                        if constexpr (FOUT) *(f32x4*)(fout + o4) = o;
                        else { const f32x4 q = o * o; s += (q.x + q.y) + (q.z + q.w); v2u w; w.x = cvtpk(o.x, o.y); w.y = cvtpk(o.z, o.w); *(v2u*)(hb + o4) = w;
                            if constexpr (HB8) *(unsigned*)(hb8 + o4) = pk4f8(o.x, o.y, o.z, o.w); } }
                if constexpr (!FOUT) { s += __shfl_xor(s, 16); s += __shfl_xor(s, 32); if (fq == 0) ss[(size_t)row * 16 + u.pn * 4 + wc] = s; }
            }
        }
    }
};
typedef EpiResT<0> EpiRes;
#ifndef SER_OUT
#define SER_OUT 0
#endif
#ifdef X_NOBPERM
__device__ __forceinline__ float lane_from(int byteaddr, float v) { return v + (float)byteaddr; }
#else
__device__ __forceinline__ float lane_from(int byteaddr, float v) { return __builtin_bit_cast(float, __builtin_amdgcn_ds_bpermute(byteaddr, __builtin_bit_cast(int, v))); }
#endif
#ifdef X_NOSILU
__device__ __forceinline__ float silu_mul(float a, float g) { return a * g; }
#else
__device__ __forceinline__ float silu_mul(float a, float g) { return a * g * __builtin_amdgcn_rcpf(1.0f + __builtin_amdgcn_exp2f(-g * LOG2E)); }
#endif
__device__ __forceinline__ float dpp_prev_lane(float v) { return __builtin_bit_cast(float, __builtin_amdgcn_update_dpp(0, __builtin_bit_cast(int, v), 0x111  , 0xf, 0xf, true)); }
template <bool F8>
struct EpiUpT {
    static constexpr bool PERM = false, PERMA = true, AFTER_DRAIN = false;
    const float* ss; const float* cw; const float* cb; bf16* act; float* halo; LAS float* cl;
    __device__ __forceinline__ void operator()(const pg8::f32x4 (&acc)[2][2][4][2], const pg8::Unit& u, int wr, int wc, int fr, int fq) const {
        asm volatile("" : "+v"(fr), "+v"(fq));
        const int colb = u.pn * 128 + wc * 32 + 8 * fq;
        const int tid_ = ((wr * 4 + wc) * 4 + fq) * 16 + fr, ce = 2 * tid_, cbj = ce >> 9, carr = (ce >> 7) & 3, cc = ce & 127;
        const f32x2_t cpre = *(const f32x2_t*)((carr < 3 ? cw + carr * NUP : cb) + cbj * FF + u.pn * 128 + cc);
        f32x4 rsl[2][4];
#pragma unroll
        for (int ai = 0; ai < 2; ++ai)
#pragma unroll
            for (int m = 0; m < 4; ++m) rsl[ai][m] = rstd_load(ss, (u.pm * 4 + ai * 2 + wr) * 64 + 4 * fr + m, fq);
        unsigned pk[2][2][4][2][2];
#pragma unroll
        for (int ai = 0; ai < 2; ++ai) {
#pragma unroll
            for (int m = 0; m < 4; ++m) {
                const float rs = F8 ? rstd_finish(rsl[ai][m]) * W8I : rstd_finish(rsl[ai][m]);
#pragma unroll
                for (int bj = 0; bj < 2; ++bj)
#pragma unroll
                    for (int n = 0; n < 2; ++n) { const f32x4 v = acc[ai][bj][m][n] * rs; pk[ai][bj][m][n][0] = cvtpk(v.x, v.y); pk[ai][bj][m][n][1] = cvtpk(v.z, v.w); }
            }
        }
        *(LAS f32x2_t*)(cl + ce) = cpre;
        asm volatile("s_waitcnt lgkmcnt(0)" ::: "memory"); __builtin_amdgcn_s_barrier(); asm volatile("" ::: "memory");
        __builtin_amdgcn_sched_barrier(0);
        if (fr == 0 || fr == 15) {
#pragma unroll
            for (int ai = 0; ai < 2; ++ai)
#pragma unroll
                for (int j = 0; j < 2; ++j)
#pragma unroll
                    for (int bj = 0; bj < 2; ++bj)
#pragma unroll
                        for (int n = 0; n < 2; ++n) { const unsigned w0 = (fr == 0) ? pk[ai][bj][j][n][0] : pk[ai][bj][2 + j][n][0], w1 = (fr == 0) ? pk[ai][bj][j][n][1] : pk[ai][bj][2 + j][n][1];
                            *(f32x4*)(halo + ((size_t)(u.pm * 4 + ai * 2 + wr) * 4 + (fr == 0 ? j : 2 + j)) * NUP + bj * FF + colb + 4 * n) = (f32x4){bf_lo(w0), bf_hi(w0), bf_lo(w1), bf_hi(w1)}; }
        }
        __builtin_amdgcn_sched_barrier(0);
#pragma unroll
        for (int ai = 0; ai < 2; ++ai) {
            const int row0 = (u.pm * 4 + ai * 2 + wr) * 64 + 4 * fr;
            unsigned outp[4][2][2];
#pragma unroll
            for (int n = 0; n < 2; ++n) {
#pragma unroll
                for (int ip = 0; ip < 2; ++ip) {
                    f32x2_t k0[2], k1[2], k2[2], kb[2];
#pragma unroll
                    for (int bj = 0; bj < 2; ++bj) { const LAS float* c = cl + bj * 512 + wc * 32 + 8 * fq + 4 * n + 2 * ip; k0[bj] = *(const LAS f32x2_t*)(c); k1[bj] = *(const LAS f32x2_t*)(c + 128); k2[bj] = *(const LAS f32x2_t*)(c + 256); kb[bj] = *(const LAS f32x2_t*)(c + 384); }
                    float y[2][4][2];
#pragma unroll
                    for (int bj = 0; bj < 2; ++bj) {
                        const unsigned w0 = pk[ai][bj][0][n][ip], w1 = pk[ai][bj][1][n][ip], w2 = pk[ai][bj][2][n][ip], w3 = pk[ai][bj][3][n][ip];
                        const unsigned q1 = (unsigned)__builtin_amdgcn_update_dpp(0, (int)w3, 0x111, 0xf, 0xf, true), q2 = (unsigned)__builtin_amdgcn_update_dpp(0, (int)w2, 0x111, 0xf, 0xf, true);
#pragma unroll
                        for (int e = 0; e < 2; ++e) { const int i = e;
                            const float u0 = e ? bf_hi(w0) : bf_lo(w0), u1 = e ? bf_hi(w1) : bf_lo(w1), u2 = e ? bf_hi(w2) : bf_lo(w2), u3 = e ? bf_hi(w3) : bf_lo(w3), p1 = e ? bf_hi(q1) : bf_lo(q1), p2 = e ? bf_hi(q2) : bf_lo(q2);
                            y[bj][0][e] = kb[bj][i] + k0[bj][i] * p2 + k1[bj][i] * p1 + k2[bj][i] * u0;
                            y[bj][1][e] = kb[bj][i] + k0[bj][i] * p1 + k1[bj][i] * u0 + k2[bj][i] * u1;
                            y[bj][2][e] = kb[bj][i] + k0[bj][i] * u0 + k1[bj][i] * u1 + k2[bj][i] * u2;
                            y[bj][3][e] = kb[bj][i] + k0[bj][i] * u1 + k1[bj][i] * u2 + k2[bj][i] * u3; }
                    }
#pragma unroll
                    for (int m = 0; m < 4; ++m) {
                        if constexpr (F8) { if (ip == 0) outp[m][n][0] = (unsigned)__builtin_amdgcn_cvt_pk_fp8_f32(silu_mul(y[0][m][0], y[1][m][0]), silu_mul(y[0][m][1], y[1][m][1]), 0, false);
                            else outp[m][n][0] = (unsigned)__builtin_amdgcn_cvt_pk_fp8_f32(silu_mul(y[0][m][0], y[1][m][0]), silu_mul(y[0][m][1], y[1][m][1]), (int)outp[m][n][0], true); }
                        else outp[m][n][ip] = cvtpk(silu_mul(y[0][m][0], y[1][m][0]), silu_mul(y[0][m][1], y[1][m][1])); }
                }
            }
#pragma unroll
            for (int m = 0; m < 4; ++m) {
                if (m < 2 && fr == 0) continue;
                if constexpr (F8) { v2u w; w.x = outp[m][0][0]; w.y = outp[m][1][0]; *(v2u*)((unsigned char*)act + (size_t)(row0 + m) * FF + colb) = w; }
                else { v4u w; w.x = outp[m][0][0]; w.y = outp[m][0][1]; w.z = outp[m][1][0]; w.w = outp[m][1][1];
                    *(v4u*)(act + (size_t)(row0 + m) * FF + colb) = w; }
            }
            asm volatile("" ::: "memory");
        }
    }
};
typedef EpiUpT<false> EpiUp;
struct EpiDummy {
    static constexpr bool PERM = false, PERMA = true, AFTER_DRAIN = false;
    float* scratch;
    __device__ __forceinline__ void operator()(const pg8::f32x4 (&acc)[2][2][4][2], const pg8::Unit& u, int wr, int wc, int fr, int fq) const {
        f32x4 s = (f32x4){0.f, 0.f, 0.f, 0.f};
#pragma unroll
        for (int ai = 0; ai < 2; ++ai)
#pragma unroll
            for (int bj = 0; bj < 2; ++bj)
#pragma unroll
                for (int m = 0; m < 4; ++m)
#pragma unroll
                    for (int n = 0; n < 2; ++n) s += acc[ai][bj][m][n];
        scratch[(size_t)(u.pm * 22 + u.pn) * 512 + ((wr * 4 + wc) * 4 + fq) * 16 + fr] = (s.x + s.y) + (s.z + s.w);
    }
};
template <bool F8>
__device__ __forceinline__ void fixup_phase(Frame& F, const float* cw, const float* cb, const float* halo, bf16* act) {
    const int gt = F.vcu * (NWAVES * 64) + F.tid, NT = F.G * NWAVES * 64;
    constexpr int C4 = FF / 4;
    for (int it = gt; it < NBLK64 * 2 * C4; it += NT) {
        const int c = (it % C4) * 4, rj = it / C4, j = rj & 1, blk = rj >> 1, t = blk * 64 + j, tb = t % SEQ;
        f32x4 y[2];
#pragma unroll
        for (int bj = 0; bj < 2; ++bj) {
            const int cc = bj * FF + c;
            const f32x4 z = (f32x4){0.f, 0.f, 0.f, 0.f};
            const f32x4 ut = *(const f32x4*)(halo + ((size_t)blk * 4 + j) * NUP + cc);
            f32x4 u1, u2;
            if (j == 1) { u1 = *(const f32x4*)(halo + ((size_t)blk * 4 + 0) * NUP + cc); u2 = (tb == 1) ? z : *(const f32x4*)(halo + ((size_t)(blk - 1) * 4 + 3) * NUP + cc); }
            else { u1 = (tb == 0) ? z : *(const f32x4*)(halo + ((size_t)(blk - 1) * 4 + 3) * NUP + cc); u2 = (tb == 0) ? z : *(const f32x4*)(halo + ((size_t)(blk - 1) * 4 + 2) * NUP + cc); }
            y[bj] = *(const f32x4*)(cb + cc) + *(const f32x4*)(cw + cc) * u2 + *(const f32x4*)(cw + NUP + cc) * u1 + *(const f32x4*)(cw + 2 * NUP + cc) * ut;
        }
        if constexpr (F8) *(unsigned*)((unsigned char*)act + (size_t)t * FF + c) = pk4f8(silu_mul(y[0].x, y[1].x), silu_mul(y[0].y, y[1].y), silu_mul(y[0].z, y[1].z), silu_mul(y[0].w, y[1].w));
        else { v2u w; w.x = cvtpk(silu_mul(y[0].x, y[1].x), silu_mul(y[0].y, y[1].y)); w.y = cvtpk(silu_mul(y[0].z, y[1].z), silu_mul(y[0].w, y[1].w));
            *(v2u*)(act + (size_t)t * FF + c) = w; }
    }
}

__device__ __forceinline__ int crow(int r, int hi) { return (r & 3) + 8 * (r >> 2) + 4 * hi; }
__device__ __forceinline__ void glds16(const void* gsrc, unsigned lds_dst) { unsigned keep;
    asm volatile("s_mov_b32 %0, m0\n\ts_mov_b32 m0, %2\n\ts_nop 0\n\tglobal_load_lds_dwordx4 %1, off\n\ts_mov_b32 m0, %0" : "=&s"(keep) : "v"(gsrc), "s"(lds_dst) : "memory"); }
__device__ __forceinline__ float max3f(float a, float b, float c) { return fmaxf(fmaxf(a, b), c); }

namespace band {
constexpr int SLOTB = 8192;
constexpr int LDS_K = 0, LDS_V = 2 * SLOTB, LDS_WS = 4 * SLOTB, LDS_TB = LDS_WS + NWAVES * 64 * 4, LDS_OST = LDS_TB + 640 * 4 + 512, LDS_END = LDS_OST + NWAVES * 4096;
static_assert(LDS_END <= RING_BYTES, "band LDS");
__device__ __forceinline__ void unit(Frame& F, int b, int h, int U, const bf16* Q, const bf16* K, const bf16* V, bf16* O, const float* rel, const bool o8) {
    const int tid = F.tid, lane = F.lane, r32 = lane & 31, hi = lane >> 5, wid = F.wave;
    LAS unsigned char* shm = F.lds + RING_OFF;
    const unsigned lds0 = (unsigned)(uintptr_t)shm;
    const long rowbase = (long)b * SEQ; const int q0 = U * 256, c0 = 4 * U, cq = c0 + (wid >> 1);
    const bf16* Qw = Q + (rowbase + q0 + wid * 32) * DM + h * 64;
    const bf16* Kh = K + rowbase * DM + h * 64; const bf16* Vh = V + rowbase * DM + h * 64;
    LAS float* wsf = (LAS float*)(shm + LDS_WS) + wid * 64;
    LAS float* tb = (LAS float*)(shm + LDS_TB);
    const bf16* ksrc = Kh + (long)lane * DM + wid * 8;
    const bf16* vsrc = Vh + (long)(16 * (wid & 3) + (lane >> 2)) * DM + (wid >> 2) * 32 + (lane & 3) * 8;
    const unsigned kdst = lds0 + LDS_K + wid * 1024, vdst = lds0 + LDS_V + wid * 1024;
    const int lo = (c0 - 8 > 0) ? c0 - 8 : 0, hiT = c0 + 3, NT = hiT - lo + 1, t0 = (c0 - 5 > 0) ? c0 - 5 : 0;
#define BAND_KT(i) ((t0 + (i) <= hiT) ? t0 + (i) : lo + (t0 + (i) - hiT - 1))
    for (int i = tid; i < 640; i += NWAVES * 64) { int d = i - 64; d = d < -256 ? -256 : (d > 256 ? 256 : d); tb[i] = rel[(d + 256) * 16 + h] * LOG2E; }
    { const int kt = BAND_KT(0); glds16(ksrc + (long)kt * 64 * DM, (unsigned)__builtin_amdgcn_readfirstlane(kdst)); glds16(vsrc + (long)kt * 64 * DM, (unsigned)__builtin_amdgcn_readfirstlane(vdst)); }
    bf16x8 qr[4];
#pragma unroll
    for (int d0 = 0; d0 < 4; ++d0) qr[d0] = *(const bf16x8*)(Qw + (long)r32 * DM + d0 * 16 + hi * 8);
    float m_run = -INFINITY, l_run = 0.f; f32x16 o[2]; o[0] = f32x16{}; o[1] = f32x16{};
    const int qpos = q0 + wid * 32 + r32;
    const LAS unsigned char* vbase = shm + LDS_V + ((lane >> 4) & 1) * 32 + (lane & 3) * 8 + (4 * hi + ((lane & 15) >> 2)) * 64;
    for (int i = 0; i < NT; ++i) { LA_B;
        asm volatile("s_waitcnt vmcnt(0) lgkmcnt(0)\n\ts_barrier" ::: "memory");
        if (i + 1 < NT) { const int kt = BAND_KT(i + 1); const unsigned so = ((i + 1) & 1) * SLOTB;
            glds16(ksrc + (long)kt * 64 * DM, (unsigned)__builtin_amdgcn_readfirstlane(kdst + so)); glds16(vsrc + (long)kt * 64 * DM, (unsigned)__builtin_amdgcn_readfirstlane(vdst + so)); }
        const int kt = BAND_KT(i);
        if (kt < cq - 8 || kt > cq) continue;
        const int so = (i & 1) * SLOTB;
        f32x16 p0 = f32x16{}, p1 = f32x16{};
        { const LAS unsigned char* kb = shm + LDS_K + so + hi * 1024 + r32 * 16;
#pragma unroll
          for (int d0 = 0; d0 < 4; ++d0) { const bf16x8 b0 = *(const LAS bf16x8*)(kb + d0 * 2048), b1 = *(const LAS bf16x8*)(kb + d0 * 2048 + 512);
              p0 = __builtin_amdgcn_mfma_f32_32x32x16_bf16(b0, qr[d0], p0, 0, 0, 0); p1 = __builtin_amdgcn_mfma_f32_32x32x16_bf16(b1, qr[d0], p1, 0, 0, 0); } }
        if (kt + 5 <= cq) { const float cbias = tb[639];
#pragma unroll
          for (int r = 0; r < 16; ++r) { p0[r] += cbias; p1[r] += cbias; } }
        else { const int ib = qpos - 64 * kt + 64 - 4 * hi;
#pragma unroll
          for (int r = 0; r < 16; ++r) { const int ix = ib - ((r & 3) + 8 * (r >> 2)); p0[r] += tb[ix]; p1[r] += tb[ix - 32]; } }
        float rm = p0[0];
#pragma unroll
        for (int r = 0; r < 16; ++r) rm = max3f(rm, p0[r], p1[r]);
        { auto rr = __builtin_amdgcn_permlane32_swap(__float_as_uint(rm), __float_as_uint(rm), false, false); rm = fmaxf(__uint_as_float(rr[0]), __uint_as_float(rr[1])); }
        const float mnew = fmaxf(m_run, rm), f = __builtin_amdgcn_exp2f(m_run - mnew); m_run = mnew;
        float sacc = 0.f;
#pragma unroll
        for (int r = 0; r < 16; ++r) { p0[r] = __builtin_amdgcn_exp2f(p0[r] - mnew); p1[r] = __builtin_amdgcn_exp2f(p1[r] - mnew); sacc += p0[r] + p1[r]; }
        l_run = l_run * f + sacc;
        if (!__all(f == 1.0f)) {
            if (hi == 0) wsf[r32] = f;
            LDS_WAIT();
#pragma unroll
            for (int r = 0; r < 16; ++r) { const float fr_ = wsf[crow(r, hi)]; o[0][r] *= fr_; o[1][r] *= fr_; }
        }
        v4u pw[4];
        pw[0] = (v4u){cvtpk(p0[0], p0[1]), cvtpk(p0[2], p0[3]), cvtpk(p0[4], p0[5]), cvtpk(p0[6], p0[7])};
        pw[1] = (v4u){cvtpk(p0[8], p0[9]), cvtpk(p0[10], p0[11]), cvtpk(p0[12], p0[13]), cvtpk(p0[14], p0[15])};
        pw[2] = (v4u){cvtpk(p1[0], p1[1]), cvtpk(p1[2], p1[3]), cvtpk(p1[4], p1[5]), cvtpk(p1[6], p1[7])};
        pw[3] = (v4u){cvtpk(p1[8], p1[9]), cvtpk(p1[10], p1[11]), cvtpk(p1[12], p1[13]), cvtpk(p1[14], p1[15])};
        const LAS unsigned char* vb = vbase + so;
#pragma unroll
        for (int d0 = 0; d0 < 2; ++d0)
#pragma unroll
            for (int ks = 0; ks < 4; ++ks) {
                const s16x4 vlo = __builtin_bit_cast(s16x4, __builtin_amdgcn_ds_read_tr16_b64_v4i16((LAS s16x4*)(vb + d0 * 4096 + ks * 1024)));
                const s16x4 vhi = __builtin_bit_cast(s16x4, __builtin_amdgcn_ds_read_tr16_b64_v4i16((LAS s16x4*)(vb + d0 * 4096 + ks * 1024 + 512)));
                const bf16x8 vf = (bf16x8){vlo[0], vlo[1], vlo[2], vlo[3], vhi[0], vhi[1], vhi[2], vhi[3]};
                o[d0] = __builtin_amdgcn_mfma_f32_32x32x16_bf16(__builtin_bit_cast(bf16x8, pw[ks]), vf, o[d0], 0, 0, 0);
            }
    }
#undef BAND_KT
    { auto rr = __builtin_amdgcn_permlane32_swap(__float_as_uint(l_run), __float_as_uint(l_run), false, false); l_run = __uint_as_float(rr[0]) + __uint_as_float(rr[1]); }
    if (hi == 0) wsf[32 + r32] = l_run;
    LDS_WAIT();
    float rli[16];
#pragma unroll
    for (int r = 0; r < 16; ++r) rli[r] = __builtin_amdgcn_rcpf(wsf[32 + crow(r, hi)]);
    bf16* Ow = O + (rowbase + q0 + wid * 32) * DM + h * 64;
    { LAS bf16* stg = (LAS bf16*)(shm + LDS_OST) + wid * 2048;
#pragma unroll
      for (int r = 0; r < 16; ++r) { const int orow = crow(r, hi);
#pragma unroll
          for (int d0 = 0; d0 < 2; ++d0) stg[orow * 64 + d0 * 32 + r32] = (bf16)f2bf(o[d0][r] * rli[r]); }
      LDS_WAIT();
#pragma unroll
      for (int i = 0; i < 4; ++i) { const int row = i * 8 + (lane >> 3), ch = lane & 7; const v4u v = *(const LAS v4u*)(stg + row * 64 + ch * 8);
          if (o8) { v2u w; w.x = pk4f8(bf_lo(v.x), bf_hi(v.x), bf_lo(v.y), bf_hi(v.y)); w.y = pk4f8(bf_lo(v.z), bf_hi(v.z), bf_lo(v.w), bf_hi(v.w));
              *(v2u*)((unsigned char*)O + (rowbase + q0 + wid * 32 + row) * DM + h * 64 + ch * 8) = w; }
          else *(v4u*)(Ow + (long)row * DM + ch * 8) = v; } }
    asm volatile("s_waitcnt lgkmcnt(0)\n\ts_barrier" ::: "memory");
}
__device__ __forceinline__ void phase(Frame& F, const bf16* Q, const bf16* K, const bf16* V, bf16* O, const float* rel, const bool o8) {
    const int NU = BATCH * 16 * 32, per = (NU + F.G - 1) / F.G;
    for (int i = 0; i < per; ++i) { const int uid = F.vcu * per + i; if (uid >= NU) break; unit(F, uid >> 9, (uid >> 5) & 15, uid & 31, Q, K, V, O, rel, o8); }
}
}

namespace dsa {
__device__ __forceinline__ unsigned okey(float s) { const unsigned u = __float_as_uint(s + 0.0f); return (u & 0x80000000u) ? ~u : (u | 0x80000000u); }
struct Ctx { const bf16* QA; const bf16* KA; const bf16* VA; const bf16* QI; const bf16* KI; const float* WI; bf16* M; const LAS float* t5l; unsigned short* SEL; };

__device__ __forceinline__ void scan_hist(const LAS unsigned* hq, int lane, unsigned need, unsigned& bin, unsigned& above) {
    const LAS v4u* hp = (const LAS v4u*)hq + lane * 4;
    unsigned wds[16];
#pragma unroll
    for (int j = 0; j < 4; ++j) { const v4u t = hp[j]; wds[4 * j] = t.x; wds[4 * j + 1] = t.y; wds[4 * j + 2] = t.z; wds[4 * j + 3] = t.w; }
    unsigned tl = 0;
#pragma unroll
    for (int j = 0; j < 16; ++j) tl += (wds[j] & 0xffffu) + (wds[j] >> 16);
    unsigned suf = tl;
#pragma unroll
    for (int o = 1; o < 64; o <<= 1) { const unsigned v = __shfl_down(suf, o); if (lane + o < 64) suf += v; }
    const unsigned S = suf - tl;
    const bool cross = (S < need) && (need <= S + tl);
    unsigned c = S, bsel = 0, ab = 0; bool found = false;
#pragma unroll
    for (int k = 31; k >= 0; --k) { const unsigned cnt = (wds[k >> 1] >> (16 * (k & 1))) & 0xffffu; if (!found && c + cnt >= need) { bsel = 32 * lane + k; ab = c; found = true; } c += cnt; }
    const unsigned long long bal = __ballot(cross);
    const int src = bal ? __builtin_ctzll(bal) : 0;
    bin = __shfl(bsel, src); above = __shfl(ab, src);
}

__device__ __forceinline__ void attend(const Ctx& C, const LAS unsigned short* sq, int nvalid, long rowbase, long token, int tpos, int lane, int g0) {
    asm volatile("" : "+v"(lane));
    const int l15 = lane & 15, l4 = lane >> 4;
    int sidx[16];
#pragma unroll
    for (int ti = 0; ti < 16; ++ti) sidx[ti] = sq[ti * 16 + l15];
    unsigned bpk[4] = {0u, 0u, 0u, 0u};
#pragma unroll
    for (int ti = 0; ti < 16; ++ti) { const int rel = sidx[ti] - tpos, n = rel < 0 ? -rel : rel;
        const int bk = (rel > 0 ? 16 : 0) + (n < 8 ? n : 8 + (n >= 12) + (n >= 16) + (n >= 23) + (n >= 32) + (n >= 46) + (n >= 64) + (n >= 91));
        bpk[ti >> 2] |= (unsigned)bk << (8 * (ti & 3)); }
#pragma unroll 1
    for (int g = g0; g < g0 + 2; ++g) {
        const bf16* qp = C.QA + token * DM + (4 * g + (lane & 3)) * 64 + 8 * l4;
        const bf16x8 qf0 = *(const bf16x8*)qp, qf1 = *(const bf16x8*)(qp + 32);
        const bf16* kbase = C.KA + rowbase * 256 + g * 64 + 8 * l4;
        f32x4 S[16];
#pragma unroll
        for (int hh = 0; hh < 4; ++hh) {
            bf16x8 kf0[4], kf1[4];
#pragma unroll
            for (int j = 0; j < 4; ++j) { const bf16* kp = kbase + (long)sidx[hh * 4 + j] * 256; kf0[j] = *(const bf16x8*)kp; kf1[j] = *(const bf16x8*)(kp + 32); }
#pragma unroll
            for (int j = 0; j < 4; ++j) { const int ti = hh * 4 + j;
                f32x4 a = *(const LAS f32x4*)(C.t5l + ((bpk[hh] >> (8 * j)) & 255u) * 16 + 4 * g);
                asm volatile("v_mfma_f32_16x16x32_bf16 %0, %1, %2, %0" : "+v"(a) : "v"(qf0), "v"(kf0[j]));
                asm volatile("v_mfma_f32_16x16x32_bf16 %0, %1, %2, %0" : "+v"(a) : "v"(qf1), "v"(kf1[j]));
                S[ti] = a; }
            asm volatile("s_nop 15\n\ts_nop 7" : "+v"(S[hh * 4]), "+v"(S[hh * 4 + 1]), "+v"(S[hh * 4 + 2]), "+v"(S[hh * 4 + 3]));
        }
#pragma unroll
        for (int ti = 0; ti < 16; ++ti) if (ti * 16 >= nvalid) S[ti] = (f32x4){-INFINITY, -INFINITY, -INFINITY, -INFINITY};
        f32x4 mx = S[0];
#pragma unroll
        for (int ti = 1; ti < 16; ++ti) { mx.x = fmaxf(mx.x, S[ti].x); mx.y = fmaxf(mx.y, S[ti].y); mx.z = fmaxf(mx.z, S[ti].z); mx.w = fmaxf(mx.w, S[ti].w); }
#pragma unroll
        for (int o = 1; o < 16; o <<= 1) { mx.x = fmaxf(mx.x, __shfl_xor(mx.x, o)); mx.y = fmaxf(mx.y, __shfl_xor(mx.y, o)); mx.z = fmaxf(mx.z, __shfl_xor(mx.z, o)); mx.w = fmaxf(mx.w, __shfl_xor(mx.w, o)); }
        f32x4 ls = (f32x4){0.f, 0.f, 0.f, 0.f};
        unsigned P01[16], P23[16];
#pragma unroll
        for (int ti = 0; ti < 16; ++ti) { const float e0 = __builtin_amdgcn_exp2f(S[ti].x - mx.x), e1 = __builtin_amdgcn_exp2f(S[ti].y - mx.y), e2 = __builtin_amdgcn_exp2f(S[ti].z - mx.z), e3 = __builtin_amdgcn_exp2f(S[ti].w - mx.w);
            ls += (f32x4){e0, e1, e2, e3}; P01[ti] = cvtpk(e0, e1); P23[ti] = cvtpk(e2, e3); }
#pragma unroll
        for (int o = 1; o < 16; o <<= 1) { ls.x += __shfl_xor(ls.x, o); ls.y += __shfl_xor(ls.y, o); ls.z += __shfl_xor(ls.z, o); ls.w += __shfl_xor(ls.w, o); }
        float o_[4][16];
#pragma unroll
        for (int h = 0; h < 4; ++h)
#pragma unroll
            for (int d = 0; d < 16; ++d) o_[h][d] = 0.f;
        const bf16* vbase = C.VA + rowbase * 256 + g * 64 + 16 * l4;
#pragma unroll
        for (int hh = 0; hh < 4; ++hh) {
            v4u va[4], vb[4];
#pragma unroll
            for (int j = 0; j < 4; ++j) { const v4u* vp = (const v4u*)(vbase + (long)sidx[hh * 4 + j] * 256); va[j] = vp[0]; vb[j] = vp[1]; }
#pragma unroll
            for (int j = 0; j < 4; ++j) { const int ti = hh * 4 + j; const v4u v0 = va[j], v1 = vb[j];
                float vf[16];
                vf[0] = bf_lo(v0.x); vf[1] = bf_hi(v0.x); vf[2] = bf_lo(v0.y); vf[3] = bf_hi(v0.y); vf[4] = bf_lo(v0.z); vf[5] = bf_hi(v0.z); vf[6] = bf_lo(v0.w); vf[7] = bf_hi(v0.w);
                vf[8] = bf_lo(v1.x); vf[9] = bf_hi(v1.x); vf[10] = bf_lo(v1.y); vf[11] = bf_hi(v1.y); vf[12] = bf_lo(v1.z); vf[13] = bf_hi(v1.z); vf[14] = bf_lo(v1.w); vf[15] = bf_hi(v1.w);
                const float p0 = bf_lo(P01[ti]), p1 = bf_hi(P01[ti]), p2 = bf_lo(P23[ti]), p3 = bf_hi(P23[ti]);
#pragma unroll
                for (int d = 0; d < 16; ++d) { o_[0][d] += p0 * vf[d]; o_[1][d] += p1 * vf[d]; o_[2][d] += p2 * vf[d]; o_[3][d] += p3 * vf[d]; } }
        }
        float res[4];
#pragma unroll
        for (int h = 0; h < 4; ++h) {
            float a8[8], a4[4], a2[2];
            const bool b3 = (l15 & 8) != 0, b2 = (l15 & 4) != 0, b1 = (l15 & 2) != 0, b0 = (l15 & 1) != 0;
#pragma unroll
            for (int d = 0; d < 8; ++d) { const float keep = b3 ? o_[h][d + 8] : o_[h][d], send = b3 ? o_[h][d] : o_[h][d + 8]; a8[d] = keep + __shfl_xor(send, 8); }
#pragma unroll
            for (int d = 0; d < 4; ++d) { const float keep = b2 ? a8[d + 4] : a8[d], send = b2 ? a8[d] : a8[d + 4]; a4[d] = keep + __shfl_xor(send, 4); }
#pragma unroll
            for (int d = 0; d < 2; ++d) { const float keep = b1 ? a4[d + 2] : a4[d], send = b1 ? a4[d] : a4[d + 2]; a2[d] = keep + __shfl_xor(send, 2); }
            { const float keep = b0 ? a2[1] : a2[0], send = b0 ? a2[0] : a2[1]; res[h] = keep + __shfl_xor(send, 1); }
        }
        bf16* mp = C.M + token * DM + (4 * g) * 64 + lane;
        mp[0] = (bf16)f2bf(res[0] * __builtin_amdgcn_rcpf(ls.x)); mp[64] = (bf16)f2bf(res[1] * __builtin_amdgcn_rcpf(ls.y)); mp[128] = (bf16)f2bf(res[2] * __builtin_amdgcn_rcpf(ls.z)); mp[192] = (bf16)f2bf(res[3] * __builtin_amdgcn_rcpf(ls.w));
    }
}

constexpr int CAND_CAP = 256;
constexpr int SELKS_OFF = KS_OFF;
__device__ __forceinline__ float relu_i(float x) { const int i = __builtin_bit_cast(int, x); return __builtin_bit_cast(float, i > 0 ? i : 0); }
struct SelState { unsigned pre[4], need[4], cnt[4], tcnt[4]; };
__device__ __forceinline__ void tile_mfma(f32x16 (&acc)[2], const LAS unsigned char* kf, const int (&koff)[4], const bf16x8 (&qa)[4]) {
#pragma unroll
    for (int h2 = 0; h2 < 2; ++h2) { acc[h2] = f32x16{};
#pragma unroll
        for (int ks = 0; ks < 4; ++ks) { const bf16x8 kb = *(const LAS bf16x8*)(kf + koff[ks] + h2 * 4096); acc[h2] = __builtin_amdgcn_mfma_f32_32x32x16_bf16(qa[ks], kb, acc[h2], 0, 0, 0); } }
}
template <class ActionT>
__device__ __forceinline__ void tile_valu(const f32x16 (&acc)[2], const f32x2_t (&wp)[2][4], int kbase, ActionT&& act) {
#pragma unroll
    for (int h2 = 0; h2 < 2; ++h2) {
        f32x2_t sa = {0.f, 0.f}, sb = {0.f, 0.f};
#pragma unroll
        for (int jp = 0; jp < 4; ++jp) {
            const f32x2_t ra = {relu_i(acc[h2][2 * jp]), relu_i(acc[h2][2 * jp + 1])};
            const f32x2_t rb = {relu_i(acc[h2][8 + 2 * jp]), relu_i(acc[h2][8 + 2 * jp + 1])};
            sa = __builtin_elementwise_fma(ra, wp[0][jp], sa); sb = __builtin_elementwise_fma(rb, wp[1][jp], sb); }
        act(kbase + h2 * 32, (sa.x + sa.y) + 0.0f, (sb.x + sb.y) + 0.0f);
    }
}
constexpr int KSLOTS = 3;
__device__ __forceinline__ void wait_tile(int newer) {
    if (newer >= 4) asm volatile("s_waitcnt vmcnt(4) lgkmcnt(0)\n\ts_barrier" ::: "memory");
    else if (newer == 3) asm volatile("s_waitcnt vmcnt(3) lgkmcnt(0)\n\ts_barrier" ::: "memory");
    else if (newer == 2) asm volatile("s_waitcnt vmcnt(2) lgkmcnt(0)\n\ts_barrier" ::: "memory");
    else if (newer == 1) asm volatile("s_waitcnt vmcnt(1) lgkmcnt(0)\n\ts_barrier" ::: "memory");
    else asm volatile("s_waitcnt vmcnt(0) lgkmcnt(0)\n\ts_barrier" ::: "memory");
}
template <class ActionT>
__device__ __forceinline__ void tile_pass(Frame& F, const bf16* ksrc, unsigned kdst, const LAS unsigned char* kfr, const int (&koff)[4], int NT, const bf16x8 (&qa)[4], const f32x2_t (&wp)[2][4], ActionT&& act) {
    asm volatile("s_waitcnt lgkmcnt(0)\n\ts_barrier" ::: "memory");
    const int npre = NT < KSLOTS ? NT : KSLOTS;
    for (int j = 0; j < npre; ++j) glds16(ksrc + (long)j * 4096, (unsigned)__builtin_amdgcn_readfirstlane(kdst + j * 8192));
    wait_tile(npre - 1);
    f32x16 accA[2], accB[2];
    tile_mfma(accA, kfr, koff, qa);
    int sl = 0;
    int kt = 0;
    for (; kt + 2 < NT; kt += 2) { LA_S;
        { const int inflight = (NT - kt - 2) < (KSLOTS - 2) ? (NT - kt - 2) : (KSLOTS - 2); wait_tile(inflight); }
        if (kt + KSLOTS < NT) glds16(ksrc + (long)(kt + KSLOTS) * 4096, (unsigned)__builtin_amdgcn_readfirstlane(kdst + sl * 8192));
        sl = (sl == KSLOTS - 1) ? 0 : sl + 1;
        tile_mfma(accB, kfr + sl * 8192, koff, qa);
        tile_valu(accA, wp, kt * 64, act);
        { const int inflight = (NT - kt - 3) < (KSLOTS - 2) ? (NT - kt - 3) : (KSLOTS - 2); wait_tile(inflight); }
        if (kt + 1 + KSLOTS < NT) glds16(ksrc + (long)(kt + 1 + KSLOTS) * 4096, (unsigned)__builtin_amdgcn_readfirstlane(kdst + sl * 8192));
        sl = (sl == KSLOTS - 1) ? 0 : sl + 1;
        tile_mfma(accA, kfr + sl * 8192, koff, qa);
        tile_valu(accB, wp, (kt + 1) * 64, act);
    }
    if (kt + 1 < NT) {
        wait_tile(0);
        sl = (sl == KSLOTS - 1) ? 0 : sl + 1;
        tile_mfma(accB, kfr + sl * 8192, koff, qa);
        tile_valu(accA, wp, kt * 64, act);
        tile_valu(accB, wp, (kt + 1) * 64, act);
    } else tile_valu(accA, wp, kt * 64, act);
    LDS_WAIT();
}
__device__ __forceinline__ void scan_hist_cnt(const LAS unsigned* hq, int lane, unsigned need, unsigned& bin, unsigned& above, unsigned& bcnt) {
    const LAS v4u* hp = (const LAS v4u*)hq + lane * 2;
    unsigned wds[8];
#pragma unroll
    for (int j = 0; j < 2; ++j) { const v4u t = hp[j]; wds[4 * j] = t.x; wds[4 * j + 1] = t.y; wds[4 * j + 2] = t.z; wds[4 * j + 3] = t.w; }
    unsigned tl = 0;
#pragma unroll
    for (int j = 0; j < 8; ++j) tl += wds[j];
    unsigned suf = tl;
#pragma unroll
    for (int o = 1; o < 64; o <<= 1) { const unsigned v = __shfl_down(suf, o); if (lane + o < 64) suf += v; }
    const unsigned S = suf - tl;
    const bool cross = (S < need) && (need <= S + tl);
    unsigned c = S, bsel = 0, ab = 0, bc = 0; bool found = false;
#pragma unroll
    for (int k = 7; k >= 0; --k) { const unsigned cnt = wds[k]; if (!found && c + cnt >= need) { bsel = 8 * lane + k; ab = c; bc = cnt; found = true; } c += cnt; }
    const unsigned long long bal = __ballot(cross);
    const int src = bal ? __builtin_ctzll(bal) : 0;
    bin = __builtin_amdgcn_readfirstlane(__shfl(bsel, src)); above = __builtin_amdgcn_readfirstlane(__shfl(ab, src)); bcnt = __builtin_amdgcn_readfirstlane(__shfl(bc, src));
}
__device__ __forceinline__ void step(Frame& F, const Ctx& C, int b, int c, int half) {
    int lane_ = F.lane; asm volatile("" : "+v"(lane_));
    const int lane = lane_, r = lane & 31, hi = lane >> 5, wave = F.wave;
    LAS unsigned* hist = (LAS unsigned*)(F.lds + RING_OFF + wave * 16384);
    LAS unsigned short* sel = (LAS unsigned short*)hist;
    LAS unsigned* cand = hist + 2048;
    LAS unsigned* fbflag = (LAS unsigned*)(F.lds + AUX_OFF + 2048);
    const long rowbase = (long)b * SEQ;
    const int tq0 = 64 * c + 32 * half + 4 * wave;
    const int N = 64 * (c + 1), NT = c + 1;
    int nvalid = 256;
    if (N <= 256) {
        nvalid = N;
        for (int j = lane; j < 4 * 256; j += 64) sel[j] = (unsigned short)(((j & 255) < N) ? (j & 255) : 0);
    } else {
        const int aq = 2 * ((r >> 2) & 1) + (r >> 4), ah = 4 * ((r >> 3) & 1) + (r & 3);
        const bf16* qip = C.QI + (rowbase + tq0 + aq) * 512 + ah * 64 + 8 * hi;
        bf16x8 qa[4];
#pragma unroll
        for (int ks = 0; ks < 4; ++ks) qa[ks] = *(const bf16x8*)(qip + 16 * ks);
        f32x2_t wp[2][4];
#pragma unroll
        for (int t = 0; t < 2; ++t) { const float* wq = C.WI + (rowbase + tq0 + 2 * hi + t) * 8; const f32x4 w0 = *(const f32x4*)wq, w1 = *(const f32x4*)(wq + 4);
            wp[t][0] = (f32x2_t){w0.x, w0.y}; wp[t][1] = (f32x2_t){w0.z, w0.w}; wp[t][2] = (f32x2_t){w1.x, w1.y}; wp[t][3] = (f32x2_t){w1.z, w1.w}; }
        float Bq;
        { float ssq = 0.f;
#pragma unroll
          for (int ks = 0; ks < 4; ++ks)
#pragma unroll
              for (int e = 0; e < 8; ++e) { const float v = bf_lo((unsigned)(unsigned short)qa[ks][e]); ssq += v * v; }
          ssq += __shfl_xor(ssq, 32);
          float term = fabsf(C.WI[(rowbase + tq0 + aq) * 8 + ah]) * sqrtf(ssq);
          term += __shfl_xor(term, 1); term += __shfl_xor(term, 2); term += __shfl_xor(term, 8);
          Bq = term * 8.25f + 1e-20f; }
        const float B0 = __shfl(Bq, (hi << 2)), B1 = __shfl(Bq, (hi << 2) | 16);
        const float sc0 = 1024.0f / B0, sc1 = 1024.0f / B1;
        asm volatile("" :: "v"(qa[0]), "v"(qa[1]), "v"(qa[2]), "v"(qa[3]));
        asm volatile("" :: "v"(wp[0][0]), "v"(wp[0][1]), "v"(wp[0][2]), "v"(wp[0][3]), "v"(wp[1][0]), "v"(wp[1][1]), "v"(wp[1][2]), "v"(wp[1][3]), "v"(sc0), "v"(sc1));
        const bf16* ksrc = C.KI + rowbase * 64 + (long)(wave * 8 + (lane >> 3)) * 64 + ((lane & 7) ^ (lane >> 3)) * 8;
        const unsigned kdst = (unsigned)(uintptr_t)(F.lds + SELKS_OFF) + wave * 1024;
        const LAS unsigned char* kfr = F.lds + SELKS_OFF + r * 128;
        int koff[4];
#pragma unroll
        for (int ks = 0; ks < 4; ++ks) koff[ks] = ((2 * ks + hi) ^ (r & 7)) * 16;
        const unsigned below = (1u << r) - 1u;
        LAS v4u* hz = (LAS v4u*)hist;
        if (wave == 0 && lane == 0) *fbflag = 0u;
#pragma unroll
        for (int j = 0; j < 8; ++j) hz[j * 64 + lane] = (v4u){0u, 0u, 0u, 0u};
        tile_pass(F, ksrc, kdst, kfr, koff, NT, qa, wp, [&](int kbase, float s0, float s1) {
            const int b0 = (int)__builtin_amdgcn_fmed3f(__builtin_fmaf(s0, sc0, 256.0f), 0.0f, 511.0f), b1 = (int)__builtin_amdgcn_fmed3f(__builtin_fmaf(s1, sc1, 256.0f), 0.0f, 511.0f);
            __hip_atomic_fetch_add(hist + (2 * hi) * 512 + b0, 1u, __ATOMIC_RELAXED, __HIP_MEMORY_SCOPE_WORKGROUP);
            __hip_atomic_fetch_add(hist + (2 * hi + 1) * 512 + b1, 1u, __ATOMIC_RELAXED, __HIP_MEMORY_SCOPE_WORKGROUP);
        });
#ifdef PROBE_SKEL
        tile_pass(F, ksrc, kdst, kfr, koff, NT, qa, wp, [&](int kbase, float s0, float s1) { });
#endif
#ifdef PROBE_SCORE
        { float dsum = 0.f; tile_pass(F, ksrc, kdst, kfr, koff, NT, qa, wp, [&](int kbase, float s0, float s1) { dsum += s0 + s1; }); if (dsum == 12345.678f) hist[0] = 1u; }
#endif
        SelState st;
        unsigned tbin[4], bcn[4]; bool ovf = false;
#pragma unroll
        for (int ql = 0; ql < 4; ++ql) { unsigned above; scan_hist_cnt(hist + ql * 512, lane, 256u, tbin[ql], above, bcn[ql]); st.cnt[ql] = 0u; st.tcnt[ql] = 0u; st.need[ql] = 256u - above; st.pre[ql] = above;
            }
        unsigned cbase[4]; { unsigned a = 0u;
#pragma unroll
            for (int ql = 0; ql < 4; ++ql) { cbase[ql] = a; a += bcn[ql]; }
            ovf = a > (unsigned)(4 * CAND_CAP); }
        LDS_WAIT();
        if (ovf && lane == 0) *fbflag = 1u;
        asm volatile("s_waitcnt lgkmcnt(0)\n\ts_barrier" ::: "memory");
#ifdef PROBE_NOFB
        const bool fb = false;
#elif defined(PROBE_NOFB2)
        const bool fb = __builtin_amdgcn_readfirstlane((int)*fbflag) == 0x7fffffff;
#else
        const bool fb = __builtin_amdgcn_readfirstlane((int)*fbflag) != 0;
#endif
        if (!fb) {
            const int tb0 = (int)(hi ? tbin[2] : tbin[0]), tb1 = (int)(hi ? tbin[3] : tbin[1]); const unsigned cb0 = hi ? cbase[2] : cbase[0], cb1 = hi ? cbase[3] : cbase[1];
            tile_pass(F, ksrc, kdst, kfr, koff, NT, qa, wp, [&](int kbase, float s0, float s1) {
#pragma unroll
                for (int t = 0; t < 2; ++t) {
                    const float s = t ? s1 : s0; const int bin = (int)__builtin_amdgcn_fmed3f(__builtin_fmaf(s, (t ? sc1 : sc0), 256.0f), 0.0f, 511.0f), tb = t ? tb1 : tb0;
                    const bool gt = bin > tb, eq = bin == tb;
                    const unsigned long long mg = __ballot(gt), me = __ballot(eq);
                    const unsigned mgh = hi ? (unsigned)(mg >> 32) : (unsigned)mg, meh = hi ? (unsigned)(me >> 32) : (unsigned)me;
                    const unsigned pos = (hi ? st.cnt[2 + t] : st.cnt[t]) + __builtin_popcount(mgh & below);
                    sel[(gt && pos < 256u) ? (2 * hi + t) * 256 + pos : 3200 + lane] = (unsigned short)(kbase + r);
                    const unsigned cpos = (hi ? st.tcnt[2 + t] : st.tcnt[t]) + __builtin_popcount(meh & below);
                    { const unsigned slot = (t ? cb1 : cb0) + cpos; LAS unsigned* cp = hist + ((eq && slot < (unsigned)(4 * CAND_CAP)) ? 2048 + slot * 2 : 1700 + 2 * lane); cp[0] = okey(s); cp[1] = (unsigned)(kbase + r); }
                    st.cnt[t] += __builtin_popcount((unsigned)mg); st.cnt[2 + t] += __builtin_popcount((unsigned)(mg >> 32));
                    st.tcnt[t] += __builtin_popcount((unsigned)me); st.tcnt[2 + t] += __builtin_popcount((unsigned)(me >> 32));
                }
            });
#pragma unroll
            for (int ql = 0; ql < 4; ++ql) {
                const unsigned nc = bcn[ql], G = st.pre[ql], rq = st.need[ql];
                const LAS unsigned* cq = cand + cbase[ql] * 2;
                unsigned base = G; const unsigned long long lt = (1ull << lane) - 1ull;
                for (unsigned c0 = 0; c0 < nc; c0 += 256u) {
                    unsigned ki4[4], xi4[4], rk4[4];
#pragma unroll
                    for (int m = 0; m < 4; ++m) { const unsigned i = c0 + (unsigned)lane + 64u * m; ki4[m] = (i < nc) ? cq[2 * i] : 0u; xi4[m] = (i < nc) ? cq[2 * i + 1] : 0u; rk4[m] = 0u; }
                    for (unsigned j = 0; j < nc; ++j) { const unsigned kj = cq[2 * j];
#pragma unroll
                        for (int m = 0; m < 4; ++m) rk4[m] += (kj > ki4[m] || (kj == ki4[m] && j < c0 + (unsigned)lane + 64u * m)) ? 1u : 0u; }
#pragma unroll
                    for (int m = 0; m < 4; ++m) { const bool take = (c0 + (unsigned)lane + 64u * m < nc) && rk4[m] < rq; const unsigned long long mm = __ballot(take);
                        const unsigned pos = base + __builtin_popcountll(mm & lt); if (take && pos < 256u) sel[ql * 256 + pos] = (unsigned short)xi4[m]; base += __builtin_popcountll(mm); }
                }
            }
        } else {
#pragma unroll
            for (int ql = 0; ql < 4; ++ql) { st.pre[ql] = 0u; st.need[ql] = 256u; st.cnt[ql] = 0u; st.tcnt[ql] = 0u; }
#pragma unroll 1
            for (int lev = 0; lev < 4; ++lev) {
#pragma unroll
                for (int j = 0; j < 8; ++j) hz[j * 64 + lane] = (v4u){0u, 0u, 0u, 0u};
                const unsigned pre0 = hi ? st.pre[2] : st.pre[0], pre1 = hi ? st.pre[3] : st.pre[1];
                const int sh = (lev == 0) ? 23 : (lev == 1) ? 14 : (lev == 2) ? 5 : 0, wd = (lev == 3) ? 5 : 9;
                tile_pass(F, ksrc, kdst, kfr, koff, NT, qa, wp, [&](int kbase, float s0, float s1) {
                    const unsigned k0 = okey(s0), k1 = okey(s1);
                    const unsigned b0 = (k0 >> sh) & ((1u << wd) - 1u), b1 = (k1 >> sh) & ((1u << wd) - 1u);
                    const bool in0 = (lev == 0) || ((k0 >> (sh + wd)) == pre0), in1 = (lev == 0) || ((k1 >> (sh + wd)) == pre1);
                    if (in0) __hip_atomic_fetch_add(hist + (2 * hi) * 512 + b0, 1u, __ATOMIC_RELAXED, __HIP_MEMORY_SCOPE_WORKGROUP);
                    if (in1) __hip_atomic_fetch_add(hist + (2 * hi + 1) * 512 + b1, 1u, __ATOMIC_RELAXED, __HIP_MEMORY_SCOPE_WORKGROUP);
                });
#pragma unroll
                for (int ql = 0; ql < 4; ++ql) { unsigned bin, above, bc; scan_hist_cnt(hist + ql * 512, lane, st.need[ql], bin, above, bc);
                    st.pre[ql] = (st.pre[ql] << wd) | bin; st.need[ql] -= above; }
                LDS_WAIT();
            }
            const unsigned T0 = hi ? st.pre[2] : st.pre[0], T1 = hi ? st.pre[3] : st.pre[1], rq0 = hi ? st.need[2] : st.need[0], rq1 = hi ? st.need[3] : st.need[1];
            tile_pass(F, ksrc, kdst, kfr, koff, NT, qa, wp, [&](int kbase, float s0, float s1) {
#pragma unroll
                for (int t = 0; t < 2; ++t) {
                    const unsigned kk = okey(t ? s1 : s0), T = t ? T1 : T0, rq = t ? rq1 : rq0;
                    const bool gt = kk > T, eq = kk == T;
                    const unsigned long long me = __ballot(eq);
                    const unsigned meh = hi ? (unsigned)(me >> 32) : (unsigned)me;
                    const unsigned trank = (hi ? st.tcnt[2 + t] : st.tcnt[t]) + __builtin_popcount(meh & below);
                    const bool take = gt || (eq && trank < rq);
                    const unsigned long long mt = __ballot(take);
                    const unsigned mth = hi ? (unsigned)(mt >> 32) : (unsigned)mt;
                    const unsigned pos = (hi ? st.cnt[2 + t] : st.cnt[t]) + __builtin_popcount(mth & below);
                    if (take && pos < 256u) sel[(2 * hi + t) * 256 + pos] = (unsigned short)(kbase + r);
                    st.cnt[t] += __builtin_popcount((unsigned)mt); st.cnt[2 + t] += __builtin_popcount((unsigned)(mt >> 32));
                    st.tcnt[t] += __builtin_popcount((unsigned)me); st.tcnt[2 + t] += __builtin_popcount((unsigned)(me >> 32));
                }
            });
        }
    }
    LDS_WAIT();
    { const LAS v4u* s4 = (const LAS v4u*)sel; v4u* g4 = (v4u*)(C.SEL + (rowbase + tq0) * 256);
#pragma unroll
      for (int j = 0; j < 2; ++j) g4[j * 64 + lane] = s4[j * 64 + lane]; }
    LDS_WAIT();
}
__device__ __forceinline__ void phase(Frame& F, const Ctx& C) {
    for (int v = F.vcu; v < 256; v += F.G) {
        const int b = v >> 6, c = v & 63;
#pragma unroll 1
        for (int it = 0; it < 4; ++it) step(F, C, b, (it < 2) ? c : 127 - c, it & 1);
    }
}
__device__ __forceinline__ void attn_phase(Frame& F, const Ctx& C) {
    int lane = F.lane; asm volatile("" : "+v"(lane));
    LAS unsigned short* sq = (LAS unsigned short*)(F.lds + RING_OFF + F.wave * 16384);
    const int nx = F.G / 32;
    for (int x = F.vcu / 32; x < 8; x += nx) {
        const int b = x >> 1, g0 = 2 * (x & 1); const long rowbase = (long)b * SEQ;
        const int w = (F.vcu & 31) * NWAVES + F.wave;
#pragma unroll 1
        for (int t = w; t < SEQ; t += 32 * NWAVES) {
            { const v4u* g4 = (const v4u*)(C.SEL + (rowbase + t) * 256); if (lane < 32) ((LAS v4u*)sq)[lane] = g4[lane]; }
            LDS_WAIT();
            const int N = 64 * ((t >> 6) + 1), nvalid = N < 256 ? N : 256;
            attend(C, sq, nvalid, rowbase, rowbase + t, t, lane, g0);
            LDS_WAIT();
        }
    }
}
}

namespace att8 {
typedef int v2i __attribute__((ext_vector_type(2)));
struct Ctx8 { const unsigned char* QA8; const unsigned char* KV8; const unsigned short* SEL; bf16* M; bool o8; };
constexpr int T2_OFF = KS_OFF, T2_BYTES = 155 * 16 * 4, SELL_OFF = KS_OFF + 10240;
static_assert(T2_BYTES <= 10240 && SELL_OFF + NWAVES * 1024 <= AUX_OFF, "attention LDS map");
__device__ __forceinline__ void mfma8(f32x4& acc, long a, long b) { asm volatile("v_mfma_f32_16x16x32_fp8_fp8 %0, %1, %2, %0" : "+v"(acc) : "v"(a), "v"(b)); }
__device__ __forceinline__ unsigned pk4_fp8(float a, float b, float c, float d) { int r = __builtin_amdgcn_cvt_pk_fp8_f32(a, b, 0, false); r = __builtin_amdgcn_cvt_pk_fp8_f32(c, d, r, true); return (unsigned)r; }

__device__ __forceinline__ void gld16(v4u& dst, const void* p) { asm volatile("global_load_dwordx4 %0, %1, off" : "=v"(dst) : "v"(p) : "memory"); }
__device__ __forceinline__ void issue_kq(const Ctx8& C, const LAS unsigned short* sq, long rowbase, long token, int g, int l15, int l4, int h, v4u (&kr)[16], v4u& qv) {
    const unsigned char* kvb = C.KV8 + rowbase * 512 + g * 128 + 16 * l4;
#pragma unroll
    for (int j = 0; j < 16; ++j) gld16(kr[j], kvb + (long)sq[j * 16 + l15] * 512);
    gld16(qv, C.QA8 + token * 1024 + (4 * g + h) * 64 + 16 * l4);
}
__device__ __forceinline__ void issue_v_half(const Ctx8& C, const LAS unsigned short* sq, long rowbase, int g, int lane, unsigned vbase, int half) {
    const unsigned char* kvb = C.KV8 + rowbase * 512 + g * 128 + 64; const int kq = lane >> 2, p = lane & 3;
#pragma unroll
    for (int j = 0; j < 8; ++j) { const int ti = half * 8 + j; const int key = sq[ti * 16 + kq]; const int x = ((kq >> 2) & 1) | ((ti & 1) << 1);
        glds16(kvb + (long)key * 512 + 16 * (p ^ x), (unsigned)__builtin_amdgcn_readfirstlane(vbase + ti * 1024)); }
}
__device__ __forceinline__ void phase(Frame& F, const Ctx8& C, const float* t5) {
    int lane = F.lane; asm volatile("" : "+v"(lane));
    LAS float* T2 = (LAS float*)(F.lds + T2_OFF);
    for (int e = F.tid; e < 155 * 16; e += NWAVES * 64) { const int rel = (e >> 4) - 91, n = rel < 0 ? -rel : rel;
        const int bk = (rel > 0 ? 16 : 0) + (n < 8 ? n : 8 + (n >= 12) + (n >= 16) + (n >= 23) + (n >= 32) + (n >= 46) + (n >= 64) + (n >= 91));
        T2[e] = t5[bk * 16 + (e & 15)] * 8.0f; }
    __syncthreads();
    LAS unsigned short* sqb = (LAS unsigned short*)(F.lds + SELL_OFF + F.wave * 1024);
    LAS unsigned char* vreg = F.lds + RING_OFF + F.wave * 16384;
    const unsigned vbase = (unsigned)(uintptr_t)vreg;
    const int l15 = lane & 15, l4 = lane >> 4, h = l15 & 3;
    const int trk = 4 * l4 + ((l15 >> 1) & 3), trt = (l15 >> 3) & 1, xs = (l4 & 1) | (trt << 1);
    const int troff = trt * 1024 + trk * 64 + 8 * (l15 & 1);
    const int x = F.vcu / 32, b = x >> 1, g0 = 2 * (x & 1); const long rowbase = (long)b * SEQ;
    const int w = (F.vcu & 31) * NWAVES + F.wave;
    constexpr int NQ = SEQ / (32 * NWAVES), NI = 2 * NQ;
    if (lane < 32) { ((LAS v4u*)sqb)[lane] = ((const v4u*)(C.SEL + (rowbase + w) * 256))[lane]; ((LAS v4u*)(sqb + 256))[lane] = ((const v4u*)(C.SEL + (rowbase + w + 32 * NWAVES) * 256))[lane]; }
    LDS_WAIT();
    v4u kr[16], qv, pf = (v4u){0u, 0u, 0u, 0u};
    issue_kq(C, sqb, rowbase, rowbase + w, g0, l15, l4, h, kr, qv);
    issue_v_half(C, sqb, rowbase, g0, lane, vbase, 0); issue_v_half(C, sqb, rowbase, g0, lane, vbase, 1);
    unsigned cib[16];
#pragma unroll 1
    for (int idx = 0; idx < NI; ++idx) { LA_A;
        const int qn = idx >> 1, gi = idx & 1, g = g0 + gi, t = w + 32 * NWAVES * qn;
        const LAS unsigned short* sq = sqb + (qn & 1) * 256;
        const int nidx = (idx + 1 < NI) ? idx + 1 : idx, nq = nidx >> 1, ng = g0 + (nidx & 1), nt = w + 32 * NWAVES * nq;
        const LAS unsigned short* nsq = sqb + (nq & 1) * 256;
        if (gi == 1) { asm volatile("s_waitcnt vmcnt(34)" : "+v"(pf) :: "memory"); if (lane < 32) ((LAS v4u*)(sqb + (qn & 1) * 256))[lane] = pf; }
        { const int pq = (qn + 2 < NQ) ? qn + 2 : NQ - 1; gld16(pf, (const v4u*)(C.SEL + (rowbase + w + 32 * NWAVES * pq) * 256) + (lane & 31)); }
        if (idx == 0) asm volatile("s_waitcnt vmcnt(0)" : "+v"(qv), "+v"(kr[0]), "+v"(kr[1]), "+v"(kr[2]), "+v"(kr[3]), "+v"(kr[4]), "+v"(kr[5]), "+v"(kr[6]), "+v"(kr[7]), "+v"(kr[8]), "+v"(kr[9]), "+v"(kr[10]), "+v"(kr[11]), "+v"(kr[12]), "+v"(kr[13]), "+v"(kr[14]), "+v"(kr[15]) :: "memory");
        else asm volatile("s_waitcnt vmcnt(20)" : "+v"(qv), "+v"(kr[0]), "+v"(kr[1]), "+v"(kr[2]), "+v"(kr[3]), "+v"(kr[4]), "+v"(kr[5]), "+v"(kr[6]), "+v"(kr[7]), "+v"(kr[8]), "+v"(kr[9]), "+v"(kr[10]), "+v"(kr[11]), "+v"(kr[12]), "+v"(kr[13]), "+v"(kr[14]), "+v"(kr[15]) :: "memory");
        if (gi == 0) {
#pragma unroll
            for (int ti = 0; ti < 16; ++ti) { const v2u i4 = *(const LAS v2u*)(sq + ti * 16 + 4 * l4);
                const int r0 = (int)(i4.x & 0xffffu) - t, r1 = (int)(i4.x >> 16) - t, r2 = (int)(i4.y & 0xffffu) - t, r3 = (int)(i4.y >> 16) - t;
                const int c0 = min(max(r0, -91), 63) + 91, c1 = min(max(r1, -91), 63) + 91, c2 = min(max(r2, -91), 63) + 91, c3 = min(max(r3, -91), 63) + 91;
                cib[ti] = (unsigned)c0 | ((unsigned)c1 << 8) | ((unsigned)c2 << 16) | ((unsigned)c3 << 24); }
        }
        const int N = 64 * ((t >> 6) + 1), nvalid = N < 256 ? N : 256;
        const long q0 = (long)(((unsigned long long)qv.y << 32) | qv.x), q1 = (long)(((unsigned long long)qv.w << 32) | qv.z);
        f32x4 S[16];
#pragma unroll
        for (int ti = 0; ti < 16; ++ti) { const unsigned cb = cib[ti];
            f32x4 a; a.x = T2[(cb & 255u) * 16 + 4 * g + h]; a.y = T2[((cb >> 8) & 255u) * 16 + 4 * g + h]; a.z = T2[((cb >> 16) & 255u) * 16 + 4 * g + h]; a.w = T2[(cb >> 24) * 16 + 4 * g + h];
            mfma8(a, (long)(((unsigned long long)kr[ti].y << 32) | kr[ti].x), q0);
            mfma8(a, (long)(((unsigned long long)kr[ti].w << 32) | kr[ti].z), q1);
            S[ti] = a; }
        asm volatile("s_nop 15\n\ts_nop 7" : "+v"(S[0]), "+v"(S[1]), "+v"(S[2]), "+v"(S[3]), "+v"(S[4]), "+v"(S[5]), "+v"(S[6]), "+v"(S[7]), "+v"(S[8]), "+v"(S[9]), "+v"(S[10]), "+v"(S[11]), "+v"(S[12]), "+v"(S[13]), "+v"(S[14]), "+v"(S[15]));
        issue_kq(C, nsq, rowbase, rowbase + nt, ng, l15, l4, h, kr, qv);
#pragma unroll
        for (int ti = 0; ti < 16; ++ti) if (ti * 16 >= nvalid) S[ti] = (f32x4){-INFINITY, -INFINITY, -INFINITY, -INFINITY};
        float mx = S[0].x;
#pragma unroll
        for (int ti = 0; ti < 16; ++ti) mx = fmaxf(fmaxf(mx, fmaxf(S[ti].x, S[ti].y)), fmaxf(S[ti].z, S[ti].w));
        mx = fmaxf(mx, __shfl_xor(mx, 16)); mx = fmaxf(mx, __shfl_xor(mx, 32));
        const float mc = -mx * C2; float ls = 0.f;
        long P8[8];
#pragma unroll
        for (int j = 0; j < 8; ++j) { float e[8];
#pragma unroll
            for (int q = 0; q < 4; ++q) { e[q] = __builtin_amdgcn_exp2f(__builtin_fmaf(S[2 * j][q], C2, mc)); e[4 + q] = __builtin_amdgcn_exp2f(__builtin_fmaf(S[2 * j + 1][q], C2, mc)); }
            ls += ((e[0] + e[1]) + (e[2] + e[3])) + ((e[4] + e[5]) + (e[6] + e[7]));
            const unsigned lo = pk4_fp8(e[0] * 256.f, e[1] * 256.f, e[2] * 256.f, e[3] * 256.f), hi = pk4_fp8(e[4] * 256.f, e[5] * 256.f, e[6] * 256.f, e[7] * 256.f);
            P8[j] = (long)(((unsigned long long)hi << 32) | lo); }
        ls += __shfl_xor(ls, 16); ls += __shfl_xor(ls, 32);
        f32x4 D[4];
#pragma unroll
        for (int db = 0; db < 4; ++db) D[db] = (f32x4){0.f, 0.f, 0.f, 0.f};
#pragma unroll
        for (int hf = 0; hf < 2; ++hf) {
            asm volatile("s_waitcnt vmcnt(28)" ::: "memory");
#pragma unroll
            for (int j = 4 * hf; j < 4 * hf + 4; ++j)
#pragma unroll
                for (int db = 0; db < 4; ++db) {
                    const v2i vv = __builtin_amdgcn_ds_read_tr8_b64_v2i32((LAS v2i*)(vreg + j * 2048 + troff + 16 * (db ^ xs)));
                    mfma8(D[db], P8[j], __builtin_bit_cast(long, vv)); }
            asm volatile("s_waitcnt lgkmcnt(0)" ::: "memory");
            issue_v_half(C, nsq, rowbase, ng, lane, vbase, hf);
        }
        asm volatile("s_nop 15\n\ts_nop 7" : "+v"(D[0]), "+v"(D[1]), "+v"(D[2]), "+v"(D[3]));
        const float lh = __shfl(ls, l4);
        const float inv = __builtin_amdgcn_rcpf(lh * 256.f);
        bf16* mp = C.M + (rowbase + t) * DM + (4 * g + l4) * 64 + l15;
#pragma unroll
        for (int db = 0; db < 4; ++db) { const float v = (l4 == 0) ? D[db].x : (l4 == 1) ? D[db].y : (l4 == 2) ? D[db].z : D[db].w;
            if (C.o8) { const unsigned o1 = (unsigned)__builtin_amdgcn_cvt_pk_fp8_f32(v * inv, 0.f, 0, false);
                asm volatile("global_store_byte %0, %1, off" :: "v"((unsigned char*)C.M + (rowbase + t) * DM + (4 * g + l4) * 64 + l15 + 16 * db), "v"(o1) : "memory"); }
            else { const unsigned short ob = (unsigned short)f2bf(v * inv);
                asm volatile("global_store_short %0, %1, off" :: "v"(mp + 16 * db), "v"((unsigned)ob) : "memory"); } }
    }
    asm volatile("s_waitcnt vmcnt(0)" ::: "memory");
}
}

#ifndef REP_P0
#define REP_P0 1
#endif
#ifndef REP_IN
#define REP_IN 1
#endif
#ifndef REP_DSA
#define REP_DSA 1
#endif
#ifndef REP_BAND
#define REP_BAND 1
#endif
#ifndef REP_UP
#define REP_UP 1
#endif
#ifndef REP_FIX
#define REP_FIX 1
#endif
constexpr int N_PHASES = 1 + 6 * DEPTH;
#ifndef MK_N_LAUNCHES
#define MK_N_LAUNCHES 1
#endif
__global__ void __launch_bounds__(NWAVES * 64, 2) mega_fwd(Args args) {
    extern __shared__ __attribute__((aligned(16))) unsigned char lds[];
    Frame F;
    F.lds = (LAS unsigned char*)lds;
    F.MISC = (volatile LAS unsigned*)(F.lds + MISC_OFF);
    F.tid = threadIdx.x; F.lane = F.tid & 63; F.wave = __builtin_amdgcn_readfirstlane(F.tid >> 6);
    F.G = GRID; { const int bx = blockIdx.x; F.vcu = (bx & 7) * (GRID / 8) + (bx >> 3); }
    unsigned char* ws = args.ws;
    F.ctl = (gu32*)(ws + WS_CTL);
    for (int u = F.tid; u < (LDS_BYTES - LDSCTL_OFF) / 4; u += NWAVES * 64) ((LAS unsigned*)(F.lds + LDSCTL_OFF))[u] = 0u;
    __syncthreads();
    XcdBarrier bar; bar.bar = (unsigned*)(F.ctl + CW_BAR); bar.x = 0; bar.st = nullptr;
    if (MK_N_LAUNCHES == 1) bar = xcd_barrier_post((unsigned*)(F.ctl + CW_BAR), F.MISC + 8);
#ifdef F8M_RUNTIME
    const int lo = args.ph_lo, hi = args.ph_hi, f8m = args.f8m;
#else
    const int lo = args.ph_lo, hi = args.ph_hi; constexpr int f8m = F8M_ALL;
#ifdef PAD_NOPS
    asm volatile(".rept %0\n\ts_nop 0\n\t.endr" :: "n"(PAD_NOPS));
#endif
#endif
#define IN(k) (lo <= (k) && (k) < hi)
#define OPQ_FRAME(Fl) Frame Fl = F; { int l_; asm volatile("v_mbcnt_lo_u32_b32 %0, -1, 0\n\tv_mbcnt_hi_u32_b32 %0, -1, %0" : "=v"(l_)); int w_ = F.wave; asm volatile("" : "+s"(w_)); Fl.wave = w_; Fl.lane = l_; Fl.tid = w_ * 64 + l_; }
#define SEAM(k) do { if (IN(k) && IN((k) + 1)) xcd_barrier(bar); } while (0)

    bf16* hb = (bf16*)(ws + WS_HB); bf16* mb = (bf16*)(ws + WS_M); float* ss = (float*)(ws + WS_SS); float* halo = (float*)(ws + WS_HALO);
    unsigned char* proj = ws + WS_PROJ; bf16* act = (bf16*)(ws + WS_PROJ);

#ifndef SKIP_P0
    if (IN(0)) { for (int rep = 0; rep < REP_P0; ++rep) { OPQ_FRAME(F0); p0_prologue(F0, args); } }
#endif
    SEAM(0);

#pragma unroll 1
    for (int L = 0; L < DEPTH; ++L) {
        const int pb = 1 + 6 * L, li = L >> 1; const bool isB = (L & 1) != 0;
        if (IN(pb)) {
#ifndef SKIP_IN
            for (int rep = 0; rep < REP_IN; ++rep)
            if (!isB) {
                pg8::Gemm g{hb, (const bf16*)(ws + WS_W_INA) + (size_t)li * NA_PAD * DM, MTOK, NA_PAD, DM}; pg8::StaticOrder S; S.init(MTOK, NA_PAD, F.G, (int)blockIdx.x);
                EpiIn E{ss, proj, args.q_norm_g + L * 64, args.k_norm_g + L * 64, 0, 1.0f};
                pg8::gemm_phase<EpiIn, pg8::StaticOrder, true, true>(F.lds + RING_OFF, g, S, E, F.wave);
            } else {
                pg8::Gemm g{hb, (const bf16*)(ws + WS_W_INB) + (size_t)li * NB * DM, MTOK, NB, DM}; pg8::StaticOrder S; S.init(MTOK, NB, F.G, (int)blockIdx.x);
                if (f8_in(f8m, L)) { pg8::Gemm g8{(const bf16*)(ws + WS_M), (const bf16*)(ws + WS_W_INB) + (size_t)li * NB * DM, MTOK, NB, DM / 2};
                    EpiIn E{ss, proj, args.q_norm_g + L * 64, args.k_norm_g + L * 64, 1, W8I};
                    pg8::gemm_phase<EpiIn, pg8::StaticOrder, true, true, true>(F.lds + RING_OFF, g8, S, E, F.wave); }
                else { EpiIn E{ss, proj, args.q_norm_g + L * 64, args.k_norm_g + L * 64, 1, 1.0f};
                    pg8::gemm_phase<EpiIn, pg8::StaticOrder, true, true>(F.lds + RING_OFF, g, S, E, F.wave); }
            }
#endif
        }
        SEAM(pb);
#if defined(DBG_NODSA) || defined(DBG_NOBAND)
#ifdef DBG_NODSA
        const bool zero_m = !isB;
#else
        const bool zero_m = isB;
#endif
        if (IN(pb + 1) && zero_m) { for (size_t i = (size_t)blockIdx.x * 512 + threadIdx.x; i < (size_t)MTOK * DM / 8; i += (size_t)gridDim.x * 512) ((v4u*)mb)[i] = (v4u){0u, 0u, 0u, 0u}; }
        if (IN(pb + 1) && !zero_m) {
#else
        if (IN(pb + 1)) {
#endif
#ifndef SKIP_DSA
            if (!isB) {
                LAS float* t5l = (LAS float*)(F.lds + AUX_OFF);
                { OPQ_FRAME(Ft); for (int i = Ft.tid; i < 512; i += NWAVES * 64) t5l[i] = args.t5_bias[i] * LOG2E; }
                __syncthreads();
                dsa::Ctx C{(const bf16*)(proj + PA_QA), (const bf16*)(proj + PA_KA), (const bf16*)(proj + PA_VA), (const bf16*)(proj + PA_QI), (const bf16*)(proj + PA_KI), (const float*)(proj + PA_WI), mb, t5l, (unsigned short*)(proj + PA_SEL)};
#ifdef DBG_DSACOPY
                { int t_ = threadIdx.x; asm volatile("" : "+v"(t_));
                for (unsigned i = blockIdx.x * 512u + (unsigned)t_; i < (unsigned)MTOK * DM; i += gridDim.x * 512u) { const unsigned t = i >> 10, c = i & 1023u;
                    float v = bf_lo(C.QA[i]); v += bf_lo(C.KA[t * 256 + (c & 255)]); v += bf_lo(C.VA[t * 256 + (c & 255)]); v += bf_lo(C.QI[t * 512 + (c & 511)]); v += bf_lo(C.KI[t * 64 + (c & 63)]); v += C.WI[t * 8 + (c & 7)];
                    mb[i] = (bf16)f2bf(v * 0.01f); asm volatile("" ::: "memory"); } }
#else
                for (int rep = 0; rep < REP_DSA; ++rep) { OPQ_FRAME(F1); dsa::phase(F1, C); }
                xcd_barrier(bar);
                { OPQ_FRAME(F1b); att8::Ctx8 C8{(const unsigned char*)(proj + PA_QA), (const unsigned char*)(proj + PA_KA), (const unsigned short*)(proj + PA_SEL), mb, f8_out(f8m, L)};
#ifndef REP_ATT8
#define REP_ATT8 1
#endif
                  for (int rep = 0; rep < REP_ATT8; ++rep) { att8::phase(F1b, C8, args.t5_bias); __syncthreads(); } }
#endif
            }
#endif
#ifndef SKIP_BAND
            if (isB) {
                for (int rep = 0; rep < REP_BAND; ++rep) { OPQ_FRAME(F2); band::phase(F2, (const bf16*)proj, (const bf16*)(proj + PB_STRIDE), (const bf16*)(proj + 2 * PB_STRIDE), mb, args.rel_bias_b + (size_t)li * 513 * 16, f8_out(f8m, L)); }
            }
#endif
        }
        SEAM(pb + 1);
        if (IN(pb + 2)) {
#ifndef SKIP_OUT
            pg8::Gemm g{mb, (const bf16*)(ws + WS_W_OUT) + (size_t)L * DM * DM, MTOK, DM, DM}; pg8::StaticOrder S; S.init(MTOK, DM, F.G, (int)blockIdx.x);
#ifdef REP_OUT
            { EpiRes E0{nullptr, hb, (bf16*)proj, halo}; pg8::gemm_phase<EpiRes, pg8::StaticOrder, true, true>(F.lds + RING_OFF, g, S, E0, F.wave); }
#endif
            unsigned char* h8o = f8_ffn(f8m, L) ? proj + PX_HB8 : nullptr;
            if (f8_out(f8m, L)) { pg8::Gemm g8{mb, (const bf16*)(ws + WS_W_OUT) + (size_t)L * DM * DM, MTOK, DM, DM / 2};
                EpiResT<1 | SER_OUT> E{nullptr, hb, hb, ss, h8o};
                pg8::gemm_phase<EpiResT<1 | SER_OUT>, pg8::StaticOrder, true, true, true>(F.lds + RING_OFF, g8, S, E, F.wave); }
            else { EpiResT<SER_OUT> E{nullptr, hb, hb, ss, h8o, L == 0 ? args.x : nullptr};
                pg8::gemm_phase<EpiResT<SER_OUT>, pg8::StaticOrder, true, true>(F.lds + RING_OFF, g, S, E, F.wave); }
#endif
        }
        SEAM(pb + 2);
        if (IN(pb + 3)) {
#ifndef SKIP_UP
            for (int rep = 0; rep < REP_UP; ++rep) {
            pg8::Gemm g{hb, (const bf16*)(ws + WS_W_UP) + (size_t)L * NUP * DM, MTOK, NUP, DM}; pg8::StaticOrder S; S.init(MTOK, NUP, F.G, (int)blockIdx.x);
#ifdef PROBE_UPK
            { EpiDummy E0{halo}; pg8::gemm_phase<EpiDummy, pg8::StaticOrder, true, true>(F.lds + RING_OFF, g, S, E0, F.wave); }
#endif
            if (f8_ffn(f8m, L)) { pg8::Gemm g8{(const bf16*)(proj + PX_HB8), (const bf16*)(ws + WS_W_UP) + (size_t)L * NUP * DM, MTOK, NUP, DM / 2};
                EpiUpT<true> E{ss, args.conv_w + (size_t)L * 3 * NUP, args.conv_b + (size_t)L * NUP, act, halo, (LAS float*)(F.lds + AUX_OFF)};
                pg8::gemm_phase<EpiUpT<true>, pg8::StaticOrder, true, true, true>(F.lds + RING_OFF, g8, S, E, F.wave); }
            else { EpiUp E{ss, args.conv_w + (size_t)L * 3 * NUP, args.conv_b + (size_t)L * NUP, act, halo, (LAS float*)(F.lds + AUX_OFF)};
                pg8::gemm_phase<EpiUp, pg8::StaticOrder, true, true>(F.lds + RING_OFF, g, S, E, F.wave); } }
#endif
        }
        SEAM(pb + 3);
#ifndef SKIP_FIX
        if (IN(pb + 4)) for (int rep = 0; rep < REP_FIX; ++rep) { OPQ_FRAME(F3); if (f8_ffn(f8m, L)) fixup_phase<true>(F3, args.conv_w + (size_t)L * 3 * NUP, args.conv_b + (size_t)L * NUP, halo, act); else fixup_phase<false>(F3, args.conv_w + (size_t)L * 3 * NUP, args.conv_b + (size_t)L * NUP, halo, act); }
#endif
        SEAM(pb + 4);
        if (IN(pb + 5)) {
#ifndef SKIP_DN
            pg8::Gemm g{act, (const bf16*)(ws + WS_W_DN) + (size_t)L * DM * FF, MTOK, DM, FF}; pg8::StaticOrder S; S.init(MTOK, DM, F.G, (int)blockIdx.x);
#ifdef REP_DN
            { EpiRes E0{nullptr, hb, mb, halo}; pg8::gemm_phase<EpiRes, pg8::StaticOrder, true, true>(F.lds + RING_OFF, g, S, E0, F.wave); }
#endif
            unsigned char* h8d = f8_in(f8m, L + 1) ? ws + WS_M : nullptr;
            if (f8_ffn(f8m, L)) { pg8::Gemm g8{act, (const bf16*)(ws + WS_W_DN) + (size_t)L * DM * FF, MTOK, DM, FF / 2};
                EpiResT<1> E{L == DEPTH - 1 ? args.out : nullptr, hb, hb, ss, h8d};
                pg8::gemm_phase<EpiResT<1>, pg8::StaticOrder, true, true, true>(F.lds + RING_OFF, g8, S, E, F.wave); }
            else { EpiRes E{L == DEPTH - 1 ? args.out : nullptr, hb, hb, ss, h8d};
                pg8::gemm_phase<EpiRes, pg8::StaticOrder, true, true>(F.lds + RING_OFF, g, S, E, F.wave); }
#endif
        }
        SEAM(pb + 5);
    }
#undef IN
#undef SEAM
}

extern "C" void kernel_launch(void* const* d_in, const int* in_sizes, int n_in, void* d_out, int out_size, void* d_ws, size_t ws_size, hipStream_t stream) {
    static int grid = 0;
    if (grid == 0) {
        if (n_in != 14 || in_sizes[0] != MTOK * DM || out_size != MTOK * DM || ws_size < WS_END) { fprintf(stderr, "kernel_launch: unexpected shapes / workspace (n_in %d, ws %zu); nothing launched\n", n_in, ws_size); grid = -1; return; }
        int dev = 0, cus = 0, per_cu = 0;
        if (hipGetDevice(&dev) != hipSuccess || hipDeviceGetAttribute(&cus, hipDeviceAttributeMultiprocessorCount, dev) != hipSuccess) { grid = -1; return; }
        if (hipFuncSetAttribute((const void*)mega_fwd, hipFuncAttributeMaxDynamicSharedMemorySize, LDS_BYTES) != hipSuccess) { fprintf(stderr, "kernel_launch: hipFuncSetAttribute failed\n"); grid = -1; return; }
        if (hipOccupancyMaxActiveBlocksPerMultiprocessor(&per_cu, (const void*)mega_fwd, NWAVES * 64, LDS_BYTES) != hipSuccess || per_cu < 1) { fprintf(stderr, "kernel_launch: occupancy query reports %d blocks per CU\n", per_cu); }
        (void)hipGetLastError();
        if (cus != GRID) { fprintf(stderr, "kernel_launch: built for a %d-CU device, found %d; nothing launched\n", GRID, cus); grid = -1; return; }
        grid = GRID;
    }
    if (grid < 0) return;
    if (hipMemsetAsync((char*)d_ws + WS_CTL, 0, CTL_ZERO_BYTES, stream) != hipSuccess) return;
    Args a{};
    a.x = (const float*)d_in[0]; a.attn_norm_g = (const float*)d_in[1]; a.w_in_a = (const float*)d_in[2]; a.w_in_b = (const float*)d_in[3]; a.q_norm_g = (const float*)d_in[4];
    a.k_norm_g = (const float*)d_in[5]; a.t5_bias = (const float*)d_in[6]; a.rel_bias_b = (const float*)d_in[7]; a.w_out = (const float*)d_in[8]; a.ffn_norm_g = (const float*)d_in[9];
    a.w_up = (const float*)d_in[10]; a.conv_w = (const float*)d_in[11]; a.conv_b = (const float*)d_in[12]; a.w_down = (const float*)d_in[13];
    a.out = (float*)d_out; a.ws = (unsigned char*)d_ws; a.f8m = F8M_ALL;
#if MK_N_LAUNCHES == 1
    a.ph_lo = 0; a.ph_hi = N_PHASES; a.li = 0;
    hipLaunchKernelGGL(mega_fwd, dim3(grid), dim3(NWAVES * 64), LDS_BYTES, stream, a);
#else
    for (int p = 0; p < N_PHASES; ++p) { a.ph_lo = p; a.ph_hi = p + 1; a.li = p; hipLaunchKernelGGL(mega_fwd, dim3(grid), dim3(NWAVES * 64), LDS_BYTES, stream, a); }
#endif
}
```

```cpp
#define OFF_G -1
#define OFF_S -1
#define OFF_A -1
#define OFF_B -1
#define F8M_IN 0xF
#define F8M_OUT 0xF
#include <hip/hip_runtime.h>
#include <cstdio>
#include <cstdint>
#ifndef OFF_G
#define OFF_G 0
#endif
#ifndef OFF_S
#define OFF_S 0
#endif
#ifndef OFF_A
#define OFF_A 0
#endif
#ifndef OFF_B
#define OFF_B 0
#endif
#define LOOP_ALIGN_N(n) asm volatile(".p2align 6\n\t.rept %0\n\ts_nop 0\n\t.endr" :: "n"(n))
#if OFF_G < 0
#define LA_G
#else
#define LA_G LOOP_ALIGN_N(OFF_G)
#endif
#if OFF_S < 0
#define LA_S
#else
#define LA_S LOOP_ALIGN_N(OFF_S)
#endif
#if OFF_A < 0
#define LA_A
#else
#define LA_A LOOP_ALIGN_N(OFF_A)
#endif
#if OFF_B < 0
#define LA_B
#else
#define LA_B LOOP_ALIGN_N(OFF_B)
#endif
namespace pg8 {
#define PG8_LAS __attribute__((address_space(3)))
typedef unsigned short bf16_t;
typedef short bf16x8 __attribute__((ext_vector_type(8)));
typedef float f32x4 __attribute__((ext_vector_type(4)));
typedef unsigned u32x4 __attribute__((ext_vector_type(4)));
typedef int i32x4 __attribute__((ext_vector_type(4)));
typedef int i32x8 __attribute__((ext_vector_type(8)));
constexpr int BM = 256, BK = 64, HALF = 128, HTB = HALF * BK * 2  , STAGE_BYTES = 8 * HTB, NXCD = 8, WGM = 8;

__host__ __device__ __forceinline__ int lds_byte(int r, int c) { const int st = (r >> 4) * 2 + (c >> 5), rr = r & 15, cc = c & 31, ob = rr * 64 + cc * 2; return st * 1024 + (ob ^ (((ob >> 9) & 1) << 5)); }
__host__ __device__ __forceinline__ void stage_rc(int b, int& R, int& C) { const int st = b / 1024, sb = b % 1024, swz = sb ^ (((sb >> 9) & 1) << 5); R = (st >> 1) * 16 + swz / 64; C = (st & 1) * 32 + (swz % 64) / 2; }
__host__ __device__ __forceinline__ int perm32(int rho) { const int n = rho >> 4, i = rho & 15; return 8 * (i >> 2) + 4 * n + (i & 3); }

struct Unit { int pm, pn; };
struct Gemm { const bf16_t* A; const bf16_t* Bt; int M, N, K; };

struct StaticOrder {
    int nM, nN, nwg, G, c;
    __host__ __device__ void init(int M, int N, int G_, int c_) { nM = M / BM; nN = N / BM; nwg = nM * nN; G = G_; c = c_; }
    __host__ __device__ bool next(int i, Unit& u) const {
        const long L = (long)i * G + c; if (L >= nwg) return false;
        int wgid = (int)L; { const int q = nwg / NXCD, r = nwg % NXCD, xcd = wgid % NXCD, off = wgid / NXCD; wgid = (xcd < r ? xcd * (q + 1) : r * (q + 1) + (xcd - r) * q) + off; }
        const int nig = WGM * nN, gid = wgid / nig, fm = gid * WGM, gsz = (nM - fm) < WGM ? (nM - fm) : WGM;
        u.pm = fm + ((wgid % nig) % gsz); u.pn = (wgid % nig) / gsz; return true;
    }
    __device__ __forceinline__ void a_ready(const Unit&) const {}
    __device__ __forceinline__ void done(const Unit&) const {}
};
__device__ __forceinline__ unsigned cvt_pk_bf16(float lo, float hi) { unsigned r; asm volatile("v_cvt_pk_bf16_f32 %0, %1, %2" : "=v"(r) : "v"(lo), "v"(hi)); return r; }
template <class Epi, class Sched, bool ALIGN_EPI = false, bool SP2 = false, bool F8 = false>
__device__ __forceinline__ void gemm_phase(PG8_LAS unsigned char* lds, const Gemm g, const Sched& S, const Epi& E, const int wave_id) {
    int lane_; asm volatile("v_mbcnt_lo_u32_b32 %0, -1, 0\n\tv_mbcnt_hi_u32_b32 %0, -1, %0" : "=v"(lane_));
    int wid_ = wave_id; asm volatile("" : "+s"(wid_));
    const int wid = wid_, lane = lane_, tid = wid * 64 + lane, wr = wid >> 2, wc = wid & 3, fr = lane & 15, fq = lane >> 4;
    const int K = g.K, nt = K / BK;
    unsigned voffA[2], voffB[2];
#pragma unroll
    for (int i = 0; i < 2; ++i) { int R, C; stage_rc(tid * 16 + i * 8192, R, C); const int Rb = Epi::PERM ? ((R & ~31) + perm32(R & 31)) : R;
        const int Ra = Epi::PERMA ? ((R & ~63) | (4 * (R & 15) + ((R >> 4) & 3))) : R;
        voffA[i] = (unsigned)(Ra * K + C) * 2u; voffB[i] = (unsigned)(Rb * K + C) * 2u; }
    const size_t kstep = (size_t)(BK * 2);
    const size_t hstep = (size_t)HALF * K * 2;
    const size_t tstep = 2 * hstep;
    const unsigned ldsw = (unsigned)wid * 1024u;
    const int aoff = lds_byte(wr * 64 + fr, fq * 8), boff = lds_byte(wc * 32 + fr, fq * 8);
#define PG8_SA(b, h) (((b) * 2 + (h)) * HTB)
#define PG8_SB(b, h) ((4 + (b) * 2 + (h)) * HTB)
#define PG8_STAGE(bufoff, gbase, voff) do { _Pragma("unroll") for (int _i = 0; _i < 2; ++_i) \
        __builtin_amdgcn_global_load_lds((const unsigned*)((const char*)(gbase) + (voff)[_i]), (PG8_LAS unsigned*)(lds + (bufoff) + ldsw + _i * 8192), 16, 0, 0); } while (0)
#define PG8_LDA(dst, b, h) do { _Pragma("unroll") for (int m = 0; m < 4; ++m) _Pragma("unroll") for (int k = 0; k < 2; ++k) dst[m][k] = *(const PG8_LAS bf16x8*)(lds + PG8_SA(b, h) + aoff + m * 2048 + k * 1024); } while (0)
#define PG8_LDB(dst, b, h) do { _Pragma("unroll") for (int n = 0; n < 2; ++n) _Pragma("unroll") for (int k = 0; k < 2; ++k) dst[n][k] = *(const PG8_LAS bf16x8*)(lds + PG8_SB(b, h) + boff + n * 2048 + k * 1024); } while (0)
#define PG8_CAT(lo, hi) __builtin_shufflevector(__builtin_bit_cast(i32x4, lo), __builtin_bit_cast(i32x4, hi), 0, 1, 2, 3, 4, 5, 6, 7)
#define PG8_MMA(ai, bj, At, Bt) do { __builtin_amdgcn_s_setprio(1); _Pragma("unroll") for (int m = 0; m < 4; ++m) _Pragma("unroll") for (int n = 0; n < 2; ++n) { \
        if constexpr (F8) { const i32x8 b8_ = PG8_CAT(Bt[n][0], Bt[n][1]), a8_ = PG8_CAT(At[m][0], At[m][1]); asm volatile("v_mfma_f32_16x16x128_f8f6f4 %0, %1, %2, %0" : "+v"(acc[ai][bj][m][n]) : "v"(b8_), "v"(a8_)); } \
        else { _Pragma("unroll") for (int k = 0; k < 2; ++k) acc[ai][bj][m][n] = __builtin_amdgcn_mfma_f32_16x16x32_bf16(Bt[n][k], At[m][k], acc[ai][bj][m][n], 0, 0, 0); } } __builtin_amdgcn_s_setprio(0); } while (0)
#define PG8_WAIT_V(n) asm volatile("s_waitcnt vmcnt(" #n ")" ::: "memory")
#define PG8_WAIT_L(n) asm volatile("s_waitcnt lgkmcnt(" #n ")" ::: "memory")
#define PG8_BAR __builtin_amdgcn_s_barrier()
#define PG8_SCHED __builtin_amdgcn_sched_barrier(0)
    Unit cur, nxt; int ui = 0;
    if (!S.next(0, cur)) return;
    f32x4 acc[2][2][4][2];
#pragma unroll
    for (int a = 0; a < 2; ++a)
#pragma unroll
        for (int b = 0; b < 2; ++b)
#pragma unroll
            for (int m = 0; m < 4; ++m)
#pragma unroll
                for (int n = 0; n < 2; ++n) acc[a][b][m][n] = (f32x4){0.f, 0.f, 0.f, 0.f};
    bf16x8 At[4][2], B0[2][2], B1[2][2];
    const char* cA = (const char*)g.A + (size_t)cur.pm * tstep; const char* cB = (const char*)g.Bt + (size_t)cur.pn * tstep;
    S.a_ready(cur);
    if constexpr (SP2) {
        PG8_STAGE(PG8_SB(0, 0), cB, voffB); PG8_STAGE(PG8_SB(0, 1), cB + hstep, voffB); PG8_STAGE(PG8_SA(0, 0), cA, voffA); PG8_STAGE(PG8_SA(0, 1), cA + hstep, voffA);
        if (wr == 1) PG8_BAR;
        PG8_WAIT_V(2); PG8_BAR;
        PG8_STAGE(PG8_SB(1, 0), cB + kstep, voffB); PG8_STAGE(PG8_SA(1, 0), cA + kstep, voffA); PG8_STAGE(PG8_SB(1, 1), cB + hstep + kstep, voffB);
        PG8_WAIT_V(6); PG8_BAR;
    } else {
        PG8_STAGE(PG8_SB(0, 0), cB, voffB); PG8_STAGE(PG8_SA(0, 0), cA, voffA); PG8_STAGE(PG8_SB(0, 1), cB + hstep, voffB); PG8_STAGE(PG8_SA(0, 1), cA + hstep, voffA);
        if (wr == 1) PG8_BAR;
        PG8_WAIT_V(4); PG8_BAR;
        PG8_STAGE(PG8_SB(1, 0), cB + kstep, voffB); PG8_STAGE(PG8_SA(1, 0), cA + kstep, voffA); PG8_STAGE(PG8_SB(1, 1), cB + hstep + kstep, voffB);
        PG8_WAIT_V(6); PG8_BAR;
    }
    for (;;) {
        const bool has_next = S.next(ui + 1, nxt);
        const char* nA = has_next ? (const char*)g.A + (size_t)nxt.pm * tstep : cA; const char* nB = has_next ? (const char*)g.Bt + (size_t)nxt.pn * tstep : cB;
        for (int t = 0; t < nt; t += 2) { LA_G;
            const bool last = (t == nt - 2);
            const char* a1 = cA + (size_t)(t + 1) * kstep;
            const char* a2 = last ? nA : cA + (size_t)(t + 2) * kstep; const char* b2 = last ? nB : cB + (size_t)(t + 2) * kstep;
            const char* a3 = a2 + kstep; const char* b3 = b2 + kstep;
            if (last && has_next) S.a_ready(nxt);
            if constexpr (SP2) {
            PG8_LDB(B0, 0, 0); PG8_LDB(B1, 0, 1); PG8_SCHED; PG8_LDA(At, 0, 0); PG8_STAGE(PG8_SA(1, 1), a1 + hstep, voffA);
            PG8_WAIT_V(8); PG8_WAIT_L(0); PG8_BAR; PG8_MMA(0, 0, At, B0); PG8_MMA(0, 1, At, B1); PG8_BAR; PG8_SCHED;
            PG8_LDA(At, 0, 1); PG8_STAGE(PG8_SB(0, 0), b2, voffB); PG8_STAGE(PG8_SB(0, 1), b2 + hstep, voffB); PG8_STAGE(PG8_SA(0, 0), a2, voffA);
            PG8_WAIT_V(8); PG8_WAIT_L(0); PG8_BAR; PG8_MMA(1, 0, At, B0); PG8_MMA(1, 1, At, B1); PG8_BAR; PG8_SCHED;
            PG8_LDB(B0, 1, 0); PG8_LDB(B1, 1, 1); PG8_SCHED; PG8_LDA(At, 1, 0); PG8_STAGE(PG8_SA(0, 1), a2 + hstep, voffA);
            PG8_WAIT_V(8); PG8_WAIT_L(0); PG8_BAR; PG8_MMA(0, 0, At, B0); PG8_MMA(0, 1, At, B1); PG8_BAR; PG8_SCHED;
            PG8_LDA(At, 1, 1); PG8_STAGE(PG8_SB(1, 0), b3, voffB); PG8_STAGE(PG8_SB(1, 1), b3 + hstep, voffB); PG8_STAGE(PG8_SA(1, 0), a3, voffA);
            PG8_WAIT_V(8); PG8_WAIT_L(0); PG8_BAR; PG8_MMA(1, 0, At, B0); PG8_MMA(1, 1, At, B1); PG8_BAR; PG8_SCHED;
            } else {
            PG8_LDB(B0, 0, 0); PG8_SCHED; PG8_LDA(At, 0, 0); PG8_STAGE(PG8_SA(1, 1), a1 + hstep, voffA);
            PG8_WAIT_L(8); PG8_BAR; PG8_WAIT_L(0); PG8_MMA(0, 0, At, B0); PG8_BAR; PG8_SCHED;
            PG8_LDB(B1, 0, 1); PG8_STAGE(PG8_SB(0, 0), b2, voffB);
            PG8_BAR; PG8_WAIT_L(0); PG8_MMA(0, 1, At, B1); PG8_BAR;
            PG8_LDA(At, 0, 1); PG8_STAGE(PG8_SA(0, 0), a2, voffA);
            PG8_BAR; PG8_WAIT_L(0); PG8_MMA(1, 0, At, B0); PG8_BAR; PG8_SCHED;
            PG8_STAGE(PG8_SB(0, 1), b2 + hstep, voffB);
            PG8_WAIT_V(6); PG8_BAR; PG8_MMA(1, 1, At, B1); PG8_BAR;
            PG8_LDB(B0, 1, 0); PG8_SCHED; PG8_LDA(At, 1, 0); PG8_STAGE(PG8_SA(0, 1), a2 + hstep, voffA);
            PG8_WAIT_L(8); PG8_BAR; PG8_WAIT_L(0); PG8_MMA(0, 0, At, B0); PG8_BAR; PG8_SCHED;
            PG8_LDB(B1, 1, 1); PG8_STAGE(PG8_SB(1, 0), b3, voffB);
            PG8_BAR; PG8_WAIT_L(0); PG8_MMA(0, 1, At, B1); PG8_BAR;
            PG8_LDA(At, 1, 1); PG8_STAGE(PG8_SA(1, 0), a3, voffA);
            PG8_BAR; PG8_WAIT_L(0); PG8_MMA(1, 0, At, B0); PG8_BAR; PG8_SCHED;
            PG8_STAGE(PG8_SB(1, 1), b3 + hstep, voffB);
            PG8_WAIT_V(6); PG8_BAR; PG8_MMA(1, 1, At, B1); PG8_BAR;
            }
        }
        if constexpr (F8) asm volatile("s_nop 15\n\ts_nop 15" ::: "memory");
        if constexpr (ALIGN_EPI) { if (wr == 0) PG8_BAR; }
        if constexpr (!Epi::AFTER_DRAIN) { E(acc, cur, wr, wc, fr, fq); S.done(cur); }
        if (!has_next) break;
#pragma unroll
        for (int a = 0; a < 2; ++a)
#pragma unroll
            for (int b = 0; b < 2; ++b)
#pragma unroll
                for (int m = 0; m < 4; ++m)
#pragma unroll
                    for (int n = 0; n < 2; ++n) acc[a][b][m][n] = (f32x4){0.f, 0.f, 0.f, 0.f};
        cur = nxt; cA = nA; cB = nB; ++ui;
        if constexpr (ALIGN_EPI) { if (wr == 1) PG8_BAR; }
    }
    PG8_WAIT_V(0);
    if constexpr (!ALIGN_EPI) { if (wr == 0) PG8_BAR; }
    PG8_BAR;
    if constexpr (Epi::AFTER_DRAIN) { E.fused(acc, cur, wr, wc, fr, fq, lds, wid, lane); S.done(cur); }
#undef PG8_SA
#undef PG8_SB
#undef PG8_STAGE
#undef PG8_LDA
#undef PG8_LDB
#undef PG8_MMA
#undef PG8_CAT
#undef PG8_WAIT_V
#undef PG8_WAIT_L
#undef PG8_BAR
#undef PG8_SCHED
}
}

constexpr int NWAVES = 8, GRID = 256;
constexpr int BATCH = 4, SEQ = 8192, DM = 1024, MTOK = BATCH * SEQ, DEPTH = 4;
constexpr int NA_SRC = 2120, NA_PAD = 2304, NB = 3072, FF = 2816, NUP = 2 * FF;
constexpr float EPS = 1e-6f;
constexpr float LOG2E = 1.4426950408889634f;
constexpr float C2 = 0.125f * LOG2E;
constexpr int NBLK64 = MTOK / 64;

constexpr size_t MiB = 1u << 20;
constexpr size_t WS_CTL = 0, CTL_ZERO_BYTES = 1 * MiB;
constexpr size_t WS_W_INA = 2 * MiB;
constexpr size_t WS_W_INB = 11 * MiB;
constexpr size_t WS_W_OUT = 23 * MiB;
constexpr size_t WS_W_UP = 31 * MiB;
constexpr size_t WS_W_DN = 75 * MiB;
constexpr size_t WS_HB = 98 * MiB;
constexpr size_t WS_M = 162 * MiB;
constexpr size_t WS_SS = 226 * MiB;
constexpr size_t WS_HALO = 228 * MiB;
constexpr size_t WS_PROJ = 272 * MiB;
constexpr size_t WS_W_INA8 = 464 * MiB;
constexpr size_t WS_END = 469 * MiB;
constexpr size_t PA_QA = 0, PA_KA = 64 * MiB, PA_VA = 80 * MiB, PA_QI = 96 * MiB, PA_KI = 128 * MiB, PA_WI = 132 * MiB, PA_SEL = 136 * MiB;
constexpr size_t PB_STRIDE = 64 * MiB;
constexpr int CW_BAR = 4096;
constexpr int F8_L0 = 2;
#ifndef F8M_IN
#define F8M_IN 0x8
#endif
#ifndef F8M_OUT
#define F8M_OUT 0xC
#endif
#ifndef F8M_FFN
#define F8M_FFN 0xC
#endif
#define F8M_ALL ((F8M_IN & 0xF) | ((F8M_OUT & 0xF) << 4) | ((F8M_FFN & 0xF) << 8))
__host__ __device__ constexpr bool f8_in(int m, int L) { return L < DEPTH && ((m >> L) & 1) != 0; }
__host__ __device__ constexpr bool f8_out(int m, int L) { return ((m >> (4 + L)) & 1) != 0; }
__host__ __device__ constexpr bool f8_ffn(int m, int L) { return ((m >> (8 + L)) & 1) != 0; }
constexpr size_t PX_HB8 = 96 * MiB;
constexpr float W8S = 128.f, W8I = 1.f / 128.f;

constexpr int RING_OFF = 0, RING_BYTES = 131072;
constexpr int KS_OFF = RING_BYTES;
constexpr int AUX_OFF = RING_BYTES + 24576;
constexpr int LDSCTL_OFF = AUX_OFF + 4096, MISC_OFF = LDSCTL_OFF + 320;
constexpr int LDS_BYTES = 163840;
static_assert(MISC_OFF + 128 <= LDS_BYTES, "LDS map");

#define GAS __attribute__((address_space(1)))
#define LAS __attribute__((address_space(3)))
typedef unsigned short bf16;
typedef unsigned v4u __attribute__((ext_vector_type(4)));
typedef unsigned v2u __attribute__((ext_vector_type(2)));
typedef float f32x4 __attribute__((ext_vector_type(4)));
typedef float f32x16 __attribute__((ext_vector_type(16)));
typedef short bf16x8 __attribute__((ext_vector_type(8)));
typedef short s16x4 __attribute__((ext_vector_type(4)));
typedef float f32x2_t __attribute__((ext_vector_type(2)));
typedef GAS unsigned gu32;
#define RLX_AGENT __ATOMIC_RELAXED, __HIP_MEMORY_SCOPE_AGENT
#define LDS_WAIT() asm volatile("s_waitcnt lgkmcnt(0)" ::: "memory")
#define VM_WAIT() asm volatile("s_waitcnt vmcnt(0)" ::: "memory")
__device__ __forceinline__ unsigned f2bf(float f) { unsigned u = __builtin_bit_cast(unsigned, f); return (u + 0x7fffu + ((u >> 16) & 1u)) >> 16; }
__device__ __forceinline__ unsigned pk2(float lo, float hi) { return f2bf(lo) | (f2bf(hi) << 16); }
typedef float f32x2c_t __attribute__((ext_vector_type(2))); typedef __bf16 bf16x2c_t __attribute__((ext_vector_type(2)));
__device__ __forceinline__ unsigned cvtpk(float lo, float hi) { const f32x2c_t v = {lo, hi}; const bf16x2c_t b = __builtin_convertvector(v, bf16x2c_t); return __builtin_bit_cast(unsigned, b); }
__device__ __forceinline__ float bf_lo(unsigned u) { return __builtin_bit_cast(float, u << 16); }
__device__ __forceinline__ float bf_hi(unsigned u) { return __builtin_bit_cast(float, u & 0xffff0000u); }

__device__ __forceinline__ unsigned pk4f8(float a, float b, float c, float d) { int r = __builtin_amdgcn_cvt_pk_fp8_f32(a, b, 0, false); r = __builtin_amdgcn_cvt_pk_fp8_f32(c, d, r, true); return (unsigned)r; }

#define XB_TMO      128
#define XB_XCNT(j)  (256  + 64 * (j))
#define XB_XSUB(j)  (1280 + 64 * (j))
#define XB_XGEN(j)  (2304 + 64 * (j))
#define XB_TOP      3328
#define XB_TOPGEN   3392
#define XCD_BAR_WORDS 3456
#define XB_SPIN_CAP (1u << 18)

__device__ __forceinline__ unsigned xb_ld(unsigned* p)              { return __hip_atomic_load(p, __ATOMIC_RELAXED, __HIP_MEMORY_SCOPE_AGENT); }
__device__ __forceinline__ unsigned xb_add(unsigned* p, unsigned v) { return __hip_atomic_fetch_add(p, v, __ATOMIC_RELAXED, __HIP_MEMORY_SCOPE_AGENT); }
__device__ __forceinline__ unsigned xb_xcc_id() { return (unsigned)__builtin_amdgcn_s_getreg((3 << 11) | 20) & 0xFu; }
#define XB_SPIN(cond, bar) do { unsigned _sp = 0; while (cond) { __builtin_amdgcn_s_sleep(1); \
    if ((++_sp & 255u) == 0u) { if (xb_ld(&(bar)[XB_TMO])) break; if (_sp > XB_SPIN_CAP) { atomicAdd(&(bar)[XB_TMO], 1u); break; } } } } while (0)

struct XcdBarrier {
    unsigned* bar; unsigned x;
    volatile LAS unsigned* st;
};

__device__ __forceinline__ XcdBarrier xcd_barrier_post(unsigned* bar, volatile LAS unsigned* st) {
    XcdBarrier b; b.bar = bar; b.x = xb_xcc_id(); b.st = st;
    if (threadIdx.x == 0) (void)xb_add(&bar[XB_XCNT(b.x)], 1u);
    return b;
}
__device__ __forceinline__ void xcd_barrier_complete(unsigned* bar, unsigned x, unsigned& nloc, unsigned& nx) {
    const unsigned G = gridDim.x * gridDim.y * gridDim.z;
    unsigned sum, cnt, mine, sp = 0u;
    for (;;) {
        sum = 0u; cnt = 0u; mine = 0u;
#pragma unroll
        for (unsigned j = 0; j < 16; ++j) { const unsigned c = xb_ld(&bar[XB_XCNT(j)]); sum += c; cnt += (c > 0u) ? 1u : 0u; mine = (j == x) ? c : mine; }
        if (sum == G) break;
        __builtin_amdgcn_s_sleep(1);
        if ((++sp & 255u) == 0u) { if (xb_ld(&bar[XB_TMO])) break; if (sp > XB_SPIN_CAP) { atomicAdd(&bar[XB_TMO], 1u); break; } }
    }
    nloc = mine > 0u ? mine : 1u; nx = cnt > 0u ? cnt : 1u;
}

__device__ __forceinline__ void xcd_barrier(const XcdBarrier& b) {
    asm volatile("s_waitcnt vmcnt(0)" ::: "memory");
    __syncthreads();
    if (threadIdx.x == 0) {
        unsigned* bar = b.bar;
        __builtin_amdgcn_s_waitcnt(0);
        unsigned nloc = b.st[0], nx = b.st[1];
        if (nloc == 0u) { xcd_barrier_complete(bar, b.x, nloc, nx); b.st[0] = nloc; b.st[1] = nx; }
        const unsigned old = xb_add(&bar[XB_XSUB(b.x)], 1u);
        const unsigned gen = old / nloc;
        if (old + 1u == (gen + 1u) * nloc) {
            __builtin_amdgcn_fence(__ATOMIC_RELEASE, "agent");
            asm volatile("s_waitcnt vmcnt(0)" ::: "memory");
            const unsigned og = xb_add(&bar[XB_TOP], 1u);
            const unsigned tg = og / nx;
            if (og + 1u == (tg + 1u) * nx) xb_add(&bar[XB_TOPGEN], 1u);
            else XB_SPIN(xb_ld(&bar[XB_TOPGEN]) == tg, bar);
            __builtin_amdgcn_fence(__ATOMIC_ACQUIRE, "agent");
            xb_add(&bar[XB_XGEN(b.x)], 1u);
            asm volatile("s_waitcnt vmcnt(0)" ::: "memory");
        } else {
            XB_SPIN(xb_ld(&bar[XB_XGEN(b.x)]) == gen, bar);
            __builtin_amdgcn_fence(__ATOMIC_ACQUIRE, "agent");
            asm volatile("s_waitcnt vmcnt(0)" ::: "memory");
        }
    }
    __syncthreads();
}


struct Args {
    const float* x; const float* attn_norm_g; const float* w_in_a; const float* w_in_b; const float* q_norm_g; const float* k_norm_g; const float* t5_bias;
    const float* rel_bias_b; const float* w_out; const float* ffn_norm_g; const float* w_up; const float* conv_w; const float* conv_b; const float* w_down;
    float* out; unsigned char* ws; int ph_lo, ph_hi, li, f8m;
};

struct Frame {
    LAS unsigned char* lds;
    volatile LAS unsigned* MISC;
    gu32* ctl;
    int tid, lane, wave, vcu, G;
};

__host__ __device__ __forceinline__ int hmap(int p) { return 64 * ((p >> 5) & 3) + 16 * ((p >> 2) & 3) + 8 * (p >> 7) + 4 * ((p >> 4) & 1) + (p & 3); }
__host__ __device__ __forceinline__ int umap(int p) { return 32 * ((p >> 5) & 3) + 8 * ((p >> 2) & 3) + 4 * ((p >> 4) & 1) + (p & 3); }
__host__ __device__ __forceinline__ int src_col(int type, int n) {
    if (type == 0) return n;
    const int pn = n >> 8, p = n & 255;
    if (type == 2) return 256 * pn + hmap(p);
    if (type == 1) { const int c = hmap(p); return pn < 8 ? 256 * pn + c : (c < 72 ? 2048 + c : -1); }
    return (p >> 7) * FF + 128 * pn + umap(p);
}
__device__ __forceinline__ void convert_item(const float* W, int K, int Nsrc, int Ndst, int type, const float* gain, bf16* WT, LAS float* scr, int item, int lane, bool o8 = false) {
    const int nblk = Ndst / 32, kb = item / nblk, nb = item % nblk, k0 = 64 * kb, n0 = 32 * nb;
    const int sc = src_col(type, n0 + (lane & 31));
#pragma unroll 8
    for (int i = 0; i < 32; ++i) { const int kk = 2 * i + (lane >> 5); float v = 0.f; if (sc >= 0) v = W[(size_t)(k0 + kk) * Nsrc + sc]; if (gain) v *= gain[k0 + kk]; scr[kk * 33 + (lane & 31)] = v; }
    LDS_WAIT(); asm volatile("" ::: "memory");
    const int c = lane & 7;
#pragma unroll
    for (int j = 0; j < 4; ++j) { const int n = (lane >> 3) + 8 * j; const LAS float* s = scr + (8 * c) * 33 + n;
        if (o8) { v2u o; o.x = pk4f8(s[0 * 33] * W8S, s[1 * 33] * W8S, s[2 * 33] * W8S, s[3 * 33] * W8S); o.y = pk4f8(s[4 * 33] * W8S, s[5 * 33] * W8S, s[6 * 33] * W8S, s[7 * 33] * W8S);
            *(v2u*)((unsigned char*)WT + (size_t)(n0 + n) * K + k0 + 8 * c) = o; }
        else { v4u o; o.x = pk2(s[0 * 33], s[1 * 33]); o.y = pk2(s[2 * 33], s[3 * 33]); o.z = pk2(s[4 * 33], s[5 * 33]); o.w = pk2(s[6 * 33], s[7 * 33]);
            *(v4u*)(WT + (size_t)(n0 + n) * K + k0 + 8 * c) = o; } }
    LDS_WAIT(); asm volatile("" ::: "memory");
}
__device__ __forceinline__ float wave_sum(float v) {
#pragma unroll
    for (int o = 1; o < 64; o <<= 1) v += __shfl_xor(v, o);
    return v;
}
#ifdef F8M_RUNTIME
#define F8MV a.f8m
#else
#define F8MV F8M_ALL
#endif
__device__ __forceinline__ void p0_prologue(Frame& F, const Args& a) {
    LAS float* scr = (LAS float*)(F.lds + RING_OFF + F.wave * 16384);
    const int gw = F.vcu * NWAVES + F.wave, NGW = F.G * NWAVES;
    constexpr int I_INA = 16 * (NA_PAD / 32), I_INB = 16 * (NB / 32), I_OUT = 16 * 32, I_UP = 16 * (NUP / 32), I_DN = (FF / 64) * 32;
    constexpr int I_INA8 = 16 * (1536 / 32);
    constexpr int NITEMS = 2 * I_INA + 2 * I_INB + 4 * I_OUT + 4 * I_UP + 4 * I_DN + 2 * I_INA8;
    unsigned char* ws = a.ws;
    for (int it = gw; it < NITEMS; it += NGW) {
        int r = it;
        if (r < 2 * I_INA) { const int l = r / I_INA; convert_item(a.w_in_a + (size_t)l * DM * NA_SRC, DM, NA_SRC, NA_PAD, 1, a.attn_norm_g + (2 * l) * DM, (bf16*)(ws + WS_W_INA) + (size_t)l * NA_PAD * DM, scr, r % I_INA, F.lane); continue; } r -= 2 * I_INA;
        if (r < 2 * I_INB) { const int l = r / I_INB; convert_item(a.w_in_b + (size_t)l * DM * NB, DM, NB, NB, 2, a.attn_norm_g + (2 * l + 1) * DM, (bf16*)(ws + WS_W_INB) + (size_t)l * NB * DM, scr, r % I_INB, F.lane, f8_in(F8MV, 2 * l + 1)); continue; } r -= 2 * I_INB;
        if (r < 4 * I_OUT) { const int l = r / I_OUT; convert_item(a.w_out + (size_t)l * DM * DM, DM, DM, DM, 0, nullptr, (bf16*)(ws + WS_W_OUT) + (size_t)l * DM * DM, scr, r % I_OUT, F.lane, f8_out(F8MV, l)); continue; } r -= 4 * I_OUT;
        if (r < 4 * I_UP) { const int l = r / I_UP; convert_item(a.w_up + (size_t)l * DM * NUP, DM, NUP, NUP, 3, a.ffn_norm_g + l * DM, (bf16*)(ws + WS_W_UP) + (size_t)l * NUP * DM, scr, r % I_UP, F.lane, f8_ffn(F8MV, l)); continue; } r -= 4 * I_UP;
        if (r >= 4 * I_DN) { r -= 4 * I_DN; const int l = r / I_INA8, i8 = r % I_INA8; if (f8_in(F8MV, 2 * l)) convert_item(a.w_in_a + (size_t)l * DM * NA_SRC, DM, NA_SRC, NA_PAD, 1, a.attn_norm_g + (2 * l) * DM, (bf16*)(ws + WS_W_INA8 + (size_t)l * NA_PAD * DM), scr, (i8 / 48) * (NA_PAD / 32) + i8 % 48, F.lane, true); continue; }
        { const int l = r / I_DN; convert_item(a.w_down + (size_t)l * FF * DM, FF, DM, DM, 0, nullptr, (bf16*)(ws + WS_W_DN) + (size_t)l * DM * FF, scr, r % I_DN, F.lane, f8_ffn(F8MV, l)); }
    }
    bf16* hb = (bf16*)(ws + WS_HB); float* ss = (float*)(ws + WS_SS);
    for (int m = gw; m < MTOK; m += NGW) {
        const f32x4* xr = (const f32x4*)(a.x + (size_t)m * DM) + F.lane; f32x4 v[4]; float s = 0.f;
#pragma unroll
        for (int j = 0; j < 4; ++j) { v[j] = xr[64 * j]; s += (v[j].x * v[j].x + v[j].y * v[j].y) + (v[j].z * v[j].z + v[j].w * v[j].w); }
        s = wave_sum(s);
        v2u* o8 = (v2u*)(hb + (size_t)m * DM) + F.lane;
#pragma unroll
        for (int j = 0; j < 4; ++j) { v2u w; w.x = pk2(v[j].x, v[j].y); w.y = pk2(v[j].z, v[j].w); o8[64 * j] = w; }
        if (f8_in(F8MV, 0)) { unsigned* o4 = (unsigned*)(ws + WS_M + (size_t)m * DM) + F.lane;
#pragma unroll
            for (int j = 0; j < 4; ++j) o4[64 * j] = pk4f8(v[j].x, v[j].y, v[j].z, v[j].w); }
        if (F.lane < 16) ss[(size_t)m * 16 + F.lane] = (F.lane == 0) ? s : 0.f;
    }
}

__device__ __forceinline__ f32x4 rstd_load(const float* ss, int row, int fq) { return *(const f32x4*)(ss + (size_t)row * 16 + 4 * fq); }
__device__ __forceinline__ float rstd_finish(f32x4 a) {
    float s = (a.x + a.y) + (a.z + a.w);
    s += __shfl_xor(s, 16); s += __shfl_xor(s, 32);
    return __builtin_amdgcn_rsqf(s * (1.0f / DM) + EPS);
}
__device__ __forceinline__ float row_rstd(const float* ss, int row, int fq) { return rstd_finish(rstd_load(ss, row, fq)); }
__device__ __forceinline__ unsigned att_pk4(f32x4 v) { int r = __builtin_amdgcn_cvt_pk_fp8_f32(v.x, v.y, 0, false); r = __builtin_amdgcn_cvt_pk_fp8_f32(v.z, v.w, r, true); return (unsigned)r; }
struct EpiIn {
    static constexpr bool PERM = false, PERMA = false, AFTER_DRAIN = false;
    const float* ss; unsigned char* proj; const float* qg; const float* kg; int isB; float as; int pn0;
    __device__ __forceinline__ void operator()(const pg8::f32x4 (&acc)[2][2][4][2], const pg8::Unit& u, int wr, int wc, int fr, int fq) const {
        asm volatile("" : "+v"(fr), "+v"(fq));
        const int pn = u.pn + pn0; int kind, pitch; bf16* dst;
        if (isB) { const int t = pn >> 2; kind = (t == 0) ? 1 : (t == 1 ? 2 : 0); dst = (bf16*)(proj + (size_t)t * PB_STRIDE) + 256 * (pn & 3); pitch = DM; }
        else if (pn < 4) { kind = 1; dst = (bf16*)(proj + PA_QA) + 256 * pn; pitch = DM; }
        else if (pn == 4) { kind = 2; dst = (bf16*)(proj + PA_KA); pitch = 256; }
        else if (pn == 5) { kind = 0; dst = (bf16*)(proj + PA_VA); pitch = 256; }
        else if (pn < 8) { kind = 0; dst = (bf16*)(proj + PA_QI) + 256 * (pn - 6); pitch = 512; }
        else { kind = 3; dst = (bf16*)(proj + PA_KI); pitch = 64; }
        if (kind == 3 && wc >= 2) return;
        const bool donorm = (kind == 1) || (kind == 2) || (kind == 3 && wc == 0);
        f32x4 g[2][2];
#pragma unroll
        for (int bj = 0; bj < 2; ++bj)
#pragma unroll
            for (int n = 0; n < 2; ++n) {
                if (kind == 1) g[bj][n] = *(const f32x4*)(qg + 16 * fq + 8 * bj + 4 * n) * (isB ? C2 : 1.0f);
                else if (kind == 2) g[bj][n] = *(const f32x4*)(kg + 16 * fq + 8 * bj + 4 * n);
                else g[bj][n] = (f32x4){1.f, 1.f, 1.f, 1.f};
            }
        float* wi = (float*)(proj + PA_WI);
        f32x4 rsl[2][4];
#pragma unroll
        for (int ai = 0; ai < 2; ++ai)
#pragma unroll
            for (int m = 0; m < 4; ++m) rsl[ai][m] = rstd_load(ss, u.pm * 256 + ai * 128 + wr * 64 + m * 16 + fr, fq);
#pragma unroll
        for (int ai = 0; ai < 2; ++ai)
#pragma unroll
            for (int m = 0; m < 4; ++m) {
                const int row = u.pm * 256 + ai * 128 + wr * 64 + m * 16 + fr;
                const float rs = rstd_finish(rsl[ai][m]) * as;
                f32x4 v[2][2]; float s = 0.f;
#pragma unroll
                for (int bj = 0; bj < 2; ++bj)
#pragma unroll
                    for (int n = 0; n < 2; ++n) { v[bj][n] = acc[ai][bj][m][n] * rs; const f32x4 q = v[bj][n] * v[bj][n]; s += (q.x + q.y) + (q.z + q.w); }
                if (donorm) {
                    s += __shfl_xor(s, 16); s += __shfl_xor(s, 32);
                    const float r = 1.0f / sqrtf(s * (1.0f / 64.0f) + EPS);
#pragma unroll
                    for (int bj = 0; bj < 2; ++bj)
#pragma unroll
                        for (int n = 0; n < 2; ++n) v[bj][n] = v[bj][n] * r * g[bj][n];
                }
                if (kind == 3 && wc == 1) {
                    if (fq == 0) { float* wp = wi + (size_t)row * 8; const float sc = 0.04419417382415922f;
                        *(f32x4*)(wp) = v[0][0] * sc; *(f32x4*)(wp + 4) = v[0][1] * sc; }
                } else if (!isB && pn < 6) {
                    unsigned char* p8 = (pn < 4) ? proj + PA_QA + (size_t)row * 1024 + 256 * pn + 64 * wc + 16 * fq : proj + PA_KA + (size_t)row * 512 + 128 * wc + 64 * (pn - 4) + 16 * fq;
                    v4u w; w.x = att_pk4(v[0][0]); w.y = att_pk4(v[0][1]); w.z = att_pk4(v[1][0]); w.w = att_pk4(v[1][1]);
                    *(v4u*)p8 = w;
                } else {
                    bf16* rp = dst + (size_t)row * pitch + 64 * wc + 16 * fq;
#pragma unroll
                    for (int bj = 0; bj < 2; ++bj) { v4u w; w.x = cvtpk(v[bj][0].x, v[bj][0].y); w.y = cvtpk(v[bj][0].z, v[bj][0].w); w.z = cvtpk(v[bj][1].x, v[bj][1].y); w.w = cvtpk(v[bj][1].z, v[bj][1].w);
                        *(v4u*)(rp + 8 * bj) = w; }
                }
            }
    }
};
template <int MODE>
struct EpiResT {
    static constexpr bool PERM = false, PERMA = false, AFTER_DRAIN = false;
    float* fout; const bf16* hbi; bf16* hb; float* ss; unsigned char* hb8; const float* xin;
    __device__ __forceinline__ void operator()(const pg8::f32x4 (&acc)[2][2][4][2], const pg8::Unit& u, int wr, int wc, int fr, int fq) const {
        if (fout) body<true, false, false>(acc, u, wr, wc, fr, fq); else if (hb8) body<false, true, false>(acc, u, wr, wc, fr, fq); else if (xin) body<false, false, true>(acc, u, wr, wc, fr, fq); else body<false, false, false>(acc, u, wr, wc, fr, fq);
    }
    template <bool FOUT, bool HB8, bool XIN>
    __device__ __forceinline__ void body(const pg8::f32x4 (&acc)[2][2][4][2], const pg8::Unit& u, int wr, int wc, int fr, int fq) const {
        asm volatile("" : "+v"(fr), "+v"(fq));
        const int col0 = u.pn * 256 + wc * 32 + 4 * fq;
#pragma unroll
        for (int ai = 0; ai < 2; ++ai) {
            v2u base[4][2][2]; f32x4 basex[XIN ? 4 : 1][2][2];
#pragma unroll
            for (int m = 0; m < 4; ++m)
#pragma unroll
                for (int bj = 0; bj < 2; ++bj)
#pragma unroll
                    for (int n = 0; n < 2; ++n) { const size_t o4 = (size_t)(u.pm * 256 + ai * 128 + wr * 64 + m * 16 + fr) * DM + col0 + bj * 128 + n * 16; if constexpr (XIN) basex[m][bj][n] = *(const f32x4*)(xin + o4); else base[m][bj][n] = *(const v2u*)(hbi + o4);
                        if ((MODE & 4) && n == 1) asm volatile("s_waitcnt vmcnt(0)" ::: "memory"); }
            asm volatile("" ::: "memory");
#pragma unroll
            for (int m = 0; m < 4; ++m) {
                const int row = u.pm * 256 + ai * 128 + wr * 64 + m * 16 + fr; const size_t off = (size_t)row * DM + col0; float s = 0.f;
#pragma unroll
                for (int bj = 0; bj < 2; ++bj)
#pragma unroll
                    for (int n = 0; n < 2; ++n) { const size_t o4 = off + bj * 128 + n * 16;
                        f32x4 bs; if constexpr (XIN) bs = basex[m][bj][n]; else { const v2u b = base[m][bj][n]; bs = (f32x4){bf_lo(b.x), bf_hi(b.x), bf_lo(b.y), bf_hi(b.y)}; }
                        const f32x4 o = (MODE & 1) ? bs + acc[ai][bj][m][n] * W8I : bs + acc[ai][bj][m][n];
                        if constexpr (FOUT) *(f32x4*)(fout + o4) = o;
                        else { const f32x4 q = o * o; s += (q.x + q.y) + (q.z + q.w); v2u w; w.x = cvtpk(o.x, o.y); w.y = cvtpk(o.z, o.w); *(v2u*)(hb + o4) = w;
                            if constexpr (HB8) *(unsigned*)(hb8 + o4) = pk4f8(o.x, o.y, o.z, o.w); } }
                if constexpr (!FOUT) { s += __shfl_xor(s, 16); s += __shfl_xor(s, 32); if (fq == 0) ss[(size_t)row * 16 + u.pn * 4 + wc] = s; }
            }
        }
    }
};
typedef EpiResT<0> EpiRes;
#ifndef SER_OUT
#define SER_OUT 0
#endif
#ifdef X_NOBPERM
__device__ __forceinline__ float lane_from(int byteaddr, float v) { return v + (float)byteaddr; }
#else
__device__ __forceinline__ float lane_from(int byteaddr, float v) { return __builtin_bit_cast(float, __builtin_amdgcn_ds_bpermute(byteaddr, __builtin_bit_cast(int, v))); }
#endif
#ifdef X_NOSILU
__device__ __forceinline__ float silu_mul(float a, float g) { return a * g; }
#else
__device__ __forceinline__ float silu_mul(float a, float g) { return a * g * __builtin_amdgcn_rcpf(1.0f + __builtin_amdgcn_exp2f(-g * LOG2E)); }
#endif
__device__ __forceinline__ float dpp_prev_lane(float v) { return __builtin_bit_cast(float, __builtin_amdgcn_update_dpp(0, __builtin_bit_cast(int, v), 0x111  , 0xf, 0xf, true)); }
template <bool F8>
struct EpiUpT {
    static constexpr bool PERM = false, PERMA = true, AFTER_DRAIN = false;
    const float* ss; const float* cw; const float* cb; bf16* act; float* halo; LAS float* cl;
    __device__ __forceinline__ void operator()(const pg8::f32x4 (&acc)[2][2][4][2], const pg8::Unit& u, int wr, int wc, int fr, int fq) const {
        asm volatile("" : "+v"(fr), "+v"(fq));
        const int colb = u.pn * 128 + wc * 32 + 8 * fq;
        const int tid_ = ((wr * 4 + wc) * 4 + fq) * 16 + fr, ce = 2 * tid_, cbj = ce >> 9, carr = (ce >> 7) & 3, cc = ce & 127;
        const f32x2_t cpre = *(const f32x2_t*)((carr < 3 ? cw + carr * NUP : cb) + cbj * FF + u.pn * 128 + cc);
        f32x4 rsl[2][4];
#pragma unroll
        for (int ai = 0; ai < 2; ++ai)
#pragma unroll
            for (int m = 0; m < 4; ++m) rsl[ai][m] = rstd_load(ss, (u.pm * 4 + ai * 2 + wr) * 64 + 4 * fr + m, fq);
        unsigned pk[2][2][4][2][2];
#pragma unroll
        for (int ai = 0; ai < 2; ++ai) {
#pragma unroll
            for (int m = 0; m < 4; ++m) {
                const float rs = F8 ? rstd_finish(rsl[ai][m]) * W8I : rstd_finish(rsl[ai][m]);
#pragma unroll
                for (int bj = 0; bj < 2; ++bj)
#pragma unroll
                    for (int n = 0; n < 2; ++n) { const f32x4 v = acc[ai][bj][m][n] * rs; pk[ai][bj][m][n][0] = cvtpk(v.x, v.y); pk[ai][bj][m][n][1] = cvtpk(v.z, v.w); }
            }
        }
        *(LAS f32x2_t*)(cl + ce) = cpre;
        asm volatile("s_waitcnt lgkmcnt(0)" ::: "memory"); __builtin_amdgcn_s_barrier(); asm volatile("" ::: "memory");
        __builtin_amdgcn_sched_barrier(0);
        if (fr == 0 || fr == 15) {
#pragma unroll
            for (int ai = 0; ai < 2; ++ai)
#pragma unroll
                for (int j = 0; j < 2; ++j)
#pragma unroll
                    for (int bj = 0; bj < 2; ++bj)
#pragma unroll
                        for (int n = 0; n < 2; ++n) { const unsigned w0 = (fr == 0) ? pk[ai][bj][j][n][0] : pk[ai][bj][2 + j][n][0], w1 = (fr == 0) ? pk[ai][bj][j][n][1] : pk[ai][bj][2 + j][n][1];
                            *(f32x4*)(halo + ((size_t)(u.pm * 4 + ai * 2 + wr) * 4 + (fr == 0 ? j : 2 + j)) * NUP + bj * FF + colb + 4 * n) = (f32x4){bf_lo(w0), bf_hi(w0), bf_lo(w1), bf_hi(w1)}; }
        }
        __builtin_amdgcn_sched_barrier(0);
#pragma unroll
        for (int ai = 0; ai < 2; ++ai) {
            const int row0 = (u.pm * 4 + ai * 2 + wr) * 64 + 4 * fr;
            unsigned outp[4][2][2];
#pragma unroll
            for (int n = 0; n < 2; ++n) {
#pragma unroll
                for (int ip = 0; ip < 2; ++ip) {
                    f32x2_t k0[2], k1[2], k2[2], kb[2];
#pragma unroll
                    for (int bj = 0; bj < 2; ++bj) { const LAS float* c = cl + bj * 512 + wc * 32 + 8 * fq + 4 * n + 2 * ip; k0[bj] = *(const LAS f32x2_t*)(c); k1[bj] = *(const LAS f32x2_t*)(c + 128); k2[bj] = *(const LAS f32x2_t*)(c + 256); kb[bj] = *(const LAS f32x2_t*)(c + 384); }
                    float y[2][4][2];
#pragma unroll
                    for (int bj = 0; bj < 2; ++bj) {
                        const unsigned w0 = pk[ai][bj][0][n][ip], w1 = pk[ai][bj][1][n][ip], w2 = pk[ai][bj][2][n][ip], w3 = pk[ai][bj][3][n][ip];
                        const unsigned q1 = (unsigned)__builtin_amdgcn_update_dpp(0, (int)w3, 0x111, 0xf, 0xf, true), q2 = (unsigned)__builtin_amdgcn_update_dpp(0, (int)w2, 0x111, 0xf, 0xf, true);
#pragma unroll
                        for (int e = 0; e < 2; ++e) { const int i = e;
                            const float u0 = e ? bf_hi(w0) : bf_lo(w0), u1 = e ? bf_hi(w1) : bf_lo(w1), u2 = e ? bf_hi(w2) : bf_lo(w2), u3 = e ? bf_hi(w3) : bf_lo(w3), p1 = e ? bf_hi(q1) : bf_lo(q1), p2 = e ? bf_hi(q2) : bf_lo(q2);
                            y[bj][0][e] = kb[bj][i] + k0[bj][i] * p2 + k1[bj][i] * p1 + k2[bj][i] * u0;
                            y[bj][1][e] = kb[bj][i] + k0[bj][i] * p1 + k1[bj][i] * u0 + k2[bj][i] * u1;
                            y[bj][2][e] = kb[bj][i] + k0[bj][i] * u0 + k1[bj][i] * u1 + k2[bj][i] * u2;
                            y[bj][3][e] = kb[bj][i] + k0[bj][i] * u1 + k1[bj][i] * u2 + k2[bj][i] * u3; }
                    }
#pragma unroll
                    for (int m = 0; m < 4; ++m) {
                        if constexpr (F8) { if (ip == 0) outp[m][n][0] = (unsigned)__builtin_amdgcn_cvt_pk_fp8_f32(silu_mul(y[0][m][0], y[1][m][0]), silu_mul(y[0][m][1], y[1][m][1]), 0, false);
                            else outp[m][n][0] = (unsigned)__builtin_amdgcn_cvt_pk_fp8_f32(silu_mul(y[0][m][0], y[1][m][0]), silu_mul(y[0][m][1], y[1][m][1]), (int)outp[m][n][0], true); }
                        else outp[m][n][ip] = cvtpk(silu_mul(y[0][m][0], y[1][m][0]), silu_mul(y[0][m][1], y[1][m][1])); }
                }
            }
#pragma unroll
            for (int m = 0; m < 4; ++m) {
                if (m < 2 && fr == 0) continue;
                if constexpr (F8) { v2u w; w.x = outp[m][0][0]; w.y = outp[m][1][0]; *(v2u*)((unsigned char*)act + (size_t)(row0 + m) * FF + colb) = w; }
                else { v4u w; w.x = outp[m][0][0]; w.y = outp[m][0][1]; w.z = outp[m][1][0]; w.w = outp[m][1][1];
                    *(v4u*)(act + (size_t)(row0 + m) * FF + colb) = w; }
            }
            asm volatile("" ::: "memory");
        }
    }
};
typedef EpiUpT<false> EpiUp;
struct EpiDummy {
    static constexpr bool PERM = false, PERMA = true, AFTER_DRAIN = false;
    float* scratch;
    __device__ __forceinline__ void operator()(const pg8::f32x4 (&acc)[2][2][4][2], const pg8::Unit& u, int wr, int wc, int fr, int fq) const {
        f32x4 s = (f32x4){0.f, 0.f, 0.f, 0.f};
#pragma unroll
        for (int ai = 0; ai < 2; ++ai)
#pragma unroll
            for (int bj = 0; bj < 2; ++bj)
#pragma unroll
                for (int m = 0; m < 4; ++m)
#pragma unroll
                    for (int n = 0; n < 2; ++n) s += acc[ai][bj][m][n];
        scratch[(size_t)(u.pm * 22 + u.pn) * 512 + ((wr * 4 + wc) * 4 + fq) * 16 + fr] = (s.x + s.y) + (s.z + s.w);
    }
};
template <bool F8>
__device__ __forceinline__ void fixup_phase(Frame& F, const float* cw, const float* cb, const float* halo, bf16* act) {
    const int gt = F.vcu * (NWAVES * 64) + F.tid, NT = F.G * NWAVES * 64;
    constexpr int C4 = FF / 4;
    for (int it = gt; it < NBLK64 * 2 * C4; it += NT) {
        const int c = (it % C4) * 4, rj = it / C4, j = rj & 1, blk = rj >> 1, t = blk * 64 + j, tb = t % SEQ;
        f32x4 y[2];
#pragma unroll
        for (int bj = 0; bj < 2; ++bj) {
            const int cc = bj * FF + c;
            const f32x4 z = (f32x4){0.f, 0.f, 0.f, 0.f};
            const f32x4 ut = *(const f32x4*)(halo + ((size_t)blk * 4 + j) * NUP + cc);
            f32x4 u1, u2;
            if (j == 1) { u1 = *(const f32x4*)(halo + ((size_t)blk * 4 + 0) * NUP + cc); u2 = (tb == 1) ? z : *(const f32x4*)(halo + ((size_t)(blk - 1) * 4 + 3) * NUP + cc); }
            else { u1 = (tb == 0) ? z : *(const f32x4*)(halo + ((size_t)(blk - 1) * 4 + 3) * NUP + cc); u2 = (tb == 0) ? z : *(const f32x4*)(halo + ((size_t)(blk - 1) * 4 + 2) * NUP + cc); }
            y[bj] = *(const f32x4*)(cb + cc) + *(const f32x4*)(cw + cc) * u2 + *(const f32x4*)(cw + NUP + cc) * u1 + *(const f32x4*)(cw + 2 * NUP + cc) * ut;
        }
        if constexpr (F8) *(unsigned*)((unsigned char*)act + (size_t)t * FF + c) = pk4f8(silu_mul(y[0].x, y[1].x), silu_mul(y[0].y, y[1].y), silu_mul(y[0].z, y[1].z), silu_mul(y[0].w, y[1].w));
        else { v2u w; w.x = cvtpk(silu_mul(y[0].x, y[1].x), silu_mul(y[0].y, y[1].y)); w.y = cvtpk(silu_mul(y[0].z, y[1].z), silu_mul(y[0].w, y[1].w));
            *(v2u*)(act + (size_t)t * FF + c) = w; }
    }
}

__device__ __forceinline__ int crow(int r, int hi) { return (r & 3) + 8 * (r >> 2) + 4 * hi; }
__device__ __forceinline__ void glds16(const void* gsrc, unsigned lds_dst) { unsigned keep;
    asm volatile("s_mov_b32 %0, m0\n\ts_mov_b32 m0, %2\n\ts_nop 0\n\tglobal_load_lds_dwordx4 %1, off\n\ts_mov_b32 m0, %0" : "=&s"(keep) : "v"(gsrc), "s"(lds_dst) : "memory"); }
__device__ __forceinline__ float max3f(float a, float b, float c) { return fmaxf(fmaxf(a, b), c); }

namespace band {
constexpr int SLOTB = 8192;
constexpr int LDS_K = 0, LDS_V = 2 * SLOTB, LDS_WS = 4 * SLOTB, LDS_TB = LDS_WS + NWAVES * 64 * 4, LDS_OST = LDS_TB + 640 * 4 + 512, LDS_END = LDS_OST + NWAVES * 4096;
static_assert(LDS_END <= RING_BYTES, "band LDS");
__device__ __forceinline__ void unit(Frame& F, int b, int h, int U, const bf16* Q, const bf16* K, const bf16* V, bf16* O, const float* rel, const bool o8) {
    const int tid = F.tid, lane = F.lane, r32 = lane & 31, hi = lane >> 5, wid = F.wave;
    LAS unsigned char* shm = F.lds + RING_OFF;
    const unsigned lds0 = (unsigned)(uintptr_t)shm;
    const long rowbase = (long)b * SEQ; const int q0 = U * 256, c0 = 4 * U, cq = c0 + (wid >> 1);
    const bf16* Qw = Q + (rowbase + q0 + wid * 32) * DM + h * 64;
    const bf16* Kh = K + rowbase * DM + h * 64; const bf16* Vh = V + rowbase * DM + h * 64;
    LAS float* wsf = (LAS float*)(shm + LDS_WS) + wid * 64;
    LAS float* tb = (LAS float*)(shm + LDS_TB);
    const bf16* ksrc = Kh + (long)lane * DM + wid * 8;
    const bf16* vsrc = Vh + (long)(16 * (wid & 3) + (lane >> 2)) * DM + (wid >> 2) * 32 + (lane & 3) * 8;
    const unsigned kdst = lds0 + LDS_K + wid * 1024, vdst = lds0 + LDS_V + wid * 1024;
    const int lo = (c0 - 8 > 0) ? c0 - 8 : 0, hiT = c0 + 3, NT = hiT - lo + 1, t0 = (c0 - 5 > 0) ? c0 - 5 : 0;
#define BAND_KT(i) ((t0 + (i) <= hiT) ? t0 + (i) : lo + (t0 + (i) - hiT - 1))
    for (int i = tid; i < 640; i += NWAVES * 64) { int d = i - 64; d = d < -256 ? -256 : (d > 256 ? 256 : d); tb[i] = rel[(d + 256) * 16 + h] * LOG2E; }
    { const int kt = BAND_KT(0); glds16(ksrc + (long)kt * 64 * DM, (unsigned)__builtin_amdgcn_readfirstlane(kdst)); glds16(vsrc + (long)kt * 64 * DM, (unsigned)__builtin_amdgcn_readfirstlane(vdst)); }
    bf16x8 qr[4];
#pragma unroll
    for (int d0 = 0; d0 < 4; ++d0) qr[d0] = *(const bf16x8*)(Qw + (long)r32 * DM + d0 * 16 + hi * 8);
    float m_run = -INFINITY, l_run = 0.f; f32x16 o[2]; o[0] = f32x16{}; o[1] = f32x16{};
    const int qpos = q0 + wid * 32 + r32;
    const LAS unsigned char* vbase = shm + LDS_V + ((lane >> 4) & 1) * 32 + (lane & 3) * 8 + (4 * hi + ((lane & 15) >> 2)) * 64;
    for (int i = 0; i < NT; ++i) { LA_B;
        asm volatile("s_waitcnt vmcnt(0) lgkmcnt(0)\n\ts_barrier" ::: "memory");
        if (i + 1 < NT) { const int kt = BAND_KT(i + 1); const unsigned so = ((i + 1) & 1) * SLOTB;
            glds16(ksrc + (long)kt * 64 * DM, (unsigned)__builtin_amdgcn_readfirstlane(kdst + so)); glds16(vsrc + (long)kt * 64 * DM, (unsigned)__builtin_amdgcn_readfirstlane(vdst + so)); }
        const int kt = BAND_KT(i);
        if (kt < cq - 8 || kt > cq) continue;
        const int so = (i & 1) * SLOTB;
        f32x16 p0 = f32x16{}, p1 = f32x16{};
        { const LAS unsigned char* kb = shm + LDS_K + so + hi * 1024 + r32 * 16;
#pragma unroll
          for (int d0 = 0; d0 < 4; ++d0) { const bf16x8 b0 = *(const LAS bf16x8*)(kb + d0 * 2048), b1 = *(const LAS bf16x8*)(kb + d0 * 2048 + 512);
              p0 = __builtin_amdgcn_mfma_f32_32x32x16_bf16(b0, qr[d0], p0, 0, 0, 0); p1 = __builtin_amdgcn_mfma_f32_32x32x16_bf16(b1, qr[d0], p1, 0, 0, 0); } }
        if (kt + 5 <= cq) { const float cbias = tb[639];
#pragma unroll
          for (int r = 0; r < 16; ++r) { p0[r] += cbias; p1[r] += cbias; } }
        else { const int ib = qpos - 64 * kt + 64 - 4 * hi;
#pragma unroll
          for (int r = 0; r < 16; ++r) { const int ix = ib - ((r & 3) + 8 * (r >> 2)); p0[r] += tb[ix]; p1[r] += tb[ix - 32]; } }
        float rm = p0[0];
#pragma unroll
        for (int r = 0; r < 16; ++r) rm = max3f(rm, p0[r], p1[r]);
        { auto rr = __builtin_amdgcn_permlane32_swap(__float_as_uint(rm), __float_as_uint(rm), false, false); rm = fmaxf(__uint_as_float(rr[0]), __uint_as_float(rr[1])); }
        const float mnew = fmaxf(m_run, rm), f = __builtin_amdgcn_exp2f(m_run - mnew); m_run = mnew;
        float sacc = 0.f;
#pragma unroll
        for (int r = 0; r < 16; ++r) { p0[r] = __builtin_amdgcn_exp2f(p0[r] - mnew); p1[r] = __builtin_amdgcn_exp2f(p1[r] - mnew); sacc += p0[r] + p1[r]; }
        l_run = l_run * f + sacc;
        if (!__all(f == 1.0f)) {
            if (hi == 0) wsf[r32] = f;
            LDS_WAIT();
#pragma unroll
            for (int r = 0; r < 16; ++r) { const float fr_ = wsf[crow(r, hi)]; o[0][r] *= fr_; o[1][r] *= fr_; }
        }
        v4u pw[4];
        pw[0] = (v4u){cvtpk(p0[0], p0[1]), cvtpk(p0[2], p0[3]), cvtpk(p0[4], p0[5]), cvtpk(p0[6], p0[7])};
        pw[1] = (v4u){cvtpk(p0[8], p0[9]), cvtpk(p0[10], p0[11]), cvtpk(p0[12], p0[13]), cvtpk(p0[14], p0[15])};
        pw[2] = (v4u){cvtpk(p1[0], p1[1]), cvtpk(p1[2], p1[3]), cvtpk(p1[4], p1[5]), cvtpk(p1[6], p1[7])};
        pw[3] = (v4u){cvtpk(p1[8], p1[9]), cvtpk(p1[10], p1[11]), cvtpk(p1[12], p1[13]), cvtpk(p1[14], p1[15])};
        const LAS unsigned char* vb = vbase + so;
#pragma unroll
        for (int d0 = 0; d0 < 2; ++d0)
#pragma unroll
            for (int ks = 0; ks < 4; ++ks) {
                const s16x4 vlo = __builtin_bit_cast(s16x4, __builtin_amdgcn_ds_read_tr16_b64_v4i16((LAS s16x4*)(vb + d0 * 4096 + ks * 1024)));
                const s16x4 vhi = __builtin_bit_cast(s16x4, __builtin_amdgcn_ds_read_tr16_b64_v4i16((LAS s16x4*)(vb + d0 * 4096 + ks * 1024 + 512)));
                const bf16x8 vf = (bf16x8){vlo[0], vlo[1], vlo[2], vlo[3], vhi[0], vhi[1], vhi[2], vhi[3]};
                o[d0] = __builtin_amdgcn_mfma_f32_32x32x16_bf16(__builtin_bit_cast(bf16x8, pw[ks]), vf, o[d0], 0, 0, 0);
            }
    }
#undef BAND_KT
    { auto rr = __builtin_amdgcn_permlane32_swap(__float_as_uint(l_run), __float_as_uint(l_run), false, false); l_run = __uint_as_float(rr[0]) + __uint_as_float(rr[1]); }
    if (hi == 0) wsf[32 + r32] = l_run;
    LDS_WAIT();
    float rli[16];
#pragma unroll
    for (int r = 0; r < 16; ++r) rli[r] = __builtin_amdgcn_rcpf(wsf[32 + crow(r, hi)]);
    bf16* Ow = O + (rowbase + q0 + wid * 32) * DM + h * 64;
    { LAS bf16* stg = (LAS bf16*)(shm + LDS_OST) + wid * 2048;
#pragma unroll
      for (int r = 0; r < 16; ++r) { const int orow = crow(r, hi);
#pragma unroll
          for (int d0 = 0; d0 < 2; ++d0) stg[orow * 64 + d0 * 32 + r32] = (bf16)f2bf(o[d0][r] * rli[r]); }
      LDS_WAIT();
#pragma unroll
      for (int i = 0; i < 4; ++i) { const int row = i * 8 + (lane >> 3), ch = lane & 7; const v4u v = *(const LAS v4u*)(stg + row * 64 + ch * 8);
          if (o8) { v2u w; w.x = pk4f8(bf_lo(v.x), bf_hi(v.x), bf_lo(v.y), bf_hi(v.y)); w.y = pk4f8(bf_lo(v.z), bf_hi(v.z), bf_lo(v.w), bf_hi(v.w));
              *(v2u*)((unsigned char*)O + (rowbase + q0 + wid * 32 + row) * DM + h * 64 + ch * 8) = w; }
          else *(v4u*)(Ow + (long)row * DM + ch * 8) = v; } }
    asm volatile("s_waitcnt lgkmcnt(0)\n\ts_barrier" ::: "memory");
}
__device__ __forceinline__ void phase(Frame& F, const bf16* Q, const bf16* K, const bf16* V, bf16* O, const float* rel, const bool o8) {
    const int NU = BATCH * 16 * 32, per = (NU + F.G - 1) / F.G;
    for (int i = 0; i < per; ++i) { const int uid = F.vcu * per + i; if (uid >= NU) break; unit(F, uid >> 9, (uid >> 5) & 15, uid & 31, Q, K, V, O, rel, o8); }
}
}

namespace dsa {
__device__ __forceinline__ unsigned okey(float s) { const unsigned u = __float_as_uint(s + 0.0f); return (u & 0x80000000u) ? ~u : (u | 0x80000000u); }
struct Ctx { const bf16* QA; const bf16* KA; const bf16* VA; const bf16* QI; const bf16* KI; const float* WI; bf16* M; const LAS float* t5l; unsigned short* SEL; };

__device__ __forceinline__ void scan_hist(const LAS unsigned* hq, int lane, unsigned need, unsigned& bin, unsigned& above) {
    const LAS v4u* hp = (const LAS v4u*)hq + lane * 4;
    unsigned wds[16];
#pragma unroll
    for (int j = 0; j < 4; ++j) { const v4u t = hp[j]; wds[4 * j] = t.x; wds[4 * j + 1] = t.y; wds[4 * j + 2] = t.z; wds[4 * j + 3] = t.w; }
    unsigned tl = 0;
#pragma unroll
    for (int j = 0; j < 16; ++j) tl += (wds[j] & 0xffffu) + (wds[j] >> 16);
    unsigned suf = tl;
#pragma unroll
    for (int o = 1; o < 64; o <<= 1) { const unsigned v = __shfl_down(suf, o); if (lane + o < 64) suf += v; }
    const unsigned S = suf - tl;
    const bool cross = (S < need) && (need <= S + tl);
    unsigned c = S, bsel = 0, ab = 0; bool found = false;
#pragma unroll
    for (int k = 31; k >= 0; --k) { const unsigned cnt = (wds[k >> 1] >> (16 * (k & 1))) & 0xffffu; if (!found && c + cnt >= need) { bsel = 32 * lane + k; ab = c; found = true; } c += cnt; }
    const unsigned long long bal = __ballot(cross);
    const int src = bal ? __builtin_ctzll(bal) : 0;
    bin = __shfl(bsel, src); above = __shfl(ab, src);
}

__device__ __forceinline__ void attend(const Ctx& C, const LAS unsigned short* sq, int nvalid, long rowbase, long token, int tpos, int lane, int g0) {
    asm volatile("" : "+v"(lane));
    const int l15 = lane & 15, l4 = lane >> 4;
    int sidx[16];
#pragma unroll
    for (int ti = 0; ti < 16; ++ti) sidx[ti] = sq[ti * 16 + l15];
    unsigned bpk[4] = {0u, 0u, 0u, 0u};
#pragma unroll
    for (int ti = 0; ti < 16; ++ti) { const int rel = sidx[ti] - tpos, n = rel < 0 ? -rel : rel;
        const int bk = (rel > 0 ? 16 : 0) + (n < 8 ? n : 8 + (n >= 12) + (n >= 16) + (n >= 23) + (n >= 32) + (n >= 46) + (n >= 64) + (n >= 91));
        bpk[ti >> 2] |= (unsigned)bk << (8 * (ti & 3)); }
#pragma unroll 1
    for (int g = g0; g < g0 + 2; ++g) {
        const bf16* qp = C.QA + token * DM + (4 * g + (lane & 3)) * 64 + 8 * l4;
        const bf16x8 qf0 = *(const bf16x8*)qp, qf1 = *(const bf16x8*)(qp + 32);
        const bf16* kbase = C.KA + rowbase * 256 + g * 64 + 8 * l4;
        f32x4 S[16];
#pragma unroll
        for (int hh = 0; hh < 4; ++hh) {
            bf16x8 kf0[4], kf1[4];
#pragma unroll
            for (int j = 0; j < 4; ++j) { const bf16* kp = kbase + (long)sidx[hh * 4 + j] * 256; kf0[j] = *(const bf16x8*)kp; kf1[j] = *(const bf16x8*)(kp + 32); }
#pragma unroll
            for (int j = 0; j < 4; ++j) { const int ti = hh * 4 + j;
                f32x4 a = *(const LAS f32x4*)(C.t5l + ((bpk[hh] >> (8 * j)) & 255u) * 16 + 4 * g);
                asm volatile("v_mfma_f32_16x16x32_bf16 %0, %1, %2, %0" : "+v"(a) : "v"(qf0), "v"(kf0[j]));
                asm volatile("v_mfma_f32_16x16x32_bf16 %0, %1, %2, %0" : "+v"(a) : "v"(qf1), "v"(kf1[j]));
                S[ti] = a; }
            asm volatile("s_nop 15\n\ts_nop 7" : "+v"(S[hh * 4]), "+v"(S[hh * 4 + 1]), "+v"(S[hh * 4 + 2]), "+v"(S[hh * 4 + 3]));
        }
#pragma unroll
        for (int ti = 0; ti < 16; ++ti) if (ti * 16 >= nvalid) S[ti] = (f32x4){-INFINITY, -INFINITY, -INFINITY, -INFINITY};
        f32x4 mx = S[0];
#pragma unroll
        for (int ti = 1; ti < 16; ++ti) { mx.x = fmaxf(mx.x, S[ti].x); mx.y = fmaxf(mx.y, S[ti].y); mx.z = fmaxf(mx.z, S[ti].z); mx.w = fmaxf(mx.w, S[ti].w); }
#pragma unroll
        for (int o = 1; o < 16; o <<= 1) { mx.x = fmaxf(mx.x, __shfl_xor(mx.x, o)); mx.y = fmaxf(mx.y, __shfl_xor(mx.y, o)); mx.z = fmaxf(mx.z, __shfl_xor(mx.z, o)); mx.w = fmaxf(mx.w, __shfl_xor(mx.w, o)); }
        f32x4 ls = (f32x4){0.f, 0.f, 0.f, 0.f};
        unsigned P01[16], P23[16];
#pragma unroll
        for (int ti = 0; ti < 16; ++ti) { const float e0 = __builtin_amdgcn_exp2f(S[ti].x - mx.x), e1 = __builtin_amdgcn_exp2f(S[ti].y - mx.y), e2 = __builtin_amdgcn_exp2f(S[ti].z - mx.z), e3 = __builtin_amdgcn_exp2f(S[ti].w - mx.w);
            ls += (f32x4){e0, e1, e2, e3}; P01[ti] = cvtpk(e0, e1); P23[ti] = cvtpk(e2, e3); }
#pragma unroll
        for (int o = 1; o < 16; o <<= 1) { ls.x += __shfl_xor(ls.x, o); ls.y += __shfl_xor(ls.y, o); ls.z += __shfl_xor(ls.z, o); ls.w += __shfl_xor(ls.w, o); }
        float o_[4][16];
#pragma unroll
        for (int h = 0; h < 4; ++h)
#pragma unroll
            for (int d = 0; d < 16; ++d) o_[h][d] = 0.f;
        const bf16* vbase = C.VA + rowbase * 256 + g * 64 + 16 * l4;
#pragma unroll
        for (int hh = 0; hh < 4; ++hh) {
            v4u va[4], vb[4];
#pragma unroll
            for (int j = 0; j < 4; ++j) { const v4u* vp = (const v4u*)(vbase + (long)sidx[hh * 4 + j] * 256); va[j] = vp[0]; vb[j] = vp[1]; }
#pragma unroll
            for (int j = 0; j < 4; ++j) { const int ti = hh * 4 + j; const v4u v0 = va[j], v1 = vb[j];
                float vf[16];
                vf[0] = bf_lo(v0.x); vf[1] = bf_hi(v0.x); vf[2] = bf_lo(v0.y); vf[3] = bf_hi(v0.y); vf[4] = bf_lo(v0.z); vf[5] = bf_hi(v0.z); vf[6] = bf_lo(v0.w); vf[7] = bf_hi(v0.w);
                vf[8] = bf_lo(v1.x); vf[9] = bf_hi(v1.x); vf[10] = bf_lo(v1.y); vf[11] = bf_hi(v1.y); vf[12] = bf_lo(v1.z); vf[13] = bf_hi(v1.z); vf[14] = bf_lo(v1.w); vf[15] = bf_hi(v1.w);
                const float p0 = bf_lo(P01[ti]), p1 = bf_hi(P01[ti]), p2 = bf_lo(P23[ti]), p3 = bf_hi(P23[ti]);
#pragma unroll
                for (int d = 0; d < 16; ++d) { o_[0][d] += p0 * vf[d]; o_[1][d] += p1 * vf[d]; o_[2][d] += p2 * vf[d]; o_[3][d] += p3 * vf[d]; } }
        }
        float res[4];
#pragma unroll
        for (int h = 0; h < 4; ++h) {
            float a8[8], a4[4], a2[2];
            const bool b3 = (l15 & 8) != 0, b2 = (l15 & 4) != 0, b1 = (l15 & 2) != 0, b0 = (l15 & 1) != 0;
#pragma unroll
            for (int d = 0; d < 8; ++d) { const float keep = b3 ? o_[h][d + 8] : o_[h][d], send = b3 ? o_[h][d] : o_[h][d + 8]; a8[d] = keep + __shfl_xor(send, 8); }
#pragma unroll
            for (int d = 0; d < 4; ++d) { const float keep = b2 ? a8[d + 4] : a8[d], send = b2 ? a8[d] : a8[d + 4]; a4[d] = keep + __shfl_xor(send, 4); }
#pragma unroll
            for (int d = 0; d < 2; ++d) { const float keep = b1 ? a4[d + 2] : a4[d], send = b1 ? a4[d] : a4[d + 2]; a2[d] = keep + __shfl_xor(send, 2); }
            { const float keep = b0 ? a2[1] : a2[0], send = b0 ? a2[0] : a2[1]; res[h] = keep + __shfl_xor(send, 1); }
        }
        bf16* mp = C.M + token * DM + (4 * g) * 64 + lane;
        mp[0] = (bf16)f2bf(res[0] * __builtin_amdgcn_rcpf(ls.x)); mp[64] = (bf16)f2bf(res[1] * __builtin_amdgcn_rcpf(ls.y)); mp[128] = (bf16)f2bf(res[2] * __builtin_amdgcn_rcpf(ls.z)); mp[192] = (bf16)f2bf(res[3] * __builtin_amdgcn_rcpf(ls.w));
    }
}

constexpr int CAND_CAP = 256;
constexpr int SELKS_OFF = KS_OFF;
__device__ __forceinline__ float relu_i(float x) { const int i = __builtin_bit_cast(int, x); return __builtin_bit_cast(float, i > 0 ? i : 0); }
struct SelState { unsigned pre[4], need[4], cnt[4], tcnt[4]; };
__device__ __forceinline__ void tile_mfma(f32x16 (&acc)[2], const LAS unsigned char* kf, const int (&koff)[4], const bf16x8 (&qa)[4]) {
#pragma unroll
    for (int h2 = 0; h2 < 2; ++h2) { acc[h2] = f32x16{};
#pragma unroll
        for (int ks = 0; ks < 4; ++ks) { const bf16x8 kb = *(const LAS bf16x8*)(kf + koff[ks] + h2 * 4096); acc[h2] = __builtin_amdgcn_mfma_f32_32x32x16_bf16(qa[ks], kb, acc[h2], 0, 0, 0); } }
}
template <class ActionT>
__device__ __forceinline__ void tile_valu(const f32x16 (&acc)[2], const f32x2_t (&wp)[2][4], int kbase, ActionT&& act) {
#pragma unroll
    for (int h2 = 0; h2 < 2; ++h2) {
        f32x2_t sa = {0.f, 0.f}, sb = {0.f, 0.f};
#pragma unroll
        for (int jp = 0; jp < 4; ++jp) {
            const f32x2_t ra = {relu_i(acc[h2][2 * jp]), relu_i(acc[h2][2 * jp + 1])};
            const f32x2_t rb = {relu_i(acc[h2][8 + 2 * jp]), relu_i(acc[h2][8 + 2 * jp + 1])};
            sa = __builtin_elementwise_fma(ra, wp[0][jp], sa); sb = __builtin_elementwise_fma(rb, wp[1][jp], sb); }
        act(kbase + h2 * 32, (sa.x + sa.y) + 0.0f, (sb.x + sb.y) + 0.0f);
    }
}
constexpr int KSLOTS = 3;
__device__ __forceinline__ void wait_tile(int newer) {
    if (newer >= 4) asm volatile("s_waitcnt vmcnt(4) lgkmcnt(0)\n\ts_barrier" ::: "memory");
    else if (newer == 3) asm volatile("s_waitcnt vmcnt(3) lgkmcnt(0)\n\ts_barrier" ::: "memory");
    else if (newer == 2) asm volatile("s_waitcnt vmcnt(2) lgkmcnt(0)\n\ts_barrier" ::: "memory");
    else if (newer == 1) asm volatile("s_waitcnt vmcnt(1) lgkmcnt(0)\n\ts_barrier" ::: "memory");
    else asm volatile("s_waitcnt vmcnt(0) lgkmcnt(0)\n\ts_barrier" ::: "memory");
}
template <class ActionT>
__device__ __forceinline__ void tile_pass(Frame& F, const bf16* ksrc, unsigned kdst, const LAS unsigned char* kfr, const int (&koff)[4], int NT, const bf16x8 (&qa)[4], const f32x2_t (&wp)[2][4], ActionT&& act) {
    asm volatile("s_waitcnt lgkmcnt(0)\n\ts_barrier" ::: "memory");
    const int npre = NT < KSLOTS ? NT : KSLOTS;
    for (int j = 0; j < npre; ++j) glds16(ksrc + (long)j * 4096, (unsigned)__builtin_amdgcn_readfirstlane(kdst + j * 8192));
    wait_tile(npre - 1);
    f32x16 accA[2], accB[2];
    tile_mfma(accA, kfr, koff, qa);
    int sl = 0;
    int kt = 0;
    for (; kt + 2 < NT; kt += 2) { LA_S;
        { const int inflight = (NT - kt - 2) < (KSLOTS - 2) ? (NT - kt - 2) : (KSLOTS - 2); wait_tile(inflight); }
        if (kt + KSLOTS < NT) glds16(ksrc + (long)(kt + KSLOTS) * 4096, (unsigned)__builtin_amdgcn_readfirstlane(kdst + sl * 8192));
        sl = (sl == KSLOTS - 1) ? 0 : sl + 1;
        tile_mfma(accB, kfr + sl * 8192, koff, qa);
        tile_valu(accA, wp, kt * 64, act);
        { const int inflight = (NT - kt - 3) < (KSLOTS - 2) ? (NT - kt - 3) : (KSLOTS - 2); wait_tile(inflight); }
        if (kt + 1 + KSLOTS < NT) glds16(ksrc + (long)(kt + 1 + KSLOTS) * 4096, (unsigned)__builtin_amdgcn_readfirstlane(kdst + sl * 8192));
        sl = (sl == KSLOTS - 1) ? 0 : sl + 1;
        tile_mfma(accA, kfr + sl * 8192, koff, qa);
        tile_valu(accB, wp, (kt + 1) * 64, act);
    }
    if (kt + 1 < NT) {
        wait_tile(0);
        sl = (sl == KSLOTS - 1) ? 0 : sl + 1;
        tile_mfma(accB, kfr + sl * 8192, koff, qa);
        tile_valu(accA, wp, kt * 64, act);
        tile_valu(accB, wp, (kt + 1) * 64, act);
    } else tile_valu(accA, wp, kt * 64, act);
    LDS_WAIT();
}
__device__ __forceinline__ void scan_hist_cnt(const LAS unsigned* hq, int lane, unsigned need, unsigned& bin, unsigned& above, unsigned& bcnt) {
    const LAS v4u* hp = (const LAS v4u*)hq + lane * 2;
    unsigned wds[8];
#pragma unroll
    for (int j = 0; j < 2; ++j) { const v4u t = hp[j]; wds[4 * j] = t.x; wds[4 * j + 1] = t.y; wds[4 * j + 2] = t.z; wds[4 * j + 3] = t.w; }
    unsigned tl = 0;
#pragma unroll
    for (int j = 0; j < 8; ++j) tl += wds[j];
    unsigned suf = tl;
#pragma unroll
    for (int o = 1; o < 64; o <<= 1) { const unsigned v = __shfl_down(suf, o); if (lane + o < 64) suf += v; }
    const unsigned S = suf - tl;
    const bool cross = (S < need) && (need <= S + tl);
    unsigned c = S, bsel = 0, ab = 0, bc = 0; bool found = false;
#pragma unroll
    for (int k = 7; k >= 0; --k) { const unsigned cnt = wds[k]; if (!found && c + cnt >= need) { bsel = 8 * lane + k; ab = c; bc = cnt; found = true; } c += cnt; }
    const unsigned long long bal = __ballot(cross);
    const int src = bal ? __builtin_ctzll(bal) : 0;
    bin = __builtin_amdgcn_readfirstlane(__shfl(bsel, src)); above = __builtin_amdgcn_readfirstlane(__shfl(ab, src)); bcnt = __builtin_amdgcn_readfirstlane(__shfl(bc, src));
}
__device__ __forceinline__ void step(Frame& F, const Ctx& C, int b, int c, int half) {
    int lane_ = F.lane; asm volatile("" : "+v"(lane_));
    const int lane = lane_, r = lane & 31, hi = lane >> 5, wave = F.wave;
    LAS unsigned* hist = (LAS unsigned*)(F.lds + RING_OFF + wave * 16384);
    LAS unsigned short* sel = (LAS unsigned short*)hist;
    LAS unsigned* cand = hist + 2048;
    LAS unsigned* fbflag = (LAS unsigned*)(F.lds + AUX_OFF + 2048);
    const long rowbase = (long)b * SEQ;
    const int tq0 = 64 * c + 32 * half + 4 * wave;
    const int N = 64 * (c + 1), NT = c + 1;
    int nvalid = 256;
    if (N <= 256) {
        nvalid = N;
        for (int j = lane; j < 4 * 256; j += 64) sel[j] = (unsigned short)(((j & 255) < N) ? (j & 255) : 0);
    } else {
        const int aq = 2 * ((r >> 2) & 1) + (r >> 4), ah = 4 * ((r >> 3) & 1) + (r & 3);
        const bf16* qip = C.QI + (rowbase + tq0 + aq) * 512 + ah * 64 + 8 * hi;
        bf16x8 qa[4];
#pragma unroll
        for (int ks = 0; ks < 4; ++ks) qa[ks] = *(const bf16x8*)(qip + 16 * ks);
        f32x2_t wp[2][4];
#pragma unroll
        for (int t = 0; t < 2; ++t) { const float* wq = C.WI + (rowbase + tq0 + 2 * hi + t) * 8; const f32x4 w0 = *(const f32x4*)wq, w1 = *(const f32x4*)(wq + 4);
            wp[t][0] = (f32x2_t){w0.x, w0.y}; wp[t][1] = (f32x2_t){w0.z, w0.w}; wp[t][2] = (f32x2_t){w1.x, w1.y}; wp[t][3] = (f32x2_t){w1.z, w1.w}; }
        float Bq;
        { float ssq = 0.f;
#pragma unroll
          for (int ks = 0; ks < 4; ++ks)
#pragma unroll
              for (int e = 0; e < 8; ++e) { const float v = bf_lo((unsigned)(unsigned short)qa[ks][e]); ssq += v * v; }
          ssq += __shfl_xor(ssq, 32);
          float term = fabsf(C.WI[(rowbase + tq0 + aq) * 8 + ah]) * sqrtf(ssq);
          term += __shfl_xor(term, 1); term += __shfl_xor(term, 2); term += __shfl_xor(term, 8);
          Bq = term * 8.25f + 1e-20f; }
        const float B0 = __shfl(Bq, (hi << 2)), B1 = __shfl(Bq, (hi << 2) | 16);
        const float sc0 = 1024.0f / B0, sc1 = 1024.0f / B1;
        asm volatile("" :: "v"(qa[0]), "v"(qa[1]), "v"(qa[2]), "v"(qa[3]));
        asm volatile("" :: "v"(wp[0][0]), "v"(wp[0][1]), "v"(wp[0][2]), "v"(wp[0][3]), "v"(wp[1][0]), "v"(wp[1][1]), "v"(wp[1][2]), "v"(wp[1][3]), "v"(sc0), "v"(sc1));
        const bf16* ksrc = C.KI + rowbase * 64 + (long)(wave * 8 + (lane >> 3)) * 64 + ((lane & 7) ^ (lane >> 3)) * 8;
        const unsigned kdst = (unsigned)(uintptr_t)(F.lds + SELKS_OFF) + wave * 1024;
        const LAS unsigned char* kfr = F.lds + SELKS_OFF + r * 128;
        int koff[4];
#pragma unroll
        for (int ks = 0; ks < 4; ++ks) koff[ks] = ((2 * ks + hi) ^ (r & 7)) * 16;
        const unsigned below = (1u << r) - 1u;
        LAS v4u* hz = (LAS v4u*)hist;
        if (wave == 0 && lane == 0) *fbflag = 0u;
#pragma unroll
        for (int j = 0; j < 8; ++j) hz[j * 64 + lane] = (v4u){0u, 0u, 0u, 0u};
        tile_pass(F, ksrc, kdst, kfr, koff, NT, qa, wp, [&](int kbase, float s0, float s1) {
            const int b0 = (int)__builtin_amdgcn_fmed3f(__builtin_fmaf(s0, sc0, 256.0f), 0.0f, 511.0f), b1 = (int)__builtin_amdgcn_fmed3f(__builtin_fmaf(s1, sc1, 256.0f), 0.0f, 511.0f);
            __hip_atomic_fetch_add(hist + (2 * hi) * 512 + b0, 1u, __ATOMIC_RELAXED, __HIP_MEMORY_SCOPE_WORKGROUP);
            __hip_atomic_fetch_add(hist + (2 * hi + 1) * 512 + b1, 1u, __ATOMIC_RELAXED, __HIP_MEMORY_SCOPE_WORKGROUP);
        });
#ifdef PROBE_SKEL
        tile_pass(F, ksrc, kdst, kfr, koff, NT, qa, wp, [&](int kbase, float s0, float s1) { });
#endif
#ifdef PROBE_SCORE
        { float dsum = 0.f; tile_pass(F, ksrc, kdst, kfr, koff, NT, qa, wp, [&](int kbase, float s0, float s1) { dsum += s0 + s1; }); if (dsum == 12345.678f) hist[0] = 1u; }
#endif
        SelState st;
        unsigned tbin[4], bcn[4]; bool ovf = false;
#pragma unroll
        for (int ql = 0; ql < 4; ++ql) { unsigned above; scan_hist_cnt(hist + ql * 512, lane, 256u, tbin[ql], above, bcn[ql]); st.cnt[ql] = 0u; st.tcnt[ql] = 0u; st.need[ql] = 256u - above; st.pre[ql] = above;
            }
        unsigned cbase[4]; { unsigned a = 0u;
#pragma unroll
            for (int ql = 0; ql < 4; ++ql) { cbase[ql] = a; a += bcn[ql]; }
            ovf = a > (unsigned)(4 * CAND_CAP); }
        LDS_WAIT();
        if (ovf && lane == 0) *fbflag = 1u;
        asm volatile("s_waitcnt lgkmcnt(0)\n\ts_barrier" ::: "memory");
#ifdef PROBE_NOFB
        const bool fb = false;
#elif defined(PROBE_NOFB2)
        const bool fb = __builtin_amdgcn_readfirstlane((int)*fbflag) == 0x7fffffff;
#else
        const bool fb = __builtin_amdgcn_readfirstlane((int)*fbflag) != 0;
#endif
        if (!fb) {
            const int tb0 = (int)(hi ? tbin[2] : tbin[0]), tb1 = (int)(hi ? tbin[3] : tbin[1]); const unsigned cb0 = hi ? cbase[2] : cbase[0], cb1 = hi ? cbase[3] : cbase[1];
            tile_pass(F, ksrc, kdst, kfr, koff, NT, qa, wp, [&](int kbase, float s0, float s1) {
#pragma unroll
                for (int t = 0; t < 2; ++t) {
                    const float s = t ? s1 : s0; const int bin = (int)__builtin_amdgcn_fmed3f(__builtin_fmaf(s, (t ? sc1 : sc0), 256.0f), 0.0f, 511.0f), tb = t ? tb1 : tb0;
                    const bool gt = bin > tb, eq = bin == tb;
                    const unsigned long long mg = __ballot(gt), me = __ballot(eq);
                    const unsigned mgh = hi ? (unsigned)(mg >> 32) : (unsigned)mg, meh = hi ? (unsigned)(me >> 32) : (unsigned)me;
                    const unsigned pos = (hi ? st.cnt[2 + t] : st.cnt[t]) + __builtin_popcount(mgh & below);
                    sel[(gt && pos < 256u) ? (2 * hi + t) * 256 + pos : 3200 + lane] = (unsigned short)(kbase + r);
                    const unsigned cpos = (hi ? st.tcnt[2 + t] : st.tcnt[t]) + __builtin_popcount(meh & below);
                    { const unsigned slot = (t ? cb1 : cb0) + cpos; LAS unsigned* cp = hist + ((eq && slot < (unsigned)(4 * CAND_CAP)) ? 2048 + slot * 2 : 1700 + 2 * lane); cp[0] = okey(s); cp[1] = (unsigned)(kbase + r); }
                    st.cnt[t] += __builtin_popcount((unsigned)mg); st.cnt[2 + t] += __builtin_popcount((unsigned)(mg >> 32));
                    st.tcnt[t] += __builtin_popcount((unsigned)me); st.tcnt[2 + t] += __builtin_popcount((unsigned)(me >> 32));
                }
            });
#pragma unroll
            for (int ql = 0; ql < 4; ++ql) {
                const unsigned nc = bcn[ql], G = st.pre[ql], rq = st.need[ql];
                const LAS unsigned* cq = cand + cbase[ql] * 2;
                unsigned base = G; const unsigned long long lt = (1ull << lane) - 1ull;
                for (unsigned c0 = 0; c0 < nc; c0 += 256u) {
                    unsigned ki4[4], xi4[4], rk4[4];
#pragma unroll
                    for (int m = 0; m < 4; ++m) { const unsigned i = c0 + (unsigned)lane + 64u * m; ki4[m] = (i < nc) ? cq[2 * i] : 0u; xi4[m] = (i < nc) ? cq[2 * i + 1] : 0u; rk4[m] = 0u; }
                    for (unsigned j = 0; j < nc; ++j) { const unsigned kj = cq[2 * j];
#pragma unroll
                        for (int m = 0; m < 4; ++m) rk4[m] += (kj > ki4[m] || (kj == ki4[m] && j < c0 + (unsigned)lane + 64u * m)) ? 1u : 0u; }
#pragma unroll
                    for (int m = 0; m < 4; ++m) { const bool take = (c0 + (unsigned)lane + 64u * m < nc) && rk4[m] < rq; const unsigned long long mm = __ballot(take);
                        const unsigned pos = base + __builtin_popcountll(mm & lt); if (take && pos < 256u) sel[ql * 256 + pos] = (unsigned short)xi4[m]; base += __builtin_popcountll(mm); }
                }
            }
        } else {
#pragma unroll
            for (int ql = 0; ql < 4; ++ql) { st.pre[ql] = 0u; st.need[ql] = 256u; st.cnt[ql] = 0u; st.tcnt[ql] = 0u; }
#pragma unroll 1
            for (int lev = 0; lev < 4; ++lev) {
#pragma unroll
                for (int j = 0; j < 8; ++j) hz[j * 64 + lane] = (v4u){0u, 0u, 0u, 0u};
                const unsigned pre0 = hi ? st.pre[2] : st.pre[0], pre1 = hi ? st.pre[3] : st.pre[1];
                const int sh = (lev == 0) ? 23 : (lev == 1) ? 14 : (lev == 2) ? 5 : 0, wd = (lev == 3) ? 5 : 9;
                tile_pass(F, ksrc, kdst, kfr, koff, NT, qa, wp, [&](int kbase, float s0, float s1) {
                    const unsigned k0 = okey(s0), k1 = okey(s1);
                    const unsigned b0 = (k0 >> sh) & ((1u << wd) - 1u), b1 = (k1 >> sh) & ((1u << wd) - 1u);
                    const bool in0 = (lev == 0) || ((k0 >> (sh + wd)) == pre0), in1 = (lev == 0) || ((k1 >> (sh + wd)) == pre1);
                    if (in0) __hip_atomic_fetch_add(hist + (2 * hi) * 512 + b0, 1u, __ATOMIC_RELAXED, __HIP_MEMORY_SCOPE_WORKGROUP);
                    if (in1) __hip_atomic_fetch_add(hist + (2 * hi + 1) * 512 + b1, 1u, __ATOMIC_RELAXED, __HIP_MEMORY_SCOPE_WORKGROUP);
                });
#pragma unroll
                for (int ql = 0; ql < 4; ++ql) { unsigned bin, above, bc; scan_hist_cnt(hist + ql * 512, lane, st.need[ql], bin, above, bc);
                    st.pre[ql] = (st.pre[ql] << wd) | bin; st.need[ql] -= above; }
                LDS_WAIT();
            }
            const unsigned T0 = hi ? st.pre[2] : st.pre[0], T1 = hi ? st.pre[3] : st.pre[1], rq0 = hi ? st.need[2] : st.need[0], rq1 = hi ? st.need[3] : st.need[1];
            tile_pass(F, ksrc, kdst, kfr, koff, NT, qa, wp, [&](int kbase, float s0, float s1) {
#pragma unroll
                for (int t = 0; t < 2; ++t) {
                    const unsigned kk = okey(t ? s1 : s0), T = t ? T1 : T0, rq = t ? rq1 : rq0;
                    const bool gt = kk > T, eq = kk == T;
                    const unsigned long long me = __ballot(eq);
                    const unsigned meh = hi ? (unsigned)(me >> 32) : (unsigned)me;
                    const unsigned trank = (hi ? st.tcnt[2 + t] : st.tcnt[t]) + __builtin_popcount(meh & below);
                    const bool take = gt || (eq && trank < rq);
                    const unsigned long long mt = __ballot(take);
                    const unsigned mth = hi ? (unsigned)(mt >> 32) : (unsigned)mt;
                    const unsigned pos = (hi ? st.cnt[2 + t] : st.cnt[t]) + __builtin_popcount(mth & below);
                    if (take && pos < 256u) sel[(2 * hi + t) * 256 + pos] = (unsigned short)(kbase + r);
                    st.cnt[t] += __builtin_popcount((unsigned)mt); st.cnt[2 + t] += __builtin_popcount((unsigned)(mt >> 32));
                    st.tcnt[t] += __builtin_popcount((unsigned)me); st.tcnt[2 + t] += __builtin_popcount((unsigned)(me >> 32));
                }
            });
        }
    }
    LDS_WAIT();
    { const LAS v4u* s4 = (const LAS v4u*)sel; v4u* g4 = (v4u*)(C.SEL + (rowbase + tq0) * 256);
#pragma unroll
      for (int j = 0; j < 2; ++j) g4[j * 64 + lane] = s4[j * 64 + lane]; }
    LDS_WAIT();
}
__device__ __forceinline__ void phase(Frame& F, const Ctx& C) {
    for (int v = F.vcu; v < 256; v += F.G) {
        const int b = v >> 6, c = v & 63;
#pragma unroll 1
        for (int it = 0; it < 4; ++it) step(F, C, b, (it < 2) ? c : 127 - c, it & 1);
    }
}
__device__ __forceinline__ void attn_phase(Frame& F, const Ctx& C) {
    int lane = F.lane; asm volatile("" : "+v"(lane));
    LAS unsigned short* sq = (LAS unsigned short*)(F.lds + RING_OFF + F.wave * 16384);
    const int nx = F.G / 32;
    for (int x = F.vcu / 32; x < 8; x += nx) {
        const int b = x >> 1, g0 = 2 * (x & 1); const long rowbase = (long)b * SEQ;
        const int w = (F.vcu & 31) * NWAVES + F.wave;
#pragma unroll 1
        for (int t = w; t < SEQ; t += 32 * NWAVES) {
            { const v4u* g4 = (const v4u*)(C.SEL + (rowbase + t) * 256); if (lane < 32) ((LAS v4u*)sq)[lane] = g4[lane]; }
            LDS_WAIT();
            const int N = 64 * ((t >> 6) + 1), nvalid = N < 256 ? N : 256;
            attend(C, sq, nvalid, rowbase, rowbase + t, t, lane, g0);
            LDS_WAIT();
        }
    }
}
}

namespace att8 {
typedef int v2i __attribute__((ext_vector_type(2)));
struct Ctx8 { const unsigned char* QA8; const unsigned char* KV8; const unsigned short* SEL; bf16* M; bool o8; };
constexpr int T2_OFF = KS_OFF, T2_BYTES = 155 * 16 * 4, SELL_OFF = KS_OFF + 10240;
static_assert(T2_BYTES <= 10240 && SELL_OFF + NWAVES * 1024 <= AUX_OFF, "attention LDS map");
__device__ __forceinline__ void mfma8(f32x4& acc, long a, long b) { asm volatile("v_mfma_f32_16x16x32_fp8_fp8 %0, %1, %2, %0" : "+v"(acc) : "v"(a), "v"(b)); }
__device__ __forceinline__ unsigned pk4_fp8(float a, float b, float c, float d) { int r = __builtin_amdgcn_cvt_pk_fp8_f32(a, b, 0, false); r = __builtin_amdgcn_cvt_pk_fp8_f32(c, d, r, true); return (unsigned)r; }

__device__ __forceinline__ void gld16(v4u& dst, const void* p) { asm volatile("global_load_dwordx4 %0, %1, off" : "=v"(dst) : "v"(p) : "memory"); }
__device__ __forceinline__ void issue_kq(const Ctx8& C, const LAS unsigned short* sq, long rowbase, long token, int g, int l15, int l4, int h, v4u (&kr)[16], v4u& qv) {
    const unsigned char* kvb = C.KV8 + rowbase * 512 + g * 128 + 16 * l4;
#pragma unroll
    for (int j = 0; j < 16; ++j) gld16(kr[j], kvb + (long)sq[j * 16 + l15] * 512);
    gld16(qv, C.QA8 + token * 1024 + (4 * g + h) * 64 + 16 * l4);
}
__device__ __forceinline__ void issue_v_half(const Ctx8& C, const LAS unsigned short* sq, long rowbase, int g, int lane, unsigned vbase, int half) {
    const unsigned char* kvb = C.KV8 + rowbase * 512 + g * 128 + 64; const int kq = lane >> 2, p = lane & 3;
#pragma unroll
    for (int j = 0; j < 8; ++j) { const int ti = half * 8 + j; const int key = sq[ti * 16 + kq]; const int x = ((kq >> 2) & 1) | ((ti & 1) << 1);
        glds16(kvb + (long)key * 512 + 16 * (p ^ x), (unsigned)__builtin_amdgcn_readfirstlane(vbase + ti * 1024)); }
}
__device__ __forceinline__ void phase(Frame& F, const Ctx8& C, const float* t5) {
    int lane = F.lane; asm volatile("" : "+v"(lane));
    LAS float* T2 = (LAS float*)(F.lds + T2_OFF);
    for (int e = F.tid; e < 155 * 16; e += NWAVES * 64) { const int rel = (e >> 4) - 91, n = rel < 0 ? -rel : rel;
        const int bk = (rel > 0 ? 16 : 0) + (n < 8 ? n : 8 + (n >= 12) + (n >= 16) + (n >= 23) + (n >= 32) + (n >= 46) + (n >= 64) + (n >= 91));
        T2[e] = t5[bk * 16 + (e & 15)] * 8.0f; }
    __syncthreads();
    LAS unsigned short* sqb = (LAS unsigned short*)(F.lds + SELL_OFF + F.wave * 1024);
    LAS unsigned char* vreg = F.lds + RING_OFF + F.wave * 16384;
    const unsigned vbase = (unsigned)(uintptr_t)vreg;
    const int l15 = lane & 15, l4 = lane >> 4, h = l15 & 3;
    const int trk = 4 * l4 + ((l15 >> 1) & 3), trt = (l15 >> 3) & 1, xs = (l4 & 1) | (trt << 1);
    const int troff = trt * 1024 + trk * 64 + 8 * (l15 & 1);
    const int x = F.vcu / 32, b = x >> 1, g0 = 2 * (x & 1); const long rowbase = (long)b * SEQ;
    const int w = (F.vcu & 31) * NWAVES + F.wave;
    constexpr int NQ = SEQ / (32 * NWAVES), NI = 2 * NQ;
    if (lane < 32) { ((LAS v4u*)sqb)[lane] = ((const v4u*)(C.SEL + (rowbase + w) * 256))[lane]; ((LAS v4u*)(sqb + 256))[lane] = ((const v4u*)(C.SEL + (rowbase + w + 32 * NWAVES) * 256))[lane]; }
    LDS_WAIT();
    v4u kr[16], qv, pf = (v4u){0u, 0u, 0u, 0u};
    issue_kq(C, sqb, rowbase, rowbase + w, g0, l15, l4, h, kr, qv);
    issue_v_half(C, sqb, rowbase, g0, lane, vbase, 0); issue_v_half(C, sqb, rowbase, g0, lane, vbase, 1);
    unsigned cib[16];
#pragma unroll 1
    for (int idx = 0; idx < NI; ++idx) { LA_A;
        const int qn = idx >> 1, gi = idx & 1, g = g0 + gi, t = w + 32 * NWAVES * qn;
        const LAS unsigned short* sq = sqb + (qn & 1) * 256;
        const int nidx = (idx + 1 < NI) ? idx + 1 : idx, nq = nidx >> 1, ng = g0 + (nidx & 1), nt = w + 32 * NWAVES * nq;
        const LAS unsigned short* nsq = sqb + (nq & 1) * 256;
        if (gi == 1) { asm volatile("s_waitcnt vmcnt(34)" : "+v"(pf) :: "memory"); if (lane < 32) ((LAS v4u*)(sqb + (qn & 1) * 256))[lane] = pf; }
        { const int pq = (qn + 2 < NQ) ? qn + 2 : NQ - 1; gld16(pf, (const v4u*)(C.SEL + (rowbase + w + 32 * NWAVES * pq) * 256) + (lane & 31)); }
        if (idx == 0) asm volatile("s_waitcnt vmcnt(0)" : "+v"(qv), "+v"(kr[0]), "+v"(kr[1]), "+v"(kr[2]), "+v"(kr[3]), "+v"(kr[4]), "+v"(kr[5]), "+v"(kr[6]), "+v"(kr[7]), "+v"(kr[8]), "+v"(kr[9]), "+v"(kr[10]), "+v"(kr[11]), "+v"(kr[12]), "+v"(kr[13]), "+v"(kr[14]), "+v"(kr[15]) :: "memory");
        else asm volatile("s_waitcnt vmcnt(20)" : "+v"(qv), "+v"(kr[0]), "+v"(kr[1]), "+v"(kr[2]), "+v"(kr[3]), "+v"(kr[4]), "+v"(kr[5]), "+v"(kr[6]), "+v"(kr[7]), "+v"(kr[8]), "+v"(kr[9]), "+v"(kr[10]), "+v"(kr[11]), "+v"(kr[12]), "+v"(kr[13]), "+v"(kr[14]), "+v"(kr[15]) :: "memory");
        if (gi == 0) {
#pragma unroll
            for (int ti = 0; ti < 16; ++ti) { const v2u i4 = *(const LAS v2u*)(sq + ti * 16 + 4 * l4);
                const int r0 = (int)(i4.x & 0xffffu) - t, r1 = (int)(i4.x >> 16) - t, r2 = (int)(i4.y & 0xffffu) - t, r3 = (int)(i4.y >> 16) - t;
                const int c0 = min(max(r0, -91), 63) + 91, c1 = min(max(r1, -91), 63) + 91, c2 = min(max(r2, -91), 63) + 91, c3 = min(max(r3, -91), 63) + 91;
                cib[ti] = (unsigned)c0 | ((unsigned)c1 << 8) | ((unsigned)c2 << 16) | ((unsigned)c3 << 24); }
        }
        const int N = 64 * ((t >> 6) + 1), nvalid = N < 256 ? N : 256;
        const long q0 = (long)(((unsigned long long)qv.y << 32) | qv.x), q1 = (long)(((unsigned long long)qv.w << 32) | qv.z);
        f32x4 S[16];
#pragma unroll
        for (int ti = 0; ti < 16; ++ti) { const unsigned cb = cib[ti];
            f32x4 a; a.x = T2[(cb & 255u) * 16 + 4 * g + h]; a.y = T2[((cb >> 8) & 255u) * 16 + 4 * g + h]; a.z = T2[((cb >> 16) & 255u) * 16 + 4 * g + h]; a.w = T2[(cb >> 24) * 16 + 4 * g + h];
            mfma8(a, (long)(((unsigned long long)kr[ti].y << 32) | kr[ti].x), q0);
            mfma8(a, (long)(((unsigned long long)kr[ti].w << 32) | kr[ti].z), q1);
            S[ti] = a; }
        asm volatile("s_nop 15\n\ts_nop 7" : "+v"(S[0]), "+v"(S[1]), "+v"(S[2]), "+v"(S[3]), "+v"(S[4]), "+v"(S[5]), "+v"(S[6]), "+v"(S[7]), "+v"(S[8]), "+v"(S[9]), "+v"(S[10]), "+v"(S[11]), "+v"(S[12]), "+v"(S[13]), "+v"(S[14]), "+v"(S[15]));
        issue_kq(C, nsq, rowbase, rowbase + nt, ng, l15, l4, h, kr, qv);
#pragma unroll
        for (int ti = 0; ti < 16; ++ti) if (ti * 16 >= nvalid) S[ti] = (f32x4){-INFINITY, -INFINITY, -INFINITY, -INFINITY};
        float mx = S[0].x;
#pragma unroll
        for (int ti = 0; ti < 16; ++ti) mx = fmaxf(fmaxf(mx, fmaxf(S[ti].x, S[ti].y)), fmaxf(S[ti].z, S[ti].w));
        mx = fmaxf(mx, __shfl_xor(mx, 16)); mx = fmaxf(mx, __shfl_xor(mx, 32));
        const float mc = -mx * C2; float ls = 0.f;
        long P8[8];
#pragma unroll
        for (int j = 0; j < 8; ++j) { float e[8];
#pragma unroll
            for (int q = 0; q < 4; ++q) { e[q] = __builtin_amdgcn_exp2f(__builtin_fmaf(S[2 * j][q], C2, mc)); e[4 + q] = __builtin_amdgcn_exp2f(__builtin_fmaf(S[2 * j + 1][q], C2, mc)); }
            ls += ((e[0] + e[1]) + (e[2] + e[3])) + ((e[4] + e[5]) + (e[6] + e[7]));
            const unsigned lo = pk4_fp8(e[0] * 256.f, e[1] * 256.f, e[2] * 256.f, e[3] * 256.f), hi = pk4_fp8(e[4] * 256.f, e[5] * 256.f, e[6] * 256.f, e[7] * 256.f);
            P8[j] = (long)(((unsigned long long)hi << 32) | lo); }
        ls += __shfl_xor(ls, 16); ls += __shfl_xor(ls, 32);
        f32x4 D[4];
#pragma unroll
        for (int db = 0; db < 4; ++db) D[db] = (f32x4){0.f, 0.f, 0.f, 0.f};
#pragma unroll
        for (int hf = 0; hf < 2; ++hf) {
            asm volatile("s_waitcnt vmcnt(28)" ::: "memory");
#pragma unroll
            for (int j = 4 * hf; j < 4 * hf + 4; ++j)
#pragma unroll
                for (int db = 0; db < 4; ++db) {
                    const v2i vv = __builtin_amdgcn_ds_read_tr8_b64_v2i32((LAS v2i*)(vreg + j * 2048 + troff + 16 * (db ^ xs)));
                    mfma8(D[db], P8[j], __builtin_bit_cast(long, vv)); }
            asm volatile("s_waitcnt lgkmcnt(0)" ::: "memory");
            issue_v_half(C, nsq, rowbase, ng, lane, vbase, hf);
        }
        asm volatile("s_nop 15\n\ts_nop 7" : "+v"(D[0]), "+v"(D[1]), "+v"(D[2]), "+v"(D[3]));
        const float lh = __shfl(ls, l4);
        const float inv = __builtin_amdgcn_rcpf(lh * 256.f);
        bf16* mp = C.M + (rowbase + t) * DM + (4 * g + l4) * 64 + l15;
#pragma unroll
        for (int db = 0; db < 4; ++db) { const float v = (l4 == 0) ? D[db].x : (l4 == 1) ? D[db].y : (l4 == 2) ? D[db].z : D[db].w;
            if (C.o8) { const unsigned o1 = (unsigned)__builtin_amdgcn_cvt_pk_fp8_f32(v * inv, 0.f, 0, false);
                asm volatile("global_store_byte %0, %1, off" :: "v"((unsigned char*)C.M + (rowbase + t) * DM + (4 * g + l4) * 64 + l15 + 16 * db), "v"(o1) : "memory"); }
            else { const unsigned short ob = (unsigned short)f2bf(v * inv);
                asm volatile("global_store_short %0, %1, off" :: "v"(mp + 16 * db), "v"((unsigned)ob) : "memory"); } }
    }
    asm volatile("s_waitcnt vmcnt(0)" ::: "memory");
}
}

#ifndef REP_P0
#define REP_P0 1
#endif
#ifndef REP_IN
#define REP_IN 1
#endif
#ifndef REP_DSA
#define REP_DSA 1
#endif
#ifndef REP_BAND
#define REP_BAND 1
#endif
#ifndef REP_UP
#define REP_UP 1
#endif
#ifndef REP_FIX
#define REP_FIX 1
#endif
constexpr int N_PHASES = 1 + 6 * DEPTH;
#ifndef MK_N_LAUNCHES
#define MK_N_LAUNCHES 1
#endif
__global__ void __launch_bounds__(NWAVES * 64, 2) mega_fwd(Args args) {
    extern __shared__ __attribute__((aligned(16))) unsigned char lds[];
    Frame F;
    F.lds = (LAS unsigned char*)lds;
    F.MISC = (volatile LAS unsigned*)(F.lds + MISC_OFF);
    F.tid = threadIdx.x; F.lane = F.tid & 63; F.wave = __builtin_amdgcn_readfirstlane(F.tid >> 6);
    F.G = GRID; { const int bx = blockIdx.x; F.vcu = (bx & 7) * (GRID / 8) + (bx >> 3); }
    unsigned char* ws = args.ws;
    F.ctl = (gu32*)(ws + WS_CTL);
    for (int u = F.tid; u < (LDS_BYTES - LDSCTL_OFF) / 4; u += NWAVES * 64) ((LAS unsigned*)(F.lds + LDSCTL_OFF))[u] = 0u;
    __syncthreads();
    XcdBarrier bar; bar.bar = (unsigned*)(F.ctl + CW_BAR); bar.x = 0; bar.st = nullptr;
    if (MK_N_LAUNCHES == 1) bar = xcd_barrier_post((unsigned*)(F.ctl + CW_BAR), F.MISC + 8);
#ifdef F8M_RUNTIME
    const int lo = args.ph_lo, hi = args.ph_hi, f8m = args.f8m;
#else
    const int lo = args.ph_lo, hi = args.ph_hi; constexpr int f8m = F8M_ALL;
#ifdef PAD_NOPS
    asm volatile(".rept %0\n\ts_nop 0\n\t.endr" :: "n"(PAD_NOPS));
#endif
#endif
#define IN(k) (lo <= (k) && (k) < hi)
#define OPQ_FRAME(Fl) Frame Fl = F; { int l_; asm volatile("v_mbcnt_lo_u32_b32 %0, -1, 0\n\tv_mbcnt_hi_u32_b32 %0, -1, %0" : "=v"(l_)); int w_ = F.wave; asm volatile("" : "+s"(w_)); Fl.wave = w_; Fl.lane = l_; Fl.tid = w_ * 64 + l_; }
#define SEAM(k) do { if (IN(k) && IN((k) + 1)) xcd_barrier(bar); } while (0)

    bf16* hb = (bf16*)(ws + WS_HB); bf16* mb = (bf16*)(ws + WS_M); float* ss = (float*)(ws + WS_SS); float* halo = (float*)(ws + WS_HALO);
    unsigned char* proj = ws + WS_PROJ; bf16* act = (bf16*)(ws + WS_PROJ);

#ifndef SKIP_P0
    if (IN(0)) { for (int rep = 0; rep < REP_P0; ++rep) { OPQ_FRAME(F0); p0_prologue(F0, args); } }
#endif
    SEAM(0);

#pragma unroll 1
    for (int L = 0; L < DEPTH; ++L) {
        const int pb = 1 + 6 * L, li = L >> 1; const bool isB = (L & 1) != 0;
        if (IN(pb)) {
#ifndef SKIP_IN
            for (int rep = 0; rep < REP_IN; ++rep)
            if (!isB) {
                pg8::Gemm g{hb, (const bf16*)(ws + WS_W_INA) + (size_t)li * NA_PAD * DM, MTOK, NA_PAD, DM}; pg8::StaticOrder S; S.init(MTOK, NA_PAD, F.G, (int)blockIdx.x);
                if (f8_in(f8m, L)) {
                    { pg8::Gemm g8{(const bf16*)(ws + WS_M), (const bf16*)(ws + WS_W_INA8 + (size_t)li * NA_PAD * DM), MTOK, 1536, DM / 2}; pg8::StaticOrder S8; S8.init(MTOK, 1536, F.G, (int)blockIdx.x);
                      EpiIn E{ss, proj, args.q_norm_g + L * 64, args.k_norm_g + L * 64, 0, W8I, 0};
                      pg8::gemm_phase<EpiIn, pg8::StaticOrder, true, true, true>(F.lds + RING_OFF, g8, S8, E, F.wave); }
                    { pg8::Gemm g2{hb, (const bf16*)(ws + WS_W_INA) + (size_t)li * NA_PAD * DM + (size_t)1536 * DM, MTOK, NA_PAD - 1536, DM}; pg8::StaticOrder S2; S2.init(MTOK, NA_PAD - 1536, F.G, (int)blockIdx.x);
                      EpiIn E{ss, proj, args.q_norm_g + L * 64, args.k_norm_g + L * 64, 0, 1.0f, 6};
                      pg8::gemm_phase<EpiIn, pg8::StaticOrder, true, true>(F.lds + RING_OFF, g2, S2, E, F.wave); }
                } else {
                EpiIn E{ss, proj, args.q_norm_g + L * 64, args.k_norm_g + L * 64, 0, 1.0f, 0};
                pg8::gemm_phase<EpiIn, pg8::StaticOrder, true, true>(F.lds + RING_OFF, g, S, E, F.wave); }
            } else {
                pg8::Gemm g{hb, (const bf16*)(ws + WS_W_INB) + (size_t)li * NB * DM, MTOK, NB, DM}; pg8::StaticOrder S; S.init(MTOK, NB, F.G, (int)blockIdx.x);
                if (f8_in(f8m, L)) { pg8::Gemm g8{(const bf16*)(ws + WS_M), (const bf16*)(ws + WS_W_INB) + (size_t)li * NB * DM, MTOK, NB, DM / 2};
                    EpiIn E{ss, proj, args.q_norm_g + L * 64, args.k_norm_g + L * 64, 1, W8I, 0};
                    pg8::gemm_phase<EpiIn, pg8::StaticOrder, true, true, true>(F.lds + RING_OFF, g8, S, E, F.wave); }
                else { EpiIn E{ss, proj, args.q_norm_g + L * 64, args.k_norm_g + L * 64, 1, 1.0f, 0};
                    pg8::gemm_phase<EpiIn, pg8::StaticOrder, true, true>(F.lds + RING_OFF, g, S, E, F.wave); }
            }
#endif
        }
        SEAM(pb);
#if defined(DBG_NODSA) || defined(DBG_NOBAND)
#ifdef DBG_NODSA
        const bool zero_m = !isB;
#else
        const bool zero_m = isB;
#endif
        if (IN(pb + 1) && zero_m) { for (size_t i = (size_t)blockIdx.x * 512 + threadIdx.x; i < (size_t)MTOK * DM / 8; i += (size_t)gridDim.x * 512) ((v4u*)mb)[i] = (v4u){0u, 0u, 0u, 0u}; }
        if (IN(pb + 1) && !zero_m) {
#else
        if (IN(pb + 1)) {
#endif
#ifndef SKIP_DSA
            if (!isB) {
                LAS float* t5l = (LAS float*)(F.lds + AUX_OFF);
                { OPQ_FRAME(Ft); for (int i = Ft.tid; i < 512; i += NWAVES * 64) t5l[i] = args.t5_bias[i] * LOG2E; }
                __syncthreads();
                dsa::Ctx C{(const bf16*)(proj + PA_QA), (const bf16*)(proj + PA_KA), (const bf16*)(proj + PA_VA), (const bf16*)(proj + PA_QI), (const bf16*)(proj + PA_KI), (const float*)(proj + PA_WI), mb, t5l, (unsigned short*)(proj + PA_SEL)};
#ifdef DBG_DSACOPY
                { int t_ = threadIdx.x; asm volatile("" : "+v"(t_));
                for (unsigned i = blockIdx.x * 512u + (unsigned)t_; i < (unsigned)MTOK * DM; i += gridDim.x * 512u) { const unsigned t = i >> 10, c = i & 1023u;
                    float v = bf_lo(C.QA[i]); v += bf_lo(C.KA[t * 256 + (c & 255)]); v += bf_lo(C.VA[t * 256 + (c & 255)]); v += bf_lo(C.QI[t * 512 + (c & 511)]); v += bf_lo(C.KI[t * 64 + (c & 63)]); v += C.WI[t * 8 + (c & 7)];
                    mb[i] = (bf16)f2bf(v * 0.01f); asm volatile("" ::: "memory"); } }
#else
                for (int rep = 0; rep < REP_DSA; ++rep) { OPQ_FRAME(F1); dsa::phase(F1, C); }
                xcd_barrier(bar);
                { OPQ_FRAME(F1b); att8::Ctx8 C8{(const unsigned char*)(proj + PA_QA), (const unsigned char*)(proj + PA_KA), (const unsigned short*)(proj + PA_SEL), mb, f8_out(f8m, L)};
#ifndef REP_ATT8
#define REP_ATT8 1
#endif
                  for (int rep = 0; rep < REP_ATT8; ++rep) { att8::phase(F1b, C8, args.t5_bias); __syncthreads(); } }
#endif
            }
#endif
#ifndef SKIP_BAND
            if (isB) {
                for (int rep = 0; rep < REP_BAND; ++rep) { OPQ_FRAME(F2); band::phase(F2, (const bf16*)proj, (const bf16*)(proj + PB_STRIDE), (const bf16*)(proj + 2 * PB_STRIDE), mb, args.rel_bias_b + (size_t)li * 513 * 16, f8_out(f8m, L)); }
            }
#endif
        }
        SEAM(pb + 1);
        if (IN(pb + 2)) {
#ifndef SKIP_OUT
            pg8::Gemm g{mb, (const bf16*)(ws + WS_W_OUT) + (size_t)L * DM * DM, MTOK, DM, DM}; pg8::StaticOrder S; S.init(MTOK, DM, F.G, (int)blockIdx.x);
#ifdef REP_OUT
            { EpiRes E0{nullptr, hb, (bf16*)proj, halo}; pg8::gemm_phase<EpiRes, pg8::StaticOrder, true, true>(F.lds + RING_OFF, g, S, E0, F.wave); }
#endif
            unsigned char* h8o = f8_ffn(f8m, L) ? proj + PX_HB8 : nullptr;
            if (f8_out(f8m, L)) { pg8::Gemm g8{mb, (const bf16*)(ws + WS_W_OUT) + (size_t)L * DM * DM, MTOK, DM, DM / 2};
                EpiResT<1 | SER_OUT> E{nullptr, hb, hb, ss, h8o};
                pg8::gemm_phase<EpiResT<1 | SER_OUT>, pg8::StaticOrder, true, true, true>(F.lds + RING_OFF, g8, S, E, F.wave); }
            else { EpiResT<SER_OUT> E{nullptr, hb, hb, ss, h8o, L == 0 ? args.x : nullptr};
                pg8::gemm_phase<EpiResT<SER_OUT>, pg8::StaticOrder, true, true>(F.lds + RING_OFF, g, S, E, F.wave); }
#endif
        }
        SEAM(pb + 2);
        if (IN(pb + 3)) {
#ifndef SKIP_UP
            for (int rep = 0; rep < REP_UP; ++rep) {
            pg8::Gemm g{hb, (const bf16*)(ws + WS_W_UP) + (size_t)L * NUP * DM, MTOK, NUP, DM}; pg8::StaticOrder S; S.init(MTOK, NUP, F.G, (int)blockIdx.x);
#ifdef PROBE_UPK
            { EpiDummy E0{halo}; pg8::gemm_phase<EpiDummy, pg8::StaticOrder, true, true>(F.lds + RING_OFF, g, S, E0, F.wave); }
#endif
            if (f8_ffn(f8m, L)) { pg8::Gemm g8{(const bf16*)(proj + PX_HB8), (const bf16*)(ws + WS_W_UP) + (size_t)L * NUP * DM, MTOK, NUP, DM / 2};
                EpiUpT<true> E{ss, args.conv_w + (size_t)L * 3 * NUP, args.conv_b + (size_t)L * NUP, act, halo, (LAS float*)(F.lds + AUX_OFF)};
                pg8::gemm_phase<EpiUpT<true>, pg8::StaticOrder, true, true, true>(F.lds + RING_OFF, g8, S, E, F.wave); }
            else { EpiUp E{ss, args.conv_w + (size_t)L * 3 * NUP, args.conv_b + (size_t)L * NUP, act, halo, (LAS float*)(F.lds + AUX_OFF)};
                pg8::gemm_phase<EpiUp, pg8::StaticOrder, true, true>(F.lds + RING_OFF, g, S, E, F.wave); } }
#endif
        }
        SEAM(pb + 3);
#ifndef SKIP_FIX
        if (IN(pb + 4)) for (int rep = 0; rep < REP_FIX; ++rep) { OPQ_FRAME(F3); if (f8_ffn(f8m, L)) fixup_phase<true>(F3, args.conv_w + (size_t)L * 3 * NUP, args.conv_b + (size_t)L * NUP, halo, act); else fixup_phase<false>(F3, args.conv_w + (size_t)L * 3 * NUP, args.conv_b + (size_t)L * NUP, halo, act); }
#endif
        SEAM(pb + 4);
        if (IN(pb + 5)) {
#ifndef SKIP_DN
            pg8::Gemm g{act, (const bf16*)(ws + WS_W_DN) + (size_t)L * DM * FF, MTOK, DM, FF}; pg8::StaticOrder S; S.init(MTOK, DM, F.G, (int)blockIdx.x);
#ifdef REP_DN
            { EpiRes E0{nullptr, hb, mb, halo}; pg8::gemm_phase<EpiRes, pg8::StaticOrder, true, true>(F.lds + RING_OFF, g, S, E0, F.wave); }
#endif
            unsigned char* h8d = f8_in(f8m, L + 1) ? ws + WS_M : nullptr;
            if (f8_ffn(f8m, L)) { pg8::Gemm g8{act, (const bf16*)(ws + WS_W_DN) + (size_t)L * DM * FF, MTOK, DM, FF / 2};
                EpiResT<1> E{L == DEPTH - 1 ? args.out : nullptr, hb, hb, ss, h8d};
                pg8::gemm_phase<EpiResT<1>, pg8::StaticOrder, true, true, true>(F.lds + RING_OFF, g8, S, E, F.wave); }
            else { EpiRes E{L == DEPTH - 1 ? args.out : nullptr, hb, hb, ss, h8d};
                pg8::gemm_phase<EpiRes, pg8::StaticOrder, true, true>(F.lds + RING_OFF, g, S, E, F.wave); }
#endif
        }
        SEAM(pb + 5);
    }
#undef IN
#undef SEAM
}

extern "C" void kernel_launch(void* const* d_in, const int* in_sizes, int n_in, void* d_out, int out_size, void* d_ws, size_t ws_size, hipStream_t stream) {
    static int grid = 0;
    if (grid == 0) {
        if (n_in != 14 || in_sizes[0] != MTOK * DM || out_size != MTOK * DM || ws_size < WS_END) { fprintf(stderr, "kernel_launch: unexpected shapes / workspace (n_in %d, ws %zu); nothing launched\n", n_in, ws_size); grid = -1; return; }
        int dev = 0, cus = 0, per_cu = 0;
        if (hipGetDevice(&dev) != hipSuccess || hipDeviceGetAttribute(&cus, hipDeviceAttributeMultiprocessorCount, dev) != hipSuccess) { grid = -1; return; }
        if (hipFuncSetAttribute((const void*)mega_fwd, hipFuncAttributeMaxDynamicSharedMemorySize, LDS_BYTES) != hipSuccess) { fprintf(stderr, "kernel_launch: hipFuncSetAttribute failed\n"); grid = -1; return; }
        if (hipOccupancyMaxActiveBlocksPerMultiprocessor(&per_cu, (const void*)mega_fwd, NWAVES * 64, LDS_BYTES) != hipSuccess || per_cu < 1) { fprintf(stderr, "kernel_launch: occupancy query reports %d blocks per CU\n", per_cu); }
        (void)hipGetLastError();
        if (cus != GRID) { fprintf(stderr, "kernel_launch: built for a %d-CU device, found %d; nothing launched\n", GRID, cus); grid = -1; return; }
        grid = GRID;
    }
    if (grid < 0) return;
    if (hipMemsetAsync((char*)d_ws + WS_CTL, 0, CTL_ZERO_BYTES, stream) != hipSuccess) return;
    Args a{};
    a.x = (const float*)d_in[0]; a.attn_norm_g = (const float*)d_in[1]; a.w_in_a = (const float*)d_in[2]; a.w_in_b = (const float*)d_in[3]; a.q_norm_g = (const float*)d_in[4];
    a.k_norm_g = (const float*)d_in[5]; a.t5_bias = (const float*)d_in[6]; a.rel_bias_b = (const float*)d_in[7]; a.w_out = (const float*)d_in[8]; a.ffn_norm_g = (const float*)d_in[9];
    a.w_up = (const float*)d_in[10]; a.conv_w = (const float*)d_in[11]; a.conv_b = (const float*)d_in[12]; a.w_down = (const float*)d_in[13];
    a.out = (float*)d_out; a.ws = (unsigned char*)d_ws; a.f8m = F8M_ALL;
#if MK_N_LAUNCHES == 1
    a.ph_lo = 0; a.ph_hi = N_PHASES; a.li = 0;
    hipLaunchKernelGGL(mega_fwd, dim3(grid), dim3(NWAVES * 64), LDS_BYTES, stream, a);
#else
    for (int p = 0; p < N_PHASES; ++p) { a.ph_lo = p; a.ph_hi = p + 1; a.li = p; hipLaunchKernelGGL(mega_fwd, dim3(grid), dim3(NWAVES * 64), LDS_BYTES, stream, a); }
#endif
}
```

```cpp
#define F8M_IN 0xF
#define F8M_OUT 0xF
#include <hip/hip_runtime.h>
#include <cstdio>
#include <cstdint>
#ifndef OFF_G
#define OFF_G 0
#endif
#ifndef OFF_S
#define OFF_S 0
#endif
#ifndef OFF_A
#define OFF_A 0
#endif
#ifndef OFF_B
#define OFF_B 0
#endif
#define LOOP_ALIGN_N(n) asm volatile(".p2align 6\n\t.rept %0\n\ts_nop 0\n\t.endr" :: "n"(n))
#if OFF_G < 0
#define LA_G
#else
#define LA_G LOOP_ALIGN_N(OFF_G)
#endif
#if OFF_S < 0
#define LA_S
#else
#define LA_S LOOP_ALIGN_N(OFF_S)
#endif
#if OFF_A < 0
#define LA_A
#else
#define LA_A LOOP_ALIGN_N(OFF_A)
#endif
#if OFF_B < 0
#define LA_B
#else
#define LA_B LOOP_ALIGN_N(OFF_B)
#endif
namespace pg8 {
#define PG8_LAS __attribute__((address_space(3)))
typedef unsigned short bf16_t;
typedef short bf16x8 __attribute__((ext_vector_type(8)));
typedef float f32x4 __attribute__((ext_vector_type(4)));
typedef unsigned u32x4 __attribute__((ext_vector_type(4)));
typedef int i32x4 __attribute__((ext_vector_type(4)));
typedef int i32x8 __attribute__((ext_vector_type(8)));
constexpr int BM = 256, BK = 64, HALF = 128, HTB = HALF * BK * 2  , STAGE_BYTES = 8 * HTB, NXCD = 8, WGM = 8;

__host__ __device__ __forceinline__ int lds_byte(int r, int c) { const int st = (r >> 4) * 2 + (c >> 5), rr = r & 15, cc = c & 31, ob = rr * 64 + cc * 2; return st * 1024 + (ob ^ (((ob >> 9) & 1) << 5)); }
__host__ __device__ __forceinline__ void stage_rc(int b, int& R, int& C) { const int st = b / 1024, sb = b % 1024, swz = sb ^ (((sb >> 9) & 1) << 5); R = (st >> 1) * 16 + swz / 64; C = (st & 1) * 32 + (swz % 64) / 2; }
__host__ __device__ __forceinline__ int perm32(int rho) { const int n = rho >> 4, i = rho & 15; return 8 * (i >> 2) + 4 * n + (i & 3); }

struct Unit { int pm, pn; };
struct Gemm { const bf16_t* A; const bf16_t* Bt; int M, N, K; };

struct StaticOrder {
    int nM, nN, nwg, G, c;
    __host__ __device__ void init(int M, int N, int G_, int c_) { nM = M / BM; nN = N / BM; nwg = nM * nN; G = G_; c = c_; }
    __host__ __device__ bool next(int i, Unit& u) const {
        const long L = (long)i * G + c; if (L >= nwg) return false;
        int wgid = (int)L; { const int q = nwg / NXCD, r = nwg % NXCD, xcd = wgid % NXCD, off = wgid / NXCD; wgid = (xcd < r ? xcd * (q + 1) : r * (q + 1) + (xcd - r) * q) + off; }
        const int nig = WGM * nN, gid = wgid / nig, fm = gid * WGM, gsz = (nM - fm) < WGM ? (nM - fm) : WGM;
        u.pm = fm + ((wgid % nig) % gsz); u.pn = (wgid % nig) / gsz; return true;
    }
    __device__ __forceinline__ void a_ready(const Unit&) const {}
    __device__ __forceinline__ void done(const Unit&) const {}
};
struct SplitOrder {
    int nN, G, c, lo, hi;
    __host__ __device__ void init(int N, int G_, int c_, int lo_, int hi_) { nN = N / BM; G = G_; c = c_; lo = lo_; hi = hi_; }
    __host__ __device__ bool next(int i, Unit& u) const {
        const bool up = c >= G / 2; if (i >= (up ? hi : lo)) return false;
        const int id = (i < lo) ? i * G + c : lo * G + (i - lo) * (G / 2) + (c - G / 2);
        u.pm = id / nN; u.pn = id % nN; return true;
    }
    __device__ __forceinline__ void a_ready(const Unit&) const {}
    __device__ __forceinline__ void done(const Unit&) const {}
};
__device__ __forceinline__ unsigned cvt_pk_bf16(float lo, float hi) { unsigned r; asm volatile("v_cvt_pk_bf16_f32 %0, %1, %2" : "=v"(r) : "v"(lo), "v"(hi)); return r; }
template <class Epi, class Sched, bool ALIGN_EPI = false, bool SP2 = false, bool F8 = false>
__device__ __forceinline__ void gemm_phase(PG8_LAS unsigned char* lds, const Gemm g, const Sched& S, const Epi& E, const int wave_id) {
    int lane_; asm volatile("v_mbcnt_lo_u32_b32 %0, -1, 0\n\tv_mbcnt_hi_u32_b32 %0, -1, %0" : "=v"(lane_));
    int wid_ = wave_id; asm volatile("" : "+s"(wid_));
    const int wid = wid_, lane = lane_, tid = wid * 64 + lane, wr = wid >> 2, wc = wid & 3, fr = lane & 15, fq = lane >> 4;
    const int K = g.K, nt = K / BK;
    unsigned voffA[2], voffB[2];
#pragma unroll
    for (int i = 0; i < 2; ++i) { int R, C; stage_rc(tid * 16 + i * 8192, R, C); const int Rb = Epi::PERM ? ((R & ~31) + perm32(R & 31)) : R;
        const int Ra = Epi::PERMA ? ((R & ~63) | (4 * (R & 15) + ((R >> 4) & 3))) : R;
        voffA[i] = (unsigned)(Ra * K + C) * 2u; voffB[i] = (unsigned)(Rb * K + C) * 2u; }
    const size_t kstep = (size_t)(BK * 2);
    const size_t hstep = (size_t)HALF * K * 2;
    const size_t tstep = 2 * hstep;
    const unsigned ldsw = (unsigned)wid * 1024u;
    const int aoff = lds_byte(wr * 64 + fr, fq * 8), boff = lds_byte(wc * 32 + fr, fq * 8);
#define PG8_SA(b, h) (((b) * 2 + (h)) * HTB)
#define PG8_SB(b, h) ((4 + (b) * 2 + (h)) * HTB)
#define PG8_STAGE(bufoff, gbase, voff) do { _Pragma("unroll") for (int _i = 0; _i < 2; ++_i) \
        __builtin_amdgcn_global_load_lds((const unsigned*)((const char*)(gbase) + (voff)[_i]), (PG8_LAS unsigned*)(lds + (bufoff) + ldsw + _i * 8192), 16, 0, 0); } while (0)
#define PG8_LDA(dst, b, h) do { _Pragma("unroll") for (int m = 0; m < 4; ++m) _Pragma("unroll") for (int k = 0; k < 2; ++k) dst[m][k] = *(const PG8_LAS bf16x8*)(lds + PG8_SA(b, h) + aoff + m * 2048 + k * 1024); } while (0)
#define PG8_LDB(dst, b, h) do { _Pragma("unroll") for (int n = 0; n < 2; ++n) _Pragma("unroll") for (int k = 0; k < 2; ++k) dst[n][k] = *(const PG8_LAS bf16x8*)(lds + PG8_SB(b, h) + boff + n * 2048 + k * 1024); } while (0)
#define PG8_CAT(lo, hi) __builtin_shufflevector(__builtin_bit_cast(i32x4, lo), __builtin_bit_cast(i32x4, hi), 0, 1, 2, 3, 4, 5, 6, 7)
#define PG8_MMA(ai, bj, At, Bt) do { __builtin_amdgcn_s_setprio(1); _Pragma("unroll") for (int m = 0; m < 4; ++m) _Pragma("unroll") for (int n = 0; n < 2; ++n) { \
        if constexpr (F8) { const i32x8 b8_ = PG8_CAT(Bt[n][0], Bt[n][1]), a8_ = PG8_CAT(At[m][0], At[m][1]); asm volatile("v_mfma_f32_16x16x128_f8f6f4 %0, %1, %2, %0" : "+v"(acc[ai][bj][m][n]) : "v"(b8_), "v"(a8_)); } \
        else { _Pragma("unroll") for (int k = 0; k < 2; ++k) acc[ai][bj][m][n] = __builtin_amdgcn_mfma_f32_16x16x32_bf16(Bt[n][k], At[m][k], acc[ai][bj][m][n], 0, 0, 0); } } __builtin_amdgcn_s_setprio(0); } while (0)
#define PG8_WAIT_V(n) asm volatile("s_waitcnt vmcnt(" #n ")" ::: "memory")
#define PG8_WAIT_L(n) asm volatile("s_waitcnt lgkmcnt(" #n ")" ::: "memory")
#define PG8_BAR __builtin_amdgcn_s_barrier()
#define PG8_SCHED __builtin_amdgcn_sched_barrier(0)
    Unit cur, nxt; int ui = 0;
    if (!S.next(0, cur)) return;
    f32x4 acc[2][2][4][2];
#pragma unroll
    for (int a = 0; a < 2; ++a)
#pragma unroll
        for (int b = 0; b < 2; ++b)
#pragma unroll
            for (int m = 0; m < 4; ++m)
#pragma unroll
                for (int n = 0; n < 2; ++n) acc[a][b][m][n] = (f32x4){0.f, 0.f, 0.f, 0.f};
    bf16x8 At[4][2], B0[2][2], B1[2][2];
    const char* cA = (const char*)g.A + (size_t)cur.pm * tstep; const char* cB = (const char*)g.Bt + (size_t)cur.pn * tstep;
    S.a_ready(cur);
    if constexpr (SP2) {
        PG8_STAGE(PG8_SB(0, 0), cB, voffB); PG8_STAGE(PG8_SB(0, 1), cB + hstep, voffB); PG8_STAGE(PG8_SA(0, 0), cA, voffA); PG8_STAGE(PG8_SA(0, 1), cA + hstep, voffA);
        if (wr == 1) PG8_BAR;
        PG8_WAIT_V(2); PG8_BAR;
        PG8_STAGE(PG8_SB(1, 0), cB + kstep, voffB); PG8_STAGE(PG8_SA(1, 0), cA + kstep, voffA); PG8_STAGE(PG8_SB(1, 1), cB + hstep + kstep, voffB);
        PG8_WAIT_V(6); PG8_BAR;
    } else {
        PG8_STAGE(PG8_SB(0, 0), cB, voffB); PG8_STAGE(PG8_SA(0, 0), cA, voffA); PG8_STAGE(PG8_SB(0, 1), cB + hstep, voffB); PG8_STAGE(PG8_SA(0, 1), cA + hstep, voffA);
        if (wr == 1) PG8_BAR;
        PG8_WAIT_V(4); PG8_BAR;
        PG8_STAGE(PG8_SB(1, 0), cB + kstep, voffB); PG8_STAGE(PG8_SA(1, 0), cA + kstep, voffA); PG8_STAGE(PG8_SB(1, 1), cB + hstep + kstep, voffB);
        PG8_WAIT_V(6); PG8_BAR;
    }
    for (;;) {
        const bool has_next = S.next(ui + 1, nxt);
        const char* nA = has_next ? (const char*)g.A + (size_t)nxt.pm * tstep : cA; const char* nB = has_next ? (const char*)g.Bt + (size_t)nxt.pn * tstep : cB;
        for (int t = 0; t < nt; t += 2) { LA_G;
            const bool last = (t == nt - 2);
            const char* a1 = cA + (size_t)(t + 1) * kstep;
            const char* a2 = last ? nA : cA + (size_t)(t + 2) * kstep; const char* b2 = last ? nB : cB + (size_t)(t + 2) * kstep;
            const char* a3 = a2 + kstep; const char* b3 = b2 + kstep;
            if (last && has_next) S.a_ready(nxt);
            if constexpr (SP2) {
            PG8_LDB(B0, 0, 0); PG8_LDB(B1, 0, 1); PG8_SCHED; PG8_LDA(At, 0, 0); PG8_STAGE(PG8_SA(1, 1), a1 + hstep, voffA);
            PG8_WAIT_V(8); PG8_WAIT_L(0); PG8_BAR; PG8_MMA(0, 0, At, B0); PG8_MMA(0, 1, At, B1); PG8_BAR; PG8_SCHED;
            PG8_LDA(At, 0, 1); PG8_STAGE(PG8_SB(0, 0), b2, voffB); PG8_STAGE(PG8_SB(0, 1), b2 + hstep, voffB); PG8_STAGE(PG8_SA(0, 0), a2, voffA);
            PG8_WAIT_V(8); PG8_WAIT_L(0); PG8_BAR; PG8_MMA(1, 0, At, B0); PG8_MMA(1, 1, At, B1); PG8_BAR; PG8_SCHED;
            PG8_LDB(B0, 1, 0); PG8_LDB(B1, 1, 1); PG8_SCHED; PG8_LDA(At, 1, 0); PG8_STAGE(PG8_SA(0, 1), a2 + hstep, voffA);
            PG8_WAIT_V(8); PG8_WAIT_L(0); PG8_BAR; PG8_MMA(0, 0, At, B0); PG8_MMA(0, 1, At, B1); PG8_BAR; PG8_SCHED;
            PG8_LDA(At, 1, 1); PG8_STAGE(PG8_SB(1, 0), b3, voffB); PG8_STAGE(PG8_SB(1, 1), b3 + hstep, voffB); PG8_STAGE(PG8_SA(1, 0), a3, voffA);
            PG8_WAIT_V(8); PG8_WAIT_L(0); PG8_BAR; PG8_MMA(1, 0, At, B0); PG8_MMA(1, 1, At, B1); PG8_BAR; PG8_SCHED;
            } else {
            PG8_LDB(B0, 0, 0); PG8_SCHED; PG8_LDA(At, 0, 0); PG8_STAGE(PG8_SA(1, 1), a1 + hstep, voffA);
            PG8_WAIT_L(8); PG8_BAR; PG8_WAIT_L(0); PG8_MMA(0, 0, At, B0); PG8_BAR; PG8_SCHED;
            PG8_LDB(B1, 0, 1); PG8_STAGE(PG8_SB(0, 0), b2, voffB);
            PG8_BAR; PG8_WAIT_L(0); PG8_MMA(0, 1, At, B1); PG8_BAR;
            PG8_LDA(At, 0, 1); PG8_STAGE(PG8_SA(0, 0), a2, voffA);
            PG8_BAR; PG8_WAIT_L(0); PG8_MMA(1, 0, At, B0); PG8_BAR; PG8_SCHED;
            PG8_STAGE(PG8_SB(0, 1), b2 + hstep, voffB);
            PG8_WAIT_V(6); PG8_BAR; PG8_MMA(1, 1, At, B1); PG8_BAR;
            PG8_LDB(B0, 1, 0); PG8_SCHED; PG8_LDA(At, 1, 0); PG8_STAGE(PG8_SA(0, 1), a2 + hstep, voffA);
            PG8_WAIT_L(8); PG8_BAR; PG8_WAIT_L(0); PG8_MMA(0, 0, At, B0); PG8_BAR; PG8_SCHED;
            PG8_LDB(B1, 1, 1); PG8_STAGE(PG8_SB(1, 0), b3, voffB);
            PG8_BAR; PG8_WAIT_L(0); PG8_MMA(0, 1, At, B1); PG8_BAR;
            PG8_LDA(At, 1, 1); PG8_STAGE(PG8_SA(1, 0), a3, voffA);
            PG8_BAR; PG8_WAIT_L(0); PG8_MMA(1, 0, At, B0); PG8_BAR; PG8_SCHED;
            PG8_STAGE(PG8_SB(1, 1), b3 + hstep, voffB);
            PG8_WAIT_V(6); PG8_BAR; PG8_MMA(1, 1, At, B1); PG8_BAR;
            }
        }
        if constexpr (F8) asm volatile("s_nop 15\n\ts_nop 15" ::: "memory");
        if constexpr (ALIGN_EPI) { if (wr == 0) PG8_BAR; }
        if constexpr (!Epi::AFTER_DRAIN) { E(acc, cur, wr, wc, fr, fq); S.done(cur); }
        if (!has_next) break;
#pragma unroll
        for (int a = 0; a < 2; ++a)
#pragma unroll
            for (int b = 0; b < 2; ++b)
#pragma unroll
                for (int m = 0; m < 4; ++m)
#pragma unroll
                    for (int n = 0; n < 2; ++n) acc[a][b][m][n] = (f32x4){0.f, 0.f, 0.f, 0.f};
        cur = nxt; cA = nA; cB = nB; ++ui;
        if constexpr (ALIGN_EPI) { if (wr == 1) PG8_BAR; }
    }
    PG8_WAIT_V(0);
    if constexpr (!ALIGN_EPI) { if (wr == 0) PG8_BAR; }
    PG8_BAR;
    if constexpr (Epi::AFTER_DRAIN) { E.fused(acc, cur, wr, wc, fr, fq, lds, wid, lane); S.done(cur); }
#undef PG8_SA
#undef PG8_SB
#undef PG8_STAGE
#undef PG8_LDA
#undef PG8_LDB
#undef PG8_MMA
#undef PG8_CAT
#undef PG8_WAIT_V
#undef PG8_WAIT_L
#undef PG8_BAR
#undef PG8_SCHED
}
}

constexpr int NWAVES = 8, GRID = 256;
constexpr int BATCH = 4, SEQ = 8192, DM = 1024, MTOK = BATCH * SEQ, DEPTH = 4;
constexpr int NA_SRC = 2120, NA_PAD = 2304, NB = 3072, FF = 2816, NUP = 2 * FF;
constexpr float EPS = 1e-6f;
constexpr float LOG2E = 1.4426950408889634f;
constexpr float C2 = 0.125f * LOG2E;
constexpr int NBLK64 = MTOK / 64;

constexpr size_t MiB = 1u << 20;
constexpr size_t WS_CTL = 0, CTL_ZERO_BYTES = 1 * MiB;
constexpr size_t WS_W_INA = 2 * MiB;
constexpr size_t WS_W_INB = 11 * MiB;
constexpr size_t WS_W_OUT = 23 * MiB;
constexpr size_t WS_W_UP = 31 * MiB;
constexpr size_t WS_W_DN = 75 * MiB;
constexpr size_t WS_HB = 98 * MiB;
constexpr size_t WS_M = 162 * MiB;
constexpr size_t WS_SS = 226 * MiB;
constexpr size_t WS_HALO = 228 * MiB;
constexpr size_t WS_PROJ = 272 * MiB;
constexpr size_t WS_W_INA8 = 464 * MiB;
constexpr size_t WS_END = 469 * MiB;
constexpr size_t PA_QA = 0, PA_KA = 64 * MiB, PA_VA = 80 * MiB, PA_QI = 96 * MiB, PA_KI = 128 * MiB, PA_WI = 132 * MiB, PA_SEL = 136 * MiB;
constexpr size_t PB_STRIDE = 64 * MiB;
constexpr int CW_BAR = 4096;
constexpr int F8_L0 = 2;
#ifndef F8M_IN
#define F8M_IN 0x8
#endif
#ifndef F8M_OUT
#define F8M_OUT 0xC
#endif
#ifndef F8M_FFN
#define F8M_FFN 0xC
#endif
#define F8M_ALL ((F8M_IN & 0xF) | ((F8M_OUT & 0xF) << 4) | ((F8M_FFN & 0xF) << 8))
__host__ __device__ constexpr bool f8_in(int m, int L) { return L < DEPTH && ((m >> L) & 1) != 0; }
__host__ __device__ constexpr bool f8_out(int m, int L) { return ((m >> (4 + L)) & 1) != 0; }
__host__ __device__ constexpr bool f8_ffn(int m, int L) { return ((m >> (8 + L)) & 1) != 0; }
constexpr size_t PX_HB8 = 96 * MiB;
constexpr float W8S = 128.f, W8I = 1.f / 128.f;

constexpr int RING_OFF = 0, RING_BYTES = 131072;
constexpr int KS_OFF = RING_BYTES;
constexpr int AUX_OFF = RING_BYTES + 24576;
constexpr int LDSCTL_OFF = AUX_OFF + 4096, MISC_OFF = LDSCTL_OFF + 320;
constexpr int LDS_BYTES = 163840;
static_assert(MISC_OFF + 128 <= LDS_BYTES, "LDS map");

#define GAS __attribute__((address_space(1)))
#define LAS __attribute__((address_space(3)))
typedef unsigned short bf16;
typedef unsigned v4u __attribute__((ext_vector_type(4)));
typedef unsigned v2u __attribute__((ext_vector_type(2)));
typedef float f32x4 __attribute__((ext_vector_type(4)));
typedef float f32x16 __attribute__((ext_vector_type(16)));
typedef short bf16x8 __attribute__((ext_vector_type(8)));
typedef short s16x4 __attribute__((ext_vector_type(4)));
typedef float f32x2_t __attribute__((ext_vector_type(2)));
typedef GAS unsigned gu32;
#define RLX_AGENT __ATOMIC_RELAXED, __HIP_MEMORY_SCOPE_AGENT
#define LDS_WAIT() asm volatile("s_waitcnt lgkmcnt(0)" ::: "memory")
#define VM_WAIT() asm volatile("s_waitcnt vmcnt(0)" ::: "memory")
__device__ __forceinline__ unsigned f2bf(float f) { unsigned u = __builtin_bit_cast(unsigned, f); return (u + 0x7fffu + ((u >> 16) & 1u)) >> 16; }
__device__ __forceinline__ unsigned pk2(float lo, float hi) { return f2bf(lo) | (f2bf(hi) << 16); }
typedef float f32x2c_t __attribute__((ext_vector_type(2))); typedef __bf16 bf16x2c_t __attribute__((ext_vector_type(2)));
__device__ __forceinline__ unsigned cvtpk(float lo, float hi) { const f32x2c_t v = {lo, hi}; const bf16x2c_t b = __builtin_convertvector(v, bf16x2c_t); return __builtin_bit_cast(unsigned, b); }
__device__ __forceinline__ float bf_lo(unsigned u) { return __builtin_bit_cast(float, u << 16); }
__device__ __forceinline__ float bf_hi(unsigned u) { return __builtin_bit_cast(float, u & 0xffff0000u); }

__device__ __forceinline__ unsigned pk4f8(float a, float b, float c, float d) { int r = __builtin_amdgcn_cvt_pk_fp8_f32(a, b, 0, false); r = __builtin_amdgcn_cvt_pk_fp8_f32(c, d, r, true); return (unsigned)r; }

#define XB_TMO      128
#define XB_XCNT(j)  (256  + 64 * (j))
#define XB_XSUB(j)  (1280 + 64 * (j))
#define XB_XGEN(j)  (2304 + 64 * (j))
#define XB_TOP      3328
#define XB_TOPGEN   3392
#define XCD_BAR_WORDS 3456
#define XB_SPIN_CAP (1u << 18)

__device__ __forceinline__ unsigned xb_ld(unsigned* p)              { return __hip_atomic_load(p, __ATOMIC_RELAXED, __HIP_MEMORY_SCOPE_AGENT); }
__device__ __forceinline__ unsigned xb_add(unsigned* p, unsigned v) { return __hip_atomic_fetch_add(p, v, __ATOMIC_RELAXED, __HIP_MEMORY_SCOPE_AGENT); }
__device__ __forceinline__ unsigned xb_xcc_id() { return (unsigned)__builtin_amdgcn_s_getreg((3 << 11) | 20) & 0xFu; }
#define XB_SPIN(cond, bar) do { unsigned _sp = 0; while (cond) { __builtin_amdgcn_s_sleep(1); \
    if ((++_sp & 255u) == 0u) { if (xb_ld(&(bar)[XB_TMO])) break; if (_sp > XB_SPIN_CAP) { atomicAdd(&(bar)[XB_TMO], 1u); break; } } } } while (0)

struct XcdBarrier {
    unsigned* bar; unsigned x;
    volatile LAS unsigned* st;
};

__device__ __forceinline__ XcdBarrier xcd_barrier_post(unsigned* bar, volatile LAS unsigned* st) {
    XcdBarrier b; b.bar = bar; b.x = xb_xcc_id(); b.st = st;
    if (threadIdx.x == 0) (void)xb_add(&bar[XB_XCNT(b.x)], 1u);
    return b;
}
__device__ __forceinline__ void xcd_barrier_complete(unsigned* bar, unsigned x, unsigned& nloc, unsigned& nx) {
    const unsigned G = gridDim.x * gridDim.y * gridDim.z;
    unsigned sum, cnt, mine, sp = 0u;
    for (;;) {
        sum = 0u; cnt = 0u; mine = 0u;
#pragma unroll
        for (unsigned j = 0; j < 16; ++j) { const unsigned c = xb_ld(&bar[XB_XCNT(j)]); sum += c; cnt += (c > 0u) ? 1u : 0u; mine = (j == x) ? c : mine; }
        if (sum == G) break;
        __builtin_amdgcn_s_sleep(1);
        if ((++sp & 255u) == 0u) { if (xb_ld(&bar[XB_TMO])) break; if (sp > XB_SPIN_CAP) { atomicAdd(&bar[XB_TMO], 1u); break; } }
    }
    nloc = mine > 0u ? mine : 1u; nx = cnt > 0u ? cnt : 1u;
}

__device__ __forceinline__ void xcd_barrier(const XcdBarrier& b) {
    asm volatile("s_waitcnt vmcnt(0)" ::: "memory");
    __syncthreads();
    if (threadIdx.x == 0) {
        unsigned* bar = b.bar;
        __builtin_amdgcn_s_waitcnt(0);
        unsigned nloc = b.st[0], nx = b.st[1];
        if (nloc == 0u) { xcd_barrier_complete(bar, b.x, nloc, nx); b.st[0] = nloc; b.st[1] = nx; }
        const unsigned old = xb_add(&bar[XB_XSUB(b.x)], 1u);
        const unsigned gen = old / nloc;
        if (old + 1u == (gen + 1u) * nloc) {
            __builtin_amdgcn_fence(__ATOMIC_RELEASE, "agent");
            asm volatile("s_waitcnt vmcnt(0)" ::: "memory");
            const unsigned og = xb_add(&bar[XB_TOP], 1u);
            const unsigned tg = og / nx;
            if (og + 1u == (tg + 1u) * nx) xb_add(&bar[XB_TOPGEN], 1u);
            else XB_SPIN(xb_ld(&bar[XB_TOPGEN]) == tg, bar);
            __builtin_amdgcn_fence(__ATOMIC_ACQUIRE, "agent");
            xb_add(&bar[XB_XGEN(b.x)], 1u);
            asm volatile("s_waitcnt vmcnt(0)" ::: "memory");
        } else {
            XB_SPIN(xb_ld(&bar[XB_XGEN(b.x)]) == gen, bar);
            __builtin_amdgcn_fence(__ATOMIC_ACQUIRE, "agent");
            asm volatile("s_waitcnt vmcnt(0)" ::: "memory");
        }
    }
    __syncthreads();
}


struct Args {
    const float* x; const float* attn_norm_g; const float* w_in_a; const float* w_in_b; const float* q_norm_g; const float* k_norm_g; const float* t5_bias;
    const float* rel_bias_b; const float* w_out; const float* ffn_norm_g; const float* w_up; const float* conv_w; const float* conv_b; const float* w_down;
    float* out; unsigned char* ws; int ph_lo, ph_hi, li, f8m;
};

struct Frame {
    LAS unsigned char* lds;
    volatile LAS unsigned* MISC;
    gu32* ctl;
    int tid, lane, wave, vcu, G;
};

__host__ __device__ __forceinline__ int hmap(int p) { return 64 * ((p >> 5) & 3) + 16 * ((p >> 2) & 3) + 8 * (p >> 7) + 4 * ((p >> 4) & 1) + (p & 3); }
__host__ __device__ __forceinline__ int umap(int p) { return 32 * ((p >> 5) & 3) + 8 * ((p >> 2) & 3) + 4 * ((p >> 4) & 1) + (p & 3); }
__host__ __device__ __forceinline__ int src_col(int type, int n) {
    if (type == 0) return n;
    const int pn = n >> 8, p = n & 255;
    if (type == 2) return 256 * pn + hmap(p);
    if (type == 1) { const int c = hmap(p); return pn < 8 ? 256 * pn + c : (c < 72 ? 2048 + c : -1); }
    return (p >> 7) * FF + 128 * pn + umap(p);
}
__device__ __forceinline__ void convert_item(const float* W, int K, int Nsrc, int Ndst, int type, const float* gain, bf16* WT, LAS float* scr, int item, int lane, bool o8 = false) {
    const int nblk = Ndst / 32, kb = item / nblk, nb = item % nblk, k0 = 64 * kb, n0 = 32 * nb;
    const int sc = src_col(type, n0 + (lane & 31));
#pragma unroll 8
    for (int i = 0; i < 32; ++i) { const int kk = 2 * i + (lane >> 5); float v = 0.f; if (sc >= 0) v = W[(size_t)(k0 + kk) * Nsrc + sc]; if (gain) v *= gain[k0 + kk]; scr[kk * 33 + (lane & 31)] = v; }
    LDS_WAIT(); asm volatile("" ::: "memory");
    const int c = lane & 7;
#pragma unroll
    for (int j = 0; j < 4; ++j) { const int n = (lane >> 3) + 8 * j; const LAS float* s = scr + (8 * c) * 33 + n;
        if (o8) { v2u o; o.x = pk4f8(s[0 * 33] * W8S, s[1 * 33] * W8S, s[2 * 33] * W8S, s[3 * 33] * W8S); o.y = pk4f8(s[4 * 33] * W8S, s[5 * 33] * W8S, s[6 * 33] * W8S, s[7 * 33] * W8S);
            *(v2u*)((unsigned char*)WT + (size_t)(n0 + n) * K + k0 + 8 * c) = o; }
        else { v4u o; o.x = pk2(s[0 * 33], s[1 * 33]); o.y = pk2(s[2 * 33], s[3 * 33]); o.z = pk2(s[4 * 33], s[5 * 33]); o.w = pk2(s[6 * 33], s[7 * 33]);
            *(v4u*)(WT + (size_t)(n0 + n) * K + k0 + 8 * c) = o; } }
    LDS_WAIT(); asm volatile("" ::: "memory");
}
__device__ __forceinline__ float wave_sum(float v) {
#pragma unroll
    for (int o = 1; o < 64; o <<= 1) v += __shfl_xor(v, o);
    return v;
}
#ifdef F8M_RUNTIME
#define F8MV a.f8m
#else
#define F8MV F8M_ALL
#endif
__device__ __forceinline__ void p0_prologue(Frame& F, const Args& a) {
    LAS float* scr = (LAS float*)(F.lds + RING_OFF + F.wave * 16384);
    const int gw = F.vcu * NWAVES + F.wave, NGW = F.G * NWAVES;
    constexpr int I_INA = 16 * (NA_PAD / 32), I_INB = 16 * (NB / 32), I_OUT = 16 * 32, I_UP = 16 * (NUP / 32), I_DN = (FF / 64) * 32;
    constexpr int I_INA8 = 16 * (1536 / 32);
    constexpr int NITEMS = 2 * I_INA + 2 * I_INB + 4 * I_OUT + 4 * I_UP + 4 * I_DN + 2 * I_INA8;
    unsigned char* ws = a.ws;
    for (int it = gw; it < NITEMS; it += NGW) {
        int r = it;
        if (r < 2 * I_INA) { const int l = r / I_INA; convert_item(a.w_in_a + (size_t)l * DM * NA_SRC, DM, NA_SRC, NA_PAD, 1, a.attn_norm_g + (2 * l) * DM, (bf16*)(ws + WS_W_INA) + (size_t)l * NA_PAD * DM, scr, r % I_INA, F.lane); continue; } r -= 2 * I_INA;
        if (r < 2 * I_INB) { const int l = r / I_INB; convert_item(a.w_in_b + (size_t)l * DM * NB, DM, NB, NB, 2, a.attn_norm_g + (2 * l + 1) * DM, (bf16*)(ws + WS_W_INB) + (size_t)l * NB * DM, scr, r % I_INB, F.lane, f8_in(F8MV, 2 * l + 1)); continue; } r -= 2 * I_INB;
        if (r < 4 * I_OUT) { const int l = r / I_OUT; convert_item(a.w_out + (size_t)l * DM * DM, DM, DM, DM, 0, nullptr, (bf16*)(ws + WS_W_OUT) + (size_t)l * DM * DM, scr, r % I_OUT, F.lane, f8_out(F8MV, l)); continue; } r -= 4 * I_OUT;
        if (r < 4 * I_UP) { const int l = r / I_UP; convert_item(a.w_up + (size_t)l * DM * NUP, DM, NUP, NUP, 3, a.ffn_norm_g + l * DM, (bf16*)(ws + WS_W_UP) + (size_t)l * NUP * DM, scr, r % I_UP, F.lane, f8_ffn(F8MV, l)); continue; } r -= 4 * I_UP;
        if (r >= 4 * I_DN) { r -= 4 * I_DN; const int l = r / I_INA8, i8 = r % I_INA8; if (f8_in(F8MV, 2 * l)) convert_item(a.w_in_a + (size_t)l * DM * NA_SRC, DM, NA_SRC, NA_PAD, 1, a.attn_norm_g + (2 * l) * DM, (bf16*)(ws + WS_W_INA8 + (size_t)l * NA_PAD * DM), scr, (i8 / 48) * (NA_PAD / 32) + i8 % 48, F.lane, true); continue; }
        { const int l = r / I_DN; convert_item(a.w_down + (size_t)l * FF * DM, FF, DM, DM, 0, nullptr, (bf16*)(ws + WS_W_DN) + (size_t)l * DM * FF, scr, r % I_DN, F.lane, f8_ffn(F8MV, l)); }
    }
    bf16* hb = (bf16*)(ws + WS_HB); float* ss = (float*)(ws + WS_SS);
    for (int m = gw; m < MTOK; m += NGW) {
        const f32x4* xr = (const f32x4*)(a.x + (size_t)m * DM) + F.lane; f32x4 v[4]; float s = 0.f;
#pragma unroll
        for (int j = 0; j < 4; ++j) { v[j] = xr[64 * j]; s += (v[j].x * v[j].x + v[j].y * v[j].y) + (v[j].z * v[j].z + v[j].w * v[j].w); }
        s = wave_sum(s);
        v2u* o8 = (v2u*)(hb + (size_t)m * DM) + F.lane;
#pragma unroll
        for (int j = 0; j < 4; ++j) { v2u w; w.x = pk2(v[j].x, v[j].y); w.y = pk2(v[j].z, v[j].w); o8[64 * j] = w; }
        if (f8_in(F8MV, 0)) { unsigned* o4 = (unsigned*)(ws + WS_M + (size_t)m * DM) + F.lane;
#pragma unroll
            for (int j = 0; j < 4; ++j) o4[64 * j] = pk4f8(v[j].x, v[j].y, v[j].z, v[j].w); }
        if (F.lane < 16) ss[(size_t)m * 16 + F.lane] = (F.lane == 0) ? s : 0.f;
    }
}

__device__ __forceinline__ f32x4 rstd_load(const float* ss, int row, int fq) { return *(const f32x4*)(ss + (size_t)row * 16 + 4 * fq); }
__device__ __forceinline__ float rstd_finish(f32x4 a) {
    float s = (a.x + a.y) + (a.z + a.w);
    s += __shfl_xor(s, 16); s += __shfl_xor(s, 32);
    return __builtin_amdgcn_rsqf(s * (1.0f / DM) + EPS);
}
__device__ __forceinline__ float row_rstd(const float* ss, int row, int fq) { return rstd_finish(rstd_load(ss, row, fq)); }
__device__ __forceinline__ unsigned att_pk4(f32x4 v) { int r = __builtin_amdgcn_cvt_pk_fp8_f32(v.x, v.y, 0, false); r = __builtin_amdgcn_cvt_pk_fp8_f32(v.z, v.w, r, true); return (unsigned)r; }
struct EpiIn {
    static constexpr bool PERM = false, PERMA = false, AFTER_DRAIN = false;
    const float* ss; unsigned char* proj; const float* qg; const float* kg; int isB; float as; int pn0;
    __device__ __forceinline__ void operator()(const pg8::f32x4 (&acc)[2][2][4][2], const pg8::Unit& u, int wr, int wc, int fr, int fq) const {
        asm volatile("" : "+v"(fr), "+v"(fq));
        const int pn = u.pn + pn0; int kind, pitch; bf16* dst;
        if (isB) { const int t = pn >> 2; kind = (t == 0) ? 1 : (t == 1 ? 2 : 0); dst = (bf16*)(proj + (size_t)t * PB_STRIDE) + 256 * (pn & 3); pitch = DM; }
        else if (pn < 4) { kind = 1; dst = (bf16*)(proj + PA_QA) + 256 * pn; pitch = DM; }
        else if (pn == 4) { kind = 2; dst = (bf16*)(proj + PA_KA); pitch = 256; }
        else if (pn == 5) { kind = 0; dst = (bf16*)(proj + PA_VA); pitch = 256; }
        else if (pn < 8) { kind = 0; dst = (bf16*)(proj + PA_QI) + 256 * (pn - 6); pitch = 512; }
        else { kind = 3; dst = (bf16*)(proj + PA_KI); pitch = 64; }
        if (kind == 3 && wc >= 2) return;
        const bool donorm = (kind == 1) || (kind == 2) || (kind == 3 && wc == 0);
        f32x4 g[2][2];
#pragma unroll
        for (int bj = 0; bj < 2; ++bj)
#pragma unroll
            for (int n = 0; n < 2; ++n) {
                if (kind == 1) g[bj][n] = *(const f32x4*)(qg + 16 * fq + 8 * bj + 4 * n) * (isB ? C2 : 1.0f);
                else if (kind == 2) g[bj][n] = *(const f32x4*)(kg + 16 * fq + 8 * bj + 4 * n);
                else g[bj][n] = (f32x4){1.f, 1.f, 1.f, 1.f};
            }
        float* wi = (float*)(proj + PA_WI);
        f32x4 rsl[2][4];
#pragma unroll
        for (int ai = 0; ai < 2; ++ai)
#pragma unroll
            for (int m = 0; m < 4; ++m) rsl[ai][m] = rstd_load(ss, u.pm * 256 + ai * 128 + wr * 64 + m * 16 + fr, fq);
#pragma unroll
        for (int ai = 0; ai < 2; ++ai)
#pragma unroll
            for (int m = 0; m < 4; ++m) {
                const int row = u.pm * 256 + ai * 128 + wr * 64 + m * 16 + fr;
                const float rs = rstd_finish(rsl[ai][m]) * as;
                f32x4 v[2][2]; float s = 0.f;
#pragma unroll
                for (int bj = 0; bj < 2; ++bj)
#pragma unroll
                    for (int n = 0; n < 2; ++n) { v[bj][n] = acc[ai][bj][m][n] * rs; const f32x4 q = v[bj][n] * v[bj][n]; s += (q.x + q.y) + (q.z + q.w); }
                if (donorm) {
                    s += __shfl_xor(s, 16); s += __shfl_xor(s, 32);
                    const float r = 1.0f / sqrtf(s * (1.0f / 64.0f) + EPS);
#pragma unroll
                    for (int bj = 0; bj < 2; ++bj)
#pragma unroll
                        for (int n = 0; n < 2; ++n) v[bj][n] = v[bj][n] * r * g[bj][n];
                }
                if (kind == 3 && wc == 1) {
                    if (fq == 0) { float* wp = wi + (size_t)row * 8; const float sc = 0.04419417382415922f;
                        *(f32x4*)(wp) = v[0][0] * sc; *(f32x4*)(wp + 4) = v[0][1] * sc; }
                } else if (!isB && pn < 6) {
                    unsigned char* p8 = (pn < 4) ? proj + PA_QA + (size_t)row * 1024 + 256 * pn + 64 * wc + 16 * fq : proj + PA_KA + (size_t)row * 512 + 128 * wc + 64 * (pn - 4) + 16 * fq;
                    v4u w; w.x = att_pk4(v[0][0]); w.y = att_pk4(v[0][1]); w.z = att_pk4(v[1][0]); w.w = att_pk4(v[1][1]);
                    *(v4u*)p8 = w;
                } else {
                    bf16* rp = dst + (size_t)row * pitch + 64 * wc + 16 * fq;
#pragma unroll
                    for (int bj = 0; bj < 2; ++bj) { v4u w; w.x = cvtpk(v[bj][0].x, v[bj][0].y); w.y = cvtpk(v[bj][0].z, v[bj][0].w); w.z = cvtpk(v[bj][1].x, v[bj][1].y); w.w = cvtpk(v[bj][1].z, v[bj][1].w);
                        *(v4u*)(rp + 8 * bj) = w; }
                }
            }
    }
};
template <int MODE>
struct EpiResT {
    static constexpr bool PERM = false, PERMA = false, AFTER_DRAIN = false;
    float* fout; const bf16* hbi; bf16* hb; float* ss; unsigned char* hb8; const float* xin;
    __device__ __forceinline__ void operator()(const pg8::f32x4 (&acc)[2][2][4][2], const pg8::Unit& u, int wr, int wc, int fr, int fq) const {
        if (fout) body<true, false, false>(acc, u, wr, wc, fr, fq); else if (hb8) body<false, true, false>(acc, u, wr, wc, fr, fq); else if (xin) body<false, false, true>(acc, u, wr, wc, fr, fq); else body<false, false, false>(acc, u, wr, wc, fr, fq);
    }
    template <bool FOUT, bool HB8, bool XIN>
    __device__ __forceinline__ void body(const pg8::f32x4 (&acc)[2][2][4][2], const pg8::Unit& u, int wr, int wc, int fr, int fq) const {
        asm volatile("" : "+v"(fr), "+v"(fq));
        const int col0 = u.pn * 256 + wc * 32 + 4 * fq;
#pragma unroll
        for (int ai = 0; ai < 2; ++ai) {
            v2u base[4][2][2]; f32x4 basex[XIN ? 4 : 1][2][2];
#pragma unroll
            for (int m = 0; m < 4; ++m)
#pragma unroll
                for (int bj = 0; bj < 2; ++bj)
#pragma unroll
                    for (int n = 0; n < 2; ++n) { const size_t o4 = (size_t)(u.pm * 256 + ai * 128 + wr * 64 + m * 16 + fr) * DM + col0 + bj * 128 + n * 16; if constexpr (XIN) basex[m][bj][n] = *(const f32x4*)(xin + o4); else base[m][bj][n] = *(const v2u*)(hbi + o4);
                        if ((MODE & 4) && n == 1) asm volatile("s_waitcnt vmcnt(0)" ::: "memory"); }
            asm volatile("" ::: "memory");
#pragma unroll
            for (int m = 0; m < 4; ++m) {
                const int row = u.pm * 256 + ai * 128 + wr * 64 + m * 16 + fr; const size_t off = (size_t)row * DM + col0; float s = 0.f;
#pragma unroll
                for (int bj = 0; bj < 2; ++bj)
#pragma unroll
                    for (int n = 0; n < 2; ++n) { const size_t o4 = off + bj * 128 + n * 16;
                        f32x4 bs; if constexpr (XIN) bs = basex[m][bj][n]; else { const v2u b = base[m][bj][n]; bs = (f32x4){bf_lo(b.x), bf_hi(b.x), bf_lo(b.y), bf_hi(b.y)}; }
                        const f32x4 o = (MODE & 1) ? bs + acc[ai][bj][m][n] * W8I : bs + acc[ai][bj][m][n];
                        if constexpr (FOUT) *(f32x4*)(fout + o4) = o;
                        else { const f32x4 q = o * o; s += (q.x + q.y) + (q.z + q.w); v2u w; w.x = cvtpk(o.x, o.y); w.y = cvtpk(o.z, o.w); *(v2u*)(hb + o4) = w;
                            if constexpr (HB8) *(unsigned*)(hb8 + o4) = pk4f8(o.x, o.y, o.z, o.w); } }
                if constexpr (!FOUT) { s += __shfl_xor(s, 16); s += __shfl_xor(s, 32); if (fq == 0) ss[(size_t)row * 16 + u.pn * 4 + wc] = s; }
            }
        }
    }
};
typedef EpiResT<0> EpiRes;
#ifndef SER_OUT
#define SER_OUT 0
#endif
#ifdef X_NOBPERM
__device__ __forceinline__ float lane_from(int byteaddr, float v) { return v + (float)byteaddr; }
#else
__device__ __forceinline__ float lane_from(int byteaddr, float v) { return __builtin_bit_cast(float, __builtin_amdgcn_ds_bpermute(byteaddr, __builtin_bit_cast(int, v))); }
#endif
#ifdef X_NOSILU
__device__ __forceinline__ float silu_mul(float a, float g) { return a * g; }
#else
__device__ __forceinline__ float silu_mul(float a, float g) { return a * g * __builtin_amdgcn_rcpf(1.0f + __builtin_amdgcn_exp2f(-g * LOG2E)); }
#endif
__device__ __forceinline__ float dpp_prev_lane(float v) { return __builtin_bit_cast(float, __builtin_amdgcn_update_dpp(0, __builtin_bit_cast(int, v), 0x111  , 0xf, 0xf, true)); }
template <bool F8>
struct EpiUpT {
    static constexpr bool PERM = false, PERMA = true, AFTER_DRAIN = false;
    const float* ss; const float* cw; const float* cb; bf16* act; float* halo; LAS float* cl;
    __device__ __forceinline__ void operator()(const pg8::f32x4 (&acc)[2][2][4][2], const pg8::Unit& u, int wr, int wc, int fr, int fq) const {
        asm volatile("" : "+v"(fr), "+v"(fq));
        const int colb = u.pn * 128 + wc * 32 + 8 * fq;
        const int tid_ = ((wr * 4 + wc) * 4 + fq) * 16 + fr, ce = 2 * tid_, cbj = ce >> 9, carr = (ce >> 7) & 3, cc = ce & 127;
        const f32x2_t cpre = *(const f32x2_t*)((carr < 3 ? cw + carr * NUP : cb) + cbj * FF + u.pn * 128 + cc);
        f32x4 rsl[2][4];
#pragma unroll
        for (int ai = 0; ai < 2; ++ai)
#pragma unroll
            for (int m = 0; m < 4; ++m) rsl[ai][m] = rstd_load(ss, (u.pm * 4 + ai * 2 + wr) * 64 + 4 * fr + m, fq);
        unsigned pk[2][2][4][2][2];
#pragma unroll
        for (int ai = 0; ai < 2; ++ai) {
#pragma unroll
            for (int m = 0; m < 4; ++m) {
                const float rs = F8 ? rstd_finish(rsl[ai][m]) * W8I : rstd_finish(rsl[ai][m]);
#pragma unroll
                for (int bj = 0; bj < 2; ++bj)
#pragma unroll
                    for (int n = 0; n < 2; ++n) { const f32x4 v = acc[ai][bj][m][n] * rs; pk[ai][bj][m][n][0] = cvtpk(v.x, v.y); pk[ai][bj][m][n][1] = cvtpk(v.z, v.w); }
            }
        }
        *(LAS f32x2_t*)(cl + ce) = cpre;
        asm volatile("s_waitcnt lgkmcnt(0)" ::: "memory"); __builtin_amdgcn_s_barrier(); asm volatile("" ::: "memory");
        __builtin_amdgcn_sched_barrier(0);
        if (fr == 0 || fr == 15) {
#pragma unroll
            for (int ai = 0; ai < 2; ++ai)
#pragma unroll
                for (int j = 0; j < 2; ++j)
#pragma unroll
                    for (int bj = 0; bj < 2; ++bj)
#pragma unroll
                        for (int n = 0; n < 2; ++n) { const unsigned w0 = (fr == 0) ? pk[ai][bj][j][n][0] : pk[ai][bj][2 + j][n][0], w1 = (fr == 0) ? pk[ai][bj][j][n][1] : pk[ai][bj][2 + j][n][1];
                            *(f32x4*)(halo + ((size_t)(u.pm * 4 + ai * 2 + wr) * 4 + (fr == 0 ? j : 2 + j)) * NUP + bj * FF + colb + 4 * n) = (f32x4){bf_lo(w0), bf_hi(w0), bf_lo(w1), bf_hi(w1)}; }
        }
        __builtin_amdgcn_sched_barrier(0);
#pragma unroll
        for (int ai = 0; ai < 2; ++ai) {
            const int row0 = (u.pm * 4 + ai * 2 + wr) * 64 + 4 * fr;
            unsigned outp[4][2][2];
#pragma unroll
            for (int n = 0; n < 2; ++n) {
#pragma unroll
                for (int ip = 0; ip < 2; ++ip) {
                    f32x2_t k0[2], k1[2], k2[2], kb[2];
#pragma unroll
                    for (int bj = 0; bj < 2; ++bj) { const LAS float* c = cl + bj * 512 + wc * 32 + 8 * fq + 4 * n + 2 * ip; k0[bj] = *(const LAS f32x2_t*)(c); k1[bj] = *(const LAS f32x2_t*)(c + 128); k2[bj] = *(const LAS f32x2_t*)(c + 256); kb[bj] = *(const LAS f32x2_t*)(c + 384); }
                    float y[2][4][2];
#pragma unroll
                    for (int bj = 0; bj < 2; ++bj) {
                        const unsigned w0 = pk[ai][bj][0][n][ip], w1 = pk[ai][bj][1][n][ip], w2 = pk[ai][bj][2][n][ip], w3 = pk[ai][bj][3][n][ip];
                        const unsigned q1 = (unsigned)__builtin_amdgcn_update_dpp(0, (int)w3, 0x111, 0xf, 0xf, true), q2 = (unsigned)__builtin_amdgcn_update_dpp(0, (int)w2, 0x111, 0xf, 0xf, true);
#pragma unroll
                        for (int e = 0; e < 2; ++e) { const int i = e;
                            const float u0 = e ? bf_hi(w0) : bf_lo(w0), u1 = e ? bf_hi(w1) : bf_lo(w1), u2 = e ? bf_hi(w2) : bf_lo(w2), u3 = e ? bf_hi(w3) : bf_lo(w3), p1 = e ? bf_hi(q1) : bf_lo(q1), p2 = e ? bf_hi(q2) : bf_lo(q2);
                            y[bj][0][e] = kb[bj][i] + k0[bj][i] * p2 + k1[bj][i] * p1 + k2[bj][i] * u0;
                            y[bj][1][e] = kb[bj][i] + k0[bj][i] * p1 + k1[bj][i] * u0 + k2[bj][i] * u1;
                            y[bj][2][e] = kb[bj][i] + k0[bj][i] * u0 + k1[bj][i] * u1 + k2[bj][i] * u2;
                            y[bj][3][e] = kb[bj][i] + k0[bj][i] * u1 + k1[bj][i] * u2 + k2[bj][i] * u3; }
                    }
#pragma unroll
                    for (int m = 0; m < 4; ++m) {
                        if constexpr (F8) { if (ip == 0) outp[m][n][0] = (unsigned)__builtin_amdgcn_cvt_pk_fp8_f32(silu_mul(y[0][m][0], y[1][m][0]), silu_mul(y[0][m][1], y[1][m][1]), 0, false);
                            else outp[m][n][0] = (unsigned)__builtin_amdgcn_cvt_pk_fp8_f32(silu_mul(y[0][m][0], y[1][m][0]), silu_mul(y[0][m][1], y[1][m][1]), (int)outp[m][n][0], true); }
                        else outp[m][n][ip] = cvtpk(silu_mul(y[0][m][0], y[1][m][0]), silu_mul(y[0][m][1], y[1][m][1])); }
                }
            }
#pragma unroll
            for (int m = 0; m < 4; ++m) {
                if (m < 2 && fr == 0) continue;
                if constexpr (F8) { v2u w; w.x = outp[m][0][0]; w.y = outp[m][1][0]; *(v2u*)((unsigned char*)act + (size_t)(row0 + m) * FF + colb) = w; }
                else { v4u w; w.x = outp[m][0][0]; w.y = outp[m][0][1]; w.z = outp[m][1][0]; w.w = outp[m][1][1];
                    *(v4u*)(act + (size_t)(row0 + m) * FF + colb) = w; }
            }
            asm volatile("" ::: "memory");
        }
    }
};
typedef EpiUpT<false> EpiUp;
struct EpiDummy {
    static constexpr bool PERM = false, PERMA = true, AFTER_DRAIN = false;
    float* scratch;
    __device__ __forceinline__ void operator()(const pg8::f32x4 (&acc)[2][2][4][2], const pg8::Unit& u, int wr, int wc, int fr, int fq) const {
        f32x4 s = (f32x4){0.f, 0.f, 0.f, 0.f};
#pragma unroll
        for (int ai = 0; ai < 2; ++ai)
#pragma unroll
            for (int bj = 0; bj < 2; ++bj)
#pragma unroll
                for (int m = 0; m < 4; ++m)
#pragma unroll
                    for (int n = 0; n < 2; ++n) s += acc[ai][bj][m][n];
        scratch[(size_t)(u.pm * 22 + u.pn) * 512 + ((wr * 4 + wc) * 4 + fq) * 16 + fr] = (s.x + s.y) + (s.z + s.w);
    }
};
template <bool F8>
__device__ __forceinline__ void fixup_phase(Frame& F, const float* cw, const float* cb, const float* halo, bf16* act) {
    const int gt = F.vcu * (NWAVES * 64) + F.tid, NT = F.G * NWAVES * 64;
    constexpr int C4 = FF / 4;
    for (int it = gt; it < NBLK64 * 2 * C4; it += NT) {
        const int c = (it % C4) * 4, rj = it / C4, j = rj & 1, blk = rj >> 1, t = blk * 64 + j, tb = t % SEQ;
        f32x4 y[2];
#pragma unroll
        for (int bj = 0; bj < 2; ++bj) {
            const int cc = bj * FF + c;
            const f32x4 z = (f32x4){0.f, 0.f, 0.f, 0.f};
            const f32x4 ut = *(const f32x4*)(halo + ((size_t)blk * 4 + j) * NUP + cc);
            f32x4 u1, u2;
            if (j == 1) { u1 = *(const f32x4*)(halo + ((size_t)blk * 4 + 0) * NUP + cc); u2 = (tb == 1) ? z : *(const f32x4*)(halo + ((size_t)(blk - 1) * 4 + 3) * NUP + cc); }
            else { u1 = (tb == 0) ? z : *(const f32x4*)(halo + ((size_t)(blk - 1) * 4 + 3) * NUP + cc); u2 = (tb == 0) ? z : *(const f32x4*)(halo + ((size_t)(blk - 1) * 4 + 2) * NUP + cc); }
            y[bj] = *(const f32x4*)(cb + cc) + *(const f32x4*)(cw + cc) * u2 + *(const f32x4*)(cw + NUP + cc) * u1 + *(const f32x4*)(cw + 2 * NUP + cc) * ut;
        }
        if constexpr (F8) *(unsigned*)((unsigned char*)act + (size_t)t * FF + c) = pk4f8(silu_mul(y[0].x, y[1].x), silu_mul(y[0].y, y[1].y), silu_mul(y[0].z, y[1].z), silu_mul(y[0].w, y[1].w));
        else { v2u w; w.x = cvtpk(silu_mul(y[0].x, y[1].x), silu_mul(y[0].y, y[1].y)); w.y = cvtpk(silu_mul(y[0].z, y[1].z), silu_mul(y[0].w, y[1].w));
            *(v2u*)(act + (size_t)t * FF + c) = w; }
    }
}

__device__ __forceinline__ int crow(int r, int hi) { return (r & 3) + 8 * (r >> 2) + 4 * hi; }
__device__ __forceinline__ void glds16(const void* gsrc, unsigned lds_dst) { unsigned keep;
    asm volatile("s_mov_b32 %0, m0\n\ts_mov_b32 m0, %2\n\ts_nop 0\n\tglobal_load_lds_dwordx4 %1, off\n\ts_mov_b32 m0, %0" : "=&s"(keep) : "v"(gsrc), "s"(lds_dst) : "memory"); }
__device__ __forceinline__ float max3f(float a, float b, float c) { return fmaxf(fmaxf(a, b), c); }

namespace band {
constexpr int SLOTB = 8192;
constexpr int LDS_K = 0, LDS_V = 2 * SLOTB, LDS_WS = 4 * SLOTB, LDS_TB = LDS_WS + NWAVES * 64 * 4, LDS_OST = LDS_TB + 640 * 4 + 512, LDS_END = LDS_OST + NWAVES * 4096;
static_assert(LDS_END <= RING_BYTES, "band LDS");
__device__ __forceinline__ void unit(Frame& F, int b, int h, int U, const bf16* Q, const bf16* K, const bf16* V, bf16* O, const float* rel, const bool o8) {
    const int tid = F.tid, lane = F.lane, r32 = lane & 31, hi = lane >> 5, wid = F.wave;
    LAS unsigned char* shm = F.lds + RING_OFF;
    const unsigned lds0 = (unsigned)(uintptr_t)shm;
    const long rowbase = (long)b * SEQ; const int q0 = U * 256, c0 = 4 * U, cq = c0 + (wid >> 1);
    const bf16* Qw = Q + (rowbase + q0 + wid * 32) * DM + h * 64;
    const bf16* Kh = K + rowbase * DM + h * 64; const bf16* Vh = V + rowbase * DM + h * 64;
    LAS float* wsf = (LAS float*)(shm + LDS_WS) + wid * 64;
    LAS float* tb = (LAS float*)(shm + LDS_TB);
    const bf16* ksrc = Kh + (long)lane * DM + wid * 8;
    const bf16* vsrc = Vh + (long)(16 * (wid & 3) + (lane >> 2)) * DM + (wid >> 2) * 32 + (lane & 3) * 8;
    const unsigned kdst = lds0 + LDS_K + wid * 1024, vdst = lds0 + LDS_V + wid * 1024;
    const int lo = (c0 - 8 > 0) ? c0 - 8 : 0, hiT = c0 + 3, NT = hiT - lo + 1, t0 = (c0 - 5 > 0) ? c0 - 5 : 0;
#define BAND_KT(i) ((t0 + (i) <= hiT) ? t0 + (i) : lo + (t0 + (i) - hiT - 1))
    for (int i = tid; i < 640; i += NWAVES * 64) { int d = i - 64; d = d < -256 ? -256 : (d > 256 ? 256 : d); tb[i] = rel[(d + 256) * 16 + h] * LOG2E; }
    { const int kt = BAND_KT(0); glds16(ksrc + (long)kt * 64 * DM, (unsigned)__builtin_amdgcn_readfirstlane(kdst)); glds16(vsrc + (long)kt * 64 * DM, (unsigned)__builtin_amdgcn_readfirstlane(vdst)); }
    bf16x8 qr[4];
#pragma unroll
    for (int d0 = 0; d0 < 4; ++d0) qr[d0] = *(const bf16x8*)(Qw + (long)r32 * DM + d0 * 16 + hi * 8);
    float m_run = -INFINITY, l_run = 0.f; f32x16 o[2]; o[0] = f32x16{}; o[1] = f32x16{};
    const int qpos = q0 + wid * 32 + r32;
    const LAS unsigned char* vbase = shm + LDS_V + ((lane >> 4) & 1) * 32 + (lane & 3) * 8 + (4 * hi + ((lane & 15) >> 2)) * 64;
    for (int i = 0; i < NT; ++i) { LA_B;
        asm volatile("s_waitcnt vmcnt(0) lgkmcnt(0)\n\ts_barrier" ::: "memory");
        if (i + 1 < NT) { const int kt = BAND_KT(i + 1); const unsigned so = ((i + 1) & 1) * SLOTB;
            glds16(ksrc + (long)kt * 64 * DM, (unsigned)__builtin_amdgcn_readfirstlane(kdst + so)); glds16(vsrc + (long)kt * 64 * DM, (unsigned)__builtin_amdgcn_readfirstlane(vdst + so)); }
        const int kt = BAND_KT(i);
        if (kt < cq - 8 || kt > cq) continue;
        const int so = (i & 1) * SLOTB;
        f32x16 p0 = f32x16{}, p1 = f32x16{};
        { const LAS unsigned char* kb = shm + LDS_K + so + hi * 1024 + r32 * 16;
#pragma unroll
          for (int d0 = 0; d0 < 4; ++d0) { const bf16x8 b0 = *(const LAS bf16x8*)(kb + d0 * 2048), b1 = *(const LAS bf16x8*)(kb + d0 * 2048 + 512);
              p0 = __builtin_amdgcn_mfma_f32_32x32x16_bf16(b0, qr[d0], p0, 0, 0, 0); p1 = __builtin_amdgcn_mfma_f32_32x32x16_bf16(b1, qr[d0], p1, 0, 0, 0); } }
        if (kt + 5 <= cq) { const float cbias = tb[639];
#pragma unroll
          for (int r = 0; r < 16; ++r) { p0[r] += cbias; p1[r] += cbias; } }
        else { const int ib = qpos - 64 * kt + 64 - 4 * hi;
#pragma unroll
          for (int r = 0; r < 16; ++r) { const int ix = ib - ((r & 3) + 8 * (r >> 2)); p0[r] += tb[ix]; p1[r] += tb[ix - 32]; } }
        float rm = p0[0];
#pragma unroll
        for (int r = 0; r < 16; ++r) rm = max3f(rm, p0[r], p1[r]);
        { auto rr = __builtin_amdgcn_permlane32_swap(__float_as_uint(rm), __float_as_uint(rm), false, false); rm = fmaxf(__uint_as_float(rr[0]), __uint_as_float(rr[1])); }
        const float mnew = fmaxf(m_run, rm), f = __builtin_amdgcn_exp2f(m_run - mnew); m_run = mnew;
        float sacc = 0.f;
#pragma unroll
        for (int r = 0; r < 16; ++r) { p0[r] = __builtin_amdgcn_exp2f(p0[r] - mnew); p1[r] = __builtin_amdgcn_exp2f(p1[r] - mnew); sacc += p0[r] + p1[r]; }
        l_run = l_run * f + sacc;
        if (!__all(f == 1.0f)) {
            if (hi == 0) wsf[r32] = f;
            LDS_WAIT();
#pragma unroll
            for (int r = 0; r < 16; ++r) { const float fr_ = wsf[crow(r, hi)]; o[0][r] *= fr_; o[1][r] *= fr_; }
        }
        v4u pw[4];
        pw[0] = (v4u){cvtpk(p0[0], p0[1]), cvtpk(p0[2], p0[3]), cvtpk(p0[4], p0[5]), cvtpk(p0[6], p0[7])};
        pw[1] = (v4u){cvtpk(p0[8], p0[9]), cvtpk(p0[10], p0[11]), cvtpk(p0[12], p0[13]), cvtpk(p0[14], p0[15])};
        pw[2] = (v4u){cvtpk(p1[0], p1[1]), cvtpk(p1[2], p1[3]), cvtpk(p1[4], p1[5]), cvtpk(p1[6], p1[7])};
        pw[3] = (v4u){cvtpk(p1[8], p1[9]), cvtpk(p1[10], p1[11]), cvtpk(p1[12], p1[13]), cvtpk(p1[14], p1[15])};
        const LAS unsigned char* vb = vbase + so;
#pragma unroll
        for (int d0 = 0; d0 < 2; ++d0)
#pragma unroll
            for (int ks = 0; ks < 4; ++ks) {
                const s16x4 vlo = __builtin_bit_cast(s16x4, __builtin_amdgcn_ds_read_tr16_b64_v4i16((LAS s16x4*)(vb + d0 * 4096 + ks * 1024)));
                const s16x4 vhi = __builtin_bit_cast(s16x4, __builtin_amdgcn_ds_read_tr16_b64_v4i16((LAS s16x4*)(vb + d0 * 4096 + ks * 1024 + 512)));
                const bf16x8 vf = (bf16x8){vlo[0], vlo[1], vlo[2], vlo[3], vhi[0], vhi[1], vhi[2], vhi[3]};
                o[d0] = __builtin_amdgcn_mfma_f32_32x32x16_bf16(__builtin_bit_cast(bf16x8, pw[ks]), vf, o[d0], 0, 0, 0);
            }
    }
#undef BAND_KT
    { auto rr = __builtin_amdgcn_permlane32_swap(__float_as_uint(l_run), __float_as_uint(l_run), false, false); l_run = __uint_as_float(rr[0]) + __uint_as_float(rr[1]); }
    if (hi == 0) wsf[32 + r32] = l_run;
    LDS_WAIT();
    float rli[16];
#pragma unroll
    for (int r = 0; r < 16; ++r) rli[r] = __builtin_amdgcn_rcpf(wsf[32 + crow(r, hi)]);
    bf16* Ow = O + (rowbase + q0 + wid * 32) * DM + h * 64;
    { LAS bf16* stg = (LAS bf16*)(shm + LDS_OST) + wid * 2048;
#pragma unroll
      for (int r = 0; r < 16; ++r) { const int orow = crow(r, hi);
#pragma unroll
          for (int d0 = 0; d0 < 2; ++d0) stg[orow * 64 + d0 * 32 + r32] = (bf16)f2bf(o[d0][r] * rli[r]); }
      LDS_WAIT();
#pragma unroll
      for (int i = 0; i < 4; ++i) { const int row = i * 8 + (lane >> 3), ch = lane & 7; const v4u v = *(const LAS v4u*)(stg + row * 64 + ch * 8);
          if (o8) { v2u w; w.x = pk4f8(bf_lo(v.x), bf_hi(v.x), bf_lo(v.y), bf_hi(v.y)); w.y = pk4f8(bf_lo(v.z), bf_hi(v.z), bf_lo(v.w), bf_hi(v.w));
              *(v2u*)((unsigned char*)O + (rowbase + q0 + wid * 32 + row) * DM + h * 64 + ch * 8) = w; }
          else *(v4u*)(Ow + (long)row * DM + ch * 8) = v; } }
    asm volatile("s_waitcnt lgkmcnt(0)\n\ts_barrier" ::: "memory");
}
__device__ __forceinline__ void phase(Frame& F, const bf16* Q, const bf16* K, const bf16* V, bf16* O, const float* rel, const bool o8) {
    const int NU = BATCH * 16 * 32, per = (NU + F.G - 1) / F.G;
    for (int i = 0; i < per; ++i) { const int uid = F.vcu * per + i; if (uid >= NU) break; unit(F, uid >> 9, (uid >> 5) & 15, uid & 31, Q, K, V, O, rel, o8); }
}
}

namespace dsa {
__device__ __forceinline__ unsigned okey(float s) { const unsigned u = __float_as_uint(s + 0.0f); return (u & 0x80000000u) ? ~u : (u | 0x80000000u); }
struct Ctx { const bf16* QA; const bf16* KA; const bf16* VA; const bf16* QI; const bf16* KI; const float* WI; bf16* M; const LAS float* t5l; unsigned short* SEL; };

__device__ __forceinline__ void scan_hist(const LAS unsigned* hq, int lane, unsigned need, unsigned& bin, unsigned& above) {
    const LAS v4u* hp = (const LAS v4u*)hq + lane * 4;
    unsigned wds[16];
#pragma unroll
    for (int j = 0; j < 4; ++j) { const v4u t = hp[j]; wds[4 * j] = t.x; wds[4 * j + 1] = t.y; wds[4 * j + 2] = t.z; wds[4 * j + 3] = t.w; }
    unsigned tl = 0;
#pragma unroll
    for (int j = 0; j < 16; ++j) tl += (wds[j] & 0xffffu) + (wds[j] >> 16);
    unsigned suf = tl;
#pragma unroll
    for (int o = 1; o < 64; o <<= 1) { const unsigned v = __shfl_down(suf, o); if (lane + o < 64) suf += v; }
    const unsigned S = suf - tl;
    const bool cross = (S < need) && (need <= S + tl);
    unsigned c = S, bsel = 0, ab = 0; bool found = false;
#pragma unroll
    for (int k = 31; k >= 0; --k) { const unsigned cnt = (wds[k >> 1] >> (16 * (k & 1))) & 0xffffu; if (!found && c + cnt >= need) { bsel = 32 * lane + k; ab = c; found = true; } c += cnt; }
    const unsigned long long bal = __ballot(cross);
    const int src = bal ? __builtin_ctzll(bal) : 0;
    bin = __shfl(bsel, src); above = __shfl(ab, src);
}

__device__ __forceinline__ void attend(const Ctx& C, const LAS unsigned short* sq, int nvalid, long rowbase, long token, int tpos, int lane, int g0) {
    asm volatile("" : "+v"(lane));
    const int l15 = lane & 15, l4 = lane >> 4;
    int sidx[16];
#pragma unroll
    for (int ti = 0; ti < 16; ++ti) sidx[ti] = sq[ti * 16 + l15];
    unsigned bpk[4] = {0u, 0u, 0u, 0u};
#pragma unroll
    for (int ti = 0; ti < 16; ++ti) { const int rel = sidx[ti] - tpos, n = rel < 0 ? -rel : rel;
        const int bk = (rel > 0 ? 16 : 0) + (n < 8 ? n : 8 + (n >= 12) + (n >= 16) + (n >= 23) + (n >= 32) + (n >= 46) + (n >= 64) + (n >= 91));
        bpk[ti >> 2] |= (unsigned)bk << (8 * (ti & 3)); }
#pragma unroll 1
    for (int g = g0; g < g0 + 2; ++g) {
        const bf16* qp = C.QA + token * DM + (4 * g + (lane & 3)) * 64 + 8 * l4;
        const bf16x8 qf0 = *(const bf16x8*)qp, qf1 = *(const bf16x8*)(qp + 32);
        const bf16* kbase = C.KA + rowbase * 256 + g * 64 + 8 * l4;
        f32x4 S[16];
#pragma unroll
        for (int hh = 0; hh < 4; ++hh) {
            bf16x8 kf0[4], kf1[4];
#pragma unroll
            for (int j = 0; j < 4; ++j) { const bf16* kp = kbase + (long)sidx[hh * 4 + j] * 256; kf0[j] = *(const bf16x8*)kp; kf1[j] = *(const bf16x8*)(kp + 32); }
#pragma unroll
            for (int j = 0; j < 4; ++j) { const int ti = hh * 4 + j;
                f32x4 a = *(const LAS f32x4*)(C.t5l + ((bpk[hh] >> (8 * j)) & 255u) * 16 + 4 * g);
                asm volatile("v_mfma_f32_16x16x32_bf16 %0, %1, %2, %0" : "+v"(a) : "v"(qf0), "v"(kf0[j]));
                asm volatile("v_mfma_f32_16x16x32_bf16 %0, %1, %2, %0" : "+v"(a) : "v"(qf1), "v"(kf1[j]));
                S[ti] = a; }
            asm volatile("s_nop 15\n\ts_nop 7" : "+v"(S[hh * 4]), "+v"(S[hh * 4 + 1]), "+v"(S[hh * 4 + 2]), "+v"(S[hh * 4 + 3]));
        }
#pragma unroll
        for (int ti = 0; ti < 16; ++ti) if (ti * 16 >= nvalid) S[ti] = (f32x4){-INFINITY, -INFINITY, -INFINITY, -INFINITY};
        f32x4 mx = S[0];
#pragma unroll
        for (int ti = 1; ti < 16; ++ti) { mx.x = fmaxf(mx.x, S[ti].x); mx.y = fmaxf(mx.y, S[ti].y); mx.z = fmaxf(mx.z, S[ti].z); mx.w = fmaxf(mx.w, S[ti].w); }
#pragma unroll
        for (int o = 1; o < 16; o <<= 1) { mx.x = fmaxf(mx.x, __shfl_xor(mx.x, o)); mx.y = fmaxf(mx.y, __shfl_xor(mx.y, o)); mx.z = fmaxf(mx.z, __shfl_xor(mx.z, o)); mx.w = fmaxf(mx.w, __shfl_xor(mx.w, o)); }
        f32x4 ls = (f32x4){0.f, 0.f, 0.f, 0.f};
        unsigned P01[16], P23[16];
#pragma unroll
        for (int ti = 0; ti < 16; ++ti) { const float e0 = __builtin_amdgcn_exp2f(S[ti].x - mx.x), e1 = __builtin_amdgcn_exp2f(S[ti].y - mx.y), e2 = __builtin_amdgcn_exp2f(S[ti].z - mx.z), e3 = __builtin_amdgcn_exp2f(S[ti].w - mx.w);
            ls += (f32x4){e0, e1, e2, e3}; P01[ti] = cvtpk(e0, e1); P23[ti] = cvtpk(e2, e3); }
#pragma unroll
        for (int o = 1; o < 16; o <<= 1) { ls.x += __shfl_xor(ls.x, o); ls.y += __shfl_xor(ls.y, o); ls.z += __shfl_xor(ls.z, o); ls.w += __shfl_xor(ls.w, o); }
        float o_[4][16];
#pragma unroll
        for (int h = 0; h < 4; ++h)
#pragma unroll
            for (int d = 0; d < 16; ++d) o_[h][d] = 0.f;
        const bf16* vbase = C.VA + rowbase * 256 + g * 64 + 16 * l4;
#pragma unroll
        for (int hh = 0; hh < 4; ++hh) {
            v4u va[4], vb[4];
#pragma unroll
            for (int j = 0; j < 4; ++j) { const v4u* vp = (const v4u*)(vbase + (long)sidx[hh * 4 + j] * 256); va[j] = vp[0]; vb[j] = vp[1]; }
#pragma unroll
            for (int j = 0; j < 4; ++j) { const int ti = hh * 4 + j; const v4u v0 = va[j], v1 = vb[j];
                float vf[16];
                vf[0] = bf_lo(v0.x); vf[1] = bf_hi(v0.x); vf[2] = bf_lo(v0.y); vf[3] = bf_hi(v0.y); vf[4] = bf_lo(v0.z); vf[5] = bf_hi(v0.z); vf[6] = bf_lo(v0.w); vf[7] = bf_hi(v0.w);
                vf[8] = bf_lo(v1.x); vf[9] = bf_hi(v1.x); vf[10] = bf_lo(v1.y); vf[11] = bf_hi(v1.y); vf[12] = bf_lo(v1.z); vf[13] = bf_hi(v1.z); vf[14] = bf_lo(v1.w); vf[15] = bf_hi(v1.w);
                const float p0 = bf_lo(P01[ti]), p1 = bf_hi(P01[ti]), p2 = bf_lo(P23[ti]), p3 = bf_hi(P23[ti]);
#pragma unroll
                for (int d = 0; d < 16; ++d) { o_[0][d] += p0 * vf[d]; o_[1][d] += p1 * vf[d]; o_[2][d] += p2 * vf[d]; o_[3][d] += p3 * vf[d]; } }
        }
        float res[4];
#pragma unroll
        for (int h = 0; h < 4; ++h) {
            float a8[8], a4[4], a2[2];
            const bool b3 = (l15 & 8) != 0, b2 = (l15 & 4) != 0, b1 = (l15 & 2) != 0, b0 = (l15 & 1) != 0;
#pragma unroll
            for (int d = 0; d < 8; ++d) { const float keep = b3 ? o_[h][d + 8] : o_[h][d], send = b3 ? o_[h][d] : o_[h][d + 8]; a8[d] = keep + __shfl_xor(send, 8); }
#pragma unroll
            for (int d = 0; d < 4; ++d) { const float keep = b2 ? a8[d + 4] : a8[d], send = b2 ? a8[d] : a8[d + 4]; a4[d] = keep + __shfl_xor(send, 4); }
#pragma unroll
            for (int d = 0; d < 2; ++d) { const float keep = b1 ? a4[d + 2] : a4[d], send = b1 ? a4[d] : a4[d + 2]; a2[d] = keep + __shfl_xor(send, 2); }
            { const float keep = b0 ? a2[1] : a2[0], send = b0 ? a2[0] : a2[1]; res[h] = keep + __shfl_xor(send, 1); }
        }
        bf16* mp = C.M + token * DM + (4 * g) * 64 + lane;
        mp[0] = (bf16)f2bf(res[0] * __builtin_amdgcn_rcpf(ls.x)); mp[64] = (bf16)f2bf(res[1] * __builtin_amdgcn_rcpf(ls.y)); mp[128] = (bf16)f2bf(res[2] * __builtin_amdgcn_rcpf(ls.z)); mp[192] = (bf16)f2bf(res[3] * __builtin_amdgcn_rcpf(ls.w));
    }
}

constexpr int CAND_CAP = 256;
constexpr int SELKS_OFF = KS_OFF;
__device__ __forceinline__ float relu_i(float x) { const int i = __builtin_bit_cast(int, x); return __builtin_bit_cast(float, i > 0 ? i : 0); }
struct SelState { unsigned pre[4], need[4], cnt[4], tcnt[4]; };
__device__ __forceinline__ void tile_mfma(f32x16 (&acc)[2], const LAS unsigned char* kf, const int (&koff)[4], const bf16x8 (&qa)[4]) {
#pragma unroll
    for (int h2 = 0; h2 < 2; ++h2) { acc[h2] = f32x16{};
#pragma unroll
        for (int ks = 0; ks < 4; ++ks) { const bf16x8 kb = *(const LAS bf16x8*)(kf + koff[ks] + h2 * 4096); acc[h2] = __builtin_amdgcn_mfma_f32_32x32x16_bf16(qa[ks], kb, acc[h2], 0, 0, 0); } }
}
template <class ActionT>
__device__ __forceinline__ void tile_valu(const f32x16 (&acc)[2], const f32x2_t (&wp)[2][4], int kbase, ActionT&& act) {
#pragma unroll
    for (int h2 = 0; h2 < 2; ++h2) {
        f32x2_t sa = {0.f, 0.f}, sb = {0.f, 0.f};
#pragma unroll
        for (int jp = 0; jp < 4; ++jp) {
            const f32x2_t ra = {relu_i(acc[h2][2 * jp]), relu_i(acc[h2][2 * jp + 1])};
            const f32x2_t rb = {relu_i(acc[h2][8 + 2 * jp]), relu_i(acc[h2][8 + 2 * jp + 1])};
            sa = __builtin_elementwise_fma(ra, wp[0][jp], sa); sb = __builtin_elementwise_fma(rb, wp[1][jp], sb); }
        act(kbase + h2 * 32, (sa.x + sa.y) + 0.0f, (sb.x + sb.y) + 0.0f);
    }
}
constexpr int KSLOTS = 3;
__device__ __forceinline__ void wait_tile(int newer) {
    if (newer >= 4) asm volatile("s_waitcnt vmcnt(4) lgkmcnt(0)\n\ts_barrier" ::: "memory");
    else if (newer == 3) asm volatile("s_waitcnt vmcnt(3) lgkmcnt(0)\n\ts_barrier" ::: "memory");
    else if (newer == 2) asm volatile("s_waitcnt vmcnt(2) lgkmcnt(0)\n\ts_barrier" ::: "memory");
    else if (newer == 1) asm volatile("s_waitcnt vmcnt(1) lgkmcnt(0)\n\ts_barrier" ::: "memory");
    else asm volatile("s_waitcnt vmcnt(0) lgkmcnt(0)\n\ts_barrier" ::: "memory");
}
template <class ActionT>
__device__ __forceinline__ void tile_pass(Frame& F, const bf16* ksrc, unsigned kdst, const LAS unsigned char* kfr, const int (&koff)[4], int NT, const bf16x8 (&qa)[4], const f32x2_t (&wp)[2][4], ActionT&& act) {
    asm volatile("s_waitcnt lgkmcnt(0)\n\ts_barrier" ::: "memory");
    const int npre = NT < KSLOTS ? NT : KSLOTS;
    for (int j = 0; j < npre; ++j) glds16(ksrc + (long)j * 4096, (unsigned)__builtin_amdgcn_readfirstlane(kdst + j * 8192));
    wait_tile(npre - 1);
    f32x16 accA[2], accB[2];
    tile_mfma(accA, kfr, koff, qa);
    int sl = 0;
    int kt = 0;
    for (; kt + 2 < NT; kt += 2) { LA_S;
        { const int inflight = (NT - kt - 2) < (KSLOTS - 2) ? (NT - kt - 2) : (KSLOTS - 2); wait_tile(inflight); }
        if (kt + KSLOTS < NT) glds16(ksrc + (long)(kt + KSLOTS) * 4096, (unsigned)__builtin_amdgcn_readfirstlane(kdst + sl * 8192));
        sl = (sl == KSLOTS - 1) ? 0 : sl + 1;
        tile_mfma(accB, kfr + sl * 8192, koff, qa);
        tile_valu(accA, wp, kt * 64, act);
        { const int inflight = (NT - kt - 3) < (KSLOTS - 2) ? (NT - kt - 3) : (KSLOTS - 2); wait_tile(inflight); }
        if (kt + 1 + KSLOTS < NT) glds16(ksrc + (long)(kt + 1 + KSLOTS) * 4096, (unsigned)__builtin_amdgcn_readfirstlane(kdst + sl * 8192));
        sl = (sl == KSLOTS - 1) ? 0 : sl + 1;
        tile_mfma(accA, kfr + sl * 8192, koff, qa);
        tile_valu(accB, wp, (kt + 1) * 64, act);
    }
    if (kt + 1 < NT) {
        wait_tile(0);
        sl = (sl == KSLOTS - 1) ? 0 : sl + 1;
        tile_mfma(accB, kfr + sl * 8192, koff, qa);
        tile_valu(accA, wp, kt * 64, act);
        tile_valu(accB, wp, (kt + 1) * 64, act);
    } else tile_valu(accA, wp, kt * 64, act);
    LDS_WAIT();
}
__device__ __forceinline__ void scan_hist_cnt(const LAS unsigned* hq, int lane, unsigned need, unsigned& bin, unsigned& above, unsigned& bcnt) {
    const LAS v4u* hp = (const LAS v4u*)hq + lane * 2;
    unsigned wds[8];
#pragma unroll
    for (int j = 0; j < 2; ++j) { const v4u t = hp[j]; wds[4 * j] = t.x; wds[4 * j + 1] = t.y; wds[4 * j + 2] = t.z; wds[4 * j + 3] = t.w; }
    unsigned tl = 0;
#pragma unroll
    for (int j = 0; j < 8; ++j) tl += wds[j];
    unsigned suf = tl;
#pragma unroll
    for (int o = 1; o < 64; o <<= 1) { const unsigned v = __shfl_down(suf, o); if (lane + o < 64) suf += v; }
    const unsigned S = suf - tl;
    const bool cross = (S < need) && (need <= S + tl);
    unsigned c = S, bsel = 0, ab = 0, bc = 0; bool found = false;
#pragma unroll
    for (int k = 7; k >= 0; --k) { const unsigned cnt = wds[k]; if (!found && c + cnt >= need) { bsel = 8 * lane + k; ab = c; bc = cnt; found = true; } c += cnt; }
    const unsigned long long bal = __ballot(cross);
    const int src = bal ? __builtin_ctzll(bal) : 0;
    bin = __builtin_amdgcn_readfirstlane(__shfl(bsel, src)); above = __builtin_amdgcn_readfirstlane(__shfl(ab, src)); bcnt = __builtin_amdgcn_readfirstlane(__shfl(bc, src));
}
__device__ __forceinline__ void step(Frame& F, const Ctx& C, int b, int c, int half) {
    int lane_ = F.lane; asm volatile("" : "+v"(lane_));
    const int lane = lane_, r = lane & 31, hi = lane >> 5, wave = F.wave;
    LAS unsigned* hist = (LAS unsigned*)(F.lds + RING_OFF + wave * 16384);
    LAS unsigned short* sel = (LAS unsigned short*)hist;
    LAS unsigned* cand = hist + 2048;
    LAS unsigned* fbflag = (LAS unsigned*)(F.lds + AUX_OFF + 2048);
    const long rowbase = (long)b * SEQ;
    const int tq0 = 64 * c + 32 * half + 4 * wave;
    const int N = 64 * (c + 1), NT = c + 1;
    int nvalid = 256;
    if (N <= 256) {
        nvalid = N;
        for (int j = lane; j < 4 * 256; j += 64) sel[j] = (unsigned short)(((j & 255) < N) ? (j & 255) : 0);
    } else {
        const int aq = 2 * ((r >> 2) & 1) + (r >> 4), ah = 4 * ((r >> 3) & 1) + (r & 3);
        const bf16* qip = C.QI + (rowbase + tq0 + aq) * 512 + ah * 64 + 8 * hi;
        bf16x8 qa[4];
#pragma unroll
        for (int ks = 0; ks < 4; ++ks) qa[ks] = *(const bf16x8*)(qip + 16 * ks);
        f32x2_t wp[2][4];
#pragma unroll
        for (int t = 0; t < 2; ++t) { const float* wq = C.WI + (rowbase + tq0 + 2 * hi + t) * 8; const f32x4 w0 = *(const f32x4*)wq, w1 = *(const f32x4*)(wq + 4);
            wp[t][0] = (f32x2_t){w0.x, w0.y}; wp[t][1] = (f32x2_t){w0.z, w0.w}; wp[t][2] = (f32x2_t){w1.x, w1.y}; wp[t][3] = (f32x2_t){w1.z, w1.w}; }
        float Bq;
        { float ssq = 0.f;
#pragma unroll
          for (int ks = 0; ks < 4; ++ks)
#pragma unroll
              for (int e = 0; e < 8; ++e) { const float v = bf_lo((unsigned)(unsigned short)qa[ks][e]); ssq += v * v; }
          ssq += __shfl_xor(ssq, 32);
          float term = fabsf(C.WI[(rowbase + tq0 + aq) * 8 + ah]) * sqrtf(ssq);
          term += __shfl_xor(term, 1); term += __shfl_xor(term, 2); term += __shfl_xor(term, 8);
          Bq = term * 8.25f + 1e-20f; }
        const float B0 = __shfl(Bq, (hi << 2)), B1 = __shfl(Bq, (hi << 2) | 16);
        const float sc0 = 1024.0f / B0, sc1 = 1024.0f / B1;
        asm volatile("" :: "v"(qa[0]), "v"(qa[1]), "v"(qa[2]), "v"(qa[3]));
        asm volatile("" :: "v"(wp[0][0]), "v"(wp[0][1]), "v"(wp[0][2]), "v"(wp[0][3]), "v"(wp[1][0]), "v"(wp[1][1]), "v"(wp[1][2]), "v"(wp[1][3]), "v"(sc0), "v"(sc1));
        const bf16* ksrc = C.KI + rowbase * 64 + (long)(wave * 8 + (lane >> 3)) * 64 + ((lane & 7) ^ (lane >> 3)) * 8;
        const unsigned kdst = (unsigned)(uintptr_t)(F.lds + SELKS_OFF) + wave * 1024;
        const LAS unsigned char* kfr = F.lds + SELKS_OFF + r * 128;
        int koff[4];
#pragma unroll
        for (int ks = 0; ks < 4; ++ks) koff[ks] = ((2 * ks + hi) ^ (r & 7)) * 16;
        const unsigned below = (1u << r) - 1u;
        LAS v4u* hz = (LAS v4u*)hist;
        if (wave == 0 && lane == 0) *fbflag = 0u;
#pragma unroll
        for (int j = 0; j < 8; ++j) hz[j * 64 + lane] = (v4u){0u, 0u, 0u, 0u};
        tile_pass(F, ksrc, kdst, kfr, koff, NT, qa, wp, [&](int kbase, float s0, float s1) {
            const int b0 = (int)__builtin_amdgcn_fmed3f(__builtin_fmaf(s0, sc0, 256.0f), 0.0f, 511.0f), b1 = (int)__builtin_amdgcn_fmed3f(__builtin_fmaf(s1, sc1, 256.0f), 0.0f, 511.0f);
            __hip_atomic_fetch_add(hist + (2 * hi) * 512 + b0, 1u, __ATOMIC_RELAXED, __HIP_MEMORY_SCOPE_WORKGROUP);
            __hip_atomic_fetch_add(hist + (2 * hi + 1) * 512 + b1, 1u, __ATOMIC_RELAXED, __HIP_MEMORY_SCOPE_WORKGROUP);
        });
#ifdef PROBE_SKEL
        tile_pass(F, ksrc, kdst, kfr, koff, NT, qa, wp, [&](int kbase, float s0, float s1) { });
#endif
#ifdef PROBE_SCORE
        { float dsum = 0.f; tile_pass(F, ksrc, kdst, kfr, koff, NT, qa, wp, [&](int kbase, float s0, float s1) { dsum += s0 + s1; }); if (dsum == 12345.678f) hist[0] = 1u; }
#endif
        SelState st;
        unsigned tbin[4], bcn[4]; bool ovf = false;
#pragma unroll
        for (int ql = 0; ql < 4; ++ql) { unsigned above; scan_hist_cnt(hist + ql * 512, lane, 256u, tbin[ql], above, bcn[ql]); st.cnt[ql] = 0u; st.tcnt[ql] = 0u; st.need[ql] = 256u - above; st.pre[ql] = above;
            }
        unsigned cbase[4]; { unsigned a = 0u;
#pragma unroll
            for (int ql = 0; ql < 4; ++ql) { cbase[ql] = a; a += bcn[ql]; }
            ovf = a > (unsigned)(4 * CAND_CAP); }
        LDS_WAIT();
        if (ovf && lane == 0) *fbflag = 1u;
        asm volatile("s_waitcnt lgkmcnt(0)\n\ts_barrier" ::: "memory");
#ifdef PROBE_NOFB
        const bool fb = false;
#elif defined(PROBE_NOFB2)
        const bool fb = __builtin_amdgcn_readfirstlane((int)*fbflag) == 0x7fffffff;
#else
        const bool fb = __builtin_amdgcn_readfirstlane((int)*fbflag) != 0;
#endif
        if (!fb) {
            const int tb0 = (int)(hi ? tbin[2] : tbin[0]), tb1 = (int)(hi ? tbin[3] : tbin[1]); const unsigned cb0 = hi ? cbase[2] : cbase[0], cb1 = hi ? cbase[3] : cbase[1];
            tile_pass(F, ksrc, kdst, kfr, koff, NT, qa, wp, [&](int kbase, float s0, float s1) {
#pragma unroll
                for (int t = 0; t < 2; ++t) {
                    const float s = t ? s1 : s0; const int bin = (int)__builtin_amdgcn_fmed3f(__builtin_fmaf(s, (t ? sc1 : sc0), 256.0f), 0.0f, 511.0f), tb = t ? tb1 : tb0;
                    const bool gt = bin > tb, eq = bin == tb;
                    const unsigned long long mg = __ballot(gt), me = __ballot(eq);
                    const unsigned mgh = hi ? (unsigned)(mg >> 32) : (unsigned)mg, meh = hi ? (unsigned)(me >> 32) : (unsigned)me;
                    const unsigned pos = (hi ? st.cnt[2 + t] : st.cnt[t]) + __builtin_popcount(mgh & below);
                    sel[(gt && pos < 256u) ? (2 * hi + t) * 256 + pos : 3200 + lane] = (unsigned short)(kbase + r);
                    const unsigned cpos = (hi ? st.tcnt[2 + t] : st.tcnt[t]) + __builtin_popcount(meh & below);
                    { const unsigned slot = (t ? cb1 : cb0) + cpos; LAS unsigned* cp = hist + ((eq && slot < (unsigned)(4 * CAND_CAP)) ? 2048 + slot * 2 : 1700 + 2 * lane); cp[0] = okey(s); cp[1] = (unsigned)(kbase + r); }
                    st.cnt[t] += __builtin_popcount((unsigned)mg); st.cnt[2 + t] += __builtin_popcount((unsigned)(mg >> 32));
                    st.tcnt[t] += __builtin_popcount((unsigned)me); st.tcnt[2 + t] += __builtin_popcount((unsigned)(me >> 32));
                }
            });
#pragma unroll
            for (int ql = 0; ql < 4; ++ql) {
                const unsigned nc = bcn[ql], G = st.pre[ql], rq = st.need[ql];
                const LAS unsigned* cq = cand + cbase[ql] * 2;
                unsigned base = G; const unsigned long long lt = (1ull << lane) - 1ull;
                for (unsigned c0 = 0; c0 < nc; c0 += 256u) {
                    unsigned ki4[4], xi4[4], rk4[4];
#pragma unroll
                    for (int m = 0; m < 4; ++m) { const unsigned i = c0 + (unsigned)lane + 64u * m; ki4[m] = (i < nc) ? cq[2 * i] : 0u; xi4[m] = (i < nc) ? cq[2 * i + 1] : 0u; rk4[m] = 0u; }
                    for (unsigned j = 0; j < nc; ++j) { const unsigned kj = cq[2 * j];
#pragma unroll
                        for (int m = 0; m < 4; ++m) rk4[m] += (kj > ki4[m] || (kj == ki4[m] && j < c0 + (unsigned)lane + 64u * m)) ? 1u : 0u; }
#pragma unroll
                    for (int m = 0; m < 4; ++m) { const bool take = (c0 + (unsigned)lane + 64u * m < nc) && rk4[m] < rq; const unsigned long long mm = __ballot(take);
                        const unsigned pos = base + __builtin_popcountll(mm & lt); if (take && pos < 256u) sel[ql * 256 + pos] = (unsigned short)xi4[m]; base += __builtin_popcountll(mm); }
                }
            }
        } else {
#pragma unroll
            for (int ql = 0; ql < 4; ++ql) { st.pre[ql] = 0u; st.need[ql] = 256u; st.cnt[ql] = 0u; st.tcnt[ql] = 0u; }
#pragma unroll 1
            for (int lev = 0; lev < 4; ++lev) {
#pragma unroll
                for (int j = 0; j < 8; ++j) hz[j * 64 + lane] = (v4u){0u, 0u, 0u, 0u};
                const unsigned pre0 = hi ? st.pre[2] : st.pre[0], pre1 = hi ? st.pre[3] : st.pre[1];
                const int sh = (lev == 0) ? 23 : (lev == 1) ? 14 : (lev == 2) ? 5 : 0, wd = (lev == 3) ? 5 : 9;
                tile_pass(F, ksrc, kdst, kfr, koff, NT, qa, wp, [&](int kbase, float s0, float s1) {
                    const unsigned k0 = okey(s0), k1 = okey(s1);
                    const unsigned b0 = (k0 >> sh) & ((1u << wd) - 1u), b1 = (k1 >> sh) & ((1u << wd) - 1u);
                    const bool in0 = (lev == 0) || ((k0 >> (sh + wd)) == pre0), in1 = (lev == 0) || ((k1 >> (sh + wd)) == pre1);
                    if (in0) __hip_atomic_fetch_add(hist + (2 * hi) * 512 + b0, 1u, __ATOMIC_RELAXED, __HIP_MEMORY_SCOPE_WORKGROUP);
                    if (in1) __hip_atomic_fetch_add(hist + (2 * hi + 1) * 512 + b1, 1u, __ATOMIC_RELAXED, __HIP_MEMORY_SCOPE_WORKGROUP);
                });
#pragma unroll
                for (int ql = 0; ql < 4; ++ql) { unsigned bin, above, bc; scan_hist_cnt(hist + ql * 512, lane, st.need[ql], bin, above, bc);
                    st.pre[ql] = (st.pre[ql] << wd) | bin; st.need[ql] -= above; }
                LDS_WAIT();
            }
            const unsigned T0 = hi ? st.pre[2] : st.pre[0], T1 = hi ? st.pre[3] : st.pre[1], rq0 = hi ? st.need[2] : st.need[0], rq1 = hi ? st.need[3] : st.need[1];
            tile_pass(F, ksrc, kdst, kfr, koff, NT, qa, wp, [&](int kbase, float s0, float s1) {
#pragma unroll
                for (int t = 0; t < 2; ++t) {
                    const unsigned kk = okey(t ? s1 : s0), T = t ? T1 : T0, rq = t ? rq1 : rq0;
                    const bool gt = kk > T, eq = kk == T;
                    const unsigned long long me = __ballot(eq);
                    const unsigned meh = hi ? (unsigned)(me >> 32) : (unsigned)me;
                    const unsigned trank = (hi ? st.tcnt[2 + t] : st.tcnt[t]) + __builtin_popcount(meh & below);
                    const bool take = gt || (eq && trank < rq);
                    const unsigned long long mt = __ballot(take);
                    const unsigned mth = hi ? (unsigned)(mt >> 32) : (unsigned)mt;
                    const unsigned pos = (hi ? st.cnt[2 + t] : st.cnt[t]) + __builtin_popcount(mth & below);
                    if (take && pos < 256u) sel[(2 * hi + t) * 256 + pos] = (unsigned short)(kbase + r);
                    st.cnt[t] += __builtin_popcount((unsigned)mt); st.cnt[2 + t] += __builtin_popcount((unsigned)(mt >> 32));
                    st.tcnt[t] += __builtin_popcount((unsigned)me); st.tcnt[2 + t] += __builtin_popcount((unsigned)(me >> 32));
                }
            });
        }
    }
    LDS_WAIT();
    { const LAS v4u* s4 = (const LAS v4u*)sel; v4u* g4 = (v4u*)(C.SEL + (rowbase + tq0) * 256);
#pragma unroll
      for (int j = 0; j < 2; ++j) g4[j * 64 + lane] = s4[j * 64 + lane]; }
    LDS_WAIT();
}
__device__ __forceinline__ void phase(Frame& F, const Ctx& C) {
    for (int v = F.vcu; v < 256; v += F.G) {
        const int b = v >> 6, c = v & 63;
#pragma unroll 1
        for (int it = 0; it < 4; ++it) step(F, C, b, (it < 2) ? c : 127 - c, it & 1);
    }
}
__device__ __forceinline__ void attn_phase(Frame& F, const Ctx& C) {
    int lane = F.lane; asm volatile("" : "+v"(lane));
    LAS unsigned short* sq = (LAS unsigned short*)(F.lds + RING_OFF + F.wave * 16384);
    const int nx = F.G / 32;
    for (int x = F.vcu / 32; x < 8; x += nx) {
        const int b = x >> 1, g0 = 2 * (x & 1); const long rowbase = (long)b * SEQ;
        const int w = (F.vcu & 31) * NWAVES + F.wave;
#pragma unroll 1
        for (int t = w; t < SEQ; t += 32 * NWAVES) {
            { const v4u* g4 = (const v4u*)(C.SEL + (rowbase + t) * 256); if (lane < 32) ((LAS v4u*)sq)[lane] = g4[lane]; }
            LDS_WAIT();
            const int N = 64 * ((t >> 6) + 1), nvalid = N < 256 ? N : 256;
            attend(C, sq, nvalid, rowbase, rowbase + t, t, lane, g0);
            LDS_WAIT();
        }
    }
}
}

namespace att8 {
typedef int v2i __attribute__((ext_vector_type(2)));
struct Ctx8 { const unsigned char* QA8; const unsigned char* KV8; const unsigned short* SEL; bf16* M; bool o8; };
constexpr int T2_OFF = KS_OFF, T2_BYTES = 155 * 16 * 4, SELL_OFF = KS_OFF + 10240;
static_assert(T2_BYTES <= 10240 && SELL_OFF + NWAVES * 1024 <= AUX_OFF, "attention LDS map");
__device__ __forceinline__ void mfma8(f32x4& acc, long a, long b) { asm volatile("v_mfma_f32_16x16x32_fp8_fp8 %0, %1, %2, %0" : "+v"(acc) : "v"(a), "v"(b)); }
__device__ __forceinline__ unsigned pk4_fp8(float a, float b, float c, float d) { int r = __builtin_amdgcn_cvt_pk_fp8_f32(a, b, 0, false); r = __builtin_amdgcn_cvt_pk_fp8_f32(c, d, r, true); return (unsigned)r; }

__device__ __forceinline__ void gld16(v4u& dst, const void* p) { asm volatile("global_load_dwordx4 %0, %1, off" : "=v"(dst) : "v"(p) : "memory"); }
__device__ __forceinline__ void issue_kq(const Ctx8& C, const LAS unsigned short* sq, long rowbase, long token, int g, int l15, int l4, int h, v4u (&kr)[16], v4u& qv) {
    const unsigned char* kvb = C.KV8 + rowbase * 512 + g * 128 + 16 * l4;
#pragma unroll
    for (int j = 0; j < 16; ++j) gld16(kr[j], kvb + (long)sq[j * 16 + l15] * 512);
    gld16(qv, C.QA8 + token * 1024 + (4 * g + h) * 64 + 16 * l4);
}
__device__ __forceinline__ void issue_v_half(const Ctx8& C, const LAS unsigned short* sq, long rowbase, int g, int lane, unsigned vbase, int half) {
    const unsigned char* kvb = C.KV8 + rowbase * 512 + g * 128 + 64; const int kq = lane >> 2, p = lane & 3;
#pragma unroll
    for (int j = 0; j < 8; ++j) { const int ti = half * 8 + j; const int key = sq[ti * 16 + kq]; const int x = ((kq >> 2) & 1) | ((ti & 1) << 1);
        glds16(kvb + (long)key * 512 + 16 * (p ^ x), (unsigned)__builtin_amdgcn_readfirstlane(vbase + ti * 1024)); }
}
__device__ __forceinline__ void phase(Frame& F, const Ctx8& C, const float* t5) {
    int lane = F.lane; asm volatile("" : "+v"(lane));
    LAS float* T2 = (LAS float*)(F.lds + T2_OFF);
    for (int e = F.tid; e < 155 * 16; e += NWAVES * 64) { const int rel = (e >> 4) - 91, n = rel < 0 ? -rel : rel;
        const int bk = (rel > 0 ? 16 : 0) + (n < 8 ? n : 8 + (n >= 12) + (n >= 16) + (n >= 23) + (n >= 32) + (n >= 46) + (n >= 64) + (n >= 91));
        T2[e] = t5[bk * 16 + (e & 15)] * 8.0f; }
    __syncthreads();
    LAS unsigned short* sqb = (LAS unsigned short*)(F.lds + SELL_OFF + F.wave * 1024);
    LAS unsigned char* vreg = F.lds + RING_OFF + F.wave * 16384;
    const unsigned vbase = (unsigned)(uintptr_t)vreg;
    const int l15 = lane & 15, l4 = lane >> 4, h = l15 & 3;
    const int trk = 4 * l4 + ((l15 >> 1) & 3), trt = (l15 >> 3) & 1, xs = (l4 & 1) | (trt << 1);
    const int troff = trt * 1024 + trk * 64 + 8 * (l15 & 1);
    const int x = F.vcu / 32, b = x >> 1, g0 = 2 * (x & 1); const long rowbase = (long)b * SEQ;
    const int w = (F.vcu & 31) * NWAVES + F.wave;
    constexpr int NQ = SEQ / (32 * NWAVES), NI = 2 * NQ;
    if (lane < 32) { ((LAS v4u*)sqb)[lane] = ((const v4u*)(C.SEL + (rowbase + w) * 256))[lane]; ((LAS v4u*)(sqb + 256))[lane] = ((const v4u*)(C.SEL + (rowbase + w + 32 * NWAVES) * 256))[lane]; }
    LDS_WAIT();
    v4u kr[16], qv, pf = (v4u){0u, 0u, 0u, 0u};
    issue_kq(C, sqb, rowbase, rowbase + w, g0, l15, l4, h, kr, qv);
    issue_v_half(C, sqb, rowbase, g0, lane, vbase, 0); issue_v_half(C, sqb, rowbase, g0, lane, vbase, 1);
    unsigned cib[16];
#pragma unroll 1
    for (int idx = 0; idx < NI; ++idx) { LA_A;
        const int qn = idx >> 1, gi = idx & 1, g = g0 + gi, t = w + 32 * NWAVES * qn;
        const LAS unsigned short* sq = sqb + (qn & 1) * 256;
        const int nidx = (idx + 1 < NI) ? idx + 1 : idx, nq = nidx >> 1, ng = g0 + (nidx & 1), nt = w + 32 * NWAVES * nq;
        const LAS unsigned short* nsq = sqb + (nq & 1) * 256;
        if (gi == 1) { asm volatile("s_waitcnt vmcnt(34)" : "+v"(pf) :: "memory"); if (lane < 32) ((LAS v4u*)(sqb + (qn & 1) * 256))[lane] = pf; }
        { const int pq = (qn + 2 < NQ) ? qn + 2 : NQ - 1; gld16(pf, (const v4u*)(C.SEL + (rowbase + w + 32 * NWAVES * pq) * 256) + (lane & 31)); }
        if (idx == 0) asm volatile("s_waitcnt vmcnt(0)" : "+v"(qv), "+v"(kr[0]), "+v"(kr[1]), "+v"(kr[2]), "+v"(kr[3]), "+v"(kr[4]), "+v"(kr[5]), "+v"(kr[6]), "+v"(kr[7]), "+v"(kr[8]), "+v"(kr[9]), "+v"(kr[10]), "+v"(kr[11]), "+v"(kr[12]), "+v"(kr[13]), "+v"(kr[14]), "+v"(kr[15]) :: "memory");
        else asm volatile("s_waitcnt vmcnt(20)" : "+v"(qv), "+v"(kr[0]), "+v"(kr[1]), "+v"(kr[2]), "+v"(kr[3]), "+v"(kr[4]), "+v"(kr[5]), "+v"(kr[6]), "+v"(kr[7]), "+v"(kr[8]), "+v"(kr[9]), "+v"(kr[10]), "+v"(kr[11]), "+v"(kr[12]), "+v"(kr[13]), "+v"(kr[14]), "+v"(kr[15]) :: "memory");
        if (gi == 0) {
#pragma unroll
            for (int ti = 0; ti < 16; ++ti) { const v2u i4 = *(const LAS v2u*)(sq + ti * 16 + 4 * l4);
                const int r0 = (int)(i4.x & 0xffffu) - t, r1 = (int)(i4.x >> 16) - t, r2 = (int)(i4.y & 0xffffu) - t, r3 = (int)(i4.y >> 16) - t;
                const int c0 = min(max(r0, -91), 63) + 91, c1 = min(max(r1, -91), 63) + 91, c2 = min(max(r2, -91), 63) + 91, c3 = min(max(r3, -91), 63) + 91;
                cib[ti] = (unsigned)c0 | ((unsigned)c1 << 8) | ((unsigned)c2 << 16) | ((unsigned)c3 << 24); }
        }
        const int N = 64 * ((t >> 6) + 1), nvalid = N < 256 ? N : 256;
        const long q0 = (long)(((unsigned long long)qv.y << 32) | qv.x), q1 = (long)(((unsigned long long)qv.w << 32) | qv.z);
        f32x4 S[16];
#pragma unroll
        for (int ti = 0; ti < 16; ++ti) { const unsigned cb = cib[ti];
            f32x4 a; a.x = T2[(cb & 255u) * 16 + 4 * g + h]; a.y = T2[((cb >> 8) & 255u) * 16 + 4 * g + h]; a.z = T2[((cb >> 16) & 255u) * 16 + 4 * g + h]; a.w = T2[(cb >> 24) * 16 + 4 * g + h];
            mfma8(a, (long)(((unsigned long long)kr[ti].y << 32) | kr[ti].x), q0);
            mfma8(a, (long)(((unsigned long long)kr[ti].w << 32) | kr[ti].z), q1);
            S[ti] = a; }
        asm volatile("s_nop 15\n\ts_nop 7" : "+v"(S[0]), "+v"(S[1]), "+v"(S[2]), "+v"(S[3]), "+v"(S[4]), "+v"(S[5]), "+v"(S[6]), "+v"(S[7]), "+v"(S[8]), "+v"(S[9]), "+v"(S[10]), "+v"(S[11]), "+v"(S[12]), "+v"(S[13]), "+v"(S[14]), "+v"(S[15]));
        issue_kq(C, nsq, rowbase, rowbase + nt, ng, l15, l4, h, kr, qv);
#pragma unroll
        for (int ti = 0; ti < 16; ++ti) if (ti * 16 >= nvalid) S[ti] = (f32x4){-INFINITY, -INFINITY, -INFINITY, -INFINITY};
        float mx = S[0].x;
#pragma unroll
        for (int ti = 0; ti < 16; ++ti) mx = fmaxf(fmaxf(mx, fmaxf(S[ti].x, S[ti].y)), fmaxf(S[ti].z, S[ti].w));
        mx = fmaxf(mx, __shfl_xor(mx, 16)); mx = fmaxf(mx, __shfl_xor(mx, 32));
        const float mc = -mx * C2; float ls = 0.f;
        long P8[8];
#pragma unroll
        for (int j = 0; j < 8; ++j) { float e[8];
#pragma unroll
            for (int q = 0; q < 4; ++q) { e[q] = __builtin_amdgcn_exp2f(__builtin_fmaf(S[2 * j][q], C2, mc)); e[4 + q] = __builtin_amdgcn_exp2f(__builtin_fmaf(S[2 * j + 1][q], C2, mc)); }
            ls += ((e[0] + e[1]) + (e[2] + e[3])) + ((e[4] + e[5]) + (e[6] + e[7]));
            const unsigned lo = pk4_fp8(e[0] * 256.f, e[1] * 256.f, e[2] * 256.f, e[3] * 256.f), hi = pk4_fp8(e[4] * 256.f, e[5] * 256.f, e[6] * 256.f, e[7] * 256.f);
            P8[j] = (long)(((unsigned long long)hi << 32) | lo); }
        ls += __shfl_xor(ls, 16); ls += __shfl_xor(ls, 32);
        f32x4 D[4];
#pragma unroll
        for (int db = 0; db < 4; ++db) D[db] = (f32x4){0.f, 0.f, 0.f, 0.f};
#pragma unroll
        for (int hf = 0; hf < 2; ++hf) {
            asm volatile("s_waitcnt vmcnt(28)" ::: "memory");
#pragma unroll
            for (int j = 4 * hf; j < 4 * hf + 4; ++j)
#pragma unroll
                for (int db = 0; db < 4; ++db) {
                    const v2i vv = __builtin_amdgcn_ds_read_tr8_b64_v2i32((LAS v2i*)(vreg + j * 2048 + troff + 16 * (db ^ xs)));
                    mfma8(D[db], P8[j], __builtin_bit_cast(long, vv)); }
            asm volatile("s_waitcnt lgkmcnt(0)" ::: "memory");
            issue_v_half(C, nsq, rowbase, ng, lane, vbase, hf);
        }
        asm volatile("s_nop 15\n\ts_nop 7" : "+v"(D[0]), "+v"(D[1]), "+v"(D[2]), "+v"(D[3]));
        const float lh = __shfl(ls, l4);
        const float inv = __builtin_amdgcn_rcpf(lh * 256.f);
        bf16* mp = C.M + (rowbase + t) * DM + (4 * g + l4) * 64 + l15;
#pragma unroll
        for (int db = 0; db < 4; ++db) { const float v = (l4 == 0) ? D[db].x : (l4 == 1) ? D[db].y : (l4 == 2) ? D[db].z : D[db].w;
            if (C.o8) { const unsigned o1 = (unsigned)__builtin_amdgcn_cvt_pk_fp8_f32(v * inv, 0.f, 0, false);
                asm volatile("global_store_byte %0, %1, off" :: "v"((unsigned char*)C.M + (rowbase + t) * DM + (4 * g + l4) * 64 + l15 + 16 * db), "v"(o1) : "memory"); }
            else { const unsigned short ob = (unsigned short)f2bf(v * inv);
                asm volatile("global_store_short %0, %1, off" :: "v"(mp + 16 * db), "v"((unsigned)ob) : "memory"); } }
    }
    asm volatile("s_waitcnt vmcnt(0)" ::: "memory");
}
}

#ifndef REP_P0
#define REP_P0 1
#endif
#ifndef REP_IN
#define REP_IN 1
#endif
#ifndef REP_DSA
#define REP_DSA 1
#endif
#ifndef REP_BAND
#define REP_BAND 1
#endif
#ifndef REP_UP
#define REP_UP 1
#endif
#ifndef REP_FIX
#define REP_FIX 1
#endif
constexpr int N_PHASES = 1 + 6 * DEPTH;
#ifndef MK_N_LAUNCHES
#define MK_N_LAUNCHES 1
#endif
__global__ void __launch_bounds__(NWAVES * 64, 2) mega_fwd(Args args) {
    extern __shared__ __attribute__((aligned(16))) unsigned char lds[];
    Frame F;
    F.lds = (LAS unsigned char*)lds;
    F.MISC = (volatile LAS unsigned*)(F.lds + MISC_OFF);
    F.tid = threadIdx.x; F.lane = F.tid & 63; F.wave = __builtin_amdgcn_readfirstlane(F.tid >> 6);
    F.G = GRID; { const int bx = blockIdx.x; F.vcu = (bx & 7) * (GRID / 8) + (bx >> 3); }
    unsigned char* ws = args.ws;
    F.ctl = (gu32*)(ws + WS_CTL);
    for (int u = F.tid; u < (LDS_BYTES - LDSCTL_OFF) / 4; u += NWAVES * 64) ((LAS unsigned*)(F.lds + LDSCTL_OFF))[u] = 0u;
    __syncthreads();
    XcdBarrier bar; bar.bar = (unsigned*)(F.ctl + CW_BAR); bar.x = 0; bar.st = nullptr;
    if (MK_N_LAUNCHES == 1) bar = xcd_barrier_post((unsigned*)(F.ctl + CW_BAR), F.MISC + 8);
#ifdef F8M_RUNTIME
    const int lo = args.ph_lo, hi = args.ph_hi, f8m = args.f8m;
#else
    const int lo = args.ph_lo, hi = args.ph_hi; constexpr int f8m = F8M_ALL;
#ifdef PAD_NOPS
    asm volatile(".rept %0\n\ts_nop 0\n\t.endr" :: "n"(PAD_NOPS));
#endif
#endif
#define IN(k) (lo <= (k) && (k) < hi)
#define OPQ_FRAME(Fl) Frame Fl = F; { int l_; asm volatile("v_mbcnt_lo_u32_b32 %0, -1, 0\n\tv_mbcnt_hi_u32_b32 %0, -1, %0" : "=v"(l_)); int w_ = F.wave; asm volatile("" : "+s"(w_)); Fl.wave = w_; Fl.lane = l_; Fl.tid = w_ * 64 + l_; }
#define SEAM(k) do { if (IN(k) && IN((k) + 1)) xcd_barrier(bar); } while (0)

    bf16* hb = (bf16*)(ws + WS_HB); bf16* mb = (bf16*)(ws + WS_M); float* ss = (float*)(ws + WS_SS); float* halo = (float*)(ws + WS_HALO);
    unsigned char* proj = ws + WS_PROJ; bf16* act = (bf16*)(ws + WS_PROJ);

#ifndef SKIP_P0
    if (IN(0)) { for (int rep = 0; rep < REP_P0; ++rep) { OPQ_FRAME(F0); p0_prologue(F0, args); } }
#endif
    SEAM(0);

#pragma unroll 1
    for (int L = 0; L < DEPTH; ++L) {
        const int pb = 1 + 6 * L, li = L >> 1; const bool isB = (L & 1) != 0;
        if (IN(pb)) {
#ifndef SKIP_IN
            for (int rep = 0; rep < REP_IN; ++rep)
            if (!isB) {
                pg8::Gemm g{hb, (const bf16*)(ws + WS_W_INA) + (size_t)li * NA_PAD * DM, MTOK, NA_PAD, DM}; pg8::StaticOrder S; S.init(MTOK, NA_PAD, F.G, (int)blockIdx.x);
                if (f8_in(f8m, L)) {
                    { pg8::Gemm g8{(const bf16*)(ws + WS_M), (const bf16*)(ws + WS_W_INA8 + (size_t)li * NA_PAD * DM), MTOK, 1536, DM / 2}; pg8::StaticOrder S8; S8.init(MTOK, 1536, F.G, (int)blockIdx.x);
                      EpiIn E{ss, proj, args.q_norm_g + L * 64, args.k_norm_g + L * 64, 0, W8I, 0};
                      pg8::gemm_phase<EpiIn, pg8::StaticOrder, true, true, true>(F.lds + RING_OFF, g8, S8, E, F.wave); }
                    { pg8::Gemm g2{hb, (const bf16*)(ws + WS_W_INA) + (size_t)li * NA_PAD * DM + (size_t)1536 * DM, MTOK, NA_PAD - 1536, DM}; pg8::StaticOrder S2; S2.init(MTOK, NA_PAD - 1536, F.G, (int)blockIdx.x);
                      EpiIn E{ss, proj, args.q_norm_g + L * 64, args.k_norm_g + L * 64, 0, 1.0f, 6};
                      pg8::gemm_phase<EpiIn, pg8::StaticOrder, true, true>(F.lds + RING_OFF, g2, S2, E, F.wave); }
                } else {
                EpiIn E{ss, proj, args.q_norm_g + L * 64, args.k_norm_g + L * 64, 0, 1.0f, 0};
                pg8::gemm_phase<EpiIn, pg8::StaticOrder, true, true>(F.lds + RING_OFF, g, S, E, F.wave); }
            } else {
                pg8::Gemm g{hb, (const bf16*)(ws + WS_W_INB) + (size_t)li * NB * DM, MTOK, NB, DM}; pg8::StaticOrder S; S.init(MTOK, NB, F.G, (int)blockIdx.x);
                if (f8_in(f8m, L)) { pg8::Gemm g8{(const bf16*)(ws + WS_M), (const bf16*)(ws + WS_W_INB) + (size_t)li * NB * DM, MTOK, NB, DM / 2};
                    EpiIn E{ss, proj, args.q_norm_g + L * 64, args.k_norm_g + L * 64, 1, W8I, 0};
                    pg8::gemm_phase<EpiIn, pg8::StaticOrder, true, true, true>(F.lds + RING_OFF, g8, S, E, F.wave); }
                else { EpiIn E{ss, proj, args.q_norm_g + L * 64, args.k_norm_g + L * 64, 1, 1.0f, 0};
                    pg8::gemm_phase<EpiIn, pg8::StaticOrder, true, true>(F.lds + RING_OFF, g, S, E, F.wave); }
            }
#endif
        }
        SEAM(pb);
#if defined(DBG_NODSA) || defined(DBG_NOBAND)
#ifdef DBG_NODSA
        const bool zero_m = !isB;
#else
        const bool zero_m = isB;
#endif
        if (IN(pb + 1) && zero_m) { for (size_t i = (size_t)blockIdx.x * 512 + threadIdx.x; i < (size_t)MTOK * DM / 8; i += (size_t)gridDim.x * 512) ((v4u*)mb)[i] = (v4u){0u, 0u, 0u, 0u}; }
        if (IN(pb + 1) && !zero_m) {
#else
        if (IN(pb + 1)) {
#endif
#ifndef SKIP_DSA
            if (!isB) {
                LAS float* t5l = (LAS float*)(F.lds + AUX_OFF);
                { OPQ_FRAME(Ft); for (int i = Ft.tid; i < 512; i += NWAVES * 64) t5l[i] = args.t5_bias[i] * LOG2E; }
                __syncthreads();
                dsa::Ctx C{(const bf16*)(proj + PA_QA), (const bf16*)(proj + PA_KA), (const bf16*)(proj + PA_VA), (const bf16*)(proj + PA_QI), (const bf16*)(proj + PA_KI), (const float*)(proj + PA_WI), mb, t5l, (unsigned short*)(proj + PA_SEL)};
#ifdef DBG_DSACOPY
                { int t_ = threadIdx.x; asm volatile("" : "+v"(t_));
                for (unsigned i = blockIdx.x * 512u + (unsigned)t_; i < (unsigned)MTOK * DM; i += gridDim.x * 512u) { const unsigned t = i >> 10, c = i & 1023u;
                    float v = bf_lo(C.QA[i]); v += bf_lo(C.KA[t * 256 + (c & 255)]); v += bf_lo(C.VA[t * 256 + (c & 255)]); v += bf_lo(C.QI[t * 512 + (c & 511)]); v += bf_lo(C.KI[t * 64 + (c & 63)]); v += C.WI[t * 8 + (c & 7)];
                    mb[i] = (bf16)f2bf(v * 0.01f); asm volatile("" ::: "memory"); } }
#else
                for (int rep = 0; rep < REP_DSA; ++rep) { OPQ_FRAME(F1); dsa::phase(F1, C); }
                xcd_barrier(bar);
                { OPQ_FRAME(F1b); att8::Ctx8 C8{(const unsigned char*)(proj + PA_QA), (const unsigned char*)(proj + PA_KA), (const unsigned short*)(proj + PA_SEL), mb, f8_out(f8m, L)};
#ifndef REP_ATT8
#define REP_ATT8 1
#endif
                  for (int rep = 0; rep < REP_ATT8; ++rep) { att8::phase(F1b, C8, args.t5_bias); __syncthreads(); } }
#endif
            }
#endif
#ifndef SKIP_BAND
            if (isB) {
                for (int rep = 0; rep < REP_BAND; ++rep) { OPQ_FRAME(F2); band::phase(F2, (const bf16*)proj, (const bf16*)(proj + PB_STRIDE), (const bf16*)(proj + 2 * PB_STRIDE), mb, args.rel_bias_b + (size_t)li * 513 * 16, f8_out(f8m, L)); }
            }
#endif
        }
        SEAM(pb + 1);
        if (IN(pb + 2)) {
#ifndef SKIP_OUT
            pg8::Gemm g{mb, (const bf16*)(ws + WS_W_OUT) + (size_t)L * DM * DM, MTOK, DM, DM}; pg8::StaticOrder S; S.init(MTOK, DM, F.G, (int)blockIdx.x);
#ifdef REP_OUT
            { EpiRes E0{nullptr, hb, (bf16*)proj, halo}; pg8::gemm_phase<EpiRes, pg8::StaticOrder, true, true>(F.lds + RING_OFF, g, S, E0, F.wave); }
#endif
            unsigned char* h8o = f8_ffn(f8m, L) ? proj + PX_HB8 : nullptr;
            if (f8_out(f8m, L)) { pg8::Gemm g8{mb, (const bf16*)(ws + WS_W_OUT) + (size_t)L * DM * DM, MTOK, DM, DM / 2};
                EpiResT<1 | SER_OUT> E{nullptr, hb, hb, ss, h8o};
                pg8::gemm_phase<EpiResT<1 | SER_OUT>, pg8::StaticOrder, true, true, true>(F.lds + RING_OFF, g8, S, E, F.wave); }
            else { EpiResT<SER_OUT> E{nullptr, hb, hb, ss, h8o, L == 0 ? args.x : nullptr};
                pg8::gemm_phase<EpiResT<SER_OUT>, pg8::StaticOrder, true, true>(F.lds + RING_OFF, g, S, E, F.wave); }
#endif
        }
        SEAM(pb + 2);
        if (IN(pb + 3)) {
#ifndef SKIP_UP
            for (int rep = 0; rep < REP_UP; ++rep) {
            pg8::Gemm g{hb, (const bf16*)(ws + WS_W_UP) + (size_t)L * NUP * DM, MTOK, NUP, DM}; pg8::StaticOrder S; S.init(MTOK, NUP, F.G, (int)blockIdx.x);
#ifdef PROBE_UPK
            { EpiDummy E0{halo}; pg8::gemm_phase<EpiDummy, pg8::StaticOrder, true, true>(F.lds + RING_OFF, g, S, E0, F.wave); }
#endif
            if (f8_ffn(f8m, L)) { pg8::Gemm g8{(const bf16*)(proj + PX_HB8), (const bf16*)(ws + WS_W_UP) + (size_t)L * NUP * DM, MTOK, NUP, DM / 2};
                EpiUpT<true> E{ss, args.conv_w + (size_t)L * 3 * NUP, args.conv_b + (size_t)L * NUP, act, halo, (LAS float*)(F.lds + AUX_OFF)};
                pg8::gemm_phase<EpiUpT<true>, pg8::StaticOrder, true, true, true>(F.lds + RING_OFF, g8, S, E, F.wave); }
            else { EpiUp E{ss, args.conv_w + (size_t)L * 3 * NUP, args.conv_b + (size_t)L * NUP, act, halo, (LAS float*)(F.lds + AUX_OFF)};
                pg8::gemm_phase<EpiUp, pg8::StaticOrder, true, true>(F.lds + RING_OFF, g, S, E, F.wave); } }
#endif
        }
        SEAM(pb + 3);
#ifndef SKIP_FIX
        if (IN(pb + 4)) for (int rep = 0; rep < REP_FIX; ++rep) { OPQ_FRAME(F3); if (f8_ffn(f8m, L)) fixup_phase<true>(F3, args.conv_w + (size_t)L * 3 * NUP, args.conv_b + (size_t)L * NUP, halo, act); else fixup_phase<false>(F3, args.conv_w + (size_t)L * 3 * NUP, args.conv_b + (size_t)L * NUP, halo, act); }
#endif
        SEAM(pb + 4);
        if (IN(pb + 5)) {
#ifndef SKIP_DN
            pg8::Gemm g{act, (const bf16*)(ws + WS_W_DN) + (size_t)L * DM * FF, MTOK, DM, FF}; pg8::StaticOrder S; S.init(MTOK, DM, F.G, (int)blockIdx.x);
#ifdef REP_DN
            { EpiRes E0{nullptr, hb, mb, halo}; pg8::gemm_phase<EpiRes, pg8::StaticOrder, true, true>(F.lds + RING_OFF, g, S, E0, F.wave); }
#endif
            unsigned char* h8d = f8_in(f8m, L + 1) ? ws + WS_M : nullptr;
            if (f8_ffn(f8m, L)) { pg8::Gemm g8{act, (const bf16*)(ws + WS_W_DN) + (size_t)L * DM * FF, MTOK, DM, FF / 2};
                EpiResT<1> E{L == DEPTH - 1 ? args.out : nullptr, hb, hb, ss, h8d};
                pg8::gemm_phase<EpiResT<1>, pg8::StaticOrder, true, true, true>(F.lds + RING_OFF, g8, S, E, F.wave); }
            else { EpiRes E{L == DEPTH - 1 ? args.out : nullptr, hb, hb, ss, h8d};
                pg8::gemm_phase<EpiRes, pg8::StaticOrder, true, true>(F.lds + RING_OFF, g, S, E, F.wave); }
#endif
        }
        SEAM(pb + 5);
    }
#undef IN
#undef SEAM
}

extern "C" void kernel_launch(void* const* d_in, const int* in_sizes, int n_in, void* d_out, int out_size, void* d_ws, size_t ws_size, hipStream_t stream) {
    static int grid = 0;
    if (grid == 0) {
        if (n_in != 14 || in_sizes[0] != MTOK * DM || out_size != MTOK * DM || ws_size < WS_END) { fprintf(stderr, "kernel_launch: unexpected shapes / workspace (n_in %d, ws %zu); nothing launched\n", n_in, ws_size); grid = -1; return; }
        int dev = 0, cus = 0, per_cu = 0;
        if (hipGetDevice(&dev) != hipSuccess || hipDeviceGetAttribute(&cus, hipDeviceAttributeMultiprocessorCount, dev) != hipSuccess) { grid = -1; return; }
        if (hipFuncSetAttribute((const void*)mega_fwd, hipFuncAttributeMaxDynamicSharedMemorySize, LDS_BYTES) != hipSuccess) { fprintf(stderr, "kernel_launch: hipFuncSetAttribute failed\n"); grid = -1; return; }
        if (hipOccupancyMaxActiveBlocksPerMultiprocessor(&per_cu, (const void*)mega_fwd, NWAVES * 64, LDS_BYTES) != hipSuccess || per_cu < 1) { fprintf(stderr, "kernel_launch: occupancy query reports %d blocks per CU\n", per_cu); }
        (void)hipGetLastError();
        if (cus != GRID) { fprintf(stderr, "kernel_launch: built for a %d-CU device, found %d; nothing launched\n", GRID, cus); grid = -1; return; }
        grid = GRID;
    }
    if (grid < 0) return;
    if (hipMemsetAsync((char*)d_ws + WS_CTL, 0, CTL_ZERO_BYTES, stream) != hipSuccess) return;
    Args a{};
    a.x = (const float*)d_in[0]; a.attn_norm_g = (const float*)d_in[1]; a.w_in_a = (const float*)d_in[2]; a.w_in_b = (const float*)d_in[3]; a.q_norm_g = (const float*)d_in[4];
    a.k_norm_g = (const float*)d_in[5]; a.t5_bias = (const float*)d_in[6]; a.rel_bias_b = (const float*)d_in[7]; a.w_out = (const float*)d_in[8]; a.ffn_norm_g = (const float*)d_in[9];
    a.w_up = (const float*)d_in[10]; a.conv_w = (const float*)d_in[11]; a.conv_b = (const float*)d_in[12]; a.w_down = (const float*)d_in[13];
    a.out = (float*)d_out; a.ws = (unsigned char*)d_ws; a.f8m = F8M_ALL;
#if MK_N_LAUNCHES == 1
    a.ph_lo = 0; a.ph_hi = N_PHASES; a.li = 0;
    hipLaunchKernelGGL(mega_fwd, dim3(grid), dim3(NWAVES * 64), LDS_BYTES, stream, a);
#else
    for (int p = 0; p < N_PHASES; ++p) { a.ph_lo = p; a.ph_hi = p + 1; a.li = p; hipLaunchKernelGGL(mega_fwd, dim3(grid), dim3(NWAVES * 64), LDS_BYTES, stream, a); }
#endif
}
```

```cpp
#define F8M_FFN 0xE
#include <hip/hip_runtime.h>
#include <cstdio>
#include <cstdint>
#ifndef OFF_G
#define OFF_G 0
#endif
#ifndef OFF_S
#define OFF_S 0
#endif
#ifndef OFF_A
#define OFF_A 0
#endif
#ifndef OFF_B
#define OFF_B 0
#endif
#define LOOP_ALIGN_N(n) asm volatile(".p2align 6\n\t.rept %0\n\ts_nop 0\n\t.endr" :: "n"(n))
#if OFF_G < 0
#define LA_G
#else
#define LA_G LOOP_ALIGN_N(OFF_G)
#endif
#if OFF_S < 0
#define LA_S
#else
#define LA_S LOOP_ALIGN_N(OFF_S)
#endif
#if OFF_A < 0
#define LA_A
#else
#define LA_A LOOP_ALIGN_N(OFF_A)
#endif
#if OFF_B < 0
#define LA_B
#else
#define LA_B LOOP_ALIGN_N(OFF_B)
#endif
namespace pg8 {
#define PG8_LAS __attribute__((address_space(3)))
typedef unsigned short bf16_t;
typedef short bf16x8 __attribute__((ext_vector_type(8)));
typedef float f32x4 __attribute__((ext_vector_type(4)));
typedef unsigned u32x4 __attribute__((ext_vector_type(4)));
typedef int i32x4 __attribute__((ext_vector_type(4)));
typedef int i32x8 __attribute__((ext_vector_type(8)));
constexpr int BM = 256, BK = 64, HALF = 128, HTB = HALF * BK * 2  , STAGE_BYTES = 8 * HTB, NXCD = 8, WGM = 8;

__host__ __device__ __forceinline__ int lds_byte(int r, int c) { const int st = (r >> 4) * 2 + (c >> 5), rr = r & 15, cc = c & 31, ob = rr * 64 + cc * 2; return st * 1024 + (ob ^ (((ob >> 9) & 1) << 5)); }
__host__ __device__ __forceinline__ void stage_rc(int b, int& R, int& C) { const int st = b / 1024, sb = b % 1024, swz = sb ^ (((sb >> 9) & 1) << 5); R = (st >> 1) * 16 + swz / 64; C = (st & 1) * 32 + (swz % 64) / 2; }
__host__ __device__ __forceinline__ int perm32(int rho) { const int n = rho >> 4, i = rho & 15; return 8 * (i >> 2) + 4 * n + (i & 3); }

struct Unit { int pm, pn; };
struct Gemm { const bf16_t* A; const bf16_t* Bt; int M, N, K; };

struct StaticOrder {
    int nM, nN, nwg, G, c;
    __host__ __device__ __forceinline__ void init(int M, int N, int G_, int c_) { nM = M / BM; nN = N / BM; nwg = nM * nN; G = G_; c = c_; }
    __host__ __device__ __forceinline__ bool next(int i, Unit& u) const {
        const long L = (long)i * G + c; if (L >= nwg) return false;
        int wgid = (int)L; { const int q = nwg / NXCD, r = nwg % NXCD, xcd = wgid % NXCD, off = wgid / NXCD; wgid = (xcd < r ? xcd * (q + 1) : r * (q + 1) + (xcd - r) * q) + off; }
        const int nig = WGM * nN, gid = wgid / nig, fm = gid * WGM, gsz = (nM - fm) < WGM ? (nM - fm) : WGM;
        u.pm = fm + ((wgid % nig) % gsz); u.pn = (wgid % nig) / gsz; return true;
    }
    __device__ __forceinline__ void a_ready(const Unit&) const {}
    __device__ __forceinline__ void done(const Unit&) const {}
};
struct SplitOrder {
    int nN, G, c, lo, hi;
    __host__ __device__ void init(int N, int G_, int c_, int lo_, int hi_) { nN = N / BM; G = G_; c = c_; lo = lo_; hi = hi_; }
    __host__ __device__ bool next(int i, Unit& u) const {
        const bool up = c >= G / 2; if (i >= (up ? hi : lo)) return false;
        const int id = (i < lo) ? i * G + c : lo * G + (i - lo) * (G / 2) + (c - G / 2);
        u.pm = id / nN; u.pn = id % nN; return true;
    }
    __device__ __forceinline__ void a_ready(const Unit&) const {}
    __device__ __forceinline__ void done(const Unit&) const {}
};
struct BalOrder {
    int nN, x, j, nall, n;
    __host__ __device__ __forceinline__ void init(int N, int c, int nall_, int nextra, bool extra_low) { nN = N / BM; x = c & 7; j = c >> 3; nall = nall_; n = nall_ + (((j < 16) == extra_low) ? nextra : 0); }
    __host__ __device__ __forceinline__ bool next(int i, Unit& u) const {
        if (i >= n) return false;
        const int e = (i < nall) ? i * 32 + j : nall * 32 + (i - nall) * 16 + (j & 15);
        u.pm = 16 * x + e / nN; u.pn = e % nN; return true;
    }
    __device__ __forceinline__ void a_ready(const Unit&) const {}
    __device__ __forceinline__ void done(const Unit&) const {}
};
__device__ __forceinline__ unsigned cvt_pk_bf16(float lo, float hi) { unsigned r; asm volatile("v_cvt_pk_bf16_f32 %0, %1, %2" : "=v"(r) : "v"(lo), "v"(hi)); return r; }
template <class Epi, class Sched, bool ALIGN_EPI = false, bool SP2 = false, bool F8 = false>
__device__ __forceinline__ void gemm_phase(PG8_LAS unsigned char* lds, const Gemm g, const Sched& S, const Epi& E, const int wave_id) {
    int lane_; asm volatile("v_mbcnt_lo_u32_b32 %0, -1, 0\n\tv_mbcnt_hi_u32_b32 %0, -1, %0" : "=v"(lane_));
    int wid_ = wave_id; asm volatile("" : "+s"(wid_));
    const int wid = wid_, lane = lane_, tid = wid * 64 + lane, wr = wid >> 2, wc = wid & 3, fr = lane & 15, fq = lane >> 4;
    const int K = g.K, nt = K / BK;
    unsigned voffA[2], voffB[2];
#pragma unroll
    for (int i = 0; i < 2; ++i) { int R, C; stage_rc(tid * 16 + i * 8192, R, C); const int Rb = Epi::PERM ? ((R & ~31) + perm32(R & 31)) : R;
        const int Ra = Epi::PERMA ? ((R & ~63) | (4 * (R & 15) + ((R >> 4) & 3))) : R;
        voffA[i] = (unsigned)(Ra * K + C) * 2u; voffB[i] = (unsigned)(Rb * K + C) * 2u; }
    const size_t kstep = (size_t)(BK * 2);
    const size_t hstep = (size_t)HALF * K * 2;
    const size_t tstep = 2 * hstep;
    const unsigned ldsw = (unsigned)wid * 1024u;
    const int aoff = lds_byte(wr * 64 + fr, fq * 8), boff = lds_byte(wc * 32 + fr, fq * 8);
#define PG8_SA(b, h) (((b) * 2 + (h)) * HTB)
#define PG8_SB(b, h) ((4 + (b) * 2 + (h)) * HTB)
#define PG8_STAGE(bufoff, gbase, voff) do { _Pragma("unroll") for (int _i = 0; _i < 2; ++_i) \
        __builtin_amdgcn_global_load_lds((const unsigned*)((const char*)(gbase) + (voff)[_i]), (PG8_LAS unsigned*)(lds + (bufoff) + ldsw + _i * 8192), 16, 0, 0); } while (0)
#define PG8_LDA(dst, b, h) do { _Pragma("unroll") for (int m = 0; m < 4; ++m) _Pragma("unroll") for (int k = 0; k < 2; ++k) dst[m][k] = *(const PG8_LAS bf16x8*)(lds + PG8_SA(b, h) + aoff + m * 2048 + k * 1024); } while (0)
#define PG8_LDB(dst, b, h) do { _Pragma("unroll") for (int n = 0; n < 2; ++n) _Pragma("unroll") for (int k = 0; k < 2; ++k) dst[n][k] = *(const PG8_LAS bf16x8*)(lds + PG8_SB(b, h) + boff + n * 2048 + k * 1024); } while (0)
#define PG8_CAT(lo, hi) __builtin_shufflevector(__builtin_bit_cast(i32x4, lo), __builtin_bit_cast(i32x4, hi), 0, 1, 2, 3, 4, 5, 6, 7)
#define PG8_MMA(ai, bj, At, Bt) do { __builtin_amdgcn_s_setprio(1); _Pragma("unroll") for (int m = 0; m < 4; ++m) _Pragma("unroll") for (int n = 0; n < 2; ++n) { \
        if constexpr (F8) { const i32x8 b8_ = PG8_CAT(Bt[n][0], Bt[n][1]), a8_ = PG8_CAT(At[m][0], At[m][1]); asm volatile("v_mfma_f32_16x16x128_f8f6f4 %0, %1, %2, %0" : "+v"(acc[ai][bj][m][n]) : "v"(b8_), "v"(a8_)); } \
        else { _Pragma("unroll") for (int k = 0; k < 2; ++k) acc[ai][bj][m][n] = __builtin_amdgcn_mfma_f32_16x16x32_bf16(Bt[n][k], At[m][k], acc[ai][bj][m][n], 0, 0, 0); } } __builtin_amdgcn_s_setprio(0); } while (0)
#define PG8_WAIT_V(n) asm volatile("s_waitcnt vmcnt(" #n ")" ::: "memory")
#define PG8_WAIT_L(n) asm volatile("s_waitcnt lgkmcnt(" #n ")" ::: "memory")
#define PG8_BAR __builtin_amdgcn_s_barrier()
#define PG8_SCHED __builtin_amdgcn_sched_barrier(0)
    Unit cur, nxt; int ui = 0;
    if (!S.next(0, cur)) return;
    f32x4 acc[2][2][4][2];
#pragma unroll
    for (int a = 0; a < 2; ++a)
#pragma unroll
        for (int b = 0; b < 2; ++b)
#pragma unroll
            for (int m = 0; m < 4; ++m)
#pragma unroll
                for (int n = 0; n < 2; ++n) acc[a][b][m][n] = (f32x4){0.f, 0.f, 0.f, 0.f};
    bf16x8 At[4][2], B0[2][2], B1[2][2];
    f32x4 epre[(Epi::HAS_PRE || Epi::WANTS_PRE) ? 4 : 1];
    const char* cA = (const char*)g.A + (size_t)cur.pm * tstep; const char* cB = (const char*)g.Bt + (size_t)cur.pn * tstep;
    S.a_ready(cur);
    if constexpr (SP2) {
        PG8_STAGE(PG8_SB(0, 0), cB, voffB); PG8_STAGE(PG8_SB(0, 1), cB + hstep, voffB); PG8_STAGE(PG8_SA(0, 0), cA, voffA); PG8_STAGE(PG8_SA(0, 1), cA + hstep, voffA);
        if (wr == 1) PG8_BAR;
        PG8_WAIT_V(2); PG8_BAR;
        PG8_STAGE(PG8_SB(1, 0), cB + kstep, voffB); PG8_STAGE(PG8_SA(1, 0), cA + kstep, voffA); PG8_STAGE(PG8_SB(1, 1), cB + hstep + kstep, voffB);
        PG8_WAIT_V(6); PG8_BAR;
    } else {
        PG8_STAGE(PG8_SB(0, 0), cB, voffB); PG8_STAGE(PG8_SA(0, 0), cA, voffA); PG8_STAGE(PG8_SB(0, 1), cB + hstep, voffB); PG8_STAGE(PG8_SA(0, 1), cA + hstep, voffA);
        if (wr == 1) PG8_BAR;
        PG8_WAIT_V(4); PG8_BAR;
        PG8_STAGE(PG8_SB(1, 0), cB + kstep, voffB); PG8_STAGE(PG8_SA(1, 0), cA + kstep, voffA); PG8_STAGE(PG8_SB(1, 1), cB + hstep + kstep, voffB);
        PG8_WAIT_V(6); PG8_BAR;
    }
    for (;;) {
        const bool has_next = S.next(ui + 1, nxt);
        const char* nA = has_next ? (const char*)g.A + (size_t)nxt.pm * tstep : cA; const char* nB = has_next ? (const char*)g.Bt + (size_t)nxt.pn * tstep : cB;
        for (int t = 0; t < nt; t += 2) { LA_G;
            const bool last = (t == nt - 2);
            if constexpr (Epi::HAS_PRE) { if (last) E.pre(cur, wr, wc, fr, fq, epre); }
            const char* a1 = cA + (size_t)(t + 1) * kstep;
            const char* a2 = last ? nA : cA + (size_t)(t + 2) * kstep; const char* b2 = last ? nB : cB + (size_t)(t + 2) * kstep;
            const char* a3 = a2 + kstep; const char* b3 = b2 + kstep;
            if (last && has_next) S.a_ready(nxt);
            if constexpr (SP2) {
            PG8_LDB(B0, 0, 0); PG8_LDB(B1, 0, 1); PG8_SCHED; PG8_LDA(At, 0, 0); PG8_STAGE(PG8_SA(1, 1), a1 + hstep, voffA);
            PG8_WAIT_V(8); PG8_WAIT_L(0); PG8_BAR; PG8_MMA(0, 0, At, B0); PG8_MMA(0, 1, At, B1); PG8_BAR; PG8_SCHED;
            PG8_LDA(At, 0, 1); PG8_STAGE(PG8_SB(0, 0), b2, voffB); PG8_STAGE(PG8_SB(0, 1), b2 + hstep, voffB); PG8_STAGE(PG8_SA(0, 0), a2, voffA);
            PG8_WAIT_V(8); PG8_WAIT_L(0); PG8_BAR; PG8_MMA(1, 0, At, B0); PG8_MMA(1, 1, At, B1); PG8_BAR; PG8_SCHED;
            PG8_LDB(B0, 1, 0); PG8_LDB(B1, 1, 1); PG8_SCHED; PG8_LDA(At, 1, 0); PG8_STAGE(PG8_SA(0, 1), a2 + hstep, voffA);
            PG8_WAIT_V(8); PG8_WAIT_L(0); PG8_BAR; PG8_MMA(0, 0, At, B0); PG8_MMA(0, 1, At, B1); PG8_BAR; PG8_SCHED;
            PG8_LDA(At, 1, 1); PG8_STAGE(PG8_SB(1, 0), b3, voffB); PG8_STAGE(PG8_SB(1, 1), b3 + hstep, voffB); PG8_STAGE(PG8_SA(1, 0), a3, voffA);
            PG8_WAIT_V(8); PG8_WAIT_L(0); PG8_BAR; PG8_MMA(1, 0, At, B0); PG8_MMA(1, 1, At, B1); PG8_BAR; PG8_SCHED;
            } else {
            PG8_LDB(B0, 0, 0); PG8_SCHED; PG8_LDA(At, 0, 0); PG8_STAGE(PG8_SA(1, 1), a1 + hstep, voffA);
            PG8_WAIT_L(8); PG8_BAR; PG8_WAIT_L(0); PG8_MMA(0, 0, At, B0); PG8_BAR; PG8_SCHED;
            PG8_LDB(B1, 0, 1); PG8_STAGE(PG8_SB(0, 0), b2, voffB);
            PG8_BAR; PG8_WAIT_L(0); PG8_MMA(0, 1, At, B1); PG8_BAR;
            PG8_LDA(At, 0, 1); PG8_STAGE(PG8_SA(0, 0), a2, voffA);
            PG8_BAR; PG8_WAIT_L(0); PG8_MMA(1, 0, At, B0); PG8_BAR; PG8_SCHED;
            PG8_STAGE(PG8_SB(0, 1), b2 + hstep, voffB);
            PG8_WAIT_V(6); PG8_BAR; PG8_MMA(1, 1, At, B1); PG8_BAR;
            PG8_LDB(B0, 1, 0); PG8_SCHED; PG8_LDA(At, 1, 0); PG8_STAGE(PG8_SA(0, 1), a2 + hstep, voffA);
            PG8_WAIT_L(8); PG8_BAR; PG8_WAIT_L(0); PG8_MMA(0, 0, At, B0); PG8_BAR; PG8_SCHED;
            PG8_LDB(B1, 1, 1); PG8_STAGE(PG8_SB(1, 0), b3, voffB);
            PG8_BAR; PG8_WAIT_L(0); PG8_MMA(0, 1, At, B1); PG8_BAR;
            PG8_LDA(At, 1, 1); PG8_STAGE(PG8_SA(1, 0), a3, voffA);
            PG8_BAR; PG8_WAIT_L(0); PG8_MMA(1, 0, At, B0); PG8_BAR; PG8_SCHED;
            PG8_STAGE(PG8_SB(1, 1), b3 + hstep, voffB);
            PG8_WAIT_V(6); PG8_BAR; PG8_MMA(1, 1, At, B1); PG8_BAR;
            }
        }
        if constexpr (F8) asm volatile("s_nop 15\n\ts_nop 15" ::: "memory");
        if constexpr (ALIGN_EPI) { if (wr == 0) PG8_BAR; }
        if constexpr (!Epi::AFTER_DRAIN) { if constexpr (Epi::HAS_PRE) E(acc, cur, wr, wc, fr, fq, epre); else if constexpr (Epi::WANTS_PRE) { E.pre(cur, wr, wc, fr, fq, epre); E(acc, cur, wr, wc, fr, fq, epre); } else E(acc, cur, wr, wc, fr, fq); S.done(cur); }
        if (!has_next) break;
#pragma unroll
        for (int a = 0; a < 2; ++a)
#pragma unroll
            for (int b = 0; b < 2; ++b)
#pragma unroll
                for (int m = 0; m < 4; ++m)
#pragma unroll
                    for (int n = 0; n < 2; ++n) acc[a][b][m][n] = (f32x4){0.f, 0.f, 0.f, 0.f};
        cur = nxt; cA = nA; cB = nB; ++ui;
        if constexpr (ALIGN_EPI) { if (wr == 1) PG8_BAR; }
    }
    PG8_WAIT_V(0);
    if constexpr (!ALIGN_EPI) { if (wr == 0) PG8_BAR; }
    PG8_BAR;
    if constexpr (Epi::AFTER_DRAIN) { E.fused(acc, cur, wr, wc, fr, fq, lds, wid, lane); S.done(cur); }
#undef PG8_SA
#undef PG8_SB
#undef PG8_STAGE
#undef PG8_LDA
#undef PG8_LDB
#undef PG8_MMA
#undef PG8_CAT
#undef PG8_WAIT_V
#undef PG8_WAIT_L
#undef PG8_BAR
#undef PG8_SCHED
}
}

constexpr int NWAVES = 8, GRID = 256;
constexpr int BATCH = 4, SEQ = 8192, DM = 1024, MTOK = BATCH * SEQ, DEPTH = 4;
constexpr int NA_SRC = 2120, NA_PAD = 2304, NB = 3072, FF = 2816, NUP = 2 * FF;
constexpr float EPS = 1e-6f;
constexpr float LOG2E = 1.4426950408889634f;
constexpr float C2 = 0.125f * LOG2E;
constexpr int NBLK64 = MTOK / 64;

constexpr size_t MiB = 1u << 20;
constexpr size_t WS_CTL = 0, CTL_ZERO_BYTES = 1 * MiB;
constexpr size_t WS_W_INA = 2 * MiB;
constexpr size_t WS_W_INB = 11 * MiB;
constexpr size_t WS_W_OUT = 23 * MiB;
constexpr size_t WS_W_UP = 31 * MiB;
constexpr size_t WS_W_DN = 75 * MiB;
constexpr size_t WS_HB = 98 * MiB;
constexpr size_t WS_M = 162 * MiB;
constexpr size_t WS_SS = 226 * MiB;
constexpr size_t WS_HALO = 228 * MiB;
constexpr size_t WS_PROJ = 272 * MiB;
constexpr size_t WS_W_INA8 = 464 * MiB;
constexpr size_t WS_END = 469 * MiB;
constexpr size_t PA_QA = 0, PA_KA = 64 * MiB, PA_VA = 80 * MiB, PA_QI = 96 * MiB, PA_KI = 128 * MiB, PA_WI = 132 * MiB, PA_SEL = 136 * MiB;
constexpr size_t PB_STRIDE = 64 * MiB;
constexpr int CW_BAR = 4096;
constexpr int F8_L0 = 2;
#ifndef F8M_IN
#define F8M_IN 0xF
#endif
#ifndef F8M_OUT
#define F8M_OUT 0xF
#endif
#ifndef F8M_FFN
#define F8M_FFN 0xC
#endif
#ifndef F8M_DN
#define F8M_DN 0x2
#endif
#define F8M_ALL ((F8M_IN & 0xF) | ((F8M_OUT & 0xF) << 4) | ((F8M_FFN & 0xF) << 8) | (((F8M_DN | F8M_FFN) & 0xF) << 12))
__host__ __device__ constexpr bool f8_in(int m, int L) { return L < DEPTH && ((m >> L) & 1) != 0; }
__host__ __device__ constexpr bool f8_out(int m, int L) { return ((m >> (4 + L)) & 1) != 0; }
__host__ __device__ constexpr bool f8_ffn(int m, int L) { return ((m >> (8 + L)) & 1) != 0; }
__host__ __device__ constexpr bool f8_dn(int m, int L) { return ((m >> (12 + L)) & 1) != 0; }
constexpr size_t PX_HB8 = 96 * MiB;
#ifndef W8SCALE
#define W8SCALE 128.f
#endif
constexpr float W8S = W8SCALE, W8I = 1.f / W8SCALE;

constexpr int RING_OFF = 0, RING_BYTES = 131072;
constexpr int KS_OFF = RING_BYTES;
constexpr int AUX_OFF = RING_BYTES + 24576;
constexpr int LDSCTL_OFF = AUX_OFF + 4096, MISC_OFF = LDSCTL_OFF + 320;
constexpr int LDS_BYTES = 163840;
static_assert(MISC_OFF + 128 <= LDS_BYTES, "LDS map");

#define GAS __attribute__((address_space(1)))
#define LAS __attribute__((address_space(3)))
typedef unsigned short bf16;
typedef unsigned v4u __attribute__((ext_vector_type(4)));
typedef unsigned v2u __attribute__((ext_vector_type(2)));
typedef float f32x4 __attribute__((ext_vector_type(4)));
typedef float f32x16 __attribute__((ext_vector_type(16)));
typedef short bf16x8 __attribute__((ext_vector_type(8)));
typedef short s16x4 __attribute__((ext_vector_type(4)));
typedef float f32x2_t __attribute__((ext_vector_type(2)));
typedef GAS unsigned gu32;
#define RLX_AGENT __ATOMIC_RELAXED, __HIP_MEMORY_SCOPE_AGENT
#define LDS_WAIT() asm volatile("s_waitcnt lgkmcnt(0)" ::: "memory")
#define VM_WAIT() asm volatile("s_waitcnt vmcnt(0)" ::: "memory")
__device__ __forceinline__ unsigned f2bf(float f) { unsigned u = __builtin_bit_cast(unsigned, f); return (u + 0x7fffu + ((u >> 16) & 1u)) >> 16; }
__device__ __forceinline__ unsigned pk2(float lo, float hi) { return f2bf(lo) | (f2bf(hi) << 16); }
typedef float f32x2c_t __attribute__((ext_vector_type(2))); typedef __bf16 bf16x2c_t __attribute__((ext_vector_type(2)));
__device__ __forceinline__ unsigned cvtpk(float lo, float hi) { const f32x2c_t v = {lo, hi}; const bf16x2c_t b = __builtin_convertvector(v, bf16x2c_t); return __builtin_bit_cast(unsigned, b); }
__device__ __forceinline__ float bf_lo(unsigned u) { return __builtin_bit_cast(float, u << 16); }
__device__ __forceinline__ float bf_hi(unsigned u) { return __builtin_bit_cast(float, u & 0xffff0000u); }

__device__ __forceinline__ unsigned pk4f8(float a, float b, float c, float d) { int r = __builtin_amdgcn_cvt_pk_fp8_f32(a, b, 0, false); r = __builtin_amdgcn_cvt_pk_fp8_f32(c, d, r, true); return (unsigned)r; }

#ifndef EPI_PRE_IN
#define EPI_PRE_IN true
#endif
#ifndef EPI_PRE_UP
#define EPI_PRE_UP true
#endif

#define XB_TMO      128
#define XB_XCNT(j)  (256  + 64 * (j))
#define XB_XSUB(j)  (1280 + 64 * (j))
#define XB_XGEN(j)  (2304 + 64 * (j))
#define XB_TOP      3328
#define XB_TOPGEN   3392
#define XCD_BAR_WORDS 3456
#define XB_SPIN_CAP (1u << 18)

__device__ __forceinline__ unsigned xb_ld(unsigned* p)              { return __hip_atomic_load(p, __ATOMIC_RELAXED, __HIP_MEMORY_SCOPE_AGENT); }
__device__ __forceinline__ unsigned xb_add(unsigned* p, unsigned v) { return __hip_atomic_fetch_add(p, v, __ATOMIC_RELAXED, __HIP_MEMORY_SCOPE_AGENT); }
__device__ __forceinline__ unsigned xb_xcc_id() { return (unsigned)__builtin_amdgcn_s_getreg((3 << 11) | 20) & 0xFu; }
#define XB_SPIN(cond, bar) do { unsigned _sp = 0; while (cond) { __builtin_amdgcn_s_sleep(1); \
    if ((++_sp & 255u) == 0u) { if (xb_ld(&(bar)[XB_TMO])) break; if (_sp > XB_SPIN_CAP) { atomicAdd(&(bar)[XB_TMO], 1u); break; } } } } while (0)

struct XcdBarrier {
    unsigned* bar; unsigned x;
    volatile LAS unsigned* st;
};

__device__ __forceinline__ XcdBarrier xcd_barrier_post(unsigned* bar, volatile LAS unsigned* st) {
    XcdBarrier b; b.bar = bar; b.x = xb_xcc_id(); b.st = st;
    if (threadIdx.x == 0) (void)xb_add(&bar[XB_XCNT(b.x)], 1u);
    return b;
}
__device__ __forceinline__ void xcd_barrier_complete(unsigned* bar, unsigned x, unsigned& nloc, unsigned& nx) {
    const unsigned G = gridDim.x * gridDim.y * gridDim.z;
    unsigned sum, cnt, mine, sp = 0u;
    for (;;) {
        sum = 0u; cnt = 0u; mine = 0u;
#pragma unroll
        for (unsigned j = 0; j < 16; ++j) { const unsigned c = xb_ld(&bar[XB_XCNT(j)]); sum += c; cnt += (c > 0u) ? 1u : 0u; mine = (j == x) ? c : mine; }
        if (sum == G) break;
        __builtin_amdgcn_s_sleep(1);
        if ((++sp & 255u) == 0u) { if (xb_ld(&bar[XB_TMO])) break; if (sp > XB_SPIN_CAP) { atomicAdd(&bar[XB_TMO], 1u); break; } }
    }
    nloc = mine > 0u ? mine : 1u; nx = cnt > 0u ? cnt : 1u;
}

__device__ __forceinline__ void xcd_barrier(const XcdBarrier& b) {
    asm volatile("s_waitcnt vmcnt(0)" ::: "memory");
    __syncthreads();
    if (threadIdx.x == 0) {
        unsigned* bar = b.bar;
        __builtin_amdgcn_s_waitcnt(0);
        unsigned nloc = b.st[0], nx = b.st[1];
        if (nloc == 0u) { xcd_barrier_complete(bar, b.x, nloc, nx); b.st[0] = nloc; b.st[1] = nx; }
        const unsigned old = xb_add(&bar[XB_XSUB(b.x)], 1u);
        const unsigned gen = old / nloc;
        if (old + 1u == (gen + 1u) * nloc) {
            __builtin_amdgcn_fence(__ATOMIC_RELEASE, "agent");
            asm volatile("s_waitcnt vmcnt(0)" ::: "memory");
            const unsigned og = xb_add(&bar[XB_TOP], 1u);
            const unsigned tg = og / nx;
            if (og + 1u == (tg + 1u) * nx) xb_add(&bar[XB_TOPGEN], 1u);
            else XB_SPIN(xb_ld(&bar[XB_TOPGEN]) == tg, bar);
            __builtin_amdgcn_fence(__ATOMIC_ACQUIRE, "agent");
            xb_add(&bar[XB_XGEN(b.x)], 1u);
            asm volatile("s_waitcnt vmcnt(0)" ::: "memory");
        } else {
            XB_SPIN(xb_ld(&bar[XB_XGEN(b.x)]) == gen, bar);
            __builtin_amdgcn_fence(__ATOMIC_ACQUIRE, "agent");
            asm volatile("s_waitcnt vmcnt(0)" ::: "memory");
        }
    }
    __syncthreads();
}


struct Args {
    const float* x; const float* attn_norm_g; const float* w_in_a; const float* w_in_b; const float* q_norm_g; const float* k_norm_g; const float* t5_bias;
    const float* rel_bias_b; const float* w_out; const float* ffn_norm_g; const float* w_up; const float* conv_w; const float* conv_b; const float* w_down;
    float* out; unsigned char* ws; int ph_lo, ph_hi, li, f8m;
};

struct Frame {
    LAS unsigned char* lds;
    volatile LAS unsigned* MISC;
    gu32* ctl;
    int tid, lane, wave, vcu, G;
};

__host__ __device__ __forceinline__ int hmap(int p) { return 64 * ((p >> 5) & 3) + 16 * ((p >> 2) & 3) + 8 * (p >> 7) + 4 * ((p >> 4) & 1) + (p & 3); }
__host__ __device__ __forceinline__ int umap(int p) { return 32 * ((p >> 5) & 3) + 8 * ((p >> 2) & 3) + 4 * ((p >> 4) & 1) + (p & 3); }
__host__ __device__ __forceinline__ int src_col(int type, int n) {
    if (type == 0) return n;
    const int pn = n >> 8, p = n & 255;
    if (type == 2) return 256 * pn + hmap(p);
    if (type == 1) { const int c = hmap(p); return pn < 8 ? 256 * pn + c : (c < 72 ? 2048 + c : -1); }
    return (p >> 7) * FF + 128 * pn + umap(p);
}
__device__ __forceinline__ void convert_item(const float* W, int K, int Nsrc, int Ndst, int type, const float* gain, bf16* WT, LAS float* scr, int item, int lane, bool o8 = false) {
    const int nblk = Ndst / 32, kb = item / nblk, nb = item % nblk, k0 = 64 * kb, n0 = 32 * nb;
    const int c4 = lane & 7, r8 = lane >> 3, sc = src_col(type, n0 + 4 * c4);
    f32x4 v[8]; float gn[8];
#pragma unroll
    for (int i = 0; i < 8; ++i) { const int kk = r8 + 8 * i; v[i] = (sc >= 0) ? *(const f32x4*)(W + (size_t)(k0 + kk) * Nsrc + sc) : (f32x4){0.f, 0.f, 0.f, 0.f}; gn[i] = gain ? gain[k0 + kk] : 1.0f; }
#pragma unroll
    for (int i = 0; i < 8; ++i) { const int kk = r8 + 8 * i; const f32x4 w = v[i] * gn[i]; LAS float* d = scr + kk * 33 + 4 * c4; d[0] = w.x; d[1] = w.y; d[2] = w.z; d[3] = w.w; }
    LDS_WAIT(); asm volatile("" ::: "memory");
    const int c = lane & 7;
#pragma unroll
    for (int j = 0; j < 4; ++j) { const int n = (lane >> 3) + 8 * j; const LAS float* s = scr + (8 * c) * 33 + n;
        if (o8) { v2u o; o.x = pk4f8(s[0 * 33] * W8S, s[1 * 33] * W8S, s[2 * 33] * W8S, s[3 * 33] * W8S); o.y = pk4f8(s[4 * 33] * W8S, s[5 * 33] * W8S, s[6 * 33] * W8S, s[7 * 33] * W8S);
            *(v2u*)((unsigned char*)WT + (size_t)(n0 + n) * K + k0 + 8 * c) = o; }
        else { v4u o; o.x = pk2(s[0 * 33], s[1 * 33]); o.y = pk2(s[2 * 33], s[3 * 33]); o.z = pk2(s[4 * 33], s[5 * 33]); o.w = pk2(s[6 * 33], s[7 * 33]);
            *(v4u*)(WT + (size_t)(n0 + n) * K + k0 + 8 * c) = o; } }
    LDS_WAIT(); asm volatile("" ::: "memory");
}
__device__ __forceinline__ float wave_sum(float v) {
#pragma unroll
    for (int o = 1; o < 64; o <<= 1) v += __shfl_xor(v, o);
    return v;
}
#ifdef F8M_RUNTIME
#define F8MV a.f8m
#else
#define F8MV F8M_ALL
#endif
__device__ __forceinline__ void p0_prologue(Frame& F, const Args& a) {
    LAS float* scr = (LAS float*)(F.lds + RING_OFF + F.wave * 16384);
    const int gw = F.vcu * NWAVES + F.wave, NGW = F.G * NWAVES;
    constexpr int I_INA = 16 * (NA_PAD / 32), I_INB = 16 * (NB / 32), I_OUT = 16 * 32, I_UP = 16 * (NUP / 32), I_DN = (FF / 64) * 32;
    constexpr int I_INA8 = 16 * (1536 / 32);
    constexpr int NITEMS = 2 * I_INA + 2 * I_INB + 4 * I_OUT + 4 * I_UP + 4 * I_DN + 2 * I_INA8;
    unsigned char* ws = a.ws;
    for (int it = gw; it < NITEMS; it += NGW) {
        int r = it;
        if (r < 2 * I_INA) { const int l = r / I_INA; convert_item(a.w_in_a + (size_t)l * DM * NA_SRC, DM, NA_SRC, NA_PAD, 1, a.attn_norm_g + (2 * l) * DM, (bf16*)(ws + WS_W_INA) + (size_t)l * NA_PAD * DM, scr, r % I_INA, F.lane); continue; } r -= 2 * I_INA;
        if (r < 2 * I_INB) { const int l = r / I_INB; convert_item(a.w_in_b + (size_t)l * DM * NB, DM, NB, NB, 2, a.attn_norm_g + (2 * l + 1) * DM, (bf16*)(ws + WS_W_INB) + (size_t)l * NB * DM, scr, r % I_INB, F.lane, f8_in(F8MV, 2 * l + 1)); continue; } r -= 2 * I_INB;
        if (r < 4 * I_OUT) { const int l = r / I_OUT; convert_item(a.w_out + (size_t)l * DM * DM, DM, DM, DM, 0, nullptr, (bf16*)(ws + WS_W_OUT) + (size_t)l * DM * DM, scr, r % I_OUT, F.lane, f8_out(F8MV, l)); continue; } r -= 4 * I_OUT;
        if (r < 4 * I_UP) { const int l = r / I_UP; convert_item(a.w_up + (size_t)l * DM * NUP, DM, NUP, NUP, 3, a.ffn_norm_g + l * DM, (bf16*)(ws + WS_W_UP) + (size_t)l * NUP * DM, scr, r % I_UP, F.lane, f8_ffn(F8MV, l)); continue; } r -= 4 * I_UP;
        if (r >= 4 * I_DN) { r -= 4 * I_DN; const int l = r / I_INA8, i8 = r % I_INA8; if (f8_in(F8MV, 2 * l)) convert_item(a.w_in_a + (size_t)l * DM * NA_SRC, DM, NA_SRC, NA_PAD, 1, a.attn_norm_g + (2 * l) * DM, (bf16*)(ws + WS_W_INA8 + (size_t)l * NA_PAD * DM), scr, (i8 / 48) * (NA_PAD / 32) + i8 % 48, F.lane, true); continue; }
        { const int l = r / I_DN; convert_item(a.w_down + (size_t)l * FF * DM, FF, DM, DM, 0, nullptr, (bf16*)(ws + WS_W_DN) + (size_t)l * DM * FF, scr, r % I_DN, F.lane, f8_dn(F8MV, l)); }
    }
    bf16* hb = (bf16*)(ws + WS_HB); float* ss = (float*)(ws + WS_SS);
    for (int m0 = gw; m0 < MTOK; m0 += 2 * NGW) {
        f32x4 v[2][4];
#pragma unroll
        for (int h = 0; h < 2; ++h) { const f32x4* xr = (const f32x4*)(a.x + (size_t)(m0 + h * NGW) * DM) + F.lane;
#pragma unroll
            for (int j = 0; j < 4; ++j) v[h][j] = xr[64 * j]; }
#pragma unroll
        for (int h = 0; h < 2; ++h) { const int m = m0 + h * NGW; float s = 0.f;
#pragma unroll
            for (int j = 0; j < 4; ++j) s += (v[h][j].x * v[h][j].x + v[h][j].y * v[h][j].y) + (v[h][j].z * v[h][j].z + v[h][j].w * v[h][j].w);
            s = wave_sum(s);
            v2u* o8 = (v2u*)(hb + (size_t)m * DM) + F.lane;
#pragma unroll
            for (int j = 0; j < 4; ++j) { v2u w; w.x = pk2(v[h][j].x, v[h][j].y); w.y = pk2(v[h][j].z, v[h][j].w); o8[64 * j] = w; }
            if (f8_in(F8MV, 0)) { unsigned* o4 = (unsigned*)(ws + WS_M + (size_t)m * DM) + F.lane;
#pragma unroll
                for (int j = 0; j < 4; ++j) o4[64 * j] = pk4f8(v[h][j].x, v[h][j].y, v[h][j].z, v[h][j].w); }
            if (F.lane < 16) ss[(size_t)m * 16 + F.lane] = (F.lane == 0) ? s : 0.f;
        }
    }
}

__device__ __forceinline__ f32x4 rstd_load(const float* ss, int row, int fq) { return *(const f32x4*)(ss + (size_t)row * 16 + 4 * fq); }
__device__ __forceinline__ float rstd_finish(f32x4 a) {
    float s = (a.x + a.y) + (a.z + a.w);
    s += __shfl_xor(s, 16); s += __shfl_xor(s, 32);
    return __builtin_amdgcn_rsqf(s * (1.0f / DM) + EPS);
}
__device__ __forceinline__ float row_rstd(const float* ss, int row, int fq) { return rstd_finish(rstd_load(ss, row, fq)); }
__device__ __forceinline__ unsigned att_pk4(f32x4 v) { int r = __builtin_amdgcn_cvt_pk_fp8_f32(v.x, v.y, 0, false); r = __builtin_amdgcn_cvt_pk_fp8_f32(v.z, v.w, r, true); return (unsigned)r; }
struct EpiIn {
    static constexpr bool PERM = false, PERMA = false, AFTER_DRAIN = false, HAS_PRE = EPI_PRE_IN, WANTS_PRE = true;
    const float* ss; unsigned char* proj; const float* qg; const float* kg; int isB; float as; int pn0;
    __device__ __forceinline__ void pre(const pg8::Unit& u, int wr, int wc, int fr, int fq, f32x4 (&rsl)[4]) const {
#pragma unroll
        for (int m = 0; m < 4; ++m) rsl[m] = rstd_load(ss, u.pm * 256 + wr * 64 + m * 16 + fr, fq);
    }
    __device__ __forceinline__ void operator()(const pg8::f32x4 (&acc)[2][2][4][2], const pg8::Unit& u, int wr, int wc, int fr, int fq, const f32x4 (&rslp)[4]) const {
        asm volatile("" : "+v"(fr), "+v"(fq));
        const int pn = u.pn + pn0; int kind, pitch; bf16* dst;
        if (isB) { const int t = pn >> 2; kind = (t == 0) ? 1 : (t == 1 ? 2 : 0); dst = (bf16*)(proj + (size_t)t * PB_STRIDE) + 256 * (pn & 3); pitch = DM; }
        else if (pn < 4) { kind = 1; dst = (bf16*)(proj + PA_QA) + 256 * pn; pitch = DM; }
        else if (pn == 4) { kind = 2; dst = (bf16*)(proj + PA_KA); pitch = 256; }
        else if (pn == 5) { kind = 0; dst = (bf16*)(proj + PA_VA); pitch = 256; }
        else if (pn < 8) { kind = 0; dst = (bf16*)(proj + PA_QI) + 256 * (pn - 6); pitch = 512; }
        else { kind = 3; dst = (bf16*)(proj + PA_KI); pitch = 64; }
        if (kind == 3 && wc >= 2) return;
        const bool donorm = (kind == 1) || (kind == 2) || (kind == 3 && wc == 0);
        f32x4 g[2][2];
#pragma unroll
        for (int bj = 0; bj < 2; ++bj)
#pragma unroll
            for (int n = 0; n < 2; ++n) {
                if (kind == 1) g[bj][n] = *(const f32x4*)(qg + 16 * fq + 8 * bj + 4 * n) * (isB ? C2 : 1.0f);
                else if (kind == 2) g[bj][n] = *(const f32x4*)(kg + 16 * fq + 8 * bj + 4 * n);
                else g[bj][n] = (f32x4){1.f, 1.f, 1.f, 1.f};
            }
        float* wi = (float*)(proj + PA_WI);
        f32x4 rsl[2][4];
#pragma unroll
        for (int m = 0; m < 4; ++m) { rsl[0][m] = rslp[m]; rsl[1][m] = rstd_load(ss, u.pm * 256 + 128 + wr * 64 + m * 16 + fr, fq); }
#pragma unroll
        for (int ai = 0; ai < 2; ++ai)
#pragma unroll
            for (int m = 0; m < 4; ++m) {
                const int row = u.pm * 256 + ai * 128 + wr * 64 + m * 16 + fr;
                const float rs = rstd_finish(rsl[ai][m]) * as;
                f32x4 v[2][2]; float s = 0.f;
#pragma unroll
                for (int bj = 0; bj < 2; ++bj)
#pragma unroll
                    for (int n = 0; n < 2; ++n) { v[bj][n] = acc[ai][bj][m][n] * rs; const f32x4 q = v[bj][n] * v[bj][n]; s += (q.x + q.y) + (q.z + q.w); }
                if (donorm) {
                    s += __shfl_xor(s, 16); s += __shfl_xor(s, 32);
                    const float r = 1.0f / sqrtf(s * (1.0f / 64.0f) + EPS);
#pragma unroll
                    for (int bj = 0; bj < 2; ++bj)
#pragma unroll
                        for (int n = 0; n < 2; ++n) v[bj][n] = v[bj][n] * r * g[bj][n];
                }
                if (kind == 3 && wc == 1) {
                    if (fq == 0) { float* wp = wi + (size_t)row * 8; const float sc = 0.04419417382415922f;
                        *(f32x4*)(wp) = v[0][0] * sc; *(f32x4*)(wp + 4) = v[0][1] * sc; }
                } else if (!isB && pn < 6) {
                    unsigned char* p8 = (pn < 4) ? proj + PA_QA + (size_t)row * 1024 + 256 * pn + 64 * wc + 16 * fq : proj + PA_KA + (size_t)row * 512 + 128 * wc + 64 * (pn - 4) + 16 * fq;
                    v4u w; w.x = att_pk4(v[0][0]); w.y = att_pk4(v[0][1]); w.z = att_pk4(v[1][0]); w.w = att_pk4(v[1][1]);
                    *(v4u*)p8 = w;
                } else {
                    bf16* rp = dst + (size_t)row * pitch + 64 * wc + 16 * fq;
#pragma unroll
                    for (int bj = 0; bj < 2; ++bj) { v4u w; w.x = cvtpk(v[bj][0].x, v[bj][0].y); w.y = cvtpk(v[bj][0].z, v[bj][0].w); w.z = cvtpk(v[bj][1].x, v[bj][1].y); w.w = cvtpk(v[bj][1].z, v[bj][1].w);
                        *(v4u*)(rp + 8 * bj) = w; }
                }
            }
    }
};
template <int MODE>
struct EpiResT {
    static constexpr bool PERM = false, PERMA = false, AFTER_DRAIN = false, HAS_PRE = false, WANTS_PRE = false;
    float* fout; const bf16* hbi; bf16* hb; float* ss; unsigned char* hb8; const float* xin;
    __device__ __forceinline__ void operator()(const pg8::f32x4 (&acc)[2][2][4][2], const pg8::Unit& u, int wr, int wc, int fr, int fq) const {
        if (fout) body<true, false, false>(acc, u, wr, wc, fr, fq); else if (hb8) body<false, true, false>(acc, u, wr, wc, fr, fq); else if (xin) body<false, false, true>(acc, u, wr, wc, fr, fq); else body<false, false, false>(acc, u, wr, wc, fr, fq);
    }
    template <bool FOUT, bool HB8, bool XIN>
    __device__ __forceinline__ void body(const pg8::f32x4 (&acc)[2][2][4][2], const pg8::Unit& u, int wr, int wc, int fr, int fq) const {
        asm volatile("" : "+v"(fr), "+v"(fq));
        const int col0 = u.pn * 256 + wc * 32 + 4 * fq;
#pragma unroll
        for (int ai = 0; ai < 2; ++ai) {
            v2u base[4][2][2]; f32x4 basex[XIN ? 4 : 1][2][2];
#pragma unroll
            for (int m = 0; m < 4; ++m)
#pragma unroll
                for (int bj = 0; bj < 2; ++bj)
#pragma unroll
                    for (int n = 0; n < 2; ++n) { const size_t o4 = (size_t)(u.pm * 256 + ai * 128 + wr * 64 + m * 16 + fr) * DM + col0 + bj * 128 + n * 16; if constexpr (XIN) basex[m][bj][n] = *(const f32x4*)(xin + o4); else base[m][bj][n] = *(const v2u*)(hbi + o4);
                        if ((MODE & 4) && n == 1) asm volatile("s_waitcnt vmcnt(0)" ::: "memory"); }
            asm volatile("" ::: "memory");
#pragma unroll
            for (int m = 0; m < 4; ++m) {
                const int row = u.pm * 256 + ai * 128 + wr * 64 + m * 16 + fr; const size_t off = (size_t)row * DM + col0; float s = 0.f;
#pragma unroll
                for (int bj = 0; bj < 2; ++bj)
#pragma unroll
                    for (int n = 0; n < 2; ++n) { const size_t o4 = off + bj * 128 + n * 16;
                        f32x4 bs; if constexpr (XIN) bs = basex[m][bj][n]; else { const v2u b = base[m][bj][n]; bs = (f32x4){bf_lo(b.x), bf_hi(b.x), bf_lo(b.y), bf_hi(b.y)}; }
                        const f32x4 o = (MODE & 1) ? bs + acc[ai][bj][m][n] * W8I : bs + acc[ai][bj][m][n];
                        if constexpr (FOUT) *(f32x4*)(fout + o4) = o;
                        else { const f32x4 q = o * o; s += (q.x + q.y) + (q.z + q.w); v2u w; w.x = cvtpk(o.x, o.y); w.y = cvtpk(o.z, o.w); *(v2u*)(hb + o4) = w;
                            if constexpr (HB8) *(unsigned*)(hb8 + o4) = pk4f8(o.x, o.y, o.z, o.w); } }
                if constexpr (!FOUT) { s += __shfl_xor(s, 16); s += __shfl_xor(s, 32); if (fq == 0) ss[(size_t)row * 16 + u.pn * 4 + wc] = s; }
            }
        }
    }
};
typedef EpiResT<0> EpiRes;
#ifndef SER_OUT
#define SER_OUT 0
#endif
#ifdef X_NOBPERM
__device__ __forceinline__ float lane_from(int byteaddr, float v) { return v + (float)byteaddr; }
#else
__device__ __forceinline__ float lane_from(int byteaddr, float v) { return __builtin_bit_cast(float, __builtin_amdgcn_ds_bpermute(byteaddr, __builtin_bit_cast(int, v))); }
#endif
#ifdef X_NOSILU
__device__ __forceinline__ float silu_mul(float a, float g) { return a * g; }
#else
__device__ __forceinline__ float silu_mul(float a, float g) { return a * g * __builtin_amdgcn_rcpf(1.0f + __builtin_amdgcn_exp2f(-g * LOG2E)); }
#endif
__device__ __forceinline__ float silu_mul2(float a, float g2) { return a * g2 * __builtin_amdgcn_rcpf(1.0f + __builtin_amdgcn_exp2f(-g2)); }
__device__ __forceinline__ float dpp_prev_lane(float v) { return __builtin_bit_cast(float, __builtin_amdgcn_update_dpp(0, __builtin_bit_cast(int, v), 0x111  , 0xf, 0xf, true)); }
__device__ __forceinline__ void up_rstd_table(const float* ss, LAS float* rl, int pm_a, int pm_b, int tid) {
    const int row = (tid < 256 ? pm_a : pm_b) * 256 + (tid & 255);
    const f32x4* p = (const f32x4*)(ss + (size_t)row * 16); const f32x4 a = p[0], b = p[1], c = p[2], d = p[3];
    const float s = (((a.x + a.y) + (a.z + a.w)) + ((b.x + b.y) + (b.z + b.w))) + (((c.x + c.y) + (c.z + c.w)) + ((d.x + d.y) + (d.z + d.w)));
    rl[tid] = __builtin_amdgcn_rsqf(s * (1.0f / DM) + EPS);
    asm volatile("s_waitcnt lgkmcnt(0)" ::: "memory"); __builtin_amdgcn_s_barrier(); asm volatile("" ::: "memory");
}
template <bool F8, bool O8 = F8>
struct EpiUpT {
    static constexpr bool PERM = false, PERMA = true, AFTER_DRAIN = false, HAS_PRE = false, WANTS_PRE = false;
    const float* ss; const float* cw; const float* cb; bf16* act; float* halo; LAS float* cl;
    __device__ __forceinline__ void operator()(const pg8::f32x4 (&acc)[2][2][4][2], const pg8::Unit& u, int wr, int wc, int fr, int fq) const {
        asm volatile("" : "+v"(fr), "+v"(fq));
        const int colb = u.pn * 128 + wc * 32 + 8 * fq;
        const int tid_ = ((wr * 4 + wc) * 4 + fq) * 16 + fr, ce = 2 * tid_, cbj = ce >> 9, carr = (ce >> 7) & 3, cc = ce & 127;
        const f32x2_t cpre = *(const f32x2_t*)((carr < 3 ? cw + carr * NUP : cb) + cbj * FF + u.pn * 128 + cc);
        f32x4 rs4[2];
#pragma unroll
        for (int ai = 0; ai < 2; ++ai) rs4[ai] = *(const LAS f32x4*)(cl - (AUX_OFF - KS_OFF) / 4 + ((u.pm >> 3) & 1) * 256 + (ai * 2 + wr) * 64 + 4 * fr);
        unsigned pk[2][2][4][2][2];
#pragma unroll
        for (int ai = 0; ai < 2; ++ai) {
#pragma unroll
            for (int m = 0; m < 4; ++m) {
                const float rs = F8 ? rs4[ai][m] * W8I : rs4[ai][m];
#pragma unroll
                for (int bj = 0; bj < 2; ++bj)
#pragma unroll
                    for (int n = 0; n < 2; ++n) { const f32x4 v = acc[ai][bj][m][n] * rs; pk[ai][bj][m][n][0] = cvtpk(v.x, v.y); pk[ai][bj][m][n][1] = cvtpk(v.z, v.w); }
            }
        }
        *(LAS f32x2_t*)(cl + ce) = cpre * (cbj ? LOG2E : 1.0f / LOG2E);
        asm volatile("s_waitcnt lgkmcnt(0)" ::: "memory"); __builtin_amdgcn_s_barrier(); asm volatile("" ::: "memory");
        __builtin_amdgcn_sched_barrier(0);
        if (fr == 0 || fr == 15) {
#pragma unroll
            for (int ai = 0; ai < 2; ++ai)
#pragma unroll
                for (int j = 0; j < 2; ++j)
#pragma unroll
                    for (int bj = 0; bj < 2; ++bj)
#pragma unroll
                        for (int n = 0; n < 2; ++n) { const unsigned w0 = (fr == 0) ? pk[ai][bj][j][n][0] : pk[ai][bj][2 + j][n][0], w1 = (fr == 0) ? pk[ai][bj][j][n][1] : pk[ai][bj][2 + j][n][1];
                            *(f32x4*)(halo + ((size_t)(u.pm * 4 + ai * 2 + wr) * 4 + (fr == 0 ? j : 2 + j)) * NUP + bj * FF + colb + 4 * n) = (f32x4){bf_lo(w0), bf_hi(w0), bf_lo(w1), bf_hi(w1)}; }
        }
        __builtin_amdgcn_sched_barrier(0);
#pragma unroll
        for (int ai = 0; ai < 2; ++ai) {
            const int row0 = (u.pm * 4 + ai * 2 + wr) * 64 + 4 * fr;
            unsigned outp[4][2][2];
#pragma unroll
            for (int n = 0; n < 2; ++n) {
#pragma unroll
                for (int ip = 0; ip < 2; ++ip) {
                    f32x2_t k0[2], k1[2], k2[2], kb[2];
#pragma unroll
                    for (int bj = 0; bj < 2; ++bj) { const LAS float* c = cl + bj * 512 + wc * 32 + 8 * fq + 4 * n + 2 * ip; k0[bj] = *(const LAS f32x2_t*)(c); k1[bj] = *(const LAS f32x2_t*)(c + 128); k2[bj] = *(const LAS f32x2_t*)(c + 256); kb[bj] = *(const LAS f32x2_t*)(c + 384); }
                    float y[2][4][2];
#pragma unroll
                    for (int bj = 0; bj < 2; ++bj) {
                        const unsigned w0 = pk[ai][bj][0][n][ip], w1 = pk[ai][bj][1][n][ip], w2 = pk[ai][bj][2][n][ip], w3 = pk[ai][bj][3][n][ip];
                        const unsigned q1 = (unsigned)__builtin_amdgcn_update_dpp(0, (int)w3, 0x111, 0xf, 0xf, true), q2 = (unsigned)__builtin_amdgcn_update_dpp(0, (int)w2, 0x111, 0xf, 0xf, true);
#pragma unroll
                        for (int e = 0; e < 2; ++e) { const int i = e;
                            const float u0 = e ? bf_hi(w0) : bf_lo(w0), u1 = e ? bf_hi(w1) : bf_lo(w1), u2 = e ? bf_hi(w2) : bf_lo(w2), u3 = e ? bf_hi(w3) : bf_lo(w3), p1 = e ? bf_hi(q1) : bf_lo(q1), p2 = e ? bf_hi(q2) : bf_lo(q2);
                            y[bj][0][e] = kb[bj][i] + k0[bj][i] * p2 + k1[bj][i] * p1 + k2[bj][i] * u0;
                            y[bj][1][e] = kb[bj][i] + k0[bj][i] * p1 + k1[bj][i] * u0 + k2[bj][i] * u1;
                            y[bj][2][e] = kb[bj][i] + k0[bj][i] * u0 + k1[bj][i] * u1 + k2[bj][i] * u2;
                            y[bj][3][e] = kb[bj][i] + k0[bj][i] * u1 + k1[bj][i] * u2 + k2[bj][i] * u3; }
                    }
#pragma unroll
                    for (int m = 0; m < 4; ++m) {
                        if constexpr (O8) { if (ip == 0) outp[m][n][0] = (unsigned)__builtin_amdgcn_cvt_pk_fp8_f32(silu_mul2(y[0][m][0], y[1][m][0]), silu_mul2(y[0][m][1], y[1][m][1]), 0, false);
                            else outp[m][n][0] = (unsigned)__builtin_amdgcn_cvt_pk_fp8_f32(silu_mul2(y[0][m][0], y[1][m][0]), silu_mul2(y[0][m][1], y[1][m][1]), (int)outp[m][n][0], true); }
                        else outp[m][n][ip] = cvtpk(silu_mul2(y[0][m][0], y[1][m][0]), silu_mul2(y[0][m][1], y[1][m][1])); }
                }
            }
#pragma unroll
            for (int m = 0; m < 4; ++m) {
                if (m < 2 && fr == 0) continue;
                if constexpr (O8) { v2u w; w.x = outp[m][0][0]; w.y = outp[m][1][0]; *(v2u*)((unsigned char*)act + (size_t)(row0 + m) * FF + colb) = w; }
                else { v4u w; w.x = outp[m][0][0]; w.y = outp[m][0][1]; w.z = outp[m][1][0]; w.w = outp[m][1][1];
                    *(v4u*)(act + (size_t)(row0 + m) * FF + colb) = w; }
            }
            asm volatile("" ::: "memory");
        }
    }
};
typedef EpiUpT<false> EpiUp;
struct EpiDummy {
    static constexpr bool PERM = false, PERMA = true, AFTER_DRAIN = false, HAS_PRE = false, WANTS_PRE = false;
    float* scratch;
    __device__ __forceinline__ void operator()(const pg8::f32x4 (&acc)[2][2][4][2], const pg8::Unit& u, int wr, int wc, int fr, int fq) const {
        f32x4 s = (f32x4){0.f, 0.f, 0.f, 0.f};
#pragma unroll
        for (int ai = 0; ai < 2; ++ai)
#pragma unroll
            for (int bj = 0; bj < 2; ++bj)
#pragma unroll
                for (int m = 0; m < 4; ++m)
#pragma unroll
                    for (int n = 0; n < 2; ++n) s += acc[ai][bj][m][n];
        scratch[(size_t)(u.pm * 22 + u.pn) * 512 + ((wr * 4 + wc) * 4 + fq) * 16 + fr] = (s.x + s.y) + (s.z + s.w);
    }
};
template <bool F8>
__device__ __forceinline__ void fixup_phase(Frame& F, const float* cw, const float* cb, const float* halo, bf16* act) {
    const int gt = F.vcu * (NWAVES * 64) + F.tid, NT = F.G * NWAVES * 64;
    constexpr int C4 = FF / 4;
    for (int it = gt; it < NBLK64 * 2 * C4; it += NT) {
        const int c = (it % C4) * 4, rj = it / C4, j = rj & 1, blk = rj >> 1, t = blk * 64 + j, tb = t % SEQ;
        f32x4 y[2];
#pragma unroll
        for (int bj = 0; bj < 2; ++bj) {
            const int cc = bj * FF + c;
            const f32x4 z = (f32x4){0.f, 0.f, 0.f, 0.f};
            const f32x4 ut = *(const f32x4*)(halo + ((size_t)blk * 4 + j) * NUP + cc);
            f32x4 u1, u2;
            if (j == 1) { u1 = *(const f32x4*)(halo + ((size_t)blk * 4 + 0) * NUP + cc); u2 = (tb == 1) ? z : *(const f32x4*)(halo + ((size_t)(blk - 1) * 4 + 3) * NUP + cc); }
            else { u1 = (tb == 0) ? z : *(const f32x4*)(halo + ((size_t)(blk - 1) * 4 + 3) * NUP + cc); u2 = (tb == 0) ? z : *(const f32x4*)(halo + ((size_t)(blk - 1) * 4 + 2) * NUP + cc); }
            y[bj] = *(const f32x4*)(cb + cc) + *(const f32x4*)(cw + cc) * u2 + *(const f32x4*)(cw + NUP + cc) * u1 + *(const f32x4*)(cw + 2 * NUP + cc) * ut;
        }
        if constexpr (F8) *(unsigned*)((unsigned char*)act + (size_t)t * FF + c) = pk4f8(silu_mul(y[0].x, y[1].x), silu_mul(y[0].y, y[1].y), silu_mul(y[0].z, y[1].z), silu_mul(y[0].w, y[1].w));
        else { v2u w; w.x = cvtpk(silu_mul(y[0].x, y[1].x), silu_mul(y[0].y, y[1].y)); w.y = cvtpk(silu_mul(y[0].z, y[1].z), silu_mul(y[0].w, y[1].w));
            *(v2u*)(act + (size_t)t * FF + c) = w; }
    }
}

__device__ __forceinline__ int crow(int r, int hi) { return (r & 3) + 8 * (r >> 2) + 4 * hi; }
__device__ __forceinline__ void glds16(const void* gsrc, unsigned lds_dst) { unsigned keep;
    asm volatile("s_mov_b32 %0, m0\n\ts_mov_b32 m0, %2\n\ts_nop 0\n\tglobal_load_lds_dwordx4 %1, off\n\ts_mov_b32 m0, %0" : "=&s"(keep) : "v"(gsrc), "s"(lds_dst) : "memory"); }
__device__ __forceinline__ float max3f(float a, float b, float c) { return fmaxf(fmaxf(a, b), c); }

namespace band {
constexpr int SLOTB = 8192, NSLOT = 4;
constexpr int LDS_K = 0, LDS_V = NSLOT * SLOTB, LDS_WS = 2 * NSLOT * SLOTB, LDS_TB = LDS_WS + NWAVES * 64 * 4, LDS_OST = LDS_TB + 640 * 4 + 512, LDS_END = LDS_OST + NWAVES * 4096;
static_assert(LDS_END <= RING_BYTES, "band LDS");
__device__ __forceinline__ void unit(Frame& F, int b, int h, int U, const bf16* Q, const bf16* K, const bf16* V, bf16* O, const float* rel, const bool o8) {
    const int tid = F.tid, lane = F.lane, r32 = lane & 31, hi = lane >> 5, wid = F.wave;
    LAS unsigned char* shm = F.lds + RING_OFF;
    const unsigned lds0 = (unsigned)(uintptr_t)shm;
    const long rowbase = (long)b * SEQ; const int q0 = U * 256, c0 = 4 * U, cq = c0 + (wid >> 1);
    const bf16* Qw = Q + (rowbase + q0 + wid * 32) * DM + h * 64;
    const bf16* Kh = K + rowbase * DM + h * 64; const bf16* Vh = V + rowbase * DM + h * 64;
    LAS float* wsf = (LAS float*)(shm + LDS_WS) + wid * 64;
    LAS float* tb = (LAS float*)(shm + LDS_TB);
    const bf16* ksrc = Kh + (long)lane * DM + wid * 8;
    const bf16* vsrc = Vh + (long)(16 * (wid & 3) + (lane >> 2)) * DM + (wid >> 2) * 32 + (lane & 3) * 8;
    const unsigned kdst = lds0 + LDS_K + wid * 1024, vdst = lds0 + LDS_V + wid * 1024;
    const int lo = (c0 - 8 > 0) ? c0 - 8 : 0, hiT = c0 + 3, NT = hiT - lo + 1, t0 = (c0 - 5 > 0) ? c0 - 5 : 0;
#define BAND_KT(i) ((t0 + (i) <= hiT) ? t0 + (i) : lo + (t0 + (i) - hiT - 1))
#define BAND_LOAD(i) do { const int kt_ = BAND_KT(i); const unsigned so_ = (unsigned)((i) & (NSLOT - 1)) * SLOTB; \
        glds16(ksrc + (long)kt_ * 64 * DM, (unsigned)__builtin_amdgcn_readfirstlane(kdst + so_)); glds16(vsrc + (long)kt_ * 64 * DM, (unsigned)__builtin_amdgcn_readfirstlane(vdst + so_)); } while (0)
    for (int i = tid; i < 640; i += NWAVES * 64) { int d = i - 64; d = d < -256 ? -256 : (d > 256 ? 256 : d); tb[i] = rel[(d + 256) * 16 + h] * LOG2E; }
    BAND_LOAD(0); if (NT > 1) BAND_LOAD(1);
    bf16x8 qr[4];
#pragma unroll
    for (int d0 = 0; d0 < 4; ++d0) qr[d0] = *(const bf16x8*)(Qw + (long)r32 * DM + d0 * 16 + hi * 8);
    float m_run = -INFINITY, l_run = 0.f; f32x16 o[2]; o[0] = f32x16{}; o[1] = f32x16{};
    const int qpos = q0 + wid * 32 + r32;
    const LAS unsigned char* vbase = shm + LDS_V + ((lane >> 4) & 1) * 32 + (lane & 3) * 8 + (4 * hi + ((lane & 15) >> 2)) * 64;
    auto qk = [&](int so, f32x16& pa, f32x16& pb) {
        const LAS unsigned char* kb = shm + LDS_K + so + hi * 1024 + r32 * 16;
#pragma unroll
        for (int d0 = 0; d0 < 4; ++d0) { const bf16x8 b0 = *(const LAS bf16x8*)(kb + d0 * 2048), b1 = *(const LAS bf16x8*)(kb + d0 * 2048 + 512);
            pa = __builtin_amdgcn_mfma_f32_32x32x16_bf16(b0, qr[d0], pa, 0, 0, 0); pb = __builtin_amdgcn_mfma_f32_32x32x16_bf16(b1, qr[d0], pb, 0, 0, 0); } };
    auto addbias = [&](int kt, f32x16& pa, f32x16& pb) {
        if (kt + 5 <= cq) { const float cbias = tb[639];
#pragma unroll
          for (int r = 0; r < 16; ++r) { pa[r] += cbias; pb[r] += cbias; } }
        else { const int ib = qpos - 64 * kt + 64 - 4 * hi;
#pragma unroll
          for (int r = 0; r < 16; ++r) { const int ix = ib - ((r & 3) + 8 * (r >> 2)); pa[r] += tb[ix]; pb[r] += tb[ix - 32]; } } };
    auto rescale = [&](float f) {
        if (!__all(f == 1.0f)) {
            if (hi == 0) wsf[r32] = f;
            LDS_WAIT();
#pragma unroll
            for (int r = 0; r < 16; ++r) { const float fr_ = wsf[crow(r, hi)]; o[0][r] *= fr_; o[1][r] *= fr_; }
        } };
    auto pv = [&](int so, const v4u (&pw)[4]) {
        const LAS unsigned char* vb = vbase + so;
#pragma unroll
        for (int d0 = 0; d0 < 2; ++d0)
#pragma unroll
            for (int ks = 0; ks < 4; ++ks) {
                const s16x4 vlo = __builtin_bit_cast(s16x4, __builtin_amdgcn_ds_read_tr16_b64_v4i16((LAS s16x4*)(vb + d0 * 4096 + ks * 1024)));
                const s16x4 vhi = __builtin_bit_cast(s16x4, __builtin_amdgcn_ds_read_tr16_b64_v4i16((LAS s16x4*)(vb + d0 * 4096 + ks * 1024 + 512)));
                const bf16x8 vf = (bf16x8){vlo[0], vlo[1], vlo[2], vlo[3], vhi[0], vhi[1], vhi[2], vhi[3]};
                o[d0] = __builtin_amdgcn_mfma_f32_32x32x16_bf16(__builtin_bit_cast(bf16x8, pw[ks]), vf, o[d0], 0, 0, 0);
            } };
    auto tile1 = [&](int kt, int so) {
        f32x16 p0 = f32x16{}, p1 = f32x16{};
        qk(so, p0, p1); addbias(kt, p0, p1);
        float rm = p0[0];
#pragma unroll
        for (int r = 0; r < 16; ++r) rm = max3f(rm, p0[r], p1[r]);
        { auto rr = __builtin_amdgcn_permlane32_swap(__float_as_uint(rm), __float_as_uint(rm), false, false); rm = fmaxf(__uint_as_float(rr[0]), __uint_as_float(rr[1])); }
        const float mnew = fmaxf(m_run, rm), f = __builtin_amdgcn_exp2f(m_run - mnew); m_run = mnew;
        float sacc = 0.f;
#pragma unroll
        for (int r = 0; r < 16; ++r) { p0[r] = __builtin_amdgcn_exp2f(p0[r] - mnew); p1[r] = __builtin_amdgcn_exp2f(p1[r] - mnew); sacc += p0[r] + p1[r]; }
        l_run = l_run * f + sacc;
        rescale(f);
        v4u pw[4];
        pw[0] = (v4u){cvtpk(p0[0], p0[1]), cvtpk(p0[2], p0[3]), cvtpk(p0[4], p0[5]), cvtpk(p0[6], p0[7])};
        pw[1] = (v4u){cvtpk(p0[8], p0[9]), cvtpk(p0[10], p0[11]), cvtpk(p0[12], p0[13]), cvtpk(p0[14], p0[15])};
        pw[2] = (v4u){cvtpk(p1[0], p1[1]), cvtpk(p1[2], p1[3]), cvtpk(p1[4], p1[5]), cvtpk(p1[6], p1[7])};
        pw[3] = (v4u){cvtpk(p1[8], p1[9]), cvtpk(p1[10], p1[11]), cvtpk(p1[12], p1[13]), cvtpk(p1[14], p1[15])};
        pv(so, pw); };
    auto tile2 = [&](int kta, int soa, int ktb, int sob) {
        f32x16 p0 = f32x16{}, p1 = f32x16{}, p2 = f32x16{}, p3 = f32x16{};
        qk(soa, p0, p1); qk(sob, p2, p3); addbias(kta, p0, p1); addbias(ktb, p2, p3);
        float rm = p0[0], rn = p2[0];
#pragma unroll
        for (int r = 0; r < 16; ++r) { rm = max3f(rm, p0[r], p1[r]); rn = max3f(rn, p2[r], p3[r]); }
        rm = fmaxf(rm, rn);
        { auto rr = __builtin_amdgcn_permlane32_swap(__float_as_uint(rm), __float_as_uint(rm), false, false); rm = fmaxf(__uint_as_float(rr[0]), __uint_as_float(rr[1])); }
        const float mnew = fmaxf(m_run, rm), f = __builtin_amdgcn_exp2f(m_run - mnew); m_run = mnew;
        float sacc = 0.f, sacd = 0.f;
#pragma unroll
        for (int r = 0; r < 16; ++r) { p0[r] = __builtin_amdgcn_exp2f(p0[r] - mnew); p1[r] = __builtin_amdgcn_exp2f(p1[r] - mnew); sacc += p0[r] + p1[r];
            p2[r] = __builtin_amdgcn_exp2f(p2[r] - mnew); p3[r] = __builtin_amdgcn_exp2f(p3[r] - mnew); sacd += p2[r] + p3[r]; }
        l_run = l_run * f + (sacc + sacd);
        rescale(f);
        v4u pw[4], px[4];
        pw[0] = (v4u){cvtpk(p0[0], p0[1]), cvtpk(p0[2], p0[3]), cvtpk(p0[4], p0[5]), cvtpk(p0[6], p0[7])};
        pw[1] = (v4u){cvtpk(p0[8], p0[9]), cvtpk(p0[10], p0[11]), cvtpk(p0[12], p0[13]), cvtpk(p0[14], p0[15])};
        pw[2] = (v4u){cvtpk(p1[0], p1[1]), cvtpk(p1[2], p1[3]), cvtpk(p1[4], p1[5]), cvtpk(p1[6], p1[7])};
        pw[3] = (v4u){cvtpk(p1[8], p1[9]), cvtpk(p1[10], p1[11]), cvtpk(p1[12], p1[13]), cvtpk(p1[14], p1[15])};
        px[0] = (v4u){cvtpk(p2[0], p2[1]), cvtpk(p2[2], p2[3]), cvtpk(p2[4], p2[5]), cvtpk(p2[6], p2[7])};
        px[1] = (v4u){cvtpk(p2[8], p2[9]), cvtpk(p2[10], p2[11]), cvtpk(p2[12], p2[13]), cvtpk(p2[14], p2[15])};
        px[2] = (v4u){cvtpk(p3[0], p3[1]), cvtpk(p3[2], p3[3]), cvtpk(p3[4], p3[5]), cvtpk(p3[6], p3[7])};
        px[3] = (v4u){cvtpk(p3[8], p3[9]), cvtpk(p3[10], p3[11]), cvtpk(p3[12], p3[13]), cvtpk(p3[14], p3[15])};
        pv(soa, pw); pv(sob, px); };
    const int NP = (NT + 1) >> 1;
    for (int ip = 0; ip < NP; ++ip) { LA_B;
        asm volatile("s_waitcnt vmcnt(0) lgkmcnt(0)\n\ts_barrier" ::: "memory");
        if (2 * ip + 2 < NT) BAND_LOAD(2 * ip + 2);
        if (2 * ip + 3 < NT) BAND_LOAD(2 * ip + 3);
        const int i0 = 2 * ip, i1 = 2 * ip + 1, kta = BAND_KT(i0), ktb = (i1 < NT) ? BAND_KT(i1) : -1000;
        const bool a0 = !(kta < cq - 8 || kta > cq), a1 = (i1 < NT) && !(ktb < cq - 8 || ktb > cq);
        const int soa = (i0 & (NSLOT - 1)) * SLOTB, sob = (i1 & (NSLOT - 1)) * SLOTB;
        if (a0 && a1) tile2(kta, soa, ktb, sob); else if (a0) tile1(kta, soa); else if (a1) tile1(ktb, sob);
    }
#undef BAND_LOAD
#undef BAND_KT
    { auto rr = __builtin_amdgcn_permlane32_swap(__float_as_uint(l_run), __float_as_uint(l_run), false, false); l_run = __uint_as_float(rr[0]) + __uint_as_float(rr[1]); }
    if (hi == 0) wsf[32 + r32] = l_run;
    LDS_WAIT();
    float rli[16];
#pragma unroll
    for (int r = 0; r < 16; ++r) rli[r] = __builtin_amdgcn_rcpf(wsf[32 + crow(r, hi)]);
    bf16* Ow = O + (rowbase + q0 + wid * 32) * DM + h * 64;
    { LAS bf16* stg = (LAS bf16*)(shm + LDS_OST) + wid * 2048;
#pragma unroll
      for (int r = 0; r < 16; ++r) { const int orow = crow(r, hi);
#pragma unroll
          for (int d0 = 0; d0 < 2; ++d0) stg[orow * 64 + d0 * 32 + r32] = (bf16)f2bf(o[d0][r] * rli[r]); }
      LDS_WAIT();
#pragma unroll
      for (int i = 0; i < 4; ++i) { const int row = i * 8 + (lane >> 3), ch = lane & 7; const v4u v = *(const LAS v4u*)(stg + row * 64 + ch * 8);
          if (o8) { v2u w; w.x = pk4f8(bf_lo(v.x), bf_hi(v.x), bf_lo(v.y), bf_hi(v.y)); w.y = pk4f8(bf_lo(v.z), bf_hi(v.z), bf_lo(v.w), bf_hi(v.w));
              *(v2u*)((unsigned char*)O + (rowbase + q0 + wid * 32 + row) * DM + h * 64 + ch * 8) = w; }
          else *(v4u*)(Ow + (long)row * DM + ch * 8) = v; } }
    asm volatile("s_waitcnt lgkmcnt(0)\n\ts_barrier" ::: "memory");
}
__device__ __forceinline__ void phase(Frame& F, const bf16* Q, const bf16* K, const bf16* V, bf16* O, const float* rel, const bool o8) {
    const int NU = BATCH * 16 * 32, per = (NU + F.G - 1) / F.G;
    for (int i = 0; i < per; ++i) { const int uid = F.vcu * per + i; if (uid >= NU) break; unit(F, uid >> 9, (uid >> 5) & 15, uid & 31, Q, K, V, O, rel, o8); }
}
}

namespace dsa {
__device__ __forceinline__ unsigned okey(float s) { const unsigned u = __float_as_uint(s + 0.0f); return (u & 0x80000000u) ? ~u : (u | 0x80000000u); }
struct Ctx { const bf16* QA; const bf16* KA; const bf16* VA; const bf16* QI; const bf16* KI; const float* WI; bf16* M; const LAS float* t5l; unsigned short* SEL; };

__device__ __forceinline__ void scan_hist(const LAS unsigned* hq, int lane, unsigned need, unsigned& bin, unsigned& above) {
    const LAS v4u* hp = (const LAS v4u*)hq + lane * 4;
    unsigned wds[16];
#pragma unroll
    for (int j = 0; j < 4; ++j) { const v4u t = hp[j]; wds[4 * j] = t.x; wds[4 * j + 1] = t.y; wds[4 * j + 2] = t.z; wds[4 * j + 3] = t.w; }
    unsigned tl = 0;
#pragma unroll
    for (int j = 0; j < 16; ++j) tl += (wds[j] & 0xffffu) + (wds[j] >> 16);
    unsigned suf = tl;
#pragma unroll
    for (int o = 1; o < 64; o <<= 1) { const unsigned v = __shfl_down(suf, o); if (lane + o < 64) suf += v; }
    const unsigned S = suf - tl;
    const bool cross = (S < need) && (need <= S + tl);
    unsigned c = S, bsel = 0, ab = 0; bool found = false;
#pragma unroll
    for (int k = 31; k >= 0; --k) { const unsigned cnt = (wds[k >> 1] >> (16 * (k & 1))) & 0xffffu; if (!found && c + cnt >= need) { bsel = 32 * lane + k; ab = c; found = true; } c += cnt; }
    const unsigned long long bal = __ballot(cross);
    const int src = bal ? __builtin_ctzll(bal) : 0;
    bin = __shfl(bsel, src); above = __shfl(ab, src);
}

__device__ __forceinline__ void attend(const Ctx& C, const LAS unsigned short* sq, int nvalid, long rowbase, long token, int tpos, int lane, int g0) {
    asm volatile("" : "+v"(lane));
    const int l15 = lane & 15, l4 = lane >> 4;
    int sidx[16];
#pragma unroll
    for (int ti = 0; ti < 16; ++ti) sidx[ti] = sq[ti * 16 + l15];
    unsigned bpk[4] = {0u, 0u, 0u, 0u};
#pragma unroll
    for (int ti = 0; ti < 16; ++ti) { const int rel = sidx[ti] - tpos, n = rel < 0 ? -rel : rel;
        const int bk = (rel > 0 ? 16 : 0) + (n < 8 ? n : 8 + (n >= 12) + (n >= 16) + (n >= 23) + (n >= 32) + (n >= 46) + (n >= 64) + (n >= 91));
        bpk[ti >> 2] |= (unsigned)bk << (8 * (ti & 3)); }
#pragma unroll 1
    for (int g = g0; g < g0 + 2; ++g) {
        const bf16* qp = C.QA + token * DM + (4 * g + (lane & 3)) * 64 + 8 * l4;
        const bf16x8 qf0 = *(const bf16x8*)qp, qf1 = *(const bf16x8*)(qp + 32);
        const bf16* kbase = C.KA + rowbase * 256 + g * 64 + 8 * l4;
        f32x4 S[16];
#pragma unroll
        for (int hh = 0; hh < 4; ++hh) {
            bf16x8 kf0[4], kf1[4];
#pragma unroll
            for (int j = 0; j < 4; ++j) { const bf16* kp = kbase + (long)sidx[hh * 4 + j] * 256; kf0[j] = *(const bf16x8*)kp; kf1[j] = *(const bf16x8*)(kp + 32); }
#pragma unroll
            for (int j = 0; j < 4; ++j) { const int ti = hh * 4 + j;
                f32x4 a = *(const LAS f32x4*)(C.t5l + ((bpk[hh] >> (8 * j)) & 255u) * 16 + 4 * g);
                asm volatile("v_mfma_f32_16x16x32_bf16 %0, %1, %2, %0" : "+v"(a) : "v"(qf0), "v"(kf0[j]));
                asm volatile("v_mfma_f32_16x16x32_bf16 %0, %1, %2, %0" : "+v"(a) : "v"(qf1), "v"(kf1[j]));
                S[ti] = a; }
            asm volatile("s_nop 15\n\ts_nop 7" : "+v"(S[hh * 4]), "+v"(S[hh * 4 + 1]), "+v"(S[hh * 4 + 2]), "+v"(S[hh * 4 + 3]));
        }
#pragma unroll
        for (int ti = 0; ti < 16; ++ti) if (ti * 16 >= nvalid) S[ti] = (f32x4){-INFINITY, -INFINITY, -INFINITY, -INFINITY};
        f32x4 mx = S[0];
#pragma unroll
        for (int ti = 1; ti < 16; ++ti) { mx.x = fmaxf(mx.x, S[ti].x); mx.y = fmaxf(mx.y, S[ti].y); mx.z = fmaxf(mx.z, S[ti].z); mx.w = fmaxf(mx.w, S[ti].w); }
#pragma unroll
        for (int o = 1; o < 16; o <<= 1) { mx.x = fmaxf(mx.x, __shfl_xor(mx.x, o)); mx.y = fmaxf(mx.y, __shfl_xor(mx.y, o)); mx.z = fmaxf(mx.z, __shfl_xor(mx.z, o)); mx.w = fmaxf(mx.w, __shfl_xor(mx.w, o)); }
        f32x4 ls = (f32x4){0.f, 0.f, 0.f, 0.f};
        unsigned P01[16], P23[16];
#pragma unroll
        for (int ti = 0; ti < 16; ++ti) { const float e0 = __builtin_amdgcn_exp2f(S[ti].x - mx.x), e1 = __builtin_amdgcn_exp2f(S[ti].y - mx.y), e2 = __builtin_amdgcn_exp2f(S[ti].z - mx.z), e3 = __builtin_amdgcn_exp2f(S[ti].w - mx.w);
            ls += (f32x4){e0, e1, e2, e3}; P01[ti] = cvtpk(e0, e1); P23[ti] = cvtpk(e2, e3); }
#pragma unroll
        for (int o = 1; o < 16; o <<= 1) { ls.x += __shfl_xor(ls.x, o); ls.y += __shfl_xor(ls.y, o); ls.z += __shfl_xor(ls.z, o); ls.w += __shfl_xor(ls.w, o); }
        float o_[4][16];
#pragma unroll
        for (int h = 0; h < 4; ++h)
#pragma unroll
            for (int d = 0; d < 16; ++d) o_[h][d] = 0.f;
        const bf16* vbase = C.VA + rowbase * 256 + g * 64 + 16 * l4;
#pragma unroll
        for (int hh = 0; hh < 4; ++hh) {
            v4u va[4], vb[4];
#pragma unroll
            for (int j = 0; j < 4; ++j) { const v4u* vp = (const v4u*)(vbase + (long)sidx[hh * 4 + j] * 256); va[j] = vp[0]; vb[j] = vp[1]; }
#pragma unroll
            for (int j = 0; j < 4; ++j) { const int ti = hh * 4 + j; const v4u v0 = va[j], v1 = vb[j];
                float vf[16];
                vf[0] = bf_lo(v0.x); vf[1] = bf_hi(v0.x); vf[2] = bf_lo(v0.y); vf[3] = bf_hi(v0.y); vf[4] = bf_lo(v0.z); vf[5] = bf_hi(v0.z); vf[6] = bf_lo(v0.w); vf[7] = bf_hi(v0.w);
                vf[8] = bf_lo(v1.x); vf[9] = bf_hi(v1.x); vf[10] = bf_lo(v1.y); vf[11] = bf_hi(v1.y); vf[12] = bf_lo(v1.z); vf[13] = bf_hi(v1.z); vf[14] = bf_lo(v1.w); vf[15] = bf_hi(v1.w);
                const float p0 = bf_lo(P01[ti]), p1 = bf_hi(P01[ti]), p2 = bf_lo(P23[ti]), p3 = bf_hi(P23[ti]);
#pragma unroll
                for (int d = 0; d < 16; ++d) { o_[0][d] += p0 * vf[d]; o_[1][d] += p1 * vf[d]; o_[2][d] += p2 * vf[d]; o_[3][d] += p3 * vf[d]; } }
        }
        float res[4];
#pragma unroll
        for (int h = 0; h < 4; ++h) {
            float a8[8], a4[4], a2[2];
            const bool b3 = (l15 & 8) != 0, b2 = (l15 & 4) != 0, b1 = (l15 & 2) != 0, b0 = (l15 & 1) != 0;
#pragma unroll
            for (int d = 0; d < 8; ++d) { const float keep = b3 ? o_[h][d + 8] : o_[h][d], send = b3 ? o_[h][d] : o_[h][d + 8]; a8[d] = keep + __shfl_xor(send, 8); }
#pragma unroll
            for (int d = 0; d < 4; ++d) { const float keep = b2 ? a8[d + 4] : a8[d], send = b2 ? a8[d] : a8[d + 4]; a4[d] = keep + __shfl_xor(send, 4); }
#pragma unroll
            for (int d = 0; d < 2; ++d) { const float keep = b1 ? a4[d + 2] : a4[d], send = b1 ? a4[d] : a4[d + 2]; a2[d] = keep + __shfl_xor(send, 2); }
            { const float keep = b0 ? a2[1] : a2[0], send = b0 ? a2[0] : a2[1]; res[h] = keep + __shfl_xor(send, 1); }
        }
        bf16* mp = C.M + token * DM + (4 * g) * 64 + lane;
        mp[0] = (bf16)f2bf(res[0] * __builtin_amdgcn_rcpf(ls.x)); mp[64] = (bf16)f2bf(res[1] * __builtin_amdgcn_rcpf(ls.y)); mp[128] = (bf16)f2bf(res[2] * __builtin_amdgcn_rcpf(ls.z)); mp[192] = (bf16)f2bf(res[3] * __builtin_amdgcn_rcpf(ls.w));
    }
}

constexpr int CAND_CAP = 256;
constexpr int SELKS_OFF = KS_OFF;
__device__ __forceinline__ float relu_i(float x) { const int i = __builtin_bit_cast(int, x); return __builtin_bit_cast(float, i > 0 ? i : 0); }
struct SelState { unsigned pre[4], need[4], cnt[4], tcnt[4]; };
__device__ __forceinline__ void tile_mfma(f32x16 (&acc)[2], const LAS unsigned char* kf, const int (&koff)[4], const bf16x8 (&qa)[4]) {
#pragma unroll
    for (int h2 = 0; h2 < 2; ++h2) { acc[h2] = f32x16{};
#pragma unroll
        for (int ks = 0; ks < 4; ++ks) { const bf16x8 kb = *(const LAS bf16x8*)(kf + koff[ks] + h2 * 4096); acc[h2] = __builtin_amdgcn_mfma_f32_32x32x16_bf16(qa[ks], kb, acc[h2], 0, 0, 0); } }
}
template <class ActionT>
__device__ __forceinline__ void tile_valu(const f32x16 (&acc)[2], const f32x2_t (&wp)[2][4], int kbase, ActionT&& act) {
#pragma unroll
    for (int h2 = 0; h2 < 2; ++h2) {
        f32x2_t sa = {0.f, 0.f}, sb = {0.f, 0.f};
#pragma unroll
        for (int jp = 0; jp < 4; ++jp) {
            const f32x2_t ra = {relu_i(acc[h2][2 * jp]), relu_i(acc[h2][2 * jp + 1])};
            const f32x2_t rb = {relu_i(acc[h2][8 + 2 * jp]), relu_i(acc[h2][8 + 2 * jp + 1])};
            sa = __builtin_elementwise_fma(ra, wp[0][jp], sa); sb = __builtin_elementwise_fma(rb, wp[1][jp], sb); }
        act(kbase + h2 * 32, (sa.x + sa.y) + 0.0f, (sb.x + sb.y) + 0.0f);
    }
}
constexpr int KSLOTS = 3;
__device__ __forceinline__ void wait_tile(int newer) {
    if (newer >= 4) asm volatile("s_waitcnt vmcnt(4) lgkmcnt(0)\n\ts_barrier" ::: "memory");
    else if (newer == 3) asm volatile("s_waitcnt vmcnt(3) lgkmcnt(0)\n\ts_barrier" ::: "memory");
    else if (newer == 2) asm volatile("s_waitcnt vmcnt(2) lgkmcnt(0)\n\ts_barrier" ::: "memory");
    else if (newer == 1) asm volatile("s_waitcnt vmcnt(1) lgkmcnt(0)\n\ts_barrier" ::: "memory");
    else asm volatile("s_waitcnt vmcnt(0) lgkmcnt(0)\n\ts_barrier" ::: "memory");
}
template <class ActionT>
__device__ __forceinline__ void tile_pass(Frame& F, const bf16* ksrc, unsigned kdst, const LAS unsigned char* kfr, const int (&koff)[4], int NT, const bf16x8 (&qa)[4], const f32x2_t (&wp)[2][4], ActionT&& act) {
    asm volatile("s_waitcnt lgkmcnt(0)\n\ts_barrier" ::: "memory");
    const int npre = NT < KSLOTS ? NT : KSLOTS;
    for (int j = 0; j < npre; ++j) glds16(ksrc + (long)j * 4096, (unsigned)__builtin_amdgcn_readfirstlane(kdst + j * 8192));
    wait_tile(npre - 1);
    f32x16 accA[2], accB[2];
    tile_mfma(accA, kfr, koff, qa);
    int sl = 0;
    int kt = 0;
    for (; kt + 2 < NT; kt += 2) { LA_S;
        { const int inflight = (NT - kt - 2) < (KSLOTS - 2) ? (NT - kt - 2) : (KSLOTS - 2); wait_tile(inflight); }
        if (kt + KSLOTS < NT) glds16(ksrc + (long)(kt + KSLOTS) * 4096, (unsigned)__builtin_amdgcn_readfirstlane(kdst + sl * 8192));
        sl = (sl == KSLOTS - 1) ? 0 : sl + 1;
        tile_mfma(accB, kfr + sl * 8192, koff, qa);
        tile_valu(accA, wp, kt * 64, act);
        { const int inflight = (NT - kt - 3) < (KSLOTS - 2) ? (NT - kt - 3) : (KSLOTS - 2); wait_tile(inflight); }
        if (kt + 1 + KSLOTS < NT) glds16(ksrc + (long)(kt + 1 + KSLOTS) * 4096, (unsigned)__builtin_amdgcn_readfirstlane(kdst + sl * 8192));
        sl = (sl == KSLOTS - 1) ? 0 : sl + 1;
        tile_mfma(accA, kfr + sl * 8192, koff, qa);
        tile_valu(accB, wp, (kt + 1) * 64, act);
    }
    if (kt + 1 < NT) {
        wait_tile(0);
        sl = (sl == KSLOTS - 1) ? 0 : sl + 1;
        tile_mfma(accB, kfr + sl * 8192, koff, qa);
        tile_valu(accA, wp, kt * 64, act);
        tile_valu(accB, wp, (kt + 1) * 64, act);
    } else tile_valu(accA, wp, kt * 64, act);
    LDS_WAIT();
}
__device__ __forceinline__ void scan_hist_cnt(const LAS unsigned* hq, int lane, unsigned need, unsigned& bin, unsigned& above, unsigned& bcnt) {
    const LAS v4u* hp = (const LAS v4u*)hq + lane * 2;
    unsigned wds[8];
#pragma unroll
    for (int j = 0; j < 2; ++j) { const v4u t = hp[j]; wds[4 * j] = t.x; wds[4 * j + 1] = t.y; wds[4 * j + 2] = t.z; wds[4 * j + 3] = t.w; }
    unsigned tl = 0;
#pragma unroll
    for (int j = 0; j < 8; ++j) tl += wds[j];
    unsigned suf = tl;
#pragma unroll
    for (int o = 1; o < 64; o <<= 1) { const unsigned v = __shfl_down(suf, o); if (lane + o < 64) suf += v; }
    const unsigned S = suf - tl;
    const bool cross = (S < need) && (need <= S + tl);
    unsigned c = S, bsel = 0, ab = 0, bc = 0; bool found = false;
#pragma unroll
    for (int k = 7; k >= 0; --k) { const unsigned cnt = wds[k]; if (!found && c + cnt >= need) { bsel = 8 * lane + k; ab = c; bc = cnt; found = true; } c += cnt; }
    const unsigned long long bal = __ballot(cross);
    const int src = bal ? __builtin_ctzll(bal) : 0;
    bin = __builtin_amdgcn_readfirstlane(__shfl(bsel, src)); above = __builtin_amdgcn_readfirstlane(__shfl(ab, src)); bcnt = __builtin_amdgcn_readfirstlane(__shfl(bc, src));
}
__device__ __forceinline__ void step(Frame& F, const Ctx& C, int b, int c, int half) {
    int lane_ = F.lane; asm volatile("" : "+v"(lane_));
    const int lane = lane_, r = lane & 31, hi = lane >> 5, wave = F.wave;
    LAS unsigned* hist = (LAS unsigned*)(F.lds + RING_OFF + wave * 16384);
    LAS unsigned short* sel = (LAS unsigned short*)hist;
    LAS unsigned* cand = hist + 2048;
    LAS unsigned* fbflag = (LAS unsigned*)(F.lds + AUX_OFF + 2048);
    const long rowbase = (long)b * SEQ;
    const int tq0 = 64 * c + 32 * half + 4 * wave;
    const int N = 64 * (c + 1), NT = c + 1;
    int nvalid = 256;
    if (N <= 256) {
        nvalid = N;
        for (int j = lane; j < 4 * 256; j += 64) sel[j] = (unsigned short)(((j & 255) < N) ? (j & 255) : 0);
    } else {
        const int aq = 2 * ((r >> 2) & 1) + (r >> 4), ah = 4 * ((r >> 3) & 1) + (r & 3);
        const bf16* qip = C.QI + (rowbase + tq0 + aq) * 512 + ah * 64 + 8 * hi;
        bf16x8 qa[4];
#pragma unroll
        for (int ks = 0; ks < 4; ++ks) qa[ks] = *(const bf16x8*)(qip + 16 * ks);
        f32x2_t wp[2][4];
#pragma unroll
        for (int t = 0; t < 2; ++t) { const float* wq = C.WI + (rowbase + tq0 + 2 * hi + t) * 8; const f32x4 w0 = *(const f32x4*)wq, w1 = *(const f32x4*)(wq + 4);
            wp[t][0] = (f32x2_t){w0.x, w0.y}; wp[t][1] = (f32x2_t){w0.z, w0.w}; wp[t][2] = (f32x2_t){w1.x, w1.y}; wp[t][3] = (f32x2_t){w1.z, w1.w}; }
        float Bq;
        { float ssq = 0.f;
#pragma unroll
          for (int ks = 0; ks < 4; ++ks)
#pragma unroll
              for (int e = 0; e < 8; ++e) { const float v = bf_lo((unsigned)(unsigned short)qa[ks][e]); ssq += v * v; }
          ssq += __shfl_xor(ssq, 32);
          float term = fabsf(C.WI[(rowbase + tq0 + aq) * 8 + ah]) * sqrtf(ssq);
          term += __shfl_xor(term, 1); term += __shfl_xor(term, 2); term += __shfl_xor(term, 8);
          Bq = term * 8.25f + 1e-20f; }
        const float B0 = __shfl(Bq, (hi << 2)), B1 = __shfl(Bq, (hi << 2) | 16);
        const float sc0 = 1024.0f / B0, sc1 = 1024.0f / B1;
        asm volatile("" :: "v"(qa[0]), "v"(qa[1]), "v"(qa[2]), "v"(qa[3]));
        asm volatile("" :: "v"(wp[0][0]), "v"(wp[0][1]), "v"(wp[0][2]), "v"(wp[0][3]), "v"(wp[1][0]), "v"(wp[1][1]), "v"(wp[1][2]), "v"(wp[1][3]), "v"(sc0), "v"(sc1));
        const bf16* ksrc = C.KI + rowbase * 64 + (long)(wave * 8 + (lane >> 3)) * 64 + ((lane & 7) ^ (lane >> 3)) * 8;
        const unsigned kdst = (unsigned)(uintptr_t)(F.lds + SELKS_OFF) + wave * 1024;
        const LAS unsigned char* kfr = F.lds + SELKS_OFF + r * 128;
        int koff[4];
#pragma unroll
        for (int ks = 0; ks < 4; ++ks) koff[ks] = ((2 * ks + hi) ^ (r & 7)) * 16;
        const unsigned below = (1u << r) - 1u;
        LAS v4u* hz = (LAS v4u*)hist;
        if (wave == 0 && lane == 0) *fbflag = 0u;
#pragma unroll
        for (int j = 0; j < 8; ++j) hz[j * 64 + lane] = (v4u){0u, 0u, 0u, 0u};
        tile_pass(F, ksrc, kdst, kfr, koff, NT, qa, wp, [&](int kbase, float s0, float s1) {
            const int b0 = (int)__builtin_amdgcn_fmed3f(__builtin_fmaf(s0, sc0, 256.0f), 0.0f, 511.0f), b1 = (int)__builtin_amdgcn_fmed3f(__builtin_fmaf(s1, sc1, 256.0f), 0.0f, 511.0f);
            __hip_atomic_fetch_add(hist + (2 * hi) * 512 + b0, 1u, __ATOMIC_RELAXED, __HIP_MEMORY_SCOPE_WORKGROUP);
            __hip_atomic_fetch_add(hist + (2 * hi + 1) * 512 + b1, 1u, __ATOMIC_RELAXED, __HIP_MEMORY_SCOPE_WORKGROUP);
        });
#ifdef PROBE_SKEL
        tile_pass(F, ksrc, kdst, kfr, koff, NT, qa, wp, [&](int kbase, float s0, float s1) { });
#endif
#ifdef PROBE_SCORE
        { float dsum = 0.f; tile_pass(F, ksrc, kdst, kfr, koff, NT, qa, wp, [&](int kbase, float s0, float s1) { dsum += s0 + s1; }); if (dsum == 12345.678f) hist[0] = 1u; }
#endif
        SelState st;
        unsigned tbin[4], bcn[4]; bool ovf = false;
#pragma unroll
        for (int ql = 0; ql < 4; ++ql) { unsigned above; scan_hist_cnt(hist + ql * 512, lane, 256u, tbin[ql], above, bcn[ql]); st.cnt[ql] = 0u; st.tcnt[ql] = 0u; st.need[ql] = 256u - above; st.pre[ql] = above;
            }
        unsigned cbase[4]; { unsigned a = 0u;
#pragma unroll
            for (int ql = 0; ql < 4; ++ql) { cbase[ql] = a; a += bcn[ql]; }
            ovf = a > (unsigned)(4 * CAND_CAP); }
        LDS_WAIT();
        if (ovf && lane == 0) *fbflag = 1u;
        asm volatile("s_waitcnt lgkmcnt(0)\n\ts_barrier" ::: "memory");
#ifdef PROBE_NOFB
        const bool fb = false;
#elif defined(PROBE_NOFB2)
        const bool fb = __builtin_amdgcn_readfirstlane((int)*fbflag) == 0x7fffffff;
#else
        const bool fb = __builtin_amdgcn_readfirstlane((int)*fbflag) != 0;
#endif
        if (!fb) {
            const int tb0 = (int)(hi ? tbin[2] : tbin[0]), tb1 = (int)(hi ? tbin[3] : tbin[1]); const unsigned cb0 = hi ? cbase[2] : cbase[0], cb1 = hi ? cbase[3] : cbase[1];
            tile_pass(F, ksrc, kdst, kfr, koff, NT, qa, wp, [&](int kbase, float s0, float s1) {
#pragma unroll
                for (int t = 0; t < 2; ++t) {
                    const float s = t ? s1 : s0; const int bin = (int)__builtin_amdgcn_fmed3f(__builtin_fmaf(s, (t ? sc1 : sc0), 256.0f), 0.0f, 511.0f), tb = t ? tb1 : tb0;
                    const bool gt = bin > tb, eq = bin == tb;
                    const unsigned long long mg = __ballot(gt), me = __ballot(eq);
                    const unsigned mgh = hi ? (unsigned)(mg >> 32) : (unsigned)mg, meh = hi ? (unsigned)(me >> 32) : (unsigned)me;
                    const unsigned pos = (hi ? st.cnt[2 + t] : st.cnt[t]) + __builtin_popcount(mgh & below);
                    sel[(gt && pos < 256u) ? (2 * hi + t) * 256 + pos : 3200 + lane] = (unsigned short)(kbase + r);
                    const unsigned cpos = (hi ? st.tcnt[2 + t] : st.tcnt[t]) + __builtin_popcount(meh & below);
                    { const unsigned slot = (t ? cb1 : cb0) + cpos; LAS unsigned* cp = hist + ((eq && slot < (unsigned)(4 * CAND_CAP)) ? 2048 + slot * 2 : 1700 + 2 * lane); cp[0] = okey(s); cp[1] = (unsigned)(kbase + r); }
                    st.cnt[t] += __builtin_popcount((unsigned)mg); st.cnt[2 + t] += __builtin_popcount((unsigned)(mg >> 32));
                    st.tcnt[t] += __builtin_popcount((unsigned)me); st.tcnt[2 + t] += __builtin_popcount((unsigned)(me >> 32));
                }
            });
#pragma unroll
            for (int ql = 0; ql < 4; ++ql) {
                const unsigned nc = bcn[ql], G = st.pre[ql], rq = st.need[ql];
                const LAS unsigned* cq = cand + cbase[ql] * 2;
                unsigned base = G; const unsigned long long lt = (1ull << lane) - 1ull;
                for (unsigned c0 = 0; c0 < nc; c0 += 256u) {
                    unsigned ki4[4], xi4[4], rk4[4];
#pragma unroll
                    for (int m = 0; m < 4; ++m) { const unsigned i = c0 + (unsigned)lane + 64u * m; ki4[m] = (i < nc) ? cq[2 * i] : 0u; xi4[m] = (i < nc) ? cq[2 * i + 1] : 0u; rk4[m] = 0u; }
                    for (unsigned j = 0; j < nc; ++j) { const unsigned kj = cq[2 * j];
#pragma unroll
                        for (int m = 0; m < 4; ++m) rk4[m] += (kj > ki4[m] || (kj == ki4[m] && j < c0 + (unsigned)lane + 64u * m)) ? 1u : 0u; }
#pragma unroll
                    for (int m = 0; m < 4; ++m) { const bool take = (c0 + (unsigned)lane + 64u * m < nc) && rk4[m] < rq; const unsigned long long mm = __ballot(take);
                        const unsigned pos = base + __builtin_popcountll(mm & lt); if (take && pos < 256u) sel[ql * 256 + pos] = (unsigned short)xi4[m]; base += __builtin_popcountll(mm); }
                }
            }
        } else {
#pragma unroll
            for (int ql = 0; ql < 4; ++ql) { st.pre[ql] = 0u; st.need[ql] = 256u; st.cnt[ql] = 0u; st.tcnt[ql] = 0u; }
#pragma unroll 1
            for (int lev = 0; lev < 4; ++lev) {
#pragma unroll
                for (int j = 0; j < 8; ++j) hz[j * 64 + lane] = (v4u){0u, 0u, 0u, 0u};
                const unsigned pre0 = hi ? st.pre[2] : st.pre[0], pre1 = hi ? st.pre[3] : st.pre[1];
                const int sh = (lev == 0) ? 23 : (lev == 1) ? 14 : (lev == 2) ? 5 : 0, wd = (lev == 3) ? 5 : 9;
                tile_pass(F, ksrc, kdst, kfr, koff, NT, qa, wp, [&](int kbase, float s0, float s1) {
                    const unsigned k0 = okey(s0), k1 = okey(s1);
                    const unsigned b0 = (k0 >> sh) & ((1u << wd) - 1u), b1 = (k1 >> sh) & ((1u << wd) - 1u);
                    const bool in0 = (lev == 0) || ((k0 >> (sh + wd)) == pre0), in1 = (lev == 0) || ((k1 >> (sh + wd)) == pre1);
                    if (in0) __hip_atomic_fetch_add(hist + (2 * hi) * 512 + b0, 1u, __ATOMIC_RELAXED, __HIP_MEMORY_SCOPE_WORKGROUP);
                    if (in1) __hip_atomic_fetch_add(hist + (2 * hi + 1) * 512 + b1, 1u, __ATOMIC_RELAXED, __HIP_MEMORY_SCOPE_WORKGROUP);
                });
#pragma unroll
                for (int ql = 0; ql < 4; ++ql) { unsigned bin, above, bc; scan_hist_cnt(hist + ql * 512, lane, st.need[ql], bin, above, bc);
                    st.pre[ql] = (st.pre[ql] << wd) | bin; st.need[ql] -= above; }
                LDS_WAIT();
            }
            const unsigned T0 = hi ? st.pre[2] : st.pre[0], T1 = hi ? st.pre[3] : st.pre[1], rq0 = hi ? st.need[2] : st.need[0], rq1 = hi ? st.need[3] : st.need[1];
            tile_pass(F, ksrc, kdst, kfr, koff, NT, qa, wp, [&](int kbase, float s0, float s1) {
#pragma unroll
                for (int t = 0; t < 2; ++t) {
                    const unsigned kk = okey(t ? s1 : s0), T = t ? T1 : T0, rq = t ? rq1 : rq0;
                    const bool gt = kk > T, eq = kk == T;
                    const unsigned long long me = __ballot(eq);
                    const unsigned meh = hi ? (unsigned)(me >> 32) : (unsigned)me;
                    const unsigned trank = (hi ? st.tcnt[2 + t] : st.tcnt[t]) + __builtin_popcount(meh & below);
                    const bool take = gt || (eq && trank < rq);
                    const unsigned long long mt = __ballot(take);
                    const unsigned mth = hi ? (unsigned)(mt >> 32) : (unsigned)mt;
                    const unsigned pos = (hi ? st.cnt[2 + t] : st.cnt[t]) + __builtin_popcount(mth & below);
                    if (take && pos < 256u) sel[(2 * hi + t) * 256 + pos] = (unsigned short)(kbase + r);
                    st.cnt[t] += __builtin_popcount((unsigned)mt); st.cnt[2 + t] += __builtin_popcount((unsigned)(mt >> 32));
                    st.tcnt[t] += __builtin_popcount((unsigned)me); st.tcnt[2 + t] += __builtin_popcount((unsigned)(me >> 32));
                }
            });
        }
    }
    LDS_WAIT();
    { const LAS v4u* s4 = (const LAS v4u*)sel; v4u* g4 = (v4u*)(C.SEL + (rowbase + tq0) * 256);
#pragma unroll
      for (int j = 0; j < 2; ++j) g4[j * 64 + lane] = s4[j * 64 + lane]; }
    LDS_WAIT();
}
__device__ __forceinline__ void phase(Frame& F, const Ctx& C) {
    for (int v = F.vcu; v < 256; v += F.G) {
        const int b = v >> 6, c = v & 63;
#pragma unroll 1
        for (int it = 0; it < 4; ++it) step(F, C, b, (it < 2) ? c : 127 - c, it & 1);
    }
}
__device__ __forceinline__ void attn_phase(Frame& F, const Ctx& C) {
    int lane = F.lane; asm volatile("" : "+v"(lane));
    LAS unsigned short* sq = (LAS unsigned short*)(F.lds + RING_OFF + F.wave * 16384);
    const int nx = F.G / 32;
    for (int x = F.vcu / 32; x < 8; x += nx) {
        const int b = x >> 1, g0 = 2 * (x & 1); const long rowbase = (long)b * SEQ;
        const int w = (F.vcu & 31) * NWAVES + F.wave;
#pragma unroll 1
        for (int t = w; t < SEQ; t += 32 * NWAVES) {
            { const v4u* g4 = (const v4u*)(C.SEL + (rowbase + t) * 256); if (lane < 32) ((LAS v4u*)sq)[lane] = g4[lane]; }
            LDS_WAIT();
            const int N = 64 * ((t >> 6) + 1), nvalid = N < 256 ? N : 256;
            attend(C, sq, nvalid, rowbase, rowbase + t, t, lane, g0);
            LDS_WAIT();
        }
    }
}
}

namespace att8 {
typedef int v2i __attribute__((ext_vector_type(2)));
typedef long l64x2 __attribute__((ext_vector_type(2)));
struct Ctx8 { const unsigned char* QA8; const unsigned char* KV8; const unsigned short* SEL; bf16* M; bool o8; };
constexpr int T2_OFF = KS_OFF, T2_BYTES = 155 * 16 * 4, SELL_OFF = KS_OFF + 10240;
static_assert(T2_BYTES <= 10240 && SELL_OFF + NWAVES * 1024 <= AUX_OFF, "attention LDS map");
__device__ __forceinline__ void mfma8(f32x4& acc, long a, long b) { asm volatile("v_mfma_f32_16x16x32_fp8_fp8 %0, %1, %2, %0" : "+v"(acc) : "v"(a), "v"(b)); }
__device__ __forceinline__ unsigned pk4_fp8(float a, float b, float c, float d) { int r = __builtin_amdgcn_cvt_pk_fp8_f32(a, b, 0, false); r = __builtin_amdgcn_cvt_pk_fp8_f32(c, d, r, true); return (unsigned)r; }

__device__ __forceinline__ void gld16(v4u& dst, const void* p) { asm volatile("global_load_dwordx4 %0, %1, off" : "=v"(dst) : "v"(p) : "memory"); }
__device__ __forceinline__ void gld16s(l64x2& dst, const void* sbase, unsigned off) { asm volatile("global_load_dwordx4 %0, %1, %2" : "=v"(dst) : "v"(off), "s"(sbase) : "memory"); }
__device__ __forceinline__ void glds16s(const void* sbase, unsigned off, unsigned lds_dst) { unsigned keep;
    asm volatile("s_mov_b32 %0, m0\n\ts_mov_b32 m0, %3\n\ts_nop 0\n\tglobal_load_lds_dwordx4 %1, %2\n\ts_mov_b32 m0, %0" : "=&s"(keep) : "v"(off), "s"(sbase), "s"(lds_dst) : "memory"); }
__device__ __forceinline__ void gld16(l64x2& dst, const void* p) { asm volatile("global_load_dwordx4 %0, %1, off" : "=v"(dst) : "v"(p) : "memory"); }
__device__ __forceinline__ void issue_kq(const Ctx8& C, const LAS unsigned short* sq, long rowbase, long token, int g, int l15, int l4, int h, l64x2 (&kr)[16], l64x2& qv) {
    const unsigned char* kvb = C.KV8 + rowbase * 512; const unsigned lo = (unsigned)(g * 128 + 16 * l4);
#pragma unroll
    for (int j = 0; j < 16; ++j) gld16s(kr[j], kvb, ((unsigned)sq[j * 16 + l15] << 9) + lo);
    gld16s(qv, C.QA8 + token * 1024, (unsigned)((4 * g + h) * 64 + 16 * l4));
}
__device__ __forceinline__ void issue_v_half(const Ctx8& C, const LAS unsigned short* sq, long rowbase, int g, int lane, unsigned vbase, int half) {
    const unsigned char* kvb = C.KV8 + rowbase * 512; const int kq = lane >> 2, p = lane & 3;
#pragma unroll
    for (int j = 0; j < 8; ++j) { const int ti = half * 8 + j; const unsigned key = sq[ti * 16 + kq]; const int x = ((kq >> 2) & 1) | ((ti & 1) << 1);
        glds16s(kvb, (key << 9) + (unsigned)(g * 128 + 64 + 16 * (p ^ x)), (unsigned)__builtin_amdgcn_readfirstlane(vbase + ti * 1024)); }
}
__device__ __forceinline__ void phase(Frame& F, const Ctx8& C, const float* t5) {
    int lane = F.lane; asm volatile("" : "+v"(lane));
    LAS float* T2 = (LAS float*)(F.lds + T2_OFF);
    for (int e = F.tid; e < 155 * 16; e += NWAVES * 64) { const int rel = (e >> 4) - 91, n = rel < 0 ? -rel : rel;
        const int bk = (rel > 0 ? 16 : 0) + (n < 8 ? n : 8 + (n >= 12) + (n >= 16) + (n >= 23) + (n >= 32) + (n >= 46) + (n >= 64) + (n >= 91));
        T2[e] = t5[bk * 16 + (e & 15)] * 8.0f; }
    __syncthreads();
    LAS unsigned short* sqb = (LAS unsigned short*)(F.lds + SELL_OFF + F.wave * 1024);
    LAS unsigned char* vreg = F.lds + RING_OFF + F.wave * 16384;
    const unsigned vbase = (unsigned)(uintptr_t)vreg;
    const int l15 = lane & 15, l4 = lane >> 4, h = l15 & 3;
    const int trk = 4 * l4 + ((l15 >> 1) & 3), trt = (l15 >> 3) & 1, xs = (l4 & 1) | (trt << 1);
    const int troff = trt * 1024 + trk * 64 + 8 * (l15 & 1);
    const int x = F.vcu / 32, b = x >> 1, g0 = 2 * (x & 1); const long rowbase = (long)b * SEQ;
    const int w = (F.vcu & 31) * NWAVES + F.wave;
    constexpr int NQ = SEQ / (32 * NWAVES), NI = 2 * NQ;
    if (lane < 32) { ((LAS v4u*)sqb)[lane] = ((const v4u*)(C.SEL + (rowbase + w) * 256))[lane]; ((LAS v4u*)(sqb + 256))[lane] = ((const v4u*)(C.SEL + (rowbase + w + 32 * NWAVES) * 256))[lane]; }
    LDS_WAIT();
    l64x2 kr[16], qv; v4u pf = (v4u){0u, 0u, 0u, 0u};
    issue_kq(C, sqb, rowbase, rowbase + w, g0, l15, l4, h, kr, qv);
    issue_v_half(C, sqb, rowbase, g0, lane, vbase, 0); issue_v_half(C, sqb, rowbase, g0, lane, vbase, 1);
    unsigned cib[16];
    f32x4 S[16];
#define ATT8_CIB(lst, tq) do { _Pragma("unroll") for (int ti = 0; ti < 16; ++ti) { const v2u i4 = *(const LAS v2u*)((lst) + ti * 16 + 4 * l4); \
            const int r0 = (int)(i4.x & 0xffffu) - (tq), r1 = (int)(i4.x >> 16) - (tq), r2 = (int)(i4.y & 0xffffu) - (tq), r3 = (int)(i4.y >> 16) - (tq); \
            const int c0 = min(max(r0, -91), 63) + 91, c1 = min(max(r1, -91), 63) + 91, c2 = min(max(r2, -91), 63) + 91, c3 = min(max(r3, -91), 63) + 91; \
            cib[ti] = (unsigned)c0 | ((unsigned)c1 << 8) | ((unsigned)c2 << 16) | ((unsigned)c3 << 24); } } while (0)
#define ATT8_BIAS(gg) do { _Pragma("unroll") for (int ti = 0; ti < 16; ++ti) { const unsigned cb = cib[ti]; \
            S[ti].x = T2[(cb & 255u) * 16 + 4 * (gg) + h]; S[ti].y = T2[((cb >> 8) & 255u) * 16 + 4 * (gg) + h]; S[ti].z = T2[((cb >> 16) & 255u) * 16 + 4 * (gg) + h]; S[ti].w = T2[(cb >> 24) * 16 + 4 * (gg) + h]; } } while (0)
    ATT8_CIB(sqb, w); ATT8_BIAS(g0);
#pragma unroll 1
    for (int idx = 0; idx < NI; ++idx) { LA_A;
        const int qn = idx >> 1, gi = idx & 1, g = g0 + gi, t = w + 32 * NWAVES * qn;
        const LAS unsigned short* sq = sqb + (qn & 1) * 256;
        const int nidx = (idx + 1 < NI) ? idx + 1 : idx, nq = nidx >> 1, ng = g0 + (nidx & 1), nt = w + 32 * NWAVES * nq;
        const LAS unsigned short* nsq = sqb + (nq & 1) * 256;
        if (gi == 1) { asm volatile("s_waitcnt vmcnt(34)" : "+v"(pf) :: "memory"); if (lane < 32) ((LAS v4u*)(sqb + (qn & 1) * 256))[lane] = pf; }
        { const int pq = (qn + 2 < NQ) ? qn + 2 : NQ - 1; gld16(pf, (const v4u*)(C.SEL + (rowbase + w + 32 * NWAVES * pq) * 256) + (lane & 31)); }
        if (idx == 0) asm volatile("s_waitcnt vmcnt(0)" : "+v"(qv), "+v"(kr[0]), "+v"(kr[1]), "+v"(kr[2]), "+v"(kr[3]), "+v"(kr[4]), "+v"(kr[5]), "+v"(kr[6]), "+v"(kr[7]), "+v"(kr[8]), "+v"(kr[9]), "+v"(kr[10]), "+v"(kr[11]), "+v"(kr[12]), "+v"(kr[13]), "+v"(kr[14]), "+v"(kr[15]) :: "memory");
        else asm volatile("s_waitcnt vmcnt(20)" : "+v"(qv), "+v"(kr[0]), "+v"(kr[1]), "+v"(kr[2]), "+v"(kr[3]), "+v"(kr[4]), "+v"(kr[5]), "+v"(kr[6]), "+v"(kr[7]), "+v"(kr[8]), "+v"(kr[9]), "+v"(kr[10]), "+v"(kr[11]), "+v"(kr[12]), "+v"(kr[13]), "+v"(kr[14]), "+v"(kr[15]) :: "memory");
        const int N = 64 * ((t >> 6) + 1), nvalid = N < 256 ? N : 256;
        const long q0 = qv.x, q1 = qv.y;
#pragma unroll
        for (int ti = 0; ti < 16; ++ti) {
            mfma8(S[ti], kr[ti].x, q0);
            mfma8(S[ti], kr[ti].y, q1); }
        asm volatile("s_nop 15\n\ts_nop 7" : "+v"(S[0]), "+v"(S[1]), "+v"(S[2]), "+v"(S[3]), "+v"(S[4]), "+v"(S[5]), "+v"(S[6]), "+v"(S[7]), "+v"(S[8]), "+v"(S[9]), "+v"(S[10]), "+v"(S[11]), "+v"(S[12]), "+v"(S[13]), "+v"(S[14]), "+v"(S[15]));
        issue_kq(C, nsq, rowbase, rowbase + nt, ng, l15, l4, h, kr, qv);
        if (nvalid < 256) {
#pragma unroll
            for (int ti = 0; ti < 16; ++ti) if (ti * 16 >= nvalid) S[ti] = (f32x4){-INFINITY, -INFINITY, -INFINITY, -INFINITY};
        }
        float mx = S[0].x;
#pragma unroll
        for (int ti = 0; ti < 16; ++ti) { mx = max3f(mx, S[ti].x, S[ti].y); mx = max3f(mx, S[ti].z, S[ti].w); }
        mx = fmaxf(mx, __shfl_xor(mx, 16)); mx = fmaxf(mx, __shfl_xor(mx, 32));
        const float mc = 8.0f - mx * C2; f32x2_t lsv = (f32x2_t){0.f, 0.f};
        long P8[8];
#pragma unroll
        for (int j = 0; j < 8; ++j) { float e[8];
#pragma unroll
            for (int q = 0; q < 4; ++q) { e[q] = __builtin_amdgcn_exp2f(__builtin_fmaf(S[2 * j][q], C2, mc)); e[4 + q] = __builtin_amdgcn_exp2f(__builtin_fmaf(S[2 * j + 1][q], C2, mc)); }
            lsv += ((f32x2_t){e[0], e[1]} + (f32x2_t){e[2], e[3]}) + ((f32x2_t){e[4], e[5]} + (f32x2_t){e[6], e[7]});
            const unsigned lo = pk4_fp8(e[0], e[1], e[2], e[3]), hi = pk4_fp8(e[4], e[5], e[6], e[7]);
            P8[j] = (long)(((unsigned long long)hi << 32) | lo); }
        float ls = lsv.x + lsv.y; ls += __shfl_xor(ls, 16); ls += __shfl_xor(ls, 32);
        if (gi == 1) ATT8_CIB(nsq, nt);
        ATT8_BIAS(ng);
        f32x4 D[4];
#pragma unroll
        for (int db = 0; db < 4; ++db) D[db] = (f32x4){0.f, 0.f, 0.f, 0.f};
#pragma unroll
        for (int hf = 0; hf < 2; ++hf) {
            asm volatile("s_waitcnt vmcnt(28)" ::: "memory");
#pragma unroll
            for (int j = 4 * hf; j < 4 * hf + 4; ++j)
#pragma unroll
                for (int db = 0; db < 4; ++db) {
                    const v2i vv = __builtin_amdgcn_ds_read_tr8_b64_v2i32((LAS v2i*)(vreg + j * 2048 + troff + 16 * (db ^ xs)));
                    mfma8(D[db], P8[j], __builtin_bit_cast(long, vv)); }
            asm volatile("s_waitcnt lgkmcnt(0)" ::: "memory");
            issue_v_half(C, nsq, rowbase, ng, lane, vbase, hf);
        }
        asm volatile("s_nop 15\n\ts_nop 7" : "+v"(D[0]), "+v"(D[1]), "+v"(D[2]), "+v"(D[3]));
        const float lh = __shfl(ls, l4);
        const float inv = __builtin_amdgcn_rcpf(lh);
        bf16* mp = C.M + (rowbase + t) * DM + (4 * g + l4) * 64 + l15;
#pragma unroll
        for (int db = 0; db < 4; ++db) { const float v = (l4 == 0) ? D[db].x : (l4 == 1) ? D[db].y : (l4 == 2) ? D[db].z : D[db].w;
            if (C.o8) { const unsigned o1 = (unsigned)__builtin_amdgcn_cvt_pk_fp8_f32(v * inv, 0.f, 0, false);
                asm volatile("global_store_byte %0, %1, off" :: "v"((unsigned char*)C.M + (rowbase + t) * DM + (4 * g + l4) * 64 + l15 + 16 * db), "v"(o1) : "memory"); }
            else { const unsigned short ob = (unsigned short)f2bf(v * inv);
                asm volatile("global_store_short %0, %1, off" :: "v"(mp + 16 * db), "v"((unsigned)ob) : "memory"); } }
    }
    asm volatile("s_waitcnt vmcnt(0)" ::: "memory");
}
#undef ATT8_CIB
#undef ATT8_BIAS
}

#ifndef REP_P0
#define REP_P0 1
#endif
#ifndef REP_IN
#define REP_IN 1
#endif
#ifndef REP_DSA
#define REP_DSA 1
#endif
#ifndef REP_BAND
#define REP_BAND 1
#endif
#ifndef REP_UP
#define REP_UP 1
#endif
#ifndef REP_FIX
#define REP_FIX 1
#endif
constexpr int N_PHASES = 1 + 6 * DEPTH;
#ifndef MK_N_LAUNCHES
#define MK_N_LAUNCHES 1
#endif
__global__ void __launch_bounds__(NWAVES * 64, 2) mega_fwd(Args args) {
    extern __shared__ __attribute__((aligned(16))) unsigned char lds[];
    Frame F;
    F.lds = (LAS unsigned char*)lds;
    F.MISC = (volatile LAS unsigned*)(F.lds + MISC_OFF);
    F.tid = threadIdx.x; F.lane = F.tid & 63; F.wave = __builtin_amdgcn_readfirstlane(F.tid >> 6);
    F.G = GRID; { const int bx = blockIdx.x; F.vcu = (bx & 7) * (GRID / 8) + (bx >> 3); }
    unsigned char* ws = args.ws;
    F.ctl = (gu32*)(ws + WS_CTL);
    for (int u = F.tid; u < (LDS_BYTES - LDSCTL_OFF) / 4; u += NWAVES * 64) ((LAS unsigned*)(F.lds + LDSCTL_OFF))[u] = 0u;
    __syncthreads();
    XcdBarrier bar; bar.bar = (unsigned*)(F.ctl + CW_BAR); bar.x = 0; bar.st = nullptr;
    if (MK_N_LAUNCHES == 1) bar = xcd_barrier_post((unsigned*)(F.ctl + CW_BAR), F.MISC + 8);
#ifdef F8M_RUNTIME
    const int lo = args.ph_lo, hi = args.ph_hi, f8m = args.f8m;
#else
    const int lo = args.ph_lo, hi = args.ph_hi; constexpr int f8m = F8M_ALL;
#ifdef PAD_NOPS
    asm volatile(".rept %0\n\ts_nop 0\n\t.endr" :: "n"(PAD_NOPS));
#endif
#endif
#define IN(k) (lo <= (k) && (k) < hi)
#define OPQ_FRAME(Fl) Frame Fl = F; { int l_; asm volatile("v_mbcnt_lo_u32_b32 %0, -1, 0\n\tv_mbcnt_hi_u32_b32 %0, -1, %0" : "=v"(l_)); int w_ = F.wave; asm volatile("" : "+s"(w_)); Fl.wave = w_; Fl.lane = l_; Fl.tid = w_ * 64 + l_; }
#define SEAM(k) do { if (IN(k) && IN((k) + 1)) xcd_barrier(bar); } while (0)

    bf16* hb = (bf16*)(ws + WS_HB); bf16* mb = (bf16*)(ws + WS_M); float* ss = (float*)(ws + WS_SS); float* halo = (float*)(ws + WS_HALO);
    unsigned char* proj = ws + WS_PROJ; bf16* act = (bf16*)(ws + WS_PROJ);

#ifndef SKIP_P0
    if (IN(0)) { for (int rep = 0; rep < REP_P0; ++rep) { OPQ_FRAME(F0); p0_prologue(F0, args); } }
#endif
    SEAM(0);

#pragma unroll 1
    for (int L = 0; L < DEPTH; ++L) {
        const int pb = 1 + 6 * L, li = L >> 1; const bool isB = (L & 1) != 0;
        if (IN(pb)) {
#ifndef SKIP_IN
            for (int rep = 0; rep < REP_IN; ++rep)
            if (!isB) {
                pg8::Gemm g{hb, (const bf16*)(ws + WS_W_INA) + (size_t)li * NA_PAD * DM, MTOK, NA_PAD, DM}; pg8::StaticOrder S; S.init(MTOK, NA_PAD, F.G, (int)blockIdx.x);
                if (f8_in(f8m, L)) {
                    { pg8::Gemm g8{(const bf16*)(ws + WS_M), (const bf16*)(ws + WS_W_INA8 + (size_t)li * NA_PAD * DM), MTOK, 1536, DM / 2}; pg8::BalOrder S8; S8.init(1536, (int)blockIdx.x, 2, 2, true);
                      EpiIn E{ss, proj, args.q_norm_g + L * 64, args.k_norm_g + L * 64, 0, W8I, 0};
                      pg8::gemm_phase<EpiIn, pg8::BalOrder, true, true, true>(F.lds + RING_OFF, g8, S8, E, F.wave); }
                    { pg8::Gemm g2{hb, (const bf16*)(ws + WS_W_INA) + (size_t)li * NA_PAD * DM + (size_t)1536 * DM, MTOK, NA_PAD - 1536, DM}; pg8::BalOrder S2; S2.init(NA_PAD - 1536, (int)blockIdx.x, 1, 1, false);
                      EpiIn E{ss, proj, args.q_norm_g + L * 64, args.k_norm_g + L * 64, 0, 1.0f, 6};
                      pg8::gemm_phase<EpiIn, pg8::BalOrder, true, true>(F.lds + RING_OFF, g2, S2, E, F.wave); }
                } else {
                EpiIn E{ss, proj, args.q_norm_g + L * 64, args.k_norm_g + L * 64, 0, 1.0f, 0};
                pg8::gemm_phase<EpiIn, pg8::StaticOrder, true, true>(F.lds + RING_OFF, g, S, E, F.wave); }
            } else {
                pg8::Gemm g{hb, (const bf16*)(ws + WS_W_INB) + (size_t)li * NB * DM, MTOK, NB, DM}; pg8::StaticOrder S; S.init(MTOK, NB, F.G, (int)blockIdx.x);
                if (f8_in(f8m, L)) { pg8::Gemm g8{(const bf16*)(ws + WS_M), (const bf16*)(ws + WS_W_INB) + (size_t)li * NB * DM, MTOK, NB, DM / 2};
                    EpiIn E{ss, proj, args.q_norm_g + L * 64, args.k_norm_g + L * 64, 1, W8I, 0};
                    pg8::gemm_phase<EpiIn, pg8::StaticOrder, true, true, true>(F.lds + RING_OFF, g8, S, E, F.wave); }
                else { EpiIn E{ss, proj, args.q_norm_g + L * 64, args.k_norm_g + L * 64, 1, 1.0f, 0};
                    pg8::gemm_phase<EpiIn, pg8::StaticOrder, true, true>(F.lds + RING_OFF, g, S, E, F.wave); }
            }
#endif
        }
        SEAM(pb);
#if defined(DBG_NODSA) || defined(DBG_NOBAND)
#ifdef DBG_NODSA
        const bool zero_m = !isB;
#else
        const bool zero_m = isB;
#endif
        if (IN(pb + 1) && zero_m) { for (size_t i = (size_t)blockIdx.x * 512 + threadIdx.x; i < (size_t)MTOK * DM / 8; i += (size_t)gridDim.x * 512) ((v4u*)mb)[i] = (v4u){0u, 0u, 0u, 0u}; }
        if (IN(pb + 1) && !zero_m) {
#else
        if (IN(pb + 1)) {
#endif
#ifndef SKIP_DSA
            if (!isB) {
                LAS float* t5l = (LAS float*)(F.lds + AUX_OFF);
                { OPQ_FRAME(Ft); for (int i = Ft.tid; i < 512; i += NWAVES * 64) t5l[i] = args.t5_bias[i] * LOG2E; }
                __syncthreads();
                dsa::Ctx C{(const bf16*)(proj + PA_QA), (const bf16*)(proj + PA_KA), (const bf16*)(proj + PA_VA), (const bf16*)(proj + PA_QI), (const bf16*)(proj + PA_KI), (const float*)(proj + PA_WI), mb, t5l, (unsigned short*)(proj + PA_SEL)};
#ifdef DBG_DSACOPY
                { int t_ = threadIdx.x; asm volatile("" : "+v"(t_));
                for (unsigned i = blockIdx.x * 512u + (unsigned)t_; i < (unsigned)MTOK * DM; i += gridDim.x * 512u) { const unsigned t = i >> 10, c = i & 1023u;
                    float v = bf_lo(C.QA[i]); v += bf_lo(C.KA[t * 256 + (c & 255)]); v += bf_lo(C.VA[t * 256 + (c & 255)]); v += bf_lo(C.QI[t * 512 + (c & 511)]); v += bf_lo(C.KI[t * 64 + (c & 63)]); v += C.WI[t * 8 + (c & 7)];
                    mb[i] = (bf16)f2bf(v * 0.01f); asm volatile("" ::: "memory"); } }
#else
                for (int rep = 0; rep < REP_DSA; ++rep) { OPQ_FRAME(F1); dsa::phase(F1, C); }
                xcd_barrier(bar);
                { OPQ_FRAME(F1b); att8::Ctx8 C8{(const unsigned char*)(proj + PA_QA), (const unsigned char*)(proj + PA_KA), (const unsigned short*)(proj + PA_SEL), mb, f8_out(f8m, L)};
#ifndef REP_ATT8
#define REP_ATT8 1
#endif
                  for (int rep = 0; rep < REP_ATT8; ++rep) { att8::phase(F1b, C8, args.t5_bias); __syncthreads(); } }
#endif
            }
#endif
#ifndef SKIP_BAND
            if (isB) {
                for (int rep = 0; rep < REP_BAND; ++rep) { OPQ_FRAME(F2); band::phase(F2, (const bf16*)proj, (const bf16*)(proj + PB_STRIDE), (const bf16*)(proj + 2 * PB_STRIDE), mb, args.rel_bias_b + (size_t)li * 513 * 16, f8_out(f8m, L)); }
            }
#endif
        }
        SEAM(pb + 1);
        if (IN(pb + 2)) {
#ifndef SKIP_OUT
            pg8::Gemm g{mb, (const bf16*)(ws + WS_W_OUT) + (size_t)L * DM * DM, MTOK, DM, DM}; pg8::StaticOrder S; S.init(MTOK, DM, F.G, (int)blockIdx.x);
#ifdef REP_OUT
            { EpiRes E0{nullptr, hb, (bf16*)proj, halo}; pg8::gemm_phase<EpiRes, pg8::StaticOrder, true, true>(F.lds + RING_OFF, g, S, E0, F.wave); }
#endif
            unsigned char* h8o = f8_ffn(f8m, L) ? proj + PX_HB8 : nullptr;
            if (f8_out(f8m, L)) { pg8::Gemm g8{mb, (const bf16*)(ws + WS_W_OUT) + (size_t)L * DM * DM, MTOK, DM, DM / 2};
                EpiResT<1 | SER_OUT> E{nullptr, hb, hb, ss, h8o};
                pg8::gemm_phase<EpiResT<1 | SER_OUT>, pg8::StaticOrder, true, true, true>(F.lds + RING_OFF, g8, S, E, F.wave); }
            else { EpiResT<SER_OUT> E{nullptr, hb, hb, ss, h8o, L == 0 ? args.x : nullptr};
                pg8::gemm_phase<EpiResT<SER_OUT>, pg8::StaticOrder, true, true>(F.lds + RING_OFF, g, S, E, F.wave); }
#endif
        }
        SEAM(pb + 2);
        if (IN(pb + 3)) {
#ifndef SKIP_UP
            for (int rep = 0; rep < REP_UP; ++rep) {
            pg8::Gemm g{hb, (const bf16*)(ws + WS_W_UP) + (size_t)L * NUP * DM, MTOK, NUP, DM}; pg8::StaticOrder S; S.init(MTOK, NUP, F.G, (int)blockIdx.x);
            LAS float* rl = (LAS float*)(F.lds + KS_OFF); int pm_a, pm_b; { pg8::Unit u0, u1; S.next(0, u0); S.next(10, u1); pm_a = u0.pm; pm_b = u1.pm; }
            { int l_; asm volatile("v_mbcnt_lo_u32_b32 %0, -1, 0\n\tv_mbcnt_hi_u32_b32 %0, -1, %0" : "=v"(l_)); up_rstd_table(ss, rl, pm_a, pm_b, F.wave * 64 + l_); }
#ifdef PROBE_UPK
            { EpiDummy E0{halo}; pg8::gemm_phase<EpiDummy, pg8::StaticOrder, true, true>(F.lds + RING_OFF, g, S, E0, F.wave); }
#endif
            if (f8_ffn(f8m, L)) { pg8::Gemm g8{(const bf16*)(proj + PX_HB8), (const bf16*)(ws + WS_W_UP) + (size_t)L * NUP * DM, MTOK, NUP, DM / 2};
                EpiUpT<true> E{ss, args.conv_w + (size_t)L * 3 * NUP, args.conv_b + (size_t)L * NUP, act, halo, (LAS float*)(F.lds + AUX_OFF)};
                pg8::gemm_phase<EpiUpT<true>, pg8::StaticOrder, true, true, true>(F.lds + RING_OFF, g8, S, E, F.wave); }
            else if (f8_dn(f8m, L)) { EpiUpT<false, true> E{ss, args.conv_w + (size_t)L * 3 * NUP, args.conv_b + (size_t)L * NUP, act, halo, (LAS float*)(F.lds + AUX_OFF)};
                pg8::gemm_phase<EpiUpT<false, true>, pg8::StaticOrder, true, true>(F.lds + RING_OFF, g, S, E, F.wave); }
            else { EpiUp E{ss, args.conv_w + (size_t)L * 3 * NUP, args.conv_b + (size_t)L * NUP, act, halo, (LAS float*)(F.lds + AUX_OFF)};
                pg8::gemm_phase<EpiUp, pg8::StaticOrder, true, true>(F.lds + RING_OFF, g, S, E, F.wave); } }
#endif
        }
        SEAM(pb + 3);
#ifndef SKIP_FIX
        if (IN(pb + 4)) for (int rep = 0; rep < REP_FIX; ++rep) { OPQ_FRAME(F3); if (f8_dn(f8m, L)) fixup_phase<true>(F3, args.conv_w + (size_t)L * 3 * NUP, args.conv_b + (size_t)L * NUP, halo, act); else fixup_phase<false>(F3, args.conv_w + (size_t)L * 3 * NUP, args.conv_b + (size_t)L * NUP, halo, act); }
#endif
        SEAM(pb + 4);
        if (IN(pb + 5)) {
#ifndef SKIP_DN
            pg8::Gemm g{act, (const bf16*)(ws + WS_W_DN) + (size_t)L * DM * FF, MTOK, DM, FF}; pg8::StaticOrder S; S.init(MTOK, DM, F.G, (int)blockIdx.x);
#ifdef REP_DN
            { EpiRes E0{nullptr, hb, mb, halo}; pg8::gemm_phase<EpiRes, pg8::StaticOrder, true, true>(F.lds + RING_OFF, g, S, E0, F.wave); }
#endif
            unsigned char* h8d = f8_in(f8m, L + 1) ? ws + WS_M : nullptr;
            if (f8_dn(f8m, L)) { pg8::Gemm g8{act, (const bf16*)(ws + WS_W_DN) + (size_t)L * DM * FF, MTOK, DM, FF / 2};
                EpiResT<1> E{L == DEPTH - 1 ? args.out : nullptr, hb, hb, ss, h8d};
                pg8::gemm_phase<EpiResT<1>, pg8::StaticOrder, true, true, true>(F.lds + RING_OFF, g8, S, E, F.wave); }
            else { EpiRes E{L == DEPTH - 1 ? args.out : nullptr, hb, hb, ss, h8d};
                pg8::gemm_phase<EpiRes, pg8::StaticOrder, true, true>(F.lds + RING_OFF, g, S, E, F.wave); }
#endif
        }
        SEAM(pb + 5);
    }
#undef IN
#undef SEAM
}

extern "C" void kernel_launch(void* const* d_in, const int* in_sizes, int n_in, void* d_out, int out_size, void* d_ws, size_t ws_size, hipStream_t stream) {
    static int grid = 0;
    if (grid == 0) {
        if (n_in != 14 || in_sizes[0] != MTOK * DM || out_size != MTOK * DM || ws_size < WS_END) { fprintf(stderr, "kernel_launch: unexpected shapes / workspace (n_in %d, ws %zu); nothing launched\n", n_in, ws_size); grid = -1; return; }
        int dev = 0, cus = 0, per_cu = 0;
        if (hipGetDevice(&dev) != hipSuccess || hipDeviceGetAttribute(&cus, hipDeviceAttributeMultiprocessorCount, dev) != hipSuccess) { grid = -1; return; }
        if (hipFuncSetAttribute((const void*)mega_fwd, hipFuncAttributeMaxDynamicSharedMemorySize, LDS_BYTES) != hipSuccess) { fprintf(stderr, "kernel_launch: hipFuncSetAttribute failed\n"); grid = -1; return; }
        if (hipOccupancyMaxActiveBlocksPerMultiprocessor(&per_cu, (const void*)mega_fwd, NWAVES * 64, LDS_BYTES) != hipSuccess || per_cu < 1) { fprintf(stderr, "kernel_launch: occupancy query reports %d blocks per CU\n", per_cu); }
        (void)hipGetLastError();
        if (cus != GRID) { fprintf(stderr, "kernel_launch: built for a %d-CU device, found %d; nothing launched\n", GRID, cus); grid = -1; return; }
        grid = GRID;
    }
    if (grid < 0) return;
    if (hipMemsetAsync((char*)d_ws + WS_CTL, 0, CTL_ZERO_BYTES, stream) != hipSuccess) return;
    Args a{};
    a.x = (const float*)d_in[0]; a.attn_norm_g = (const float*)d_in[1]; a.w_in_a = (const float*)d_in[2]; a.w_in_b = (const float*)d_in[3]; a.q_norm_g = (const float*)d_in[4];
    a.k_norm_g = (const float*)d_in[5]; a.t5_bias = (const float*)d_in[6]; a.rel_bias_b = (const float*)d_in[7]; a.w_out = (const float*)d_in[8]; a.ffn_norm_g = (const float*)d_in[9];
    a.w_up = (const float*)d_in[10]; a.conv_w = (const float*)d_in[11]; a.conv_b = (const float*)d_in[12]; a.w_down = (const float*)d_in[13];
    a.out = (float*)d_out; a.ws = (unsigned char*)d_ws; a.f8m = F8M_ALL;
#if MK_N_LAUNCHES == 1
    a.ph_lo = 0; a.ph_hi = N_PHASES; a.li = 0;
    hipLaunchKernelGGL(mega_fwd, dim3(grid), dim3(NWAVES * 64), LDS_BYTES, stream, a);
#else
    for (int p = 0; p < N_PHASES; ++p) { a.ph_lo = p; a.ph_hi = p + 1; a.li = p; hipLaunchKernelGGL(mega_fwd, dim3(grid), dim3(NWAVES * 64), LDS_BYTES, stream, a); }
#endif
}
```
